# Optimizing an MI355X kernel written in HIP

```python
import math
import jax
import jax.numpy as jnp
from jax import lax
import numpy as np

D_MODEL = 1024
BATCH = 2
SEQ = 8192
DEPTH = 1

N_HEADS = 8
HEAD_DIM = 64
ATTN_WIDTH = N_HEADS * HEAD_DIM
ROPE_THETA = 10000.0
MOBA_BLOCK = 256
MOBA_TOPK = 3
Q_CHUNK = 64
SSM_GROUP_SIZE = 16
SSM_GROUPS = 32
SSM_WIDTH = SSM_GROUPS * SSM_GROUP_SIZE
SSM_STATE = 64
DT_MIN = 0.001
DT_MAX = 0.1
IN_WIDTH = SSM_WIDTH + 3 * ATTN_WIDTH + 2 * D_MODEL
N_EXPERTS = 32
TOP_K = 4
D_FF = D_MODEL
SWIGLU_ALPHA = 1.702
SWIGLU_LIMIT = 7.0
MOE_BLOCK = 128
NORM_EPS = 1e-6
NEG_INF = -1e30

kernel_name = "hybrid_s5_moba_moe_block"


def rms_norm(t, g):
    tf = t.astype(jnp.float32)
    tf = tf * lax.rsqrt(jnp.mean(tf * tf, axis=-1, keepdims=True) + NORM_EPS)
    return tf * g.astype(jnp.float32)


def apply_rope(t, positions):
    half = HEAD_DIM // 2
    inv_freq = ROPE_THETA ** (-jnp.arange(half, dtype=jnp.float32) / half)
    ang = positions.astype(jnp.float32)[..., None] * inv_freq
    cos = jnp.cos(ang)[:, :, None, :]
    sin = jnp.sin(ang)[:, :, None, :]
    tf = t.astype(jnp.float32)
    t1, t2 = tf[..., :half], tf[..., half:]
    return jnp.concatenate([t1 * cos - t2 * sin, t2 * cos + t1 * sin], axis=-1)


def _linear_recurrence(left, right):
    a_l, b_l = left
    a_r, b_r = right
    return a_r * a_l, a_r * b_l + b_r


def s5_mixer(u, lam_re, lam_im, log_dt, b_re, b_im, c_re, c_im, d_skip, w_glu):
    bsz, seq, _ = u.shape
    uf = u.astype(jnp.float32)
    ug = uf.reshape(bsz, seq, SSM_GROUPS, SSM_GROUP_SIZE)
    lam = lax.complex(lam_re.astype(jnp.float32), lam_im.astype(jnp.float32))
    dt = jnp.exp(log_dt.astype(jnp.float32))[:, None]
    lam_bar = jnp.exp(lam * dt)
    b_mat = lax.complex(b_re.astype(jnp.float32), b_im.astype(jnp.float32))
    c_mat = lax.complex(c_re.astype(jnp.float32), c_im.astype(jnp.float32))
    b_bar = ((lam_bar - 1.0) / lam)[..., None] * b_mat
    bu = jnp.einsum('gpc,bsgc->bsgp', b_bar, ug.astype(jnp.complex64))
    a = jnp.broadcast_to(lam_bar, bu.shape)
    _, states = lax.associative_scan(_linear_recurrence, (a, bu), axis=1)
    y = jnp.einsum('gcp,bsgp->bsgc', c_mat, states).real.reshape(bsz, seq, SSM_WIDTH)
    y = y + d_skip.astype(jnp.float32) * uf
    y = jax.nn.gelu(y)
    y = y * jax.nn.sigmoid(y @ w_glu.astype(jnp.float32))
    return y


def moba_attention(q, k, v):
    bsz, nh, seq, hd = q.shape
    qf, kf, vf = q.astype(jnp.float32), k.astype(jnp.float32), v.astype(jnp.float32)
    nb = -(-seq // MOBA_BLOCK)
    pad = nb * MOBA_BLOCK - seq
    kb = jnp.pad(kf, ((0, 0), (0, 0), (0, pad), (0, 0))).reshape(bsz, nh, nb, MOBA_BLOCK, hd)
    vb = jnp.pad(vf, ((0, 0), (0, 0), (0, pad), (0, 0))).reshape(bsz, nh, nb, MOBA_BLOCK, hd)
    k_mean = jnp.mean(kb, axis=3)
    n_sel = min(MOBA_TOPK, nb)
    scale = HEAD_DIM ** -0.5
    n_chunks = seq // Q_CHUNK
    q_chunks = qf.reshape(bsz, nh, n_chunks, Q_CHUNK, hd).transpose(2, 0, 1, 3, 4)
    gather_blocks = jax.vmap(jax.vmap(lambda blocks, idx: blocks[idx]))
    block_ids = jnp.arange(nb)
    offs = jnp.arange(MOBA_BLOCK)

    def chunk_attend(args):
        ci, qi = args
        q_pos = ci * Q_CHUNK + jnp.arange(Q_CHUNK)
        q_blk = q_pos // MOBA_BLOCK
        own = (ci * Q_CHUNK) // MOBA_BLOCK
        gate = jnp.einsum('bhqd,bhnd->bhqn', qi, k_mean)
        gate = jnp.where(block_ids[None, :] < q_blk[:, None], gate, NEG_INF)
        _, sel = lax.top_k(gate, n_sel)
        sel_ok = sel < q_blk[:, None]
        k_sel = gather_blocks(kb, sel)
        v_sel = gather_blocks(vb, sel)
        s_sel = jnp.einsum('bhqd,bhqnld->bhqnl', qi, k_sel) * scale
        s_sel = jnp.where(sel_ok[..., None], s_sel, NEG_INF).reshape(bsz, nh, Q_CHUNK, n_sel * MOBA_BLOCK)
        k_own = lax.dynamic_index_in_dim(kb, own, axis=2, keepdims=False)
        v_own = lax.dynamic_index_in_dim(vb, own, axis=2, keepdims=False)
        s_own = jnp.einsum('bhqd,bhld->bhql', qi, k_own) * scale
        k_pos = own * MOBA_BLOCK + offs
        s_own = jnp.where(k_pos[None, :] <= q_pos[:, None], s_own, NEG_INF)
        p = jax.nn.softmax(jnp.concatenate([s_sel, s_own], axis=-1), axis=-1)
        p_sel = p[..., :n_sel * MOBA_BLOCK].reshape(bsz, nh, Q_CHUNK, n_sel, MOBA_BLOCK)
        p_own = p[..., n_sel * MOBA_BLOCK:]
        return (jnp.einsum('bhqnl,bhqnld->bhqd', p_sel, v_sel)
                + jnp.einsum('bhql,bhld->bhqd', p_own, v_own))

    out = lax.map(chunk_attend, (jnp.arange(n_chunks), q_chunks))
    return out.transpose(1, 2, 0, 3, 4).reshape(bsz, nh, seq, hd)


def moe_ffn(h, router_w, router_b, w_gate, b_gate, w_up, b_up, w_down, b_down):
    bsz, seq, d = h.shape
    n_tok = bsz * seq
    hf = h.reshape(n_tok, d).astype(jnp.float32)
    logits = hf @ router_w.astype(jnp.float32) + router_b.astype(jnp.float32)
    top_val, top_idx = lax.top_k(logits, TOP_K)
    top_w = jax.nn.softmax(top_val, axis=-1)
    n_assign = n_tok * TOP_K
    eid = top_idx.reshape(n_assign)
    order = jnp.argsort(eid)
    s_eid = eid[order]
    s_tok = order // TOP_K
    s_w = top_w.reshape(n_assign)[order]
    counts = jnp.bincount(eid, length=N_EXPERTS)
    starts = jnp.cumsum(counts) - counts
    padded = (counts + MOE_BLOCK - 1) // MOE_BLOCK * MOE_BLOCK
    p_ends = jnp.cumsum(padded)
    p_starts = p_ends - padded
    dest = p_starts[s_eid] + jnp.arange(n_assign) - starts[s_eid]
    n_blocks = -(-n_assign // MOE_BLOCK) + N_EXPERTS
    n_rows = n_blocks * MOE_BLOCK
    row_tok = jnp.full((n_rows,), n_tok, dtype=jnp.int32).at[dest].set(s_tok.astype(jnp.int32))
    row_w = jnp.zeros((n_rows,), jnp.float32).at[dest].set(s_w)
    blk_exp = jnp.minimum(jnp.searchsorted(p_ends, jnp.arange(n_blocks) * MOE_BLOCK, side='right'),
                          N_EXPERTS - 1)
    h_pad = jnp.concatenate([hf, jnp.zeros((1, d), jnp.float32)], axis=0)
    xs = h_pad[row_tok].reshape(n_blocks, MOE_BLOCK, d)

    def expert_block(args):
        xb, e = args
        g = xb @ w_gate[e].astype(jnp.float32) + b_gate[e].astype(jnp.float32)
        u = xb @ w_up[e].astype(jnp.float32) + b_up[e].astype(jnp.float32)
        g = jnp.minimum(g, SWIGLU_LIMIT)
        u = jnp.clip(u, -SWIGLU_LIMIT, SWIGLU_LIMIT)
        act = g * jax.nn.sigmoid(SWIGLU_ALPHA * g) * (u + 1.0)
        return act @ w_down[e].astype(jnp.float32) + b_down[e].astype(jnp.float32)

    yb = lax.map(expert_block, (xs, blk_exp)).reshape(n_rows, d)
    y = jnp.zeros((n_tok + 1, d), jnp.float32).at[row_tok].add(yb * row_w[:, None])
    return y[:n_tok].reshape(bsz, seq, d)


def setup_inputs(seed: int = 0) -> dict:
    key = jax.random.key(seed)
    ks = jax.random.split(key, 32)
    f32 = jnp.float32
    nrm = lambda k, shape, s: jax.random.normal(k, shape, f32) * s
    L, D, G, P, HG, E, F = DEPTH, D_MODEL, SSM_GROUPS, SSM_STATE, SSM_GROUP_SIZE, N_EXPERTS, D_FF
    x = jax.random.normal(ks[0], (BATCH, SEQ, D), f32)
    c = jax.random.normal(ks[1], (BATCH, D), f32)
    offset = jax.random.randint(ks[2], (BATCH, 1), 0, 1024, dtype=jnp.int32)
    positions = (jnp.arange(SEQ, dtype=jnp.int32)[None, :] + offset).astype(jnp.int32)
    lam_im0 = jnp.pi * jnp.arange(P, dtype=f32)
    return {
        'x': x,
        'c': c,
        'positions': positions,
        'ada_w': nrm(ks[3], (L, D, 6 * D), 0.5 * D ** -0.5),
        'ada_b': nrm(ks[4], (L, 6 * D), 0.01),
        'mix_pre_g': 1.0 + nrm(ks[5], (L, D), 0.05),
        'mix_post_g': 1.0 + nrm(ks[6], (L, D), 0.05),
        'ffn_pre_g': 1.0 + nrm(ks[7], (L, D), 0.05),
        'ffn_post_g': 1.0 + nrm(ks[8], (L, D), 0.05),
        'w_in': nrm(ks[9], (L, D, IN_WIDTH), D ** -0.5),
        'ssm_lam_re': -0.5 + nrm(ks[10], (L, G, P), 0.01),
        'ssm_lam_im': lam_im0 + nrm(ks[11], (L, G, P), 0.01),
        'ssm_log_dt': jax.random.uniform(ks[12], (L, G), f32, math.log(DT_MIN), math.log(DT_MAX)),
        'ssm_b_re': nrm(ks[13], (L, G, P, HG), (2 * HG) ** -0.5),
        'ssm_b_im': nrm(ks[14], (L, G, P, HG), (2 * HG) ** -0.5),
        'ssm_c_re': nrm(ks[15], (L, G, HG, P), (2 * P) ** -0.5),
        'ssm_c_im': nrm(ks[16], (L, G, HG, P), (2 * P) ** -0.5),
        'ssm_d': nrm(ks[17], (L, SSM_WIDTH), 1.0),
        'ssm_w_glu': nrm(ks[18], (L, SSM_WIDTH, SSM_WIDTH), SSM_WIDTH ** -0.5),
        'w_ssm_branch': nrm(ks[19], (L, SSM_WIDTH, D), SSM_WIDTH ** -0.5),
        'w_attn_branch': nrm(ks[20], (L, ATTN_WIDTH, D), ATTN_WIDTH ** -0.5),
        'w_out': nrm(ks[21], (L, D, D), D ** -0.5),
        'router_w': nrm(ks[22], (L, D, E), D ** -0.5),
        'router_b': nrm(ks[23], (L, E), 0.01),
        'w_gate': nrm(ks[24], (L, E, D, F), D ** -0.5),
        'b_gate': nrm(ks[25], (L, E, F), 0.01),
        'w_up': nrm(ks[26], (L, E, D, F), D ** -0.5),
        'b_up': nrm(ks[27], (L, E, F), 0.01),
        'w_down': nrm(ks[28], (L, E, F, D), F ** -0.5),
        'b_down': nrm(ks[29], (L, E, D), 0.01),
    }


def reference(x, c, positions, ada_w, ada_b, mix_pre_g, mix_post_g, ffn_pre_g, ffn_post_g,
              w_in, ssm_lam_re, ssm_lam_im, ssm_log_dt, ssm_b_re, ssm_b_im, ssm_c_re, ssm_c_im,
              ssm_d, ssm_w_glu, w_ssm_branch, w_attn_branch, w_out,
              router_w, router_b, w_gate, b_gate, w_up, b_up, w_down, b_down):
    bsz, seq, _ = x.shape
    dtype = x.dtype
    cond = jax.nn.silu(c.astype(jnp.float32))
    splits = [SSM_WIDTH, SSM_WIDTH + ATTN_WIDTH, SSM_WIDTH + 2 * ATTN_WIDTH,
              SSM_WIDTH + 3 * ATTN_WIDTH, SSM_WIDTH + 3 * ATTN_WIDTH + D_MODEL]
    for l in range(DEPTH):
        ada = cond @ ada_w[l].astype(jnp.float32) + ada_b[l].astype(jnp.float32)
        sh_m, sc_m, gt_m, sh_f, sc_f, gt_f = [a[:, None, :] for a in jnp.split(ada, 6, axis=-1)]

        h = (rms_norm(x, mix_pre_g[l]) * (1.0 + sc_m) + sh_m).astype(dtype)
        proj = h @ w_in[l]
        u_s, q, k, v, g_s, g_a = jnp.split(proj, splits, axis=-1)
        y_s = s5_mixer(u_s, ssm_lam_re[l], ssm_lam_im[l], ssm_log_dt[l], ssm_b_re[l], ssm_b_im[l],
                       ssm_c_re[l], ssm_c_im[l], ssm_d[l], ssm_w_glu[l])
        q = apply_rope(q.reshape(bsz, seq, N_HEADS, HEAD_DIM), positions).transpose(0, 2, 1, 3)
        k = apply_rope(k.reshape(bsz, seq, N_HEADS, HEAD_DIM), positions).transpose(0, 2, 1, 3)
        v = v.reshape(bsz, seq, N_HEADS, HEAD_DIM).transpose(0, 2, 1, 3)
        y_a = moba_attention(q, k, v).transpose(0, 2, 1, 3).reshape(bsz, seq, ATTN_WIDTH)
        merged = (jax.nn.sigmoid(g_s.astype(jnp.float32)) * (y_s @ w_ssm_branch[l].astype(jnp.float32))
                  + jax.nn.sigmoid(g_a.astype(jnp.float32)) * (y_a @ w_attn_branch[l].astype(jnp.float32)))
        mix = merged @ w_out[l].astype(jnp.float32)
        x = (x.astype(jnp.float32) + gt_m * rms_norm(mix, mix_post_g[l])).astype(dtype)

        h2 = (rms_norm(x, ffn_pre_g[l]) * (1.0 + sc_f) + sh_f).astype(dtype)
        ff = moe_ffn(h2, router_w[l], router_b[l], w_gate[l], b_gate[l], w_up[l], b_up[l],
                     w_down[l], b_down[l])
        x = (x.astype(jnp.float32) + gt_f * rms_norm(ff, ffn_post_g[l])).astype(dtype)
    return x
```

```cpp
#include <hip/hip_runtime.h>
#include <cstdio>
#include <cstdint>
#define MK_N_LAUNCHES 15
namespace pg8 {
#define PG8_LAS __attribute__((address_space(3)))
typedef unsigned short bf16_t;
typedef short bf16x8 __attribute__((ext_vector_type(8)));
typedef float f32x4 __attribute__((ext_vector_type(4)));
typedef unsigned u32x4 __attribute__((ext_vector_type(4)));
typedef unsigned u32x2 __attribute__((ext_vector_type(2)));
constexpr int BM = 256, BK = 64, HALF = 128, HTB = HALF * BK * 2  , STAGE_BYTES = 8 * HTB, NXCD = 8, WGM = 8;

__host__ __device__ __forceinline__ int lds_byte(int r, int c) { const int st = (r >> 4) * 2 + (c >> 5), rr = r & 15, cc = c & 31, ob = rr * 64 + cc * 2; return st * 1024 + (ob ^ (((ob >> 9) & 1) << 5)); }
__host__ __device__ __forceinline__ void stage_rc(int b, int& R, int& C) { const int st = b / 1024, sb = b % 1024, swz = sb ^ (((sb >> 9) & 1) << 5); R = (st >> 1) * 16 + swz / 64; C = (st & 1) * 32 + (swz % 64) / 2; }

struct Unit { int arow, brow, pm, pn, e, nrow; };
struct Gemm { const bf16_t* A; const bf16_t* Bt; int lda, ldb, K; };

struct DenseOrder {
    int nM, nN, nwg, G, c;
    __device__ __forceinline__ void init(int M, int N, int G_, int c_) { nM = M / BM; nN = N / BM; nwg = nM * nN; G = G_; c = c_; }
    __device__ __forceinline__ bool next(int i, Unit& u) const {
        const long L = (long)i * G + c; if (L >= nwg) return false;
        int wgid = (int)L; { const int q = nwg / NXCD, r = nwg % NXCD, xcd = wgid % NXCD, off = wgid / NXCD; wgid = (xcd < r ? xcd * (q + 1) : r * (q + 1) + (xcd - r) * q) + off; }
        const int nig = WGM * nN, gid = wgid / nig, fm = gid * WGM, gsz = (nM - fm) < WGM ? (nM - fm) : WGM;
        u.pm = fm + ((wgid % nig) % gsz); u.pn = (wgid % nig) / gsz; u.arow = u.pm * BM; u.brow = u.pn * BM; u.e = 0; u.nrow = BM; return true;
    }
};

template <class Epi, class Sched>
__device__ __forceinline__ void gemm_phase(PG8_LAS unsigned char* lds, const Gemm g, const Sched& S, const Epi& E) {
    const int tid = threadIdx.x, wid = __builtin_amdgcn_readfirstlane(tid >> 6), lane = tid & 63, wr = wid >> 2, wc = wid & 3, fr = lane & 15, fq = lane >> 4;
    const int K = g.K, nt = K / BK;
    unsigned voffA[2], voffB[2];
#pragma unroll
    for (int i = 0; i < 2; ++i) { int R, C; stage_rc(tid * 16 + i * 8192, R, C);
        voffA[i] = (unsigned)(R * g.lda + C) * 2u; voffB[i] = (unsigned)(R * g.ldb + C) * 2u; }
    const size_t kstep = (size_t)(BK * 2);
    const size_t hstepA = (size_t)HALF * g.lda * 2, hstepB = (size_t)HALF * g.ldb * 2;
    const size_t rowA = (size_t)g.lda * 2, rowB = (size_t)g.ldb * 2;
    const unsigned ldsw = (unsigned)wid * 1024u;
    const int aoff = lds_byte(wr * 64 + fr, fq * 8), boff = lds_byte(wc * 32 + fr, fq * 8);
#define PG8_SA(b, h) (((b) * 2 + (h)) * HTB)
#define PG8_SB(b, h) ((4 + (b) * 2 + (h)) * HTB)
#define PG8_STAGE(bufoff, gbase, voff) do { _Pragma("unroll") for (int _i = 0; _i < 2; ++_i) \
        __builtin_amdgcn_global_load_lds((const unsigned*)((const char*)(gbase) + (voff)[_i]), (PG8_LAS unsigned*)(lds + (bufoff) + ldsw + _i * 8192), 16, 0, 0); } while (0)
#define PG8_LDA(dst, b, h) do { _Pragma("unroll") for (int m = 0; m < 4; ++m) _Pragma("unroll") for (int k = 0; k < 2; ++k) dst[m][k] = *(const PG8_LAS bf16x8*)(lds + PG8_SA(b, h) + aoff + m * 2048 + k * 1024); } while (0)
#define PG8_LDB(dst, b, h) do { _Pragma("unroll") for (int n = 0; n < 2; ++n) _Pragma("unroll") for (int k = 0; k < 2; ++k) dst[n][k] = *(const PG8_LAS bf16x8*)(lds + PG8_SB(b, h) + boff + n * 2048 + k * 1024); } while (0)
#define PG8_MMA(ai, bj, At, Bt) do { __builtin_amdgcn_s_setprio(1); _Pragma("unroll") for (int m = 0; m < 4; ++m) _Pragma("unroll") for (int n = 0; n < 2; ++n) _Pragma("unroll") for (int k = 0; k < 2; ++k) \
        acc[ai][bj][m][n] = __builtin_amdgcn_mfma_f32_16x16x32_bf16(Bt[n][k], At[m][k], acc[ai][bj][m][n], 0, 0, 0); __builtin_amdgcn_s_setprio(0); } while (0)
#define PG8_WAIT_V(n) asm volatile("s_waitcnt vmcnt(" #n ")" ::: "memory")
#define PG8_WAIT_L(n) asm volatile("s_waitcnt lgkmcnt(" #n ")" ::: "memory")
#define PG8_BAR __builtin_amdgcn_s_barrier()
#define PG8_SCHED __builtin_amdgcn_sched_barrier(0)
    Unit cur, nxt; int ui = 0;
    if (!S.next(0, cur)) return;
    f32x4 acc[2][2][4][2];
#pragma unroll
    for (int a = 0; a < 2; ++a)
#pragma unroll
        for (int b = 0; b < 2; ++b)
#pragma unroll
            for (int m = 0; m < 4; ++m)
#pragma unroll
                for (int n = 0; n < 2; ++n) acc[a][b][m][n] = (f32x4){0.f, 0.f, 0.f, 0.f};
    bf16x8 At[4][2], B0[2][2], B1[2][2];
    const char* cA = (const char*)g.A + (size_t)cur.arow * rowA; const char* cB = (const char*)g.Bt + (size_t)cur.brow * rowB;
    PG8_STAGE(PG8_SB(0, 0), cB, voffB); PG8_STAGE(PG8_SB(0, 1), cB + hstepB, voffB); PG8_STAGE(PG8_SA(0, 0), cA, voffA); PG8_STAGE(PG8_SA(0, 1), cA + hstepA, voffA);
    if (wr == 1) PG8_BAR;
    PG8_WAIT_V(2); PG8_BAR;
    PG8_STAGE(PG8_SB(1, 0), cB + kstep, voffB); PG8_STAGE(PG8_SA(1, 0), cA + kstep, voffA); PG8_STAGE(PG8_SB(1, 1), cB + hstepB + kstep, voffB);
    PG8_WAIT_V(6); PG8_BAR;
    for (;;) {
        const bool has_next = S.next(ui + 1, nxt);
        const char* nA = has_next ? (const char*)g.A + (size_t)nxt.arow * rowA : cA; const char* nB = has_next ? (const char*)g.Bt + (size_t)nxt.brow * rowB : cB;
        for (int t = 0; t < nt; t += 2) {
            const bool last = (t == nt - 2);
            const char* a1 = cA + (size_t)(t + 1) * kstep;
            const char* a2 = last ? nA : cA + (size_t)(t + 2) * kstep; const char* b2 = last ? nB : cB + (size_t)(t + 2) * kstep;
            const char* a3 = a2 + kstep; const char* b3 = b2 + kstep;
            PG8_LDB(B0, 0, 0); PG8_LDB(B1, 0, 1); PG8_SCHED; PG8_LDA(At, 0, 0); PG8_STAGE(PG8_SA(1, 1), a1 + hstepA, voffA);
            PG8_WAIT_V(8); PG8_WAIT_L(0); PG8_BAR; PG8_MMA(0, 0, At, B0); PG8_MMA(0, 1, At, B1); PG8_BAR; PG8_SCHED;
            PG8_LDA(At, 0, 1); PG8_STAGE(PG8_SB(0, 0), b2, voffB); PG8_STAGE(PG8_SB(0, 1), b2 + hstepB, voffB); PG8_STAGE(PG8_SA(0, 0), a2, voffA);
            PG8_WAIT_V(8); PG8_WAIT_L(0); PG8_BAR; PG8_MMA(1, 0, At, B0); PG8_MMA(1, 1, At, B1); PG8_BAR; PG8_SCHED;
            PG8_LDB(B0, 1, 0); PG8_LDB(B1, 1, 1); PG8_SCHED; PG8_LDA(At, 1, 0); PG8_STAGE(PG8_SA(0, 1), a2 + hstepA, voffA);
            PG8_WAIT_V(8); PG8_WAIT_L(0); PG8_BAR; PG8_MMA(0, 0, At, B0); PG8_MMA(0, 1, At, B1); PG8_BAR; PG8_SCHED;
            PG8_LDA(At, 1, 1); PG8_STAGE(PG8_SB(1, 0), b3, voffB); PG8_STAGE(PG8_SB(1, 1), b3 + hstepB, voffB); PG8_STAGE(PG8_SA(1, 0), a3, voffA);
            PG8_WAIT_V(8); PG8_WAIT_L(0); PG8_BAR; PG8_MMA(1, 0, At, B0); PG8_MMA(1, 1, At, B1); PG8_BAR; PG8_SCHED;
        }
        if (wr == 0) PG8_BAR;
        E(acc, cur, wr, wc, fr, fq);
        if (!has_next) break;
#pragma unroll
        for (int a = 0; a < 2; ++a)
#pragma unroll
            for (int b = 0; b < 2; ++b)
#pragma unroll
                for (int m = 0; m < 4; ++m)
#pragma unroll
                    for (int n = 0; n < 2; ++n) acc[a][b][m][n] = (f32x4){0.f, 0.f, 0.f, 0.f};
        cur = nxt; cA = nA; cB = nB; ++ui;
        if (wr == 1) PG8_BAR;
    }
    PG8_WAIT_V(0);
    PG8_BAR;
#undef PG8_SA
#undef PG8_SB
#undef PG8_STAGE
#undef PG8_LDA
#undef PG8_LDB
#undef PG8_MMA
#undef PG8_WAIT_V
#undef PG8_WAIT_L
#undef PG8_BAR
#undef PG8_SCHED
}
}
constexpr int NWAVES = 8;
constexpr int BATCH = 2, SEQ = 8192, T = BATCH * SEQ, D = 1024, NH = 8, HD = 64, AW = 512, SW = 512, NG = 32, NP = 64, GS16 = 16;
constexpr int NE = 32, FF = 1024, INW = 4096, TOPK = 4, NBLK = SEQ / 256;
constexpr float NORM_EPS = 1e-6f;
constexpr float C2 = 0.125f * 1.4426950408889634f;
constexpr int S5CH = 256, S5NC = SEQ / S5CH;
constexpr int XROWS = T * TOPK + 256;

constexpr size_t MiB = 1u << 20;
constexpr size_t WS_CTL = 0, CTL_ZERO_BYTES = 1 * MiB;
constexpr size_t WS_ADA = 1 * MiB;
constexpr size_t WS_ADAF = WS_ADA + 832 * 1024;
constexpr size_t WS_ROPE = 2 * MiB;
constexpr size_t WS_S5P = 6 * MiB;
constexpr size_t WS_S5E = 7 * MiB;
constexpr size_t WS_S5S = 8 * MiB;
constexpr size_t WS_ROUTE = 9 * MiB;
constexpr size_t WS_WIN_T = 18 * MiB, WS_WGLU_T = 26 * MiB, WS_WSB_T = 27 * MiB, WS_WAB_T = 28 * MiB, WS_WOUT_T = 29 * MiB;
constexpr size_t WS_WGU_T = 32 * MiB, WS_WDN_T = 160 * MiB;
constexpr size_t WS_XN = 224 * MiB;
constexpr size_t WS_UA = 256 * MiB, WS_Q = 280 * MiB, WS_K = 296 * MiB, WS_V = 312 * MiB, WS_VT = 328 * MiB;
constexpr size_t WS_MIX = 256 * MiB;
constexpr size_t WS_GS = 344 * MiB, WS_GA = 376 * MiB;
constexpr size_t WS_YG = 408 * MiB, WS_Y2 = 424 * MiB, WS_YA = 440 * MiB;
constexpr size_t WS_M1 = 456 * MiB;
constexpr size_t WS_H2 = 480 * MiB;
constexpr size_t WS_XG = 224 * MiB, WS_YB = 224 * MiB;
constexpr size_t WS_H1 = WS_XG + (size_t)XROWS * D * 2;
constexpr size_t WS_END = 512 * MiB;
static_assert(WS_H1 + (size_t)XROWS * FF * 2 <= WS_H2 + 1 * MiB + 0 && WS_H1 + (size_t)XROWS * FF * 2 <= WS_END, "ws map");
constexpr int CW_TMO = 0, CW_CODE = 1, CW_BAR = 4096, CW_ECNT = 8192, CW_KM = 16384;
static_assert((CW_KM + BATCH * NH * NBLK * HD) * 4 <= (int)CTL_ZERO_BYTES, "ctl");

constexpr int RING_OFF = 0, RING_BYTES = 131072;
constexpr int LDSCTL_OFF = 152 * 1024, MISC_OFF = LDSCTL_OFF + 320;
constexpr int LDS_BYTES = 156 * 1024;

#define GAS __attribute__((address_space(1)))
#define LAS __attribute__((address_space(3)))
typedef unsigned short bf16;
typedef unsigned v4u __attribute__((ext_vector_type(4)));
typedef unsigned v2u __attribute__((ext_vector_type(2)));
typedef float f32x4 __attribute__((ext_vector_type(4)));
typedef GAS unsigned gu32;
#define RLX_AGENT __ATOMIC_RELAXED, __HIP_MEMORY_SCOPE_AGENT
#define LDS_WAIT() asm volatile("s_waitcnt lgkmcnt(0)" ::: "memory")
#define VM_WAIT() asm volatile("s_waitcnt vmcnt(0)" ::: "memory")
__device__ __forceinline__ unsigned f2bf(float f) { unsigned u = __builtin_bit_cast(unsigned, f); return (u + 0x7fffu + ((u >> 16) & 1u)) >> 16; }
__device__ __forceinline__ unsigned pk2(float lo, float hi) { return f2bf(lo) | (f2bf(hi) << 16); }
__device__ __forceinline__ float bflo(unsigned w) { return __builtin_bit_cast(float, w << 16); }
__device__ __forceinline__ float bfhi(unsigned w) { return __builtin_bit_cast(float, w & 0xffff0000u); }
__device__ __forceinline__ float bf2f(bf16 h) { return __builtin_bit_cast(float, (unsigned)h << 16); }
__device__ __forceinline__ float sigmoidf_(float x) { return 1.f / (1.f + __expf(-x)); }
__device__ __forceinline__ float gelu_tanh(float x) { const float u = 0.7978845608028654f * (x + 0.044715f * x * x * x); const float e = __expf(-2.f * fabsf(u)); const float th = (1.f - e) / (1.f + e); return 0.5f * x * (1.f + (u < 0.f ? -th : th)); }

#define XB_TMO      128
#define XB_XCNT(j)  (256  + 64 * (j))
#define XB_XSUB(j)  (1280 + 64 * (j))
#define XB_XGEN(j)  (2304 + 64 * (j))
#define XB_TOP      3328
#define XB_TOPGEN   3392
#define XCD_BAR_WORDS 3456
#define XB_SPIN_CAP (1u << 18)
__device__ __forceinline__ unsigned xb_ld(unsigned* p)              { return __hip_atomic_load(p, __ATOMIC_RELAXED, __HIP_MEMORY_SCOPE_AGENT); }
__device__ __forceinline__ unsigned xb_add(unsigned* p, unsigned v) { return __hip_atomic_fetch_add(p, v, __ATOMIC_RELAXED, __HIP_MEMORY_SCOPE_AGENT); }
__device__ __forceinline__ unsigned xb_xcc_id() { return (unsigned)__builtin_amdgcn_s_getreg((3 << 11) | 20) & 0xFu; }
#define XB_SPIN(cond, bar) do { unsigned _sp = 0; while (cond) { __builtin_amdgcn_s_sleep(1); \
    if ((++_sp & 255u) == 0u) { if (xb_ld(&(bar)[XB_TMO])) break; if (_sp > XB_SPIN_CAP) { atomicAdd(&(bar)[XB_TMO], 1u); break; } } } } while (0)
struct XcdBarrier { unsigned* bar; unsigned x; volatile LAS unsigned* st; };
__device__ __forceinline__ XcdBarrier xcd_barrier_post(unsigned* bar, volatile LAS unsigned* st) {
    XcdBarrier b; b.bar = bar; b.x = xb_xcc_id(); b.st = st;
    if (threadIdx.x == 0) (void)xb_add(&bar[XB_XCNT(b.x)], 1u);
    return b;
}
__device__ __forceinline__ void xcd_barrier_complete(unsigned* bar, unsigned x, unsigned& nloc, unsigned& nx) {
    const unsigned G = gridDim.x * gridDim.y * gridDim.z;
    unsigned sum, cnt, mine, sp = 0u;
    for (;;) {
        sum = 0u; cnt = 0u; mine = 0u;
#pragma unroll
        for (unsigned j = 0; j < 16; ++j) { const unsigned c = xb_ld(&bar[XB_XCNT(j)]); sum += c; cnt += (c > 0u) ? 1u : 0u; mine = (j == x) ? c : mine; }
        if (sum == G) break;
        __builtin_amdgcn_s_sleep(1);
        if ((++sp & 255u) == 0u) { if (xb_ld(&bar[XB_TMO])) break; if (sp > XB_SPIN_CAP) { atomicAdd(&bar[XB_TMO], 1u); break; } }
    }
    nloc = mine > 0u ? mine : 1u; nx = cnt > 0u ? cnt : 1u;
}
__device__ __forceinline__ void xcd_barrier(const XcdBarrier& b) {
    asm volatile("s_waitcnt vmcnt(0)" ::: "memory");
    __syncthreads();
    if (threadIdx.x == 0) {
        unsigned* bar = b.bar;
        __builtin_amdgcn_s_waitcnt(0);
        unsigned nloc = b.st[0], nx = b.st[1];
        if (nloc == 0u) { xcd_barrier_complete(bar, b.x, nloc, nx); b.st[0] = nloc; b.st[1] = nx; }
        const unsigned old = xb_add(&bar[XB_XSUB(b.x)], 1u);
        const unsigned gen = old / nloc;
        if (old + 1u == (gen + 1u) * nloc) {
            __builtin_amdgcn_fence(__ATOMIC_RELEASE, "agent");
            asm volatile("s_waitcnt vmcnt(0)" ::: "memory");
            const unsigned og = xb_add(&bar[XB_TOP], 1u);
            const unsigned tg = og / nx;
            if (og + 1u == (tg + 1u) * nx) xb_add(&bar[XB_TOPGEN], 1u);
            else XB_SPIN(xb_ld(&bar[XB_TOPGEN]) == tg, bar);
            __builtin_amdgcn_fence(__ATOMIC_ACQUIRE, "agent");
            xb_add(&bar[XB_XGEN(b.x)], 1u);
            asm volatile("s_waitcnt vmcnt(0)" ::: "memory");
        } else {
            XB_SPIN(xb_ld(&bar[XB_XGEN(b.x)]) == gen, bar);
            __builtin_amdgcn_fence(__ATOMIC_ACQUIRE, "agent");
            asm volatile("s_waitcnt vmcnt(0)" ::: "memory");
        }
    }
    __syncthreads();
}

__device__ __forceinline__ float wave_sum(float v) {
#pragma unroll
    for (int o = 1; o < 64; o <<= 1) v += __shfl_xor(v, o);
    return v;
}
__device__ __forceinline__ float wave_max(float v) {
#pragma unroll
    for (int o = 1; o < 64; o <<= 1) v = fmaxf(v, __shfl_xor(v, o));
    return v;
}
struct Frame {
    LAS unsigned char* lds;
    volatile LAS unsigned* MISC;
    gu32* ctl;
    int tid, lane, wave;
    int vcu, G;
    unsigned char* ws;
    const float* in[30];
    float* out;
};
#define WSP(T_, off) ((T_*)(F.ws + (off)))

__device__ __forceinline__ int perm8(int c) { return (c & ~31) + 16 * ((c >> 2) & 1) + 4 * ((c >> 3) & 3) + (c & 3); }
struct MapP8 { int off; __device__ __forceinline__ int operator()(int n) const { return off + perm8(n); } };
struct MapWin { __device__ __forceinline__ int operator()(int c) const {
    if (c < 512 || c >= 1536) return perm8(c);
    const int base = (c < 1024) ? 512 : 1024, cc = c - base, head = cc >> 6, d = cc & 63, pnq = head >> 2, hh = head & 3, n = d >> 5, dd = d & 31;
    const int wc = 2 * (hh & 1) + (dd >> 4), bj = hh >> 1, j = dd & 15;
    return base + 256 * pnq + 128 * bj + 32 * wc + 16 * n + j; } };
struct MapGU { int e, up; __device__ __forceinline__ int operator()(int f) const { return e * 2048 + (f >> 7) * 256 + up * 128 + perm8(f & 127); } };

template <class RowMap>
__device__ __forceinline__ void p0_transpose_item(const float* W, int K, int N, bf16* WT, LAS float* scr, int item, int lane, const RowMap rm) {
    const int nblk = N / 32, kb = item / nblk, nb = item % nblk, k0 = 64 * kb, n0 = 32 * nb;
#pragma unroll 8
    for (int i = 0; i < 32; ++i) { const int kk = 2 * i + (lane >> 5); scr[kk * 33 + (lane & 31)] = W[(size_t)(k0 + kk) * N + n0 + (lane & 31)]; }
    LDS_WAIT(); asm volatile("" ::: "memory");
    const int c = lane & 7;
#pragma unroll
    for (int j = 0; j < 4; ++j) { const int n = (lane >> 3) + 8 * j; const LAS float* s = scr + (8 * c) * 33 + n;
        v4u o; o.x = pk2(s[0 * 33], s[1 * 33]); o.y = pk2(s[2 * 33], s[3 * 33]); o.z = pk2(s[4 * 33], s[5 * 33]); o.w = pk2(s[6 * 33], s[7 * 33]);
        *(GAS v4u*)(WT + (size_t)rm(n0 + n) * K + k0 + 8 * c) = o; }
    LDS_WAIT(); asm volatile("" ::: "memory");
}

__device__ __forceinline__ void phase0(Frame& F) {
    LAS float* scr = (LAS float*)(F.lds + RING_OFF + F.wave * 16384);
    const int gw = F.vcu * NWAVES + F.wave, NGW = F.G * NWAVES;
    constexpr int I_WIN = 16 * 128, I_GLU = 8 * 16, I_SB = 8 * 32, I_AB = 8 * 32, I_OUT = 16 * 32, I_E = 16 * 32;
    constexpr int I_SMALL = I_WIN + I_GLU + I_SB + I_AB + I_OUT, I_MOE = 3 * NE * I_E, I_ADA = 16 * 96;
    constexpr int NITEMS = I_SMALL + I_MOE + I_ADA;
    for (int it = gw; it < NITEMS; it += NGW) {
        int r = it;
        if (r < I_WIN) { p0_transpose_item(F.in[9], D, INW, WSP(bf16, WS_WIN_T), scr, r, F.lane, MapWin{}); continue; } r -= I_WIN;
        if (r < I_GLU) { p0_transpose_item(F.in[18], SW, SW, WSP(bf16, WS_WGLU_T), scr, r, F.lane, MapP8{0}); continue; } r -= I_GLU;
        if (r < I_SB) { p0_transpose_item(F.in[19], SW, D, WSP(bf16, WS_WSB_T), scr, r, F.lane, MapP8{0}); continue; } r -= I_SB;
        if (r < I_AB) { p0_transpose_item(F.in[20], AW, D, WSP(bf16, WS_WAB_T), scr, r, F.lane, MapP8{0}); continue; } r -= I_AB;
        if (r < I_OUT) { p0_transpose_item(F.in[21], D, D, WSP(bf16, WS_WOUT_T), scr, r, F.lane, MapP8{0}); continue; } r -= I_OUT;
        if (r < I_MOE) {
            const int mat = r / I_E, item = r % I_E, kind = mat / NE, e = mat % NE;
            if (kind == 0) p0_transpose_item(F.in[24] + (size_t)e * D * FF, D, FF, WSP(bf16, WS_WGU_T), scr, item, F.lane, MapGU{e, 0});
            else if (kind == 1) p0_transpose_item(F.in[26] + (size_t)e * D * FF, D, FF, WSP(bf16, WS_WGU_T), scr, item, F.lane, MapGU{e, 1});
            else p0_transpose_item(F.in[28] + (size_t)e * FF * D, FF, D, WSP(bf16, WS_WDN_T), scr, item, F.lane, MapP8{e * 1024});
            continue; }
        r -= I_MOE;
        {
            const int ks = r / 96, cc = r % 96, n = cc * 64 + F.lane;
            const float* cvec = F.in[1]; const float* aw = F.in[3];
            float a0 = 0.f, a1 = 0.f;
            for (int k = ks * 64; k < ks * 64 + 64; ++k) {
                const float c0 = cvec[k], c1 = cvec[D + k];
                const float s0 = c0 / (1.f + __expf(-c0)), s1 = c1 / (1.f + __expf(-c1));
                const float w = aw[(size_t)k * (6 * D) + n];
                a0 += s0 * w; a1 += s1 * w; }
            float* part = WSP(float, WS_ADA);
            part[(ks * 2 + 0) * (6 * D) + n] = a0; part[(ks * 2 + 1) * (6 * D) + n] = a1;
        }
    }
    const int gt = F.vcu * (NWAVES * 64) + F.tid, NGT = F.G * NWAVES * 64;
    { const int* pos = (const int*)F.in[2]; float* rc = WSP(float, WS_ROPE); float* rs = rc + (size_t)T * 32;
      for (int i = gt; i < T * 32; i += NGT) { const int t = i >> 5, p = i & 31;
          const float invf = exp2f(-(float)p * (13.287712379549449f / 32.f));
          const double ang = (double)pos[t] * (double)invf; double rev = ang * 0.15915494309189535; rev -= floor(rev);
          const float fr = (float)rev;
          rc[i] = __builtin_amdgcn_cosf(fr); rs[i] = __builtin_amdgcn_sinf(fr); } }
    { float* P5 = WSP(float, WS_S5P);
      for (int i = gt; i < NG * NP; i += NGT) { const int g = i >> 6;
          const float dt = __expf(F.in[12][g]); const float lr = F.in[10][i], li = F.in[11][i];
          const float er = __expf(lr * dt); const double ang = (double)li * (double)dt; double rev = ang * 0.15915494309189535; rev -= floor(rev);
          const float cs = __builtin_amdgcn_cosf((float)rev), sn = __builtin_amdgcn_sinf((float)rev);
          float br = er * cs, bi = er * sn;
          P5[i] = br; P5[2048 + i] = bi;
          const float nr = br - 1.f, ni = bi, den = lr * lr + li * li;
          const float qr = (nr * lr + ni * li) / den, qi = (ni * lr - nr * li) / den;
          P5[8192 + i] = qr; P5[8192 + 2048 + i] = qi;
          float pr = br, pi_ = bi;
#pragma unroll
          for (int s = 0; s < 8; ++s) { const float tr = pr * pr - pi_ * pi_, ti = 2.f * pr * pi_; pr = tr; pi_ = ti; }
          P5[4096 + i] = pr; P5[6144 + i] = pi_; }
    }
}

__device__ __forceinline__ void phase1(Frame& F) {
    LAS float* A1 = (LAS float*)(F.lds + RING_OFF); LAS float* A2 = A1 + 2 * D;
    const float* part = WSP(float, WS_ADA); const float* ab = F.in[4]; const float* pg = F.in[5];
    for (int k = F.tid; k < D; k += NWAVES * 64)
#pragma unroll
        for (int b = 0; b < 2; ++b) { float sh = ab[k], sc = ab[D + k];
            for (int ks = 0; ks < 16; ++ks) { sh += part[(ks * 2 + b) * (6 * D) + k]; sc += part[(ks * 2 + b) * (6 * D) + D + k]; }
            A1[b * D + k] = pg[k] * (1.f + sc); A2[b * D + k] = sh; }
    const int gt = F.vcu * (NWAVES * 64) + F.tid, NGT = F.G * NWAVES * 64;
    { float* adaf = WSP(float, WS_ADAF);
      for (int n = gt; n < 2 * 6 * D; n += NGT) { const int b = n / (6 * D), j = n % (6 * D); float a = ab[j];
          for (int ks = 0; ks < 16; ++ks) a += part[(ks * 2 + b) * (6 * D) + j];
          adaf[n] = a; } }
    { float* P5 = WSP(float, WS_S5P);
      for (int i = gt; i < NG * NP * GS16; i += NGT) { const int gp = i >> 4; const float qr = P5[8192 + gp], qi = P5[8192 + 2048 + gp];
          const float b_r = F.in[13][i], b_i = F.in[14][i];
          P5[16384 + i] = qr * b_r - qi * b_i; P5[16384 + 32768 + i] = qr * b_i + qi * b_r; } }
    __syncthreads();
    const int gw = F.vcu * NWAVES + F.wave, NGW = F.G * NWAVES;
    bf16* XN = WSP(bf16, WS_XN);
    for (int m = gw; m < T; m += NGW) {
        const int b = m >> 13;
        const GAS f32x4* xr = (const GAS f32x4*)(F.in[0] + (size_t)m * D) + F.lane;
        f32x4 v[4]; float s = 0.f;
#pragma unroll
        for (int j = 0; j < 4; ++j) { v[j] = xr[64 * j]; s += (v[j].x * v[j].x + v[j].y * v[j].y) + (v[j].z * v[j].z + v[j].w * v[j].w); }
        const float rstd = 1.f / sqrtf(wave_sum(s) * (1.f / D) + NORM_EPS);
        GAS unsigned long long* o8 = (GAS unsigned long long*)(XN + (size_t)m * D) + F.lane;
#pragma unroll
        for (int j = 0; j < 4; ++j) { const f32x4 a1 = *(const LAS f32x4*)(A1 + b * D + 4 * F.lane + 256 * j), a2 = *(const LAS f32x4*)(A2 + b * D + 4 * F.lane + 256 * j);
            const f32x4 o = v[j] * rstd * a1 + a2;
            o8[64 * j] = (unsigned long long)pk2(o.x, o.y) | ((unsigned long long)pk2(o.z, o.w) << 32); }
    }
    __syncthreads();
}

struct EpiG1 {
    bf16 *UA, *Q, *K, *V, *VT, *GSp, *GAp; const float *rc, *rs; float* km;
    __device__ __forceinline__ void operator()(const pg8::f32x4 (&acc)[2][2][4][2], const pg8::Unit& u, int wr, int wc, int fr, int fq) const {
        asm volatile("" : "+v"(fr), "+v"(fq));
        const int pn = u.pn, row0 = u.pm * 256 + wr * 64 + fr;
        if (pn < 2) {
#pragma unroll
            for (int ai = 0; ai < 2; ++ai)
#pragma unroll
                for (int m = 0; m < 4; ++m) { const int t = row0 + ai * 128 + m * 16, b = t >> 13, tt = t & (SEQ - 1), c = tt >> 4, s = tt & 15;
#pragma unroll
                    for (int bj = 0; bj < 2; ++bj) { const int ch = pn * 256 + bj * 128 + wc * 32 + 8 * fq, g = ch >> 4, ci = ch & 15;
                        const pg8::f32x4 v0 = acc[ai][bj][m][0], v1 = acc[ai][bj][m][1];
                        v4u w; w.x = pk2(v0[0], v0[1]); w.y = pk2(v0[2], v0[3]); w.z = pk2(v1[0], v1[1]); w.w = pk2(v1[2], v1[3]);
                        *(v4u*)(UA + ((size_t)(g * 1024 + b * 512 + c) * 384 + 16 * s + ci)) = w; } }
        } else if (pn < 6) {
            const bool isk = pn >= 4; bf16* X = isk ? K : Q; const float sc = isk ? 1.f : C2;
            const int p0 = 16 * (wc & 1) + 4 * fq;
#pragma unroll
            for (int bj = 0; bj < 2; ++bj) {
                const int head = 4 * (pn & 1) + 2 * bj + (wc >> 1);
                int rowb = row0; asm volatile("" : "+v"(rowb));
                float ks[2][4];
#pragma unroll
                for (int b = 0; b < 2; ++b)
#pragma unroll
                    for (int i = 0; i < 4; ++i) ks[b][i] = 0.f;
#pragma unroll
                for (int ai = 0; ai < 2; ++ai)
#pragma unroll
                    for (int m = 0; m < 4; ++m) { const int t = rowb + ai * 128 + m * 16;
                        const pg8::f32x4 cs = *(const pg8::f32x4*)(rc + (size_t)t * 32 + p0), sn = *(const pg8::f32x4*)(rs + (size_t)t * 32 + p0);
                        const pg8::f32x4 t1 = acc[ai][bj][m][0], t2 = acc[ai][bj][m][1];
                        const pg8::f32x4 o1 = t1 * cs - t2 * sn, o2 = t2 * cs + t1 * sn;
                        v2u w1, w2; w1.x = pk2(o1[0] * sc, o1[1] * sc); w1.y = pk2(o1[2] * sc, o1[3] * sc); w2.x = pk2(o2[0] * sc, o2[1] * sc); w2.y = pk2(o2[2] * sc, o2[3] * sc);
                        bf16* dst = X + (size_t)t * AW + head * 64 + p0;
                        *(v2u*)dst = w1; *(v2u*)(dst + 32) = w2;
#pragma unroll
                        for (int i = 0; i < 4; ++i) { ks[0][i] += o1[i]; ks[1][i] += o2[i]; }
                        __builtin_amdgcn_sched_barrier(0); }
                if (isk) {
                    const int b = u.pm >> 5, blk = u.pm & 31;
#pragma unroll
                    for (int n = 0; n < 2; ++n)
#pragma unroll
                        for (int i = 0; i < 4; ++i) { float v = ks[n][i];
                            v += __shfl_xor(v, 1); v += __shfl_xor(v, 2); v += __shfl_xor(v, 4); v += __shfl_xor(v, 8);
                            if (fr == 0) atomicAdd(km + ((size_t)((b * NH + head) * NBLK + blk) * HD + 32 * n + p0 + i), v); }
                }
            }
        } else if (pn < 8) {
#pragma unroll
            for (int ai = 0; ai < 2; ++ai)
#pragma unroll
                for (int m = 0; m < 4; ++m) { const int t = row0 + ai * 128 + m * 16, b = t >> 13, tt = t & (SEQ - 1);
#pragma unroll
                    for (int bj = 0; bj < 2; ++bj) { const int cv = (pn - 6) * 256 + bj * 128 + wc * 32 + 8 * fq, head = cv >> 6, d = cv & 63;
                        const pg8::f32x4 v0 = acc[ai][bj][m][0], v1 = acc[ai][bj][m][1];
                        v4u w; w.x = pk2(v0[0], v0[1]); w.y = pk2(v0[2], v0[3]); w.z = pk2(v1[0], v1[1]); w.w = pk2(v1[2], v1[3]);
                        *(v4u*)(V + (size_t)t * AW + cv) = w;
                        bf16* vt = VT + ((size_t)((b * NH + head) * HD + d) * SEQ + tt);
                        vt[0 * SEQ] = (bf16)(w.x & 0xffff); vt[1 * SEQ] = (bf16)(w.x >> 16); vt[2 * SEQ] = (bf16)(w.y & 0xffff); vt[3 * SEQ] = (bf16)(w.y >> 16);
                        vt[4 * SEQ] = (bf16)(w.z & 0xffff); vt[5 * SEQ] = (bf16)(w.z >> 16); vt[6 * SEQ] = (bf16)(w.w & 0xffff); vt[7 * SEQ] = (bf16)(w.w >> 16); } }
        } else {
            bf16* Gp = (pn < 12) ? GSp : GAp; const int cb = ((pn - 8) & 3) * 256;
#pragma unroll
            for (int ai = 0; ai < 2; ++ai)
#pragma unroll
                for (int m = 0; m < 4; ++m) { const int t = row0 + ai * 128 + m * 16;
#pragma unroll
                    for (int bj = 0; bj < 2; ++bj) { const int col = cb + bj * 128 + wc * 32 + 8 * fq;
                        const pg8::f32x4 v0 = acc[ai][bj][m][0], v1 = acc[ai][bj][m][1];
                        v4u w; w.x = pk2(sigmoidf_(v0[0]), sigmoidf_(v0[1])); w.y = pk2(sigmoidf_(v0[2]), sigmoidf_(v0[3]));
                        w.z = pk2(sigmoidf_(v1[0]), sigmoidf_(v1[1])); w.w = pk2(sigmoidf_(v1[2]), sigmoidf_(v1[3]));
                        *(v4u*)(Gp + (size_t)t * D + col) = w; } }
        }
    }
};

template <int MODE> struct EpiEw {
    bf16* O; const bf16* X1; const bf16* X2; float* Of; int ld;
    __device__ __forceinline__ void operator()(const pg8::f32x4 (&acc)[2][2][4][2], const pg8::Unit& u, int wr, int wc, int fr, int fq) const {
        const int row0 = u.pm * 256 + wr * 64 + fr, col0 = u.pn * 256 + wc * 32 + 8 * fq;
#pragma unroll
        for (int ai = 0; ai < 2; ++ai)
#pragma unroll
            for (int m = 0; m < 4; ++m) { const size_t rb = (size_t)(row0 + ai * 128 + m * 16) * ld + col0;
#pragma unroll
                for (int bj = 0; bj < 2; ++bj) { const size_t off = rb + bj * 128;
                    const pg8::f32x4 v0 = acc[ai][bj][m][0], v1 = acc[ai][bj][m][1];
                    if (MODE == 3) { *(pg8::f32x4*)(Of + off) = v0; *(pg8::f32x4*)(Of + off + 4) = v1; }
                    else {
                        const v4u x = *(const v4u*)(X1 + off);
                        float r[8] = {v0[0], v0[1], v0[2], v0[3], v1[0], v1[1], v1[2], v1[3]};
                        const float xv[8] = {bflo(x.x), bfhi(x.x), bflo(x.y), bfhi(x.y), bflo(x.z), bfhi(x.z), bflo(x.w), bfhi(x.w)};
                        if (MODE == 0) {
#pragma unroll
                            for (int i = 0; i < 8; ++i) r[i] = xv[i] * sigmoidf_(r[i]);
                        } else if (MODE == 1) {
#pragma unroll
                            for (int i = 0; i < 8; ++i) r[i] = xv[i] * r[i];
                        } else {
                            const v4u y = *(const v4u*)(X2 + off);
                            const float yv[8] = {bflo(y.x), bfhi(y.x), bflo(y.y), bfhi(y.y), bflo(y.z), bfhi(y.z), bflo(y.w), bfhi(y.w)};
#pragma unroll
                            for (int i = 0; i < 8; ++i) r[i] = yv[i] + xv[i] * r[i];
                        }
                        v4u w; w.x = pk2(r[0], r[1]); w.y = pk2(r[2], r[3]); w.z = pk2(r[4], r[5]); w.w = pk2(r[6], r[7]);
                        *(v4u*)(O + off) = w; } } }
    }
};

__device__ __forceinline__ void s5_load_u(const bf16* UA, int g, int b, int tt, float (&u)[16]) {
    const v4u* p = (const v4u*)(UA + ((size_t)(g * 1024 + b * 512 + (tt >> 4)) * 384 + 16 * (tt & 15)));
    const v4u a = p[0], c = p[1];
    u[0] = bflo(a.x); u[1] = bfhi(a.x); u[2] = bflo(a.y); u[3] = bfhi(a.y); u[4] = bflo(a.z); u[5] = bfhi(a.z); u[6] = bflo(a.w); u[7] = bfhi(a.w);
    u[8] = bflo(c.x); u[9] = bfhi(c.x); u[10] = bflo(c.y); u[11] = bfhi(c.y); u[12] = bflo(c.z); u[13] = bfhi(c.z); u[14] = bflo(c.w); u[15] = bfhi(c.w);
}
__device__ __forceinline__ void s5_pass_a(Frame& F) {
    const int gw = F.vcu * NWAVES + F.wave, NGW = F.G * NWAVES, p = F.lane;
    const float* P5 = WSP(float, WS_S5P); const bf16* UA = WSP(bf16, WS_UA); float* E = WSP(float, WS_S5E);
    for (int w = gw; w < BATCH * NG * S5NC; w += NGW) {
        const int ch = w % S5NC, bg = w / S5NC, g = bg % NG, b = bg / NG;
        const float lr = P5[g * 64 + p], li = P5[2048 + g * 64 + p];
        float bbr[16], bbi[16];
#pragma unroll
        for (int i = 0; i < 16; ++i) { bbr[i] = P5[16384 + (g * 64 + p) * 16 + i]; bbi[i] = P5[16384 + 32768 + (g * 64 + p) * 16 + i]; }
        float sr = 0.f, si = 0.f;
        for (int tk = 0; tk < S5CH; ++tk) { float u[16]; s5_load_u(UA, g, b, ch * S5CH + tk, u);
            float br = 0.f, bi = 0.f;
#pragma unroll
            for (int i = 0; i < 16; ++i) { br += bbr[i] * u[i]; bi += bbi[i] * u[i]; }
            const float nr = lr * sr - li * si + br, ni = lr * si + li * sr + bi; sr = nr; si = ni; }
        E[(size_t)w * 128 + 2 * p] = sr; E[(size_t)w * 128 + 2 * p + 1] = si;
    }
}
__device__ __forceinline__ void s5_carry(Frame& F) {
    const int gw = F.vcu * NWAVES + F.wave, NGW = F.G * NWAVES, p = F.lane;
    const float* P5 = WSP(float, WS_S5P); const float* E = WSP(float, WS_S5E); float* Sp = WSP(float, WS_S5S);
    for (int bg = gw; bg < BATCH * NG; bg += NGW) { const int g = bg % NG;
        const float cr = P5[4096 + g * 64 + p], ci = P5[6144 + g * 64 + p];
        float sr = 0.f, si = 0.f;
        for (int ch = 0; ch < S5NC; ++ch) { const size_t o = ((size_t)bg * S5NC + ch) * 128 + 2 * p;
            Sp[o] = sr; Sp[o + 1] = si;
            const float er = E[o], ei = E[o + 1];
            const float nr = cr * sr - ci * si + er, ni = cr * si + ci * sr + ei; sr = nr; si = ni; } }
}
__device__ __forceinline__ void s5_pass_c(Frame& F) {
    const int gw = F.vcu * NWAVES + F.wave, NGW = F.G * NWAVES, p = F.lane, L = F.lane;
    const float* P5 = WSP(float, WS_S5P); const bf16* UA = WSP(bf16, WS_UA); const float* Sp = WSP(float, WS_S5S); bf16* YG = WSP(bf16, WS_YG);
    const int h1 = (L >> 5) & 1, h2 = (L >> 4) & 1, h3 = (L >> 3) & 1, h4 = (L >> 2) & 1, co = 8 * h1 + 4 * h2 + 2 * h3 + h4;
    for (int w = gw; w < BATCH * NG * S5NC; w += NGW) {
        const int ch = w % S5NC, bg = w / S5NC, g = bg % NG, b = bg / NG;
        const float lr = P5[g * 64 + p], li = P5[2048 + g * 64 + p];
        float bbr[16], bbi[16], ccr[16], cci[16];
#pragma unroll
        for (int i = 0; i < 16; ++i) { bbr[i] = P5[16384 + (g * 64 + p) * 16 + i]; bbi[i] = P5[16384 + 32768 + (g * 64 + p) * 16 + i];
            ccr[i] = F.in[15][(g * 16 + i) * 64 + p]; cci[i] = F.in[16][(g * 16 + i) * 64 + p]; }
        const float dsk = F.in[17][g * 16 + co];
        float sr = Sp[(size_t)w * 128 + 2 * p], si = Sp[(size_t)w * 128 + 2 * p + 1];
        for (int tk = 0; tk < S5CH; ++tk) { const int tt = ch * S5CH + tk; float u[16]; s5_load_u(UA, g, b, tt, u);
            float br = 0.f, bi = 0.f;
#pragma unroll
            for (int i = 0; i < 16; ++i) { br += bbr[i] * u[i]; bi += bbi[i] * u[i]; }
            const float nr = lr * sr - li * si + br, ni = lr * si + li * sr + bi; sr = nr; si = ni;
            float v[16];
#pragma unroll
            for (int i = 0; i < 16; ++i) v[i] = ccr[i] * sr - cci[i] * si;
#pragma unroll
            for (int k = 0; k < 8; ++k) { const float mine = h1 ? v[k + 8] : v[k], oth = h1 ? v[k] : v[k + 8]; v[k] = mine + __shfl_xor(oth, 32); }
#pragma unroll
            for (int k = 0; k < 4; ++k) { const float mine = h2 ? v[k + 4] : v[k], oth = h2 ? v[k] : v[k + 4]; v[k] = mine + __shfl_xor(oth, 16); }
#pragma unroll
            for (int k = 0; k < 2; ++k) { const float mine = h3 ? v[k + 2] : v[k], oth = h3 ? v[k] : v[k + 2]; v[k] = mine + __shfl_xor(oth, 8); }
            { const float mine = h4 ? v[1] : v[0], oth = h4 ? v[0] : v[1]; v[0] = mine + __shfl_xor(oth, 4); }
            v[0] += __shfl_xor(v[0], 2); v[0] += __shfl_xor(v[0], 1);
            const float uco = bf2f(UA[((size_t)(g * 1024 + b * 512 + (tt >> 4)) * 384 + 16 * (tt & 15)) + co]);
            const float y = gelu_tanh(v[0] + dsk * uco);
            if ((L & 3) == 0) YG[(size_t)(b * SEQ + tt) * SW + g * 16 + co] = (bf16)f2bf(y);
        }
    }
}

__device__ __forceinline__ void attn_naive(Frame& F) {
    const int gw = F.vcu * NWAVES + F.wave, NGW = F.G * NWAVES;
    const bf16* Q = WSP(bf16, WS_Q); const bf16* K = WSP(bf16, WS_K); const bf16* V = WSP(bf16, WS_V); bf16* YA = WSP(bf16, WS_YA);
    const float* km = (const float*)(F.ctl + CW_KM);
    for (int w = gw; w < BATCH * NH * (SEQ / 64); w += NGW) {
        const int bh = w >> 7, b = bh >> 3, h = bh & 7, tt = (w & 127) * 64 + F.lane, t = b * SEQ + tt, blk = tt >> 8;
        float q[64];
        { const v4u* qp = (const v4u*)(Q + (size_t)t * AW + h * 64);
#pragma unroll
          for (int i = 0; i < 8; ++i) { const v4u x = qp[i]; q[8 * i] = bflo(x.x); q[8 * i + 1] = bfhi(x.x); q[8 * i + 2] = bflo(x.y); q[8 * i + 3] = bfhi(x.y);
              q[8 * i + 4] = bflo(x.z); q[8 * i + 5] = bfhi(x.z); q[8 * i + 6] = bflo(x.w); q[8 * i + 7] = bfhi(x.w); } }
        float v0 = -3e38f, v1 = -3e38f, v2 = -3e38f; int i0 = -1, i1 = -1, i2 = -1;
        for (int j = 0; j < blk; ++j) { const float* kp = km + (size_t)((b * NH + h) * NBLK + j) * HD; float g = 0.f;
#pragma unroll
            for (int d = 0; d < 64; ++d) g += q[d] * kp[d];
            if (g > v0) { v2 = v1; i2 = i1; v1 = v0; i1 = i0; v0 = g; i0 = j; }
            else if (g > v1) { v2 = v1; i2 = i1; v1 = g; i1 = j; }
            else if (g > v2) { v2 = g; i2 = j; } }
        float m = -1e30f, l = 0.f, o[64];
#pragma unroll
        for (int d = 0; d < 64; ++d) o[d] = 0.f;
#pragma unroll 1
        for (int slot = 0; slot < 4; ++slot) {
            const int jb = slot == 0 ? blk : (slot == 1 ? i0 : (slot == 2 ? i1 : i2));
            const int cnt = slot == 0 ? (tt & 255) + 1 : (jb >= 0 ? 256 : 0);
            if (!__any(cnt > 0)) continue;
            const int jbb = jb < 0 ? 0 : jb;
#pragma unroll 1
            for (int kk = 0; kk < 256; ++kk) {
                if (!__any(kk < cnt)) break;
                if (kk < cnt) {
                    const size_t key = (size_t)(b * SEQ + jbb * 256 + kk) * AW + h * 64;
                    const v4u* kp = (const v4u*)(K + key); float s = 0.f;
#pragma unroll
                    for (int i = 0; i < 8; ++i) { const v4u x = kp[i];
                        s += q[8 * i] * bflo(x.x) + q[8 * i + 1] * bfhi(x.x) + q[8 * i + 2] * bflo(x.y) + q[8 * i + 3] * bfhi(x.y)
                           + q[8 * i + 4] * bflo(x.z) + q[8 * i + 5] * bfhi(x.z) + q[8 * i + 6] * bflo(x.w) + q[8 * i + 7] * bfhi(x.w); }
                    const float mn = fmaxf(m, s), a = exp2f(m - mn), pp = exp2f(s - mn);
                    l = l * a + pp; m = mn;
                    const v4u* vp = (const v4u*)(V + key);
#pragma unroll
                    for (int i = 0; i < 8; ++i) { const v4u x = vp[i];
                        o[8 * i] = o[8 * i] * a + pp * bflo(x.x); o[8 * i + 1] = o[8 * i + 1] * a + pp * bfhi(x.x);
                        o[8 * i + 2] = o[8 * i + 2] * a + pp * bflo(x.y); o[8 * i + 3] = o[8 * i + 3] * a + pp * bfhi(x.y);
                        o[8 * i + 4] = o[8 * i + 4] * a + pp * bflo(x.z); o[8 * i + 5] = o[8 * i + 5] * a + pp * bfhi(x.z);
                        o[8 * i + 6] = o[8 * i + 6] * a + pp * bflo(x.w); o[8 * i + 7] = o[8 * i + 7] * a + pp * bfhi(x.w); }
                }
            }
        }
        const float rl = 1.f / l;
        v4u* op = (v4u*)(YA + (size_t)t * AW + h * 64);
#pragma unroll
        for (int i = 0; i < 8; ++i) { v4u wv; wv.x = pk2(o[8 * i] * rl, o[8 * i + 1] * rl); wv.y = pk2(o[8 * i + 2] * rl, o[8 * i + 3] * rl);
            wv.z = pk2(o[8 * i + 4] * rl, o[8 * i + 5] * rl); wv.w = pk2(o[8 * i + 6] * rl, o[8 * i + 7] * rl); op[i] = wv; }
    }
}
constexpr int SCR_OFF = LDSCTL_OFF + 512;
__device__ __forceinline__ void phase_rows(Frame& F) {
    LAS float* WrT = (LAS float*)(F.lds);
    LAS float* gtm = (LAS float*)(F.lds + 131072);
    LAS float* pg2 = gtm + 2 * D; LAS float* shf = pg2 + 2 * D;
    LAS unsigned* hist = (LAS unsigned*)(F.lds + SCR_OFF); LAS unsigned* base = hist + 32; LAS int* rec_e = (LAS int*)(base + 32); LAS int* rec_lp = rec_e + 256;
    const float* adaf = WSP(float, WS_ADAF);
    for (int i = F.tid; i < D * NE; i += NWAVES * 64) { const int k = i >> 5, e = i & 31; WrT[e * D + k] = F.in[22][i]; }
    for (int i = F.tid; i < 2 * D; i += NWAVES * 64) { const int b = i >> 10, k = i & (D - 1);
        gtm[i] = adaf[b * 6 * D + 2 * D + k] * F.in[6][k];
        pg2[i] = F.in[7][k] * (1.f + adaf[b * 6 * D + 4 * D + k]); shf[i] = adaf[b * 6 * D + 3 * D + k]; }
    if (F.tid < 32) hist[F.tid] = 0u;
    __syncthreads();
    const float* mix = WSP(float, WS_MIX); bf16* H2 = WSP(bf16, WS_H2);
    int* tok_e = WSP(int, WS_ROUTE); float* tok_w = (float*)(tok_e + T * 4); int* tok_pos = tok_e + 2 * T * 4;
    unsigned* gcnt = (unsigned*)(F.ctl + CW_ECNT);
    const int L = F.lane;
    for (int t0 = F.vcu * 64; t0 < T; t0 += F.G * 64) {
        for (int tk = 0; tk < 8; ++tk) {
            const int tl = F.wave * 8 + tk, t = t0 + tl, b = t >> 13;
            const GAS f32x4* mr = (const GAS f32x4*)(mix + (size_t)t * D) + L; const GAS f32x4* xr = (const GAS f32x4*)(F.in[0] + (size_t)t * D) + L;
            f32x4 mv[4], xv[4]; float s = 0.f;
#pragma unroll
            for (int j = 0; j < 4; ++j) { mv[j] = mr[64 * j]; xv[j] = xr[64 * j]; s += (mv[j].x * mv[j].x + mv[j].y * mv[j].y) + (mv[j].z * mv[j].z + mv[j].w * mv[j].w); }
            const float r1 = 1.f / sqrtf(wave_sum(s) * (1.f / D) + NORM_EPS);
            float s2 = 0.f;
            GAS f32x4* orow = (GAS f32x4*)(F.out + (size_t)t * D) + L;
#pragma unroll
            for (int j = 0; j < 4; ++j) { const f32x4 g = *(const LAS f32x4*)(gtm + b * D + 4 * L + 256 * j);
                xv[j] = xv[j] + g * (mv[j] * r1); orow[64 * j] = xv[j];
                s2 += (xv[j].x * xv[j].x + xv[j].y * xv[j].y) + (xv[j].z * xv[j].z + xv[j].w * xv[j].w); }
            const float r2 = 1.f / sqrtf(wave_sum(s2) * (1.f / D) + NORM_EPS);
            GAS unsigned long long* h8 = (GAS unsigned long long*)(H2 + (size_t)t * D) + L;
#pragma unroll
            for (int j = 0; j < 4; ++j) { const f32x4 a = *(const LAS f32x4*)(pg2 + b * D + 4 * L + 256 * j), c = *(const LAS f32x4*)(shf + b * D + 4 * L + 256 * j);
                xv[j] = xv[j] * r2 * a + c;
                h8[64 * j] = (unsigned long long)pk2(xv[j].x, xv[j].y) | ((unsigned long long)pk2(xv[j].z, xv[j].w) << 32); }
            float pe[32];
#pragma unroll
            for (int e = 0; e < 32; ++e) { float a = 0.f;
#pragma unroll
                for (int j = 0; j < 4; ++j) { const f32x4 w = *(const LAS f32x4*)(WrT + e * D + 4 * L + 256 * j); a += (xv[j].x * w.x + xv[j].y * w.y) + (xv[j].z * w.z + xv[j].w * w.w); }
                pe[e] = a; }
            { const int h = (L >> 5) & 1;
#pragma unroll
              for (int k = 0; k < 16; ++k) { const float mine = h ? pe[k + 16] : pe[k], oth = h ? pe[k] : pe[k + 16]; pe[k] = mine + __shfl_xor(oth, 32); } }
            { const int h = (L >> 4) & 1;
#pragma unroll
              for (int k = 0; k < 8; ++k) { const float mine = h ? pe[k + 8] : pe[k], oth = h ? pe[k] : pe[k + 8]; pe[k] = mine + __shfl_xor(oth, 16); } }
            { const int h = (L >> 3) & 1;
#pragma unroll
              for (int k = 0; k < 4; ++k) { const float mine = h ? pe[k + 4] : pe[k], oth = h ? pe[k] : pe[k + 4]; pe[k] = mine + __shfl_xor(oth, 8); } }
            { const int h = (L >> 2) & 1;
#pragma unroll
              for (int k = 0; k < 2; ++k) { const float mine = h ? pe[k + 2] : pe[k], oth = h ? pe[k] : pe[k + 2]; pe[k] = mine + __shfl_xor(oth, 4); } }
            { const int h = (L >> 1) & 1; const float mine = h ? pe[1] : pe[0], oth = h ? pe[0] : pe[1]; pe[0] = mine + __shfl_xor(oth, 2); }
            pe[0] += __shfl_xor(pe[0], 1);
            const int myE = L >> 1;
            float val = pe[0] + F.in[23][myE];
            if (L & 1) val = -3e38f;
            int se[4]; float sv[4];
#pragma unroll
            for (int r = 0; r < 4; ++r) { const float mx = wave_max(val); const unsigned long long bal = __ballot(val == mx); const int win = __ffsll((long long)bal) - 1;
                se[r] = win >> 1; sv[r] = mx; if (L == win) val = -3e38f; }
            const float e1 = __expf(sv[1] - sv[0]), e2 = __expf(sv[2] - sv[0]), e3 = __expf(sv[3] - sv[0]), inv = 1.f / (1.f + e1 + e2 + e3);
            if (L < 4) { const int e = L == 0 ? se[0] : (L == 1 ? se[1] : (L == 2 ? se[2] : se[3]));
                const float wv = (L == 0 ? 1.f : (L == 1 ? e1 : (L == 2 ? e2 : e3))) * inv;
                tok_e[t * 4 + L] = e; tok_w[t * 4 + L] = wv;
                const unsigned lp = atomicAdd((unsigned*)(hist + e), 1u);
                rec_e[tl * 4 + L] = e; rec_lp[tl * 4 + L] = (int)lp; }
        }
        __syncthreads();
        if (F.tid < 32) { const unsigned h = hist[F.tid]; base[F.tid] = h ? __hip_atomic_fetch_add(gcnt + F.tid, h, RLX_AGENT) : 0u; }
        __syncthreads();
        if (F.tid < 256) { tok_pos[(t0 + (F.tid >> 2)) * 4 + (F.tid & 3)] = (int)base[rec_e[F.tid]] + rec_lp[F.tid]; }
        __syncthreads();
        if (F.tid < 32) hist[F.tid] = 0u;
        __syncthreads();
    }
}

__device__ __forceinline__ void moe_tables(Frame& F) {
    LAS int* cnt = (LAS int*)(F.lds + SCR_OFF); LAS int* off = cnt + 32; LAS int* tpre = off + 32;
    if (F.tid == 0) { int o = 0, tp = 0;
        for (int e = 0; e < NE; ++e) { const int c = (int)__hip_atomic_load(F.ctl + CW_ECNT + e, RLX_AGENT); cnt[e] = c; off[e] = o; tpre[e] = tp; o += c; tp += (c + 255) >> 8; }
        tpre[NE] = tp; }
    __syncthreads();
}
__device__ __forceinline__ void phase_gather(Frame& F) {
    moe_tables(F);
    const LAS int* off = (const LAS int*)(F.lds + SCR_OFF) + 32;
    const int gw = F.vcu * NWAVES + F.wave, NGW = F.G * NWAVES;
    const int* tok_e = WSP(int, WS_ROUTE); const int* tok_pos = tok_e + 2 * T * 4;
    const v4u* H2 = WSP(v4u, WS_H2); v4u* XG = WSP(v4u, WS_XG);
    for (int a = gw; a < T * TOPK; a += NGW) { const int t = a >> 2, e = tok_e[a], row = off[e] + tok_pos[a];
        const v4u x0 = H2[(size_t)t * 128 + F.lane], x1 = H2[(size_t)t * 128 + 64 + F.lane];
        XG[(size_t)row * 128 + F.lane] = x0; XG[(size_t)row * 128 + 64 + F.lane] = x1; }
}
struct MoeOrder {
    const LAS int* tab; int nct, brows, G, c;
    __device__ __forceinline__ bool next(int i, pg8::Unit& u) const {
        const int L = i * G + c, total = tab[64 + NE] * nct; if (L >= total) return false;
        const int rtg = L / nct, pn = L % nct; int e = 0;
        for (int k = 1; k < NE; ++k) if (tab[64 + k] <= rtg) e = k;
        const int rt = rtg - tab[64 + e], cnt = tab[e], off = tab[32 + e];
        u.e = __builtin_amdgcn_readfirstlane(e); u.pm = rt; u.pn = pn; u.arow = __builtin_amdgcn_readfirstlane(off + rt * 256); u.brow = __builtin_amdgcn_readfirstlane(e * brows + pn * 256);
        const int nr = cnt - rt * 256; u.nrow = __builtin_amdgcn_readfirstlane(nr > 256 ? 256 : nr); return true;
    }
};
struct EpiGU { bf16* H1; const float* bg; const float* bu;
    __device__ __forceinline__ void operator()(const pg8::f32x4 (&acc)[2][2][4][2], const pg8::Unit& u, int wr, int wc, int fr, int fq) const {
        const int f0 = u.pn * 128 + wc * 32 + 8 * fq;
        const pg8::f32x4 g0 = *(const pg8::f32x4*)(bg + u.e * FF + f0), g1 = *(const pg8::f32x4*)(bg + u.e * FF + f0 + 4);
        const pg8::f32x4 u0 = *(const pg8::f32x4*)(bu + u.e * FF + f0), u1 = *(const pg8::f32x4*)(bu + u.e * FF + f0 + 4);
#pragma unroll
        for (int ai = 0; ai < 2; ++ai)
#pragma unroll
            for (int m = 0; m < 4; ++m) { const int r = ai * 128 + wr * 64 + m * 16 + fr;
                const pg8::f32x4 a0 = acc[ai][0][m][0] + g0, a1 = acc[ai][0][m][1] + g1, b0 = acc[ai][1][m][0] + u0, b1 = acc[ai][1][m][1] + u1;
                float gg[8] = {a0[0], a0[1], a0[2], a0[3], a1[0], a1[1], a1[2], a1[3]}, uu[8] = {b0[0], b0[1], b0[2], b0[3], b1[0], b1[1], b1[2], b1[3]}, o[8];
#pragma unroll
                for (int i = 0; i < 8; ++i) { const float g = fminf(gg[i], 7.f), up = fminf(fmaxf(uu[i], -7.f), 7.f); o[i] = g * sigmoidf_(1.702f * g) * (up + 1.f); }
                v4u w; w.x = pk2(o[0], o[1]); w.y = pk2(o[2], o[3]); w.z = pk2(o[4], o[5]); w.w = pk2(o[6], o[7]);
                if (r < u.nrow) *(v4u*)(H1 + (size_t)(u.arow + r) * FF + f0) = w; }
    }
};
struct EpiDn { bf16* YB; const float* bd;
    __device__ __forceinline__ void operator()(const pg8::f32x4 (&acc)[2][2][4][2], const pg8::Unit& u, int wr, int wc, int fr, int fq) const {
        const int c0 = u.pn * 256 + wc * 32 + 8 * fq;
#pragma unroll
        for (int bj = 0; bj < 2; ++bj) { const pg8::f32x4 d0 = *(const pg8::f32x4*)(bd + u.e * D + c0 + bj * 128), d1 = *(const pg8::f32x4*)(bd + u.e * D + c0 + bj * 128 + 4);
#pragma unroll
            for (int ai = 0; ai < 2; ++ai)
#pragma unroll
                for (int m = 0; m < 4; ++m) { const int r = ai * 128 + wr * 64 + m * 16 + fr;
                    const pg8::f32x4 a0 = acc[ai][bj][m][0] + d0, a1 = acc[ai][bj][m][1] + d1;
                    v4u w; w.x = pk2(a0[0], a0[1]); w.y = pk2(a0[2], a0[3]); w.z = pk2(a1[0], a1[1]); w.w = pk2(a1[2], a1[3]);
                    if (r < u.nrow) *(v4u*)(YB + (size_t)(u.arow + r) * D + c0 + bj * 128) = w; } }
    }
};
__device__ __forceinline__ void phase_final(Frame& F) {
    moe_tables(F);
    const LAS int* off = (const LAS int*)(F.lds + SCR_OFF) + 32;
    LAS float* gtf = (LAS float*)(F.lds);
    const float* adaf = WSP(float, WS_ADAF);
    for (int i = F.tid; i < 2 * D; i += NWAVES * 64) { const int b = i >> 10, k = i & (D - 1); gtf[i] = adaf[b * 6 * D + 5 * D + k] * F.in[8][k]; }
    __syncthreads();
    const int gw = F.vcu * NWAVES + F.wave, NGW = F.G * NWAVES, L = F.lane;
    const int* tok_e = WSP(int, WS_ROUTE); const float* tok_w = (const float*)(tok_e + T * 4); const int* tok_pos = tok_e + 2 * T * 4;
    const bf16* YB = WSP(bf16, WS_YB);
    for (int t = gw; t < T; t += NGW) { const int b = t >> 13;
        f32x4 y[4];
#pragma unroll
        for (int j = 0; j < 4; ++j) y[j] = (f32x4){0.f, 0.f, 0.f, 0.f};
#pragma unroll
        for (int k = 0; k < 4; ++k) { const int e = tok_e[t * 4 + k], row = off[e] + tok_pos[t * 4 + k]; const float w = tok_w[t * 4 + k];
            const GAS v2u* yr = (const GAS v2u*)(YB + (size_t)row * D) + L;
#pragma unroll
            for (int j = 0; j < 4; ++j) { const v2u x = yr[64 * j]; y[j].x += w * bflo(x.x); y[j].y += w * bfhi(x.x); y[j].z += w * bflo(x.y); y[j].w += w * bfhi(x.y); } }
        float s = 0.f;
#pragma unroll
        for (int j = 0; j < 4; ++j) s += (y[j].x * y[j].x + y[j].y * y[j].y) + (y[j].z * y[j].z + y[j].w * y[j].w);
        const float r = 1.f / sqrtf(wave_sum(s) * (1.f / D) + NORM_EPS);
        GAS f32x4* orow = (GAS f32x4*)(F.out + (size_t)t * D) + L;
#pragma unroll
        for (int j = 0; j < 4; ++j) { const f32x4 g = *(const LAS f32x4*)(gtf + b * D + 4 * L + 256 * j); const f32x4 x1 = orow[64 * j]; orow[64 * j] = x1 + g * (y[j] * r); }
    }
}
#ifndef MK_N_LAUNCHES
#define MK_N_LAUNCHES 1
#endif
constexpr int N_PHASES = 15;
struct Args { const float* in[30]; float* out; unsigned char* ws; int ph_lo, ph_hi; };
__global__ void __launch_bounds__(NWAVES * 64, 2) mega_fwd(Args args) {
    extern __shared__ __attribute__((aligned(16))) unsigned char lds[];
    Frame F;
    F.lds = (LAS unsigned char*)lds;
    F.MISC = (volatile LAS unsigned*)(F.lds + MISC_OFF);
    F.tid = threadIdx.x; F.lane = F.tid & 63; F.wave = __builtin_amdgcn_readfirstlane(F.tid >> 6);
    F.G = gridDim.x; { const int bx = blockIdx.x; F.vcu = (F.G % 8 == 0) ? (bx % 8) * (F.G / 8) + bx / 8 : bx; }
    F.ws = args.ws; F.ctl = (gu32*)(args.ws + WS_CTL); F.out = args.out;
#pragma unroll
    for (int i = 0; i < 30; ++i) F.in[i] = args.in[i];
    for (int u = F.tid; u < (LDS_BYTES - LDSCTL_OFF) / 4; u += NWAVES * 64) ((LAS unsigned*)(F.lds + LDSCTL_OFF))[u] = 0u;
    __syncthreads();
    XcdBarrier bar; bar.bar = (unsigned*)(F.ctl + CW_BAR); bar.x = 0; bar.st = nullptr;
    if (MK_N_LAUNCHES == 1) bar = xcd_barrier_post((unsigned*)(F.ctl + CW_BAR), F.MISC + 8);
    const int lo = args.ph_lo, hi = args.ph_hi;
#ifndef PHMASK
#define PHMASK 0x7fff
#endif
#define IN(k) (((PHMASK >> (k)) & 1) && lo <= (k) && (k) < hi)
#define SEAM(k) do { if (IN(k) && IN((k) + 1)) xcd_barrier(bar); } while (0)
    PG8_LAS unsigned char* ring = F.lds + RING_OFF;
    const int bx = (int)blockIdx.x;

    if (IN(0)) { phase0(F); } SEAM(0);
    if (IN(1)) { phase1(F); } SEAM(1);
    if (IN(2)) {
        pg8::Gemm g{WSP(bf16, WS_XN), WSP(bf16, WS_WIN_T), D, D, D}; pg8::DenseOrder S; S.init(T, INW, F.G, bx);
        EpiG1 E{WSP(bf16, WS_UA), WSP(bf16, WS_Q), WSP(bf16, WS_K), WSP(bf16, WS_V), WSP(bf16, WS_VT), WSP(bf16, WS_GS), WSP(bf16, WS_GA),
                WSP(float, WS_ROPE), WSP(float, WS_ROPE) + (size_t)T * 32, (float*)(F.ctl + CW_KM)};
        pg8::gemm_phase(ring, g, S, E);
    } SEAM(2);
    if (IN(3)) { s5_pass_a(F); attn_naive(F); } SEAM(3);
    if (IN(4)) { s5_carry(F); } SEAM(4);
    if (IN(5)) { s5_pass_c(F); } SEAM(5);
    if (IN(6)) {
        pg8::Gemm g{WSP(bf16, WS_YG), WSP(bf16, WS_WGLU_T), SW, SW, SW}; pg8::DenseOrder S; S.init(T, SW, F.G, bx);
        EpiEw<0> E{WSP(bf16, WS_Y2), WSP(bf16, WS_YG), nullptr, nullptr, SW};
        pg8::gemm_phase(ring, g, S, E);
    } SEAM(6);
    if (IN(7)) {
        pg8::Gemm g{WSP(bf16, WS_Y2), WSP(bf16, WS_WSB_T), SW, SW, SW}; pg8::DenseOrder S; S.init(T, D, F.G, bx);
        EpiEw<1> E{WSP(bf16, WS_M1), WSP(bf16, WS_GS), nullptr, nullptr, D};
        pg8::gemm_phase(ring, g, S, E);
    } SEAM(7);
    if (IN(8)) {
        pg8::Gemm g{WSP(bf16, WS_YA), WSP(bf16, WS_WAB_T), AW, AW, AW}; pg8::DenseOrder S; S.init(T, D, F.G, bx);
        EpiEw<2> E{WSP(bf16, WS_XN), WSP(bf16, WS_GA), WSP(bf16, WS_M1), nullptr, D};
        pg8::gemm_phase(ring, g, S, E);
    } SEAM(8);
    if (IN(9)) {
        pg8::Gemm g{WSP(bf16, WS_XN), WSP(bf16, WS_WOUT_T), D, D, D}; pg8::DenseOrder S; S.init(T, D, F.G, bx);
        EpiEw<3> E{nullptr, nullptr, nullptr, WSP(float, WS_MIX), D};
        pg8::gemm_phase(ring, g, S, E);
    } SEAM(9);
    if (IN(10)) { phase_rows(F); } SEAM(10);
    if (IN(11)) { phase_gather(F); } SEAM(11);
    if (IN(12)) {
        moe_tables(F);
        pg8::Gemm g{WSP(bf16, WS_XG), WSP(bf16, WS_WGU_T), D, D, D}; MoeOrder S{(const LAS int*)(F.lds + SCR_OFF), 8, 2048, F.G, bx};
        EpiGU E{WSP(bf16, WS_H1), F.in[25], F.in[27]};
        pg8::gemm_phase(ring, g, S, E);
    } SEAM(12);
    if (IN(13)) {
        moe_tables(F);
        pg8::Gemm g{WSP(bf16, WS_H1), WSP(bf16, WS_WDN_T), FF, FF, FF}; MoeOrder S{(const LAS int*)(F.lds + SCR_OFF), 4, 1024, F.G, bx};
        EpiDn E{WSP(bf16, WS_YB), F.in[29]};
        pg8::gemm_phase(ring, g, S, E);
    } SEAM(13);
    if (IN(14)) { phase_final(F); }
#undef IN
#undef SEAM
}

extern "C" void kernel_launch(void* const* d_in, const int* in_sizes, int n_in, void* d_out, int out_size, void* d_ws, size_t ws_size, hipStream_t stream) {
    static int grid = 0;
    if (grid == 0) {
        if (n_in != 30 || in_sizes[0] != T * D || out_size != T * D || ws_size < WS_END) { fprintf(stderr, "kernel_launch: unexpected shapes (n_in %d, in0 %d, out %d, ws %zu)\n", n_in, n_in > 0 ? in_sizes[0] : -1, out_size, ws_size); grid = -1; return; }
        int dev = 0, cus = 0, per_cu = 0;
        if (hipGetDevice(&dev) != hipSuccess || hipDeviceGetAttribute(&cus, hipDeviceAttributeMultiprocessorCount, dev) != hipSuccess) { grid = -1; return; }
        if (hipFuncSetAttribute((const void*)mega_fwd, hipFuncAttributeMaxDynamicSharedMemorySize, LDS_BYTES) != hipSuccess) { fprintf(stderr, "kernel_launch: hipFuncSetAttribute failed\n"); grid = -1; return; }
        if (hipOccupancyMaxActiveBlocksPerMultiprocessor(&per_cu, (const void*)mega_fwd, NWAVES * 64, LDS_BYTES) != hipSuccess || per_cu < 1) { fprintf(stderr, "kernel_launch: occupancy query says %d\n", per_cu); }
        (void)hipGetLastError();
        grid = cus;
    }
    if (grid < 0) return;
    (void)hipMemsetAsync((char*)d_ws + WS_CTL, 0, CTL_ZERO_BYTES, stream);
    Args a{};
    for (int i = 0; i < 30; ++i) a.in[i] = (const float*)d_in[i];
    a.out = (float*)d_out; a.ws = (unsigned char*)d_ws;
    if (MK_N_LAUNCHES == 1) { a.ph_lo = 0; a.ph_hi = N_PHASES; hipLaunchKernelGGL(mega_fwd, dim3(grid), dim3(NWAVES * 64), LDS_BYTES, stream, a); }
    else for (int p = 0; p < N_PHASES; ++p) { a.ph_lo = p; a.ph_hi = p + 1; hipLaunchKernelGGL(mega_fwd, dim3(grid), dim3(NWAVES * 64), LDS_BYTES, stream, a); }
}
```

```cpp
#include <hip/hip_runtime.h>
#include <cstdio>
#include <cstdint>
#define MK_N_LAUNCHES 1
namespace pg8 {
#define PG8_LAS __attribute__((address_space(3)))
typedef unsigned short bf16_t;
typedef short bf16x8 __attribute__((ext_vector_type(8)));
typedef float f32x4 __attribute__((ext_vector_type(4)));
typedef unsigned u32x4 __attribute__((ext_vector_type(4)));
typedef unsigned u32x2 __attribute__((ext_vector_type(2)));
constexpr int BM = 256, BK = 64, HALF = 128, HTB = HALF * BK * 2  , STAGE_BYTES = 8 * HTB, NXCD = 8, WGM = 8;

__host__ __device__ __forceinline__ int lds_byte(int r, int c) { const int st = (r >> 4) * 2 + (c >> 5), rr = r & 15, cc = c & 31, ob = rr * 64 + cc * 2; return st * 1024 + (ob ^ (((ob >> 9) & 1) << 5)); }
__host__ __device__ __forceinline__ void stage_rc(int b, int& R, int& C) { const int st = b / 1024, sb = b % 1024, swz = sb ^ (((sb >> 9) & 1) << 5); R = (st >> 1) * 16 + swz / 64; C = (st & 1) * 32 + (swz % 64) / 2; }

struct Unit { int arow, brow, pm, pn, e, nrow; };
struct Gemm { const bf16_t* A; const bf16_t* Bt; int lda, ldb, K; };

struct DenseOrder {
    int nM, nN, nwg, G, c;
    __device__ __forceinline__ void init(int M, int N, int G_, int c_) { nM = M / BM; nN = N / BM; nwg = nM * nN; G = G_; c = c_; }
    __device__ __forceinline__ bool next(int i, Unit& u) const {
        const long L = (long)i * G + c; if (L >= nwg) return false;
        int wgid = (int)L; { const int q = nwg / NXCD, r = nwg % NXCD, xcd = wgid % NXCD, off = wgid / NXCD; wgid = (xcd < r ? xcd * (q + 1) : r * (q + 1) + (xcd - r) * q) + off; }
        const int nig = WGM * nN, gid = wgid / nig, fm = gid * WGM, gsz = (nM - fm) < WGM ? (nM - fm) : WGM;
        u.pm = fm + ((wgid % nig) % gsz); u.pn = (wgid % nig) / gsz; u.arow = u.pm * BM; u.brow = u.pn * BM; u.e = 0; u.nrow = BM; return true;
    }
};

template <class Epi, class Sched>
__device__ __forceinline__ void gemm_phase(PG8_LAS unsigned char* lds, const Gemm g, const Sched& S, const Epi& E) {
    const int tid = threadIdx.x, wid = __builtin_amdgcn_readfirstlane(tid >> 6), lane = tid & 63, wr = wid >> 2, wc = wid & 3, fr = lane & 15, fq = lane >> 4;
    const int K = g.K, nt = K / BK;
    unsigned voffA[2], voffB[2];
#pragma unroll
    for (int i = 0; i < 2; ++i) { int R, C; stage_rc(tid * 16 + i * 8192, R, C);
        voffA[i] = (unsigned)(R * g.lda + C) * 2u; voffB[i] = (unsigned)(R * g.ldb + C) * 2u; }
    const size_t kstep = (size_t)(BK * 2);
    const size_t hstepA = (size_t)HALF * g.lda * 2, hstepB = (size_t)HALF * g.ldb * 2;
    const size_t rowA = (size_t)g.lda * 2, rowB = (size_t)g.ldb * 2;
    const unsigned ldsw = (unsigned)wid * 1024u;
    const int aoff = lds_byte(wr * 64 + fr, fq * 8), boff = lds_byte(wc * 32 + fr, fq * 8);
#define PG8_SA(b, h) (((b) * 2 + (h)) * HTB)
#define PG8_SB(b, h) ((4 + (b) * 2 + (h)) * HTB)
#define PG8_STAGE(bufoff, gbase, voff) do { _Pragma("unroll") for (int _i = 0; _i < 2; ++_i) \
        __builtin_amdgcn_global_load_lds((const unsigned*)((const char*)(gbase) + (voff)[_i]), (PG8_LAS unsigned*)(lds + (bufoff) + ldsw + _i * 8192), 16, 0, 0); } while (0)
#define PG8_LDA(dst, b, h) do { _Pragma("unroll") for (int m = 0; m < 4; ++m) _Pragma("unroll") for (int k = 0; k < 2; ++k) dst[m][k] = *(const PG8_LAS bf16x8*)(lds + PG8_SA(b, h) + aoff + m * 2048 + k * 1024); } while (0)
#define PG8_LDB(dst, b, h) do { _Pragma("unroll") for (int n = 0; n < 2; ++n) _Pragma("unroll") for (int k = 0; k < 2; ++k) dst[n][k] = *(const PG8_LAS bf16x8*)(lds + PG8_SB(b, h) + boff + n * 2048 + k * 1024); } while (0)
#define PG8_MMA(ai, bj, At, Bt) do { __builtin_amdgcn_s_setprio(1); _Pragma("unroll") for (int m = 0; m < 4; ++m) _Pragma("unroll") for (int n = 0; n < 2; ++n) _Pragma("unroll") for (int k = 0; k < 2; ++k) \
        acc[ai][bj][m][n] = __builtin_amdgcn_mfma_f32_16x16x32_bf16(Bt[n][k], At[m][k], acc[ai][bj][m][n], 0, 0, 0); __builtin_amdgcn_s_setprio(0); } while (0)
#define PG8_WAIT_V(n) asm volatile("s_waitcnt vmcnt(" #n ")" ::: "memory")
#define PG8_WAIT_L(n) asm volatile("s_waitcnt lgkmcnt(" #n ")" ::: "memory")
#define PG8_BAR __builtin_amdgcn_s_barrier()
#define PG8_SCHED __builtin_amdgcn_sched_barrier(0)
    Unit cur, nxt; int ui = 0;
    if (!S.next(0, cur)) return;
    f32x4 acc[2][2][4][2];
#pragma unroll
    for (int a = 0; a < 2; ++a)
#pragma unroll
        for (int b = 0; b < 2; ++b)
#pragma unroll
            for (int m = 0; m < 4; ++m)
#pragma unroll
                for (int n = 0; n < 2; ++n) acc[a][b][m][n] = (f32x4){0.f, 0.f, 0.f, 0.f};
    bf16x8 At[4][2], B0[2][2], B1[2][2];
    const char* cA = (const char*)g.A + (size_t)cur.arow * rowA; const char* cB = (const char*)g.Bt + (size_t)cur.brow * rowB;
    PG8_STAGE(PG8_SB(0, 0), cB, voffB); PG8_STAGE(PG8_SB(0, 1), cB + hstepB, voffB); PG8_STAGE(PG8_SA(0, 0), cA, voffA); PG8_STAGE(PG8_SA(0, 1), cA + hstepA, voffA);
    if (wr == 1) PG8_BAR;
    PG8_WAIT_V(2); PG8_BAR;
    PG8_STAGE(PG8_SB(1, 0), cB + kstep, voffB); PG8_STAGE(PG8_SA(1, 0), cA + kstep, voffA); PG8_STAGE(PG8_SB(1, 1), cB + hstepB + kstep, voffB);
    PG8_WAIT_V(6); PG8_BAR;
    for (;;) {
        const bool has_next = S.next(ui + 1, nxt);
        const char* nA = has_next ? (const char*)g.A + (size_t)nxt.arow * rowA : cA; const char* nB = has_next ? (const char*)g.Bt + (size_t)nxt.brow * rowB : cB;
        for (int t = 0; t < nt; t += 2) {
            const bool last = (t == nt - 2);
            const char* a1 = cA + (size_t)(t + 1) * kstep;
            const char* a2 = last ? nA : cA + (size_t)(t + 2) * kstep; const char* b2 = last ? nB : cB + (size_t)(t + 2) * kstep;
            const char* a3 = a2 + kstep; const char* b3 = b2 + kstep;
            PG8_LDB(B0, 0, 0); PG8_LDB(B1, 0, 1); PG8_SCHED; PG8_LDA(At, 0, 0); PG8_STAGE(PG8_SA(1, 1), a1 + hstepA, voffA);
            PG8_WAIT_V(8); PG8_WAIT_L(0); PG8_BAR; PG8_MMA(0, 0, At, B0); PG8_MMA(0, 1, At, B1); PG8_BAR; PG8_SCHED;
            PG8_LDA(At, 0, 1); PG8_STAGE(PG8_SB(0, 0), b2, voffB); PG8_STAGE(PG8_SB(0, 1), b2 + hstepB, voffB); PG8_STAGE(PG8_SA(0, 0), a2, voffA);
            PG8_WAIT_V(8); PG8_WAIT_L(0); PG8_BAR; PG8_MMA(1, 0, At, B0); PG8_MMA(1, 1, At, B1); PG8_BAR; PG8_SCHED;
            PG8_LDB(B0, 1, 0); PG8_LDB(B1, 1, 1); PG8_SCHED; PG8_LDA(At, 1, 0); PG8_STAGE(PG8_SA(0, 1), a2 + hstepA, voffA);
            PG8_WAIT_V(8); PG8_WAIT_L(0); PG8_BAR; PG8_MMA(0, 0, At, B0); PG8_MMA(0, 1, At, B1); PG8_BAR; PG8_SCHED;
            PG8_LDA(At, 1, 1); PG8_STAGE(PG8_SB(1, 0), b3, voffB); PG8_STAGE(PG8_SB(1, 1), b3 + hstepB, voffB); PG8_STAGE(PG8_SA(1, 0), a3, voffA);
            PG8_WAIT_V(8); PG8_WAIT_L(0); PG8_BAR; PG8_MMA(1, 0, At, B0); PG8_MMA(1, 1, At, B1); PG8_BAR; PG8_SCHED;
        }
        if (wr == 0) PG8_BAR;
        E(acc, cur, wr, wc, fr, fq);
        if (!has_next) break;
#pragma unroll
        for (int a = 0; a < 2; ++a)
#pragma unroll
            for (int b = 0; b < 2; ++b)
#pragma unroll
                for (int m = 0; m < 4; ++m)
#pragma unroll
                    for (int n = 0; n < 2; ++n) acc[a][b][m][n] = (f32x4){0.f, 0.f, 0.f, 0.f};
        cur = nxt; cA = nA; cB = nB; ++ui;
        if (wr == 1) PG8_BAR;
    }
    PG8_WAIT_V(0);
    PG8_BAR;
#undef PG8_SA
#undef PG8_SB
#undef PG8_STAGE
#undef PG8_LDA
#undef PG8_LDB
#undef PG8_MMA
#undef PG8_WAIT_V
#undef PG8_WAIT_L
#undef PG8_BAR
#undef PG8_SCHED
}
}
constexpr int NWAVES = 8;
constexpr int BATCH = 2, SEQ = 8192, T = BATCH * SEQ, D = 1024, NH = 8, HD = 64, AW = 512, SW = 512, NG = 32, NP = 64, GS16 = 16;
constexpr int NE = 32, FF = 1024, INW = 4096, TOPK = 4, NBLK = SEQ / 256;
constexpr float NORM_EPS = 1e-6f;
constexpr float C2 = 0.125f * 1.4426950408889634f;
constexpr int S5CH = 256, S5NC = SEQ / S5CH;
constexpr int XROWS = T * TOPK + 256;

constexpr size_t MiB = 1u << 20;
constexpr size_t WS_CTL = 0, CTL_ZERO_BYTES = 1 * MiB;
constexpr size_t WS_ADA = 1 * MiB;
constexpr size_t WS_ADAF = WS_ADA + 832 * 1024;
constexpr size_t WS_ROPE = 2 * MiB;
constexpr size_t WS_S5P = 6 * MiB;
constexpr size_t WS_S5E = 7 * MiB;
constexpr size_t WS_S5S = 8 * MiB;
constexpr size_t WS_ROUTE = 9 * MiB;
constexpr size_t WS_WIN_T = 18 * MiB, WS_WGLU_T = 26 * MiB, WS_WSB_T = 27 * MiB, WS_WAB_T = 28 * MiB, WS_WOUT_T = 29 * MiB;
constexpr size_t WS_WGU_T = 32 * MiB, WS_WDN_T = 160 * MiB;
constexpr size_t WS_XN = 224 * MiB;
constexpr size_t WS_UA = 256 * MiB, WS_Q = 280 * MiB, WS_K = 296 * MiB, WS_V = 312 * MiB, WS_VT = 328 * MiB;
constexpr size_t WS_MIX = 256 * MiB;
constexpr size_t WS_GS = 344 * MiB, WS_GA = 376 * MiB;
constexpr size_t WS_YG = 408 * MiB, WS_Y2 = 424 * MiB, WS_YA = 440 * MiB;
constexpr size_t WS_M1 = 456 * MiB;
constexpr size_t WS_H2 = 480 * MiB;
constexpr size_t WS_XG = 224 * MiB, WS_YB = 224 * MiB;
constexpr size_t WS_H1 = WS_XG + (size_t)XROWS * D * 2;
constexpr size_t WS_END = 512 * MiB;
static_assert(WS_H1 + (size_t)XROWS * FF * 2 <= WS_H2 + 1 * MiB + 0 && WS_H1 + (size_t)XROWS * FF * 2 <= WS_END, "ws map");
constexpr int CW_TMO = 0, CW_CODE = 1, CW_BAR = 4096, CW_ECNT = 8192, CW_KM = 16384;
static_assert((CW_KM + BATCH * NH * NBLK * HD) * 4 <= (int)CTL_ZERO_BYTES, "ctl");

constexpr int RING_OFF = 0, RING_BYTES = 131072;
constexpr int LDSCTL_OFF = 152 * 1024, MISC_OFF = LDSCTL_OFF + 320;
constexpr int LDS_BYTES = 156 * 1024;

#define GAS __attribute__((address_space(1)))
#define LAS __attribute__((address_space(3)))
typedef unsigned short bf16;
typedef unsigned v4u __attribute__((ext_vector_type(4)));
typedef unsigned v2u __attribute__((ext_vector_type(2)));
typedef float f32x4 __attribute__((ext_vector_type(4)));
typedef GAS unsigned gu32;
#define RLX_AGENT __ATOMIC_RELAXED, __HIP_MEMORY_SCOPE_AGENT
#define LDS_WAIT() asm volatile("s_waitcnt lgkmcnt(0)" ::: "memory")
#define VM_WAIT() asm volatile("s_waitcnt vmcnt(0)" ::: "memory")
__device__ __forceinline__ unsigned f2bf(float f) { unsigned u = __builtin_bit_cast(unsigned, f); return (u + 0x7fffu + ((u >> 16) & 1u)) >> 16; }
__device__ __forceinline__ unsigned pk2(float lo, float hi) { return f2bf(lo) | (f2bf(hi) << 16); }
__device__ __forceinline__ float bflo(unsigned w) { return __builtin_bit_cast(float, w << 16); }
__device__ __forceinline__ float bfhi(unsigned w) { return __builtin_bit_cast(float, w & 0xffff0000u); }
__device__ __forceinline__ float bf2f(bf16 h) { return __builtin_bit_cast(float, (unsigned)h << 16); }
__device__ __forceinline__ float sigmoidf_(float x) { return 1.f / (1.f + __expf(-x)); }
__device__ __forceinline__ float gelu_tanh(float x) { const float u = 0.7978845608028654f * (x + 0.044715f * x * x * x); const float e = __expf(-2.f * fabsf(u)); const float th = (1.f - e) / (1.f + e); return 0.5f * x * (1.f + (u < 0.f ? -th : th)); }

#define XB_TMO      128
#define XB_XCNT(j)  (256  + 64 * (j))
#define XB_XSUB(j)  (1280 + 64 * (j))
#define XB_XGEN(j)  (2304 + 64 * (j))
#define XB_TOP      3328
#define XB_TOPGEN   3392
#define XCD_BAR_WORDS 3456
#define XB_SPIN_CAP (1u << 18)
__device__ __forceinline__ unsigned xb_ld(unsigned* p)              { return __hip_atomic_load(p, __ATOMIC_RELAXED, __HIP_MEMORY_SCOPE_AGENT); }
__device__ __forceinline__ unsigned xb_add(unsigned* p, unsigned v) { return __hip_atomic_fetch_add(p, v, __ATOMIC_RELAXED, __HIP_MEMORY_SCOPE_AGENT); }
__device__ __forceinline__ unsigned xb_xcc_id() { return (unsigned)__builtin_amdgcn_s_getreg((3 << 11) | 20) & 0xFu; }
#define XB_SPIN(cond, bar) do { unsigned _sp = 0; while (cond) { __builtin_amdgcn_s_sleep(1); \
    if ((++_sp & 255u) == 0u) { if (xb_ld(&(bar)[XB_TMO])) break; if (_sp > XB_SPIN_CAP) { atomicAdd(&(bar)[XB_TMO], 1u); break; } } } } while (0)
struct XcdBarrier { unsigned* bar; unsigned x; volatile LAS unsigned* st; };
__device__ __forceinline__ XcdBarrier xcd_barrier_post(unsigned* bar, volatile LAS unsigned* st) {
    XcdBarrier b; b.bar = bar; b.x = xb_xcc_id(); b.st = st;
    if (threadIdx.x == 0) (void)xb_add(&bar[XB_XCNT(b.x)], 1u);
    return b;
}
__device__ __forceinline__ void xcd_barrier_complete(unsigned* bar, unsigned x, unsigned& nloc, unsigned& nx) {
    const unsigned G = gridDim.x * gridDim.y * gridDim.z;
    unsigned sum, cnt, mine, sp = 0u;
    for (;;) {
        sum = 0u; cnt = 0u; mine = 0u;
#pragma unroll
        for (unsigned j = 0; j < 16; ++j) { const unsigned c = xb_ld(&bar[XB_XCNT(j)]); sum += c; cnt += (c > 0u) ? 1u : 0u; mine = (j == x) ? c : mine; }
        if (sum == G) break;
        __builtin_amdgcn_s_sleep(1);
        if ((++sp & 255u) == 0u) { if (xb_ld(&bar[XB_TMO])) break; if (sp > XB_SPIN_CAP) { atomicAdd(&bar[XB_TMO], 1u); break; } }
    }
    nloc = mine > 0u ? mine : 1u; nx = cnt > 0u ? cnt : 1u;
}
__device__ __forceinline__ void xcd_barrier(const XcdBarrier& b) {
    asm volatile("s_waitcnt vmcnt(0)" ::: "memory");
    __syncthreads();
    if (threadIdx.x == 0) {
        unsigned* bar = b.bar;
        __builtin_amdgcn_s_waitcnt(0);
        unsigned nloc = b.st[0], nx = b.st[1];
        if (nloc == 0u) { xcd_barrier_complete(bar, b.x, nloc, nx); b.st[0] = nloc; b.st[1] = nx; }
        const unsigned old = xb_add(&bar[XB_XSUB(b.x)], 1u);
        const unsigned gen = old / nloc;
        if (old + 1u == (gen + 1u) * nloc) {
            __builtin_amdgcn_fence(__ATOMIC_RELEASE, "agent");
            asm volatile("s_waitcnt vmcnt(0)" ::: "memory");
            const unsigned og = xb_add(&bar[XB_TOP], 1u);
            const unsigned tg = og / nx;
            if (og + 1u == (tg + 1u) * nx) xb_add(&bar[XB_TOPGEN], 1u);
            else XB_SPIN(xb_ld(&bar[XB_TOPGEN]) == tg, bar);
            __builtin_amdgcn_fence(__ATOMIC_ACQUIRE, "agent");
            xb_add(&bar[XB_XGEN(b.x)], 1u);
            asm volatile("s_waitcnt vmcnt(0)" ::: "memory");
        } else {
            XB_SPIN(xb_ld(&bar[XB_XGEN(b.x)]) == gen, bar);
            __builtin_amdgcn_fence(__ATOMIC_ACQUIRE, "agent");
            asm volatile("s_waitcnt vmcnt(0)" ::: "memory");
        }
    }
    __syncthreads();
}

__device__ __forceinline__ float wave_sum(float v) {
#pragma unroll
    for (int o = 1; o < 64; o <<= 1) v += __shfl_xor(v, o);
    return v;
}
__device__ __forceinline__ float wave_max(float v) {
#pragma unroll
    for (int o = 1; o < 64; o <<= 1) v = fmaxf(v, __shfl_xor(v, o));
    return v;
}
struct Frame {
    LAS unsigned char* lds;
    volatile LAS unsigned* MISC;
    gu32* ctl;
    int tid, lane, wave;
    int vcu, G;
    unsigned char* ws;
    const float* in[30];
    float* out;
};
#define WSP(T_, off) ((T_*)(F.ws + (off)))

__device__ __forceinline__ int perm8(int c) { return (c & ~31) + 16 * ((c >> 2) & 1) + 4 * ((c >> 3) & 3) + (c & 3); }
struct MapP8 { int off; __device__ __forceinline__ int operator()(int n) const { return off + perm8(n); } };
struct MapWin { __device__ __forceinline__ int operator()(int c) const {
    if (c < 512 || c >= 1536) return perm8(c);
    const int base = (c < 1024) ? 512 : 1024, cc = c - base, head = cc >> 6, d = cc & 63, pnq = head >> 2, hh = head & 3, n = d >> 5, dd = d & 31;
    const int wc = 2 * (hh & 1) + (dd >> 4), bj = hh >> 1, j = dd & 15;
    return base + 256 * pnq + 128 * bj + 32 * wc + 16 * n + j; } };
struct MapGU { int e, up; __device__ __forceinline__ int operator()(int f) const { return e * 2048 + (f >> 7) * 256 + up * 128 + perm8(f & 127); } };

template <class RowMap>
__device__ __forceinline__ void p0_transpose_item(const float* W, int K, int N, bf16* WT, LAS float* scr, int item, int lane, const RowMap rm) {
    const int nblk = N / 32, kb = item / nblk, nb = item % nblk, k0 = 64 * kb, n0 = 32 * nb;
#pragma unroll 8
    for (int i = 0; i < 32; ++i) { const int kk = 2 * i + (lane >> 5); scr[kk * 33 + (lane & 31)] = W[(size_t)(k0 + kk) * N + n0 + (lane & 31)]; }
    LDS_WAIT(); asm volatile("" ::: "memory");
    const int c = lane & 7;
#pragma unroll
    for (int j = 0; j < 4; ++j) { const int n = (lane >> 3) + 8 * j; const LAS float* s = scr + (8 * c) * 33 + n;
        v4u o; o.x = pk2(s[0 * 33], s[1 * 33]); o.y = pk2(s[2 * 33], s[3 * 33]); o.z = pk2(s[4 * 33], s[5 * 33]); o.w = pk2(s[6 * 33], s[7 * 33]);
        *(GAS v4u*)(WT + (size_t)rm(n0 + n) * K + k0 + 8 * c) = o; }
    LDS_WAIT(); asm volatile("" ::: "memory");
}

__device__ __forceinline__ void phase0(Frame& F) {
    LAS float* scr = (LAS float*)(F.lds + RING_OFF + F.wave * 16384);
    const int gw = F.vcu * NWAVES + F.wave, NGW = F.G * NWAVES;
    constexpr int I_WIN = 16 * 128, I_GLU = 8 * 16, I_SB = 8 * 32, I_AB = 8 * 32, I_OUT = 16 * 32, I_E = 16 * 32;
    constexpr int I_SMALL = I_WIN + I_GLU + I_SB + I_AB + I_OUT, I_MOE = 3 * NE * I_E, I_ADA = 16 * 96;
    constexpr int NITEMS = I_SMALL + I_MOE + I_ADA;
    for (int it = gw; it < NITEMS; it += NGW) {
        int r = it;
        if (r < I_WIN) { p0_transpose_item(F.in[9], D, INW, WSP(bf16, WS_WIN_T), scr, r, F.lane, MapWin{}); continue; } r -= I_WIN;
        if (r < I_GLU) { p0_transpose_item(F.in[18], SW, SW, WSP(bf16, WS_WGLU_T), scr, r, F.lane, MapP8{0}); continue; } r -= I_GLU;
        if (r < I_SB) { p0_transpose_item(F.in[19], SW, D, WSP(bf16, WS_WSB_T), scr, r, F.lane, MapP8{0}); continue; } r -= I_SB;
        if (r < I_AB) { p0_transpose_item(F.in[20], AW, D, WSP(bf16, WS_WAB_T), scr, r, F.lane, MapP8{0}); continue; } r -= I_AB;
        if (r < I_OUT) { p0_transpose_item(F.in[21], D, D, WSP(bf16, WS_WOUT_T), scr, r, F.lane, MapP8{0}); continue; } r -= I_OUT;
        if (r < I_MOE) {
            const int mat = r / I_E, item = r % I_E, kind = mat / NE, e = mat % NE;
            if (kind == 0) p0_transpose_item(F.in[24] + (size_t)e * D * FF, D, FF, WSP(bf16, WS_WGU_T), scr, item, F.lane, MapGU{e, 0});
            else if (kind == 1) p0_transpose_item(F.in[26] + (size_t)e * D * FF, D, FF, WSP(bf16, WS_WGU_T), scr, item, F.lane, MapGU{e, 1});
            else p0_transpose_item(F.in[28] + (size_t)e * FF * D, FF, D, WSP(bf16, WS_WDN_T), scr, item, F.lane, MapP8{e * 1024});
            continue; }
        r -= I_MOE;
        {
            const int ks = r / 96, cc = r % 96, n = cc * 64 + F.lane;
            const float* cvec = F.in[1]; const float* aw = F.in[3];
            float a0 = 0.f, a1 = 0.f;
            for (int k = ks * 64; k < ks * 64 + 64; ++k) {
                const float c0 = cvec[k], c1 = cvec[D + k];
                const float s0 = c0 / (1.f + __expf(-c0)), s1 = c1 / (1.f + __expf(-c1));
                const float w = aw[(size_t)k * (6 * D) + n];
                a0 += s0 * w; a1 += s1 * w; }
            float* part = WSP(float, WS_ADA);
            part[(ks * 2 + 0) * (6 * D) + n] = a0; part[(ks * 2 + 1) * (6 * D) + n] = a1;
        }
    }
    const int gt = F.vcu * (NWAVES * 64) + F.tid, NGT = F.G * NWAVES * 64;
    { const int* pos = (const int*)F.in[2]; float* rc = WSP(float, WS_ROPE); float* rs = rc + (size_t)T * 32;
      for (int i = gt; i < T * 32; i += NGT) { const int t = i >> 5, p = i & 31;
          const float invf = exp2f(-(float)p * (13.287712379549449f / 32.f));
          const double ang = (double)pos[t] * (double)invf; double rev = ang * 0.15915494309189535; rev -= floor(rev);
          const float fr = (float)rev;
          rc[i] = __builtin_amdgcn_cosf(fr); rs[i] = __builtin_amdgcn_sinf(fr); } }
    { float* P5 = WSP(float, WS_S5P);
      for (int i = gt; i < NG * NP; i += NGT) { const int g = i >> 6;
          const float dt = __expf(F.in[12][g]); const float lr = F.in[10][i], li = F.in[11][i];
          const float er = __expf(lr * dt); const double ang = (double)li * (double)dt; double rev = ang * 0.15915494309189535; rev -= floor(rev);
          const float cs = __builtin_amdgcn_cosf((float)rev), sn = __builtin_amdgcn_sinf((float)rev);
          float br = er * cs, bi = er * sn;
          P5[i] = br; P5[2048 + i] = bi;
          const float nr = br - 1.f, ni = bi, den = lr * lr + li * li;
          const float qr = (nr * lr + ni * li) / den, qi = (ni * lr - nr * li) / den;
          P5[8192 + i] = qr; P5[8192 + 2048 + i] = qi;
          float pr = br, pi_ = bi;
#pragma unroll
          for (int s = 0; s < 8; ++s) { const float tr = pr * pr - pi_ * pi_, ti = 2.f * pr * pi_; pr = tr; pi_ = ti; }
          P5[4096 + i] = pr; P5[6144 + i] = pi_; }
    }
}

__device__ __forceinline__ void phase1(Frame& F) {
    LAS float* A1 = (LAS float*)(F.lds + RING_OFF); LAS float* A2 = A1 + 2 * D;
    const float* part = WSP(float, WS_ADA); const float* ab = F.in[4]; const float* pg = F.in[5];
    for (int k = F.tid; k < D; k += NWAVES * 64)
#pragma unroll
        for (int b = 0; b < 2; ++b) { float sh = ab[k], sc = ab[D + k];
            for (int ks = 0; ks < 16; ++ks) { sh += part[(ks * 2 + b) * (6 * D) + k]; sc += part[(ks * 2 + b) * (6 * D) + D + k]; }
            A1[b * D + k] = pg[k] * (1.f + sc); A2[b * D + k] = sh; }
    const int gt = F.vcu * (NWAVES * 64) + F.tid, NGT = F.G * NWAVES * 64;
    { float* adaf = WSP(float, WS_ADAF);
      for (int n = gt; n < 2 * 6 * D; n += NGT) { const int b = n / (6 * D), j = n % (6 * D); float a = ab[j];
          for (int ks = 0; ks < 16; ++ks) a += part[(ks * 2 + b) * (6 * D) + j];
          adaf[n] = a; } }
    { float* P5 = WSP(float, WS_S5P);
      for (int i = gt; i < NG * NP * GS16; i += NGT) { const int gp = i >> 4; const float qr = P5[8192 + gp], qi = P5[8192 + 2048 + gp];
          const float b_r = F.in[13][i], b_i = F.in[14][i];
          P5[16384 + i] = qr * b_r - qi * b_i; P5[16384 + 32768 + i] = qr * b_i + qi * b_r; } }
    __syncthreads();
    const int gw = F.vcu * NWAVES + F.wave, NGW = F.G * NWAVES;
    bf16* XN = WSP(bf16, WS_XN);
    for (int m = gw; m < T; m += NGW) {
        const int b = m >> 13;
        const GAS f32x4* xr = (const GAS f32x4*)(F.in[0] + (size_t)m * D) + F.lane;
        f32x4 v[4]; float s = 0.f;
#pragma unroll
        for (int j = 0; j < 4; ++j) { v[j] = xr[64 * j]; s += (v[j].x * v[j].x + v[j].y * v[j].y) + (v[j].z * v[j].z + v[j].w * v[j].w); }
        const float rstd = 1.f / sqrtf(wave_sum(s) * (1.f / D) + NORM_EPS);
        GAS unsigned long long* o8 = (GAS unsigned long long*)(XN + (size_t)m * D) + F.lane;
#pragma unroll
        for (int j = 0; j < 4; ++j) { const f32x4 a1 = *(const LAS f32x4*)(A1 + b * D + 4 * F.lane + 256 * j), a2 = *(const LAS f32x4*)(A2 + b * D + 4 * F.lane + 256 * j);
            const f32x4 o = v[j] * rstd * a1 + a2;
            o8[64 * j] = (unsigned long long)pk2(o.x, o.y) | ((unsigned long long)pk2(o.z, o.w) << 32); }
    }
    __syncthreads();
}

struct EpiG1 {
    bf16 *UA, *Q, *K, *V, *VT, *GSp, *GAp; const float *rc, *rs; float* km;
    __device__ __forceinline__ void operator()(const pg8::f32x4 (&acc)[2][2][4][2], const pg8::Unit& u, int wr, int wc, int fr, int fq) const {
        asm volatile("" : "+v"(fr), "+v"(fq));
        const int pn = u.pn, row0 = u.pm * 256 + wr * 64 + fr;
        if (pn < 2) {
#pragma unroll
            for (int ai = 0; ai < 2; ++ai)
#pragma unroll
                for (int m = 0; m < 4; ++m) { const int t = row0 + ai * 128 + m * 16, b = t >> 13, tt = t & (SEQ - 1), c = tt >> 4, s = tt & 15;
#pragma unroll
                    for (int bj = 0; bj < 2; ++bj) { const int ch = pn * 256 + bj * 128 + wc * 32 + 8 * fq, g = ch >> 4, ci = ch & 15;
                        const pg8::f32x4 v0 = acc[ai][bj][m][0], v1 = acc[ai][bj][m][1];
                        v4u w; w.x = pk2(v0[0], v0[1]); w.y = pk2(v0[2], v0[3]); w.z = pk2(v1[0], v1[1]); w.w = pk2(v1[2], v1[3]);
                        *(v4u*)(UA + ((size_t)(g * 1024 + b * 512 + c) * 384 + 16 * s + ci)) = w; } }
        } else if (pn < 6) {
            const bool isk = pn >= 4; bf16* X = isk ? K : Q; const float sc = isk ? 1.f : C2;
            const int p0 = 16 * (wc & 1) + 4 * fq;
#pragma unroll
            for (int bj = 0; bj < 2; ++bj) {
                const int head = 4 * (pn & 1) + 2 * bj + (wc >> 1);
                int rowb = row0; asm volatile("" : "+v"(rowb));
                float ks[2][4];
#pragma unroll
                for (int b = 0; b < 2; ++b)
#pragma unroll
                    for (int i = 0; i < 4; ++i) ks[b][i] = 0.f;
#pragma unroll
                for (int ai = 0; ai < 2; ++ai)
#pragma unroll
                    for (int m = 0; m < 4; ++m) { const int t = rowb + ai * 128 + m * 16;
                        const pg8::f32x4 cs = *(const pg8::f32x4*)(rc + (size_t)t * 32 + p0), sn = *(const pg8::f32x4*)(rs + (size_t)t * 32 + p0);
                        const pg8::f32x4 t1 = acc[ai][bj][m][0], t2 = acc[ai][bj][m][1];
                        const pg8::f32x4 o1 = t1 * cs - t2 * sn, o2 = t2 * cs + t1 * sn;
                        v2u w1, w2; w1.x = pk2(o1[0] * sc, o1[1] * sc); w1.y = pk2(o1[2] * sc, o1[3] * sc); w2.x = pk2(o2[0] * sc, o2[1] * sc); w2.y = pk2(o2[2] * sc, o2[3] * sc);
                        bf16* dst = X + (size_t)t * AW + head * 64 + p0;
                        *(v2u*)dst = w1; *(v2u*)(dst + 32) = w2;
#pragma unroll
                        for (int i = 0; i < 4; ++i) { ks[0][i] += o1[i]; ks[1][i] += o2[i]; }
                        __builtin_amdgcn_sched_barrier(0); }
                if (isk) {
                    const int b = u.pm >> 5, blk = u.pm & 31;
#pragma unroll
                    for (int n = 0; n < 2; ++n)
#pragma unroll
                        for (int i = 0; i < 4; ++i) { float v = ks[n][i];
                            v += __shfl_xor(v, 1); v += __shfl_xor(v, 2); v += __shfl_xor(v, 4); v += __shfl_xor(v, 8);
                            if (fr == 0) atomicAdd(km + ((size_t)((b * NH + head) * NBLK + blk) * HD + 32 * n + p0 + i), v); }
                }
            }
        } else if (pn < 8) {
#pragma unroll
            for (int ai = 0; ai < 2; ++ai)
#pragma unroll
                for (int m = 0; m < 4; ++m) { const int t = row0 + ai * 128 + m * 16, b = t >> 13, tt = t & (SEQ - 1);
#pragma unroll
                    for (int bj = 0; bj < 2; ++bj) { const int cv = (pn - 6) * 256 + bj * 128 + wc * 32 + 8 * fq, head = cv >> 6, d = cv & 63;
                        const pg8::f32x4 v0 = acc[ai][bj][m][0], v1 = acc[ai][bj][m][1];
                        v4u w; w.x = pk2(v0[0], v0[1]); w.y = pk2(v0[2], v0[3]); w.z = pk2(v1[0], v1[1]); w.w = pk2(v1[2], v1[3]);
                        *(v4u*)(V + (size_t)t * AW + cv) = w;
                        bf16* vt = VT + ((size_t)((b * NH + head) * HD + d) * SEQ + tt);
                        vt[0 * SEQ] = (bf16)(w.x & 0xffff); vt[1 * SEQ] = (bf16)(w.x >> 16); vt[2 * SEQ] = (bf16)(w.y & 0xffff); vt[3 * SEQ] = (bf16)(w.y >> 16);
                        vt[4 * SEQ] = (bf16)(w.z & 0xffff); vt[5 * SEQ] = (bf16)(w.z >> 16); vt[6 * SEQ] = (bf16)(w.w & 0xffff); vt[7 * SEQ] = (bf16)(w.w >> 16); } }
        } else {
            bf16* Gp = (pn < 12) ? GSp : GAp; const int cb = ((pn - 8) & 3) * 256;
#pragma unroll
            for (int ai = 0; ai < 2; ++ai)
#pragma unroll
                for (int m = 0; m < 4; ++m) { const int t = row0 + ai * 128 + m * 16;
#pragma unroll
                    for (int bj = 0; bj < 2; ++bj) { const int col = cb + bj * 128 + wc * 32 + 8 * fq;
                        const pg8::f32x4 v0 = acc[ai][bj][m][0], v1 = acc[ai][bj][m][1];
                        v4u w; w.x = pk2(sigmoidf_(v0[0]), sigmoidf_(v0[1])); w.y = pk2(sigmoidf_(v0[2]), sigmoidf_(v0[3]));
                        w.z = pk2(sigmoidf_(v1[0]), sigmoidf_(v1[1])); w.w = pk2(sigmoidf_(v1[2]), sigmoidf_(v1[3]));
                        *(v4u*)(Gp + (size_t)t * D + col) = w; } }
        }
    }
};

template <int MODE> struct EpiEw {
    bf16* O; const bf16* X1; const bf16* X2; float* Of; int ld;
    __device__ __forceinline__ void operator()(const pg8::f32x4 (&acc)[2][2][4][2], const pg8::Unit& u, int wr, int wc, int fr, int fq) const {
        const int row0 = u.pm * 256 + wr * 64 + fr, col0 = u.pn * 256 + wc * 32 + 8 * fq;
#pragma unroll
        for (int ai = 0; ai < 2; ++ai)
#pragma unroll
            for (int m = 0; m < 4; ++m) { const size_t rb = (size_t)(row0 + ai * 128 + m * 16) * ld + col0;
#pragma unroll
                for (int bj = 0; bj < 2; ++bj) { const size_t off = rb + bj * 128;
                    const pg8::f32x4 v0 = acc[ai][bj][m][0], v1 = acc[ai][bj][m][1];
                    if (MODE == 3) { *(pg8::f32x4*)(Of + off) = v0; *(pg8::f32x4*)(Of + off + 4) = v1; }
                    else {
                        const v4u x = *(const v4u*)(X1 + off);
                        float r[8] = {v0[0], v0[1], v0[2], v0[3], v1[0], v1[1], v1[2], v1[3]};
                        const float xv[8] = {bflo(x.x), bfhi(x.x), bflo(x.y), bfhi(x.y), bflo(x.z), bfhi(x.z), bflo(x.w), bfhi(x.w)};
                        if (MODE == 0) {
#pragma unroll
                            for (int i = 0; i < 8; ++i) r[i] = xv[i] * sigmoidf_(r[i]);
                        } else if (MODE == 1) {
#pragma unroll
                            for (int i = 0; i < 8; ++i) r[i] = xv[i] * r[i];
                        } else {
                            const v4u y = *(const v4u*)(X2 + off);
                            const float yv[8] = {bflo(y.x), bfhi(y.x), bflo(y.y), bfhi(y.y), bflo(y.z), bfhi(y.z), bflo(y.w), bfhi(y.w)};
#pragma unroll
                            for (int i = 0; i < 8; ++i) r[i] = yv[i] + xv[i] * r[i];
                        }
                        v4u w; w.x = pk2(r[0], r[1]); w.y = pk2(r[2], r[3]); w.z = pk2(r[4], r[5]); w.w = pk2(r[6], r[7]);
                        *(v4u*)(O + off) = w; } } }
    }
};

__device__ __forceinline__ void s5_load_u(const bf16* UA, int g, int b, int tt, float (&u)[16]) {
    const v4u* p = (const v4u*)(UA + ((size_t)(g * 1024 + b * 512 + (tt >> 4)) * 384 + 16 * (tt & 15)));
    const v4u a = p[0], c = p[1];
    u[0] = bflo(a.x); u[1] = bfhi(a.x); u[2] = bflo(a.y); u[3] = bfhi(a.y); u[4] = bflo(a.z); u[5] = bfhi(a.z); u[6] = bflo(a.w); u[7] = bfhi(a.w);
    u[8] = bflo(c.x); u[9] = bfhi(c.x); u[10] = bflo(c.y); u[11] = bfhi(c.y); u[12] = bflo(c.z); u[13] = bfhi(c.z); u[14] = bflo(c.w); u[15] = bfhi(c.w);
}
__device__ __forceinline__ void s5_pass_a(Frame& F) {
    const int gw = F.vcu * NWAVES + F.wave, NGW = F.G * NWAVES, p = F.lane;
    const float* P5 = WSP(float, WS_S5P); const bf16* UA = WSP(bf16, WS_UA); float* E = WSP(float, WS_S5E);
    for (int w = gw; w < BATCH * NG * S5NC; w += NGW) {
        const int ch = w % S5NC, bg = w / S5NC, g = bg % NG, b = bg / NG;
        const float lr = P5[g * 64 + p], li = P5[2048 + g * 64 + p];
        float bbr[16], bbi[16];
#pragma unroll
        for (int i = 0; i < 16; ++i) { bbr[i] = P5[16384 + (g * 64 + p) * 16 + i]; bbi[i] = P5[16384 + 32768 + (g * 64 + p) * 16 + i]; }
        float sr = 0.f, si = 0.f;
        for (int tk = 0; tk < S5CH; ++tk) { float u[16]; s5_load_u(UA, g, b, ch * S5CH + tk, u);
            float br = 0.f, bi = 0.f;
#pragma unroll
            for (int i = 0; i < 16; ++i) { br += bbr[i] * u[i]; bi += bbi[i] * u[i]; }
            const float nr = lr * sr - li * si + br, ni = lr * si + li * sr + bi; sr = nr; si = ni; }
        E[(size_t)w * 128 + 2 * p] = sr; E[(size_t)w * 128 + 2 * p + 1] = si;
    }
}
__device__ __forceinline__ void s5_carry(Frame& F) {
    const int gw = F.vcu * NWAVES + F.wave, NGW = F.G * NWAVES, p = F.lane;
    const float* P5 = WSP(float, WS_S5P); const float* E = WSP(float, WS_S5E); float* Sp = WSP(float, WS_S5S);
    for (int bg = gw; bg < BATCH * NG; bg += NGW) { const int g = bg % NG;
        const float cr = P5[4096 + g * 64 + p], ci = P5[6144 + g * 64 + p];
        float sr = 0.f, si = 0.f;
        for (int ch = 0; ch < S5NC; ++ch) { const size_t o = ((size_t)bg * S5NC + ch) * 128 + 2 * p;
            Sp[o] = sr; Sp[o + 1] = si;
            const float er = E[o], ei = E[o + 1];
            const float nr = cr * sr - ci * si + er, ni = cr * si + ci * sr + ei; sr = nr; si = ni; } }
}
__device__ __forceinline__ void s5_pass_c(Frame& F) {
    const int gw = F.vcu * NWAVES + F.wave, NGW = F.G * NWAVES, p = F.lane, L = F.lane;
    const float* P5 = WSP(float, WS_S5P); const bf16* UA = WSP(bf16, WS_UA); const float* Sp = WSP(float, WS_S5S); bf16* YG = WSP(bf16, WS_YG);
    const int h1 = (L >> 5) & 1, h2 = (L >> 4) & 1, h3 = (L >> 3) & 1, h4 = (L >> 2) & 1, co = 8 * h1 + 4 * h2 + 2 * h3 + h4;
    for (int w = gw; w < BATCH * NG * S5NC; w += NGW) {
        const int ch = w % S5NC, bg = w / S5NC, g = bg % NG, b = bg / NG;
        const float lr = P5[g * 64 + p], li = P5[2048 + g * 64 + p];
        float bbr[16], bbi[16], ccr[16], cci[16];
#pragma unroll
        for (int i = 0; i < 16; ++i) { bbr[i] = P5[16384 + (g * 64 + p) * 16 + i]; bbi[i] = P5[16384 + 32768 + (g * 64 + p) * 16 + i];
            ccr[i] = F.in[15][(g * 16 + i) * 64 + p]; cci[i] = F.in[16][(g * 16 + i) * 64 + p]; }
        const float dsk = F.in[17][g * 16 + co];
        float sr = Sp[(size_t)w * 128 + 2 * p], si = Sp[(size_t)w * 128 + 2 * p + 1];
        for (int tk = 0; tk < S5CH; ++tk) { const int tt = ch * S5CH + tk; float u[16]; s5_load_u(UA, g, b, tt, u);
            float br = 0.f, bi = 0.f;
#pragma unroll
            for (int i = 0; i < 16; ++i) { br += bbr[i] * u[i]; bi += bbi[i] * u[i]; }
            const float nr = lr * sr - li * si + br, ni = lr * si + li * sr + bi; sr = nr; si = ni;
            float v[16];
#pragma unroll
            for (int i = 0; i < 16; ++i) v[i] = ccr[i] * sr - cci[i] * si;
#pragma unroll
            for (int k = 0; k < 8; ++k) { const float mine = h1 ? v[k + 8] : v[k], oth = h1 ? v[k] : v[k + 8]; v[k] = mine + __shfl_xor(oth, 32); }
#pragma unroll
            for (int k = 0; k < 4; ++k) { const float mine = h2 ? v[k + 4] : v[k], oth = h2 ? v[k] : v[k + 4]; v[k] = mine + __shfl_xor(oth, 16); }
#pragma unroll
            for (int k = 0; k < 2; ++k) { const float mine = h3 ? v[k + 2] : v[k], oth = h3 ? v[k] : v[k + 2]; v[k] = mine + __shfl_xor(oth, 8); }
            { const float mine = h4 ? v[1] : v[0], oth = h4 ? v[0] : v[1]; v[0] = mine + __shfl_xor(oth, 4); }
            v[0] += __shfl_xor(v[0], 2); v[0] += __shfl_xor(v[0], 1);
            const float uco = bf2f(UA[((size_t)(g * 1024 + b * 512 + (tt >> 4)) * 384 + 16 * (tt & 15)) + co]);
            const float y = gelu_tanh(v[0] + dsk * uco);
            if ((L & 3) == 0) YG[(size_t)(b * SEQ + tt) * SW + g * 16 + co] = (bf16)f2bf(y);
        }
    }
}

__device__ __forceinline__ void attn_naive(Frame& F) {
    const int gw = F.vcu * NWAVES + F.wave, NGW = F.G * NWAVES;
    const bf16* Q = WSP(bf16, WS_Q); const bf16* K = WSP(bf16, WS_K); const bf16* V = WSP(bf16, WS_V); bf16* YA = WSP(bf16, WS_YA);
    const float* km = (const float*)(F.ctl + CW_KM);
    for (int w = gw; w < BATCH * NH * (SEQ / 64); w += NGW) {
        const int bh = w >> 7, b = bh >> 3, h = bh & 7, tt = (w & 127) * 64 + F.lane, t = b * SEQ + tt, blk = tt >> 8;
        float q[64];
        { const v4u* qp = (const v4u*)(Q + (size_t)t * AW + h * 64);
#pragma unroll
          for (int i = 0; i < 8; ++i) { const v4u x = qp[i]; q[8 * i] = bflo(x.x); q[8 * i + 1] = bfhi(x.x); q[8 * i + 2] = bflo(x.y); q[8 * i + 3] = bfhi(x.y);
              q[8 * i + 4] = bflo(x.z); q[8 * i + 5] = bfhi(x.z); q[8 * i + 6] = bflo(x.w); q[8 * i + 7] = bfhi(x.w); } }
        float v0 = -3e38f, v1 = -3e38f, v2 = -3e38f; int i0 = -1, i1 = -1, i2 = -1;
        for (int j = 0; j < blk; ++j) { const float* kp = km + (size_t)((b * NH + h) * NBLK + j) * HD; float g = 0.f;
#pragma unroll
            for (int d = 0; d < 64; ++d) g += q[d] * kp[d];
            if (g > v0) { v2 = v1; i2 = i1; v1 = v0; i1 = i0; v0 = g; i0 = j; }
            else if (g > v1) { v2 = v1; i2 = i1; v1 = g; i1 = j; }
            else if (g > v2) { v2 = g; i2 = j; } }
        float m = -1e30f, l = 0.f, o[64];
#pragma unroll
        for (int d = 0; d < 64; ++d) o[d] = 0.f;
#pragma unroll 1
        for (int slot = 0; slot < 4; ++slot) {
            const int jb = slot == 0 ? blk : (slot == 1 ? i0 : (slot == 2 ? i1 : i2));
            const int cnt = slot == 0 ? (tt & 255) + 1 : (jb >= 0 ? 256 : 0);
            if (!__any(cnt > 0)) continue;
            const int jbb = jb < 0 ? 0 : jb;
#pragma unroll 1
            for (int kk = 0; kk < 256; ++kk) {
                if (!__any(kk < cnt)) break;
                if (kk < cnt) {
                    const size_t key = (size_t)(b * SEQ + jbb * 256 + kk) * AW + h * 64;
                    const v4u* kp = (const v4u*)(K + key); float s = 0.f;
#pragma unroll
                    for (int i = 0; i < 8; ++i) { const v4u x = kp[i];
                        s += q[8 * i] * bflo(x.x) + q[8 * i + 1] * bfhi(x.x) + q[8 * i + 2] * bflo(x.y) + q[8 * i + 3] * bfhi(x.y)
                           + q[8 * i + 4] * bflo(x.z) + q[8 * i + 5] * bfhi(x.z) + q[8 * i + 6] * bflo(x.w) + q[8 * i + 7] * bfhi(x.w); }
                    const float mn = fmaxf(m, s), a = exp2f(m - mn), pp = exp2f(s - mn);
                    l = l * a + pp; m = mn;
                    const v4u* vp = (const v4u*)(V + key);
#pragma unroll
                    for (int i = 0; i < 8; ++i) { const v4u x = vp[i];
                        o[8 * i] = o[8 * i] * a + pp * bflo(x.x); o[8 * i + 1] = o[8 * i + 1] * a + pp * bfhi(x.x);
                        o[8 * i + 2] = o[8 * i + 2] * a + pp * bflo(x.y); o[8 * i + 3] = o[8 * i + 3] * a + pp * bfhi(x.y);
                        o[8 * i + 4] = o[8 * i + 4] * a + pp * bflo(x.z); o[8 * i + 5] = o[8 * i + 5] * a + pp * bfhi(x.z);
                        o[8 * i + 6] = o[8 * i + 6] * a + pp * bflo(x.w); o[8 * i + 7] = o[8 * i + 7] * a + pp * bfhi(x.w); }
                }
            }
        }
        const float rl = 1.f / l;
        v4u* op = (v4u*)(YA + (size_t)t * AW + h * 64);
#pragma unroll
        for (int i = 0; i < 8; ++i) { v4u wv; wv.x = pk2(o[8 * i] * rl, o[8 * i + 1] * rl); wv.y = pk2(o[8 * i + 2] * rl, o[8 * i + 3] * rl);
            wv.z = pk2(o[8 * i + 4] * rl, o[8 * i + 5] * rl); wv.w = pk2(o[8 * i + 6] * rl, o[8 * i + 7] * rl); op[i] = wv; }
    }
}
constexpr int SCR_OFF = LDSCTL_OFF + 512;
__device__ __forceinline__ void phase_rows(Frame& F) {
    LAS float* WrT = (LAS float*)(F.lds);
    LAS float* gtm = (LAS float*)(F.lds + 131072);
    LAS float* pg2 = gtm + 2 * D; LAS float* shf = pg2 + 2 * D;
    LAS unsigned* hist = (LAS unsigned*)(F.lds + SCR_OFF); LAS unsigned* base = hist + 32; LAS int* rec_e = (LAS int*)(base + 32); LAS int* rec_lp = rec_e + 256;
    const float* adaf = WSP(float, WS_ADAF);
    for (int i = F.tid; i < D * NE; i += NWAVES * 64) { const int k = i >> 5, e = i & 31; WrT[e * D + k] = F.in[22][i]; }
    for (int i = F.tid; i < 2 * D; i += NWAVES * 64) { const int b = i >> 10, k = i & (D - 1);
        gtm[i] = adaf[b * 6 * D + 2 * D + k] * F.in[6][k];
        pg2[i] = F.in[7][k] * (1.f + adaf[b * 6 * D + 4 * D + k]); shf[i] = adaf[b * 6 * D + 3 * D + k]; }
    if (F.tid < 32) hist[F.tid] = 0u;
    __syncthreads();
    const float* mix = WSP(float, WS_MIX); bf16* H2 = WSP(bf16, WS_H2);
    int* tok_e = WSP(int, WS_ROUTE); float* tok_w = (float*)(tok_e + T * 4); int* tok_pos = tok_e + 2 * T * 4;
    unsigned* gcnt = (unsigned*)(F.ctl + CW_ECNT);
    const int L = F.lane;
    for (int t0 = F.vcu * 64; t0 < T; t0 += F.G * 64) {
        for (int tk = 0; tk < 8; ++tk) {
            const int tl = F.wave * 8 + tk, t = t0 + tl, b = t >> 13;
            const GAS f32x4* mr = (const GAS f32x4*)(mix + (size_t)t * D) + L; const GAS f32x4* xr = (const GAS f32x4*)(F.in[0] + (size_t)t * D) + L;
            f32x4 mv[4], xv[4]; float s = 0.f;
#pragma unroll
            for (int j = 0; j < 4; ++j) { mv[j] = mr[64 * j]; xv[j] = xr[64 * j]; s += (mv[j].x * mv[j].x + mv[j].y * mv[j].y) + (mv[j].z * mv[j].z + mv[j].w * mv[j].w); }
            const float r1 = 1.f / sqrtf(wave_sum(s) * (1.f / D) + NORM_EPS);
            float s2 = 0.f;
            GAS f32x4* orow = (GAS f32x4*)(F.out + (size_t)t * D) + L;
#pragma unroll
            for (int j = 0; j < 4; ++j) { const f32x4 g = *(const LAS f32x4*)(gtm + b * D + 4 * L + 256 * j);
                xv[j] = xv[j] + g * (mv[j] * r1); orow[64 * j] = xv[j];
                s2 += (xv[j].x * xv[j].x + xv[j].y * xv[j].y) + (xv[j].z * xv[j].z + xv[j].w * xv[j].w); }
            const float r2 = 1.f / sqrtf(wave_sum(s2) * (1.f / D) + NORM_EPS);
            GAS unsigned long long* h8 = (GAS unsigned long long*)(H2 + (size_t)t * D) + L;
#pragma unroll
            for (int j = 0; j < 4; ++j) { const f32x4 a = *(const LAS f32x4*)(pg2 + b * D + 4 * L + 256 * j), c = *(const LAS f32x4*)(shf + b * D + 4 * L + 256 * j);
                xv[j] = xv[j] * r2 * a + c;
                h8[64 * j] = (unsigned long long)pk2(xv[j].x, xv[j].y) | ((unsigned long long)pk2(xv[j].z, xv[j].w) << 32); }
            float pe[32];
#pragma unroll
            for (int e = 0; e < 32; ++e) { float a = 0.f;
#pragma unroll
                for (int j = 0; j < 4; ++j) { const f32x4 w = *(const LAS f32x4*)(WrT + e * D + 4 * L + 256 * j); a += (xv[j].x * w.x + xv[j].y * w.y) + (xv[j].z * w.z + xv[j].w * w.w); }
                pe[e] = a; }
            { const int h = (L >> 5) & 1;
#pragma unroll
              for (int k = 0; k < 16; ++k) { const float mine = h ? pe[k + 16] : pe[k], oth = h ? pe[k] : pe[k + 16]; pe[k] = mine + __shfl_xor(oth, 32); } }
            { const int h = (L >> 4) & 1;
#pragma unroll
              for (int k = 0; k < 8; ++k) { const float mine = h ? pe[k + 8] : pe[k], oth = h ? pe[k] : pe[k + 8]; pe[k] = mine + __shfl_xor(oth, 16); } }
            { const int h = (L >> 3) & 1;
#pragma unroll
              for (int k = 0; k < 4; ++k) { const float mine = h ? pe[k + 4] : pe[k], oth = h ? pe[k] : pe[k + 4]; pe[k] = mine + __shfl_xor(oth, 8); } }
            { const int h = (L >> 2) & 1;
#pragma unroll
              for (int k = 0; k < 2; ++k) { const float mine = h ? pe[k + 2] : pe[k], oth = h ? pe[k] : pe[k + 2]; pe[k] = mine + __shfl_xor(oth, 4); } }
            { const int h = (L >> 1) & 1; const float mine = h ? pe[1] : pe[0], oth = h ? pe[0] : pe[1]; pe[0] = mine + __shfl_xor(oth, 2); }
            pe[0] += __shfl_xor(pe[0], 1);
            const int myE = L >> 1;
            float val = pe[0] + F.in[23][myE];
            if (L & 1) val = -3e38f;
            int se[4]; float sv[4];
#pragma unroll
            for (int r = 0; r < 4; ++r) { const float mx = wave_max(val); const unsigned long long bal = __ballot(val == mx); const int win = __ffsll((long long)bal) - 1;
                se[r] = win >> 1; sv[r] = mx; if (L == win) val = -3e38f; }
            const float e1 = __expf(sv[1] - sv[0]), e2 = __expf(sv[2] - sv[0]), e3 = __expf(sv[3] - sv[0]), inv = 1.f / (1.f + e1 + e2 + e3);
            if (L < 4) { const int e = L == 0 ? se[0] : (L == 1 ? se[1] : (L == 2 ? se[2] : se[3]));
                const float wv = (L == 0 ? 1.f : (L == 1 ? e1 : (L == 2 ? e2 : e3))) * inv;
                tok_e[t * 4 + L] = e; tok_w[t * 4 + L] = wv;
                const unsigned lp = atomicAdd((unsigned*)(hist + e), 1u);
                rec_e[tl * 4 + L] = e; rec_lp[tl * 4 + L] = (int)lp; }
        }
        __syncthreads();
        if (F.tid < 32) { const unsigned h = hist[F.tid]; base[F.tid] = h ? __hip_atomic_fetch_add(gcnt + F.tid, h, RLX_AGENT) : 0u; }
        __syncthreads();
        if (F.tid < 256) { tok_pos[(t0 + (F.tid >> 2)) * 4 + (F.tid & 3)] = (int)base[rec_e[F.tid]] + rec_lp[F.tid]; }
        __syncthreads();
        if (F.tid < 32) hist[F.tid] = 0u;
        __syncthreads();
    }
}

__device__ __forceinline__ void moe_tables(Frame& F) {
    LAS int* cnt = (LAS int*)(F.lds + SCR_OFF); LAS int* off = cnt + 32; LAS int* tpre = off + 32;
    if (F.tid == 0) { int o = 0, tp = 0;
        for (int e = 0; e < NE; ++e) { const int c = (int)__hip_atomic_load(F.ctl + CW_ECNT + e, RLX_AGENT); cnt[e] = c; off[e] = o; tpre[e] = tp; o += c; tp += (c + 255) >> 8; }
        tpre[NE] = tp; }
    __syncthreads();
}
__device__ __forceinline__ void phase_gather(Frame& F) {
    moe_tables(F);
    const LAS int* off = (const LAS int*)(F.lds + SCR_OFF) + 32;
    const int gw = F.vcu * NWAVES + F.wave, NGW = F.G * NWAVES;
    const int* tok_e = WSP(int, WS_ROUTE); const int* tok_pos = tok_e + 2 * T * 4;
    const v4u* H2 = WSP(v4u, WS_H2); v4u* XG = WSP(v4u, WS_XG);
    for (int a = gw; a < T * TOPK; a += NGW) { const int t = a >> 2, e = tok_e[a], row = off[e] + tok_pos[a];
        const v4u x0 = H2[(size_t)t * 128 + F.lane], x1 = H2[(size_t)t * 128 + 64 + F.lane];
        XG[(size_t)row * 128 + F.lane] = x0; XG[(size_t)row * 128 + 64 + F.lane] = x1; }
}
struct MoeOrder {
    const LAS int* tab; int nct, brows, G, c;
    __device__ __forceinline__ bool next(int i, pg8::Unit& u) const {
        const int L = i * G + c, total = tab[64 + NE] * nct; if (L >= total) return false;
        const int rtg = L / nct, pn = L % nct; int e = 0;
        for (int k = 1; k < NE; ++k) if (tab[64 + k] <= rtg) e = k;
        const int rt = rtg - tab[64 + e], cnt = tab[e], off = tab[32 + e];
        u.e = __builtin_amdgcn_readfirstlane(e); u.pm = rt; u.pn = pn; u.arow = __builtin_amdgcn_readfirstlane(off + rt * 256); u.brow = __builtin_amdgcn_readfirstlane(e * brows + pn * 256);
        const int nr = cnt - rt * 256; u.nrow = __builtin_amdgcn_readfirstlane(nr > 256 ? 256 : nr); return true;
    }
};
struct EpiGU { bf16* H1; const float* bg; const float* bu;
    __device__ __forceinline__ void operator()(const pg8::f32x4 (&acc)[2][2][4][2], const pg8::Unit& u, int wr, int wc, int fr, int fq) const {
        const int f0 = u.pn * 128 + wc * 32 + 8 * fq;
        const pg8::f32x4 g0 = *(const pg8::f32x4*)(bg + u.e * FF + f0), g1 = *(const pg8::f32x4*)(bg + u.e * FF + f0 + 4);
        const pg8::f32x4 u0 = *(const pg8::f32x4*)(bu + u.e * FF + f0), u1 = *(const pg8::f32x4*)(bu + u.e * FF + f0 + 4);
#pragma unroll
        for (int ai = 0; ai < 2; ++ai)
#pragma unroll
            for (int m = 0; m < 4; ++m) { const int r = ai * 128 + wr * 64 + m * 16 + fr;
                const pg8::f32x4 a0 = acc[ai][0][m][0] + g0, a1 = acc[ai][0][m][1] + g1, b0 = acc[ai][1][m][0] + u0, b1 = acc[ai][1][m][1] + u1;
                float gg[8] = {a0[0], a0[1], a0[2], a0[3], a1[0], a1[1], a1[2], a1[3]}, uu[8] = {b0[0], b0[1], b0[2], b0[3], b1[0], b1[1], b1[2], b1[3]}, o[8];
#pragma unroll
                for (int i = 0; i < 8; ++i) { const float g = fminf(gg[i], 7.f), up = fminf(fmaxf(uu[i], -7.f), 7.f); o[i] = g * sigmoidf_(1.702f * g) * (up + 1.f); }
                v4u w; w.x = pk2(o[0], o[1]); w.y = pk2(o[2], o[3]); w.z = pk2(o[4], o[5]); w.w = pk2(o[6], o[7]);
                if (r < u.nrow) *(v4u*)(H1 + (size_t)(u.arow + r) * FF + f0) = w; }
    }
};
struct EpiDn { bf16* YB; const float* bd;
    __device__ __forceinline__ void operator()(const pg8::f32x4 (&acc)[2][2][4][2], const pg8::Unit& u, int wr, int wc, int fr, int fq) const {
        const int c0 = u.pn * 256 + wc * 32 + 8 * fq;
#pragma unroll
        for (int bj = 0; bj < 2; ++bj) { const pg8::f32x4 d0 = *(const pg8::f32x4*)(bd + u.e * D + c0 + bj * 128), d1 = *(const pg8::f32x4*)(bd + u.e * D + c0 + bj * 128 + 4);
#pragma unroll
            for (int ai = 0; ai < 2; ++ai)
#pragma unroll
                for (int m = 0; m < 4; ++m) { const int r = ai * 128 + wr * 64 + m * 16 + fr;
                    const pg8::f32x4 a0 = acc[ai][bj][m][0] + d0, a1 = acc[ai][bj][m][1] + d1;
                    v4u w; w.x = pk2(a0[0], a0[1]); w.y = pk2(a0[2], a0[3]); w.z = pk2(a1[0], a1[1]); w.w = pk2(a1[2], a1[3]);
                    if (r < u.nrow) *(v4u*)(YB + (size_t)(u.arow + r) * D + c0 + bj * 128) = w; } }
    }
};
__device__ __forceinline__ void phase_final(Frame& F) {
    moe_tables(F);
    const LAS int* off = (const LAS int*)(F.lds + SCR_OFF) + 32;
    LAS float* gtf = (LAS float*)(F.lds);
    const float* adaf = WSP(float, WS_ADAF);
    for (int i = F.tid; i < 2 * D; i += NWAVES * 64) { const int b = i >> 10, k = i & (D - 1); gtf[i] = adaf[b * 6 * D + 5 * D + k] * F.in[8][k]; }
    __syncthreads();
    const int gw = F.vcu * NWAVES + F.wave, NGW = F.G * NWAVES, L = F.lane;
    const int* tok_e = WSP(int, WS_ROUTE); const float* tok_w = (const float*)(tok_e + T * 4); const int* tok_pos = tok_e + 2 * T * 4;
    const bf16* YB = WSP(bf16, WS_YB);
    for (int t = gw; t < T; t += NGW) { const int b = t >> 13;
        f32x4 y[4];
#pragma unroll
        for (int j = 0; j < 4; ++j) y[j] = (f32x4){0.f, 0.f, 0.f, 0.f};
#pragma unroll
        for (int k = 0; k < 4; ++k) { const int e = tok_e[t * 4 + k], row = off[e] + tok_pos[t * 4 + k]; const float w = tok_w[t * 4 + k];
            const GAS v2u* yr = (const GAS v2u*)(YB + (size_t)row * D) + L;
#pragma unroll
            for (int j = 0; j < 4; ++j) { const v2u x = yr[64 * j]; y[j].x += w * bflo(x.x); y[j].y += w * bfhi(x.x); y[j].z += w * bflo(x.y); y[j].w += w * bfhi(x.y); } }
        float s = 0.f;
#pragma unroll
        for (int j = 0; j < 4; ++j) s += (y[j].x * y[j].x + y[j].y * y[j].y) + (y[j].z * y[j].z + y[j].w * y[j].w);
        const float r = 1.f / sqrtf(wave_sum(s) * (1.f / D) + NORM_EPS);
        GAS f32x4* orow = (GAS f32x4*)(F.out + (size_t)t * D) + L;
#pragma unroll
        for (int j = 0; j < 4; ++j) { const f32x4 g = *(const LAS f32x4*)(gtf + b * D + 4 * L + 256 * j); const f32x4 x1 = orow[64 * j]; orow[64 * j] = x1 + g * (y[j] * r); }
    }
}
#ifndef MK_N_LAUNCHES
#define MK_N_LAUNCHES 1
#endif
constexpr int N_PHASES = 15;
struct Args { const float* in[30]; float* out; unsigned char* ws; int ph_lo, ph_hi; };
__global__ void __launch_bounds__(NWAVES * 64, 2) mega_fwd(Args args) {
    extern __shared__ __attribute__((aligned(16))) unsigned char lds[];
    Frame F;
    F.lds = (LAS unsigned char*)lds;
    F.MISC = (volatile LAS unsigned*)(F.lds + MISC_OFF);
    F.tid = threadIdx.x; F.lane = F.tid & 63; F.wave = __builtin_amdgcn_readfirstlane(F.tid >> 6);
    F.G = gridDim.x; { const int bx = blockIdx.x; F.vcu = (F.G % 8 == 0) ? (bx % 8) * (F.G / 8) + bx / 8 : bx; }
    F.ws = args.ws; F.ctl = (gu32*)(args.ws + WS_CTL); F.out = args.out;
#pragma unroll
    for (int i = 0; i < 30; ++i) F.in[i] = args.in[i];
    for (int u = F.tid; u < (LDS_BYTES - LDSCTL_OFF) / 4; u += NWAVES * 64) ((LAS unsigned*)(F.lds + LDSCTL_OFF))[u] = 0u;
    __syncthreads();
    XcdBarrier bar; bar.bar = (unsigned*)(F.ctl + CW_BAR); bar.x = 0; bar.st = nullptr;
    if (MK_N_LAUNCHES == 1) bar = xcd_barrier_post((unsigned*)(F.ctl + CW_BAR), F.MISC + 8);
    const int lo = args.ph_lo, hi = args.ph_hi;
#ifndef PHMASK
#define PHMASK 0x7fff
#endif
#define IN(k) (((PHMASK >> (k)) & 1) && lo <= (k) && (k) < hi)
#define SEAM(k) do { if (IN(k) && IN((k) + 1)) xcd_barrier(bar); } while (0)
    PG8_LAS unsigned char* ring = F.lds + RING_OFF;
    const int bx = (int)blockIdx.x;

    if (IN(0)) { phase0(F); } SEAM(0);
    if (IN(1)) { phase1(F); } SEAM(1);
    if (IN(2)) {
        pg8::Gemm g{WSP(bf16, WS_XN), WSP(bf16, WS_WIN_T), D, D, D}; pg8::DenseOrder S; S.init(T, INW, F.G, bx);
        EpiG1 E{WSP(bf16, WS_UA), WSP(bf16, WS_Q), WSP(bf16, WS_K), WSP(bf16, WS_V), WSP(bf16, WS_VT), WSP(bf16, WS_GS), WSP(bf16, WS_GA),
                WSP(float, WS_ROPE), WSP(float, WS_ROPE) + (size_t)T * 32, (float*)(F.ctl + CW_KM)};
        pg8::gemm_phase(ring, g, S, E);
    } SEAM(2);
    if (IN(3)) { s5_pass_a(F); attn_naive(F); } SEAM(3);
    if (IN(4)) { s5_carry(F); } SEAM(4);
    if (IN(5)) { s5_pass_c(F); } SEAM(5);
    if (IN(6)) {
        pg8::Gemm g{WSP(bf16, WS_YG), WSP(bf16, WS_WGLU_T), SW, SW, SW}; pg8::DenseOrder S; S.init(T, SW, F.G, bx);
        EpiEw<0> E{WSP(bf16, WS_Y2), WSP(bf16, WS_YG), nullptr, nullptr, SW};
        pg8::gemm_phase(ring, g, S, E);
    } SEAM(6);
    if (IN(7)) {
        pg8::Gemm g{WSP(bf16, WS_Y2), WSP(bf16, WS_WSB_T), SW, SW, SW}; pg8::DenseOrder S; S.init(T, D, F.G, bx);
        EpiEw<1> E{WSP(bf16, WS_M1), WSP(bf16, WS_GS), nullptr, nullptr, D};
        pg8::gemm_phase(ring, g, S, E);
    } SEAM(7);
    if (IN(8)) {
        pg8::Gemm g{WSP(bf16, WS_YA), WSP(bf16, WS_WAB_T), AW, AW, AW}; pg8::DenseOrder S; S.init(T, D, F.G, bx);
        EpiEw<2> E{WSP(bf16, WS_XN), WSP(bf16, WS_GA), WSP(bf16, WS_M1), nullptr, D};
        pg8::gemm_phase(ring, g, S, E);
    } SEAM(8);
    if (IN(9)) {
        pg8::Gemm g{WSP(bf16, WS_XN), WSP(bf16, WS_WOUT_T), D, D, D}; pg8::DenseOrder S; S.init(T, D, F.G, bx);
        EpiEw<3> E{nullptr, nullptr, nullptr, WSP(float, WS_MIX), D};
        pg8::gemm_phase(ring, g, S, E);
    } SEAM(9);
    if (IN(10)) { phase_rows(F); } SEAM(10);
    if (IN(11)) { phase_gather(F); } SEAM(11);
    if (IN(12)) {
        moe_tables(F);
        pg8::Gemm g{WSP(bf16, WS_XG), WSP(bf16, WS_WGU_T), D, D, D}; MoeOrder S{(const LAS int*)(F.lds + SCR_OFF), 8, 2048, F.G, bx};
        EpiGU E{WSP(bf16, WS_H1), F.in[25], F.in[27]};
        pg8::gemm_phase(ring, g, S, E);
    } SEAM(12);
    if (IN(13)) {
        moe_tables(F);
        pg8::Gemm g{WSP(bf16, WS_H1), WSP(bf16, WS_WDN_T), FF, FF, FF}; MoeOrder S{(const LAS int*)(F.lds + SCR_OFF), 4, 1024, F.G, bx};
        EpiDn E{WSP(bf16, WS_YB), F.in[29]};
        pg8::gemm_phase(ring, g, S, E);
    } SEAM(13);
    if (IN(14)) { phase_final(F); }
#undef IN
#undef SEAM
}

extern "C" void kernel_launch(void* const* d_in, const int* in_sizes, int n_in, void* d_out, int out_size, void* d_ws, size_t ws_size, hipStream_t stream) {
    static int grid = 0;
    if (grid == 0) {
        if (n_in != 30 || in_sizes[0] != T * D || out_size != T * D || ws_size < WS_END) { fprintf(stderr, "kernel_launch: unexpected shapes (n_in %d, in0 %d, out %d, ws %zu)\n", n_in, n_in > 0 ? in_sizes[0] : -1, out_size, ws_size); grid = -1; return; }
        int dev = 0, cus = 0, per_cu = 0;
        if (hipGetDevice(&dev) != hipSuccess || hipDeviceGetAttribute(&cus, hipDeviceAttributeMultiprocessorCount, dev) != hipSuccess) { grid = -1; return; }
        if (hipFuncSetAttribute((const void*)mega_fwd, hipFuncAttributeMaxDynamicSharedMemorySize, LDS_BYTES) != hipSuccess) { fprintf(stderr, "kernel_launch: hipFuncSetAttribute failed\n"); grid = -1; return; }
        if (hipOccupancyMaxActiveBlocksPerMultiprocessor(&per_cu, (const void*)mega_fwd, NWAVES * 64, LDS_BYTES) != hipSuccess || per_cu < 1) { fprintf(stderr, "kernel_launch: occupancy query says %d\n", per_cu); }
        (void)hipGetLastError();
        grid = cus;
    }
    if (grid < 0) return;
    (void)hipMemsetAsync((char*)d_ws + WS_CTL, 0, CTL_ZERO_BYTES, stream);
    Args a{};
    for (int i = 0; i < 30; ++i) a.in[i] = (const float*)d_in[i];
    a.out = (float*)d_out; a.ws = (unsigned char*)d_ws;
    if (MK_N_LAUNCHES == 1) { a.ph_lo = 0; a.ph_hi = N_PHASES; hipLaunchKernelGGL(mega_fwd, dim3(grid), dim3(NWAVES * 64), LDS_BYTES, stream, a); }
    else for (int p = 0; p < N_PHASES; ++p) { a.ph_lo = p; a.ph_hi = p + 1; hipLaunchKernelGGL(mega_fwd, dim3(grid), dim3(NWAVES * 64), LDS_BYTES, stream, a); }
}
```

```cpp
#include <hip/hip_runtime.h>
#include <cstdio>
#include <cstdint>
#define MK_N_LAUNCHES 1
namespace pg8 {
#define PG8_LAS __attribute__((address_space(3)))
typedef unsigned short bf16_t;
typedef short bf16x8 __attribute__((ext_vector_type(8)));
typedef float f32x4 __attribute__((ext_vector_type(4)));
typedef unsigned u32x4 __attribute__((ext_vector_type(4)));
typedef unsigned u32x2 __attribute__((ext_vector_type(2)));
constexpr int BM = 256, BK = 64, HALF = 128, HTB = HALF * BK * 2  , STAGE_BYTES = 8 * HTB, NXCD = 8, WGM = 8;

__host__ __device__ __forceinline__ int lds_byte(int r, int c) { const int st = (r >> 4) * 2 + (c >> 5), rr = r & 15, cc = c & 31, ob = rr * 64 + cc * 2; return st * 1024 + (ob ^ (((ob >> 9) & 1) << 5)); }
__host__ __device__ __forceinline__ void stage_rc(int b, int& R, int& C) { const int st = b / 1024, sb = b % 1024, swz = sb ^ (((sb >> 9) & 1) << 5); R = (st >> 1) * 16 + swz / 64; C = (st & 1) * 32 + (swz % 64) / 2; }

struct Unit { int arow, brow, pm, pn, e, nrow; };
struct Gemm { const bf16_t* A; const bf16_t* Bt; int lda, ldb, K; };

struct DenseOrder {
    int nM, nN, nwg, G, c;
    __device__ __forceinline__ void init(int M, int N, int G_, int c_) { nM = M / BM; nN = N / BM; nwg = nM * nN; G = G_; c = c_; }
    __device__ __forceinline__ bool next(int i, Unit& u) const {
        const long L = (long)i * G + c; if (L >= nwg) return false;
        int wgid = (int)L; { const int q = nwg / NXCD, r = nwg % NXCD, xcd = wgid % NXCD, off = wgid / NXCD; wgid = (xcd < r ? xcd * (q + 1) : r * (q + 1) + (xcd - r) * q) + off; }
        const int nig = WGM * nN, gid = wgid / nig, fm = gid * WGM, gsz = (nM - fm) < WGM ? (nM - fm) : WGM;
        u.pm = fm + ((wgid % nig) % gsz); u.pn = (wgid % nig) / gsz; u.arow = u.pm * BM; u.brow = u.pn * BM; u.e = 0; u.nrow = BM; return true;
    }
};

template <class Epi, class Sched>
__device__ __forceinline__ void gemm_phase(PG8_LAS unsigned char* lds, const Gemm g, const Sched& S, const Epi& E) {
    const int tid = threadIdx.x, wid = __builtin_amdgcn_readfirstlane(tid >> 6), lane = tid & 63, wr = wid >> 2, wc = wid & 3, fr = lane & 15, fq = lane >> 4;
    const int K = g.K, nt = K / BK;
    unsigned voffA[2], voffB[2];
#pragma unroll
    for (int i = 0; i < 2; ++i) { int R, C; stage_rc(tid * 16 + i * 8192, R, C);
        voffA[i] = (unsigned)(R * g.lda + C) * 2u; voffB[i] = (unsigned)(R * g.ldb + C) * 2u; }
    const size_t kstep = (size_t)(BK * 2);
    const size_t hstepA = (size_t)HALF * g.lda * 2, hstepB = (size_t)HALF * g.ldb * 2;
    const size_t rowA = (size_t)g.lda * 2, rowB = (size_t)g.ldb * 2;
    const unsigned ldsw = (unsigned)wid * 1024u;
    const int aoff = lds_byte(wr * 64 + fr, fq * 8), boff = lds_byte(wc * 32 + fr, fq * 8);
#define PG8_SA(b, h) (((b) * 2 + (h)) * HTB)
#define PG8_SB(b, h) ((4 + (b) * 2 + (h)) * HTB)
#define PG8_STAGE(bufoff, gbase, voff) do { _Pragma("unroll") for (int _i = 0; _i < 2; ++_i) \
        __builtin_amdgcn_global_load_lds((const unsigned*)((const char*)(gbase) + (voff)[_i]), (PG8_LAS unsigned*)(lds + (bufoff) + ldsw + _i * 8192), 16, 0, 0); } while (0)
#define PG8_LDA(dst, b, h) do { _Pragma("unroll") for (int m = 0; m < 4; ++m) _Pragma("unroll") for (int k = 0; k < 2; ++k) dst[m][k] = *(const PG8_LAS bf16x8*)(lds + PG8_SA(b, h) + aoff + m * 2048 + k * 1024); } while (0)
#define PG8_LDB(dst, b, h) do { _Pragma("unroll") for (int n = 0; n < 2; ++n) _Pragma("unroll") for (int k = 0; k < 2; ++k) dst[n][k] = *(const PG8_LAS bf16x8*)(lds + PG8_SB(b, h) + boff + n * 2048 + k * 1024); } while (0)
#define PG8_MMA(ai, bj, At, Bt) do { __builtin_amdgcn_s_setprio(1); _Pragma("unroll") for (int m = 0; m < 4; ++m) _Pragma("unroll") for (int n = 0; n < 2; ++n) _Pragma("unroll") for (int k = 0; k < 2; ++k) \
        acc[ai][bj][m][n] = __builtin_amdgcn_mfma_f32_16x16x32_bf16(Bt[n][k], At[m][k], acc[ai][bj][m][n], 0, 0, 0); __builtin_amdgcn_s_setprio(0); } while (0)
#define PG8_WAIT_V(n) asm volatile("s_waitcnt vmcnt(" #n ")" ::: "memory")
#define PG8_WAIT_L(n) asm volatile("s_waitcnt lgkmcnt(" #n ")" ::: "memory")
#define PG8_BAR __builtin_amdgcn_s_barrier()
#define PG8_SCHED __builtin_amdgcn_sched_barrier(0)
    Unit cur, nxt; int ui = 0;
    if (!S.next(0, cur)) return;
    f32x4 acc[2][2][4][2];
#pragma unroll
    for (int a = 0; a < 2; ++a)
#pragma unroll
        for (int b = 0; b < 2; ++b)
#pragma unroll
            for (int m = 0; m < 4; ++m)
#pragma unroll
                for (int n = 0; n < 2; ++n) acc[a][b][m][n] = (f32x4){0.f, 0.f, 0.f, 0.f};
    bf16x8 At[4][2], B0[2][2], B1[2][2];
    const char* cA = (const char*)g.A + (size_t)cur.arow * rowA; const char* cB = (const char*)g.Bt + (size_t)cur.brow * rowB;
    PG8_STAGE(PG8_SB(0, 0), cB, voffB); PG8_STAGE(PG8_SB(0, 1), cB + hstepB, voffB); PG8_STAGE(PG8_SA(0, 0), cA, voffA); PG8_STAGE(PG8_SA(0, 1), cA + hstepA, voffA);
    if (wr == 1) PG8_BAR;
    PG8_WAIT_V(2); PG8_BAR;
    PG8_STAGE(PG8_SB(1, 0), cB + kstep, voffB); PG8_STAGE(PG8_SA(1, 0), cA + kstep, voffA); PG8_STAGE(PG8_SB(1, 1), cB + hstepB + kstep, voffB);
    PG8_WAIT_V(6); PG8_BAR;
    for (;;) {
        const bool has_next = S.next(ui + 1, nxt);
        const char* nA = has_next ? (const char*)g.A + (size_t)nxt.arow * rowA : cA; const char* nB = has_next ? (const char*)g.Bt + (size_t)nxt.brow * rowB : cB;
        for (int t = 0; t < nt; t += 2) {
            const bool last = (t == nt - 2);
            const char* a1 = cA + (size_t)(t + 1) * kstep;
            const char* a2 = last ? nA : cA + (size_t)(t + 2) * kstep; const char* b2 = last ? nB : cB + (size_t)(t + 2) * kstep;
            const char* a3 = a2 + kstep; const char* b3 = b2 + kstep;
            PG8_LDB(B0, 0, 0); PG8_LDB(B1, 0, 1); PG8_SCHED; PG8_LDA(At, 0, 0); PG8_STAGE(PG8_SA(1, 1), a1 + hstepA, voffA);
            PG8_WAIT_V(8); PG8_WAIT_L(0); PG8_BAR; PG8_MMA(0, 0, At, B0); PG8_MMA(0, 1, At, B1); PG8_BAR; PG8_SCHED;
            PG8_LDA(At, 0, 1); PG8_STAGE(PG8_SB(0, 0), b2, voffB); PG8_STAGE(PG8_SB(0, 1), b2 + hstepB, voffB); PG8_STAGE(PG8_SA(0, 0), a2, voffA);
            PG8_WAIT_V(8); PG8_WAIT_L(0); PG8_BAR; PG8_MMA(1, 0, At, B0); PG8_MMA(1, 1, At, B1); PG8_BAR; PG8_SCHED;
            PG8_LDB(B0, 1, 0); PG8_LDB(B1, 1, 1); PG8_SCHED; PG8_LDA(At, 1, 0); PG8_STAGE(PG8_SA(0, 1), a2 + hstepA, voffA);
            PG8_WAIT_V(8); PG8_WAIT_L(0); PG8_BAR; PG8_MMA(0, 0, At, B0); PG8_MMA(0, 1, At, B1); PG8_BAR; PG8_SCHED;
            PG8_LDA(At, 1, 1); PG8_STAGE(PG8_SB(1, 0), b3, voffB); PG8_STAGE(PG8_SB(1, 1), b3 + hstepB, voffB); PG8_STAGE(PG8_SA(1, 0), a3, voffA);
            PG8_WAIT_V(8); PG8_WAIT_L(0); PG8_BAR; PG8_MMA(1, 0, At, B0); PG8_MMA(1, 1, At, B1); PG8_BAR; PG8_SCHED;
        }
        if (wr == 0) PG8_BAR;
        E(acc, cur, wr, wc, fr, fq);
        if (!has_next) break;
#pragma unroll
        for (int a = 0; a < 2; ++a)
#pragma unroll
            for (int b = 0; b < 2; ++b)
#pragma unroll
                for (int m = 0; m < 4; ++m)
#pragma unroll
                    for (int n = 0; n < 2; ++n) acc[a][b][m][n] = (f32x4){0.f, 0.f, 0.f, 0.f};
        cur = nxt; cA = nA; cB = nB; ++ui;
        if (wr == 1) PG8_BAR;
    }
    PG8_WAIT_V(0);
    PG8_BAR;
#undef PG8_SA
#undef PG8_SB
#undef PG8_STAGE
#undef PG8_LDA
#undef PG8_LDB
#undef PG8_MMA
#undef PG8_WAIT_V
#undef PG8_WAIT_L
#undef PG8_BAR
#undef PG8_SCHED
}
}
constexpr int NWAVES = 8;
constexpr int BATCH = 2, SEQ = 8192, T = BATCH * SEQ, D = 1024, NH = 8, HD = 64, AW = 512, SW = 512, NG = 32, NP = 64, GS16 = 16;
constexpr int NE = 32, FF = 1024, INW = 4096, TOPK = 4, NBLK = SEQ / 256;
constexpr float NORM_EPS = 1e-6f;
constexpr float C2 = 0.125f * 1.4426950408889634f;
constexpr int S5CH = 256, S5NC = SEQ / S5CH;
constexpr int XROWS = T * TOPK + 256;

constexpr size_t MiB = 1u << 20;
constexpr size_t WS_CTL = 0, CTL_ZERO_BYTES = 1 * MiB;
constexpr size_t WS_ADA = 1 * MiB;
constexpr size_t WS_ADAF = WS_ADA + 832 * 1024;
constexpr size_t WS_ROPE = 2 * MiB;
constexpr size_t WS_S5P = 6 * MiB;
constexpr size_t WS_S5E = 7 * MiB;
constexpr size_t WS_S5S = 8 * MiB;
constexpr size_t WS_ROUTE = 9 * MiB;
constexpr size_t WS_WIN_T = 18 * MiB, WS_WGLU_T = 26 * MiB, WS_WSB_T = 27 * MiB, WS_WAB_T = 28 * MiB, WS_WOUT_T = 29 * MiB;
constexpr size_t WS_WGU_T = 32 * MiB, WS_WDN_T = 160 * MiB;
constexpr size_t WS_XN = 224 * MiB;
constexpr size_t WS_UA = 256 * MiB, WS_Q = 280 * MiB, WS_K = 296 * MiB, WS_V = 312 * MiB, WS_VT = 328 * MiB;
constexpr size_t WS_MIX = 256 * MiB;
constexpr size_t WS_GS = 344 * MiB, WS_GA = 376 * MiB;
constexpr size_t WS_YG = 408 * MiB, WS_Y2 = 424 * MiB, WS_YA = 440 * MiB;
constexpr size_t WS_M1 = 456 * MiB;
constexpr size_t WS_H2 = 480 * MiB;
constexpr size_t WS_XG = 224 * MiB, WS_YB = 224 * MiB;
constexpr size_t WS_H1 = WS_XG + (size_t)XROWS * D * 2;
constexpr size_t WS_END = 512 * MiB;
static_assert(WS_H1 + (size_t)XROWS * FF * 2 <= WS_H2 + 1 * MiB + 0 && WS_H1 + (size_t)XROWS * FF * 2 <= WS_END, "ws map");
constexpr int CW_TMO = 0, CW_CODE = 1, CW_BAR = 4096, CW_ECNT = 8192, CW_KM = 16384;
static_assert((CW_KM + BATCH * NH * NBLK * HD) * 4 <= (int)CTL_ZERO_BYTES, "ctl");

constexpr int RING_OFF = 0, RING_BYTES = 131072;
constexpr int LDSCTL_OFF = 152 * 1024, MISC_OFF = LDSCTL_OFF + 320;
constexpr int LDS_BYTES = 156 * 1024;

#define GAS __attribute__((address_space(1)))
#define LAS __attribute__((address_space(3)))
typedef unsigned short bf16;
typedef unsigned v4u __attribute__((ext_vector_type(4)));
typedef unsigned v2u __attribute__((ext_vector_type(2)));
typedef float f32x4 __attribute__((ext_vector_type(4)));
typedef GAS unsigned gu32;
#define RLX_AGENT __ATOMIC_RELAXED, __HIP_MEMORY_SCOPE_AGENT
#define LDS_WAIT() asm volatile("s_waitcnt lgkmcnt(0)" ::: "memory")
#define VM_WAIT() asm volatile("s_waitcnt vmcnt(0)" ::: "memory")
__device__ __forceinline__ unsigned f2bf(float f) { unsigned u = __builtin_bit_cast(unsigned, f); return (u + 0x7fffu + ((u >> 16) & 1u)) >> 16; }
__device__ __forceinline__ unsigned pk2(float lo, float hi) { typedef float f32x2_t __attribute__((ext_vector_type(2))); typedef __bf16 bf16x2_t __attribute__((ext_vector_type(2)));
    f32x2_t v = {lo, hi}; bf16x2_t r = __builtin_convertvector(v, bf16x2_t); return __builtin_bit_cast(unsigned, r); }
__device__ __forceinline__ float bflo(unsigned w) { return __builtin_bit_cast(float, w << 16); }
__device__ __forceinline__ float bfhi(unsigned w) { return __builtin_bit_cast(float, w & 0xffff0000u); }
__device__ __forceinline__ float bf2f(bf16 h) { return __builtin_bit_cast(float, (unsigned)h << 16); }
__device__ __forceinline__ float sigmoidf_(float x) { return 1.f / (1.f + __expf(-x)); }
__device__ __forceinline__ float gelu_tanh(float x) { const float u = 0.7978845608028654f * (x + 0.044715f * x * x * x); const float e = __expf(-2.f * fabsf(u)); const float th = (1.f - e) / (1.f + e); return 0.5f * x * (1.f + (u < 0.f ? -th : th)); }

#define XB_TMO      128
#define XB_XCNT(j)  (256  + 64 * (j))
#define XB_XSUB(j)  (1280 + 64 * (j))
#define XB_XGEN(j)  (2304 + 64 * (j))
#define XB_TOP      3328
#define XB_TOPGEN   3392
#define XCD_BAR_WORDS 3456
#define XB_SPIN_CAP (1u << 18)
__device__ __forceinline__ unsigned xb_ld(unsigned* p)              { return __hip_atomic_load(p, __ATOMIC_RELAXED, __HIP_MEMORY_SCOPE_AGENT); }
__device__ __forceinline__ unsigned xb_add(unsigned* p, unsigned v) { return __hip_atomic_fetch_add(p, v, __ATOMIC_RELAXED, __HIP_MEMORY_SCOPE_AGENT); }
__device__ __forceinline__ unsigned xb_xcc_id() { return (unsigned)__builtin_amdgcn_s_getreg((3 << 11) | 20) & 0xFu; }
#define XB_SPIN(cond, bar) do { unsigned _sp = 0; while (cond) { __builtin_amdgcn_s_sleep(1); \
    if ((++_sp & 255u) == 0u) { if (xb_ld(&(bar)[XB_TMO])) break; if (_sp > XB_SPIN_CAP) { atomicAdd(&(bar)[XB_TMO], 1u); break; } } } } while (0)
struct XcdBarrier { unsigned* bar; unsigned x; volatile LAS unsigned* st; };
__device__ __forceinline__ XcdBarrier xcd_barrier_post(unsigned* bar, volatile LAS unsigned* st) {
    XcdBarrier b; b.bar = bar; b.x = xb_xcc_id(); b.st = st;
    if (threadIdx.x == 0) (void)xb_add(&bar[XB_XCNT(b.x)], 1u);
    return b;
}
__device__ __forceinline__ void xcd_barrier_complete(unsigned* bar, unsigned x, unsigned& nloc, unsigned& nx) {
    const unsigned G = gridDim.x * gridDim.y * gridDim.z;
    unsigned sum, cnt, mine, sp = 0u;
    for (;;) {
        sum = 0u; cnt = 0u; mine = 0u;
#pragma unroll
        for (unsigned j = 0; j < 16; ++j) { const unsigned c = xb_ld(&bar[XB_XCNT(j)]); sum += c; cnt += (c > 0u) ? 1u : 0u; mine = (j == x) ? c : mine; }
        if (sum == G) break;
        __builtin_amdgcn_s_sleep(1);
        if ((++sp & 255u) == 0u) { if (xb_ld(&bar[XB_TMO])) break; if (sp > XB_SPIN_CAP) { atomicAdd(&bar[XB_TMO], 1u); break; } }
    }
    nloc = mine > 0u ? mine : 1u; nx = cnt > 0u ? cnt : 1u;
}
__device__ __forceinline__ void xcd_barrier(const XcdBarrier& b) {
    asm volatile("s_waitcnt vmcnt(0)" ::: "memory");
    __syncthreads();
    if (threadIdx.x == 0) {
        unsigned* bar = b.bar;
        __builtin_amdgcn_s_waitcnt(0);
        unsigned nloc = b.st[0], nx = b.st[1];
        if (nloc == 0u) { xcd_barrier_complete(bar, b.x, nloc, nx); b.st[0] = nloc; b.st[1] = nx; }
        const unsigned old = xb_add(&bar[XB_XSUB(b.x)], 1u);
        const unsigned gen = old / nloc;
        if (old + 1u == (gen + 1u) * nloc) {
            __builtin_amdgcn_fence(__ATOMIC_RELEASE, "agent");
            asm volatile("s_waitcnt vmcnt(0)" ::: "memory");
            const unsigned og = xb_add(&bar[XB_TOP], 1u);
            const unsigned tg = og / nx;
            if (og + 1u == (tg + 1u) * nx) xb_add(&bar[XB_TOPGEN], 1u);
            else XB_SPIN(xb_ld(&bar[XB_TOPGEN]) == tg, bar);
            __builtin_amdgcn_fence(__ATOMIC_ACQUIRE, "agent");
            xb_add(&bar[XB_XGEN(b.x)], 1u);
            asm volatile("s_waitcnt vmcnt(0)" ::: "memory");
        } else {
            XB_SPIN(xb_ld(&bar[XB_XGEN(b.x)]) == gen, bar);
            __builtin_amdgcn_fence(__ATOMIC_ACQUIRE, "agent");
            asm volatile("s_waitcnt vmcnt(0)" ::: "memory");
        }
    }
    __syncthreads();
}

__device__ __forceinline__ float wave_sum(float v) {
#pragma unroll
    for (int o = 1; o < 64; o <<= 1) v += __shfl_xor(v, o);
    return v;
}
__device__ __forceinline__ float wave_max(float v) {
#pragma unroll
    for (int o = 1; o < 64; o <<= 1) v = fmaxf(v, __shfl_xor(v, o));
    return v;
}
struct Frame {
    LAS unsigned char* lds;
    volatile LAS unsigned* MISC;
    gu32* ctl;
    int tid, lane, wave;
    int vcu, G;
    unsigned char* ws;
    const float* in[30];
    float* out;
};
#define WSP(T_, off) ((T_*)(F.ws + (off)))

__device__ __forceinline__ int perm8(int c) { return (c & ~31) + 16 * ((c >> 2) & 1) + 4 * ((c >> 3) & 3) + (c & 3); }
struct MapP8 { int off; __device__ __forceinline__ int operator()(int n) const { return off + perm8(n); } };
struct MapWin { __device__ __forceinline__ int operator()(int c) const {
    if (c < 512 || c >= 1536) return perm8(c);
    const int base = (c < 1024) ? 512 : 1024, cc = c - base, head = cc >> 6, d = cc & 63, pnq = head >> 2, hh = head & 3, n = d >> 5, dd = d & 31;
    const int wc = 2 * (hh & 1) + (dd >> 4), bj = hh >> 1, j = dd & 15;
    return base + 256 * pnq + 128 * bj + 32 * wc + 16 * n + j; } };
struct MapGU { int e, up; __device__ __forceinline__ int operator()(int f) const { return e * 2048 + (f >> 7) * 256 + up * 128 + perm8(f & 127); } };

template <class RowMap>
__device__ __forceinline__ void p0_transpose_item(const float* W, int K, int N, bf16* WT, LAS float* scr, int item, int lane, const RowMap rm) {
    const int nblk = N / 32, kb = item / nblk, nb = item % nblk, k0 = 64 * kb, n0 = 32 * nb;
#pragma unroll 8
    for (int i = 0; i < 32; ++i) { const int kk = 2 * i + (lane >> 5); scr[kk * 33 + (lane & 31)] = W[(size_t)(k0 + kk) * N + n0 + (lane & 31)]; }
    LDS_WAIT(); asm volatile("" ::: "memory");
    const int c = lane & 7;
#pragma unroll
    for (int j = 0; j < 4; ++j) { const int n = (lane >> 3) + 8 * j; const LAS float* s = scr + (8 * c) * 33 + n;
        v4u o; o.x = pk2(s[0 * 33], s[1 * 33]); o.y = pk2(s[2 * 33], s[3 * 33]); o.z = pk2(s[4 * 33], s[5 * 33]); o.w = pk2(s[6 * 33], s[7 * 33]);
        *(GAS v4u*)(WT + (size_t)rm(n0 + n) * K + k0 + 8 * c) = o; }
    LDS_WAIT(); asm volatile("" ::: "memory");
}

__device__ __forceinline__ void phase0(Frame& F) {
    LAS float* scr = (LAS float*)(F.lds + RING_OFF + F.wave * 16384);
    const int gw = F.vcu * NWAVES + F.wave, NGW = F.G * NWAVES;
    constexpr int I_WIN = 16 * 128, I_GLU = 8 * 16, I_SB = 8 * 32, I_AB = 8 * 32, I_OUT = 16 * 32, I_E = 16 * 32;
    constexpr int I_SMALL = I_WIN + I_GLU + I_SB + I_AB + I_OUT, I_MOE = 3 * NE * I_E, I_ADA = 16 * 96;
    constexpr int NITEMS = I_SMALL + I_MOE + I_ADA;
    for (int it = gw; it < NITEMS; it += NGW) {
        int r = it;
        if (r < I_WIN) { p0_transpose_item(F.in[9], D, INW, WSP(bf16, WS_WIN_T), scr, r, F.lane, MapWin{}); continue; } r -= I_WIN;
        if (r < I_GLU) { p0_transpose_item(F.in[18], SW, SW, WSP(bf16, WS_WGLU_T), scr, r, F.lane, MapP8{0}); continue; } r -= I_GLU;
        if (r < I_SB) { p0_transpose_item(F.in[19], SW, D, WSP(bf16, WS_WSB_T), scr, r, F.lane, MapP8{0}); continue; } r -= I_SB;
        if (r < I_AB) { p0_transpose_item(F.in[20], AW, D, WSP(bf16, WS_WAB_T), scr, r, F.lane, MapP8{0}); continue; } r -= I_AB;
        if (r < I_OUT) { p0_transpose_item(F.in[21], D, D, WSP(bf16, WS_WOUT_T), scr, r, F.lane, MapP8{0}); continue; } r -= I_OUT;
        if (r < I_MOE) {
            const int mat = r / I_E, item = r % I_E, kind = mat / NE, e = mat % NE;
            if (kind == 0) p0_transpose_item(F.in[24] + (size_t)e * D * FF, D, FF, WSP(bf16, WS_WGU_T), scr, item, F.lane, MapGU{e, 0});
            else if (kind == 1) p0_transpose_item(F.in[26] + (size_t)e * D * FF, D, FF, WSP(bf16, WS_WGU_T), scr, item, F.lane, MapGU{e, 1});
            else p0_transpose_item(F.in[28] + (size_t)e * FF * D, FF, D, WSP(bf16, WS_WDN_T), scr, item, F.lane, MapP8{e * 1024});
            continue; }
        r -= I_MOE;
        {
            const int ks = r / 96, cc = r % 96, n = cc * 64 + F.lane;
            const float* cvec = F.in[1]; const float* aw = F.in[3];
            float a0 = 0.f, a1 = 0.f;
            for (int k = ks * 64; k < ks * 64 + 64; ++k) {
                const float c0 = cvec[k], c1 = cvec[D + k];
                const float s0 = c0 / (1.f + __expf(-c0)), s1 = c1 / (1.f + __expf(-c1));
                const float w = aw[(size_t)k * (6 * D) + n];
                a0 += s0 * w; a1 += s1 * w; }
            float* part = WSP(float, WS_ADA);
            part[(ks * 2 + 0) * (6 * D) + n] = a0; part[(ks * 2 + 1) * (6 * D) + n] = a1;
        }
    }
    const int gt = F.vcu * (NWAVES * 64) + F.tid, NGT = F.G * NWAVES * 64;
    { const int* pos = (const int*)F.in[2]; float* rc = WSP(float, WS_ROPE); float* rs = rc + (size_t)T * 32;
      for (int i = gt; i < T * 32; i += NGT) { const int t = i >> 5, p = i & 31;
          const float invf = exp2f(-(float)p * (13.287712379549449f / 32.f));
          const double ang = (double)pos[t] * (double)invf; double rev = ang * 0.15915494309189535; rev -= floor(rev);
          const float fr = (float)rev;
          rc[i] = __builtin_amdgcn_cosf(fr); rs[i] = __builtin_amdgcn_sinf(fr); } }
    { float* P5 = WSP(float, WS_S5P);
      for (int i = gt; i < NG * NP; i += NGT) { const int g = i >> 6;
          const float dt = __expf(F.in[12][g]); const float lr = F.in[10][i], li = F.in[11][i];
          const float er = __expf(lr * dt); const double ang = (double)li * (double)dt; double rev = ang * 0.15915494309189535; rev -= floor(rev);
          const float cs = __builtin_amdgcn_cosf((float)rev), sn = __builtin_amdgcn_sinf((float)rev);
          float br = er * cs, bi = er * sn;
          P5[i] = br; P5[2048 + i] = bi;
          const float nr = br - 1.f, ni = bi, den = lr * lr + li * li;
          const float qr = (nr * lr + ni * li) / den, qi = (ni * lr - nr * li) / den;
          P5[8192 + i] = qr; P5[8192 + 2048 + i] = qi;
          float pr = br, pi_ = bi;
#pragma unroll
          for (int s = 0; s < 8; ++s) { const float tr = pr * pr - pi_ * pi_, ti = 2.f * pr * pi_; pr = tr; pi_ = ti; }
          P5[4096 + i] = pr; P5[6144 + i] = pi_; }
    }
}

__device__ __forceinline__ void phase1(Frame& F) {
    LAS float* A1 = (LAS float*)(F.lds + RING_OFF); LAS float* A2 = A1 + 2 * D;
    const float* part = WSP(float, WS_ADA); const float* ab = F.in[4]; const float* pg = F.in[5];
    for (int k = F.tid; k < D; k += NWAVES * 64)
#pragma unroll
        for (int b = 0; b < 2; ++b) { float sh = ab[k], sc = ab[D + k];
            for (int ks = 0; ks < 16; ++ks) { sh += part[(ks * 2 + b) * (6 * D) + k]; sc += part[(ks * 2 + b) * (6 * D) + D + k]; }
            A1[b * D + k] = pg[k] * (1.f + sc); A2[b * D + k] = sh; }
    const int gt = F.vcu * (NWAVES * 64) + F.tid, NGT = F.G * NWAVES * 64;
    { float* adaf = WSP(float, WS_ADAF);
      for (int n = gt; n < 2 * 6 * D; n += NGT) { const int b = n / (6 * D), j = n % (6 * D); float a = ab[j];
          for (int ks = 0; ks < 16; ++ks) a += part[(ks * 2 + b) * (6 * D) + j];
          adaf[n] = a; } }
    { float* P5 = WSP(float, WS_S5P);
      for (int i = gt; i < NG * NP * GS16; i += NGT) { const int gp = i >> 4; const float qr = P5[8192 + gp], qi = P5[8192 + 2048 + gp];
          const float b_r = F.in[13][i], b_i = F.in[14][i];
          P5[16384 + i] = qr * b_r - qi * b_i; P5[16384 + 32768 + i] = qr * b_i + qi * b_r; } }
    __syncthreads();
    const int gw = F.vcu * NWAVES + F.wave, NGW = F.G * NWAVES;
    bf16* XN = WSP(bf16, WS_XN);
    for (int m = gw; m < T; m += NGW) {
        const int b = m >> 13;
        const GAS f32x4* xr = (const GAS f32x4*)(F.in[0] + (size_t)m * D) + F.lane;
        f32x4 v[4]; float s = 0.f;
#pragma unroll
        for (int j = 0; j < 4; ++j) { v[j] = xr[64 * j]; s += (v[j].x * v[j].x + v[j].y * v[j].y) + (v[j].z * v[j].z + v[j].w * v[j].w); }
        const float rstd = 1.f / sqrtf(wave_sum(s) * (1.f / D) + NORM_EPS);
        GAS unsigned long long* o8 = (GAS unsigned long long*)(XN + (size_t)m * D) + F.lane;
#pragma unroll
        for (int j = 0; j < 4; ++j) { const f32x4 a1 = *(const LAS f32x4*)(A1 + b * D + 4 * F.lane + 256 * j), a2 = *(const LAS f32x4*)(A2 + b * D + 4 * F.lane + 256 * j);
            const f32x4 o = v[j] * rstd * a1 + a2;
            o8[64 * j] = (unsigned long long)pk2(o.x, o.y) | ((unsigned long long)pk2(o.z, o.w) << 32); }
    }
    __syncthreads();
}

struct EpiG1 {
    bf16 *UA, *Q, *K, *V, *VT, *GSp, *GAp; const float *rc, *rs; float* km;
    __device__ __forceinline__ void operator()(const pg8::f32x4 (&acc)[2][2][4][2], const pg8::Unit& u, int wr, int wc, int fr, int fq) const {
        asm volatile("" : "+v"(fr), "+v"(fq));
        const int pn = u.pn, row0 = u.pm * 256 + wr * 64 + fr;
        if (pn < 2) {
#pragma unroll
            for (int ai = 0; ai < 2; ++ai)
#pragma unroll
                for (int m = 0; m < 4; ++m) { const int t = row0 + ai * 128 + m * 16, b = t >> 13, tt = t & (SEQ - 1), c = tt >> 4, s = tt & 15;
#pragma unroll
                    for (int bj = 0; bj < 2; ++bj) { const int ch = pn * 256 + bj * 128 + wc * 32 + 8 * fq, g = ch >> 4, ci = ch & 15;
                        const pg8::f32x4 v0 = acc[ai][bj][m][0], v1 = acc[ai][bj][m][1];
                        v4u w; w.x = pk2(v0[0], v0[1]); w.y = pk2(v0[2], v0[3]); w.z = pk2(v1[0], v1[1]); w.w = pk2(v1[2], v1[3]);
                        *(v4u*)(UA + ((size_t)(g * 1024 + b * 512 + c) * 384 + 16 * s + ci)) = w; } }
        } else if (pn < 6) {
            const bool isk = pn >= 4; bf16* X = isk ? K : Q; const float sc = isk ? 1.f : C2;
            const int p0 = 16 * (wc & 1) + 4 * fq;
#pragma unroll
            for (int bj = 0; bj < 2; ++bj) {
                const int head = 4 * (pn & 1) + 2 * bj + (wc >> 1);
                int rowb = row0; asm volatile("" : "+v"(rowb));
                float ks[2][4];
#pragma unroll
                for (int b = 0; b < 2; ++b)
#pragma unroll
                    for (int i = 0; i < 4; ++i) ks[b][i] = 0.f;
#pragma unroll
                for (int ai = 0; ai < 2; ++ai)
#pragma unroll
                    for (int m = 0; m < 4; ++m) { const int t = rowb + ai * 128 + m * 16;
                        const pg8::f32x4 cs = *(const pg8::f32x4*)(rc + (size_t)t * 32 + p0), sn = *(const pg8::f32x4*)(rs + (size_t)t * 32 + p0);
                        const pg8::f32x4 t1 = acc[ai][bj][m][0], t2 = acc[ai][bj][m][1];
                        const pg8::f32x4 o1 = t1 * cs - t2 * sn, o2 = t2 * cs + t1 * sn;
                        v2u w1, w2; w1.x = pk2(o1[0] * sc, o1[1] * sc); w1.y = pk2(o1[2] * sc, o1[3] * sc); w2.x = pk2(o2[0] * sc, o2[1] * sc); w2.y = pk2(o2[2] * sc, o2[3] * sc);
                        bf16* dst = X + (size_t)t * AW + head * 64 + p0;
                        *(v2u*)dst = w1; *(v2u*)(dst + 32) = w2;
#pragma unroll
                        for (int i = 0; i < 4; ++i) { ks[0][i] += o1[i]; ks[1][i] += o2[i]; }
                        __builtin_amdgcn_sched_barrier(0); }
                if (isk) {
                    const int b = u.pm >> 5, blk = u.pm & 31;
#pragma unroll
                    for (int n = 0; n < 2; ++n)
#pragma unroll
                        for (int i = 0; i < 4; ++i) { float v = ks[n][i];
                            v += __shfl_xor(v, 1); v += __shfl_xor(v, 2); v += __shfl_xor(v, 4); v += __shfl_xor(v, 8);
                            if (fr == 0) atomicAdd(km + ((size_t)((b * NH + head) * NBLK + blk) * HD + 32 * n + p0 + i), v); }
                }
            }
        } else if (pn < 8) {
#pragma unroll
            for (int ai = 0; ai < 2; ++ai)
#pragma unroll
                for (int m = 0; m < 4; ++m) { const int t = row0 + ai * 128 + m * 16, b = t >> 13, tt = t & (SEQ - 1);
#pragma unroll
                    for (int bj = 0; bj < 2; ++bj) { const int cv = (pn - 6) * 256 + bj * 128 + wc * 32 + 8 * fq, head = cv >> 6, d = cv & 63;
                        const pg8::f32x4 v0 = acc[ai][bj][m][0], v1 = acc[ai][bj][m][1];
                        v4u w; w.x = pk2(v0[0], v0[1]); w.y = pk2(v0[2], v0[3]); w.z = pk2(v1[0], v1[1]); w.w = pk2(v1[2], v1[3]);
                        bf16* vt = VT + ((size_t)((b * NH + head) * HD + d) * SEQ + tt);
                        vt[0 * SEQ] = (bf16)(w.x & 0xffff); vt[1 * SEQ] = (bf16)(w.x >> 16); vt[2 * SEQ] = (bf16)(w.y & 0xffff); vt[3 * SEQ] = (bf16)(w.y >> 16);
                        vt[4 * SEQ] = (bf16)(w.z & 0xffff); vt[5 * SEQ] = (bf16)(w.z >> 16); vt[6 * SEQ] = (bf16)(w.w & 0xffff); vt[7 * SEQ] = (bf16)(w.w >> 16); } }
        } else {
            bf16* Gp = (pn < 12) ? GSp : GAp; const int cb = ((pn - 8) & 3) * 256;
#pragma unroll
            for (int ai = 0; ai < 2; ++ai)
#pragma unroll
                for (int m = 0; m < 4; ++m) { const int t = row0 + ai * 128 + m * 16;
#pragma unroll
                    for (int bj = 0; bj < 2; ++bj) { const int col = cb + bj * 128 + wc * 32 + 8 * fq;
                        const pg8::f32x4 v0 = acc[ai][bj][m][0], v1 = acc[ai][bj][m][1];
                        v4u w; w.x = pk2(sigmoidf_(v0[0]), sigmoidf_(v0[1])); w.y = pk2(sigmoidf_(v0[2]), sigmoidf_(v0[3]));
                        w.z = pk2(sigmoidf_(v1[0]), sigmoidf_(v1[1])); w.w = pk2(sigmoidf_(v1[2]), sigmoidf_(v1[3]));
                        *(v4u*)(Gp + (size_t)t * D + col) = w; } }
        }
    }
};

template <int MODE> struct EpiEw {
    bf16* O; const bf16* X1; const bf16* X2; float* Of; int ld;
    __device__ __forceinline__ void operator()(const pg8::f32x4 (&acc)[2][2][4][2], const pg8::Unit& u, int wr, int wc, int fr, int fq) const {
        const int row0 = u.pm * 256 + wr * 64 + fr, col0 = u.pn * 256 + wc * 32 + 8 * fq;
#pragma unroll
        for (int ai = 0; ai < 2; ++ai)
#pragma unroll
            for (int m = 0; m < 4; ++m) { const size_t rb = (size_t)(row0 + ai * 128 + m * 16) * ld + col0;
#pragma unroll
                for (int bj = 0; bj < 2; ++bj) { const size_t off = rb + bj * 128;
                    const pg8::f32x4 v0 = acc[ai][bj][m][0], v1 = acc[ai][bj][m][1];
                    if (MODE == 3) { *(pg8::f32x4*)(Of + off) = v0; *(pg8::f32x4*)(Of + off + 4) = v1; }
                    else {
                        const v4u x = *(const v4u*)(X1 + off);
                        float r[8] = {v0[0], v0[1], v0[2], v0[3], v1[0], v1[1], v1[2], v1[3]};
                        const float xv[8] = {bflo(x.x), bfhi(x.x), bflo(x.y), bfhi(x.y), bflo(x.z), bfhi(x.z), bflo(x.w), bfhi(x.w)};
                        if (MODE == 0) {
#pragma unroll
                            for (int i = 0; i < 8; ++i) r[i] = xv[i] * sigmoidf_(r[i]);
                        } else if (MODE == 1) {
#pragma unroll
                            for (int i = 0; i < 8; ++i) r[i] = xv[i] * r[i];
                        } else {
                            const v4u y = *(const v4u*)(X2 + off);
                            const float yv[8] = {bflo(y.x), bfhi(y.x), bflo(y.y), bfhi(y.y), bflo(y.z), bfhi(y.z), bflo(y.w), bfhi(y.w)};
#pragma unroll
                            for (int i = 0; i < 8; ++i) r[i] = yv[i] + xv[i] * r[i];
                        }
                        v4u w; w.x = pk2(r[0], r[1]); w.y = pk2(r[2], r[3]); w.z = pk2(r[4], r[5]); w.w = pk2(r[6], r[7]);
                        *(v4u*)(O + off) = w; } } }
    }
};

__device__ __forceinline__ void s5_load_u(const bf16* UA, int g, int b, int tt, float (&u)[16]) {
    const v4u* p = (const v4u*)(UA + ((size_t)(g * 1024 + b * 512 + (tt >> 4)) * 384 + 16 * (tt & 15)));
    const v4u a = p[0], c = p[1];
    u[0] = bflo(a.x); u[1] = bfhi(a.x); u[2] = bflo(a.y); u[3] = bfhi(a.y); u[4] = bflo(a.z); u[5] = bfhi(a.z); u[6] = bflo(a.w); u[7] = bfhi(a.w);
    u[8] = bflo(c.x); u[9] = bfhi(c.x); u[10] = bflo(c.y); u[11] = bfhi(c.y); u[12] = bflo(c.z); u[13] = bfhi(c.z); u[14] = bflo(c.w); u[15] = bfhi(c.w);
}
__device__ __forceinline__ void s5_pass_a(Frame& F) {
    const int gw = F.vcu * NWAVES + F.wave, NGW = F.G * NWAVES, p = F.lane;
    const float* P5 = WSP(float, WS_S5P); const bf16* UA = WSP(bf16, WS_UA); float* E = WSP(float, WS_S5E);
    for (int w = gw; w < BATCH * NG * S5NC; w += NGW) {
        const int ch = w % S5NC, bg = w / S5NC, g = bg % NG, b = bg / NG;
        const float lr = P5[g * 64 + p], li = P5[2048 + g * 64 + p];
        float bbr[16], bbi[16];
#pragma unroll
        for (int i = 0; i < 16; ++i) { bbr[i] = P5[16384 + (g * 64 + p) * 16 + i]; bbi[i] = P5[16384 + 32768 + (g * 64 + p) * 16 + i]; }
        float sr = 0.f, si = 0.f;
        for (int tk = 0; tk < S5CH; ++tk) { float u[16]; s5_load_u(UA, g, b, ch * S5CH + tk, u);
            float br = 0.f, bi = 0.f;
#pragma unroll
            for (int i = 0; i < 16; ++i) { br += bbr[i] * u[i]; bi += bbi[i] * u[i]; }
            const float nr = lr * sr - li * si + br, ni = lr * si + li * sr + bi; sr = nr; si = ni; }
        E[(size_t)w * 128 + 2 * p] = sr; E[(size_t)w * 128 + 2 * p + 1] = si;
    }
}
__device__ __forceinline__ void s5_carry(Frame& F) {
    const int gw = F.vcu * NWAVES + F.wave, NGW = F.G * NWAVES, p = F.lane;
    const float* P5 = WSP(float, WS_S5P); const float* E = WSP(float, WS_S5E); float* Sp = WSP(float, WS_S5S);
    for (int bg = gw; bg < BATCH * NG; bg += NGW) { const int g = bg % NG;
        const float cr = P5[4096 + g * 64 + p], ci = P5[6144 + g * 64 + p];
        float sr = 0.f, si = 0.f;
        for (int ch = 0; ch < S5NC; ++ch) { const size_t o = ((size_t)bg * S5NC + ch) * 128 + 2 * p;
            Sp[o] = sr; Sp[o + 1] = si;
            const float er = E[o], ei = E[o + 1];
            const float nr = cr * sr - ci * si + er, ni = cr * si + ci * sr + ei; sr = nr; si = ni; } }
}
__device__ __forceinline__ void s5_pass_c(Frame& F) {
    const int gw = F.vcu * NWAVES + F.wave, NGW = F.G * NWAVES, p = F.lane, L = F.lane;
    const float* P5 = WSP(float, WS_S5P); const bf16* UA = WSP(bf16, WS_UA); const float* Sp = WSP(float, WS_S5S); bf16* YG = WSP(bf16, WS_YG);
    const int h1 = (L >> 5) & 1, h2 = (L >> 4) & 1, h3 = (L >> 3) & 1, h4 = (L >> 2) & 1, co = 8 * h1 + 4 * h2 + 2 * h3 + h4;
    for (int w = gw; w < BATCH * NG * S5NC; w += NGW) {
        const int ch = w % S5NC, bg = w / S5NC, g = bg % NG, b = bg / NG;
        const float lr = P5[g * 64 + p], li = P5[2048 + g * 64 + p];
        float bbr[16], bbi[16], ccr[16], cci[16];
#pragma unroll
        for (int i = 0; i < 16; ++i) { bbr[i] = P5[16384 + (g * 64 + p) * 16 + i]; bbi[i] = P5[16384 + 32768 + (g * 64 + p) * 16 + i];
            ccr[i] = F.in[15][(g * 16 + i) * 64 + p]; cci[i] = F.in[16][(g * 16 + i) * 64 + p]; }
        const float dsk = F.in[17][g * 16 + co];
        float sr = Sp[(size_t)w * 128 + 2 * p], si = Sp[(size_t)w * 128 + 2 * p + 1];
        for (int tk = 0; tk < S5CH; ++tk) { const int tt = ch * S5CH + tk; float u[16]; s5_load_u(UA, g, b, tt, u);
            float br = 0.f, bi = 0.f;
#pragma unroll
            for (int i = 0; i < 16; ++i) { br += bbr[i] * u[i]; bi += bbi[i] * u[i]; }
            const float nr = lr * sr - li * si + br, ni = lr * si + li * sr + bi; sr = nr; si = ni;
            float v[16];
#pragma unroll
            for (int i = 0; i < 16; ++i) v[i] = ccr[i] * sr - cci[i] * si;
#pragma unroll
            for (int k = 0; k < 8; ++k) { const float mine = h1 ? v[k + 8] : v[k], oth = h1 ? v[k] : v[k + 8]; v[k] = mine + __shfl_xor(oth, 32); }
#pragma unroll
            for (int k = 0; k < 4; ++k) { const float mine = h2 ? v[k + 4] : v[k], oth = h2 ? v[k] : v[k + 4]; v[k] = mine + __shfl_xor(oth, 16); }
#pragma unroll
            for (int k = 0; k < 2; ++k) { const float mine = h3 ? v[k + 2] : v[k], oth = h3 ? v[k] : v[k + 2]; v[k] = mine + __shfl_xor(oth, 8); }
            { const float mine = h4 ? v[1] : v[0], oth = h4 ? v[0] : v[1]; v[0] = mine + __shfl_xor(oth, 4); }
            v[0] += __shfl_xor(v[0], 2); v[0] += __shfl_xor(v[0], 1);
            const float uco = bf2f(UA[((size_t)(g * 1024 + b * 512 + (tt >> 4)) * 384 + 16 * (tt & 15)) + co]);
            const float y = gelu_tanh(v[0] + dsk * uco);
            if ((L & 3) == 0) YG[(size_t)(b * SEQ + tt) * SW + g * 16 + co] = (bf16)f2bf(y);
        }
    }
}

__device__ __forceinline__ void attn_naive(Frame& F) {
    const int gw = F.vcu * NWAVES + F.wave, NGW = F.G * NWAVES;
    const bf16* Q = WSP(bf16, WS_Q); const bf16* K = WSP(bf16, WS_K); const bf16* V = WSP(bf16, WS_V); bf16* YA = WSP(bf16, WS_YA);
    const float* km = (const float*)(F.ctl + CW_KM);
    for (int w = gw; w < BATCH * NH * (SEQ / 64); w += NGW) {
        const int bh = w >> 7, b = bh >> 3, h = bh & 7, tt = (w & 127) * 64 + F.lane, t = b * SEQ + tt, blk = tt >> 8;
        float q[64];
        { const v4u* qp = (const v4u*)(Q + (size_t)t * AW + h * 64);
#pragma unroll
          for (int i = 0; i < 8; ++i) { const v4u x = qp[i]; q[8 * i] = bflo(x.x); q[8 * i + 1] = bfhi(x.x); q[8 * i + 2] = bflo(x.y); q[8 * i + 3] = bfhi(x.y);
              q[8 * i + 4] = bflo(x.z); q[8 * i + 5] = bfhi(x.z); q[8 * i + 6] = bflo(x.w); q[8 * i + 7] = bfhi(x.w); } }
        float v0 = -3e38f, v1 = -3e38f, v2 = -3e38f; int i0 = -1, i1 = -1, i2 = -1;
        for (int j = 0; j < blk; ++j) { const float* kp = km + (size_t)((b * NH + h) * NBLK + j) * HD; float g = 0.f;
#pragma unroll
            for (int d = 0; d < 64; ++d) g += q[d] * kp[d];
            if (g > v0) { v2 = v1; i2 = i1; v1 = v0; i1 = i0; v0 = g; i0 = j; }
            else if (g > v1) { v2 = v1; i2 = i1; v1 = g; i1 = j; }
            else if (g > v2) { v2 = g; i2 = j; } }
        float m = -1e30f, l = 0.f, o[64];
#pragma unroll
        for (int d = 0; d < 64; ++d) o[d] = 0.f;
#pragma unroll 1
        for (int slot = 0; slot < 4; ++slot) {
            const int jb = slot == 0 ? blk : (slot == 1 ? i0 : (slot == 2 ? i1 : i2));
            const int cnt = slot == 0 ? (tt & 255) + 1 : (jb >= 0 ? 256 : 0);
            if (!__any(cnt > 0)) continue;
            const int jbb = jb < 0 ? 0 : jb;
#pragma unroll 1
            for (int kk = 0; kk < 256; ++kk) {
                if (!__any(kk < cnt)) break;
                if (kk < cnt) {
                    const size_t key = (size_t)(b * SEQ + jbb * 256 + kk) * AW + h * 64;
                    const v4u* kp = (const v4u*)(K + key); float s = 0.f;
#pragma unroll
                    for (int i = 0; i < 8; ++i) { const v4u x = kp[i];
                        s += q[8 * i] * bflo(x.x) + q[8 * i + 1] * bfhi(x.x) + q[8 * i + 2] * bflo(x.y) + q[8 * i + 3] * bfhi(x.y)
                           + q[8 * i + 4] * bflo(x.z) + q[8 * i + 5] * bfhi(x.z) + q[8 * i + 6] * bflo(x.w) + q[8 * i + 7] * bfhi(x.w); }
                    const float mn = fmaxf(m, s), a = exp2f(m - mn), pp = exp2f(s - mn);
                    l = l * a + pp; m = mn;
                    const v4u* vp = (const v4u*)(V + key);
#pragma unroll
                    for (int i = 0; i < 8; ++i) { const v4u x = vp[i];
                        o[8 * i] = o[8 * i] * a + pp * bflo(x.x); o[8 * i + 1] = o[8 * i + 1] * a + pp * bfhi(x.x);
                        o[8 * i + 2] = o[8 * i + 2] * a + pp * bflo(x.y); o[8 * i + 3] = o[8 * i + 3] * a + pp * bfhi(x.y);
                        o[8 * i + 4] = o[8 * i + 4] * a + pp * bflo(x.z); o[8 * i + 5] = o[8 * i + 5] * a + pp * bfhi(x.z);
                        o[8 * i + 6] = o[8 * i + 6] * a + pp * bflo(x.w); o[8 * i + 7] = o[8 * i + 7] * a + pp * bfhi(x.w); }
                }
            }
        }
        const float rl = 1.f / l;
        v4u* op = (v4u*)(YA + (size_t)t * AW + h * 64);
#pragma unroll
        for (int i = 0; i < 8; ++i) { v4u wv; wv.x = pk2(o[8 * i] * rl, o[8 * i + 1] * rl); wv.y = pk2(o[8 * i + 2] * rl, o[8 * i + 3] * rl);
            wv.z = pk2(o[8 * i + 4] * rl, o[8 * i + 5] * rl); wv.w = pk2(o[8 * i + 6] * rl, o[8 * i + 7] * rl); op[i] = wv; }
    }
}
typedef short bf16x8 __attribute__((ext_vector_type(8)));
typedef float f32x16 __attribute__((ext_vector_type(16)));
constexpr size_t WS_ALIST = 456 * MiB;
constexpr size_t WS_OP01 = 224 * MiB;
constexpr size_t WS_OP23 = 472 * MiB;
constexpr size_t WS_LSE = 504 * MiB;
constexpr int CW_BCNT = 12288;
constexpr int ALCAP = 8192;

__device__ __forceinline__ void attn_gate(Frame& F) {
    const int gw = F.vcu * NWAVES + F.wave, NGW = F.G * NWAVES, L = F.lane;
    const bf16* Q = WSP(bf16, WS_Q); const float* km = (const float*)(F.ctl + CW_KM);
    unsigned* bcnt = (unsigned*)(F.ctl + CW_BCNT); unsigned* list = WSP(unsigned, WS_ALIST); float* lse = WSP(float, WS_LSE);
    for (int w = gw; w < BATCH * NH * (SEQ / 64); w += NGW) {
        const int bh = w >> 7, b = bh >> 3, h = bh & 7, tt = (w & 127) * 64 + L, t = b * SEQ + tt, blk = tt >> 8;
        float q[64];
        { const v4u* qp = (const v4u*)(Q + (size_t)t * AW + h * 64);
#pragma unroll
          for (int i = 0; i < 8; ++i) { const v4u x = qp[i]; q[8 * i] = bflo(x.x); q[8 * i + 1] = bfhi(x.x); q[8 * i + 2] = bflo(x.y); q[8 * i + 3] = bfhi(x.y);
              q[8 * i + 4] = bflo(x.z); q[8 * i + 5] = bfhi(x.z); q[8 * i + 6] = bflo(x.w); q[8 * i + 7] = bfhi(x.w); } }
        float v0 = -3e38f, v1 = -3e38f, v2 = -3e38f; int i0 = -1, i1 = -1, i2 = -1;
        for (int j = 0; j < blk; ++j) { const float* kp = km + (size_t)((b * NH + h) * NBLK + j) * HD; float g = 0.f;
#pragma unroll
            for (int d = 0; d < 64; ++d) g += q[d] * kp[d];
            if (g > v0) { v2 = v1; i2 = i1; v1 = v0; i1 = i0; v0 = g; i0 = j; }
            else if (g > v1) { v2 = v1; i2 = i1; v1 = g; i1 = j; }
            else if (g > v2) { v2 = g; i2 = j; } }
        float* lp = lse + ((size_t)t * NH + h) * 4;
        if (i0 < 0) lp[0] = -1e30f; if (i1 < 0) lp[1] = -1e30f; if (i2 < 0) lp[2] = -1e30f;
        for (int j = 0; j < blk; ++j) {
            const bool sel = (i0 == j) || (i1 == j) || (i2 == j);
            const unsigned long long mask = __ballot(sel);
            if (mask) { const int leader = __ffsll((long long)mask) - 1; const int bucket = (b * NH + h) * NBLK + j;
                unsigned base = 0u;
                if (L == leader) base = __hip_atomic_fetch_add(bcnt + bucket, (unsigned)__popcll(mask), RLX_AGENT);
                base = (unsigned)__shfl((int)base, leader);
                if (sel) { const unsigned pos = base + (unsigned)__popcll(mask & ((1ull << L) - 1ull)); const unsigned slot = (i0 == j) ? 0u : ((i1 == j) ? 1u : 2u);
                    list[(size_t)bucket * ALCAP + pos] = ((unsigned)tt << 2) | slot; } }
        }
    }
}

__device__ __forceinline__ unsigned cvtpk(float lo, float hi) { typedef float f32x2_t __attribute__((ext_vector_type(2))); typedef __bf16 bf16x2_t __attribute__((ext_vector_type(2)));
    f32x2_t v = {lo, hi}; bf16x2_t r = __builtin_convertvector(v, bf16x2_t); return __builtin_bit_cast(unsigned, r); }

constexpr int AT_KROW = 144, AT_VROW = 520, AT_KOFF = 0, AT_VOFF = 256 * AT_KROW;
__device__ __forceinline__ void attn_item(Frame& F, int b, int h, int j, bool own, const unsigned* lst, int nvalid) {
    const int tid = F.tid, L = F.lane, r = L & 31, hh = L >> 5, wv = F.wave;
    LAS unsigned char* Kl = F.lds + AT_KOFF; LAS unsigned char* Vl = F.lds + AT_VOFF;
    const bf16* Kg = WSP(bf16, WS_K) + ((size_t)(b * SEQ + j * 256)) * AW + h * 64;
    const bf16* Vg = WSP(bf16, WS_VT) + ((size_t)((b * NH + h) * HD)) * SEQ + j * 256;
    v4u kr[4], vr[4];
#pragma unroll
    for (int i = 0; i < 4; ++i) { const int idx = tid + 512 * i; kr[i] = *(const v4u*)(Kg + (size_t)(idx >> 3) * AW + (idx & 7) * 8); vr[i] = *(const v4u*)(Vg + (size_t)(idx >> 5) * SEQ + (idx & 31) * 8); }
    const int qi = wv * 32 + r; const bool valid = qi < nvalid;
    unsigned ent; if (own) ent = ((unsigned)(j * 256 + qi) << 2) | 3u; else ent = lst[valid ? qi : 0];
    const int tt = (int)(ent >> 2), slot = (int)(ent & 3u), t = b * SEQ + tt;
    bf16x8 qf[4];
    { const bf16* qp = WSP(bf16, WS_Q) + (size_t)t * AW + h * 64 + hh * 8;
#pragma unroll
      for (int d0 = 0; d0 < 4; ++d0) qf[d0] = *(const bf16x8*)(qp + d0 * 16); }
#pragma unroll
    for (int i = 0; i < 4; ++i) { const int idx = tid + 512 * i; *(LAS v4u*)(Kl + (idx >> 3) * AT_KROW + (idx & 7) * 16) = kr[i]; *(LAS v4u*)(Vl + (idx >> 5) * AT_VROW + (idx & 31) * 16) = vr[i]; }
    __syncthreads();
    if (wv * 32 < nvalid) {
        float m = -1e30f, l = 0.f; f32x16 O0 = {}, O1 = {};
        const int qrel = tt & 255;
#pragma unroll
        for (int hk = 0; hk < 2; ++hk) {
            if (own && hk * 128 > wv * 32 + 31) continue;
            f32x16 S[4];
#pragma unroll
            for (int kt = 0; kt < 4; ++kt) { S[kt] = (f32x16){};
#pragma unroll
                for (int d0 = 0; d0 < 4; ++d0) { const bf16x8 kf = *(const LAS bf16x8*)(Kl + (hk * 128 + kt * 32 + r) * AT_KROW + d0 * 32 + hh * 16);
                    S[kt] = __builtin_amdgcn_mfma_f32_32x32x16_bf16(kf, qf[d0], S[kt], 0, 0, 0); } }
            if (own) {
#pragma unroll
                for (int kt = 0; kt < 4; ++kt)
#pragma unroll
                    for (int rg = 0; rg < 16; ++rg) { const int key = hk * 128 + kt * 32 + (rg & 3) + 8 * (rg >> 2) + 4 * hh; if (key > qrel) S[kt][rg] = -1e30f; } }
            float mx = S[0][0];
#pragma unroll
            for (int kt = 0; kt < 4; ++kt)
#pragma unroll
                for (int rg = 0; rg < 16; ++rg) mx = fmaxf(mx, S[kt][rg]);
            mx = fmaxf(mx, __shfl_xor(mx, 32));
            const float mn = fmaxf(m, mx), alpha = __builtin_amdgcn_exp2f(m - mn); m = mn; l *= alpha;
#pragma unroll
            for (int rg = 0; rg < 16; ++rg) { O0[rg] *= alpha; O1[rg] *= alpha; }
            float ls = 0.f; unsigned pw[4][8];
#pragma unroll
            for (int kt = 0; kt < 4; ++kt)
#pragma unroll
                for (int rg = 0; rg < 16; rg += 2) { const float p0 = __builtin_amdgcn_exp2f(S[kt][rg] - mn), p1 = __builtin_amdgcn_exp2f(S[kt][rg + 1] - mn); ls += p0 + p1; pw[kt][rg >> 1] = cvtpk(p0, p1); }
            l += ls;
#pragma unroll
            for (int kt = 0; kt < 4; ++kt)
#pragma unroll
                for (int s = 0; s < 2; ++s) {
                    const v4u pv = {pw[kt][4 * s], pw[kt][4 * s + 1], pw[kt][4 * s + 2], pw[kt][4 * s + 3]}; const bf16x8 pf = __builtin_bit_cast(bf16x8, pv);
                    const int kb = (hk * 128 + kt * 32 + 16 * s + 4 * hh) * 2;
                    { const LAS unsigned char* vp = Vl + r * AT_VROW + kb; const v2u lo = *(const LAS v2u*)vp, hi = *(const LAS v2u*)(vp + 16);
                      const v4u vv = {lo.x, lo.y, hi.x, hi.y}; O0 = __builtin_amdgcn_mfma_f32_32x32x16_bf16(__builtin_bit_cast(bf16x8, vv), pf, O0, 0, 0, 0); }
                    { const LAS unsigned char* vp = Vl + (32 + r) * AT_VROW + kb; const v2u lo = *(const LAS v2u*)vp, hi = *(const LAS v2u*)(vp + 16);
                      const v4u vv = {lo.x, lo.y, hi.x, hi.y}; O1 = __builtin_amdgcn_mfma_f32_32x32x16_bf16(__builtin_bit_cast(bf16x8, vv), pf, O1, 0, 0, 0); } }
        }
        l += __shfl_xor(l, 32);
        if (valid) {
            const float rl = 1.f / l;
            bf16* op = (slot < 2 ? WSP(bf16, WS_OP01) + (((size_t)t * NH + h) * 2 + slot) * 64 : WSP(bf16, WS_OP23) + (((size_t)t * NH + h) * 2 + (slot - 2)) * 64) + 4 * hh;
#pragma unroll
            for (int g4 = 0; g4 < 4; ++g4) { v2u w0, w1; w0.x = cvtpk(O0[4 * g4] * rl, O0[4 * g4 + 1] * rl); w0.y = cvtpk(O0[4 * g4 + 2] * rl, O0[4 * g4 + 3] * rl);
                w1.x = cvtpk(O1[4 * g4] * rl, O1[4 * g4 + 1] * rl); w1.y = cvtpk(O1[4 * g4 + 2] * rl, O1[4 * g4 + 3] * rl);
                *(v2u*)(op + 8 * g4) = w0; *(v2u*)(op + 32 + 8 * g4) = w1; }
            if (hh == 0) WSP(float, WS_LSE)[((size_t)t * NH + h) * 4 + slot] = m + log2f(l);
        }
    }
    __syncthreads();
}
__device__ __forceinline__ void attn_items(Frame& F) {
    LAS int* pre = (LAS int*)(F.lds + 72 * 1024);
    const unsigned* bcnt = (const unsigned*)(F.ctl + CW_BCNT);
    LAS int* cntl = pre + 520;
    for (int i = F.tid; i < 512; i += NWAVES * 64) cntl[i] = (int)__hip_atomic_load((gu32*)(F.ctl + CW_BCNT) + i, RLX_AGENT);
    __syncthreads();
    if (F.tid == 0) { int a = 0; for (int i = 0; i < 512; ++i) { pre[i] = a; a += (cntl[i] + 255) >> 8; } pre[512] = a; }
    __syncthreads();
    const int total = 512 + pre[512];
    for (int it = (int)blockIdx.x; it < total; it += F.G) {
        if (it < 512) { const int bh = it >> 5, i = it & 31; attn_item(F, bh >> 3, bh & 7, i, true, nullptr, 256); }
        else { const int s = it - 512; int lo = 0, hi = 512;
            while (hi - lo > 1) { const int mid = (lo + hi) >> 1; if (pre[mid] <= s) lo = mid; else hi = mid; }
            const int bucket = lo, tile = s - pre[bucket], n = cntl[bucket] - tile * 256, bh = bucket >> 5, j = bucket & 31;
            attn_item(F, bh >> 3, bh & 7, j, false, WSP(unsigned, WS_ALIST) + (size_t)bucket * ALCAP + tile * 256, n > 256 ? 256 : n); }
    }
}
__device__ __forceinline__ void attn_combine(Frame& F) {
    const int gw = F.vcu * NWAVES + F.wave, NGW = F.G * NWAVES, L = F.lane, h = L >> 3, ch = L & 7;
    const float* lse = WSP(float, WS_LSE); bf16* YA = WSP(bf16, WS_YA);
    for (int t = gw; t < T; t += NGW) {
        const size_t th = (size_t)t * NH + h;
        const f32x4 ls = *(const f32x4*)(lse + th * 4);
        const float mx = fmaxf(fmaxf(ls[0], ls[1]), fmaxf(ls[2], ls[3]));
        const float w0 = __builtin_amdgcn_exp2f(ls[0] - mx), w1 = __builtin_amdgcn_exp2f(ls[1] - mx), w2 = __builtin_amdgcn_exp2f(ls[2] - mx), w3 = __builtin_amdgcn_exp2f(ls[3] - mx), inv = 1.f / (w0 + w1 + w2 + w3);
        const v4u a0 = *(const v4u*)(WSP(bf16, WS_OP01) + (th * 2 + 0) * 64 + ch * 8), a1 = *(const v4u*)(WSP(bf16, WS_OP01) + (th * 2 + 1) * 64 + ch * 8);
        const v4u a2 = *(const v4u*)(WSP(bf16, WS_OP23) + (th * 2 + 0) * 64 + ch * 8), a3 = *(const v4u*)(WSP(bf16, WS_OP23) + (th * 2 + 1) * 64 + ch * 8);
        float o[8];
        const unsigned x0[4] = {a0.x, a0.y, a0.z, a0.w}, x1[4] = {a1.x, a1.y, a1.z, a1.w}, x2[4] = {a2.x, a2.y, a2.z, a2.w}, x3[4] = {a3.x, a3.y, a3.z, a3.w};
#pragma unroll
        for (int i = 0; i < 4; ++i) {
            float lo_ = w3 * bflo(x3[i]), hi_ = w3 * bfhi(x3[i]);
            if (ls[0] > -1e29f) { lo_ += w0 * bflo(x0[i]); hi_ += w0 * bfhi(x0[i]); }
            if (ls[1] > -1e29f) { lo_ += w1 * bflo(x1[i]); hi_ += w1 * bfhi(x1[i]); }
            if (ls[2] > -1e29f) { lo_ += w2 * bflo(x2[i]); hi_ += w2 * bfhi(x2[i]); }
            o[2 * i] = lo_ * inv; o[2 * i + 1] = hi_ * inv; }
        v4u w; w.x = cvtpk(o[0], o[1]); w.y = cvtpk(o[2], o[3]); w.z = cvtpk(o[4], o[5]); w.w = cvtpk(o[6], o[7]);
        *(v4u*)(YA + (size_t)t * AW + h * 64 + ch * 8) = w;
    }
}
constexpr int SCR_OFF = LDSCTL_OFF + 512;
__device__ __forceinline__ void phase_rows(Frame& F) {
    LAS float* WrT = (LAS float*)(F.lds);
    LAS float* gtm = (LAS float*)(F.lds + 131072);
    LAS float* pg2 = gtm + 2 * D; LAS float* shf = pg2 + 2 * D;
    LAS unsigned* hist = (LAS unsigned*)(F.lds + SCR_OFF); LAS unsigned* base = hist + 32; LAS int* rec_e = (LAS int*)(base + 32); LAS int* rec_lp = rec_e + 256;
    const float* adaf = WSP(float, WS_ADAF);
    for (int i = F.tid; i < D * NE; i += NWAVES * 64) { const int k = i >> 5, e = i & 31; WrT[e * D + k] = F.in[22][i]; }
    for (int i = F.tid; i < 2 * D; i += NWAVES * 64) { const int b = i >> 10, k = i & (D - 1);
        gtm[i] = adaf[b * 6 * D + 2 * D + k] * F.in[6][k];
        pg2[i] = F.in[7][k] * (1.f + adaf[b * 6 * D + 4 * D + k]); shf[i] = adaf[b * 6 * D + 3 * D + k]; }
    if (F.tid < 32) hist[F.tid] = 0u;
    __syncthreads();
    const float* mix = WSP(float, WS_MIX); bf16* H2 = WSP(bf16, WS_H2);
    int* tok_e = WSP(int, WS_ROUTE); float* tok_w = (float*)(tok_e + T * 4); int* tok_pos = tok_e + 2 * T * 4;
    unsigned* gcnt = (unsigned*)(F.ctl + CW_ECNT);
    const int L = F.lane;
    for (int t0 = F.vcu * 64; t0 < T; t0 += F.G * 64) {
        for (int tk = 0; tk < 8; ++tk) {
            const int tl = F.wave * 8 + tk, t = t0 + tl, b = t >> 13;
            const GAS f32x4* mr = (const GAS f32x4*)(mix + (size_t)t * D) + L; const GAS f32x4* xr = (const GAS f32x4*)(F.in[0] + (size_t)t * D) + L;
            f32x4 mv[4], xv[4]; float s = 0.f;
#pragma unroll
            for (int j = 0; j < 4; ++j) { mv[j] = mr[64 * j]; xv[j] = xr[64 * j]; s += (mv[j].x * mv[j].x + mv[j].y * mv[j].y) + (mv[j].z * mv[j].z + mv[j].w * mv[j].w); }
            const float r1 = 1.f / sqrtf(wave_sum(s) * (1.f / D) + NORM_EPS);
            float s2 = 0.f;
            GAS f32x4* orow = (GAS f32x4*)(F.out + (size_t)t * D) + L;
#pragma unroll
            for (int j = 0; j < 4; ++j) { const f32x4 g = *(const LAS f32x4*)(gtm + b * D + 4 * L + 256 * j);
                xv[j] = xv[j] + g * (mv[j] * r1); orow[64 * j] = xv[j];
                s2 += (xv[j].x * xv[j].x + xv[j].y * xv[j].y) + (xv[j].z * xv[j].z + xv[j].w * xv[j].w); }
            const float r2 = 1.f / sqrtf(wave_sum(s2) * (1.f / D) + NORM_EPS);
            GAS unsigned long long* h8 = (GAS unsigned long long*)(H2 + (size_t)t * D) + L;
#pragma unroll
            for (int j = 0; j < 4; ++j) { const f32x4 a = *(const LAS f32x4*)(pg2 + b * D + 4 * L + 256 * j), c = *(const LAS f32x4*)(shf + b * D + 4 * L + 256 * j);
                xv[j] = xv[j] * r2 * a + c;
                h8[64 * j] = (unsigned long long)pk2(xv[j].x, xv[j].y) | ((unsigned long long)pk2(xv[j].z, xv[j].w) << 32); }
            float pe[32];
#pragma unroll
            for (int e = 0; e < 32; ++e) { float a = 0.f;
#pragma unroll
                for (int j = 0; j < 4; ++j) { const f32x4 w = *(const LAS f32x4*)(WrT + e * D + 4 * L + 256 * j); a += (xv[j].x * w.x + xv[j].y * w.y) + (xv[j].z * w.z + xv[j].w * w.w); }
                pe[e] = a; }
            { const int h = (L >> 5) & 1;
#pragma unroll
              for (int k = 0; k < 16; ++k) { const float mine = h ? pe[k + 16] : pe[k], oth = h ? pe[k] : pe[k + 16]; pe[k] = mine + __shfl_xor(oth, 32); } }
            { const int h = (L >> 4) & 1;
#pragma unroll
              for (int k = 0; k < 8; ++k) { const float mine = h ? pe[k + 8] : pe[k], oth = h ? pe[k] : pe[k + 8]; pe[k] = mine + __shfl_xor(oth, 16); } }
            { const int h = (L >> 3) & 1;
#pragma unroll
              for (int k = 0; k < 4; ++k) { const float mine = h ? pe[k + 4] : pe[k], oth = h ? pe[k] : pe[k + 4]; pe[k] = mine + __shfl_xor(oth, 8); } }
            { const int h = (L >> 2) & 1;
#pragma unroll
              for (int k = 0; k < 2; ++k) { const float mine = h ? pe[k + 2] : pe[k], oth = h ? pe[k] : pe[k + 2]; pe[k] = mine + __shfl_xor(oth, 4); } }
            { const int h = (L >> 1) & 1; const float mine = h ? pe[1] : pe[0], oth = h ? pe[0] : pe[1]; pe[0] = mine + __shfl_xor(oth, 2); }
            pe[0] += __shfl_xor(pe[0], 1);
            const int myE = L >> 1;
            float val = pe[0] + F.in[23][myE];
            if (L & 1) val = -3e38f;
            int se[4]; float sv[4];
#pragma unroll
            for (int r = 0; r < 4; ++r) { const float mx = wave_max(val); const unsigned long long bal = __ballot(val == mx); const int win = __ffsll((long long)bal) - 1;
                se[r] = win >> 1; sv[r] = mx; if (L == win) val = -3e38f; }
            const float e1 = __expf(sv[1] - sv[0]), e2 = __expf(sv[2] - sv[0]), e3 = __expf(sv[3] - sv[0]), inv = 1.f / (1.f + e1 + e2 + e3);
            if (L < 4) { const int e = L == 0 ? se[0] : (L == 1 ? se[1] : (L == 2 ? se[2] : se[3]));
                const float wv = (L == 0 ? 1.f : (L == 1 ? e1 : (L == 2 ? e2 : e3))) * inv;
                tok_e[t * 4 + L] = e; tok_w[t * 4 + L] = wv;
                const unsigned lp = atomicAdd((unsigned*)(hist + e), 1u);
                rec_e[tl * 4 + L] = e; rec_lp[tl * 4 + L] = (int)lp; }
        }
        __syncthreads();
        if (F.tid < 32) { const unsigned h = hist[F.tid]; base[F.tid] = h ? __hip_atomic_fetch_add(gcnt + F.tid, h, RLX_AGENT) : 0u; }
        __syncthreads();
        if (F.tid < 256) { tok_pos[(t0 + (F.tid >> 2)) * 4 + (F.tid & 3)] = (int)base[rec_e[F.tid]] + rec_lp[F.tid]; }
        __syncthreads();
        if (F.tid < 32) hist[F.tid] = 0u;
        __syncthreads();
    }
}

__device__ __forceinline__ void moe_tables(Frame& F) {
    LAS int* cnt = (LAS int*)(F.lds + SCR_OFF); LAS int* off = cnt + 32; LAS int* tpre = off + 32;
    if (F.tid == 0) { int o = 0, tp = 0;
        for (int e = 0; e < NE; ++e) { const int c = (int)__hip_atomic_load(F.ctl + CW_ECNT + e, RLX_AGENT); cnt[e] = c; off[e] = o; tpre[e] = tp; o += c; tp += (c + 255) >> 8; }
        tpre[NE] = tp; }
    __syncthreads();
}
__device__ __forceinline__ void phase_gather(Frame& F) {
    moe_tables(F);
    const LAS int* off = (const LAS int*)(F.lds + SCR_OFF) + 32;
    const int gw = F.vcu * NWAVES + F.wave, NGW = F.G * NWAVES;
    const int* tok_e = WSP(int, WS_ROUTE); const int* tok_pos = tok_e + 2 * T * 4;
    const v4u* H2 = WSP(v4u, WS_H2); v4u* XG = WSP(v4u, WS_XG);
    for (int a = gw; a < T * TOPK; a += NGW) { const int t = a >> 2, e = tok_e[a], row = off[e] + tok_pos[a];
        const v4u x0 = H2[(size_t)t * 128 + F.lane], x1 = H2[(size_t)t * 128 + 64 + F.lane];
        XG[(size_t)row * 128 + F.lane] = x0; XG[(size_t)row * 128 + 64 + F.lane] = x1; }
}
struct MoeOrder {
    const LAS int* tab; int nct, brows, G, c;
    __device__ __forceinline__ bool next(int i, pg8::Unit& u) const {
        const int L = i * G + c, total = tab[64 + NE] * nct; if (L >= total) return false;
        const int rtg = L / nct, pn = L % nct; int e = 0;
        for (int k = 1; k < NE; ++k) if (tab[64 + k] <= rtg) e = k;
        const int rt = rtg - tab[64 + e], cnt = tab[e], off = tab[32 + e];
        u.e = __builtin_amdgcn_readfirstlane(e); u.pm = rt; u.pn = pn; u.arow = __builtin_amdgcn_readfirstlane(off + rt * 256); u.brow = __builtin_amdgcn_readfirstlane(e * brows + pn * 256);
        const int nr = cnt - rt * 256; u.nrow = __builtin_amdgcn_readfirstlane(nr > 256 ? 256 : nr); return true;
    }
};
struct EpiGU { bf16* H1; const float* bg; const float* bu;
    __device__ __forceinline__ void operator()(const pg8::f32x4 (&acc)[2][2][4][2], const pg8::Unit& u, int wr, int wc, int fr, int fq) const {
        const int f0 = u.pn * 128 + wc * 32 + 8 * fq;
        const pg8::f32x4 g0 = *(const pg8::f32x4*)(bg + u.e * FF + f0), g1 = *(const pg8::f32x4*)(bg + u.e * FF + f0 + 4);
        const pg8::f32x4 u0 = *(const pg8::f32x4*)(bu + u.e * FF + f0), u1 = *(const pg8::f32x4*)(bu + u.e * FF + f0 + 4);
#pragma unroll
        for (int ai = 0; ai < 2; ++ai)
#pragma unroll
            for (int m = 0; m < 4; ++m) { const int r = ai * 128 + wr * 64 + m * 16 + fr;
                const pg8::f32x4 a0 = acc[ai][0][m][0] + g0, a1 = acc[ai][0][m][1] + g1, b0 = acc[ai][1][m][0] + u0, b1 = acc[ai][1][m][1] + u1;
                float gg[8] = {a0[0], a0[1], a0[2], a0[3], a1[0], a1[1], a1[2], a1[3]}, uu[8] = {b0[0], b0[1], b0[2], b0[3], b1[0], b1[1], b1[2], b1[3]}, o[8];
#pragma unroll
                for (int i = 0; i < 8; ++i) { const float g = fminf(gg[i], 7.f), up = fminf(fmaxf(uu[i], -7.f), 7.f); o[i] = g * sigmoidf_(1.702f * g) * (up + 1.f); }
                v4u w; w.x = pk2(o[0], o[1]); w.y = pk2(o[2], o[3]); w.z = pk2(o[4], o[5]); w.w = pk2(o[6], o[7]);
                if (r < u.nrow) *(v4u*)(H1 + (size_t)(u.arow + r) * FF + f0) = w; }
    }
};
struct EpiDn { bf16* YB; const float* bd;
    __device__ __forceinline__ void operator()(const pg8::f32x4 (&acc)[2][2][4][2], const pg8::Unit& u, int wr, int wc, int fr, int fq) const {
        const int c0 = u.pn * 256 + wc * 32 + 8 * fq;
#pragma unroll
        for (int bj = 0; bj < 2; ++bj) { const pg8::f32x4 d0 = *(const pg8::f32x4*)(bd + u.e * D + c0 + bj * 128), d1 = *(const pg8::f32x4*)(bd + u.e * D + c0 + bj * 128 + 4);
#pragma unroll
            for (int ai = 0; ai < 2; ++ai)
#pragma unroll
                for (int m = 0; m < 4; ++m) { const int r = ai * 128 + wr * 64 + m * 16 + fr;
                    const pg8::f32x4 a0 = acc[ai][bj][m][0] + d0, a1 = acc[ai][bj][m][1] + d1;
                    v4u w; w.x = pk2(a0[0], a0[1]); w.y = pk2(a0[2], a0[3]); w.z = pk2(a1[0], a1[1]); w.w = pk2(a1[2], a1[3]);
                    if (r < u.nrow) *(v4u*)(YB + (size_t)(u.arow + r) * D + c0 + bj * 128) = w; } }
    }
};
__device__ __forceinline__ void phase_final(Frame& F) {
    moe_tables(F);
    const LAS int* off = (const LAS int*)(F.lds + SCR_OFF) + 32;
    LAS float* gtf = (LAS float*)(F.lds);
    const float* adaf = WSP(float, WS_ADAF);
    for (int i = F.tid; i < 2 * D; i += NWAVES * 64) { const int b = i >> 10, k = i & (D - 1); gtf[i] = adaf[b * 6 * D + 5 * D + k] * F.in[8][k]; }
    __syncthreads();
    const int gw = F.vcu * NWAVES + F.wave, NGW = F.G * NWAVES, L = F.lane;
    const int* tok_e = WSP(int, WS_ROUTE); const float* tok_w = (const float*)(tok_e + T * 4); const int* tok_pos = tok_e + 2 * T * 4;
    const bf16* YB = WSP(bf16, WS_YB);
    for (int t = gw; t < T; t += NGW) { const int b = t >> 13;
        f32x4 y[4];
#pragma unroll
        for (int j = 0; j < 4; ++j) y[j] = (f32x4){0.f, 0.f, 0.f, 0.f};
#pragma unroll
        for (int k = 0; k < 4; ++k) { const int e = tok_e[t * 4 + k], row = off[e] + tok_pos[t * 4 + k]; const float w = tok_w[t * 4 + k];
            const GAS v2u* yr = (const GAS v2u*)(YB + (size_t)row * D) + L;
#pragma unroll
            for (int j = 0; j < 4; ++j) { const v2u x = yr[64 * j]; y[j].x += w * bflo(x.x); y[j].y += w * bfhi(x.x); y[j].z += w * bflo(x.y); y[j].w += w * bfhi(x.y); } }
        float s = 0.f;
#pragma unroll
        for (int j = 0; j < 4; ++j) s += (y[j].x * y[j].x + y[j].y * y[j].y) + (y[j].z * y[j].z + y[j].w * y[j].w);
        const float r = 1.f / sqrtf(wave_sum(s) * (1.f / D) + NORM_EPS);
        GAS f32x4* orow = (GAS f32x4*)(F.out + (size_t)t * D) + L;
#pragma unroll
        for (int j = 0; j < 4; ++j) { const f32x4 g = *(const LAS f32x4*)(gtf + b * D + 4 * L + 256 * j); const f32x4 x1 = orow[64 * j]; orow[64 * j] = x1 + g * (y[j] * r); }
    }
}
#ifndef MK_N_LAUNCHES
#define MK_N_LAUNCHES 1
#endif
constexpr int N_PHASES = 15;
struct Args { const float* in[30]; float* out; unsigned char* ws; int ph_lo, ph_hi; };
__global__ void __launch_bounds__(NWAVES * 64, 2) mega_fwd(Args args) {
    extern __shared__ __attribute__((aligned(16))) unsigned char lds[];
    Frame F;
    F.lds = (LAS unsigned char*)lds;
    F.MISC = (volatile LAS unsigned*)(F.lds + MISC_OFF);
    F.tid = threadIdx.x; F.lane = F.tid & 63; F.wave = __builtin_amdgcn_readfirstlane(F.tid >> 6);
    F.G = gridDim.x; { const int bx = blockIdx.x; F.vcu = (F.G % 8 == 0) ? (bx % 8) * (F.G / 8) + bx / 8 : bx; }
    F.ws = args.ws; F.ctl = (gu32*)(args.ws + WS_CTL); F.out = args.out;
#pragma unroll
    for (int i = 0; i < 30; ++i) F.in[i] = args.in[i];
    for (int u = F.tid; u < (LDS_BYTES - LDSCTL_OFF) / 4; u += NWAVES * 64) ((LAS unsigned*)(F.lds + LDSCTL_OFF))[u] = 0u;
    __syncthreads();
    XcdBarrier bar; bar.bar = (unsigned*)(F.ctl + CW_BAR); bar.x = 0; bar.st = nullptr;
    if (MK_N_LAUNCHES == 1) bar = xcd_barrier_post((unsigned*)(F.ctl + CW_BAR), F.MISC + 8);
    const int lo = args.ph_lo, hi = args.ph_hi;
#ifndef PHMASK
#define PHMASK 0x7fff
#endif
#define IN(k) (((PHMASK >> (k)) & 1) && lo <= (k) && (k) < hi)
#define SEAM(k) do { if (IN(k) && IN((k) + 1)) xcd_barrier(bar); } while (0)
    PG8_LAS unsigned char* ring = F.lds + RING_OFF;
    const int bx = (int)blockIdx.x;

    if (IN(0)) { phase0(F); } SEAM(0);
    if (IN(1)) { phase1(F); } SEAM(1);
    if (IN(2)) {
        pg8::Gemm g{WSP(bf16, WS_XN), WSP(bf16, WS_WIN_T), D, D, D}; pg8::DenseOrder S; S.init(T, INW, F.G, bx);
        EpiG1 E{WSP(bf16, WS_UA), WSP(bf16, WS_Q), WSP(bf16, WS_K), WSP(bf16, WS_V), WSP(bf16, WS_VT), WSP(bf16, WS_GS), WSP(bf16, WS_GA),
                WSP(float, WS_ROPE), WSP(float, WS_ROPE) + (size_t)T * 32, (float*)(F.ctl + CW_KM)};
        pg8::gemm_phase(ring, g, S, E);
    } SEAM(2);
    if (IN(3)) { attn_gate(F); s5_pass_a(F); } SEAM(3);
    if (IN(4)) { attn_items(F); s5_carry(F); } SEAM(4);
    if (IN(5)) { attn_combine(F); s5_pass_c(F); } SEAM(5);
    if (IN(6)) {
        pg8::Gemm g{WSP(bf16, WS_YG), WSP(bf16, WS_WGLU_T), SW, SW, SW}; pg8::DenseOrder S; S.init(T, SW, F.G, bx);
        EpiEw<0> E{WSP(bf16, WS_Y2), WSP(bf16, WS_YG), nullptr, nullptr, SW};
        pg8::gemm_phase(ring, g, S, E);
    } SEAM(6);
    if (IN(7)) {
        pg8::Gemm g{WSP(bf16, WS_Y2), WSP(bf16, WS_WSB_T), SW, SW, SW}; pg8::DenseOrder S; S.init(T, D, F.G, bx);
        EpiEw<1> E{WSP(bf16, WS_M1), WSP(bf16, WS_GS), nullptr, nullptr, D};
        pg8::gemm_phase(ring, g, S, E);
    } SEAM(7);
    if (IN(8)) {
        pg8::Gemm g{WSP(bf16, WS_YA), WSP(bf16, WS_WAB_T), AW, AW, AW}; pg8::DenseOrder S; S.init(T, D, F.G, bx);
        EpiEw<2> E{WSP(bf16, WS_XN), WSP(bf16, WS_GA), WSP(bf16, WS_M1), nullptr, D};
        pg8::gemm_phase(ring, g, S, E);
    } SEAM(8);
    if (IN(9)) {
        pg8::Gemm g{WSP(bf16, WS_XN), WSP(bf16, WS_WOUT_T), D, D, D}; pg8::DenseOrder S; S.init(T, D, F.G, bx);
        EpiEw<3> E{nullptr, nullptr, nullptr, WSP(float, WS_MIX), D};
        pg8::gemm_phase(ring, g, S, E);
    } SEAM(9);
    if (IN(10)) { phase_rows(F); } SEAM(10);
    if (IN(11)) { phase_gather(F); } SEAM(11);
    if (IN(12)) {
        moe_tables(F);
        pg8::Gemm g{WSP(bf16, WS_XG), WSP(bf16, WS_WGU_T), D, D, D}; MoeOrder S{(const LAS int*)(F.lds + SCR_OFF), 8, 2048, F.G, bx};
        EpiGU E{WSP(bf16, WS_H1), F.in[25], F.in[27]};
        pg8::gemm_phase(ring, g, S, E);
    } SEAM(12);
    if (IN(13)) {
        moe_tables(F);
        pg8::Gemm g{WSP(bf16, WS_H1), WSP(bf16, WS_WDN_T), FF, FF, FF}; MoeOrder S{(const LAS int*)(F.lds + SCR_OFF), 4, 1024, F.G, bx};
        EpiDn E{WSP(bf16, WS_YB), F.in[29]};
        pg8::gemm_phase(ring, g, S, E);
    } SEAM(13);
    if (IN(14)) { phase_final(F); }
#undef IN
#undef SEAM
}

extern "C" void kernel_launch(void* const* d_in, const int* in_sizes, int n_in, void* d_out, int out_size, void* d_ws, size_t ws_size, hipStream_t stream) {
    static int grid = 0;
    if (grid == 0) {
        if (n_in != 30 || in_sizes[0] != T * D || out_size != T * D || ws_size < WS_END) { fprintf(stderr, "kernel_launch: unexpected shapes (n_in %d, in0 %d, out %d, ws %zu)\n", n_in, n_in > 0 ? in_sizes[0] : -1, out_size, ws_size); grid = -1; return; }
        int dev = 0, cus = 0, per_cu = 0;
        if (hipGetDevice(&dev) != hipSuccess || hipDeviceGetAttribute(&cus, hipDeviceAttributeMultiprocessorCount, dev) != hipSuccess) { grid = -1; return; }
        if (hipFuncSetAttribute((const void*)mega_fwd, hipFuncAttributeMaxDynamicSharedMemorySize, LDS_BYTES) != hipSuccess) { fprintf(stderr, "kernel_launch: hipFuncSetAttribute failed\n"); grid = -1; return; }
        if (hipOccupancyMaxActiveBlocksPerMultiprocessor(&per_cu, (const void*)mega_fwd, NWAVES * 64, LDS_BYTES) != hipSuccess || per_cu < 1) { fprintf(stderr, "kernel_launch: occupancy query says %d\n", per_cu); }
        (void)hipGetLastError();
        grid = cus;
    }
    if (grid < 0) return;
    (void)hipMemsetAsync((char*)d_ws + WS_CTL, 0, CTL_ZERO_BYTES, stream);
    Args a{};
    for (int i = 0; i < 30; ++i) a.in[i] = (const float*)d_in[i];
    a.out = (float*)d_out; a.ws = (unsigned char*)d_ws;
    if (MK_N_LAUNCHES == 1) { a.ph_lo = 0; a.ph_hi = N_PHASES; hipLaunchKernelGGL(mega_fwd, dim3(grid), dim3(NWAVES * 64), LDS_BYTES, stream, a); }
    else for (int p = 0; p < N_PHASES; ++p) { a.ph_lo = p; a.ph_hi = p + 1; hipLaunchKernelGGL(mega_fwd, dim3(grid), dim3(NWAVES * 64), LDS_BYTES, stream, a); }
}
```

```cpp
#include <hip/hip_runtime.h>
#include <cstdio>
#include <cstdint>
#define MK_N_LAUNCHES 1
namespace pg8 {
#define PG8_LAS __attribute__((address_space(3)))
typedef unsigned short bf16_t;
typedef short bf16x8 __attribute__((ext_vector_type(8)));
typedef float f32x4 __attribute__((ext_vector_type(4)));
typedef unsigned u32x4 __attribute__((ext_vector_type(4)));
typedef unsigned u32x2 __attribute__((ext_vector_type(2)));
constexpr int BM = 256, BK = 64, HALF = 128, HTB = HALF * BK * 2  , STAGE_BYTES = 8 * HTB, NXCD = 8, WGM = 8;

__host__ __device__ __forceinline__ int lds_byte(int r, int c) { const int st = (r >> 4) * 2 + (c >> 5), rr = r & 15, cc = c & 31, ob = rr * 64 + cc * 2; return st * 1024 + (ob ^ (((ob >> 9) & 1) << 5)); }
__host__ __device__ __forceinline__ void stage_rc(int b, int& R, int& C) { const int st = b / 1024, sb = b % 1024, swz = sb ^ (((sb >> 9) & 1) << 5); R = (st >> 1) * 16 + swz / 64; C = (st & 1) * 32 + (swz % 64) / 2; }

struct Unit { int arow, brow, pm, pn, e, nrow; };
struct Gemm { const bf16_t* A; const bf16_t* Bt; int lda, ldb, K; };

struct DenseOrder {
    int nM, nN, nwg, G, c;
    __device__ __forceinline__ void init(int M, int N, int G_, int c_) { nM = M / BM; nN = N / BM; nwg = nM * nN; G = G_; c = c_; }
    __device__ __forceinline__ bool next(int i, Unit& u) const {
        const long L = (long)i * G + c; if (L >= nwg) return false;
        int wgid = (int)L; { const int q = nwg / NXCD, r = nwg % NXCD, xcd = wgid % NXCD, off = wgid / NXCD; wgid = (xcd < r ? xcd * (q + 1) : r * (q + 1) + (xcd - r) * q) + off; }
        const int nig = WGM * nN, gid = wgid / nig, fm = gid * WGM, gsz = (nM - fm) < WGM ? (nM - fm) : WGM;
        u.pm = fm + ((wgid % nig) % gsz); u.pn = (wgid % nig) / gsz; u.arow = u.pm * BM; u.brow = u.pn * BM; u.e = 0; u.nrow = BM; return true;
    }
};

template <class Epi, class Sched>
__device__ __forceinline__ void gemm_phase(PG8_LAS unsigned char* lds, const Gemm g, const Sched& S, const Epi& E) {
    const int tid = threadIdx.x, wid = __builtin_amdgcn_readfirstlane(tid >> 6), lane = tid & 63, wr = wid >> 2, wc = wid & 3, fr = lane & 15, fq = lane >> 4;
    const int K = g.K, nt = K / BK;
    unsigned voffA[2], voffB[2];
#pragma unroll
    for (int i = 0; i < 2; ++i) { int R, C; stage_rc(tid * 16 + i * 8192, R, C);
        voffA[i] = (unsigned)(R * g.lda + C) * 2u; voffB[i] = (unsigned)(R * g.ldb + C) * 2u; }
    const size_t kstep = (size_t)(BK * 2);
    const size_t hstepA = (size_t)HALF * g.lda * 2, hstepB = (size_t)HALF * g.ldb * 2;
    const size_t rowA = (size_t)g.lda * 2, rowB = (size_t)g.ldb * 2;
    const unsigned ldsw = (unsigned)wid * 1024u;
    const int aoff = lds_byte(wr * 64 + fr, fq * 8), boff = lds_byte(wc * 32 + fr, fq * 8);
#define PG8_SA(b, h) (((b) * 2 + (h)) * HTB)
#define PG8_SB(b, h) ((4 + (b) * 2 + (h)) * HTB)
#define PG8_STAGE(bufoff, gbase, voff) do { _Pragma("unroll") for (int _i = 0; _i < 2; ++_i) \
        __builtin_amdgcn_global_load_lds((const unsigned*)((const char*)(gbase) + (voff)[_i]), (PG8_LAS unsigned*)(lds + (bufoff) + ldsw + _i * 8192), 16, 0, 0); } while (0)
#define PG8_LDA(dst, b, h) do { _Pragma("unroll") for (int m = 0; m < 4; ++m) _Pragma("unroll") for (int k = 0; k < 2; ++k) dst[m][k] = *(const PG8_LAS bf16x8*)(lds + PG8_SA(b, h) + aoff + m * 2048 + k * 1024); } while (0)
#define PG8_LDB(dst, b, h) do { _Pragma("unroll") for (int n = 0; n < 2; ++n) _Pragma("unroll") for (int k = 0; k < 2; ++k) dst[n][k] = *(const PG8_LAS bf16x8*)(lds + PG8_SB(b, h) + boff + n * 2048 + k * 1024); } while (0)
#define PG8_MMA(ai, bj, At, Bt) do { __builtin_amdgcn_s_setprio(1); _Pragma("unroll") for (int m = 0; m < 4; ++m) _Pragma("unroll") for (int n = 0; n < 2; ++n) _Pragma("unroll") for (int k = 0; k < 2; ++k) \
        acc[ai][bj][m][n] = __builtin_amdgcn_mfma_f32_16x16x32_bf16(Bt[n][k], At[m][k], acc[ai][bj][m][n], 0, 0, 0); __builtin_amdgcn_s_setprio(0); } while (0)
#define PG8_WAIT_V(n) asm volatile("s_waitcnt vmcnt(" #n ")" ::: "memory")
#define PG8_WAIT_L(n) asm volatile("s_waitcnt lgkmcnt(" #n ")" ::: "memory")
#define PG8_BAR __builtin_amdgcn_s_barrier()
#define PG8_SCHED __builtin_amdgcn_sched_barrier(0)
    Unit cur, nxt; int ui = 0;
    if (!S.next(0, cur)) return;
    f32x4 acc[2][2][4][2];
#pragma unroll
    for (int a = 0; a < 2; ++a)
#pragma unroll
        for (int b = 0; b < 2; ++b)
#pragma unroll
            for (int m = 0; m < 4; ++m)
#pragma unroll
                for (int n = 0; n < 2; ++n) acc[a][b][m][n] = (f32x4){0.f, 0.f, 0.f, 0.f};
    bf16x8 At[4][2], B0[2][2], B1[2][2];
    const char* cA = (const char*)g.A + (size_t)cur.arow * rowA; const char* cB = (const char*)g.Bt + (size_t)cur.brow * rowB;
    PG8_STAGE(PG8_SB(0, 0), cB, voffB); PG8_STAGE(PG8_SB(0, 1), cB + hstepB, voffB); PG8_STAGE(PG8_SA(0, 0), cA, voffA); PG8_STAGE(PG8_SA(0, 1), cA + hstepA, voffA);
    if (wr == 1) PG8_BAR;
    PG8_WAIT_V(2); PG8_BAR;
    PG8_STAGE(PG8_SB(1, 0), cB + kstep, voffB); PG8_STAGE(PG8_SA(1, 0), cA + kstep, voffA); PG8_STAGE(PG8_SB(1, 1), cB + hstepB + kstep, voffB);
    PG8_WAIT_V(6); PG8_BAR;
    for (;;) {
        const bool has_next = S.next(ui + 1, nxt);
        const char* nA = has_next ? (const char*)g.A + (size_t)nxt.arow * rowA : cA; const char* nB = has_next ? (const char*)g.Bt + (size_t)nxt.brow * rowB : cB;
#pragma unroll 1
        for (int t = 0; t < nt; t += 2) {
            const bool last = (t == nt - 2);
            const char* a1 = cA + (size_t)(t + 1) * kstep;
            const char* a2 = last ? nA : cA + (size_t)(t + 2) * kstep; const char* b2 = last ? nB : cB + (size_t)(t + 2) * kstep;
            const char* a3 = a2 + kstep; const char* b3 = b2 + kstep;
            PG8_LDB(B0, 0, 0); PG8_LDB(B1, 0, 1); PG8_SCHED; PG8_LDA(At, 0, 0); PG8_STAGE(PG8_SA(1, 1), a1 + hstepA, voffA);
            PG8_WAIT_V(8); PG8_WAIT_L(0); PG8_BAR; PG8_MMA(0, 0, At, B0); PG8_MMA(0, 1, At, B1); PG8_BAR; PG8_SCHED;
            PG8_LDA(At, 0, 1); PG8_STAGE(PG8_SB(0, 0), b2, voffB); PG8_STAGE(PG8_SB(0, 1), b2 + hstepB, voffB); PG8_STAGE(PG8_SA(0, 0), a2, voffA);
            PG8_WAIT_V(8); PG8_WAIT_L(0); PG8_BAR; PG8_MMA(1, 0, At, B0); PG8_MMA(1, 1, At, B1); PG8_BAR; PG8_SCHED;
            PG8_LDB(B0, 1, 0); PG8_LDB(B1, 1, 1); PG8_SCHED; PG8_LDA(At, 1, 0); PG8_STAGE(PG8_SA(0, 1), a2 + hstepA, voffA);
            PG8_WAIT_V(8); PG8_WAIT_L(0); PG8_BAR; PG8_MMA(0, 0, At, B0); PG8_MMA(0, 1, At, B1); PG8_BAR; PG8_SCHED;
            PG8_LDA(At, 1, 1); PG8_STAGE(PG8_SB(1, 0), b3, voffB); PG8_STAGE(PG8_SB(1, 1), b3 + hstepB, voffB); PG8_STAGE(PG8_SA(1, 0), a3, voffA);
            PG8_WAIT_V(8); PG8_WAIT_L(0); PG8_BAR; PG8_MMA(1, 0, At, B0); PG8_MMA(1, 1, At, B1); PG8_BAR; PG8_SCHED;
        }
        if (wr == 0) PG8_BAR;
        E(acc, cur, wr, wc, fr, fq);
        if (!has_next) break;
#pragma unroll
        for (int a = 0; a < 2; ++a)
#pragma unroll
            for (int b = 0; b < 2; ++b)
#pragma unroll
                for (int m = 0; m < 4; ++m)
#pragma unroll
                    for (int n = 0; n < 2; ++n) acc[a][b][m][n] = (f32x4){0.f, 0.f, 0.f, 0.f};
        cur = nxt; cA = nA; cB = nB; ++ui;
        if (wr == 1) PG8_BAR;
    }
    PG8_WAIT_V(0);
    PG8_BAR;
#undef PG8_SA
#undef PG8_SB
#undef PG8_STAGE
#undef PG8_LDA
#undef PG8_LDB
#undef PG8_MMA
#undef PG8_WAIT_V
#undef PG8_WAIT_L
#undef PG8_BAR
#undef PG8_SCHED
}
}
constexpr int NWAVES = 8;
constexpr int BATCH = 2, SEQ = 8192, T = BATCH * SEQ, D = 1024, NH = 8, HD = 64, AW = 512, SW = 512, NG = 32, NP = 64, GS16 = 16;
constexpr int NE = 32, FF = 1024, INW = 4096, TOPK = 4, NBLK = SEQ / 256;
constexpr float NORM_EPS = 1e-6f;
constexpr float C2 = 0.125f * 1.4426950408889634f;
constexpr int XROWS = T * TOPK + 256;

constexpr size_t MiB = 1u << 20;
constexpr size_t WS_CTL = 0, CTL_ZERO_BYTES = 1 * MiB;
constexpr size_t WS_ADA = 1 * MiB;
constexpr size_t WS_ADAF = WS_ADA + 832 * 1024;
constexpr size_t WS_ROPE = 2 * MiB;
constexpr size_t WS_S5P = 6 * MiB;
constexpr size_t WS_S5KT = 7 * MiB;
constexpr size_t WS_S5M1 = 10 * MiB;
constexpr size_t WS_S5WC = 506 * MiB;
constexpr size_t WS_S5E = 408 * MiB;
constexpr size_t WS_ROUTE = 9 * MiB;
constexpr size_t WS_WIN_T = 18 * MiB, WS_WGLU_T = 26 * MiB, WS_WSB_T = 27 * MiB, WS_WAB_T = 28 * MiB, WS_WOUT_T = 29 * MiB;
constexpr size_t WS_PAR = 31 * MiB;
constexpr int PAR_MPG = 0, PAR_FPRE = 1024, PAR_FPOST = 2048, PAR_RB = 3072, PAR_RW = 4096, PAR_BG = 36864, PAR_BU = 69632, PAR_BD = 102400, PAR_CRE = 135168, PAR_CIM = 167936, PAR_SD = 200704;
constexpr size_t WS_WGU_T = 32 * MiB, WS_WDN_T = 160 * MiB;
constexpr size_t WS_XN = 224 * MiB;
constexpr size_t WS_UA = 256 * MiB, WS_Q = 280 * MiB, WS_K = 296 * MiB, WS_V = 312 * MiB, WS_VT = 328 * MiB;
constexpr size_t WS_MIX = 256 * MiB;
constexpr size_t WS_GS = 344 * MiB, WS_GA = 376 * MiB;
constexpr size_t WS_YG = 408 * MiB, WS_Y2 = 424 * MiB, WS_YA = 440 * MiB;
constexpr size_t WS_M1 = 456 * MiB;
constexpr size_t WS_H2 = 480 * MiB;
constexpr size_t WS_XG = 224 * MiB, WS_YB = 224 * MiB;
constexpr size_t WS_H1 = WS_XG + (size_t)XROWS * D * 2;
constexpr size_t WS_END = 512 * MiB;
static_assert(WS_H1 + (size_t)XROWS * FF * 2 <= WS_H2 + 1 * MiB + 0 && WS_H1 + (size_t)XROWS * FF * 2 <= WS_END, "ws map");
constexpr int CW_TMO = 0, CW_CODE = 1, CW_BAR = 4096, CW_ECNT = 8192, CW_KM = 16384;
static_assert((CW_KM + BATCH * NH * NBLK * HD) * 4 <= (int)CTL_ZERO_BYTES, "ctl");

constexpr int RING_OFF = 0, RING_BYTES = 131072;
constexpr int LDSCTL_OFF = 152 * 1024, MISC_OFF = LDSCTL_OFF + 320;
constexpr int LDS_BYTES = 156 * 1024;

#define GAS __attribute__((address_space(1)))
#define LAS __attribute__((address_space(3)))
typedef unsigned short bf16;
typedef unsigned v4u __attribute__((ext_vector_type(4)));
typedef unsigned v2u __attribute__((ext_vector_type(2)));
typedef float f32x4 __attribute__((ext_vector_type(4)));
typedef GAS unsigned gu32;
#define RLX_AGENT __ATOMIC_RELAXED, __HIP_MEMORY_SCOPE_AGENT
#define LDS_WAIT() asm volatile("s_waitcnt lgkmcnt(0)" ::: "memory")
#define VM_WAIT() asm volatile("s_waitcnt vmcnt(0)" ::: "memory")
__device__ __forceinline__ unsigned f2bf(float f) { unsigned u = __builtin_bit_cast(unsigned, f); return (u + 0x7fffu + ((u >> 16) & 1u)) >> 16; }
__device__ __forceinline__ unsigned pk2(float lo, float hi) { typedef float f32x2_t __attribute__((ext_vector_type(2))); typedef __bf16 bf16x2_t __attribute__((ext_vector_type(2)));
    f32x2_t v = {lo, hi}; bf16x2_t r = __builtin_convertvector(v, bf16x2_t); return __builtin_bit_cast(unsigned, r); }
__device__ __forceinline__ float bflo(unsigned w) { return __builtin_bit_cast(float, w << 16); }
__device__ __forceinline__ float bfhi(unsigned w) { return __builtin_bit_cast(float, w & 0xffff0000u); }
__device__ __forceinline__ float bf2f(bf16 h) { return __builtin_bit_cast(float, (unsigned)h << 16); }
__device__ __forceinline__ float sigmoidf_(float x) { return 1.f / (1.f + __expf(-x)); }
__device__ __forceinline__ float gelu_tanh(float x) { const float u = 1.5957691216057308f * (x + 0.044715f * x * x * x); return x / (1.f + __expf(-u)); }

#define XB_TMO      128
#define XB_XCNT(j)  (256  + 64 * (j))
#define XB_XSUB(j)  (1280 + 64 * (j))
#define XB_XGEN(j)  (2304 + 64 * (j))
#define XB_TOP      3328
#define XB_TOPGEN   3392
#define XCD_BAR_WORDS 3456
#define XB_SPIN_CAP (1u << 18)
__device__ __forceinline__ unsigned xb_ld(unsigned* p)              { return __hip_atomic_load(p, __ATOMIC_RELAXED, __HIP_MEMORY_SCOPE_AGENT); }
__device__ __forceinline__ unsigned xb_add(unsigned* p, unsigned v) { return __hip_atomic_fetch_add(p, v, __ATOMIC_RELAXED, __HIP_MEMORY_SCOPE_AGENT); }
__device__ __forceinline__ unsigned xb_xcc_id() { return (unsigned)__builtin_amdgcn_s_getreg((3 << 11) | 20) & 0xFu; }
#define XB_SPIN(cond, bar) do { unsigned _sp = 0; while (cond) { __builtin_amdgcn_s_sleep(1); \
    if ((++_sp & 255u) == 0u) { if (xb_ld(&(bar)[XB_TMO])) break; if (_sp > XB_SPIN_CAP) { atomicAdd(&(bar)[XB_TMO], 1u); break; } } } } while (0)
struct XcdBarrier { unsigned* bar; unsigned x; volatile LAS unsigned* st; };
__device__ __forceinline__ XcdBarrier xcd_barrier_post(unsigned* bar, volatile LAS unsigned* st) {
    XcdBarrier b; b.bar = bar; b.x = xb_xcc_id(); b.st = st;
    if (threadIdx.x == 0) (void)xb_add(&bar[XB_XCNT(b.x)], 1u);
    return b;
}
__device__ __forceinline__ void xcd_barrier_complete(unsigned* bar, unsigned x, unsigned& nloc, unsigned& nx) {
    const unsigned G = gridDim.x * gridDim.y * gridDim.z;
    unsigned sum, cnt, mine, sp = 0u;
    for (;;) {
        sum = 0u; cnt = 0u; mine = 0u;
#pragma unroll
        for (unsigned j = 0; j < 16; ++j) { const unsigned c = xb_ld(&bar[XB_XCNT(j)]); sum += c; cnt += (c > 0u) ? 1u : 0u; mine = (j == x) ? c : mine; }
        if (sum == G) break;
        __builtin_amdgcn_s_sleep(1);
        if ((++sp & 255u) == 0u) { if (xb_ld(&bar[XB_TMO])) break; if (sp > XB_SPIN_CAP) { atomicAdd(&bar[XB_TMO], 1u); break; } }
    }
    nloc = mine > 0u ? mine : 1u; nx = cnt > 0u ? cnt : 1u;
}
__device__ __forceinline__ void xcd_barrier(const XcdBarrier& b) {
    asm volatile("s_waitcnt vmcnt(0)" ::: "memory");
    __syncthreads();
    if (threadIdx.x == 0) {
        unsigned* bar = b.bar;
        __builtin_amdgcn_s_waitcnt(0);
        unsigned nloc = b.st[0], nx = b.st[1];
        if (nloc == 0u) { xcd_barrier_complete(bar, b.x, nloc, nx); b.st[0] = nloc; b.st[1] = nx; }
        const unsigned old = xb_add(&bar[XB_XSUB(b.x)], 1u);
        const unsigned gen = old / nloc;
        if (old + 1u == (gen + 1u) * nloc) {
            __builtin_amdgcn_fence(__ATOMIC_RELEASE, "agent");
            asm volatile("s_waitcnt vmcnt(0)" ::: "memory");
            const unsigned og = xb_add(&bar[XB_TOP], 1u);
            const unsigned tg = og / nx;
            if (og + 1u == (tg + 1u) * nx) xb_add(&bar[XB_TOPGEN], 1u);
            else XB_SPIN(xb_ld(&bar[XB_TOPGEN]) == tg, bar);
            __builtin_amdgcn_fence(__ATOMIC_ACQUIRE, "agent");
            xb_add(&bar[XB_XGEN(b.x)], 1u);
            asm volatile("s_waitcnt vmcnt(0)" ::: "memory");
        } else {
            XB_SPIN(xb_ld(&bar[XB_XGEN(b.x)]) == gen, bar);
            __builtin_amdgcn_fence(__ATOMIC_ACQUIRE, "agent");
            asm volatile("s_waitcnt vmcnt(0)" ::: "memory");
        }
    }
    __syncthreads();
}

__device__ __forceinline__ float wave_sum(float v) {
#pragma unroll
    for (int o = 1; o < 64; o <<= 1) v += __shfl_xor(v, o);
    return v;
}
__device__ __forceinline__ float wave_max(float v) {
#pragma unroll
    for (int o = 1; o < 64; o <<= 1) v = fmaxf(v, __shfl_xor(v, o));
    return v;
}
struct Frame {
    LAS unsigned char* lds;
    volatile LAS unsigned* MISC;
    gu32* ctl;
    int tid, lane, wave;
    int vcu, G;
    unsigned char* ws;
    const float* in[30];
    float* out;
};
#define WSP(T_, off) ((T_*)(F.ws + (off)))

__device__ __forceinline__ int perm8(int c) { return (c & ~31) + 16 * ((c >> 2) & 1) + 4 * ((c >> 3) & 3) + (c & 3); }
struct MapP8 { int off; __device__ __forceinline__ int operator()(int n) const { return off + perm8(n); } };
struct MapWin { __device__ __forceinline__ int operator()(int c) const {
    if (c < 512 || c >= 1536) return perm8(c);
    const int base = (c < 1024) ? 512 : 1024, cc = c - base, head = cc >> 6, d = cc & 63, pnq = head >> 2, hh = head & 3, n = d >> 5, dd = d & 31;
    const int wc = 2 * (hh & 1) + (dd >> 4), bj = hh >> 1, j = dd & 15;
    return base + 256 * pnq + 128 * bj + 32 * wc + 16 * n + j; } };
struct MapGU { int e, up; __device__ __forceinline__ int operator()(int f) const { return e * 2048 + (f >> 7) * 256 + up * 128 + perm8(f & 127); } };

template <class RowMap>
__device__ __forceinline__ void p0_transpose_item(const float* W, int K, int N, bf16* WT, LAS float* scr, int item, int lane, const RowMap rm) {
    const int nblk = N / 32, kb = item / nblk, nb = item % nblk, k0 = 64 * kb, n0 = 32 * nb;
#pragma unroll 8
    for (int i = 0; i < 32; ++i) { const int kk = 2 * i + (lane >> 5); scr[kk * 33 + (lane & 31)] = W[(size_t)(k0 + kk) * N + n0 + (lane & 31)]; }
    LDS_WAIT(); asm volatile("" ::: "memory");
    const int c = lane & 7;
#pragma unroll
    for (int j = 0; j < 4; ++j) { const int n = (lane >> 3) + 8 * j; const LAS float* s = scr + (8 * c) * 33 + n;
        v4u o; o.x = pk2(s[0 * 33], s[1 * 33]); o.y = pk2(s[2 * 33], s[3 * 33]); o.z = pk2(s[4 * 33], s[5 * 33]); o.w = pk2(s[6 * 33], s[7 * 33]);
        *(GAS v4u*)(WT + (size_t)rm(n0 + n) * K + k0 + 8 * c) = o; }
    LDS_WAIT(); asm volatile("" ::: "memory");
}

__device__ __forceinline__ void phase0(Frame& F) {
    LAS float* scr = (LAS float*)(F.lds + RING_OFF + F.wave * 16384);
    const int gw = F.vcu * NWAVES + F.wave, NGW = F.G * NWAVES;
    constexpr int I_WIN = 16 * 128, I_GLU = 8 * 16, I_SB = 8 * 32, I_AB = 8 * 32, I_OUT = 16 * 32, I_E = 16 * 32;
    constexpr int I_SMALL = I_WIN + I_GLU + I_SB + I_AB + I_OUT, I_MOE = 3 * NE * I_E, I_ADA = 16 * 96;
    constexpr int NITEMS = I_SMALL + I_MOE + I_ADA;
    for (int it = gw; it < NITEMS; it += NGW) {
        int r = it;
        if (r < I_WIN) { p0_transpose_item(F.in[9], D, INW, WSP(bf16, WS_WIN_T), scr, r, F.lane, MapWin{}); continue; } r -= I_WIN;
        if (r < I_GLU) { p0_transpose_item(F.in[18], SW, SW, WSP(bf16, WS_WGLU_T), scr, r, F.lane, MapP8{0}); continue; } r -= I_GLU;
        if (r < I_SB) { p0_transpose_item(F.in[19], SW, D, WSP(bf16, WS_WSB_T), scr, r, F.lane, MapP8{0}); continue; } r -= I_SB;
        if (r < I_AB) { p0_transpose_item(F.in[20], AW, D, WSP(bf16, WS_WAB_T), scr, r, F.lane, MapP8{0}); continue; } r -= I_AB;
        if (r < I_OUT) { p0_transpose_item(F.in[21], D, D, WSP(bf16, WS_WOUT_T), scr, r, F.lane, MapP8{0}); continue; } r -= I_OUT;
        if (r < I_MOE) {
            const int mat = r / I_E, item = r % I_E, kind = mat / NE, e = mat % NE;
            if (kind == 0) p0_transpose_item(F.in[24] + (size_t)e * D * FF, D, FF, WSP(bf16, WS_WGU_T), scr, item, F.lane, MapGU{e, 0});
            else if (kind == 1) p0_transpose_item(F.in[26] + (size_t)e * D * FF, D, FF, WSP(bf16, WS_WGU_T), scr, item, F.lane, MapGU{e, 1});
            else p0_transpose_item(F.in[28] + (size_t)e * FF * D, FF, D, WSP(bf16, WS_WDN_T), scr, item, F.lane, MapP8{e * 1024});
            continue; }
        r -= I_MOE;
        {
            const int ks = r / 96, cc = r % 96, n = cc * 64 + F.lane;
            const float* cvec = F.in[1]; const float* aw = F.in[3];
            float a0 = 0.f, a1 = 0.f;
            for (int k = ks * 64; k < ks * 64 + 64; ++k) {
                const float c0 = cvec[k], c1 = cvec[D + k];
                const float s0 = c0 / (1.f + __expf(-c0)), s1 = c1 / (1.f + __expf(-c1));
                const float w = aw[(size_t)k * (6 * D) + n];
                a0 += s0 * w; a1 += s1 * w; }
            float* part = WSP(float, WS_ADA);
            part[(ks * 2 + 0) * (6 * D) + n] = a0; part[(ks * 2 + 1) * (6 * D) + n] = a1;
        }
    }
    const int gt = F.vcu * (NWAVES * 64) + F.tid, NGT = F.G * NWAVES * 64;
    { const int* pos = (const int*)F.in[2]; float* rc = WSP(float, WS_ROPE); float* rs = rc + (size_t)T * 32;
      for (int i = gt; i < T * 32; i += NGT) { const int t = i >> 5, p = i & 31;
          const float invf = exp2f(-(float)p * (13.287712379549449f / 32.f));
          const double ang = (double)pos[t] * (double)invf; double rev = ang * 0.15915494309189535; rev -= floor(rev);
          const float fr = (float)rev;
          rc[i] = __builtin_amdgcn_cosf(fr); rs[i] = __builtin_amdgcn_sinf(fr); } }
    { float* P5 = WSP(float, WS_S5P);
      for (int i = gt; i < NG * NP; i += NGT) { const int g = i >> 6;
          const float dt = __expf(F.in[12][g]); const float lr = F.in[10][i], li = F.in[11][i];
          const float er = __expf(lr * dt); const double ang = (double)li * (double)dt; double rev = ang * 0.15915494309189535; rev -= floor(rev);
          const float cs = __builtin_amdgcn_cosf((float)rev), sn = __builtin_amdgcn_sinf((float)rev);
          float br = er * cs, bi = er * sn;
          P5[i] = br; P5[2048 + i] = bi;
          const float nr = br - 1.f, ni = bi, den = lr * lr + li * li;
          const float qr = (nr * lr + ni * li) / den, qi = (ni * lr - nr * li) / den;
          P5[8192 + i] = qr; P5[8192 + 2048 + i] = qi;
          float pr = br, pi_ = bi;
#pragma unroll
          for (int s = 0; s < 8; ++s) { const float tr = pr * pr - pi_ * pi_, ti = 2.f * pr * pi_; pr = tr; pi_ = ti; }
          P5[4096 + i] = pr; P5[6144 + i] = pi_;
          float* PW = P5 + 131072;
          float wr_ = 1.f, wi_ = 0.f;
#pragma unroll
          for (int k = 0; k <= 16; ++k) { PW[i * 17 + k] = wr_; PW[2048 * 17 + i * 17 + k] = wi_; const float tr = wr_ * br - wi_ * bi, ti = wr_ * bi + wi_ * br; wr_ = tr; wi_ = ti; } }
    }
}

__device__ __forceinline__ void phase1(Frame& F) {
    LAS float* A1 = (LAS float*)(F.lds + RING_OFF); LAS float* A2 = A1 + 2 * D;
    const float* part = WSP(float, WS_ADA); const float* ab = F.in[4]; const float* pg = F.in[5];
    for (int k = F.tid; k < D; k += NWAVES * 64)
#pragma unroll
        for (int b = 0; b < 2; ++b) { float sh = ab[k], sc = ab[D + k];
            for (int ks = 0; ks < 16; ++ks) { sh += part[(ks * 2 + b) * (6 * D) + k]; sc += part[(ks * 2 + b) * (6 * D) + D + k]; }
            A1[b * D + k] = pg[k] * (1.f + sc); A2[b * D + k] = sh; }
    const int gt = F.vcu * (NWAVES * 64) + F.tid, NGT = F.G * NWAVES * 64;
    { float* adaf = WSP(float, WS_ADAF);
      for (int n = gt; n < 2 * 6 * D; n += NGT) { const int b = n / (6 * D), j = n % (6 * D); float a = ab[j];
          for (int ks = 0; ks < 16; ++ks) a += part[(ks * 2 + b) * (6 * D) + j];
          adaf[n] = a; } }
    { float* par = WSP(float, WS_PAR);
      for (int i = gt; i < 32768; i += NGT) { par[PAR_RW + i] = F.in[22][i]; par[PAR_BG + i] = F.in[25][i]; par[PAR_BU + i] = F.in[27][i]; par[PAR_BD + i] = F.in[29][i];
          par[PAR_CRE + i] = F.in[15][i]; par[PAR_CIM + i] = F.in[16][i];
          if (i < 1024) { par[PAR_MPG + i] = F.in[6][i]; par[PAR_FPRE + i] = F.in[7][i]; par[PAR_FPOST + i] = F.in[8][i]; }
          if (i < 512) par[PAR_SD + i] = F.in[17][i];
          if (i < 32) par[PAR_RB + i] = F.in[23][i]; } }
    { const float* P5 = WSP(float, WS_S5P); const float* PWr = P5 + 131072; const float* PWi = PWr + 2048 * 17;
      bf16* M1t = WSP(bf16, WS_S5M1);
      for (int i = gt; i < NG * 256 * 256; i += NGT) { const int k = i & 255, n = (i >> 8) & 255, g = i >> 16; float val = 0.f;
          if (n < 128) { const int p = n & 63, gp = g * 64 + p, s_ = k >> 4, ci = k & 15;
              const float qr = P5[8192 + gp], qi = P5[8192 + 2048 + gp], b_r = F.in[13][gp * 16 + ci], b_i = F.in[14][gp * 16 + ci];
              const float bbr = qr * b_r - qi * b_i, bbi = qr * b_i + qi * b_r, wr_ = PWr[gp * 17 + 15 - s_], wi_ = PWi[gp * 17 + 15 - s_];
              val = (n < 64) ? (wr_ * bbr - wi_ * bbi) : (wr_ * bbi + wi_ * bbr); }
          M1t[((size_t)(g * 256 + perm8(n))) * 256 + k] = (bf16)f2bf(val); }
      float* KT = WSP(float, WS_S5KT);
      for (int i = gt; i < NG * 16 * 256; i += NGT) { const int ci = i & 15, co = (i >> 4) & 15, tau = (i >> 8) & 15, g = i >> 12; float a = 0.f;
          for (int p = 0; p < 64; ++p) { const int gp = g * 64 + p;
              const float qr = P5[8192 + gp], qi = P5[8192 + 2048 + gp], b_r = F.in[13][gp * 16 + ci], b_i = F.in[14][gp * 16 + ci];
              const float bbr = qr * b_r - qi * b_i, bbi = qr * b_i + qi * b_r, wr_ = PWr[gp * 17 + tau], wi_ = PWi[gp * 17 + tau];
              const float xr = wr_ * bbr - wi_ * bbi, xi = wr_ * bbi + wi_ * bbr;
              const float cr = F.in[15][(g * 16 + co) * 64 + p], ci_ = F.in[16][(g * 16 + co) * 64 + p];
              a += cr * xr - ci_ * xi; }
          KT[i] = a; } }
    __syncthreads();
    const int gw = F.vcu * NWAVES + F.wave, NGW = F.G * NWAVES;
    bf16* XN = WSP(bf16, WS_XN);
    for (int m = gw; m < T; m += NGW) {
        const int b = m >> 13;
        const GAS f32x4* xr = (const GAS f32x4*)(F.in[0] + (size_t)m * D) + F.lane;
        f32x4 v[4]; float s = 0.f;
#pragma unroll
        for (int j = 0; j < 4; ++j) { v[j] = xr[64 * j]; s += (v[j].x * v[j].x + v[j].y * v[j].y) + (v[j].z * v[j].z + v[j].w * v[j].w); }
        const float rstd = 1.f / sqrtf(wave_sum(s) * (1.f / D) + NORM_EPS);
        GAS unsigned long long* o8 = (GAS unsigned long long*)(XN + (size_t)m * D) + F.lane;
#pragma unroll
        for (int j = 0; j < 4; ++j) { const f32x4 a1 = *(const LAS f32x4*)(A1 + b * D + 4 * F.lane + 256 * j), a2 = *(const LAS f32x4*)(A2 + b * D + 4 * F.lane + 256 * j);
            const f32x4 o = v[j] * rstd * a1 + a2;
            o8[64 * j] = (unsigned long long)pk2(o.x, o.y) | ((unsigned long long)pk2(o.z, o.w) << 32); }
    }
    __syncthreads();
}

struct EpiG1 {
    bf16 *UA, *Q, *K, *V, *VT, *GSp, *GAp; const float *rc, *rs; float* km;
    __device__ __forceinline__ void operator()(const pg8::f32x4 (&acc)[2][2][4][2], const pg8::Unit& u, int wr, int wc, int fr, int fq) const {
        asm volatile("" : "+v"(fr), "+v"(fq));
        const int pn = u.pn, row0 = u.pm * 256 + wr * 64 + fr;
        if (pn < 2) {
#pragma unroll
            for (int ai = 0; ai < 2; ++ai)
#pragma unroll
                for (int m = 0; m < 4; ++m) { const int t = row0 + ai * 128 + m * 16, b = t >> 13, tt = t & (SEQ - 1), c = tt >> 4, s = tt & 15;
#pragma unroll
                    for (int bj = 0; bj < 2; ++bj) { const int ch = pn * 256 + bj * 128 + wc * 32 + 8 * fq, g = ch >> 4, ci = ch & 15;
                        const pg8::f32x4 v0 = acc[ai][bj][m][0], v1 = acc[ai][bj][m][1];
                        v4u w; w.x = pk2(v0[0], v0[1]); w.y = pk2(v0[2], v0[3]); w.z = pk2(v1[0], v1[1]); w.w = pk2(v1[2], v1[3]);
                        *(v4u*)(UA + ((size_t)(g * 1024 + b * 512 + c) * 384 + 16 * s + ci)) = w; } }
        } else if (pn < 6) {
            const bool isk = pn >= 4; bf16* X = isk ? K : Q; const float sc = isk ? 1.f : C2;
            const int p0 = 16 * (wc & 1) + 4 * fq;
#pragma unroll
            for (int bj = 0; bj < 2; ++bj) {
                const int head = 4 * (pn & 1) + 2 * bj + (wc >> 1);
                int rowb = row0; asm volatile("" : "+v"(rowb));
                float ks[2][4];
#pragma unroll
                for (int b = 0; b < 2; ++b)
#pragma unroll
                    for (int i = 0; i < 4; ++i) ks[b][i] = 0.f;
#pragma unroll
                for (int ai = 0; ai < 2; ++ai)
#pragma unroll
                    for (int m = 0; m < 4; ++m) { const int t = rowb + ai * 128 + m * 16;
                        const pg8::f32x4 cs = *(const pg8::f32x4*)(rc + (size_t)t * 32 + p0), sn = *(const pg8::f32x4*)(rs + (size_t)t * 32 + p0);
                        const pg8::f32x4 t1 = acc[ai][bj][m][0], t2 = acc[ai][bj][m][1];
                        const pg8::f32x4 o1 = t1 * cs - t2 * sn, o2 = t2 * cs + t1 * sn;
                        v2u w1, w2; w1.x = pk2(o1[0] * sc, o1[1] * sc); w1.y = pk2(o1[2] * sc, o1[3] * sc); w2.x = pk2(o2[0] * sc, o2[1] * sc); w2.y = pk2(o2[2] * sc, o2[3] * sc);
                        bf16* dst = X + (size_t)t * AW + head * 64 + p0;
                        *(v2u*)dst = w1; *(v2u*)(dst + 32) = w2;
#pragma unroll
                        for (int i = 0; i < 4; ++i) { ks[0][i] += o1[i]; ks[1][i] += o2[i]; }
                        __builtin_amdgcn_sched_barrier(0); }
                if (isk) {
                    const int b = u.pm >> 5, blk = u.pm & 31;
#pragma unroll
                    for (int n = 0; n < 2; ++n)
#pragma unroll
                        for (int i = 0; i < 4; ++i) { float v = ks[n][i];
                            v += __shfl_xor(v, 1); v += __shfl_xor(v, 2); v += __shfl_xor(v, 4); v += __shfl_xor(v, 8);
                            if (fr == 0) atomicAdd(km + ((size_t)((b * NH + head) * NBLK + blk) * HD + 32 * n + p0 + i), v); }
                }
            }
        } else if (pn < 8) {
#pragma unroll
            for (int ai = 0; ai < 2; ++ai)
#pragma unroll
                for (int m = 0; m < 4; ++m) { const int t = row0 + ai * 128 + m * 16, b = t >> 13, tt = t & (SEQ - 1);
#pragma unroll
                    for (int bj = 0; bj < 2; ++bj) { const int cv = (pn - 6) * 256 + bj * 128 + wc * 32 + 8 * fq, head = cv >> 6, d = cv & 63;
                        const pg8::f32x4 v0 = acc[ai][bj][m][0], v1 = acc[ai][bj][m][1];
                        v4u w; w.x = pk2(v0[0], v0[1]); w.y = pk2(v0[2], v0[3]); w.z = pk2(v1[0], v1[1]); w.w = pk2(v1[2], v1[3]);
                        bf16* vt = VT + ((size_t)((b * NH + head) * HD + d) * SEQ + tt);
                        vt[0 * SEQ] = (bf16)(w.x & 0xffff); vt[1 * SEQ] = (bf16)(w.x >> 16); vt[2 * SEQ] = (bf16)(w.y & 0xffff); vt[3 * SEQ] = (bf16)(w.y >> 16);
                        vt[4 * SEQ] = (bf16)(w.z & 0xffff); vt[5 * SEQ] = (bf16)(w.z >> 16); vt[6 * SEQ] = (bf16)(w.w & 0xffff); vt[7 * SEQ] = (bf16)(w.w >> 16); } }
        } else {
            bf16* Gp = (pn < 12) ? GSp : GAp; const int cb = ((pn - 8) & 3) * 256;
#pragma unroll
            for (int ai = 0; ai < 2; ++ai)
#pragma unroll
                for (int m = 0; m < 4; ++m) { const int t = row0 + ai * 128 + m * 16;
#pragma unroll
                    for (int bj = 0; bj < 2; ++bj) { const int col = cb + bj * 128 + wc * 32 + 8 * fq;
                        const pg8::f32x4 v0 = acc[ai][bj][m][0], v1 = acc[ai][bj][m][1];
                        v4u w; w.x = pk2(sigmoidf_(v0[0]), sigmoidf_(v0[1])); w.y = pk2(sigmoidf_(v0[2]), sigmoidf_(v0[3]));
                        w.z = pk2(sigmoidf_(v1[0]), sigmoidf_(v1[1])); w.w = pk2(sigmoidf_(v1[2]), sigmoidf_(v1[3]));
                        *(v4u*)(Gp + (size_t)t * D + col) = w; } }
        }
    }
};

template <int MODE> struct EpiEw {
    bf16* O; const bf16* X1; const bf16* X2; float* Of; int ld;
    __device__ __forceinline__ void operator()(const pg8::f32x4 (&acc)[2][2][4][2], const pg8::Unit& u, int wr, int wc, int fr, int fq) const {
        const int row0 = u.pm * 256 + wr * 64 + fr, col0 = u.pn * 256 + wc * 32 + 8 * fq;
#pragma unroll
        for (int ai = 0; ai < 2; ++ai)
#pragma unroll
            for (int m = 0; m < 4; ++m) { const size_t rb = (size_t)(row0 + ai * 128 + m * 16) * ld + col0;
#pragma unroll
                for (int bj = 0; bj < 2; ++bj) { const size_t off = rb + bj * 128;
                    const pg8::f32x4 v0 = acc[ai][bj][m][0], v1 = acc[ai][bj][m][1];
                    if (MODE == 3) { *(pg8::f32x4*)(Of + off) = v0; *(pg8::f32x4*)(Of + off + 4) = v1; }
                    else {
                        const v4u x = *(const v4u*)(X1 + off);
                        float r[8] = {v0[0], v0[1], v0[2], v0[3], v1[0], v1[1], v1[2], v1[3]};
                        const float xv[8] = {bflo(x.x), bfhi(x.x), bflo(x.y), bfhi(x.y), bflo(x.z), bfhi(x.z), bflo(x.w), bfhi(x.w)};
                        if (MODE == 0) {
#pragma unroll
                            for (int i = 0; i < 8; ++i) r[i] = xv[i] * sigmoidf_(r[i]);
                        } else if (MODE == 1) {
#pragma unroll
                            for (int i = 0; i < 8; ++i) r[i] = xv[i] * r[i];
                        } else {
                            const v4u y = *(const v4u*)(X2 + off);
                            const float yv[8] = {bflo(y.x), bfhi(y.x), bflo(y.y), bfhi(y.y), bflo(y.z), bfhi(y.z), bflo(y.w), bfhi(y.w)};
#pragma unroll
                            for (int i = 0; i < 8; ++i) r[i] = yv[i] + xv[i] * r[i];
                        }
                        v4u w; w.x = pk2(r[0], r[1]); w.y = pk2(r[2], r[3]); w.z = pk2(r[4], r[5]); w.w = pk2(r[6], r[7]);
                        *(v4u*)(O + off) = w; } } }
    }
};

typedef short bf16x8 __attribute__((ext_vector_type(8)));
typedef float f32x16 __attribute__((ext_vector_type(16)));
constexpr size_t WS_ALIST = 456 * MiB;
constexpr size_t WS_OP01 = 224 * MiB;
constexpr size_t WS_OP23 = 472 * MiB;
constexpr size_t WS_LSE = 504 * MiB;
constexpr int CW_BCNT = 12288;
constexpr int ALCAP = 8192;

__device__ __forceinline__ void attn_gate(Frame& F) {
    const int gw = F.vcu * NWAVES + F.wave, NGW = F.G * NWAVES, L = F.lane;
    const bf16* Q = WSP(bf16, WS_Q); const float* km = (const float*)(F.ctl + CW_KM);
    unsigned* bcnt = (unsigned*)(F.ctl + CW_BCNT); unsigned* list = WSP(unsigned, WS_ALIST); float* lse = WSP(float, WS_LSE);
    for (int w = gw; w < BATCH * NH * (SEQ / 64); w += NGW) {
        const int bh = w >> 7, b = bh >> 3, h = bh & 7, tt = (w & 127) * 64 + L, t = b * SEQ + tt, blk = tt >> 8;
        float q[64];
        { const v4u* qp = (const v4u*)(Q + (size_t)t * AW + h * 64);
#pragma unroll
          for (int i = 0; i < 8; ++i) { const v4u x = qp[i]; q[8 * i] = bflo(x.x); q[8 * i + 1] = bfhi(x.x); q[8 * i + 2] = bflo(x.y); q[8 * i + 3] = bfhi(x.y);
              q[8 * i + 4] = bflo(x.z); q[8 * i + 5] = bfhi(x.z); q[8 * i + 6] = bflo(x.w); q[8 * i + 7] = bfhi(x.w); } }
        float v0 = -3e38f, v1 = -3e38f, v2 = -3e38f; int i0 = -1, i1 = -1, i2 = -1;
        for (int j = 0; j < blk; ++j) { const float* kp = km + (size_t)((b * NH + h) * NBLK + j) * HD; float g = 0.f;
#pragma unroll
            for (int d = 0; d < 64; ++d) g += q[d] * kp[d];
            if (g > v0) { v2 = v1; i2 = i1; v1 = v0; i1 = i0; v0 = g; i0 = j; }
            else if (g > v1) { v2 = v1; i2 = i1; v1 = g; i1 = j; }
            else if (g > v2) { v2 = g; i2 = j; } }
        float* lp = lse + ((size_t)t * NH + h) * 4;
        if (i0 < 0) lp[0] = -1e30f; if (i1 < 0) lp[1] = -1e30f; if (i2 < 0) lp[2] = -1e30f;
        for (int j = 0; j < blk; ++j) {
            const bool sel = (i0 == j) || (i1 == j) || (i2 == j);
            const unsigned long long mask = __ballot(sel);
            if (mask) { const int leader = __ffsll((long long)mask) - 1; const int bucket = (b * NH + h) * NBLK + j;
                unsigned base = 0u;
                if (L == leader) base = __hip_atomic_fetch_add(bcnt + bucket, (unsigned)__popcll(mask), RLX_AGENT);
                base = (unsigned)__shfl((int)base, leader);
                if (sel) { const unsigned pos = base + (unsigned)__popcll(mask & ((1ull << L) - 1ull)); const unsigned slot = (i0 == j) ? 0u : ((i1 == j) ? 1u : 2u);
                    list[(size_t)bucket * ALCAP + pos] = ((unsigned)tt << 2) | slot; } }
        }
    }
}

__device__ __forceinline__ unsigned cvtpk(float lo, float hi) { typedef float f32x2_t __attribute__((ext_vector_type(2))); typedef __bf16 bf16x2_t __attribute__((ext_vector_type(2)));
    f32x2_t v = {lo, hi}; bf16x2_t r = __builtin_convertvector(v, bf16x2_t); return __builtin_bit_cast(unsigned, r); }

constexpr int AT_KROW = 144, AT_VROW = 520, AT_KOFF = 0, AT_VOFF = 256 * AT_KROW;
__device__ __forceinline__ void attn_item(Frame& F, int b, int h, int j, bool own, const unsigned* lst, int nvalid) {
    const int tid = F.tid, L = F.lane, r = L & 31, hh = L >> 5, wv = F.wave;
    LAS unsigned char* Kl = F.lds + AT_KOFF; LAS unsigned char* Vl = F.lds + AT_VOFF;
    const bf16* Kg = WSP(bf16, WS_K) + ((size_t)(b * SEQ + j * 256)) * AW + h * 64;
    const bf16* Vg = WSP(bf16, WS_VT) + ((size_t)((b * NH + h) * HD)) * SEQ + j * 256;
    v4u kr[4], vr[4];
#pragma unroll
    for (int i = 0; i < 4; ++i) { const int idx = tid + 512 * i; kr[i] = *(const v4u*)(Kg + (size_t)(idx >> 3) * AW + (idx & 7) * 8); vr[i] = *(const v4u*)(Vg + (size_t)(idx >> 5) * SEQ + (idx & 31) * 8); }
    const int qi = wv * 32 + r; const bool valid = qi < nvalid;
    unsigned ent; if (own) ent = ((unsigned)(j * 256 + qi) << 2) | 3u; else ent = lst[valid ? qi : 0];
    const int tt = (int)(ent >> 2), slot = (int)(ent & 3u), t = b * SEQ + tt;
    bf16x8 qf[4];
    { const bf16* qp = WSP(bf16, WS_Q) + (size_t)t * AW + h * 64 + hh * 8;
#pragma unroll
      for (int d0 = 0; d0 < 4; ++d0) qf[d0] = *(const bf16x8*)(qp + d0 * 16); }
#pragma unroll
    for (int i = 0; i < 4; ++i) { const int idx = tid + 512 * i; *(LAS v4u*)(Kl + (idx >> 3) * AT_KROW + (idx & 7) * 16) = kr[i]; *(LAS v4u*)(Vl + (idx >> 5) * AT_VROW + (idx & 31) * 16) = vr[i]; }
    __syncthreads();
    if (wv * 32 < nvalid) {
        float m = -1e30f, l = 0.f; f32x16 O0 = {}, O1 = {};
        const int qrel = tt & 255;
#pragma unroll
        for (int hk = 0; hk < 2; ++hk) {
            if (own && hk * 128 > wv * 32 + 31) continue;
            f32x16 S[4];
#pragma unroll
            for (int kt = 0; kt < 4; ++kt) { S[kt] = (f32x16){};
#pragma unroll
                for (int d0 = 0; d0 < 4; ++d0) { const bf16x8 kf = *(const LAS bf16x8*)(Kl + (hk * 128 + kt * 32 + r) * AT_KROW + d0 * 32 + hh * 16);
                    S[kt] = __builtin_amdgcn_mfma_f32_32x32x16_bf16(kf, qf[d0], S[kt], 0, 0, 0); } }
            if (own) {
#pragma unroll
                for (int kt = 0; kt < 4; ++kt)
#pragma unroll
                    for (int rg = 0; rg < 16; ++rg) { const int key = hk * 128 + kt * 32 + (rg & 3) + 8 * (rg >> 2) + 4 * hh; if (key > qrel) S[kt][rg] = -1e30f; } }
            float mx = S[0][0];
#pragma unroll
            for (int kt = 0; kt < 4; ++kt)
#pragma unroll
                for (int rg = 0; rg < 16; ++rg) mx = fmaxf(mx, S[kt][rg]);
            mx = fmaxf(mx, __shfl_xor(mx, 32));
            const float mn = fmaxf(m, mx), alpha = __builtin_amdgcn_exp2f(m - mn); m = mn; l *= alpha;
#pragma unroll
            for (int rg = 0; rg < 16; ++rg) { O0[rg] *= alpha; O1[rg] *= alpha; }
            float ls = 0.f; unsigned pw[4][8];
#pragma unroll
            for (int kt = 0; kt < 4; ++kt)
#pragma unroll
                for (int rg = 0; rg < 16; rg += 2) { const float p0 = __builtin_amdgcn_exp2f(S[kt][rg] - mn), p1 = __builtin_amdgcn_exp2f(S[kt][rg + 1] - mn); ls += p0 + p1; pw[kt][rg >> 1] = cvtpk(p0, p1); }
            l += ls;
#pragma unroll
            for (int kt = 0; kt < 4; ++kt)
#pragma unroll
                for (int s = 0; s < 2; ++s) {
                    const v4u pv = {pw[kt][4 * s], pw[kt][4 * s + 1], pw[kt][4 * s + 2], pw[kt][4 * s + 3]}; const bf16x8 pf = __builtin_bit_cast(bf16x8, pv);
                    const int kb = (hk * 128 + kt * 32 + 16 * s + 4 * hh) * 2;
                    { const LAS unsigned char* vp = Vl + r * AT_VROW + kb; const v2u lo = *(const LAS v2u*)vp, hi = *(const LAS v2u*)(vp + 16);
                      const v4u vv = {lo.x, lo.y, hi.x, hi.y}; O0 = __builtin_amdgcn_mfma_f32_32x32x16_bf16(__builtin_bit_cast(bf16x8, vv), pf, O0, 0, 0, 0); }
                    { const LAS unsigned char* vp = Vl + (32 + r) * AT_VROW + kb; const v2u lo = *(const LAS v2u*)vp, hi = *(const LAS v2u*)(vp + 16);
                      const v4u vv = {lo.x, lo.y, hi.x, hi.y}; O1 = __builtin_amdgcn_mfma_f32_32x32x16_bf16(__builtin_bit_cast(bf16x8, vv), pf, O1, 0, 0, 0); } }
        }
        l += __shfl_xor(l, 32);
        if (valid) {
            const float rl = 1.f / l;
            bf16* op = (slot < 2 ? WSP(bf16, WS_OP01) + (((size_t)t * NH + h) * 2 + slot) * 64 : WSP(bf16, WS_OP23) + (((size_t)t * NH + h) * 2 + (slot - 2)) * 64) + 4 * hh;
#pragma unroll
            for (int g4 = 0; g4 < 4; ++g4) { v2u w0, w1; w0.x = cvtpk(O0[4 * g4] * rl, O0[4 * g4 + 1] * rl); w0.y = cvtpk(O0[4 * g4 + 2] * rl, O0[4 * g4 + 3] * rl);
                w1.x = cvtpk(O1[4 * g4] * rl, O1[4 * g4 + 1] * rl); w1.y = cvtpk(O1[4 * g4 + 2] * rl, O1[4 * g4 + 3] * rl);
                *(v2u*)(op + 8 * g4) = w0; *(v2u*)(op + 32 + 8 * g4) = w1; }
            if (hh == 0) WSP(float, WS_LSE)[((size_t)t * NH + h) * 4 + slot] = m + log2f(l);
        }
    }
    __syncthreads();
}
__device__ __forceinline__ void attn_items(Frame& F) {
    LAS int* pre = (LAS int*)(F.lds + 72 * 1024);
    const unsigned* bcnt = (const unsigned*)(F.ctl + CW_BCNT);
    LAS int* cntl = pre + 520;
    for (int i = F.tid; i < 512; i += NWAVES * 64) cntl[i] = (int)__hip_atomic_load((gu32*)(F.ctl + CW_BCNT) + i, RLX_AGENT);
    __syncthreads();
    if (F.tid == 0) { int a = 0; for (int i = 0; i < 512; ++i) { pre[i] = a; a += (cntl[i] + 255) >> 8; } pre[512] = a; }
    __syncthreads();
    const int total = 512 + pre[512];
    for (int it = (int)blockIdx.x; it < total; it += F.G) {
        if (it < 512) { const int bh = it >> 5, i = it & 31; attn_item(F, bh >> 3, bh & 7, i, true, nullptr, 256); }
        else { const int s = it - 512; int lo = 0, hi = 512;
            while (hi - lo > 1) { const int mid = (lo + hi) >> 1; if (pre[mid] <= s) lo = mid; else hi = mid; }
            const int bucket = lo, tile = s - pre[bucket], n = cntl[bucket] - tile * 256, bh = bucket >> 5, j = bucket & 31;
            attn_item(F, bh >> 3, bh & 7, j, false, WSP(unsigned, WS_ALIST) + (size_t)bucket * ALCAP + tile * 256, n > 256 ? 256 : n); }
    }
}
__device__ __forceinline__ void attn_combine(Frame& F) {
    const int gw = F.vcu * NWAVES + F.wave, NGW = F.G * NWAVES, L = F.lane, h = L >> 3, ch = L & 7;
    const float* lse = WSP(float, WS_LSE); bf16* YA = WSP(bf16, WS_YA);
    for (int t = gw; t < T; t += NGW) {
        const size_t th = (size_t)t * NH + h;
        const f32x4 ls = *(const f32x4*)(lse + th * 4);
        const float mx = fmaxf(fmaxf(ls[0], ls[1]), fmaxf(ls[2], ls[3]));
        const float w0 = __builtin_amdgcn_exp2f(ls[0] - mx), w1 = __builtin_amdgcn_exp2f(ls[1] - mx), w2 = __builtin_amdgcn_exp2f(ls[2] - mx), w3 = __builtin_amdgcn_exp2f(ls[3] - mx), inv = 1.f / (w0 + w1 + w2 + w3);
        const v4u a0 = *(const v4u*)(WSP(bf16, WS_OP01) + (th * 2 + 0) * 64 + ch * 8), a1 = *(const v4u*)(WSP(bf16, WS_OP01) + (th * 2 + 1) * 64 + ch * 8);
        const v4u a2 = *(const v4u*)(WSP(bf16, WS_OP23) + (th * 2 + 0) * 64 + ch * 8), a3 = *(const v4u*)(WSP(bf16, WS_OP23) + (th * 2 + 1) * 64 + ch * 8);
        float o[8];
        const unsigned x0[4] = {a0.x, a0.y, a0.z, a0.w}, x1[4] = {a1.x, a1.y, a1.z, a1.w}, x2[4] = {a2.x, a2.y, a2.z, a2.w}, x3[4] = {a3.x, a3.y, a3.z, a3.w};
#pragma unroll
        for (int i = 0; i < 4; ++i) {
            float lo_ = w3 * bflo(x3[i]), hi_ = w3 * bfhi(x3[i]);
            if (ls[0] > -1e29f) { lo_ += w0 * bflo(x0[i]); hi_ += w0 * bfhi(x0[i]); }
            if (ls[1] > -1e29f) { lo_ += w1 * bflo(x1[i]); hi_ += w1 * bfhi(x1[i]); }
            if (ls[2] > -1e29f) { lo_ += w2 * bflo(x2[i]); hi_ += w2 * bfhi(x2[i]); }
            o[2 * i] = lo_ * inv; o[2 * i + 1] = hi_ * inv; }
        v4u w; w.x = cvtpk(o[0], o[1]); w.y = cvtpk(o[2], o[3]); w.z = cvtpk(o[4], o[5]); w.w = cvtpk(o[6], o[7]);
        *(v4u*)(YA + (size_t)t * AW + h * 64 + ch * 8) = w;
    }
}
struct S5Order { int G, c;
    __device__ __forceinline__ bool next(int i, pg8::Unit& u) const { const int L = i * G + c; if (L >= NG * 4) return false; const int g = L >> 2, rt = L & 3;
        u.arow = g * 1024 + rt * 256; u.brow = g * 256; u.pm = rt; u.pn = 0; u.e = g; u.nrow = 256; return true; } };
struct EpiS5A { float* E;
    __device__ __forceinline__ void operator()(const pg8::f32x4 (&acc)[2][2][4][2], const pg8::Unit& u, int wr, int wc, int fr, int fq) const {
        asm volatile("" : "+v"(fr), "+v"(fq));
#pragma unroll
        for (int ai = 0; ai < 2; ++ai)
#pragma unroll
            for (int m = 0; m < 4; ++m) { float* p = E + (size_t)(u.arow + ai * 128 + wr * 64 + m * 16 + fr) * 128 + wc * 32 + 8 * fq;
                *(pg8::f32x4*)p = acc[ai][0][m][0]; *(pg8::f32x4*)(p + 4) = acc[ai][0][m][1]; }
    }
};
struct EpiS5C { bf16* YG;
    __device__ __forceinline__ void operator()(const pg8::f32x4 (&acc)[2][2][4][2], const pg8::Unit& u, int wr, int wc, int fr, int fq) const {
        asm volatile("" : "+v"(fr), "+v"(fq));
        const int g = u.e, n0 = wc * 32 + 8 * fq, t0 = n0 >> 4, co0 = n0 & 15;
#pragma unroll
        for (int ai = 0; ai < 2; ++ai)
#pragma unroll
            for (int m = 0; m < 4; ++m) { const int row = u.pm * 256 + ai * 128 + wr * 64 + m * 16 + fr, b = row >> 9, c = row & 511;
                bf16* yp = YG + (size_t)(b * SEQ + 16 * c + t0) * SW + 16 * g + co0;
#pragma unroll
                for (int bj = 0; bj < 2; ++bj) {
                    const pg8::f32x4 v0 = acc[ai][bj][m][0], v1 = acc[ai][bj][m][1];
                    v4u w; w.x = pk2(gelu_tanh(v0[0]), gelu_tanh(v0[1])); w.y = pk2(gelu_tanh(v0[2]), gelu_tanh(v0[3]));
                    w.z = pk2(gelu_tanh(v1[0]), gelu_tanh(v1[1])); w.w = pk2(gelu_tanh(v1[2]), gelu_tanh(v1[3]));
                    *(v4u*)(yp + (size_t)bj * 8 * SW) = w; }
                __builtin_amdgcn_sched_barrier(0); }
    }
};
__device__ __forceinline__ void s5_fill_wc(Frame& F) {
    const int gt = F.vcu * (NWAVES * 64) + F.tid, NGT = F.G * NWAVES * 64;
    const float* P5 = WSP(float, WS_S5P); const float* PWr = P5 + 131072; const float* PWi = PWr + 2048 * 17; const float* KT = WSP(float, WS_S5KT); const float* par = WSP(float, WS_PAR);
    bf16* Wc = WSP(bf16, WS_S5WC);
    for (int i = gt; i < NG * 256 * 384; i += NGT) { const int k = i % 384, n = (i / 384) & 255, g = i / (384 * 256), t = n >> 4, co = n & 15; float val = 0.f;
        if (k < 256) { const int s_ = k >> 4, ci = k & 15;
            if (s_ <= t) val = KT[((g * 16 + (t - s_)) * 16 + co) * 16 + ci];
            if (s_ == t && ci == co) val += par[PAR_SD + g * 16 + co]; }
        else { const int p = (k - 256) & 63, gp = g * 64 + p; const float cr = par[PAR_CRE + (g * 16 + co) * 64 + p], ci_ = par[PAR_CIM + (g * 16 + co) * 64 + p];
            const float wr_ = PWr[gp * 17 + t + 1], wi_ = PWi[gp * 17 + t + 1];
            val = (k < 320) ? (cr * wr_ - ci_ * wi_) : -(cr * wi_ + ci_ * wr_); }
        Wc[((size_t)(g * 256 + perm8(n))) * 384 + k] = (bf16)f2bf(val); }
}
__device__ __forceinline__ void s5_carry(Frame& F) {
    const float* P5 = WSP(float, WS_S5P); const float* PWr = P5 + 131072; const float* PWi = PWr + 2048 * 17; const float* E = WSP(float, WS_S5E); bf16* UA = WSP(bf16, WS_UA);
    LAS float* Z = (LAS float*)(F.lds);
    const int seg = F.wave, p = F.lane;
    for (int bg = F.vcu; bg < BATCH * NG; bg += F.G) { const int b = bg / NG, g = bg % NG, gp = g * 64 + p;
        const float ar = PWr[gp * 17 + 16], ai = PWi[gp * 17 + 16];
        const size_t row0 = (size_t)g * 1024 + b * 512 + seg * 64;
        float zr = 0.f, zi = 0.f;
        for (int c0 = 0; c0 < 64; c0 += 8) { float er[8], ei[8];
#pragma unroll
            for (int k = 0; k < 8; ++k) { er[k] = E[(row0 + c0 + k) * 128 + p]; ei[k] = E[(row0 + c0 + k) * 128 + 64 + p]; }
#pragma unroll
            for (int k = 0; k < 8; ++k) { const float nr = ar * zr - ai * zi + er[k], ni = ar * zi + ai * zr + ei[k]; zr = nr; zi = ni; } }
        Z[(seg * 64 + p) * 2] = zr; Z[(seg * 64 + p) * 2 + 1] = zi;
        __syncthreads();
        if (seg == 0) { float br = ar, bi = ai;
#pragma unroll
            for (int k = 0; k < 6; ++k) { const float tr = br * br - bi * bi, ti = 2.f * br * bi; br = tr; bi = ti; }
            float sr = 0.f, si = 0.f;
            for (int sg = 0; sg < 8; ++sg) { const float xr = Z[(sg * 64 + p) * 2], xi = Z[(sg * 64 + p) * 2 + 1]; Z[(sg * 64 + p) * 2] = sr; Z[(sg * 64 + p) * 2 + 1] = si;
                const float nr = br * sr - bi * si + xr, ni = br * si + bi * sr + xi; sr = nr; si = ni; } }
        __syncthreads();
        float sr = Z[(seg * 64 + p) * 2], si = Z[(seg * 64 + p) * 2 + 1];
        for (int c0 = 0; c0 < 64; c0 += 8) { float er[8], ei[8];
#pragma unroll
            for (int k = 0; k < 8; ++k) { er[k] = E[(row0 + c0 + k) * 128 + p]; ei[k] = E[(row0 + c0 + k) * 128 + 64 + p]; }
#pragma unroll
            for (int k = 0; k < 8; ++k) { bf16* up = UA + (row0 + c0 + k) * 384 + 256 + p; up[0] = (bf16)f2bf(sr); up[64] = (bf16)f2bf(si);
                const float nr = ar * sr - ai * si + er[k], ni = ar * si + ai * sr + ei[k]; sr = nr; si = ni; } }
        __syncthreads();
    }
}
constexpr int SCR_OFF = LDSCTL_OFF + 512;
__device__ __forceinline__ void phase_rows(Frame& F) {
    LAS float* WrT = (LAS float*)(F.lds);
    LAS float* gtm = (LAS float*)(F.lds + 131072);
    LAS float* pg2 = gtm + 2 * D; LAS float* shf = pg2 + 2 * D;
    LAS unsigned* hist = (LAS unsigned*)(F.lds + SCR_OFF); LAS unsigned* base = hist + 32; LAS int* rec_e = (LAS int*)(base + 32); LAS int* rec_lp = rec_e + 256;
    const float* adaf = WSP(float, WS_ADAF);
    for (int i = F.tid; i < D * NE; i += NWAVES * 64) { const int k = i >> 5, e = i & 31; WrT[e * D + k] = WSP(float, WS_PAR)[PAR_RW + i]; }
    for (int i = F.tid; i < 2 * D; i += NWAVES * 64) { const int b = i >> 10, k = i & (D - 1);
        gtm[i] = adaf[b * 6 * D + 2 * D + k] * WSP(float, WS_PAR)[PAR_MPG + k];
        pg2[i] = WSP(float, WS_PAR)[PAR_FPRE + k] * (1.f + adaf[b * 6 * D + 4 * D + k]); shf[i] = adaf[b * 6 * D + 3 * D + k]; }
    if (F.tid < 32) hist[F.tid] = 0u;
    __syncthreads();
    const float* mix = WSP(float, WS_MIX); bf16* H2 = WSP(bf16, WS_H2);
    int* tok_e = WSP(int, WS_ROUTE); float* tok_w = (float*)(tok_e + T * 4); int* tok_pos = tok_e + 2 * T * 4;
    unsigned* gcnt = (unsigned*)(F.ctl + CW_ECNT);
    const int L = F.lane;
    for (int t0 = F.vcu * 64; t0 < T; t0 += F.G * 64) {
        for (int tk = 0; tk < 8; ++tk) {
            const int tl = F.wave * 8 + tk, t = t0 + tl, b = t >> 13;
            const GAS f32x4* mr = (const GAS f32x4*)(mix + (size_t)t * D) + L; const GAS f32x4* xr = (const GAS f32x4*)(F.in[0] + (size_t)t * D) + L;
            f32x4 mv[4], xv[4]; float s = 0.f;
#pragma unroll
            for (int j = 0; j < 4; ++j) { mv[j] = mr[64 * j]; xv[j] = xr[64 * j]; s += (mv[j].x * mv[j].x + mv[j].y * mv[j].y) + (mv[j].z * mv[j].z + mv[j].w * mv[j].w); }
            const float r1 = 1.f / sqrtf(wave_sum(s) * (1.f / D) + NORM_EPS);
            float s2 = 0.f;
            GAS f32x4* orow = (GAS f32x4*)(F.out + (size_t)t * D) + L;
#pragma unroll
            for (int j = 0; j < 4; ++j) { const f32x4 g = *(const LAS f32x4*)(gtm + b * D + 4 * L + 256 * j);
                xv[j] = xv[j] + g * (mv[j] * r1); orow[64 * j] = xv[j];
                s2 += (xv[j].x * xv[j].x + xv[j].y * xv[j].y) + (xv[j].z * xv[j].z + xv[j].w * xv[j].w); }
            const float r2 = 1.f / sqrtf(wave_sum(s2) * (1.f / D) + NORM_EPS);
            GAS unsigned long long* h8 = (GAS unsigned long long*)(H2 + (size_t)t * D) + L;
#pragma unroll
            for (int j = 0; j < 4; ++j) { const f32x4 a = *(const LAS f32x4*)(pg2 + b * D + 4 * L + 256 * j), c = *(const LAS f32x4*)(shf + b * D + 4 * L + 256 * j);
                xv[j] = xv[j] * r2 * a + c;
                h8[64 * j] = (unsigned long long)pk2(xv[j].x, xv[j].y) | ((unsigned long long)pk2(xv[j].z, xv[j].w) << 32); }
            float pe[32];
#pragma unroll
            for (int e = 0; e < 32; ++e) { float a = 0.f;
#pragma unroll
                for (int j = 0; j < 4; ++j) { const f32x4 w = *(const LAS f32x4*)(WrT + e * D + 4 * L + 256 * j); a += (xv[j].x * w.x + xv[j].y * w.y) + (xv[j].z * w.z + xv[j].w * w.w); }
                pe[e] = a; }
            { const int h = (L >> 5) & 1;
#pragma unroll
              for (int k = 0; k < 16; ++k) { const float mine = h ? pe[k + 16] : pe[k], oth = h ? pe[k] : pe[k + 16]; pe[k] = mine + __shfl_xor(oth, 32); } }
            { const int h = (L >> 4) & 1;
#pragma unroll
              for (int k = 0; k < 8; ++k) { const float mine = h ? pe[k + 8] : pe[k], oth = h ? pe[k] : pe[k + 8]; pe[k] = mine + __shfl_xor(oth, 16); } }
            { const int h = (L >> 3) & 1;
#pragma unroll
              for (int k = 0; k < 4; ++k) { const float mine = h ? pe[k + 4] : pe[k], oth = h ? pe[k] : pe[k + 4]; pe[k] = mine + __shfl_xor(oth, 8); } }
            { const int h = (L >> 2) & 1;
#pragma unroll
              for (int k = 0; k < 2; ++k) { const float mine = h ? pe[k + 2] : pe[k], oth = h ? pe[k] : pe[k + 2]; pe[k] = mine + __shfl_xor(oth, 4); } }
            { const int h = (L >> 1) & 1; const float mine = h ? pe[1] : pe[0], oth = h ? pe[0] : pe[1]; pe[0] = mine + __shfl_xor(oth, 2); }
            pe[0] += __shfl_xor(pe[0], 1);
            const int myE = L >> 1;
            float val = pe[0] + WSP(float, WS_PAR)[PAR_RB + myE];
            if (L & 1) val = -3e38f;
            int se[4]; float sv[4];
#pragma unroll
            for (int r = 0; r < 4; ++r) { const float mx = wave_max(val); const unsigned long long bal = __ballot(val == mx); const int win = __ffsll((long long)bal) - 1;
                se[r] = win >> 1; sv[r] = mx; if (L == win) val = -3e38f; }
            const float e1 = __expf(sv[1] - sv[0]), e2 = __expf(sv[2] - sv[0]), e3 = __expf(sv[3] - sv[0]), inv = 1.f / (1.f + e1 + e2 + e3);
            if (L < 4) { const int e = L == 0 ? se[0] : (L == 1 ? se[1] : (L == 2 ? se[2] : se[3]));
                const float wv = (L == 0 ? 1.f : (L == 1 ? e1 : (L == 2 ? e2 : e3))) * inv;
                tok_e[t * 4 + L] = e; tok_w[t * 4 + L] = wv;
                const unsigned lp = atomicAdd((unsigned*)(hist + e), 1u);
                rec_e[tl * 4 + L] = e; rec_lp[tl * 4 + L] = (int)lp; }
        }
        __syncthreads();
        if (F.tid < 32) { const unsigned h = hist[F.tid]; base[F.tid] = h ? __hip_atomic_fetch_add(gcnt + F.tid, h, RLX_AGENT) : 0u; }
        __syncthreads();
        if (F.tid < 256) { tok_pos[(t0 + (F.tid >> 2)) * 4 + (F.tid & 3)] = (int)base[rec_e[F.tid]] + rec_lp[F.tid]; }
        __syncthreads();
        if (F.tid < 32) hist[F.tid] = 0u;
        __syncthreads();
    }
}

__device__ __forceinline__ void moe_tables(Frame& F) {
    LAS int* cnt = (LAS int*)(F.lds + SCR_OFF); LAS int* off = cnt + 32; LAS int* tpre = off + 32;
    if (F.tid == 0) { int o = 0, tp = 0;
        for (int e = 0; e < NE; ++e) { const int c = (int)__hip_atomic_load(F.ctl + CW_ECNT + e, RLX_AGENT); cnt[e] = c; off[e] = o; tpre[e] = tp; o += c; tp += (c + 255) >> 8; }
        tpre[NE] = tp; }
    __syncthreads();
}
__device__ __forceinline__ void phase_gather(Frame& F) {
    moe_tables(F);
    const LAS int* off = (const LAS int*)(F.lds + SCR_OFF) + 32;
    const int gw = F.vcu * NWAVES + F.wave, NGW = F.G * NWAVES;
    const int* tok_e = WSP(int, WS_ROUTE); const int* tok_pos = tok_e + 2 * T * 4;
    const v4u* H2 = WSP(v4u, WS_H2); v4u* XG = WSP(v4u, WS_XG);
    for (int a = gw; a < T * TOPK; a += NGW) { const int t = a >> 2, e = tok_e[a], row = off[e] + tok_pos[a];
        const v4u x0 = H2[(size_t)t * 128 + F.lane], x1 = H2[(size_t)t * 128 + 64 + F.lane];
        XG[(size_t)row * 128 + F.lane] = x0; XG[(size_t)row * 128 + 64 + F.lane] = x1; }
}
struct MoeOrder {
    const LAS int* tab; int nct, brows, G, c;
    __device__ __forceinline__ bool next(int i, pg8::Unit& u) const {
        const int L = i * G + c, total = tab[64 + NE] * nct; if (L >= total) return false;
        const int rtg = L / nct, pn = L % nct; int e = 0;
        for (int k = 1; k < NE; ++k) if (tab[64 + k] <= rtg) e = k;
        const int rt = rtg - tab[64 + e], cnt = tab[e], off = tab[32 + e];
        u.e = __builtin_amdgcn_readfirstlane(e); u.pm = rt; u.pn = pn; u.arow = __builtin_amdgcn_readfirstlane(off + rt * 256); u.brow = __builtin_amdgcn_readfirstlane(e * brows + pn * 256);
        const int nr = cnt - rt * 256; u.nrow = __builtin_amdgcn_readfirstlane(nr > 256 ? 256 : nr); return true;
    }
};
struct EpiGU { bf16* H1; const float* bg; const float* bu;
    __device__ __forceinline__ void operator()(const pg8::f32x4 (&acc)[2][2][4][2], const pg8::Unit& u, int wr, int wc, int fr, int fq) const {
        const int f0 = u.pn * 128 + wc * 32 + 8 * fq;
        const pg8::f32x4 g0 = *(const pg8::f32x4*)(bg + u.e * FF + f0), g1 = *(const pg8::f32x4*)(bg + u.e * FF + f0 + 4);
        const pg8::f32x4 u0 = *(const pg8::f32x4*)(bu + u.e * FF + f0), u1 = *(const pg8::f32x4*)(bu + u.e * FF + f0 + 4);
#pragma unroll
        for (int ai = 0; ai < 2; ++ai)
#pragma unroll
            for (int m = 0; m < 4; ++m) { const int r = ai * 128 + wr * 64 + m * 16 + fr;
                const pg8::f32x4 a0 = acc[ai][0][m][0] + g0, a1 = acc[ai][0][m][1] + g1, b0 = acc[ai][1][m][0] + u0, b1 = acc[ai][1][m][1] + u1;
                float gg[8] = {a0[0], a0[1], a0[2], a0[3], a1[0], a1[1], a1[2], a1[3]}, uu[8] = {b0[0], b0[1], b0[2], b0[3], b1[0], b1[1], b1[2], b1[3]}, o[8];
#pragma unroll
                for (int i = 0; i < 8; ++i) { const float g = fminf(gg[i], 7.f), up = fminf(fmaxf(uu[i], -7.f), 7.f); o[i] = g * sigmoidf_(1.702f * g) * (up + 1.f); }
                v4u w; w.x = pk2(o[0], o[1]); w.y = pk2(o[2], o[3]); w.z = pk2(o[4], o[5]); w.w = pk2(o[6], o[7]);
                if (r < u.nrow) *(v4u*)(H1 + (size_t)(u.arow + r) * FF + f0) = w; }
    }
};
struct EpiDn { bf16* YB; const float* bd;
    __device__ __forceinline__ void operator()(const pg8::f32x4 (&acc)[2][2][4][2], const pg8::Unit& u, int wr, int wc, int fr, int fq) const {
        const int c0 = u.pn * 256 + wc * 32 + 8 * fq;
#pragma unroll
        for (int bj = 0; bj < 2; ++bj) { const pg8::f32x4 d0 = *(const pg8::f32x4*)(bd + u.e * D + c0 + bj * 128), d1 = *(const pg8::f32x4*)(bd + u.e * D + c0 + bj * 128 + 4);
#pragma unroll
            for (int ai = 0; ai < 2; ++ai)
#pragma unroll
                for (int m = 0; m < 4; ++m) { const int r = ai * 128 + wr * 64 + m * 16 + fr;
                    const pg8::f32x4 a0 = acc[ai][bj][m][0] + d0, a1 = acc[ai][bj][m][1] + d1;
                    v4u w; w.x = pk2(a0[0], a0[1]); w.y = pk2(a0[2], a0[3]); w.z = pk2(a1[0], a1[1]); w.w = pk2(a1[2], a1[3]);
                    if (r < u.nrow) *(v4u*)(YB + (size_t)(u.arow + r) * D + c0 + bj * 128) = w; } }
    }
};
__device__ __forceinline__ void phase_final(Frame& F) {
    moe_tables(F);
    const LAS int* off = (const LAS int*)(F.lds + SCR_OFF) + 32;
    LAS float* gtf = (LAS float*)(F.lds);
    const float* adaf = WSP(float, WS_ADAF);
    for (int i = F.tid; i < 2 * D; i += NWAVES * 64) { const int b = i >> 10, k = i & (D - 1); gtf[i] = adaf[b * 6 * D + 5 * D + k] * WSP(float, WS_PAR)[PAR_FPOST + k]; }
    __syncthreads();
    const int gw = F.vcu * NWAVES + F.wave, NGW = F.G * NWAVES, L = F.lane;
    const int* tok_e = WSP(int, WS_ROUTE); const float* tok_w = (const float*)(tok_e + T * 4); const int* tok_pos = tok_e + 2 * T * 4;
    const bf16* YB = WSP(bf16, WS_YB);
    for (int t = gw; t < T; t += NGW) { const int b = t >> 13;
        f32x4 y[4];
#pragma unroll
        for (int j = 0; j < 4; ++j) y[j] = (f32x4){0.f, 0.f, 0.f, 0.f};
#pragma unroll
        for (int k = 0; k < 4; ++k) { const int e = tok_e[t * 4 + k], row = off[e] + tok_pos[t * 4 + k]; const float w = tok_w[t * 4 + k];
            const GAS v2u* yr = (const GAS v2u*)(YB + (size_t)row * D) + L;
#pragma unroll
            for (int j = 0; j < 4; ++j) { const v2u x = yr[64 * j]; y[j].x += w * bflo(x.x); y[j].y += w * bfhi(x.x); y[j].z += w * bflo(x.y); y[j].w += w * bfhi(x.y); } }
        float s = 0.f;
#pragma unroll
        for (int j = 0; j < 4; ++j) s += (y[j].x * y[j].x + y[j].y * y[j].y) + (y[j].z * y[j].z + y[j].w * y[j].w);
        const float r = 1.f / sqrtf(wave_sum(s) * (1.f / D) + NORM_EPS);
        GAS f32x4* orow = (GAS f32x4*)(F.out + (size_t)t * D) + L;
#pragma unroll
        for (int j = 0; j < 4; ++j) { const f32x4 g = *(const LAS f32x4*)(gtf + b * D + 4 * L + 256 * j); const f32x4 x1 = orow[64 * j]; orow[64 * j] = x1 + g * (y[j] * r); }
    }
}
#ifndef MK_N_LAUNCHES
#define MK_N_LAUNCHES 1
#endif
constexpr int N_PHASES = 15;
struct Args { const float* in[30]; float* out; unsigned char* ws; int ph_lo, ph_hi; };
__global__ void __launch_bounds__(NWAVES * 64, 2) mega_fwd(Args args) {
    extern __shared__ __attribute__((aligned(16))) unsigned char lds[];
    Frame F;
    F.lds = (LAS unsigned char*)lds;
    F.MISC = (volatile LAS unsigned*)(F.lds + MISC_OFF);
    F.tid = threadIdx.x; F.lane = F.tid & 63; F.wave = __builtin_amdgcn_readfirstlane(F.tid >> 6);
    F.G = gridDim.x; { const int bx = blockIdx.x; F.vcu = (F.G % 8 == 0) ? (bx % 8) * (F.G / 8) + bx / 8 : bx; }
    F.ws = args.ws; F.ctl = (gu32*)(args.ws + WS_CTL); F.out = args.out;
#pragma unroll
    for (int i = 0; i < 30; ++i) F.in[i] = args.in[i];
    for (int u = F.tid; u < (LDS_BYTES - LDSCTL_OFF) / 4; u += NWAVES * 64) ((LAS unsigned*)(F.lds + LDSCTL_OFF))[u] = 0u;
    __syncthreads();
    XcdBarrier bar; bar.bar = (unsigned*)(F.ctl + CW_BAR); bar.x = 0; bar.st = nullptr;
    if (MK_N_LAUNCHES == 1) bar = xcd_barrier_post((unsigned*)(F.ctl + CW_BAR), F.MISC + 8);
    const int lo = args.ph_lo, hi = args.ph_hi;
#ifndef PHMASK
#define PHMASK 0x7fff
#endif
#define IN(k) (((PHMASK >> (k)) & 1) && lo <= (k) && (k) < hi)
#define SEAM(k) do { if (IN(k) && IN((k) + 1)) xcd_barrier(bar); } while (0)
    PG8_LAS unsigned char* ring = F.lds + RING_OFF;
    const int bx = (int)blockIdx.x;

    if (IN(0)) { phase0(F); } SEAM(0);
    if (IN(1)) { phase1(F); } SEAM(1);
    if (IN(2)) {
        pg8::Gemm g{WSP(bf16, WS_XN), WSP(bf16, WS_WIN_T), D, D, D}; pg8::DenseOrder S; S.init(T, INW, F.G, bx);
        EpiG1 E{WSP(bf16, WS_UA), WSP(bf16, WS_Q), WSP(bf16, WS_K), WSP(bf16, WS_V), WSP(bf16, WS_VT), WSP(bf16, WS_GS), WSP(bf16, WS_GA),
                WSP(float, WS_ROPE), WSP(float, WS_ROPE) + (size_t)T * 32, (float*)(F.ctl + CW_KM)};
        pg8::gemm_phase(ring, g, S, E);
        s5_fill_wc(F);
    } SEAM(2);
    if (IN(3)) {
        pg8::Gemm g{WSP(bf16, WS_UA), WSP(bf16, WS_S5M1), 384, 256, 256}; S5Order S{F.G, bx}; EpiS5A E{WSP(float, WS_S5E)};
        pg8::gemm_phase(ring, g, S, E);
        attn_gate(F);
    } SEAM(3);
    if (IN(4)) { attn_items(F); s5_carry(F); } SEAM(4);
    if (IN(5)) {
        pg8::Gemm g{WSP(bf16, WS_UA), WSP(bf16, WS_S5WC), 384, 384, 384}; S5Order S{F.G, bx}; EpiS5C E{WSP(bf16, WS_YG)};
        pg8::gemm_phase(ring, g, S, E);
        attn_combine(F);
    } SEAM(5);
    if (IN(6)) {
        pg8::Gemm g{WSP(bf16, WS_YG), WSP(bf16, WS_WGLU_T), SW, SW, SW}; pg8::DenseOrder S; S.init(T, SW, F.G, bx);
        EpiEw<0> E{WSP(bf16, WS_Y2), WSP(bf16, WS_YG), nullptr, nullptr, SW};
        pg8::gemm_phase(ring, g, S, E);
    } SEAM(6);
    if (IN(7)) {
        pg8::Gemm g{WSP(bf16, WS_Y2), WSP(bf16, WS_WSB_T), SW, SW, SW}; pg8::DenseOrder S; S.init(T, D, F.G, bx);
        EpiEw<1> E{WSP(bf16, WS_M1), WSP(bf16, WS_GS), nullptr, nullptr, D};
        pg8::gemm_phase(ring, g, S, E);
    } SEAM(7);
    if (IN(8)) {
        pg8::Gemm g{WSP(bf16, WS_YA), WSP(bf16, WS_WAB_T), AW, AW, AW}; pg8::DenseOrder S; S.init(T, D, F.G, bx);
        EpiEw<2> E{WSP(bf16, WS_XN), WSP(bf16, WS_GA), WSP(bf16, WS_M1), nullptr, D};
        pg8::gemm_phase(ring, g, S, E);
    } SEAM(8);
    if (IN(9)) {
        pg8::Gemm g{WSP(bf16, WS_XN), WSP(bf16, WS_WOUT_T), D, D, D}; pg8::DenseOrder S; S.init(T, D, F.G, bx);
        EpiEw<3> E{nullptr, nullptr, nullptr, WSP(float, WS_MIX), D};
        pg8::gemm_phase(ring, g, S, E);
    } SEAM(9);
    if (IN(10)) { phase_rows(F); } SEAM(10);
    if (IN(11)) { phase_gather(F); } SEAM(11);
    if (IN(12)) {
        moe_tables(F);
        pg8::Gemm g{WSP(bf16, WS_XG), WSP(bf16, WS_WGU_T), D, D, D}; MoeOrder S{(const LAS int*)(F.lds + SCR_OFF), 8, 2048, F.G, bx};
        EpiGU E{WSP(bf16, WS_H1), WSP(float, WS_PAR) + PAR_BG, WSP(float, WS_PAR) + PAR_BU};
        pg8::gemm_phase(ring, g, S, E);
    } SEAM(12);
    if (IN(13)) {
        moe_tables(F);
        pg8::Gemm g{WSP(bf16, WS_H1), WSP(bf16, WS_WDN_T), FF, FF, FF}; MoeOrder S{(const LAS int*)(F.lds + SCR_OFF), 4, 1024, F.G, bx};
        EpiDn E{WSP(bf16, WS_YB), WSP(float, WS_PAR) + PAR_BD};
        pg8::gemm_phase(ring, g, S, E);
    } SEAM(13);
    if (IN(14)) { phase_final(F); }
#undef IN
#undef SEAM
}

extern "C" void kernel_launch(void* const* d_in, const int* in_sizes, int n_in, void* d_out, int out_size, void* d_ws, size_t ws_size, hipStream_t stream) {
    static int grid = 0;
    if (grid == 0) {
        if (n_in != 30 || in_sizes[0] != T * D || out_size != T * D || ws_size < WS_END) { fprintf(stderr, "kernel_launch: unexpected shapes (n_in %d, in0 %d, out %d, ws %zu)\n", n_in, n_in > 0 ? in_sizes[0] : -1, out_size, ws_size); grid = -1; return; }
        int dev = 0, cus = 0, per_cu = 0;
        if (hipGetDevice(&dev) != hipSuccess || hipDeviceGetAttribute(&cus, hipDeviceAttributeMultiprocessorCount, dev) != hipSuccess) { grid = -1; return; }
        if (hipFuncSetAttribute((const void*)mega_fwd, hipFuncAttributeMaxDynamicSharedMemorySize, LDS_BYTES) != hipSuccess) { fprintf(stderr, "kernel_launch: hipFuncSetAttribute failed\n"); grid = -1; return; }
        if (hipOccupancyMaxActiveBlocksPerMultiprocessor(&per_cu, (const void*)mega_fwd, NWAVES * 64, LDS_BYTES) != hipSuccess || per_cu < 1) { fprintf(stderr, "kernel_launch: occupancy query says %d\n", per_cu); }
        (void)hipGetLastError();
        grid = cus;
    }
    if (grid < 0) return;
    (void)hipMemsetAsync((char*)d_ws + WS_CTL, 0, CTL_ZERO_BYTES, stream);
    Args a{};
    for (int i = 0; i < 30; ++i) a.in[i] = (const float*)d_in[i];
    a.out = (float*)d_out; a.ws = (unsigned char*)d_ws;
    if (MK_N_LAUNCHES == 1) { a.ph_lo = 0; a.ph_hi = N_PHASES; hipLaunchKernelGGL(mega_fwd, dim3(grid), dim3(NWAVES * 64), LDS_BYTES, stream, a); }
    else for (int p = 0; p < N_PHASES; ++p) { a.ph_lo = p; a.ph_hi = p + 1; hipLaunchKernelGGL(mega_fwd, dim3(grid), dim3(NWAVES * 64), LDS_BYTES, stream, a); }
}
```

```cpp
#include <hip/hip_runtime.h>
#include <cstdio>
#include <cstdint>
#define MK_N_LAUNCHES 1
namespace pg8 {
#define PG8_LAS __attribute__((address_space(3)))
typedef unsigned short bf16_t;
typedef short bf16x8 __attribute__((ext_vector_type(8)));
typedef float f32x4 __attribute__((ext_vector_type(4)));
typedef unsigned u32x4 __attribute__((ext_vector_type(4)));
typedef unsigned u32x2 __attribute__((ext_vector_type(2)));
constexpr int BM = 256, BK = 64, HALF = 128, HTB = HALF * BK * 2  , STAGE_BYTES = 8 * HTB, NXCD = 8, WGM = 8;

__host__ __device__ __forceinline__ int lds_byte(int r, int c) { const int st = (r >> 4) * 2 + (c >> 5), rr = r & 15, cc = c & 31, ob = rr * 64 + cc * 2; return st * 1024 + (ob ^ (((ob >> 9) & 1) << 5)); }
__host__ __device__ __forceinline__ void stage_rc(int b, int& R, int& C) { const int st = b / 1024, sb = b % 1024, swz = sb ^ (((sb >> 9) & 1) << 5); R = (st >> 1) * 16 + swz / 64; C = (st & 1) * 32 + (swz % 64) / 2; }

struct Unit { int arow, brow, pm, pn, e, nrow, kind, aux; };
struct Gemm { const bf16_t* A; const bf16_t* Bt; int lda, ldb, K; };

struct DenseOrder {
    static constexpr bool GATHER = false;
    __device__ __forceinline__ void a_ready(const Unit&) const {}
    __device__ __forceinline__ void done(const Unit&) const {}
    int nM, nN, nwg, G, c;
    __device__ __forceinline__ void init(int M, int N, int G_, int c_) { nM = M / BM; nN = N / BM; nwg = nM * nN; G = G_; c = c_; }
    __device__ __forceinline__ bool next(int i, Unit& u) const {
        const long L = (long)i * G + c; if (L >= nwg) return false;
        int wgid = (int)L; { const int q = nwg / NXCD, r = nwg % NXCD, xcd = wgid % NXCD, off = wgid / NXCD; wgid = (xcd < r ? xcd * (q + 1) : r * (q + 1) + (xcd - r) * q) + off; }
        const int nig = WGM * nN, gid = wgid / nig, fm = gid * WGM, gsz = (nM - fm) < WGM ? (nM - fm) : WGM;
        u.pm = fm + ((wgid % nig) % gsz); u.pn = (wgid % nig) / gsz; u.arow = u.pm * BM; u.brow = u.pn * BM; u.e = 0; u.nrow = BM; u.kind = 0; u.aux = 0; return true;
    }
};

template <class Epi, class Sched>
__device__ __forceinline__ int gemm_phase(PG8_LAS unsigned char* lds, const Gemm g, const Sched& S, const Epi& E) {
    const int tid = threadIdx.x, wid = __builtin_amdgcn_readfirstlane(tid >> 6), lane = tid & 63, wr = wid >> 2, wc = wid & 3, fr = lane & 15, fq = lane >> 4;
    const int K = g.K, nt = K / BK;
    constexpr bool GA = Sched::GATHER;
    unsigned voffA[2], voffB[2]; int gR[2]; unsigned gC[2];
#pragma unroll
    for (int i = 0; i < 2; ++i) { int R, C; stage_rc(tid * 16 + i * 8192, R, C); gR[i] = R; gC[i] = (unsigned)C * 2u;
        voffA[i] = (unsigned)(R * g.lda + C) * 2u; voffB[i] = (unsigned)(R * g.ldb + C) * 2u; }
    unsigned gA_cur[2][2], gA_nxt[2][2];
#define PG8_GATH(dst, un) do { _Pragma("unroll") for (int _h = 0; _h < 2; ++_h) _Pragma("unroll") for (int _i = 0; _i < 2; ++_i) dst[_h][_i] = (unsigned)S.arow_of(un, _h * HALF + gR[_i]) * (unsigned)(g.lda * 2) + gC[_i]; } while (0)
#define PG8_STAGE_A(bufoff, h, kbytes, nx) do { if constexpr (GA) { const char* gb_ = (const char*)g.A + (kbytes); _Pragma("unroll") for (int _i = 0; _i < 2; ++_i) { const unsigned vo_ = (nx) ? gA_nxt[h][_i] : gA_cur[h][_i]; \
        __builtin_amdgcn_global_load_lds((const unsigned*)(gb_ + vo_), (PG8_LAS unsigned*)(lds + (bufoff) + ldsw + _i * 8192), 16, 0, 0); } } \
    else { const char* gb_ = ((nx) ? nA : cA) + (kbytes) + (h) * hstepA; PG8_STAGE(bufoff, gb_, voffA); } } while (0)
    const size_t kstep = (size_t)(BK * 2);
    const size_t hstepA = (size_t)HALF * g.lda * 2, hstepB = (size_t)HALF * g.ldb * 2;
    const size_t rowA = (size_t)g.lda * 2, rowB = (size_t)g.ldb * 2;
    const unsigned ldsw = (unsigned)wid * 1024u;
    const int aoff = lds_byte(wr * 64 + fr, fq * 8), boff = lds_byte(wc * 32 + fr, fq * 8);
#define PG8_SA(b, h) (((b) * 2 + (h)) * HTB)
#define PG8_SB(b, h) ((4 + (b) * 2 + (h)) * HTB)
#define PG8_STAGE(bufoff, gbase, voff) do { _Pragma("unroll") for (int _i = 0; _i < 2; ++_i) \
        __builtin_amdgcn_global_load_lds((const unsigned*)((const char*)(gbase) + (voff)[_i]), (PG8_LAS unsigned*)(lds + (bufoff) + ldsw + _i * 8192), 16, 0, 0); } while (0)
#define PG8_LDA(dst, b, h) do { _Pragma("unroll") for (int m = 0; m < 4; ++m) _Pragma("unroll") for (int k = 0; k < 2; ++k) dst[m][k] = *(const PG8_LAS bf16x8*)(lds + PG8_SA(b, h) + aoff + m * 2048 + k * 1024); } while (0)
#define PG8_LDB(dst, b, h) do { _Pragma("unroll") for (int n = 0; n < 2; ++n) _Pragma("unroll") for (int k = 0; k < 2; ++k) dst[n][k] = *(const PG8_LAS bf16x8*)(lds + PG8_SB(b, h) + boff + n * 2048 + k * 1024); } while (0)
#define PG8_MMA(ai, bj, At, Bt) do { __builtin_amdgcn_s_setprio(1); _Pragma("unroll") for (int m = 0; m < 4; ++m) _Pragma("unroll") for (int n = 0; n < 2; ++n) _Pragma("unroll") for (int k = 0; k < 2; ++k) \
        acc[ai][bj][m][n] = __builtin_amdgcn_mfma_f32_16x16x32_bf16(Bt[n][k], At[m][k], acc[ai][bj][m][n], 0, 0, 0); __builtin_amdgcn_s_setprio(0); } while (0)
#define PG8_WAIT_V(n) asm volatile("s_waitcnt vmcnt(" #n ")" ::: "memory")
#define PG8_WAIT_L(n) asm volatile("s_waitcnt lgkmcnt(" #n ")" ::: "memory")
#define PG8_BAR __builtin_amdgcn_s_barrier()
#define PG8_SCHED __builtin_amdgcn_sched_barrier(0)
    Unit cur, nxt; int ui = 0;
    if (!S.next(0, cur)) return 0;
    f32x4 acc[2][2][4][2];
#pragma unroll
    for (int a = 0; a < 2; ++a)
#pragma unroll
        for (int b = 0; b < 2; ++b)
#pragma unroll
            for (int m = 0; m < 4; ++m)
#pragma unroll
                for (int n = 0; n < 2; ++n) acc[a][b][m][n] = (f32x4){0.f, 0.f, 0.f, 0.f};
    bf16x8 At[4][2], B0[2][2], B1[2][2];
    const char* cA = GA ? (const char*)g.A : (const char*)g.A + (size_t)cur.arow * rowA; const char* cB = (const char*)g.Bt + (size_t)cur.brow * rowB; const char* nA = cA;
    if constexpr (GA) { PG8_GATH(gA_cur, cur); }
    S.a_ready(cur);
    PG8_STAGE(PG8_SB(0, 0), cB, voffB); PG8_STAGE(PG8_SB(0, 1), cB + hstepB, voffB); PG8_STAGE_A(PG8_SA(0, 0), 0, 0, false); PG8_STAGE_A(PG8_SA(0, 1), 1, 0, false);
    if (wr == 1) PG8_BAR;
    PG8_WAIT_V(2); PG8_BAR;
    PG8_STAGE(PG8_SB(1, 0), cB + kstep, voffB); PG8_STAGE_A(PG8_SA(1, 0), 0, kstep, false); PG8_STAGE(PG8_SB(1, 1), cB + hstepB + kstep, voffB);
    PG8_WAIT_V(6); PG8_BAR;
    for (;;) {
        const bool has_next = S.next(ui + 1, nxt);
        nA = GA ? cA : (has_next ? (const char*)g.A + (size_t)nxt.arow * rowA : cA); const char* nB = has_next ? (const char*)g.Bt + (size_t)nxt.brow * rowB : cB;
        if constexpr (GA) { if (has_next) { PG8_GATH(gA_nxt, nxt); } else { _Pragma("unroll") for (int _h = 0; _h < 2; ++_h) _Pragma("unroll") for (int _i = 0; _i < 2; ++_i) gA_nxt[_h][_i] = gA_cur[_h][_i]; } }
#pragma unroll 1
        for (int t = 0; t < nt; t += 2) {
            const bool last = (t == nt - 2);
            if (last && has_next) S.a_ready(nxt);
            const size_t k1 = (size_t)(t + 1) * kstep, k2 = last ? (size_t)0 : (size_t)(t + 2) * kstep, k3 = k2 + kstep;
            const char* b2 = last ? nB : cB + (size_t)(t + 2) * kstep; const char* b3 = b2 + kstep;
            PG8_LDB(B0, 0, 0); PG8_LDB(B1, 0, 1); PG8_SCHED; PG8_LDA(At, 0, 0); PG8_STAGE_A(PG8_SA(1, 1), 1, k1, false);
            PG8_WAIT_V(8); PG8_WAIT_L(0); PG8_BAR; PG8_MMA(0, 0, At, B0); PG8_MMA(0, 1, At, B1); PG8_BAR; PG8_SCHED;
            PG8_LDA(At, 0, 1); PG8_STAGE(PG8_SB(0, 0), b2, voffB); PG8_STAGE(PG8_SB(0, 1), b2 + hstepB, voffB); PG8_STAGE_A(PG8_SA(0, 0), 0, k2, last);
            PG8_WAIT_V(8); PG8_WAIT_L(0); PG8_BAR; PG8_MMA(1, 0, At, B0); PG8_MMA(1, 1, At, B1); PG8_BAR; PG8_SCHED;
            PG8_LDB(B0, 1, 0); PG8_LDB(B1, 1, 1); PG8_SCHED; PG8_LDA(At, 1, 0); PG8_STAGE_A(PG8_SA(0, 1), 1, k2, last);
            PG8_WAIT_V(8); PG8_WAIT_L(0); PG8_BAR; PG8_MMA(0, 0, At, B0); PG8_MMA(0, 1, At, B1); PG8_BAR; PG8_SCHED;
            PG8_LDA(At, 1, 1); PG8_STAGE(PG8_SB(1, 0), b3, voffB); PG8_STAGE(PG8_SB(1, 1), b3 + hstepB, voffB); PG8_STAGE_A(PG8_SA(1, 0), 0, k3, last);
            PG8_WAIT_V(8); PG8_WAIT_L(0); PG8_BAR; PG8_MMA(1, 0, At, B0); PG8_MMA(1, 1, At, B1); PG8_BAR; PG8_SCHED;
        }
        if (wr == 0) PG8_BAR;
        E(acc, cur, wr, wc, fr, fq);
        S.done(cur);
        if (!has_next) break;
#pragma unroll
        for (int a = 0; a < 2; ++a)
#pragma unroll
            for (int b = 0; b < 2; ++b)
#pragma unroll
                for (int m = 0; m < 4; ++m)
#pragma unroll
                    for (int n = 0; n < 2; ++n) acc[a][b][m][n] = (f32x4){0.f, 0.f, 0.f, 0.f};
        cur = nxt; cA = nA; cB = nB; ++ui;
        if constexpr (GA) { _Pragma("unroll") for (int _h = 0; _h < 2; ++_h) _Pragma("unroll") for (int _i = 0; _i < 2; ++_i) gA_cur[_h][_i] = gA_nxt[_h][_i]; }
        if (wr == 1) PG8_BAR;
    }
    PG8_WAIT_V(0);
    PG8_BAR;
    const int n_done_ = ui + 1;
#undef PG8_SA
#undef PG8_SB
#undef PG8_STAGE
#undef PG8_STAGE_A
#undef PG8_GATH
#undef PG8_LDA
#undef PG8_LDB
#undef PG8_MMA
#undef PG8_WAIT_V
#undef PG8_WAIT_L
#undef PG8_BAR
#undef PG8_SCHED
    return n_done_;
}
}
constexpr int NWAVES = 8;
constexpr int BATCH = 2, SEQ = 8192, T = BATCH * SEQ, D = 1024, NH = 8, HD = 64, AW = 512, SW = 512, NG = 32, NP = 64, GS16 = 16;
constexpr int NE = 32, FF = 1024, INW = 4096, TOPK = 4, NBLK = SEQ / 256;
constexpr float NORM_EPS = 1e-6f;
constexpr float C2 = 0.125f * 1.4426950408889634f;
constexpr int XROWS = T * TOPK + 256;

constexpr size_t MiB = 1u << 20;
constexpr size_t WS_CTL = 0, CTL_ZERO_BYTES = 1 * MiB;
constexpr size_t WS_ADA = 1 * MiB;
constexpr size_t WS_ADAF = WS_ADA + 832 * 1024;
constexpr size_t WS_ROPE = 2 * MiB;
constexpr size_t WS_S5P = 6 * MiB;
constexpr size_t WS_S5KT = 7 * MiB;
constexpr size_t WS_S5M1 = 10 * MiB;
constexpr size_t WS_S5WC = 506 * MiB;
constexpr size_t WS_S5E = 408 * MiB;
constexpr size_t WS_ROUTE = 9 * MiB;
constexpr size_t WS_ELIST = 14 * MiB; constexpr int ELCAP = T;
constexpr size_t WS_WIN_T = 18 * MiB, WS_WGLU_T = 26 * MiB, WS_WSB_T = 27 * MiB, WS_WAB_T = 28 * MiB, WS_WOUT_T = 29 * MiB;
constexpr size_t WS_PAR = 16 * MiB;
constexpr int PAR_MPG = 0, PAR_FPRE = 1024, PAR_FPOST = 2048, PAR_RB = 3072, PAR_RW = 4096, PAR_BG = 36864, PAR_BU = 69632, PAR_BD = 102400, PAR_CRE = 135168, PAR_CIM = 167936, PAR_SD = 200704, PAR_BRE = 201728, PAR_BIM = 234496;
constexpr size_t WS_WGU_T = 32 * MiB, WS_WDN_T = 160 * MiB;
constexpr size_t WS_XN = 224 * MiB;
constexpr size_t WS_UA = 256 * MiB, WS_Q = 280 * MiB, WS_K = 296 * MiB, WS_V = 312 * MiB, WS_VT = 328 * MiB;
constexpr size_t WS_MIX = 256 * MiB;
constexpr size_t WS_GS = 344 * MiB, WS_GA = 376 * MiB;
constexpr size_t WS_YG = 408 * MiB, WS_Y2 = 424 * MiB, WS_YA = 440 * MiB;
constexpr size_t WS_M1 = 456 * MiB;
constexpr size_t WS_H2 = 480 * MiB;
constexpr size_t WS_XG = 224 * MiB, WS_YB = 224 * MiB;
constexpr size_t WS_H1 = 352 * MiB;
constexpr size_t WS_END = 512 * MiB;
static_assert(WS_YB + (size_t)T * TOPK * D * 2 <= WS_H1 && WS_H1 + (size_t)T * TOPK * FF * 2 <= WS_H2 && WS_H2 + (size_t)T * D * 2 <= WS_END, "ws map");
constexpr int CW_TMO = 0, CW_CODE = 1, CW_BAR = 4096, CW_ECNT = 8192, CW_KM = 16384;
constexpr size_t CTL_ZERO_USED = (size_t)(CW_KM + BATCH * NH * NBLK * HD) * 4;
static_assert(CTL_ZERO_USED <= CTL_ZERO_BYTES, "ctl");

constexpr int RING_OFF = 0, RING_BYTES = 131072;
constexpr int LDSCTL_OFF = 152 * 1024, MISC_OFF = LDSCTL_OFF + 320;
constexpr int LDS_BYTES = 156 * 1024;

#define GAS __attribute__((address_space(1)))
#define LAS __attribute__((address_space(3)))
typedef unsigned short bf16;
typedef unsigned v4u __attribute__((ext_vector_type(4)));
typedef unsigned v2u __attribute__((ext_vector_type(2)));
typedef float f32x4 __attribute__((ext_vector_type(4)));
typedef GAS unsigned gu32;
#define RLX_AGENT __ATOMIC_RELAXED, __HIP_MEMORY_SCOPE_AGENT
#define LDS_WAIT() asm volatile("s_waitcnt lgkmcnt(0)" ::: "memory")
#define VM_WAIT() asm volatile("s_waitcnt vmcnt(0)" ::: "memory")
__device__ __forceinline__ unsigned f2bf(float f) { unsigned u = __builtin_bit_cast(unsigned, f); return (u + 0x7fffu + ((u >> 16) & 1u)) >> 16; }
__device__ __forceinline__ unsigned pk2(float lo, float hi) { typedef float f32x2_t __attribute__((ext_vector_type(2))); typedef __bf16 bf16x2_t __attribute__((ext_vector_type(2)));
    f32x2_t v = {lo, hi}; bf16x2_t r = __builtin_convertvector(v, bf16x2_t); return __builtin_bit_cast(unsigned, r); }
__device__ __forceinline__ float bflo(unsigned w) { return __builtin_bit_cast(float, w << 16); }
__device__ __forceinline__ float bfhi(unsigned w) { return __builtin_bit_cast(float, w & 0xffff0000u); }
__device__ __forceinline__ float bf2f(bf16 h) { return __builtin_bit_cast(float, (unsigned)h << 16); }
__device__ __forceinline__ float sigmoidf_(float x) { return 1.f / (1.f + __expf(-x)); }
__device__ __forceinline__ float gelu_tanh(float x) { const float u = 1.5957691216057308f * (x + 0.044715f * x * x * x); return x / (1.f + __expf(-u)); }

#define XB_TMO      128
#define XB_XCNT(j)  (256  + 64 * (j))
#define XB_XSUB(j)  (1280 + 64 * (j))
#define XB_XGEN(j)  (2304 + 64 * (j))
#define XB_TOP      3328
#define XB_TOPGEN   3392
#define XCD_BAR_WORDS 3456
#define XB_SPIN_CAP (1u << 18)
__device__ __forceinline__ unsigned xb_ld(unsigned* p)              { return __hip_atomic_load(p, __ATOMIC_RELAXED, __HIP_MEMORY_SCOPE_AGENT); }
__device__ __forceinline__ unsigned xb_add(unsigned* p, unsigned v) { return __hip_atomic_fetch_add(p, v, __ATOMIC_RELAXED, __HIP_MEMORY_SCOPE_AGENT); }
__device__ __forceinline__ unsigned xb_xcc_id() { return (unsigned)__builtin_amdgcn_s_getreg((3 << 11) | 20) & 0xFu; }
#define XB_SPIN(cond, bar) do { unsigned _sp = 0; while (cond) { __builtin_amdgcn_s_sleep(1); \
    if ((++_sp & 255u) == 0u) { if (xb_ld(&(bar)[XB_TMO])) break; if (_sp > XB_SPIN_CAP) { atomicAdd(&(bar)[XB_TMO], 1u); break; } } } } while (0)
struct XcdBarrier { unsigned* bar; unsigned x; volatile LAS unsigned* st; };
__device__ __forceinline__ XcdBarrier xcd_barrier_post(unsigned* bar, volatile LAS unsigned* st) {
    XcdBarrier b; b.bar = bar; b.x = xb_xcc_id(); b.st = st;
    if (threadIdx.x == 0) (void)xb_add(&bar[XB_XCNT(b.x)], 1u);
    return b;
}
__device__ __forceinline__ void xcd_barrier_complete(unsigned* bar, unsigned x, unsigned& nloc, unsigned& nx) {
    const unsigned G = gridDim.x * gridDim.y * gridDim.z;
    unsigned sum, cnt, mine, sp = 0u;
    for (;;) {
        sum = 0u; cnt = 0u; mine = 0u;
#pragma unroll
        for (unsigned j = 0; j < 16; ++j) { const unsigned c = xb_ld(&bar[XB_XCNT(j)]); sum += c; cnt += (c > 0u) ? 1u : 0u; mine = (j == x) ? c : mine; }
        if (sum == G) break;
        __builtin_amdgcn_s_sleep(1);
        if ((++sp & 255u) == 0u) { if (xb_ld(&bar[XB_TMO])) break; if (sp > XB_SPIN_CAP) { atomicAdd(&bar[XB_TMO], 1u); break; } }
    }
    nloc = mine > 0u ? mine : 1u; nx = cnt > 0u ? cnt : 1u;
}
__device__ __forceinline__ void xcd_barrier(const XcdBarrier& b) {
    asm volatile("s_waitcnt vmcnt(0)" ::: "memory");
    __syncthreads();
    if (threadIdx.x == 0) {
        unsigned* bar = b.bar;
        __builtin_amdgcn_s_waitcnt(0);
        unsigned nloc = b.st[0], nx = b.st[1];
        if (nloc == 0u) { xcd_barrier_complete(bar, b.x, nloc, nx); b.st[0] = nloc; b.st[1] = nx; }
        const unsigned old = xb_add(&bar[XB_XSUB(b.x)], 1u);
        const unsigned gen = old / nloc;
        if (old + 1u == (gen + 1u) * nloc) {
            __builtin_amdgcn_fence(__ATOMIC_RELEASE, "agent");
            asm volatile("s_waitcnt vmcnt(0)" ::: "memory");
            const unsigned og = xb_add(&bar[XB_TOP], 1u);
            const unsigned tg = og / nx;
            if (og + 1u == (tg + 1u) * nx) xb_add(&bar[XB_TOPGEN], 1u);
            else XB_SPIN(xb_ld(&bar[XB_TOPGEN]) == tg, bar);
            __builtin_amdgcn_fence(__ATOMIC_ACQUIRE, "agent");
            xb_add(&bar[XB_XGEN(b.x)], 1u);
            asm volatile("s_waitcnt vmcnt(0)" ::: "memory");
        } else {
            XB_SPIN(xb_ld(&bar[XB_XGEN(b.x)]) == gen, bar);
            __builtin_amdgcn_fence(__ATOMIC_ACQUIRE, "agent");
            asm volatile("s_waitcnt vmcnt(0)" ::: "memory");
        }
    }
    __syncthreads();
}

__device__ __forceinline__ float wave_sum(float v) {
#pragma unroll
    for (int o = 1; o < 64; o <<= 1) v += __shfl_xor(v, o);
    return v;
}
__device__ __forceinline__ float wave_max(float v) {
#pragma unroll
    for (int o = 1; o < 64; o <<= 1) v = fmaxf(v, __shfl_xor(v, o));
    return v;
}
struct Frame {
    LAS unsigned char* lds;
    volatile LAS unsigned* MISC;
    gu32* ctl;
    int tid, lane, wave;
    int vcu, G;
    unsigned char* ws;
    const float* in[30];
    float* out;
};
#define WSP(T_, off) ((T_*)(F.ws + (off)))

__device__ __forceinline__ int perm8(int c) { return (c & ~31) + 16 * ((c >> 2) & 1) + 4 * ((c >> 3) & 3) + (c & 3); }
struct MapP8 { int off; __device__ __forceinline__ int operator()(int n) const { return off + perm8(n); } };
struct MapWin { __device__ __forceinline__ int operator()(int c) const {
    if (c < 512 || c >= 1536) return perm8(c);
    const int base = (c < 1024) ? 512 : 1024, cc = c - base, head = cc >> 6, d = cc & 63, pnq = head >> 2, hh = head & 3, n = d >> 5, dd = d & 31;
    const int wc = 2 * (hh & 1) + (dd >> 4), bj = hh >> 1, j = dd & 15;
    return base + 256 * pnq + 128 * bj + 32 * wc + 16 * n + j; } };
struct MapGU { int e, up; __device__ __forceinline__ int operator()(int f) const { return e * 2048 + (f >> 7) * 256 + up * 128 + perm8(f & 127); } };

template <class RowMap>
__device__ __forceinline__ void p0_transpose_item(const float* W, int K, int N, bf16* WT, LAS float* scr, int item, int lane, const RowMap rm) {
    const int nblk = N / 64, kb = item / nblk, nb = item % nblk, k0 = 64 * kb, n0 = 64 * nb;
    const int lr = lane >> 4, lc = 4 * (lane & 15);
    f32x4 v[16];
#pragma unroll
    for (int i = 0; i < 16; ++i) v[i] = __builtin_nontemporal_load((const GAS f32x4*)(W + (size_t)(k0 + 4 * i + lr) * N + n0 + lc));
#pragma unroll
    for (int i = 0; i < 16; ++i) { LAS float* d = scr + (4 * i + lr) * 65 + lc; d[0] = v[i].x; d[1] = v[i].y; d[2] = v[i].z; d[3] = v[i].w; }
    LDS_WAIT(); asm volatile("" ::: "memory");
    const int c = lane & 7;
#pragma unroll
    for (int j = 0; j < 8; ++j) { const int n = (lane >> 3) + 8 * j; const LAS float* s = scr + (8 * c) * 65 + n;
        v4u o; o.x = pk2(s[0 * 65], s[1 * 65]); o.y = pk2(s[2 * 65], s[3 * 65]); o.z = pk2(s[4 * 65], s[5 * 65]); o.w = pk2(s[6 * 65], s[7 * 65]);
        __builtin_nontemporal_store(o, (GAS v4u*)(WT + (size_t)rm(n0 + n) * K + k0 + 8 * c)); }
    LDS_WAIT(); asm volatile("" ::: "memory");
}

__device__ __forceinline__ void phase0(Frame& F) {
    LAS float* scr = (LAS float*)(F.lds + RING_OFF + F.wave * 16640);
    const int gw = F.vcu * NWAVES + F.wave, NGW = F.G * NWAVES;
    constexpr int I_WIN = 16 * 64, I_GLU = 8 * 8, I_SB = 8 * 16, I_AB = 8 * 16, I_OUT = 16 * 16, I_E = 16 * 16;
    constexpr int I_SMALL = I_WIN + I_GLU + I_SB + I_AB + I_OUT, I_MOE = 3 * NE * I_E, I_ADA = 16 * 96;
    constexpr int NITEMS = I_SMALL + I_MOE + I_ADA;
    for (int it = gw; it < NITEMS; it += NGW) {
        int r = it;
        if (r < I_WIN) { p0_transpose_item(F.in[9], D, INW, WSP(bf16, WS_WIN_T), scr, r, F.lane, MapWin{}); continue; } r -= I_WIN;
        if (r < I_GLU) { p0_transpose_item(F.in[18], SW, SW, WSP(bf16, WS_WGLU_T), scr, r, F.lane, MapP8{0}); continue; } r -= I_GLU;
        if (r < I_SB) { p0_transpose_item(F.in[19], SW, D, WSP(bf16, WS_WSB_T), scr, r, F.lane, MapP8{0}); continue; } r -= I_SB;
        if (r < I_AB) { p0_transpose_item(F.in[20], AW, D, WSP(bf16, WS_WAB_T), scr, r, F.lane, MapP8{0}); continue; } r -= I_AB;
        if (r < I_OUT) { p0_transpose_item(F.in[21], D, D, WSP(bf16, WS_WOUT_T), scr, r, F.lane, MapP8{0}); continue; } r -= I_OUT;
        if (r < I_MOE) {
            const int mat = r / I_E, item = r % I_E, kind = mat / NE, e = mat % NE;
            if (kind == 0) p0_transpose_item(F.in[24] + (size_t)e * D * FF, D, FF, WSP(bf16, WS_WGU_T), scr, item, F.lane, MapGU{e, 0});
            else if (kind == 1) p0_transpose_item(F.in[26] + (size_t)e * D * FF, D, FF, WSP(bf16, WS_WGU_T), scr, item, F.lane, MapGU{e, 1});
            else p0_transpose_item(F.in[28] + (size_t)e * FF * D, FF, D, WSP(bf16, WS_WDN_T), scr, item, F.lane, MapP8{e * 1024});
            continue; }
        r -= I_MOE;
        {
            const int ks = r / 96, cc = r % 96, n = cc * 64 + F.lane;
            const float* cvec = F.in[1]; const float* aw = F.in[3];
            float a0 = 0.f, a1 = 0.f;
            for (int k = ks * 64; k < ks * 64 + 64; ++k) {
                const float c0 = cvec[k], c1 = cvec[D + k];
                const float s0 = c0 / (1.f + __expf(-c0)), s1 = c1 / (1.f + __expf(-c1));
                const float w = __builtin_nontemporal_load(aw + (size_t)k * (6 * D) + n);
                a0 += s0 * w; a1 += s1 * w; }
            float* part = WSP(float, WS_ADA);
            part[(ks * 2 + 0) * (6 * D) + n] = a0; part[(ks * 2 + 1) * (6 * D) + n] = a1;
        }
    }
    const int gt = F.vcu * (NWAVES * 64) + F.tid, NGT = F.G * NWAVES * 64;
    { const int* pos = (const int*)F.in[2]; float* rc = WSP(float, WS_ROPE); float* rs = rc + (size_t)T * 32;
      for (int i = gt; i < T * 32; i += NGT) { const int t = i >> 5, p = i & 31;
          const float invf = exp2f(-(float)p * (13.287712379549449f / 32.f));
          const double ang = (double)pos[t] * (double)invf; double rev = ang * 0.15915494309189535; rev -= floor(rev);
          const float fr = (float)rev;
          rc[i] = __builtin_amdgcn_cosf(fr); rs[i] = __builtin_amdgcn_sinf(fr); } }
    { float* P5 = WSP(float, WS_S5P);
      for (int i = gt; i < NG * NP; i += NGT) { const int g = i >> 6;
          const float dt = __expf(F.in[12][g]); const float lr = F.in[10][i], li = F.in[11][i];
          const float er = __expf(lr * dt); const double ang = (double)li * (double)dt; double rev = ang * 0.15915494309189535; rev -= floor(rev);
          const float cs = __builtin_amdgcn_cosf((float)rev), sn = __builtin_amdgcn_sinf((float)rev);
          float br = er * cs, bi = er * sn;
          P5[i] = br; P5[2048 + i] = bi;
          const float nr = br - 1.f, ni = bi, den = lr * lr + li * li;
          const float qr = (nr * lr + ni * li) / den, qi = (ni * lr - nr * li) / den;
          P5[8192 + i] = qr; P5[8192 + 2048 + i] = qi;
          float pr = br, pi_ = bi;
#pragma unroll
          for (int s = 0; s < 8; ++s) { const float tr = pr * pr - pi_ * pi_, ti = 2.f * pr * pi_; pr = tr; pi_ = ti; }
          P5[4096 + i] = pr; P5[6144 + i] = pi_;
          float* PW = P5 + 131072;
          float wr_ = 1.f, wi_ = 0.f;
#pragma unroll
          for (int k = 0; k <= 16; ++k) { PW[i * 17 + k] = wr_; PW[2048 * 17 + i * 17 + k] = wi_; const float tr = wr_ * br - wi_ * bi, ti = wr_ * bi + wi_ * br; wr_ = tr; wi_ = ti; } }
    }
}

__device__ __forceinline__ void phase1(Frame& F) {
    LAS float* A1 = (LAS float*)(F.lds + RING_OFF); LAS float* A2 = A1 + 2 * D;
    const float* part = WSP(float, WS_ADA); const float* ab = F.in[4]; const float* pg = F.in[5];
    for (int k = F.tid; k < D; k += NWAVES * 64)
#pragma unroll
        for (int b = 0; b < 2; ++b) { float sh = ab[k], sc = ab[D + k];
            for (int ks = 0; ks < 16; ++ks) { sh += part[(ks * 2 + b) * (6 * D) + k]; sc += part[(ks * 2 + b) * (6 * D) + D + k]; }
            A1[b * D + k] = pg[k] * (1.f + sc); A2[b * D + k] = sh; }
    const int gt = F.vcu * (NWAVES * 64) + F.tid, NGT = F.G * NWAVES * 64;
    { float* adaf = WSP(float, WS_ADAF);
      for (int n = gt; n < 2 * 6 * D; n += NGT) { const int b = n / (6 * D), j = n % (6 * D); float a = ab[j];
          for (int ks = 0; ks < 16; ++ks) a += part[(ks * 2 + b) * (6 * D) + j];
          adaf[n] = a; } }
    { float* par = WSP(float, WS_PAR);
      for (int i = gt; i < 32768; i += NGT) { par[PAR_RW + i] = F.in[22][i]; par[PAR_BG + i] = F.in[25][i]; par[PAR_BU + i] = F.in[27][i]; par[PAR_BD + i] = F.in[29][i];
          par[PAR_CRE + i] = F.in[15][i]; par[PAR_CIM + i] = F.in[16][i]; par[PAR_BRE + i] = F.in[13][i]; par[PAR_BIM + i] = F.in[14][i];
          if (i < 1024) { par[PAR_MPG + i] = F.in[6][i]; par[PAR_FPRE + i] = F.in[7][i]; par[PAR_FPOST + i] = F.in[8][i]; }
          if (i < 512) par[PAR_SD + i] = F.in[17][i];
          if (i < 32) par[PAR_RB + i] = F.in[23][i]; } }
    { const float* P5 = WSP(float, WS_S5P); const float* PWr = P5 + 131072; const float* PWi = PWr + 2048 * 17;
      bf16* M1t = WSP(bf16, WS_S5M1);
      for (int i = gt; i < NG * 256 * 256; i += NGT) { const int k = i & 255, n = (i >> 8) & 255, g = i >> 16; float val = 0.f;
          if (n < 128) { const int p = n & 63, gp = g * 64 + p, s_ = k >> 4, ci = k & 15;
              const float qr = P5[8192 + gp], qi = P5[8192 + 2048 + gp], b_r = F.in[13][gp * 16 + ci], b_i = F.in[14][gp * 16 + ci];
              const float bbr = qr * b_r - qi * b_i, bbi = qr * b_i + qi * b_r, wr_ = PWr[gp * 17 + 15 - s_], wi_ = PWi[gp * 17 + 15 - s_];
              val = (n < 64) ? (wr_ * bbr - wi_ * bbi) : (wr_ * bbi + wi_ * bbr); }
          M1t[((size_t)(g * 256 + perm8(n))) * 256 + k] = (bf16)f2bf(val); }
    }
    __syncthreads();
    const int gw = F.vcu * NWAVES + F.wave, NGW = F.G * NWAVES;
    bf16* XN = WSP(bf16, WS_XN);
    for (int m0 = gw * 2; m0 < T; m0 += NGW * 2) {
        const int b = m0 >> 13;
        f32x4 v[2][4];
#pragma unroll
        for (int q = 0; q < 2; ++q) { const GAS f32x4* xr = (const GAS f32x4*)(F.in[0] + (size_t)(m0 + q) * D) + F.lane;
#pragma unroll
            for (int j = 0; j < 4; ++j) v[q][j] = __builtin_nontemporal_load(xr + 64 * j); }
#pragma unroll
        for (int q = 0; q < 2; ++q) { float s = 0.f;
#pragma unroll
            for (int j = 0; j < 4; ++j) s += (v[q][j].x * v[q][j].x + v[q][j].y * v[q][j].y) + (v[q][j].z * v[q][j].z + v[q][j].w * v[q][j].w);
            const float rstd = 1.f / sqrtf(wave_sum(s) * (1.f / D) + NORM_EPS);
            GAS unsigned long long* o8 = (GAS unsigned long long*)(XN + (size_t)(m0 + q) * D) + F.lane;
#pragma unroll
            for (int j = 0; j < 4; ++j) { const f32x4 a1 = *(const LAS f32x4*)(A1 + b * D + 4 * F.lane + 256 * j), a2 = *(const LAS f32x4*)(A2 + b * D + 4 * F.lane + 256 * j);
                const f32x4 o = v[q][j] * rstd * a1 + a2;
                o8[64 * j] = (unsigned long long)pk2(o.x, o.y) | ((unsigned long long)pk2(o.z, o.w) << 32); } }
    }
    __syncthreads();
}

struct EpiG1 {
    bf16 *UA, *Q, *K, *V, *VT, *GSp, *GAp; const float *rc, *rs; float* km;
    __device__ __forceinline__ void operator()(const pg8::f32x4 (&acc)[2][2][4][2], const pg8::Unit& u, int wr, int wc, int fr, int fq) const {
        asm volatile("" : "+v"(fr), "+v"(fq));
        const int pn = u.pn, row0 = u.pm * 256 + wr * 64 + fr;
        if (pn < 2) {
#pragma unroll
            for (int ai = 0; ai < 2; ++ai)
#pragma unroll
                for (int m = 0; m < 4; ++m) { const int t = row0 + ai * 128 + m * 16, b = t >> 13, tt = t & (SEQ - 1), c = tt >> 4, s = tt & 15;
#pragma unroll
                    for (int bj = 0; bj < 2; ++bj) { const int ch = pn * 256 + bj * 128 + wc * 32 + 8 * fq, g = ch >> 4, ci = ch & 15;
                        const pg8::f32x4 v0 = acc[ai][bj][m][0], v1 = acc[ai][bj][m][1];
                        v4u w; w.x = pk2(v0[0], v0[1]); w.y = pk2(v0[2], v0[3]); w.z = pk2(v1[0], v1[1]); w.w = pk2(v1[2], v1[3]);
                        *(v4u*)(UA + ((size_t)(g * 1024 + b * 512 + c) * 384 + 16 * s + ci)) = w; } }
        } else if (pn < 6) {
            const bool isk = pn >= 4; bf16* X = isk ? K : Q; const float sc = isk ? 1.f : C2;
            const int p0 = 16 * (wc & 1) + 4 * fq;
#pragma unroll
            for (int bj = 0; bj < 2; ++bj) {
                const int head = 4 * (pn & 1) + 2 * bj + (wc >> 1);
                int rowb = row0; asm volatile("" : "+v"(rowb));
                float ks[2][4];
#pragma unroll
                for (int b = 0; b < 2; ++b)
#pragma unroll
                    for (int i = 0; i < 4; ++i) ks[b][i] = 0.f;
#pragma unroll
                for (int ai = 0; ai < 2; ++ai)
#pragma unroll
                    for (int m = 0; m < 4; ++m) { const int t = rowb + ai * 128 + m * 16;
                        const pg8::f32x4 cs = *(const pg8::f32x4*)(rc + (size_t)t * 32 + p0), sn = *(const pg8::f32x4*)(rs + (size_t)t * 32 + p0);
                        const pg8::f32x4 t1 = acc[ai][bj][m][0], t2 = acc[ai][bj][m][1];
                        const pg8::f32x4 o1 = t1 * cs - t2 * sn, o2 = t2 * cs + t1 * sn;
                        v2u w1, w2; w1.x = pk2(o1[0] * sc, o1[1] * sc); w1.y = pk2(o1[2] * sc, o1[3] * sc); w2.x = pk2(o2[0] * sc, o2[1] * sc); w2.y = pk2(o2[2] * sc, o2[3] * sc);
                        bf16* dst = X + (size_t)t * AW + head * 64 + p0;
                        *(v2u*)dst = w1; *(v2u*)(dst + 32) = w2;
#pragma unroll
                        for (int i = 0; i < 4; ++i) { ks[0][i] += o1[i]; ks[1][i] += o2[i]; }
                        __builtin_amdgcn_sched_barrier(0); }
                if (isk) {
                    const int b = u.pm >> 5, blk = u.pm & 31;
#pragma unroll
                    for (int n = 0; n < 2; ++n)
#pragma unroll
                        for (int i = 0; i < 4; ++i) { float v = ks[n][i];
                            v += __shfl_xor(v, 1); v += __shfl_xor(v, 2); v += __shfl_xor(v, 4); v += __shfl_xor(v, 8);
                            if (fr == 0) atomicAdd(km + ((size_t)((b * NH + head) * NBLK + blk) * HD + 32 * n + p0 + i), v); }
                }
            }
        } else if (pn < 8) {
#pragma unroll
            for (int ai = 0; ai < 2; ++ai)
#pragma unroll
                for (int m = 0; m < 4; ++m) { const int t = row0 + ai * 128 + m * 16, b = t >> 13, tt = t & (SEQ - 1);
#pragma unroll
                    for (int bj = 0; bj < 2; ++bj) { const int cv = (pn - 6) * 256 + bj * 128 + wc * 32 + 8 * fq, head = cv >> 6, d = cv & 63;
                        const pg8::f32x4 v0 = acc[ai][bj][m][0], v1 = acc[ai][bj][m][1];
                        v4u w; w.x = pk2(v0[0], v0[1]); w.y = pk2(v0[2], v0[3]); w.z = pk2(v1[0], v1[1]); w.w = pk2(v1[2], v1[3]);
                        bf16* vt = VT + ((size_t)((b * NH + head) * HD + d) * SEQ + tt);
                        vt[0 * SEQ] = (bf16)(w.x & 0xffff); vt[1 * SEQ] = (bf16)(w.x >> 16); vt[2 * SEQ] = (bf16)(w.y & 0xffff); vt[3 * SEQ] = (bf16)(w.y >> 16);
                        vt[4 * SEQ] = (bf16)(w.z & 0xffff); vt[5 * SEQ] = (bf16)(w.z >> 16); vt[6 * SEQ] = (bf16)(w.w & 0xffff); vt[7 * SEQ] = (bf16)(w.w >> 16); } }
        } else {
            bf16* Gp = (pn < 12) ? GSp : GAp; const int cb = ((pn - 8) & 3) * 256;
#pragma unroll
            for (int ai = 0; ai < 2; ++ai)
#pragma unroll
                for (int m = 0; m < 4; ++m) { const int t = row0 + ai * 128 + m * 16;
#pragma unroll
                    for (int bj = 0; bj < 2; ++bj) { const int col = cb + bj * 128 + wc * 32 + 8 * fq;
                        const pg8::f32x4 v0 = acc[ai][bj][m][0], v1 = acc[ai][bj][m][1];
                        v4u w; w.x = pk2(sigmoidf_(v0[0]), sigmoidf_(v0[1])); w.y = pk2(sigmoidf_(v0[2]), sigmoidf_(v0[3]));
                        w.z = pk2(sigmoidf_(v1[0]), sigmoidf_(v1[1])); w.w = pk2(sigmoidf_(v1[2]), sigmoidf_(v1[3]));
                        __builtin_nontemporal_store(w, (v4u*)(Gp + (size_t)t * D + col)); } }
        }
    }
};

template <int MODE> struct EpiEw {
    bf16* O; const bf16* X1; const bf16* X2; float* Of; int ld;
    __device__ __forceinline__ void operator()(const pg8::f32x4 (&acc)[2][2][4][2], const pg8::Unit& u, int wr, int wc, int fr, int fq) const {
        const int row0 = u.pm * 256 + wr * 64 + fr, col0 = u.pn * 256 + wc * 32 + 8 * fq;
#pragma unroll
        for (int ai = 0; ai < 2; ++ai)
#pragma unroll
            for (int m = 0; m < 4; ++m) { const size_t rb = (size_t)(row0 + ai * 128 + m * 16) * ld + col0;
#pragma unroll
                for (int bj = 0; bj < 2; ++bj) { const size_t off = rb + bj * 128;
                    const pg8::f32x4 v0 = acc[ai][bj][m][0], v1 = acc[ai][bj][m][1];
                    if (MODE == 3) { *(pg8::f32x4*)(Of + off) = v0; *(pg8::f32x4*)(Of + off + 4) = v1; }
                    else {
                        const v4u x = __builtin_nontemporal_load((const v4u*)(X1 + off));
                        float r[8] = {v0[0], v0[1], v0[2], v0[3], v1[0], v1[1], v1[2], v1[3]};
                        const float xv[8] = {bflo(x.x), bfhi(x.x), bflo(x.y), bfhi(x.y), bflo(x.z), bfhi(x.z), bflo(x.w), bfhi(x.w)};
                        if (MODE == 0) {
#pragma unroll
                            for (int i = 0; i < 8; ++i) r[i] = xv[i] * sigmoidf_(r[i]);
                        } else if (MODE == 1) {
#pragma unroll
                            for (int i = 0; i < 8; ++i) r[i] = xv[i] * r[i];
                        } else {
                            const v4u y = __builtin_nontemporal_load((const v4u*)(X2 + off));
                            const float yv[8] = {bflo(y.x), bfhi(y.x), bflo(y.y), bfhi(y.y), bflo(y.z), bfhi(y.z), bflo(y.w), bfhi(y.w)};
#pragma unroll
                            for (int i = 0; i < 8; ++i) r[i] = yv[i] + xv[i] * r[i];
                        }
                        v4u w; w.x = pk2(r[0], r[1]); w.y = pk2(r[2], r[3]); w.z = pk2(r[4], r[5]); w.w = pk2(r[6], r[7]);
                        *(v4u*)(O + off) = w; } } }
    }
};

typedef short bf16x8 __attribute__((ext_vector_type(8)));
typedef float f32x16 __attribute__((ext_vector_type(16)));
constexpr size_t WS_ALIST = 456 * MiB;
constexpr size_t WS_OP01 = 224 * MiB;
constexpr size_t WS_OP23 = 472 * MiB;
constexpr size_t WS_LSE = 504 * MiB;
constexpr int CW_BCNT = 12288;
constexpr int ALCAP = 8192;

__device__ __forceinline__ void attn_gate(Frame& F) {
    const int gw = F.vcu * NWAVES + F.wave, NGW = F.G * NWAVES, L = F.lane;
    const bf16* Q = WSP(bf16, WS_Q); const float* km = (const float*)(F.ctl + CW_KM);
    unsigned* bcnt = (unsigned*)(F.ctl + CW_BCNT); unsigned* list = WSP(unsigned, WS_ALIST); float* lse = WSP(float, WS_LSE);
    for (int w = gw; w < BATCH * NH * (SEQ / 64); w += NGW) {
        const int bh = w >> 7, b = bh >> 3, h = bh & 7, tt = (w & 127) * 64 + L, t = b * SEQ + tt, blk = tt >> 8;
        float q[64];
        { const v4u* qp = (const v4u*)(Q + (size_t)t * AW + h * 64);
#pragma unroll
          for (int i = 0; i < 8; ++i) { const v4u x = qp[i]; q[8 * i] = bflo(x.x); q[8 * i + 1] = bfhi(x.x); q[8 * i + 2] = bflo(x.y); q[8 * i + 3] = bfhi(x.y);
              q[8 * i + 4] = bflo(x.z); q[8 * i + 5] = bfhi(x.z); q[8 * i + 6] = bflo(x.w); q[8 * i + 7] = bfhi(x.w); } }
        float v0 = -3e38f, v1 = -3e38f, v2 = -3e38f; int i0 = -1, i1 = -1, i2 = -1;
        for (int j = 0; j < blk; ++j) { const float* kp = km + (size_t)((b * NH + h) * NBLK + j) * HD; float g = 0.f;
#pragma unroll
            for (int d = 0; d < 64; ++d) g += q[d] * kp[d];
            if (g > v0) { v2 = v1; i2 = i1; v1 = v0; i1 = i0; v0 = g; i0 = j; }
            else if (g > v1) { v2 = v1; i2 = i1; v1 = g; i1 = j; }
            else if (g > v2) { v2 = g; i2 = j; } }
        float* lp = lse + ((size_t)t * NH + h) * 4;
        if (i0 < 0) lp[0] = -1e30f; if (i1 < 0) lp[1] = -1e30f; if (i2 < 0) lp[2] = -1e30f;
        for (int j = 0; j < blk; ++j) {
            const bool sel = (i0 == j) || (i1 == j) || (i2 == j);
            const unsigned long long mask = __ballot(sel);
            if (mask) { const int leader = __ffsll((long long)mask) - 1; const int bucket = (b * NH + h) * NBLK + j;
                unsigned base = 0u;
                if (L == leader) base = __hip_atomic_fetch_add(bcnt + bucket, (unsigned)__popcll(mask), RLX_AGENT);
                base = (unsigned)__shfl((int)base, leader);
                if (sel) { const unsigned pos = base + (unsigned)__popcll(mask & ((1ull << L) - 1ull)); const unsigned slot = (i0 == j) ? 0u : ((i1 == j) ? 1u : 2u);
                    list[(size_t)bucket * ALCAP + pos] = ((unsigned)tt << 2) | slot; } }
        }
    }
}

__device__ __forceinline__ unsigned cvtpk(float lo, float hi) { typedef float f32x2_t __attribute__((ext_vector_type(2))); typedef __bf16 bf16x2_t __attribute__((ext_vector_type(2)));
    f32x2_t v = {lo, hi}; bf16x2_t r = __builtin_convertvector(v, bf16x2_t); return __builtin_bit_cast(unsigned, r); }

constexpr int AT_KROW = 144, AT_VROW = 520, AT_KOFF = 0, AT_VOFF = 256 * AT_KROW;
__device__ __forceinline__ void attn_item(Frame& F, int b, int h, int j, bool own, const unsigned* lst, int nvalid) {
    const int tid = F.tid, L = F.lane, r = L & 31, hh = L >> 5, wv = F.wave;
    LAS unsigned char* Kl = F.lds + AT_KOFF; LAS unsigned char* Vl = F.lds + AT_VOFF;
    const bf16* Kg = WSP(bf16, WS_K) + ((size_t)(b * SEQ + j * 256)) * AW + h * 64;
    const bf16* Vg = WSP(bf16, WS_VT) + ((size_t)((b * NH + h) * HD)) * SEQ + j * 256;
    v4u kr[4], vr[4];
#pragma unroll
    for (int i = 0; i < 4; ++i) { const int idx = tid + 512 * i; kr[i] = *(const v4u*)(Kg + (size_t)(idx >> 3) * AW + (idx & 7) * 8); vr[i] = *(const v4u*)(Vg + (size_t)(idx >> 5) * SEQ + (idx & 31) * 8); }
    const int qi = wv * 32 + r; const bool valid = qi < nvalid;
    unsigned ent; if (own) ent = ((unsigned)(j * 256 + qi) << 2) | 3u; else ent = lst[valid ? qi : 0];
    const int tt = (int)(ent >> 2), slot = (int)(ent & 3u), t = b * SEQ + tt;
    bf16x8 qf[4];
    { const bf16* qp = WSP(bf16, WS_Q) + (size_t)t * AW + h * 64 + hh * 8;
#pragma unroll
      for (int d0 = 0; d0 < 4; ++d0) qf[d0] = *(const bf16x8*)(qp + d0 * 16); }
#pragma unroll
    for (int i = 0; i < 4; ++i) { const int idx = tid + 512 * i; *(LAS v4u*)(Kl + (idx >> 3) * AT_KROW + (idx & 7) * 16) = kr[i]; *(LAS v4u*)(Vl + (idx >> 5) * AT_VROW + (idx & 31) * 16) = vr[i]; }
    __syncthreads();
#ifdef ATT_STAGGER
    if (wv >= 4) __builtin_amdgcn_s_sleep(ATT_STAGGER);
#endif
#ifdef ATT_REP_COMPUTE
    for (int arep = 0; arep < 2; ++arep)
#endif
    if (wv * 32 < nvalid) {
        float m = -1e30f, l = 0.f; f32x16 O0 = {}, O1 = {};
        const int qrel = tt & 255;
#pragma unroll
        for (int hk = 0; hk < 2; ++hk) {
            if (own && hk * 4 > wv) continue;
            f32x16 S[4];
#pragma unroll
            for (int kt = 0; kt < 4; ++kt) S[kt] = (f32x16){};
#pragma unroll
            for (int d0 = 0; d0 < 4; ++d0) {
#pragma unroll
                for (int kt = 0; kt < 4; ++kt) {
                    if (own && hk * 4 + kt > wv) continue;
                    const bf16x8 kf = *(const LAS bf16x8*)(Kl + (hk * 128 + kt * 32 + r) * AT_KROW + d0 * 32 + hh * 16);
                    S[kt] = __builtin_amdgcn_mfma_f32_32x32x16_bf16(kf, qf[d0], S[kt], 0, 0, 0); }
                __builtin_amdgcn_sched_barrier(0); }
            if (own) {
#pragma unroll
                for (int kt = 0; kt < 4; ++kt) {
                    if (hk * 4 + kt > wv) {
#pragma unroll
                        for (int rg = 0; rg < 16; ++rg) S[kt][rg] = -1e30f;
                    } else if (hk * 4 + kt == wv) {
#pragma unroll
                        for (int rg = 0; rg < 16; ++rg) { const int key = hk * 128 + kt * 32 + (rg & 3) + 8 * (rg >> 2) + 4 * hh; if (key > qrel) S[kt][rg] = -1e30f; } } } }
            float mx = S[0][0];
#pragma unroll
            for (int kt = 0; kt < 4; ++kt)
#pragma unroll
                for (int rg = 0; rg < 16; ++rg) mx = fmaxf(mx, S[kt][rg]);
            mx = fmaxf(mx, __shfl_xor(mx, 32));
            const float mn = fmaxf(m, mx), alpha = __builtin_amdgcn_exp2f(m - mn); m = mn; l *= alpha;
#pragma unroll
            for (int rg = 0; rg < 16; ++rg) { O0[rg] *= alpha; O1[rg] *= alpha; }
            float ls = 0.f;
#pragma unroll
            for (int kt = 0; kt < 4; ++kt) {
                if (own && hk * 4 + kt > wv) continue;
                unsigned pw[8];
#pragma unroll
                for (int rg = 0; rg < 16; rg += 2) { const float p0 = __builtin_amdgcn_exp2f(S[kt][rg] - mn), p1 = __builtin_amdgcn_exp2f(S[kt][rg + 1] - mn); ls += p0 + p1; pw[rg >> 1] = cvtpk(p0, p1); }
#pragma unroll
                for (int s = 0; s < 2; ++s) {
                    const v4u pv = {pw[4 * s], pw[4 * s + 1], pw[4 * s + 2], pw[4 * s + 3]}; const bf16x8 pf = __builtin_bit_cast(bf16x8, pv);
                    const int kb = (hk * 128 + kt * 32 + 16 * s + 4 * hh) * 2;
                    { const LAS unsigned char* vp = Vl + r * AT_VROW + kb; const v2u lo = *(const LAS v2u*)vp, hi = *(const LAS v2u*)(vp + 16);
                      const v4u vv = {lo.x, lo.y, hi.x, hi.y}; O0 = __builtin_amdgcn_mfma_f32_32x32x16_bf16(__builtin_bit_cast(bf16x8, vv), pf, O0, 0, 0, 0); }
                    { const LAS unsigned char* vp = Vl + (32 + r) * AT_VROW + kb; const v2u lo = *(const LAS v2u*)vp, hi = *(const LAS v2u*)(vp + 16);
                      const v4u vv = {lo.x, lo.y, hi.x, hi.y}; O1 = __builtin_amdgcn_mfma_f32_32x32x16_bf16(__builtin_bit_cast(bf16x8, vv), pf, O1, 0, 0, 0); } } }
            l += ls;
        }
        l += __shfl_xor(l, 32);
        if (valid) {
            const float rl = 1.f / l;
            bf16* op = (slot < 2 ? WSP(bf16, WS_OP01) + (((size_t)t * NH + h) * 2 + slot) * 64 : WSP(bf16, WS_OP23) + (((size_t)t * NH + h) * 2 + (slot - 2)) * 64) + 4 * hh;
#pragma unroll
            for (int g4 = 0; g4 < 4; ++g4) { v2u w0, w1; w0.x = cvtpk(O0[4 * g4] * rl, O0[4 * g4 + 1] * rl); w0.y = cvtpk(O0[4 * g4 + 2] * rl, O0[4 * g4 + 3] * rl);
                w1.x = cvtpk(O1[4 * g4] * rl, O1[4 * g4 + 1] * rl); w1.y = cvtpk(O1[4 * g4 + 2] * rl, O1[4 * g4 + 3] * rl);
                *(v2u*)(op + 8 * g4) = w0; *(v2u*)(op + 32 + 8 * g4) = w1; }
            if (hh == 0) WSP(float, WS_LSE)[((size_t)t * NH + h) * 4 + slot] = m + log2f(l);
        }
    }
    __syncthreads();
}
__device__ __forceinline__ void attn_items(Frame& F) {
    LAS int* pre = (LAS int*)(F.lds + 72 * 1024);
    const unsigned* bcnt = (const unsigned*)(F.ctl + CW_BCNT);
    LAS int* cntl = pre + 520;
    for (int i = F.tid; i < 512; i += NWAVES * 64) cntl[i] = (int)__hip_atomic_load((gu32*)(F.ctl + CW_BCNT) + i, RLX_AGENT);
    __syncthreads();
    if (F.tid == 0) { int a = 0; for (int i = 0; i < 512; ++i) { pre[i] = a; a += (cntl[i] + 255) >> 8; } pre[512] = a; }
    __syncthreads();
    const int total = 512 + pre[512];
    for (int it = (int)blockIdx.x; it < total; it += F.G) {
        int bh, j, n; bool own; const unsigned* lst;
        if (it < 512) { bh = it >> 5; j = it & 31; own = true; lst = nullptr; n = 256; }
        else { const int s = it - 512; int lo = 0, hi = 512;
            while (hi - lo > 1) { const int mid = (lo + hi) >> 1; if (pre[mid] <= s) lo = mid; else hi = mid; }
            const int bucket = lo, tile = s - pre[bucket]; n = cntl[bucket] - tile * 256; n = n > 256 ? 256 : n; bh = bucket >> 5; j = bucket & 31; own = false;
            lst = WSP(unsigned, WS_ALIST) + (size_t)bucket * ALCAP + tile * 256; }
        const int b_ = __builtin_amdgcn_readfirstlane(bh >> 3), h_ = __builtin_amdgcn_readfirstlane(bh & 7), j_ = __builtin_amdgcn_readfirstlane(j), n_ = __builtin_amdgcn_readfirstlane(n);
        attn_item(F, b_, h_, j_, own, lst, n_);
    }
}
__device__ __forceinline__ void attn_combine(Frame& F) {
    if (F.G == 256 && blockIdx.x < 128) return;
    const int nb = F.G == 256 ? 128 : F.G, bi = F.G == 256 ? (int)blockIdx.x - 128 : F.vcu;
    const int gw = bi * NWAVES + F.wave, NGW = nb * NWAVES, L = F.lane, h = L >> 3, ch = L & 7;
    const float* lse = WSP(float, WS_LSE); bf16* YA = WSP(bf16, WS_YA);
    for (int t = gw; t < T; t += NGW) {
        const size_t th = (size_t)t * NH + h;
        const f32x4 ls = *(const f32x4*)(lse + th * 4);
        const float mx = fmaxf(fmaxf(ls[0], ls[1]), fmaxf(ls[2], ls[3]));
        const float w0 = __builtin_amdgcn_exp2f(ls[0] - mx), w1 = __builtin_amdgcn_exp2f(ls[1] - mx), w2 = __builtin_amdgcn_exp2f(ls[2] - mx), w3 = __builtin_amdgcn_exp2f(ls[3] - mx), inv = 1.f / (w0 + w1 + w2 + w3);
        const v4u a0 = *(const v4u*)(WSP(bf16, WS_OP01) + (th * 2 + 0) * 64 + ch * 8), a1 = *(const v4u*)(WSP(bf16, WS_OP01) + (th * 2 + 1) * 64 + ch * 8);
        const v4u a2 = *(const v4u*)(WSP(bf16, WS_OP23) + (th * 2 + 0) * 64 + ch * 8), a3 = *(const v4u*)(WSP(bf16, WS_OP23) + (th * 2 + 1) * 64 + ch * 8);
        float o[8];
        const unsigned x0[4] = {a0.x, a0.y, a0.z, a0.w}, x1[4] = {a1.x, a1.y, a1.z, a1.w}, x2[4] = {a2.x, a2.y, a2.z, a2.w}, x3[4] = {a3.x, a3.y, a3.z, a3.w};
#pragma unroll
        for (int i = 0; i < 4; ++i) {
            float lo_ = w3 * bflo(x3[i]), hi_ = w3 * bfhi(x3[i]);
            if (ls[0] > -1e29f) { lo_ += w0 * bflo(x0[i]); hi_ += w0 * bfhi(x0[i]); }
            if (ls[1] > -1e29f) { lo_ += w1 * bflo(x1[i]); hi_ += w1 * bfhi(x1[i]); }
            if (ls[2] > -1e29f) { lo_ += w2 * bflo(x2[i]); hi_ += w2 * bfhi(x2[i]); }
            o[2 * i] = lo_ * inv; o[2 * i + 1] = hi_ * inv; }
        v4u w; w.x = cvtpk(o[0], o[1]); w.y = cvtpk(o[2], o[3]); w.z = cvtpk(o[4], o[5]); w.w = cvtpk(o[6], o[7]);
        *(v4u*)(YA + (size_t)t * AW + h * 64 + ch * 8) = w;
    }
}
struct S5Order { static constexpr bool GATHER = false; int G, c;
    __device__ __forceinline__ void a_ready(const pg8::Unit&) const {}
    __device__ __forceinline__ void done(const pg8::Unit&) const {}
    __device__ __forceinline__ bool next(int i, pg8::Unit& u) const { const int L = i * G + c; if (L >= NG * 4) return false; const int g = L >> 2, rt = L & 3;
        u.arow = g * 1024 + rt * 256; u.brow = g * 256; u.pm = rt; u.pn = 0; u.e = g; u.nrow = 256; u.kind = 0; u.aux = 0; return true; } };
struct EpiS5A { float* E;
    __device__ __forceinline__ void operator()(const pg8::f32x4 (&acc)[2][2][4][2], const pg8::Unit& u, int wr, int wc, int fr, int fq) const {
        asm volatile("" : "+v"(fr), "+v"(fq));
#pragma unroll
        for (int ai = 0; ai < 2; ++ai)
#pragma unroll
            for (int m = 0; m < 4; ++m) { float* p = E + (size_t)(u.arow + ai * 128 + wr * 64 + m * 16 + fr) * 128 + wc * 32 + 8 * fq;
                *(pg8::f32x4*)p = acc[ai][0][m][0]; *(pg8::f32x4*)(p + 4) = acc[ai][0][m][1]; }
    }
};
struct EpiS5C { bf16* YG;
    __device__ __forceinline__ void operator()(const pg8::f32x4 (&acc)[2][2][4][2], const pg8::Unit& u, int wr, int wc, int fr, int fq) const {
        asm volatile("" : "+v"(fr), "+v"(fq));
        const int g = u.e, n0 = wc * 32 + 8 * fq, t0 = n0 >> 4, co0 = n0 & 15;
#pragma unroll
        for (int ai = 0; ai < 2; ++ai)
#pragma unroll
            for (int m = 0; m < 4; ++m) { const int row = u.pm * 256 + ai * 128 + wr * 64 + m * 16 + fr, b = row >> 9, c = row & 511;
                bf16* yp = YG + (size_t)(b * SEQ + 16 * c + t0) * SW + 16 * g + co0;
#pragma unroll
                for (int bj = 0; bj < 2; ++bj) {
                    const pg8::f32x4 v0 = acc[ai][bj][m][0], v1 = acc[ai][bj][m][1];
                    v4u w; w.x = pk2(gelu_tanh(v0[0]), gelu_tanh(v0[1])); w.y = pk2(gelu_tanh(v0[2]), gelu_tanh(v0[3]));
                    w.z = pk2(gelu_tanh(v1[0]), gelu_tanh(v1[1])); w.w = pk2(gelu_tanh(v1[2]), gelu_tanh(v1[3]));
                    *(v4u*)(yp + (size_t)bj * 8 * SW) = w; }
                __builtin_amdgcn_sched_barrier(0); }
    }
};
__device__ __forceinline__ void s5_fill_kt(Frame& F) {
    const int gt = F.vcu * (NWAVES * 64) + F.tid, NGT = F.G * NWAVES * 64;
    const float* P5 = WSP(float, WS_S5P); const float* PWr = P5 + 131072; const float* PWi = PWr + 2048 * 17; const float* par = WSP(float, WS_PAR);
    float* KT = WSP(float, WS_S5KT);
    for (int i = gt; i < NG * 16 * 256; i += NGT) { const int ci = i & 15, co = (i >> 4) & 15, tau = (i >> 8) & 15, g = i >> 12; float a = 0.f;
        for (int p = 0; p < 64; ++p) { const int gp = g * 64 + p;
            const float qr = P5[8192 + gp], qi = P5[8192 + 2048 + gp], b_r = par[PAR_BRE + gp * 16 + ci], b_i = par[PAR_BIM + gp * 16 + ci];
            const float bbr = qr * b_r - qi * b_i, bbi = qr * b_i + qi * b_r, wr_ = PWr[gp * 17 + tau], wi_ = PWi[gp * 17 + tau];
            const float xr = wr_ * bbr - wi_ * bbi, xi = wr_ * bbi + wi_ * bbr;
            const float cr = par[PAR_CRE + (g * 16 + co) * 64 + p], ci_ = par[PAR_CIM + (g * 16 + co) * 64 + p];
            a += cr * xr - ci_ * xi; }
        KT[i] = a; }
}
__device__ __forceinline__ void s5_fill_wc(Frame& F) {
    const int gt = F.vcu * (NWAVES * 64) + F.tid, NGT = F.G * NWAVES * 64;
    const float* P5 = WSP(float, WS_S5P); const float* PWr = P5 + 131072; const float* PWi = PWr + 2048 * 17; const float* KT = WSP(float, WS_S5KT); const float* par = WSP(float, WS_PAR);
    bf16* Wc = WSP(bf16, WS_S5WC);
    for (int i = gt; i < NG * 256 * 384; i += NGT) { const int k = i % 384, n = (i / 384) & 255, g = i / (384 * 256), t = n >> 4, co = n & 15; float val = 0.f;
        if (k < 256) { const int s_ = k >> 4, ci = k & 15;
            if (s_ <= t) val = KT[((g * 16 + (t - s_)) * 16 + co) * 16 + ci];
            if (s_ == t && ci == co) val += par[PAR_SD + g * 16 + co]; }
        else { const int p = (k - 256) & 63, gp = g * 64 + p; const float cr = par[PAR_CRE + (g * 16 + co) * 64 + p], ci_ = par[PAR_CIM + (g * 16 + co) * 64 + p];
            const float wr_ = PWr[gp * 17 + t + 1], wi_ = PWi[gp * 17 + t + 1];
            val = (k < 320) ? (cr * wr_ - ci_ * wi_) : -(cr * wi_ + ci_ * wr_); }
        Wc[((size_t)(g * 256 + perm8(n))) * 384 + k] = (bf16)f2bf(val); }
}
__device__ __forceinline__ void s5_carry(Frame& F) {
    const float* P5 = WSP(float, WS_S5P); const float* PWr = P5 + 131072; const float* PWi = PWr + 2048 * 17; const float* E = WSP(float, WS_S5E); bf16* UA = WSP(bf16, WS_UA);
    LAS float* Z = (LAS float*)(F.lds);
    const int seg = F.wave, p = F.lane;
    for (int bg = F.vcu; bg < BATCH * NG; bg += F.G) { const int b = bg / NG, g = bg % NG, gp = g * 64 + p;
        const float ar = PWr[gp * 17 + 16], ai = PWi[gp * 17 + 16];
        const size_t row0 = (size_t)g * 1024 + b * 512 + seg * 64;
        float zr = 0.f, zi = 0.f;
        for (int c0 = 0; c0 < 64; c0 += 8) { float er[8], ei[8];
#pragma unroll
            for (int k = 0; k < 8; ++k) { er[k] = E[(row0 + c0 + k) * 128 + p]; ei[k] = E[(row0 + c0 + k) * 128 + 64 + p]; }
#pragma unroll
            for (int k = 0; k < 8; ++k) { const float nr = ar * zr - ai * zi + er[k], ni = ar * zi + ai * zr + ei[k]; zr = nr; zi = ni; } }
        Z[(seg * 64 + p) * 2] = zr; Z[(seg * 64 + p) * 2 + 1] = zi;
        __syncthreads();
        if (seg == 0) { float br = ar, bi = ai;
#pragma unroll
            for (int k = 0; k < 6; ++k) { const float tr = br * br - bi * bi, ti = 2.f * br * bi; br = tr; bi = ti; }
            float sr = 0.f, si = 0.f;
            for (int sg = 0; sg < 8; ++sg) { const float xr = Z[(sg * 64 + p) * 2], xi = Z[(sg * 64 + p) * 2 + 1]; Z[(sg * 64 + p) * 2] = sr; Z[(sg * 64 + p) * 2 + 1] = si;
                const float nr = br * sr - bi * si + xr, ni = br * si + bi * sr + xi; sr = nr; si = ni; } }
        __syncthreads();
        float sr = Z[(seg * 64 + p) * 2], si = Z[(seg * 64 + p) * 2 + 1];
        for (int c0 = 0; c0 < 64; c0 += 8) { float er[8], ei[8];
#pragma unroll
            for (int k = 0; k < 8; ++k) { er[k] = E[(row0 + c0 + k) * 128 + p]; ei[k] = E[(row0 + c0 + k) * 128 + 64 + p]; }
#pragma unroll
            for (int k = 0; k < 8; ++k) { bf16* up = UA + (row0 + c0 + k) * 384 + 256 + p; up[0] = (bf16)f2bf(sr); up[64] = (bf16)f2bf(si);
                const float nr = ar * sr - ai * si + er[k], ni = ar * si + ai * sr + ei[k]; sr = nr; si = ni; } }
        __syncthreads();
    }
}
constexpr int SCR_OFF = LDSCTL_OFF + 512;
#ifndef MOE_LAG
#define MOE_LAG 2
#endif
constexpr int MT_SEG = 100, MT_MAXSEG = 72;
__device__ __forceinline__ void phase_rows(Frame& F, bool dry = false) {
    LAS float* h2t = (LAS float*)(F.lds);
    LAS float* lg = (LAS float*)(F.lds + 65536);
    LAS float* gtm = (LAS float*)(F.lds + 131072);
    LAS float* pg2 = gtm + 2 * D; LAS float* shf = pg2 + 2 * D;
    LAS unsigned* hist = (LAS unsigned*)(F.lds + SCR_OFF); LAS unsigned* base = hist + 32; LAS int* rec_e = (LAS int*)(base + 32); LAS int* rec_lp = rec_e + 256;
    const float* adaf = WSP(float, WS_ADAF); const float* par = WSP(float, WS_PAR);
    const int L = F.lane, wv = F.wave;
    for (int i = F.tid; i < 2 * D; i += NWAVES * 64) { const int b = i >> 10, k = i & (D - 1);
        gtm[i] = adaf[b * 6 * D + 2 * D + k] * par[PAR_MPG + k];
        pg2[i] = par[PAR_FPRE + k] * (1.f + adaf[b * 6 * D + 4 * D + k]); shf[i] = adaf[b * 6 * D + 3 * D + k]; }
    f32x4 wreg[16];
#pragma unroll
    for (int j = 0; j < 4; ++j)
#pragma unroll
        for (int i = 0; i < 4; ++i) wreg[j * 4 + i] = *(const f32x4*)(par + PAR_RW + (4 * L + 256 * j + i) * NE + 4 * wv);
    if (F.tid < 32) hist[F.tid] = 0u;
    __syncthreads();
    const float* mix = WSP(float, WS_MIX); bf16* H2 = WSP(bf16, WS_H2);
    int* tok_e = WSP(int, WS_ROUTE); float* tok_w = (float*)(tok_e + T * 4); int* tok_pos = tok_e + 2 * T * 4;
    unsigned* gcnt = (unsigned*)(F.ctl + CW_ECNT);
    for (int t0 = F.vcu * 16; t0 < T; t0 += F.G * 16) {
        {
            const int t = t0 + 2 * wv, b = t >> 13;
            f32x4 mv[2][4], xv[2][4];
#pragma unroll
            for (int q = 0; q < 2; ++q) { const GAS f32x4* mr = (const GAS f32x4*)(mix + (size_t)(t + q) * D) + L; const GAS f32x4* xr = (const GAS f32x4*)(F.in[0] + (size_t)(t + q) * D) + L;
#pragma unroll
                for (int j = 0; j < 4; ++j) { mv[q][j] = __builtin_nontemporal_load(mr + 64 * j); xv[q][j] = __builtin_nontemporal_load(xr + 64 * j); } }
#pragma unroll
            for (int q = 0; q < 2; ++q) { float s = 0.f;
#pragma unroll
                for (int j = 0; j < 4; ++j) s += (mv[q][j].x * mv[q][j].x + mv[q][j].y * mv[q][j].y) + (mv[q][j].z * mv[q][j].z + mv[q][j].w * mv[q][j].w);
                const float r1 = 1.f / sqrtf(wave_sum(s) * (1.f / D) + NORM_EPS);
                float s2 = 0.f; GAS f32x4* orow = (GAS f32x4*)(F.out + (size_t)(t + q) * D) + L;
#pragma unroll
                for (int j = 0; j < 4; ++j) { const f32x4 g = *(const LAS f32x4*)(gtm + b * D + 4 * L + 256 * j);
                    xv[q][j] = xv[q][j] + g * (mv[q][j] * r1); __builtin_nontemporal_store(xv[q][j], orow + 64 * j);
                    s2 += (xv[q][j].x * xv[q][j].x + xv[q][j].y * xv[q][j].y) + (xv[q][j].z * xv[q][j].z + xv[q][j].w * xv[q][j].w); }
                const float r2 = 1.f / sqrtf(wave_sum(s2) * (1.f / D) + NORM_EPS);
                GAS unsigned long long* h8 = (GAS unsigned long long*)(H2 + (size_t)(t + q) * D) + L;
#pragma unroll
                for (int j = 0; j < 4; ++j) { const f32x4 a = *(const LAS f32x4*)(pg2 + b * D + 4 * L + 256 * j), c = *(const LAS f32x4*)(shf + b * D + 4 * L + 256 * j);
                    const f32x4 h = xv[q][j] * r2 * a + c;
                    h8[64 * j] = (unsigned long long)pk2(h.x, h.y) | ((unsigned long long)pk2(h.z, h.w) << 32);
                    *(LAS f32x4*)(h2t + (2 * wv + q) * D + 4 * L + 256 * j) = h; } }
        }
        __syncthreads();
        {
            const int hi = (L >> 5) & 1, h2b = (L >> 4) & 1;
#pragma unroll 2
            for (int tk = 0; tk < 16; ++tk) {
                f32x4 a = {0.f, 0.f, 0.f, 0.f};
#pragma unroll
                for (int j = 0; j < 4; ++j) { const f32x4 h = *(const LAS f32x4*)(h2t + tk * D + 4 * L + 256 * j);
                    a += wreg[j * 4 + 0] * h.x; a += wreg[j * 4 + 1] * h.y; a += wreg[j * 4 + 2] * h.z; a += wreg[j * 4 + 3] * h.w; }
                const float m0 = hi ? a.z : a.x, o0 = hi ? a.x : a.z, m1 = hi ? a.w : a.y, o1 = hi ? a.y : a.w;
                const float v0 = m0 + __shfl_xor(o0, 32), v1 = m1 + __shfl_xor(o1, 32);
                float v = (h2b ? v1 : v0) + __shfl_xor(h2b ? v0 : v1, 16);
                v += __shfl_xor(v, 8); v += __shfl_xor(v, 4); v += __shfl_xor(v, 2); v += __shfl_xor(v, 1);
                if ((L & 15) == 0) lg[tk * NE + 4 * wv + 2 * hi + h2b] = v;
            }
        }
        __syncthreads();
        {
            const int e = L & 31, half = L >> 5, tl = 2 * wv + half, t = t0 + tl;
            float val = lg[tl * NE + e] + par[PAR_RB + e];
            int se[4]; float sv[4];
#pragma unroll
            for (int r = 0; r < 4; ++r) { float mx = val;
                mx = fmaxf(mx, __shfl_xor(mx, 16)); mx = fmaxf(mx, __shfl_xor(mx, 8)); mx = fmaxf(mx, __shfl_xor(mx, 4)); mx = fmaxf(mx, __shfl_xor(mx, 2)); mx = fmaxf(mx, __shfl_xor(mx, 1));
                const unsigned long long bal = __ballot(val == mx); const unsigned hm = half ? (unsigned)(bal >> 32) : (unsigned)bal; const int win = __ffs((int)hm) - 1;
                se[r] = win; sv[r] = mx; if (e == win) val = -3e38f; }
            const float e1 = __expf(sv[1] - sv[0]), e2 = __expf(sv[2] - sv[0]), e3 = __expf(sv[3] - sv[0]), inv = 1.f / (1.f + e1 + e2 + e3);
            if (e < 4) { const int ex = e == 0 ? se[0] : (e == 1 ? se[1] : (e == 2 ? se[2] : se[3]));
                const float wgt = (e == 0 ? 1.f : (e == 1 ? e1 : (e == 2 ? e2 : e3))) * inv;
                tok_e[t * 4 + e] = ex; tok_w[t * 4 + e] = wgt;
                const unsigned lp = dry ? 0u : __hip_atomic_fetch_add(hist + ex, 1u, __ATOMIC_RELAXED, __HIP_MEMORY_SCOPE_WORKGROUP);
                rec_e[tl * 4 + e] = ex; rec_lp[tl * 4 + e] = (int)lp; }
        }
        __syncthreads();
        if (F.tid < 32) { const unsigned h = hist[F.tid]; base[F.tid] = h ? __hip_atomic_fetch_add(gcnt + F.tid, h, RLX_AGENT) : 0u; }
        __syncthreads();
        if (!dry && F.tid < 64) { const int e_ = rec_e[F.tid], pos_ = (int)base[e_] + rec_lp[F.tid]; tok_pos[(t0 + (F.tid >> 2)) * 4 + (F.tid & 3)] = pos_;
            WSP(int, WS_ELIST)[e_ * ELCAP + pos_] = t0 + (F.tid >> 2); }
        if (F.tid < 32) hist[F.tid] = 0u;
        __syncthreads();
    }
}

__device__ __forceinline__ void moe_tables(Frame& F) {
    LAS int* cnt = (LAS int*)(F.lds + SCR_OFF); LAS int* off = cnt + 32; LAS int* tpre = off + 32;
    if (F.tid < NE) cnt[F.tid] = (int)__hip_atomic_load(F.ctl + CW_ECNT + F.tid, RLX_AGENT);
    __syncthreads();
    if (F.tid == 0) { int o = 0, tp = 0;
        for (int e = 0; e < NE; ++e) { const int c = cnt[e]; off[e] = o; tpre[e] = tp; o += c; tp += (c + 255) >> 8; }
        tpre[NE] = tp;
        LAS int* sg = cnt + MT_SEG; const int n = (tp + 31) >> 5; int ns = 0, pos = 0;
        for (int g = 0; g < n; ++g) { const int tg = (tp - 32 * g) < 32 ? (tp - 32 * g) : 32;
            sg[1 + ns] = pos; sg[1 + MT_MAXSEG + ns] = 0; sg[1 + 2 * MT_MAXSEG + ns] = g; ++ns; pos += 8 * tg; sg[1 + 3 * MT_MAXSEG + g] = pos;
            if (g >= MOE_LAG) { sg[1 + ns] = pos; sg[1 + MT_MAXSEG + ns] = 1; sg[1 + 2 * MT_MAXSEG + ns] = g - MOE_LAG; ++ns; pos += 4 * 32; } }
        for (int g = (n > MOE_LAG ? n - MOE_LAG : 0); g < n; ++g) { const int tg = (tp - 32 * g) < 32 ? (tp - 32 * g) : 32; sg[1 + ns] = pos; sg[1 + MT_MAXSEG + ns] = 1; sg[1 + 2 * MT_MAXSEG + ns] = g; ++ns; pos += 4 * tg; }
        sg[1 + ns] = pos; sg[0] = ns; }
    __syncthreads();
}
template <bool GA> struct MoeOrder {
    static constexpr bool GATHER = GA;
#if defined(T_ACQ)
    __device__ __forceinline__ void a_ready(const pg8::Unit&) const { if (!GA) { if (threadIdx.x < 64) { __builtin_amdgcn_fence(__ATOMIC_ACQUIRE, "agent"); asm volatile("s_waitcnt vmcnt(0)" ::: "memory"); } asm volatile("" ::: "memory"); __builtin_amdgcn_s_barrier(); asm volatile("" ::: "memory"); } }
#else
    __device__ __forceinline__ void a_ready(const pg8::Unit&) const {}
#endif
#if defined(T_DRAIN)
    __device__ __forceinline__ void done(const pg8::Unit&) const { if (GA) asm volatile("s_waitcnt vmcnt(0)" ::: "memory"); }
#else
    __device__ __forceinline__ void done(const pg8::Unit&) const {}
#endif
    const LAS int* tab; const int* elist; int nct, brows, G, c;
    __device__ __forceinline__ bool next(int i, pg8::Unit& u) const {
        int rtg, pn;
        if (G == 256) { const int xcd = c & 7, slot = c >> 3, rpx = 32 / nct;
            rtg = (i * 8 + xcd) * rpx + slot / nct; pn = slot % nct; if (rtg >= tab[64 + NE]) return false; }
        else { const int L = i * G + c, total = tab[64 + NE] * nct; if (L >= total) return false; rtg = L / nct; pn = L % nct; }
        int e = 0;
        for (int k = 1; k < NE; ++k) if (tab[64 + k] <= rtg) e = k;
        const int rt = rtg - tab[64 + e], cnt = tab[e], off = tab[32 + e];
        u.e = __builtin_amdgcn_readfirstlane(e); u.pm = __builtin_amdgcn_readfirstlane(rt); u.pn = pn; u.arow = __builtin_amdgcn_readfirstlane(off + rt * 256); u.brow = __builtin_amdgcn_readfirstlane(e * brows + pn * 256);
        const int nr = cnt - rt * 256; u.nrow = __builtin_amdgcn_readfirstlane(nr > 256 ? 256 : nr); u.kind = 0; u.aux = 0; return true;
    }
    __device__ __forceinline__ int arow_of(const pg8::Unit& u, int r) const { return r < u.nrow ? elist[u.e * ELCAP + u.pm * 256 + r] : 0; }
};
struct EpiGU { bf16* H1; const float* bg; const float* bu;
    __device__ __forceinline__ void operator()(const pg8::f32x4 (&acc)[2][2][4][2], const pg8::Unit& u, int wr, int wc, int fr, int fq) const {
        asm volatile("" : "+v"(fr), "+v"(fq));
        const int f0 = u.pn * 128 + wc * 32 + 8 * fq;
#pragma unroll
        for (int ai = 0; ai < 2; ++ai) {
            int fb = f0; asm volatile("" : "+v"(fb));
            const pg8::f32x4 g0 = *(const pg8::f32x4*)(bg + u.e * FF + fb), g1 = *(const pg8::f32x4*)(bg + u.e * FF + fb + 4);
            const pg8::f32x4 u0 = *(const pg8::f32x4*)(bu + u.e * FF + fb), u1 = *(const pg8::f32x4*)(bu + u.e * FF + fb + 4);
#pragma unroll
            for (int m = 0; m < 4; ++m) { const int r = ai * 128 + wr * 64 + m * 16 + fr;
                const pg8::f32x4 a0 = acc[ai][0][m][0] + g0, a1 = acc[ai][0][m][1] + g1, b0 = acc[ai][1][m][0] + u0, b1 = acc[ai][1][m][1] + u1;
                float gg[8] = {a0[0], a0[1], a0[2], a0[3], a1[0], a1[1], a1[2], a1[3]}, uu[8] = {b0[0], b0[1], b0[2], b0[3], b1[0], b1[1], b1[2], b1[3]}, o[8];
#pragma unroll
                for (int i = 0; i < 8; ++i) { const float g = fminf(gg[i], 7.f), up = fminf(fmaxf(uu[i], -7.f), 7.f); o[i] = g * sigmoidf_(1.702f * g) * (up + 1.f); }
                v4u w; w.x = pk2(o[0], o[1]); w.y = pk2(o[2], o[3]); w.z = pk2(o[4], o[5]); w.w = pk2(o[6], o[7]);
#ifdef T_SC1
                if (r < u.nrow) __builtin_amdgcn_raw_buffer_store_b128(w, __builtin_amdgcn_make_buffer_rsrc(H1, 0, (int)((size_t)T * TOPK * FF * 2), 0x00020000), (unsigned)((u.arow + r) * (FF * 2) + fb * 2), 0, 16); } }
#else
                if (r < u.nrow) *(v4u*)(H1 + (size_t)(u.arow + r) * FF + fb) = w; } }
#endif
    }
};
struct EpiDn { bf16* YB; const float* bd;
    __device__ __forceinline__ void operator()(const pg8::f32x4 (&acc)[2][2][4][2], const pg8::Unit& u, int wr, int wc, int fr, int fq) const {
        const int c0 = u.pn * 256 + wc * 32 + 8 * fq;
#pragma unroll
        for (int bj = 0; bj < 2; ++bj) { const pg8::f32x4 d0 = *(const pg8::f32x4*)(bd + u.e * D + c0 + bj * 128), d1 = *(const pg8::f32x4*)(bd + u.e * D + c0 + bj * 128 + 4);
#pragma unroll
            for (int ai = 0; ai < 2; ++ai)
#pragma unroll
                for (int m = 0; m < 4; ++m) { const int r = ai * 128 + wr * 64 + m * 16 + fr;
                    const pg8::f32x4 a0 = acc[ai][bj][m][0] + d0, a1 = acc[ai][bj][m][1] + d1;
                    v4u w; w.x = pk2(a0[0], a0[1]); w.y = pk2(a0[2], a0[3]); w.z = pk2(a1[0], a1[1]); w.w = pk2(a1[2], a1[3]);
                    if (r < u.nrow) *(v4u*)(YB + (size_t)(u.arow + r) * D + c0 + bj * 128) = w; } }
    }
};
constexpr int CW_RDY = 8448;
constexpr int H2ROW0 = (int)(WS_H2 / 2048), H1ROW0 = (int)(WS_H1 / 2048), DN_BROW0 = (int)((WS_WDN_T - WS_WGU_T) / 2048);
struct MoeFused {
    static constexpr bool GATHER = true;
    const LAS int* tab; const int* elist; gu32* ctl; int G, c, base;
    __device__ __forceinline__ bool next(int i, pg8::Unit& u) const {
        const LAS int* sg = tab + MT_SEG; const int ns = sg[0], L = (base + i) * G + c; if (L >= sg[1 + ns]) return false;
        int s = 0; for (int k = 1; k < ns; ++k) if (sg[1 + k] <= L) s = k;
        if (i > 0 && sg[1 + MT_MAXSEG + s] == 1 && L - sg[1 + 3 * MT_MAXSEG + sg[1 + 2 * MT_MAXSEG + s]] < G) return false;
        const int kind = sg[1 + MT_MAXSEG + s], g = sg[1 + 2 * MT_MAXSEG + s], ui = L - sg[1 + s], TT = tab[64 + NE], tg = (TT - 32 * g) < 32 ? (TT - 32 * g) : 32;
        int rt, pn;
        if (kind == 0) { if (tg == 32) { const int xcd = ui & 7, slot = ui >> 3; rt = xcd * 4 + (slot >> 3); pn = slot & 7; } else { rt = ui >> 3; pn = ui & 7; } }
        else { if (tg == 32) { const int xcd = ui & 7, slot = ui >> 3; rt = xcd * 4 + (slot >> 2); pn = slot & 3; } else { rt = ui >> 2; pn = ui & 3; } }
        const int rtg = 32 * g + rt; int e = 0;
        for (int k = 1; k < NE; ++k) if (tab[64 + k] <= rtg) e = k;
        const int rte = rtg - tab[64 + e], cnt = tab[e], off = tab[32 + e], nr = cnt - rte * 256;
        u.e = __builtin_amdgcn_readfirstlane(e); u.pm = __builtin_amdgcn_readfirstlane(rte); u.pn = __builtin_amdgcn_readfirstlane(pn); u.kind = __builtin_amdgcn_readfirstlane(kind); u.aux = __builtin_amdgcn_readfirstlane(rtg);
        u.arow = __builtin_amdgcn_readfirstlane(off + rte * 256); u.nrow = __builtin_amdgcn_readfirstlane(nr > 256 ? 256 : nr);
        u.brow = __builtin_amdgcn_readfirstlane(kind == 0 ? e * 2048 + pn * 256 : DN_BROW0 + e * 1024 + pn * 256); return true;
    }
    __device__ __forceinline__ int arow_of(const pg8::Unit& u, int r) const { return u.kind == 0 ? H2ROW0 + (r < u.nrow ? elist[u.e * ELCAP + u.pm * 256 + r] : 0) : H1ROW0 + u.arow + (r < u.nrow ? r : 0); }
    __device__ __forceinline__ void a_ready(const pg8::Unit& u) const {
        if (u.kind != 1) return;
        if (threadIdx.x < 64) {
            gu32* w = ctl + CW_RDY + u.aux; const unsigned long long t0 = __builtin_amdgcn_s_memrealtime();
            while ((unsigned)__builtin_amdgcn_readfirstlane(__hip_atomic_load(w, RLX_AGENT)) < 64u) {
                if (__builtin_amdgcn_s_memrealtime() - t0 > 2000000ull) { if (threadIdx.x == 0) __hip_atomic_store(ctl + CW_TMO, 1u, RLX_AGENT); break; }
                __builtin_amdgcn_s_sleep(2); }
#ifdef MOE_DELAY
            { const unsigned long long t1 = __builtin_amdgcn_s_memrealtime(); while (__builtin_amdgcn_s_memrealtime() - t1 < 2000ull) __builtin_amdgcn_s_sleep(8); }
#endif
            __builtin_amdgcn_fence(__ATOMIC_ACQUIRE, "agent");
            asm volatile("s_waitcnt vmcnt(0)" ::: "memory");
        }
        asm volatile("" ::: "memory"); __builtin_amdgcn_s_barrier(); asm volatile("" ::: "memory");
    }
    __device__ __forceinline__ void done(const pg8::Unit& u) const {
        if (u.kind != 0) return;
#ifndef DIAG_NODRAIN
        asm volatile("s_waitcnt vmcnt(0)" ::: "memory");
#endif
#if defined(MOE_REL)
        __builtin_amdgcn_fence(__ATOMIC_RELEASE, "agent"); asm volatile("s_waitcnt vmcnt(0)" ::: "memory");
#endif
        if ((threadIdx.x & 63) == 0) __hip_atomic_fetch_add(ctl + CW_RDY + u.aux, 1u, RLX_AGENT);
    }
};
struct EpiMoe { bf16* H1; bf16* YB; const float* bg; const float* bu; const float* bd;
    __device__ __forceinline__ void operator()(const pg8::f32x4 (&acc)[2][2][4][2], const pg8::Unit& u, int wr, int wc, int fr, int fq) const {
        asm volatile("" : "+v"(fr), "+v"(fq));
        if (u.kind == 0) {
            const int f0 = u.pn * 128 + wc * 32 + 8 * fq;
            const __amdgpu_buffer_rsrc_t h1rs = __builtin_amdgcn_make_buffer_rsrc(H1, 0, (int)((size_t)T * TOPK * FF * 2), 0x00020000);
#pragma unroll
            for (int ai = 0; ai < 2; ++ai) {
                int fb = f0; asm volatile("" : "+v"(fb));
                const pg8::f32x4 g0 = *(const pg8::f32x4*)(bg + u.e * FF + fb), g1 = *(const pg8::f32x4*)(bg + u.e * FF + fb + 4);
                const pg8::f32x4 u0 = *(const pg8::f32x4*)(bu + u.e * FF + fb), u1 = *(const pg8::f32x4*)(bu + u.e * FF + fb + 4);
#pragma unroll
                for (int m = 0; m < 4; ++m) { const int r = ai * 128 + wr * 64 + m * 16 + fr;
                    const pg8::f32x4 a0 = acc[ai][0][m][0] + g0, a1 = acc[ai][0][m][1] + g1, b0 = acc[ai][1][m][0] + u0, b1 = acc[ai][1][m][1] + u1;
                    float gg[8] = {a0[0], a0[1], a0[2], a0[3], a1[0], a1[1], a1[2], a1[3]}, uu[8] = {b0[0], b0[1], b0[2], b0[3], b1[0], b1[1], b1[2], b1[3]}, o[8];
#pragma unroll
                    for (int i = 0; i < 8; ++i) { const float g = fminf(gg[i], 7.f), up = fminf(fmaxf(uu[i], -7.f), 7.f); o[i] = g * sigmoidf_(1.702f * g) * (up + 1.f); }
#ifdef MOE_PLAIN
                    if (r < u.nrow) { v4u w; w.x = pk2(o[0], o[1]); w.y = pk2(o[2], o[3]); w.z = pk2(o[4], o[5]); w.w = pk2(o[6], o[7]); *(GAS v4u*)(H1 + (size_t)(u.arow + r) * FF + fb) = w; } } }
#else
                    if (r < u.nrow) { v4u w; w.x = pk2(o[0], o[1]); w.y = pk2(o[2], o[3]); w.z = pk2(o[4], o[5]); w.w = pk2(o[6], o[7]);
                        __builtin_amdgcn_raw_buffer_store_b128(w, h1rs, (unsigned)((u.arow + r) * (FF * 2) + fb * 2), 0, 16); } } }
#endif
        } else {
            const int c0 = u.pn * 256 + wc * 32 + 8 * fq;
#pragma unroll
            for (int bj = 0; bj < 2; ++bj) { const pg8::f32x4 d0 = *(const pg8::f32x4*)(bd + u.e * D + c0 + bj * 128), d1 = *(const pg8::f32x4*)(bd + u.e * D + c0 + bj * 128 + 4);
#pragma unroll
                for (int ai = 0; ai < 2; ++ai)
#pragma unroll
                    for (int m = 0; m < 4; ++m) { const int r = ai * 128 + wr * 64 + m * 16 + fr;
                        const pg8::f32x4 a0 = acc[ai][bj][m][0] + d0, a1 = acc[ai][bj][m][1] + d1;
                        v4u w; w.x = pk2(a0[0], a0[1]); w.y = pk2(a0[2], a0[3]); w.z = pk2(a1[0], a1[1]); w.w = pk2(a1[2], a1[3]);
                        if (r < u.nrow) *(GAS v4u*)(YB + (size_t)(u.arow + r) * D + c0 + bj * 128) = w; } }
        }
    }
};
__device__ __forceinline__ void phase_final(Frame& F, bool dry = false) {
    moe_tables(F);
    const LAS int* off = (const LAS int*)(F.lds + SCR_OFF) + 32;
    LAS float* gtf = (LAS float*)(F.lds);
    const float* adaf = WSP(float, WS_ADAF);
    for (int i = F.tid; i < 2 * D; i += NWAVES * 64) { const int b = i >> 10, k = i & (D - 1); gtf[i] = adaf[b * 6 * D + 5 * D + k] * WSP(float, WS_PAR)[PAR_FPOST + k]; }
    __syncthreads();
    const int gw = F.vcu * NWAVES + F.wave, NGW = F.G * NWAVES, L = F.lane;
    const int* tok_e = WSP(int, WS_ROUTE); const float* tok_w = (const float*)(tok_e + T * 4); const int* tok_pos = tok_e + 2 * T * 4;
    const bf16* YB = WSP(bf16, WS_YB);
    for (int t = gw * 2; t < T; t += NGW * 2) { const int b = t >> 13;
        int row_l = 0; float w_l = 0.f;
        if (L < 8) { const int idx = (t + (L >> 2)) * 4 + (L & 3); row_l = off[tok_e[idx]] + tok_pos[idx]; w_l = tok_w[idx]; }
        v2u yv[2][4][4]; f32x4 x1v[2][4]; float wk[2][4];
#pragma unroll
        for (int q = 0; q < 2; ++q) {
#pragma unroll
            for (int k = 0; k < 4; ++k) { const int row = __shfl(row_l, q * 4 + k); wk[q][k] = __shfl(w_l, q * 4 + k);
                const GAS v2u* yr = (const GAS v2u*)(YB + (size_t)row * D) + L;
#pragma unroll
                for (int j = 0; j < 4; ++j) yv[q][k][j] = __builtin_nontemporal_load(yr + 64 * j);
#ifdef DRY14_NOYB
                if (dry) { _Pragma("unroll") for (int j = 0; j < 4; ++j) yv[q][k][j] = (v2u){0x3f803f80u, 0x3f803f80u}; }
#endif
            }
            const GAS f32x4* xr = (const GAS f32x4*)(F.out + (size_t)(t + q) * D) + L;
#pragma unroll
            for (int j = 0; j < 4; ++j) x1v[q][j] = __builtin_nontemporal_load(xr + 64 * j); }
#pragma unroll
        for (int q = 0; q < 2; ++q) {
            f32x4 y[4];
#pragma unroll
            for (int j = 0; j < 4; ++j) y[j] = (f32x4){0.f, 0.f, 0.f, 0.f};
#pragma unroll
            for (int k = 0; k < 4; ++k)
#pragma unroll
                for (int j = 0; j < 4; ++j) { const v2u x = yv[q][k][j]; const float w = wk[q][k]; y[j].x += w * bflo(x.x); y[j].y += w * bfhi(x.x); y[j].z += w * bflo(x.y); y[j].w += w * bfhi(x.y); }
            float s = 0.f;
#pragma unroll
            for (int j = 0; j < 4; ++j) s += (y[j].x * y[j].x + y[j].y * y[j].y) + (y[j].z * y[j].z + y[j].w * y[j].w);
            const float r = 1.f / sqrtf(wave_sum(s) * (1.f / D) + NORM_EPS);
            GAS f32x4* wrow = dry ? (GAS f32x4*)(WSP(float, WS_WGU_T) + (size_t)(t + q) * D) + L : (GAS f32x4*)(F.out + (size_t)(t + q) * D) + L;
#pragma unroll
            for (int j = 0; j < 4; ++j) { const f32x4 g = *(const LAS f32x4*)(gtf + b * D + 4 * L + 256 * j); __builtin_nontemporal_store(x1v[q][j] + g * (y[j] * r), wrow + 64 * j); }
        }
    }
}
__device__ __forceinline__ bool opaque_ws(Frame& F) { asm volatile("" : "+s"(F.ws)); return true; }
#ifndef MK_N_LAUNCHES
#define MK_N_LAUNCHES 1
#endif
constexpr int N_PHASES = 15;
struct Args { const float* in[30]; float* out; unsigned char* ws; int ph_lo, ph_hi; };
__global__ void __launch_bounds__(NWAVES * 64, 2) mega_fwd(Args args) {
    extern __shared__ __attribute__((aligned(16))) unsigned char lds[];
    Frame F;
    F.lds = (LAS unsigned char*)lds;
    F.MISC = (volatile LAS unsigned*)(F.lds + MISC_OFF);
    F.tid = threadIdx.x; F.lane = F.tid & 63; F.wave = __builtin_amdgcn_readfirstlane(F.tid >> 6);
    F.G = gridDim.x; { const int bx = blockIdx.x; F.vcu = (F.G % 8 == 0) ? (bx % 8) * (F.G / 8) + bx / 8 : bx; }
    F.ws = args.ws; F.ctl = (gu32*)(args.ws + WS_CTL); F.out = args.out;
#pragma unroll
    for (int i = 0; i < 30; ++i) F.in[i] = args.in[i];
    for (int u = F.tid; u < (LDS_BYTES - LDSCTL_OFF) / 4; u += NWAVES * 64) ((LAS unsigned*)(F.lds + LDSCTL_OFF))[u] = 0u;
    __syncthreads();
    XcdBarrier bar; bar.bar = (unsigned*)(F.ctl + CW_BAR); bar.x = 0; bar.st = nullptr;
    if (MK_N_LAUNCHES == 1) bar = xcd_barrier_post((unsigned*)(F.ctl + CW_BAR), F.MISC + 8);
    const int lo = args.ph_lo, hi = args.ph_hi;
#ifndef PHMASK
#define PHMASK 0x7fff
#endif
#define IN(k) (((PHMASK >> (k)) & 1) && lo <= (k) && (k) < hi)
#ifdef DBG_A
#define STAMP(k) do { if (blockIdx.x == 0 && F.tid == 0) ((unsigned long long*)(F.ctl + 2048))[k] = __builtin_amdgcn_s_memrealtime(); } while (0)
#else
#define STAMP(k) do {} while (0)
#endif
#ifndef REP_PHASE
#define REP_PHASE -1
#endif
#define REPL(k) for (int rep_ = 0; rep_ < (REP_PHASE == (k) ? 2 : 1); ++rep_) if (opaque_ws(F))
#ifdef DBL_BAR
#define SEAM(k) do { if (IN(k)) { xcd_barrier(bar); xcd_barrier(bar); } STAMP((k) + 1); } while (0)
#else
#define SEAM(k) do { if (IN(k)) xcd_barrier(bar); STAMP((k) + 1); } while (0)
#endif
    PG8_LAS unsigned char* ring = F.lds + RING_OFF;
    const int bx = (int)blockIdx.x;

    STAMP(0);
    if (IN(0)) REPL(0) { phase0(F); } SEAM(0);
    if (IN(1)) REPL(1) { phase1(F); } SEAM(1);
    if (IN(2)) REPL(2) {
        pg8::Gemm g{WSP(bf16, WS_XN), WSP(bf16, WS_WIN_T), D, D, D}; pg8::DenseOrder S; S.init(T, INW, F.G, bx);
        EpiG1 E{WSP(bf16, WS_UA), WSP(bf16, WS_Q), WSP(bf16, WS_K), WSP(bf16, WS_V), WSP(bf16, WS_VT), WSP(bf16, WS_GS), WSP(bf16, WS_GA),
                WSP(float, WS_ROPE), WSP(float, WS_ROPE) + (size_t)T * 32, (float*)(F.ctl + CW_KM)};
        pg8::gemm_phase(ring, g, S, E);
        s5_fill_kt(F);
    } SEAM(2);
    if (IN(3)) REPL(3) {
        pg8::Gemm g{WSP(bf16, WS_UA), WSP(bf16, WS_S5M1), 384, 256, 256}; S5Order S{F.G, bx}; EpiS5A E{WSP(float, WS_S5E)};
        pg8::gemm_phase(ring, g, S, E);
        s5_fill_wc(F);
        attn_gate(F);
    } SEAM(3);
    if (IN(4)) REPL(4) { attn_items(F); s5_carry(F); } SEAM(4);
    if (IN(5)) REPL(5) {
        pg8::Gemm g{WSP(bf16, WS_UA), WSP(bf16, WS_S5WC), 384, 384, 384}; S5Order S{F.G, bx}; EpiS5C E{WSP(bf16, WS_YG)};
        pg8::gemm_phase(ring, g, S, E);
        attn_combine(F);
    } SEAM(5);
    if (IN(6)) REPL(6) {
        pg8::Gemm g{WSP(bf16, WS_YG), WSP(bf16, WS_WGLU_T), SW, SW, SW}; pg8::DenseOrder S; S.init(T, SW, F.G, bx);
        EpiEw<0> E{WSP(bf16, WS_Y2), WSP(bf16, WS_YG), nullptr, nullptr, SW};
        pg8::gemm_phase(ring, g, S, E);
    } SEAM(6);
    if (IN(7)) REPL(7) {
        pg8::Gemm g{WSP(bf16, WS_Y2), WSP(bf16, WS_WSB_T), SW, SW, SW}; pg8::DenseOrder S; S.init(T, D, F.G, bx);
        EpiEw<1> E{WSP(bf16, WS_M1), WSP(bf16, WS_GS), nullptr, nullptr, D};
        pg8::gemm_phase(ring, g, S, E);
    } SEAM(7);
    if (IN(8)) REPL(8) {
        pg8::Gemm g{WSP(bf16, WS_YA), WSP(bf16, WS_WAB_T), AW, AW, AW}; pg8::DenseOrder S; S.init(T, D, F.G, bx);
        EpiEw<2> E{WSP(bf16, WS_XN), WSP(bf16, WS_GA), WSP(bf16, WS_M1), nullptr, D};
        pg8::gemm_phase(ring, g, S, E);
    } SEAM(8);
    if (IN(9)) REPL(9) {
        pg8::Gemm g{WSP(bf16, WS_XN), WSP(bf16, WS_WOUT_T), D, D, D}; pg8::DenseOrder S; S.init(T, D, F.G, bx);
        EpiEw<3> E{nullptr, nullptr, nullptr, WSP(float, WS_MIX), D};
        pg8::gemm_phase(ring, g, S, E);
    } SEAM(9);
    if (IN(10)) REPL(10) { phase_rows(F, REP_PHASE == 10 && rep_ == 0); } SEAM(10);
#ifndef MOE_FUSED
    if (IN(12)) REPL(12) {
        moe_tables(F);
        pg8::Gemm g{WSP(bf16, WS_H2), WSP(bf16, WS_WGU_T), D, D, D}; MoeOrder<true> S{(const LAS int*)(F.lds + SCR_OFF), WSP(int, WS_ELIST), 8, 2048, F.G, bx};
        EpiGU E{WSP(bf16, WS_H1), WSP(float, WS_PAR) + PAR_BG, WSP(float, WS_PAR) + PAR_BU};
        pg8::gemm_phase(ring, g, S, E);
    } SEAM(12);
    if (IN(13)) REPL(13) {
        moe_tables(F);
        pg8::Gemm g{WSP(bf16, WS_H1), WSP(bf16, WS_WDN_T), FF, FF, FF}; MoeOrder<false> S{(const LAS int*)(F.lds + SCR_OFF), nullptr, 4, 1024, F.G, bx};
        EpiDn E{WSP(bf16, WS_YB), WSP(float, WS_PAR) + PAR_BD};
        pg8::gemm_phase(ring, g, S, E);
    } SEAM(13);
#else
    if (IN(12)) REPL(12) {
        moe_tables(F);
        pg8::Gemm g{(const bf16*)F.ws, WSP(bf16, WS_WGU_T), D, D, D};
        EpiMoe E{WSP(bf16, WS_H1), WSP(bf16, WS_YB), WSP(float, WS_PAR) + PAR_BG, WSP(float, WS_PAR) + PAR_BU, WSP(float, WS_PAR) + PAR_BD};
        for (int base = 0;;) { MoeFused S{(const LAS int*)(F.lds + SCR_OFF), WSP(int, WS_ELIST), F.ctl, F.G, bx, base};
            const int nd = pg8::gemm_phase(ring, g, S, E); if (nd == 0) break; base += nd; }
    } SEAM(12);
#endif
    if (IN(14)) REPL(14) { phase_final(F, REP_PHASE == 14 && rep_ == 0); }
#undef IN
#undef SEAM
}

extern "C" void kernel_launch(void* const* d_in, const int* in_sizes, int n_in, void* d_out, int out_size, void* d_ws, size_t ws_size, hipStream_t stream) {
    static int grid = 0;
    if (grid == 0) {
        if (n_in != 30 || in_sizes[0] != T * D || out_size != T * D || ws_size < WS_END) { fprintf(stderr, "kernel_launch: unexpected shapes (n_in %d, in0 %d, out %d, ws %zu)\n", n_in, n_in > 0 ? in_sizes[0] : -1, out_size, ws_size); grid = -1; return; }
        int dev = 0, cus = 0, per_cu = 0;
        if (hipGetDevice(&dev) != hipSuccess || hipDeviceGetAttribute(&cus, hipDeviceAttributeMultiprocessorCount, dev) != hipSuccess) { grid = -1; return; }
        if (hipFuncSetAttribute((const void*)mega_fwd, hipFuncAttributeMaxDynamicSharedMemorySize, LDS_BYTES) != hipSuccess) { fprintf(stderr, "kernel_launch: hipFuncSetAttribute failed\n"); grid = -1; return; }
        if (hipOccupancyMaxActiveBlocksPerMultiprocessor(&per_cu, (const void*)mega_fwd, NWAVES * 64, LDS_BYTES) != hipSuccess || per_cu < 1) { fprintf(stderr, "kernel_launch: occupancy query says %d\n", per_cu); }
        (void)hipGetLastError();
        grid = cus;
    }
    if (grid < 0) return;
    (void)hipMemsetAsync((char*)d_ws + WS_CTL, 0, CTL_ZERO_USED, stream);
    Args a{};
    for (int i = 0; i < 30; ++i) a.in[i] = (const float*)d_in[i];
    a.out = (float*)d_out; a.ws = (unsigned char*)d_ws;
#ifndef PLAIN_LAUNCH
    if (MK_N_LAUNCHES == 1) { a.ph_lo = 0; a.ph_hi = N_PHASES; void* kargs[] = {(void*)&a};
        const hipError_t e = hipLaunchCooperativeKernel((const void*)mega_fwd, dim3(grid), dim3(NWAVES * 64), kargs, LDS_BYTES, stream);
        if (e != hipSuccess) fprintf(stderr, "kernel_launch: cooperative launch failed: %s\n", hipGetErrorString(e)); }
#else
    if (MK_N_LAUNCHES == 1) { a.ph_lo = 0; a.ph_hi = N_PHASES; hipLaunchKernelGGL(mega_fwd, dim3(grid), dim3(NWAVES * 64), LDS_BYTES, stream, a); }
#endif
    else for (int p = 0; p < N_PHASES; ++p) { a.ph_lo = p; a.ph_hi = p + 1; hipLaunchKernelGGL(mega_fwd, dim3(grid), dim3(NWAVES * 64), LDS_BYTES, stream, a); }
}
```

```cpp
#include <hip/hip_runtime.h>
#include <cstdio>
#include <cstdint>
#define MK_N_LAUNCHES 1
namespace pg8 {
#define PG8_LAS __attribute__((address_space(3)))
typedef unsigned short bf16_t;
typedef short bf16x8 __attribute__((ext_vector_type(8)));
typedef float f32x4 __attribute__((ext_vector_type(4)));
typedef unsigned u32x4 __attribute__((ext_vector_type(4)));
typedef unsigned u32x2 __attribute__((ext_vector_type(2)));
constexpr int BM = 256, BK = 64, HALF = 128, HTB = HALF * BK * 2  , STAGE_BYTES = 8 * HTB, NXCD = 8, WGM = 8;

__host__ __device__ __forceinline__ int lds_byte(int r, int c) { const int st = (r >> 4) * 2 + (c >> 5), rr = r & 15, cc = c & 31, ob = rr * 64 + cc * 2; return st * 1024 + (ob ^ (((ob >> 9) & 1) << 5)); }
__host__ __device__ __forceinline__ void stage_rc(int b, int& R, int& C) { const int st = b / 1024, sb = b % 1024, swz = sb ^ (((sb >> 9) & 1) << 5); R = (st >> 1) * 16 + swz / 64; C = (st & 1) * 32 + (swz % 64) / 2; }

struct Unit { int arow, brow, pm, pn, e, nrow, kind, aux; };
struct Gemm { const bf16_t* A; const bf16_t* Bt; int lda, ldb, K; };

struct DenseOrder {
    static constexpr bool GATHER = false;
    __device__ __forceinline__ void a_ready(const Unit&) const {}
    __device__ __forceinline__ void done(const Unit&) const {}
    int nM, nN, nwg, G, c;
    __device__ __forceinline__ void init(int M, int N, int G_, int c_) { nM = M / BM; nN = N / BM; nwg = nM * nN; G = G_; c = c_; }
    __device__ __forceinline__ bool next(int i, Unit& u) const {
        const long L = (long)i * G + c; if (L >= nwg) return false;
        int wgid = (int)L; { const int q = nwg / NXCD, r = nwg % NXCD, xcd = wgid % NXCD, off = wgid / NXCD; wgid = (xcd < r ? xcd * (q + 1) : r * (q + 1) + (xcd - r) * q) + off; }
        const int nig = WGM * nN, gid = wgid / nig, fm = gid * WGM, gsz = (nM - fm) < WGM ? (nM - fm) : WGM;
        u.pm = fm + ((wgid % nig) % gsz); u.pn = (wgid % nig) / gsz; u.arow = u.pm * BM; u.brow = u.pn * BM; u.e = 0; u.nrow = BM; u.kind = 0; u.aux = 0; return true;
    }
};

template <class Epi, class Sched>
__device__ __forceinline__ int gemm_phase(PG8_LAS unsigned char* lds, const Gemm g, const Sched& S, const Epi& E) {
    const int tid = threadIdx.x, wid = __builtin_amdgcn_readfirstlane(tid >> 6), lane = tid & 63, wr = wid >> 2, wc = wid & 3, fr = lane & 15, fq = lane >> 4;
    const int K = g.K, nt = K / BK;
    constexpr bool GA = Sched::GATHER;
    unsigned voffA[2], voffB[2]; int gR[2]; unsigned gC[2];
#pragma unroll
    for (int i = 0; i < 2; ++i) { int R, C; stage_rc(tid * 16 + i * 8192, R, C); gR[i] = R; gC[i] = (unsigned)C * 2u;
        voffA[i] = (unsigned)(R * g.lda + C) * 2u; voffB[i] = (unsigned)(R * g.ldb + C) * 2u; }
    unsigned gA_cur[2][2], gA_nxt[2][2];
#define PG8_GATH(dst, un) do { _Pragma("unroll") for (int _h = 0; _h < 2; ++_h) _Pragma("unroll") for (int _i = 0; _i < 2; ++_i) dst[_h][_i] = (unsigned)S.arow_of(un, _h * HALF + gR[_i]) * (unsigned)(g.lda * 2) + gC[_i]; } while (0)
#define PG8_STAGE_A(bufoff, h, kbytes, nx) do { if constexpr (GA) { const char* gb_ = (const char*)g.A + (kbytes); _Pragma("unroll") for (int _i = 0; _i < 2; ++_i) { const unsigned vo_ = (nx) ? gA_nxt[h][_i] : gA_cur[h][_i]; \
        __builtin_amdgcn_global_load_lds((const unsigned*)(gb_ + vo_), (PG8_LAS unsigned*)(lds + (bufoff) + ldsw + _i * 8192), 16, 0, 0); } } \
    else { const char* gb_ = ((nx) ? nA : cA) + (kbytes) + (h) * hstepA; PG8_STAGE(bufoff, gb_, voffA); } } while (0)
    const size_t kstep = (size_t)(BK * 2);
    const size_t hstepA = (size_t)HALF * g.lda * 2, hstepB = (size_t)HALF * g.ldb * 2;
    const size_t rowA = (size_t)g.lda * 2, rowB = (size_t)g.ldb * 2;
    const unsigned ldsw = (unsigned)wid * 1024u;
    const int aoff = lds_byte(wr * 64 + fr, fq * 8), boff = lds_byte(wc * 32 + fr, fq * 8);
#define PG8_SA(b, h) (((b) * 2 + (h)) * HTB)
#define PG8_SB(b, h) ((4 + (b) * 2 + (h)) * HTB)
#define PG8_STAGE(bufoff, gbase, voff) do { _Pragma("unroll") for (int _i = 0; _i < 2; ++_i) \
        __builtin_amdgcn_global_load_lds((const unsigned*)((const char*)(gbase) + (voff)[_i]), (PG8_LAS unsigned*)(lds + (bufoff) + ldsw + _i * 8192), 16, 0, 0); } while (0)
#define PG8_LDA(dst, b, h) do { _Pragma("unroll") for (int m = 0; m < 4; ++m) _Pragma("unroll") for (int k = 0; k < 2; ++k) dst[m][k] = *(const PG8_LAS bf16x8*)(lds + PG8_SA(b, h) + aoff + m * 2048 + k * 1024); } while (0)
#define PG8_LDB(dst, b, h) do { _Pragma("unroll") for (int n = 0; n < 2; ++n) _Pragma("unroll") for (int k = 0; k < 2; ++k) dst[n][k] = *(const PG8_LAS bf16x8*)(lds + PG8_SB(b, h) + boff + n * 2048 + k * 1024); } while (0)
#define PG8_MMA(ai, bj, At, Bt) do { __builtin_amdgcn_s_setprio(1); _Pragma("unroll") for (int m = 0; m < 4; ++m) _Pragma("unroll") for (int n = 0; n < 2; ++n) _Pragma("unroll") for (int k = 0; k < 2; ++k) \
        acc[ai][bj][m][n] = __builtin_amdgcn_mfma_f32_16x16x32_bf16(Bt[n][k], At[m][k], acc[ai][bj][m][n], 0, 0, 0); __builtin_amdgcn_s_setprio(0); } while (0)
#define PG8_WAIT_V(n) asm volatile("s_waitcnt vmcnt(" #n ")" ::: "memory")
#define PG8_WAIT_L(n) asm volatile("s_waitcnt lgkmcnt(" #n ")" ::: "memory")
#define PG8_BAR __builtin_amdgcn_s_barrier()
#define PG8_SCHED __builtin_amdgcn_sched_barrier(0)
    Unit cur, nxt; int ui = 0;
    if (!S.next(0, cur)) return 0;
    f32x4 acc[2][2][4][2];
#pragma unroll
    for (int a = 0; a < 2; ++a)
#pragma unroll
        for (int b = 0; b < 2; ++b)
#pragma unroll
            for (int m = 0; m < 4; ++m)
#pragma unroll
                for (int n = 0; n < 2; ++n) acc[a][b][m][n] = (f32x4){0.f, 0.f, 0.f, 0.f};
    bf16x8 At[4][2], B0[2][2], B1[2][2];
    const char* cA = GA ? (const char*)g.A : (const char*)g.A + (size_t)cur.arow * rowA; const char* cB = (const char*)g.Bt + (size_t)cur.brow * rowB; const char* nA = cA;
    if constexpr (GA) { PG8_GATH(gA_cur, cur); }
    S.a_ready(cur);
    PG8_STAGE(PG8_SB(0, 0), cB, voffB); PG8_STAGE(PG8_SB(0, 1), cB + hstepB, voffB); PG8_STAGE_A(PG8_SA(0, 0), 0, 0, false); PG8_STAGE_A(PG8_SA(0, 1), 1, 0, false);
    if (wr == 1) PG8_BAR;
    PG8_WAIT_V(2); PG8_BAR;
    PG8_STAGE(PG8_SB(1, 0), cB + kstep, voffB); PG8_STAGE_A(PG8_SA(1, 0), 0, kstep, false); PG8_STAGE(PG8_SB(1, 1), cB + hstepB + kstep, voffB);
    PG8_WAIT_V(6); PG8_BAR;
    for (;;) {
        const bool has_next = S.next(ui + 1, nxt);
        nA = GA ? cA : (has_next ? (const char*)g.A + (size_t)nxt.arow * rowA : cA); const char* nB = has_next ? (const char*)g.Bt + (size_t)nxt.brow * rowB : cB;
        if constexpr (GA) { if (has_next) { PG8_GATH(gA_nxt, nxt); } else { _Pragma("unroll") for (int _h = 0; _h < 2; ++_h) _Pragma("unroll") for (int _i = 0; _i < 2; ++_i) gA_nxt[_h][_i] = gA_cur[_h][_i]; } }
#pragma unroll 1
        for (int t = 0; t < nt; t += 2) {
            const bool last = (t == nt - 2);
            if (last && has_next) S.a_ready(nxt);
            const size_t k1 = (size_t)(t + 1) * kstep, k2 = last ? (size_t)0 : (size_t)(t + 2) * kstep, k3 = k2 + kstep;
            const char* b2 = last ? nB : cB + (size_t)(t + 2) * kstep; const char* b3 = b2 + kstep;
            PG8_LDB(B0, 0, 0); PG8_LDB(B1, 0, 1); PG8_SCHED; PG8_LDA(At, 0, 0); PG8_STAGE_A(PG8_SA(1, 1), 1, k1, false);
            PG8_WAIT_V(8); PG8_WAIT_L(0); PG8_BAR; PG8_MMA(0, 0, At, B0); PG8_MMA(0, 1, At, B1); PG8_BAR; PG8_SCHED;
            PG8_LDA(At, 0, 1); PG8_STAGE(PG8_SB(0, 0), b2, voffB); PG8_STAGE(PG8_SB(0, 1), b2 + hstepB, voffB); PG8_STAGE_A(PG8_SA(0, 0), 0, k2, last);
            PG8_WAIT_V(8); PG8_WAIT_L(0); PG8_BAR; PG8_MMA(1, 0, At, B0); PG8_MMA(1, 1, At, B1); PG8_BAR; PG8_SCHED;
            PG8_LDB(B0, 1, 0); PG8_LDB(B1, 1, 1); PG8_SCHED; PG8_LDA(At, 1, 0); PG8_STAGE_A(PG8_SA(0, 1), 1, k2, last);
            PG8_WAIT_V(8); PG8_WAIT_L(0); PG8_BAR; PG8_MMA(0, 0, At, B0); PG8_MMA(0, 1, At, B1); PG8_BAR; PG8_SCHED;
            PG8_LDA(At, 1, 1); PG8_STAGE(PG8_SB(1, 0), b3, voffB); PG8_STAGE(PG8_SB(1, 1), b3 + hstepB, voffB); PG8_STAGE_A(PG8_SA(1, 0), 0, k3, last);
            PG8_WAIT_V(8); PG8_WAIT_L(0); PG8_BAR; PG8_MMA(1, 0, At, B0); PG8_MMA(1, 1, At, B1); PG8_BAR; PG8_SCHED;
        }
        if (wr == 0) PG8_BAR;
        E(acc, cur, wr, wc, fr, fq);
        S.done(cur);
        if (!has_next) break;
#pragma unroll
        for (int a = 0; a < 2; ++a)
#pragma unroll
            for (int b = 0; b < 2; ++b)
#pragma unroll
                for (int m = 0; m < 4; ++m)
#pragma unroll
                    for (int n = 0; n < 2; ++n) acc[a][b][m][n] = (f32x4){0.f, 0.f, 0.f, 0.f};
        cur = nxt; cA = nA; cB = nB; ++ui;
        if constexpr (GA) { _Pragma("unroll") for (int _h = 0; _h < 2; ++_h) _Pragma("unroll") for (int _i = 0; _i < 2; ++_i) gA_cur[_h][_i] = gA_nxt[_h][_i]; }
        if (wr == 1) PG8_BAR;
    }
    PG8_WAIT_V(0);
    PG8_BAR;
    const int n_done_ = ui + 1;
#undef PG8_SA
#undef PG8_SB
#undef PG8_STAGE
#undef PG8_STAGE_A
#undef PG8_GATH
#undef PG8_LDA
#undef PG8_LDB
#undef PG8_MMA
#undef PG8_WAIT_V
#undef PG8_WAIT_L
#undef PG8_BAR
#undef PG8_SCHED
    return n_done_;
}
}
constexpr int NWAVES = 8;
constexpr int BATCH = 2, SEQ = 8192, T = BATCH * SEQ, D = 1024, NH = 8, HD = 64, AW = 512, SW = 512, NG = 32, NP = 64, GS16 = 16;
constexpr int NE = 32, FF = 1024, INW = 4096, TOPK = 4, NBLK = SEQ / 256;
constexpr float NORM_EPS = 1e-6f;
constexpr float C2 = 0.125f * 1.4426950408889634f;
constexpr int XROWS = T * TOPK + 256;

constexpr size_t MiB = 1u << 20;
constexpr size_t WS_CTL = 0, CTL_ZERO_BYTES = 1 * MiB;
constexpr size_t WS_ADA = 1 * MiB;
constexpr size_t WS_ADAF = WS_ADA + 832 * 1024;
constexpr size_t WS_ROPE = 2 * MiB;
constexpr size_t WS_S5P = 6 * MiB;
constexpr size_t WS_S5KT = 7 * MiB;
constexpr size_t WS_S5M1 = 10 * MiB;
constexpr size_t WS_S5WC = 506 * MiB;
constexpr size_t WS_S5E = 408 * MiB;
constexpr size_t WS_ROUTE = 9 * MiB;
constexpr size_t WS_ELIST = 14 * MiB; constexpr int ELCAP = T;
constexpr size_t WS_WIN_T = 18 * MiB, WS_WGLU_T = 26 * MiB, WS_WSB_T = 27 * MiB, WS_WAB_T = 28 * MiB, WS_WOUT_T = 29 * MiB;
constexpr size_t WS_PAR = 16 * MiB;
constexpr int PAR_MPG = 0, PAR_FPRE = 1024, PAR_FPOST = 2048, PAR_RB = 3072, PAR_RW = 4096, PAR_BG = 36864, PAR_BU = 69632, PAR_BD = 102400, PAR_CRE = 135168, PAR_CIM = 167936, PAR_SD = 200704, PAR_BRE = 201728, PAR_BIM = 234496;
constexpr size_t WS_WGU_T = 32 * MiB, WS_WDN_T = 160 * MiB;
constexpr size_t WS_XN = 224 * MiB;
constexpr size_t WS_UA = 256 * MiB, WS_Q = 280 * MiB, WS_K = 296 * MiB, WS_V = 312 * MiB, WS_VT = 328 * MiB;
constexpr size_t WS_MIX = 256 * MiB;
constexpr size_t WS_GS = 344 * MiB, WS_GA = 376 * MiB;
constexpr size_t WS_YG = 408 * MiB, WS_Y2 = 424 * MiB, WS_YA = 440 * MiB;
constexpr size_t WS_M1 = 456 * MiB;
constexpr size_t WS_H2 = 480 * MiB;
constexpr size_t WS_XG = 224 * MiB, WS_YB = 224 * MiB;
constexpr size_t WS_H1 = 352 * MiB;
constexpr size_t WS_END = 512 * MiB;
static_assert(WS_YB + (size_t)T * TOPK * D * 2 <= WS_H1 && WS_H1 + (size_t)T * TOPK * FF * 2 <= WS_H2 && WS_H2 + (size_t)T * D * 2 <= WS_END, "ws map");
constexpr int CW_TMO = 0, CW_CODE = 1, CW_BAR = 4096, CW_ECNT = 8192, CW_KM = 16384;
constexpr size_t CTL_ZERO_USED = (size_t)(CW_KM + BATCH * NH * NBLK * HD) * 4;
static_assert(CTL_ZERO_USED <= CTL_ZERO_BYTES, "ctl");

constexpr int RING_OFF = 0, RING_BYTES = 131072;
constexpr int LDSCTL_OFF = 152 * 1024, MISC_OFF = LDSCTL_OFF + 320;
constexpr int LDS_BYTES = 156 * 1024;

#define GAS __attribute__((address_space(1)))
#define LAS __attribute__((address_space(3)))
typedef unsigned short bf16;
typedef unsigned v4u __attribute__((ext_vector_type(4)));
typedef unsigned v2u __attribute__((ext_vector_type(2)));
typedef float f32x4 __attribute__((ext_vector_type(4)));
typedef GAS unsigned gu32;
#define RLX_AGENT __ATOMIC_RELAXED, __HIP_MEMORY_SCOPE_AGENT
#define LDS_WAIT() asm volatile("s_waitcnt lgkmcnt(0)" ::: "memory")
#define VM_WAIT() asm volatile("s_waitcnt vmcnt(0)" ::: "memory")
__device__ __forceinline__ unsigned f2bf(float f) { unsigned u = __builtin_bit_cast(unsigned, f); return (u + 0x7fffu + ((u >> 16) & 1u)) >> 16; }
__device__ __forceinline__ unsigned pk2(float lo, float hi) { typedef float f32x2_t __attribute__((ext_vector_type(2))); typedef __bf16 bf16x2_t __attribute__((ext_vector_type(2)));
    f32x2_t v = {lo, hi}; bf16x2_t r = __builtin_convertvector(v, bf16x2_t); return __builtin_bit_cast(unsigned, r); }
#ifdef WT_STORES
__device__ __forceinline__ void st16(void* p, v4u v) { asm volatile("global_store_dwordx4 %0, %1, off sc1\n\ts_nop 1" :: "v"(p), "v"(v) : "memory"); }
__device__ __forceinline__ void st8(void* p, v2u v) { asm volatile("global_store_dwordx2 %0, %1, off sc1\n\ts_nop 1" :: "v"(p), "v"(v) : "memory"); }
#else
__device__ __forceinline__ void st16(void* p, v4u v) { *(v4u*)p = v; }
__device__ __forceinline__ void st8(void* p, v2u v) { *(v2u*)p = v; }
#endif
__device__ __forceinline__ float bflo(unsigned w) { return __builtin_bit_cast(float, w << 16); }
__device__ __forceinline__ float bfhi(unsigned w) { return __builtin_bit_cast(float, w & 0xffff0000u); }
__device__ __forceinline__ float bf2f(bf16 h) { return __builtin_bit_cast(float, (unsigned)h << 16); }
__device__ __forceinline__ float sigmoidf_(float x) { return 1.f / (1.f + __expf(-x)); }
__device__ __forceinline__ float gelu_tanh(float x) { const float u = 1.5957691216057308f * (x + 0.044715f * x * x * x); return x / (1.f + __expf(-u)); }

#define XB_TMO      128
#define XB_XCNT(j)  (256  + 64 * (j))
#define XB_XSUB(j)  (1280 + 64 * (j))
#define XB_XGEN(j)  (2304 + 64 * (j))
#define XB_TOP      3328
#define XB_TOPGEN   3392
#define XCD_BAR_WORDS 3456
#define XB_SPIN_CAP (1u << 18)
__device__ __forceinline__ unsigned xb_ld(unsigned* p)              { return __hip_atomic_load(p, __ATOMIC_RELAXED, __HIP_MEMORY_SCOPE_AGENT); }
__device__ __forceinline__ unsigned xb_add(unsigned* p, unsigned v) { return __hip_atomic_fetch_add(p, v, __ATOMIC_RELAXED, __HIP_MEMORY_SCOPE_AGENT); }
__device__ __forceinline__ unsigned xb_xcc_id() { return (unsigned)__builtin_amdgcn_s_getreg((3 << 11) | 20) & 0xFu; }
#define XB_SPIN(cond, bar) do { unsigned _sp = 0; while (cond) { __builtin_amdgcn_s_sleep(1); \
    if ((++_sp & 255u) == 0u) { if (xb_ld(&(bar)[XB_TMO])) break; if (_sp > XB_SPIN_CAP) { atomicAdd(&(bar)[XB_TMO], 1u); break; } } } } while (0)
struct XcdBarrier { unsigned* bar; unsigned x; volatile LAS unsigned* st; };
__device__ __forceinline__ XcdBarrier xcd_barrier_post(unsigned* bar, volatile LAS unsigned* st) {
    XcdBarrier b; b.bar = bar; b.x = xb_xcc_id(); b.st = st;
    if (threadIdx.x == 0) (void)xb_add(&bar[XB_XCNT(b.x)], 1u);
    return b;
}
__device__ __forceinline__ void xcd_barrier_complete(unsigned* bar, unsigned x, unsigned& nloc, unsigned& nx) {
    const unsigned G = gridDim.x * gridDim.y * gridDim.z;
    unsigned sum, cnt, mine, sp = 0u;
    for (;;) {
        sum = 0u; cnt = 0u; mine = 0u;
#pragma unroll
        for (unsigned j = 0; j < 16; ++j) { const unsigned c = xb_ld(&bar[XB_XCNT(j)]); sum += c; cnt += (c > 0u) ? 1u : 0u; mine = (j == x) ? c : mine; }
        if (sum == G) break;
        __builtin_amdgcn_s_sleep(1);
        if ((++sp & 255u) == 0u) { if (xb_ld(&bar[XB_TMO])) break; if (sp > XB_SPIN_CAP) { atomicAdd(&bar[XB_TMO], 1u); break; } }
    }
    nloc = mine > 0u ? mine : 1u; nx = cnt > 0u ? cnt : 1u;
}
__device__ __forceinline__ void xcd_barrier(const XcdBarrier& b) {
    asm volatile("s_waitcnt vmcnt(0)" ::: "memory");
    __syncthreads();
    if (threadIdx.x == 0) {
        unsigned* bar = b.bar;
        __builtin_amdgcn_s_waitcnt(0);
        unsigned nloc = b.st[0], nx = b.st[1];
        if (nloc == 0u) { xcd_barrier_complete(bar, b.x, nloc, nx); b.st[0] = nloc; b.st[1] = nx; }
        const unsigned old = xb_add(&bar[XB_XSUB(b.x)], 1u);
        const unsigned gen = old / nloc;
        if (old + 1u == (gen + 1u) * nloc) {
            __builtin_amdgcn_fence(__ATOMIC_RELEASE, "agent");
            asm volatile("s_waitcnt vmcnt(0)" ::: "memory");
            const unsigned og = xb_add(&bar[XB_TOP], 1u);
            const unsigned tg = og / nx;
            if (og + 1u == (tg + 1u) * nx) xb_add(&bar[XB_TOPGEN], 1u);
            else XB_SPIN(xb_ld(&bar[XB_TOPGEN]) == tg, bar);
            __builtin_amdgcn_fence(__ATOMIC_ACQUIRE, "agent");
            xb_add(&bar[XB_XGEN(b.x)], 1u);
            asm volatile("s_waitcnt vmcnt(0)" ::: "memory");
        } else {
            XB_SPIN(xb_ld(&bar[XB_XGEN(b.x)]) == gen, bar);
            __builtin_amdgcn_fence(__ATOMIC_ACQUIRE, "agent");
            asm volatile("s_waitcnt vmcnt(0)" ::: "memory");
        }
    }
    __syncthreads();
}

__device__ __forceinline__ float wave_sum(float v) {
#pragma unroll
    for (int o = 1; o < 64; o <<= 1) v += __shfl_xor(v, o);
    return v;
}
__device__ __forceinline__ float wave_max(float v) {
#pragma unroll
    for (int o = 1; o < 64; o <<= 1) v = fmaxf(v, __shfl_xor(v, o));
    return v;
}
struct Frame {
    LAS unsigned char* lds;
    volatile LAS unsigned* MISC;
    gu32* ctl;
    int tid, lane, wave;
    int vcu, G;
    unsigned char* ws;
    const float* in[30];
    float* out;
};
#define WSP(T_, off) ((T_*)(F.ws + (off)))

__device__ __forceinline__ int perm8(int c) { return (c & ~31) + 16 * ((c >> 2) & 1) + 4 * ((c >> 3) & 3) + (c & 3); }
struct MapP8 { int off; __device__ __forceinline__ int operator()(int n) const { return off + perm8(n); } };
struct MapWin { __device__ __forceinline__ int operator()(int c) const {
    if (c < 512 || c >= 1536) return perm8(c);
    const int base = (c < 1024) ? 512 : 1024, cc = c - base, head = cc >> 6, d = cc & 63, pnq = head >> 2, hh = head & 3, n = d >> 5, dd = d & 31;
    const int wc = 2 * (hh & 1) + (dd >> 4), bj = hh >> 1, j = dd & 15;
    return base + 256 * pnq + 128 * bj + 32 * wc + 16 * n + j; } };
struct MapGU { int e, up; __device__ __forceinline__ int operator()(int f) const { return e * 2048 + (f >> 7) * 256 + up * 128 + perm8(f & 127); } };

template <class RowMap>
__device__ __forceinline__ void p0_transpose_item(const float* W, int K, int N, bf16* WT, LAS float* scr, int item, int lane, const RowMap rm) {
    const int nblk = N / 64, kb = item / nblk, nb = item % nblk, k0 = 64 * kb, n0 = 64 * nb;
    const int lr = lane >> 4, lc = 4 * (lane & 15);
    f32x4 v[16];
#pragma unroll
    for (int i = 0; i < 16; ++i) v[i] = __builtin_nontemporal_load((const GAS f32x4*)(W + (size_t)(k0 + 4 * i + lr) * N + n0 + lc));
#pragma unroll
    for (int i = 0; i < 16; ++i) { LAS float* d = scr + (4 * i + lr) * 65 + lc; d[0] = v[i].x; d[1] = v[i].y; d[2] = v[i].z; d[3] = v[i].w; }
    LDS_WAIT(); asm volatile("" ::: "memory");
    const int c = lane & 7;
#pragma unroll
    for (int j = 0; j < 8; ++j) { const int n = (lane >> 3) + 8 * j; const LAS float* s = scr + (8 * c) * 65 + n;
        v4u o; o.x = pk2(s[0 * 65], s[1 * 65]); o.y = pk2(s[2 * 65], s[3 * 65]); o.z = pk2(s[4 * 65], s[5 * 65]); o.w = pk2(s[6 * 65], s[7 * 65]);
        __builtin_nontemporal_store(o, (GAS v4u*)(WT + (size_t)rm(n0 + n) * K + k0 + 8 * c)); }
    LDS_WAIT(); asm volatile("" ::: "memory");
}

__device__ __forceinline__ void phase0(Frame& F) {
    LAS float* scr = (LAS float*)(F.lds + RING_OFF + F.wave * 16640);
    const int gw = F.vcu * NWAVES + F.wave, NGW = F.G * NWAVES;
    constexpr int I_WIN = 16 * 64, I_GLU = 8 * 8, I_SB = 8 * 16, I_AB = 8 * 16, I_OUT = 16 * 16, I_E = 16 * 16;
    constexpr int I_SMALL = I_WIN + I_GLU + I_SB + I_AB + I_OUT, I_MOE = 3 * NE * I_E, I_ADA = 16 * 96;
    constexpr int NITEMS = I_SMALL + I_MOE + I_ADA;
    for (int it = gw; it < NITEMS; it += NGW) {
        int r = it;
        if (r < I_WIN) { p0_transpose_item(F.in[9], D, INW, WSP(bf16, WS_WIN_T), scr, r, F.lane, MapWin{}); continue; } r -= I_WIN;
        if (r < I_GLU) { p0_transpose_item(F.in[18], SW, SW, WSP(bf16, WS_WGLU_T), scr, r, F.lane, MapP8{0}); continue; } r -= I_GLU;
        if (r < I_SB) { p0_transpose_item(F.in[19], SW, D, WSP(bf16, WS_WSB_T), scr, r, F.lane, MapP8{0}); continue; } r -= I_SB;
        if (r < I_AB) { p0_transpose_item(F.in[20], AW, D, WSP(bf16, WS_WAB_T), scr, r, F.lane, MapP8{0}); continue; } r -= I_AB;
        if (r < I_OUT) { p0_transpose_item(F.in[21], D, D, WSP(bf16, WS_WOUT_T), scr, r, F.lane, MapP8{0}); continue; } r -= I_OUT;
        if (r < I_MOE) {
            const int mat = r / I_E, item = r % I_E, kind = mat / NE, e = mat % NE;
            if (kind == 0) p0_transpose_item(F.in[24] + (size_t)e * D * FF, D, FF, WSP(bf16, WS_WGU_T), scr, item, F.lane, MapGU{e, 0});
            else if (kind == 1) p0_transpose_item(F.in[26] + (size_t)e * D * FF, D, FF, WSP(bf16, WS_WGU_T), scr, item, F.lane, MapGU{e, 1});
            else p0_transpose_item(F.in[28] + (size_t)e * FF * D, FF, D, WSP(bf16, WS_WDN_T), scr, item, F.lane, MapP8{e * 1024});
            continue; }
        r -= I_MOE;
        {
            const int ks = r / 96, cc = r % 96, n = cc * 64 + F.lane;
            const float* cvec = F.in[1]; const float* aw = F.in[3];
            float a0 = 0.f, a1 = 0.f;
            for (int k = ks * 64; k < ks * 64 + 64; ++k) {
                const float c0 = cvec[k], c1 = cvec[D + k];
                const float s0 = c0 / (1.f + __expf(-c0)), s1 = c1 / (1.f + __expf(-c1));
                const float w = __builtin_nontemporal_load(aw + (size_t)k * (6 * D) + n);
                a0 += s0 * w; a1 += s1 * w; }
            float* part = WSP(float, WS_ADA);
            part[(ks * 2 + 0) * (6 * D) + n] = a0; part[(ks * 2 + 1) * (6 * D) + n] = a1;
        }
    }
    const int gt = F.vcu * (NWAVES * 64) + F.tid, NGT = F.G * NWAVES * 64;
    { const int* pos = (const int*)F.in[2]; float* rc = WSP(float, WS_ROPE); float* rs = rc + (size_t)T * 32;
      for (int i = gt; i < T * 32; i += NGT) { const int t = i >> 5, p = i & 31;
          const float invf = exp2f(-(float)p * (13.287712379549449f / 32.f));
          const double ang = (double)pos[t] * (double)invf; double rev = ang * 0.15915494309189535; rev -= floor(rev);
          const float fr = (float)rev;
          rc[i] = __builtin_amdgcn_cosf(fr); rs[i] = __builtin_amdgcn_sinf(fr); } }
    { float* P5 = WSP(float, WS_S5P);
      for (int i = gt; i < NG * NP; i += NGT) { const int g = i >> 6;
          const float dt = __expf(F.in[12][g]); const float lr = F.in[10][i], li = F.in[11][i];
          const float er = __expf(lr * dt); const double ang = (double)li * (double)dt; double rev = ang * 0.15915494309189535; rev -= floor(rev);
          const float cs = __builtin_amdgcn_cosf((float)rev), sn = __builtin_amdgcn_sinf((float)rev);
          float br = er * cs, bi = er * sn;
          P5[i] = br; P5[2048 + i] = bi;
          const float nr = br - 1.f, ni = bi, den = lr * lr + li * li;
          const float qr = (nr * lr + ni * li) / den, qi = (ni * lr - nr * li) / den;
          P5[8192 + i] = qr; P5[8192 + 2048 + i] = qi;
          float pr = br, pi_ = bi;
#pragma unroll
          for (int s = 0; s < 8; ++s) { const float tr = pr * pr - pi_ * pi_, ti = 2.f * pr * pi_; pr = tr; pi_ = ti; }
          P5[4096 + i] = pr; P5[6144 + i] = pi_;
          float* PW = P5 + 131072;
          float wr_ = 1.f, wi_ = 0.f;
#pragma unroll
          for (int k = 0; k <= 16; ++k) { PW[i * 17 + k] = wr_; PW[2048 * 17 + i * 17 + k] = wi_; const float tr = wr_ * br - wi_ * bi, ti = wr_ * bi + wi_ * br; wr_ = tr; wi_ = ti; } }
    }
}

__device__ __forceinline__ void phase1(Frame& F) {
    LAS float* A1 = (LAS float*)(F.lds + RING_OFF); LAS float* A2 = A1 + 2 * D;
    const float* part = WSP(float, WS_ADA); const float* ab = F.in[4]; const float* pg = F.in[5];
    for (int k = F.tid; k < D; k += NWAVES * 64)
#pragma unroll
        for (int b = 0; b < 2; ++b) { float sh = ab[k], sc = ab[D + k];
            for (int ks = 0; ks < 16; ++ks) { sh += part[(ks * 2 + b) * (6 * D) + k]; sc += part[(ks * 2 + b) * (6 * D) + D + k]; }
            A1[b * D + k] = pg[k] * (1.f + sc); A2[b * D + k] = sh; }
    const int gt = F.vcu * (NWAVES * 64) + F.tid, NGT = F.G * NWAVES * 64;
    { float* adaf = WSP(float, WS_ADAF);
      for (int n = gt; n < 2 * 6 * D; n += NGT) { const int b = n / (6 * D), j = n % (6 * D); float a = ab[j];
          for (int ks = 0; ks < 16; ++ks) a += part[(ks * 2 + b) * (6 * D) + j];
          adaf[n] = a; } }
    { float* par = WSP(float, WS_PAR);
      for (int i = gt; i < 32768; i += NGT) { par[PAR_RW + i] = F.in[22][i]; par[PAR_BG + i] = F.in[25][i]; par[PAR_BU + i] = F.in[27][i]; par[PAR_BD + i] = F.in[29][i];
          par[PAR_CRE + i] = F.in[15][i]; par[PAR_CIM + i] = F.in[16][i]; par[PAR_BRE + i] = F.in[13][i]; par[PAR_BIM + i] = F.in[14][i];
          if (i < 1024) { par[PAR_MPG + i] = F.in[6][i]; par[PAR_FPRE + i] = F.in[7][i]; par[PAR_FPOST + i] = F.in[8][i]; }
          if (i < 512) par[PAR_SD + i] = F.in[17][i];
          if (i < 32) par[PAR_RB + i] = F.in[23][i]; } }
    { const float* P5 = WSP(float, WS_S5P); const float* PWr = P5 + 131072; const float* PWi = PWr + 2048 * 17;
      bf16* M1t = WSP(bf16, WS_S5M1);
      for (int i = gt; i < NG * 256 * 256; i += NGT) { const int k = i & 255, n = (i >> 8) & 255, g = i >> 16; float val = 0.f;
          if (n < 128) { const int p = n & 63, gp = g * 64 + p, s_ = k >> 4, ci = k & 15;
              const float qr = P5[8192 + gp], qi = P5[8192 + 2048 + gp], b_r = F.in[13][gp * 16 + ci], b_i = F.in[14][gp * 16 + ci];
              const float bbr = qr * b_r - qi * b_i, bbi = qr * b_i + qi * b_r, wr_ = PWr[gp * 17 + 15 - s_], wi_ = PWi[gp * 17 + 15 - s_];
              val = (n < 64) ? (wr_ * bbr - wi_ * bbi) : (wr_ * bbi + wi_ * bbr); }
          M1t[((size_t)(g * 256 + perm8(n))) * 256 + k] = (bf16)f2bf(val); }
    }
    __syncthreads();
    const int gw = F.vcu * NWAVES + F.wave, NGW = F.G * NWAVES;
    bf16* XN = WSP(bf16, WS_XN);
    for (int m0 = gw * 2; m0 < T; m0 += NGW * 2) {
        const int b = m0 >> 13;
        f32x4 v[2][4];
#pragma unroll
        for (int q = 0; q < 2; ++q) { const GAS f32x4* xr = (const GAS f32x4*)(F.in[0] + (size_t)(m0 + q) * D) + F.lane;
#pragma unroll
            for (int j = 0; j < 4; ++j) v[q][j] = __builtin_nontemporal_load(xr + 64 * j); }
#pragma unroll
        for (int q = 0; q < 2; ++q) { float s = 0.f;
#pragma unroll
            for (int j = 0; j < 4; ++j) s += (v[q][j].x * v[q][j].x + v[q][j].y * v[q][j].y) + (v[q][j].z * v[q][j].z + v[q][j].w * v[q][j].w);
            const float rstd = 1.f / sqrtf(wave_sum(s) * (1.f / D) + NORM_EPS);
            GAS unsigned long long* o8 = (GAS unsigned long long*)(XN + (size_t)(m0 + q) * D) + F.lane;
#pragma unroll
            for (int j = 0; j < 4; ++j) { const f32x4 a1 = *(const LAS f32x4*)(A1 + b * D + 4 * F.lane + 256 * j), a2 = *(const LAS f32x4*)(A2 + b * D + 4 * F.lane + 256 * j);
                const f32x4 o = v[q][j] * rstd * a1 + a2;
                o8[64 * j] = (unsigned long long)pk2(o.x, o.y) | ((unsigned long long)pk2(o.z, o.w) << 32); } }
    }
    __syncthreads();
}

struct EpiG1 {
    bf16 *UA, *Q, *K, *V, *VT, *GSp, *GAp; const float *rc, *rs; float* km;
    __device__ __forceinline__ void operator()(const pg8::f32x4 (&acc)[2][2][4][2], const pg8::Unit& u, int wr, int wc, int fr, int fq) const {
        asm volatile("" : "+v"(fr), "+v"(fq));
        const int pn = u.pn, row0 = u.pm * 256 + wr * 64 + fr;
        if (pn < 2) {
#pragma unroll
            for (int ai = 0; ai < 2; ++ai)
#pragma unroll
                for (int m = 0; m < 4; ++m) { const int t = row0 + ai * 128 + m * 16, b = t >> 13, tt = t & (SEQ - 1), c = tt >> 4, s = tt & 15;
#pragma unroll
                    for (int bj = 0; bj < 2; ++bj) { const int ch = pn * 256 + bj * 128 + wc * 32 + 8 * fq, g = ch >> 4, ci = ch & 15;
                        const pg8::f32x4 v0 = acc[ai][bj][m][0], v1 = acc[ai][bj][m][1];
                        v4u w; w.x = pk2(v0[0], v0[1]); w.y = pk2(v0[2], v0[3]); w.z = pk2(v1[0], v1[1]); w.w = pk2(v1[2], v1[3]);
                        st16(UA + ((size_t)(g * 1024 + b * 512 + c) * 384 + 16 * s + ci), w); } }
        } else if (pn < 6) {
            const bool isk = pn >= 4; bf16* X = isk ? K : Q; const float sc = isk ? 1.f : C2;
            const int p0 = 16 * (wc & 1) + 4 * fq;
#pragma unroll
            for (int bj = 0; bj < 2; ++bj) {
                const int head = 4 * (pn & 1) + 2 * bj + (wc >> 1);
                int rowb = row0; asm volatile("" : "+v"(rowb));
                float ks[2][4];
#pragma unroll
                for (int b = 0; b < 2; ++b)
#pragma unroll
                    for (int i = 0; i < 4; ++i) ks[b][i] = 0.f;
#pragma unroll
                for (int ai = 0; ai < 2; ++ai)
#pragma unroll
                    for (int m = 0; m < 4; ++m) { const int t = rowb + ai * 128 + m * 16;
                        const pg8::f32x4 cs = *(const pg8::f32x4*)(rc + (size_t)t * 32 + p0), sn = *(const pg8::f32x4*)(rs + (size_t)t * 32 + p0);
                        const pg8::f32x4 t1 = acc[ai][bj][m][0], t2 = acc[ai][bj][m][1];
                        const pg8::f32x4 o1 = t1 * cs - t2 * sn, o2 = t2 * cs + t1 * sn;
                        v2u w1, w2; w1.x = pk2(o1[0] * sc, o1[1] * sc); w1.y = pk2(o1[2] * sc, o1[3] * sc); w2.x = pk2(o2[0] * sc, o2[1] * sc); w2.y = pk2(o2[2] * sc, o2[3] * sc);
                        bf16* dst = X + (size_t)t * AW + head * 64 + p0;
                        st8(dst, w1); st8(dst + 32, w2);
#pragma unroll
                        for (int i = 0; i < 4; ++i) { ks[0][i] += o1[i]; ks[1][i] += o2[i]; }
                        __builtin_amdgcn_sched_barrier(0); }
                if (isk) {
                    const int b = u.pm >> 5, blk = u.pm & 31;
#pragma unroll
                    for (int n = 0; n < 2; ++n)
#pragma unroll
                        for (int i = 0; i < 4; ++i) { float v = ks[n][i];
                            v += __shfl_xor(v, 1); v += __shfl_xor(v, 2); v += __shfl_xor(v, 4); v += __shfl_xor(v, 8);
                            if (fr == 0) atomicAdd(km + ((size_t)((b * NH + head) * NBLK + blk) * HD + 32 * n + p0 + i), v); }
                }
            }
        } else if (pn < 8) {
#pragma unroll
            for (int ai = 0; ai < 2; ++ai)
#pragma unroll
                for (int m = 0; m < 4; ++m) { const int t = row0 + ai * 128 + m * 16, b = t >> 13, tt = t & (SEQ - 1);
#pragma unroll
                    for (int bj = 0; bj < 2; ++bj) { const int cv = (pn - 6) * 256 + bj * 128 + wc * 32 + 8 * fq, head = cv >> 6, d = cv & 63;
                        const pg8::f32x4 v0 = acc[ai][bj][m][0], v1 = acc[ai][bj][m][1];
                        v4u w; w.x = pk2(v0[0], v0[1]); w.y = pk2(v0[2], v0[3]); w.z = pk2(v1[0], v1[1]); w.w = pk2(v1[2], v1[3]);
                        bf16* vt = VT + ((size_t)((b * NH + head) * HD + d) * SEQ + tt);
                        vt[0 * SEQ] = (bf16)(w.x & 0xffff); vt[1 * SEQ] = (bf16)(w.x >> 16); vt[2 * SEQ] = (bf16)(w.y & 0xffff); vt[3 * SEQ] = (bf16)(w.y >> 16);
                        vt[4 * SEQ] = (bf16)(w.z & 0xffff); vt[5 * SEQ] = (bf16)(w.z >> 16); vt[6 * SEQ] = (bf16)(w.w & 0xffff); vt[7 * SEQ] = (bf16)(w.w >> 16); } }
        } else {
            bf16* Gp = (pn < 12) ? GSp : GAp; const int cb = ((pn - 8) & 3) * 256;
#pragma unroll
            for (int ai = 0; ai < 2; ++ai)
#pragma unroll
                for (int m = 0; m < 4; ++m) { const int t = row0 + ai * 128 + m * 16;
#pragma unroll
                    for (int bj = 0; bj < 2; ++bj) { const int col = cb + bj * 128 + wc * 32 + 8 * fq;
                        const pg8::f32x4 v0 = acc[ai][bj][m][0], v1 = acc[ai][bj][m][1];
                        v4u w; w.x = pk2(sigmoidf_(v0[0]), sigmoidf_(v0[1])); w.y = pk2(sigmoidf_(v0[2]), sigmoidf_(v0[3]));
                        w.z = pk2(sigmoidf_(v1[0]), sigmoidf_(v1[1])); w.w = pk2(sigmoidf_(v1[2]), sigmoidf_(v1[3]));
                        __builtin_nontemporal_store(w, (v4u*)(Gp + (size_t)t * D + col)); } }
        }
    }
};

template <int MODE> struct EpiEw {
    bf16* O; const bf16* X1; const bf16* X2; float* Of; int ld;
    __device__ __forceinline__ void operator()(const pg8::f32x4 (&acc)[2][2][4][2], const pg8::Unit& u, int wr, int wc, int fr, int fq) const {
        const int row0 = u.pm * 256 + wr * 64 + fr, col0 = u.pn * 256 + wc * 32 + 8 * fq;
#pragma unroll
        for (int ai = 0; ai < 2; ++ai)
#pragma unroll
            for (int m = 0; m < 4; ++m) { const size_t rb = (size_t)(row0 + ai * 128 + m * 16) * ld + col0;
#pragma unroll
                for (int bj = 0; bj < 2; ++bj) { const size_t off = rb + bj * 128;
                    const pg8::f32x4 v0 = acc[ai][bj][m][0], v1 = acc[ai][bj][m][1];
                    if (MODE == 3) { *(pg8::f32x4*)(Of + off) = v0; *(pg8::f32x4*)(Of + off + 4) = v1; }
                    else {
                        const v4u x = __builtin_nontemporal_load((const v4u*)(X1 + off));
                        float r[8] = {v0[0], v0[1], v0[2], v0[3], v1[0], v1[1], v1[2], v1[3]};
                        const float xv[8] = {bflo(x.x), bfhi(x.x), bflo(x.y), bfhi(x.y), bflo(x.z), bfhi(x.z), bflo(x.w), bfhi(x.w)};
                        if (MODE == 0) {
#pragma unroll
                            for (int i = 0; i < 8; ++i) r[i] = xv[i] * sigmoidf_(r[i]);
                        } else if (MODE == 1) {
#pragma unroll
                            for (int i = 0; i < 8; ++i) r[i] = xv[i] * r[i];
                        } else {
                            const v4u y = __builtin_nontemporal_load((const v4u*)(X2 + off));
                            const float yv[8] = {bflo(y.x), bfhi(y.x), bflo(y.y), bfhi(y.y), bflo(y.z), bfhi(y.z), bflo(y.w), bfhi(y.w)};
#pragma unroll
                            for (int i = 0; i < 8; ++i) r[i] = yv[i] + xv[i] * r[i];
                        }
                        v4u w; w.x = pk2(r[0], r[1]); w.y = pk2(r[2], r[3]); w.z = pk2(r[4], r[5]); w.w = pk2(r[6], r[7]);
                        st16(O + off, w); } } }
    }
};

typedef short bf16x8 __attribute__((ext_vector_type(8)));
typedef float f32x16 __attribute__((ext_vector_type(16)));
constexpr size_t WS_ALIST = 456 * MiB;
constexpr size_t WS_OP01 = 224 * MiB;
constexpr size_t WS_OP23 = 472 * MiB;
constexpr size_t WS_LSE = 504 * MiB;
constexpr int CW_BCNT = 12288;
constexpr int ALCAP = 8192;

__device__ __forceinline__ void attn_gate(Frame& F) {
    const int gw = F.vcu * NWAVES + F.wave, NGW = F.G * NWAVES, L = F.lane;
    const bf16* Q = WSP(bf16, WS_Q); const float* km = (const float*)(F.ctl + CW_KM);
    unsigned* bcnt = (unsigned*)(F.ctl + CW_BCNT); unsigned* list = WSP(unsigned, WS_ALIST); float* lse = WSP(float, WS_LSE);
    for (int w = gw; w < BATCH * NH * (SEQ / 64); w += NGW) {
        const int bh = w >> 7, b = bh >> 3, h = bh & 7, tt = (w & 127) * 64 + L, t = b * SEQ + tt, blk = tt >> 8;
        float q[64];
        { const v4u* qp = (const v4u*)(Q + (size_t)t * AW + h * 64);
#pragma unroll
          for (int i = 0; i < 8; ++i) { const v4u x = qp[i]; q[8 * i] = bflo(x.x); q[8 * i + 1] = bfhi(x.x); q[8 * i + 2] = bflo(x.y); q[8 * i + 3] = bfhi(x.y);
              q[8 * i + 4] = bflo(x.z); q[8 * i + 5] = bfhi(x.z); q[8 * i + 6] = bflo(x.w); q[8 * i + 7] = bfhi(x.w); } }
        float v0 = -3e38f, v1 = -3e38f, v2 = -3e38f; int i0 = -1, i1 = -1, i2 = -1;
        for (int j = 0; j < blk; ++j) { const float* kp = km + (size_t)((b * NH + h) * NBLK + j) * HD; float g = 0.f;
#pragma unroll
            for (int d = 0; d < 64; ++d) g += q[d] * kp[d];
            if (g > v0) { v2 = v1; i2 = i1; v1 = v0; i1 = i0; v0 = g; i0 = j; }
            else if (g > v1) { v2 = v1; i2 = i1; v1 = g; i1 = j; }
            else if (g > v2) { v2 = g; i2 = j; } }
        float* lp = lse + ((size_t)t * NH + h) * 4;
        if (i0 < 0) lp[0] = -1e30f; if (i1 < 0) lp[1] = -1e30f; if (i2 < 0) lp[2] = -1e30f;
        for (int j = 0; j < blk; ++j) {
            const bool sel = (i0 == j) || (i1 == j) || (i2 == j);
            const unsigned long long mask = __ballot(sel);
            if (mask) { const int leader = __ffsll((long long)mask) - 1; const int bucket = (b * NH + h) * NBLK + j;
                unsigned base = 0u;
                if (L == leader) base = __hip_atomic_fetch_add(bcnt + bucket, (unsigned)__popcll(mask), RLX_AGENT);
                base = (unsigned)__shfl((int)base, leader);
                if (sel) { const unsigned pos = base + (unsigned)__popcll(mask & ((1ull << L) - 1ull)); const unsigned slot = (i0 == j) ? 0u : ((i1 == j) ? 1u : 2u);
                    list[(size_t)bucket * ALCAP + pos] = ((unsigned)tt << 2) | slot; } }
        }
    }
}

__device__ __forceinline__ unsigned cvtpk(float lo, float hi) { typedef float f32x2_t __attribute__((ext_vector_type(2))); typedef __bf16 bf16x2_t __attribute__((ext_vector_type(2)));
    f32x2_t v = {lo, hi}; bf16x2_t r = __builtin_convertvector(v, bf16x2_t); return __builtin_bit_cast(unsigned, r); }

constexpr int AT_KROW = 144, AT_VROW = 520, AT_KOFF = 0, AT_VOFF = 256 * AT_KROW;
__device__ __forceinline__ void attn_item(Frame& F, int b, int h, int j, bool own, const unsigned* lst, int nvalid) {
    const int tid = F.tid, L = F.lane, r = L & 31, hh = L >> 5, wv = F.wave;
    LAS unsigned char* Kl = F.lds + AT_KOFF; LAS unsigned char* Vl = F.lds + AT_VOFF;
    const bf16* Kg = WSP(bf16, WS_K) + ((size_t)(b * SEQ + j * 256)) * AW + h * 64;
    const bf16* Vg = WSP(bf16, WS_VT) + ((size_t)((b * NH + h) * HD)) * SEQ + j * 256;
    v4u kr[4], vr[4];
#pragma unroll
    for (int i = 0; i < 4; ++i) { const int idx = tid + 512 * i; kr[i] = *(const v4u*)(Kg + (size_t)(idx >> 3) * AW + (idx & 7) * 8); vr[i] = *(const v4u*)(Vg + (size_t)(idx >> 5) * SEQ + (idx & 31) * 8); }
    const int qi = wv * 32 + r; const bool valid = qi < nvalid;
    unsigned ent; if (own) ent = ((unsigned)(j * 256 + qi) << 2) | 3u; else ent = lst[valid ? qi : 0];
    const int tt = (int)(ent >> 2), slot = (int)(ent & 3u), t = b * SEQ + tt;
    bf16x8 qf[4];
    { const bf16* qp = WSP(bf16, WS_Q) + (size_t)t * AW + h * 64 + hh * 8;
#pragma unroll
      for (int d0 = 0; d0 < 4; ++d0) qf[d0] = *(const bf16x8*)(qp + d0 * 16); }
#pragma unroll
    for (int i = 0; i < 4; ++i) { const int idx = tid + 512 * i; *(LAS v4u*)(Kl + (idx >> 3) * AT_KROW + (idx & 7) * 16) = kr[i]; *(LAS v4u*)(Vl + (idx >> 5) * AT_VROW + (idx & 31) * 16) = vr[i]; }
    __syncthreads();
#ifdef ATT_STAGGER
    if (wv >= 4) __builtin_amdgcn_s_sleep(ATT_STAGGER);
#endif
#ifdef ATT_REP_COMPUTE
    for (int arep = 0; arep < 2; ++arep)
#endif
    if (wv * 32 < nvalid) {
        float m = -1e30f, l = 0.f; f32x16 O0 = {}, O1 = {};
        const int qrel = tt & 255;
#pragma unroll
        for (int hk = 0; hk < 2; ++hk) {
            if (own && hk * 4 > wv) continue;
            f32x16 S[4];
#pragma unroll
            for (int kt = 0; kt < 4; ++kt) S[kt] = (f32x16){};
#pragma unroll
            for (int d0 = 0; d0 < 4; ++d0) {
#pragma unroll
                for (int kt = 0; kt < 4; ++kt) { const bf16x8 kf = *(const LAS bf16x8*)(Kl + (hk * 128 + kt * 32 + r) * AT_KROW + d0 * 32 + hh * 16);
                    S[kt] = __builtin_amdgcn_mfma_f32_32x32x16_bf16(kf, qf[d0], S[kt], 0, 0, 0); }
                if (d0 & 1) __builtin_amdgcn_sched_barrier(0); }
            if (own) {
                asm volatile("; causal masking (own block only)" ::: "memory");
#pragma unroll
                for (int kt = 0; kt < 4; ++kt)
#pragma unroll
                    for (int rg = 0; rg < 16; ++rg) { const int key = hk * 128 + kt * 32 + (rg & 3) + 8 * (rg >> 2) + 4 * hh; if (key > qrel) S[kt][rg] = -1e30f; } }
            float mx = S[0][0];
#pragma unroll
            for (int kt = 0; kt < 4; ++kt)
#pragma unroll
                for (int rg = 0; rg < 16; ++rg) mx = fmaxf(mx, S[kt][rg]);
            mx = fmaxf(mx, __shfl_xor(mx, 32));
            const float mn = fmaxf(m, mx), alpha = __builtin_amdgcn_exp2f(m - mn); m = mn; l *= alpha;
#pragma unroll
            for (int rg = 0; rg < 16; ++rg) { O0[rg] *= alpha; O1[rg] *= alpha; }
            float ls = 0.f;
#pragma unroll
            for (int kt = 0; kt < 4; ++kt) {
                unsigned pw[8];
#pragma unroll
                for (int rg = 0; rg < 16; rg += 2) { const float p0 = __builtin_amdgcn_exp2f(S[kt][rg] - mn), p1 = __builtin_amdgcn_exp2f(S[kt][rg + 1] - mn); ls += p0 + p1; pw[rg >> 1] = cvtpk(p0, p1); }
#pragma unroll
                for (int s = 0; s < 2; ++s) {
                    const v4u pv = {pw[4 * s], pw[4 * s + 1], pw[4 * s + 2], pw[4 * s + 3]}; const bf16x8 pf = __builtin_bit_cast(bf16x8, pv);
                    const int kb = (hk * 128 + kt * 32 + 16 * s + 4 * hh) * 2;
                    { const LAS unsigned char* vp = Vl + r * AT_VROW + kb; const v2u lo = *(const LAS v2u*)vp, hi = *(const LAS v2u*)(vp + 16);
                      const v4u vv = {lo.x, lo.y, hi.x, hi.y}; O0 = __builtin_amdgcn_mfma_f32_32x32x16_bf16(__builtin_bit_cast(bf16x8, vv), pf, O0, 0, 0, 0); }
                    { const LAS unsigned char* vp = Vl + (32 + r) * AT_VROW + kb; const v2u lo = *(const LAS v2u*)vp, hi = *(const LAS v2u*)(vp + 16);
                      const v4u vv = {lo.x, lo.y, hi.x, hi.y}; O1 = __builtin_amdgcn_mfma_f32_32x32x16_bf16(__builtin_bit_cast(bf16x8, vv), pf, O1, 0, 0, 0); } } }
            l += ls;
        }
        l += __shfl_xor(l, 32);
        if (valid) {
            const float rl = 1.f / l;
            bf16* op = (slot < 2 ? WSP(bf16, WS_OP01) + (((size_t)t * NH + h) * 2 + slot) * 64 : WSP(bf16, WS_OP23) + (((size_t)t * NH + h) * 2 + (slot - 2)) * 64) + 4 * hh;
#pragma unroll
            for (int g4 = 0; g4 < 4; ++g4) { v2u w0, w1; w0.x = cvtpk(O0[4 * g4] * rl, O0[4 * g4 + 1] * rl); w0.y = cvtpk(O0[4 * g4 + 2] * rl, O0[4 * g4 + 3] * rl);
                w1.x = cvtpk(O1[4 * g4] * rl, O1[4 * g4 + 1] * rl); w1.y = cvtpk(O1[4 * g4 + 2] * rl, O1[4 * g4 + 3] * rl);
                *(v2u*)(op + 8 * g4) = w0; *(v2u*)(op + 32 + 8 * g4) = w1; }
            if (hh == 0) WSP(float, WS_LSE)[((size_t)t * NH + h) * 4 + slot] = m + log2f(l);
        }
    }
    __syncthreads();
}
__device__ __forceinline__ void attn_items(Frame& F) {
    LAS int* pre = (LAS int*)(F.lds + 72 * 1024);
    const unsigned* bcnt = (const unsigned*)(F.ctl + CW_BCNT);
    LAS int* cntl = pre + 520;
    for (int i = F.tid; i < 512; i += NWAVES * 64) cntl[i] = (int)__hip_atomic_load((gu32*)(F.ctl + CW_BCNT) + i, RLX_AGENT);
    __syncthreads();
    if (F.tid == 0) { int a = 0; for (int i = 0; i < 512; ++i) { pre[i] = a; a += (cntl[i] + 255) >> 8; } pre[512] = a; }
    __syncthreads();
    const int total = 512 + pre[512];
    for (int it = (int)blockIdx.x; it < total; it += F.G) {
        int bh, j, n; bool own; const unsigned* lst;
        if (it < 512) { bh = it >> 5; j = it & 31; own = true; lst = nullptr; n = 256; }
        else { const int s = it - 512; int lo = 0, hi = 512;
            while (hi - lo > 1) { const int mid = (lo + hi) >> 1; if (pre[mid] <= s) lo = mid; else hi = mid; }
            const int bucket = lo, tile = s - pre[bucket]; n = cntl[bucket] - tile * 256; n = n > 256 ? 256 : n; bh = bucket >> 5; j = bucket & 31; own = false;
            lst = WSP(unsigned, WS_ALIST) + (size_t)bucket * ALCAP + tile * 256; }
        const int b_ = __builtin_amdgcn_readfirstlane(bh >> 3), h_ = __builtin_amdgcn_readfirstlane(bh & 7), j_ = __builtin_amdgcn_readfirstlane(j), n_ = __builtin_amdgcn_readfirstlane(n);
        attn_item(F, b_, h_, j_, own, lst, n_);
    }
}
__device__ __forceinline__ void attn_combine(Frame& F) {
    if (F.G == 256 && blockIdx.x < 128) return;
    const int nb = F.G == 256 ? 128 : F.G, bi = F.G == 256 ? (int)blockIdx.x - 128 : F.vcu;
    const int gw = bi * NWAVES + F.wave, NGW = nb * NWAVES, L = F.lane, h = L >> 3, ch = L & 7;
    const float* lse = WSP(float, WS_LSE); bf16* YA = WSP(bf16, WS_YA);
    for (int t = gw; t < T; t += NGW) {
        const size_t th = (size_t)t * NH + h;
        const f32x4 ls = *(const f32x4*)(lse + th * 4);
        const float mx = fmaxf(fmaxf(ls[0], ls[1]), fmaxf(ls[2], ls[3]));
        const float w0 = __builtin_amdgcn_exp2f(ls[0] - mx), w1 = __builtin_amdgcn_exp2f(ls[1] - mx), w2 = __builtin_amdgcn_exp2f(ls[2] - mx), w3 = __builtin_amdgcn_exp2f(ls[3] - mx), inv = 1.f / (w0 + w1 + w2 + w3);
        const v4u a0 = __builtin_nontemporal_load((const v4u*)(WSP(bf16, WS_OP01) + (th * 2 + 0) * 64 + ch * 8)), a1 = __builtin_nontemporal_load((const v4u*)(WSP(bf16, WS_OP01) + (th * 2 + 1) * 64 + ch * 8));
        const v4u a2 = __builtin_nontemporal_load((const v4u*)(WSP(bf16, WS_OP23) + (th * 2 + 0) * 64 + ch * 8)), a3 = __builtin_nontemporal_load((const v4u*)(WSP(bf16, WS_OP23) + (th * 2 + 1) * 64 + ch * 8));
        float o[8];
        const unsigned x0[4] = {a0.x, a0.y, a0.z, a0.w}, x1[4] = {a1.x, a1.y, a1.z, a1.w}, x2[4] = {a2.x, a2.y, a2.z, a2.w}, x3[4] = {a3.x, a3.y, a3.z, a3.w};
#pragma unroll
        for (int i = 0; i < 4; ++i) {
            float lo_ = w3 * bflo(x3[i]), hi_ = w3 * bfhi(x3[i]);
            if (ls[0] > -1e29f) { lo_ += w0 * bflo(x0[i]); hi_ += w0 * bfhi(x0[i]); }
            if (ls[1] > -1e29f) { lo_ += w1 * bflo(x1[i]); hi_ += w1 * bfhi(x1[i]); }
            if (ls[2] > -1e29f) { lo_ += w2 * bflo(x2[i]); hi_ += w2 * bfhi(x2[i]); }
            o[2 * i] = lo_ * inv; o[2 * i + 1] = hi_ * inv; }
        v4u w; w.x = cvtpk(o[0], o[1]); w.y = cvtpk(o[2], o[3]); w.z = cvtpk(o[4], o[5]); w.w = cvtpk(o[6], o[7]);
        *(v4u*)(YA + (size_t)t * AW + h * 64 + ch * 8) = w;
    }
}
struct S5Order { static constexpr bool GATHER = false; int G, c;
    __device__ __forceinline__ void a_ready(const pg8::Unit&) const {}
    __device__ __forceinline__ void done(const pg8::Unit&) const {}
    __device__ __forceinline__ bool next(int i, pg8::Unit& u) const { const int L = i * G + c; if (L >= NG * 4) return false; const int g = L >> 2, rt = L & 3;
        u.arow = g * 1024 + rt * 256; u.brow = g * 256; u.pm = rt; u.pn = 0; u.e = g; u.nrow = 256; u.kind = 0; u.aux = 0; return true; } };
struct EpiS5A { float* E;
    __device__ __forceinline__ void operator()(const pg8::f32x4 (&acc)[2][2][4][2], const pg8::Unit& u, int wr, int wc, int fr, int fq) const {
        asm volatile("" : "+v"(fr), "+v"(fq));
#pragma unroll
        for (int ai = 0; ai < 2; ++ai)
#pragma unroll
            for (int m = 0; m < 4; ++m) { float* p = E + (size_t)(u.arow + ai * 128 + wr * 64 + m * 16 + fr) * 128 + wc * 32 + 8 * fq;
                *(pg8::f32x4*)p = acc[ai][0][m][0]; *(pg8::f32x4*)(p + 4) = acc[ai][0][m][1]; }
    }
};
struct EpiS5C { bf16* YG;
    __device__ __forceinline__ void operator()(const pg8::f32x4 (&acc)[2][2][4][2], const pg8::Unit& u, int wr, int wc, int fr, int fq) const {
        asm volatile("" : "+v"(fr), "+v"(fq));
        const int g = u.e, n0 = wc * 32 + 8 * fq, t0 = n0 >> 4, co0 = n0 & 15;
#pragma unroll
        for (int ai = 0; ai < 2; ++ai)
#pragma unroll
            for (int m = 0; m < 4; ++m) { const int row = u.pm * 256 + ai * 128 + wr * 64 + m * 16 + fr, b = row >> 9, c = row & 511;
                bf16* yp = YG + (size_t)(b * SEQ + 16 * c + t0) * SW + 16 * g + co0;
#pragma unroll
                for (int bj = 0; bj < 2; ++bj) {
                    const pg8::f32x4 v0 = acc[ai][bj][m][0], v1 = acc[ai][bj][m][1];
                    v4u w; w.x = pk2(gelu_tanh(v0[0]), gelu_tanh(v0[1])); w.y = pk2(gelu_tanh(v0[2]), gelu_tanh(v0[3]));
                    w.z = pk2(gelu_tanh(v1[0]), gelu_tanh(v1[1])); w.w = pk2(gelu_tanh(v1[2]), gelu_tanh(v1[3]));
                    *(v4u*)(yp + (size_t)bj * 8 * SW) = w; }
                __builtin_amdgcn_sched_barrier(0); }
    }
};
__device__ __forceinline__ void s5_fill_kt(Frame& F) {
    const int gt = F.vcu * (NWAVES * 64) + F.tid, NGT = F.G * NWAVES * 64;
    const float* P5 = WSP(float, WS_S5P); const float* PWr = P5 + 131072; const float* PWi = PWr + 2048 * 17; const float* par = WSP(float, WS_PAR);
    float* KT = WSP(float, WS_S5KT);
    for (int i = gt; i < NG * 16 * 256; i += NGT) { const int ci = i & 15, co = (i >> 4) & 15, tau = (i >> 8) & 15, g = i >> 12; float a = 0.f;
        for (int p = 0; p < 64; ++p) { const int gp = g * 64 + p;
            const float qr = P5[8192 + gp], qi = P5[8192 + 2048 + gp], b_r = par[PAR_BRE + gp * 16 + ci], b_i = par[PAR_BIM + gp * 16 + ci];
            const float bbr = qr * b_r - qi * b_i, bbi = qr * b_i + qi * b_r, wr_ = PWr[gp * 17 + tau], wi_ = PWi[gp * 17 + tau];
            const float xr = wr_ * bbr - wi_ * bbi, xi = wr_ * bbi + wi_ * bbr;
            const float cr = par[PAR_CRE + (g * 16 + co) * 64 + p], ci_ = par[PAR_CIM + (g * 16 + co) * 64 + p];
            a += cr * xr - ci_ * xi; }
        KT[i] = a; }
}
__device__ __forceinline__ void s5_fill_wc(Frame& F) {
    const int gt = F.vcu * (NWAVES * 64) + F.tid, NGT = F.G * NWAVES * 64;
    const float* P5 = WSP(float, WS_S5P); const float* PWr = P5 + 131072; const float* PWi = PWr + 2048 * 17; const float* KT = WSP(float, WS_S5KT); const float* par = WSP(float, WS_PAR);
    bf16* Wc = WSP(bf16, WS_S5WC);
    for (int i = gt; i < NG * 256 * 384; i += NGT) { const int k = i % 384, n = (i / 384) & 255, g = i / (384 * 256), t = n >> 4, co = n & 15; float val = 0.f;
        if (k < 256) { const int s_ = k >> 4, ci = k & 15;
            if (s_ <= t) val = KT[((g * 16 + (t - s_)) * 16 + co) * 16 + ci];
            if (s_ == t && ci == co) val += par[PAR_SD + g * 16 + co]; }
        else { const int p = (k - 256) & 63, gp = g * 64 + p; const float cr = par[PAR_CRE + (g * 16 + co) * 64 + p], ci_ = par[PAR_CIM + (g * 16 + co) * 64 + p];
            const float wr_ = PWr[gp * 17 + t + 1], wi_ = PWi[gp * 17 + t + 1];
            val = (k < 320) ? (cr * wr_ - ci_ * wi_) : -(cr * wi_ + ci_ * wr_); }
        Wc[((size_t)(g * 256 + perm8(n))) * 384 + k] = (bf16)f2bf(val); }
}
__device__ __forceinline__ void s5_carry(Frame& F) {
    const float* P5 = WSP(float, WS_S5P); const float* PWr = P5 + 131072; const float* PWi = PWr + 2048 * 17; const float* E = WSP(float, WS_S5E); bf16* UA = WSP(bf16, WS_UA);
    LAS float* Z = (LAS float*)(F.lds);
    const int seg = F.wave, p = F.lane;
    for (int bg = F.vcu; bg < BATCH * NG; bg += F.G) { const int b = bg / NG, g = bg % NG, gp = g * 64 + p;
        const float ar = PWr[gp * 17 + 16], ai = PWi[gp * 17 + 16];
        const size_t row0 = (size_t)g * 1024 + b * 512 + seg * 64;
        float zr = 0.f, zi = 0.f;
        for (int c0 = 0; c0 < 64; c0 += 8) { float er[8], ei[8];
#pragma unroll
            for (int k = 0; k < 8; ++k) { er[k] = E[(row0 + c0 + k) * 128 + p]; ei[k] = E[(row0 + c0 + k) * 128 + 64 + p]; }
#pragma unroll
            for (int k = 0; k < 8; ++k) { const float nr = ar * zr - ai * zi + er[k], ni = ar * zi + ai * zr + ei[k]; zr = nr; zi = ni; } }
        Z[(seg * 64 + p) * 2] = zr; Z[(seg * 64 + p) * 2 + 1] = zi;
        __syncthreads();
        if (seg == 0) { float br = ar, bi = ai;
#pragma unroll
            for (int k = 0; k < 6; ++k) { const float tr = br * br - bi * bi, ti = 2.f * br * bi; br = tr; bi = ti; }
            float sr = 0.f, si = 0.f;
            for (int sg = 0; sg < 8; ++sg) { const float xr = Z[(sg * 64 + p) * 2], xi = Z[(sg * 64 + p) * 2 + 1]; Z[(sg * 64 + p) * 2] = sr; Z[(sg * 64 + p) * 2 + 1] = si;
                const float nr = br * sr - bi * si + xr, ni = br * si + bi * sr + xi; sr = nr; si = ni; } }
        __syncthreads();
        float sr = Z[(seg * 64 + p) * 2], si = Z[(seg * 64 + p) * 2 + 1];
        for (int c0 = 0; c0 < 64; c0 += 8) { float er[8], ei[8];
#pragma unroll
            for (int k = 0; k < 8; ++k) { er[k] = E[(row0 + c0 + k) * 128 + p]; ei[k] = E[(row0 + c0 + k) * 128 + 64 + p]; }
#pragma unroll
            for (int k = 0; k < 8; ++k) { bf16* up = UA + (row0 + c0 + k) * 384 + 256 + p; up[0] = (bf16)f2bf(sr); up[64] = (bf16)f2bf(si);
                const float nr = ar * sr - ai * si + er[k], ni = ar * si + ai * sr + ei[k]; sr = nr; si = ni; } }
        __syncthreads();
    }
}
constexpr int SCR_OFF = LDSCTL_OFF + 512;
#ifndef MOE_LAG
#define MOE_LAG 2
#endif
constexpr int MT_SEG = 100, MT_MAXSEG = 72;
__device__ __forceinline__ void phase_rows(Frame& F, bool dry = false) {
    LAS float* h2t = (LAS float*)(F.lds);
    LAS float* lg = (LAS float*)(F.lds + 65536);
    LAS float* gtm = (LAS float*)(F.lds + 131072);
    LAS float* pg2 = gtm + 2 * D; LAS float* shf = pg2 + 2 * D;
    LAS unsigned* hist = (LAS unsigned*)(F.lds + SCR_OFF); LAS unsigned* base = hist + 32; LAS int* rec_e = (LAS int*)(base + 32); LAS int* rec_lp = rec_e + 256;
    const float* adaf = WSP(float, WS_ADAF); const float* par = WSP(float, WS_PAR);
    const int L = F.lane, wv = F.wave;
    for (int i = F.tid; i < 2 * D; i += NWAVES * 64) { const int b = i >> 10, k = i & (D - 1);
        gtm[i] = adaf[b * 6 * D + 2 * D + k] * par[PAR_MPG + k];
        pg2[i] = par[PAR_FPRE + k] * (1.f + adaf[b * 6 * D + 4 * D + k]); shf[i] = adaf[b * 6 * D + 3 * D + k]; }
    f32x4 wreg[16];
#pragma unroll
    for (int j = 0; j < 4; ++j)
#pragma unroll
        for (int i = 0; i < 4; ++i) wreg[j * 4 + i] = *(const f32x4*)(par + PAR_RW + (4 * L + 256 * j + i) * NE + 4 * wv);
    if (F.tid < 32) hist[F.tid] = 0u;
    __syncthreads();
    const float* mix = WSP(float, WS_MIX); bf16* H2 = WSP(bf16, WS_H2);
    int* tok_e = WSP(int, WS_ROUTE); float* tok_w = (float*)(tok_e + T * 4); int* tok_pos = tok_e + 2 * T * 4;
    unsigned* gcnt = (unsigned*)(F.ctl + CW_ECNT);
    for (int t0 = F.vcu * 16; t0 < T; t0 += F.G * 16) {
        {
            const int t = t0 + 2 * wv, b = t >> 13;
            f32x4 mv[2][4], xv[2][4];
#pragma unroll
            for (int q = 0; q < 2; ++q) { const GAS f32x4* mr = (const GAS f32x4*)(mix + (size_t)(t + q) * D) + L; const GAS f32x4* xr = (const GAS f32x4*)(F.in[0] + (size_t)(t + q) * D) + L;
#pragma unroll
                for (int j = 0; j < 4; ++j) { mv[q][j] = __builtin_nontemporal_load(mr + 64 * j); xv[q][j] = __builtin_nontemporal_load(xr + 64 * j); } }
#pragma unroll
            for (int q = 0; q < 2; ++q) { float s = 0.f;
#pragma unroll
                for (int j = 0; j < 4; ++j) s += (mv[q][j].x * mv[q][j].x + mv[q][j].y * mv[q][j].y) + (mv[q][j].z * mv[q][j].z + mv[q][j].w * mv[q][j].w);
                const float r1 = 1.f / sqrtf(wave_sum(s) * (1.f / D) + NORM_EPS);
                float s2 = 0.f; GAS f32x4* orow = (GAS f32x4*)(F.out + (size_t)(t + q) * D) + L;
#pragma unroll
                for (int j = 0; j < 4; ++j) { const f32x4 g = *(const LAS f32x4*)(gtm + b * D + 4 * L + 256 * j);
                    xv[q][j] = xv[q][j] + g * (mv[q][j] * r1); __builtin_nontemporal_store(xv[q][j], orow + 64 * j);
                    s2 += (xv[q][j].x * xv[q][j].x + xv[q][j].y * xv[q][j].y) + (xv[q][j].z * xv[q][j].z + xv[q][j].w * xv[q][j].w); }
                const float r2 = 1.f / sqrtf(wave_sum(s2) * (1.f / D) + NORM_EPS);
                GAS unsigned long long* h8 = (GAS unsigned long long*)(H2 + (size_t)(t + q) * D) + L;
#pragma unroll
                for (int j = 0; j < 4; ++j) { const f32x4 a = *(const LAS f32x4*)(pg2 + b * D + 4 * L + 256 * j), c = *(const LAS f32x4*)(shf + b * D + 4 * L + 256 * j);
                    const f32x4 h = xv[q][j] * r2 * a + c;
                    h8[64 * j] = (unsigned long long)pk2(h.x, h.y) | ((unsigned long long)pk2(h.z, h.w) << 32);
                    *(LAS f32x4*)(h2t + (2 * wv + q) * D + 4 * L + 256 * j) = h; } }
        }
        __syncthreads();
        {
            const int hi = (L >> 5) & 1, h2b = (L >> 4) & 1;
#pragma unroll 2
            for (int tk = 0; tk < 16; ++tk) {
                f32x4 a = {0.f, 0.f, 0.f, 0.f};
#pragma unroll
                for (int j = 0; j < 4; ++j) { const f32x4 h = *(const LAS f32x4*)(h2t + tk * D + 4 * L + 256 * j);
                    a += wreg[j * 4 + 0] * h.x; a += wreg[j * 4 + 1] * h.y; a += wreg[j * 4 + 2] * h.z; a += wreg[j * 4 + 3] * h.w; }
                const float m0 = hi ? a.z : a.x, o0 = hi ? a.x : a.z, m1 = hi ? a.w : a.y, o1 = hi ? a.y : a.w;
                const float v0 = m0 + __shfl_xor(o0, 32), v1 = m1 + __shfl_xor(o1, 32);
                float v = (h2b ? v1 : v0) + __shfl_xor(h2b ? v0 : v1, 16);
                v += __shfl_xor(v, 8); v += __shfl_xor(v, 4); v += __shfl_xor(v, 2); v += __shfl_xor(v, 1);
                if ((L & 15) == 0) lg[tk * NE + 4 * wv + 2 * hi + h2b] = v;
            }
        }
        __syncthreads();
        {
            const int e = L & 31, half = L >> 5, tl = 2 * wv + half, t = t0 + tl;
            float val = lg[tl * NE + e] + par[PAR_RB + e];
            int se[4]; float sv[4];
#pragma unroll
            for (int r = 0; r < 4; ++r) { float mx = val;
                mx = fmaxf(mx, __shfl_xor(mx, 16)); mx = fmaxf(mx, __shfl_xor(mx, 8)); mx = fmaxf(mx, __shfl_xor(mx, 4)); mx = fmaxf(mx, __shfl_xor(mx, 2)); mx = fmaxf(mx, __shfl_xor(mx, 1));
                const unsigned long long bal = __ballot(val == mx); const unsigned hm = half ? (unsigned)(bal >> 32) : (unsigned)bal; const int win = __ffs((int)hm) - 1;
                se[r] = win; sv[r] = mx; if (e == win) val = -3e38f; }
            const float e1 = __expf(sv[1] - sv[0]), e2 = __expf(sv[2] - sv[0]), e3 = __expf(sv[3] - sv[0]), inv = 1.f / (1.f + e1 + e2 + e3);
            if (e < 4) { const int ex = e == 0 ? se[0] : (e == 1 ? se[1] : (e == 2 ? se[2] : se[3]));
                const float wgt = (e == 0 ? 1.f : (e == 1 ? e1 : (e == 2 ? e2 : e3))) * inv;
                tok_e[t * 4 + e] = ex; tok_w[t * 4 + e] = wgt;
                const unsigned lp = dry ? 0u : __hip_atomic_fetch_add(hist + ex, 1u, __ATOMIC_RELAXED, __HIP_MEMORY_SCOPE_WORKGROUP);
                rec_e[tl * 4 + e] = ex; rec_lp[tl * 4 + e] = (int)lp; }
        }
        __syncthreads();
        if (F.tid < 32) { const unsigned h = hist[F.tid]; base[F.tid] = h ? __hip_atomic_fetch_add(gcnt + F.tid, h, RLX_AGENT) : 0u; }
        __syncthreads();
        if (!dry && F.tid < 64) { const int e_ = rec_e[F.tid], pos_ = (int)base[e_] + rec_lp[F.tid]; tok_pos[(t0 + (F.tid >> 2)) * 4 + (F.tid & 3)] = pos_;
            WSP(int, WS_ELIST)[e_ * ELCAP + pos_] = t0 + (F.tid >> 2); }
        if (F.tid < 32) hist[F.tid] = 0u;
        __syncthreads();
    }
}

__device__ __forceinline__ void moe_tables(Frame& F) {
    LAS int* cnt = (LAS int*)(F.lds + SCR_OFF); LAS int* off = cnt + 32; LAS int* tpre = off + 32;
    if (F.tid < NE) cnt[F.tid] = (int)__hip_atomic_load(F.ctl + CW_ECNT + F.tid, RLX_AGENT);
    __syncthreads();
    if (F.tid == 0) { int o = 0, tp = 0;
        for (int e = 0; e < NE; ++e) { const int c = cnt[e]; off[e] = o; tpre[e] = tp; o += c; tp += (c + 255) >> 8; }
        tpre[NE] = tp;
        LAS int* sg = cnt + MT_SEG; const int n = (tp + 31) >> 5; int ns = 0, pos = 0;
        for (int g = 0; g < n; ++g) { const int tg = (tp - 32 * g) < 32 ? (tp - 32 * g) : 32;
            sg[1 + ns] = pos; sg[1 + MT_MAXSEG + ns] = 0; sg[1 + 2 * MT_MAXSEG + ns] = g; ++ns; pos += 8 * tg; sg[1 + 3 * MT_MAXSEG + g] = pos;
            if (g >= MOE_LAG) { sg[1 + ns] = pos; sg[1 + MT_MAXSEG + ns] = 1; sg[1 + 2 * MT_MAXSEG + ns] = g - MOE_LAG; ++ns; pos += 4 * 32; } }
        for (int g = (n > MOE_LAG ? n - MOE_LAG : 0); g < n; ++g) { const int tg = (tp - 32 * g) < 32 ? (tp - 32 * g) : 32; sg[1 + ns] = pos; sg[1 + MT_MAXSEG + ns] = 1; sg[1 + 2 * MT_MAXSEG + ns] = g; ++ns; pos += 4 * tg; }
        sg[1 + ns] = pos; sg[0] = ns; }
    __syncthreads();
}
template <bool GA> struct MoeOrder {
    static constexpr bool GATHER = GA;
#if defined(T_ACQ)
    __device__ __forceinline__ void a_ready(const pg8::Unit&) const { if (!GA) { if (threadIdx.x < 64) { __builtin_amdgcn_fence(__ATOMIC_ACQUIRE, "agent"); asm volatile("s_waitcnt vmcnt(0)" ::: "memory"); } asm volatile("" ::: "memory"); __builtin_amdgcn_s_barrier(); asm volatile("" ::: "memory"); } }
#else
    __device__ __forceinline__ void a_ready(const pg8::Unit&) const {}
#endif
#if defined(T_DRAIN)
    __device__ __forceinline__ void done(const pg8::Unit&) const { if (GA) asm volatile("s_waitcnt vmcnt(0)" ::: "memory"); }
#else
    __device__ __forceinline__ void done(const pg8::Unit&) const {}
#endif
    const LAS int* tab; const int* elist; int nct, brows, G, c;
    __device__ __forceinline__ bool next(int i, pg8::Unit& u) const {
        int rtg, pn;
        if (G == 256) { const int xcd = c & 7, slot = c >> 3, rpx = 32 / nct;
            rtg = (i * 8 + xcd) * rpx + slot / nct; pn = slot % nct; if (rtg >= tab[64 + NE]) return false; }
        else { const int L = i * G + c, total = tab[64 + NE] * nct; if (L >= total) return false; rtg = L / nct; pn = L % nct; }
        int e = 0;
        for (int k = 1; k < NE; ++k) if (tab[64 + k] <= rtg) e = k;
        const int rt = rtg - tab[64 + e], cnt = tab[e], off = tab[32 + e];
        u.e = __builtin_amdgcn_readfirstlane(e); u.pm = __builtin_amdgcn_readfirstlane(rt); u.pn = pn; u.arow = __builtin_amdgcn_readfirstlane(off + rt * 256); u.brow = __builtin_amdgcn_readfirstlane(e * brows + pn * 256);
        const int nr = cnt - rt * 256; u.nrow = __builtin_amdgcn_readfirstlane(nr > 256 ? 256 : nr); u.kind = 0; u.aux = 0; return true;
    }
    __device__ __forceinline__ int arow_of(const pg8::Unit& u, int r) const { return r < u.nrow ? elist[u.e * ELCAP + u.pm * 256 + r] : 0; }
};
struct EpiGU { bf16* H1; const float* bg; const float* bu;
    __device__ __forceinline__ void operator()(const pg8::f32x4 (&acc)[2][2][4][2], const pg8::Unit& u, int wr, int wc, int fr, int fq) const {
        asm volatile("" : "+v"(fr), "+v"(fq));
        const int f0 = u.pn * 128 + wc * 32 + 8 * fq;
#pragma unroll
        for (int ai = 0; ai < 2; ++ai) {
            int fb = f0; asm volatile("" : "+v"(fb));
            const pg8::f32x4 g0 = *(const pg8::f32x4*)(bg + u.e * FF + fb), g1 = *(const pg8::f32x4*)(bg + u.e * FF + fb + 4);
            const pg8::f32x4 u0 = *(const pg8::f32x4*)(bu + u.e * FF + fb), u1 = *(const pg8::f32x4*)(bu + u.e * FF + fb + 4);
#pragma unroll
            for (int m = 0; m < 4; ++m) { const int r = ai * 128 + wr * 64 + m * 16 + fr;
                const pg8::f32x4 a0 = acc[ai][0][m][0] + g0, a1 = acc[ai][0][m][1] + g1, b0 = acc[ai][1][m][0] + u0, b1 = acc[ai][1][m][1] + u1;
                float gg[8] = {a0[0], a0[1], a0[2], a0[3], a1[0], a1[1], a1[2], a1[3]}, uu[8] = {b0[0], b0[1], b0[2], b0[3], b1[0], b1[1], b1[2], b1[3]}, o[8];
#pragma unroll
                for (int i = 0; i < 8; ++i) { const float g = fminf(gg[i], 7.f), up = fminf(fmaxf(uu[i], -7.f), 7.f); o[i] = g * sigmoidf_(1.702f * g) * (up + 1.f); }
                v4u w; w.x = pk2(o[0], o[1]); w.y = pk2(o[2], o[3]); w.z = pk2(o[4], o[5]); w.w = pk2(o[6], o[7]);
#ifdef T_SC1
                if (r < u.nrow) __builtin_amdgcn_raw_buffer_store_b128(w, __builtin_amdgcn_make_buffer_rsrc(H1, 0, (int)((size_t)T * TOPK * FF * 2), 0x00020000), (unsigned)((u.arow + r) * (FF * 2) + fb * 2), 0, 16); } }
#else
                if (r < u.nrow) *(v4u*)(H1 + (size_t)(u.arow + r) * FF + fb) = w; } }
#endif
    }
};
struct EpiDn { bf16* YB; const float* bd;
    __device__ __forceinline__ void operator()(const pg8::f32x4 (&acc)[2][2][4][2], const pg8::Unit& u, int wr, int wc, int fr, int fq) const {
        const int c0 = u.pn * 256 + wc * 32 + 8 * fq;
#pragma unroll
        for (int bj = 0; bj < 2; ++bj) { const pg8::f32x4 d0 = *(const pg8::f32x4*)(bd + u.e * D + c0 + bj * 128), d1 = *(const pg8::f32x4*)(bd + u.e * D + c0 + bj * 128 + 4);
#pragma unroll
            for (int ai = 0; ai < 2; ++ai)
#pragma unroll
                for (int m = 0; m < 4; ++m) { const int r = ai * 128 + wr * 64 + m * 16 + fr;
                    const pg8::f32x4 a0 = acc[ai][bj][m][0] + d0, a1 = acc[ai][bj][m][1] + d1;
                    v4u w; w.x = pk2(a0[0], a0[1]); w.y = pk2(a0[2], a0[3]); w.z = pk2(a1[0], a1[1]); w.w = pk2(a1[2], a1[3]);
                    if (r < u.nrow) *(v4u*)(YB + (size_t)(u.arow + r) * D + c0 + bj * 128) = w; } }
    }
};
constexpr int CW_RDY = 8448;
constexpr int H2ROW0 = (int)(WS_H2 / 2048), H1ROW0 = (int)(WS_H1 / 2048), DN_BROW0 = (int)((WS_WDN_T - WS_WGU_T) / 2048);
struct MoeFused {
    static constexpr bool GATHER = true;
    const LAS int* tab; const int* elist; gu32* ctl; int G, c, base;
    __device__ __forceinline__ bool next(int i, pg8::Unit& u) const {
        const LAS int* sg = tab + MT_SEG; const int ns = sg[0], L = (base + i) * G + c; if (L >= sg[1 + ns]) return false;
        int s = 0; for (int k = 1; k < ns; ++k) if (sg[1 + k] <= L) s = k;
        if (i > 0 && sg[1 + MT_MAXSEG + s] == 1 && L - sg[1 + 3 * MT_MAXSEG + sg[1 + 2 * MT_MAXSEG + s]] < G) return false;
        const int kind = sg[1 + MT_MAXSEG + s], g = sg[1 + 2 * MT_MAXSEG + s], ui = L - sg[1 + s], TT = tab[64 + NE], tg = (TT - 32 * g) < 32 ? (TT - 32 * g) : 32;
        int rt, pn;
        if (kind == 0) { if (tg == 32) { const int xcd = ui & 7, slot = ui >> 3; rt = xcd * 4 + (slot >> 3); pn = slot & 7; } else { rt = ui >> 3; pn = ui & 7; } }
        else { if (tg == 32) { const int xcd = ui & 7, slot = ui >> 3; rt = xcd * 4 + (slot >> 2); pn = slot & 3; } else { rt = ui >> 2; pn = ui & 3; } }
        const int rtg = 32 * g + rt; int e = 0;
        for (int k = 1; k < NE; ++k) if (tab[64 + k] <= rtg) e = k;
        const int rte = rtg - tab[64 + e], cnt = tab[e], off = tab[32 + e], nr = cnt - rte * 256;
        u.e = __builtin_amdgcn_readfirstlane(e); u.pm = __builtin_amdgcn_readfirstlane(rte); u.pn = __builtin_amdgcn_readfirstlane(pn); u.kind = __builtin_amdgcn_readfirstlane(kind); u.aux = __builtin_amdgcn_readfirstlane(rtg);
        u.arow = __builtin_amdgcn_readfirstlane(off + rte * 256); u.nrow = __builtin_amdgcn_readfirstlane(nr > 256 ? 256 : nr);
        u.brow = __builtin_amdgcn_readfirstlane(kind == 0 ? e * 2048 + pn * 256 : DN_BROW0 + e * 1024 + pn * 256); return true;
    }
    __device__ __forceinline__ int arow_of(const pg8::Unit& u, int r) const { return u.kind == 0 ? H2ROW0 + (r < u.nrow ? elist[u.e * ELCAP + u.pm * 256 + r] : 0) : H1ROW0 + u.arow + (r < u.nrow ? r : 0); }
    __device__ __forceinline__ void a_ready(const pg8::Unit& u) const {
        if (u.kind != 1) return;
        if (threadIdx.x < 64) {
            gu32* w = ctl + CW_RDY + u.aux; const unsigned long long t0 = __builtin_amdgcn_s_memrealtime();
            while ((unsigned)__builtin_amdgcn_readfirstlane(__hip_atomic_load(w, RLX_AGENT)) < 64u) {
                if (__builtin_amdgcn_s_memrealtime() - t0 > 2000000ull) { if (threadIdx.x == 0) __hip_atomic_store(ctl + CW_TMO, 1u, RLX_AGENT); break; }
                __builtin_amdgcn_s_sleep(2); }
#ifdef MOE_DELAY
            { const unsigned long long t1 = __builtin_amdgcn_s_memrealtime(); while (__builtin_amdgcn_s_memrealtime() - t1 < 2000ull) __builtin_amdgcn_s_sleep(8); }
#endif
            __builtin_amdgcn_fence(__ATOMIC_ACQUIRE, "agent");
            asm volatile("s_waitcnt vmcnt(0)" ::: "memory");
        }
        asm volatile("" ::: "memory"); __builtin_amdgcn_s_barrier(); asm volatile("" ::: "memory");
    }
    __device__ __forceinline__ void done(const pg8::Unit& u) const {
        if (u.kind != 0) return;
#ifndef DIAG_NODRAIN
        asm volatile("s_waitcnt vmcnt(0)" ::: "memory");
#endif
#if defined(MOE_REL)
        __builtin_amdgcn_fence(__ATOMIC_RELEASE, "agent"); asm volatile("s_waitcnt vmcnt(0)" ::: "memory");
#endif
        if ((threadIdx.x & 63) == 0) __hip_atomic_fetch_add(ctl + CW_RDY + u.aux, 1u, RLX_AGENT);
    }
};
struct EpiMoe { bf16* H1; bf16* YB; const float* bg; const float* bu; const float* bd;
    __device__ __forceinline__ void operator()(const pg8::f32x4 (&acc)[2][2][4][2], const pg8::Unit& u, int wr, int wc, int fr, int fq) const {
        asm volatile("" : "+v"(fr), "+v"(fq));
        if (u.kind == 0) {
            const int f0 = u.pn * 128 + wc * 32 + 8 * fq;
            const __amdgpu_buffer_rsrc_t h1rs = __builtin_amdgcn_make_buffer_rsrc(H1, 0, (int)((size_t)T * TOPK * FF * 2), 0x00020000);
#pragma unroll
            for (int ai = 0; ai < 2; ++ai) {
                int fb = f0; asm volatile("" : "+v"(fb));
                const pg8::f32x4 g0 = *(const pg8::f32x4*)(bg + u.e * FF + fb), g1 = *(const pg8::f32x4*)(bg + u.e * FF + fb + 4);
                const pg8::f32x4 u0 = *(const pg8::f32x4*)(bu + u.e * FF + fb), u1 = *(const pg8::f32x4*)(bu + u.e * FF + fb + 4);
#pragma unroll
                for (int m = 0; m < 4; ++m) { const int r = ai * 128 + wr * 64 + m * 16 + fr;
                    const pg8::f32x4 a0 = acc[ai][0][m][0] + g0, a1 = acc[ai][0][m][1] + g1, b0 = acc[ai][1][m][0] + u0, b1 = acc[ai][1][m][1] + u1;
                    float gg[8] = {a0[0], a0[1], a0[2], a0[3], a1[0], a1[1], a1[2], a1[3]}, uu[8] = {b0[0], b0[1], b0[2], b0[3], b1[0], b1[1], b1[2], b1[3]}, o[8];
#pragma unroll
                    for (int i = 0; i < 8; ++i) { const float g = fminf(gg[i], 7.f), up = fminf(fmaxf(uu[i], -7.f), 7.f); o[i] = g * sigmoidf_(1.702f * g) * (up + 1.f); }
#ifdef MOE_PLAIN
                    if (r < u.nrow) { v4u w; w.x = pk2(o[0], o[1]); w.y = pk2(o[2], o[3]); w.z = pk2(o[4], o[5]); w.w = pk2(o[6], o[7]); *(GAS v4u*)(H1 + (size_t)(u.arow + r) * FF + fb) = w; } } }
#else
                    if (r < u.nrow) { v4u w; w.x = pk2(o[0], o[1]); w.y = pk2(o[2], o[3]); w.z = pk2(o[4], o[5]); w.w = pk2(o[6], o[7]);
                        __builtin_amdgcn_raw_buffer_store_b128(w, h1rs, (unsigned)((u.arow + r) * (FF * 2) + fb * 2), 0, 16); } } }
#endif
        } else {
            const int c0 = u.pn * 256 + wc * 32 + 8 * fq;
#pragma unroll
            for (int bj = 0; bj < 2; ++bj) { const pg8::f32x4 d0 = *(const pg8::f32x4*)(bd + u.e * D + c0 + bj * 128), d1 = *(const pg8::f32x4*)(bd + u.e * D + c0 + bj * 128 + 4);
#pragma unroll
                for (int ai = 0; ai < 2; ++ai)
#pragma unroll
                    for (int m = 0; m < 4; ++m) { const int r = ai * 128 + wr * 64 + m * 16 + fr;
                        const pg8::f32x4 a0 = acc[ai][bj][m][0] + d0, a1 = acc[ai][bj][m][1] + d1;
                        v4u w; w.x = pk2(a0[0], a0[1]); w.y = pk2(a0[2], a0[3]); w.z = pk2(a1[0], a1[1]); w.w = pk2(a1[2], a1[3]);
                        if (r < u.nrow) *(GAS v4u*)(YB + (size_t)(u.arow + r) * D + c0 + bj * 128) = w; } }
        }
    }
};
__device__ __forceinline__ void phase_final(Frame& F, bool dry = false) {
    moe_tables(F);
    const LAS int* off = (const LAS int*)(F.lds + SCR_OFF) + 32;
    LAS float* gtf = (LAS float*)(F.lds);
    const float* adaf = WSP(float, WS_ADAF);
    for (int i = F.tid; i < 2 * D; i += NWAVES * 64) { const int b = i >> 10, k = i & (D - 1); gtf[i] = adaf[b * 6 * D + 5 * D + k] * WSP(float, WS_PAR)[PAR_FPOST + k]; }
    __syncthreads();
    const int gw = F.vcu * NWAVES + F.wave, NGW = F.G * NWAVES, L = F.lane;
    const int* tok_e = WSP(int, WS_ROUTE); const float* tok_w = (const float*)(tok_e + T * 4); const int* tok_pos = tok_e + 2 * T * 4;
    const bf16* YB = WSP(bf16, WS_YB);
    for (int t = gw * 2; t < T; t += NGW * 2) { const int b = t >> 13;
        int row_l = 0; float w_l = 0.f;
        if (L < 8) { const int idx = (t + (L >> 2)) * 4 + (L & 3); row_l = off[tok_e[idx]] + tok_pos[idx]; w_l = tok_w[idx]; }
        v2u yv[2][4][4]; f32x4 x1v[2][4]; float wk[2][4];
#pragma unroll
        for (int q = 0; q < 2; ++q) {
#pragma unroll
            for (int k = 0; k < 4; ++k) { const int row = __shfl(row_l, q * 4 + k); wk[q][k] = __shfl(w_l, q * 4 + k);
                const GAS v2u* yr = (const GAS v2u*)(YB + (size_t)row * D) + L;
#pragma unroll
                for (int j = 0; j < 4; ++j) yv[q][k][j] = __builtin_nontemporal_load(yr + 64 * j);
#ifdef DRY14_NOYB
                if (dry) { _Pragma("unroll") for (int j = 0; j < 4; ++j) yv[q][k][j] = (v2u){0x3f803f80u, 0x3f803f80u}; }
#endif
            }
            const GAS f32x4* xr = (const GAS f32x4*)(F.out + (size_t)(t + q) * D) + L;
#pragma unroll
            for (int j = 0; j < 4; ++j) x1v[q][j] = __builtin_nontemporal_load(xr + 64 * j); }
#pragma unroll
        for (int q = 0; q < 2; ++q) {
            f32x4 y[4];
#pragma unroll
            for (int j = 0; j < 4; ++j) y[j] = (f32x4){0.f, 0.f, 0.f, 0.f};
#pragma unroll
            for (int k = 0; k < 4; ++k)
#pragma unroll
                for (int j = 0; j < 4; ++j) { const v2u x = yv[q][k][j]; const float w = wk[q][k]; y[j].x += w * bflo(x.x); y[j].y += w * bfhi(x.x); y[j].z += w * bflo(x.y); y[j].w += w * bfhi(x.y); }
            float s = 0.f;
#pragma unroll
            for (int j = 0; j < 4; ++j) s += (y[j].x * y[j].x + y[j].y * y[j].y) + (y[j].z * y[j].z + y[j].w * y[j].w);
            const float r = 1.f / sqrtf(wave_sum(s) * (1.f / D) + NORM_EPS);
            GAS f32x4* wrow = dry ? (GAS f32x4*)(WSP(float, WS_WGU_T) + (size_t)(t + q) * D) + L : (GAS f32x4*)(F.out + (size_t)(t + q) * D) + L;
#pragma unroll
            for (int j = 0; j < 4; ++j) { const f32x4 g = *(const LAS f32x4*)(gtf + b * D + 4 * L + 256 * j); __builtin_nontemporal_store(x1v[q][j] + g * (y[j] * r), wrow + 64 * j); }
        }
    }
}
__device__ __forceinline__ bool opaque_ws(Frame& F) { asm volatile("" : "+s"(F.ws)); return true; }
#ifndef MK_N_LAUNCHES
#define MK_N_LAUNCHES 1
#endif
constexpr int N_PHASES = 15;
struct Args { const float* in[30]; float* out; unsigned char* ws; int ph_lo, ph_hi; };
__global__ void __launch_bounds__(NWAVES * 64, 2) mega_fwd(Args args) {
    extern __shared__ __attribute__((aligned(16))) unsigned char lds[];
    Frame F;
    F.lds = (LAS unsigned char*)lds;
    F.MISC = (volatile LAS unsigned*)(F.lds + MISC_OFF);
    F.tid = threadIdx.x; F.lane = F.tid & 63; F.wave = __builtin_amdgcn_readfirstlane(F.tid >> 6);
    F.G = gridDim.x; { const int bx = blockIdx.x; F.vcu = (F.G % 8 == 0) ? (bx % 8) * (F.G / 8) + bx / 8 : bx; }
    F.ws = args.ws; F.ctl = (gu32*)(args.ws + WS_CTL); F.out = args.out;
#pragma unroll
    for (int i = 0; i < 30; ++i) F.in[i] = args.in[i];
    for (int u = F.tid; u < (LDS_BYTES - LDSCTL_OFF) / 4; u += NWAVES * 64) ((LAS unsigned*)(F.lds + LDSCTL_OFF))[u] = 0u;
    __syncthreads();
    XcdBarrier bar; bar.bar = (unsigned*)(F.ctl + CW_BAR); bar.x = 0; bar.st = nullptr;
    if (MK_N_LAUNCHES == 1) bar = xcd_barrier_post((unsigned*)(F.ctl + CW_BAR), F.MISC + 8);
    const int lo = args.ph_lo, hi = args.ph_hi;
#ifndef PHMASK
#define PHMASK 0x7fff
#endif
#define IN(k) (((PHMASK >> (k)) & 1) && lo <= (k) && (k) < hi)
#ifdef DBG_A
#define STAMP(k) do { if (blockIdx.x == 0 && F.tid == 0) ((unsigned long long*)(F.ctl + 2048))[k] = __builtin_amdgcn_s_memrealtime(); } while (0)
#else
#define STAMP(k) do {} while (0)
#endif
#ifndef REP_PHASE
#define REP_PHASE -1
#endif
#define REPL(k) for (int rep_ = 0; rep_ < (REP_PHASE == (k) ? 2 : 1); ++rep_) if (opaque_ws(F))
#ifdef DBL_BAR
#define SEAM(k) do { if (IN(k)) { xcd_barrier(bar); xcd_barrier(bar); } STAMP((k) + 1); } while (0)
#else
#define SEAM(k) do { if (IN(k)) xcd_barrier(bar); STAMP((k) + 1); } while (0)
#endif
    PG8_LAS unsigned char* ring = F.lds + RING_OFF;
    const int bx = (int)blockIdx.x;

    STAMP(0);
    if (IN(0)) REPL(0) { phase0(F); } SEAM(0);
    if (IN(1)) REPL(1) { phase1(F); } SEAM(1);
    if (IN(2)) REPL(2) {
        pg8::Gemm g{WSP(bf16, WS_XN), WSP(bf16, WS_WIN_T), D, D, D}; pg8::DenseOrder S; S.init(T, INW, F.G, bx);
        EpiG1 E{WSP(bf16, WS_UA), WSP(bf16, WS_Q), WSP(bf16, WS_K), WSP(bf16, WS_V), WSP(bf16, WS_VT), WSP(bf16, WS_GS), WSP(bf16, WS_GA),
                WSP(float, WS_ROPE), WSP(float, WS_ROPE) + (size_t)T * 32, (float*)(F.ctl + CW_KM)};
        pg8::gemm_phase(ring, g, S, E);
        s5_fill_kt(F);
    } SEAM(2);
    if (IN(3)) REPL(3) {
        pg8::Gemm g{WSP(bf16, WS_UA), WSP(bf16, WS_S5M1), 384, 256, 256}; S5Order S{F.G, bx}; EpiS5A E{WSP(float, WS_S5E)};
        pg8::gemm_phase(ring, g, S, E);
        s5_fill_wc(F);
        attn_gate(F);
    } SEAM(3);
    if (IN(4)) REPL(4) { attn_items(F); s5_carry(F); } SEAM(4);
    if (IN(5)) REPL(5) {
        pg8::Gemm g{WSP(bf16, WS_UA), WSP(bf16, WS_S5WC), 384, 384, 384}; S5Order S{F.G, bx}; EpiS5C E{WSP(bf16, WS_YG)};
        pg8::gemm_phase(ring, g, S, E);
        attn_combine(F);
    } SEAM(5);
    if (IN(6)) REPL(6) {
        pg8::Gemm g{WSP(bf16, WS_YG), WSP(bf16, WS_WGLU_T), SW, SW, SW}; pg8::DenseOrder S; S.init(T, SW, F.G, bx);
        EpiEw<0> E{WSP(bf16, WS_Y2), WSP(bf16, WS_YG), nullptr, nullptr, SW};
        pg8::gemm_phase(ring, g, S, E);
    } SEAM(6);
    if (IN(7)) REPL(7) {
        pg8::Gemm g{WSP(bf16, WS_Y2), WSP(bf16, WS_WSB_T), SW, SW, SW}; pg8::DenseOrder S; S.init(T, D, F.G, bx);
        EpiEw<1> E{WSP(bf16, WS_M1), WSP(bf16, WS_GS), nullptr, nullptr, D};
        pg8::gemm_phase(ring, g, S, E);
    } SEAM(7);
    if (IN(8)) REPL(8) {
        pg8::Gemm g{WSP(bf16, WS_YA), WSP(bf16, WS_WAB_T), AW, AW, AW}; pg8::DenseOrder S; S.init(T, D, F.G, bx);
        EpiEw<2> E{WSP(bf16, WS_XN), WSP(bf16, WS_GA), WSP(bf16, WS_M1), nullptr, D};
        pg8::gemm_phase(ring, g, S, E);
    } SEAM(8);
    if (IN(9)) REPL(9) {
        pg8::Gemm g{WSP(bf16, WS_XN), WSP(bf16, WS_WOUT_T), D, D, D}; pg8::DenseOrder S; S.init(T, D, F.G, bx);
        EpiEw<3> E{nullptr, nullptr, nullptr, WSP(float, WS_MIX), D};
        pg8::gemm_phase(ring, g, S, E);
    } SEAM(9);
    if (IN(10)) REPL(10) { phase_rows(F, REP_PHASE == 10 && rep_ == 0); } SEAM(10);
#ifndef MOE_FUSED
    if (IN(12)) REPL(12) {
        moe_tables(F);
        pg8::Gemm g{WSP(bf16, WS_H2), WSP(bf16, WS_WGU_T), D, D, D}; MoeOrder<true> S{(const LAS int*)(F.lds + SCR_OFF), WSP(int, WS_ELIST), 8, 2048, F.G, bx};
        EpiGU E{WSP(bf16, WS_H1), WSP(float, WS_PAR) + PAR_BG, WSP(float, WS_PAR) + PAR_BU};
        pg8::gemm_phase(ring, g, S, E);
    } SEAM(12);
    if (IN(13)) REPL(13) {
        moe_tables(F);
        pg8::Gemm g{WSP(bf16, WS_H1), WSP(bf16, WS_WDN_T), FF, FF, FF}; MoeOrder<false> S{(const LAS int*)(F.lds + SCR_OFF), nullptr, 4, 1024, F.G, bx};
        EpiDn E{WSP(bf16, WS_YB), WSP(float, WS_PAR) + PAR_BD};
        pg8::gemm_phase(ring, g, S, E);
    } SEAM(13);
#else
    if (IN(12)) REPL(12) {
        moe_tables(F);
        pg8::Gemm g{(const bf16*)F.ws, WSP(bf16, WS_WGU_T), D, D, D};
        EpiMoe E{WSP(bf16, WS_H1), WSP(bf16, WS_YB), WSP(float, WS_PAR) + PAR_BG, WSP(float, WS_PAR) + PAR_BU, WSP(float, WS_PAR) + PAR_BD};
        for (int base = 0;;) { MoeFused S{(const LAS int*)(F.lds + SCR_OFF), WSP(int, WS_ELIST), F.ctl, F.G, bx, base};
            const int nd = pg8::gemm_phase(ring, g, S, E); if (nd == 0) break; base += nd; }
    } SEAM(12);
#endif
    if (IN(14)) REPL(14) { phase_final(F, REP_PHASE == 14 && rep_ == 0); }
#undef IN
#undef SEAM
}

extern "C" void kernel_launch(void* const* d_in, const int* in_sizes, int n_in, void* d_out, int out_size, void* d_ws, size_t ws_size, hipStream_t stream) {
    static int grid = 0;
    if (grid == 0) {
        if (n_in != 30 || in_sizes[0] != T * D || out_size != T * D || ws_size < WS_END) { fprintf(stderr, "kernel_launch: unexpected shapes (n_in %d, in0 %d, out %d, ws %zu)\n", n_in, n_in > 0 ? in_sizes[0] : -1, out_size, ws_size); grid = -1; return; }
        int dev = 0, cus = 0, per_cu = 0;
        if (hipGetDevice(&dev) != hipSuccess || hipDeviceGetAttribute(&cus, hipDeviceAttributeMultiprocessorCount, dev) != hipSuccess) { grid = -1; return; }
        if (hipFuncSetAttribute((const void*)mega_fwd, hipFuncAttributeMaxDynamicSharedMemorySize, LDS_BYTES) != hipSuccess) { fprintf(stderr, "kernel_launch: hipFuncSetAttribute failed\n"); grid = -1; return; }
        if (hipOccupancyMaxActiveBlocksPerMultiprocessor(&per_cu, (const void*)mega_fwd, NWAVES * 64, LDS_BYTES) != hipSuccess || per_cu < 1) { fprintf(stderr, "kernel_launch: occupancy query says %d\n", per_cu); }
        (void)hipGetLastError();
        grid = cus;
    }
    if (grid < 0) return;
    (void)hipMemsetAsync((char*)d_ws + WS_CTL, 0, CTL_ZERO_USED, stream);
    Args a{};
    for (int i = 0; i < 30; ++i) a.in[i] = (const float*)d_in[i];
    a.out = (float*)d_out; a.ws = (unsigned char*)d_ws;
#ifndef PLAIN_LAUNCH
    if (MK_N_LAUNCHES == 1) { a.ph_lo = 0; a.ph_hi = N_PHASES; void* kargs[] = {(void*)&a};
        const hipError_t e = hipLaunchCooperativeKernel((const void*)mega_fwd, dim3(grid), dim3(NWAVES * 64), kargs, LDS_BYTES, stream);
        if (e != hipSuccess) fprintf(stderr, "kernel_launch: cooperative launch failed: %s\n", hipGetErrorString(e)); }
#else
    if (MK_N_LAUNCHES == 1) { a.ph_lo = 0; a.ph_hi = N_PHASES; hipLaunchKernelGGL(mega_fwd, dim3(grid), dim3(NWAVES * 64), LDS_BYTES, stream, a); }
#endif
    else for (int p = 0; p < N_PHASES; ++p) { a.ph_lo = p; a.ph_hi = p + 1; hipLaunchKernelGGL(mega_fwd, dim3(grid), dim3(NWAVES * 64), LDS_BYTES, stream, a); }
}
```

```cpp
#include <hip/hip_runtime.h>
#include <cstdio>
#include <cstdint>
#define MK_N_LAUNCHES 1
namespace pg8 {
#define PG8_LAS __attribute__((address_space(3)))
typedef unsigned short bf16_t;
typedef short bf16x8 __attribute__((ext_vector_type(8)));
typedef float f32x4 __attribute__((ext_vector_type(4)));
typedef unsigned u32x4 __attribute__((ext_vector_type(4)));
typedef unsigned u32x2 __attribute__((ext_vector_type(2)));
typedef int v4i32 __attribute__((ext_vector_type(4)));
typedef int v8i32 __attribute__((ext_vector_type(8)));
constexpr int BM = 256, BK = 64, HALF = 128, HTB = HALF * BK * 2  , STAGE_BYTES = 8 * HTB, NXCD = 8, WGM = 8;

__host__ __device__ __forceinline__ int lds_byte(int r, int c) { const int st = (r >> 4) * 2 + (c >> 5), rr = r & 15, cc = c & 31, ob = rr * 64 + cc * 2; return st * 1024 + (ob ^ (((ob >> 9) & 1) << 5)); }
__host__ __device__ __forceinline__ void stage_rc(int b, int& R, int& C) { const int st = b / 1024, sb = b % 1024, swz = sb ^ (((sb >> 9) & 1) << 5); R = (st >> 1) * 16 + swz / 64; C = (st & 1) * 32 + (swz % 64) / 2; }

struct Unit { int arow, brow, pm, pn, e, nrow, kind, aux; };
struct Gemm { const bf16_t* A; const bf16_t* Bt; int lda, ldb, K; };

struct DenseOrder {
    static constexpr bool GATHER = false;
    __device__ __forceinline__ void a_ready(const Unit&) const {}
    __device__ __forceinline__ void done(const Unit&) const {}
    int nM, nN, nwg, G, c;
    __device__ __forceinline__ void init(int M, int N, int G_, int c_) { nM = M / BM; nN = N / BM; nwg = nM * nN; G = G_; c = c_; }
    __device__ __forceinline__ bool next(int i, Unit& u) const {
        const long L = (long)i * G + c; if (L >= nwg) return false;
        int wgid = (int)L; { const int q = nwg / NXCD, r = nwg % NXCD, xcd = wgid % NXCD, off = wgid / NXCD; wgid = (xcd < r ? xcd * (q + 1) : r * (q + 1) + (xcd - r) * q) + off; }
        const int nig = WGM * nN, gid = wgid / nig, fm = gid * WGM, gsz = (nM - fm) < WGM ? (nM - fm) : WGM;
        u.pm = fm + ((wgid % nig) % gsz); u.pn = (wgid % nig) / gsz; u.arow = u.pm * BM; u.brow = u.pn * BM; u.e = 0; u.nrow = BM; u.kind = 0; u.aux = 0; return true;
    }
};

template <class Epi, class Sched, bool F8 = false>
__device__ __forceinline__ int gemm_phase(PG8_LAS unsigned char* lds, const Gemm g, const Sched& S, const Epi& E) {
    const int tid = threadIdx.x, wid = __builtin_amdgcn_readfirstlane(tid >> 6), lane = tid & 63, wr = wid >> 2, wc = wid & 3, fr = lane & 15, fq = lane >> 4;
    const int K = g.K, nt = K / BK;
    constexpr bool GA = Sched::GATHER;
    unsigned voffA[2], voffB[2]; int gR[2]; unsigned gC[2];
#pragma unroll
    for (int i = 0; i < 2; ++i) { int R, C; stage_rc(tid * 16 + i * 8192, R, C); gR[i] = R; gC[i] = (unsigned)C * 2u;
        voffA[i] = (unsigned)(R * g.lda + C) * 2u; voffB[i] = (unsigned)(R * g.ldb + C) * 2u; }
    unsigned gA_cur[2][2], gA_nxt[2][2];
#define PG8_GATH(dst, un) do { _Pragma("unroll") for (int _h = 0; _h < 2; ++_h) _Pragma("unroll") for (int _i = 0; _i < 2; ++_i) dst[_h][_i] = (unsigned)S.arow_of(un, _h * HALF + gR[_i]) * (unsigned)(g.lda * 2) + gC[_i]; } while (0)
#define PG8_STAGE_A(bufoff, h, kbytes, nx) do { if constexpr (GA) { const char* gb_ = (const char*)g.A + (kbytes); _Pragma("unroll") for (int _i = 0; _i < 2; ++_i) { const unsigned vo_ = (nx) ? gA_nxt[h][_i] : gA_cur[h][_i]; \
        __builtin_amdgcn_global_load_lds((const unsigned*)(gb_ + vo_), (PG8_LAS unsigned*)(lds + (bufoff) + ldsw + _i * 8192), 16, 0, 0); } } \
    else { const char* gb_ = ((nx) ? nA : cA) + (kbytes) + (h) * hstepA; PG8_STAGE(bufoff, gb_, voffA); } } while (0)
    const size_t kstep = (size_t)(BK * 2);
    const size_t hstepA = (size_t)HALF * g.lda * 2, hstepB = (size_t)HALF * g.ldb * 2;
    const size_t rowA = (size_t)g.lda * 2, rowB = (size_t)g.ldb * 2;
    const unsigned ldsw = (unsigned)wid * 1024u;
    const int aoff = lds_byte(wr * 64 + fr, fq * 8), boff = lds_byte(wc * 32 + fr, fq * 8);
#define PG8_SA(b, h) (((b) * 2 + (h)) * HTB)
#define PG8_SB(b, h) ((4 + (b) * 2 + (h)) * HTB)
#define PG8_STAGE(bufoff, gbase, voff) do { _Pragma("unroll") for (int _i = 0; _i < 2; ++_i) \
        __builtin_amdgcn_global_load_lds((const unsigned*)((const char*)(gbase) + (voff)[_i]), (PG8_LAS unsigned*)(lds + (bufoff) + ldsw + _i * 8192), 16, 0, 0); } while (0)
#define PG8_LDA(dst, b, h) do { _Pragma("unroll") for (int m = 0; m < 4; ++m) { if constexpr (F8) { const v4i32 lo_ = *(const PG8_LAS v4i32*)(lds + PG8_SA(b, h) + aoff + m * 2048), hi_ = *(const PG8_LAS v4i32*)(lds + PG8_SA(b, h) + aoff + m * 2048 + 1024); dst##8[m] = __builtin_shufflevector(lo_, hi_, 0, 1, 2, 3, 4, 5, 6, 7); } \
        else { _Pragma("unroll") for (int k = 0; k < 2; ++k) dst[m][k] = *(const PG8_LAS bf16x8*)(lds + PG8_SA(b, h) + aoff + m * 2048 + k * 1024); } } } while (0)
#define PG8_LDB(dst, b, h) do { _Pragma("unroll") for (int n = 0; n < 2; ++n) { if constexpr (F8) { const v4i32 lo_ = *(const PG8_LAS v4i32*)(lds + PG8_SB(b, h) + boff + n * 2048), hi_ = *(const PG8_LAS v4i32*)(lds + PG8_SB(b, h) + boff + n * 2048 + 1024); dst##8[n] = __builtin_shufflevector(lo_, hi_, 0, 1, 2, 3, 4, 5, 6, 7); } \
        else { _Pragma("unroll") for (int k = 0; k < 2; ++k) dst[n][k] = *(const PG8_LAS bf16x8*)(lds + PG8_SB(b, h) + boff + n * 2048 + k * 1024); } } } while (0)
#define PG8_MMA(ai, bj, At, Bt) do { __builtin_amdgcn_s_setprio(1); _Pragma("unroll") for (int m = 0; m < 4; ++m) _Pragma("unroll") for (int n = 0; n < 2; ++n) { \
        if constexpr (F8) { asm("v_mfma_scale_f32_16x16x128_f8f6f4 %0, %1, %2, %0, %3, %3 op_sel_hi:[0,0,0]" : "+v"(acc[ai][bj][m][n]) : "v"(Bt##8[n]), "v"(At##8[m]), "v"(one_scale)); } \
        else { _Pragma("unroll") for (int k = 0; k < 2; ++k) acc[ai][bj][m][n] = __builtin_amdgcn_mfma_f32_16x16x32_bf16(Bt[n][k], At[m][k], acc[ai][bj][m][n], 0, 0, 0); } } \
        __builtin_amdgcn_s_setprio(0); } while (0)
#define PG8_WAIT_V(n) asm volatile("s_waitcnt vmcnt(" #n ")" ::: "memory")
#define PG8_WAIT_L(n) asm volatile("s_waitcnt lgkmcnt(" #n ")" ::: "memory")
#define PG8_BAR __builtin_amdgcn_s_barrier()
#define PG8_SCHED __builtin_amdgcn_sched_barrier(0)
    Unit cur, nxt; int ui = 0;
    if (!S.next(0, cur)) return 0;
    f32x4 acc[2][2][4][2];
#pragma unroll
    for (int a = 0; a < 2; ++a)
#pragma unroll
        for (int b = 0; b < 2; ++b)
#pragma unroll
            for (int m = 0; m < 4; ++m)
#pragma unroll
                for (int n = 0; n < 2; ++n) acc[a][b][m][n] = (f32x4){0.f, 0.f, 0.f, 0.f};
    const int one_scale = 0x7f7f7f7f;
    bf16x8 At[4][2], B0[2][2], B1[2][2];
    v8i32 At8[4], B08[2], B18[2];
    const char* cA = GA ? (const char*)g.A : (const char*)g.A + (size_t)cur.arow * rowA; const char* cB = (const char*)g.Bt + (size_t)cur.brow * rowB; const char* nA = cA;
    if constexpr (GA) { PG8_GATH(gA_cur, cur); }
    S.a_ready(cur);
    PG8_STAGE(PG8_SB(0, 0), cB, voffB); PG8_STAGE(PG8_SB(0, 1), cB + hstepB, voffB); PG8_STAGE_A(PG8_SA(0, 0), 0, 0, false); PG8_STAGE_A(PG8_SA(0, 1), 1, 0, false);
    if (wr == 1) PG8_BAR;
    PG8_WAIT_V(2); PG8_BAR;
    PG8_STAGE(PG8_SB(1, 0), cB + kstep, voffB); PG8_STAGE_A(PG8_SA(1, 0), 0, kstep, false); PG8_STAGE(PG8_SB(1, 1), cB + hstepB + kstep, voffB);
    PG8_WAIT_V(6); PG8_BAR;
    for (;;) {
        const bool has_next = S.next(ui + 1, nxt);
        nA = GA ? cA : (has_next ? (const char*)g.A + (size_t)nxt.arow * rowA : cA); const char* nB = has_next ? (const char*)g.Bt + (size_t)nxt.brow * rowB : cB;
        if constexpr (GA) { if (has_next) { PG8_GATH(gA_nxt, nxt); } else { _Pragma("unroll") for (int _h = 0; _h < 2; ++_h) _Pragma("unroll") for (int _i = 0; _i < 2; ++_i) gA_nxt[_h][_i] = gA_cur[_h][_i]; } }
#pragma unroll 1
        for (int t = 0; t < nt; t += 2) {
            const bool last = (t == nt - 2);
            if (last && has_next) S.a_ready(nxt);
            const size_t k1 = (size_t)(t + 1) * kstep, k2 = last ? (size_t)0 : (size_t)(t + 2) * kstep, k3 = k2 + kstep;
            const char* b2 = last ? nB : cB + (size_t)(t + 2) * kstep; const char* b3 = b2 + kstep;
            PG8_LDB(B0, 0, 0); PG8_LDB(B1, 0, 1); PG8_SCHED; PG8_LDA(At, 0, 0); PG8_STAGE_A(PG8_SA(1, 1), 1, k1, false);
            PG8_WAIT_V(8); PG8_WAIT_L(0); PG8_BAR; PG8_MMA(0, 0, At, B0); PG8_MMA(0, 1, At, B1); PG8_BAR; PG8_SCHED;
            PG8_LDA(At, 0, 1); PG8_STAGE(PG8_SB(0, 0), b2, voffB); PG8_STAGE(PG8_SB(0, 1), b2 + hstepB, voffB); PG8_STAGE_A(PG8_SA(0, 0), 0, k2, last);
            PG8_WAIT_V(8); PG8_WAIT_L(0); PG8_BAR; PG8_MMA(1, 0, At, B0); PG8_MMA(1, 1, At, B1); PG8_BAR; PG8_SCHED;
            PG8_LDB(B0, 1, 0); PG8_LDB(B1, 1, 1); PG8_SCHED; PG8_LDA(At, 1, 0); PG8_STAGE_A(PG8_SA(0, 1), 1, k2, last);
            PG8_WAIT_V(8); PG8_WAIT_L(0); PG8_BAR; PG8_MMA(0, 0, At, B0); PG8_MMA(0, 1, At, B1); PG8_BAR; PG8_SCHED;
            PG8_LDA(At, 1, 1); PG8_STAGE(PG8_SB(1, 0), b3, voffB); PG8_STAGE(PG8_SB(1, 1), b3 + hstepB, voffB); PG8_STAGE_A(PG8_SA(1, 0), 0, k3, last);
            PG8_WAIT_V(8); PG8_WAIT_L(0); PG8_BAR; PG8_MMA(1, 0, At, B0); PG8_MMA(1, 1, At, B1); PG8_BAR; PG8_SCHED;
        }
        if (wr == 0) PG8_BAR;
        E(acc, cur, wr, wc, fr, fq);
        S.done(cur);
        if (!has_next) break;
#pragma unroll
        for (int a = 0; a < 2; ++a)
#pragma unroll
            for (int b = 0; b < 2; ++b)
#pragma unroll
                for (int m = 0; m < 4; ++m)
#pragma unroll
                    for (int n = 0; n < 2; ++n) acc[a][b][m][n] = (f32x4){0.f, 0.f, 0.f, 0.f};
        cur = nxt; cA = nA; cB = nB; ++ui;
        if constexpr (GA) { _Pragma("unroll") for (int _h = 0; _h < 2; ++_h) _Pragma("unroll") for (int _i = 0; _i < 2; ++_i) gA_cur[_h][_i] = gA_nxt[_h][_i]; }
        if (wr == 1) PG8_BAR;
    }
    PG8_WAIT_V(0);
    PG8_BAR;
    const int n_done_ = ui + 1;
#undef PG8_SA
#undef PG8_SB
#undef PG8_STAGE
#undef PG8_STAGE_A
#undef PG8_GATH
#undef PG8_LDA
#undef PG8_LDB
#undef PG8_MMA
#undef PG8_WAIT_V
#undef PG8_WAIT_L
#undef PG8_BAR
#undef PG8_SCHED
    return n_done_;
}
}
constexpr int NWAVES = 8;
constexpr int BATCH = 2, SEQ = 8192, T = BATCH * SEQ, D = 1024, NH = 8, HD = 64, AW = 512, SW = 512, NG = 32, NP = 64, GS16 = 16;
constexpr int NE = 32, FF = 1024, INW = 4096, TOPK = 4, NBLK = SEQ / 256;
constexpr float NORM_EPS = 1e-6f;
constexpr float C2 = 0.125f * 1.4426950408889634f;
constexpr int XROWS = T * TOPK + 256;

constexpr size_t MiB = 1u << 20;
constexpr size_t WS_CTL = 0, CTL_ZERO_BYTES = 1 * MiB;
constexpr size_t WS_ADA = 1 * MiB;
constexpr size_t WS_ADAF = WS_ADA + 832 * 1024;
constexpr size_t WS_ROPE = 2 * MiB;
constexpr size_t WS_S5P = 6 * MiB;
constexpr size_t WS_S5KT = 7 * MiB;
constexpr size_t WS_S5M1 = 10 * MiB;
constexpr size_t WS_S5WC = 506 * MiB;
constexpr size_t WS_S5E = 408 * MiB;
constexpr size_t WS_ROUTE = 9 * MiB;
constexpr size_t WS_ELIST = 14 * MiB; constexpr int ELCAP = T;
constexpr size_t WS_HSC = WS_ROUTE + 768 * 1024;
constexpr int PAR_WSC = 270000;
#ifndef MOE_BF16
#define MOE_F8 1
#endif
constexpr size_t WS_WIN_T = 18 * MiB, WS_WGLU_T = 26 * MiB, WS_WSB_T = 27 * MiB, WS_WAB_T = 28 * MiB, WS_WOUT_T = 29 * MiB;
constexpr size_t WS_PAR = 16 * MiB;
constexpr int PAR_MPG = 0, PAR_FPRE = 1024, PAR_FPOST = 2048, PAR_RB = 3072, PAR_RW = 4096, PAR_BG = 36864, PAR_BU = 69632, PAR_BD = 102400, PAR_CRE = 135168, PAR_CIM = 167936, PAR_SD = 200704, PAR_BRE = 201728, PAR_BIM = 234496;
constexpr size_t WS_WGU_T = 32 * MiB, WS_WDN_T = 160 * MiB;
constexpr size_t WS_XN = 224 * MiB;
constexpr size_t WS_UA = 256 * MiB, WS_Q = 280 * MiB, WS_K = 296 * MiB, WS_V = 312 * MiB, WS_VT = 328 * MiB;
constexpr size_t WS_MIX = 256 * MiB;
constexpr size_t WS_GS = 344 * MiB, WS_GA = 376 * MiB;
constexpr size_t WS_YG = 408 * MiB, WS_Y2 = 424 * MiB, WS_YA = 440 * MiB;
constexpr size_t WS_M1 = 456 * MiB;
constexpr size_t WS_H2 = 480 * MiB;
constexpr size_t WS_XG = 224 * MiB, WS_YB = 224 * MiB;
constexpr size_t WS_H1 = 352 * MiB;
constexpr size_t WS_END = 512 * MiB;
static_assert(WS_YB + (size_t)T * TOPK * D * 2 <= WS_H1 && WS_H1 + (size_t)T * TOPK * FF * 2 <= WS_H2 && WS_H2 + (size_t)T * D * 2 <= WS_END, "ws map");
constexpr int CW_TMO = 0, CW_CODE = 1, CW_BAR = 4096, CW_ECNT = 8192, CW_KM = 16384;
constexpr size_t CTL_ZERO_USED = (size_t)(CW_KM + BATCH * NH * NBLK * HD) * 4;
static_assert(CTL_ZERO_USED <= CTL_ZERO_BYTES, "ctl");

constexpr int RING_OFF = 0, RING_BYTES = 131072;
constexpr int LDSCTL_OFF = 152 * 1024, MISC_OFF = LDSCTL_OFF + 320;
constexpr int LDS_BYTES = 156 * 1024;

#define GAS __attribute__((address_space(1)))
#define LAS __attribute__((address_space(3)))
typedef unsigned short bf16;
typedef unsigned v4u __attribute__((ext_vector_type(4)));
typedef unsigned v2u __attribute__((ext_vector_type(2)));
typedef float f32x4 __attribute__((ext_vector_type(4)));
typedef GAS unsigned gu32;
#define RLX_AGENT __ATOMIC_RELAXED, __HIP_MEMORY_SCOPE_AGENT
#define LDS_WAIT() asm volatile("s_waitcnt lgkmcnt(0)" ::: "memory")
#define VM_WAIT() asm volatile("s_waitcnt vmcnt(0)" ::: "memory")
__device__ __forceinline__ unsigned f2bf(float f) { unsigned u = __builtin_bit_cast(unsigned, f); return (u + 0x7fffu + ((u >> 16) & 1u)) >> 16; }
__device__ __forceinline__ unsigned pk2(float lo, float hi) { typedef float f32x2_t __attribute__((ext_vector_type(2))); typedef __bf16 bf16x2_t __attribute__((ext_vector_type(2)));
    f32x2_t v = {lo, hi}; bf16x2_t r = __builtin_convertvector(v, bf16x2_t); return __builtin_bit_cast(unsigned, r); }
#ifdef WT_STORES
__device__ __forceinline__ void st16(void* p, v4u v) { asm volatile("global_store_dwordx4 %0, %1, off sc1\n\ts_nop 1" :: "v"(p), "v"(v) : "memory"); }
__device__ __forceinline__ void st8(void* p, v2u v) { asm volatile("global_store_dwordx2 %0, %1, off sc1\n\ts_nop 1" :: "v"(p), "v"(v) : "memory"); }
#else
__device__ __forceinline__ void st16(void* p, v4u v) { *(v4u*)p = v; }
__device__ __forceinline__ void st8(void* p, v2u v) { *(v2u*)p = v; }
#endif
__device__ __forceinline__ unsigned pk4_fp8(float a, float b, float c, float d) {
    a = fminf(fmaxf(a, -448.f), 448.f); b = fminf(fmaxf(b, -448.f), 448.f); c = fminf(fmaxf(c, -448.f), 448.f); d = fminf(fmaxf(d, -448.f), 448.f);
    int w = 0; w = __builtin_amdgcn_cvt_pk_fp8_f32(a, b, w, false); w = __builtin_amdgcn_cvt_pk_fp8_f32(c, d, w, true); return (unsigned)w; }
__device__ __forceinline__ float bflo(unsigned w) { return __builtin_bit_cast(float, w << 16); }
__device__ __forceinline__ float bfhi(unsigned w) { return __builtin_bit_cast(float, w & 0xffff0000u); }
__device__ __forceinline__ float bf2f(bf16 h) { return __builtin_bit_cast(float, (unsigned)h << 16); }
__device__ __forceinline__ float sigmoidf_(float x) { return 1.f / (1.f + __expf(-x)); }
__device__ __forceinline__ float gelu_tanh(float x) { const float u = 1.5957691216057308f * (x + 0.044715f * x * x * x); return x / (1.f + __expf(-u)); }

#define XB_TMO      128
#define XB_XCNT(j)  (256  + 64 * (j))
#define XB_XSUB(j)  (1280 + 64 * (j))
#define XB_XGEN(j)  (2304 + 64 * (j))
#define XB_TOP      3328
#define XB_TOPGEN   3392
#define XCD_BAR_WORDS 3456
#define XB_SPIN_CAP (1u << 18)
__device__ __forceinline__ unsigned xb_ld(unsigned* p)              { return __hip_atomic_load(p, __ATOMIC_RELAXED, __HIP_MEMORY_SCOPE_AGENT); }
__device__ __forceinline__ unsigned xb_add(unsigned* p, unsigned v) { return __hip_atomic_fetch_add(p, v, __ATOMIC_RELAXED, __HIP_MEMORY_SCOPE_AGENT); }
__device__ __forceinline__ unsigned xb_xcc_id() { return (unsigned)__builtin_amdgcn_s_getreg((3 << 11) | 20) & 0xFu; }
#define XB_SPIN(cond, bar) do { unsigned _sp = 0; while (cond) { __builtin_amdgcn_s_sleep(1); \
    if ((++_sp & 255u) == 0u) { if (xb_ld(&(bar)[XB_TMO])) break; if (_sp > XB_SPIN_CAP) { atomicAdd(&(bar)[XB_TMO], 1u); break; } } } } while (0)
struct XcdBarrier { unsigned* bar; unsigned x; volatile LAS unsigned* st; };
__device__ __forceinline__ XcdBarrier xcd_barrier_post(unsigned* bar, volatile LAS unsigned* st) {
    XcdBarrier b; b.bar = bar; b.x = xb_xcc_id(); b.st = st;
    if (threadIdx.x == 0) (void)xb_add(&bar[XB_XCNT(b.x)], 1u);
    return b;
}
__device__ __forceinline__ void xcd_barrier_complete(unsigned* bar, unsigned x, unsigned& nloc, unsigned& nx) {
    const unsigned G = gridDim.x * gridDim.y * gridDim.z;
    unsigned sum, cnt, mine, sp = 0u;
    for (;;) {
        sum = 0u; cnt = 0u; mine = 0u;
#pragma unroll
        for (unsigned j = 0; j < 16; ++j) { const unsigned c = xb_ld(&bar[XB_XCNT(j)]); sum += c; cnt += (c > 0u) ? 1u : 0u; mine = (j == x) ? c : mine; }
        if (sum == G) break;
        __builtin_amdgcn_s_sleep(1);
        if ((++sp & 255u) == 0u) { if (xb_ld(&bar[XB_TMO])) break; if (sp > XB_SPIN_CAP) { atomicAdd(&bar[XB_TMO], 1u); break; } }
    }
    nloc = mine > 0u ? mine : 1u; nx = cnt > 0u ? cnt : 1u;
}
__device__ __forceinline__ void xcd_barrier(const XcdBarrier& b) {
    asm volatile("s_waitcnt vmcnt(0)" ::: "memory");
    __syncthreads();
    if (threadIdx.x == 0) {
        unsigned* bar = b.bar;
        __builtin_amdgcn_s_waitcnt(0);
        unsigned nloc = b.st[0], nx = b.st[1];
        if (nloc == 0u) { xcd_barrier_complete(bar, b.x, nloc, nx); b.st[0] = nloc; b.st[1] = nx; }
        const unsigned old = xb_add(&bar[XB_XSUB(b.x)], 1u);
        const unsigned gen = old / nloc;
        if (old + 1u == (gen + 1u) * nloc) {
            __builtin_amdgcn_fence(__ATOMIC_RELEASE, "agent");
            asm volatile("s_waitcnt vmcnt(0)" ::: "memory");
            const unsigned og = xb_add(&bar[XB_TOP], 1u);
            const unsigned tg = og / nx;
            if (og + 1u == (tg + 1u) * nx) xb_add(&bar[XB_TOPGEN], 1u);
            else XB_SPIN(xb_ld(&bar[XB_TOPGEN]) == tg, bar);
            __builtin_amdgcn_fence(__ATOMIC_ACQUIRE, "agent");
            xb_add(&bar[XB_XGEN(b.x)], 1u);
            asm volatile("s_waitcnt vmcnt(0)" ::: "memory");
        } else {
            XB_SPIN(xb_ld(&bar[XB_XGEN(b.x)]) == gen, bar);
            __builtin_amdgcn_fence(__ATOMIC_ACQUIRE, "agent");
            asm volatile("s_waitcnt vmcnt(0)" ::: "memory");
        }
    }
    __syncthreads();
}

__device__ __forceinline__ float wave_sum(float v) {
#pragma unroll
    for (int o = 1; o < 64; o <<= 1) v += __shfl_xor(v, o);
    return v;
}
__device__ __forceinline__ float wave_max(float v) {
#pragma unroll
    for (int o = 1; o < 64; o <<= 1) v = fmaxf(v, __shfl_xor(v, o));
    return v;
}
struct Frame {
    LAS unsigned char* lds;
    volatile LAS unsigned* MISC;
    gu32* ctl;
    int tid, lane, wave;
    int vcu, G;
    unsigned char* ws;
    const float* in[30];
    float* out;
};
#define WSP(T_, off) ((T_*)(F.ws + (off)))

__device__ __forceinline__ int perm8(int c) { return (c & ~31) + 16 * ((c >> 2) & 1) + 4 * ((c >> 3) & 3) + (c & 3); }
struct MapP8 { int off; __device__ __forceinline__ int operator()(int n) const { return off + perm8(n); } };
struct MapWin { __device__ __forceinline__ int operator()(int c) const {
    if (c < 512 || c >= 1536) return perm8(c);
    const int base = (c < 1024) ? 512 : 1024, cc = c - base, head = cc >> 6, d = cc & 63, pnq = head >> 2, hh = head & 3, n = d >> 5, dd = d & 31;
    const int wc = 2 * (hh & 1) + (dd >> 4), bj = hh >> 1, j = dd & 15;
    return base + 256 * pnq + 128 * bj + 32 * wc + 16 * n + j; } };
struct MapGU { int e, up; __device__ __forceinline__ int operator()(int f) const { return e * 2048 + (f >> 7) * 256 + up * 128 + perm8(f & 127); } };

template <class RowMap>
__device__ __forceinline__ void p0_transpose_item(const float* W, int K, int N, bf16* WT, LAS float* scr, int item, int lane, const RowMap rm) {
    const int nblk = N / 64, kb = item / nblk, nb = item % nblk, k0 = 64 * kb, n0 = 64 * nb;
    const int lr = lane >> 4, lc = 4 * (lane & 15);
    f32x4 v[16];
#pragma unroll
    for (int i = 0; i < 16; ++i) v[i] = __builtin_nontemporal_load((const GAS f32x4*)(W + (size_t)(k0 + 4 * i + lr) * N + n0 + lc));
#pragma unroll
    for (int i = 0; i < 16; ++i) { LAS float* d = scr + (4 * i + lr) * 65 + lc; d[0] = v[i].x; d[1] = v[i].y; d[2] = v[i].z; d[3] = v[i].w; }
    LDS_WAIT(); asm volatile("" ::: "memory");
    const int c = lane & 7;
#pragma unroll
    for (int j = 0; j < 8; ++j) { const int n = (lane >> 3) + 8 * j; const LAS float* s = scr + (8 * c) * 65 + n;
        v4u o; o.x = pk2(s[0 * 65], s[1 * 65]); o.y = pk2(s[2 * 65], s[3 * 65]); o.z = pk2(s[4 * 65], s[5 * 65]); o.w = pk2(s[6 * 65], s[7 * 65]);
        __builtin_nontemporal_store(o, (GAS v4u*)(WT + (size_t)rm(n0 + n) * K + k0 + 8 * c)); }
    LDS_WAIT(); asm volatile("" ::: "memory");
}

template <class RowMap>
__device__ __forceinline__ void p0_transpose_item_f8(const float* W, int K, int N, unsigned char* WT, LAS float* scr, int item, int lane, const RowMap rm, float wsc) {
    const int nblk = N / 64, kb = item / nblk, nb = item % nblk, k0 = 64 * kb, n0 = 64 * nb;
    const int lr = lane >> 4, lc = 4 * (lane & 15);
    f32x4 v[16];
#pragma unroll
    for (int i = 0; i < 16; ++i) v[i] = __builtin_nontemporal_load((const GAS f32x4*)(W + (size_t)(k0 + 4 * i + lr) * N + n0 + lc));
#pragma unroll
    for (int i = 0; i < 16; ++i) { LAS float* d = scr + (4 * i + lr) * 65 + lc; d[0] = v[i].x * wsc; d[1] = v[i].y * wsc; d[2] = v[i].z * wsc; d[3] = v[i].w * wsc; }
    LDS_WAIT(); asm volatile("" ::: "memory");
    const int c = lane & 3;
#pragma unroll
    for (int j = 0; j < 4; ++j) { const int n = (lane >> 2) + 16 * j; const LAS float* s = scr + (16 * c) * 65 + n;
        v4u o; o.x = pk4_fp8(s[0 * 65], s[1 * 65], s[2 * 65], s[3 * 65]); o.y = pk4_fp8(s[4 * 65], s[5 * 65], s[6 * 65], s[7 * 65]);
        o.z = pk4_fp8(s[8 * 65], s[9 * 65], s[10 * 65], s[11 * 65]); o.w = pk4_fp8(s[12 * 65], s[13 * 65], s[14 * 65], s[15 * 65]);
        __builtin_nontemporal_store(o, (GAS v4u*)(WT + (size_t)rm(n0 + n) * K + k0 + 16 * c)); }
    LDS_WAIT(); asm volatile("" ::: "memory");
}

__device__ __forceinline__ void phase0(Frame& F) {
    LAS float* scr = (LAS float*)(F.lds + RING_OFF + F.wave * 16640);
    const int gw = F.vcu * NWAVES + F.wave, NGW = F.G * NWAVES;
#ifdef MOE_F8
    float wsc;
    { float am = 0.f;
      for (int j = F.tid; j < 2048; j += NWAVES * 64) { const size_t o = (size_t)j * 16384 + 37 * (j & 63);
          am = fmaxf(am, fmaxf(fabsf(F.in[24][o]), fmaxf(fabsf(F.in[26][o]), fabsf(F.in[28][o])))); }
      am = wave_max(am); LAS float* red = (LAS float*)(F.lds + LDSCTL_OFF + 64);
      if (F.lane == 0) red[F.wave] = am;
      __syncthreads();
      am = red[0];
#pragma unroll
      for (int w = 1; w < NWAVES; ++w) am = fmaxf(am, red[w]);
      wsc = exp2f(floorf(log2f(448.f / (fmaxf(am, 1e-30f) * 8.f))));
      if (blockIdx.x == 0 && F.tid == 0) WSP(float, WS_PAR)[PAR_WSC] = wsc;
      __syncthreads(); }
#endif
    constexpr int I_WIN = 16 * 64, I_GLU = 8 * 8, I_SB = 8 * 16, I_AB = 8 * 16, I_OUT = 16 * 16, I_E = 16 * 16;
    constexpr int I_SMALL = I_WIN + I_GLU + I_SB + I_AB + I_OUT, I_MOE = 3 * NE * I_E, I_ADA = 16 * 96;
    constexpr int NITEMS = I_SMALL + I_MOE + I_ADA;
    for (int it = gw; it < NITEMS; it += NGW) {
        int r = it;
        if (r < I_WIN) { p0_transpose_item(F.in[9], D, INW, WSP(bf16, WS_WIN_T), scr, r, F.lane, MapWin{}); continue; } r -= I_WIN;
        if (r < I_GLU) { p0_transpose_item(F.in[18], SW, SW, WSP(bf16, WS_WGLU_T), scr, r, F.lane, MapP8{0}); continue; } r -= I_GLU;
        if (r < I_SB) { p0_transpose_item(F.in[19], SW, D, WSP(bf16, WS_WSB_T), scr, r, F.lane, MapP8{0}); continue; } r -= I_SB;
        if (r < I_AB) { p0_transpose_item(F.in[20], AW, D, WSP(bf16, WS_WAB_T), scr, r, F.lane, MapP8{0}); continue; } r -= I_AB;
        if (r < I_OUT) { p0_transpose_item(F.in[21], D, D, WSP(bf16, WS_WOUT_T), scr, r, F.lane, MapP8{0}); continue; } r -= I_OUT;
        if (r < I_MOE) {
            const int mat = r / I_E, item = r % I_E, kind = mat / NE, e = mat % NE;
#ifdef MOE_F8
            if (kind == 0) p0_transpose_item_f8(F.in[24] + (size_t)e * D * FF, D, FF, WSP(unsigned char, WS_WGU_T), scr, item, F.lane, MapGU{e, 0}, wsc);
            else if (kind == 1) p0_transpose_item_f8(F.in[26] + (size_t)e * D * FF, D, FF, WSP(unsigned char, WS_WGU_T), scr, item, F.lane, MapGU{e, 1}, wsc);
            else p0_transpose_item_f8(F.in[28] + (size_t)e * FF * D, FF, D, WSP(unsigned char, WS_WDN_T), scr, item, F.lane, MapP8{e * 1024}, wsc);
#else
            if (kind == 0) p0_transpose_item(F.in[24] + (size_t)e * D * FF, D, FF, WSP(bf16, WS_WGU_T), scr, item, F.lane, MapGU{e, 0});
            else if (kind == 1) p0_transpose_item(F.in[26] + (size_t)e * D * FF, D, FF, WSP(bf16, WS_WGU_T), scr, item, F.lane, MapGU{e, 1});
            else p0_transpose_item(F.in[28] + (size_t)e * FF * D, FF, D, WSP(bf16, WS_WDN_T), scr, item, F.lane, MapP8{e * 1024});
#endif
            continue; }
        r -= I_MOE;
        {
            const int ks = r / 96, cc = r % 96, n = cc * 64 + F.lane;
            const float* cvec = F.in[1]; const float* aw = F.in[3];
            float a0 = 0.f, a1 = 0.f;
            for (int k = ks * 64; k < ks * 64 + 64; ++k) {
                const float c0 = cvec[k], c1 = cvec[D + k];
                const float s0 = c0 / (1.f + __expf(-c0)), s1 = c1 / (1.f + __expf(-c1));
                const float w = __builtin_nontemporal_load(aw + (size_t)k * (6 * D) + n);
                a0 += s0 * w; a1 += s1 * w; }
            float* part = WSP(float, WS_ADA);
            part[(ks * 2 + 0) * (6 * D) + n] = a0; part[(ks * 2 + 1) * (6 * D) + n] = a1;
        }
    }
    const int gt = F.vcu * (NWAVES * 64) + F.tid, NGT = F.G * NWAVES * 64;
    { const int* pos = (const int*)F.in[2]; float* rc = WSP(float, WS_ROPE); float* rs = rc + (size_t)T * 32;
      for (int i = gt; i < T * 32; i += NGT) { const int t = i >> 5, p = i & 31;
          const float invf = exp2f(-(float)p * (13.287712379549449f / 32.f));
          const double ang = (double)pos[t] * (double)invf; double rev = ang * 0.15915494309189535; rev -= floor(rev);
          const float fr = (float)rev;
          rc[i] = __builtin_amdgcn_cosf(fr); rs[i] = __builtin_amdgcn_sinf(fr); } }
    { float* P5 = WSP(float, WS_S5P);
      for (int i = gt; i < NG * NP; i += NGT) { const int g = i >> 6;
          const float dt = __expf(F.in[12][g]); const float lr = F.in[10][i], li = F.in[11][i];
          const float er = __expf(lr * dt); const double ang = (double)li * (double)dt; double rev = ang * 0.15915494309189535; rev -= floor(rev);
          const float cs = __builtin_amdgcn_cosf((float)rev), sn = __builtin_amdgcn_sinf((float)rev);
          float br = er * cs, bi = er * sn;
          P5[i] = br; P5[2048 + i] = bi;
          const float nr = br - 1.f, ni = bi, den = lr * lr + li * li;
          const float qr = (nr * lr + ni * li) / den, qi = (ni * lr - nr * li) / den;
          P5[8192 + i] = qr; P5[8192 + 2048 + i] = qi;
          float pr = br, pi_ = bi;
#pragma unroll
          for (int s = 0; s < 8; ++s) { const float tr = pr * pr - pi_ * pi_, ti = 2.f * pr * pi_; pr = tr; pi_ = ti; }
          P5[4096 + i] = pr; P5[6144 + i] = pi_;
          float* PW = P5 + 131072;
          float wr_ = 1.f, wi_ = 0.f;
#pragma unroll
          for (int k = 0; k <= 16; ++k) { PW[i * 17 + k] = wr_; PW[2048 * 17 + i * 17 + k] = wi_; const float tr = wr_ * br - wi_ * bi, ti = wr_ * bi + wi_ * br; wr_ = tr; wi_ = ti; } }
    }
}

__device__ __forceinline__ void phase1(Frame& F) {
    LAS float* A1 = (LAS float*)(F.lds + RING_OFF); LAS float* A2 = A1 + 2 * D;
    const float* part = WSP(float, WS_ADA); const float* ab = F.in[4]; const float* pg = F.in[5];
    for (int k = F.tid; k < D; k += NWAVES * 64)
#pragma unroll
        for (int b = 0; b < 2; ++b) { float sh = ab[k], sc = ab[D + k];
            for (int ks = 0; ks < 16; ++ks) { sh += part[(ks * 2 + b) * (6 * D) + k]; sc += part[(ks * 2 + b) * (6 * D) + D + k]; }
            A1[b * D + k] = pg[k] * (1.f + sc); A2[b * D + k] = sh; }
    const int gt = F.vcu * (NWAVES * 64) + F.tid, NGT = F.G * NWAVES * 64;
    { float* adaf = WSP(float, WS_ADAF);
      for (int n = gt; n < 2 * 6 * D; n += NGT) { const int b = n / (6 * D), j = n % (6 * D); float a = ab[j];
          for (int ks = 0; ks < 16; ++ks) a += part[(ks * 2 + b) * (6 * D) + j];
          adaf[n] = a; } }
    { float* par = WSP(float, WS_PAR);
      for (int i = gt; i < 32768; i += NGT) { par[PAR_RW + i] = F.in[22][i]; par[PAR_BG + i] = F.in[25][i]; par[PAR_BU + i] = F.in[27][i]; par[PAR_BD + i] = F.in[29][i];
          par[PAR_CRE + i] = F.in[15][i]; par[PAR_CIM + i] = F.in[16][i]; par[PAR_BRE + i] = F.in[13][i]; par[PAR_BIM + i] = F.in[14][i];
          if (i < 1024) { par[PAR_MPG + i] = F.in[6][i]; par[PAR_FPRE + i] = F.in[7][i]; par[PAR_FPOST + i] = F.in[8][i]; }
          if (i < 512) par[PAR_SD + i] = F.in[17][i];
          if (i < 32) par[PAR_RB + i] = F.in[23][i]; } }
    { const float* P5 = WSP(float, WS_S5P); const float* PWr = P5 + 131072; const float* PWi = PWr + 2048 * 17;
      bf16* M1t = WSP(bf16, WS_S5M1);
      for (int i = gt; i < NG * 256 * 256; i += NGT) { const int k = i & 255, n = (i >> 8) & 255, g = i >> 16; float val = 0.f;
          if (n < 128) { const int p = n & 63, gp = g * 64 + p, s_ = k >> 4, ci = k & 15;
              const float qr = P5[8192 + gp], qi = P5[8192 + 2048 + gp], b_r = F.in[13][gp * 16 + ci], b_i = F.in[14][gp * 16 + ci];
              const float bbr = qr * b_r - qi * b_i, bbi = qr * b_i + qi * b_r, wr_ = PWr[gp * 17 + 15 - s_], wi_ = PWi[gp * 17 + 15 - s_];
              val = (n < 64) ? (wr_ * bbr - wi_ * bbi) : (wr_ * bbi + wi_ * bbr); }
          M1t[((size_t)(g * 256 + perm8(n))) * 256 + k] = (bf16)f2bf(val); }
    }
    __syncthreads();
    const int gw = F.vcu * NWAVES + F.wave, NGW = F.G * NWAVES;
    bf16* XN = WSP(bf16, WS_XN);
    for (int m0 = gw * 2; m0 < T; m0 += NGW * 2) {
        const int b = m0 >> 13;
        f32x4 v[2][4];
#pragma unroll
        for (int q = 0; q < 2; ++q) { const GAS f32x4* xr = (const GAS f32x4*)(F.in[0] + (size_t)(m0 + q) * D) + F.lane;
#pragma unroll
            for (int j = 0; j < 4; ++j) v[q][j] = __builtin_nontemporal_load(xr + 64 * j); }
#pragma unroll
        for (int q = 0; q < 2; ++q) { float s = 0.f;
#pragma unroll
            for (int j = 0; j < 4; ++j) s += (v[q][j].x * v[q][j].x + v[q][j].y * v[q][j].y) + (v[q][j].z * v[q][j].z + v[q][j].w * v[q][j].w);
            const float rstd = 1.f / sqrtf(wave_sum(s) * (1.f / D) + NORM_EPS);
            GAS unsigned long long* o8 = (GAS unsigned long long*)(XN + (size_t)(m0 + q) * D) + F.lane;
#pragma unroll
            for (int j = 0; j < 4; ++j) { const f32x4 a1 = *(const LAS f32x4*)(A1 + b * D + 4 * F.lane + 256 * j), a2 = *(const LAS f32x4*)(A2 + b * D + 4 * F.lane + 256 * j);
                const f32x4 o = v[q][j] * rstd * a1 + a2;
                o8[64 * j] = (unsigned long long)pk2(o.x, o.y) | ((unsigned long long)pk2(o.z, o.w) << 32); } }
    }
    __syncthreads();
}

struct EpiG1 {
    bf16 *UA, *Q, *K, *V, *VT, *GSp, *GAp; const float *rc, *rs; float* km;
    __device__ __forceinline__ void operator()(const pg8::f32x4 (&acc)[2][2][4][2], const pg8::Unit& u, int wr, int wc, int fr, int fq) const {
        asm volatile("" : "+v"(fr), "+v"(fq));
        const int pn = u.pn, row0 = u.pm * 256 + wr * 64 + fr;
        if (pn < 2) {
#pragma unroll
            for (int ai = 0; ai < 2; ++ai)
#pragma unroll
                for (int m = 0; m < 4; ++m) { const int t = row0 + ai * 128 + m * 16, b = t >> 13, tt = t & (SEQ - 1), c = tt >> 4, s = tt & 15;
#pragma unroll
                    for (int bj = 0; bj < 2; ++bj) { const int ch = pn * 256 + bj * 128 + wc * 32 + 8 * fq, g = ch >> 4, ci = ch & 15;
                        const pg8::f32x4 v0 = acc[ai][bj][m][0], v1 = acc[ai][bj][m][1];
                        v4u w; w.x = pk2(v0[0], v0[1]); w.y = pk2(v0[2], v0[3]); w.z = pk2(v1[0], v1[1]); w.w = pk2(v1[2], v1[3]);
                        st16(UA + ((size_t)(g * 1024 + b * 512 + c) * 384 + 16 * s + ci), w); } }
        } else if (pn < 6) {
            const bool isk = pn >= 4; bf16* X = isk ? K : Q; const float sc = isk ? 1.f : C2;
            const int p0 = 16 * (wc & 1) + 4 * fq;
#pragma unroll
            for (int bj = 0; bj < 2; ++bj) {
                const int head = 4 * (pn & 1) + 2 * bj + (wc >> 1);
                int rowb = row0; asm volatile("" : "+v"(rowb));
                float ks[2][4];
#pragma unroll
                for (int b = 0; b < 2; ++b)
#pragma unroll
                    for (int i = 0; i < 4; ++i) ks[b][i] = 0.f;
#pragma unroll
                for (int ai = 0; ai < 2; ++ai)
#pragma unroll
                    for (int m = 0; m < 4; ++m) { const int t = rowb + ai * 128 + m * 16;
                        const pg8::f32x4 cs = *(const pg8::f32x4*)(rc + (size_t)t * 32 + p0), sn = *(const pg8::f32x4*)(rs + (size_t)t * 32 + p0);
                        const pg8::f32x4 t1 = acc[ai][bj][m][0], t2 = acc[ai][bj][m][1];
                        const pg8::f32x4 o1 = t1 * cs - t2 * sn, o2 = t2 * cs + t1 * sn;
                        v2u w1, w2; w1.x = pk2(o1[0] * sc, o1[1] * sc); w1.y = pk2(o1[2] * sc, o1[3] * sc); w2.x = pk2(o2[0] * sc, o2[1] * sc); w2.y = pk2(o2[2] * sc, o2[3] * sc);
                        bf16* dst = X + (size_t)t * AW + head * 64 + p0;
                        st8(dst, w1); st8(dst + 32, w2);
#pragma unroll
                        for (int i = 0; i < 4; ++i) { ks[0][i] += o1[i]; ks[1][i] += o2[i]; }
                        __builtin_amdgcn_sched_barrier(0); }
                if (isk) {
                    const int b = u.pm >> 5, blk = u.pm & 31;
#pragma unroll
                    for (int n = 0; n < 2; ++n)
#pragma unroll
                        for (int i = 0; i < 4; ++i) { float v = ks[n][i];
                            v += __shfl_xor(v, 1); v += __shfl_xor(v, 2); v += __shfl_xor(v, 4); v += __shfl_xor(v, 8);
                            if (fr == 0) atomicAdd(km + ((size_t)((b * NH + head) * NBLK + blk) * HD + 32 * n + p0 + i), v); }
                }
            }
        } else if (pn < 8) {
#pragma unroll
            for (int ai = 0; ai < 2; ++ai)
#pragma unroll
                for (int m = 0; m < 4; ++m) { const int t = row0 + ai * 128 + m * 16, b = t >> 13, tt = t & (SEQ - 1);
#pragma unroll
                    for (int bj = 0; bj < 2; ++bj) { const int cv = (pn - 6) * 256 + bj * 128 + wc * 32 + 8 * fq, head = cv >> 6, d = cv & 63;
                        const pg8::f32x4 v0 = acc[ai][bj][m][0], v1 = acc[ai][bj][m][1];
                        v4u w; w.x = pk2(v0[0], v0[1]); w.y = pk2(v0[2], v0[3]); w.z = pk2(v1[0], v1[1]); w.w = pk2(v1[2], v1[3]);
                        bf16* vt = VT + ((size_t)((b * NH + head) * HD + d) * SEQ + tt);
                        vt[0 * SEQ] = (bf16)(w.x & 0xffff); vt[1 * SEQ] = (bf16)(w.x >> 16); vt[2 * SEQ] = (bf16)(w.y & 0xffff); vt[3 * SEQ] = (bf16)(w.y >> 16);
                        vt[4 * SEQ] = (bf16)(w.z & 0xffff); vt[5 * SEQ] = (bf16)(w.z >> 16); vt[6 * SEQ] = (bf16)(w.w & 0xffff); vt[7 * SEQ] = (bf16)(w.w >> 16); } }
        } else {
            bf16* Gp = (pn < 12) ? GSp : GAp; const int cb = ((pn - 8) & 3) * 256;
#pragma unroll
            for (int ai = 0; ai < 2; ++ai)
#pragma unroll
                for (int m = 0; m < 4; ++m) { const int t = row0 + ai * 128 + m * 16;
#pragma unroll
                    for (int bj = 0; bj < 2; ++bj) { const int col = cb + bj * 128 + wc * 32 + 8 * fq;
                        const pg8::f32x4 v0 = acc[ai][bj][m][0], v1 = acc[ai][bj][m][1];
                        v4u w; w.x = pk2(sigmoidf_(v0[0]), sigmoidf_(v0[1])); w.y = pk2(sigmoidf_(v0[2]), sigmoidf_(v0[3]));
                        w.z = pk2(sigmoidf_(v1[0]), sigmoidf_(v1[1])); w.w = pk2(sigmoidf_(v1[2]), sigmoidf_(v1[3]));
                        __builtin_nontemporal_store(w, (v4u*)(Gp + (size_t)t * D + col)); } }
        }
    }
};

template <int MODE> struct EpiEw {
    bf16* O; const bf16* X1; const bf16* X2; float* Of; int ld;
    __device__ __forceinline__ void operator()(const pg8::f32x4 (&acc)[2][2][4][2], const pg8::Unit& u, int wr, int wc, int fr, int fq) const {
        const int row0 = u.pm * 256 + wr * 64 + fr, col0 = u.pn * 256 + wc * 32 + 8 * fq;
#pragma unroll
        for (int ai = 0; ai < 2; ++ai)
#pragma unroll
            for (int m = 0; m < 4; ++m) { const size_t rb = (size_t)(row0 + ai * 128 + m * 16) * ld + col0;
#pragma unroll
                for (int bj = 0; bj < 2; ++bj) { const size_t off = rb + bj * 128;
                    const pg8::f32x4 v0 = acc[ai][bj][m][0], v1 = acc[ai][bj][m][1];
                    if (MODE == 3) { *(pg8::f32x4*)(Of + off) = v0; *(pg8::f32x4*)(Of + off + 4) = v1; }
                    else {
                        const v4u x = __builtin_nontemporal_load((const v4u*)(X1 + off));
                        float r[8] = {v0[0], v0[1], v0[2], v0[3], v1[0], v1[1], v1[2], v1[3]};
                        const float xv[8] = {bflo(x.x), bfhi(x.x), bflo(x.y), bfhi(x.y), bflo(x.z), bfhi(x.z), bflo(x.w), bfhi(x.w)};
                        if (MODE == 0) {
#pragma unroll
                            for (int i = 0; i < 8; ++i) r[i] = xv[i] * sigmoidf_(r[i]);
                        } else if (MODE == 1) {
#pragma unroll
                            for (int i = 0; i < 8; ++i) r[i] = xv[i] * r[i];
                        } else {
                            const v4u y = __builtin_nontemporal_load((const v4u*)(X2 + off));
                            const float yv[8] = {bflo(y.x), bfhi(y.x), bflo(y.y), bfhi(y.y), bflo(y.z), bfhi(y.z), bflo(y.w), bfhi(y.w)};
#pragma unroll
                            for (int i = 0; i < 8; ++i) r[i] = yv[i] + xv[i] * r[i];
                        }
                        v4u w; w.x = pk2(r[0], r[1]); w.y = pk2(r[2], r[3]); w.z = pk2(r[4], r[5]); w.w = pk2(r[6], r[7]);
                        st16(O + off, w); } } }
    }
};

typedef short bf16x8 __attribute__((ext_vector_type(8)));
typedef float f32x16 __attribute__((ext_vector_type(16)));
constexpr size_t WS_ALIST = 456 * MiB;
constexpr size_t WS_OP01 = 224 * MiB;
constexpr size_t WS_OP23 = 472 * MiB;
constexpr size_t WS_LSE = 504 * MiB;
constexpr int CW_BCNT = 12288;
constexpr int ALCAP = 8192;

__device__ __forceinline__ void attn_gate(Frame& F) {
    const int gw = F.vcu * NWAVES + F.wave, NGW = F.G * NWAVES, L = F.lane;
    const bf16* Q = WSP(bf16, WS_Q); const float* km = (const float*)(F.ctl + CW_KM);
    unsigned* bcnt = (unsigned*)(F.ctl + CW_BCNT); unsigned* list = WSP(unsigned, WS_ALIST); float* lse = WSP(float, WS_LSE);
    for (int w = gw; w < BATCH * NH * (SEQ / 64); w += NGW) {
        const int bh = w >> 7, b = bh >> 3, h = bh & 7, tt = (w & 127) * 64 + L, t = b * SEQ + tt, blk = tt >> 8;
        float q[64];
        { const v4u* qp = (const v4u*)(Q + (size_t)t * AW + h * 64);
#pragma unroll
          for (int i = 0; i < 8; ++i) { const v4u x = qp[i]; q[8 * i] = bflo(x.x); q[8 * i + 1] = bfhi(x.x); q[8 * i + 2] = bflo(x.y); q[8 * i + 3] = bfhi(x.y);
              q[8 * i + 4] = bflo(x.z); q[8 * i + 5] = bfhi(x.z); q[8 * i + 6] = bflo(x.w); q[8 * i + 7] = bfhi(x.w); } }
        float v0 = -3e38f, v1 = -3e38f, v2 = -3e38f; int i0 = -1, i1 = -1, i2 = -1;
        for (int j = 0; j < blk; ++j) { const float* kp = km + (size_t)((b * NH + h) * NBLK + j) * HD; float g = 0.f;
#pragma unroll
            for (int d = 0; d < 64; ++d) g += q[d] * kp[d];
            if (g > v0) { v2 = v1; i2 = i1; v1 = v0; i1 = i0; v0 = g; i0 = j; }
            else if (g > v1) { v2 = v1; i2 = i1; v1 = g; i1 = j; }
            else if (g > v2) { v2 = g; i2 = j; } }
        float* lp = lse + ((size_t)t * NH + h) * 4;
        if (i0 < 0) lp[0] = -1e30f; if (i1 < 0) lp[1] = -1e30f; if (i2 < 0) lp[2] = -1e30f;
        for (int j = 0; j < blk; ++j) {
            const bool sel = (i0 == j) || (i1 == j) || (i2 == j);
            const unsigned long long mask = __ballot(sel);
            if (mask) { const int leader = __ffsll((long long)mask) - 1; const int bucket = (b * NH + h) * NBLK + j;
                unsigned base = 0u;
                if (L == leader) base = __hip_atomic_fetch_add(bcnt + bucket, (unsigned)__popcll(mask), RLX_AGENT);
                base = (unsigned)__shfl((int)base, leader);
                if (sel) { const unsigned pos = base + (unsigned)__popcll(mask & ((1ull << L) - 1ull)); const unsigned slot = (i0 == j) ? 0u : ((i1 == j) ? 1u : 2u);
                    list[(size_t)bucket * ALCAP + pos] = ((unsigned)tt << 2) | slot; } }
        }
    }
}

__device__ __forceinline__ unsigned cvtpk(float lo, float hi) { typedef float f32x2_t __attribute__((ext_vector_type(2))); typedef __bf16 bf16x2_t __attribute__((ext_vector_type(2)));
    f32x2_t v = {lo, hi}; bf16x2_t r = __builtin_convertvector(v, bf16x2_t); return __builtin_bit_cast(unsigned, r); }

constexpr int AT_KROW = 144, AT_VROW = 520, AT_KOFF = 0, AT_VOFF = 256 * AT_KROW;
__device__ __forceinline__ void attn_item(Frame& F, int b, int h, int j, bool own, const unsigned* lst, int nvalid) {
    const int tid = F.tid, L = F.lane, r = L & 31, hh = L >> 5, wv = F.wave;
    LAS unsigned char* Kl = F.lds + AT_KOFF; LAS unsigned char* Vl = F.lds + AT_VOFF;
    const bf16* Kg = WSP(bf16, WS_K) + ((size_t)(b * SEQ + j * 256)) * AW + h * 64;
    const bf16* Vg = WSP(bf16, WS_VT) + ((size_t)((b * NH + h) * HD)) * SEQ + j * 256;
    v4u kr[4], vr[4];
#pragma unroll
    for (int i = 0; i < 4; ++i) { const int idx = tid + 512 * i; kr[i] = *(const v4u*)(Kg + (size_t)(idx >> 3) * AW + (idx & 7) * 8); vr[i] = *(const v4u*)(Vg + (size_t)(idx >> 5) * SEQ + (idx & 31) * 8); }
    const int qi = wv * 32 + r; const bool valid = qi < nvalid;
    unsigned ent; if (own) ent = ((unsigned)(j * 256 + qi) << 2) | 3u; else ent = lst[valid ? qi : 0];
    const int tt = (int)(ent >> 2), slot = (int)(ent & 3u), t = b * SEQ + tt;
    bf16x8 qf[4];
    { const bf16* qp = WSP(bf16, WS_Q) + (size_t)t * AW + h * 64 + hh * 8;
#pragma unroll
      for (int d0 = 0; d0 < 4; ++d0) qf[d0] = *(const bf16x8*)(qp + d0 * 16); }
#pragma unroll
    for (int i = 0; i < 4; ++i) { const int idx = tid + 512 * i; *(LAS v4u*)(Kl + (idx >> 3) * AT_KROW + (idx & 7) * 16) = kr[i]; *(LAS v4u*)(Vl + (idx >> 5) * AT_VROW + (idx & 31) * 16) = vr[i]; }
    __syncthreads();
#ifdef ATT_STAGGER
    if (wv >= 4) __builtin_amdgcn_s_sleep(ATT_STAGGER);
#endif
#ifdef ATT_REP_COMPUTE
    for (int arep = 0; arep < 2; ++arep)
#endif
    if (wv * 32 < nvalid) {
        float m = -1e30f, l = 0.f; f32x16 O0 = {}, O1 = {};
        const int qrel = tt & 255;
#pragma unroll
        for (int hk = 0; hk < 2; ++hk) {
            if (own && hk * 4 > wv) continue;
            f32x16 S[4];
#pragma unroll
            for (int kt = 0; kt < 4; ++kt) S[kt] = (f32x16){};
#pragma unroll
            for (int d0 = 0; d0 < 4; ++d0) {
#pragma unroll
                for (int kt = 0; kt < 4; ++kt) { const bf16x8 kf = *(const LAS bf16x8*)(Kl + (hk * 128 + kt * 32 + r) * AT_KROW + d0 * 32 + hh * 16);
                    S[kt] = __builtin_amdgcn_mfma_f32_32x32x16_bf16(kf, qf[d0], S[kt], 0, 0, 0); }
                if (d0 & 1) __builtin_amdgcn_sched_barrier(0); }
            if (own) {
                asm volatile("; causal masking (own block only)" ::: "memory");
#pragma unroll
                for (int kt = 0; kt < 4; ++kt)
#pragma unroll
                    for (int rg = 0; rg < 16; ++rg) { const int key = hk * 128 + kt * 32 + (rg & 3) + 8 * (rg >> 2) + 4 * hh; if (key > qrel) S[kt][rg] = -1e30f; } }
            float mx = S[0][0];
#pragma unroll
            for (int kt = 0; kt < 4; ++kt)
#pragma unroll
                for (int rg = 0; rg < 16; ++rg) mx = fmaxf(mx, S[kt][rg]);
            mx = fmaxf(mx, __shfl_xor(mx, 32));
            const float mn = fmaxf(m, mx), alpha = __builtin_amdgcn_exp2f(m - mn); m = mn; l *= alpha;
#pragma unroll
            for (int rg = 0; rg < 16; ++rg) { O0[rg] *= alpha; O1[rg] *= alpha; }
            float ls = 0.f;
#pragma unroll
            for (int kt = 0; kt < 4; ++kt) {
                unsigned pw[8];
#pragma unroll
                for (int rg = 0; rg < 16; rg += 2) { const float p0 = __builtin_amdgcn_exp2f(S[kt][rg] - mn), p1 = __builtin_amdgcn_exp2f(S[kt][rg + 1] - mn); ls += p0 + p1; pw[rg >> 1] = cvtpk(p0, p1); }
#pragma unroll
                for (int s = 0; s < 2; ++s) {
                    const v4u pv = {pw[4 * s], pw[4 * s + 1], pw[4 * s + 2], pw[4 * s + 3]}; const bf16x8 pf = __builtin_bit_cast(bf16x8, pv);
                    const int kb = (hk * 128 + kt * 32 + 16 * s + 4 * hh) * 2;
                    { const LAS unsigned char* vp = Vl + r * AT_VROW + kb; const v2u lo = *(const LAS v2u*)vp, hi = *(const LAS v2u*)(vp + 16);
                      const v4u vv = {lo.x, lo.y, hi.x, hi.y}; O0 = __builtin_amdgcn_mfma_f32_32x32x16_bf16(__builtin_bit_cast(bf16x8, vv), pf, O0, 0, 0, 0); }
                    { const LAS unsigned char* vp = Vl + (32 + r) * AT_VROW + kb; const v2u lo = *(const LAS v2u*)vp, hi = *(const LAS v2u*)(vp + 16);
                      const v4u vv = {lo.x, lo.y, hi.x, hi.y}; O1 = __builtin_amdgcn_mfma_f32_32x32x16_bf16(__builtin_bit_cast(bf16x8, vv), pf, O1, 0, 0, 0); } } }
            l += ls;
        }
        l += __shfl_xor(l, 32);
        if (valid) {
            const float rl = 1.f / l;
            bf16* op = (slot < 2 ? WSP(bf16, WS_OP01) + (((size_t)t * NH + h) * 2 + slot) * 64 : WSP(bf16, WS_OP23) + (((size_t)t * NH + h) * 2 + (slot - 2)) * 64) + 4 * hh;
#pragma unroll
            for (int g4 = 0; g4 < 4; ++g4) { v2u w0, w1; w0.x = cvtpk(O0[4 * g4] * rl, O0[4 * g4 + 1] * rl); w0.y = cvtpk(O0[4 * g4 + 2] * rl, O0[4 * g4 + 3] * rl);
                w1.x = cvtpk(O1[4 * g4] * rl, O1[4 * g4 + 1] * rl); w1.y = cvtpk(O1[4 * g4 + 2] * rl, O1[4 * g4 + 3] * rl);
                *(v2u*)(op + 8 * g4) = w0; *(v2u*)(op + 32 + 8 * g4) = w1; }
            if (hh == 0) WSP(float, WS_LSE)[((size_t)t * NH + h) * 4 + slot] = m + log2f(l);
        }
    }
    __syncthreads();
}
__device__ __forceinline__ void attn_items(Frame& F) {
    LAS int* pre = (LAS int*)(F.lds + 72 * 1024);
    const unsigned* bcnt = (const unsigned*)(F.ctl + CW_BCNT);
    LAS int* cntl = pre + 520;
    for (int i = F.tid; i < 512; i += NWAVES * 64) cntl[i] = (int)__hip_atomic_load((gu32*)(F.ctl + CW_BCNT) + i, RLX_AGENT);
    __syncthreads();
    if (F.tid == 0) { int a = 0; for (int i = 0; i < 512; ++i) { pre[i] = a; a += (cntl[i] + 255) >> 8; } pre[512] = a; }
    __syncthreads();
    const int total = 512 + pre[512];
    for (int it = (int)blockIdx.x; it < total; it += F.G) {
        int bh, j, n; bool own; const unsigned* lst;
        if (it < 512) { bh = it >> 5; j = it & 31; own = true; lst = nullptr; n = 256; }
        else { const int s = it - 512; int lo = 0, hi = 512;
            while (hi - lo > 1) { const int mid = (lo + hi) >> 1; if (pre[mid] <= s) lo = mid; else hi = mid; }
            const int bucket = lo, tile = s - pre[bucket]; n = cntl[bucket] - tile * 256; n = n > 256 ? 256 : n; bh = bucket >> 5; j = bucket & 31; own = false;
            lst = WSP(unsigned, WS_ALIST) + (size_t)bucket * ALCAP + tile * 256; }
        const int b_ = __builtin_amdgcn_readfirstlane(bh >> 3), h_ = __builtin_amdgcn_readfirstlane(bh & 7), j_ = __builtin_amdgcn_readfirstlane(j), n_ = __builtin_amdgcn_readfirstlane(n);
        attn_item(F, b_, h_, j_, own, lst, n_);
    }
}
__device__ __forceinline__ void attn_combine(Frame& F) {
    if (F.G == 256 && blockIdx.x < 128) return;
    const int nb = F.G == 256 ? 128 : F.G, bi = F.G == 256 ? (int)blockIdx.x - 128 : F.vcu;
    const int gw = bi * NWAVES + F.wave, NGW = nb * NWAVES, L = F.lane, h = L >> 3, ch = L & 7;
    const float* lse = WSP(float, WS_LSE); bf16* YA = WSP(bf16, WS_YA);
    for (int t = gw; t < T; t += NGW) {
        const size_t th = (size_t)t * NH + h;
        const f32x4 ls = *(const f32x4*)(lse + th * 4);
        const float mx = fmaxf(fmaxf(ls[0], ls[1]), fmaxf(ls[2], ls[3]));
        const float w0 = __builtin_amdgcn_exp2f(ls[0] - mx), w1 = __builtin_amdgcn_exp2f(ls[1] - mx), w2 = __builtin_amdgcn_exp2f(ls[2] - mx), w3 = __builtin_amdgcn_exp2f(ls[3] - mx), inv = 1.f / (w0 + w1 + w2 + w3);
        const v4u a0 = __builtin_nontemporal_load((const v4u*)(WSP(bf16, WS_OP01) + (th * 2 + 0) * 64 + ch * 8)), a1 = __builtin_nontemporal_load((const v4u*)(WSP(bf16, WS_OP01) + (th * 2 + 1) * 64 + ch * 8));
        const v4u a2 = __builtin_nontemporal_load((const v4u*)(WSP(bf16, WS_OP23) + (th * 2 + 0) * 64 + ch * 8)), a3 = __builtin_nontemporal_load((const v4u*)(WSP(bf16, WS_OP23) + (th * 2 + 1) * 64 + ch * 8));
        float o[8];
        const unsigned x0[4] = {a0.x, a0.y, a0.z, a0.w}, x1[4] = {a1.x, a1.y, a1.z, a1.w}, x2[4] = {a2.x, a2.y, a2.z, a2.w}, x3[4] = {a3.x, a3.y, a3.z, a3.w};
#pragma unroll
        for (int i = 0; i < 4; ++i) {
            float lo_ = w3 * bflo(x3[i]), hi_ = w3 * bfhi(x3[i]);
            if (ls[0] > -1e29f) { lo_ += w0 * bflo(x0[i]); hi_ += w0 * bfhi(x0[i]); }
            if (ls[1] > -1e29f) { lo_ += w1 * bflo(x1[i]); hi_ += w1 * bfhi(x1[i]); }
            if (ls[2] > -1e29f) { lo_ += w2 * bflo(x2[i]); hi_ += w2 * bfhi(x2[i]); }
            o[2 * i] = lo_ * inv; o[2 * i + 1] = hi_ * inv; }
        v4u w; w.x = cvtpk(o[0], o[1]); w.y = cvtpk(o[2], o[3]); w.z = cvtpk(o[4], o[5]); w.w = cvtpk(o[6], o[7]);
        *(v4u*)(YA + (size_t)t * AW + h * 64 + ch * 8) = w;
    }
}
struct S5Order { static constexpr bool GATHER = false; int G, c;
    __device__ __forceinline__ void a_ready(const pg8::Unit&) const {}
    __device__ __forceinline__ void done(const pg8::Unit&) const {}
    __device__ __forceinline__ bool next(int i, pg8::Unit& u) const { const int L = i * G + c; if (L >= NG * 4) return false; const int g = L >> 2, rt = L & 3;
        u.arow = g * 1024 + rt * 256; u.brow = g * 256; u.pm = rt; u.pn = 0; u.e = g; u.nrow = 256; u.kind = 0; u.aux = 0; return true; } };
struct EpiS5A { float* E;
    __device__ __forceinline__ void operator()(const pg8::f32x4 (&acc)[2][2][4][2], const pg8::Unit& u, int wr, int wc, int fr, int fq) const {
        asm volatile("" : "+v"(fr), "+v"(fq));
#pragma unroll
        for (int ai = 0; ai < 2; ++ai)
#pragma unroll
            for (int m = 0; m < 4; ++m) { float* p = E + (size_t)(u.arow + ai * 128 + wr * 64 + m * 16 + fr) * 128 + wc * 32 + 8 * fq;
                *(pg8::f32x4*)p = acc[ai][0][m][0]; *(pg8::f32x4*)(p + 4) = acc[ai][0][m][1]; }
    }
};
struct EpiS5C { bf16* YG;
    __device__ __forceinline__ void operator()(const pg8::f32x4 (&acc)[2][2][4][2], const pg8::Unit& u, int wr, int wc, int fr, int fq) const {
        asm volatile("" : "+v"(fr), "+v"(fq));
        const int g = u.e, n0 = wc * 32 + 8 * fq, t0 = n0 >> 4, co0 = n0 & 15;
#pragma unroll
        for (int ai = 0; ai < 2; ++ai)
#pragma unroll
            for (int m = 0; m < 4; ++m) { const int row = u.pm * 256 + ai * 128 + wr * 64 + m * 16 + fr, b = row >> 9, c = row & 511;
                bf16* yp = YG + (size_t)(b * SEQ + 16 * c + t0) * SW + 16 * g + co0;
#pragma unroll
                for (int bj = 0; bj < 2; ++bj) {
                    const pg8::f32x4 v0 = acc[ai][bj][m][0], v1 = acc[ai][bj][m][1];
                    v4u w; w.x = pk2(gelu_tanh(v0[0]), gelu_tanh(v0[1])); w.y = pk2(gelu_tanh(v0[2]), gelu_tanh(v0[3]));
                    w.z = pk2(gelu_tanh(v1[0]), gelu_tanh(v1[1])); w.w = pk2(gelu_tanh(v1[2]), gelu_tanh(v1[3]));
                    *(v4u*)(yp + (size_t)bj * 8 * SW) = w; }
                __builtin_amdgcn_sched_barrier(0); }
    }
};
__device__ __forceinline__ void s5_fill_kt(Frame& F) {
    const int gt = F.vcu * (NWAVES * 64) + F.tid, NGT = F.G * NWAVES * 64;
    const float* P5 = WSP(float, WS_S5P); const float* PWr = P5 + 131072; const float* PWi = PWr + 2048 * 17; const float* par = WSP(float, WS_PAR);
    float* KT = WSP(float, WS_S5KT);
    for (int i = gt; i < NG * 16 * 256; i += NGT) { const int ci = i & 15, co = (i >> 4) & 15, tau = (i >> 8) & 15, g = i >> 12; float a = 0.f;
        for (int p = 0; p < 64; ++p) { const int gp = g * 64 + p;
            const float qr = P5[8192 + gp], qi = P5[8192 + 2048 + gp], b_r = par[PAR_BRE + gp * 16 + ci], b_i = par[PAR_BIM + gp * 16 + ci];
            const float bbr = qr * b_r - qi * b_i, bbi = qr * b_i + qi * b_r, wr_ = PWr[gp * 17 + tau], wi_ = PWi[gp * 17 + tau];
            const float xr = wr_ * bbr - wi_ * bbi, xi = wr_ * bbi + wi_ * bbr;
            const float cr = par[PAR_CRE + (g * 16 + co) * 64 + p], ci_ = par[PAR_CIM + (g * 16 + co) * 64 + p];
            a += cr * xr - ci_ * xi; }
        KT[i] = a; }
}
__device__ __forceinline__ void s5_fill_wc(Frame& F) {
    const int gt = F.vcu * (NWAVES * 64) + F.tid, NGT = F.G * NWAVES * 64;
    const float* P5 = WSP(float, WS_S5P); const float* PWr = P5 + 131072; const float* PWi = PWr + 2048 * 17; const float* KT = WSP(float, WS_S5KT); const float* par = WSP(float, WS_PAR);
    bf16* Wc = WSP(bf16, WS_S5WC);
    for (int i = gt; i < NG * 256 * 384; i += NGT) { const int k = i % 384, n = (i / 384) & 255, g = i / (384 * 256), t = n >> 4, co = n & 15; float val = 0.f;
        if (k < 256) { const int s_ = k >> 4, ci = k & 15;
            if (s_ <= t) val = KT[((g * 16 + (t - s_)) * 16 + co) * 16 + ci];
            if (s_ == t && ci == co) val += par[PAR_SD + g * 16 + co]; }
        else { const int p = (k - 256) & 63, gp = g * 64 + p; const float cr = par[PAR_CRE + (g * 16 + co) * 64 + p], ci_ = par[PAR_CIM + (g * 16 + co) * 64 + p];
            const float wr_ = PWr[gp * 17 + t + 1], wi_ = PWi[gp * 17 + t + 1];
            val = (k < 320) ? (cr * wr_ - ci_ * wi_) : -(cr * wi_ + ci_ * wr_); }
        Wc[((size_t)(g * 256 + perm8(n))) * 384 + k] = (bf16)f2bf(val); }
}
__device__ __forceinline__ void s5_carry(Frame& F) {
    const float* P5 = WSP(float, WS_S5P); const float* PWr = P5 + 131072; const float* PWi = PWr + 2048 * 17; const float* E = WSP(float, WS_S5E); bf16* UA = WSP(bf16, WS_UA);
    LAS float* Z = (LAS float*)(F.lds);
    const int seg = F.wave, p = F.lane;
    for (int bg = F.vcu; bg < BATCH * NG; bg += F.G) { const int b = bg / NG, g = bg % NG, gp = g * 64 + p;
        const float ar = PWr[gp * 17 + 16], ai = PWi[gp * 17 + 16];
        const size_t row0 = (size_t)g * 1024 + b * 512 + seg * 64;
        float zr = 0.f, zi = 0.f;
        for (int c0 = 0; c0 < 64; c0 += 8) { float er[8], ei[8];
#pragma unroll
            for (int k = 0; k < 8; ++k) { er[k] = E[(row0 + c0 + k) * 128 + p]; ei[k] = E[(row0 + c0 + k) * 128 + 64 + p]; }
#pragma unroll
            for (int k = 0; k < 8; ++k) { const float nr = ar * zr - ai * zi + er[k], ni = ar * zi + ai * zr + ei[k]; zr = nr; zi = ni; } }
        Z[(seg * 64 + p) * 2] = zr; Z[(seg * 64 + p) * 2 + 1] = zi;
        __syncthreads();
        if (seg == 0) { float br = ar, bi = ai;
#pragma unroll
            for (int k = 0; k < 6; ++k) { const float tr = br * br - bi * bi, ti = 2.f * br * bi; br = tr; bi = ti; }
            float sr = 0.f, si = 0.f;
            for (int sg = 0; sg < 8; ++sg) { const float xr = Z[(sg * 64 + p) * 2], xi = Z[(sg * 64 + p) * 2 + 1]; Z[(sg * 64 + p) * 2] = sr; Z[(sg * 64 + p) * 2 + 1] = si;
                const float nr = br * sr - bi * si + xr, ni = br * si + bi * sr + xi; sr = nr; si = ni; } }
        __syncthreads();
        float sr = Z[(seg * 64 + p) * 2], si = Z[(seg * 64 + p) * 2 + 1];
        for (int c0 = 0; c0 < 64; c0 += 8) { float er[8], ei[8];
#pragma unroll
            for (int k = 0; k < 8; ++k) { er[k] = E[(row0 + c0 + k) * 128 + p]; ei[k] = E[(row0 + c0 + k) * 128 + 64 + p]; }
#pragma unroll
            for (int k = 0; k < 8; ++k) { bf16* up = UA + (row0 + c0 + k) * 384 + 256 + p; up[0] = (bf16)f2bf(sr); up[64] = (bf16)f2bf(si);
                const float nr = ar * sr - ai * si + er[k], ni = ar * si + ai * sr + ei[k]; sr = nr; si = ni; } }
        __syncthreads();
    }
}
constexpr int SCR_OFF = LDSCTL_OFF + 512;
#ifndef MOE_LAG
#define MOE_LAG 2
#endif
constexpr int MT_SEG = 100, MT_MAXSEG = 72;
__device__ __forceinline__ void phase_rows(Frame& F, bool dry = false) {
    LAS float* h2t = (LAS float*)(F.lds);
    LAS float* lg = (LAS float*)(F.lds + 65536);
    LAS float* gtm = (LAS float*)(F.lds + 131072);
    LAS float* pg2 = gtm + 2 * D; LAS float* shf = pg2 + 2 * D;
    LAS unsigned* hist = (LAS unsigned*)(F.lds + SCR_OFF); LAS unsigned* base = hist + 32; LAS int* rec_e = (LAS int*)(base + 32); LAS int* rec_lp = rec_e + 256;
    const float* adaf = WSP(float, WS_ADAF); const float* par = WSP(float, WS_PAR);
    const int L = F.lane, wv = F.wave;
    for (int i = F.tid; i < 2 * D; i += NWAVES * 64) { const int b = i >> 10, k = i & (D - 1);
        gtm[i] = adaf[b * 6 * D + 2 * D + k] * par[PAR_MPG + k];
        pg2[i] = par[PAR_FPRE + k] * (1.f + adaf[b * 6 * D + 4 * D + k]); shf[i] = adaf[b * 6 * D + 3 * D + k]; }
    f32x4 wreg[16];
#pragma unroll
    for (int j = 0; j < 4; ++j)
#pragma unroll
        for (int i = 0; i < 4; ++i) wreg[j * 4 + i] = *(const f32x4*)(par + PAR_RW + (4 * L + 256 * j + i) * NE + 4 * wv);
    if (F.tid < 32) hist[F.tid] = 0u;
    __syncthreads();
    const float* mix = WSP(float, WS_MIX); bf16* H2 = WSP(bf16, WS_H2);
    int* tok_e = WSP(int, WS_ROUTE); float* tok_w = (float*)(tok_e + T * 4); int* tok_pos = tok_e + 2 * T * 4;
    unsigned* gcnt = (unsigned*)(F.ctl + CW_ECNT);
    for (int t0 = F.vcu * 16; t0 < T; t0 += F.G * 16) {
        {
            const int t = t0 + 2 * wv, b = t >> 13;
            f32x4 mv[2][4], xv[2][4];
#pragma unroll
            for (int q = 0; q < 2; ++q) { const GAS f32x4* mr = (const GAS f32x4*)(mix + (size_t)(t + q) * D) + L; const GAS f32x4* xr = (const GAS f32x4*)(F.in[0] + (size_t)(t + q) * D) + L;
#pragma unroll
                for (int j = 0; j < 4; ++j) { mv[q][j] = __builtin_nontemporal_load(mr + 64 * j); xv[q][j] = __builtin_nontemporal_load(xr + 64 * j); } }
#pragma unroll
            for (int q = 0; q < 2; ++q) { float s = 0.f;
#pragma unroll
                for (int j = 0; j < 4; ++j) s += (mv[q][j].x * mv[q][j].x + mv[q][j].y * mv[q][j].y) + (mv[q][j].z * mv[q][j].z + mv[q][j].w * mv[q][j].w);
                const float r1 = 1.f / sqrtf(wave_sum(s) * (1.f / D) + NORM_EPS);
                float s2 = 0.f; GAS f32x4* orow = (GAS f32x4*)(F.out + (size_t)(t + q) * D) + L;
#pragma unroll
                for (int j = 0; j < 4; ++j) { const f32x4 g = *(const LAS f32x4*)(gtm + b * D + 4 * L + 256 * j);
                    xv[q][j] = xv[q][j] + g * (mv[q][j] * r1); __builtin_nontemporal_store(xv[q][j], orow + 64 * j);
                    s2 += (xv[q][j].x * xv[q][j].x + xv[q][j].y * xv[q][j].y) + (xv[q][j].z * xv[q][j].z + xv[q][j].w * xv[q][j].w); }
                const float r2 = 1.f / sqrtf(wave_sum(s2) * (1.f / D) + NORM_EPS);
#ifdef MOE_F8
                GAS unsigned* h4 = (GAS unsigned*)(WSP(unsigned char, WS_H2) + (size_t)(t + q) * D) + L;
#pragma unroll
                for (int j = 0; j < 4; ++j) { const f32x4 a = *(const LAS f32x4*)(pg2 + b * D + 4 * L + 256 * j), c = *(const LAS f32x4*)(shf + b * D + 4 * L + 256 * j);
                    const f32x4 h = xv[q][j] * r2 * a + c;
                    h4[64 * j] = pk4_fp8(8.f * h.x, 8.f * h.y, 8.f * h.z, 8.f * h.w);
                    *(LAS f32x4*)(h2t + (2 * wv + q) * D + 4 * L + 256 * j) = h; } }
#else
                GAS unsigned long long* h8 = (GAS unsigned long long*)(H2 + (size_t)(t + q) * D) + L;
#pragma unroll
                for (int j = 0; j < 4; ++j) { const f32x4 a = *(const LAS f32x4*)(pg2 + b * D + 4 * L + 256 * j), c = *(const LAS f32x4*)(shf + b * D + 4 * L + 256 * j);
                    const f32x4 h = xv[q][j] * r2 * a + c;
                    h8[64 * j] = (unsigned long long)pk2(h.x, h.y) | ((unsigned long long)pk2(h.z, h.w) << 32);
                    *(LAS f32x4*)(h2t + (2 * wv + q) * D + 4 * L + 256 * j) = h; } }
#endif
        }
        __syncthreads();
        {
            const int hi = (L >> 5) & 1, h2b = (L >> 4) & 1;
#pragma unroll 2
            for (int tk = 0; tk < 16; ++tk) {
                f32x4 a = {0.f, 0.f, 0.f, 0.f};
#pragma unroll
                for (int j = 0; j < 4; ++j) { const f32x4 h = *(const LAS f32x4*)(h2t + tk * D + 4 * L + 256 * j);
                    a += wreg[j * 4 + 0] * h.x; a += wreg[j * 4 + 1] * h.y; a += wreg[j * 4 + 2] * h.z; a += wreg[j * 4 + 3] * h.w; }
                const float m0 = hi ? a.z : a.x, o0 = hi ? a.x : a.z, m1 = hi ? a.w : a.y, o1 = hi ? a.y : a.w;
                const float v0 = m0 + __shfl_xor(o0, 32), v1 = m1 + __shfl_xor(o1, 32);
                float v = (h2b ? v1 : v0) + __shfl_xor(h2b ? v0 : v1, 16);
                v += __shfl_xor(v, 8); v += __shfl_xor(v, 4); v += __shfl_xor(v, 2); v += __shfl_xor(v, 1);
                if ((L & 15) == 0) lg[tk * NE + 4 * wv + 2 * hi + h2b] = v;
            }
        }
        __syncthreads();
        {
            const int e = L & 31, half = L >> 5, tl = 2 * wv + half, t = t0 + tl;
            float val = lg[tl * NE + e] + par[PAR_RB + e];
            int se[4]; float sv[4];
#pragma unroll
            for (int r = 0; r < 4; ++r) { float mx = val;
                mx = fmaxf(mx, __shfl_xor(mx, 16)); mx = fmaxf(mx, __shfl_xor(mx, 8)); mx = fmaxf(mx, __shfl_xor(mx, 4)); mx = fmaxf(mx, __shfl_xor(mx, 2)); mx = fmaxf(mx, __shfl_xor(mx, 1));
                const unsigned long long bal = __ballot(val == mx); const unsigned hm = half ? (unsigned)(bal >> 32) : (unsigned)bal; const int win = __ffs((int)hm) - 1;
                se[r] = win; sv[r] = mx; if (e == win) val = -3e38f; }
            const float e1 = __expf(sv[1] - sv[0]), e2 = __expf(sv[2] - sv[0]), e3 = __expf(sv[3] - sv[0]), inv = 1.f / (1.f + e1 + e2 + e3);
            if (e < 4) { const int ex = e == 0 ? se[0] : (e == 1 ? se[1] : (e == 2 ? se[2] : se[3]));
                const float wgt = (e == 0 ? 1.f : (e == 1 ? e1 : (e == 2 ? e2 : e3))) * inv;
                tok_e[t * 4 + e] = ex; tok_w[t * 4 + e] = wgt;
                const unsigned lp = dry ? 0u : __hip_atomic_fetch_add(hist + ex, 1u, __ATOMIC_RELAXED, __HIP_MEMORY_SCOPE_WORKGROUP);
                rec_e[tl * 4 + e] = ex; rec_lp[tl * 4 + e] = (int)lp; }
        }
        __syncthreads();
        if (F.tid < 32) { const unsigned h = hist[F.tid]; base[F.tid] = h ? __hip_atomic_fetch_add(gcnt + F.tid, h, RLX_AGENT) : 0u; }
        __syncthreads();
        if (!dry && F.tid < 64) { const int e_ = rec_e[F.tid], pos_ = (int)base[e_] + rec_lp[F.tid]; tok_pos[(t0 + (F.tid >> 2)) * 4 + (F.tid & 3)] = pos_;
            WSP(int, WS_ELIST)[e_ * ELCAP + pos_] = t0 + (F.tid >> 2); }
        if (F.tid < 32) hist[F.tid] = 0u;
        __syncthreads();
    }
}

__device__ __forceinline__ void moe_tables(Frame& F) {
    LAS int* cnt = (LAS int*)(F.lds + SCR_OFF); LAS int* off = cnt + 32; LAS int* tpre = off + 32;
    if (F.tid < NE) cnt[F.tid] = (int)__hip_atomic_load(F.ctl + CW_ECNT + F.tid, RLX_AGENT);
    __syncthreads();
    if (F.tid == 0) { int o = 0, tp = 0;
        for (int e = 0; e < NE; ++e) { const int c = cnt[e]; off[e] = o; tpre[e] = tp; o += c; tp += (c + 255) >> 8; }
        tpre[NE] = tp;
        LAS int* sg = cnt + MT_SEG; const int n = (tp + 31) >> 5; int ns = 0, pos = 0;
        for (int g = 0; g < n; ++g) { const int tg = (tp - 32 * g) < 32 ? (tp - 32 * g) : 32;
            sg[1 + ns] = pos; sg[1 + MT_MAXSEG + ns] = 0; sg[1 + 2 * MT_MAXSEG + ns] = g; ++ns; pos += 8 * tg; sg[1 + 3 * MT_MAXSEG + g] = pos;
            if (g >= MOE_LAG) { sg[1 + ns] = pos; sg[1 + MT_MAXSEG + ns] = 1; sg[1 + 2 * MT_MAXSEG + ns] = g - MOE_LAG; ++ns; pos += 4 * 32; } }
        for (int g = (n > MOE_LAG ? n - MOE_LAG : 0); g < n; ++g) { const int tg = (tp - 32 * g) < 32 ? (tp - 32 * g) : 32; sg[1 + ns] = pos; sg[1 + MT_MAXSEG + ns] = 1; sg[1 + 2 * MT_MAXSEG + ns] = g; ++ns; pos += 4 * tg; }
        sg[1 + ns] = pos; sg[0] = ns; }
    __syncthreads();
}
template <bool GA> struct MoeOrder {
    static constexpr bool GATHER = GA;
#if defined(T_ACQ)
    __device__ __forceinline__ void a_ready(const pg8::Unit&) const { if (!GA) { if (threadIdx.x < 64) { __builtin_amdgcn_fence(__ATOMIC_ACQUIRE, "agent"); asm volatile("s_waitcnt vmcnt(0)" ::: "memory"); } asm volatile("" ::: "memory"); __builtin_amdgcn_s_barrier(); asm volatile("" ::: "memory"); } }
#else
    __device__ __forceinline__ void a_ready(const pg8::Unit&) const {}
#endif
#if defined(T_DRAIN)
    __device__ __forceinline__ void done(const pg8::Unit&) const { if (GA) asm volatile("s_waitcnt vmcnt(0)" ::: "memory"); }
#else
    __device__ __forceinline__ void done(const pg8::Unit&) const {}
#endif
    const LAS int* tab; const int* elist; int nct, brows, G, c;
    __device__ __forceinline__ bool next(int i, pg8::Unit& u) const {
        int rtg, pn;
        if (G == 256) { const int xcd = c & 7, slot = c >> 3, rpx = 32 / nct;
            rtg = (i * 8 + xcd) * rpx + slot / nct; pn = slot % nct; if (rtg >= tab[64 + NE]) return false; }
        else { const int L = i * G + c, total = tab[64 + NE] * nct; if (L >= total) return false; rtg = L / nct; pn = L % nct; }
        int e = 0;
        for (int k = 1; k < NE; ++k) if (tab[64 + k] <= rtg) e = k;
        const int rt = rtg - tab[64 + e], cnt = tab[e], off = tab[32 + e];
        u.e = __builtin_amdgcn_readfirstlane(e); u.pm = __builtin_amdgcn_readfirstlane(rt); u.pn = pn; u.arow = __builtin_amdgcn_readfirstlane(off + rt * 256); u.brow = __builtin_amdgcn_readfirstlane(e * brows + pn * 256);
        const int nr = cnt - rt * 256; u.nrow = __builtin_amdgcn_readfirstlane(nr > 256 ? 256 : nr); u.kind = 0; u.aux = 0; return true;
    }
    __device__ __forceinline__ int arow_of(const pg8::Unit& u, int r) const { return r < u.nrow ? elist[u.e * ELCAP + u.pm * 256 + r] : 0; }
};
struct EpiGU { bf16* H1; const float* bg; const float* bu;
    __device__ __forceinline__ void operator()(const pg8::f32x4 (&acc)[2][2][4][2], const pg8::Unit& u, int wr, int wc, int fr, int fq) const {
        asm volatile("" : "+v"(fr), "+v"(fq));
        const int f0 = u.pn * 128 + wc * 32 + 8 * fq;
#pragma unroll
        for (int ai = 0; ai < 2; ++ai) {
            int fb = f0; asm volatile("" : "+v"(fb));
            const pg8::f32x4 g0 = *(const pg8::f32x4*)(bg + u.e * FF + fb), g1 = *(const pg8::f32x4*)(bg + u.e * FF + fb + 4);
            const pg8::f32x4 u0 = *(const pg8::f32x4*)(bu + u.e * FF + fb), u1 = *(const pg8::f32x4*)(bu + u.e * FF + fb + 4);
#pragma unroll
            for (int m = 0; m < 4; ++m) { const int r = ai * 128 + wr * 64 + m * 16 + fr;
                const pg8::f32x4 a0 = acc[ai][0][m][0] + g0, a1 = acc[ai][0][m][1] + g1, b0 = acc[ai][1][m][0] + u0, b1 = acc[ai][1][m][1] + u1;
                float gg[8] = {a0[0], a0[1], a0[2], a0[3], a1[0], a1[1], a1[2], a1[3]}, uu[8] = {b0[0], b0[1], b0[2], b0[3], b1[0], b1[1], b1[2], b1[3]}, o[8];
#pragma unroll
                for (int i = 0; i < 8; ++i) { const float g = fminf(gg[i], 7.f), up = fminf(fmaxf(uu[i], -7.f), 7.f); o[i] = g * sigmoidf_(1.702f * g) * (up + 1.f); }
                v4u w; w.x = pk2(o[0], o[1]); w.y = pk2(o[2], o[3]); w.z = pk2(o[4], o[5]); w.w = pk2(o[6], o[7]);
#ifdef T_SC1
                if (r < u.nrow) __builtin_amdgcn_raw_buffer_store_b128(w, __builtin_amdgcn_make_buffer_rsrc(H1, 0, (int)((size_t)T * TOPK * FF * 2), 0x00020000), (unsigned)((u.arow + r) * (FF * 2) + fb * 2), 0, 16); } }
#else
                if (r < u.nrow) *(v4u*)(H1 + (size_t)(u.arow + r) * FF + fb) = w; } }
#endif
    }
};
struct EpiDn { bf16* YB; const float* bd;
    __device__ __forceinline__ void operator()(const pg8::f32x4 (&acc)[2][2][4][2], const pg8::Unit& u, int wr, int wc, int fr, int fq) const {
        const int c0 = u.pn * 256 + wc * 32 + 8 * fq;
#pragma unroll
        for (int bj = 0; bj < 2; ++bj) { const pg8::f32x4 d0 = *(const pg8::f32x4*)(bd + u.e * D + c0 + bj * 128), d1 = *(const pg8::f32x4*)(bd + u.e * D + c0 + bj * 128 + 4);
#pragma unroll
            for (int ai = 0; ai < 2; ++ai)
#pragma unroll
                for (int m = 0; m < 4; ++m) { const int r = ai * 128 + wr * 64 + m * 16 + fr;
                    const pg8::f32x4 a0 = acc[ai][bj][m][0] + d0, a1 = acc[ai][bj][m][1] + d1;
                    v4u w; w.x = pk2(a0[0], a0[1]); w.y = pk2(a0[2], a0[3]); w.z = pk2(a1[0], a1[1]); w.w = pk2(a1[2], a1[3]);
                    if (r < u.nrow) *(v4u*)(YB + (size_t)(u.arow + r) * D + c0 + bj * 128) = w; } }
    }
};
struct EpiGU8 { unsigned char* H1; const float* bg; const float* bu; const float* wscp;
    __device__ __forceinline__ void operator()(const pg8::f32x4 (&acc)[2][2][4][2], const pg8::Unit& u, int wr, int wc, int fr, int fq) const {
        asm volatile("" : "+v"(fr), "+v"(fq));
        const int f0 = u.pn * 128 + wc * 32 + 8 * fq; const float sr = 0.125f / *wscp;
#pragma unroll
        for (int ai = 0; ai < 2; ++ai) {
            int fb = f0; asm volatile("" : "+v"(fb));
            const pg8::f32x4 g0 = *(const pg8::f32x4*)(bg + u.e * FF + fb), g1 = *(const pg8::f32x4*)(bg + u.e * FF + fb + 4);
            const pg8::f32x4 u0 = *(const pg8::f32x4*)(bu + u.e * FF + fb), u1 = *(const pg8::f32x4*)(bu + u.e * FF + fb + 4);
#pragma unroll
            for (int m = 0; m < 4; ++m) { const int r = ai * 128 + wr * 64 + m * 16 + fr;
                const pg8::f32x4 a0 = acc[ai][0][m][0] * sr + g0, a1 = acc[ai][0][m][1] * sr + g1, b0 = acc[ai][1][m][0] * sr + u0, b1 = acc[ai][1][m][1] * sr + u1;
                float gg[8] = {a0[0], a0[1], a0[2], a0[3], a1[0], a1[1], a1[2], a1[3]}, uu[8] = {b0[0], b0[1], b0[2], b0[3], b1[0], b1[1], b1[2], b1[3]}, o[8];
#pragma unroll
                for (int i = 0; i < 8; ++i) { const float g = fminf(gg[i], 7.f), up = fminf(fmaxf(uu[i], -7.f), 7.f); o[i] = 8.f * (g * sigmoidf_(1.702f * g) * (up + 1.f)); }
                v2u w; w.x = pk4_fp8(o[0], o[1], o[2], o[3]); w.y = pk4_fp8(o[4], o[5], o[6], o[7]);
                if (r < u.nrow) *(v2u*)(H1 + (size_t)(u.arow + r) * FF + fb) = w; } }
    }
};
struct EpiDn8 { bf16* YB; const float* bd; const float* wscp;
    __device__ __forceinline__ void operator()(const pg8::f32x4 (&acc)[2][2][4][2], const pg8::Unit& u, int wr, int wc, int fr, int fq) const {
        const int c0 = u.pn * 256 + wc * 32 + 8 * fq; const float sc = 0.125f / *wscp;
#pragma unroll
        for (int bj = 0; bj < 2; ++bj) { const pg8::f32x4 d0 = *(const pg8::f32x4*)(bd + u.e * D + c0 + bj * 128), d1 = *(const pg8::f32x4*)(bd + u.e * D + c0 + bj * 128 + 4);
#pragma unroll
            for (int ai = 0; ai < 2; ++ai)
#pragma unroll
                for (int m = 0; m < 4; ++m) { const int r = ai * 128 + wr * 64 + m * 16 + fr;
                    const pg8::f32x4 a0 = acc[ai][bj][m][0] * sc + d0, a1 = acc[ai][bj][m][1] * sc + d1;
                    v4u w; w.x = pk2(a0[0], a0[1]); w.y = pk2(a0[2], a0[3]); w.z = pk2(a1[0], a1[1]); w.w = pk2(a1[2], a1[3]);
                    if (r < u.nrow) *(v4u*)(YB + (size_t)(u.arow + r) * D + c0 + bj * 128) = w; } }
    }
};
constexpr int CW_RDY = 8448;
constexpr int H2ROW0 = (int)(WS_H2 / 2048), H1ROW0 = (int)(WS_H1 / 2048), DN_BROW0 = (int)((WS_WDN_T - WS_WGU_T) / 2048);
struct MoeFused {
    static constexpr bool GATHER = true;
    const LAS int* tab; const int* elist; gu32* ctl; int G, c, base;
    __device__ __forceinline__ bool next(int i, pg8::Unit& u) const {
        const LAS int* sg = tab + MT_SEG; const int ns = sg[0], L = (base + i) * G + c; if (L >= sg[1 + ns]) return false;
        int s = 0; for (int k = 1; k < ns; ++k) if (sg[1 + k] <= L) s = k;
        if (i > 0 && sg[1 + MT_MAXSEG + s] == 1 && L - sg[1 + 3 * MT_MAXSEG + sg[1 + 2 * MT_MAXSEG + s]] < G) return false;
        const int kind = sg[1 + MT_MAXSEG + s], g = sg[1 + 2 * MT_MAXSEG + s], ui = L - sg[1 + s], TT = tab[64 + NE], tg = (TT - 32 * g) < 32 ? (TT - 32 * g) : 32;
        int rt, pn;
        if (kind == 0) { if (tg == 32) { const int xcd = ui & 7, slot = ui >> 3; rt = xcd * 4 + (slot >> 3); pn = slot & 7; } else { rt = ui >> 3; pn = ui & 7; } }
        else { if (tg == 32) { const int xcd = ui & 7, slot = ui >> 3; rt = xcd * 4 + (slot >> 2); pn = slot & 3; } else { rt = ui >> 2; pn = ui & 3; } }
        const int rtg = 32 * g + rt; int e = 0;
        for (int k = 1; k < NE; ++k) if (tab[64 + k] <= rtg) e = k;
        const int rte = rtg - tab[64 + e], cnt = tab[e], off = tab[32 + e], nr = cnt - rte * 256;
        u.e = __builtin_amdgcn_readfirstlane(e); u.pm = __builtin_amdgcn_readfirstlane(rte); u.pn = __builtin_amdgcn_readfirstlane(pn); u.kind = __builtin_amdgcn_readfirstlane(kind); u.aux = __builtin_amdgcn_readfirstlane(rtg);
        u.arow = __builtin_amdgcn_readfirstlane(off + rte * 256); u.nrow = __builtin_amdgcn_readfirstlane(nr > 256 ? 256 : nr);
        u.brow = __builtin_amdgcn_readfirstlane(kind == 0 ? e * 2048 + pn * 256 : DN_BROW0 + e * 1024 + pn * 256); return true;
    }
    __device__ __forceinline__ int arow_of(const pg8::Unit& u, int r) const { return u.kind == 0 ? H2ROW0 + (r < u.nrow ? elist[u.e * ELCAP + u.pm * 256 + r] : 0) : H1ROW0 + u.arow + (r < u.nrow ? r : 0); }
    __device__ __forceinline__ void a_ready(const pg8::Unit& u) const {
        if (u.kind != 1) return;
        if (threadIdx.x < 64) {
            gu32* w = ctl + CW_RDY + u.aux; const unsigned long long t0 = __builtin_amdgcn_s_memrealtime();
            while ((unsigned)__builtin_amdgcn_readfirstlane(__hip_atomic_load(w, RLX_AGENT)) < 64u) {
                if (__builtin_amdgcn_s_memrealtime() - t0 > 2000000ull) { if (threadIdx.x == 0) __hip_atomic_store(ctl + CW_TMO, 1u, RLX_AGENT); break; }
                __builtin_amdgcn_s_sleep(2); }
#ifdef MOE_DELAY
            { const unsigned long long t1 = __builtin_amdgcn_s_memrealtime(); while (__builtin_amdgcn_s_memrealtime() - t1 < 2000ull) __builtin_amdgcn_s_sleep(8); }
#endif
            __builtin_amdgcn_fence(__ATOMIC_ACQUIRE, "agent");
            asm volatile("s_waitcnt vmcnt(0)" ::: "memory");
        }
        asm volatile("" ::: "memory"); __builtin_amdgcn_s_barrier(); asm volatile("" ::: "memory");
    }
    __device__ __forceinline__ void done(const pg8::Unit& u) const {
        if (u.kind != 0) return;
#ifndef DIAG_NODRAIN
        asm volatile("s_waitcnt vmcnt(0)" ::: "memory");
#endif
#if defined(MOE_REL)
        __builtin_amdgcn_fence(__ATOMIC_RELEASE, "agent"); asm volatile("s_waitcnt vmcnt(0)" ::: "memory");
#endif
        if ((threadIdx.x & 63) == 0) __hip_atomic_fetch_add(ctl + CW_RDY + u.aux, 1u, RLX_AGENT);
    }
};
struct EpiMoe { bf16* H1; bf16* YB; const float* bg; const float* bu; const float* bd;
    __device__ __forceinline__ void operator()(const pg8::f32x4 (&acc)[2][2][4][2], const pg8::Unit& u, int wr, int wc, int fr, int fq) const {
        asm volatile("" : "+v"(fr), "+v"(fq));
        if (u.kind == 0) {
            const int f0 = u.pn * 128 + wc * 32 + 8 * fq;
            const __amdgpu_buffer_rsrc_t h1rs = __builtin_amdgcn_make_buffer_rsrc(H1, 0, (int)((size_t)T * TOPK * FF * 2), 0x00020000);
#pragma unroll
            for (int ai = 0; ai < 2; ++ai) {
                int fb = f0; asm volatile("" : "+v"(fb));
                const pg8::f32x4 g0 = *(const pg8::f32x4*)(bg + u.e * FF + fb), g1 = *(const pg8::f32x4*)(bg + u.e * FF + fb + 4);
                const pg8::f32x4 u0 = *(const pg8::f32x4*)(bu + u.e * FF + fb), u1 = *(const pg8::f32x4*)(bu + u.e * FF + fb + 4);
#pragma unroll
                for (int m = 0; m < 4; ++m) { const int r = ai * 128 + wr * 64 + m * 16 + fr;
                    const pg8::f32x4 a0 = acc[ai][0][m][0] + g0, a1 = acc[ai][0][m][1] + g1, b0 = acc[ai][1][m][0] + u0, b1 = acc[ai][1][m][1] + u1;
                    float gg[8] = {a0[0], a0[1], a0[2], a0[3], a1[0], a1[1], a1[2], a1[3]}, uu[8] = {b0[0], b0[1], b0[2], b0[3], b1[0], b1[1], b1[2], b1[3]}, o[8];
#pragma unroll
                    for (int i = 0; i < 8; ++i) { const float g = fminf(gg[i], 7.f), up = fminf(fmaxf(uu[i], -7.f), 7.f); o[i] = g * sigmoidf_(1.702f * g) * (up + 1.f); }
#ifdef MOE_PLAIN
                    if (r < u.nrow) { v4u w; w.x = pk2(o[0], o[1]); w.y = pk2(o[2], o[3]); w.z = pk2(o[4], o[5]); w.w = pk2(o[6], o[7]); *(GAS v4u*)(H1 + (size_t)(u.arow + r) * FF + fb) = w; } } }
#else
                    if (r < u.nrow) { v4u w; w.x = pk2(o[0], o[1]); w.y = pk2(o[2], o[3]); w.z = pk2(o[4], o[5]); w.w = pk2(o[6], o[7]);
                        __builtin_amdgcn_raw_buffer_store_b128(w, h1rs, (unsigned)((u.arow + r) * (FF * 2) + fb * 2), 0, 16); } } }
#endif
        } else {
            const int c0 = u.pn * 256 + wc * 32 + 8 * fq;
#pragma unroll
            for (int bj = 0; bj < 2; ++bj) { const pg8::f32x4 d0 = *(const pg8::f32x4*)(bd + u.e * D + c0 + bj * 128), d1 = *(const pg8::f32x4*)(bd + u.e * D + c0 + bj * 128 + 4);
#pragma unroll
                for (int ai = 0; ai < 2; ++ai)
#pragma unroll
                    for (int m = 0; m < 4; ++m) { const int r = ai * 128 + wr * 64 + m * 16 + fr;
                        const pg8::f32x4 a0 = acc[ai][bj][m][0] + d0, a1 = acc[ai][bj][m][1] + d1;
                        v4u w; w.x = pk2(a0[0], a0[1]); w.y = pk2(a0[2], a0[3]); w.z = pk2(a1[0], a1[1]); w.w = pk2(a1[2], a1[3]);
                        if (r < u.nrow) *(GAS v4u*)(YB + (size_t)(u.arow + r) * D + c0 + bj * 128) = w; } }
        }
    }
};
__device__ __forceinline__ void phase_final(Frame& F, bool dry = false) {
    moe_tables(F);
    const LAS int* off = (const LAS int*)(F.lds + SCR_OFF) + 32;
    LAS float* gtf = (LAS float*)(F.lds);
    const float* adaf = WSP(float, WS_ADAF);
    for (int i = F.tid; i < 2 * D; i += NWAVES * 64) { const int b = i >> 10, k = i & (D - 1); gtf[i] = adaf[b * 6 * D + 5 * D + k] * WSP(float, WS_PAR)[PAR_FPOST + k]; }
    __syncthreads();
    const int gw = F.vcu * NWAVES + F.wave, NGW = F.G * NWAVES, L = F.lane;
    const int* tok_e = WSP(int, WS_ROUTE); const float* tok_w = (const float*)(tok_e + T * 4); const int* tok_pos = tok_e + 2 * T * 4;
    const bf16* YB = WSP(bf16, WS_YB);
    for (int t = gw * 2; t < T; t += NGW * 2) { const int b = t >> 13;
        int row_l = 0; float w_l = 0.f;
        if (L < 8) { const int idx = (t + (L >> 2)) * 4 + (L & 3); row_l = off[tok_e[idx]] + tok_pos[idx]; w_l = tok_w[idx]; }
        v2u yv[2][4][4]; f32x4 x1v[2][4]; float wk[2][4];
#pragma unroll
        for (int q = 0; q < 2; ++q) {
#pragma unroll
            for (int k = 0; k < 4; ++k) { const int row = __shfl(row_l, q * 4 + k); wk[q][k] = __shfl(w_l, q * 4 + k);
                const GAS v2u* yr = (const GAS v2u*)(YB + (size_t)row * D) + L;
#pragma unroll
                for (int j = 0; j < 4; ++j) yv[q][k][j] = __builtin_nontemporal_load(yr + 64 * j);
#ifdef DRY14_NOYB
                if (dry) { _Pragma("unroll") for (int j = 0; j < 4; ++j) yv[q][k][j] = (v2u){0x3f803f80u, 0x3f803f80u}; }
#endif
            }
            const GAS f32x4* xr = (const GAS f32x4*)(F.out + (size_t)(t + q) * D) + L;
#pragma unroll
            for (int j = 0; j < 4; ++j) x1v[q][j] = __builtin_nontemporal_load(xr + 64 * j); }
#pragma unroll
        for (int q = 0; q < 2; ++q) {
            f32x4 y[4];
#pragma unroll
            for (int j = 0; j < 4; ++j) y[j] = (f32x4){0.f, 0.f, 0.f, 0.f};
#pragma unroll
            for (int k = 0; k < 4; ++k)
#pragma unroll
                for (int j = 0; j < 4; ++j) { const v2u x = yv[q][k][j]; const float w = wk[q][k]; y[j].x += w * bflo(x.x); y[j].y += w * bfhi(x.x); y[j].z += w * bflo(x.y); y[j].w += w * bfhi(x.y); }
            float s = 0.f;
#pragma unroll
            for (int j = 0; j < 4; ++j) s += (y[j].x * y[j].x + y[j].y * y[j].y) + (y[j].z * y[j].z + y[j].w * y[j].w);
            const float r = 1.f / sqrtf(wave_sum(s) * (1.f / D) + NORM_EPS);
            GAS f32x4* wrow = dry ? (GAS f32x4*)(WSP(float, WS_WGU_T) + (size_t)(t + q) * D) + L : (GAS f32x4*)(F.out + (size_t)(t + q) * D) + L;
#pragma unroll
            for (int j = 0; j < 4; ++j) { const f32x4 g = *(const LAS f32x4*)(gtf + b * D + 4 * L + 256 * j); __builtin_nontemporal_store(x1v[q][j] + g * (y[j] * r), wrow + 64 * j); }
        }
    }
}
__device__ __forceinline__ bool opaque_ws(Frame& F) { asm volatile("" : "+s"(F.ws)); return true; }
#ifndef MK_N_LAUNCHES
#define MK_N_LAUNCHES 1
#endif
constexpr int N_PHASES = 15;
struct Args { const float* in[30]; float* out; unsigned char* ws; int ph_lo, ph_hi; };
__global__ void __launch_bounds__(NWAVES * 64, 2) mega_fwd(Args args) {
    extern __shared__ __attribute__((aligned(16))) unsigned char lds[];
    Frame F;
    F.lds = (LAS unsigned char*)lds;
    F.MISC = (volatile LAS unsigned*)(F.lds + MISC_OFF);
    F.tid = threadIdx.x; F.lane = F.tid & 63; F.wave = __builtin_amdgcn_readfirstlane(F.tid >> 6);
    F.G = gridDim.x; { const int bx = blockIdx.x; F.vcu = (F.G % 8 == 0) ? (bx % 8) * (F.G / 8) + bx / 8 : bx; }
    F.ws = args.ws; F.ctl = (gu32*)(args.ws + WS_CTL); F.out = args.out;
#pragma unroll
    for (int i = 0; i < 30; ++i) F.in[i] = args.in[i];
    for (int u = F.tid; u < (LDS_BYTES - LDSCTL_OFF) / 4; u += NWAVES * 64) ((LAS unsigned*)(F.lds + LDSCTL_OFF))[u] = 0u;
    __syncthreads();
    XcdBarrier bar; bar.bar = (unsigned*)(F.ctl + CW_BAR); bar.x = 0; bar.st = nullptr;
    if (MK_N_LAUNCHES == 1) bar = xcd_barrier_post((unsigned*)(F.ctl + CW_BAR), F.MISC + 8);
    const int lo = args.ph_lo, hi = args.ph_hi;
#ifndef PHMASK
#define PHMASK 0x7fff
#endif
#define IN(k) (((PHMASK >> (k)) & 1) && lo <= (k) && (k) < hi)
#ifdef DBG_A
#define STAMP(k) do { if (blockIdx.x == 0 && F.tid == 0) ((unsigned long long*)(F.ctl + 2048))[k] = __builtin_amdgcn_s_memrealtime(); } while (0)
#else
#define STAMP(k) do {} while (0)
#endif
#ifndef REP_PHASE
#define REP_PHASE -1
#endif
#define REPL(k) for (int rep_ = 0; rep_ < (REP_PHASE == (k) ? 2 : 1); ++rep_) if (opaque_ws(F))
#ifdef DBL_BAR
#define SEAM(k) do { if (IN(k)) { xcd_barrier(bar); xcd_barrier(bar); } STAMP((k) + 1); } while (0)
#else
#define SEAM(k) do { if (IN(k)) xcd_barrier(bar); STAMP((k) + 1); } while (0)
#endif
    PG8_LAS unsigned char* ring = F.lds + RING_OFF;
    const int bx = (int)blockIdx.x;

    STAMP(0);
    if (IN(0)) REPL(0) { phase0(F); } SEAM(0);
    if (IN(1)) REPL(1) { phase1(F); } SEAM(1);
    if (IN(2)) REPL(2) {
        pg8::Gemm g{WSP(bf16, WS_XN), WSP(bf16, WS_WIN_T), D, D, D}; pg8::DenseOrder S; S.init(T, INW, F.G, bx);
        EpiG1 E{WSP(bf16, WS_UA), WSP(bf16, WS_Q), WSP(bf16, WS_K), WSP(bf16, WS_V), WSP(bf16, WS_VT), WSP(bf16, WS_GS), WSP(bf16, WS_GA),
                WSP(float, WS_ROPE), WSP(float, WS_ROPE) + (size_t)T * 32, (float*)(F.ctl + CW_KM)};
        pg8::gemm_phase(ring, g, S, E);
        s5_fill_kt(F);
    } SEAM(2);
    if (IN(3)) REPL(3) {
        pg8::Gemm g{WSP(bf16, WS_UA), WSP(bf16, WS_S5M1), 384, 256, 256}; S5Order S{F.G, bx}; EpiS5A E{WSP(float, WS_S5E)};
        pg8::gemm_phase(ring, g, S, E);
        s5_fill_wc(F);
        attn_gate(F);
    } SEAM(3);
    if (IN(4)) REPL(4) { attn_items(F); s5_carry(F); } SEAM(4);
    if (IN(5)) REPL(5) {
        pg8::Gemm g{WSP(bf16, WS_UA), WSP(bf16, WS_S5WC), 384, 384, 384}; S5Order S{F.G, bx}; EpiS5C E{WSP(bf16, WS_YG)};
        pg8::gemm_phase(ring, g, S, E);
        attn_combine(F);
    } SEAM(5);
    if (IN(6)) REPL(6) {
        pg8::Gemm g{WSP(bf16, WS_YG), WSP(bf16, WS_WGLU_T), SW, SW, SW}; pg8::DenseOrder S; S.init(T, SW, F.G, bx);
        EpiEw<0> E{WSP(bf16, WS_Y2), WSP(bf16, WS_YG), nullptr, nullptr, SW};
        pg8::gemm_phase(ring, g, S, E);
    } SEAM(6);
    if (IN(7)) REPL(7) {
        pg8::Gemm g{WSP(bf16, WS_Y2), WSP(bf16, WS_WSB_T), SW, SW, SW}; pg8::DenseOrder S; S.init(T, D, F.G, bx);
        EpiEw<1> E{WSP(bf16, WS_M1), WSP(bf16, WS_GS), nullptr, nullptr, D};
        pg8::gemm_phase(ring, g, S, E);
    } SEAM(7);
    if (IN(8)) REPL(8) {
        pg8::Gemm g{WSP(bf16, WS_YA), WSP(bf16, WS_WAB_T), AW, AW, AW}; pg8::DenseOrder S; S.init(T, D, F.G, bx);
        EpiEw<2> E{WSP(bf16, WS_XN), WSP(bf16, WS_GA), WSP(bf16, WS_M1), nullptr, D};
        pg8::gemm_phase(ring, g, S, E);
    } SEAM(8);
    if (IN(9)) REPL(9) {
        pg8::Gemm g{WSP(bf16, WS_XN), WSP(bf16, WS_WOUT_T), D, D, D}; pg8::DenseOrder S; S.init(T, D, F.G, bx);
        EpiEw<3> E{nullptr, nullptr, nullptr, WSP(float, WS_MIX), D};
        pg8::gemm_phase(ring, g, S, E);
    } SEAM(9);
    if (IN(10)) REPL(10) { phase_rows(F, REP_PHASE == 10 && rep_ == 0); } SEAM(10);
#ifndef MOE_FUSED
#ifdef MOE_F8
    if (IN(12)) REPL(12) {
        moe_tables(F);
        pg8::Gemm g{WSP(bf16, WS_H2), WSP(bf16, WS_WGU_T), D / 2, D / 2, D / 2}; MoeOrder<true> S{(const LAS int*)(F.lds + SCR_OFF), WSP(int, WS_ELIST), 8, 2048, F.G, bx};
        EpiGU8 E{WSP(unsigned char, WS_H1), WSP(float, WS_PAR) + PAR_BG, WSP(float, WS_PAR) + PAR_BU, WSP(float, WS_PAR) + PAR_WSC};
        pg8::gemm_phase<EpiGU8, MoeOrder<true>, true>(ring, g, S, E);
    } SEAM(12);
    if (IN(13)) REPL(13) {
        moe_tables(F);
        pg8::Gemm g{WSP(bf16, WS_H1), WSP(bf16, WS_WDN_T), FF / 2, FF / 2, FF / 2}; MoeOrder<false> S{(const LAS int*)(F.lds + SCR_OFF), nullptr, 4, 1024, F.G, bx};
        EpiDn8 E{WSP(bf16, WS_YB), WSP(float, WS_PAR) + PAR_BD, WSP(float, WS_PAR) + PAR_WSC};
        pg8::gemm_phase<EpiDn8, MoeOrder<false>, true>(ring, g, S, E);
    } SEAM(13);
#else
    if (IN(12)) REPL(12) {
        moe_tables(F);
        pg8::Gemm g{WSP(bf16, WS_H2), WSP(bf16, WS_WGU_T), D, D, D}; MoeOrder<true> S{(const LAS int*)(F.lds + SCR_OFF), WSP(int, WS_ELIST), 8, 2048, F.G, bx};
        EpiGU E{WSP(bf16, WS_H1), WSP(float, WS_PAR) + PAR_BG, WSP(float, WS_PAR) + PAR_BU};
        pg8::gemm_phase(ring, g, S, E);
    } SEAM(12);
    if (IN(13)) REPL(13) {
        moe_tables(F);
        pg8::Gemm g{WSP(bf16, WS_H1), WSP(bf16, WS_WDN_T), FF, FF, FF}; MoeOrder<false> S{(const LAS int*)(F.lds + SCR_OFF), nullptr, 4, 1024, F.G, bx};
        EpiDn E{WSP(bf16, WS_YB), WSP(float, WS_PAR) + PAR_BD};
        pg8::gemm_phase(ring, g, S, E);
    } SEAM(13);
#endif
#else
    if (IN(12)) REPL(12) {
        moe_tables(F);
        pg8::Gemm g{(const bf16*)F.ws, WSP(bf16, WS_WGU_T), D, D, D};
        EpiMoe E{WSP(bf16, WS_H1), WSP(bf16, WS_YB), WSP(float, WS_PAR) + PAR_BG, WSP(float, WS_PAR) + PAR_BU, WSP(float, WS_PAR) + PAR_BD};
        for (int base = 0;;) { MoeFused S{(const LAS int*)(F.lds + SCR_OFF), WSP(int, WS_ELIST), F.ctl, F.G, bx, base};
            const int nd = pg8::gemm_phase(ring, g, S, E); if (nd == 0) break; base += nd; }
    } SEAM(12);
#endif
    if (IN(14)) REPL(14) { phase_final(F, REP_PHASE == 14 && rep_ == 0); }
#undef IN
#undef SEAM
}

extern "C" void kernel_launch(void* const* d_in, const int* in_sizes, int n_in, void* d_out, int out_size, void* d_ws, size_t ws_size, hipStream_t stream) {
    static int grid = 0;
    if (grid == 0) {
        if (n_in != 30 || in_sizes[0] != T * D || out_size != T * D || ws_size < WS_END) { fprintf(stderr, "kernel_launch: unexpected shapes (n_in %d, in0 %d, out %d, ws %zu)\n", n_in, n_in > 0 ? in_sizes[0] : -1, out_size, ws_size); grid = -1; return; }
        int dev = 0, cus = 0, per_cu = 0;
        if (hipGetDevice(&dev) != hipSuccess || hipDeviceGetAttribute(&cus, hipDeviceAttributeMultiprocessorCount, dev) != hipSuccess) { grid = -1; return; }
        if (hipFuncSetAttribute((const void*)mega_fwd, hipFuncAttributeMaxDynamicSharedMemorySize, LDS_BYTES) != hipSuccess) { fprintf(stderr, "kernel_launch: hipFuncSetAttribute failed\n"); grid = -1; return; }
        if (hipOccupancyMaxActiveBlocksPerMultiprocessor(&per_cu, (const void*)mega_fwd, NWAVES * 64, LDS_BYTES) != hipSuccess || per_cu < 1) { fprintf(stderr, "kernel_launch: occupancy query says %d\n", per_cu); }
        (void)hipGetLastError();
        grid = cus;
    }
    if (grid < 0) return;
    (void)hipMemsetAsync((char*)d_ws + WS_CTL, 0, CTL_ZERO_USED, stream);
    Args a{};
    for (int i = 0; i < 30; ++i) a.in[i] = (const float*)d_in[i];
    a.out = (float*)d_out; a.ws = (unsigned char*)d_ws;
#ifndef PLAIN_LAUNCH
    if (MK_N_LAUNCHES == 1) { a.ph_lo = 0; a.ph_hi = N_PHASES; void* kargs[] = {(void*)&a};
        const hipError_t e = hipLaunchCooperativeKernel((const void*)mega_fwd, dim3(grid), dim3(NWAVES * 64), kargs, LDS_BYTES, stream);
        if (e != hipSuccess) fprintf(stderr, "kernel_launch: cooperative launch failed: %s\n", hipGetErrorString(e)); }
#else
    if (MK_N_LAUNCHES == 1) { a.ph_lo = 0; a.ph_hi = N_PHASES; hipLaunchKernelGGL(mega_fwd, dim3(grid), dim3(NWAVES * 64), LDS_BYTES, stream, a); }
#endif
    else for (int p = 0; p < N_PHASES; ++p) { a.ph_lo = p; a.ph_hi = p + 1; hipLaunchKernelGGL(mega_fwd, dim3(grid), dim3(NWAVES * 64), LDS_BYTES, stream, a); }
}
```

```cpp
#include <hip/hip_runtime.h>
#include <cstdio>
#include <cstdint>
#define MK_N_LAUNCHES 1
namespace pg8 {
#define PG8_LAS __attribute__((address_space(3)))
typedef unsigned short bf16_t;
typedef short bf16x8 __attribute__((ext_vector_type(8)));
typedef float f32x4 __attribute__((ext_vector_type(4)));
typedef unsigned u32x4 __attribute__((ext_vector_type(4)));
typedef unsigned u32x2 __attribute__((ext_vector_type(2)));
typedef int v4i32 __attribute__((ext_vector_type(4)));
typedef int v8i32 __attribute__((ext_vector_type(8)));
constexpr int BM = 256, BK = 64, HALF = 128, HTB = HALF * BK * 2  , STAGE_BYTES = 8 * HTB, NXCD = 8, WGM = 8;

__host__ __device__ __forceinline__ int lds_byte(int r, int c) { const int st = (r >> 4) * 2 + (c >> 5), rr = r & 15, cc = c & 31, ob = rr * 64 + cc * 2; return st * 1024 + (ob ^ (((ob >> 9) & 1) << 5)); }
__host__ __device__ __forceinline__ void stage_rc(int b, int& R, int& C) { const int st = b / 1024, sb = b % 1024, swz = sb ^ (((sb >> 9) & 1) << 5); R = (st >> 1) * 16 + swz / 64; C = (st & 1) * 32 + (swz % 64) / 2; }

struct Unit { int arow, brow, pm, pn, e, nrow, kind, aux; };
struct Gemm { const bf16_t* A; const bf16_t* Bt; int lda, ldb, K; };

struct DenseOrder {
    static constexpr bool GATHER = false;
    __device__ __forceinline__ void a_ready(const Unit&) const {}
    __device__ __forceinline__ void done(const Unit&) const {}
    int nM, nN, nwg, G, c;
    __device__ __forceinline__ void init(int M, int N, int G_, int c_) { nM = M / BM; nN = N / BM; nwg = nM * nN; G = G_; c = c_; }
    __device__ __forceinline__ bool next(int i, Unit& u) const {
        const long L = (long)i * G + c; if (L >= nwg) return false;
        int wgid = (int)L; { const int q = nwg / NXCD, r = nwg % NXCD, xcd = wgid % NXCD, off = wgid / NXCD; wgid = (xcd < r ? xcd * (q + 1) : r * (q + 1) + (xcd - r) * q) + off; }
        const int nig = WGM * nN, gid = wgid / nig, fm = gid * WGM, gsz = (nM - fm) < WGM ? (nM - fm) : WGM;
        u.pm = fm + ((wgid % nig) % gsz); u.pn = (wgid % nig) / gsz; u.arow = u.pm * BM; u.brow = u.pn * BM; u.e = 0; u.nrow = BM; u.kind = 0; u.aux = 0; return true;
    }
};

template <class Epi, class Sched, bool F8 = false>
__device__ __forceinline__ int gemm_phase(PG8_LAS unsigned char* lds, const Gemm g, const Sched& S, const Epi& E) {
    const int tid = threadIdx.x, wid = __builtin_amdgcn_readfirstlane(tid >> 6), lane = tid & 63, wr = wid >> 2, wc = wid & 3, fr = lane & 15, fq = lane >> 4;
    const int K = g.K, nt = K / BK;
    constexpr bool GA = Sched::GATHER;
    unsigned voffA[2], voffB[2]; int gR[2]; unsigned gC[2];
#pragma unroll
    for (int i = 0; i < 2; ++i) { int R, C; stage_rc(tid * 16 + i * 8192, R, C); gR[i] = R; gC[i] = (unsigned)C * 2u;
        voffA[i] = (unsigned)(R * g.lda + C) * 2u; voffB[i] = (unsigned)(R * g.ldb + C) * 2u; }
    unsigned gA_cur[2][2], gA_nxt[2][2];
#define PG8_GATH(dst, un) do { _Pragma("unroll") for (int _h = 0; _h < 2; ++_h) _Pragma("unroll") for (int _i = 0; _i < 2; ++_i) dst[_h][_i] = (unsigned)S.arow_of(un, _h * HALF + gR[_i]) * (unsigned)(g.lda * 2) + gC[_i]; } while (0)
#define PG8_STAGE_A(bufoff, h, kbytes, nx) do { if constexpr (GA) { const char* gb_ = (const char*)g.A + (kbytes); _Pragma("unroll") for (int _i = 0; _i < 2; ++_i) { const unsigned vo_ = (nx) ? gA_nxt[h][_i] : gA_cur[h][_i]; \
        __builtin_amdgcn_global_load_lds((const unsigned*)(gb_ + vo_), (PG8_LAS unsigned*)(lds + (bufoff) + ldsw + _i * 8192), 16, 0, 0); } } \
    else { const char* gb_ = ((nx) ? nA : cA) + (kbytes) + (h) * hstepA; PG8_STAGE(bufoff, gb_, voffA); } } while (0)
    const size_t kstep = (size_t)(BK * 2);
    const size_t hstepA = (size_t)HALF * g.lda * 2, hstepB = (size_t)HALF * g.ldb * 2;
    const size_t rowA = (size_t)g.lda * 2, rowB = (size_t)g.ldb * 2;
    const unsigned ldsw = (unsigned)wid * 1024u;
    const int aoff = lds_byte(wr * 64 + fr, fq * 8), boff = lds_byte(wc * 32 + fr, fq * 8);
#define PG8_SA(b, h) (((b) * 2 + (h)) * HTB)
#define PG8_SB(b, h) ((4 + (b) * 2 + (h)) * HTB)
#define PG8_STAGE(bufoff, gbase, voff) do { _Pragma("unroll") for (int _i = 0; _i < 2; ++_i) \
        __builtin_amdgcn_global_load_lds((const unsigned*)((const char*)(gbase) + (voff)[_i]), (PG8_LAS unsigned*)(lds + (bufoff) + ldsw + _i * 8192), 16, 0, 0); } while (0)
#define PG8_LDA(dst, b, h) do { _Pragma("unroll") for (int m = 0; m < 4; ++m) { if constexpr (F8) { const v4i32 lo_ = *(const PG8_LAS v4i32*)(lds + PG8_SA(b, h) + aoff + m * 2048), hi_ = *(const PG8_LAS v4i32*)(lds + PG8_SA(b, h) + aoff + m * 2048 + 1024); dst##8[m] = __builtin_shufflevector(lo_, hi_, 0, 1, 2, 3, 4, 5, 6, 7); } \
        else { _Pragma("unroll") for (int k = 0; k < 2; ++k) dst[m][k] = *(const PG8_LAS bf16x8*)(lds + PG8_SA(b, h) + aoff + m * 2048 + k * 1024); } } } while (0)
#define PG8_LDB(dst, b, h) do { _Pragma("unroll") for (int n = 0; n < 2; ++n) { if constexpr (F8) { const v4i32 lo_ = *(const PG8_LAS v4i32*)(lds + PG8_SB(b, h) + boff + n * 2048), hi_ = *(const PG8_LAS v4i32*)(lds + PG8_SB(b, h) + boff + n * 2048 + 1024); dst##8[n] = __builtin_shufflevector(lo_, hi_, 0, 1, 2, 3, 4, 5, 6, 7); } \
        else { _Pragma("unroll") for (int k = 0; k < 2; ++k) dst[n][k] = *(const PG8_LAS bf16x8*)(lds + PG8_SB(b, h) + boff + n * 2048 + k * 1024); } } } while (0)
#define PG8_MMA(ai, bj, At, Bt) do { __builtin_amdgcn_s_setprio(1); _Pragma("unroll") for (int m = 0; m < 4; ++m) _Pragma("unroll") for (int n = 0; n < 2; ++n) { \
        if constexpr (F8) { asm("v_mfma_scale_f32_16x16x128_f8f6f4 %0, %1, %2, %0, %3, %3 op_sel_hi:[0,0,0]" : "+v"(acc[ai][bj][m][n]) : "v"(Bt##8[n]), "v"(At##8[m]), "v"(one_scale)); } \
        else { _Pragma("unroll") for (int k = 0; k < 2; ++k) acc[ai][bj][m][n] = __builtin_amdgcn_mfma_f32_16x16x32_bf16(Bt[n][k], At[m][k], acc[ai][bj][m][n], 0, 0, 0); } } \
        __builtin_amdgcn_s_setprio(0); } while (0)
#define PG8_WAIT_V(n) asm volatile("s_waitcnt vmcnt(" #n ")" ::: "memory")
#define PG8_WAIT_L(n) asm volatile("s_waitcnt lgkmcnt(" #n ")" ::: "memory")
#define PG8_BAR __builtin_amdgcn_s_barrier()
#define PG8_SCHED __builtin_amdgcn_sched_barrier(0)
    Unit cur, nxt; int ui = 0;
    if (!S.next(0, cur)) return 0;
    f32x4 acc[2][2][4][2];
#pragma unroll
    for (int a = 0; a < 2; ++a)
#pragma unroll
        for (int b = 0; b < 2; ++b)
#pragma unroll
            for (int m = 0; m < 4; ++m)
#pragma unroll
                for (int n = 0; n < 2; ++n) acc[a][b][m][n] = (f32x4){0.f, 0.f, 0.f, 0.f};
    const int one_scale = 0x7f7f7f7f;
    bf16x8 At[4][2], B0[2][2], B1[2][2];
    v8i32 At8[4], B08[2], B18[2];
    const char* cA = GA ? (const char*)g.A : (const char*)g.A + (size_t)cur.arow * rowA; const char* cB = (const char*)g.Bt + (size_t)cur.brow * rowB; const char* nA = cA;
    if constexpr (GA) { PG8_GATH(gA_cur, cur); }
    S.a_ready(cur);
    PG8_STAGE(PG8_SB(0, 0), cB, voffB); PG8_STAGE(PG8_SB(0, 1), cB + hstepB, voffB); PG8_STAGE_A(PG8_SA(0, 0), 0, 0, false); PG8_STAGE_A(PG8_SA(0, 1), 1, 0, false);
    if (wr == 1) PG8_BAR;
    PG8_WAIT_V(2); PG8_BAR;
    PG8_STAGE(PG8_SB(1, 0), cB + kstep, voffB); PG8_STAGE_A(PG8_SA(1, 0), 0, kstep, false); PG8_STAGE(PG8_SB(1, 1), cB + hstepB + kstep, voffB);
    PG8_WAIT_V(6); PG8_BAR;
    for (;;) {
        const bool has_next = S.next(ui + 1, nxt);
        nA = GA ? cA : (has_next ? (const char*)g.A + (size_t)nxt.arow * rowA : cA); const char* nB = has_next ? (const char*)g.Bt + (size_t)nxt.brow * rowB : cB;
        if constexpr (GA) { if (has_next) { PG8_GATH(gA_nxt, nxt); } else { _Pragma("unroll") for (int _h = 0; _h < 2; ++_h) _Pragma("unroll") for (int _i = 0; _i < 2; ++_i) gA_nxt[_h][_i] = gA_cur[_h][_i]; } }
#pragma unroll 1
        for (int t = 0; t < nt; t += 2) {
            const bool last = (t == nt - 2);
            if (last && has_next) S.a_ready(nxt);
            const size_t k1 = (size_t)(t + 1) * kstep, k2 = last ? (size_t)0 : (size_t)(t + 2) * kstep, k3 = k2 + kstep;
            const char* b2 = last ? nB : cB + (size_t)(t + 2) * kstep; const char* b3 = b2 + kstep;
            PG8_LDB(B0, 0, 0); PG8_LDB(B1, 0, 1); PG8_SCHED; PG8_LDA(At, 0, 0); PG8_STAGE_A(PG8_SA(1, 1), 1, k1, false);
            PG8_WAIT_V(8); PG8_WAIT_L(0); PG8_BAR; PG8_MMA(0, 0, At, B0); PG8_MMA(0, 1, At, B1); PG8_BAR; PG8_SCHED;
            PG8_LDA(At, 0, 1); PG8_STAGE(PG8_SB(0, 0), b2, voffB); PG8_STAGE(PG8_SB(0, 1), b2 + hstepB, voffB); PG8_STAGE_A(PG8_SA(0, 0), 0, k2, last);
            PG8_WAIT_V(8); PG8_WAIT_L(0); PG8_BAR; PG8_MMA(1, 0, At, B0); PG8_MMA(1, 1, At, B1); PG8_BAR; PG8_SCHED;
            PG8_LDB(B0, 1, 0); PG8_LDB(B1, 1, 1); PG8_SCHED; PG8_LDA(At, 1, 0); PG8_STAGE_A(PG8_SA(0, 1), 1, k2, last);
            PG8_WAIT_V(8); PG8_WAIT_L(0); PG8_BAR; PG8_MMA(0, 0, At, B0); PG8_MMA(0, 1, At, B1); PG8_BAR; PG8_SCHED;
            PG8_LDA(At, 1, 1); PG8_STAGE(PG8_SB(1, 0), b3, voffB); PG8_STAGE(PG8_SB(1, 1), b3 + hstepB, voffB); PG8_STAGE_A(PG8_SA(1, 0), 0, k3, last);
            PG8_WAIT_V(8); PG8_WAIT_L(0); PG8_BAR; PG8_MMA(1, 0, At, B0); PG8_MMA(1, 1, At, B1); PG8_BAR; PG8_SCHED;
        }
        if (wr == 0) PG8_BAR;
        E(acc, cur, wr, wc, fr, fq);
        S.done(cur);
        if (!has_next) break;
#pragma unroll
        for (int a = 0; a < 2; ++a)
#pragma unroll
            for (int b = 0; b < 2; ++b)
#pragma unroll
                for (int m = 0; m < 4; ++m)
#pragma unroll
                    for (int n = 0; n < 2; ++n) acc[a][b][m][n] = (f32x4){0.f, 0.f, 0.f, 0.f};
        cur = nxt; cA = nA; cB = nB; ++ui;
        if constexpr (GA) { _Pragma("unroll") for (int _h = 0; _h < 2; ++_h) _Pragma("unroll") for (int _i = 0; _i < 2; ++_i) gA_cur[_h][_i] = gA_nxt[_h][_i]; }
        if (wr == 1) PG8_BAR;
    }
    PG8_WAIT_V(0);
    PG8_BAR;
    const int n_done_ = ui + 1;
#undef PG8_SA
#undef PG8_SB
#undef PG8_STAGE
#undef PG8_STAGE_A
#undef PG8_GATH
#undef PG8_LDA
#undef PG8_LDB
#undef PG8_MMA
#undef PG8_WAIT_V
#undef PG8_WAIT_L
#undef PG8_BAR
#undef PG8_SCHED
    return n_done_;
}
}
constexpr int NWAVES = 8;
constexpr int BATCH = 2, SEQ = 8192, T = BATCH * SEQ, D = 1024, NH = 8, HD = 64, AW = 512, SW = 512, NG = 32, NP = 64, GS16 = 16;
constexpr int NE = 32, FF = 1024, INW = 4096, TOPK = 4, NBLK = SEQ / 256;
constexpr float NORM_EPS = 1e-6f;
constexpr float C2 = 0.125f * 1.4426950408889634f;
constexpr int XROWS = T * TOPK + 256;

constexpr size_t MiB = 1u << 20;
constexpr size_t WS_CTL = 0, CTL_ZERO_BYTES = 1 * MiB;
constexpr size_t WS_ADA = 1 * MiB;
constexpr size_t WS_ADAF = WS_ADA + 832 * 1024;
constexpr size_t WS_ROPE = 2 * MiB;
constexpr size_t WS_S5P = 6 * MiB;
constexpr size_t WS_S5KT = 7 * MiB;
constexpr size_t WS_S5M1 = 10 * MiB;
constexpr size_t WS_S5WC = 506 * MiB;
constexpr size_t WS_S5E = 408 * MiB;
constexpr size_t WS_ROUTE = 9 * MiB;
constexpr size_t WS_ELIST = 14 * MiB; constexpr int ELCAP = T;
constexpr size_t WS_HSC = WS_ROUTE + 768 * 1024;
constexpr int PAR_WSC = 270000;
#ifndef MOE_BF16
#define MOE_F8 1
#endif
constexpr size_t WS_WIN_T = 18 * MiB, WS_WGLU_T = 26 * MiB, WS_WSB_T = 27 * MiB, WS_WAB_T = 28 * MiB, WS_WOUT_T = 29 * MiB;
constexpr size_t WS_PAR = 16 * MiB;
constexpr int PAR_MPG = 0, PAR_FPRE = 1024, PAR_FPOST = 2048, PAR_RB = 3072, PAR_RW = 4096, PAR_BG = 36864, PAR_BU = 69632, PAR_BD = 102400, PAR_CRE = 135168, PAR_CIM = 167936, PAR_SD = 200704, PAR_BRE = 201728, PAR_BIM = 234496;
constexpr size_t WS_WGU_T = 32 * MiB, WS_WDN_T = 160 * MiB;
constexpr size_t WS_XN = 224 * MiB;
constexpr size_t WS_UA = 256 * MiB, WS_Q = 280 * MiB, WS_K = 296 * MiB, WS_V = 312 * MiB, WS_VT = 328 * MiB;
constexpr size_t WS_MIX = 256 * MiB;
constexpr size_t WS_GS = 344 * MiB, WS_GA = 376 * MiB;
constexpr size_t WS_YG = 408 * MiB, WS_Y2 = 424 * MiB, WS_YA = 440 * MiB;
constexpr size_t WS_M1 = 456 * MiB;
constexpr size_t WS_H2 = 480 * MiB;
constexpr size_t WS_XG = 224 * MiB, WS_YB = 224 * MiB;
constexpr size_t WS_H1 = 352 * MiB;
constexpr size_t WS_END = 512 * MiB;
static_assert(WS_YB + (size_t)T * TOPK * D * 2 <= WS_H1 && WS_H1 + (size_t)T * TOPK * FF * 2 <= WS_H2 && WS_H2 + (size_t)T * D * 2 <= WS_END, "ws map");
constexpr int CW_TMO = 0, CW_CODE = 1, CW_BAR = 4096, CW_ECNT = 8192, CW_KM = 16384;
constexpr size_t CTL_ZERO_USED = (size_t)(CW_KM + BATCH * NH * NBLK * HD) * 4;
static_assert(CTL_ZERO_USED <= CTL_ZERO_BYTES, "ctl");

constexpr int RING_OFF = 0, RING_BYTES = 131072;
constexpr int LDSCTL_OFF = 152 * 1024, MISC_OFF = LDSCTL_OFF + 320;
constexpr int LDS_BYTES = 156 * 1024;

#define GAS __attribute__((address_space(1)))
#define LAS __attribute__((address_space(3)))
typedef unsigned short bf16;
typedef unsigned v4u __attribute__((ext_vector_type(4)));
typedef unsigned v2u __attribute__((ext_vector_type(2)));
typedef float f32x4 __attribute__((ext_vector_type(4)));
typedef GAS unsigned gu32;
#define RLX_AGENT __ATOMIC_RELAXED, __HIP_MEMORY_SCOPE_AGENT
#define LDS_WAIT() asm volatile("s_waitcnt lgkmcnt(0)" ::: "memory")
#define VM_WAIT() asm volatile("s_waitcnt vmcnt(0)" ::: "memory")
__device__ __forceinline__ unsigned f2bf(float f) { unsigned u = __builtin_bit_cast(unsigned, f); return (u + 0x7fffu + ((u >> 16) & 1u)) >> 16; }
__device__ __forceinline__ unsigned pk2(float lo, float hi) { typedef float f32x2_t __attribute__((ext_vector_type(2))); typedef __bf16 bf16x2_t __attribute__((ext_vector_type(2)));
    f32x2_t v = {lo, hi}; bf16x2_t r = __builtin_convertvector(v, bf16x2_t); return __builtin_bit_cast(unsigned, r); }
#ifdef WT_STORES
__device__ __forceinline__ void st16(void* p, v4u v) { asm volatile("global_store_dwordx4 %0, %1, off sc1\n\ts_nop 1" :: "v"(p), "v"(v) : "memory"); }
__device__ __forceinline__ void st8(void* p, v2u v) { asm volatile("global_store_dwordx2 %0, %1, off sc1\n\ts_nop 1" :: "v"(p), "v"(v) : "memory"); }
#else
__device__ __forceinline__ void st16(void* p, v4u v) { *(v4u*)p = v; }
__device__ __forceinline__ void st8(void* p, v2u v) { *(v2u*)p = v; }
#endif
__device__ __forceinline__ unsigned pk4_fp8(float a, float b, float c, float d) {
    a = fminf(fmaxf(a, -448.f), 448.f); b = fminf(fmaxf(b, -448.f), 448.f); c = fminf(fmaxf(c, -448.f), 448.f); d = fminf(fmaxf(d, -448.f), 448.f);
    int w = 0; w = __builtin_amdgcn_cvt_pk_fp8_f32(a, b, w, false); w = __builtin_amdgcn_cvt_pk_fp8_f32(c, d, w, true); return (unsigned)w; }
__device__ __forceinline__ float bflo(unsigned w) { return __builtin_bit_cast(float, w << 16); }
__device__ __forceinline__ float bfhi(unsigned w) { return __builtin_bit_cast(float, w & 0xffff0000u); }
__device__ __forceinline__ float bf2f(bf16 h) { return __builtin_bit_cast(float, (unsigned)h << 16); }
__device__ __forceinline__ float sigmoidf_(float x) { return 1.f / (1.f + __expf(-x)); }
__device__ __forceinline__ float gelu_tanh(float x) { const float u = 1.5957691216057308f * (x + 0.044715f * x * x * x); return x / (1.f + __expf(-u)); }

#define XB_TMO      128
#define XB_XCNT(j)  (256  + 64 * (j))
#define XB_XSUB(j)  (1280 + 64 * (j))
#define XB_XGEN(j)  (2304 + 64 * (j))
#define XB_TOP      3328
#define XB_TOPGEN   3392
#define XCD_BAR_WORDS 3456
#define XB_SPIN_CAP (1u << 18)
__device__ __forceinline__ unsigned xb_ld(unsigned* p)              { return __hip_atomic_load(p, __ATOMIC_RELAXED, __HIP_MEMORY_SCOPE_AGENT); }
__device__ __forceinline__ unsigned xb_add(unsigned* p, unsigned v) { return __hip_atomic_fetch_add(p, v, __ATOMIC_RELAXED, __HIP_MEMORY_SCOPE_AGENT); }
__device__ __forceinline__ unsigned xb_xcc_id() { return (unsigned)__builtin_amdgcn_s_getreg((3 << 11) | 20) & 0xFu; }
#define XB_SPIN(cond, bar) do { unsigned _sp = 0; while (cond) { __builtin_amdgcn_s_sleep(1); \
    if ((++_sp & 255u) == 0u) { if (xb_ld(&(bar)[XB_TMO])) break; if (_sp > XB_SPIN_CAP) { atomicAdd(&(bar)[XB_TMO], 1u); break; } } } } while (0)
struct XcdBarrier { unsigned* bar; unsigned x; volatile LAS unsigned* st; };
__device__ __forceinline__ XcdBarrier xcd_barrier_post(unsigned* bar, volatile LAS unsigned* st) {
    XcdBarrier b; b.bar = bar; b.x = xb_xcc_id(); b.st = st;
    if (threadIdx.x == 0) (void)xb_add(&bar[XB_XCNT(b.x)], 1u);
    return b;
}
__device__ __forceinline__ void xcd_barrier_complete(unsigned* bar, unsigned x, unsigned& nloc, unsigned& nx) {
    const unsigned G = gridDim.x * gridDim.y * gridDim.z;
    unsigned sum, cnt, mine, sp = 0u;
    for (;;) {
        sum = 0u; cnt = 0u; mine = 0u;
#pragma unroll
        for (unsigned j = 0; j < 16; ++j) { const unsigned c = xb_ld(&bar[XB_XCNT(j)]); sum += c; cnt += (c > 0u) ? 1u : 0u; mine = (j == x) ? c : mine; }
        if (sum == G) break;
        __builtin_amdgcn_s_sleep(1);
        if ((++sp & 255u) == 0u) { if (xb_ld(&bar[XB_TMO])) break; if (sp > XB_SPIN_CAP) { atomicAdd(&bar[XB_TMO], 1u); break; } }
    }
    nloc = mine > 0u ? mine : 1u; nx = cnt > 0u ? cnt : 1u;
}
__device__ __forceinline__ void xcd_barrier(const XcdBarrier& b) {
    asm volatile("s_waitcnt vmcnt(0)" ::: "memory");
    __syncthreads();
    if (threadIdx.x == 0) {
        unsigned* bar = b.bar;
        __builtin_amdgcn_s_waitcnt(0);
        unsigned nloc = b.st[0], nx = b.st[1];
        if (nloc == 0u) { xcd_barrier_complete(bar, b.x, nloc, nx); b.st[0] = nloc; b.st[1] = nx; }
        const unsigned old = xb_add(&bar[XB_XSUB(b.x)], 1u);
        const unsigned gen = old / nloc;
        if (old + 1u == (gen + 1u) * nloc) {
            __builtin_amdgcn_fence(__ATOMIC_RELEASE, "agent");
            asm volatile("s_waitcnt vmcnt(0)" ::: "memory");
            const unsigned og = xb_add(&bar[XB_TOP], 1u);
            const unsigned tg = og / nx;
            if (og + 1u == (tg + 1u) * nx) xb_add(&bar[XB_TOPGEN], 1u);
            else XB_SPIN(xb_ld(&bar[XB_TOPGEN]) == tg, bar);
            __builtin_amdgcn_fence(__ATOMIC_ACQUIRE, "agent");
            xb_add(&bar[XB_XGEN(b.x)], 1u);
            asm volatile("s_waitcnt vmcnt(0)" ::: "memory");
        } else {
            XB_SPIN(xb_ld(&bar[XB_XGEN(b.x)]) == gen, bar);
            __builtin_amdgcn_fence(__ATOMIC_ACQUIRE, "agent");
            asm volatile("s_waitcnt vmcnt(0)" ::: "memory");
        }
    }
    __syncthreads();
}

__device__ __forceinline__ float wave_sum(float v) {
#pragma unroll
    for (int o = 1; o < 64; o <<= 1) v += __shfl_xor(v, o);
    return v;
}
__device__ __forceinline__ float wave_max(float v) {
#pragma unroll
    for (int o = 1; o < 64; o <<= 1) v = fmaxf(v, __shfl_xor(v, o));
    return v;
}
struct Frame {
    LAS unsigned char* lds;
    volatile LAS unsigned* MISC;
    gu32* ctl;
    int tid, lane, wave;
    int vcu, G;
    unsigned char* ws;
    const float* in[30];
    float* out;
};
#define WSP(T_, off) ((T_*)(F.ws + (off)))

__device__ __forceinline__ int perm8(int c) { return (c & ~31) + 16 * ((c >> 2) & 1) + 4 * ((c >> 3) & 3) + (c & 3); }
struct MapP8 { int off; __device__ __forceinline__ int operator()(int n) const { return off + perm8(n); } };
struct MapWin { __device__ __forceinline__ int operator()(int c) const {
    if (c < 512 || c >= 1536) return perm8(c);
    const int base = (c < 1024) ? 512 : 1024, cc = c - base, head = cc >> 6, d = cc & 63, pnq = head >> 2, hh = head & 3, n = d >> 5, dd = d & 31;
    const int wc = 2 * (hh & 1) + (dd >> 4), bj = hh >> 1, j = dd & 15;
    return base + 256 * pnq + 128 * bj + 32 * wc + 16 * n + j; } };
struct MapGU { int e, up; __device__ __forceinline__ int operator()(int f) const { return e * 2048 + (f >> 7) * 256 + up * 128 + perm8(f & 127); } };

template <class RowMap>
__device__ __forceinline__ void p0_transpose_item(const float* W, int K, int N, bf16* WT, LAS float* scr, int item, int lane, const RowMap rm) {
    const int nblk = N / 64, kb = item / nblk, nb = item % nblk, k0 = 64 * kb, n0 = 64 * nb;
    const int lr = lane >> 4, lc = 4 * (lane & 15);
    f32x4 v[16];
#pragma unroll
    for (int i = 0; i < 16; ++i) v[i] = __builtin_nontemporal_load((const GAS f32x4*)(W + (size_t)(k0 + 4 * i + lr) * N + n0 + lc));
#pragma unroll
    for (int i = 0; i < 16; ++i) { LAS float* d = scr + (4 * i + lr) * 65 + lc; d[0] = v[i].x; d[1] = v[i].y; d[2] = v[i].z; d[3] = v[i].w; }
    LDS_WAIT(); asm volatile("" ::: "memory");
    const int c = lane & 7;
#pragma unroll
    for (int j = 0; j < 8; ++j) { const int n = (lane >> 3) + 8 * j; const LAS float* s = scr + (8 * c) * 65 + n;
        v4u o; o.x = pk2(s[0 * 65], s[1 * 65]); o.y = pk2(s[2 * 65], s[3 * 65]); o.z = pk2(s[4 * 65], s[5 * 65]); o.w = pk2(s[6 * 65], s[7 * 65]);
        __builtin_nontemporal_store(o, (GAS v4u*)(WT + (size_t)rm(n0 + n) * K + k0 + 8 * c)); }
    LDS_WAIT(); asm volatile("" ::: "memory");
}

template <class RowMap>
__device__ __forceinline__ void p0_transpose_item_f8(const float* W, int K, int N, unsigned char* WT, LAS float* scr, int item, int lane, const RowMap rm, float wsc) {
    const int nblk = N / 64, kb = item / nblk, nb = item % nblk, k0 = 64 * kb, n0 = 64 * nb;
    const int lr = lane >> 4, lc = 4 * (lane & 15);
    f32x4 v[16];
#pragma unroll
    for (int i = 0; i < 16; ++i) v[i] = __builtin_nontemporal_load((const GAS f32x4*)(W + (size_t)(k0 + 4 * i + lr) * N + n0 + lc));
#pragma unroll
    for (int i = 0; i < 16; ++i) { LAS float* d = scr + (4 * i + lr) * 65 + lc; d[0] = v[i].x * wsc; d[1] = v[i].y * wsc; d[2] = v[i].z * wsc; d[3] = v[i].w * wsc; }
    LDS_WAIT(); asm volatile("" ::: "memory");
    const int c = lane & 3;
#pragma unroll
    for (int j = 0; j < 4; ++j) { const int n = (lane >> 2) + 16 * j; const LAS float* s = scr + (16 * c) * 65 + n;
        v4u o; o.x = pk4_fp8(s[0 * 65], s[1 * 65], s[2 * 65], s[3 * 65]); o.y = pk4_fp8(s[4 * 65], s[5 * 65], s[6 * 65], s[7 * 65]);
        o.z = pk4_fp8(s[8 * 65], s[9 * 65], s[10 * 65], s[11 * 65]); o.w = pk4_fp8(s[12 * 65], s[13 * 65], s[14 * 65], s[15 * 65]);
        __builtin_nontemporal_store(o, (GAS v4u*)(WT + (size_t)rm(n0 + n) * K + k0 + 16 * c)); }
    LDS_WAIT(); asm volatile("" ::: "memory");
}

__device__ __forceinline__ void p0_moe_load(const float* W, int item, int lane, f32x4 (&v)[16]) {
    const int kb = item >> 4, nb = item & 15, k0 = 64 * kb, n0 = 64 * nb, lr = lane >> 4, lc = 4 * (lane & 15);
#pragma unroll
    for (int i = 0; i < 16; ++i) v[i] = __builtin_nontemporal_load((const GAS f32x4*)(W + (size_t)(k0 + 4 * i + lr) * 1024 + n0 + lc));
}
__device__ __forceinline__ void p0_moe_finish(unsigned char* WT, int rowbase, int kind, int item, LAS float* scr, int lane, const f32x4 (&v)[16], float wsc) {
    const int kb = item >> 4, nb = item & 15, k0 = 64 * kb, n0 = 64 * nb, lr = lane >> 4, lc = 4 * (lane & 15);
#pragma unroll
    for (int i = 0; i < 16; ++i) { LAS float* d = scr + (4 * i + lr) * 65 + lc; d[0] = v[i].x * wsc; d[1] = v[i].y * wsc; d[2] = v[i].z * wsc; d[3] = v[i].w * wsc; }
    LDS_WAIT(); asm volatile("" ::: "memory");
    const int c = lane & 3;
#pragma unroll
    for (int j = 0; j < 4; ++j) { const int n = n0 + (lane >> 2) + 16 * j; const LAS float* s = scr + (16 * c) * 65 + (n - n0);
        const int row = rowbase + (kind < 2 ? (n >> 7) * 256 + kind * 128 + perm8(n & 127) : perm8(n));
        v4u o; o.x = pk4_fp8(s[0 * 65], s[1 * 65], s[2 * 65], s[3 * 65]); o.y = pk4_fp8(s[4 * 65], s[5 * 65], s[6 * 65], s[7 * 65]);
        o.z = pk4_fp8(s[8 * 65], s[9 * 65], s[10 * 65], s[11 * 65]); o.w = pk4_fp8(s[12 * 65], s[13 * 65], s[14 * 65], s[15 * 65]);
        __builtin_nontemporal_store(o, (GAS v4u*)(WT + (size_t)row * 1024 + k0 + 16 * c)); }
    LDS_WAIT(); asm volatile("" ::: "memory");
}

__device__ __forceinline__ void phase0(Frame& F) {
    LAS float* scr = (LAS float*)(F.lds + RING_OFF + F.wave * 16640);
    const int gw = F.vcu * NWAVES + F.wave, NGW = F.G * NWAVES;
#ifdef MOE_F8
    float wsc;
    { float am = 0.f;
      for (int j = F.tid; j < 2048; j += NWAVES * 64) { const size_t o = (size_t)j * 16384 + 37 * (j & 63);
          am = fmaxf(am, fmaxf(fabsf(F.in[24][o]), fmaxf(fabsf(F.in[26][o]), fabsf(F.in[28][o])))); }
      am = wave_max(am); LAS float* red = (LAS float*)(F.lds + LDSCTL_OFF + 64);
      if (F.lane == 0) red[F.wave] = am;
      __syncthreads();
      am = red[0];
#pragma unroll
      for (int w = 1; w < NWAVES; ++w) am = fmaxf(am, red[w]);
      wsc = exp2f(floorf(log2f(448.f / (fmaxf(am, 1e-30f) * 8.f))));
      if (blockIdx.x == 0 && F.tid == 0) WSP(float, WS_PAR)[PAR_WSC] = wsc;
      __syncthreads(); }
#endif
    constexpr int I_WIN = 16 * 64, I_GLU = 8 * 8, I_SB = 8 * 16, I_AB = 8 * 16, I_OUT = 16 * 16, I_E = 16 * 16;
    constexpr int I_SMALL = I_WIN + I_GLU + I_SB + I_AB + I_OUT, I_MOE = 3 * NE * I_E, I_ADA = 16 * 96;
    constexpr int NITEMS = I_SMALL + I_MOE + I_ADA;
    for (int it = gw; it < NITEMS; it += NGW) {
        int r = it;
        if (r < I_WIN) { p0_transpose_item(F.in[9], D, INW, WSP(bf16, WS_WIN_T), scr, r, F.lane, MapWin{}); continue; } r -= I_WIN;
        if (r < I_GLU) { p0_transpose_item(F.in[18], SW, SW, WSP(bf16, WS_WGLU_T), scr, r, F.lane, MapP8{0}); continue; } r -= I_GLU;
        if (r < I_SB) { p0_transpose_item(F.in[19], SW, D, WSP(bf16, WS_WSB_T), scr, r, F.lane, MapP8{0}); continue; } r -= I_SB;
        if (r < I_AB) { p0_transpose_item(F.in[20], AW, D, WSP(bf16, WS_WAB_T), scr, r, F.lane, MapP8{0}); continue; } r -= I_AB;
        if (r < I_OUT) { p0_transpose_item(F.in[21], D, D, WSP(bf16, WS_WOUT_T), scr, r, F.lane, MapP8{0}); continue; } r -= I_OUT;
        if (r < I_MOE) {
#ifdef MOE_F8
            continue;
#endif
            const int mat = r / I_E, item = r % I_E, kind = mat / NE, e = mat % NE;
#ifdef MOE_F8
            if (kind == 0) p0_transpose_item_f8(F.in[24] + (size_t)e * D * FF, D, FF, WSP(unsigned char, WS_WGU_T), scr, item, F.lane, MapGU{e, 0}, wsc);
            else if (kind == 1) p0_transpose_item_f8(F.in[26] + (size_t)e * D * FF, D, FF, WSP(unsigned char, WS_WGU_T), scr, item, F.lane, MapGU{e, 1}, wsc);
            else p0_transpose_item_f8(F.in[28] + (size_t)e * FF * D, FF, D, WSP(unsigned char, WS_WDN_T), scr, item, F.lane, MapP8{e * 1024}, wsc);
#else
            if (kind == 0) p0_transpose_item(F.in[24] + (size_t)e * D * FF, D, FF, WSP(bf16, WS_WGU_T), scr, item, F.lane, MapGU{e, 0});
            else if (kind == 1) p0_transpose_item(F.in[26] + (size_t)e * D * FF, D, FF, WSP(bf16, WS_WGU_T), scr, item, F.lane, MapGU{e, 1});
            else p0_transpose_item(F.in[28] + (size_t)e * FF * D, FF, D, WSP(bf16, WS_WDN_T), scr, item, F.lane, MapP8{e * 1024});
#endif
            continue; }
        r -= I_MOE;
        {
            const int ks = r / 96, cc = r % 96, n = cc * 64 + F.lane;
            const float* cvec = F.in[1]; const float* aw = F.in[3];
            float a0 = 0.f, a1 = 0.f;
            for (int k = ks * 64; k < ks * 64 + 64; ++k) {
                const float c0 = cvec[k], c1 = cvec[D + k];
                const float s0 = c0 / (1.f + __expf(-c0)), s1 = c1 / (1.f + __expf(-c1));
                const float w = __builtin_nontemporal_load(aw + (size_t)k * (6 * D) + n);
                a0 += s0 * w; a1 += s1 * w; }
            float* part = WSP(float, WS_ADA);
            part[(ks * 2 + 0) * (6 * D) + n] = a0; part[(ks * 2 + 1) * (6 * D) + n] = a1;
        }
    }
#ifdef MOE_F8
    {   const float* wg = F.in[24]; const float* wu = F.in[26]; const float* wd = F.in[28];
        unsigned char* tgu = WSP(unsigned char, WS_WGU_T); unsigned char* tdn = WSP(unsigned char, WS_WDN_T);
#define P0_DEC(r_, W_, WT_, rb_, kd_, it_) const int mat_##r_ = (r_) >> 8, it_ = (r_) & 255, kd_ = mat_##r_ >> 5, e_##r_ = mat_##r_ & 31; \
        const float* W_ = (kd_ == 0 ? wg : (kd_ == 1 ? wu : wd)) + (size_t)e_##r_ * D * FF; unsigned char* WT_ = kd_ < 2 ? tgu : tdn; const int rb_ = kd_ < 2 ? e_##r_ * 2048 : e_##r_ * 1024;
        f32x4 va[16], vb[16]; int r = gw;
        if (r < I_MOE) { P0_DEC(r, W0, T0, b0, k0_, i0); (void)T0; (void)b0; (void)k0_; p0_moe_load(W0, i0, F.lane, va); }
        while (r < I_MOE) {
            { const int rn = r + NGW; if (rn < I_MOE) { P0_DEC(rn, W1, T1, b1, k1_, i1); (void)T1; (void)b1; (void)k1_; p0_moe_load(W1, i1, F.lane, vb); } }
            { P0_DEC(r, W2, T2, b2, k2_, i2); (void)W2; p0_moe_finish(T2, b2, k2_, i2, scr, F.lane, va, wsc); }
            r += NGW; if (r >= I_MOE) break;
            { const int rn = r + NGW; if (rn < I_MOE) { P0_DEC(rn, W3, T3, b3, k3_, i3); (void)T3; (void)b3; (void)k3_; p0_moe_load(W3, i3, F.lane, va); } }
            { P0_DEC(r, W4, T4, b4, k4_, i4); (void)W4; p0_moe_finish(T4, b4, k4_, i4, scr, F.lane, vb, wsc); }
            r += NGW;
        }
#undef P0_DEC
    }
#endif
    const int gt = F.vcu * (NWAVES * 64) + F.tid, NGT = F.G * NWAVES * 64;
    { const int* pos = (const int*)F.in[2]; float* rc = WSP(float, WS_ROPE); float* rs = rc + (size_t)T * 32;
      for (int i = gt; i < T * 32; i += NGT) { const int t = i >> 5, p = i & 31;
          const float invf = exp2f(-(float)p * (13.287712379549449f / 32.f));
          const double ang = (double)pos[t] * (double)invf; double rev = ang * 0.15915494309189535; rev -= floor(rev);
          const float fr = (float)rev;
          rc[i] = __builtin_amdgcn_cosf(fr); rs[i] = __builtin_amdgcn_sinf(fr); } }
    { float* P5 = WSP(float, WS_S5P);
      for (int i = gt; i < NG * NP; i += NGT) { const int g = i >> 6;
          const float dt = __expf(F.in[12][g]); const float lr = F.in[10][i], li = F.in[11][i];
          const float er = __expf(lr * dt); const double ang = (double)li * (double)dt; double rev = ang * 0.15915494309189535; rev -= floor(rev);
          const float cs = __builtin_amdgcn_cosf((float)rev), sn = __builtin_amdgcn_sinf((float)rev);
          float br = er * cs, bi = er * sn;
          P5[i] = br; P5[2048 + i] = bi;
          const float nr = br - 1.f, ni = bi, den = lr * lr + li * li;
          const float qr = (nr * lr + ni * li) / den, qi = (ni * lr - nr * li) / den;
          P5[8192 + i] = qr; P5[8192 + 2048 + i] = qi;
          float pr = br, pi_ = bi;
#pragma unroll
          for (int s = 0; s < 8; ++s) { const float tr = pr * pr - pi_ * pi_, ti = 2.f * pr * pi_; pr = tr; pi_ = ti; }
          P5[4096 + i] = pr; P5[6144 + i] = pi_;
          float* PW = P5 + 131072;
          float wr_ = 1.f, wi_ = 0.f;
#pragma unroll
          for (int k = 0; k <= 16; ++k) { PW[i * 17 + k] = wr_; PW[2048 * 17 + i * 17 + k] = wi_; const float tr = wr_ * br - wi_ * bi, ti = wr_ * bi + wi_ * br; wr_ = tr; wi_ = ti; } }
    }
}

__device__ __forceinline__ void phase1(Frame& F) {
    LAS float* A1 = (LAS float*)(F.lds + RING_OFF); LAS float* A2 = A1 + 2 * D;
    const float* part = WSP(float, WS_ADA); const float* ab = F.in[4]; const float* pg = F.in[5];
    for (int k = F.tid; k < D; k += NWAVES * 64)
#pragma unroll
        for (int b = 0; b < 2; ++b) { float sh = ab[k], sc = ab[D + k];
            for (int ks = 0; ks < 16; ++ks) { sh += part[(ks * 2 + b) * (6 * D) + k]; sc += part[(ks * 2 + b) * (6 * D) + D + k]; }
            A1[b * D + k] = pg[k] * (1.f + sc); A2[b * D + k] = sh; }
    const int gt = F.vcu * (NWAVES * 64) + F.tid, NGT = F.G * NWAVES * 64;
    { float* adaf = WSP(float, WS_ADAF);
      for (int n = gt; n < 2 * 6 * D; n += NGT) { const int b = n / (6 * D), j = n % (6 * D); float a = ab[j];
          for (int ks = 0; ks < 16; ++ks) a += part[(ks * 2 + b) * (6 * D) + j];
          adaf[n] = a; } }
    { float* par = WSP(float, WS_PAR);
      for (int i = gt; i < 32768; i += NGT) { par[PAR_RW + i] = F.in[22][i]; par[PAR_BG + i] = F.in[25][i]; par[PAR_BU + i] = F.in[27][i]; par[PAR_BD + i] = F.in[29][i];
          par[PAR_CRE + i] = F.in[15][i]; par[PAR_CIM + i] = F.in[16][i]; par[PAR_BRE + i] = F.in[13][i]; par[PAR_BIM + i] = F.in[14][i];
          if (i < 1024) { par[PAR_MPG + i] = F.in[6][i]; par[PAR_FPRE + i] = F.in[7][i]; par[PAR_FPOST + i] = F.in[8][i]; }
          if (i < 512) par[PAR_SD + i] = F.in[17][i];
          if (i < 32) par[PAR_RB + i] = F.in[23][i]; } }
    { const float* P5 = WSP(float, WS_S5P); const float* PWr = P5 + 131072; const float* PWi = PWr + 2048 * 17;
      bf16* M1t = WSP(bf16, WS_S5M1);
      for (int i = gt; i < NG * 256 * 256; i += NGT) { const int k = i & 255, n = (i >> 8) & 255, g = i >> 16; float val = 0.f;
          if (n < 128) { const int p = n & 63, gp = g * 64 + p, s_ = k >> 4, ci = k & 15;
              const float qr = P5[8192 + gp], qi = P5[8192 + 2048 + gp], b_r = F.in[13][gp * 16 + ci], b_i = F.in[14][gp * 16 + ci];
              const float bbr = qr * b_r - qi * b_i, bbi = qr * b_i + qi * b_r, wr_ = PWr[gp * 17 + 15 - s_], wi_ = PWi[gp * 17 + 15 - s_];
              val = (n < 64) ? (wr_ * bbr - wi_ * bbi) : (wr_ * bbi + wi_ * bbr); }
          M1t[((size_t)(g * 256 + perm8(n))) * 256 + k] = (bf16)f2bf(val); }
    }
    __syncthreads();
    const int gw = F.vcu * NWAVES + F.wave, NGW = F.G * NWAVES;
    bf16* XN = WSP(bf16, WS_XN);
    for (int m0 = gw * 2; m0 < T; m0 += NGW * 2) {
        const int b = m0 >> 13;
        f32x4 v[2][4];
#pragma unroll
        for (int q = 0; q < 2; ++q) { const GAS f32x4* xr = (const GAS f32x4*)(F.in[0] + (size_t)(m0 + q) * D) + F.lane;
#pragma unroll
            for (int j = 0; j < 4; ++j) v[q][j] = __builtin_nontemporal_load(xr + 64 * j); }
#pragma unroll
        for (int q = 0; q < 2; ++q) { float s = 0.f;
#pragma unroll
            for (int j = 0; j < 4; ++j) s += (v[q][j].x * v[q][j].x + v[q][j].y * v[q][j].y) + (v[q][j].z * v[q][j].z + v[q][j].w * v[q][j].w);
            const float rstd = 1.f / sqrtf(wave_sum(s) * (1.f / D) + NORM_EPS);
            GAS unsigned long long* o8 = (GAS unsigned long long*)(XN + (size_t)(m0 + q) * D) + F.lane;
#pragma unroll
            for (int j = 0; j < 4; ++j) { const f32x4 a1 = *(const LAS f32x4*)(A1 + b * D + 4 * F.lane + 256 * j), a2 = *(const LAS f32x4*)(A2 + b * D + 4 * F.lane + 256 * j);
                const f32x4 o = v[q][j] * rstd * a1 + a2;
                o8[64 * j] = (unsigned long long)pk2(o.x, o.y) | ((unsigned long long)pk2(o.z, o.w) << 32); } }
    }
    __syncthreads();
}

struct EpiG1 {
    bf16 *UA, *Q, *K, *V, *VT, *GSp, *GAp; const float *rc, *rs; float* km;
    __device__ __forceinline__ void operator()(const pg8::f32x4 (&acc)[2][2][4][2], const pg8::Unit& u, int wr, int wc, int fr, int fq) const {
        asm volatile("" : "+v"(fr), "+v"(fq));
        const int pn = u.pn, row0 = u.pm * 256 + wr * 64 + fr;
        if (pn < 2) {
#pragma unroll
            for (int ai = 0; ai < 2; ++ai)
#pragma unroll
                for (int m = 0; m < 4; ++m) { const int t = row0 + ai * 128 + m * 16, b = t >> 13, tt = t & (SEQ - 1), c = tt >> 4, s = tt & 15;
#pragma unroll
                    for (int bj = 0; bj < 2; ++bj) { const int ch = pn * 256 + bj * 128 + wc * 32 + 8 * fq, g = ch >> 4, ci = ch & 15;
                        const pg8::f32x4 v0 = acc[ai][bj][m][0], v1 = acc[ai][bj][m][1];
                        v4u w; w.x = pk2(v0[0], v0[1]); w.y = pk2(v0[2], v0[3]); w.z = pk2(v1[0], v1[1]); w.w = pk2(v1[2], v1[3]);
                        st16(UA + ((size_t)(g * 1024 + b * 512 + c) * 384 + 16 * s + ci), w); } }
        } else if (pn < 6) {
            const bool isk = pn >= 4; bf16* X = isk ? K : Q; const float sc = isk ? 1.f : C2;
            const int p0 = 16 * (wc & 1) + 4 * fq;
#pragma unroll
            for (int bj = 0; bj < 2; ++bj) {
                const int head = 4 * (pn & 1) + 2 * bj + (wc >> 1);
                int rowb = row0; asm volatile("" : "+v"(rowb));
                float ks[2][4];
#pragma unroll
                for (int b = 0; b < 2; ++b)
#pragma unroll
                    for (int i = 0; i < 4; ++i) ks[b][i] = 0.f;
#pragma unroll
                for (int ai = 0; ai < 2; ++ai)
#pragma unroll
                    for (int m = 0; m < 4; ++m) { const int t = rowb + ai * 128 + m * 16;
                        const pg8::f32x4 cs = *(const pg8::f32x4*)(rc + (size_t)t * 32 + p0), sn = *(const pg8::f32x4*)(rs + (size_t)t * 32 + p0);
                        const pg8::f32x4 t1 = acc[ai][bj][m][0], t2 = acc[ai][bj][m][1];
                        const pg8::f32x4 o1 = t1 * cs - t2 * sn, o2 = t2 * cs + t1 * sn;
                        v2u w1, w2; w1.x = pk2(o1[0] * sc, o1[1] * sc); w1.y = pk2(o1[2] * sc, o1[3] * sc); w2.x = pk2(o2[0] * sc, o2[1] * sc); w2.y = pk2(o2[2] * sc, o2[3] * sc);
                        bf16* dst = X + (size_t)t * AW + head * 64 + p0;
                        st8(dst, w1); st8(dst + 32, w2);
#pragma unroll
                        for (int i = 0; i < 4; ++i) { ks[0][i] += o1[i]; ks[1][i] += o2[i]; }
                        __builtin_amdgcn_sched_barrier(0); }
                if (isk) {
                    const int b = u.pm >> 5, blk = u.pm & 31;
#pragma unroll
                    for (int n = 0; n < 2; ++n)
#pragma unroll
                        for (int i = 0; i < 4; ++i) { float v = ks[n][i];
                            v += __shfl_xor(v, 1); v += __shfl_xor(v, 2); v += __shfl_xor(v, 4); v += __shfl_xor(v, 8);
                            if (fr == 0) atomicAdd(km + ((size_t)((b * NH + head) * NBLK + blk) * HD + 32 * n + p0 + i), v); }
                }
            }
        } else if (pn < 8) {
#pragma unroll
            for (int ai = 0; ai < 2; ++ai)
#pragma unroll
                for (int m = 0; m < 4; ++m) { const int t = row0 + ai * 128 + m * 16, b = t >> 13, tt = t & (SEQ - 1);
#pragma unroll
                    for (int bj = 0; bj < 2; ++bj) { const int cv = (pn - 6) * 256 + bj * 128 + wc * 32 + 8 * fq, head = cv >> 6, d = cv & 63;
                        const pg8::f32x4 v0 = acc[ai][bj][m][0], v1 = acc[ai][bj][m][1];
                        v4u w; w.x = pk2(v0[0], v0[1]); w.y = pk2(v0[2], v0[3]); w.z = pk2(v1[0], v1[1]); w.w = pk2(v1[2], v1[3]);
                        bf16* vt = VT + ((size_t)((b * NH + head) * HD + d) * SEQ + tt);
                        vt[0 * SEQ] = (bf16)(w.x & 0xffff); vt[1 * SEQ] = (bf16)(w.x >> 16); vt[2 * SEQ] = (bf16)(w.y & 0xffff); vt[3 * SEQ] = (bf16)(w.y >> 16);
                        vt[4 * SEQ] = (bf16)(w.z & 0xffff); vt[5 * SEQ] = (bf16)(w.z >> 16); vt[6 * SEQ] = (bf16)(w.w & 0xffff); vt[7 * SEQ] = (bf16)(w.w >> 16); } }
        } else {
            bf16* Gp = (pn < 12) ? GSp : GAp; const int cb = ((pn - 8) & 3) * 256;
#pragma unroll
            for (int ai = 0; ai < 2; ++ai)
#pragma unroll
                for (int m = 0; m < 4; ++m) { const int t = row0 + ai * 128 + m * 16;
#pragma unroll
                    for (int bj = 0; bj < 2; ++bj) { const int col = cb + bj * 128 + wc * 32 + 8 * fq;
                        const pg8::f32x4 v0 = acc[ai][bj][m][0], v1 = acc[ai][bj][m][1];
                        v4u w; w.x = pk2(sigmoidf_(v0[0]), sigmoidf_(v0[1])); w.y = pk2(sigmoidf_(v0[2]), sigmoidf_(v0[3]));
                        w.z = pk2(sigmoidf_(v1[0]), sigmoidf_(v1[1])); w.w = pk2(sigmoidf_(v1[2]), sigmoidf_(v1[3]));
                        __builtin_nontemporal_store(w, (v4u*)(Gp + (size_t)t * D + col)); } }
        }
    }
};

template <int MODE> struct EpiEw {
    bf16* O; const bf16* X1; const bf16* X2; float* Of; int ld;
    __device__ __forceinline__ void operator()(const pg8::f32x4 (&acc)[2][2][4][2], const pg8::Unit& u, int wr, int wc, int fr, int fq) const {
        const int row0 = u.pm * 256 + wr * 64 + fr, col0 = u.pn * 256 + wc * 32 + 8 * fq;
#pragma unroll
        for (int ai = 0; ai < 2; ++ai)
#pragma unroll
            for (int m = 0; m < 4; ++m) { const size_t rb = (size_t)(row0 + ai * 128 + m * 16) * ld + col0;
#pragma unroll
                for (int bj = 0; bj < 2; ++bj) { const size_t off = rb + bj * 128;
                    const pg8::f32x4 v0 = acc[ai][bj][m][0], v1 = acc[ai][bj][m][1];
                    if (MODE == 3) { *(pg8::f32x4*)(Of + off) = v0; *(pg8::f32x4*)(Of + off + 4) = v1; }
                    else {
                        const v4u x = __builtin_nontemporal_load((const v4u*)(X1 + off));
                        float r[8] = {v0[0], v0[1], v0[2], v0[3], v1[0], v1[1], v1[2], v1[3]};
                        const float xv[8] = {bflo(x.x), bfhi(x.x), bflo(x.y), bfhi(x.y), bflo(x.z), bfhi(x.z), bflo(x.w), bfhi(x.w)};
                        if (MODE == 0) {
#pragma unroll
                            for (int i = 0; i < 8; ++i) r[i] = xv[i] * sigmoidf_(r[i]);
                        } else if (MODE == 1) {
#pragma unroll
                            for (int i = 0; i < 8; ++i) r[i] = xv[i] * r[i];
                        } else {
                            const v4u y = __builtin_nontemporal_load((const v4u*)(X2 + off));
                            const float yv[8] = {bflo(y.x), bfhi(y.x), bflo(y.y), bfhi(y.y), bflo(y.z), bfhi(y.z), bflo(y.w), bfhi(y.w)};
#pragma unroll
                            for (int i = 0; i < 8; ++i) r[i] = yv[i] + xv[i] * r[i];
                        }
                        v4u w; w.x = pk2(r[0], r[1]); w.y = pk2(r[2], r[3]); w.z = pk2(r[4], r[5]); w.w = pk2(r[6], r[7]);
                        st16(O + off, w); } } }
    }
};

typedef short bf16x8 __attribute__((ext_vector_type(8)));
typedef float f32x16 __attribute__((ext_vector_type(16)));
constexpr size_t WS_ALIST = 456 * MiB;
constexpr size_t WS_OP01 = 224 * MiB;
constexpr size_t WS_OP23 = 472 * MiB;
constexpr size_t WS_LSE = 504 * MiB;
constexpr int CW_BCNT = 12288;
constexpr int ALCAP = 8192;

__device__ __forceinline__ void attn_gate(Frame& F) {
    const int gw = F.vcu * NWAVES + F.wave, NGW = F.G * NWAVES, L = F.lane;
    const bf16* Q = WSP(bf16, WS_Q); const float* km = (const float*)(F.ctl + CW_KM);
    unsigned* bcnt = (unsigned*)(F.ctl + CW_BCNT); unsigned* list = WSP(unsigned, WS_ALIST); float* lse = WSP(float, WS_LSE);
    for (int w = gw; w < BATCH * NH * (SEQ / 64); w += NGW) {
        const int bh = w >> 7, b = bh >> 3, h = bh & 7, tt = (w & 127) * 64 + L, t = b * SEQ + tt, blk = tt >> 8;
        float q[64];
        { const v4u* qp = (const v4u*)(Q + (size_t)t * AW + h * 64);
#pragma unroll
          for (int i = 0; i < 8; ++i) { const v4u x = qp[i]; q[8 * i] = bflo(x.x); q[8 * i + 1] = bfhi(x.x); q[8 * i + 2] = bflo(x.y); q[8 * i + 3] = bfhi(x.y);
              q[8 * i + 4] = bflo(x.z); q[8 * i + 5] = bfhi(x.z); q[8 * i + 6] = bflo(x.w); q[8 * i + 7] = bfhi(x.w); } }
        float v0 = -3e38f, v1 = -3e38f, v2 = -3e38f; int i0 = -1, i1 = -1, i2 = -1;
        for (int j = 0; j < blk; ++j) { const float* kp = km + (size_t)((b * NH + h) * NBLK + j) * HD; float g = 0.f;
#pragma unroll
            for (int d = 0; d < 64; ++d) g += q[d] * kp[d];
            if (g > v0) { v2 = v1; i2 = i1; v1 = v0; i1 = i0; v0 = g; i0 = j; }
            else if (g > v1) { v2 = v1; i2 = i1; v1 = g; i1 = j; }
            else if (g > v2) { v2 = g; i2 = j; } }
        float* lp = lse + ((size_t)t * NH + h) * 4;
        if (i0 < 0) lp[0] = -1e30f; if (i1 < 0) lp[1] = -1e30f; if (i2 < 0) lp[2] = -1e30f;
        for (int j = 0; j < blk; ++j) {
            const bool sel = (i0 == j) || (i1 == j) || (i2 == j);
            const unsigned long long mask = __ballot(sel);
            if (mask) { const int leader = __ffsll((long long)mask) - 1; const int bucket = (b * NH + h) * NBLK + j;
                unsigned base = 0u;
                if (L == leader) base = __hip_atomic_fetch_add(bcnt + bucket, (unsigned)__popcll(mask), RLX_AGENT);
                base = (unsigned)__shfl((int)base, leader);
                if (sel) { const unsigned pos = base + (unsigned)__popcll(mask & ((1ull << L) - 1ull)); const unsigned slot = (i0 == j) ? 0u : ((i1 == j) ? 1u : 2u);
                    list[(size_t)bucket * ALCAP + pos] = ((unsigned)tt << 2) | slot; } }
        }
    }
}

__device__ __forceinline__ unsigned cvtpk(float lo, float hi) { typedef float f32x2_t __attribute__((ext_vector_type(2))); typedef __bf16 bf16x2_t __attribute__((ext_vector_type(2)));
    f32x2_t v = {lo, hi}; bf16x2_t r = __builtin_convertvector(v, bf16x2_t); return __builtin_bit_cast(unsigned, r); }

constexpr int AT_KROW = 144, AT_VROW = 520, AT_KOFF = 0, AT_VOFF = 256 * AT_KROW;
__device__ __forceinline__ void attn_item(Frame& F, int b, int h, int j, bool own, const unsigned* lst, int nvalid) {
    const int tid = F.tid, L = F.lane, r = L & 31, hh = L >> 5, wv = F.wave;
    LAS unsigned char* Kl = F.lds + AT_KOFF; LAS unsigned char* Vl = F.lds + AT_VOFF;
    const bf16* Kg = WSP(bf16, WS_K) + ((size_t)(b * SEQ + j * 256)) * AW + h * 64;
    const bf16* Vg = WSP(bf16, WS_VT) + ((size_t)((b * NH + h) * HD)) * SEQ + j * 256;
    v4u kr[4], vr[4];
#pragma unroll
    for (int i = 0; i < 4; ++i) { const int idx = tid + 512 * i; kr[i] = *(const v4u*)(Kg + (size_t)(idx >> 3) * AW + (idx & 7) * 8); vr[i] = *(const v4u*)(Vg + (size_t)(idx >> 5) * SEQ + (idx & 31) * 8); }
    const int qi = wv * 32 + r; const bool valid = qi < nvalid;
    unsigned ent; if (own) ent = ((unsigned)(j * 256 + qi) << 2) | 3u; else ent = lst[valid ? qi : 0];
    const int tt = (int)(ent >> 2), slot = (int)(ent & 3u), t = b * SEQ + tt;
    bf16x8 qf[4];
    { const bf16* qp = WSP(bf16, WS_Q) + (size_t)t * AW + h * 64 + hh * 8;
#pragma unroll
      for (int d0 = 0; d0 < 4; ++d0) qf[d0] = *(const bf16x8*)(qp + d0 * 16); }
#pragma unroll
    for (int i = 0; i < 4; ++i) { const int idx = tid + 512 * i; *(LAS v4u*)(Kl + (idx >> 3) * AT_KROW + (idx & 7) * 16) = kr[i]; *(LAS v4u*)(Vl + (idx >> 5) * AT_VROW + (idx & 31) * 16) = vr[i]; }
    __syncthreads();
#ifdef ATT_STAGGER
    if (wv >= 4) __builtin_amdgcn_s_sleep(ATT_STAGGER);
#endif
#ifdef ATT_REP_COMPUTE
    for (int arep = 0; arep < 2; ++arep)
#endif
    if (wv * 32 < nvalid) {
        float m = -1e30f, l = 0.f; f32x16 O0 = {}, O1 = {};
        const int qrel = tt & 255;
#pragma unroll
        for (int hk = 0; hk < 2; ++hk) {
            if (own && hk * 4 > wv) continue;
            f32x16 S[4];
#pragma unroll
            for (int kt = 0; kt < 4; ++kt) S[kt] = (f32x16){};
#pragma unroll
            for (int d0 = 0; d0 < 4; ++d0) {
#pragma unroll
                for (int kt = 0; kt < 4; ++kt) { const bf16x8 kf = *(const LAS bf16x8*)(Kl + (hk * 128 + kt * 32 + r) * AT_KROW + d0 * 32 + hh * 16);
                    S[kt] = __builtin_amdgcn_mfma_f32_32x32x16_bf16(kf, qf[d0], S[kt], 0, 0, 0); }
                if (d0 & 1) __builtin_amdgcn_sched_barrier(0); }
            if (own) {
                asm volatile("; causal masking (own block only)" ::: "memory");
#pragma unroll
                for (int kt = 0; kt < 4; ++kt)
#pragma unroll
                    for (int rg = 0; rg < 16; ++rg) { const int key = hk * 128 + kt * 32 + (rg & 3) + 8 * (rg >> 2) + 4 * hh; if (key > qrel) S[kt][rg] = -1e30f; } }
            float mx = S[0][0];
#pragma unroll
            for (int kt = 0; kt < 4; ++kt)
#pragma unroll
                for (int rg = 0; rg < 16; ++rg) mx = fmaxf(mx, S[kt][rg]);
            mx = fmaxf(mx, __shfl_xor(mx, 32));
            const float mn = fmaxf(m, mx), alpha = __builtin_amdgcn_exp2f(m - mn); m = mn; l *= alpha;
#pragma unroll
            for (int rg = 0; rg < 16; ++rg) { O0[rg] *= alpha; O1[rg] *= alpha; }
            float ls = 0.f;
#pragma unroll
            for (int kt = 0; kt < 4; ++kt) {
                unsigned pw[8];
#pragma unroll
                for (int rg = 0; rg < 16; rg += 2) { const float p0 = __builtin_amdgcn_exp2f(S[kt][rg] - mn), p1 = __builtin_amdgcn_exp2f(S[kt][rg + 1] - mn); ls += p0 + p1; pw[rg >> 1] = cvtpk(p0, p1); }
#pragma unroll
                for (int s = 0; s < 2; ++s) {
                    const v4u pv = {pw[4 * s], pw[4 * s + 1], pw[4 * s + 2], pw[4 * s + 3]}; const bf16x8 pf = __builtin_bit_cast(bf16x8, pv);
                    const int kb = (hk * 128 + kt * 32 + 16 * s + 4 * hh) * 2;
                    { const LAS unsigned char* vp = Vl + r * AT_VROW + kb; const v2u lo = *(const LAS v2u*)vp, hi = *(const LAS v2u*)(vp + 16);
                      const v4u vv = {lo.x, lo.y, hi.x, hi.y}; O0 = __builtin_amdgcn_mfma_f32_32x32x16_bf16(__builtin_bit_cast(bf16x8, vv), pf, O0, 0, 0, 0); }
                    { const LAS unsigned char* vp = Vl + (32 + r) * AT_VROW + kb; const v2u lo = *(const LAS v2u*)vp, hi = *(const LAS v2u*)(vp + 16);
                      const v4u vv = {lo.x, lo.y, hi.x, hi.y}; O1 = __builtin_amdgcn_mfma_f32_32x32x16_bf16(__builtin_bit_cast(bf16x8, vv), pf, O1, 0, 0, 0); } } }
            l += ls;
        }
        l += __shfl_xor(l, 32);
        if (valid) {
            const float rl = 1.f / l;
            bf16* op = (slot < 2 ? WSP(bf16, WS_OP01) + (((size_t)t * NH + h) * 2 + slot) * 64 : WSP(bf16, WS_OP23) + (((size_t)t * NH + h) * 2 + (slot - 2)) * 64) + 4 * hh;
#pragma unroll
            for (int g4 = 0; g4 < 4; ++g4) { v2u w0, w1; w0.x = cvtpk(O0[4 * g4] * rl, O0[4 * g4 + 1] * rl); w0.y = cvtpk(O0[4 * g4 + 2] * rl, O0[4 * g4 + 3] * rl);
                w1.x = cvtpk(O1[4 * g4] * rl, O1[4 * g4 + 1] * rl); w1.y = cvtpk(O1[4 * g4 + 2] * rl, O1[4 * g4 + 3] * rl);
                *(v2u*)(op + 8 * g4) = w0; *(v2u*)(op + 32 + 8 * g4) = w1; }
            if (hh == 0) WSP(float, WS_LSE)[((size_t)t * NH + h) * 4 + slot] = m + log2f(l);
        }
    }
    __syncthreads();
}
__device__ __forceinline__ void attn_items(Frame& F) {
    LAS int* pre = (LAS int*)(F.lds + 72 * 1024);
    const unsigned* bcnt = (const unsigned*)(F.ctl + CW_BCNT);
    LAS int* cntl = pre + 520;
    for (int i = F.tid; i < 512; i += NWAVES * 64) cntl[i] = (int)__hip_atomic_load((gu32*)(F.ctl + CW_BCNT) + i, RLX_AGENT);
    __syncthreads();
    if (F.tid == 0) { int a = 0; for (int i = 0; i < 512; ++i) { pre[i] = a; a += (cntl[i] + 255) >> 8; } pre[512] = a; }
    __syncthreads();
    const int total = 512 + pre[512];
    for (int it = (int)blockIdx.x; it < total; it += F.G) {
        int bh, j, n; bool own; const unsigned* lst;
        if (it < 512) { bh = it >> 5; j = it & 31; own = true; lst = nullptr; n = 256; }
        else { const int s = it - 512; int lo = 0, hi = 512;
            while (hi - lo > 1) { const int mid = (lo + hi) >> 1; if (pre[mid] <= s) lo = mid; else hi = mid; }
            const int bucket = lo, tile = s - pre[bucket]; n = cntl[bucket] - tile * 256; n = n > 256 ? 256 : n; bh = bucket >> 5; j = bucket & 31; own = false;
            lst = WSP(unsigned, WS_ALIST) + (size_t)bucket * ALCAP + tile * 256; }
        const int b_ = __builtin_amdgcn_readfirstlane(bh >> 3), h_ = __builtin_amdgcn_readfirstlane(bh & 7), j_ = __builtin_amdgcn_readfirstlane(j), n_ = __builtin_amdgcn_readfirstlane(n);
        attn_item(F, b_, h_, j_, own, lst, n_);
    }
}
__device__ __forceinline__ void attn_combine(Frame& F) {
    if (F.G == 256 && blockIdx.x < 128) return;
    const int nb = F.G == 256 ? 128 : F.G, bi = F.G == 256 ? (int)blockIdx.x - 128 : F.vcu;
    const int gw = bi * NWAVES + F.wave, NGW = nb * NWAVES, L = F.lane, h = L >> 3, ch = L & 7;
    const float* lse = WSP(float, WS_LSE); bf16* YA = WSP(bf16, WS_YA);
    for (int t = gw; t < T; t += NGW) {
        const size_t th = (size_t)t * NH + h;
        const f32x4 ls = *(const f32x4*)(lse + th * 4);
        const float mx = fmaxf(fmaxf(ls[0], ls[1]), fmaxf(ls[2], ls[3]));
        const float w0 = __builtin_amdgcn_exp2f(ls[0] - mx), w1 = __builtin_amdgcn_exp2f(ls[1] - mx), w2 = __builtin_amdgcn_exp2f(ls[2] - mx), w3 = __builtin_amdgcn_exp2f(ls[3] - mx), inv = 1.f / (w0 + w1 + w2 + w3);
        const v4u a0 = __builtin_nontemporal_load((const v4u*)(WSP(bf16, WS_OP01) + (th * 2 + 0) * 64 + ch * 8)), a1 = __builtin_nontemporal_load((const v4u*)(WSP(bf16, WS_OP01) + (th * 2 + 1) * 64 + ch * 8));
        const v4u a2 = __builtin_nontemporal_load((const v4u*)(WSP(bf16, WS_OP23) + (th * 2 + 0) * 64 + ch * 8)), a3 = __builtin_nontemporal_load((const v4u*)(WSP(bf16, WS_OP23) + (th * 2 + 1) * 64 + ch * 8));
        float o[8];
        const unsigned x0[4] = {a0.x, a0.y, a0.z, a0.w}, x1[4] = {a1.x, a1.y, a1.z, a1.w}, x2[4] = {a2.x, a2.y, a2.z, a2.w}, x3[4] = {a3.x, a3.y, a3.z, a3.w};
#pragma unroll
        for (int i = 0; i < 4; ++i) {
            float lo_ = w3 * bflo(x3[i]), hi_ = w3 * bfhi(x3[i]);
            if (ls[0] > -1e29f) { lo_ += w0 * bflo(x0[i]); hi_ += w0 * bfhi(x0[i]); }
            if (ls[1] > -1e29f) { lo_ += w1 * bflo(x1[i]); hi_ += w1 * bfhi(x1[i]); }
            if (ls[2] > -1e29f) { lo_ += w2 * bflo(x2[i]); hi_ += w2 * bfhi(x2[i]); }
            o[2 * i] = lo_ * inv; o[2 * i + 1] = hi_ * inv; }
        v4u w; w.x = cvtpk(o[0], o[1]); w.y = cvtpk(o[2], o[3]); w.z = cvtpk(o[4], o[5]); w.w = cvtpk(o[6], o[7]);
        *(v4u*)(YA + (size_t)t * AW + h * 64 + ch * 8) = w;
    }
}
struct S5Order { static constexpr bool GATHER = false; int G, c;
    __device__ __forceinline__ void a_ready(const pg8::Unit&) const {}
    __device__ __forceinline__ void done(const pg8::Unit&) const {}
    __device__ __forceinline__ bool next(int i, pg8::Unit& u) const { const int L = i * G + c; if (L >= NG * 4) return false; const int g = L >> 2, rt = L & 3;
        u.arow = g * 1024 + rt * 256; u.brow = g * 256; u.pm = rt; u.pn = 0; u.e = g; u.nrow = 256; u.kind = 0; u.aux = 0; return true; } };
struct EpiS5A { float* E;
    __device__ __forceinline__ void operator()(const pg8::f32x4 (&acc)[2][2][4][2], const pg8::Unit& u, int wr, int wc, int fr, int fq) const {
        asm volatile("" : "+v"(fr), "+v"(fq));
#pragma unroll
        for (int ai = 0; ai < 2; ++ai)
#pragma unroll
            for (int m = 0; m < 4; ++m) { float* p = E + (size_t)(u.arow + ai * 128 + wr * 64 + m * 16 + fr) * 128 + wc * 32 + 8 * fq;
                *(pg8::f32x4*)p = acc[ai][0][m][0]; *(pg8::f32x4*)(p + 4) = acc[ai][0][m][1]; }
    }
};
struct EpiS5C { bf16* YG;
    __device__ __forceinline__ void operator()(const pg8::f32x4 (&acc)[2][2][4][2], const pg8::Unit& u, int wr, int wc, int fr, int fq) const {
        asm volatile("" : "+v"(fr), "+v"(fq));
        const int g = u.e, n0 = wc * 32 + 8 * fq, t0 = n0 >> 4, co0 = n0 & 15;
#pragma unroll
        for (int ai = 0; ai < 2; ++ai)
#pragma unroll
            for (int m = 0; m < 4; ++m) { const int row = u.pm * 256 + ai * 128 + wr * 64 + m * 16 + fr, b = row >> 9, c = row & 511;
                bf16* yp = YG + (size_t)(b * SEQ + 16 * c + t0) * SW + 16 * g + co0;
#pragma unroll
                for (int bj = 0; bj < 2; ++bj) {
                    const pg8::f32x4 v0 = acc[ai][bj][m][0], v1 = acc[ai][bj][m][1];
                    v4u w; w.x = pk2(gelu_tanh(v0[0]), gelu_tanh(v0[1])); w.y = pk2(gelu_tanh(v0[2]), gelu_tanh(v0[3]));
                    w.z = pk2(gelu_tanh(v1[0]), gelu_tanh(v1[1])); w.w = pk2(gelu_tanh(v1[2]), gelu_tanh(v1[3]));
                    *(v4u*)(yp + (size_t)bj * 8 * SW) = w; }
                __builtin_amdgcn_sched_barrier(0); }
    }
};
__device__ __forceinline__ void s5_fill_kt(Frame& F) {
    const int gt = F.vcu * (NWAVES * 64) + F.tid, NGT = F.G * NWAVES * 64;
    const float* P5 = WSP(float, WS_S5P); const float* PWr = P5 + 131072; const float* PWi = PWr + 2048 * 17; const float* par = WSP(float, WS_PAR);
    float* KT = WSP(float, WS_S5KT);
    for (int i = gt; i < NG * 16 * 256; i += NGT) { const int ci = i & 15, co = (i >> 4) & 15, tau = (i >> 8) & 15, g = i >> 12; float a = 0.f;
        for (int p = 0; p < 64; ++p) { const int gp = g * 64 + p;
            const float qr = P5[8192 + gp], qi = P5[8192 + 2048 + gp], b_r = par[PAR_BRE + gp * 16 + ci], b_i = par[PAR_BIM + gp * 16 + ci];
            const float bbr = qr * b_r - qi * b_i, bbi = qr * b_i + qi * b_r, wr_ = PWr[gp * 17 + tau], wi_ = PWi[gp * 17 + tau];
            const float xr = wr_ * bbr - wi_ * bbi, xi = wr_ * bbi + wi_ * bbr;
            const float cr = par[PAR_CRE + (g * 16 + co) * 64 + p], ci_ = par[PAR_CIM + (g * 16 + co) * 64 + p];
            a += cr * xr - ci_ * xi; }
        KT[i] = a; }
}
__device__ __forceinline__ void s5_fill_wc(Frame& F) {
    const int gt = F.vcu * (NWAVES * 64) + F.tid, NGT = F.G * NWAVES * 64;
    const float* P5 = WSP(float, WS_S5P); const float* PWr = P5 + 131072; const float* PWi = PWr + 2048 * 17; const float* KT = WSP(float, WS_S5KT); const float* par = WSP(float, WS_PAR);
    bf16* Wc = WSP(bf16, WS_S5WC);
    for (int i = gt; i < NG * 256 * 384; i += NGT) { const int k = i % 384, n = (i / 384) & 255, g = i / (384 * 256), t = n >> 4, co = n & 15; float val = 0.f;
        if (k < 256) { const int s_ = k >> 4, ci = k & 15;
            if (s_ <= t) val = KT[((g * 16 + (t - s_)) * 16 + co) * 16 + ci];
            if (s_ == t && ci == co) val += par[PAR_SD + g * 16 + co]; }
        else { const int p = (k - 256) & 63, gp = g * 64 + p; const float cr = par[PAR_CRE + (g * 16 + co) * 64 + p], ci_ = par[PAR_CIM + (g * 16 + co) * 64 + p];
            const float wr_ = PWr[gp * 17 + t + 1], wi_ = PWi[gp * 17 + t + 1];
            val = (k < 320) ? (cr * wr_ - ci_ * wi_) : -(cr * wi_ + ci_ * wr_); }
        Wc[((size_t)(g * 256 + perm8(n))) * 384 + k] = (bf16)f2bf(val); }
}
__device__ __forceinline__ void s5_carry(Frame& F) {
    const float* P5 = WSP(float, WS_S5P); const float* PWr = P5 + 131072; const float* PWi = PWr + 2048 * 17; const float* E = WSP(float, WS_S5E); bf16* UA = WSP(bf16, WS_UA);
    LAS float* Z = (LAS float*)(F.lds);
    const int seg = F.wave, p = F.lane;
    for (int bg = F.vcu; bg < BATCH * NG; bg += F.G) { const int b = bg / NG, g = bg % NG, gp = g * 64 + p;
        const float ar = PWr[gp * 17 + 16], ai = PWi[gp * 17 + 16];
        const size_t row0 = (size_t)g * 1024 + b * 512 + seg * 64;
        float zr = 0.f, zi = 0.f;
        for (int c0 = 0; c0 < 64; c0 += 8) { float er[8], ei[8];
#pragma unroll
            for (int k = 0; k < 8; ++k) { er[k] = E[(row0 + c0 + k) * 128 + p]; ei[k] = E[(row0 + c0 + k) * 128 + 64 + p]; }
#pragma unroll
            for (int k = 0; k < 8; ++k) { const float nr = ar * zr - ai * zi + er[k], ni = ar * zi + ai * zr + ei[k]; zr = nr; zi = ni; } }
        Z[(seg * 64 + p) * 2] = zr; Z[(seg * 64 + p) * 2 + 1] = zi;
        __syncthreads();
        if (seg == 0) { float br = ar, bi = ai;
#pragma unroll
            for (int k = 0; k < 6; ++k) { const float tr = br * br - bi * bi, ti = 2.f * br * bi; br = tr; bi = ti; }
            float sr = 0.f, si = 0.f;
            for (int sg = 0; sg < 8; ++sg) { const float xr = Z[(sg * 64 + p) * 2], xi = Z[(sg * 64 + p) * 2 + 1]; Z[(sg * 64 + p) * 2] = sr; Z[(sg * 64 + p) * 2 + 1] = si;
                const float nr = br * sr - bi * si + xr, ni = br * si + bi * sr + xi; sr = nr; si = ni; } }
        __syncthreads();
        float sr = Z[(seg * 64 + p) * 2], si = Z[(seg * 64 + p) * 2 + 1];
        for (int c0 = 0; c0 < 64; c0 += 8) { float er[8], ei[8];
#pragma unroll
            for (int k = 0; k < 8; ++k) { er[k] = E[(row0 + c0 + k) * 128 + p]; ei[k] = E[(row0 + c0 + k) * 128 + 64 + p]; }
#pragma unroll
            for (int k = 0; k < 8; ++k) { bf16* up = UA + (row0 + c0 + k) * 384 + 256 + p; up[0] = (bf16)f2bf(sr); up[64] = (bf16)f2bf(si);
                const float nr = ar * sr - ai * si + er[k], ni = ar * si + ai * sr + ei[k]; sr = nr; si = ni; } }
        __syncthreads();
    }
}
constexpr int SCR_OFF = LDSCTL_OFF + 512;
#ifndef MOE_LAG
#define MOE_LAG 2
#endif
constexpr int MT_SEG = 100, MT_MAXSEG = 72;
__device__ __forceinline__ void phase_rows(Frame& F, bool dry = false) {
    LAS float* h2t = (LAS float*)(F.lds);
    LAS float* lg = (LAS float*)(F.lds + 65536);
    LAS float* gtm = (LAS float*)(F.lds + 131072);
    LAS float* pg2 = gtm + 2 * D; LAS float* shf = pg2 + 2 * D;
    LAS unsigned* hist = (LAS unsigned*)(F.lds + SCR_OFF); LAS unsigned* base = hist + 32; LAS int* rec_e = (LAS int*)(base + 32); LAS int* rec_lp = rec_e + 256;
    const float* adaf = WSP(float, WS_ADAF); const float* par = WSP(float, WS_PAR);
    const int L = F.lane, wv = F.wave;
    for (int i = F.tid; i < 2 * D; i += NWAVES * 64) { const int b = i >> 10, k = i & (D - 1);
        gtm[i] = adaf[b * 6 * D + 2 * D + k] * par[PAR_MPG + k];
        pg2[i] = par[PAR_FPRE + k] * (1.f + adaf[b * 6 * D + 4 * D + k]); shf[i] = adaf[b * 6 * D + 3 * D + k]; }
    f32x4 wreg[16];
#pragma unroll
    for (int j = 0; j < 4; ++j)
#pragma unroll
        for (int i = 0; i < 4; ++i) wreg[j * 4 + i] = *(const f32x4*)(par + PAR_RW + (4 * L + 256 * j + i) * NE + 4 * wv);
    if (F.tid < 32) hist[F.tid] = 0u;
    __syncthreads();
    const float* mix = WSP(float, WS_MIX); bf16* H2 = WSP(bf16, WS_H2);
    int* tok_e = WSP(int, WS_ROUTE); float* tok_w = (float*)(tok_e + T * 4); int* tok_pos = tok_e + 2 * T * 4;
    unsigned* gcnt = (unsigned*)(F.ctl + CW_ECNT);
    for (int t0 = F.vcu * 16; t0 < T; t0 += F.G * 16) {
        {
            const int t = t0 + 2 * wv, b = t >> 13;
            f32x4 mv[2][4], xv[2][4];
#pragma unroll
            for (int q = 0; q < 2; ++q) { const GAS f32x4* mr = (const GAS f32x4*)(mix + (size_t)(t + q) * D) + L; const GAS f32x4* xr = (const GAS f32x4*)(F.in[0] + (size_t)(t + q) * D) + L;
#pragma unroll
                for (int j = 0; j < 4; ++j) { mv[q][j] = __builtin_nontemporal_load(mr + 64 * j); xv[q][j] = __builtin_nontemporal_load(xr + 64 * j); } }
#pragma unroll
            for (int q = 0; q < 2; ++q) { float s = 0.f;
#pragma unroll
                for (int j = 0; j < 4; ++j) s += (mv[q][j].x * mv[q][j].x + mv[q][j].y * mv[q][j].y) + (mv[q][j].z * mv[q][j].z + mv[q][j].w * mv[q][j].w);
                const float r1 = 1.f / sqrtf(wave_sum(s) * (1.f / D) + NORM_EPS);
                float s2 = 0.f; GAS f32x4* orow = (GAS f32x4*)(F.out + (size_t)(t + q) * D) + L;
#pragma unroll
                for (int j = 0; j < 4; ++j) { const f32x4 g = *(const LAS f32x4*)(gtm + b * D + 4 * L + 256 * j);
                    xv[q][j] = xv[q][j] + g * (mv[q][j] * r1); __builtin_nontemporal_store(xv[q][j], orow + 64 * j);
                    s2 += (xv[q][j].x * xv[q][j].x + xv[q][j].y * xv[q][j].y) + (xv[q][j].z * xv[q][j].z + xv[q][j].w * xv[q][j].w); }
                const float r2 = 1.f / sqrtf(wave_sum(s2) * (1.f / D) + NORM_EPS);
#ifdef MOE_F8
                GAS unsigned* h4 = (GAS unsigned*)(WSP(unsigned char, WS_H2) + (size_t)(t + q) * D) + L;
#pragma unroll
                for (int j = 0; j < 4; ++j) { const f32x4 a = *(const LAS f32x4*)(pg2 + b * D + 4 * L + 256 * j), c = *(const LAS f32x4*)(shf + b * D + 4 * L + 256 * j);
                    const f32x4 h = xv[q][j] * r2 * a + c;
                    h4[64 * j] = pk4_fp8(8.f * h.x, 8.f * h.y, 8.f * h.z, 8.f * h.w);
                    *(LAS f32x4*)(h2t + (2 * wv + q) * D + 4 * L + 256 * j) = h; } }
#else
                GAS unsigned long long* h8 = (GAS unsigned long long*)(H2 + (size_t)(t + q) * D) + L;
#pragma unroll
                for (int j = 0; j < 4; ++j) { const f32x4 a = *(const LAS f32x4*)(pg2 + b * D + 4 * L + 256 * j), c = *(const LAS f32x4*)(shf + b * D + 4 * L + 256 * j);
                    const f32x4 h = xv[q][j] * r2 * a + c;
                    h8[64 * j] = (unsigned long long)pk2(h.x, h.y) | ((unsigned long long)pk2(h.z, h.w) << 32);
                    *(LAS f32x4*)(h2t + (2 * wv + q) * D + 4 * L + 256 * j) = h; } }
#endif
        }
        __syncthreads();
        {
            const int hi = (L >> 5) & 1, h2b = (L >> 4) & 1;
#pragma unroll 2
            for (int tk = 0; tk < 16; ++tk) {
                f32x4 a = {0.f, 0.f, 0.f, 0.f};
#pragma unroll
                for (int j = 0; j < 4; ++j) { const f32x4 h = *(const LAS f32x4*)(h2t + tk * D + 4 * L + 256 * j);
                    a += wreg[j * 4 + 0] * h.x; a += wreg[j * 4 + 1] * h.y; a += wreg[j * 4 + 2] * h.z; a += wreg[j * 4 + 3] * h.w; }
                const float m0 = hi ? a.z : a.x, o0 = hi ? a.x : a.z, m1 = hi ? a.w : a.y, o1 = hi ? a.y : a.w;
                const float v0 = m0 + __shfl_xor(o0, 32), v1 = m1 + __shfl_xor(o1, 32);
                float v = (h2b ? v1 : v0) + __shfl_xor(h2b ? v0 : v1, 16);
                v += __shfl_xor(v, 8); v += __shfl_xor(v, 4); v += __shfl_xor(v, 2); v += __shfl_xor(v, 1);
                if ((L & 15) == 0) lg[tk * NE + 4 * wv + 2 * hi + h2b] = v;
            }
        }
        __syncthreads();
        {
            const int e = L & 31, half = L >> 5, tl = 2 * wv + half, t = t0 + tl;
            float val = lg[tl * NE + e] + par[PAR_RB + e];
            int se[4]; float sv[4];
#pragma unroll
            for (int r = 0; r < 4; ++r) { float mx = val;
                mx = fmaxf(mx, __shfl_xor(mx, 16)); mx = fmaxf(mx, __shfl_xor(mx, 8)); mx = fmaxf(mx, __shfl_xor(mx, 4)); mx = fmaxf(mx, __shfl_xor(mx, 2)); mx = fmaxf(mx, __shfl_xor(mx, 1));
                const unsigned long long bal = __ballot(val == mx); const unsigned hm = half ? (unsigned)(bal >> 32) : (unsigned)bal; const int win = __ffs((int)hm) - 1;
                se[r] = win; sv[r] = mx; if (e == win) val = -3e38f; }
            const float e1 = __expf(sv[1] - sv[0]), e2 = __expf(sv[2] - sv[0]), e3 = __expf(sv[3] - sv[0]), inv = 1.f / (1.f + e1 + e2 + e3);
            if (e < 4) { const int ex = e == 0 ? se[0] : (e == 1 ? se[1] : (e == 2 ? se[2] : se[3]));
                const float wgt = (e == 0 ? 1.f : (e == 1 ? e1 : (e == 2 ? e2 : e3))) * inv;
                tok_e[t * 4 + e] = ex; tok_w[t * 4 + e] = wgt;
                const unsigned lp = dry ? 0u : __hip_atomic_fetch_add(hist + ex, 1u, __ATOMIC_RELAXED, __HIP_MEMORY_SCOPE_WORKGROUP);
                rec_e[tl * 4 + e] = ex; rec_lp[tl * 4 + e] = (int)lp; }
        }
        __syncthreads();
        if (F.tid < 32) { const unsigned h = hist[F.tid]; base[F.tid] = h ? __hip_atomic_fetch_add(gcnt + F.tid, h, RLX_AGENT) : 0u; }
        __syncthreads();
        if (!dry && F.tid < 64) { const int e_ = rec_e[F.tid], pos_ = (int)base[e_] + rec_lp[F.tid]; tok_pos[(t0 + (F.tid >> 2)) * 4 + (F.tid & 3)] = pos_;
            WSP(int, WS_ELIST)[e_ * ELCAP + pos_] = t0 + (F.tid >> 2); }
        if (F.tid < 32) hist[F.tid] = 0u;
        __syncthreads();
    }
}

__device__ __forceinline__ void moe_tables(Frame& F) {
    LAS int* cnt = (LAS int*)(F.lds + SCR_OFF); LAS int* off = cnt + 32; LAS int* tpre = off + 32;
    if (F.tid < NE) cnt[F.tid] = (int)__hip_atomic_load(F.ctl + CW_ECNT + F.tid, RLX_AGENT);
    __syncthreads();
    if (F.tid == 0) { int o = 0, tp = 0;
        for (int e = 0; e < NE; ++e) { const int c = cnt[e]; off[e] = o; tpre[e] = tp; o += c; tp += (c + 255) >> 8; }
        tpre[NE] = tp;
        LAS int* sg = cnt + MT_SEG; const int n = (tp + 31) >> 5; int ns = 0, pos = 0;
        for (int g = 0; g < n; ++g) { const int tg = (tp - 32 * g) < 32 ? (tp - 32 * g) : 32;
            sg[1 + ns] = pos; sg[1 + MT_MAXSEG + ns] = 0; sg[1 + 2 * MT_MAXSEG + ns] = g; ++ns; pos += 8 * tg; sg[1 + 3 * MT_MAXSEG + g] = pos;
            if (g >= MOE_LAG) { sg[1 + ns] = pos; sg[1 + MT_MAXSEG + ns] = 1; sg[1 + 2 * MT_MAXSEG + ns] = g - MOE_LAG; ++ns; pos += 4 * 32; } }
        for (int g = (n > MOE_LAG ? n - MOE_LAG : 0); g < n; ++g) { const int tg = (tp - 32 * g) < 32 ? (tp - 32 * g) : 32; sg[1 + ns] = pos; sg[1 + MT_MAXSEG + ns] = 1; sg[1 + 2 * MT_MAXSEG + ns] = g; ++ns; pos += 4 * tg; }
        sg[1 + ns] = pos; sg[0] = ns; }
    __syncthreads();
}
template <bool GA> struct MoeOrder {
    static constexpr bool GATHER = GA;
#if defined(T_ACQ)
    __device__ __forceinline__ void a_ready(const pg8::Unit&) const { if (!GA) { if (threadIdx.x < 64) { __builtin_amdgcn_fence(__ATOMIC_ACQUIRE, "agent"); asm volatile("s_waitcnt vmcnt(0)" ::: "memory"); } asm volatile("" ::: "memory"); __builtin_amdgcn_s_barrier(); asm volatile("" ::: "memory"); } }
#else
    __device__ __forceinline__ void a_ready(const pg8::Unit&) const {}
#endif
#if defined(T_DRAIN)
    __device__ __forceinline__ void done(const pg8::Unit&) const { if (GA) asm volatile("s_waitcnt vmcnt(0)" ::: "memory"); }
#else
    __device__ __forceinline__ void done(const pg8::Unit&) const {}
#endif
    const LAS int* tab; const int* elist; int nct, brows, G, c;
    __device__ __forceinline__ bool next(int i, pg8::Unit& u) const {
        int rtg, pn;
        if (G == 256) { const int xcd = c & 7, slot = c >> 3, rpx = 32 / nct;
            rtg = (i * 8 + xcd) * rpx + slot / nct; pn = slot % nct; if (rtg >= tab[64 + NE]) return false; }
        else { const int L = i * G + c, total = tab[64 + NE] * nct; if (L >= total) return false; rtg = L / nct; pn = L % nct; }
        int e = 0;
        for (int k = 1; k < NE; ++k) if (tab[64 + k] <= rtg) e = k;
        const int rt = rtg - tab[64 + e], cnt = tab[e], off = tab[32 + e];
        u.e = __builtin_amdgcn_readfirstlane(e); u.pm = __builtin_amdgcn_readfirstlane(rt); u.pn = pn; u.arow = __builtin_amdgcn_readfirstlane(off + rt * 256); u.brow = __builtin_amdgcn_readfirstlane(e * brows + pn * 256);
        const int nr = cnt - rt * 256; u.nrow = __builtin_amdgcn_readfirstlane(nr > 256 ? 256 : nr); u.kind = 0; u.aux = 0; return true;
    }
    __device__ __forceinline__ int arow_of(const pg8::Unit& u, int r) const { return r < u.nrow ? elist[u.e * ELCAP + u.pm * 256 + r] : 0; }
};
struct EpiGU { bf16* H1; const float* bg; const float* bu;
    __device__ __forceinline__ void operator()(const pg8::f32x4 (&acc)[2][2][4][2], const pg8::Unit& u, int wr, int wc, int fr, int fq) const {
        asm volatile("" : "+v"(fr), "+v"(fq));
        const int f0 = u.pn * 128 + wc * 32 + 8 * fq;
#pragma unroll
        for (int ai = 0; ai < 2; ++ai) {
            int fb = f0; asm volatile("" : "+v"(fb));
            const pg8::f32x4 g0 = *(const pg8::f32x4*)(bg + u.e * FF + fb), g1 = *(const pg8::f32x4*)(bg + u.e * FF + fb + 4);
            const pg8::f32x4 u0 = *(const pg8::f32x4*)(bu + u.e * FF + fb), u1 = *(const pg8::f32x4*)(bu + u.e * FF + fb + 4);
#pragma unroll
            for (int m = 0; m < 4; ++m) { const int r = ai * 128 + wr * 64 + m * 16 + fr;
                const pg8::f32x4 a0 = acc[ai][0][m][0] + g0, a1 = acc[ai][0][m][1] + g1, b0 = acc[ai][1][m][0] + u0, b1 = acc[ai][1][m][1] + u1;
                float gg[8] = {a0[0], a0[1], a0[2], a0[3], a1[0], a1[1], a1[2], a1[3]}, uu[8] = {b0[0], b0[1], b0[2], b0[3], b1[0], b1[1], b1[2], b1[3]}, o[8];
#pragma unroll
                for (int i = 0; i < 8; ++i) { const float g = fminf(gg[i], 7.f), up = fminf(fmaxf(uu[i], -7.f), 7.f); o[i] = g * sigmoidf_(1.702f * g) * (up + 1.f); }
                v4u w; w.x = pk2(o[0], o[1]); w.y = pk2(o[2], o[3]); w.z = pk2(o[4], o[5]); w.w = pk2(o[6], o[7]);
#ifdef T_SC1
                if (r < u.nrow) __builtin_amdgcn_raw_buffer_store_b128(w, __builtin_amdgcn_make_buffer_rsrc(H1, 0, (int)((size_t)T * TOPK * FF * 2), 0x00020000), (unsigned)((u.arow + r) * (FF * 2) + fb * 2), 0, 16); } }
#else
                if (r < u.nrow) *(v4u*)(H1 + (size_t)(u.arow + r) * FF + fb) = w; } }
#endif
    }
};
struct EpiDn { bf16* YB; const float* bd;
    __device__ __forceinline__ void operator()(const pg8::f32x4 (&acc)[2][2][4][2], const pg8::Unit& u, int wr, int wc, int fr, int fq) const {
        const int c0 = u.pn * 256 + wc * 32 + 8 * fq;
#pragma unroll
        for (int bj = 0; bj < 2; ++bj) { const pg8::f32x4 d0 = *(const pg8::f32x4*)(bd + u.e * D + c0 + bj * 128), d1 = *(const pg8::f32x4*)(bd + u.e * D + c0 + bj * 128 + 4);
#pragma unroll
            for (int ai = 0; ai < 2; ++ai)
#pragma unroll
                for (int m = 0; m < 4; ++m) { const int r = ai * 128 + wr * 64 + m * 16 + fr;
                    const pg8::f32x4 a0 = acc[ai][bj][m][0] + d0, a1 = acc[ai][bj][m][1] + d1;
                    v4u w; w.x = pk2(a0[0], a0[1]); w.y = pk2(a0[2], a0[3]); w.z = pk2(a1[0], a1[1]); w.w = pk2(a1[2], a1[3]);
                    if (r < u.nrow) *(v4u*)(YB + (size_t)(u.arow + r) * D + c0 + bj * 128) = w; } }
    }
};
struct EpiGU8 { unsigned char* H1; const float* bg; const float* bu; const float* wscp;
    __device__ __forceinline__ void operator()(const pg8::f32x4 (&acc)[2][2][4][2], const pg8::Unit& u, int wr, int wc, int fr, int fq) const {
        asm volatile("" : "+v"(fr), "+v"(fq));
        const int f0 = u.pn * 128 + wc * 32 + 8 * fq; const float sr = 0.125f / *wscp;
#pragma unroll
        for (int ai = 0; ai < 2; ++ai) {
            int fb = f0; asm volatile("" : "+v"(fb));
            const pg8::f32x4 g0 = *(const pg8::f32x4*)(bg + u.e * FF + fb), g1 = *(const pg8::f32x4*)(bg + u.e * FF + fb + 4);
            const pg8::f32x4 u0 = *(const pg8::f32x4*)(bu + u.e * FF + fb), u1 = *(const pg8::f32x4*)(bu + u.e * FF + fb + 4);
#pragma unroll
            for (int m = 0; m < 4; ++m) { const int r = ai * 128 + wr * 64 + m * 16 + fr;
                const pg8::f32x4 a0 = acc[ai][0][m][0] * sr + g0, a1 = acc[ai][0][m][1] * sr + g1, b0 = acc[ai][1][m][0] * sr + u0, b1 = acc[ai][1][m][1] * sr + u1;
                float gg[8] = {a0[0], a0[1], a0[2], a0[3], a1[0], a1[1], a1[2], a1[3]}, uu[8] = {b0[0], b0[1], b0[2], b0[3], b1[0], b1[1], b1[2], b1[3]}, o[8];
#pragma unroll
                for (int i = 0; i < 8; ++i) { const float g = fminf(gg[i], 7.f), up = fminf(fmaxf(uu[i], -7.f), 7.f); o[i] = 8.f * (g * sigmoidf_(1.702f * g) * (up + 1.f)); }
                v2u w; w.x = pk4_fp8(o[0], o[1], o[2], o[3]); w.y = pk4_fp8(o[4], o[5], o[6], o[7]);
                if (r < u.nrow) *(v2u*)(H1 + (size_t)(u.arow + r) * FF + fb) = w; } }
    }
};
struct EpiDn8 { bf16* YB; const float* bd; const float* wscp;
    __device__ __forceinline__ void operator()(const pg8::f32x4 (&acc)[2][2][4][2], const pg8::Unit& u, int wr, int wc, int fr, int fq) const {
        const int c0 = u.pn * 256 + wc * 32 + 8 * fq; const float sc = 0.125f / *wscp;
#pragma unroll
        for (int bj = 0; bj < 2; ++bj) { const pg8::f32x4 d0 = *(const pg8::f32x4*)(bd + u.e * D + c0 + bj * 128), d1 = *(const pg8::f32x4*)(bd + u.e * D + c0 + bj * 128 + 4);
#pragma unroll
            for (int ai = 0; ai < 2; ++ai)
#pragma unroll
                for (int m = 0; m < 4; ++m) { const int r = ai * 128 + wr * 64 + m * 16 + fr;
                    const pg8::f32x4 a0 = acc[ai][bj][m][0] * sc + d0, a1 = acc[ai][bj][m][1] * sc + d1;
                    v4u w; w.x = pk2(a0[0], a0[1]); w.y = pk2(a0[2], a0[3]); w.z = pk2(a1[0], a1[1]); w.w = pk2(a1[2], a1[3]);
                    if (r < u.nrow) *(v4u*)(YB + (size_t)(u.arow + r) * D + c0 + bj * 128) = w; } }
    }
};
constexpr int CW_RDY = 8448;
constexpr int H2ROW0 = (int)(WS_H2 / 2048), H1ROW0 = (int)(WS_H1 / 2048), DN_BROW0 = (int)((WS_WDN_T - WS_WGU_T) / 2048);
struct MoeFused {
    static constexpr bool GATHER = true;
    const LAS int* tab; const int* elist; gu32* ctl; int G, c, base;
    __device__ __forceinline__ bool next(int i, pg8::Unit& u) const {
        const LAS int* sg = tab + MT_SEG; const int ns = sg[0], L = (base + i) * G + c; if (L >= sg[1 + ns]) return false;
        int s = 0; for (int k = 1; k < ns; ++k) if (sg[1 + k] <= L) s = k;
        if (i > 0 && sg[1 + MT_MAXSEG + s] == 1 && L - sg[1 + 3 * MT_MAXSEG + sg[1 + 2 * MT_MAXSEG + s]] < G) return false;
        const int kind = sg[1 + MT_MAXSEG + s], g = sg[1 + 2 * MT_MAXSEG + s], ui = L - sg[1 + s], TT = tab[64 + NE], tg = (TT - 32 * g) < 32 ? (TT - 32 * g) : 32;
        int rt, pn;
        if (kind == 0) { if (tg == 32) { const int xcd = ui & 7, slot = ui >> 3; rt = xcd * 4 + (slot >> 3); pn = slot & 7; } else { rt = ui >> 3; pn = ui & 7; } }
        else { if (tg == 32) { const int xcd = ui & 7, slot = ui >> 3; rt = xcd * 4 + (slot >> 2); pn = slot & 3; } else { rt = ui >> 2; pn = ui & 3; } }
        const int rtg = 32 * g + rt; int e = 0;
        for (int k = 1; k < NE; ++k) if (tab[64 + k] <= rtg) e = k;
        const int rte = rtg - tab[64 + e], cnt = tab[e], off = tab[32 + e], nr = cnt - rte * 256;
        u.e = __builtin_amdgcn_readfirstlane(e); u.pm = __builtin_amdgcn_readfirstlane(rte); u.pn = __builtin_amdgcn_readfirstlane(pn); u.kind = __builtin_amdgcn_readfirstlane(kind); u.aux = __builtin_amdgcn_readfirstlane(rtg);
        u.arow = __builtin_amdgcn_readfirstlane(off + rte * 256); u.nrow = __builtin_amdgcn_readfirstlane(nr > 256 ? 256 : nr);
        u.brow = __builtin_amdgcn_readfirstlane(kind == 0 ? e * 2048 + pn * 256 : DN_BROW0 + e * 1024 + pn * 256); return true;
    }
    __device__ __forceinline__ int arow_of(const pg8::Unit& u, int r) const { return u.kind == 0 ? H2ROW0 + (r < u.nrow ? elist[u.e * ELCAP + u.pm * 256 + r] : 0) : H1ROW0 + u.arow + (r < u.nrow ? r : 0); }
    __device__ __forceinline__ void a_ready(const pg8::Unit& u) const {
        if (u.kind != 1) return;
        if (threadIdx.x < 64) {
            gu32* w = ctl + CW_RDY + u.aux; const unsigned long long t0 = __builtin_amdgcn_s_memrealtime();
            while ((unsigned)__builtin_amdgcn_readfirstlane(__hip_atomic_load(w, RLX_AGENT)) < 64u) {
                if (__builtin_amdgcn_s_memrealtime() - t0 > 2000000ull) { if (threadIdx.x == 0) __hip_atomic_store(ctl + CW_TMO, 1u, RLX_AGENT); break; }
                __builtin_amdgcn_s_sleep(2); }
#ifdef MOE_DELAY
            { const unsigned long long t1 = __builtin_amdgcn_s_memrealtime(); while (__builtin_amdgcn_s_memrealtime() - t1 < 2000ull) __builtin_amdgcn_s_sleep(8); }
#endif
            __builtin_amdgcn_fence(__ATOMIC_ACQUIRE, "agent");
            asm volatile("s_waitcnt vmcnt(0)" ::: "memory");
        }
        asm volatile("" ::: "memory"); __builtin_amdgcn_s_barrier(); asm volatile("" ::: "memory");
    }
    __device__ __forceinline__ void done(const pg8::Unit& u) const {
        if (u.kind != 0) return;
#ifndef DIAG_NODRAIN
        asm volatile("s_waitcnt vmcnt(0)" ::: "memory");
#endif
#if defined(MOE_REL)
        __builtin_amdgcn_fence(__ATOMIC_RELEASE, "agent"); asm volatile("s_waitcnt vmcnt(0)" ::: "memory");
#endif
        if ((threadIdx.x & 63) == 0) __hip_atomic_fetch_add(ctl + CW_RDY + u.aux, 1u, RLX_AGENT);
    }
};
struct EpiMoe { bf16* H1; bf16* YB; const float* bg; const float* bu; const float* bd;
    __device__ __forceinline__ void operator()(const pg8::f32x4 (&acc)[2][2][4][2], const pg8::Unit& u, int wr, int wc, int fr, int fq) const {
        asm volatile("" : "+v"(fr), "+v"(fq));
        if (u.kind == 0) {
            const int f0 = u.pn * 128 + wc * 32 + 8 * fq;
            const __amdgpu_buffer_rsrc_t h1rs = __builtin_amdgcn_make_buffer_rsrc(H1, 0, (int)((size_t)T * TOPK * FF * 2), 0x00020000);
#pragma unroll
            for (int ai = 0; ai < 2; ++ai) {
                int fb = f0; asm volatile("" : "+v"(fb));
                const pg8::f32x4 g0 = *(const pg8::f32x4*)(bg + u.e * FF + fb), g1 = *(const pg8::f32x4*)(bg + u.e * FF + fb + 4);
                const pg8::f32x4 u0 = *(const pg8::f32x4*)(bu + u.e * FF + fb), u1 = *(const pg8::f32x4*)(bu + u.e * FF + fb + 4);
#pragma unroll
                for (int m = 0; m < 4; ++m) { const int r = ai * 128 + wr * 64 + m * 16 + fr;
                    const pg8::f32x4 a0 = acc[ai][0][m][0] + g0, a1 = acc[ai][0][m][1] + g1, b0 = acc[ai][1][m][0] + u0, b1 = acc[ai][1][m][1] + u1;
                    float gg[8] = {a0[0], a0[1], a0[2], a0[3], a1[0], a1[1], a1[2], a1[3]}, uu[8] = {b0[0], b0[1], b0[2], b0[3], b1[0], b1[1], b1[2], b1[3]}, o[8];
#pragma unroll
                    for (int i = 0; i < 8; ++i) { const float g = fminf(gg[i], 7.f), up = fminf(fmaxf(uu[i], -7.f), 7.f); o[i] = g * sigmoidf_(1.702f * g) * (up + 1.f); }
#ifdef MOE_PLAIN
                    if (r < u.nrow) { v4u w; w.x = pk2(o[0], o[1]); w.y = pk2(o[2], o[3]); w.z = pk2(o[4], o[5]); w.w = pk2(o[6], o[7]); *(GAS v4u*)(H1 + (size_t)(u.arow + r) * FF + fb) = w; } } }
#else
                    if (r < u.nrow) { v4u w; w.x = pk2(o[0], o[1]); w.y = pk2(o[2], o[3]); w.z = pk2(o[4], o[5]); w.w = pk2(o[6], o[7]);
                        __builtin_amdgcn_raw_buffer_store_b128(w, h1rs, (unsigned)((u.arow + r) * (FF * 2) + fb * 2), 0, 16); } } }
#endif
        } else {
            const int c0 = u.pn * 256 + wc * 32 + 8 * fq;
#pragma unroll
            for (int bj = 0; bj < 2; ++bj) { const pg8::f32x4 d0 = *(const pg8::f32x4*)(bd + u.e * D + c0 + bj * 128), d1 = *(const pg8::f32x4*)(bd + u.e * D + c0 + bj * 128 + 4);
#pragma unroll
                for (int ai = 0; ai < 2; ++ai)
#pragma unroll
                    for (int m = 0; m < 4; ++m) { const int r = ai * 128 + wr * 64 + m * 16 + fr;
                        const pg8::f32x4 a0 = acc[ai][bj][m][0] + d0, a1 = acc[ai][bj][m][1] + d1;
                        v4u w; w.x = pk2(a0[0], a0[1]); w.y = pk2(a0[2], a0[3]); w.z = pk2(a1[0], a1[1]); w.w = pk2(a1[2], a1[3]);
                        if (r < u.nrow) *(GAS v4u*)(YB + (size_t)(u.arow + r) * D + c0 + bj * 128) = w; } }
        }
    }
};
__device__ __forceinline__ void phase_final(Frame& F, bool dry = false) {
    moe_tables(F);
    const LAS int* off = (const LAS int*)(F.lds + SCR_OFF) + 32;
    LAS float* gtf = (LAS float*)(F.lds);
    const float* adaf = WSP(float, WS_ADAF);
    for (int i = F.tid; i < 2 * D; i += NWAVES * 64) { const int b = i >> 10, k = i & (D - 1); gtf[i] = adaf[b * 6 * D + 5 * D + k] * WSP(float, WS_PAR)[PAR_FPOST + k]; }
    __syncthreads();
    const int gw = F.vcu * NWAVES + F.wave, NGW = F.G * NWAVES, L = F.lane;
    const int* tok_e = WSP(int, WS_ROUTE); const float* tok_w = (const float*)(tok_e + T * 4); const int* tok_pos = tok_e + 2 * T * 4;
    const bf16* YB = WSP(bf16, WS_YB);
    for (int t = gw * 2; t < T; t += NGW * 2) { const int b = t >> 13;
        int row_l = 0; float w_l = 0.f;
        if (L < 8) { const int idx = (t + (L >> 2)) * 4 + (L & 3); row_l = off[tok_e[idx]] + tok_pos[idx]; w_l = tok_w[idx]; }
        v2u yv[2][4][4]; f32x4 x1v[2][4]; float wk[2][4];
#pragma unroll
        for (int q = 0; q < 2; ++q) {
#pragma unroll
            for (int k = 0; k < 4; ++k) { const int row = __shfl(row_l, q * 4 + k); wk[q][k] = __shfl(w_l, q * 4 + k);
                const GAS v2u* yr = (const GAS v2u*)(YB + (size_t)row * D) + L;
#pragma unroll
                for (int j = 0; j < 4; ++j) yv[q][k][j] = __builtin_nontemporal_load(yr + 64 * j);
#ifdef DRY14_NOYB
                if (dry) { _Pragma("unroll") for (int j = 0; j < 4; ++j) yv[q][k][j] = (v2u){0x3f803f80u, 0x3f803f80u}; }
#endif
            }
            const GAS f32x4* xr = (const GAS f32x4*)(F.out + (size_t)(t + q) * D) + L;
#pragma unroll
            for (int j = 0; j < 4; ++j) x1v[q][j] = __builtin_nontemporal_load(xr + 64 * j); }
#pragma unroll
        for (int q = 0; q < 2; ++q) {
            f32x4 y[4];
#pragma unroll
            for (int j = 0; j < 4; ++j) y[j] = (f32x4){0.f, 0.f, 0.f, 0.f};
#pragma unroll
            for (int k = 0; k < 4; ++k)
#pragma unroll
                for (int j = 0; j < 4; ++j) { const v2u x = yv[q][k][j]; const float w = wk[q][k]; y[j].x += w * bflo(x.x); y[j].y += w * bfhi(x.x); y[j].z += w * bflo(x.y); y[j].w += w * bfhi(x.y); }
            float s = 0.f;
#pragma unroll
            for (int j = 0; j < 4; ++j) s += (y[j].x * y[j].x + y[j].y * y[j].y) + (y[j].z * y[j].z + y[j].w * y[j].w);
            const float r = 1.f / sqrtf(wave_sum(s) * (1.f / D) + NORM_EPS);
            GAS f32x4* wrow = dry ? (GAS f32x4*)(WSP(float, WS_WGU_T) + (size_t)(t + q) * D) + L : (GAS f32x4*)(F.out + (size_t)(t + q) * D) + L;
#pragma unroll
            for (int j = 0; j < 4; ++j) { const f32x4 g = *(const LAS f32x4*)(gtf + b * D + 4 * L + 256 * j); __builtin_nontemporal_store(x1v[q][j] + g * (y[j] * r), wrow + 64 * j); }
        }
    }
}
__device__ __forceinline__ bool opaque_ws(Frame& F) { asm volatile("" : "+s"(F.ws)); return true; }
#ifndef MK_N_LAUNCHES
#define MK_N_LAUNCHES 1
#endif
constexpr int N_PHASES = 15;
struct Args { const float* in[30]; float* out; unsigned char* ws; int ph_lo, ph_hi; };
__global__ void __launch_bounds__(NWAVES * 64, 2) mega_fwd(Args args) {
    extern __shared__ __attribute__((aligned(16))) unsigned char lds[];
    Frame F;
    F.lds = (LAS unsigned char*)lds;
    F.MISC = (volatile LAS unsigned*)(F.lds + MISC_OFF);
    F.tid = threadIdx.x; F.lane = F.tid & 63; F.wave = __builtin_amdgcn_readfirstlane(F.tid >> 6);
    F.G = gridDim.x; { const int bx = blockIdx.x; F.vcu = (F.G % 8 == 0) ? (bx % 8) * (F.G / 8) + bx / 8 : bx; }
    F.ws = args.ws; F.ctl = (gu32*)(args.ws + WS_CTL); F.out = args.out;
#pragma unroll
    for (int i = 0; i < 30; ++i) F.in[i] = args.in[i];
    for (int u = F.tid; u < (LDS_BYTES - LDSCTL_OFF) / 4; u += NWAVES * 64) ((LAS unsigned*)(F.lds + LDSCTL_OFF))[u] = 0u;
    __syncthreads();
    XcdBarrier bar; bar.bar = (unsigned*)(F.ctl + CW_BAR); bar.x = 0; bar.st = nullptr;
    if (MK_N_LAUNCHES == 1) bar = xcd_barrier_post((unsigned*)(F.ctl + CW_BAR), F.MISC + 8);
    const int lo = args.ph_lo, hi = args.ph_hi;
#ifndef PHMASK
#define PHMASK 0x7fff
#endif
#define IN(k) (((PHMASK >> (k)) & 1) && lo <= (k) && (k) < hi)
#ifdef DBG_A
#define STAMP(k) do { if (blockIdx.x == 0 && F.tid == 0) ((unsigned long long*)(F.ctl + 2048))[k] = __builtin_amdgcn_s_memrealtime(); } while (0)
#else
#define STAMP(k) do {} while (0)
#endif
#ifndef REP_PHASE
#define REP_PHASE -1
#endif
#define REPL(k) for (int rep_ = 0; rep_ < (REP_PHASE == (k) ? 2 : 1); ++rep_) if (opaque_ws(F))
#ifdef DBL_BAR
#define SEAM(k) do { if (IN(k)) { xcd_barrier(bar); xcd_barrier(bar); } STAMP((k) + 1); } while (0)
#else
#define SEAM(k) do { if (IN(k)) xcd_barrier(bar); STAMP((k) + 1); } while (0)
#endif
    PG8_LAS unsigned char* ring = F.lds + RING_OFF;
    const int bx = (int)blockIdx.x;

    STAMP(0);
    if (IN(0)) REPL(0) { phase0(F); } SEAM(0);
    if (IN(1)) REPL(1) { phase1(F); } SEAM(1);
    if (IN(2)) REPL(2) {
        pg8::Gemm g{WSP(bf16, WS_XN), WSP(bf16, WS_WIN_T), D, D, D}; pg8::DenseOrder S; S.init(T, INW, F.G, bx);
        EpiG1 E{WSP(bf16, WS_UA), WSP(bf16, WS_Q), WSP(bf16, WS_K), WSP(bf16, WS_V), WSP(bf16, WS_VT), WSP(bf16, WS_GS), WSP(bf16, WS_GA),
                WSP(float, WS_ROPE), WSP(float, WS_ROPE) + (size_t)T * 32, (float*)(F.ctl + CW_KM)};
        pg8::gemm_phase(ring, g, S, E);
        s5_fill_kt(F);
    } SEAM(2);
    if (IN(3)) REPL(3) {
        pg8::Gemm g{WSP(bf16, WS_UA), WSP(bf16, WS_S5M1), 384, 256, 256}; S5Order S{F.G, bx}; EpiS5A E{WSP(float, WS_S5E)};
        pg8::gemm_phase(ring, g, S, E);
        s5_fill_wc(F);
        attn_gate(F);
    } SEAM(3);
    if (IN(4)) REPL(4) { attn_items(F); s5_carry(F); } SEAM(4);
    if (IN(5)) REPL(5) {
        pg8::Gemm g{WSP(bf16, WS_UA), WSP(bf16, WS_S5WC), 384, 384, 384}; S5Order S{F.G, bx}; EpiS5C E{WSP(bf16, WS_YG)};
        pg8::gemm_phase(ring, g, S, E);
        attn_combine(F);
    } SEAM(5);
    if (IN(6)) REPL(6) {
        pg8::Gemm g{WSP(bf16, WS_YG), WSP(bf16, WS_WGLU_T), SW, SW, SW}; pg8::DenseOrder S; S.init(T, SW, F.G, bx);
        EpiEw<0> E{WSP(bf16, WS_Y2), WSP(bf16, WS_YG), nullptr, nullptr, SW};
        pg8::gemm_phase(ring, g, S, E);
    } SEAM(6);
    if (IN(7)) REPL(7) {
        pg8::Gemm g{WSP(bf16, WS_Y2), WSP(bf16, WS_WSB_T), SW, SW, SW}; pg8::DenseOrder S; S.init(T, D, F.G, bx);
        EpiEw<1> E{WSP(bf16, WS_M1), WSP(bf16, WS_GS), nullptr, nullptr, D};
        pg8::gemm_phase(ring, g, S, E);
    } SEAM(7);
    if (IN(8)) REPL(8) {
        pg8::Gemm g{WSP(bf16, WS_YA), WSP(bf16, WS_WAB_T), AW, AW, AW}; pg8::DenseOrder S; S.init(T, D, F.G, bx);
        EpiEw<2> E{WSP(bf16, WS_XN), WSP(bf16, WS_GA), WSP(bf16, WS_M1), nullptr, D};
        pg8::gemm_phase(ring, g, S, E);
    } SEAM(8);
    if (IN(9)) REPL(9) {
        pg8::Gemm g{WSP(bf16, WS_XN), WSP(bf16, WS_WOUT_T), D, D, D}; pg8::DenseOrder S; S.init(T, D, F.G, bx);
        EpiEw<3> E{nullptr, nullptr, nullptr, WSP(float, WS_MIX), D};
        pg8::gemm_phase(ring, g, S, E);
    } SEAM(9);
    if (IN(10)) REPL(10) { phase_rows(F, REP_PHASE == 10 && rep_ == 0); } SEAM(10);
#ifndef MOE_FUSED
#ifdef MOE_F8
    if (IN(12)) REPL(12) {
        moe_tables(F);
        pg8::Gemm g{WSP(bf16, WS_H2), WSP(bf16, WS_WGU_T), D / 2, D / 2, D / 2}; MoeOrder<true> S{(const LAS int*)(F.lds + SCR_OFF), WSP(int, WS_ELIST), 8, 2048, F.G, bx};
        EpiGU8 E{WSP(unsigned char, WS_H1), WSP(float, WS_PAR) + PAR_BG, WSP(float, WS_PAR) + PAR_BU, WSP(float, WS_PAR) + PAR_WSC};
        pg8::gemm_phase<EpiGU8, MoeOrder<true>, true>(ring, g, S, E);
    } SEAM(12);
    if (IN(13)) REPL(13) {
        moe_tables(F);
        pg8::Gemm g{WSP(bf16, WS_H1), WSP(bf16, WS_WDN_T), FF / 2, FF / 2, FF / 2}; MoeOrder<false> S{(const LAS int*)(F.lds + SCR_OFF), nullptr, 4, 1024, F.G, bx};
        EpiDn8 E{WSP(bf16, WS_YB), WSP(float, WS_PAR) + PAR_BD, WSP(float, WS_PAR) + PAR_WSC};
        pg8::gemm_phase<EpiDn8, MoeOrder<false>, true>(ring, g, S, E);
    } SEAM(13);
#else
    if (IN(12)) REPL(12) {
        moe_tables(F);
        pg8::Gemm g{WSP(bf16, WS_H2), WSP(bf16, WS_WGU_T), D, D, D}; MoeOrder<true> S{(const LAS int*)(F.lds + SCR_OFF), WSP(int, WS_ELIST), 8, 2048, F.G, bx};
        EpiGU E{WSP(bf16, WS_H1), WSP(float, WS_PAR) + PAR_BG, WSP(float, WS_PAR) + PAR_BU};
        pg8::gemm_phase(ring, g, S, E);
    } SEAM(12);
    if (IN(13)) REPL(13) {
        moe_tables(F);
        pg8::Gemm g{WSP(bf16, WS_H1), WSP(bf16, WS_WDN_T), FF, FF, FF}; MoeOrder<false> S{(const LAS int*)(F.lds + SCR_OFF), nullptr, 4, 1024, F.G, bx};
        EpiDn E{WSP(bf16, WS_YB), WSP(float, WS_PAR) + PAR_BD};
        pg8::gemm_phase(ring, g, S, E);
    } SEAM(13);
#endif
#else
    if (IN(12)) REPL(12) {
        moe_tables(F);
        pg8::Gemm g{(const bf16*)F.ws, WSP(bf16, WS_WGU_T), D, D, D};
        EpiMoe E{WSP(bf16, WS_H1), WSP(bf16, WS_YB), WSP(float, WS_PAR) + PAR_BG, WSP(float, WS_PAR) + PAR_BU, WSP(float, WS_PAR) + PAR_BD};
        for (int base = 0;;) { MoeFused S{(const LAS int*)(F.lds + SCR_OFF), WSP(int, WS_ELIST), F.ctl, F.G, bx, base};
            const int nd = pg8::gemm_phase(ring, g, S, E); if (nd == 0) break; base += nd; }
    } SEAM(12);
#endif
    if (IN(14)) REPL(14) { phase_final(F, REP_PHASE == 14 && rep_ == 0); }
#undef IN
#undef SEAM
}

extern "C" void kernel_launch(void* const* d_in, const int* in_sizes, int n_in, void* d_out, int out_size, void* d_ws, size_t ws_size, hipStream_t stream) {
    static int grid = 0;
    if (grid == 0) {
        if (n_in != 30 || in_sizes[0] != T * D || out_size != T * D || ws_size < WS_END) { fprintf(stderr, "kernel_launch: unexpected shapes (n_in %d, in0 %d, out %d, ws %zu)\n", n_in, n_in > 0 ? in_sizes[0] : -1, out_size, ws_size); grid = -1; return; }
        int dev = 0, cus = 0, per_cu = 0;
        if (hipGetDevice(&dev) != hipSuccess || hipDeviceGetAttribute(&cus, hipDeviceAttributeMultiprocessorCount, dev) != hipSuccess) { grid = -1; return; }
        if (hipFuncSetAttribute((const void*)mega_fwd, hipFuncAttributeMaxDynamicSharedMemorySize, LDS_BYTES) != hipSuccess) { fprintf(stderr, "kernel_launch: hipFuncSetAttribute failed\n"); grid = -1; return; }
        if (hipOccupancyMaxActiveBlocksPerMultiprocessor(&per_cu, (const void*)mega_fwd, NWAVES * 64, LDS_BYTES) != hipSuccess || per_cu < 1) { fprintf(stderr, "kernel_launch: occupancy query says %d\n", per_cu); }
        (void)hipGetLastError();
        grid = cus;
    }
    if (grid < 0) return;
    (void)hipMemsetAsync((char*)d_ws + WS_CTL, 0, CTL_ZERO_USED, stream);
    Args a{};
    for (int i = 0; i < 30; ++i) a.in[i] = (const float*)d_in[i];
    a.out = (float*)d_out; a.ws = (unsigned char*)d_ws;
#ifndef PLAIN_LAUNCH
    if (MK_N_LAUNCHES == 1) { a.ph_lo = 0; a.ph_hi = N_PHASES; void* kargs[] = {(void*)&a};
        const hipError_t e = hipLaunchCooperativeKernel((const void*)mega_fwd, dim3(grid), dim3(NWAVES * 64), kargs, LDS_BYTES, stream);
        if (e != hipSuccess) fprintf(stderr, "kernel_launch: cooperative launch failed: %s\n", hipGetErrorString(e)); }
#else
    if (MK_N_LAUNCHES == 1) { a.ph_lo = 0; a.ph_hi = N_PHASES; hipLaunchKernelGGL(mega_fwd, dim3(grid), dim3(NWAVES * 64), LDS_BYTES, stream, a); }
#endif
    else for (int p = 0; p < N_PHASES; ++p) { a.ph_lo = p; a.ph_hi = p + 1; hipLaunchKernelGGL(mega_fwd, dim3(grid), dim3(NWAVES * 64), LDS_BYTES, stream, a); }
}
```

```cpp
#include <hip/hip_runtime.h>
#include <cstdio>
#include <cstdint>
#define MK_N_LAUNCHES 1
namespace pg8 {
#define PG8_LAS __attribute__((address_space(3)))
typedef unsigned short bf16_t;
typedef short bf16x8 __attribute__((ext_vector_type(8)));
typedef float f32x4 __attribute__((ext_vector_type(4)));
typedef unsigned u32x4 __attribute__((ext_vector_type(4)));
typedef unsigned u32x2 __attribute__((ext_vector_type(2)));
typedef int v4i32 __attribute__((ext_vector_type(4)));
typedef int v8i32 __attribute__((ext_vector_type(8)));
constexpr int BIAS_LDS_OFF = 156 * 1024;
constexpr int BM = 256, BK = 64, HALF = 128, HTB = HALF * BK * 2  , STAGE_BYTES = 8 * HTB, NXCD = 8, WGM = 8;

__host__ __device__ __forceinline__ int lds_byte(int r, int c) { const int st = (r >> 4) * 2 + (c >> 5), rr = r & 15, cc = c & 31, ob = rr * 64 + cc * 2; return st * 1024 + (ob ^ (((ob >> 9) & 1) << 5)); }
__host__ __device__ __forceinline__ void stage_rc(int b, int& R, int& C) { const int st = b / 1024, sb = b % 1024, swz = sb ^ (((sb >> 9) & 1) << 5); R = (st >> 1) * 16 + swz / 64; C = (st & 1) * 32 + (swz % 64) / 2; }

struct Unit { int arow, brow, pm, pn, e, nrow, kind, aux; };
struct Gemm { const bf16_t* A; const bf16_t* Bt; int lda, ldb, K; };

struct DenseOrder {
    static constexpr bool GATHER = false;
    __device__ __forceinline__ void a_ready(const Unit&) const {}
    __device__ __forceinline__ void done(const Unit&) const {}
    int nM, nN, nwg, G, c;
    __device__ __forceinline__ void init(int M, int N, int G_, int c_) { nM = M / BM; nN = N / BM; nwg = nM * nN; G = G_; c = c_; }
    __device__ __forceinline__ bool next(int i, Unit& u) const {
        const long L = (long)i * G + c; if (L >= nwg) return false;
        int wgid = (int)L; { const int q = nwg / NXCD, r = nwg % NXCD, xcd = wgid % NXCD, off = wgid / NXCD; wgid = (xcd < r ? xcd * (q + 1) : r * (q + 1) + (xcd - r) * q) + off; }
        const int nig = WGM * nN, gid = wgid / nig, fm = gid * WGM, gsz = (nM - fm) < WGM ? (nM - fm) : WGM;
        u.pm = fm + ((wgid % nig) % gsz); u.pn = (wgid % nig) / gsz; u.arow = u.pm * BM; u.brow = u.pn * BM; u.e = 0; u.nrow = BM; u.kind = 0; u.aux = 0; return true;
    }
};

template <class T_> struct has_bias_lds { template <class U_> static constexpr bool get(decltype(U_::BIAS_LDS)*) { return U_::BIAS_LDS; } template <class U_> static constexpr bool get(...) { return false; } static constexpr bool value = get<T_>(nullptr); };
template <class Epi, class Sched, bool F8 = false>
__device__ __forceinline__ int gemm_phase(PG8_LAS unsigned char* lds, const Gemm g, const Sched& S, const Epi& E) {
    const int tid = threadIdx.x, wid = __builtin_amdgcn_readfirstlane(tid >> 6), lane = tid & 63, wr = wid >> 2, wc = wid & 3, fr = lane & 15, fq = lane >> 4;
    const int K = g.K, nt = K / BK;
    PG8_LAS unsigned char* biaslds = lds + BIAS_LDS_OFF;
    constexpr bool GA = Sched::GATHER;
    unsigned voffA[2], voffB[2]; int gR[2]; unsigned gC[2];
#pragma unroll
    for (int i = 0; i < 2; ++i) { int R, C; stage_rc(tid * 16 + i * 8192, R, C); gR[i] = R; gC[i] = (unsigned)C * 2u;
        voffA[i] = (unsigned)(R * g.lda + C) * 2u; voffB[i] = (unsigned)(R * g.ldb + C) * 2u; }
    unsigned gA_cur[2][2], gA_nxt[2][2];
#define PG8_GATH(dst, un) do { _Pragma("unroll") for (int _h = 0; _h < 2; ++_h) _Pragma("unroll") for (int _i = 0; _i < 2; ++_i) dst[_h][_i] = (unsigned)S.arow_of(un, _h * HALF + gR[_i]) * (unsigned)(g.lda * 2) + gC[_i]; } while (0)
#define PG8_STAGE_A(bufoff, h, kbytes, nx) do { if constexpr (GA) { const char* gb_ = (const char*)g.A + (kbytes); _Pragma("unroll") for (int _i = 0; _i < 2; ++_i) { const unsigned vo_ = (nx) ? gA_nxt[h][_i] : gA_cur[h][_i]; \
        __builtin_amdgcn_global_load_lds((const unsigned*)(gb_ + vo_), (PG8_LAS unsigned*)(lds + (bufoff) + ldsw + _i * 8192), 16, 0, 0); } } \
    else { const char* gb_ = ((nx) ? nA : cA) + (kbytes) + (h) * hstepA; PG8_STAGE(bufoff, gb_, voffA); } } while (0)
    const size_t kstep = (size_t)(BK * 2);
    const size_t hstepA = (size_t)HALF * g.lda * 2, hstepB = (size_t)HALF * g.ldb * 2;
    const size_t rowA = (size_t)g.lda * 2, rowB = (size_t)g.ldb * 2;
    const unsigned ldsw = (unsigned)wid * 1024u;
    const int aoff = lds_byte(wr * 64 + fr, fq * 8), boff = lds_byte(wc * 32 + fr, fq * 8);
#define PG8_SA(b, h) (((b) * 2 + (h)) * HTB)
#define PG8_SB(b, h) ((4 + (b) * 2 + (h)) * HTB)
#define PG8_STAGE(bufoff, gbase, voff) do { _Pragma("unroll") for (int _i = 0; _i < 2; ++_i) \
        __builtin_amdgcn_global_load_lds((const unsigned*)((const char*)(gbase) + (voff)[_i]), (PG8_LAS unsigned*)(lds + (bufoff) + ldsw + _i * 8192), 16, 0, 0); } while (0)
#define PG8_LDA(dst, b, h) do { _Pragma("unroll") for (int m = 0; m < 4; ++m) { if constexpr (F8) { const v4i32 lo_ = *(const PG8_LAS v4i32*)(lds + PG8_SA(b, h) + aoff + m * 2048), hi_ = *(const PG8_LAS v4i32*)(lds + PG8_SA(b, h) + aoff + m * 2048 + 1024); dst##8[m] = __builtin_shufflevector(lo_, hi_, 0, 1, 2, 3, 4, 5, 6, 7); } \
        else { _Pragma("unroll") for (int k = 0; k < 2; ++k) dst[m][k] = *(const PG8_LAS bf16x8*)(lds + PG8_SA(b, h) + aoff + m * 2048 + k * 1024); } } } while (0)
#define PG8_LDB(dst, b, h) do { _Pragma("unroll") for (int n = 0; n < 2; ++n) { if constexpr (F8) { const v4i32 lo_ = *(const PG8_LAS v4i32*)(lds + PG8_SB(b, h) + boff + n * 2048), hi_ = *(const PG8_LAS v4i32*)(lds + PG8_SB(b, h) + boff + n * 2048 + 1024); dst##8[n] = __builtin_shufflevector(lo_, hi_, 0, 1, 2, 3, 4, 5, 6, 7); } \
        else { _Pragma("unroll") for (int k = 0; k < 2; ++k) dst[n][k] = *(const PG8_LAS bf16x8*)(lds + PG8_SB(b, h) + boff + n * 2048 + k * 1024); } } } while (0)
#define PG8_MMA(ai, bj, At, Bt) do { __builtin_amdgcn_s_setprio(1); _Pragma("unroll") for (int m = 0; m < 4; ++m) _Pragma("unroll") for (int n = 0; n < 2; ++n) { \
        if constexpr (F8) { asm("v_mfma_scale_f32_16x16x128_f8f6f4 %0, %1, %2, %0, %3, %3 op_sel_hi:[0,0,0]" : "+v"(acc[ai][bj][m][n]) : "v"(Bt##8[n]), "v"(At##8[m]), "v"(one_scale)); } \
        else { _Pragma("unroll") for (int k = 0; k < 2; ++k) acc[ai][bj][m][n] = __builtin_amdgcn_mfma_f32_16x16x32_bf16(Bt[n][k], At[m][k], acc[ai][bj][m][n], 0, 0, 0); } } \
        __builtin_amdgcn_s_setprio(0); } while (0)
#define PG8_WAIT_V(n) asm volatile("s_waitcnt vmcnt(" #n ")" ::: "memory")
#define PG8_WAIT_L(n) asm volatile("s_waitcnt lgkmcnt(" #n ")" ::: "memory")
#define PG8_BAR __builtin_amdgcn_s_barrier()
#define PG8_SCHED __builtin_amdgcn_sched_barrier(0)
    Unit cur, nxt; int ui = 0;
    if (!S.next(0, cur)) return 0;
    f32x4 acc[2][2][4][2];
#pragma unroll
    for (int a = 0; a < 2; ++a)
#pragma unroll
        for (int b = 0; b < 2; ++b)
#pragma unroll
            for (int m = 0; m < 4; ++m)
#pragma unroll
                for (int n = 0; n < 2; ++n) acc[a][b][m][n] = (f32x4){0.f, 0.f, 0.f, 0.f};
    const int one_scale = 0x7f7f7f7f;
    bf16x8 At[4][2], B0[2][2], B1[2][2];
    v8i32 At8[4], B08[2], B18[2];
    const char* cA = GA ? (const char*)g.A : (const char*)g.A + (size_t)cur.arow * rowA; const char* cB = (const char*)g.Bt + (size_t)cur.brow * rowB; const char* nA = cA;
    if constexpr (GA) { PG8_GATH(gA_cur, cur); }
    S.a_ready(cur);
    PG8_STAGE(PG8_SB(0, 0), cB, voffB); PG8_STAGE(PG8_SB(0, 1), cB + hstepB, voffB); PG8_STAGE_A(PG8_SA(0, 0), 0, 0, false); PG8_STAGE_A(PG8_SA(0, 1), 1, 0, false);
    if (wr == 1) PG8_BAR;
    PG8_WAIT_V(2); PG8_BAR;
    PG8_STAGE(PG8_SB(1, 0), cB + kstep, voffB); PG8_STAGE_A(PG8_SA(1, 0), 0, kstep, false); PG8_STAGE(PG8_SB(1, 1), cB + hstepB + kstep, voffB);
    PG8_WAIT_V(6); PG8_BAR;
    for (;;) {
        const bool has_next = S.next(ui + 1, nxt);
        if constexpr (has_bias_lds<Epi>::value) E.stage_bias(biaslds + (ui & 1) * 1024, cur, wid, lane);
        nA = GA ? cA : (has_next ? (const char*)g.A + (size_t)nxt.arow * rowA : cA); const char* nB = has_next ? (const char*)g.Bt + (size_t)nxt.brow * rowB : cB;
        if constexpr (GA) { if (has_next) { PG8_GATH(gA_nxt, nxt); } else { _Pragma("unroll") for (int _h = 0; _h < 2; ++_h) _Pragma("unroll") for (int _i = 0; _i < 2; ++_i) gA_nxt[_h][_i] = gA_cur[_h][_i]; } }
#pragma unroll 1
        for (int t = 0; t < nt; t += 2) {
            const bool last = (t == nt - 2);
            if (last && has_next) S.a_ready(nxt);
            const size_t k1 = (size_t)(t + 1) * kstep, k2 = last ? (size_t)0 : (size_t)(t + 2) * kstep, k3 = k2 + kstep;
            const char* b2 = last ? nB : cB + (size_t)(t + 2) * kstep; const char* b3 = b2 + kstep;
            PG8_LDB(B0, 0, 0); PG8_LDB(B1, 0, 1); PG8_SCHED; PG8_LDA(At, 0, 0); PG8_STAGE_A(PG8_SA(1, 1), 1, k1, false);
            PG8_WAIT_V(8); PG8_WAIT_L(0); PG8_BAR; PG8_MMA(0, 0, At, B0); PG8_MMA(0, 1, At, B1); PG8_BAR; PG8_SCHED;
            PG8_LDA(At, 0, 1); PG8_STAGE(PG8_SB(0, 0), b2, voffB); PG8_STAGE(PG8_SB(0, 1), b2 + hstepB, voffB); PG8_STAGE_A(PG8_SA(0, 0), 0, k2, last);
            PG8_WAIT_V(8); PG8_WAIT_L(0); PG8_BAR; PG8_MMA(1, 0, At, B0); PG8_MMA(1, 1, At, B1); PG8_BAR; PG8_SCHED;
            PG8_LDB(B0, 1, 0); PG8_LDB(B1, 1, 1); PG8_SCHED; PG8_LDA(At, 1, 0); PG8_STAGE_A(PG8_SA(0, 1), 1, k2, last);
            PG8_WAIT_V(8); PG8_WAIT_L(0); PG8_BAR; PG8_MMA(0, 0, At, B0); PG8_MMA(0, 1, At, B1); PG8_BAR; PG8_SCHED;
            PG8_LDA(At, 1, 1); PG8_STAGE(PG8_SB(1, 0), b3, voffB); PG8_STAGE(PG8_SB(1, 1), b3 + hstepB, voffB); PG8_STAGE_A(PG8_SA(1, 0), 0, k3, last);
            PG8_WAIT_V(8); PG8_WAIT_L(0); PG8_BAR; PG8_MMA(1, 0, At, B0); PG8_MMA(1, 1, At, B1); PG8_BAR; PG8_SCHED;
        }
        if (wr == 0) PG8_BAR;
        if constexpr (has_bias_lds<Epi>::value) E(acc, cur, wr, wc, fr, fq, (const PG8_LAS float*)(biaslds + (ui & 1) * 1024)); else E(acc, cur, wr, wc, fr, fq);
        S.done(cur);
        if (!has_next) break;
#pragma unroll
        for (int a = 0; a < 2; ++a)
#pragma unroll
            for (int b = 0; b < 2; ++b)
#pragma unroll
                for (int m = 0; m < 4; ++m)
#pragma unroll
                    for (int n = 0; n < 2; ++n) acc[a][b][m][n] = (f32x4){0.f, 0.f, 0.f, 0.f};
        cur = nxt; cA = nA; cB = nB; ++ui;
        if constexpr (GA) { _Pragma("unroll") for (int _h = 0; _h < 2; ++_h) _Pragma("unroll") for (int _i = 0; _i < 2; ++_i) gA_cur[_h][_i] = gA_nxt[_h][_i]; }
        if (wr == 1) PG8_BAR;
    }
    PG8_WAIT_V(0);
    PG8_BAR;
    const int n_done_ = ui + 1;
#undef PG8_SA
#undef PG8_SB
#undef PG8_STAGE
#undef PG8_STAGE_A
#undef PG8_GATH
#undef PG8_LDA
#undef PG8_LDB
#undef PG8_MMA
#undef PG8_WAIT_V
#undef PG8_WAIT_L
#undef PG8_BAR
#undef PG8_SCHED
    return n_done_;
}
}
constexpr int NWAVES = 8;
constexpr int BATCH = 2, SEQ = 8192, T = BATCH * SEQ, D = 1024, NH = 8, HD = 64, AW = 512, SW = 512, NG = 32, NP = 64, GS16 = 16;
constexpr int NE = 32, FF = 1024, INW = 4096, TOPK = 4, NBLK = SEQ / 256;
constexpr float NORM_EPS = 1e-6f;
constexpr float C2 = 0.125f * 1.4426950408889634f;
constexpr int XROWS = T * TOPK + 256;

constexpr size_t MiB = 1u << 20;
constexpr size_t WS_CTL = 0, CTL_ZERO_BYTES = 1 * MiB;
constexpr size_t WS_ADA = 1 * MiB;
constexpr size_t WS_ADAF = WS_ADA + 832 * 1024;
constexpr size_t WS_ROPE = 2 * MiB;
constexpr size_t WS_S5P = 6 * MiB;
constexpr size_t WS_S5KT = 7 * MiB;
constexpr size_t WS_S5M1 = 10 * MiB;
constexpr size_t WS_S5WC = 506 * MiB;
constexpr size_t WS_S5E = 408 * MiB;
constexpr size_t WS_ROUTE = 9 * MiB;
constexpr size_t WS_ELIST = 14 * MiB; constexpr int ELCAP = T;
constexpr size_t WS_HSC = WS_ROUTE + 768 * 1024;
constexpr int PAR_WSC = 270000, PAR_WSC1 = 270001;
#ifndef MOE_BF16
#define MOE_F8 1
#endif
constexpr size_t WS_WIN_T = 18 * MiB, WS_WGLU_T = 26 * MiB, WS_WSB_T = 27 * MiB, WS_WAB_T = 28 * MiB, WS_WOUT_T = 29 * MiB;
constexpr size_t WS_PAR = 16 * MiB;
constexpr int PAR_MPG = 0, PAR_FPRE = 1024, PAR_FPOST = 2048, PAR_RB = 3072, PAR_RW = 4096, PAR_BG = 36864, PAR_BU = 69632, PAR_BD = 102400, PAR_CRE = 135168, PAR_CIM = 167936, PAR_SD = 200704, PAR_BRE = 201728, PAR_BIM = 234496;
constexpr size_t WS_WGU_T = 32 * MiB, WS_WDN_T = 160 * MiB;
constexpr size_t WS_XN = 224 * MiB;
constexpr size_t WS_UA = 256 * MiB, WS_Q = 280 * MiB, WS_K = 296 * MiB, WS_V = 312 * MiB, WS_VT = 328 * MiB;
constexpr size_t WS_MIX = 256 * MiB;
constexpr size_t WS_GS = 344 * MiB, WS_GA = 376 * MiB;
constexpr size_t WS_YG = 408 * MiB, WS_Y2 = 424 * MiB, WS_YA = 440 * MiB;
constexpr size_t WS_M1 = 456 * MiB;
constexpr size_t WS_H2 = 480 * MiB;
constexpr size_t WS_XG = 224 * MiB, WS_YB = 224 * MiB;
constexpr size_t WS_H1 = 352 * MiB;
constexpr size_t WS_END = 512 * MiB;
static_assert(WS_YB + (size_t)T * TOPK * D * 2 <= WS_H1 && WS_H1 + (size_t)T * TOPK * FF * 2 <= WS_H2 && WS_H2 + (size_t)T * D * 2 <= WS_END, "ws map");
constexpr int CW_TMO = 0, CW_CODE = 1, CW_BAR = 4096, CW_ECNT = 8192, CW_KM = 16384;
constexpr size_t CTL_ZERO_USED = (size_t)(CW_KM + BATCH * NH * NBLK * HD) * 4;
static_assert(CTL_ZERO_USED <= CTL_ZERO_BYTES, "ctl");

constexpr int RING_OFF = 0, RING_BYTES = 131072;
constexpr int LDSCTL_OFF = 152 * 1024, MISC_OFF = LDSCTL_OFF + 320;
constexpr int LDS_BYTES = 158 * 1024;

#define GAS __attribute__((address_space(1)))
#define LAS __attribute__((address_space(3)))
typedef unsigned short bf16;
typedef unsigned v4u __attribute__((ext_vector_type(4)));
typedef unsigned v2u __attribute__((ext_vector_type(2)));
typedef float f32x4 __attribute__((ext_vector_type(4)));
typedef GAS unsigned gu32;
#define RLX_AGENT __ATOMIC_RELAXED, __HIP_MEMORY_SCOPE_AGENT
#define LDS_WAIT() asm volatile("s_waitcnt lgkmcnt(0)" ::: "memory")
#define VM_WAIT() asm volatile("s_waitcnt vmcnt(0)" ::: "memory")
__device__ __forceinline__ unsigned f2bf(float f) { unsigned u = __builtin_bit_cast(unsigned, f); return (u + 0x7fffu + ((u >> 16) & 1u)) >> 16; }
__device__ __forceinline__ unsigned pk2(float lo, float hi) { typedef float f32x2_t __attribute__((ext_vector_type(2))); typedef __bf16 bf16x2_t __attribute__((ext_vector_type(2)));
    f32x2_t v = {lo, hi}; bf16x2_t r = __builtin_convertvector(v, bf16x2_t); return __builtin_bit_cast(unsigned, r); }
#ifdef WT_STORES
__device__ __forceinline__ void st16(void* p, v4u v) { asm volatile("global_store_dwordx4 %0, %1, off sc1\n\ts_nop 1" :: "v"(p), "v"(v) : "memory"); }
__device__ __forceinline__ void st8(void* p, v2u v) { asm volatile("global_store_dwordx2 %0, %1, off sc1\n\ts_nop 1" :: "v"(p), "v"(v) : "memory"); }
#else
__device__ __forceinline__ void st16(void* p, v4u v) { *(v4u*)p = v; }
__device__ __forceinline__ void st8(void* p, v2u v) { *(v2u*)p = v; }
#endif
__device__ __forceinline__ unsigned pk4_fp8(float a, float b, float c, float d) {
    a = fminf(fmaxf(a, -448.f), 448.f); b = fminf(fmaxf(b, -448.f), 448.f); c = fminf(fmaxf(c, -448.f), 448.f); d = fminf(fmaxf(d, -448.f), 448.f);
    int w = 0; w = __builtin_amdgcn_cvt_pk_fp8_f32(a, b, w, false); w = __builtin_amdgcn_cvt_pk_fp8_f32(c, d, w, true); return (unsigned)w; }
__device__ __forceinline__ float bflo(unsigned w) { return __builtin_bit_cast(float, w << 16); }
__device__ __forceinline__ float bfhi(unsigned w) { return __builtin_bit_cast(float, w & 0xffff0000u); }
__device__ __forceinline__ float bf2f(bf16 h) { return __builtin_bit_cast(float, (unsigned)h << 16); }
__device__ __forceinline__ float sigmoidf_(float x) { return 1.f / (1.f + __expf(-x)); }
__device__ __forceinline__ float gelu_tanh(float x) { const float u = 1.5957691216057308f * (x + 0.044715f * x * x * x); return x / (1.f + __expf(-u)); }

#define XB_TMO      128
#define XB_XCNT(j)  (256  + 64 * (j))
#define XB_XSUB(j)  (1280 + 64 * (j))
#define XB_XGEN(j)  (2304 + 64 * (j))
#define XB_TOP      3328
#define XB_TOPGEN   3392
#define XCD_BAR_WORDS 3456
#define XB_SPIN_CAP (1u << 18)
__device__ __forceinline__ unsigned xb_ld(unsigned* p)              { return __hip_atomic_load(p, __ATOMIC_RELAXED, __HIP_MEMORY_SCOPE_AGENT); }
__device__ __forceinline__ unsigned xb_add(unsigned* p, unsigned v) { return __hip_atomic_fetch_add(p, v, __ATOMIC_RELAXED, __HIP_MEMORY_SCOPE_AGENT); }
__device__ __forceinline__ unsigned xb_xcc_id() { return (unsigned)__builtin_amdgcn_s_getreg((3 << 11) | 20) & 0xFu; }
#define XB_SPIN(cond, bar) do { unsigned _sp = 0; while (cond) { __builtin_amdgcn_s_sleep(1); \
    if ((++_sp & 255u) == 0u) { if (xb_ld(&(bar)[XB_TMO])) break; if (_sp > XB_SPIN_CAP) { atomicAdd(&(bar)[XB_TMO], 1u); break; } } } } while (0)
struct XcdBarrier { unsigned* bar; unsigned x; volatile LAS unsigned* st; };
__device__ __forceinline__ XcdBarrier xcd_barrier_post(unsigned* bar, volatile LAS unsigned* st) {
    XcdBarrier b; b.bar = bar; b.x = xb_xcc_id(); b.st = st;
    if (threadIdx.x == 0) (void)xb_add(&bar[XB_XCNT(b.x)], 1u);
    return b;
}
__device__ __forceinline__ void xcd_barrier_complete(unsigned* bar, unsigned x, unsigned& nloc, unsigned& nx) {
    const unsigned G = gridDim.x * gridDim.y * gridDim.z;
    unsigned sum, cnt, mine, sp = 0u;
    for (;;) {
        sum = 0u; cnt = 0u; mine = 0u;
#pragma unroll
        for (unsigned j = 0; j < 16; ++j) { const unsigned c = xb_ld(&bar[XB_XCNT(j)]); sum += c; cnt += (c > 0u) ? 1u : 0u; mine = (j == x) ? c : mine; }
        if (sum == G) break;
        __builtin_amdgcn_s_sleep(1);
        if ((++sp & 255u) == 0u) { if (xb_ld(&bar[XB_TMO])) break; if (sp > XB_SPIN_CAP) { atomicAdd(&bar[XB_TMO], 1u); break; } }
    }
    nloc = mine > 0u ? mine : 1u; nx = cnt > 0u ? cnt : 1u;
}
__device__ __forceinline__ void xcd_barrier(const XcdBarrier& b) {
    asm volatile("s_waitcnt vmcnt(0)" ::: "memory");
    __syncthreads();
    if (threadIdx.x == 0) {
        unsigned* bar = b.bar;
        __builtin_amdgcn_s_waitcnt(0);
        unsigned nloc = b.st[0], nx = b.st[1];
        if (nloc == 0u) { xcd_barrier_complete(bar, b.x, nloc, nx); b.st[0] = nloc; b.st[1] = nx; }
        const unsigned old = xb_add(&bar[XB_XSUB(b.x)], 1u);
        const unsigned gen = old / nloc;
        if (old + 1u == (gen + 1u) * nloc) {
            __builtin_amdgcn_fence(__ATOMIC_RELEASE, "agent");
            asm volatile("s_waitcnt vmcnt(0)" ::: "memory");
            const unsigned og = xb_add(&bar[XB_TOP], 1u);
            const unsigned tg = og / nx;
            if (og + 1u == (tg + 1u) * nx) xb_add(&bar[XB_TOPGEN], 1u);
            else XB_SPIN(xb_ld(&bar[XB_TOPGEN]) == tg, bar);
            __builtin_amdgcn_fence(__ATOMIC_ACQUIRE, "agent");
            xb_add(&bar[XB_XGEN(b.x)], 1u);
            asm volatile("s_waitcnt vmcnt(0)" ::: "memory");
        } else {
            XB_SPIN(xb_ld(&bar[XB_XGEN(b.x)]) == gen, bar);
            __builtin_amdgcn_fence(__ATOMIC_ACQUIRE, "agent");
            asm volatile("s_waitcnt vmcnt(0)" ::: "memory");
        }
    }
    __syncthreads();
}

__device__ __forceinline__ float wave_sum(float v) {
#pragma unroll
    for (int o = 1; o < 64; o <<= 1) v += __shfl_xor(v, o);
    return v;
}
__device__ __forceinline__ float wave_max(float v) {
#pragma unroll
    for (int o = 1; o < 64; o <<= 1) v = fmaxf(v, __shfl_xor(v, o));
    return v;
}
struct Frame {
    LAS unsigned char* lds;
    volatile LAS unsigned* MISC;
    gu32* ctl;
    int tid, lane, wave;
    int vcu, G;
    unsigned char* ws;
    const float* in[30];
    float* out;
};
#define WSP(T_, off) ((T_*)(F.ws + (off)))

__device__ __forceinline__ int perm8(int c) { return (c & ~31) + 16 * ((c >> 2) & 1) + 4 * ((c >> 3) & 3) + (c & 3); }
struct MapP8 { int off; __device__ __forceinline__ int operator()(int n) const { return off + perm8(n); } };
struct MapWin { __device__ __forceinline__ int operator()(int c) const {
    if (c < 512 || c >= 1536) return perm8(c);
    const int base = (c < 1024) ? 512 : 1024, cc = c - base, head = cc >> 6, d = cc & 63, pnq = head >> 2, hh = head & 3, n = d >> 5, dd = d & 31;
    const int wc = 2 * (hh & 1) + (dd >> 4), bj = hh >> 1, j = dd & 15;
    return base + 256 * pnq + 128 * bj + 32 * wc + 16 * n + j; } };
struct MapGU { int e, up; __device__ __forceinline__ int operator()(int f) const { return e * 2048 + (f >> 7) * 256 + up * 128 + perm8(f & 127); } };

template <class RowMap>
__device__ __forceinline__ void p0_transpose_item(const float* W, int K, int N, bf16* WT, LAS float* scr, int item, int lane, const RowMap rm) {
    const int nblk = N / 64, kb = item / nblk, nb = item % nblk, k0 = 64 * kb, n0 = 64 * nb;
    const int lr = lane >> 4, lc = 4 * (lane & 15);
    f32x4 v[16];
#pragma unroll
    for (int i = 0; i < 16; ++i) v[i] = __builtin_nontemporal_load((const GAS f32x4*)(W + (size_t)(k0 + 4 * i + lr) * N + n0 + lc));
#pragma unroll
    for (int i = 0; i < 16; ++i) { LAS float* d = scr + (4 * i + lr) * 65 + lc; d[0] = v[i].x; d[1] = v[i].y; d[2] = v[i].z; d[3] = v[i].w; }
    LDS_WAIT(); asm volatile("" ::: "memory");
    const int c = lane & 7;
#pragma unroll
    for (int j = 0; j < 8; ++j) { const int n = (lane >> 3) + 8 * j; const LAS float* s = scr + (8 * c) * 65 + n;
        v4u o; o.x = pk2(s[0 * 65], s[1 * 65]); o.y = pk2(s[2 * 65], s[3 * 65]); o.z = pk2(s[4 * 65], s[5 * 65]); o.w = pk2(s[6 * 65], s[7 * 65]);
        __builtin_nontemporal_store(o, (GAS v4u*)(WT + (size_t)rm(n0 + n) * K + k0 + 8 * c)); }
    LDS_WAIT(); asm volatile("" ::: "memory");
}

template <class RowMap>
__device__ __forceinline__ void p0_transpose_item_f8(const float* W, int K, int N, unsigned char* WT, LAS float* scr, int item, int lane, const RowMap rm, float wsc) {
    const int nblk = N / 64, kb = item / nblk, nb = item % nblk, k0 = 64 * kb, n0 = 64 * nb;
    const int lr = lane >> 4, lc = 4 * (lane & 15);
    f32x4 v[16];
#pragma unroll
    for (int i = 0; i < 16; ++i) v[i] = __builtin_nontemporal_load((const GAS f32x4*)(W + (size_t)(k0 + 4 * i + lr) * N + n0 + lc));
#pragma unroll
    for (int i = 0; i < 16; ++i) { LAS float* d = scr + (4 * i + lr) * 65 + lc; d[0] = v[i].x * wsc; d[1] = v[i].y * wsc; d[2] = v[i].z * wsc; d[3] = v[i].w * wsc; }
    LDS_WAIT(); asm volatile("" ::: "memory");
    const int c = lane & 3;
#pragma unroll
    for (int j = 0; j < 4; ++j) { const int n = (lane >> 2) + 16 * j; const LAS float* s = scr + (16 * c) * 65 + n;
        v4u o; o.x = pk4_fp8(s[0 * 65], s[1 * 65], s[2 * 65], s[3 * 65]); o.y = pk4_fp8(s[4 * 65], s[5 * 65], s[6 * 65], s[7 * 65]);
        o.z = pk4_fp8(s[8 * 65], s[9 * 65], s[10 * 65], s[11 * 65]); o.w = pk4_fp8(s[12 * 65], s[13 * 65], s[14 * 65], s[15 * 65]);
        __builtin_nontemporal_store(o, (GAS v4u*)(WT + (size_t)rm(n0 + n) * K + k0 + 16 * c)); }
    LDS_WAIT(); asm volatile("" ::: "memory");
}

__device__ __forceinline__ void p0_moe_load(const float* W, int item, int lane, f32x4 (&v)[16]) {
    const int kb = item >> 4, nb = item & 15, k0 = 64 * kb, n0 = 64 * nb, lr = lane >> 4, lc = 4 * (lane & 15);
#pragma unroll
    for (int i = 0; i < 16; ++i) v[i] = __builtin_nontemporal_load((const GAS f32x4*)(W + (size_t)(k0 + 4 * i + lr) * 1024 + n0 + lc));
}
__device__ __forceinline__ void p0_moe_finish(unsigned char* WT, int rowbase, int kind, int item, LAS float* scr, int lane, const f32x4 (&v)[16], float wsc) {
    const int kb = item >> 4, nb = item & 15, k0 = 64 * kb, n0 = 64 * nb, lr = lane >> 4, lc = 4 * (lane & 15);
#pragma unroll
    for (int i = 0; i < 16; ++i) { LAS float* d = scr + (4 * i + lr) * 65 + lc; d[0] = v[i].x * wsc; d[1] = v[i].y * wsc; d[2] = v[i].z * wsc; d[3] = v[i].w * wsc; }
    LDS_WAIT(); asm volatile("" ::: "memory");
    const int c = lane & 3;
#pragma unroll
    for (int j = 0; j < 4; ++j) { const int n = n0 + (lane >> 2) + 16 * j; const LAS float* s = scr + (16 * c) * 65 + (n - n0);
        const int row = rowbase + (kind < 2 ? (n >> 7) * 256 + kind * 128 + perm8(n & 127) : perm8(n));
        v4u o; o.x = pk4_fp8(s[0 * 65], s[1 * 65], s[2 * 65], s[3 * 65]); o.y = pk4_fp8(s[4 * 65], s[5 * 65], s[6 * 65], s[7 * 65]);
        o.z = pk4_fp8(s[8 * 65], s[9 * 65], s[10 * 65], s[11 * 65]); o.w = pk4_fp8(s[12 * 65], s[13 * 65], s[14 * 65], s[15 * 65]);
        __builtin_nontemporal_store(o, (GAS v4u*)(WT + (size_t)row * 1024 + k0 + 16 * c)); }
    LDS_WAIT(); asm volatile("" ::: "memory");
}

__device__ __forceinline__ void phase0(Frame& F) {
    LAS float* scr = (LAS float*)(F.lds + RING_OFF + F.wave * 16640);
    const int gw = F.vcu * NWAVES + F.wave, NGW = F.G * NWAVES;
#ifdef MOE_F8
    float wsc;
    { float am = 0.f;
      for (int j = F.tid; j < 2048; j += NWAVES * 64) { const size_t o = (size_t)j * 16384 + 37 * (j & 63);
          am = fmaxf(am, fmaxf(fabsf(F.in[24][o]), fmaxf(fabsf(F.in[26][o]), fabsf(F.in[28][o])))); }
      am = wave_max(am); LAS float* red = (LAS float*)(F.lds + LDSCTL_OFF + 64);
      if (F.lane == 0) red[F.wave] = am;
      __syncthreads();
      am = red[0];
#pragma unroll
      for (int w = 1; w < NWAVES; ++w) am = fmaxf(am, red[w]);
      wsc = exp2f(floorf(log2f(448.f / (fmaxf(am, 1e-30f) * 8.f))));
      if (blockIdx.x == 0 && F.tid == 0) WSP(float, WS_PAR)[PAR_WSC] = wsc;
      __syncthreads(); }
#endif
#ifdef G1_F8
    float wsc1;
    { float am = 0.f;
      for (int j = F.tid; j < 2048; j += NWAVES * 64) am = fmaxf(am, fabsf(F.in[9][(size_t)j * 2048 + 37 * (j & 31)]));
      am = wave_max(am); LAS float* red = (LAS float*)(F.lds + LDSCTL_OFF + 64);
      if (F.lane == 0) red[F.wave] = am;
      __syncthreads();
      am = red[0];
#pragma unroll
      for (int w = 1; w < NWAVES; ++w) am = fmaxf(am, red[w]);
      wsc1 = exp2f(floorf(log2f(448.f / (fmaxf(am, 1e-30f) * 8.f))));
      if (blockIdx.x == 0 && F.tid == 0) WSP(float, WS_PAR)[PAR_WSC1] = wsc1;
      __syncthreads(); }
#endif
    constexpr int I_WIN = 16 * 64, I_GLU = 8 * 8, I_SB = 8 * 16, I_AB = 8 * 16, I_OUT = 16 * 16, I_E = 16 * 16;
    constexpr int I_SMALL = I_WIN + I_GLU + I_SB + I_AB + I_OUT, I_MOE = 3 * NE * I_E, I_ADA = 16 * 96;
    constexpr int NITEMS = I_SMALL + I_MOE + I_ADA;
    for (int it = gw; it < NITEMS; it += NGW) {
        int r = it;
#ifdef G1_F8
        if (r < I_WIN) { p0_transpose_item_f8(F.in[9], D, INW, WSP(unsigned char, WS_WIN_T), scr, r, F.lane, MapWin{}, wsc1); continue; } r -= I_WIN;
#else
        if (r < I_WIN) { p0_transpose_item(F.in[9], D, INW, WSP(bf16, WS_WIN_T), scr, r, F.lane, MapWin{}); continue; } r -= I_WIN;
#endif
        if (r < I_GLU) { p0_transpose_item(F.in[18], SW, SW, WSP(bf16, WS_WGLU_T), scr, r, F.lane, MapP8{0}); continue; } r -= I_GLU;
        if (r < I_SB) { p0_transpose_item(F.in[19], SW, D, WSP(bf16, WS_WSB_T), scr, r, F.lane, MapP8{0}); continue; } r -= I_SB;
        if (r < I_AB) { p0_transpose_item(F.in[20], AW, D, WSP(bf16, WS_WAB_T), scr, r, F.lane, MapP8{0}); continue; } r -= I_AB;
        if (r < I_OUT) { p0_transpose_item(F.in[21], D, D, WSP(bf16, WS_WOUT_T), scr, r, F.lane, MapP8{0}); continue; } r -= I_OUT;
        if (r < I_MOE) {
#ifdef MOE_F8
            continue;
#endif
            const int mat = r / I_E, item = r % I_E, kind = mat / NE, e = mat % NE;
#ifdef MOE_F8
            if (kind == 0) p0_transpose_item_f8(F.in[24] + (size_t)e * D * FF, D, FF, WSP(unsigned char, WS_WGU_T), scr, item, F.lane, MapGU{e, 0}, wsc);
            else if (kind == 1) p0_transpose_item_f8(F.in[26] + (size_t)e * D * FF, D, FF, WSP(unsigned char, WS_WGU_T), scr, item, F.lane, MapGU{e, 1}, wsc);
            else p0_transpose_item_f8(F.in[28] + (size_t)e * FF * D, FF, D, WSP(unsigned char, WS_WDN_T), scr, item, F.lane, MapP8{e * 1024}, wsc);
#else
            if (kind == 0) p0_transpose_item(F.in[24] + (size_t)e * D * FF, D, FF, WSP(bf16, WS_WGU_T), scr, item, F.lane, MapGU{e, 0});
            else if (kind == 1) p0_transpose_item(F.in[26] + (size_t)e * D * FF, D, FF, WSP(bf16, WS_WGU_T), scr, item, F.lane, MapGU{e, 1});
            else p0_transpose_item(F.in[28] + (size_t)e * FF * D, FF, D, WSP(bf16, WS_WDN_T), scr, item, F.lane, MapP8{e * 1024});
#endif
            continue; }
        r -= I_MOE;
        {
            const int ks = r / 96, cc = r % 96, n = cc * 64 + F.lane;
            const float* cvec = F.in[1]; const float* aw = F.in[3];
            float a0 = 0.f, a1 = 0.f;
            for (int k = ks * 64; k < ks * 64 + 64; ++k) {
                const float c0 = cvec[k], c1 = cvec[D + k];
                const float s0 = c0 / (1.f + __expf(-c0)), s1 = c1 / (1.f + __expf(-c1));
                const float w = __builtin_nontemporal_load(aw + (size_t)k * (6 * D) + n);
                a0 += s0 * w; a1 += s1 * w; }
            float* part = WSP(float, WS_ADA);
            part[(ks * 2 + 0) * (6 * D) + n] = a0; part[(ks * 2 + 1) * (6 * D) + n] = a1;
        }
    }
#ifdef MOE_F8
    {   const float* wg = F.in[24]; const float* wu = F.in[26]; const float* wd = F.in[28];
        unsigned char* tgu = WSP(unsigned char, WS_WGU_T); unsigned char* tdn = WSP(unsigned char, WS_WDN_T);
#define P0_DEC(r_, W_, WT_, rb_, kd_, it_) const int mat_##r_ = (r_) >> 8, it_ = (r_) & 255, kd_ = mat_##r_ >> 5, e_##r_ = mat_##r_ & 31; \
        const float* W_ = (kd_ == 0 ? wg : (kd_ == 1 ? wu : wd)) + (size_t)e_##r_ * D * FF; unsigned char* WT_ = kd_ < 2 ? tgu : tdn; const int rb_ = kd_ < 2 ? e_##r_ * 2048 : e_##r_ * 1024;
        f32x4 va[16], vb[16]; int r = gw;
        if (r < I_MOE) { P0_DEC(r, W0, T0, b0, k0_, i0); (void)T0; (void)b0; (void)k0_; p0_moe_load(W0, i0, F.lane, va); }
        while (r < I_MOE) {
            { const int rn = r + NGW; if (rn < I_MOE) { P0_DEC(rn, W1, T1, b1, k1_, i1); (void)T1; (void)b1; (void)k1_; p0_moe_load(W1, i1, F.lane, vb); } }
            { P0_DEC(r, W2, T2, b2, k2_, i2); (void)W2; p0_moe_finish(T2, b2, k2_, i2, scr, F.lane, va, wsc); }
            r += NGW; if (r >= I_MOE) break;
            { const int rn = r + NGW; if (rn < I_MOE) { P0_DEC(rn, W3, T3, b3, k3_, i3); (void)T3; (void)b3; (void)k3_; p0_moe_load(W3, i3, F.lane, va); } }
            { P0_DEC(r, W4, T4, b4, k4_, i4); (void)W4; p0_moe_finish(T4, b4, k4_, i4, scr, F.lane, vb, wsc); }
            r += NGW;
        }
#undef P0_DEC
    }
#endif
    const int gt = F.vcu * (NWAVES * 64) + F.tid, NGT = F.G * NWAVES * 64;
    { const int* pos = (const int*)F.in[2]; float* rc = WSP(float, WS_ROPE); float* rs = rc + (size_t)T * 32;
      for (int i = gt; i < T * 32; i += NGT) { const int t = i >> 5, p = i & 31;
          const float invf = exp2f(-(float)p * (13.287712379549449f / 32.f));
          const double ang = (double)pos[t] * (double)invf; double rev = ang * 0.15915494309189535; rev -= floor(rev);
          const float fr = (float)rev;
          rc[i] = __builtin_amdgcn_cosf(fr); rs[i] = __builtin_amdgcn_sinf(fr); } }
    { float* P5 = WSP(float, WS_S5P);
      for (int i = gt; i < NG * NP; i += NGT) { const int g = i >> 6;
          const float dt = __expf(F.in[12][g]); const float lr = F.in[10][i], li = F.in[11][i];
          const float er = __expf(lr * dt); const double ang = (double)li * (double)dt; double rev = ang * 0.15915494309189535; rev -= floor(rev);
          const float cs = __builtin_amdgcn_cosf((float)rev), sn = __builtin_amdgcn_sinf((float)rev);
          float br = er * cs, bi = er * sn;
          P5[i] = br; P5[2048 + i] = bi;
          const float nr = br - 1.f, ni = bi, den = lr * lr + li * li;
          const float qr = (nr * lr + ni * li) / den, qi = (ni * lr - nr * li) / den;
          P5[8192 + i] = qr; P5[8192 + 2048 + i] = qi;
          float pr = br, pi_ = bi;
#pragma unroll
          for (int s = 0; s < 8; ++s) { const float tr = pr * pr - pi_ * pi_, ti = 2.f * pr * pi_; pr = tr; pi_ = ti; }
          P5[4096 + i] = pr; P5[6144 + i] = pi_;
          float* PW = P5 + 131072;
          float wr_ = 1.f, wi_ = 0.f;
#pragma unroll
          for (int k = 0; k <= 16; ++k) { PW[i * 17 + k] = wr_; PW[2048 * 17 + i * 17 + k] = wi_; const float tr = wr_ * br - wi_ * bi, ti = wr_ * bi + wi_ * br; wr_ = tr; wi_ = ti; } }
    }
}

__device__ __forceinline__ void phase1(Frame& F) {
    LAS float* A1 = (LAS float*)(F.lds + RING_OFF); LAS float* A2 = A1 + 2 * D;
    const float* part = WSP(float, WS_ADA); const float* ab = F.in[4]; const float* pg = F.in[5];
    for (int k = F.tid; k < D; k += NWAVES * 64)
#pragma unroll
        for (int b = 0; b < 2; ++b) { float sh = ab[k], sc = ab[D + k];
            for (int ks = 0; ks < 16; ++ks) { sh += part[(ks * 2 + b) * (6 * D) + k]; sc += part[(ks * 2 + b) * (6 * D) + D + k]; }
            A1[b * D + k] = pg[k] * (1.f + sc); A2[b * D + k] = sh; }
    const int gt = F.vcu * (NWAVES * 64) + F.tid, NGT = F.G * NWAVES * 64;
    { float* adaf = WSP(float, WS_ADAF);
      for (int n = gt; n < 2 * 6 * D; n += NGT) { const int b = n / (6 * D), j = n % (6 * D); float a = ab[j];
          for (int ks = 0; ks < 16; ++ks) a += part[(ks * 2 + b) * (6 * D) + j];
          adaf[n] = a; } }
    { float* par = WSP(float, WS_PAR);
      for (int i = gt; i < 32768; i += NGT) { par[PAR_RW + i] = F.in[22][i]; par[PAR_BG + i] = F.in[25][i]; par[PAR_BU + i] = F.in[27][i]; par[PAR_BD + i] = F.in[29][i];
          par[PAR_CRE + i] = F.in[15][i]; par[PAR_CIM + i] = F.in[16][i]; par[PAR_BRE + i] = F.in[13][i]; par[PAR_BIM + i] = F.in[14][i];
          if (i < 1024) { par[PAR_MPG + i] = F.in[6][i]; par[PAR_FPRE + i] = F.in[7][i]; par[PAR_FPOST + i] = F.in[8][i]; }
          if (i < 512) par[PAR_SD + i] = F.in[17][i];
          if (i < 32) par[PAR_RB + i] = F.in[23][i]; } }
    { const float* P5 = WSP(float, WS_S5P); const float* PWr = P5 + 131072; const float* PWi = PWr + 2048 * 17;
      bf16* M1t = WSP(bf16, WS_S5M1);
      for (int i = gt; i < NG * 256 * 256; i += NGT) { const int k = i & 255, n = (i >> 8) & 255, g = i >> 16; float val = 0.f;
          if (n < 128) { const int p = n & 63, gp = g * 64 + p, s_ = k >> 4, ci = k & 15;
              const float qr = P5[8192 + gp], qi = P5[8192 + 2048 + gp], b_r = F.in[13][gp * 16 + ci], b_i = F.in[14][gp * 16 + ci];
              const float bbr = qr * b_r - qi * b_i, bbi = qr * b_i + qi * b_r, wr_ = PWr[gp * 17 + 15 - s_], wi_ = PWi[gp * 17 + 15 - s_];
              val = (n < 64) ? (wr_ * bbr - wi_ * bbi) : (wr_ * bbi + wi_ * bbr); }
          M1t[((size_t)(g * 256 + perm8(n))) * 256 + k] = (bf16)f2bf(val); }
    }
    __syncthreads();
    const int gw = F.vcu * NWAVES + F.wave, NGW = F.G * NWAVES;
    bf16* XN = WSP(bf16, WS_XN);
    for (int m0 = gw * 2; m0 < T; m0 += NGW * 2) {
        const int b = m0 >> 13;
        f32x4 v[2][4];
#pragma unroll
        for (int q = 0; q < 2; ++q) { const GAS f32x4* xr = (const GAS f32x4*)(F.in[0] + (size_t)(m0 + q) * D) + F.lane;
#pragma unroll
            for (int j = 0; j < 4; ++j) v[q][j] = __builtin_nontemporal_load(xr + 64 * j); }
#pragma unroll
        for (int q = 0; q < 2; ++q) { float s = 0.f;
#pragma unroll
            for (int j = 0; j < 4; ++j) s += (v[q][j].x * v[q][j].x + v[q][j].y * v[q][j].y) + (v[q][j].z * v[q][j].z + v[q][j].w * v[q][j].w);
            const float rstd = 1.f / sqrtf(wave_sum(s) * (1.f / D) + NORM_EPS);
#ifdef G1_F8
            GAS unsigned* o4 = (GAS unsigned*)((unsigned char*)XN + (size_t)(m0 + q) * D) + F.lane;
#pragma unroll
            for (int j = 0; j < 4; ++j) { const f32x4 a1 = *(const LAS f32x4*)(A1 + b * D + 4 * F.lane + 256 * j), a2 = *(const LAS f32x4*)(A2 + b * D + 4 * F.lane + 256 * j);
                const f32x4 o = v[q][j] * rstd * a1 + a2;
                o4[64 * j] = pk4_fp8(8.f * o.x, 8.f * o.y, 8.f * o.z, 8.f * o.w); } }
#else
            GAS unsigned long long* o8 = (GAS unsigned long long*)(XN + (size_t)(m0 + q) * D) + F.lane;
#pragma unroll
            for (int j = 0; j < 4; ++j) { const f32x4 a1 = *(const LAS f32x4*)(A1 + b * D + 4 * F.lane + 256 * j), a2 = *(const LAS f32x4*)(A2 + b * D + 4 * F.lane + 256 * j);
                const f32x4 o = v[q][j] * rstd * a1 + a2;
                o8[64 * j] = (unsigned long long)pk2(o.x, o.y) | ((unsigned long long)pk2(o.z, o.w) << 32); } }
#endif
    }
    __syncthreads();
}

struct EpiG1 {
    bf16 *UA, *Q, *K, *V, *VT, *GSp, *GAp; const float *rc, *rs; float* km; const float* wscp;
    __device__ __forceinline__ void operator()(const pg8::f32x4 (&acc0)[2][2][4][2], const pg8::Unit& u, int wr, int wc, int fr, int fq) const {
        pg8::f32x4 (&acc)[2][2][4][2] = const_cast<pg8::f32x4 (&)[2][2][4][2]>(acc0);
#ifdef G1_F8
        { const float s_ = 0.125f / *wscp;
#pragma unroll
            for (int a = 0; a < 2; ++a)
#pragma unroll
                for (int b = 0; b < 2; ++b)
#pragma unroll
                    for (int m = 0; m < 4; ++m)
#pragma unroll
                        for (int n = 0; n < 2; ++n) acc[a][b][m][n] = acc[a][b][m][n] * s_; }
#endif
        asm volatile("" : "+v"(fr), "+v"(fq));
        const int pn = u.pn, row0 = u.pm * 256 + wr * 64 + fr;
        if (pn < 2) {
#pragma unroll
            for (int ai = 0; ai < 2; ++ai)
#pragma unroll
                for (int m = 0; m < 4; ++m) { const int t = row0 + ai * 128 + m * 16, b = t >> 13, tt = t & (SEQ - 1), c = tt >> 4, s = tt & 15;
#pragma unroll
                    for (int bj = 0; bj < 2; ++bj) { const int ch = pn * 256 + bj * 128 + wc * 32 + 8 * fq, g = ch >> 4, ci = ch & 15;
                        const pg8::f32x4 v0 = acc[ai][bj][m][0], v1 = acc[ai][bj][m][1];
                        v4u w; w.x = pk2(v0[0], v0[1]); w.y = pk2(v0[2], v0[3]); w.z = pk2(v1[0], v1[1]); w.w = pk2(v1[2], v1[3]);
                        st16(UA + ((size_t)(g * 1024 + b * 512 + c) * 384 + 16 * s + ci), w); } }
        } else if (pn < 6) {
            const bool isk = pn >= 4; bf16* X = isk ? K : Q; const float sc = isk ? 1.f : C2;
            const int p0 = 16 * (wc & 1) + 4 * fq;
#pragma unroll
            for (int bj = 0; bj < 2; ++bj) {
                const int head = 4 * (pn & 1) + 2 * bj + (wc >> 1);
                int rowb = row0; asm volatile("" : "+v"(rowb));
                float ks[2][4];
#pragma unroll
                for (int b = 0; b < 2; ++b)
#pragma unroll
                    for (int i = 0; i < 4; ++i) ks[b][i] = 0.f;
#pragma unroll
                for (int ai = 0; ai < 2; ++ai)
#pragma unroll
                    for (int m = 0; m < 4; ++m) { const int t = rowb + ai * 128 + m * 16;
                        const pg8::f32x4 cs = *(const pg8::f32x4*)(rc + (size_t)t * 32 + p0), sn = *(const pg8::f32x4*)(rs + (size_t)t * 32 + p0);
                        const pg8::f32x4 t1 = acc[ai][bj][m][0], t2 = acc[ai][bj][m][1];
                        const pg8::f32x4 o1 = t1 * cs - t2 * sn, o2 = t2 * cs + t1 * sn;
                        v2u w1, w2; w1.x = pk2(o1[0] * sc, o1[1] * sc); w1.y = pk2(o1[2] * sc, o1[3] * sc); w2.x = pk2(o2[0] * sc, o2[1] * sc); w2.y = pk2(o2[2] * sc, o2[3] * sc);
                        bf16* dst = X + (size_t)t * AW + head * 64 + p0;
                        st8(dst, w1); st8(dst + 32, w2);
#pragma unroll
                        for (int i = 0; i < 4; ++i) { ks[0][i] += o1[i]; ks[1][i] += o2[i]; }
                        __builtin_amdgcn_sched_barrier(0); }
                if (isk) {
                    const int b = u.pm >> 5, blk = u.pm & 31;
#pragma unroll
                    for (int n = 0; n < 2; ++n)
#pragma unroll
                        for (int i = 0; i < 4; ++i) { float v = ks[n][i];
                            v += __shfl_xor(v, 1); v += __shfl_xor(v, 2); v += __shfl_xor(v, 4); v += __shfl_xor(v, 8);
                            if (fr == 0) atomicAdd(km + ((size_t)((b * NH + head) * NBLK + blk) * HD + 32 * n + p0 + i), v); }
                }
            }
        } else if (pn < 8) {
#pragma unroll
            for (int ai = 0; ai < 2; ++ai)
#pragma unroll
                for (int m = 0; m < 4; ++m) { const int t = row0 + ai * 128 + m * 16, b = t >> 13, tt = t & (SEQ - 1);
#pragma unroll
                    for (int bj = 0; bj < 2; ++bj) { const int cv = (pn - 6) * 256 + bj * 128 + wc * 32 + 8 * fq, head = cv >> 6, d = cv & 63;
                        const pg8::f32x4 v0 = acc[ai][bj][m][0], v1 = acc[ai][bj][m][1];
                        v4u w; w.x = pk2(v0[0], v0[1]); w.y = pk2(v0[2], v0[3]); w.z = pk2(v1[0], v1[1]); w.w = pk2(v1[2], v1[3]);
                        bf16* vt = VT + ((size_t)((b * NH + head) * HD + d) * SEQ + tt);
                        vt[0 * SEQ] = (bf16)(w.x & 0xffff); vt[1 * SEQ] = (bf16)(w.x >> 16); vt[2 * SEQ] = (bf16)(w.y & 0xffff); vt[3 * SEQ] = (bf16)(w.y >> 16);
                        vt[4 * SEQ] = (bf16)(w.z & 0xffff); vt[5 * SEQ] = (bf16)(w.z >> 16); vt[6 * SEQ] = (bf16)(w.w & 0xffff); vt[7 * SEQ] = (bf16)(w.w >> 16); } }
        } else {
            bf16* Gp = (pn < 12) ? GSp : GAp; const int cb = ((pn - 8) & 3) * 256;
#pragma unroll
            for (int ai = 0; ai < 2; ++ai)
#pragma unroll
                for (int m = 0; m < 4; ++m) { const int t = row0 + ai * 128 + m * 16;
#pragma unroll
                    for (int bj = 0; bj < 2; ++bj) { const int col = cb + bj * 128 + wc * 32 + 8 * fq;
                        const pg8::f32x4 v0 = acc[ai][bj][m][0], v1 = acc[ai][bj][m][1];
                        v4u w; w.x = pk2(sigmoidf_(v0[0]), sigmoidf_(v0[1])); w.y = pk2(sigmoidf_(v0[2]), sigmoidf_(v0[3]));
                        w.z = pk2(sigmoidf_(v1[0]), sigmoidf_(v1[1])); w.w = pk2(sigmoidf_(v1[2]), sigmoidf_(v1[3]));
                        __builtin_nontemporal_store(w, (v4u*)(Gp + (size_t)t * D + col)); } }
        }
    }
};

template <int MODE> struct EpiEw {
    bf16* O; const bf16* X1; const bf16* X2; float* Of; int ld;
    __device__ __forceinline__ void operator()(const pg8::f32x4 (&acc)[2][2][4][2], const pg8::Unit& u, int wr, int wc, int fr, int fq) const {
        const int row0 = u.pm * 256 + wr * 64 + fr, col0 = u.pn * 256 + wc * 32 + 8 * fq;
#pragma unroll
        for (int ai = 0; ai < 2; ++ai)
#pragma unroll
            for (int m = 0; m < 4; ++m) { const size_t rb = (size_t)(row0 + ai * 128 + m * 16) * ld + col0;
#pragma unroll
                for (int bj = 0; bj < 2; ++bj) { const size_t off = rb + bj * 128;
                    const pg8::f32x4 v0 = acc[ai][bj][m][0], v1 = acc[ai][bj][m][1];
                    if (MODE == 3) { *(pg8::f32x4*)(Of + off) = v0; *(pg8::f32x4*)(Of + off + 4) = v1; }
                    else {
                        const v4u x = __builtin_nontemporal_load((const v4u*)(X1 + off));
                        float r[8] = {v0[0], v0[1], v0[2], v0[3], v1[0], v1[1], v1[2], v1[3]};
                        const float xv[8] = {bflo(x.x), bfhi(x.x), bflo(x.y), bfhi(x.y), bflo(x.z), bfhi(x.z), bflo(x.w), bfhi(x.w)};
                        if (MODE == 0) {
#pragma unroll
                            for (int i = 0; i < 8; ++i) r[i] = xv[i] * sigmoidf_(r[i]);
                        } else if (MODE == 1) {
#pragma unroll
                            for (int i = 0; i < 8; ++i) r[i] = xv[i] * r[i];
                        } else {
                            const v4u y = __builtin_nontemporal_load((const v4u*)(X2 + off));
                            const float yv[8] = {bflo(y.x), bfhi(y.x), bflo(y.y), bfhi(y.y), bflo(y.z), bfhi(y.z), bflo(y.w), bfhi(y.w)};
#pragma unroll
                            for (int i = 0; i < 8; ++i) r[i] = yv[i] + xv[i] * r[i];
                        }
                        v4u w; w.x = pk2(r[0], r[1]); w.y = pk2(r[2], r[3]); w.z = pk2(r[4], r[5]); w.w = pk2(r[6], r[7]);
                        st16(O + off, w); } } }
    }
};

typedef short bf16x8 __attribute__((ext_vector_type(8)));
typedef float f32x16 __attribute__((ext_vector_type(16)));
constexpr size_t WS_ALIST = 456 * MiB;
constexpr size_t WS_OP01 = 224 * MiB;
constexpr size_t WS_OP23 = 472 * MiB;
constexpr size_t WS_LSE = 504 * MiB;
constexpr int CW_BCNT = 12288;
constexpr int ALCAP = 8192;

__device__ __forceinline__ void attn_gate(Frame& F) {
    const int gw = F.vcu * NWAVES + F.wave, NGW = F.G * NWAVES, L = F.lane;
    const bf16* Q = WSP(bf16, WS_Q); const float* km = (const float*)(F.ctl + CW_KM);
    unsigned* bcnt = (unsigned*)(F.ctl + CW_BCNT); unsigned* list = WSP(unsigned, WS_ALIST); float* lse = WSP(float, WS_LSE);
    for (int w = gw; w < BATCH * NH * (SEQ / 64); w += NGW) {
        const int bh = w >> 7, b = bh >> 3, h = bh & 7, tt = (w & 127) * 64 + L, t = b * SEQ + tt, blk = tt >> 8;
        float q[64];
        { const v4u* qp = (const v4u*)(Q + (size_t)t * AW + h * 64);
#pragma unroll
          for (int i = 0; i < 8; ++i) { const v4u x = qp[i]; q[8 * i] = bflo(x.x); q[8 * i + 1] = bfhi(x.x); q[8 * i + 2] = bflo(x.y); q[8 * i + 3] = bfhi(x.y);
              q[8 * i + 4] = bflo(x.z); q[8 * i + 5] = bfhi(x.z); q[8 * i + 6] = bflo(x.w); q[8 * i + 7] = bfhi(x.w); } }
        float v0 = -3e38f, v1 = -3e38f, v2 = -3e38f; int i0 = -1, i1 = -1, i2 = -1;
        for (int j = 0; j < blk; ++j) { const float* kp = km + (size_t)((b * NH + h) * NBLK + j) * HD; float g = 0.f;
#pragma unroll
            for (int d = 0; d < 64; ++d) g += q[d] * kp[d];
            if (g > v0) { v2 = v1; i2 = i1; v1 = v0; i1 = i0; v0 = g; i0 = j; }
            else if (g > v1) { v2 = v1; i2 = i1; v1 = g; i1 = j; }
            else if (g > v2) { v2 = g; i2 = j; } }
        float* lp = lse + ((size_t)t * NH + h) * 4;
        if (i0 < 0) lp[0] = -1e30f; if (i1 < 0) lp[1] = -1e30f; if (i2 < 0) lp[2] = -1e30f;
        for (int j = 0; j < blk; ++j) {
            const bool sel = (i0 == j) || (i1 == j) || (i2 == j);
            const unsigned long long mask = __ballot(sel);
            if (mask) { const int leader = __ffsll((long long)mask) - 1; const int bucket = (b * NH + h) * NBLK + j;
                unsigned base = 0u;
                if (L == leader) base = __hip_atomic_fetch_add(bcnt + bucket, (unsigned)__popcll(mask), RLX_AGENT);
                base = (unsigned)__shfl((int)base, leader);
                if (sel) { const unsigned pos = base + (unsigned)__popcll(mask & ((1ull << L) - 1ull)); const unsigned slot = (i0 == j) ? 0u : ((i1 == j) ? 1u : 2u);
                    list[(size_t)bucket * ALCAP + pos] = ((unsigned)tt << 2) | slot; } }
        }
    }
}

__device__ __forceinline__ unsigned cvtpk(float lo, float hi) { typedef float f32x2_t __attribute__((ext_vector_type(2))); typedef __bf16 bf16x2_t __attribute__((ext_vector_type(2)));
    f32x2_t v = {lo, hi}; bf16x2_t r = __builtin_convertvector(v, bf16x2_t); return __builtin_bit_cast(unsigned, r); }

constexpr int AT_KROW = 144, AT_VROW = 520, AT_KOFF = 0, AT_VOFF = 256 * AT_KROW;
__device__ __forceinline__ void attn_item(Frame& F, int b, int h, int j, bool own, const unsigned* lst, int nvalid) {
    const int tid = F.tid, L = F.lane, r = L & 31, hh = L >> 5, wv = F.wave;
    LAS unsigned char* Kl = F.lds + AT_KOFF; LAS unsigned char* Vl = F.lds + AT_VOFF;
    const bf16* Kg = WSP(bf16, WS_K) + ((size_t)(b * SEQ + j * 256)) * AW + h * 64;
    const bf16* Vg = WSP(bf16, WS_VT) + ((size_t)((b * NH + h) * HD)) * SEQ + j * 256;
    v4u kr[4], vr[4];
#pragma unroll
    for (int i = 0; i < 4; ++i) { const int idx = tid + 512 * i; kr[i] = *(const v4u*)(Kg + (size_t)(idx >> 3) * AW + (idx & 7) * 8); vr[i] = *(const v4u*)(Vg + (size_t)(idx >> 5) * SEQ + (idx & 31) * 8); }
    const int qi = wv * 32 + r; const bool valid = qi < nvalid;
    unsigned ent; if (own) ent = ((unsigned)(j * 256 + qi) << 2) | 3u; else ent = lst[valid ? qi : 0];
    const int tt = (int)(ent >> 2), slot = (int)(ent & 3u), t = b * SEQ + tt;
    bf16x8 qf[4];
    { const bf16* qp = WSP(bf16, WS_Q) + (size_t)t * AW + h * 64 + hh * 8;
#pragma unroll
      for (int d0 = 0; d0 < 4; ++d0) qf[d0] = *(const bf16x8*)(qp + d0 * 16); }
#pragma unroll
    for (int i = 0; i < 4; ++i) { const int idx = tid + 512 * i; *(LAS v4u*)(Kl + (idx >> 3) * AT_KROW + (idx & 7) * 16) = kr[i]; *(LAS v4u*)(Vl + (idx >> 5) * AT_VROW + (idx & 31) * 16) = vr[i]; }
    __syncthreads();
#ifdef ATT_STAGGER
    if (wv >= 4) __builtin_amdgcn_s_sleep(ATT_STAGGER);
#endif
#ifdef ATT_REP_COMPUTE
    for (int arep = 0; arep < 2; ++arep)
#endif
    if (wv * 32 < nvalid) {
        float m = -1e30f, l = 0.f; f32x16 O0 = {}, O1 = {};
        const int qrel = tt & 255;
#pragma unroll
        for (int hk = 0; hk < 2; ++hk) {
            if (own && hk * 4 > wv) continue;
            f32x16 S[4];
#pragma unroll
            for (int kt = 0; kt < 4; ++kt) S[kt] = (f32x16){};
#pragma unroll
            for (int d0 = 0; d0 < 4; ++d0) {
#pragma unroll
                for (int kt = 0; kt < 4; ++kt) { const bf16x8 kf = *(const LAS bf16x8*)(Kl + (hk * 128 + kt * 32 + r) * AT_KROW + d0 * 32 + hh * 16);
                    S[kt] = __builtin_amdgcn_mfma_f32_32x32x16_bf16(kf, qf[d0], S[kt], 0, 0, 0); }
                if (d0 & 1) __builtin_amdgcn_sched_barrier(0); }
            if (own) {
                asm volatile("; causal masking (own block only)" ::: "memory");
#pragma unroll
                for (int kt = 0; kt < 4; ++kt)
#pragma unroll
                    for (int rg = 0; rg < 16; ++rg) { const int key = hk * 128 + kt * 32 + (rg & 3) + 8 * (rg >> 2) + 4 * hh; if (key > qrel) S[kt][rg] = -1e30f; } }
            float mx = S[0][0];
#pragma unroll
            for (int kt = 0; kt < 4; ++kt)
#pragma unroll
                for (int rg = 0; rg < 16; ++rg) mx = fmaxf(mx, S[kt][rg]);
            mx = fmaxf(mx, __shfl_xor(mx, 32));
            const float mn = fmaxf(m, mx), alpha = __builtin_amdgcn_exp2f(m - mn); m = mn; l *= alpha;
#pragma unroll
            for (int rg = 0; rg < 16; ++rg) { O0[rg] *= alpha; O1[rg] *= alpha; }
            float ls = 0.f;
#pragma unroll
            for (int kt = 0; kt < 4; ++kt) {
                unsigned pw[8];
#pragma unroll
                for (int rg = 0; rg < 16; rg += 2) { const float p0 = __builtin_amdgcn_exp2f(S[kt][rg] - mn), p1 = __builtin_amdgcn_exp2f(S[kt][rg + 1] - mn); ls += p0 + p1; pw[rg >> 1] = cvtpk(p0, p1); }
#pragma unroll
                for (int s = 0; s < 2; ++s) {
                    const v4u pv = {pw[4 * s], pw[4 * s + 1], pw[4 * s + 2], pw[4 * s + 3]}; const bf16x8 pf = __builtin_bit_cast(bf16x8, pv);
                    const int kb = (hk * 128 + kt * 32 + 16 * s + 4 * hh) * 2;
                    { const LAS unsigned char* vp = Vl + r * AT_VROW + kb; const v2u lo = *(const LAS v2u*)vp, hi = *(const LAS v2u*)(vp + 16);
                      const v4u vv = {lo.x, lo.y, hi.x, hi.y}; O0 = __builtin_amdgcn_mfma_f32_32x32x16_bf16(__builtin_bit_cast(bf16x8, vv), pf, O0, 0, 0, 0); }
                    { const LAS unsigned char* vp = Vl + (32 + r) * AT_VROW + kb; const v2u lo = *(const LAS v2u*)vp, hi = *(const LAS v2u*)(vp + 16);
                      const v4u vv = {lo.x, lo.y, hi.x, hi.y}; O1 = __builtin_amdgcn_mfma_f32_32x32x16_bf16(__builtin_bit_cast(bf16x8, vv), pf, O1, 0, 0, 0); } } }
            l += ls;
        }
        l += __shfl_xor(l, 32);
        if (valid) {
            const float rl = 1.f / l;
            bf16* op = (slot < 2 ? WSP(bf16, WS_OP01) + (((size_t)t * NH + h) * 2 + slot) * 64 : WSP(bf16, WS_OP23) + (((size_t)t * NH + h) * 2 + (slot - 2)) * 64) + 4 * hh;
#pragma unroll
            for (int g4 = 0; g4 < 4; ++g4) { v2u w0, w1; w0.x = cvtpk(O0[4 * g4] * rl, O0[4 * g4 + 1] * rl); w0.y = cvtpk(O0[4 * g4 + 2] * rl, O0[4 * g4 + 3] * rl);
                w1.x = cvtpk(O1[4 * g4] * rl, O1[4 * g4 + 1] * rl); w1.y = cvtpk(O1[4 * g4 + 2] * rl, O1[4 * g4 + 3] * rl);
                *(v2u*)(op + 8 * g4) = w0; *(v2u*)(op + 32 + 8 * g4) = w1; }
            if (hh == 0) WSP(float, WS_LSE)[((size_t)t * NH + h) * 4 + slot] = m + log2f(l);
        }
    }
    __syncthreads();
}
__device__ __forceinline__ void attn_items(Frame& F) {
    LAS int* pre = (LAS int*)(F.lds + 72 * 1024);
    const unsigned* bcnt = (const unsigned*)(F.ctl + CW_BCNT);
    LAS int* cntl = pre + 520;
    for (int i = F.tid; i < 512; i += NWAVES * 64) cntl[i] = (int)__hip_atomic_load((gu32*)(F.ctl + CW_BCNT) + i, RLX_AGENT);
    __syncthreads();
    if (F.tid == 0) { int a = 0; for (int i = 0; i < 512; ++i) { pre[i] = a; a += (cntl[i] + 255) >> 8; } pre[512] = a; }
    __syncthreads();
    const int total = 512 + pre[512];
    for (int it = (int)blockIdx.x; it < total; it += F.G) {
        int bh, j, n; bool own; const unsigned* lst;
        if (it < 512) { bh = it >> 5; j = it & 31; own = true; lst = nullptr; n = 256; }
        else { const int s = it - 512; int lo = 0, hi = 512;
            while (hi - lo > 1) { const int mid = (lo + hi) >> 1; if (pre[mid] <= s) lo = mid; else hi = mid; }
            const int bucket = lo, tile = s - pre[bucket]; n = cntl[bucket] - tile * 256; n = n > 256 ? 256 : n; bh = bucket >> 5; j = bucket & 31; own = false;
            lst = WSP(unsigned, WS_ALIST) + (size_t)bucket * ALCAP + tile * 256; }
        const int b_ = __builtin_amdgcn_readfirstlane(bh >> 3), h_ = __builtin_amdgcn_readfirstlane(bh & 7), j_ = __builtin_amdgcn_readfirstlane(j), n_ = __builtin_amdgcn_readfirstlane(n);
        attn_item(F, b_, h_, j_, own, lst, n_);
    }
}
__device__ __forceinline__ void attn_combine(Frame& F) {
    if (F.G == 256 && blockIdx.x < 128) return;
    const int nb = F.G == 256 ? 128 : F.G, bi = F.G == 256 ? (int)blockIdx.x - 128 : F.vcu;
    const int gw = bi * NWAVES + F.wave, NGW = nb * NWAVES, L = F.lane, h = L >> 3, ch = L & 7;
    const float* lse = WSP(float, WS_LSE); bf16* YA = WSP(bf16, WS_YA);
    for (int t = gw; t < T; t += NGW) {
        const size_t th = (size_t)t * NH + h;
        const f32x4 ls = *(const f32x4*)(lse + th * 4);
        const float mx = fmaxf(fmaxf(ls[0], ls[1]), fmaxf(ls[2], ls[3]));
        const float w0 = __builtin_amdgcn_exp2f(ls[0] - mx), w1 = __builtin_amdgcn_exp2f(ls[1] - mx), w2 = __builtin_amdgcn_exp2f(ls[2] - mx), w3 = __builtin_amdgcn_exp2f(ls[3] - mx), inv = 1.f / (w0 + w1 + w2 + w3);
        const v4u a0 = __builtin_nontemporal_load((const v4u*)(WSP(bf16, WS_OP01) + (th * 2 + 0) * 64 + ch * 8)), a1 = __builtin_nontemporal_load((const v4u*)(WSP(bf16, WS_OP01) + (th * 2 + 1) * 64 + ch * 8));
        const v4u a2 = __builtin_nontemporal_load((const v4u*)(WSP(bf16, WS_OP23) + (th * 2 + 0) * 64 + ch * 8)), a3 = __builtin_nontemporal_load((const v4u*)(WSP(bf16, WS_OP23) + (th * 2 + 1) * 64 + ch * 8));
        float o[8];
        const unsigned x0[4] = {a0.x, a0.y, a0.z, a0.w}, x1[4] = {a1.x, a1.y, a1.z, a1.w}, x2[4] = {a2.x, a2.y, a2.z, a2.w}, x3[4] = {a3.x, a3.y, a3.z, a3.w};
#pragma unroll
        for (int i = 0; i < 4; ++i) {
            float lo_ = w3 * bflo(x3[i]), hi_ = w3 * bfhi(x3[i]);
            if (ls[0] > -1e29f) { lo_ += w0 * bflo(x0[i]); hi_ += w0 * bfhi(x0[i]); }
            if (ls[1] > -1e29f) { lo_ += w1 * bflo(x1[i]); hi_ += w1 * bfhi(x1[i]); }
            if (ls[2] > -1e29f) { lo_ += w2 * bflo(x2[i]); hi_ += w2 * bfhi(x2[i]); }
            o[2 * i] = lo_ * inv; o[2 * i + 1] = hi_ * inv; }
        v4u w; w.x = cvtpk(o[0], o[1]); w.y = cvtpk(o[2], o[3]); w.z = cvtpk(o[4], o[5]); w.w = cvtpk(o[6], o[7]);
        *(v4u*)(YA + (size_t)t * AW + h * 64 + ch * 8) = w;
    }
}
struct S5Order { static constexpr bool GATHER = false; int G, c;
    __device__ __forceinline__ void a_ready(const pg8::Unit&) const {}
    __device__ __forceinline__ void done(const pg8::Unit&) const {}
    __device__ __forceinline__ bool next(int i, pg8::Unit& u) const { const int L = i * G + c; if (L >= NG * 4) return false; const int g = L >> 2, rt = L & 3;
        u.arow = g * 1024 + rt * 256; u.brow = g * 256; u.pm = rt; u.pn = 0; u.e = g; u.nrow = 256; u.kind = 0; u.aux = 0; return true; } };
struct EpiS5A { float* E;
    __device__ __forceinline__ void operator()(const pg8::f32x4 (&acc)[2][2][4][2], const pg8::Unit& u, int wr, int wc, int fr, int fq) const {
        asm volatile("" : "+v"(fr), "+v"(fq));
#pragma unroll
        for (int ai = 0; ai < 2; ++ai)
#pragma unroll
            for (int m = 0; m < 4; ++m) { float* p = E + (size_t)(u.arow + ai * 128 + wr * 64 + m * 16 + fr) * 128 + wc * 32 + 8 * fq;
                *(pg8::f32x4*)p = acc[ai][0][m][0]; *(pg8::f32x4*)(p + 4) = acc[ai][0][m][1]; }
    }
};
struct EpiS5C { bf16* YG;
    __device__ __forceinline__ void operator()(const pg8::f32x4 (&acc)[2][2][4][2], const pg8::Unit& u, int wr, int wc, int fr, int fq) const {
        asm volatile("" : "+v"(fr), "+v"(fq));
        const int g = u.e, n0 = wc * 32 + 8 * fq, t0 = n0 >> 4, co0 = n0 & 15;
#pragma unroll
        for (int ai = 0; ai < 2; ++ai)
#pragma unroll
            for (int m = 0; m < 4; ++m) { const int row = u.pm * 256 + ai * 128 + wr * 64 + m * 16 + fr, b = row >> 9, c = row & 511;
                bf16* yp = YG + (size_t)(b * SEQ + 16 * c + t0) * SW + 16 * g + co0;
#pragma unroll
                for (int bj = 0; bj < 2; ++bj) {
                    const pg8::f32x4 v0 = acc[ai][bj][m][0], v1 = acc[ai][bj][m][1];
                    v4u w; w.x = pk2(gelu_tanh(v0[0]), gelu_tanh(v0[1])); w.y = pk2(gelu_tanh(v0[2]), gelu_tanh(v0[3]));
                    w.z = pk2(gelu_tanh(v1[0]), gelu_tanh(v1[1])); w.w = pk2(gelu_tanh(v1[2]), gelu_tanh(v1[3]));
                    *(v4u*)(yp + (size_t)bj * 8 * SW) = w; }
                __builtin_amdgcn_sched_barrier(0); }
    }
};
__device__ __forceinline__ void s5_fill_kt(Frame& F) {
    const int gt = F.vcu * (NWAVES * 64) + F.tid, NGT = F.G * NWAVES * 64;
    const float* P5 = WSP(float, WS_S5P); const float* PWr = P5 + 131072; const float* PWi = PWr + 2048 * 17; const float* par = WSP(float, WS_PAR);
    float* KT = WSP(float, WS_S5KT);
    for (int i = gt; i < NG * 16 * 256; i += NGT) { const int ci = i & 15, co = (i >> 4) & 15, tau = (i >> 8) & 15, g = i >> 12; float a = 0.f;
        for (int p = 0; p < 64; ++p) { const int gp = g * 64 + p;
            const float qr = P5[8192 + gp], qi = P5[8192 + 2048 + gp], b_r = par[PAR_BRE + gp * 16 + ci], b_i = par[PAR_BIM + gp * 16 + ci];
            const float bbr = qr * b_r - qi * b_i, bbi = qr * b_i + qi * b_r, wr_ = PWr[gp * 17 + tau], wi_ = PWi[gp * 17 + tau];
            const float xr = wr_ * bbr - wi_ * bbi, xi = wr_ * bbi + wi_ * bbr;
            const float cr = par[PAR_CRE + (g * 16 + co) * 64 + p], ci_ = par[PAR_CIM + (g * 16 + co) * 64 + p];
            a += cr * xr - ci_ * xi; }
        KT[i] = a; }
}
__device__ __forceinline__ void s5_fill_wc(Frame& F) {
    const int gt = F.vcu * (NWAVES * 64) + F.tid, NGT = F.G * NWAVES * 64;
    const float* P5 = WSP(float, WS_S5P); const float* PWr = P5 + 131072; const float* PWi = PWr + 2048 * 17; const float* KT = WSP(float, WS_S5KT); const float* par = WSP(float, WS_PAR);
    bf16* Wc = WSP(bf16, WS_S5WC);
    for (int i = gt; i < NG * 256 * 384; i += NGT) { const int k = i % 384, n = (i / 384) & 255, g = i / (384 * 256), t = n >> 4, co = n & 15; float val = 0.f;
        if (k < 256) { const int s_ = k >> 4, ci = k & 15;
            if (s_ <= t) val = KT[((g * 16 + (t - s_)) * 16 + co) * 16 + ci];
            if (s_ == t && ci == co) val += par[PAR_SD + g * 16 + co]; }
        else { const int p = (k - 256) & 63, gp = g * 64 + p; const float cr = par[PAR_CRE + (g * 16 + co) * 64 + p], ci_ = par[PAR_CIM + (g * 16 + co) * 64 + p];
            const float wr_ = PWr[gp * 17 + t + 1], wi_ = PWi[gp * 17 + t + 1];
            val = (k < 320) ? (cr * wr_ - ci_ * wi_) : -(cr * wi_ + ci_ * wr_); }
        Wc[((size_t)(g * 256 + perm8(n))) * 384 + k] = (bf16)f2bf(val); }
}
__device__ __forceinline__ void s5_carry(Frame& F) {
    const float* P5 = WSP(float, WS_S5P); const float* PWr = P5 + 131072; const float* PWi = PWr + 2048 * 17; const float* E = WSP(float, WS_S5E); bf16* UA = WSP(bf16, WS_UA);
    LAS float* Z = (LAS float*)(F.lds);
    const int seg = F.wave, p = F.lane;
    for (int bg = F.vcu; bg < BATCH * NG; bg += F.G) { const int b = bg / NG, g = bg % NG, gp = g * 64 + p;
        const float ar = PWr[gp * 17 + 16], ai = PWi[gp * 17 + 16];
        const size_t row0 = (size_t)g * 1024 + b * 512 + seg * 64;
        float zr = 0.f, zi = 0.f;
        for (int c0 = 0; c0 < 64; c0 += 8) { float er[8], ei[8];
#pragma unroll
            for (int k = 0; k < 8; ++k) { er[k] = E[(row0 + c0 + k) * 128 + p]; ei[k] = E[(row0 + c0 + k) * 128 + 64 + p]; }
#pragma unroll
            for (int k = 0; k < 8; ++k) { const float nr = ar * zr - ai * zi + er[k], ni = ar * zi + ai * zr + ei[k]; zr = nr; zi = ni; } }
        Z[(seg * 64 + p) * 2] = zr; Z[(seg * 64 + p) * 2 + 1] = zi;
        __syncthreads();
        if (seg == 0) { float br = ar, bi = ai;
#pragma unroll
            for (int k = 0; k < 6; ++k) { const float tr = br * br - bi * bi, ti = 2.f * br * bi; br = tr; bi = ti; }
            float sr = 0.f, si = 0.f;
            for (int sg = 0; sg < 8; ++sg) { const float xr = Z[(sg * 64 + p) * 2], xi = Z[(sg * 64 + p) * 2 + 1]; Z[(sg * 64 + p) * 2] = sr; Z[(sg * 64 + p) * 2 + 1] = si;
                const float nr = br * sr - bi * si + xr, ni = br * si + bi * sr + xi; sr = nr; si = ni; } }
        __syncthreads();
        float sr = Z[(seg * 64 + p) * 2], si = Z[(seg * 64 + p) * 2 + 1];
        for (int c0 = 0; c0 < 64; c0 += 8) { float er[8], ei[8];
#pragma unroll
            for (int k = 0; k < 8; ++k) { er[k] = E[(row0 + c0 + k) * 128 + p]; ei[k] = E[(row0 + c0 + k) * 128 + 64 + p]; }
#pragma unroll
            for (int k = 0; k < 8; ++k) { bf16* up = UA + (row0 + c0 + k) * 384 + 256 + p; up[0] = (bf16)f2bf(sr); up[64] = (bf16)f2bf(si);
                const float nr = ar * sr - ai * si + er[k], ni = ar * si + ai * sr + ei[k]; sr = nr; si = ni; } }
        __syncthreads();
    }
}
constexpr int SCR_OFF = LDSCTL_OFF + 512;
#ifndef MOE_LAG
#define MOE_LAG 2
#endif
constexpr int MT_SEG = 100, MT_MAXSEG = 72, MT_ULIST = 400, MT_MAXU = 16;
__device__ __forceinline__ void phase_rows(Frame& F, bool dry = false) {
    LAS float* h2t = (LAS float*)(F.lds);
    LAS float* lg = (LAS float*)(F.lds + 65536);
    LAS float* gtm = (LAS float*)(F.lds + 131072);
    LAS float* pg2 = gtm + 2 * D; LAS float* shf = pg2 + 2 * D;
    LAS unsigned* hist = (LAS unsigned*)(F.lds + SCR_OFF); LAS unsigned* base = hist + 32; LAS int* rec_e = (LAS int*)(base + 32); LAS int* rec_lp = rec_e + 256;
    const float* adaf = WSP(float, WS_ADAF); const float* par = WSP(float, WS_PAR);
    const int L = F.lane, wv = F.wave;
    for (int i = F.tid; i < 2 * D; i += NWAVES * 64) { const int b = i >> 10, k = i & (D - 1);
        gtm[i] = adaf[b * 6 * D + 2 * D + k] * par[PAR_MPG + k];
        pg2[i] = par[PAR_FPRE + k] * (1.f + adaf[b * 6 * D + 4 * D + k]); shf[i] = adaf[b * 6 * D + 3 * D + k]; }
    f32x4 wreg[16];
#pragma unroll
    for (int j = 0; j < 4; ++j)
#pragma unroll
        for (int i = 0; i < 4; ++i) wreg[j * 4 + i] = *(const f32x4*)(par + PAR_RW + (4 * L + 256 * j + i) * NE + 4 * wv);
    if (F.tid < 32) hist[F.tid] = 0u;
    __syncthreads();
    const float* mix = WSP(float, WS_MIX); bf16* H2 = WSP(bf16, WS_H2);
    int* tok_e = WSP(int, WS_ROUTE); float* tok_w = (float*)(tok_e + T * 4); int* tok_pos = tok_e + 2 * T * 4;
    unsigned* gcnt = (unsigned*)(F.ctl + CW_ECNT);
    for (int t0 = F.vcu * 16; t0 < T; t0 += F.G * 16) {
        {
            const int t = t0 + 2 * wv, b = t >> 13;
            f32x4 mv[2][4], xv[2][4];
#pragma unroll
            for (int q = 0; q < 2; ++q) { const GAS f32x4* mr = (const GAS f32x4*)(mix + (size_t)(t + q) * D) + L; const GAS f32x4* xr = (const GAS f32x4*)(F.in[0] + (size_t)(t + q) * D) + L;
#pragma unroll
                for (int j = 0; j < 4; ++j) { mv[q][j] = __builtin_nontemporal_load(mr + 64 * j); xv[q][j] = __builtin_nontemporal_load(xr + 64 * j); } }
#pragma unroll
            for (int q = 0; q < 2; ++q) { float s = 0.f;
#pragma unroll
                for (int j = 0; j < 4; ++j) s += (mv[q][j].x * mv[q][j].x + mv[q][j].y * mv[q][j].y) + (mv[q][j].z * mv[q][j].z + mv[q][j].w * mv[q][j].w);
                const float r1 = 1.f / sqrtf(wave_sum(s) * (1.f / D) + NORM_EPS);
                float s2 = 0.f; GAS f32x4* orow = (GAS f32x4*)(F.out + (size_t)(t + q) * D) + L;
#pragma unroll
                for (int j = 0; j < 4; ++j) { const f32x4 g = *(const LAS f32x4*)(gtm + b * D + 4 * L + 256 * j);
                    xv[q][j] = xv[q][j] + g * (mv[q][j] * r1); __builtin_nontemporal_store(xv[q][j], orow + 64 * j);
                    s2 += (xv[q][j].x * xv[q][j].x + xv[q][j].y * xv[q][j].y) + (xv[q][j].z * xv[q][j].z + xv[q][j].w * xv[q][j].w); }
                const float r2 = 1.f / sqrtf(wave_sum(s2) * (1.f / D) + NORM_EPS);
#ifdef MOE_F8
                GAS unsigned* h4 = (GAS unsigned*)(WSP(unsigned char, WS_H2) + (size_t)(t + q) * D) + L;
#pragma unroll
                for (int j = 0; j < 4; ++j) { const f32x4 a = *(const LAS f32x4*)(pg2 + b * D + 4 * L + 256 * j), c = *(const LAS f32x4*)(shf + b * D + 4 * L + 256 * j);
                    const f32x4 h = xv[q][j] * r2 * a + c;
                    h4[64 * j] = pk4_fp8(8.f * h.x, 8.f * h.y, 8.f * h.z, 8.f * h.w);
                    *(LAS f32x4*)(h2t + (2 * wv + q) * D + 4 * L + 256 * j) = h; } }
#else
                GAS unsigned long long* h8 = (GAS unsigned long long*)(H2 + (size_t)(t + q) * D) + L;
#pragma unroll
                for (int j = 0; j < 4; ++j) { const f32x4 a = *(const LAS f32x4*)(pg2 + b * D + 4 * L + 256 * j), c = *(const LAS f32x4*)(shf + b * D + 4 * L + 256 * j);
                    const f32x4 h = xv[q][j] * r2 * a + c;
                    h8[64 * j] = (unsigned long long)pk2(h.x, h.y) | ((unsigned long long)pk2(h.z, h.w) << 32);
                    *(LAS f32x4*)(h2t + (2 * wv + q) * D + 4 * L + 256 * j) = h; } }
#endif
        }
        __syncthreads();
        {
            const int hi = (L >> 5) & 1, h2b = (L >> 4) & 1;
#pragma unroll 2
            for (int tk = 0; tk < 16; ++tk) {
                f32x4 a = {0.f, 0.f, 0.f, 0.f};
#pragma unroll
                for (int j = 0; j < 4; ++j) { const f32x4 h = *(const LAS f32x4*)(h2t + tk * D + 4 * L + 256 * j);
                    a += wreg[j * 4 + 0] * h.x; a += wreg[j * 4 + 1] * h.y; a += wreg[j * 4 + 2] * h.z; a += wreg[j * 4 + 3] * h.w; }
                const float m0 = hi ? a.z : a.x, o0 = hi ? a.x : a.z, m1 = hi ? a.w : a.y, o1 = hi ? a.y : a.w;
                const float v0 = m0 + __shfl_xor(o0, 32), v1 = m1 + __shfl_xor(o1, 32);
                float v = (h2b ? v1 : v0) + __shfl_xor(h2b ? v0 : v1, 16);
                v += __shfl_xor(v, 8); v += __shfl_xor(v, 4); v += __shfl_xor(v, 2); v += __shfl_xor(v, 1);
                if ((L & 15) == 0) lg[tk * NE + 4 * wv + 2 * hi + h2b] = v;
            }
        }
        __syncthreads();
        {
            const int e = L & 31, half = L >> 5, tl = 2 * wv + half, t = t0 + tl;
            float val = lg[tl * NE + e] + par[PAR_RB + e];
            int se[4]; float sv[4];
#pragma unroll
            for (int r = 0; r < 4; ++r) { float mx = val;
                mx = fmaxf(mx, __shfl_xor(mx, 16)); mx = fmaxf(mx, __shfl_xor(mx, 8)); mx = fmaxf(mx, __shfl_xor(mx, 4)); mx = fmaxf(mx, __shfl_xor(mx, 2)); mx = fmaxf(mx, __shfl_xor(mx, 1));
                const unsigned long long bal = __ballot(val == mx); const unsigned hm = half ? (unsigned)(bal >> 32) : (unsigned)bal; const int win = __ffs((int)hm) - 1;
                se[r] = win; sv[r] = mx; if (e == win) val = -3e38f; }
            const float e1 = __expf(sv[1] - sv[0]), e2 = __expf(sv[2] - sv[0]), e3 = __expf(sv[3] - sv[0]), inv = 1.f / (1.f + e1 + e2 + e3);
            if (e < 4) { const int ex = e == 0 ? se[0] : (e == 1 ? se[1] : (e == 2 ? se[2] : se[3]));
                const float wgt = (e == 0 ? 1.f : (e == 1 ? e1 : (e == 2 ? e2 : e3))) * inv;
                tok_e[t * 4 + e] = ex; tok_w[t * 4 + e] = wgt;
                const unsigned lp = dry ? 0u : __hip_atomic_fetch_add(hist + ex, 1u, __ATOMIC_RELAXED, __HIP_MEMORY_SCOPE_WORKGROUP);
                rec_e[tl * 4 + e] = ex; rec_lp[tl * 4 + e] = (int)lp; }
        }
        __syncthreads();
        if (F.tid < 32) { const unsigned h = hist[F.tid]; base[F.tid] = h ? __hip_atomic_fetch_add(gcnt + F.tid, h, RLX_AGENT) : 0u; }
        __syncthreads();
        if (!dry && F.tid < 64) { const int e_ = rec_e[F.tid], pos_ = (int)base[e_] + rec_lp[F.tid]; tok_pos[(t0 + (F.tid >> 2)) * 4 + (F.tid & 3)] = pos_;
            WSP(int, WS_ELIST)[e_ * ELCAP + pos_] = t0 + (F.tid >> 2); }
        if (F.tid < 32) hist[F.tid] = 0u;
        __syncthreads();
    }
}

__device__ __forceinline__ void moe_tables(Frame& F, int nct = 0, int brows = 0) {
    LAS int* cnt = (LAS int*)(F.lds + SCR_OFF); LAS int* off = cnt + 32; LAS int* tpre = off + 32;
    if (F.tid < NE) cnt[F.tid] = (int)__hip_atomic_load(F.ctl + CW_ECNT + F.tid, RLX_AGENT);
    __syncthreads();
    if (F.tid == 0) { int o = 0, tp = 0;
        for (int e = 0; e < NE; ++e) { const int c = cnt[e]; off[e] = o; tpre[e] = tp; o += c; tp += (c + 255) >> 8; }
        tpre[NE] = tp;
        LAS int* sg = cnt + MT_SEG; const int n = (tp + 31) >> 5; int ns = 0, pos = 0;
        for (int g = 0; g < n; ++g) { const int tg = (tp - 32 * g) < 32 ? (tp - 32 * g) : 32;
            sg[1 + ns] = pos; sg[1 + MT_MAXSEG + ns] = 0; sg[1 + 2 * MT_MAXSEG + ns] = g; ++ns; pos += 8 * tg; sg[1 + 3 * MT_MAXSEG + g] = pos;
            if (g >= MOE_LAG) { sg[1 + ns] = pos; sg[1 + MT_MAXSEG + ns] = 1; sg[1 + 2 * MT_MAXSEG + ns] = g - MOE_LAG; ++ns; pos += 4 * 32; } }
        for (int g = (n > MOE_LAG ? n - MOE_LAG : 0); g < n; ++g) { const int tg = (tp - 32 * g) < 32 ? (tp - 32 * g) : 32; sg[1 + ns] = pos; sg[1 + MT_MAXSEG + ns] = 1; sg[1 + 2 * MT_MAXSEG + ns] = g; ++ns; pos += 4 * tg; }
        sg[1 + ns] = pos; sg[0] = ns; }
    __syncthreads();
    if (nct > 0 && F.G == 256 && F.tid < MT_MAXU) {
        LAS int* ul = cnt + MT_ULIST + 8 * F.tid; const int i = F.tid, c = (int)blockIdx.x, xcd = c & 7, slot = c >> 3, rpx = 32 / nct;
        const int rtg = (i * 8 + xcd) * rpx + slot / nct, pn = slot % nct;
        if (rtg >= tpre[NE]) { ul[0] = -1; }
        else { int e = 0; for (int k = 1; k < NE; ++k) if (tpre[k] <= rtg) e = k;
            const int rt = rtg - tpre[e], nr = cnt[e] - rt * 256;
            ul[0] = off[e] + rt * 256; ul[1] = e * brows + pn * 256; ul[2] = rt; ul[3] = pn; ul[4] = e; ul[5] = nr > 256 ? 256 : nr; } }
    __syncthreads();
}
template <bool GA> struct MoeOrder {
    static constexpr bool GATHER = GA;
#if defined(T_ACQ)
    __device__ __forceinline__ void a_ready(const pg8::Unit&) const { if (!GA) { if (threadIdx.x < 64) { __builtin_amdgcn_fence(__ATOMIC_ACQUIRE, "agent"); asm volatile("s_waitcnt vmcnt(0)" ::: "memory"); } asm volatile("" ::: "memory"); __builtin_amdgcn_s_barrier(); asm volatile("" ::: "memory"); } }
#else
    __device__ __forceinline__ void a_ready(const pg8::Unit&) const {}
#endif
#if defined(T_DRAIN)
    __device__ __forceinline__ void done(const pg8::Unit&) const { if (GA) asm volatile("s_waitcnt vmcnt(0)" ::: "memory"); }
#else
    __device__ __forceinline__ void done(const pg8::Unit&) const {}
#endif
    const LAS int* tab; const int* elist; int nct, brows, G, c;
    __device__ __forceinline__ bool next(int i, pg8::Unit& u) const {
        if (G == 256) { if (i >= MT_MAXU) return false; const LAS int* ul = tab + MT_ULIST + 8 * i; const int a0 = ul[0]; if (a0 < 0) return false;
            u.arow = __builtin_amdgcn_readfirstlane(a0); u.brow = __builtin_amdgcn_readfirstlane(ul[1]); u.pm = __builtin_amdgcn_readfirstlane(ul[2]); u.pn = __builtin_amdgcn_readfirstlane(ul[3]);
            u.e = __builtin_amdgcn_readfirstlane(ul[4]); u.nrow = __builtin_amdgcn_readfirstlane(ul[5]); u.kind = 0; u.aux = 0; return true; }
        int rtg, pn;
        if (false) { const int xcd = c & 7, slot = c >> 3, rpx = 32 / nct;
            rtg = (i * 8 + xcd) * rpx + slot / nct; pn = slot % nct; if (rtg >= tab[64 + NE]) return false; }
        else { const int L = i * G + c, total = tab[64 + NE] * nct; if (L >= total) return false; rtg = L / nct; pn = L % nct; }
        int e = 0;
        for (int k = 1; k < NE; ++k) if (tab[64 + k] <= rtg) e = k;
        const int rt = rtg - tab[64 + e], cnt = tab[e], off = tab[32 + e];
        u.e = __builtin_amdgcn_readfirstlane(e); u.pm = __builtin_amdgcn_readfirstlane(rt); u.pn = pn; u.arow = __builtin_amdgcn_readfirstlane(off + rt * 256); u.brow = __builtin_amdgcn_readfirstlane(e * brows + pn * 256);
        const int nr = cnt - rt * 256; u.nrow = __builtin_amdgcn_readfirstlane(nr > 256 ? 256 : nr); u.kind = 0; u.aux = 0; return true;
    }
    __device__ __forceinline__ int arow_of(const pg8::Unit& u, int r) const { return r < u.nrow ? elist[u.e * ELCAP + u.pm * 256 + r] : 0; }
};
struct EpiGU { bf16* H1; const float* bg; const float* bu;
    __device__ __forceinline__ void operator()(const pg8::f32x4 (&acc)[2][2][4][2], const pg8::Unit& u, int wr, int wc, int fr, int fq) const {
        asm volatile("" : "+v"(fr), "+v"(fq));
        const int f0 = u.pn * 128 + wc * 32 + 8 * fq;
#pragma unroll
        for (int ai = 0; ai < 2; ++ai) {
            int fb = f0; asm volatile("" : "+v"(fb));
            const pg8::f32x4 g0 = *(const pg8::f32x4*)(bg + u.e * FF + fb), g1 = *(const pg8::f32x4*)(bg + u.e * FF + fb + 4);
            const pg8::f32x4 u0 = *(const pg8::f32x4*)(bu + u.e * FF + fb), u1 = *(const pg8::f32x4*)(bu + u.e * FF + fb + 4);
#pragma unroll
            for (int m = 0; m < 4; ++m) { const int r = ai * 128 + wr * 64 + m * 16 + fr;
                const pg8::f32x4 a0 = acc[ai][0][m][0] + g0, a1 = acc[ai][0][m][1] + g1, b0 = acc[ai][1][m][0] + u0, b1 = acc[ai][1][m][1] + u1;
                float gg[8] = {a0[0], a0[1], a0[2], a0[3], a1[0], a1[1], a1[2], a1[3]}, uu[8] = {b0[0], b0[1], b0[2], b0[3], b1[0], b1[1], b1[2], b1[3]}, o[8];
#pragma unroll
                for (int i = 0; i < 8; ++i) { const float g = fminf(gg[i], 7.f), up = fminf(fmaxf(uu[i], -7.f), 7.f); o[i] = g * sigmoidf_(1.702f * g) * (up + 1.f); }
                v4u w; w.x = pk2(o[0], o[1]); w.y = pk2(o[2], o[3]); w.z = pk2(o[4], o[5]); w.w = pk2(o[6], o[7]);
#ifdef T_SC1
                if (r < u.nrow) __builtin_amdgcn_raw_buffer_store_b128(w, __builtin_amdgcn_make_buffer_rsrc(H1, 0, (int)((size_t)T * TOPK * FF * 2), 0x00020000), (unsigned)((u.arow + r) * (FF * 2) + fb * 2), 0, 16); } }
#else
                if (r < u.nrow) *(v4u*)(H1 + (size_t)(u.arow + r) * FF + fb) = w; } }
#endif
    }
};
struct EpiDn { bf16* YB; const float* bd;
    __device__ __forceinline__ void operator()(const pg8::f32x4 (&acc)[2][2][4][2], const pg8::Unit& u, int wr, int wc, int fr, int fq) const {
        const int c0 = u.pn * 256 + wc * 32 + 8 * fq;
#pragma unroll
        for (int bj = 0; bj < 2; ++bj) { const pg8::f32x4 d0 = *(const pg8::f32x4*)(bd + u.e * D + c0 + bj * 128), d1 = *(const pg8::f32x4*)(bd + u.e * D + c0 + bj * 128 + 4);
#pragma unroll
            for (int ai = 0; ai < 2; ++ai)
#pragma unroll
                for (int m = 0; m < 4; ++m) { const int r = ai * 128 + wr * 64 + m * 16 + fr;
                    const pg8::f32x4 a0 = acc[ai][bj][m][0] + d0, a1 = acc[ai][bj][m][1] + d1;
                    v4u w; w.x = pk2(a0[0], a0[1]); w.y = pk2(a0[2], a0[3]); w.z = pk2(a1[0], a1[1]); w.w = pk2(a1[2], a1[3]);
                    if (r < u.nrow) *(v4u*)(YB + (size_t)(u.arow + r) * D + c0 + bj * 128) = w; } }
    }
};
struct EpiGU8 { unsigned char* H1; const float* bg; const float* bu; const float* wscp;
    static constexpr bool BIAS_LDS = true;
    __device__ __forceinline__ void stage_bias(PG8_LAS unsigned char* dst, const pg8::Unit& u, int wid, int lane) const {
        if (wid < 4) { const float* src = (wid < 2 ? bg : bu) + u.e * FF + u.pn * 128 + (wid & 1) * 64 + lane;
            __builtin_amdgcn_global_load_lds((const unsigned*)src, (PG8_LAS unsigned*)(dst + wid * 256), 4, 0, 0); } }
    __device__ __forceinline__ void operator()(const pg8::f32x4 (&acc)[2][2][4][2], const pg8::Unit& u, int wr, int wc, int fr, int fq, const PG8_LAS float* bl) const {
        asm volatile("" : "+v"(fr), "+v"(fq));
        const int fl = wc * 32 + 8 * fq, f0 = u.pn * 128 + fl; const float sr = 0.125f / *wscp;
        const pg8::f32x4 g0 = *(const PG8_LAS pg8::f32x4*)(bl + fl), g1 = *(const PG8_LAS pg8::f32x4*)(bl + fl + 4), u0 = *(const PG8_LAS pg8::f32x4*)(bl + 128 + fl), u1 = *(const PG8_LAS pg8::f32x4*)(bl + 128 + fl + 4);
#pragma unroll
        for (int ai = 0; ai < 2; ++ai)
#pragma unroll
            for (int m = 0; m < 4; ++m) { const int r = ai * 128 + wr * 64 + m * 16 + fr;
                const pg8::f32x4 a0 = acc[ai][0][m][0] * sr + g0, a1 = acc[ai][0][m][1] * sr + g1, b0 = acc[ai][1][m][0] * sr + u0, b1 = acc[ai][1][m][1] * sr + u1;
                float gg[8] = {a0[0], a0[1], a0[2], a0[3], a1[0], a1[1], a1[2], a1[3]}, uu[8] = {b0[0], b0[1], b0[2], b0[3], b1[0], b1[1], b1[2], b1[3]}, o[8];
#pragma unroll
                for (int i = 0; i < 8; ++i) { const float g = fminf(gg[i], 7.f), up = fminf(fmaxf(uu[i], -7.f), 7.f); o[i] = 8.f * (g * sigmoidf_(1.702f * g) * (up + 1.f)); }
                v2u w; w.x = pk4_fp8(o[0], o[1], o[2], o[3]); w.y = pk4_fp8(o[4], o[5], o[6], o[7]);
                if (r < u.nrow) *(v2u*)(H1 + (size_t)(u.arow + r) * FF + f0) = w; }
    }
};
struct EpiDn8 { bf16* YB; const float* bd; const float* wscp;
    static constexpr bool BIAS_LDS = true;
    __device__ __forceinline__ void stage_bias(PG8_LAS unsigned char* dst, const pg8::Unit& u, int wid, int lane) const {
        if (wid < 4) { const float* src = bd + u.e * D + u.pn * 256 + wid * 64 + lane;
            __builtin_amdgcn_global_load_lds((const unsigned*)src, (PG8_LAS unsigned*)(dst + wid * 256), 4, 0, 0); } }
    __device__ __forceinline__ void operator()(const pg8::f32x4 (&acc)[2][2][4][2], const pg8::Unit& u, int wr, int wc, int fr, int fq, const PG8_LAS float* bl) const {
        const int cl = wc * 32 + 8 * fq, c0 = u.pn * 256 + cl; const float sc = 0.125f / *wscp;
#pragma unroll
        for (int bj = 0; bj < 2; ++bj) { const pg8::f32x4 d0 = *(const PG8_LAS pg8::f32x4*)(bl + cl + bj * 128), d1 = *(const PG8_LAS pg8::f32x4*)(bl + cl + bj * 128 + 4);
#pragma unroll
            for (int ai = 0; ai < 2; ++ai)
#pragma unroll
                for (int m = 0; m < 4; ++m) { const int r = ai * 128 + wr * 64 + m * 16 + fr;
                    const pg8::f32x4 a0 = acc[ai][bj][m][0] * sc + d0, a1 = acc[ai][bj][m][1] * sc + d1;
                    v4u w; w.x = pk2(a0[0], a0[1]); w.y = pk2(a0[2], a0[3]); w.z = pk2(a1[0], a1[1]); w.w = pk2(a1[2], a1[3]);
                    if (r < u.nrow) *(v4u*)(YB + (size_t)(u.arow + r) * D + c0 + bj * 128) = w; } }
    }
};
constexpr int CW_RDY = 8448;
constexpr int H2ROW0 = (int)(WS_H2 / 2048), H1ROW0 = (int)(WS_H1 / 2048), DN_BROW0 = (int)((WS_WDN_T - WS_WGU_T) / 2048);
struct MoeFused {
    static constexpr bool GATHER = true;
    const LAS int* tab; const int* elist; gu32* ctl; int G, c, base;
    __device__ __forceinline__ bool next(int i, pg8::Unit& u) const {
        const LAS int* sg = tab + MT_SEG; const int ns = sg[0], L = (base + i) * G + c; if (L >= sg[1 + ns]) return false;
        int s = 0; for (int k = 1; k < ns; ++k) if (sg[1 + k] <= L) s = k;
        if (i > 0 && sg[1 + MT_MAXSEG + s] == 1 && L - sg[1 + 3 * MT_MAXSEG + sg[1 + 2 * MT_MAXSEG + s]] < G) return false;
        const int kind = sg[1 + MT_MAXSEG + s], g = sg[1 + 2 * MT_MAXSEG + s], ui = L - sg[1 + s], TT = tab[64 + NE], tg = (TT - 32 * g) < 32 ? (TT - 32 * g) : 32;
        int rt, pn;
        if (kind == 0) { if (tg == 32) { const int xcd = ui & 7, slot = ui >> 3; rt = xcd * 4 + (slot >> 3); pn = slot & 7; } else { rt = ui >> 3; pn = ui & 7; } }
        else { if (tg == 32) { const int xcd = ui & 7, slot = ui >> 3; rt = xcd * 4 + (slot >> 2); pn = slot & 3; } else { rt = ui >> 2; pn = ui & 3; } }
        const int rtg = 32 * g + rt; int e = 0;
        for (int k = 1; k < NE; ++k) if (tab[64 + k] <= rtg) e = k;
        const int rte = rtg - tab[64 + e], cnt = tab[e], off = tab[32 + e], nr = cnt - rte * 256;
        u.e = __builtin_amdgcn_readfirstlane(e); u.pm = __builtin_amdgcn_readfirstlane(rte); u.pn = __builtin_amdgcn_readfirstlane(pn); u.kind = __builtin_amdgcn_readfirstlane(kind); u.aux = __builtin_amdgcn_readfirstlane(rtg);
        u.arow = __builtin_amdgcn_readfirstlane(off + rte * 256); u.nrow = __builtin_amdgcn_readfirstlane(nr > 256 ? 256 : nr);
        u.brow = __builtin_amdgcn_readfirstlane(kind == 0 ? e * 2048 + pn * 256 : DN_BROW0 + e * 1024 + pn * 256); return true;
    }
    __device__ __forceinline__ int arow_of(const pg8::Unit& u, int r) const { return u.kind == 0 ? H2ROW0 + (r < u.nrow ? elist[u.e * ELCAP + u.pm * 256 + r] : 0) : H1ROW0 + u.arow + (r < u.nrow ? r : 0); }
    __device__ __forceinline__ void a_ready(const pg8::Unit& u) const {
        if (u.kind != 1) return;
        if (threadIdx.x < 64) {
            gu32* w = ctl + CW_RDY + u.aux; const unsigned long long t0 = __builtin_amdgcn_s_memrealtime();
            while ((unsigned)__builtin_amdgcn_readfirstlane(__hip_atomic_load(w, RLX_AGENT)) < 64u) {
                if (__builtin_amdgcn_s_memrealtime() - t0 > 2000000ull) { if (threadIdx.x == 0) __hip_atomic_store(ctl + CW_TMO, 1u, RLX_AGENT); break; }
                __builtin_amdgcn_s_sleep(2); }
#ifdef MOE_DELAY
            { const unsigned long long t1 = __builtin_amdgcn_s_memrealtime(); while (__builtin_amdgcn_s_memrealtime() - t1 < 2000ull) __builtin_amdgcn_s_sleep(8); }
#endif
            __builtin_amdgcn_fence(__ATOMIC_ACQUIRE, "agent");
            asm volatile("s_waitcnt vmcnt(0)" ::: "memory");
        }
        asm volatile("" ::: "memory"); __builtin_amdgcn_s_barrier(); asm volatile("" ::: "memory");
    }
    __device__ __forceinline__ void done(const pg8::Unit& u) const {
        if (u.kind != 0) return;
#ifndef DIAG_NODRAIN
        asm volatile("s_waitcnt vmcnt(0)" ::: "memory");
#endif
#if defined(MOE_REL)
        __builtin_amdgcn_fence(__ATOMIC_RELEASE, "agent"); asm volatile("s_waitcnt vmcnt(0)" ::: "memory");
#endif
        if ((threadIdx.x & 63) == 0) __hip_atomic_fetch_add(ctl + CW_RDY + u.aux, 1u, RLX_AGENT);
    }
};
struct EpiMoe { bf16* H1; bf16* YB; const float* bg; const float* bu; const float* bd;
    __device__ __forceinline__ void operator()(const pg8::f32x4 (&acc)[2][2][4][2], const pg8::Unit& u, int wr, int wc, int fr, int fq) const {
        asm volatile("" : "+v"(fr), "+v"(fq));
        if (u.kind == 0) {
            const int f0 = u.pn * 128 + wc * 32 + 8 * fq;
            const __amdgpu_buffer_rsrc_t h1rs = __builtin_amdgcn_make_buffer_rsrc(H1, 0, (int)((size_t)T * TOPK * FF * 2), 0x00020000);
#pragma unroll
            for (int ai = 0; ai < 2; ++ai) {
                int fb = f0; asm volatile("" : "+v"(fb));
                const pg8::f32x4 g0 = *(const pg8::f32x4*)(bg + u.e * FF + fb), g1 = *(const pg8::f32x4*)(bg + u.e * FF + fb + 4);
                const pg8::f32x4 u0 = *(const pg8::f32x4*)(bu + u.e * FF + fb), u1 = *(const pg8::f32x4*)(bu + u.e * FF + fb + 4);
#pragma unroll
                for (int m = 0; m < 4; ++m) { const int r = ai * 128 + wr * 64 + m * 16 + fr;
                    const pg8::f32x4 a0 = acc[ai][0][m][0] + g0, a1 = acc[ai][0][m][1] + g1, b0 = acc[ai][1][m][0] + u0, b1 = acc[ai][1][m][1] + u1;
                    float gg[8] = {a0[0], a0[1], a0[2], a0[3], a1[0], a1[1], a1[2], a1[3]}, uu[8] = {b0[0], b0[1], b0[2], b0[3], b1[0], b1[1], b1[2], b1[3]}, o[8];
#pragma unroll
                    for (int i = 0; i < 8; ++i) { const float g = fminf(gg[i], 7.f), up = fminf(fmaxf(uu[i], -7.f), 7.f); o[i] = g * sigmoidf_(1.702f * g) * (up + 1.f); }
#ifdef MOE_PLAIN
                    if (r < u.nrow) { v4u w; w.x = pk2(o[0], o[1]); w.y = pk2(o[2], o[3]); w.z = pk2(o[4], o[5]); w.w = pk2(o[6], o[7]); *(GAS v4u*)(H1 + (size_t)(u.arow + r) * FF + fb) = w; } } }
#else
                    if (r < u.nrow) { v4u w; w.x = pk2(o[0], o[1]); w.y = pk2(o[2], o[3]); w.z = pk2(o[4], o[5]); w.w = pk2(o[6], o[7]);
                        __builtin_amdgcn_raw_buffer_store_b128(w, h1rs, (unsigned)((u.arow + r) * (FF * 2) + fb * 2), 0, 16); } } }
#endif
        } else {
            const int c0 = u.pn * 256 + wc * 32 + 8 * fq;
#pragma unroll
            for (int bj = 0; bj < 2; ++bj) { const pg8::f32x4 d0 = *(const pg8::f32x4*)(bd + u.e * D + c0 + bj * 128), d1 = *(const pg8::f32x4*)(bd + u.e * D + c0 + bj * 128 + 4);
#pragma unroll
                for (int ai = 0; ai < 2; ++ai)
#pragma unroll
                    for (int m = 0; m < 4; ++m) { const int r = ai * 128 + wr * 64 + m * 16 + fr;
                        const pg8::f32x4 a0 = acc[ai][bj][m][0] + d0, a1 = acc[ai][bj][m][1] + d1;
                        v4u w; w.x = pk2(a0[0], a0[1]); w.y = pk2(a0[2], a0[3]); w.z = pk2(a1[0], a1[1]); w.w = pk2(a1[2], a1[3]);
                        if (r < u.nrow) *(GAS v4u*)(YB + (size_t)(u.arow + r) * D + c0 + bj * 128) = w; } }
        }
    }
};
__device__ __forceinline__ void phase_final(Frame& F, bool dry = false) {
    moe_tables(F);
    const LAS int* off = (const LAS int*)(F.lds + SCR_OFF) + 32;
    LAS float* gtf = (LAS float*)(F.lds);
    const float* adaf = WSP(float, WS_ADAF);
    for (int i = F.tid; i < 2 * D; i += NWAVES * 64) { const int b = i >> 10, k = i & (D - 1); gtf[i] = adaf[b * 6 * D + 5 * D + k] * WSP(float, WS_PAR)[PAR_FPOST + k]; }
    __syncthreads();
    const int gw = F.vcu * NWAVES + F.wave, NGW = F.G * NWAVES, L = F.lane;
    const int* tok_e = WSP(int, WS_ROUTE); const float* tok_w = (const float*)(tok_e + T * 4); const int* tok_pos = tok_e + 2 * T * 4;
    const bf16* YB = WSP(bf16, WS_YB);
    for (int t = gw * 2; t < T; t += NGW * 2) { const int b = t >> 13;
        int row_l = 0; float w_l = 0.f;
        if (L < 8) { const int idx = (t + (L >> 2)) * 4 + (L & 3); row_l = off[tok_e[idx]] + tok_pos[idx]; w_l = tok_w[idx]; }
        v2u yv[2][4][4]; f32x4 x1v[2][4]; float wk[2][4];
#pragma unroll
        for (int q = 0; q < 2; ++q) {
#pragma unroll
            for (int k = 0; k < 4; ++k) { const int row = __shfl(row_l, q * 4 + k); wk[q][k] = __shfl(w_l, q * 4 + k);
                const GAS v2u* yr = (const GAS v2u*)(YB + (size_t)row * D) + L;
#pragma unroll
                for (int j = 0; j < 4; ++j) yv[q][k][j] = __builtin_nontemporal_load(yr + 64 * j);
#ifdef DRY14_NOYB
                if (dry) { _Pragma("unroll") for (int j = 0; j < 4; ++j) yv[q][k][j] = (v2u){0x3f803f80u, 0x3f803f80u}; }
#endif
            }
            const GAS f32x4* xr = (const GAS f32x4*)(F.out + (size_t)(t + q) * D) + L;
#pragma unroll
            for (int j = 0; j < 4; ++j) x1v[q][j] = __builtin_nontemporal_load(xr + 64 * j); }
#pragma unroll
        for (int q = 0; q < 2; ++q) {
            f32x4 y[4];
#pragma unroll
            for (int j = 0; j < 4; ++j) y[j] = (f32x4){0.f, 0.f, 0.f, 0.f};
#pragma unroll
            for (int k = 0; k < 4; ++k)
#pragma unroll
                for (int j = 0; j < 4; ++j) { const v2u x = yv[q][k][j]; const float w = wk[q][k]; y[j].x += w * bflo(x.x); y[j].y += w * bfhi(x.x); y[j].z += w * bflo(x.y); y[j].w += w * bfhi(x.y); }
            float s = 0.f;
#pragma unroll
            for (int j = 0; j < 4; ++j) s += (y[j].x * y[j].x + y[j].y * y[j].y) + (y[j].z * y[j].z + y[j].w * y[j].w);
            const float r = 1.f / sqrtf(wave_sum(s) * (1.f / D) + NORM_EPS);
            GAS f32x4* wrow = dry ? (GAS f32x4*)(WSP(float, WS_WGU_T) + (size_t)(t + q) * D) + L : (GAS f32x4*)(F.out + (size_t)(t + q) * D) + L;
#pragma unroll
            for (int j = 0; j < 4; ++j) { const f32x4 g = *(const LAS f32x4*)(gtf + b * D + 4 * L + 256 * j); __builtin_nontemporal_store(x1v[q][j] + g * (y[j] * r), wrow + 64 * j); }
        }
    }
}
__device__ __forceinline__ bool opaque_ws(Frame& F) { asm volatile("" : "+s"(F.ws)); return true; }
#ifndef MK_N_LAUNCHES
#define MK_N_LAUNCHES 1
#endif
constexpr int N_PHASES = 15;
struct Args { const float* in[30]; float* out; unsigned char* ws; int ph_lo, ph_hi; };
__global__ void __launch_bounds__(NWAVES * 64, 2) mega_fwd(Args args) {
    extern __shared__ __attribute__((aligned(16))) unsigned char lds[];
    Frame F;
    F.lds = (LAS unsigned char*)lds;
    F.MISC = (volatile LAS unsigned*)(F.lds + MISC_OFF);
    F.tid = threadIdx.x; F.lane = F.tid & 63; F.wave = __builtin_amdgcn_readfirstlane(F.tid >> 6);
    F.G = gridDim.x; { const int bx = blockIdx.x; F.vcu = (F.G % 8 == 0) ? (bx % 8) * (F.G / 8) + bx / 8 : bx; }
    F.ws = args.ws; F.ctl = (gu32*)(args.ws + WS_CTL); F.out = args.out;
#pragma unroll
    for (int i = 0; i < 30; ++i) F.in[i] = args.in[i];
    for (int u = F.tid; u < (LDS_BYTES - LDSCTL_OFF) / 4; u += NWAVES * 64) ((LAS unsigned*)(F.lds + LDSCTL_OFF))[u] = 0u;
    __syncthreads();
    XcdBarrier bar; bar.bar = (unsigned*)(F.ctl + CW_BAR); bar.x = 0; bar.st = nullptr;
    if (MK_N_LAUNCHES == 1) bar = xcd_barrier_post((unsigned*)(F.ctl + CW_BAR), F.MISC + 8);
    const int lo = args.ph_lo, hi = args.ph_hi;
#ifndef PHMASK
#define PHMASK 0x7fff
#endif
#define IN(k) (((PHMASK >> (k)) & 1) && lo <= (k) && (k) < hi)
#ifdef DBG_A
#define STAMP(k) do { if (blockIdx.x == 0 && F.tid == 0) ((unsigned long long*)(F.ctl + 2048))[k] = __builtin_amdgcn_s_memrealtime(); } while (0)
#else
#define STAMP(k) do {} while (0)
#endif
#ifndef REP_PHASE
#define REP_PHASE -1
#endif
#define REPL(k) for (int rep_ = 0; rep_ < (REP_PHASE == (k) ? 2 : 1); ++rep_) if (opaque_ws(F))
#ifdef DBL_BAR
#define SEAM(k) do { if (IN(k)) { xcd_barrier(bar); xcd_barrier(bar); } STAMP((k) + 1); } while (0)
#else
#define SEAM(k) do { if (IN(k)) xcd_barrier(bar); STAMP((k) + 1); } while (0)
#endif
    PG8_LAS unsigned char* ring = F.lds + RING_OFF;
    const int bx = (int)blockIdx.x;

    STAMP(0);
    if (IN(0)) REPL(0) { phase0(F); } SEAM(0);
    if (IN(1)) REPL(1) { phase1(F); } SEAM(1);
    if (IN(2)) REPL(2) {
#ifdef G1_F8
        pg8::Gemm g{WSP(bf16, WS_XN), WSP(bf16, WS_WIN_T), D / 2, D / 2, D / 2}; pg8::DenseOrder S; S.init(T, INW, F.G, bx);
#else
        pg8::Gemm g{WSP(bf16, WS_XN), WSP(bf16, WS_WIN_T), D, D, D}; pg8::DenseOrder S; S.init(T, INW, F.G, bx);
#endif
        EpiG1 E{WSP(bf16, WS_UA), WSP(bf16, WS_Q), WSP(bf16, WS_K), WSP(bf16, WS_V), WSP(bf16, WS_VT), WSP(bf16, WS_GS), WSP(bf16, WS_GA),
                WSP(float, WS_ROPE), WSP(float, WS_ROPE) + (size_t)T * 32, (float*)(F.ctl + CW_KM), WSP(float, WS_PAR) + PAR_WSC1};
#ifdef G1_F8
        pg8::gemm_phase<EpiG1, pg8::DenseOrder, true>(ring, g, S, E);
#else
        pg8::gemm_phase(ring, g, S, E);
#endif
        s5_fill_kt(F);
    } SEAM(2);
    if (IN(3)) REPL(3) {
        pg8::Gemm g{WSP(bf16, WS_UA), WSP(bf16, WS_S5M1), 384, 256, 256}; S5Order S{F.G, bx}; EpiS5A E{WSP(float, WS_S5E)};
        pg8::gemm_phase(ring, g, S, E);
        s5_fill_wc(F);
        attn_gate(F);
    } SEAM(3);
    if (IN(4)) REPL(4) { attn_items(F); s5_carry(F); } SEAM(4);
    if (IN(5)) REPL(5) {
        pg8::Gemm g{WSP(bf16, WS_UA), WSP(bf16, WS_S5WC), 384, 384, 384}; S5Order S{F.G, bx}; EpiS5C E{WSP(bf16, WS_YG)};
        pg8::gemm_phase(ring, g, S, E);
        attn_combine(F);
    } SEAM(5);
    if (IN(6)) REPL(6) {
        pg8::Gemm g{WSP(bf16, WS_YG), WSP(bf16, WS_WGLU_T), SW, SW, SW}; pg8::DenseOrder S; S.init(T, SW, F.G, bx);
        EpiEw<0> E{WSP(bf16, WS_Y2), WSP(bf16, WS_YG), nullptr, nullptr, SW};
        pg8::gemm_phase(ring, g, S, E);
    } SEAM(6);
    if (IN(7)) REPL(7) {
        pg8::Gemm g{WSP(bf16, WS_Y2), WSP(bf16, WS_WSB_T), SW, SW, SW}; pg8::DenseOrder S; S.init(T, D, F.G, bx);
        EpiEw<1> E{WSP(bf16, WS_M1), WSP(bf16, WS_GS), nullptr, nullptr, D};
        pg8::gemm_phase(ring, g, S, E);
    } SEAM(7);
    if (IN(8)) REPL(8) {
        pg8::Gemm g{WSP(bf16, WS_YA), WSP(bf16, WS_WAB_T), AW, AW, AW}; pg8::DenseOrder S; S.init(T, D, F.G, bx);
        EpiEw<2> E{WSP(bf16, WS_XN), WSP(bf16, WS_GA), WSP(bf16, WS_M1), nullptr, D};
        pg8::gemm_phase(ring, g, S, E);
    } SEAM(8);
    if (IN(9)) REPL(9) {
        pg8::Gemm g{WSP(bf16, WS_XN), WSP(bf16, WS_WOUT_T), D, D, D}; pg8::DenseOrder S; S.init(T, D, F.G, bx);
        EpiEw<3> E{nullptr, nullptr, nullptr, WSP(float, WS_MIX), D};
        pg8::gemm_phase(ring, g, S, E);
    } SEAM(9);
    if (IN(10)) REPL(10) { phase_rows(F, REP_PHASE == 10 && rep_ == 0); } SEAM(10);
#ifndef MOE_FUSED
#ifdef MOE_F8
    if (IN(12)) REPL(12) {
        moe_tables(F, 8, 2048);
        pg8::Gemm g{WSP(bf16, WS_H2), WSP(bf16, WS_WGU_T), D / 2, D / 2, D / 2}; MoeOrder<true> S{(const LAS int*)(F.lds + SCR_OFF), WSP(int, WS_ELIST), 8, 2048, F.G, bx};
        EpiGU8 E{WSP(unsigned char, WS_H1), WSP(float, WS_PAR) + PAR_BG, WSP(float, WS_PAR) + PAR_BU, WSP(float, WS_PAR) + PAR_WSC};
        pg8::gemm_phase<EpiGU8, MoeOrder<true>, true>(ring, g, S, E);
    } SEAM(12);
    if (IN(13)) REPL(13) {
        moe_tables(F, 4, 1024);
        pg8::Gemm g{WSP(bf16, WS_H1), WSP(bf16, WS_WDN_T), FF / 2, FF / 2, FF / 2}; MoeOrder<false> S{(const LAS int*)(F.lds + SCR_OFF), nullptr, 4, 1024, F.G, bx};
        EpiDn8 E{WSP(bf16, WS_YB), WSP(float, WS_PAR) + PAR_BD, WSP(float, WS_PAR) + PAR_WSC};
        pg8::gemm_phase<EpiDn8, MoeOrder<false>, true>(ring, g, S, E);
    } SEAM(13);
#else
    if (IN(12)) REPL(12) {
        moe_tables(F, 8, 2048);
        pg8::Gemm g{WSP(bf16, WS_H2), WSP(bf16, WS_WGU_T), D, D, D}; MoeOrder<true> S{(const LAS int*)(F.lds + SCR_OFF), WSP(int, WS_ELIST), 8, 2048, F.G, bx};
        EpiGU E{WSP(bf16, WS_H1), WSP(float, WS_PAR) + PAR_BG, WSP(float, WS_PAR) + PAR_BU};
        pg8::gemm_phase(ring, g, S, E);
    } SEAM(12);
    if (IN(13)) REPL(13) {
        moe_tables(F, 4, 1024);
        pg8::Gemm g{WSP(bf16, WS_H1), WSP(bf16, WS_WDN_T), FF, FF, FF}; MoeOrder<false> S{(const LAS int*)(F.lds + SCR_OFF), nullptr, 4, 1024, F.G, bx};
        EpiDn E{WSP(bf16, WS_YB), WSP(float, WS_PAR) + PAR_BD};
        pg8::gemm_phase(ring, g, S, E);
    } SEAM(13);
#endif
#else
    if (IN(12)) REPL(12) {
        moe_tables(F);
        pg8::Gemm g{(const bf16*)F.ws, WSP(bf16, WS_WGU_T), D, D, D};
        EpiMoe E{WSP(bf16, WS_H1), WSP(bf16, WS_YB), WSP(float, WS_PAR) + PAR_BG, WSP(float, WS_PAR) + PAR_BU, WSP(float, WS_PAR) + PAR_BD};
        for (int base = 0;;) { MoeFused S{(const LAS int*)(F.lds + SCR_OFF), WSP(int, WS_ELIST), F.ctl, F.G, bx, base};
            const int nd = pg8::gemm_phase(ring, g, S, E); if (nd == 0) break; base += nd; }
    } SEAM(12);
#endif
    if (IN(14)) REPL(14) { phase_final(F, REP_PHASE == 14 && rep_ == 0); }
#undef IN
#undef SEAM
}

extern "C" void kernel_launch(void* const* d_in, const int* in_sizes, int n_in, void* d_out, int out_size, void* d_ws, size_t ws_size, hipStream_t stream) {
    static int grid = 0;
    if (grid == 0) {
        if (n_in != 30 || in_sizes[0] != T * D || out_size != T * D || ws_size < WS_END) { fprintf(stderr, "kernel_launch: unexpected shapes (n_in %d, in0 %d, out %d, ws %zu)\n", n_in, n_in > 0 ? in_sizes[0] : -1, out_size, ws_size); grid = -1; return; }
        int dev = 0, cus = 0, per_cu = 0;
        if (hipGetDevice(&dev) != hipSuccess || hipDeviceGetAttribute(&cus, hipDeviceAttributeMultiprocessorCount, dev) != hipSuccess) { grid = -1; return; }
        if (hipFuncSetAttribute((const void*)mega_fwd, hipFuncAttributeMaxDynamicSharedMemorySize, LDS_BYTES) != hipSuccess) { fprintf(stderr, "kernel_launch: hipFuncSetAttribute failed\n"); grid = -1; return; }
        if (hipOccupancyMaxActiveBlocksPerMultiprocessor(&per_cu, (const void*)mega_fwd, NWAVES * 64, LDS_BYTES) != hipSuccess || per_cu < 1) { fprintf(stderr, "kernel_launch: occupancy query says %d\n", per_cu); }
        (void)hipGetLastError();
        grid = cus;
    }
    if (grid < 0) return;
    (void)hipMemsetAsync((char*)d_ws + WS_CTL, 0, CTL_ZERO_USED, stream);
    Args a{};
    for (int i = 0; i < 30; ++i) a.in[i] = (const float*)d_in[i];
    a.out = (float*)d_out; a.ws = (unsigned char*)d_ws;
#ifndef PLAIN_LAUNCH
    if (MK_N_LAUNCHES == 1) { a.ph_lo = 0; a.ph_hi = N_PHASES; void* kargs[] = {(void*)&a};
        const hipError_t e = hipLaunchCooperativeKernel((const void*)mega_fwd, dim3(grid), dim3(NWAVES * 64), kargs, LDS_BYTES, stream);
        if (e != hipSuccess) fprintf(stderr, "kernel_launch: cooperative launch failed: %s\n", hipGetErrorString(e)); }
#else
    if (MK_N_LAUNCHES == 1) { a.ph_lo = 0; a.ph_hi = N_PHASES; hipLaunchKernelGGL(mega_fwd, dim3(grid), dim3(NWAVES * 64), LDS_BYTES, stream, a); }
#endif
    else for (int p = 0; p < N_PHASES; ++p) { a.ph_lo = p; a.ph_hi = p + 1; hipLaunchKernelGGL(mega_fwd, dim3(grid), dim3(NWAVES * 64), LDS_BYTES, stream, a); }
}
```

```cpp
#include <hip/hip_runtime.h>
#include <cstdio>
#include <cstdint>
#define MK_N_LAUNCHES 1
namespace pg8 {
#define PG8_LAS __attribute__((address_space(3)))
typedef unsigned short bf16_t;
typedef short bf16x8 __attribute__((ext_vector_type(8)));
typedef float f32x4 __attribute__((ext_vector_type(4)));
typedef unsigned u32x4 __attribute__((ext_vector_type(4)));
typedef unsigned u32x2 __attribute__((ext_vector_type(2)));
typedef int v4i32 __attribute__((ext_vector_type(4)));
typedef int v8i32 __attribute__((ext_vector_type(8)));
constexpr int BIAS_LDS_OFF = 156 * 1024;
constexpr int BM = 256, BK = 64, HALF = 128, HTB = HALF * BK * 2  , STAGE_BYTES = 8 * HTB, NXCD = 8, WGM = 8;

__host__ __device__ __forceinline__ int lds_byte(int r, int c) { const int st = (r >> 4) * 2 + (c >> 5), rr = r & 15, cc = c & 31, ob = rr * 64 + cc * 2; return st * 1024 + (ob ^ (((ob >> 9) & 1) << 5)); }
__host__ __device__ __forceinline__ void stage_rc(int b, int& R, int& C) { const int st = b / 1024, sb = b % 1024, swz = sb ^ (((sb >> 9) & 1) << 5); R = (st >> 1) * 16 + swz / 64; C = (st & 1) * 32 + (swz % 64) / 2; }

struct Unit { int arow, brow, pm, pn, e, nrow, kind, aux; };
struct Gemm { const bf16_t* A; const bf16_t* Bt; int lda, ldb, K; };

struct DenseOrder {
    static constexpr bool GATHER = false;
    __device__ __forceinline__ void a_ready(const Unit&) const {}
    __device__ __forceinline__ void done(const Unit&) const {}
    int nM, nN, nwg, G, c;
    __device__ __forceinline__ void init(int M, int N, int G_, int c_) { nM = M / BM; nN = N / BM; nwg = nM * nN; G = G_; c = c_; }
    __device__ __forceinline__ bool next(int i, Unit& u) const {
        const long L = (long)i * G + c; if (L >= nwg) return false;
        int wgid = (int)L; { const int q = nwg / NXCD, r = nwg % NXCD, xcd = wgid % NXCD, off = wgid / NXCD; wgid = (xcd < r ? xcd * (q + 1) : r * (q + 1) + (xcd - r) * q) + off; }
        const int nig = WGM * nN, gid = wgid / nig, fm = gid * WGM, gsz = (nM - fm) < WGM ? (nM - fm) : WGM;
        u.pm = fm + ((wgid % nig) % gsz); u.pn = (wgid % nig) / gsz; u.arow = u.pm * BM; u.brow = u.pn * BM; u.e = 0; u.nrow = BM; u.kind = 0; u.aux = 0; return true;
    }
};

template <class T_> struct has_bias_lds { template <class U_> static constexpr bool get(decltype(U_::BIAS_LDS)*) { return U_::BIAS_LDS; } template <class U_> static constexpr bool get(...) { return false; } static constexpr bool value = get<T_>(nullptr); };
template <class Epi, class Sched, bool F8 = false>
__device__ __forceinline__ int gemm_phase(PG8_LAS unsigned char* lds, const Gemm g, const Sched& S, const Epi& E) {
    const int tid = threadIdx.x, wid = __builtin_amdgcn_readfirstlane(tid >> 6), lane = tid & 63, wr = wid >> 2, wc = wid & 3, fr = lane & 15, fq = lane >> 4;
    const int K = g.K, nt = K / BK;
    PG8_LAS unsigned char* biaslds = lds + BIAS_LDS_OFF;
    constexpr bool GA = Sched::GATHER;
    unsigned voffA[2], voffB[2]; int gR[2]; unsigned gC[2];
#pragma unroll
    for (int i = 0; i < 2; ++i) { int R, C; stage_rc(tid * 16 + i * 8192, R, C); gR[i] = R; gC[i] = (unsigned)C * 2u;
        voffA[i] = (unsigned)(R * g.lda + C) * 2u; voffB[i] = (unsigned)(R * g.ldb + C) * 2u; }
    unsigned gA_cur[2][2], gA_nxt[2][2];
#define PG8_GATH(dst, un) do { _Pragma("unroll") for (int _h = 0; _h < 2; ++_h) _Pragma("unroll") for (int _i = 0; _i < 2; ++_i) dst[_h][_i] = (unsigned)S.arow_of(un, _h * HALF + gR[_i]) * (unsigned)(g.lda * 2) + gC[_i]; } while (0)
#define PG8_STAGE_A(bufoff, h, kbytes, nx) do { if constexpr (GA) { const char* gb_ = (const char*)g.A + (kbytes); _Pragma("unroll") for (int _i = 0; _i < 2; ++_i) { const unsigned vo_ = (nx) ? gA_nxt[h][_i] : gA_cur[h][_i]; \
        __builtin_amdgcn_global_load_lds((const unsigned*)(gb_ + vo_), (PG8_LAS unsigned*)(lds + (bufoff) + ldsw + _i * 8192), 16, 0, 0); } } \
    else { const char* gb_ = ((nx) ? nA : cA) + (kbytes) + (h) * hstepA; PG8_STAGE(bufoff, gb_, voffA); } } while (0)
    const size_t kstep = (size_t)(BK * 2);
    const size_t hstepA = (size_t)HALF * g.lda * 2, hstepB = (size_t)HALF * g.ldb * 2;
    const size_t rowA = (size_t)g.lda * 2, rowB = (size_t)g.ldb * 2;
    const unsigned ldsw = (unsigned)wid * 1024u;
    const int aoff = lds_byte(wr * 64 + fr, fq * 8), boff = lds_byte(wc * 32 + fr, fq * 8);
#define PG8_SA(b, h) (((b) * 2 + (h)) * HTB)
#define PG8_SB(b, h) ((4 + (b) * 2 + (h)) * HTB)
#define PG8_STAGE(bufoff, gbase, voff) do { _Pragma("unroll") for (int _i = 0; _i < 2; ++_i) \
        __builtin_amdgcn_global_load_lds((const unsigned*)((const char*)(gbase) + (voff)[_i]), (PG8_LAS unsigned*)(lds + (bufoff) + ldsw + _i * 8192), 16, 0, 0); } while (0)
#define PG8_LDA(dst, b, h) do { _Pragma("unroll") for (int m = 0; m < 4; ++m) { if constexpr (F8) { const v4i32 lo_ = *(const PG8_LAS v4i32*)(lds + PG8_SA(b, h) + aoff + m * 2048), hi_ = *(const PG8_LAS v4i32*)(lds + PG8_SA(b, h) + aoff + m * 2048 + 1024); dst##8[m] = __builtin_shufflevector(lo_, hi_, 0, 1, 2, 3, 4, 5, 6, 7); } \
        else { _Pragma("unroll") for (int k = 0; k < 2; ++k) dst[m][k] = *(const PG8_LAS bf16x8*)(lds + PG8_SA(b, h) + aoff + m * 2048 + k * 1024); } } } while (0)
#define PG8_LDB(dst, b, h) do { _Pragma("unroll") for (int n = 0; n < 2; ++n) { if constexpr (F8) { const v4i32 lo_ = *(const PG8_LAS v4i32*)(lds + PG8_SB(b, h) + boff + n * 2048), hi_ = *(const PG8_LAS v4i32*)(lds + PG8_SB(b, h) + boff + n * 2048 + 1024); dst##8[n] = __builtin_shufflevector(lo_, hi_, 0, 1, 2, 3, 4, 5, 6, 7); } \
        else { _Pragma("unroll") for (int k = 0; k < 2; ++k) dst[n][k] = *(const PG8_LAS bf16x8*)(lds + PG8_SB(b, h) + boff + n * 2048 + k * 1024); } } } while (0)
#define PG8_MMA(ai, bj, At, Bt) do { __builtin_amdgcn_s_setprio(1); _Pragma("unroll") for (int m = 0; m < 4; ++m) _Pragma("unroll") for (int n = 0; n < 2; ++n) { \
        if constexpr (F8) { asm("v_mfma_scale_f32_16x16x128_f8f6f4 %0, %1, %2, %0, %3, %3 op_sel_hi:[0,0,0]" : "+v"(acc[ai][bj][m][n]) : "v"(Bt##8[n]), "v"(At##8[m]), "v"(one_scale)); } \
        else { _Pragma("unroll") for (int k = 0; k < 2; ++k) acc[ai][bj][m][n] = __builtin_amdgcn_mfma_f32_16x16x32_bf16(Bt[n][k], At[m][k], acc[ai][bj][m][n], 0, 0, 0); } } \
        __builtin_amdgcn_s_setprio(0); } while (0)
#define PG8_WAIT_V(n) asm volatile("s_waitcnt vmcnt(" #n ")" ::: "memory")
#define PG8_WAIT_L(n) asm volatile("s_waitcnt lgkmcnt(" #n ")" ::: "memory")
#define PG8_BAR __builtin_amdgcn_s_barrier()
#define PG8_SCHED __builtin_amdgcn_sched_barrier(0)
    Unit cur, nxt; int ui = 0;
    if (!S.next(0, cur)) return 0;
    f32x4 acc[2][2][4][2];
#pragma unroll
    for (int a = 0; a < 2; ++a)
#pragma unroll
        for (int b = 0; b < 2; ++b)
#pragma unroll
            for (int m = 0; m < 4; ++m)
#pragma unroll
                for (int n = 0; n < 2; ++n) acc[a][b][m][n] = (f32x4){0.f, 0.f, 0.f, 0.f};
    const int one_scale = 0x7f7f7f7f;
    bf16x8 At[4][2], B0[2][2], B1[2][2];
    v8i32 At8[4], B08[2], B18[2];
    const char* cA = GA ? (const char*)g.A : (const char*)g.A + (size_t)cur.arow * rowA; const char* cB = (const char*)g.Bt + (size_t)cur.brow * rowB; const char* nA = cA;
    if constexpr (GA) { PG8_GATH(gA_cur, cur); }
    S.a_ready(cur);
    PG8_STAGE(PG8_SB(0, 0), cB, voffB); PG8_STAGE(PG8_SB(0, 1), cB + hstepB, voffB); PG8_STAGE_A(PG8_SA(0, 0), 0, 0, false); PG8_STAGE_A(PG8_SA(0, 1), 1, 0, false);
    if (wr == 1) PG8_BAR;
    PG8_WAIT_V(2); PG8_BAR;
    PG8_STAGE(PG8_SB(1, 0), cB + kstep, voffB); PG8_STAGE_A(PG8_SA(1, 0), 0, kstep, false); PG8_STAGE(PG8_SB(1, 1), cB + hstepB + kstep, voffB);
    PG8_WAIT_V(6); PG8_BAR;
    for (;;) {
        const bool has_next = S.next(ui + 1, nxt);
        if constexpr (has_bias_lds<Epi>::value) E.stage_bias(biaslds + (ui & 1) * 1024, cur, wid, lane);
        nA = GA ? cA : (has_next ? (const char*)g.A + (size_t)nxt.arow * rowA : cA); const char* nB = has_next ? (const char*)g.Bt + (size_t)nxt.brow * rowB : cB;
        if constexpr (GA) { if (has_next) { PG8_GATH(gA_nxt, nxt); } else { _Pragma("unroll") for (int _h = 0; _h < 2; ++_h) _Pragma("unroll") for (int _i = 0; _i < 2; ++_i) gA_nxt[_h][_i] = gA_cur[_h][_i]; } }
#pragma unroll 1
        for (int t = 0; t < nt; t += 2) {
            const bool last = (t == nt - 2);
            if (last && has_next) S.a_ready(nxt);
            const size_t k1 = (size_t)(t + 1) * kstep, k2 = last ? (size_t)0 : (size_t)(t + 2) * kstep, k3 = k2 + kstep;
            const char* b2 = last ? nB : cB + (size_t)(t + 2) * kstep; const char* b3 = b2 + kstep;
            PG8_LDB(B0, 0, 0); PG8_LDB(B1, 0, 1); PG8_SCHED; PG8_LDA(At, 0, 0); PG8_STAGE_A(PG8_SA(1, 1), 1, k1, false);
            PG8_WAIT_V(8); PG8_WAIT_L(0); PG8_BAR; PG8_MMA(0, 0, At, B0); PG8_MMA(0, 1, At, B1); PG8_BAR; PG8_SCHED;
            PG8_LDA(At, 0, 1); PG8_STAGE(PG8_SB(0, 0), b2, voffB); PG8_STAGE(PG8_SB(0, 1), b2 + hstepB, voffB); PG8_STAGE_A(PG8_SA(0, 0), 0, k2, last);
            PG8_WAIT_V(8); PG8_WAIT_L(0); PG8_BAR; PG8_MMA(1, 0, At, B0); PG8_MMA(1, 1, At, B1); PG8_BAR; PG8_SCHED;
            PG8_LDB(B0, 1, 0); PG8_LDB(B1, 1, 1); PG8_SCHED; PG8_LDA(At, 1, 0); PG8_STAGE_A(PG8_SA(0, 1), 1, k2, last);
            PG8_WAIT_V(8); PG8_WAIT_L(0); PG8_BAR; PG8_MMA(0, 0, At, B0); PG8_MMA(0, 1, At, B1); PG8_BAR; PG8_SCHED;
            PG8_LDA(At, 1, 1); PG8_STAGE(PG8_SB(1, 0), b3, voffB); PG8_STAGE(PG8_SB(1, 1), b3 + hstepB, voffB); PG8_STAGE_A(PG8_SA(1, 0), 0, k3, last);
            PG8_WAIT_V(8); PG8_WAIT_L(0); PG8_BAR; PG8_MMA(1, 0, At, B0); PG8_MMA(1, 1, At, B1); PG8_BAR; PG8_SCHED;
        }
        if (wr == 0) PG8_BAR;
        if constexpr (has_bias_lds<Epi>::value) E(acc, cur, wr, wc, fr, fq, (const PG8_LAS float*)(biaslds + (ui & 1) * 1024)); else E(acc, cur, wr, wc, fr, fq);
        S.done(cur);
        if (!has_next) break;
#pragma unroll
        for (int a = 0; a < 2; ++a)
#pragma unroll
            for (int b = 0; b < 2; ++b)
#pragma unroll
                for (int m = 0; m < 4; ++m)
#pragma unroll
                    for (int n = 0; n < 2; ++n) acc[a][b][m][n] = (f32x4){0.f, 0.f, 0.f, 0.f};
        cur = nxt; cA = nA; cB = nB; ++ui;
        if constexpr (GA) { _Pragma("unroll") for (int _h = 0; _h < 2; ++_h) _Pragma("unroll") for (int _i = 0; _i < 2; ++_i) gA_cur[_h][_i] = gA_nxt[_h][_i]; }
        if (wr == 1) PG8_BAR;
    }
    PG8_WAIT_V(0);
    PG8_BAR;
    const int n_done_ = ui + 1;
#undef PG8_SA
#undef PG8_SB
#undef PG8_STAGE
#undef PG8_STAGE_A
#undef PG8_GATH
#undef PG8_LDA
#undef PG8_LDB
#undef PG8_MMA
#undef PG8_WAIT_V
#undef PG8_WAIT_L
#undef PG8_BAR
#undef PG8_SCHED
    return n_done_;
}
}
constexpr int NWAVES = 8;
constexpr int BATCH = 2, SEQ = 8192, T = BATCH * SEQ, D = 1024, NH = 8, HD = 64, AW = 512, SW = 512, NG = 32, NP = 64, GS16 = 16;
constexpr int NE = 32, FF = 1024, INW = 4096, TOPK = 4, NBLK = SEQ / 256;
constexpr float NORM_EPS = 1e-6f;
constexpr float C2 = 0.125f * 1.4426950408889634f;
constexpr int XROWS = T * TOPK + 256;

constexpr size_t MiB = 1u << 20;
constexpr size_t WS_CTL = 0, CTL_ZERO_BYTES = 1 * MiB;
constexpr size_t WS_ADA = 1 * MiB;
constexpr size_t WS_ADAF = WS_ADA + 832 * 1024;
constexpr size_t WS_ROPE = 2 * MiB;
constexpr size_t WS_S5P = 6 * MiB;
constexpr size_t WS_S5KT = 7 * MiB;
constexpr size_t WS_S5M1 = 10 * MiB;
constexpr size_t WS_S5WC = 506 * MiB;
constexpr size_t WS_S5E = 408 * MiB;
constexpr size_t WS_ROUTE = 9 * MiB;
constexpr size_t WS_ELIST = 14 * MiB; constexpr int ELCAP = T;
constexpr size_t WS_HSC = WS_ROUTE + 768 * 1024;
constexpr int PAR_WSC = 270000, PAR_WSC1 = 270001;
#ifndef MOE_BF16
#define MOE_F8 1
#endif
constexpr size_t WS_WIN_T = 18 * MiB, WS_WGLU_T = 26 * MiB, WS_WSB_T = 27 * MiB, WS_WAB_T = 28 * MiB, WS_WOUT_T = 29 * MiB;
constexpr size_t WS_PAR = 16 * MiB;
constexpr int PAR_MPG = 0, PAR_FPRE = 1024, PAR_FPOST = 2048, PAR_RB = 3072, PAR_RW = 4096, PAR_BG = 36864, PAR_BU = 69632, PAR_BD = 102400, PAR_CRE = 135168, PAR_CIM = 167936, PAR_SD = 200704, PAR_BRE = 201728, PAR_BIM = 234496;
constexpr size_t WS_WGU_T = 32 * MiB, WS_WDN_T = 160 * MiB;
constexpr size_t WS_XN = 224 * MiB;
constexpr size_t WS_UA = 256 * MiB, WS_Q = 280 * MiB, WS_K = 296 * MiB, WS_V = 312 * MiB, WS_VT = 328 * MiB;
constexpr size_t WS_MIX = 256 * MiB;
constexpr size_t WS_GS = 344 * MiB, WS_GA = 376 * MiB;
constexpr size_t WS_YG = 408 * MiB, WS_Y2 = 424 * MiB, WS_YA = 440 * MiB;
constexpr size_t WS_M1 = 456 * MiB;
constexpr size_t WS_H2 = 480 * MiB;
constexpr size_t WS_X1B = 416 * MiB;
constexpr size_t WS_XG = 224 * MiB, WS_YB = 224 * MiB;
constexpr size_t WS_H1 = 352 * MiB;
constexpr size_t WS_END = 512 * MiB;
static_assert(WS_YB + (size_t)T * TOPK * D * 2 <= WS_H1 && WS_H1 + (size_t)T * TOPK * FF * 2 <= WS_H2 && WS_H2 + (size_t)T * D * 2 <= WS_END, "ws map");
constexpr int CW_TMO = 0, CW_CODE = 1, CW_BAR = 4096, CW_ECNT = 8192, CW_KM = 16384;
constexpr size_t CTL_ZERO_USED = (size_t)(CW_KM + BATCH * NH * NBLK * HD) * 4;
static_assert(CTL_ZERO_USED <= CTL_ZERO_BYTES, "ctl");

constexpr int RING_OFF = 0, RING_BYTES = 131072;
constexpr int LDSCTL_OFF = 152 * 1024, MISC_OFF = LDSCTL_OFF + 320;
constexpr int LDS_BYTES = 158 * 1024;

#define GAS __attribute__((address_space(1)))
#define LAS __attribute__((address_space(3)))
typedef unsigned short bf16;
typedef unsigned v4u __attribute__((ext_vector_type(4)));
typedef unsigned v2u __attribute__((ext_vector_type(2)));
typedef float f32x4 __attribute__((ext_vector_type(4)));
typedef GAS unsigned gu32;
#define RLX_AGENT __ATOMIC_RELAXED, __HIP_MEMORY_SCOPE_AGENT
#define LDS_WAIT() asm volatile("s_waitcnt lgkmcnt(0)" ::: "memory")
#define VM_WAIT() asm volatile("s_waitcnt vmcnt(0)" ::: "memory")
__device__ __forceinline__ unsigned f2bf(float f) { unsigned u = __builtin_bit_cast(unsigned, f); return (u + 0x7fffu + ((u >> 16) & 1u)) >> 16; }
__device__ __forceinline__ unsigned pk2(float lo, float hi) { typedef float f32x2_t __attribute__((ext_vector_type(2))); typedef __bf16 bf16x2_t __attribute__((ext_vector_type(2)));
    f32x2_t v = {lo, hi}; bf16x2_t r = __builtin_convertvector(v, bf16x2_t); return __builtin_bit_cast(unsigned, r); }
#ifdef WT_STORES
__device__ __forceinline__ void st16(void* p, v4u v) { asm volatile("global_store_dwordx4 %0, %1, off sc1\n\ts_nop 1" :: "v"(p), "v"(v) : "memory"); }
__device__ __forceinline__ void st8(void* p, v2u v) { asm volatile("global_store_dwordx2 %0, %1, off sc1\n\ts_nop 1" :: "v"(p), "v"(v) : "memory"); }
#else
__device__ __forceinline__ void st16(void* p, v4u v) { *(v4u*)p = v; }
__device__ __forceinline__ void st8(void* p, v2u v) { *(v2u*)p = v; }
#endif
__device__ __forceinline__ unsigned pk4_fp8(float a, float b, float c, float d) {
    a = fminf(fmaxf(a, -448.f), 448.f); b = fminf(fmaxf(b, -448.f), 448.f); c = fminf(fmaxf(c, -448.f), 448.f); d = fminf(fmaxf(d, -448.f), 448.f);
    int w = 0; w = __builtin_amdgcn_cvt_pk_fp8_f32(a, b, w, false); w = __builtin_amdgcn_cvt_pk_fp8_f32(c, d, w, true); return (unsigned)w; }
__device__ __forceinline__ float bflo(unsigned w) { return __builtin_bit_cast(float, w << 16); }
__device__ __forceinline__ float bfhi(unsigned w) { return __builtin_bit_cast(float, w & 0xffff0000u); }
__device__ __forceinline__ float bf2f(bf16 h) { return __builtin_bit_cast(float, (unsigned)h << 16); }
__device__ __forceinline__ float sigmoidf_(float x) { return 1.f / (1.f + __expf(-x)); }
__device__ __forceinline__ float gelu_tanh(float x) { const float u = 1.5957691216057308f * (x + 0.044715f * x * x * x); return x / (1.f + __expf(-u)); }

#define XB_TMO      128
#define XB_XCNT(j)  (256  + 64 * (j))
#define XB_XSUB(j)  (1280 + 64 * (j))
#define XB_XGEN(j)  (2304 + 64 * (j))
#define XB_TOP      3328
#define XB_TOPGEN   3392
#define XCD_BAR_WORDS 3456
#define XB_SPIN_CAP (1u << 18)
__device__ __forceinline__ unsigned xb_ld(unsigned* p)              { return __hip_atomic_load(p, __ATOMIC_RELAXED, __HIP_MEMORY_SCOPE_AGENT); }
__device__ __forceinline__ unsigned xb_add(unsigned* p, unsigned v) { return __hip_atomic_fetch_add(p, v, __ATOMIC_RELAXED, __HIP_MEMORY_SCOPE_AGENT); }
__device__ __forceinline__ unsigned xb_xcc_id() { return (unsigned)__builtin_amdgcn_s_getreg((3 << 11) | 20) & 0xFu; }
#define XB_SPIN(cond, bar) do { unsigned _sp = 0; while (cond) { __builtin_amdgcn_s_sleep(1); \
    if ((++_sp & 255u) == 0u) { if (xb_ld(&(bar)[XB_TMO])) break; if (_sp > XB_SPIN_CAP) { atomicAdd(&(bar)[XB_TMO], 1u); break; } } } } while (0)
struct XcdBarrier { unsigned* bar; unsigned x; volatile LAS unsigned* st; };
__device__ __forceinline__ XcdBarrier xcd_barrier_post(unsigned* bar, volatile LAS unsigned* st) {
    XcdBarrier b; b.bar = bar; b.x = xb_xcc_id(); b.st = st;
    if (threadIdx.x == 0) (void)xb_add(&bar[XB_XCNT(b.x)], 1u);
    return b;
}
__device__ __forceinline__ void xcd_barrier_complete(unsigned* bar, unsigned x, unsigned& nloc, unsigned& nx) {
    const unsigned G = gridDim.x * gridDim.y * gridDim.z;
    unsigned sum, cnt, mine, sp = 0u;
    for (;;) {
        sum = 0u; cnt = 0u; mine = 0u;
#pragma unroll
        for (unsigned j = 0; j < 16; ++j) { const unsigned c = xb_ld(&bar[XB_XCNT(j)]); sum += c; cnt += (c > 0u) ? 1u : 0u; mine = (j == x) ? c : mine; }
        if (sum == G) break;
        __builtin_amdgcn_s_sleep(1);
        if ((++sp & 255u) == 0u) { if (xb_ld(&bar[XB_TMO])) break; if (sp > XB_SPIN_CAP) { atomicAdd(&bar[XB_TMO], 1u); break; } }
    }
    nloc = mine > 0u ? mine : 1u; nx = cnt > 0u ? cnt : 1u;
}
__device__ __forceinline__ void xcd_barrier(const XcdBarrier& b) {
    asm volatile("s_waitcnt vmcnt(0)" ::: "memory");
    __syncthreads();
    if (threadIdx.x == 0) {
        unsigned* bar = b.bar;
        __builtin_amdgcn_s_waitcnt(0);
        unsigned nloc = b.st[0], nx = b.st[1];
        if (nloc == 0u) { xcd_barrier_complete(bar, b.x, nloc, nx); b.st[0] = nloc; b.st[1] = nx; }
        const unsigned old = xb_add(&bar[XB_XSUB(b.x)], 1u);
        const unsigned gen = old / nloc;
        if (old + 1u == (gen + 1u) * nloc) {
            __builtin_amdgcn_fence(__ATOMIC_RELEASE, "agent");
            asm volatile("s_waitcnt vmcnt(0)" ::: "memory");
            const unsigned og = xb_add(&bar[XB_TOP], 1u);
            const unsigned tg = og / nx;
            if (og + 1u == (tg + 1u) * nx) xb_add(&bar[XB_TOPGEN], 1u);
            else XB_SPIN(xb_ld(&bar[XB_TOPGEN]) == tg, bar);
            __builtin_amdgcn_fence(__ATOMIC_ACQUIRE, "agent");
            xb_add(&bar[XB_XGEN(b.x)], 1u);
            asm volatile("s_waitcnt vmcnt(0)" ::: "memory");
        } else {
            XB_SPIN(xb_ld(&bar[XB_XGEN(b.x)]) == gen, bar);
            __builtin_amdgcn_fence(__ATOMIC_ACQUIRE, "agent");
            asm volatile("s_waitcnt vmcnt(0)" ::: "memory");
        }
    }
    __syncthreads();
}

__device__ __forceinline__ float wave_sum(float v) {
#pragma unroll
    for (int o = 1; o < 64; o <<= 1) v += __shfl_xor(v, o);
    return v;
}
__device__ __forceinline__ float wave_max(float v) {
#pragma unroll
    for (int o = 1; o < 64; o <<= 1) v = fmaxf(v, __shfl_xor(v, o));
    return v;
}
struct Frame {
    LAS unsigned char* lds;
    volatile LAS unsigned* MISC;
    gu32* ctl;
    int tid, lane, wave;
    int vcu, G;
    unsigned char* ws;
    const float* in[30];
    float* out;
};
#define WSP(T_, off) ((T_*)(F.ws + (off)))

__device__ __forceinline__ int perm8(int c) { return (c & ~31) + 16 * ((c >> 2) & 1) + 4 * ((c >> 3) & 3) + (c & 3); }
struct MapP8 { int off; __device__ __forceinline__ int operator()(int n) const { return off + perm8(n); } };
struct MapWin { __device__ __forceinline__ int operator()(int c) const {
    if (c < 512 || c >= 1536) return perm8(c);
    const int base = (c < 1024) ? 512 : 1024, cc = c - base, head = cc >> 6, d = cc & 63, pnq = head >> 2, hh = head & 3, n = d >> 5, dd = d & 31;
    const int wc = 2 * (hh & 1) + (dd >> 4), bj = hh >> 1, j = dd & 15;
    return base + 256 * pnq + 128 * bj + 32 * wc + 16 * n + j; } };
struct MapGU { int e, up; __device__ __forceinline__ int operator()(int f) const { return e * 2048 + (f >> 7) * 256 + up * 128 + perm8(f & 127); } };

template <class RowMap>
__device__ __forceinline__ void p0_transpose_item(const float* W, int K, int N, bf16* WT, LAS float* scr, int item, int lane, const RowMap rm) {
    const int nblk = N / 64, kb = item / nblk, nb = item % nblk, k0 = 64 * kb, n0 = 64 * nb;
    const int lr = lane >> 4, lc = 4 * (lane & 15);
    f32x4 v[16];
#pragma unroll
    for (int i = 0; i < 16; ++i) v[i] = __builtin_nontemporal_load((const GAS f32x4*)(W + (size_t)(k0 + 4 * i + lr) * N + n0 + lc));
#pragma unroll
    for (int i = 0; i < 16; ++i) { LAS float* d = scr + (4 * i + lr) * 65 + lc; d[0] = v[i].x; d[1] = v[i].y; d[2] = v[i].z; d[3] = v[i].w; }
    LDS_WAIT(); asm volatile("" ::: "memory");
    const int c = lane & 7;
#pragma unroll
    for (int j = 0; j < 8; ++j) { const int n = (lane >> 3) + 8 * j; const LAS float* s = scr + (8 * c) * 65 + n;
        v4u o; o.x = pk2(s[0 * 65], s[1 * 65]); o.y = pk2(s[2 * 65], s[3 * 65]); o.z = pk2(s[4 * 65], s[5 * 65]); o.w = pk2(s[6 * 65], s[7 * 65]);
        __builtin_nontemporal_store(o, (GAS v4u*)(WT + (size_t)rm(n0 + n) * K + k0 + 8 * c)); }
    LDS_WAIT(); asm volatile("" ::: "memory");
}

template <class RowMap>
__device__ __forceinline__ void p0_transpose_item_f8(const float* W, int K, int N, unsigned char* WT, LAS float* scr, int item, int lane, const RowMap rm, float wsc) {
    const int nblk = N / 64, kb = item / nblk, nb = item % nblk, k0 = 64 * kb, n0 = 64 * nb;
    const int lr = lane >> 4, lc = 4 * (lane & 15);
    f32x4 v[16];
#pragma unroll
    for (int i = 0; i < 16; ++i) v[i] = __builtin_nontemporal_load((const GAS f32x4*)(W + (size_t)(k0 + 4 * i + lr) * N + n0 + lc));
#pragma unroll
    for (int i = 0; i < 16; ++i) { LAS float* d = scr + (4 * i + lr) * 65 + lc; d[0] = v[i].x * wsc; d[1] = v[i].y * wsc; d[2] = v[i].z * wsc; d[3] = v[i].w * wsc; }
    LDS_WAIT(); asm volatile("" ::: "memory");
    const int c = lane & 3;
#pragma unroll
    for (int j = 0; j < 4; ++j) { const int n = (lane >> 2) + 16 * j; const LAS float* s = scr + (16 * c) * 65 + n;
        v4u o; o.x = pk4_fp8(s[0 * 65], s[1 * 65], s[2 * 65], s[3 * 65]); o.y = pk4_fp8(s[4 * 65], s[5 * 65], s[6 * 65], s[7 * 65]);
        o.z = pk4_fp8(s[8 * 65], s[9 * 65], s[10 * 65], s[11 * 65]); o.w = pk4_fp8(s[12 * 65], s[13 * 65], s[14 * 65], s[15 * 65]);
        __builtin_nontemporal_store(o, (GAS v4u*)(WT + (size_t)rm(n0 + n) * K + k0 + 16 * c)); }
    LDS_WAIT(); asm volatile("" ::: "memory");
}

__device__ __forceinline__ void p0_moe_load(const float* W, int item, int lane, f32x4 (&v)[16]) {
    const int kb = item >> 4, nb = item & 15, k0 = 64 * kb, n0 = 64 * nb, lr = lane >> 4, lc = 4 * (lane & 15);
#pragma unroll
    for (int i = 0; i < 16; ++i) v[i] = __builtin_nontemporal_load((const GAS f32x4*)(W + (size_t)(k0 + 4 * i + lr) * 1024 + n0 + lc));
}
__device__ __forceinline__ void p0_moe_finish(unsigned char* WT, int rowbase, int kind, int item, LAS float* scr, int lane, const f32x4 (&v)[16], float wsc) {
    const int kb = item >> 4, nb = item & 15, k0 = 64 * kb, n0 = 64 * nb, lr = lane >> 4, lc = 4 * (lane & 15);
#pragma unroll
    for (int i = 0; i < 16; ++i) { LAS float* d = scr + (4 * i + lr) * 65 + lc; d[0] = v[i].x * wsc; d[1] = v[i].y * wsc; d[2] = v[i].z * wsc; d[3] = v[i].w * wsc; }
    LDS_WAIT(); asm volatile("" ::: "memory");
    const int c = lane & 3;
#pragma unroll
    for (int j = 0; j < 4; ++j) { const int n = n0 + (lane >> 2) + 16 * j; const LAS float* s = scr + (16 * c) * 65 + (n - n0);
        const int row = rowbase + (kind < 2 ? (n >> 7) * 256 + kind * 128 + perm8(n & 127) : perm8(n));
        v4u o; o.x = pk4_fp8(s[0 * 65], s[1 * 65], s[2 * 65], s[3 * 65]); o.y = pk4_fp8(s[4 * 65], s[5 * 65], s[6 * 65], s[7 * 65]);
        o.z = pk4_fp8(s[8 * 65], s[9 * 65], s[10 * 65], s[11 * 65]); o.w = pk4_fp8(s[12 * 65], s[13 * 65], s[14 * 65], s[15 * 65]);
        __builtin_nontemporal_store(o, (GAS v4u*)(WT + (size_t)row * 1024 + k0 + 16 * c)); }
    LDS_WAIT(); asm volatile("" ::: "memory");
}

__device__ __forceinline__ void phase0(Frame& F) {
    LAS float* scr = (LAS float*)(F.lds + RING_OFF + F.wave * 16640);
    const int gw = F.vcu * NWAVES + F.wave, NGW = F.G * NWAVES;
#ifdef MOE_F8
    float wsc;
    { float am = 0.f;
      for (int j = F.tid; j < 2048; j += NWAVES * 64) { const size_t o = (size_t)j * 16384 + 37 * (j & 63);
          am = fmaxf(am, fmaxf(fabsf(F.in[24][o]), fmaxf(fabsf(F.in[26][o]), fabsf(F.in[28][o])))); }
      am = wave_max(am); LAS float* red = (LAS float*)(F.lds + LDSCTL_OFF + 64);
      if (F.lane == 0) red[F.wave] = am;
      __syncthreads();
      am = red[0];
#pragma unroll
      for (int w = 1; w < NWAVES; ++w) am = fmaxf(am, red[w]);
      wsc = exp2f(floorf(log2f(448.f / (fmaxf(am, 1e-30f) * 8.f))));
      if (blockIdx.x == 0 && F.tid == 0) WSP(float, WS_PAR)[PAR_WSC] = wsc;
      __syncthreads(); }
#endif
#ifdef G1_F8
    float wsc1;
    { float am = 0.f;
      for (int j = F.tid; j < 2048; j += NWAVES * 64) am = fmaxf(am, fabsf(F.in[9][(size_t)j * 2048 + 37 * (j & 31)]));
      am = wave_max(am); LAS float* red = (LAS float*)(F.lds + LDSCTL_OFF + 64);
      if (F.lane == 0) red[F.wave] = am;
      __syncthreads();
      am = red[0];
#pragma unroll
      for (int w = 1; w < NWAVES; ++w) am = fmaxf(am, red[w]);
      wsc1 = exp2f(floorf(log2f(448.f / (fmaxf(am, 1e-30f) * 8.f))));
      if (blockIdx.x == 0 && F.tid == 0) WSP(float, WS_PAR)[PAR_WSC1] = wsc1;
      __syncthreads(); }
#endif
    constexpr int I_WIN = 16 * 64, I_GLU = 8 * 8, I_SB = 8 * 16, I_AB = 8 * 16, I_OUT = 16 * 16, I_E = 16 * 16;
    constexpr int I_SMALL = I_WIN + I_GLU + I_SB + I_AB + I_OUT, I_MOE = 3 * NE * I_E, I_ADA = 16 * 96;
    constexpr int NITEMS = I_SMALL + I_MOE + I_ADA;
    for (int it = gw; it < NITEMS; it += NGW) {
        int r = it;
#ifdef G1_F8
        if (r < I_WIN) { p0_transpose_item_f8(F.in[9], D, INW, WSP(unsigned char, WS_WIN_T), scr, r, F.lane, MapWin{}, wsc1); continue; } r -= I_WIN;
#else
        if (r < I_WIN) { p0_transpose_item(F.in[9], D, INW, WSP(bf16, WS_WIN_T), scr, r, F.lane, MapWin{}); continue; } r -= I_WIN;
#endif
        if (r < I_GLU) { p0_transpose_item(F.in[18], SW, SW, WSP(bf16, WS_WGLU_T), scr, r, F.lane, MapP8{0}); continue; } r -= I_GLU;
        if (r < I_SB) { p0_transpose_item(F.in[19], SW, D, WSP(bf16, WS_WSB_T), scr, r, F.lane, MapP8{0}); continue; } r -= I_SB;
        if (r < I_AB) { p0_transpose_item(F.in[20], AW, D, WSP(bf16, WS_WAB_T), scr, r, F.lane, MapP8{0}); continue; } r -= I_AB;
        if (r < I_OUT) { p0_transpose_item(F.in[21], D, D, WSP(bf16, WS_WOUT_T), scr, r, F.lane, MapP8{0}); continue; } r -= I_OUT;
        if (r < I_MOE) {
#ifdef MOE_F8
            continue;
#endif
            const int mat = r / I_E, item = r % I_E, kind = mat / NE, e = mat % NE;
#ifdef MOE_F8
            if (kind == 0) p0_transpose_item_f8(F.in[24] + (size_t)e * D * FF, D, FF, WSP(unsigned char, WS_WGU_T), scr, item, F.lane, MapGU{e, 0}, wsc);
            else if (kind == 1) p0_transpose_item_f8(F.in[26] + (size_t)e * D * FF, D, FF, WSP(unsigned char, WS_WGU_T), scr, item, F.lane, MapGU{e, 1}, wsc);
            else p0_transpose_item_f8(F.in[28] + (size_t)e * FF * D, FF, D, WSP(unsigned char, WS_WDN_T), scr, item, F.lane, MapP8{e * 1024}, wsc);
#else
            if (kind == 0) p0_transpose_item(F.in[24] + (size_t)e * D * FF, D, FF, WSP(bf16, WS_WGU_T), scr, item, F.lane, MapGU{e, 0});
            else if (kind == 1) p0_transpose_item(F.in[26] + (size_t)e * D * FF, D, FF, WSP(bf16, WS_WGU_T), scr, item, F.lane, MapGU{e, 1});
            else p0_transpose_item(F.in[28] + (size_t)e * FF * D, FF, D, WSP(bf16, WS_WDN_T), scr, item, F.lane, MapP8{e * 1024});
#endif
            continue; }
        r -= I_MOE;
        {
            const int ks = r / 96, cc = r % 96, n = cc * 64 + F.lane;
            const float* cvec = F.in[1]; const float* aw = F.in[3];
            float a0 = 0.f, a1 = 0.f;
            for (int k = ks * 64; k < ks * 64 + 64; ++k) {
                const float c0 = cvec[k], c1 = cvec[D + k];
                const float s0 = c0 / (1.f + __expf(-c0)), s1 = c1 / (1.f + __expf(-c1));
                const float w = __builtin_nontemporal_load(aw + (size_t)k * (6 * D) + n);
                a0 += s0 * w; a1 += s1 * w; }
            float* part = WSP(float, WS_ADA);
            part[(ks * 2 + 0) * (6 * D) + n] = a0; part[(ks * 2 + 1) * (6 * D) + n] = a1;
        }
    }
#ifdef MOE_F8
    {   const float* wg = F.in[24]; const float* wu = F.in[26]; const float* wd = F.in[28];
        unsigned char* tgu = WSP(unsigned char, WS_WGU_T); unsigned char* tdn = WSP(unsigned char, WS_WDN_T);
#define P0_DEC(r_, W_, WT_, rb_, kd_, it_) const int mat_##r_ = (r_) >> 8, it_ = (r_) & 255, kd_ = mat_##r_ >> 5, e_##r_ = mat_##r_ & 31; \
        const float* W_ = (kd_ == 0 ? wg : (kd_ == 1 ? wu : wd)) + (size_t)e_##r_ * D * FF; unsigned char* WT_ = kd_ < 2 ? tgu : tdn; const int rb_ = kd_ < 2 ? e_##r_ * 2048 : e_##r_ * 1024;
        f32x4 va[16], vb[16]; int r = gw;
        if (r < I_MOE) { P0_DEC(r, W0, T0, b0, k0_, i0); (void)T0; (void)b0; (void)k0_; p0_moe_load(W0, i0, F.lane, va); }
        while (r < I_MOE) {
            { const int rn = r + NGW; if (rn < I_MOE) { P0_DEC(rn, W1, T1, b1, k1_, i1); (void)T1; (void)b1; (void)k1_; p0_moe_load(W1, i1, F.lane, vb); } }
            { P0_DEC(r, W2, T2, b2, k2_, i2); (void)W2; p0_moe_finish(T2, b2, k2_, i2, scr, F.lane, va, wsc); }
            r += NGW; if (r >= I_MOE) break;
            { const int rn = r + NGW; if (rn < I_MOE) { P0_DEC(rn, W3, T3, b3, k3_, i3); (void)T3; (void)b3; (void)k3_; p0_moe_load(W3, i3, F.lane, va); } }
            { P0_DEC(r, W4, T4, b4, k4_, i4); (void)W4; p0_moe_finish(T4, b4, k4_, i4, scr, F.lane, vb, wsc); }
            r += NGW;
        }
#undef P0_DEC
    }
#endif
    const int gt = F.vcu * (NWAVES * 64) + F.tid, NGT = F.G * NWAVES * 64;
    { const int* pos = (const int*)F.in[2]; float* rc = WSP(float, WS_ROPE); float* rs = rc + (size_t)T * 32;
      for (int i = gt; i < T * 32; i += NGT) { const int t = i >> 5, p = i & 31;
          const float invf = exp2f(-(float)p * (13.287712379549449f / 32.f));
          const double ang = (double)pos[t] * (double)invf; double rev = ang * 0.15915494309189535; rev -= floor(rev);
          const float fr = (float)rev;
          rc[i] = __builtin_amdgcn_cosf(fr); rs[i] = __builtin_amdgcn_sinf(fr); } }
    { float* P5 = WSP(float, WS_S5P);
      for (int i = gt; i < NG * NP; i += NGT) { const int g = i >> 6;
          const float dt = __expf(F.in[12][g]); const float lr = F.in[10][i], li = F.in[11][i];
          const float er = __expf(lr * dt); const double ang = (double)li * (double)dt; double rev = ang * 0.15915494309189535; rev -= floor(rev);
          const float cs = __builtin_amdgcn_cosf((float)rev), sn = __builtin_amdgcn_sinf((float)rev);
          float br = er * cs, bi = er * sn;
          P5[i] = br; P5[2048 + i] = bi;
          const float nr = br - 1.f, ni = bi, den = lr * lr + li * li;
          const float qr = (nr * lr + ni * li) / den, qi = (ni * lr - nr * li) / den;
          P5[8192 + i] = qr; P5[8192 + 2048 + i] = qi;
          float pr = br, pi_ = bi;
#pragma unroll
          for (int s = 0; s < 8; ++s) { const float tr = pr * pr - pi_ * pi_, ti = 2.f * pr * pi_; pr = tr; pi_ = ti; }
          P5[4096 + i] = pr; P5[6144 + i] = pi_;
          float* PW = P5 + 131072;
          float wr_ = 1.f, wi_ = 0.f;
#pragma unroll
          for (int k = 0; k <= 16; ++k) { PW[i * 17 + k] = wr_; PW[2048 * 17 + i * 17 + k] = wi_; const float tr = wr_ * br - wi_ * bi, ti = wr_ * bi + wi_ * br; wr_ = tr; wi_ = ti; } }
    }
}

__device__ __forceinline__ void phase1(Frame& F) {
    LAS float* A1 = (LAS float*)(F.lds + RING_OFF); LAS float* A2 = A1 + 2 * D;
    const float* part = WSP(float, WS_ADA); const float* ab = F.in[4]; const float* pg = F.in[5];
    for (int k = F.tid; k < D; k += NWAVES * 64)
#pragma unroll
        for (int b = 0; b < 2; ++b) { float sh = ab[k], sc = ab[D + k];
            for (int ks = 0; ks < 16; ++ks) { sh += part[(ks * 2 + b) * (6 * D) + k]; sc += part[(ks * 2 + b) * (6 * D) + D + k]; }
            A1[b * D + k] = pg[k] * (1.f + sc); A2[b * D + k] = sh; }
    const int gt = F.vcu * (NWAVES * 64) + F.tid, NGT = F.G * NWAVES * 64;
    { float* adaf = WSP(float, WS_ADAF);
      for (int n = gt; n < 2 * 6 * D; n += NGT) { const int b = n / (6 * D), j = n % (6 * D); float a = ab[j];
          for (int ks = 0; ks < 16; ++ks) a += part[(ks * 2 + b) * (6 * D) + j];
          adaf[n] = a; } }
    { float* par = WSP(float, WS_PAR);
      for (int i = gt; i < 32768; i += NGT) { par[PAR_RW + i] = F.in[22][i]; par[PAR_BG + i] = F.in[25][i]; par[PAR_BU + i] = F.in[27][i]; par[PAR_BD + i] = F.in[29][i];
          par[PAR_CRE + i] = F.in[15][i]; par[PAR_CIM + i] = F.in[16][i]; par[PAR_BRE + i] = F.in[13][i]; par[PAR_BIM + i] = F.in[14][i];
          if (i < 1024) { par[PAR_MPG + i] = F.in[6][i]; par[PAR_FPRE + i] = F.in[7][i]; par[PAR_FPOST + i] = F.in[8][i]; }
          if (i < 512) par[PAR_SD + i] = F.in[17][i];
          if (i < 32) par[PAR_RB + i] = F.in[23][i]; } }
    { const float* P5 = WSP(float, WS_S5P); const float* PWr = P5 + 131072; const float* PWi = PWr + 2048 * 17;
      bf16* M1t = WSP(bf16, WS_S5M1);
      for (int i = gt; i < NG * 256 * 256; i += NGT) { const int k = i & 255, n = (i >> 8) & 255, g = i >> 16; float val = 0.f;
          if (n < 128) { const int p = n & 63, gp = g * 64 + p, s_ = k >> 4, ci = k & 15;
              const float qr = P5[8192 + gp], qi = P5[8192 + 2048 + gp], b_r = F.in[13][gp * 16 + ci], b_i = F.in[14][gp * 16 + ci];
              const float bbr = qr * b_r - qi * b_i, bbi = qr * b_i + qi * b_r, wr_ = PWr[gp * 17 + 15 - s_], wi_ = PWi[gp * 17 + 15 - s_];
              val = (n < 64) ? (wr_ * bbr - wi_ * bbi) : (wr_ * bbi + wi_ * bbr); }
          M1t[((size_t)(g * 256 + perm8(n))) * 256 + k] = (bf16)f2bf(val); }
    }
    __syncthreads();
    const int gw = F.vcu * NWAVES + F.wave, NGW = F.G * NWAVES;
    bf16* XN = WSP(bf16, WS_XN);
    for (int m0 = gw * 2; m0 < T; m0 += NGW * 2) {
        const int b = m0 >> 13;
        f32x4 v[2][4];
#pragma unroll
        for (int q = 0; q < 2; ++q) { const GAS f32x4* xr = (const GAS f32x4*)(F.in[0] + (size_t)(m0 + q) * D) + F.lane;
#pragma unroll
            for (int j = 0; j < 4; ++j) v[q][j] = __builtin_nontemporal_load(xr + 64 * j); }
#pragma unroll
        for (int q = 0; q < 2; ++q) { float s = 0.f;
#pragma unroll
            for (int j = 0; j < 4; ++j) s += (v[q][j].x * v[q][j].x + v[q][j].y * v[q][j].y) + (v[q][j].z * v[q][j].z + v[q][j].w * v[q][j].w);
            const float rstd = 1.f / sqrtf(wave_sum(s) * (1.f / D) + NORM_EPS);
#ifdef G1_F8
            GAS unsigned* o4 = (GAS unsigned*)((unsigned char*)XN + (size_t)(m0 + q) * D) + F.lane;
#pragma unroll
            for (int j = 0; j < 4; ++j) { const f32x4 a1 = *(const LAS f32x4*)(A1 + b * D + 4 * F.lane + 256 * j), a2 = *(const LAS f32x4*)(A2 + b * D + 4 * F.lane + 256 * j);
                const f32x4 o = v[q][j] * rstd * a1 + a2;
                o4[64 * j] = pk4_fp8(8.f * o.x, 8.f * o.y, 8.f * o.z, 8.f * o.w); } }
#else
            GAS unsigned long long* o8 = (GAS unsigned long long*)(XN + (size_t)(m0 + q) * D) + F.lane;
#pragma unroll
            for (int j = 0; j < 4; ++j) { const f32x4 a1 = *(const LAS f32x4*)(A1 + b * D + 4 * F.lane + 256 * j), a2 = *(const LAS f32x4*)(A2 + b * D + 4 * F.lane + 256 * j);
                const f32x4 o = v[q][j] * rstd * a1 + a2;
                o8[64 * j] = (unsigned long long)pk2(o.x, o.y) | ((unsigned long long)pk2(o.z, o.w) << 32); } }
#endif
    }
    __syncthreads();
}

struct EpiG1 {
    bf16 *UA, *Q, *K, *V, *VT, *GSp, *GAp; const float *rc, *rs; float* km; const float* wscp;
    __device__ __forceinline__ void operator()(const pg8::f32x4 (&acc0)[2][2][4][2], const pg8::Unit& u, int wr, int wc, int fr, int fq) const {
        pg8::f32x4 (&acc)[2][2][4][2] = const_cast<pg8::f32x4 (&)[2][2][4][2]>(acc0);
#ifdef G1_F8
        { const float s_ = 0.125f / *wscp;
#pragma unroll
            for (int a = 0; a < 2; ++a)
#pragma unroll
                for (int b = 0; b < 2; ++b)
#pragma unroll
                    for (int m = 0; m < 4; ++m)
#pragma unroll
                        for (int n = 0; n < 2; ++n) acc[a][b][m][n] = acc[a][b][m][n] * s_; }
#endif
        asm volatile("" : "+v"(fr), "+v"(fq));
        const int pn = u.pn, row0 = u.pm * 256 + wr * 64 + fr;
        if (pn < 2) {
#pragma unroll
            for (int ai = 0; ai < 2; ++ai)
#pragma unroll
                for (int m = 0; m < 4; ++m) { const int t = row0 + ai * 128 + m * 16, b = t >> 13, tt = t & (SEQ - 1), c = tt >> 4, s = tt & 15;
#pragma unroll
                    for (int bj = 0; bj < 2; ++bj) { const int ch = pn * 256 + bj * 128 + wc * 32 + 8 * fq, g = ch >> 4, ci = ch & 15;
                        const pg8::f32x4 v0 = acc[ai][bj][m][0], v1 = acc[ai][bj][m][1];
                        v4u w; w.x = pk2(v0[0], v0[1]); w.y = pk2(v0[2], v0[3]); w.z = pk2(v1[0], v1[1]); w.w = pk2(v1[2], v1[3]);
                        st16(UA + ((size_t)(g * 1024 + b * 512 + c) * 384 + 16 * s + ci), w); } }
        } else if (pn < 6) {
            const bool isk = pn >= 4; bf16* X = isk ? K : Q; const float sc = isk ? 1.f : C2;
            const int p0 = 16 * (wc & 1) + 4 * fq;
#pragma unroll
            for (int bj = 0; bj < 2; ++bj) {
                const int head = 4 * (pn & 1) + 2 * bj + (wc >> 1);
                int rowb = row0; asm volatile("" : "+v"(rowb));
                float ks[2][4];
#pragma unroll
                for (int b = 0; b < 2; ++b)
#pragma unroll
                    for (int i = 0; i < 4; ++i) ks[b][i] = 0.f;
#pragma unroll
                for (int ai = 0; ai < 2; ++ai)
#pragma unroll
                    for (int m = 0; m < 4; ++m) { const int t = rowb + ai * 128 + m * 16;
                        const pg8::f32x4 cs = *(const pg8::f32x4*)(rc + (size_t)t * 32 + p0), sn = *(const pg8::f32x4*)(rs + (size_t)t * 32 + p0);
                        const pg8::f32x4 t1 = acc[ai][bj][m][0], t2 = acc[ai][bj][m][1];
                        const pg8::f32x4 o1 = t1 * cs - t2 * sn, o2 = t2 * cs + t1 * sn;
                        v2u w1, w2; w1.x = pk2(o1[0] * sc, o1[1] * sc); w1.y = pk2(o1[2] * sc, o1[3] * sc); w2.x = pk2(o2[0] * sc, o2[1] * sc); w2.y = pk2(o2[2] * sc, o2[3] * sc);
                        bf16* dst = X + (size_t)t * AW + head * 64 + p0;
                        st8(dst, w1); st8(dst + 32, w2);
#pragma unroll
                        for (int i = 0; i < 4; ++i) { ks[0][i] += o1[i]; ks[1][i] += o2[i]; }
                        __builtin_amdgcn_sched_barrier(0); }
                if (isk) {
                    const int b = u.pm >> 5, blk = u.pm & 31;
#pragma unroll
                    for (int n = 0; n < 2; ++n)
#pragma unroll
                        for (int i = 0; i < 4; ++i) { float v = ks[n][i];
                            v += __shfl_xor(v, 1); v += __shfl_xor(v, 2); v += __shfl_xor(v, 4); v += __shfl_xor(v, 8);
                            if (fr == 0) atomicAdd(km + ((size_t)((b * NH + head) * NBLK + blk) * HD + 32 * n + p0 + i), v); }
                }
            }
        } else if (pn < 8) {
#pragma unroll
            for (int ai = 0; ai < 2; ++ai)
#pragma unroll
                for (int m = 0; m < 4; ++m) { const int t = row0 + ai * 128 + m * 16, b = t >> 13, tt = t & (SEQ - 1);
#pragma unroll
                    for (int bj = 0; bj < 2; ++bj) { const int cv = (pn - 6) * 256 + bj * 128 + wc * 32 + 8 * fq, head = cv >> 6, d = cv & 63;
                        const pg8::f32x4 v0 = acc[ai][bj][m][0], v1 = acc[ai][bj][m][1];
                        v4u w; w.x = pk2(v0[0], v0[1]); w.y = pk2(v0[2], v0[3]); w.z = pk2(v1[0], v1[1]); w.w = pk2(v1[2], v1[3]);
                        bf16* vt = VT + ((size_t)((b * NH + head) * HD + d) * SEQ + tt);
                        vt[0 * SEQ] = (bf16)(w.x & 0xffff); vt[1 * SEQ] = (bf16)(w.x >> 16); vt[2 * SEQ] = (bf16)(w.y & 0xffff); vt[3 * SEQ] = (bf16)(w.y >> 16);
                        vt[4 * SEQ] = (bf16)(w.z & 0xffff); vt[5 * SEQ] = (bf16)(w.z >> 16); vt[6 * SEQ] = (bf16)(w.w & 0xffff); vt[7 * SEQ] = (bf16)(w.w >> 16); } }
        } else {
            bf16* Gp = (pn < 12) ? GSp : GAp; const int cb = ((pn - 8) & 3) * 256;
#pragma unroll
            for (int ai = 0; ai < 2; ++ai)
#pragma unroll
                for (int m = 0; m < 4; ++m) { const int t = row0 + ai * 128 + m * 16;
#pragma unroll
                    for (int bj = 0; bj < 2; ++bj) { const int col = cb + bj * 128 + wc * 32 + 8 * fq;
                        const pg8::f32x4 v0 = acc[ai][bj][m][0], v1 = acc[ai][bj][m][1];
                        v4u w; w.x = pk2(sigmoidf_(v0[0]), sigmoidf_(v0[1])); w.y = pk2(sigmoidf_(v0[2]), sigmoidf_(v0[3]));
                        w.z = pk2(sigmoidf_(v1[0]), sigmoidf_(v1[1])); w.w = pk2(sigmoidf_(v1[2]), sigmoidf_(v1[3]));
                        __builtin_nontemporal_store(w, (v4u*)(Gp + (size_t)t * D + col)); } }
        }
    }
};

template <int MODE> struct EpiEw {
    bf16* O; const bf16* X1; const bf16* X2; float* Of; int ld;
    __device__ __forceinline__ void operator()(const pg8::f32x4 (&acc)[2][2][4][2], const pg8::Unit& u, int wr, int wc, int fr, int fq) const {
        const int row0 = u.pm * 256 + wr * 64 + fr, col0 = u.pn * 256 + wc * 32 + 8 * fq;
#pragma unroll
        for (int ai = 0; ai < 2; ++ai)
#pragma unroll
            for (int m = 0; m < 4; ++m) { const size_t rb = (size_t)(row0 + ai * 128 + m * 16) * ld + col0;
#pragma unroll
                for (int bj = 0; bj < 2; ++bj) { const size_t off = rb + bj * 128;
                    const pg8::f32x4 v0 = acc[ai][bj][m][0], v1 = acc[ai][bj][m][1];
                    if (MODE == 3) { *(pg8::f32x4*)(Of + off) = v0; *(pg8::f32x4*)(Of + off + 4) = v1; }
                    else if (MODE == 4) { v4u w; w.x = pk2(v0[0], v0[1]); w.y = pk2(v0[2], v0[3]); w.z = pk2(v1[0], v1[1]); w.w = pk2(v1[2], v1[3]); st16(O + off, w); }
                    else {
                        const v4u x = __builtin_nontemporal_load((const v4u*)(X1 + off));
                        float r[8] = {v0[0], v0[1], v0[2], v0[3], v1[0], v1[1], v1[2], v1[3]};
                        const float xv[8] = {bflo(x.x), bfhi(x.x), bflo(x.y), bfhi(x.y), bflo(x.z), bfhi(x.z), bflo(x.w), bfhi(x.w)};
                        if (MODE == 0) {
#pragma unroll
                            for (int i = 0; i < 8; ++i) r[i] = xv[i] * sigmoidf_(r[i]);
                        } else if (MODE == 1) {
#pragma unroll
                            for (int i = 0; i < 8; ++i) r[i] = xv[i] * r[i];
                        } else {
                            const v4u y = __builtin_nontemporal_load((const v4u*)(X2 + off));
                            const float yv[8] = {bflo(y.x), bfhi(y.x), bflo(y.y), bfhi(y.y), bflo(y.z), bfhi(y.z), bflo(y.w), bfhi(y.w)};
#pragma unroll
                            for (int i = 0; i < 8; ++i) r[i] = yv[i] + xv[i] * r[i];
                        }
                        v4u w; w.x = pk2(r[0], r[1]); w.y = pk2(r[2], r[3]); w.z = pk2(r[4], r[5]); w.w = pk2(r[6], r[7]);
                        st16(O + off, w); } } }
    }
};

typedef short bf16x8 __attribute__((ext_vector_type(8)));
typedef float f32x16 __attribute__((ext_vector_type(16)));
constexpr size_t WS_ALIST = 456 * MiB;
constexpr size_t WS_OP01 = 224 * MiB;
constexpr size_t WS_OP23 = 472 * MiB;
constexpr size_t WS_LSE = 504 * MiB;
constexpr int CW_BCNT = 12288;
constexpr int ALCAP = 8192;

__device__ __forceinline__ void attn_gate(Frame& F) {
    const int gw = F.vcu * NWAVES + F.wave, NGW = F.G * NWAVES, L = F.lane;
    const bf16* Q = WSP(bf16, WS_Q); const float* km = (const float*)(F.ctl + CW_KM);
    unsigned* bcnt = (unsigned*)(F.ctl + CW_BCNT); unsigned* list = WSP(unsigned, WS_ALIST); float* lse = WSP(float, WS_LSE);
    for (int w = gw; w < BATCH * NH * (SEQ / 64); w += NGW) {
        const int bh = w >> 7, b = bh >> 3, h = bh & 7, tt = (w & 127) * 64 + L, t = b * SEQ + tt, blk = tt >> 8;
        float q[64];
        { const v4u* qp = (const v4u*)(Q + (size_t)t * AW + h * 64);
#pragma unroll
          for (int i = 0; i < 8; ++i) { const v4u x = qp[i]; q[8 * i] = bflo(x.x); q[8 * i + 1] = bfhi(x.x); q[8 * i + 2] = bflo(x.y); q[8 * i + 3] = bfhi(x.y);
              q[8 * i + 4] = bflo(x.z); q[8 * i + 5] = bfhi(x.z); q[8 * i + 6] = bflo(x.w); q[8 * i + 7] = bfhi(x.w); } }
        float v0 = -3e38f, v1 = -3e38f, v2 = -3e38f; int i0 = -1, i1 = -1, i2 = -1;
        for (int j = 0; j < blk; ++j) { const float* kp = km + (size_t)((b * NH + h) * NBLK + j) * HD; float g = 0.f;
#pragma unroll
            for (int d = 0; d < 64; ++d) g += q[d] * kp[d];
            if (g > v0) { v2 = v1; i2 = i1; v1 = v0; i1 = i0; v0 = g; i0 = j; }
            else if (g > v1) { v2 = v1; i2 = i1; v1 = g; i1 = j; }
            else if (g > v2) { v2 = g; i2 = j; } }
        float* lp = lse + ((size_t)t * NH + h) * 4;
        if (i0 < 0) lp[0] = -1e30f; if (i1 < 0) lp[1] = -1e30f; if (i2 < 0) lp[2] = -1e30f;
        for (int j = 0; j < blk; ++j) {
            const bool sel = (i0 == j) || (i1 == j) || (i2 == j);
            const unsigned long long mask = __ballot(sel);
            if (mask) { const int leader = __ffsll((long long)mask) - 1; const int bucket = (b * NH + h) * NBLK + j;
                unsigned base = 0u;
                if (L == leader) base = __hip_atomic_fetch_add(bcnt + bucket, (unsigned)__popcll(mask), RLX_AGENT);
                base = (unsigned)__shfl((int)base, leader);
                if (sel) { const unsigned pos = base + (unsigned)__popcll(mask & ((1ull << L) - 1ull)); const unsigned slot = (i0 == j) ? 0u : ((i1 == j) ? 1u : 2u);
                    list[(size_t)bucket * ALCAP + pos] = ((unsigned)tt << 2) | slot; } }
        }
    }
}

__device__ __forceinline__ unsigned cvtpk(float lo, float hi) { typedef float f32x2_t __attribute__((ext_vector_type(2))); typedef __bf16 bf16x2_t __attribute__((ext_vector_type(2)));
    f32x2_t v = {lo, hi}; bf16x2_t r = __builtin_convertvector(v, bf16x2_t); return __builtin_bit_cast(unsigned, r); }

constexpr int AT_KROW = 144, AT_VROW = 520, AT_KOFF = 0, AT_VOFF = 256 * AT_KROW;
__device__ __forceinline__ void attn_item(Frame& F, int b, int h, int j, bool own, const unsigned* lst, int nvalid) {
    const int tid = F.tid, L = F.lane, r = L & 31, hh = L >> 5, wv = F.wave;
    LAS unsigned char* Kl = F.lds + AT_KOFF; LAS unsigned char* Vl = F.lds + AT_VOFF;
    const bf16* Kg = WSP(bf16, WS_K) + ((size_t)(b * SEQ + j * 256)) * AW + h * 64;
    const bf16* Vg = WSP(bf16, WS_VT) + ((size_t)((b * NH + h) * HD)) * SEQ + j * 256;
    v4u kr[4], vr[4];
#pragma unroll
    for (int i = 0; i < 4; ++i) { const int idx = tid + 512 * i; kr[i] = *(const v4u*)(Kg + (size_t)(idx >> 3) * AW + (idx & 7) * 8); vr[i] = *(const v4u*)(Vg + (size_t)(idx >> 5) * SEQ + (idx & 31) * 8); }
    const int qi = wv * 32 + r; const bool valid = qi < nvalid;
    unsigned ent; if (own) ent = ((unsigned)(j * 256 + qi) << 2) | 3u; else ent = lst[valid ? qi : 0];
    const int tt = (int)(ent >> 2), slot = (int)(ent & 3u), t = b * SEQ + tt;
    bf16x8 qf[4];
    { const bf16* qp = WSP(bf16, WS_Q) + (size_t)t * AW + h * 64 + hh * 8;
#pragma unroll
      for (int d0 = 0; d0 < 4; ++d0) qf[d0] = *(const bf16x8*)(qp + d0 * 16); }
#pragma unroll
    for (int i = 0; i < 4; ++i) { const int idx = tid + 512 * i; *(LAS v4u*)(Kl + (idx >> 3) * AT_KROW + (idx & 7) * 16) = kr[i]; *(LAS v4u*)(Vl + (idx >> 5) * AT_VROW + (idx & 31) * 16) = vr[i]; }
    __syncthreads();
#ifdef ATT_STAGGER
    if (wv >= 4) __builtin_amdgcn_s_sleep(ATT_STAGGER);
#endif
#ifdef ATT_REP_COMPUTE
    for (int arep = 0; arep < 2; ++arep)
#endif
    if (wv * 32 < nvalid) {
        float m = -1e30f, l = 0.f; f32x16 O0 = {}, O1 = {};
        const int qrel = tt & 255;
#pragma unroll
        for (int hk = 0; hk < 2; ++hk) {
            if (own && hk * 4 > wv) continue;
            f32x16 S[4];
#pragma unroll
            for (int kt = 0; kt < 4; ++kt) S[kt] = (f32x16){};
#pragma unroll
            for (int d0 = 0; d0 < 4; ++d0) {
#pragma unroll
                for (int kt = 0; kt < 4; ++kt) { const bf16x8 kf = *(const LAS bf16x8*)(Kl + (hk * 128 + kt * 32 + r) * AT_KROW + d0 * 32 + hh * 16);
                    S[kt] = __builtin_amdgcn_mfma_f32_32x32x16_bf16(kf, qf[d0], S[kt], 0, 0, 0); }
                if (d0 & 1) __builtin_amdgcn_sched_barrier(0); }
            if (own) {
                asm volatile("; causal masking (own block only)" ::: "memory");
#pragma unroll
                for (int kt = 0; kt < 4; ++kt)
#pragma unroll
                    for (int rg = 0; rg < 16; ++rg) { const int key = hk * 128 + kt * 32 + (rg & 3) + 8 * (rg >> 2) + 4 * hh; if (key > qrel) S[kt][rg] = -1e30f; } }
            float mx = S[0][0];
#pragma unroll
            for (int kt = 0; kt < 4; ++kt)
#pragma unroll
                for (int rg = 0; rg < 16; ++rg) mx = fmaxf(mx, S[kt][rg]);
            mx = fmaxf(mx, __shfl_xor(mx, 32));
            const float mn = fmaxf(m, mx), alpha = __builtin_amdgcn_exp2f(m - mn); m = mn; l *= alpha;
#pragma unroll
            for (int rg = 0; rg < 16; ++rg) { O0[rg] *= alpha; O1[rg] *= alpha; }
            float ls = 0.f;
#pragma unroll
            for (int kt = 0; kt < 4; ++kt) {
                unsigned pw[8];
#pragma unroll
                for (int rg = 0; rg < 16; rg += 2) { const float p0 = __builtin_amdgcn_exp2f(S[kt][rg] - mn), p1 = __builtin_amdgcn_exp2f(S[kt][rg + 1] - mn); ls += p0 + p1; pw[rg >> 1] = cvtpk(p0, p1); }
#pragma unroll
                for (int s = 0; s < 2; ++s) {
                    const v4u pv = {pw[4 * s], pw[4 * s + 1], pw[4 * s + 2], pw[4 * s + 3]}; const bf16x8 pf = __builtin_bit_cast(bf16x8, pv);
                    const int kb = (hk * 128 + kt * 32 + 16 * s + 4 * hh) * 2;
                    { const LAS unsigned char* vp = Vl + r * AT_VROW + kb; const v2u lo = *(const LAS v2u*)vp, hi = *(const LAS v2u*)(vp + 16);
                      const v4u vv = {lo.x, lo.y, hi.x, hi.y}; O0 = __builtin_amdgcn_mfma_f32_32x32x16_bf16(__builtin_bit_cast(bf16x8, vv), pf, O0, 0, 0, 0); }
                    { const LAS unsigned char* vp = Vl + (32 + r) * AT_VROW + kb; const v2u lo = *(const LAS v2u*)vp, hi = *(const LAS v2u*)(vp + 16);
                      const v4u vv = {lo.x, lo.y, hi.x, hi.y}; O1 = __builtin_amdgcn_mfma_f32_32x32x16_bf16(__builtin_bit_cast(bf16x8, vv), pf, O1, 0, 0, 0); } } }
            l += ls;
        }
        l += __shfl_xor(l, 32);
        if (valid) {
            const float rl = 1.f / l;
            bf16* op = (slot < 2 ? WSP(bf16, WS_OP01) + (((size_t)t * NH + h) * 2 + slot) * 64 : WSP(bf16, WS_OP23) + (((size_t)t * NH + h) * 2 + (slot - 2)) * 64) + 4 * hh;
#pragma unroll
            for (int g4 = 0; g4 < 4; ++g4) { v2u w0, w1; w0.x = cvtpk(O0[4 * g4] * rl, O0[4 * g4 + 1] * rl); w0.y = cvtpk(O0[4 * g4 + 2] * rl, O0[4 * g4 + 3] * rl);
                w1.x = cvtpk(O1[4 * g4] * rl, O1[4 * g4 + 1] * rl); w1.y = cvtpk(O1[4 * g4 + 2] * rl, O1[4 * g4 + 3] * rl);
                *(v2u*)(op + 8 * g4) = w0; *(v2u*)(op + 32 + 8 * g4) = w1; }
            if (hh == 0) WSP(float, WS_LSE)[((size_t)t * NH + h) * 4 + slot] = m + log2f(l);
        }
    }
    __syncthreads();
}
__device__ __forceinline__ void attn_items(Frame& F) {
    LAS int* pre = (LAS int*)(F.lds + 72 * 1024);
    const unsigned* bcnt = (const unsigned*)(F.ctl + CW_BCNT);
    LAS int* cntl = pre + 520;
    for (int i = F.tid; i < 512; i += NWAVES * 64) cntl[i] = (int)__hip_atomic_load((gu32*)(F.ctl + CW_BCNT) + i, RLX_AGENT);
    __syncthreads();
    if (F.tid == 0) { int a = 0; for (int i = 0; i < 512; ++i) { pre[i] = a; a += (cntl[i] + 255) >> 8; } pre[512] = a; }
    __syncthreads();
    const int total = 512 + pre[512];
    for (int it = (int)blockIdx.x; it < total; it += F.G) {
        int bh, j, n; bool own; const unsigned* lst;
        if (it < 512) { bh = it >> 5; j = it & 31; own = true; lst = nullptr; n = 256; }
        else { const int s = it - 512; int lo = 0, hi = 512;
            while (hi - lo > 1) { const int mid = (lo + hi) >> 1; if (pre[mid] <= s) lo = mid; else hi = mid; }
            const int bucket = lo, tile = s - pre[bucket]; n = cntl[bucket] - tile * 256; n = n > 256 ? 256 : n; bh = bucket >> 5; j = bucket & 31; own = false;
            lst = WSP(unsigned, WS_ALIST) + (size_t)bucket * ALCAP + tile * 256; }
        const int b_ = __builtin_amdgcn_readfirstlane(bh >> 3), h_ = __builtin_amdgcn_readfirstlane(bh & 7), j_ = __builtin_amdgcn_readfirstlane(j), n_ = __builtin_amdgcn_readfirstlane(n);
        attn_item(F, b_, h_, j_, own, lst, n_);
    }
}
__device__ __forceinline__ void attn_combine(Frame& F) {
    if (F.G == 256 && blockIdx.x < 128) return;
    const int nb = F.G == 256 ? 128 : F.G, bi = F.G == 256 ? (int)blockIdx.x - 128 : F.vcu;
    const int gw = bi * NWAVES + F.wave, NGW = nb * NWAVES, L = F.lane, h = L >> 3, ch = L & 7;
    const float* lse = WSP(float, WS_LSE); bf16* YA = WSP(bf16, WS_YA);
    for (int t = gw; t < T; t += NGW) {
        const size_t th = (size_t)t * NH + h;
        const f32x4 ls = *(const f32x4*)(lse + th * 4);
        const float mx = fmaxf(fmaxf(ls[0], ls[1]), fmaxf(ls[2], ls[3]));
        const float w0 = __builtin_amdgcn_exp2f(ls[0] - mx), w1 = __builtin_amdgcn_exp2f(ls[1] - mx), w2 = __builtin_amdgcn_exp2f(ls[2] - mx), w3 = __builtin_amdgcn_exp2f(ls[3] - mx), inv = 1.f / (w0 + w1 + w2 + w3);
        const v4u a0 = __builtin_nontemporal_load((const v4u*)(WSP(bf16, WS_OP01) + (th * 2 + 0) * 64 + ch * 8)), a1 = __builtin_nontemporal_load((const v4u*)(WSP(bf16, WS_OP01) + (th * 2 + 1) * 64 + ch * 8));
        const v4u a2 = __builtin_nontemporal_load((const v4u*)(WSP(bf16, WS_OP23) + (th * 2 + 0) * 64 + ch * 8)), a3 = __builtin_nontemporal_load((const v4u*)(WSP(bf16, WS_OP23) + (th * 2 + 1) * 64 + ch * 8));
        float o[8];
        const unsigned x0[4] = {a0.x, a0.y, a0.z, a0.w}, x1[4] = {a1.x, a1.y, a1.z, a1.w}, x2[4] = {a2.x, a2.y, a2.z, a2.w}, x3[4] = {a3.x, a3.y, a3.z, a3.w};
#pragma unroll
        for (int i = 0; i < 4; ++i) {
            float lo_ = w3 * bflo(x3[i]), hi_ = w3 * bfhi(x3[i]);
            if (ls[0] > -1e29f) { lo_ += w0 * bflo(x0[i]); hi_ += w0 * bfhi(x0[i]); }
            if (ls[1] > -1e29f) { lo_ += w1 * bflo(x1[i]); hi_ += w1 * bfhi(x1[i]); }
            if (ls[2] > -1e29f) { lo_ += w2 * bflo(x2[i]); hi_ += w2 * bfhi(x2[i]); }
            o[2 * i] = lo_ * inv; o[2 * i + 1] = hi_ * inv; }
        v4u w; w.x = cvtpk(o[0], o[1]); w.y = cvtpk(o[2], o[3]); w.z = cvtpk(o[4], o[5]); w.w = cvtpk(o[6], o[7]);
        *(v4u*)(YA + (size_t)t * AW + h * 64 + ch * 8) = w;
    }
}
struct S5Order { static constexpr bool GATHER = false; int G, c;
    __device__ __forceinline__ void a_ready(const pg8::Unit&) const {}
    __device__ __forceinline__ void done(const pg8::Unit&) const {}
    __device__ __forceinline__ bool next(int i, pg8::Unit& u) const { const int L = i * G + c; if (L >= NG * 4) return false; const int g = L >> 2, rt = L & 3;
        u.arow = g * 1024 + rt * 256; u.brow = g * 256; u.pm = rt; u.pn = 0; u.e = g; u.nrow = 256; u.kind = 0; u.aux = 0; return true; } };
struct EpiS5A { float* E;
    __device__ __forceinline__ void operator()(const pg8::f32x4 (&acc)[2][2][4][2], const pg8::Unit& u, int wr, int wc, int fr, int fq) const {
        asm volatile("" : "+v"(fr), "+v"(fq));
#pragma unroll
        for (int ai = 0; ai < 2; ++ai)
#pragma unroll
            for (int m = 0; m < 4; ++m) { float* p = E + (size_t)(u.arow + ai * 128 + wr * 64 + m * 16 + fr) * 128 + wc * 32 + 8 * fq;
                *(pg8::f32x4*)p = acc[ai][0][m][0]; *(pg8::f32x4*)(p + 4) = acc[ai][0][m][1]; }
    }
};
struct EpiS5C { bf16* YG;
    __device__ __forceinline__ void operator()(const pg8::f32x4 (&acc)[2][2][4][2], const pg8::Unit& u, int wr, int wc, int fr, int fq) const {
        asm volatile("" : "+v"(fr), "+v"(fq));
        const int g = u.e, n0 = wc * 32 + 8 * fq, t0 = n0 >> 4, co0 = n0 & 15;
#pragma unroll
        for (int ai = 0; ai < 2; ++ai)
#pragma unroll
            for (int m = 0; m < 4; ++m) { const int row = u.pm * 256 + ai * 128 + wr * 64 + m * 16 + fr, b = row >> 9, c = row & 511;
                bf16* yp = YG + (size_t)(b * SEQ + 16 * c + t0) * SW + 16 * g + co0;
#pragma unroll
                for (int bj = 0; bj < 2; ++bj) {
                    const pg8::f32x4 v0 = acc[ai][bj][m][0], v1 = acc[ai][bj][m][1];
                    v4u w; w.x = pk2(gelu_tanh(v0[0]), gelu_tanh(v0[1])); w.y = pk2(gelu_tanh(v0[2]), gelu_tanh(v0[3]));
                    w.z = pk2(gelu_tanh(v1[0]), gelu_tanh(v1[1])); w.w = pk2(gelu_tanh(v1[2]), gelu_tanh(v1[3]));
                    *(v4u*)(yp + (size_t)bj * 8 * SW) = w; }
                __builtin_amdgcn_sched_barrier(0); }
    }
};
__device__ __forceinline__ void s5_fill_kt(Frame& F) {
    const int gt = F.vcu * (NWAVES * 64) + F.tid, NGT = F.G * NWAVES * 64;
    const float* P5 = WSP(float, WS_S5P); const float* PWr = P5 + 131072; const float* PWi = PWr + 2048 * 17; const float* par = WSP(float, WS_PAR);
    float* KT = WSP(float, WS_S5KT);
    for (int i = gt; i < NG * 16 * 256; i += NGT) { const int ci = i & 15, co = (i >> 4) & 15, tau = (i >> 8) & 15, g = i >> 12; float a = 0.f;
        for (int p = 0; p < 64; ++p) { const int gp = g * 64 + p;
            const float qr = P5[8192 + gp], qi = P5[8192 + 2048 + gp], b_r = par[PAR_BRE + gp * 16 + ci], b_i = par[PAR_BIM + gp * 16 + ci];
            const float bbr = qr * b_r - qi * b_i, bbi = qr * b_i + qi * b_r, wr_ = PWr[gp * 17 + tau], wi_ = PWi[gp * 17 + tau];
            const float xr = wr_ * bbr - wi_ * bbi, xi = wr_ * bbi + wi_ * bbr;
            const float cr = par[PAR_CRE + (g * 16 + co) * 64 + p], ci_ = par[PAR_CIM + (g * 16 + co) * 64 + p];
            a += cr * xr - ci_ * xi; }
        KT[i] = a; }
}
__device__ __forceinline__ void s5_fill_wc(Frame& F) {
    const int gt = F.vcu * (NWAVES * 64) + F.tid, NGT = F.G * NWAVES * 64;
    const float* P5 = WSP(float, WS_S5P); const float* PWr = P5 + 131072; const float* PWi = PWr + 2048 * 17; const float* KT = WSP(float, WS_S5KT); const float* par = WSP(float, WS_PAR);
    bf16* Wc = WSP(bf16, WS_S5WC);
    for (int i = gt; i < NG * 256 * 384; i += NGT) { const int k = i % 384, n = (i / 384) & 255, g = i / (384 * 256), t = n >> 4, co = n & 15; float val = 0.f;
        if (k < 256) { const int s_ = k >> 4, ci = k & 15;
            if (s_ <= t) val = KT[((g * 16 + (t - s_)) * 16 + co) * 16 + ci];
            if (s_ == t && ci == co) val += par[PAR_SD + g * 16 + co]; }
        else { const int p = (k - 256) & 63, gp = g * 64 + p; const float cr = par[PAR_CRE + (g * 16 + co) * 64 + p], ci_ = par[PAR_CIM + (g * 16 + co) * 64 + p];
            const float wr_ = PWr[gp * 17 + t + 1], wi_ = PWi[gp * 17 + t + 1];
            val = (k < 320) ? (cr * wr_ - ci_ * wi_) : -(cr * wi_ + ci_ * wr_); }
        Wc[((size_t)(g * 256 + perm8(n))) * 384 + k] = (bf16)f2bf(val); }
}
__device__ __forceinline__ void s5_carry(Frame& F) {
    const float* P5 = WSP(float, WS_S5P); const float* PWr = P5 + 131072; const float* PWi = PWr + 2048 * 17; const float* E = WSP(float, WS_S5E); bf16* UA = WSP(bf16, WS_UA);
    LAS float* Z = (LAS float*)(F.lds);
    const int seg = F.wave, p = F.lane;
    for (int bg = F.vcu; bg < BATCH * NG; bg += F.G) { const int b = bg / NG, g = bg % NG, gp = g * 64 + p;
        const float ar = PWr[gp * 17 + 16], ai = PWi[gp * 17 + 16];
        const size_t row0 = (size_t)g * 1024 + b * 512 + seg * 64;
        float zr = 0.f, zi = 0.f;
        for (int c0 = 0; c0 < 64; c0 += 8) { float er[8], ei[8];
#pragma unroll
            for (int k = 0; k < 8; ++k) { er[k] = E[(row0 + c0 + k) * 128 + p]; ei[k] = E[(row0 + c0 + k) * 128 + 64 + p]; }
#pragma unroll
            for (int k = 0; k < 8; ++k) { const float nr = ar * zr - ai * zi + er[k], ni = ar * zi + ai * zr + ei[k]; zr = nr; zi = ni; } }
        Z[(seg * 64 + p) * 2] = zr; Z[(seg * 64 + p) * 2 + 1] = zi;
        __syncthreads();
        if (seg == 0) { float br = ar, bi = ai;
#pragma unroll
            for (int k = 0; k < 6; ++k) { const float tr = br * br - bi * bi, ti = 2.f * br * bi; br = tr; bi = ti; }
            float sr = 0.f, si = 0.f;
            for (int sg = 0; sg < 8; ++sg) { const float xr = Z[(sg * 64 + p) * 2], xi = Z[(sg * 64 + p) * 2 + 1]; Z[(sg * 64 + p) * 2] = sr; Z[(sg * 64 + p) * 2 + 1] = si;
                const float nr = br * sr - bi * si + xr, ni = br * si + bi * sr + xi; sr = nr; si = ni; } }
        __syncthreads();
        float sr = Z[(seg * 64 + p) * 2], si = Z[(seg * 64 + p) * 2 + 1];
        for (int c0 = 0; c0 < 64; c0 += 8) { float er[8], ei[8];
#pragma unroll
            for (int k = 0; k < 8; ++k) { er[k] = E[(row0 + c0 + k) * 128 + p]; ei[k] = E[(row0 + c0 + k) * 128 + 64 + p]; }
#pragma unroll
            for (int k = 0; k < 8; ++k) { bf16* up = UA + (row0 + c0 + k) * 384 + 256 + p; up[0] = (bf16)f2bf(sr); up[64] = (bf16)f2bf(si);
                const float nr = ar * sr - ai * si + er[k], ni = ar * si + ai * sr + ei[k]; sr = nr; si = ni; } }
        __syncthreads();
    }
}
constexpr int SCR_OFF = LDSCTL_OFF + 512;
#ifndef MOE_LAG
#define MOE_LAG 2
#endif
constexpr int MT_SEG = 100, MT_MAXSEG = 72, MT_ULIST = 400, MT_MAXU = 16;
__device__ __forceinline__ void phase_rows(Frame& F, bool dry = false) {
    LAS float* h2t = (LAS float*)(F.lds);
    LAS float* lg = (LAS float*)(F.lds + 65536);
    LAS float* gtm = (LAS float*)(F.lds + 131072);
    LAS float* pg2 = gtm + 2 * D; LAS float* shf = pg2 + 2 * D;
    LAS unsigned* hist = (LAS unsigned*)(F.lds + SCR_OFF); LAS unsigned* base = hist + 32; LAS int* rec_e = (LAS int*)(base + 32); LAS int* rec_lp = rec_e + 256;
    const float* adaf = WSP(float, WS_ADAF); const float* par = WSP(float, WS_PAR);
    const int L = F.lane, wv = F.wave;
    for (int i = F.tid; i < 2 * D; i += NWAVES * 64) { const int b = i >> 10, k = i & (D - 1);
        gtm[i] = adaf[b * 6 * D + 2 * D + k] * par[PAR_MPG + k];
        pg2[i] = par[PAR_FPRE + k] * (1.f + adaf[b * 6 * D + 4 * D + k]); shf[i] = adaf[b * 6 * D + 3 * D + k]; }
    f32x4 wreg[16];
#pragma unroll
    for (int j = 0; j < 4; ++j)
#pragma unroll
        for (int i = 0; i < 4; ++i) wreg[j * 4 + i] = *(const f32x4*)(par + PAR_RW + (4 * L + 256 * j + i) * NE + 4 * wv);
    if (F.tid < 32) hist[F.tid] = 0u;
    __syncthreads();
    const bf16* mix = WSP(bf16, WS_MIX); bf16* H2 = WSP(bf16, WS_H2); bf16* X1B = WSP(bf16, WS_X1B);
    int* tok_e = WSP(int, WS_ROUTE); float* tok_w = (float*)(tok_e + T * 4); int* tok_pos = tok_e + 2 * T * 4;
    unsigned* gcnt = (unsigned*)(F.ctl + CW_ECNT);
    for (int t0 = F.vcu * 16; t0 < T; t0 += F.G * 16) {
        {
            const int t = t0 + 2 * wv, b = t >> 13;
            f32x4 mv[2][4], xv[2][4];
#pragma unroll
            for (int q = 0; q < 2; ++q) { const GAS v2u* mr = (const GAS v2u*)(mix + (size_t)(t + q) * D) + L; const GAS f32x4* xr = (const GAS f32x4*)(F.in[0] + (size_t)(t + q) * D) + L;
#pragma unroll
                for (int j = 0; j < 4; ++j) { const v2u mw = __builtin_nontemporal_load(mr + 64 * j); mv[q][j] = (f32x4){bflo(mw.x), bfhi(mw.x), bflo(mw.y), bfhi(mw.y)}; xv[q][j] = __builtin_nontemporal_load(xr + 64 * j); } }
#pragma unroll
            for (int q = 0; q < 2; ++q) { float s = 0.f;
#pragma unroll
                for (int j = 0; j < 4; ++j) s += (mv[q][j].x * mv[q][j].x + mv[q][j].y * mv[q][j].y) + (mv[q][j].z * mv[q][j].z + mv[q][j].w * mv[q][j].w);
                const float r1 = 1.f / sqrtf(wave_sum(s) * (1.f / D) + NORM_EPS);
                float s2 = 0.f; GAS v2u* orow = (GAS v2u*)(X1B + (size_t)(t + q) * D) + L;
#pragma unroll
                for (int j = 0; j < 4; ++j) { const f32x4 g = *(const LAS f32x4*)(gtm + b * D + 4 * L + 256 * j);
                    xv[q][j] = xv[q][j] + g * (mv[q][j] * r1); { v2u w; w.x = pk2(xv[q][j].x, xv[q][j].y); w.y = pk2(xv[q][j].z, xv[q][j].w); __builtin_nontemporal_store(w, orow + 64 * j); }
                    s2 += (xv[q][j].x * xv[q][j].x + xv[q][j].y * xv[q][j].y) + (xv[q][j].z * xv[q][j].z + xv[q][j].w * xv[q][j].w); }
                const float r2 = 1.f / sqrtf(wave_sum(s2) * (1.f / D) + NORM_EPS);
#ifdef MOE_F8
                GAS unsigned* h4 = (GAS unsigned*)(WSP(unsigned char, WS_H2) + (size_t)(t + q) * D) + L;
#pragma unroll
                for (int j = 0; j < 4; ++j) { const f32x4 a = *(const LAS f32x4*)(pg2 + b * D + 4 * L + 256 * j), c = *(const LAS f32x4*)(shf + b * D + 4 * L + 256 * j);
                    const f32x4 h = xv[q][j] * r2 * a + c;
                    h4[64 * j] = pk4_fp8(8.f * h.x, 8.f * h.y, 8.f * h.z, 8.f * h.w);
                    *(LAS f32x4*)(h2t + (2 * wv + q) * D + 4 * L + 256 * j) = h; } }
#else
                GAS unsigned long long* h8 = (GAS unsigned long long*)(H2 + (size_t)(t + q) * D) + L;
#pragma unroll
                for (int j = 0; j < 4; ++j) { const f32x4 a = *(const LAS f32x4*)(pg2 + b * D + 4 * L + 256 * j), c = *(const LAS f32x4*)(shf + b * D + 4 * L + 256 * j);
                    const f32x4 h = xv[q][j] * r2 * a + c;
                    h8[64 * j] = (unsigned long long)pk2(h.x, h.y) | ((unsigned long long)pk2(h.z, h.w) << 32);
                    *(LAS f32x4*)(h2t + (2 * wv + q) * D + 4 * L + 256 * j) = h; } }
#endif
        }
        __syncthreads();
        {
            const int hi = (L >> 5) & 1, h2b = (L >> 4) & 1;
#pragma unroll 2
            for (int tk = 0; tk < 16; ++tk) {
                f32x4 a = {0.f, 0.f, 0.f, 0.f};
#pragma unroll
                for (int j = 0; j < 4; ++j) { const f32x4 h = *(const LAS f32x4*)(h2t + tk * D + 4 * L + 256 * j);
                    a += wreg[j * 4 + 0] * h.x; a += wreg[j * 4 + 1] * h.y; a += wreg[j * 4 + 2] * h.z; a += wreg[j * 4 + 3] * h.w; }
                const float m0 = hi ? a.z : a.x, o0 = hi ? a.x : a.z, m1 = hi ? a.w : a.y, o1 = hi ? a.y : a.w;
                const float v0 = m0 + __shfl_xor(o0, 32), v1 = m1 + __shfl_xor(o1, 32);
                float v = (h2b ? v1 : v0) + __shfl_xor(h2b ? v0 : v1, 16);
                v += __shfl_xor(v, 8); v += __shfl_xor(v, 4); v += __shfl_xor(v, 2); v += __shfl_xor(v, 1);
                if ((L & 15) == 0) lg[tk * NE + 4 * wv + 2 * hi + h2b] = v;
            }
        }
        __syncthreads();
        {
            const int e = L & 31, half = L >> 5, tl = 2 * wv + half, t = t0 + tl;
            float val = lg[tl * NE + e] + par[PAR_RB + e];
            int se[4]; float sv[4];
#pragma unroll
            for (int r = 0; r < 4; ++r) { float mx = val;
                mx = fmaxf(mx, __shfl_xor(mx, 16)); mx = fmaxf(mx, __shfl_xor(mx, 8)); mx = fmaxf(mx, __shfl_xor(mx, 4)); mx = fmaxf(mx, __shfl_xor(mx, 2)); mx = fmaxf(mx, __shfl_xor(mx, 1));
                const unsigned long long bal = __ballot(val == mx); const unsigned hm = half ? (unsigned)(bal >> 32) : (unsigned)bal; const int win = __ffs((int)hm) - 1;
                se[r] = win; sv[r] = mx; if (e == win) val = -3e38f; }
            const float e1 = __expf(sv[1] - sv[0]), e2 = __expf(sv[2] - sv[0]), e3 = __expf(sv[3] - sv[0]), inv = 1.f / (1.f + e1 + e2 + e3);
            if (e < 4) { const int ex = e == 0 ? se[0] : (e == 1 ? se[1] : (e == 2 ? se[2] : se[3]));
                const float wgt = (e == 0 ? 1.f : (e == 1 ? e1 : (e == 2 ? e2 : e3))) * inv;
                tok_e[t * 4 + e] = ex; tok_w[t * 4 + e] = wgt;
                const unsigned lp = dry ? 0u : __hip_atomic_fetch_add(hist + ex, 1u, __ATOMIC_RELAXED, __HIP_MEMORY_SCOPE_WORKGROUP);
                rec_e[tl * 4 + e] = ex; rec_lp[tl * 4 + e] = (int)lp; }
        }
        __syncthreads();
        if (F.tid < 32) { const unsigned h = hist[F.tid]; base[F.tid] = h ? __hip_atomic_fetch_add(gcnt + F.tid, h, RLX_AGENT) : 0u; }
        __syncthreads();
        if (!dry && F.tid < 64) { const int e_ = rec_e[F.tid], pos_ = (int)base[e_] + rec_lp[F.tid]; tok_pos[(t0 + (F.tid >> 2)) * 4 + (F.tid & 3)] = pos_;
            WSP(int, WS_ELIST)[e_ * ELCAP + pos_] = t0 + (F.tid >> 2); }
        if (F.tid < 32) hist[F.tid] = 0u;
        __syncthreads();
    }
}

__device__ __forceinline__ void moe_tables(Frame& F, int nct = 0, int brows = 0) {
    LAS int* cnt = (LAS int*)(F.lds + SCR_OFF); LAS int* off = cnt + 32; LAS int* tpre = off + 32;
    if (F.tid < NE) cnt[F.tid] = (int)__hip_atomic_load(F.ctl + CW_ECNT + F.tid, RLX_AGENT);
    __syncthreads();
    if (F.tid == 0) { int o = 0, tp = 0;
        for (int e = 0; e < NE; ++e) { const int c = cnt[e]; off[e] = o; tpre[e] = tp; o += c; tp += (c + 255) >> 8; }
        tpre[NE] = tp;
        LAS int* sg = cnt + MT_SEG; const int n = (tp + 31) >> 5; int ns = 0, pos = 0;
        for (int g = 0; g < n; ++g) { const int tg = (tp - 32 * g) < 32 ? (tp - 32 * g) : 32;
            sg[1 + ns] = pos; sg[1 + MT_MAXSEG + ns] = 0; sg[1 + 2 * MT_MAXSEG + ns] = g; ++ns; pos += 8 * tg; sg[1 + 3 * MT_MAXSEG + g] = pos;
            if (g >= MOE_LAG) { sg[1 + ns] = pos; sg[1 + MT_MAXSEG + ns] = 1; sg[1 + 2 * MT_MAXSEG + ns] = g - MOE_LAG; ++ns; pos += 4 * 32; } }
        for (int g = (n > MOE_LAG ? n - MOE_LAG : 0); g < n; ++g) { const int tg = (tp - 32 * g) < 32 ? (tp - 32 * g) : 32; sg[1 + ns] = pos; sg[1 + MT_MAXSEG + ns] = 1; sg[1 + 2 * MT_MAXSEG + ns] = g; ++ns; pos += 4 * tg; }
        sg[1 + ns] = pos; sg[0] = ns; }
    __syncthreads();
    if (nct > 0 && F.G == 256 && F.tid < MT_MAXU) {
        LAS int* ul = cnt + MT_ULIST + 8 * F.tid; const int i = F.tid, c = (int)blockIdx.x, xcd = c & 7, slot = c >> 3, rpx = 32 / nct;
        const int rtg = (i * 8 + xcd) * rpx + slot / nct, pn = slot % nct;
        if (rtg >= tpre[NE]) { ul[0] = -1; }
        else { int e = 0; for (int k = 1; k < NE; ++k) if (tpre[k] <= rtg) e = k;
            const int rt = rtg - tpre[e], nr = cnt[e] - rt * 256;
            ul[0] = off[e] + rt * 256; ul[1] = e * brows + pn * 256; ul[2] = rt; ul[3] = pn; ul[4] = e; ul[5] = nr > 256 ? 256 : nr; } }
    __syncthreads();
}
template <bool GA> struct MoeOrder {
    static constexpr bool GATHER = GA;
#if defined(T_ACQ)
    __device__ __forceinline__ void a_ready(const pg8::Unit&) const { if (!GA) { if (threadIdx.x < 64) { __builtin_amdgcn_fence(__ATOMIC_ACQUIRE, "agent"); asm volatile("s_waitcnt vmcnt(0)" ::: "memory"); } asm volatile("" ::: "memory"); __builtin_amdgcn_s_barrier(); asm volatile("" ::: "memory"); } }
#else
    __device__ __forceinline__ void a_ready(const pg8::Unit&) const {}
#endif
#if defined(T_DRAIN)
    __device__ __forceinline__ void done(const pg8::Unit&) const { if (GA) asm volatile("s_waitcnt vmcnt(0)" ::: "memory"); }
#else
    __device__ __forceinline__ void done(const pg8::Unit&) const {}
#endif
    const LAS int* tab; const int* elist; int nct, brows, G, c;
    __device__ __forceinline__ bool next(int i, pg8::Unit& u) const {
        if (G == 256) { if (i >= MT_MAXU) return false; const LAS int* ul = tab + MT_ULIST + 8 * i; const int a0 = ul[0]; if (a0 < 0) return false;
            u.arow = __builtin_amdgcn_readfirstlane(a0); u.brow = __builtin_amdgcn_readfirstlane(ul[1]); u.pm = __builtin_amdgcn_readfirstlane(ul[2]); u.pn = __builtin_amdgcn_readfirstlane(ul[3]);
            u.e = __builtin_amdgcn_readfirstlane(ul[4]); u.nrow = __builtin_amdgcn_readfirstlane(ul[5]); u.kind = 0; u.aux = 0; return true; }
        int rtg, pn;
        if (false) { const int xcd = c & 7, slot = c >> 3, rpx = 32 / nct;
            rtg = (i * 8 + xcd) * rpx + slot / nct; pn = slot % nct; if (rtg >= tab[64 + NE]) return false; }
        else { const int L = i * G + c, total = tab[64 + NE] * nct; if (L >= total) return false; rtg = L / nct; pn = L % nct; }
        int e = 0;
        for (int k = 1; k < NE; ++k) if (tab[64 + k] <= rtg) e = k;
        const int rt = rtg - tab[64 + e], cnt = tab[e], off = tab[32 + e];
        u.e = __builtin_amdgcn_readfirstlane(e); u.pm = __builtin_amdgcn_readfirstlane(rt); u.pn = pn; u.arow = __builtin_amdgcn_readfirstlane(off + rt * 256); u.brow = __builtin_amdgcn_readfirstlane(e * brows + pn * 256);
        const int nr = cnt - rt * 256; u.nrow = __builtin_amdgcn_readfirstlane(nr > 256 ? 256 : nr); u.kind = 0; u.aux = 0; return true;
    }
    __device__ __forceinline__ int arow_of(const pg8::Unit& u, int r) const { return r < u.nrow ? elist[u.e * ELCAP + u.pm * 256 + r] : 0; }
};
struct EpiGU { bf16* H1; const float* bg; const float* bu;
    __device__ __forceinline__ void operator()(const pg8::f32x4 (&acc)[2][2][4][2], const pg8::Unit& u, int wr, int wc, int fr, int fq) const {
        asm volatile("" : "+v"(fr), "+v"(fq));
        const int f0 = u.pn * 128 + wc * 32 + 8 * fq;
#pragma unroll
        for (int ai = 0; ai < 2; ++ai) {
            int fb = f0; asm volatile("" : "+v"(fb));
            const pg8::f32x4 g0 = *(const pg8::f32x4*)(bg + u.e * FF + fb), g1 = *(const pg8::f32x4*)(bg + u.e * FF + fb + 4);
            const pg8::f32x4 u0 = *(const pg8::f32x4*)(bu + u.e * FF + fb), u1 = *(const pg8::f32x4*)(bu + u.e * FF + fb + 4);
#pragma unroll
            for (int m = 0; m < 4; ++m) { const int r = ai * 128 + wr * 64 + m * 16 + fr;
                const pg8::f32x4 a0 = acc[ai][0][m][0] + g0, a1 = acc[ai][0][m][1] + g1, b0 = acc[ai][1][m][0] + u0, b1 = acc[ai][1][m][1] + u1;
                float gg[8] = {a0[0], a0[1], a0[2], a0[3], a1[0], a1[1], a1[2], a1[3]}, uu[8] = {b0[0], b0[1], b0[2], b0[3], b1[0], b1[1], b1[2], b1[3]}, o[8];
#pragma unroll
                for (int i = 0; i < 8; ++i) { const float g = fminf(gg[i], 7.f), up = fminf(fmaxf(uu[i], -7.f), 7.f); o[i] = g * sigmoidf_(1.702f * g) * (up + 1.f); }
                v4u w; w.x = pk2(o[0], o[1]); w.y = pk2(o[2], o[3]); w.z = pk2(o[4], o[5]); w.w = pk2(o[6], o[7]);
#ifdef T_SC1
                if (r < u.nrow) __builtin_amdgcn_raw_buffer_store_b128(w, __builtin_amdgcn_make_buffer_rsrc(H1, 0, (int)((size_t)T * TOPK * FF * 2), 0x00020000), (unsigned)((u.arow + r) * (FF * 2) + fb * 2), 0, 16); } }
#else
                if (r < u.nrow) *(v4u*)(H1 + (size_t)(u.arow + r) * FF + fb) = w; } }
#endif
    }
};
struct EpiDn { bf16* YB; const float* bd;
    __device__ __forceinline__ void operator()(const pg8::f32x4 (&acc)[2][2][4][2], const pg8::Unit& u, int wr, int wc, int fr, int fq) const {
        const int c0 = u.pn * 256 + wc * 32 + 8 * fq;
#pragma unroll
        for (int bj = 0; bj < 2; ++bj) { const pg8::f32x4 d0 = *(const pg8::f32x4*)(bd + u.e * D + c0 + bj * 128), d1 = *(const pg8::f32x4*)(bd + u.e * D + c0 + bj * 128 + 4);
#pragma unroll
            for (int ai = 0; ai < 2; ++ai)
#pragma unroll
                for (int m = 0; m < 4; ++m) { const int r = ai * 128 + wr * 64 + m * 16 + fr;
                    const pg8::f32x4 a0 = acc[ai][bj][m][0] + d0, a1 = acc[ai][bj][m][1] + d1;
                    v4u w; w.x = pk2(a0[0], a0[1]); w.y = pk2(a0[2], a0[3]); w.z = pk2(a1[0], a1[1]); w.w = pk2(a1[2], a1[3]);
                    if (r < u.nrow) *(v4u*)(YB + (size_t)(u.arow + r) * D + c0 + bj * 128) = w; } }
    }
};
constexpr float YB_SCALE = 16.f;
struct EpiGU8 { unsigned char* H1; const float* bg; const float* bu; const float* wscp;
    static constexpr bool BIAS_LDS = true;
    __device__ __forceinline__ void stage_bias(PG8_LAS unsigned char* dst, const pg8::Unit& u, int wid, int lane) const {
        if (wid < 4) { const float* src = (wid < 2 ? bg : bu) + u.e * FF + u.pn * 128 + (wid & 1) * 64 + lane;
            __builtin_amdgcn_global_load_lds((const unsigned*)src, (PG8_LAS unsigned*)(dst + wid * 256), 4, 0, 0); } }
    __device__ __forceinline__ void operator()(const pg8::f32x4 (&acc)[2][2][4][2], const pg8::Unit& u, int wr, int wc, int fr, int fq, const PG8_LAS float* bl) const {
        asm volatile("" : "+v"(fr), "+v"(fq));
        const int fl = wc * 32 + 8 * fq, f0 = u.pn * 128 + fl; const float sr = 0.125f / *wscp;
        const pg8::f32x4 g0 = *(const PG8_LAS pg8::f32x4*)(bl + fl), g1 = *(const PG8_LAS pg8::f32x4*)(bl + fl + 4), u0 = *(const PG8_LAS pg8::f32x4*)(bl + 128 + fl), u1 = *(const PG8_LAS pg8::f32x4*)(bl + 128 + fl + 4);
#pragma unroll
        for (int ai = 0; ai < 2; ++ai)
#pragma unroll
            for (int m = 0; m < 4; ++m) { const int r = ai * 128 + wr * 64 + m * 16 + fr;
                const pg8::f32x4 a0 = acc[ai][0][m][0] * sr + g0, a1 = acc[ai][0][m][1] * sr + g1, b0 = acc[ai][1][m][0] * sr + u0, b1 = acc[ai][1][m][1] * sr + u1;
                float gg[8] = {a0[0], a0[1], a0[2], a0[3], a1[0], a1[1], a1[2], a1[3]}, uu[8] = {b0[0], b0[1], b0[2], b0[3], b1[0], b1[1], b1[2], b1[3]}, o[8];
#pragma unroll
                for (int i = 0; i < 8; ++i) { const float g = fminf(gg[i], 7.f), up = fminf(fmaxf(uu[i], -7.f), 7.f); o[i] = 8.f * (g * sigmoidf_(1.702f * g) * (up + 1.f)); }
                v2u w; w.x = pk4_fp8(o[0], o[1], o[2], o[3]); w.y = pk4_fp8(o[4], o[5], o[6], o[7]);
                if (r < u.nrow) *(v2u*)(H1 + (size_t)(u.arow + r) * FF + f0) = w; }
    }
};
struct EpiDn8 { bf16* YB; const float* bd; const float* wscp;
    static constexpr bool BIAS_LDS = true;
    __device__ __forceinline__ void stage_bias(PG8_LAS unsigned char* dst, const pg8::Unit& u, int wid, int lane) const {
        if (wid < 4) { const float* src = bd + u.e * D + u.pn * 256 + wid * 64 + lane;
            __builtin_amdgcn_global_load_lds((const unsigned*)src, (PG8_LAS unsigned*)(dst + wid * 256), 4, 0, 0); } }
    __device__ __forceinline__ void operator()(const pg8::f32x4 (&acc)[2][2][4][2], const pg8::Unit& u, int wr, int wc, int fr, int fq, const PG8_LAS float* bl) const {
        const int cl = wc * 32 + 8 * fq, c0 = u.pn * 256 + cl; const float sc = 0.125f / *wscp;
#pragma unroll
        for (int bj = 0; bj < 2; ++bj) { const pg8::f32x4 d0 = *(const PG8_LAS pg8::f32x4*)(bl + cl + bj * 128), d1 = *(const PG8_LAS pg8::f32x4*)(bl + cl + bj * 128 + 4);
#pragma unroll
            for (int ai = 0; ai < 2; ++ai)
#pragma unroll
                for (int m = 0; m < 4; ++m) { const int r = ai * 128 + wr * 64 + m * 16 + fr;
                    const pg8::f32x4 a0 = (acc[ai][bj][m][0] * sc + d0) * YB_SCALE, a1 = (acc[ai][bj][m][1] * sc + d1) * YB_SCALE;
                    v2u w; w.x = pk4_fp8(a0[0], a0[1], a0[2], a0[3]); w.y = pk4_fp8(a1[0], a1[1], a1[2], a1[3]);
                    if (r < u.nrow) *(v2u*)((unsigned char*)YB + (size_t)(u.arow + r) * D + c0 + bj * 128) = w; } }
    }
};
constexpr int CW_RDY = 8448;
constexpr int H2ROW0 = (int)(WS_H2 / 2048), H1ROW0 = (int)(WS_H1 / 2048), DN_BROW0 = (int)((WS_WDN_T - WS_WGU_T) / 2048);
struct MoeFused {
    static constexpr bool GATHER = true;
    const LAS int* tab; const int* elist; gu32* ctl; int G, c, base;
    __device__ __forceinline__ bool next(int i, pg8::Unit& u) const {
        const LAS int* sg = tab + MT_SEG; const int ns = sg[0], L = (base + i) * G + c; if (L >= sg[1 + ns]) return false;
        int s = 0; for (int k = 1; k < ns; ++k) if (sg[1 + k] <= L) s = k;
        if (i > 0 && sg[1 + MT_MAXSEG + s] == 1 && L - sg[1 + 3 * MT_MAXSEG + sg[1 + 2 * MT_MAXSEG + s]] < G) return false;
        const int kind = sg[1 + MT_MAXSEG + s], g = sg[1 + 2 * MT_MAXSEG + s], ui = L - sg[1 + s], TT = tab[64 + NE], tg = (TT - 32 * g) < 32 ? (TT - 32 * g) : 32;
        int rt, pn;
        if (kind == 0) { if (tg == 32) { const int xcd = ui & 7, slot = ui >> 3; rt = xcd * 4 + (slot >> 3); pn = slot & 7; } else { rt = ui >> 3; pn = ui & 7; } }
        else { if (tg == 32) { const int xcd = ui & 7, slot = ui >> 3; rt = xcd * 4 + (slot >> 2); pn = slot & 3; } else { rt = ui >> 2; pn = ui & 3; } }
        const int rtg = 32 * g + rt; int e = 0;
        for (int k = 1; k < NE; ++k) if (tab[64 + k] <= rtg) e = k;
        const int rte = rtg - tab[64 + e], cnt = tab[e], off = tab[32 + e], nr = cnt - rte * 256;
        u.e = __builtin_amdgcn_readfirstlane(e); u.pm = __builtin_amdgcn_readfirstlane(rte); u.pn = __builtin_amdgcn_readfirstlane(pn); u.kind = __builtin_amdgcn_readfirstlane(kind); u.aux = __builtin_amdgcn_readfirstlane(rtg);
        u.arow = __builtin_amdgcn_readfirstlane(off + rte * 256); u.nrow = __builtin_amdgcn_readfirstlane(nr > 256 ? 256 : nr);
        u.brow = __builtin_amdgcn_readfirstlane(kind == 0 ? e * 2048 + pn * 256 : DN_BROW0 + e * 1024 + pn * 256); return true;
    }
    __device__ __forceinline__ int arow_of(const pg8::Unit& u, int r) const { return u.kind == 0 ? H2ROW0 + (r < u.nrow ? elist[u.e * ELCAP + u.pm * 256 + r] : 0) : H1ROW0 + u.arow + (r < u.nrow ? r : 0); }
    __device__ __forceinline__ void a_ready(const pg8::Unit& u) const {
        if (u.kind != 1) return;
        if (threadIdx.x < 64) {
            gu32* w = ctl + CW_RDY + u.aux; const unsigned long long t0 = __builtin_amdgcn_s_memrealtime();
            while ((unsigned)__builtin_amdgcn_readfirstlane(__hip_atomic_load(w, RLX_AGENT)) < 64u) {
                if (__builtin_amdgcn_s_memrealtime() - t0 > 2000000ull) { if (threadIdx.x == 0) __hip_atomic_store(ctl + CW_TMO, 1u, RLX_AGENT); break; }
                __builtin_amdgcn_s_sleep(2); }
#ifdef MOE_DELAY
            { const unsigned long long t1 = __builtin_amdgcn_s_memrealtime(); while (__builtin_amdgcn_s_memrealtime() - t1 < 2000ull) __builtin_amdgcn_s_sleep(8); }
#endif
            __builtin_amdgcn_fence(__ATOMIC_ACQUIRE, "agent");
            asm volatile("s_waitcnt vmcnt(0)" ::: "memory");
        }
        asm volatile("" ::: "memory"); __builtin_amdgcn_s_barrier(); asm volatile("" ::: "memory");
    }
    __device__ __forceinline__ void done(const pg8::Unit& u) const {
        if (u.kind != 0) return;
#ifndef DIAG_NODRAIN
        asm volatile("s_waitcnt vmcnt(0)" ::: "memory");
#endif
#if defined(MOE_REL)
        __builtin_amdgcn_fence(__ATOMIC_RELEASE, "agent"); asm volatile("s_waitcnt vmcnt(0)" ::: "memory");
#endif
        if ((threadIdx.x & 63) == 0) __hip_atomic_fetch_add(ctl + CW_RDY + u.aux, 1u, RLX_AGENT);
    }
};
struct EpiMoe { bf16* H1; bf16* YB; const float* bg; const float* bu; const float* bd;
    __device__ __forceinline__ void operator()(const pg8::f32x4 (&acc)[2][2][4][2], const pg8::Unit& u, int wr, int wc, int fr, int fq) const {
        asm volatile("" : "+v"(fr), "+v"(fq));
        if (u.kind == 0) {
            const int f0 = u.pn * 128 + wc * 32 + 8 * fq;
            const __amdgpu_buffer_rsrc_t h1rs = __builtin_amdgcn_make_buffer_rsrc(H1, 0, (int)((size_t)T * TOPK * FF * 2), 0x00020000);
#pragma unroll
            for (int ai = 0; ai < 2; ++ai) {
                int fb = f0; asm volatile("" : "+v"(fb));
                const pg8::f32x4 g0 = *(const pg8::f32x4*)(bg + u.e * FF + fb), g1 = *(const pg8::f32x4*)(bg + u.e * FF + fb + 4);
                const pg8::f32x4 u0 = *(const pg8::f32x4*)(bu + u.e * FF + fb), u1 = *(const pg8::f32x4*)(bu + u.e * FF + fb + 4);
#pragma unroll
                for (int m = 0; m < 4; ++m) { const int r = ai * 128 + wr * 64 + m * 16 + fr;
                    const pg8::f32x4 a0 = acc[ai][0][m][0] + g0, a1 = acc[ai][0][m][1] + g1, b0 = acc[ai][1][m][0] + u0, b1 = acc[ai][1][m][1] + u1;
                    float gg[8] = {a0[0], a0[1], a0[2], a0[3], a1[0], a1[1], a1[2], a1[3]}, uu[8] = {b0[0], b0[1], b0[2], b0[3], b1[0], b1[1], b1[2], b1[3]}, o[8];
#pragma unroll
                    for (int i = 0; i < 8; ++i) { const float g = fminf(gg[i], 7.f), up = fminf(fmaxf(uu[i], -7.f), 7.f); o[i] = g * sigmoidf_(1.702f * g) * (up + 1.f); }
#ifdef MOE_PLAIN
                    if (r < u.nrow) { v4u w; w.x = pk2(o[0], o[1]); w.y = pk2(o[2], o[3]); w.z = pk2(o[4], o[5]); w.w = pk2(o[6], o[7]); *(GAS v4u*)(H1 + (size_t)(u.arow + r) * FF + fb) = w; } } }
#else
                    if (r < u.nrow) { v4u w; w.x = pk2(o[0], o[1]); w.y = pk2(o[2], o[3]); w.z = pk2(o[4], o[5]); w.w = pk2(o[6], o[7]);
                        __builtin_amdgcn_raw_buffer_store_b128(w, h1rs, (unsigned)((u.arow + r) * (FF * 2) + fb * 2), 0, 16); } } }
#endif
        } else {
            const int c0 = u.pn * 256 + wc * 32 + 8 * fq;
#pragma unroll
            for (int bj = 0; bj < 2; ++bj) { const pg8::f32x4 d0 = *(const pg8::f32x4*)(bd + u.e * D + c0 + bj * 128), d1 = *(const pg8::f32x4*)(bd + u.e * D + c0 + bj * 128 + 4);
#pragma unroll
                for (int ai = 0; ai < 2; ++ai)
#pragma unroll
                    for (int m = 0; m < 4; ++m) { const int r = ai * 128 + wr * 64 + m * 16 + fr;
                        const pg8::f32x4 a0 = acc[ai][bj][m][0] + d0, a1 = acc[ai][bj][m][1] + d1;
                        v4u w; w.x = pk2(a0[0], a0[1]); w.y = pk2(a0[2], a0[3]); w.z = pk2(a1[0], a1[1]); w.w = pk2(a1[2], a1[3]);
                        if (r < u.nrow) *(GAS v4u*)(YB + (size_t)(u.arow + r) * D + c0 + bj * 128) = w; } }
        }
    }
};
__device__ __forceinline__ void phase_final(Frame& F, bool dry = false) {
    moe_tables(F);
    const LAS int* off = (const LAS int*)(F.lds + SCR_OFF) + 32;
    LAS float* gtf = (LAS float*)(F.lds);
    const float* adaf = WSP(float, WS_ADAF);
    for (int i = F.tid; i < 2 * D; i += NWAVES * 64) { const int b = i >> 10, k = i & (D - 1); gtf[i] = adaf[b * 6 * D + 5 * D + k] * WSP(float, WS_PAR)[PAR_FPOST + k]; }
    __syncthreads();
    const int gw = F.vcu * NWAVES + F.wave, NGW = F.G * NWAVES, L = F.lane;
    const int* tok_e = WSP(int, WS_ROUTE); const float* tok_w = (const float*)(tok_e + T * 4); const int* tok_pos = tok_e + 2 * T * 4;
    const bf16* YB = WSP(bf16, WS_YB);
    for (int t = gw * 2; t < T; t += NGW * 2) { const int b = t >> 13;
        int row_l = 0; float w_l = 0.f;
        if (L < 8) { const int idx = (t + (L >> 2)) * 4 + (L & 3); row_l = off[tok_e[idx]] + tok_pos[idx]; w_l = tok_w[idx]; }
        unsigned yv[2][4][4]; f32x4 x1v[2][4]; float wk[2][4];
#pragma unroll
        for (int q = 0; q < 2; ++q) {
#pragma unroll
            for (int k = 0; k < 4; ++k) { const int row = __shfl(row_l, q * 4 + k); wk[q][k] = __shfl(w_l, q * 4 + k);
                const GAS unsigned* yr = (const GAS unsigned*)((const unsigned char*)YB + (size_t)row * D) + L;
#pragma unroll
                for (int j = 0; j < 4; ++j) yv[q][k][j] = __builtin_nontemporal_load(yr + 64 * j);
#ifdef DRY14_NOYB
                if (dry) { _Pragma("unroll") for (int j = 0; j < 4; ++j) yv[q][k][j] = 0x38383838u; }
#endif
            }
            const GAS v2u* xr = (const GAS v2u*)(WSP(bf16, WS_X1B) + (size_t)(t + q) * D) + L;
#pragma unroll
            for (int j = 0; j < 4; ++j) { const v2u xw = __builtin_nontemporal_load(xr + 64 * j); x1v[q][j] = (f32x4){bflo(xw.x), bfhi(xw.x), bflo(xw.y), bfhi(xw.y)}; } }
#pragma unroll
        for (int q = 0; q < 2; ++q) {
            f32x4 y[4];
#pragma unroll
            for (int j = 0; j < 4; ++j) y[j] = (f32x4){0.f, 0.f, 0.f, 0.f};
#pragma unroll
            for (int k = 0; k < 4; ++k)
#pragma unroll
                for (int j = 0; j < 4; ++j) { const unsigned x = yv[q][k][j]; const float w = wk[q][k] * (1.f / YB_SCALE);
                    y[j].x += w * __builtin_amdgcn_cvt_f32_fp8((int)x, 0); y[j].y += w * __builtin_amdgcn_cvt_f32_fp8((int)x, 1); y[j].z += w * __builtin_amdgcn_cvt_f32_fp8((int)x, 2); y[j].w += w * __builtin_amdgcn_cvt_f32_fp8((int)x, 3); }
            float s = 0.f;
#pragma unroll
            for (int j = 0; j < 4; ++j) s += (y[j].x * y[j].x + y[j].y * y[j].y) + (y[j].z * y[j].z + y[j].w * y[j].w);
            const float r = 1.f / sqrtf(wave_sum(s) * (1.f / D) + NORM_EPS);
            GAS f32x4* wrow = dry ? (GAS f32x4*)(WSP(float, WS_WGU_T) + (size_t)(t + q) * D) + L : (GAS f32x4*)(F.out + (size_t)(t + q) * D) + L;
#pragma unroll
            for (int j = 0; j < 4; ++j) { const f32x4 g = *(const LAS f32x4*)(gtf + b * D + 4 * L + 256 * j); __builtin_nontemporal_store(x1v[q][j] + g * (y[j] * r), wrow + 64 * j); }
        }
    }
}
__device__ __forceinline__ bool opaque_ws(Frame& F) { asm volatile("" : "+s"(F.ws)); return true; }
#ifndef MK_N_LAUNCHES
#define MK_N_LAUNCHES 1
#endif
constexpr int N_PHASES = 15;
struct Args { const float* in[30]; float* out; unsigned char* ws; int ph_lo, ph_hi; };
__global__ void __launch_bounds__(NWAVES * 64, 2) mega_fwd(Args args) {
    extern __shared__ __attribute__((aligned(16))) unsigned char lds[];
    Frame F;
    F.lds = (LAS unsigned char*)lds;
    F.MISC = (volatile LAS unsigned*)(F.lds + MISC_OFF);
    F.tid = threadIdx.x; F.lane = F.tid & 63; F.wave = __builtin_amdgcn_readfirstlane(F.tid >> 6);
    F.G = gridDim.x; { const int bx = blockIdx.x; F.vcu = (F.G % 8 == 0) ? (bx % 8) * (F.G / 8) + bx / 8 : bx; }
    F.ws = args.ws; F.ctl = (gu32*)(args.ws + WS_CTL); F.out = args.out;
#pragma unroll
    for (int i = 0; i < 30; ++i) F.in[i] = args.in[i];
    for (int u = F.tid; u < (LDS_BYTES - LDSCTL_OFF) / 4; u += NWAVES * 64) ((LAS unsigned*)(F.lds + LDSCTL_OFF))[u] = 0u;
    __syncthreads();
    XcdBarrier bar; bar.bar = (unsigned*)(F.ctl + CW_BAR); bar.x = 0; bar.st = nullptr;
    if (MK_N_LAUNCHES == 1) bar = xcd_barrier_post((unsigned*)(F.ctl + CW_BAR), F.MISC + 8);
    const int lo = args.ph_lo, hi = args.ph_hi;
#ifndef PHMASK
#define PHMASK 0x7fff
#endif
#define IN(k) (((PHMASK >> (k)) & 1) && lo <= (k) && (k) < hi)
#ifdef DBG_A
#define STAMP(k) do { if (blockIdx.x == 0 && F.tid == 0) ((unsigned long long*)(F.ctl + 2048))[k] = __builtin_amdgcn_s_memrealtime(); } while (0)
#else
#define STAMP(k) do {} while (0)
#endif
#ifndef REP_PHASE
#define REP_PHASE -1
#endif
#define REPL(k) for (int rep_ = 0; rep_ < (REP_PHASE == (k) ? 2 : 1); ++rep_) if (opaque_ws(F))
#ifdef DBL_BAR
#define SEAM(k) do { if (IN(k)) { xcd_barrier(bar); xcd_barrier(bar); } STAMP((k) + 1); } while (0)
#else
#define SEAM(k) do { if (IN(k)) xcd_barrier(bar); STAMP((k) + 1); } while (0)
#endif
    PG8_LAS unsigned char* ring = F.lds + RING_OFF;
    const int bx = (int)blockIdx.x;

    STAMP(0);
    if (IN(0)) REPL(0) { phase0(F); } SEAM(0);
    if (IN(1)) REPL(1) { phase1(F); } SEAM(1);
    if (IN(2)) REPL(2) {
#ifdef G1_F8
        pg8::Gemm g{WSP(bf16, WS_XN), WSP(bf16, WS_WIN_T), D / 2, D / 2, D / 2}; pg8::DenseOrder S; S.init(T, INW, F.G, bx);
#else
        pg8::Gemm g{WSP(bf16, WS_XN), WSP(bf16, WS_WIN_T), D, D, D}; pg8::DenseOrder S; S.init(T, INW, F.G, bx);
#endif
        EpiG1 E{WSP(bf16, WS_UA), WSP(bf16, WS_Q), WSP(bf16, WS_K), WSP(bf16, WS_V), WSP(bf16, WS_VT), WSP(bf16, WS_GS), WSP(bf16, WS_GA),
                WSP(float, WS_ROPE), WSP(float, WS_ROPE) + (size_t)T * 32, (float*)(F.ctl + CW_KM), WSP(float, WS_PAR) + PAR_WSC1};
#ifdef G1_F8
        pg8::gemm_phase<EpiG1, pg8::DenseOrder, true>(ring, g, S, E);
#else
        pg8::gemm_phase(ring, g, S, E);
#endif
        s5_fill_kt(F);
    } SEAM(2);
    if (IN(3)) REPL(3) {
        pg8::Gemm g{WSP(bf16, WS_UA), WSP(bf16, WS_S5M1), 384, 256, 256}; S5Order S{F.G, bx}; EpiS5A E{WSP(float, WS_S5E)};
        pg8::gemm_phase(ring, g, S, E);
        s5_fill_wc(F);
        attn_gate(F);
    } SEAM(3);
    if (IN(4)) REPL(4) { attn_items(F); s5_carry(F); } SEAM(4);
    if (IN(5)) REPL(5) {
        pg8::Gemm g{WSP(bf16, WS_UA), WSP(bf16, WS_S5WC), 384, 384, 384}; S5Order S{F.G, bx}; EpiS5C E{WSP(bf16, WS_YG)};
        pg8::gemm_phase(ring, g, S, E);
        attn_combine(F);
    } SEAM(5);
    if (IN(6)) REPL(6) {
        pg8::Gemm g{WSP(bf16, WS_YG), WSP(bf16, WS_WGLU_T), SW, SW, SW}; pg8::DenseOrder S; S.init(T, SW, F.G, bx);
        EpiEw<0> E{WSP(bf16, WS_Y2), WSP(bf16, WS_YG), nullptr, nullptr, SW};
        pg8::gemm_phase(ring, g, S, E);
    } SEAM(6);
    if (IN(7)) REPL(7) {
        pg8::Gemm g{WSP(bf16, WS_Y2), WSP(bf16, WS_WSB_T), SW, SW, SW}; pg8::DenseOrder S; S.init(T, D, F.G, bx);
        EpiEw<1> E{WSP(bf16, WS_M1), WSP(bf16, WS_GS), nullptr, nullptr, D};
        pg8::gemm_phase(ring, g, S, E);
    } SEAM(7);
    if (IN(8)) REPL(8) {
        pg8::Gemm g{WSP(bf16, WS_YA), WSP(bf16, WS_WAB_T), AW, AW, AW}; pg8::DenseOrder S; S.init(T, D, F.G, bx);
        EpiEw<2> E{WSP(bf16, WS_XN), WSP(bf16, WS_GA), WSP(bf16, WS_M1), nullptr, D};
        pg8::gemm_phase(ring, g, S, E);
    } SEAM(8);
    if (IN(9)) REPL(9) {
        pg8::Gemm g{WSP(bf16, WS_XN), WSP(bf16, WS_WOUT_T), D, D, D}; pg8::DenseOrder S; S.init(T, D, F.G, bx);
        EpiEw<4> E{WSP(bf16, WS_MIX), nullptr, nullptr, nullptr, D};
        pg8::gemm_phase(ring, g, S, E);
    } SEAM(9);
    if (IN(10)) REPL(10) { phase_rows(F, REP_PHASE == 10 && rep_ == 0); } SEAM(10);
#ifndef MOE_FUSED
#ifdef MOE_F8
    if (IN(12)) REPL(12) {
        moe_tables(F, 8, 2048);
        pg8::Gemm g{WSP(bf16, WS_H2), WSP(bf16, WS_WGU_T), D / 2, D / 2, D / 2}; MoeOrder<true> S{(const LAS int*)(F.lds + SCR_OFF), WSP(int, WS_ELIST), 8, 2048, F.G, bx};
        EpiGU8 E{WSP(unsigned char, WS_H1), WSP(float, WS_PAR) + PAR_BG, WSP(float, WS_PAR) + PAR_BU, WSP(float, WS_PAR) + PAR_WSC};
        pg8::gemm_phase<EpiGU8, MoeOrder<true>, true>(ring, g, S, E);
    } SEAM(12);
    if (IN(13)) REPL(13) {
        moe_tables(F, 4, 1024);
        pg8::Gemm g{WSP(bf16, WS_H1), WSP(bf16, WS_WDN_T), FF / 2, FF / 2, FF / 2}; MoeOrder<false> S{(const LAS int*)(F.lds + SCR_OFF), nullptr, 4, 1024, F.G, bx};
        EpiDn8 E{WSP(bf16, WS_YB), WSP(float, WS_PAR) + PAR_BD, WSP(float, WS_PAR) + PAR_WSC};
        pg8::gemm_phase<EpiDn8, MoeOrder<false>, true>(ring, g, S, E);
    } SEAM(13);
#else
    if (IN(12)) REPL(12) {
        moe_tables(F, 8, 2048);
        pg8::Gemm g{WSP(bf16, WS_H2), WSP(bf16, WS_WGU_T), D, D, D}; MoeOrder<true> S{(const LAS int*)(F.lds + SCR_OFF), WSP(int, WS_ELIST), 8, 2048, F.G, bx};
        EpiGU E{WSP(bf16, WS_H1), WSP(float, WS_PAR) + PAR_BG, WSP(float, WS_PAR) + PAR_BU};
        pg8::gemm_phase(ring, g, S, E);
    } SEAM(12);
    if (IN(13)) REPL(13) {
        moe_tables(F, 4, 1024);
        pg8::Gemm g{WSP(bf16, WS_H1), WSP(bf16, WS_WDN_T), FF, FF, FF}; MoeOrder<false> S{(const LAS int*)(F.lds + SCR_OFF), nullptr, 4, 1024, F.G, bx};
        EpiDn E{WSP(bf16, WS_YB), WSP(float, WS_PAR) + PAR_BD};
        pg8::gemm_phase(ring, g, S, E);
    } SEAM(13);
#endif
#else
    if (IN(12)) REPL(12) {
        moe_tables(F);
        pg8::Gemm g{(const bf16*)F.ws, WSP(bf16, WS_WGU_T), D, D, D};
        EpiMoe E{WSP(bf16, WS_H1), WSP(bf16, WS_YB), WSP(float, WS_PAR) + PAR_BG, WSP(float, WS_PAR) + PAR_BU, WSP(float, WS_PAR) + PAR_BD};
        for (int base = 0;;) { MoeFused S{(const LAS int*)(F.lds + SCR_OFF), WSP(int, WS_ELIST), F.ctl, F.G, bx, base};
            const int nd = pg8::gemm_phase(ring, g, S, E); if (nd == 0) break; base += nd; }
    } SEAM(12);
#endif
    if (IN(14)) REPL(14) { phase_final(F, REP_PHASE == 14 && rep_ == 0); }
#undef IN
#undef SEAM
}

extern "C" void kernel_launch(void* const* d_in, const int* in_sizes, int n_in, void* d_out, int out_size, void* d_ws, size_t ws_size, hipStream_t stream) {
    static int grid = 0;
    if (grid == 0) {
        if (n_in != 30 || in_sizes[0] != T * D || out_size != T * D || ws_size < WS_END) { fprintf(stderr, "kernel_launch: unexpected shapes (n_in %d, in0 %d, out %d, ws %zu)\n", n_in, n_in > 0 ? in_sizes[0] : -1, out_size, ws_size); grid = -1; return; }
        int dev = 0, cus = 0, per_cu = 0;
        if (hipGetDevice(&dev) != hipSuccess || hipDeviceGetAttribute(&cus, hipDeviceAttributeMultiprocessorCount, dev) != hipSuccess) { grid = -1; return; }
        if (hipFuncSetAttribute((const void*)mega_fwd, hipFuncAttributeMaxDynamicSharedMemorySize, LDS_BYTES) != hipSuccess) { fprintf(stderr, "kernel_launch: hipFuncSetAttribute failed\n"); grid = -1; return; }
        if (hipOccupancyMaxActiveBlocksPerMultiprocessor(&per_cu, (const void*)mega_fwd, NWAVES * 64, LDS_BYTES) != hipSuccess || per_cu < 1) { fprintf(stderr, "kernel_launch: occupancy query says %d\n", per_cu); }
        (void)hipGetLastError();
        grid = cus;
    }
    if (grid < 0) return;
    (void)hipMemsetAsync((char*)d_ws + WS_CTL, 0, CTL_ZERO_USED, stream);
    Args a{};
    for (int i = 0; i < 30; ++i) a.in[i] = (const float*)d_in[i];
    a.out = (float*)d_out; a.ws = (unsigned char*)d_ws;
#ifndef PLAIN_LAUNCH
    if (MK_N_LAUNCHES == 1) { a.ph_lo = 0; a.ph_hi = N_PHASES; void* kargs[] = {(void*)&a};
        const hipError_t e = hipLaunchCooperativeKernel((const void*)mega_fwd, dim3(grid), dim3(NWAVES * 64), kargs, LDS_BYTES, stream);
        if (e != hipSuccess) fprintf(stderr, "kernel_launch: cooperative launch failed: %s\n", hipGetErrorString(e)); }
#else
    if (MK_N_LAUNCHES == 1) { a.ph_lo = 0; a.ph_hi = N_PHASES; hipLaunchKernelGGL(mega_fwd, dim3(grid), dim3(NWAVES * 64), LDS_BYTES, stream, a); }
#endif
    else for (int p = 0; p < N_PHASES; ++p) { a.ph_lo = p; a.ph_hi = p + 1; hipLaunchKernelGGL(mega_fwd, dim3(grid), dim3(NWAVES * 64), LDS_BYTES, stream, a); }
}
```

```cpp
#include <hip/hip_runtime.h>
#include <cstdio>
#include <cstdint>
#define MK_N_LAUNCHES 1
namespace pg8 {
#define PG8_LAS __attribute__((address_space(3)))
typedef unsigned short bf16_t;
typedef short bf16x8 __attribute__((ext_vector_type(8)));
typedef float f32x4 __attribute__((ext_vector_type(4)));
typedef unsigned u32x4 __attribute__((ext_vector_type(4)));
typedef unsigned u32x2 __attribute__((ext_vector_type(2)));
typedef int v4i32 __attribute__((ext_vector_type(4)));
typedef int v8i32 __attribute__((ext_vector_type(8)));
constexpr int BIAS_LDS_OFF = 156 * 1024;
constexpr int BM = 256, BK = 64, HALF = 128, HTB = HALF * BK * 2  , STAGE_BYTES = 8 * HTB, NXCD = 8, WGM = 8;

__host__ __device__ __forceinline__ int lds_byte(int r, int c) { const int st = (r >> 4) * 2 + (c >> 5), rr = r & 15, cc = c & 31, ob = rr * 64 + cc * 2; return st * 1024 + (ob ^ (((ob >> 9) & 1) << 5)); }
__host__ __device__ __forceinline__ void stage_rc(int b, int& R, int& C) { const int st = b / 1024, sb = b % 1024, swz = sb ^ (((sb >> 9) & 1) << 5); R = (st >> 1) * 16 + swz / 64; C = (st & 1) * 32 + (swz % 64) / 2; }

struct Unit { int arow, brow, pm, pn, e, nrow, kind, aux; };
struct Gemm { const bf16_t* A; const bf16_t* Bt; int lda, ldb, K; };

struct DenseOrder {
    static constexpr bool GATHER = false;
    __device__ __forceinline__ void a_ready(const Unit&) const {}
    __device__ __forceinline__ void done(const Unit&) const {}
    int nM, nN, nwg, G, c;
    __device__ __forceinline__ void init(int M, int N, int G_, int c_) { nM = M / BM; nN = N / BM; nwg = nM * nN; G = G_; c = c_; }
    __device__ __forceinline__ bool next(int i, Unit& u) const {
        const long L = (long)i * G + c; if (L >= nwg) return false;
        int wgid = (int)L; { const int q = nwg / NXCD, r = nwg % NXCD, xcd = wgid % NXCD, off = wgid / NXCD; wgid = (xcd < r ? xcd * (q + 1) : r * (q + 1) + (xcd - r) * q) + off; }
        const int nig = WGM * nN, gid = wgid / nig, fm = gid * WGM, gsz = (nM - fm) < WGM ? (nM - fm) : WGM;
        u.pm = fm + ((wgid % nig) % gsz); u.pn = (wgid % nig) / gsz; u.arow = u.pm * BM; u.brow = u.pn * BM; u.e = 0; u.nrow = BM; u.kind = 0; u.aux = 0; return true;
    }
};

struct ColSubsetOrder {
    static constexpr bool GATHER = false;
    DenseOrder d; int base, split, skip;
    __device__ __forceinline__ void a_ready(const Unit&) const {}
    __device__ __forceinline__ void done(const Unit&) const {}
    __device__ __forceinline__ bool next(int i, Unit& u) const { if (!d.next(i, u)) return false; const int pa = base + (u.pn < split ? u.pn : u.pn + skip); u.pn = pa; u.brow = pa * BM; return true; }
};

template <class T_> struct has_bias_lds { template <class U_> static constexpr bool get(decltype(U_::BIAS_LDS)*) { return U_::BIAS_LDS; } template <class U_> static constexpr bool get(...) { return false; } static constexpr bool value = get<T_>(nullptr); };
template <class Epi, class Sched, bool F8 = false>
__device__ __forceinline__ int gemm_phase(PG8_LAS unsigned char* lds, const Gemm g, const Sched& S, const Epi& E) {
    const int tid = threadIdx.x, wid = __builtin_amdgcn_readfirstlane(tid >> 6), lane = tid & 63, wr = wid >> 2, wc = wid & 3, fr = lane & 15, fq = lane >> 4;
    const int K = g.K, nt = K / BK;
    PG8_LAS unsigned char* biaslds = lds + BIAS_LDS_OFF;
    constexpr bool GA = Sched::GATHER;
    unsigned voffA[2], voffB[2]; int gR[2]; unsigned gC[2];
#pragma unroll
    for (int i = 0; i < 2; ++i) { int R, C; stage_rc(tid * 16 + i * 8192, R, C); gR[i] = R; gC[i] = (unsigned)C * 2u;
        voffA[i] = (unsigned)(R * g.lda + C) * 2u; voffB[i] = (unsigned)(R * g.ldb + C) * 2u; }
    unsigned gA_cur[2][2], gA_nxt[2][2];
#define PG8_GATH(dst, un) do { _Pragma("unroll") for (int _h = 0; _h < 2; ++_h) _Pragma("unroll") for (int _i = 0; _i < 2; ++_i) dst[_h][_i] = (unsigned)S.arow_of(un, _h * HALF + gR[_i]) * (unsigned)(g.lda * 2) + gC[_i]; } while (0)
#define PG8_STAGE_A(bufoff, h, kbytes, nx) do { if constexpr (GA) { const char* gb_ = (const char*)g.A + (kbytes); _Pragma("unroll") for (int _i = 0; _i < 2; ++_i) { const unsigned vo_ = (nx) ? gA_nxt[h][_i] : gA_cur[h][_i]; \
        __builtin_amdgcn_global_load_lds((const unsigned*)(gb_ + vo_), (PG8_LAS unsigned*)(lds + (bufoff) + ldsw + _i * 8192), 16, 0, 0); } } \
    else { const char* gb_ = ((nx) ? nA : cA) + (kbytes) + (h) * hstepA; PG8_STAGE(bufoff, gb_, voffA); } } while (0)
    const size_t kstep = (size_t)(BK * 2);
    const size_t hstepA = (size_t)HALF * g.lda * 2, hstepB = (size_t)HALF * g.ldb * 2;
    const size_t rowA = (size_t)g.lda * 2, rowB = (size_t)g.ldb * 2;
    const unsigned ldsw = (unsigned)wid * 1024u;
    const int aoff = lds_byte(wr * 64 + fr, fq * 8), boff = lds_byte(wc * 32 + fr, fq * 8);
#define PG8_SA(b, h) (((b) * 2 + (h)) * HTB)
#define PG8_SB(b, h) ((4 + (b) * 2 + (h)) * HTB)
#define PG8_STAGE(bufoff, gbase, voff) do { _Pragma("unroll") for (int _i = 0; _i < 2; ++_i) \
        __builtin_amdgcn_global_load_lds((const unsigned*)((const char*)(gbase) + (voff)[_i]), (PG8_LAS unsigned*)(lds + (bufoff) + ldsw + _i * 8192), 16, 0, 0); } while (0)
#define PG8_LDA(dst, b, h) do { _Pragma("unroll") for (int m = 0; m < 4; ++m) { if constexpr (F8) { const v4i32 lo_ = *(const PG8_LAS v4i32*)(lds + PG8_SA(b, h) + aoff + m * 2048), hi_ = *(const PG8_LAS v4i32*)(lds + PG8_SA(b, h) + aoff + m * 2048 + 1024); dst##8[m] = __builtin_shufflevector(lo_, hi_, 0, 1, 2, 3, 4, 5, 6, 7); } \
        else { _Pragma("unroll") for (int k = 0; k < 2; ++k) dst[m][k] = *(const PG8_LAS bf16x8*)(lds + PG8_SA(b, h) + aoff + m * 2048 + k * 1024); } } } while (0)
#define PG8_LDB(dst, b, h) do { _Pragma("unroll") for (int n = 0; n < 2; ++n) { if constexpr (F8) { const v4i32 lo_ = *(const PG8_LAS v4i32*)(lds + PG8_SB(b, h) + boff + n * 2048), hi_ = *(const PG8_LAS v4i32*)(lds + PG8_SB(b, h) + boff + n * 2048 + 1024); dst##8[n] = __builtin_shufflevector(lo_, hi_, 0, 1, 2, 3, 4, 5, 6, 7); } \
        else { _Pragma("unroll") for (int k = 0; k < 2; ++k) dst[n][k] = *(const PG8_LAS bf16x8*)(lds + PG8_SB(b, h) + boff + n * 2048 + k * 1024); } } } while (0)
#define PG8_MMA(ai, bj, At, Bt) do { __builtin_amdgcn_s_setprio(1); _Pragma("unroll") for (int m = 0; m < 4; ++m) _Pragma("unroll") for (int n = 0; n < 2; ++n) { \
        if constexpr (F8) { asm("v_mfma_scale_f32_16x16x128_f8f6f4 %0, %1, %2, %0, %3, %3 op_sel_hi:[0,0,0]" : "+v"(acc[ai][bj][m][n]) : "v"(Bt##8[n]), "v"(At##8[m]), "v"(one_scale)); } \
        else { _Pragma("unroll") for (int k = 0; k < 2; ++k) acc[ai][bj][m][n] = __builtin_amdgcn_mfma_f32_16x16x32_bf16(Bt[n][k], At[m][k], acc[ai][bj][m][n], 0, 0, 0); } } \
        __builtin_amdgcn_s_setprio(0); } while (0)
#define PG8_WAIT_V(n) asm volatile("s_waitcnt vmcnt(" #n ")" ::: "memory")
#define PG8_WAIT_L(n) asm volatile("s_waitcnt lgkmcnt(" #n ")" ::: "memory")
#define PG8_BAR __builtin_amdgcn_s_barrier()
#define PG8_SCHED __builtin_amdgcn_sched_barrier(0)
    Unit cur, nxt; int ui = 0;
    if (!S.next(0, cur)) return 0;
    f32x4 acc[2][2][4][2];
#pragma unroll
    for (int a = 0; a < 2; ++a)
#pragma unroll
        for (int b = 0; b < 2; ++b)
#pragma unroll
            for (int m = 0; m < 4; ++m)
#pragma unroll
                for (int n = 0; n < 2; ++n) acc[a][b][m][n] = (f32x4){0.f, 0.f, 0.f, 0.f};
    const int one_scale = 0x7f7f7f7f;
    bf16x8 At[4][2], B0[2][2], B1[2][2];
    v8i32 At8[4], B08[2], B18[2];
    const char* cA = GA ? (const char*)g.A : (const char*)g.A + (size_t)cur.arow * rowA; const char* cB = (const char*)g.Bt + (size_t)cur.brow * rowB; const char* nA = cA;
    if constexpr (GA) { PG8_GATH(gA_cur, cur); }
    S.a_ready(cur);
    PG8_STAGE(PG8_SB(0, 0), cB, voffB); PG8_STAGE(PG8_SB(0, 1), cB + hstepB, voffB); PG8_STAGE_A(PG8_SA(0, 0), 0, 0, false); PG8_STAGE_A(PG8_SA(0, 1), 1, 0, false);
    if (wr == 1) PG8_BAR;
    PG8_WAIT_V(2); PG8_BAR;
    PG8_STAGE(PG8_SB(1, 0), cB + kstep, voffB); PG8_STAGE_A(PG8_SA(1, 0), 0, kstep, false); PG8_STAGE(PG8_SB(1, 1), cB + hstepB + kstep, voffB);
    PG8_WAIT_V(6); PG8_BAR;
    for (;;) {
        const bool has_next = S.next(ui + 1, nxt);
        if constexpr (has_bias_lds<Epi>::value) E.stage_bias(biaslds + (ui & 1) * 1024, cur, wid, lane);
        nA = GA ? cA : (has_next ? (const char*)g.A + (size_t)nxt.arow * rowA : cA); const char* nB = has_next ? (const char*)g.Bt + (size_t)nxt.brow * rowB : cB;
        if constexpr (GA) { if (has_next) { PG8_GATH(gA_nxt, nxt); } else { _Pragma("unroll") for (int _h = 0; _h < 2; ++_h) _Pragma("unroll") for (int _i = 0; _i < 2; ++_i) gA_nxt[_h][_i] = gA_cur[_h][_i]; } }
#pragma unroll 1
        for (int t = 0; t < nt; t += 2) {
            const bool last = (t == nt - 2);
            if (last && has_next) S.a_ready(nxt);
            const size_t k1 = (size_t)(t + 1) * kstep, k2 = last ? (size_t)0 : (size_t)(t + 2) * kstep, k3 = k2 + kstep;
            const char* b2 = last ? nB : cB + (size_t)(t + 2) * kstep; const char* b3 = b2 + kstep;
            PG8_LDB(B0, 0, 0); PG8_LDB(B1, 0, 1); PG8_SCHED; PG8_LDA(At, 0, 0); PG8_STAGE_A(PG8_SA(1, 1), 1, k1, false);
            PG8_WAIT_V(8); PG8_WAIT_L(0); PG8_BAR; PG8_MMA(0, 0, At, B0); PG8_MMA(0, 1, At, B1); PG8_BAR; PG8_SCHED;
            PG8_LDA(At, 0, 1); PG8_STAGE(PG8_SB(0, 0), b2, voffB); PG8_STAGE(PG8_SB(0, 1), b2 + hstepB, voffB); PG8_STAGE_A(PG8_SA(0, 0), 0, k2, last);
            PG8_WAIT_V(8); PG8_WAIT_L(0); PG8_BAR; PG8_MMA(1, 0, At, B0); PG8_MMA(1, 1, At, B1); PG8_BAR; PG8_SCHED;
            PG8_LDB(B0, 1, 0); PG8_LDB(B1, 1, 1); PG8_SCHED; PG8_LDA(At, 1, 0); PG8_STAGE_A(PG8_SA(0, 1), 1, k2, last);
            PG8_WAIT_V(8); PG8_WAIT_L(0); PG8_BAR; PG8_MMA(0, 0, At, B0); PG8_MMA(0, 1, At, B1); PG8_BAR; PG8_SCHED;
            PG8_LDA(At, 1, 1); PG8_STAGE(PG8_SB(1, 0), b3, voffB); PG8_STAGE(PG8_SB(1, 1), b3 + hstepB, voffB); PG8_STAGE_A(PG8_SA(1, 0), 0, k3, last);
            PG8_WAIT_V(8); PG8_WAIT_L(0); PG8_BAR; PG8_MMA(1, 0, At, B0); PG8_MMA(1, 1, At, B1); PG8_BAR; PG8_SCHED;
        }
        if (wr == 0) PG8_BAR;
        if constexpr (has_bias_lds<Epi>::value) E(acc, cur, wr, wc, fr, fq, (const PG8_LAS float*)(biaslds + (ui & 1) * 1024)); else E(acc, cur, wr, wc, fr, fq);
        S.done(cur);
        if (!has_next) break;
#pragma unroll
        for (int a = 0; a < 2; ++a)
#pragma unroll
            for (int b = 0; b < 2; ++b)
#pragma unroll
                for (int m = 0; m < 4; ++m)
#pragma unroll
                    for (int n = 0; n < 2; ++n) acc[a][b][m][n] = (f32x4){0.f, 0.f, 0.f, 0.f};
        cur = nxt; cA = nA; cB = nB; ++ui;
        if constexpr (GA) { _Pragma("unroll") for (int _h = 0; _h < 2; ++_h) _Pragma("unroll") for (int _i = 0; _i < 2; ++_i) gA_cur[_h][_i] = gA_nxt[_h][_i]; }
        if (wr == 1) PG8_BAR;
    }
    PG8_WAIT_V(0);
    PG8_BAR;
    const int n_done_ = ui + 1;
#undef PG8_SA
#undef PG8_SB
#undef PG8_STAGE
#undef PG8_STAGE_A
#undef PG8_GATH
#undef PG8_LDA
#undef PG8_LDB
#undef PG8_MMA
#undef PG8_WAIT_V
#undef PG8_WAIT_L
#undef PG8_BAR
#undef PG8_SCHED
    return n_done_;
}
}
constexpr int NWAVES = 8;
constexpr int BATCH = 2, SEQ = 8192, T = BATCH * SEQ, D = 1024, NH = 8, HD = 64, AW = 512, SW = 512, NG = 32, NP = 64, GS16 = 16;
constexpr int NE = 32, FF = 1024, INW = 4096, TOPK = 4, NBLK = SEQ / 256;
constexpr float NORM_EPS = 1e-6f;
constexpr float C2 = 0.125f * 1.4426950408889634f;
constexpr int XROWS = T * TOPK + 256;

constexpr size_t MiB = 1u << 20;
constexpr size_t WS_CTL = 0, CTL_ZERO_BYTES = 1 * MiB;
constexpr size_t WS_ADA = 1 * MiB;
constexpr size_t WS_ADAF = WS_ADA + 832 * 1024;
constexpr size_t WS_ROPE = 2 * MiB;
constexpr size_t WS_S5P = 6 * MiB;
constexpr size_t WS_S5KT = 7 * MiB;
constexpr size_t WS_S5M1 = 10 * MiB;
constexpr size_t WS_S5WC = 506 * MiB;
constexpr size_t WS_S5E = 408 * MiB;
constexpr size_t WS_ROUTE = 9 * MiB;
constexpr size_t WS_ELIST = 14 * MiB; constexpr int ELCAP = T;
constexpr size_t WS_HSC = WS_ROUTE + 768 * 1024;
constexpr int PAR_WSC = 270000, PAR_WSC1 = 270001;
#ifndef MOE_BF16
#define MOE_F8 1
#endif
constexpr size_t WS_WIN_T = 18 * MiB, WS_WGLU_T = 26 * MiB, WS_WSB_T = 27 * MiB, WS_WAB_T = 28 * MiB, WS_WOUT_T = 29 * MiB;
constexpr size_t WS_PAR = 16 * MiB;
constexpr int PAR_MPG = 0, PAR_FPRE = 1024, PAR_FPOST = 2048, PAR_RB = 3072, PAR_RW = 4096, PAR_BG = 36864, PAR_BU = 69632, PAR_BD = 102400, PAR_CRE = 135168, PAR_CIM = 167936, PAR_SD = 200704, PAR_BRE = 201728, PAR_BIM = 234496;
constexpr size_t WS_WGU_T = 32 * MiB, WS_WDN_T = 160 * MiB;
constexpr size_t WS_XN = 224 * MiB;
constexpr size_t WS_UA = 256 * MiB, WS_Q = 280 * MiB, WS_K = 296 * MiB, WS_V = 312 * MiB, WS_VT = 328 * MiB;
constexpr size_t WS_MIX = 256 * MiB;
constexpr size_t WS_GS = 344 * MiB, WS_GA = 376 * MiB;
constexpr size_t WS_YG = 408 * MiB, WS_Y2 = 424 * MiB, WS_YA = 440 * MiB;
constexpr size_t WS_M1 = 456 * MiB;
constexpr size_t WS_H2 = 480 * MiB;
constexpr size_t WS_WIN8 = 96 * MiB, WS_XN8 = 100 * MiB;
constexpr size_t WS_X1B = 416 * MiB;
constexpr size_t WS_XG = 224 * MiB, WS_YB = 224 * MiB;
constexpr size_t WS_H1 = 352 * MiB;
constexpr size_t WS_END = 512 * MiB;
static_assert(WS_YB + (size_t)T * TOPK * D * 2 <= WS_H1 && WS_H1 + (size_t)T * TOPK * FF * 2 <= WS_H2 && WS_H2 + (size_t)T * D * 2 <= WS_END, "ws map");
constexpr int CW_TMO = 0, CW_CODE = 1, CW_BAR = 4096, CW_ECNT = 8192, CW_KM = 16384;
constexpr size_t CTL_ZERO_USED = (size_t)(CW_KM + BATCH * NH * NBLK * HD) * 4;
static_assert(CTL_ZERO_USED <= CTL_ZERO_BYTES, "ctl");

constexpr int RING_OFF = 0, RING_BYTES = 131072;
constexpr int LDSCTL_OFF = 152 * 1024, MISC_OFF = LDSCTL_OFF + 320;
constexpr int LDS_BYTES = 158 * 1024;

#define GAS __attribute__((address_space(1)))
#define LAS __attribute__((address_space(3)))
typedef unsigned short bf16;
typedef unsigned v4u __attribute__((ext_vector_type(4)));
typedef unsigned v2u __attribute__((ext_vector_type(2)));
typedef float f32x4 __attribute__((ext_vector_type(4)));
typedef GAS unsigned gu32;
#define RLX_AGENT __ATOMIC_RELAXED, __HIP_MEMORY_SCOPE_AGENT
#define LDS_WAIT() asm volatile("s_waitcnt lgkmcnt(0)" ::: "memory")
#define VM_WAIT() asm volatile("s_waitcnt vmcnt(0)" ::: "memory")
__device__ __forceinline__ unsigned f2bf(float f) { unsigned u = __builtin_bit_cast(unsigned, f); return (u + 0x7fffu + ((u >> 16) & 1u)) >> 16; }
__device__ __forceinline__ unsigned pk2(float lo, float hi) { typedef float f32x2_t __attribute__((ext_vector_type(2))); typedef __bf16 bf16x2_t __attribute__((ext_vector_type(2)));
    f32x2_t v = {lo, hi}; bf16x2_t r = __builtin_convertvector(v, bf16x2_t); return __builtin_bit_cast(unsigned, r); }
#ifdef WT_STORES
__device__ __forceinline__ void st16(void* p, v4u v) { asm volatile("global_store_dwordx4 %0, %1, off sc1\n\ts_nop 1" :: "v"(p), "v"(v) : "memory"); }
__device__ __forceinline__ void st8(void* p, v2u v) { asm volatile("global_store_dwordx2 %0, %1, off sc1\n\ts_nop 1" :: "v"(p), "v"(v) : "memory"); }
#else
__device__ __forceinline__ void st16(void* p, v4u v) { *(v4u*)p = v; }
__device__ __forceinline__ void st8(void* p, v2u v) { *(v2u*)p = v; }
#endif
__device__ __forceinline__ unsigned pk4_fp8(float a, float b, float c, float d) {
    a = fminf(fmaxf(a, -448.f), 448.f); b = fminf(fmaxf(b, -448.f), 448.f); c = fminf(fmaxf(c, -448.f), 448.f); d = fminf(fmaxf(d, -448.f), 448.f);
    int w = 0; w = __builtin_amdgcn_cvt_pk_fp8_f32(a, b, w, false); w = __builtin_amdgcn_cvt_pk_fp8_f32(c, d, w, true); return (unsigned)w; }
__device__ __forceinline__ float bflo(unsigned w) { return __builtin_bit_cast(float, w << 16); }
__device__ __forceinline__ float bfhi(unsigned w) { return __builtin_bit_cast(float, w & 0xffff0000u); }
__device__ __forceinline__ float bf2f(bf16 h) { return __builtin_bit_cast(float, (unsigned)h << 16); }
__device__ __forceinline__ float sigmoidf_(float x) { return 1.f / (1.f + __expf(-x)); }
__device__ __forceinline__ float gelu_tanh(float x) { const float u = 1.5957691216057308f * (x + 0.044715f * x * x * x); return x / (1.f + __expf(-u)); }

#define XB_TMO      128
#define XB_XCNT(j)  (256  + 64 * (j))
#define XB_XSUB(j)  (1280 + 64 * (j))
#define XB_XGEN(j)  (2304 + 64 * (j))
#define XB_TOP      3328
#define XB_TOPGEN   3392
#define XCD_BAR_WORDS 3456
#define XB_SPIN_CAP (1u << 18)
__device__ __forceinline__ unsigned xb_ld(unsigned* p)              { return __hip_atomic_load(p, __ATOMIC_RELAXED, __HIP_MEMORY_SCOPE_AGENT); }
__device__ __forceinline__ unsigned xb_add(unsigned* p, unsigned v) { return __hip_atomic_fetch_add(p, v, __ATOMIC_RELAXED, __HIP_MEMORY_SCOPE_AGENT); }
__device__ __forceinline__ unsigned xb_xcc_id() { return (unsigned)__builtin_amdgcn_s_getreg((3 << 11) | 20) & 0xFu; }
#define XB_SPIN(cond, bar) do { unsigned _sp = 0; while (cond) { __builtin_amdgcn_s_sleep(1); \
    if ((++_sp & 255u) == 0u) { if (xb_ld(&(bar)[XB_TMO])) break; if (_sp > XB_SPIN_CAP) { atomicAdd(&(bar)[XB_TMO], 1u); break; } } } } while (0)
struct XcdBarrier { unsigned* bar; unsigned x; volatile LAS unsigned* st; };
__device__ __forceinline__ XcdBarrier xcd_barrier_post(unsigned* bar, volatile LAS unsigned* st) {
    XcdBarrier b; b.bar = bar; b.x = xb_xcc_id(); b.st = st;
    if (threadIdx.x == 0) (void)xb_add(&bar[XB_XCNT(b.x)], 1u);
    return b;
}
__device__ __forceinline__ void xcd_barrier_complete(unsigned* bar, unsigned x, unsigned& nloc, unsigned& nx) {
    const unsigned G = gridDim.x * gridDim.y * gridDim.z;
    unsigned sum, cnt, mine, sp = 0u;
    for (;;) {
        sum = 0u; cnt = 0u; mine = 0u;
#pragma unroll
        for (unsigned j = 0; j < 16; ++j) { const unsigned c = xb_ld(&bar[XB_XCNT(j)]); sum += c; cnt += (c > 0u) ? 1u : 0u; mine = (j == x) ? c : mine; }
        if (sum == G) break;
        __builtin_amdgcn_s_sleep(1);
        if ((++sp & 255u) == 0u) { if (xb_ld(&bar[XB_TMO])) break; if (sp > XB_SPIN_CAP) { atomicAdd(&bar[XB_TMO], 1u); break; } }
    }
    nloc = mine > 0u ? mine : 1u; nx = cnt > 0u ? cnt : 1u;
}
__device__ __forceinline__ void xcd_barrier(const XcdBarrier& b) {
    asm volatile("s_waitcnt vmcnt(0)" ::: "memory");
    __syncthreads();
    if (threadIdx.x == 0) {
        unsigned* bar = b.bar;
        __builtin_amdgcn_s_waitcnt(0);
        unsigned nloc = b.st[0], nx = b.st[1];
        if (nloc == 0u) { xcd_barrier_complete(bar, b.x, nloc, nx); b.st[0] = nloc; b.st[1] = nx; }
        const unsigned old = xb_add(&bar[XB_XSUB(b.x)], 1u);
        const unsigned gen = old / nloc;
        if (old + 1u == (gen + 1u) * nloc) {
            __builtin_amdgcn_fence(__ATOMIC_RELEASE, "agent");
            asm volatile("s_waitcnt vmcnt(0)" ::: "memory");
            const unsigned og = xb_add(&bar[XB_TOP], 1u);
            const unsigned tg = og / nx;
            if (og + 1u == (tg + 1u) * nx) xb_add(&bar[XB_TOPGEN], 1u);
            else XB_SPIN(xb_ld(&bar[XB_TOPGEN]) == tg, bar);
            __builtin_amdgcn_fence(__ATOMIC_ACQUIRE, "agent");
            xb_add(&bar[XB_XGEN(b.x)], 1u);
            asm volatile("s_waitcnt vmcnt(0)" ::: "memory");
        } else {
            XB_SPIN(xb_ld(&bar[XB_XGEN(b.x)]) == gen, bar);
            __builtin_amdgcn_fence(__ATOMIC_ACQUIRE, "agent");
            asm volatile("s_waitcnt vmcnt(0)" ::: "memory");
        }
    }
    __syncthreads();
}

__device__ __forceinline__ float wave_sum(float v) {
#pragma unroll
    for (int o = 1; o < 64; o <<= 1) v += __shfl_xor(v, o);
    return v;
}
__device__ __forceinline__ float wave_max(float v) {
#pragma unroll
    for (int o = 1; o < 64; o <<= 1) v = fmaxf(v, __shfl_xor(v, o));
    return v;
}
struct Frame {
    LAS unsigned char* lds;
    volatile LAS unsigned* MISC;
    gu32* ctl;
    int tid, lane, wave;
    int vcu, G;
    unsigned char* ws;
    const float* in[30];
    float* out;
};
#define WSP(T_, off) ((T_*)(F.ws + (off)))

__device__ __forceinline__ int perm8(int c) { return (c & ~31) + 16 * ((c >> 2) & 1) + 4 * ((c >> 3) & 3) + (c & 3); }
struct MapP8 { int off; __device__ __forceinline__ int operator()(int n) const { return off + perm8(n); } };
struct MapWin { __device__ __forceinline__ int operator()(int c) const {
    if (c < 512 || c >= 1536) return perm8(c);
    const int base = (c < 1024) ? 512 : 1024, cc = c - base, head = cc >> 6, d = cc & 63, pnq = head >> 2, hh = head & 3, n = d >> 5, dd = d & 31;
    const int wc = 2 * (hh & 1) + (dd >> 4), bj = hh >> 1, j = dd & 15;
    return base + 256 * pnq + 128 * bj + 32 * wc + 16 * n + j; } };
struct MapGU { int e, up; __device__ __forceinline__ int operator()(int f) const { return e * 2048 + (f >> 7) * 256 + up * 128 + perm8(f & 127); } };

template <class RowMap>
__device__ __forceinline__ void p0_transpose_item(const float* W, int K, int N, bf16* WT, LAS float* scr, int item, int lane, const RowMap rm) {
    const int nblk = N / 64, kb = item / nblk, nb = item % nblk, k0 = 64 * kb, n0 = 64 * nb;
    const int lr = lane >> 4, lc = 4 * (lane & 15);
    f32x4 v[16];
#pragma unroll
    for (int i = 0; i < 16; ++i) v[i] = __builtin_nontemporal_load((const GAS f32x4*)(W + (size_t)(k0 + 4 * i + lr) * N + n0 + lc));
#pragma unroll
    for (int i = 0; i < 16; ++i) { LAS float* d = scr + (4 * i + lr) * 65 + lc; d[0] = v[i].x; d[1] = v[i].y; d[2] = v[i].z; d[3] = v[i].w; }
    LDS_WAIT(); asm volatile("" ::: "memory");
    const int c = lane & 7;
#pragma unroll
    for (int j = 0; j < 8; ++j) { const int n = (lane >> 3) + 8 * j; const LAS float* s = scr + (8 * c) * 65 + n;
        v4u o; o.x = pk2(s[0 * 65], s[1 * 65]); o.y = pk2(s[2 * 65], s[3 * 65]); o.z = pk2(s[4 * 65], s[5 * 65]); o.w = pk2(s[6 * 65], s[7 * 65]);
        __builtin_nontemporal_store(o, (GAS v4u*)(WT + (size_t)rm(n0 + n) * K + k0 + 8 * c)); }
    LDS_WAIT(); asm volatile("" ::: "memory");
}

template <class RowMap>
__device__ __forceinline__ void p0_transpose_item_f8(const float* W, int K, int N, unsigned char* WT, LAS float* scr, int item, int lane, const RowMap rm, float wsc) {
    const int nblk = N / 64, kb = item / nblk, nb = item % nblk, k0 = 64 * kb, n0 = 64 * nb;
    const int lr = lane >> 4, lc = 4 * (lane & 15);
    f32x4 v[16];
#pragma unroll
    for (int i = 0; i < 16; ++i) v[i] = __builtin_nontemporal_load((const GAS f32x4*)(W + (size_t)(k0 + 4 * i + lr) * N + n0 + lc));
#pragma unroll
    for (int i = 0; i < 16; ++i) { LAS float* d = scr + (4 * i + lr) * 65 + lc; d[0] = v[i].x * wsc; d[1] = v[i].y * wsc; d[2] = v[i].z * wsc; d[3] = v[i].w * wsc; }
    LDS_WAIT(); asm volatile("" ::: "memory");
    const int c = lane & 3;
#pragma unroll
    for (int j = 0; j < 4; ++j) { const int n = (lane >> 2) + 16 * j; const LAS float* s = scr + (16 * c) * 65 + n;
        v4u o; o.x = pk4_fp8(s[0 * 65], s[1 * 65], s[2 * 65], s[3 * 65]); o.y = pk4_fp8(s[4 * 65], s[5 * 65], s[6 * 65], s[7 * 65]);
        o.z = pk4_fp8(s[8 * 65], s[9 * 65], s[10 * 65], s[11 * 65]); o.w = pk4_fp8(s[12 * 65], s[13 * 65], s[14 * 65], s[15 * 65]);
        __builtin_nontemporal_store(o, (GAS v4u*)(WT + (size_t)rm(n0 + n) * K + k0 + 16 * c)); }
    LDS_WAIT(); asm volatile("" ::: "memory");
}

__device__ __forceinline__ void p0_moe_load(const float* W, int item, int lane, f32x4 (&v)[16]) {
    const int kb = item >> 4, nb = item & 15, k0 = 64 * kb, n0 = 64 * nb, lr = lane >> 4, lc = 4 * (lane & 15);
#pragma unroll
    for (int i = 0; i < 16; ++i) v[i] = __builtin_nontemporal_load((const GAS f32x4*)(W + (size_t)(k0 + 4 * i + lr) * 1024 + n0 + lc));
}
__device__ __forceinline__ void p0_moe_finish(unsigned char* WT, int rowbase, int kind, int item, LAS float* scr, int lane, const f32x4 (&v)[16], float wsc) {
    const int kb = item >> 4, nb = item & 15, k0 = 64 * kb, n0 = 64 * nb, lr = lane >> 4, lc = 4 * (lane & 15);
#pragma unroll
    for (int i = 0; i < 16; ++i) { LAS float* d = scr + (4 * i + lr) * 65 + lc; d[0] = v[i].x * wsc; d[1] = v[i].y * wsc; d[2] = v[i].z * wsc; d[3] = v[i].w * wsc; }
    LDS_WAIT(); asm volatile("" ::: "memory");
    const int c = lane & 3;
#pragma unroll
    for (int j = 0; j < 4; ++j) { const int n = n0 + (lane >> 2) + 16 * j; const LAS float* s = scr + (16 * c) * 65 + (n - n0);
        const int row = rowbase + (kind < 2 ? (n >> 7) * 256 + kind * 128 + perm8(n & 127) : perm8(n));
        v4u o; o.x = pk4_fp8(s[0 * 65], s[1 * 65], s[2 * 65], s[3 * 65]); o.y = pk4_fp8(s[4 * 65], s[5 * 65], s[6 * 65], s[7 * 65]);
        o.z = pk4_fp8(s[8 * 65], s[9 * 65], s[10 * 65], s[11 * 65]); o.w = pk4_fp8(s[12 * 65], s[13 * 65], s[14 * 65], s[15 * 65]);
        __builtin_nontemporal_store(o, (GAS v4u*)(WT + (size_t)row * 1024 + k0 + 16 * c)); }
    LDS_WAIT(); asm volatile("" ::: "memory");
}

constexpr int MOE_ITEMS_ALL = 3 * NE * 256, MOE_ITEMS_P3 = 2048, MOE_ITEMS_P5 = 2048, MOE_ITEMS_P6 = 6144, MOE_ITEMS_P0 = MOE_ITEMS_ALL - MOE_ITEMS_P3 - MOE_ITEMS_P5 - MOE_ITEMS_P6;
__device__ __forceinline__ void p0_moe_range(Frame& F, int first, int count, int gw, int ngw, float wsc) {
    LAS float* scr = (LAS float*)(F.lds + RING_OFF + F.wave * 16640);
    const float* wg = F.in[24]; const float* wu = F.in[26]; const float* wd = F.in[28];
    unsigned char* tgu = WSP(unsigned char, WS_WGU_T); unsigned char* tdn = WSP(unsigned char, WS_WDN_T);
#define P0_DEC(r_, W_, WT_, rb_, kd_, it_) const int mat_##r_ = (first + (r_)) >> 8, it_ = (first + (r_)) & 255, kd_ = mat_##r_ >> 5, e_##r_ = mat_##r_ & 31; \
    const float* W_ = (kd_ == 0 ? wg : (kd_ == 1 ? wu : wd)) + (size_t)e_##r_ * D * FF; unsigned char* WT_ = kd_ < 2 ? tgu : tdn; const int rb_ = kd_ < 2 ? e_##r_ * 2048 : e_##r_ * 1024;
    f32x4 va[16], vb[16]; int r = gw;
    if (r < count) { P0_DEC(r, W0, T0, b0, k0_, i0); (void)T0; (void)b0; (void)k0_; p0_moe_load(W0, i0, F.lane, va); }
    while (r < count) {
        { const int rn = r + ngw; if (rn < count) { P0_DEC(rn, W1, T1, b1, k1_, i1); (void)T1; (void)b1; (void)k1_; p0_moe_load(W1, i1, F.lane, vb); } }
        { P0_DEC(r, W2, T2, b2, k2_, i2); (void)W2; p0_moe_finish(T2, b2, k2_, i2, scr, F.lane, va, wsc); }
        r += ngw; if (r >= count) break;
        { const int rn = r + ngw; if (rn < count) { P0_DEC(rn, W3, T3, b3, k3_, i3); (void)T3; (void)b3; (void)k3_; p0_moe_load(W3, i3, F.lane, va); } }
        { P0_DEC(r, W4, T4, b4, k4_, i4); (void)W4; p0_moe_finish(T4, b4, k4_, i4, scr, F.lane, vb, wsc); }
        r += ngw;
    }
#undef P0_DEC
}
__device__ __forceinline__ void moe_convert_idle(Frame& F, int first, int count) {
    if (F.G != 256) { if (blockIdx.x == 0) { } }
    const int nb = F.G == 256 ? 128 : F.G, bi = F.G == 256 ? (int)blockIdx.x - 128 : (int)blockIdx.x;
    if (bi < 0) return;
    p0_moe_range(F, first, count, bi * NWAVES + F.wave, nb * NWAVES, WSP(float, WS_PAR)[PAR_WSC]);
}

__device__ __forceinline__ void phase0(Frame& F) {
    LAS float* scr = (LAS float*)(F.lds + RING_OFF + F.wave * 16640);
    const int gw = F.vcu * NWAVES + F.wave, NGW = F.G * NWAVES;
#ifdef MOE_F8
    float wsc;
    { float am = 0.f;
      for (int j = F.tid; j < 2048; j += NWAVES * 64) { const size_t o = (size_t)j * 16384 + 37 * (j & 63);
          am = fmaxf(am, fmaxf(fabsf(F.in[24][o]), fmaxf(fabsf(F.in[26][o]), fabsf(F.in[28][o])))); }
      am = wave_max(am); LAS float* red = (LAS float*)(F.lds + LDSCTL_OFF + 64);
      if (F.lane == 0) red[F.wave] = am;
      __syncthreads();
      am = red[0];
#pragma unroll
      for (int w = 1; w < NWAVES; ++w) am = fmaxf(am, red[w]);
      wsc = exp2f(floorf(log2f(448.f / (fmaxf(am, 1e-30f) * 8.f))));
      if (blockIdx.x == 0 && F.tid == 0) WSP(float, WS_PAR)[PAR_WSC] = wsc;
      __syncthreads(); }
#endif
#if defined(G1_F8) || defined(G1_MIX)
    float wsc1;
    { float am = 0.f;
      for (int j = F.tid; j < 2048; j += NWAVES * 64) am = fmaxf(am, fabsf(F.in[9][(size_t)j * 2048 + 37 * (j & 31)]));
      am = wave_max(am); LAS float* red = (LAS float*)(F.lds + LDSCTL_OFF + 64);
      if (F.lane == 0) red[F.wave] = am;
      __syncthreads();
      am = red[0];
#pragma unroll
      for (int w = 1; w < NWAVES; ++w) am = fmaxf(am, red[w]);
      wsc1 = exp2f(floorf(log2f(448.f / (fmaxf(am, 1e-30f) * 8.f))));
      if (blockIdx.x == 0 && F.tid == 0) WSP(float, WS_PAR)[PAR_WSC1] = wsc1;
      __syncthreads(); }
#endif
    constexpr int I_WIN = 16 * 64, I_GLU = 8 * 8, I_SB = 8 * 16, I_AB = 8 * 16, I_OUT = 16 * 16, I_E = 16 * 16;
    constexpr int I_SMALL = I_WIN + I_GLU + I_SB + I_AB + I_OUT, I_MOE = 3 * NE * I_E, I_ADA = 16 * 96;
    constexpr int NITEMS = I_SMALL + I_MOE + I_ADA;
    for (int it = gw; it < NITEMS; it += NGW) {
        int r = it;
#if defined(G1_MIX)
        if (r < I_WIN) { p0_transpose_item(F.in[9], D, INW, WSP(bf16, WS_WIN_T), scr, r, F.lane, MapWin{}); p0_transpose_item_f8(F.in[9], D, INW, WSP(unsigned char, WS_WIN8), scr, r, F.lane, MapWin{}, wsc1); continue; } r -= I_WIN;
#elif defined(G1_F8)
        if (r < I_WIN) { p0_transpose_item_f8(F.in[9], D, INW, WSP(unsigned char, WS_WIN_T), scr, r, F.lane, MapWin{}, wsc1); continue; } r -= I_WIN;
#else
        if (r < I_WIN) { p0_transpose_item(F.in[9], D, INW, WSP(bf16, WS_WIN_T), scr, r, F.lane, MapWin{}); continue; } r -= I_WIN;
#endif
        if (r < I_GLU) { p0_transpose_item(F.in[18], SW, SW, WSP(bf16, WS_WGLU_T), scr, r, F.lane, MapP8{0}); continue; } r -= I_GLU;
        if (r < I_SB) { p0_transpose_item(F.in[19], SW, D, WSP(bf16, WS_WSB_T), scr, r, F.lane, MapP8{0}); continue; } r -= I_SB;
        if (r < I_AB) { p0_transpose_item(F.in[20], AW, D, WSP(bf16, WS_WAB_T), scr, r, F.lane, MapP8{0}); continue; } r -= I_AB;
        if (r < I_OUT) { p0_transpose_item(F.in[21], D, D, WSP(bf16, WS_WOUT_T), scr, r, F.lane, MapP8{0}); continue; } r -= I_OUT;
        if (r < I_MOE) {
#ifdef MOE_F8
            continue;
#endif
            const int mat = r / I_E, item = r % I_E, kind = mat / NE, e = mat % NE;
#ifdef MOE_F8
            if (kind == 0) p0_transpose_item_f8(F.in[24] + (size_t)e * D * FF, D, FF, WSP(unsigned char, WS_WGU_T), scr, item, F.lane, MapGU{e, 0}, wsc);
            else if (kind == 1) p0_transpose_item_f8(F.in[26] + (size_t)e * D * FF, D, FF, WSP(unsigned char, WS_WGU_T), scr, item, F.lane, MapGU{e, 1}, wsc);
            else p0_transpose_item_f8(F.in[28] + (size_t)e * FF * D, FF, D, WSP(unsigned char, WS_WDN_T), scr, item, F.lane, MapP8{e * 1024}, wsc);
#else
            if (kind == 0) p0_transpose_item(F.in[24] + (size_t)e * D * FF, D, FF, WSP(bf16, WS_WGU_T), scr, item, F.lane, MapGU{e, 0});
            else if (kind == 1) p0_transpose_item(F.in[26] + (size_t)e * D * FF, D, FF, WSP(bf16, WS_WGU_T), scr, item, F.lane, MapGU{e, 1});
            else p0_transpose_item(F.in[28] + (size_t)e * FF * D, FF, D, WSP(bf16, WS_WDN_T), scr, item, F.lane, MapP8{e * 1024});
#endif
            continue; }
        r -= I_MOE;
        {
            const int ks = r / 96, cc = r % 96, n = cc * 64 + F.lane;
            const float* cvec = F.in[1]; const float* aw = F.in[3];
            float a0 = 0.f, a1 = 0.f;
            for (int k = ks * 64; k < ks * 64 + 64; ++k) {
                const float c0 = cvec[k], c1 = cvec[D + k];
                const float s0 = c0 / (1.f + __expf(-c0)), s1 = c1 / (1.f + __expf(-c1));
                const float w = __builtin_nontemporal_load(aw + (size_t)k * (6 * D) + n);
                a0 += s0 * w; a1 += s1 * w; }
            float* part = WSP(float, WS_ADA);
            part[(ks * 2 + 0) * (6 * D) + n] = a0; part[(ks * 2 + 1) * (6 * D) + n] = a1;
        }
    }
#ifdef MOE_F8
    p0_moe_range(F, 0, MOE_ITEMS_P0, gw, NGW, wsc);
#endif
    const int gt = F.vcu * (NWAVES * 64) + F.tid, NGT = F.G * NWAVES * 64;
    { const int* pos = (const int*)F.in[2]; float* rc = WSP(float, WS_ROPE); float* rs = rc + (size_t)T * 32;
      for (int i = gt; i < T * 32; i += NGT) { const int t = i >> 5, p = i & 31;
          const float invf = exp2f(-(float)p * (13.287712379549449f / 32.f));
          const double ang = (double)pos[t] * (double)invf; double rev = ang * 0.15915494309189535; rev -= floor(rev);
          const float fr = (float)rev;
          rc[i] = __builtin_amdgcn_cosf(fr); rs[i] = __builtin_amdgcn_sinf(fr); } }
    { float* P5 = WSP(float, WS_S5P);
      for (int i = gt; i < NG * NP; i += NGT) { const int g = i >> 6;
          const float dt = __expf(F.in[12][g]); const float lr = F.in[10][i], li = F.in[11][i];
          const float er = __expf(lr * dt); const double ang = (double)li * (double)dt; double rev = ang * 0.15915494309189535; rev -= floor(rev);
          const float cs = __builtin_amdgcn_cosf((float)rev), sn = __builtin_amdgcn_sinf((float)rev);
          float br = er * cs, bi = er * sn;
          P5[i] = br; P5[2048 + i] = bi;
          const float nr = br - 1.f, ni = bi, den = lr * lr + li * li;
          const float qr = (nr * lr + ni * li) / den, qi = (ni * lr - nr * li) / den;
          P5[8192 + i] = qr; P5[8192 + 2048 + i] = qi;
          float pr = br, pi_ = bi;
#pragma unroll
          for (int s = 0; s < 8; ++s) { const float tr = pr * pr - pi_ * pi_, ti = 2.f * pr * pi_; pr = tr; pi_ = ti; }
          P5[4096 + i] = pr; P5[6144 + i] = pi_;
          float* PW = P5 + 131072;
          float wr_ = 1.f, wi_ = 0.f;
#pragma unroll
          for (int k = 0; k <= 16; ++k) { PW[i * 17 + k] = wr_; PW[2048 * 17 + i * 17 + k] = wi_; const float tr = wr_ * br - wi_ * bi, ti = wr_ * bi + wi_ * br; wr_ = tr; wi_ = ti; } }
    }
}

__device__ __forceinline__ void phase1(Frame& F) {
    LAS float* A1 = (LAS float*)(F.lds + RING_OFF); LAS float* A2 = A1 + 2 * D;
    const float* part = WSP(float, WS_ADA); const float* ab = F.in[4]; const float* pg = F.in[5];
    for (int k = F.tid; k < D; k += NWAVES * 64)
#pragma unroll
        for (int b = 0; b < 2; ++b) { float sh = ab[k], sc = ab[D + k];
            for (int ks = 0; ks < 16; ++ks) { sh += part[(ks * 2 + b) * (6 * D) + k]; sc += part[(ks * 2 + b) * (6 * D) + D + k]; }
            A1[b * D + k] = pg[k] * (1.f + sc); A2[b * D + k] = sh; }
    const int gt = F.vcu * (NWAVES * 64) + F.tid, NGT = F.G * NWAVES * 64;
    { float* adaf = WSP(float, WS_ADAF);
      for (int n = gt; n < 2 * 6 * D; n += NGT) { const int b = n / (6 * D), j = n % (6 * D); float a = ab[j];
          for (int ks = 0; ks < 16; ++ks) a += part[(ks * 2 + b) * (6 * D) + j];
          adaf[n] = a; } }
    { float* par = WSP(float, WS_PAR);
      for (int i = gt; i < 32768; i += NGT) { par[PAR_RW + i] = F.in[22][i]; par[PAR_BG + i] = F.in[25][i]; par[PAR_BU + i] = F.in[27][i]; par[PAR_BD + i] = F.in[29][i];
          par[PAR_CRE + i] = F.in[15][i]; par[PAR_CIM + i] = F.in[16][i]; par[PAR_BRE + i] = F.in[13][i]; par[PAR_BIM + i] = F.in[14][i];
          if (i < 1024) { par[PAR_MPG + i] = F.in[6][i]; par[PAR_FPRE + i] = F.in[7][i]; par[PAR_FPOST + i] = F.in[8][i]; }
          if (i < 512) par[PAR_SD + i] = F.in[17][i];
          if (i < 32) par[PAR_RB + i] = F.in[23][i]; } }
    { const float* P5 = WSP(float, WS_S5P); const float* PWr = P5 + 131072; const float* PWi = PWr + 2048 * 17;
      bf16* M1t = WSP(bf16, WS_S5M1);
      for (int i = gt; i < NG * 256 * 256; i += NGT) { const int k = i & 255, n = (i >> 8) & 255, g = i >> 16; float val = 0.f;
          if (n < 128) { const int p = n & 63, gp = g * 64 + p, s_ = k >> 4, ci = k & 15;
              const float qr = P5[8192 + gp], qi = P5[8192 + 2048 + gp], b_r = F.in[13][gp * 16 + ci], b_i = F.in[14][gp * 16 + ci];
              const float bbr = qr * b_r - qi * b_i, bbi = qr * b_i + qi * b_r, wr_ = PWr[gp * 17 + 15 - s_], wi_ = PWi[gp * 17 + 15 - s_];
              val = (n < 64) ? (wr_ * bbr - wi_ * bbi) : (wr_ * bbi + wi_ * bbr); }
          M1t[((size_t)(g * 256 + perm8(n))) * 256 + k] = (bf16)f2bf(val); }
    }
    __syncthreads();
    const int gw = F.vcu * NWAVES + F.wave, NGW = F.G * NWAVES;
    bf16* XN = WSP(bf16, WS_XN);
    for (int m0 = gw * 2; m0 < T; m0 += NGW * 2) {
        const int b = m0 >> 13;
        f32x4 v[2][4];
#pragma unroll
        for (int q = 0; q < 2; ++q) { const GAS f32x4* xr = (const GAS f32x4*)(F.in[0] + (size_t)(m0 + q) * D) + F.lane;
#pragma unroll
            for (int j = 0; j < 4; ++j) v[q][j] = __builtin_nontemporal_load(xr + 64 * j); }
#pragma unroll
        for (int q = 0; q < 2; ++q) { float s = 0.f;
#pragma unroll
            for (int j = 0; j < 4; ++j) s += (v[q][j].x * v[q][j].x + v[q][j].y * v[q][j].y) + (v[q][j].z * v[q][j].z + v[q][j].w * v[q][j].w);
            const float rstd = 1.f / sqrtf(wave_sum(s) * (1.f / D) + NORM_EPS);
#ifdef G1_F8
            GAS unsigned* o4 = (GAS unsigned*)((unsigned char*)XN + (size_t)(m0 + q) * D) + F.lane;
#pragma unroll
            for (int j = 0; j < 4; ++j) { const f32x4 a1 = *(const LAS f32x4*)(A1 + b * D + 4 * F.lane + 256 * j), a2 = *(const LAS f32x4*)(A2 + b * D + 4 * F.lane + 256 * j);
                const f32x4 o = v[q][j] * rstd * a1 + a2;
                o4[64 * j] = pk4_fp8(8.f * o.x, 8.f * o.y, 8.f * o.z, 8.f * o.w); } }
#else
            GAS unsigned long long* o8 = (GAS unsigned long long*)(XN + (size_t)(m0 + q) * D) + F.lane;
#pragma unroll
            for (int j = 0; j < 4; ++j) { const f32x4 a1 = *(const LAS f32x4*)(A1 + b * D + 4 * F.lane + 256 * j), a2 = *(const LAS f32x4*)(A2 + b * D + 4 * F.lane + 256 * j);
                const f32x4 o = v[q][j] * rstd * a1 + a2;
                o8[64 * j] = (unsigned long long)pk2(o.x, o.y) | ((unsigned long long)pk2(o.z, o.w) << 32);
#ifdef G1_MIX
                ((GAS unsigned*)(WSP(unsigned char, WS_XN8) + (size_t)(m0 + q) * D) + F.lane)[64 * j] = pk4_fp8(8.f * o.x, 8.f * o.y, 8.f * o.z, 8.f * o.w);
#endif
            } }
#endif
    }
    __syncthreads();
}

struct EpiG1 {
    bf16 *UA, *Q, *K, *V, *VT, *GSp, *GAp; const float *rc, *rs; float* km; const float* wscp; bool f8;
    __device__ __forceinline__ void operator()(const pg8::f32x4 (&acc0)[2][2][4][2], const pg8::Unit& u, int wr, int wc, int fr, int fq) const {
        pg8::f32x4 (&acc)[2][2][4][2] = const_cast<pg8::f32x4 (&)[2][2][4][2]>(acc0);
#if defined(G1_F8) || defined(G1_MIX)
        if (f8) { const float s_ = 0.125f / *wscp;
#pragma unroll
            for (int a = 0; a < 2; ++a)
#pragma unroll
                for (int b = 0; b < 2; ++b)
#pragma unroll
                    for (int m = 0; m < 4; ++m)
#pragma unroll
                        for (int n = 0; n < 2; ++n) acc[a][b][m][n] = acc[a][b][m][n] * s_; }
#endif
        asm volatile("" : "+v"(fr), "+v"(fq));
        const int pn = u.pn, row0 = u.pm * 256 + wr * 64 + fr;
        if (pn < 2) {
#pragma unroll
            for (int ai = 0; ai < 2; ++ai)
#pragma unroll
                for (int m = 0; m < 4; ++m) { const int t = row0 + ai * 128 + m * 16, b = t >> 13, tt = t & (SEQ - 1), c = tt >> 4, s = tt & 15;
#pragma unroll
                    for (int bj = 0; bj < 2; ++bj) { const int ch = pn * 256 + bj * 128 + wc * 32 + 8 * fq, g = ch >> 4, ci = ch & 15;
                        const pg8::f32x4 v0 = acc[ai][bj][m][0], v1 = acc[ai][bj][m][1];
                        v4u w; w.x = pk2(v0[0], v0[1]); w.y = pk2(v0[2], v0[3]); w.z = pk2(v1[0], v1[1]); w.w = pk2(v1[2], v1[3]);
                        st16(UA + ((size_t)(g * 1024 + b * 512 + c) * 384 + 16 * s + ci), w); } }
        } else if (pn < 6) {
            const bool isk = pn >= 4; bf16* X = isk ? K : Q; const float sc = isk ? 1.f : C2;
            const int p0 = 16 * (wc & 1) + 4 * fq;
#pragma unroll
            for (int bj = 0; bj < 2; ++bj) {
                const int head = 4 * (pn & 1) + 2 * bj + (wc >> 1);
                int rowb = row0; asm volatile("" : "+v"(rowb));
                float ks[2][4];
#pragma unroll
                for (int b = 0; b < 2; ++b)
#pragma unroll
                    for (int i = 0; i < 4; ++i) ks[b][i] = 0.f;
#pragma unroll
                for (int ai = 0; ai < 2; ++ai)
#pragma unroll
                    for (int m = 0; m < 4; ++m) { const int t = rowb + ai * 128 + m * 16;
                        const pg8::f32x4 cs = *(const pg8::f32x4*)(rc + (size_t)t * 32 + p0), sn = *(const pg8::f32x4*)(rs + (size_t)t * 32 + p0);
                        const pg8::f32x4 t1 = acc[ai][bj][m][0], t2 = acc[ai][bj][m][1];
                        const pg8::f32x4 o1 = t1 * cs - t2 * sn, o2 = t2 * cs + t1 * sn;
                        v2u w1, w2; w1.x = pk2(o1[0] * sc, o1[1] * sc); w1.y = pk2(o1[2] * sc, o1[3] * sc); w2.x = pk2(o2[0] * sc, o2[1] * sc); w2.y = pk2(o2[2] * sc, o2[3] * sc);
                        bf16* dst = X + (size_t)t * AW + head * 64 + p0;
                        st8(dst, w1); st8(dst + 32, w2);
#pragma unroll
                        for (int i = 0; i < 4; ++i) { ks[0][i] += o1[i]; ks[1][i] += o2[i]; }
                        __builtin_amdgcn_sched_barrier(0); }
                if (isk) {
                    const int b = u.pm >> 5, blk = u.pm & 31;
#pragma unroll
                    for (int n = 0; n < 2; ++n)
#pragma unroll
                        for (int i = 0; i < 4; ++i) { float v = ks[n][i];
                            v += __shfl_xor(v, 1); v += __shfl_xor(v, 2); v += __shfl_xor(v, 4); v += __shfl_xor(v, 8);
                            if (fr == 0) atomicAdd(km + ((size_t)((b * NH + head) * NBLK + blk) * HD + 32 * n + p0 + i), v); }
                }
            }
        } else if (pn < 8) {
#pragma unroll
            for (int ai = 0; ai < 2; ++ai)
#pragma unroll
                for (int m = 0; m < 4; ++m) { const int t = row0 + ai * 128 + m * 16, b = t >> 13, tt = t & (SEQ - 1);
#pragma unroll
                    for (int bj = 0; bj < 2; ++bj) { const int cv = (pn - 6) * 256 + bj * 128 + wc * 32 + 8 * fq, head = cv >> 6, d = cv & 63;
                        const pg8::f32x4 v0 = acc[ai][bj][m][0], v1 = acc[ai][bj][m][1];
                        v4u w; w.x = pk2(v0[0], v0[1]); w.y = pk2(v0[2], v0[3]); w.z = pk2(v1[0], v1[1]); w.w = pk2(v1[2], v1[3]);
                        bf16* vt = VT + ((size_t)((b * NH + head) * HD + d) * SEQ + tt);
                        vt[0 * SEQ] = (bf16)(w.x & 0xffff); vt[1 * SEQ] = (bf16)(w.x >> 16); vt[2 * SEQ] = (bf16)(w.y & 0xffff); vt[3 * SEQ] = (bf16)(w.y >> 16);
                        vt[4 * SEQ] = (bf16)(w.z & 0xffff); vt[5 * SEQ] = (bf16)(w.z >> 16); vt[6 * SEQ] = (bf16)(w.w & 0xffff); vt[7 * SEQ] = (bf16)(w.w >> 16); } }
        } else {
            bf16* Gp = (pn < 12) ? GSp : GAp; const int cb = ((pn - 8) & 3) * 256;
#pragma unroll
            for (int ai = 0; ai < 2; ++ai)
#pragma unroll
                for (int m = 0; m < 4; ++m) { const int t = row0 + ai * 128 + m * 16;
#pragma unroll
                    for (int bj = 0; bj < 2; ++bj) { const int col = cb + bj * 128 + wc * 32 + 8 * fq;
                        const pg8::f32x4 v0 = acc[ai][bj][m][0], v1 = acc[ai][bj][m][1];
                        v4u w; w.x = pk2(sigmoidf_(v0[0]), sigmoidf_(v0[1])); w.y = pk2(sigmoidf_(v0[2]), sigmoidf_(v0[3]));
                        w.z = pk2(sigmoidf_(v1[0]), sigmoidf_(v1[1])); w.w = pk2(sigmoidf_(v1[2]), sigmoidf_(v1[3]));
                        __builtin_nontemporal_store(w, (v4u*)(Gp + (size_t)t * D + col)); } }
        }
    }
};

template <int MODE> struct EpiEw {
    bf16* O; const bf16* X1; const bf16* X2; float* Of; int ld;
    __device__ __forceinline__ void operator()(const pg8::f32x4 (&acc)[2][2][4][2], const pg8::Unit& u, int wr, int wc, int fr, int fq) const {
        const int row0 = u.pm * 256 + wr * 64 + fr, col0 = u.pn * 256 + wc * 32 + 8 * fq;
#pragma unroll
        for (int ai = 0; ai < 2; ++ai)
#pragma unroll
            for (int m = 0; m < 4; ++m) { const size_t rb = (size_t)(row0 + ai * 128 + m * 16) * ld + col0;
#pragma unroll
                for (int bj = 0; bj < 2; ++bj) { const size_t off = rb + bj * 128;
                    const pg8::f32x4 v0 = acc[ai][bj][m][0], v1 = acc[ai][bj][m][1];
                    if (MODE == 3) { *(pg8::f32x4*)(Of + off) = v0; *(pg8::f32x4*)(Of + off + 4) = v1; }
                    else if (MODE == 4) { v4u w; w.x = pk2(v0[0], v0[1]); w.y = pk2(v0[2], v0[3]); w.z = pk2(v1[0], v1[1]); w.w = pk2(v1[2], v1[3]); st16(O + off, w); }
                    else {
                        const v4u x = __builtin_nontemporal_load((const v4u*)(X1 + off));
                        float r[8] = {v0[0], v0[1], v0[2], v0[3], v1[0], v1[1], v1[2], v1[3]};
                        const float xv[8] = {bflo(x.x), bfhi(x.x), bflo(x.y), bfhi(x.y), bflo(x.z), bfhi(x.z), bflo(x.w), bfhi(x.w)};
                        if (MODE == 0) {
#pragma unroll
                            for (int i = 0; i < 8; ++i) r[i] = xv[i] * sigmoidf_(r[i]);
                        } else if (MODE == 1) {
#pragma unroll
                            for (int i = 0; i < 8; ++i) r[i] = xv[i] * r[i];
                        } else {
                            const v4u y = __builtin_nontemporal_load((const v4u*)(X2 + off));
                            const float yv[8] = {bflo(y.x), bfhi(y.x), bflo(y.y), bfhi(y.y), bflo(y.z), bfhi(y.z), bflo(y.w), bfhi(y.w)};
#pragma unroll
                            for (int i = 0; i < 8; ++i) r[i] = yv[i] + xv[i] * r[i];
                        }
                        v4u w; w.x = pk2(r[0], r[1]); w.y = pk2(r[2], r[3]); w.z = pk2(r[4], r[5]); w.w = pk2(r[6], r[7]);
                        st16(O + off, w); } } }
    }
};

typedef short bf16x8 __attribute__((ext_vector_type(8)));
typedef float f32x16 __attribute__((ext_vector_type(16)));
constexpr size_t WS_ALIST = 456 * MiB;
constexpr size_t WS_OP01 = 224 * MiB;
constexpr size_t WS_OP23 = 472 * MiB;
constexpr size_t WS_LSE = 504 * MiB;
constexpr int CW_BCNT = 12288;
constexpr int ALCAP = 8192;

__device__ __forceinline__ void attn_gate(Frame& F) {
    const int gw = F.vcu * NWAVES + F.wave, NGW = F.G * NWAVES, L = F.lane;
    const bf16* Q = WSP(bf16, WS_Q); const float* km = (const float*)(F.ctl + CW_KM);
    unsigned* bcnt = (unsigned*)(F.ctl + CW_BCNT); unsigned* list = WSP(unsigned, WS_ALIST); float* lse = WSP(float, WS_LSE);
    for (int w = gw; w < BATCH * NH * (SEQ / 64); w += NGW) {
        const int bh = w >> 7, b = bh >> 3, h = bh & 7, tt = (w & 127) * 64 + L, t = b * SEQ + tt, blk = tt >> 8;
        float q[64];
        { const v4u* qp = (const v4u*)(Q + (size_t)t * AW + h * 64);
#pragma unroll
          for (int i = 0; i < 8; ++i) { const v4u x = qp[i]; q[8 * i] = bflo(x.x); q[8 * i + 1] = bfhi(x.x); q[8 * i + 2] = bflo(x.y); q[8 * i + 3] = bfhi(x.y);
              q[8 * i + 4] = bflo(x.z); q[8 * i + 5] = bfhi(x.z); q[8 * i + 6] = bflo(x.w); q[8 * i + 7] = bfhi(x.w); } }
        float v0 = -3e38f, v1 = -3e38f, v2 = -3e38f; int i0 = -1, i1 = -1, i2 = -1;
        for (int j = 0; j < blk; ++j) { const float* kp = km + (size_t)((b * NH + h) * NBLK + j) * HD; float g = 0.f;
#pragma unroll
            for (int d = 0; d < 64; ++d) g += q[d] * kp[d];
            if (g > v0) { v2 = v1; i2 = i1; v1 = v0; i1 = i0; v0 = g; i0 = j; }
            else if (g > v1) { v2 = v1; i2 = i1; v1 = g; i1 = j; }
            else if (g > v2) { v2 = g; i2 = j; } }
        float* lp = lse + ((size_t)t * NH + h) * 4;
        if (i0 < 0) lp[0] = -1e30f; if (i1 < 0) lp[1] = -1e30f; if (i2 < 0) lp[2] = -1e30f;
        for (int j = 0; j < blk; ++j) {
            const bool sel = (i0 == j) || (i1 == j) || (i2 == j);
            const unsigned long long mask = __ballot(sel);
            if (mask) { const int leader = __ffsll((long long)mask) - 1; const int bucket = (b * NH + h) * NBLK + j;
                unsigned base = 0u;
                if (L == leader) base = __hip_atomic_fetch_add(bcnt + bucket, (unsigned)__popcll(mask), RLX_AGENT);
                base = (unsigned)__shfl((int)base, leader);
                if (sel) { const unsigned pos = base + (unsigned)__popcll(mask & ((1ull << L) - 1ull)); const unsigned slot = (i0 == j) ? 0u : ((i1 == j) ? 1u : 2u);
                    list[(size_t)bucket * ALCAP + pos] = ((unsigned)tt << 2) | slot; } }
        }
    }
}

__device__ __forceinline__ unsigned cvtpk(float lo, float hi) { typedef float f32x2_t __attribute__((ext_vector_type(2))); typedef __bf16 bf16x2_t __attribute__((ext_vector_type(2)));
    f32x2_t v = {lo, hi}; bf16x2_t r = __builtin_convertvector(v, bf16x2_t); return __builtin_bit_cast(unsigned, r); }

constexpr int AT_KROW = 144, AT_VROW = 520, AT_KOFF = 0, AT_VOFF = 256 * AT_KROW;
__device__ __forceinline__ void attn_item(Frame& F, int b, int h, int j, bool own, const unsigned* lst, int nvalid) {
    const int tid = F.tid, L = F.lane, r = L & 31, hh = L >> 5, wv = F.wave;
    LAS unsigned char* Kl = F.lds + AT_KOFF; LAS unsigned char* Vl = F.lds + AT_VOFF;
    const bf16* Kg = WSP(bf16, WS_K) + ((size_t)(b * SEQ + j * 256)) * AW + h * 64;
    const bf16* Vg = WSP(bf16, WS_VT) + ((size_t)((b * NH + h) * HD)) * SEQ + j * 256;
    v4u kr[4], vr[4];
#pragma unroll
    for (int i = 0; i < 4; ++i) { const int idx = tid + 512 * i; kr[i] = *(const v4u*)(Kg + (size_t)(idx >> 3) * AW + (idx & 7) * 8); vr[i] = *(const v4u*)(Vg + (size_t)(idx >> 5) * SEQ + (idx & 31) * 8); }
    const int qi = wv * 32 + r; const bool valid = qi < nvalid;
    unsigned ent; if (own) ent = ((unsigned)(j * 256 + qi) << 2) | 3u; else ent = lst[valid ? qi : 0];
    const int tt = (int)(ent >> 2), slot = (int)(ent & 3u), t = b * SEQ + tt;
    bf16x8 qf[4];
    { const bf16* qp = WSP(bf16, WS_Q) + (size_t)t * AW + h * 64 + hh * 8;
#pragma unroll
      for (int d0 = 0; d0 < 4; ++d0) qf[d0] = *(const bf16x8*)(qp + d0 * 16); }
#pragma unroll
    for (int i = 0; i < 4; ++i) { const int idx = tid + 512 * i; *(LAS v4u*)(Kl + (idx >> 3) * AT_KROW + (idx & 7) * 16) = kr[i]; *(LAS v4u*)(Vl + (idx >> 5) * AT_VROW + (idx & 31) * 16) = vr[i]; }
    __syncthreads();
#ifdef ATT_STAGGER
    if (wv >= 4) __builtin_amdgcn_s_sleep(ATT_STAGGER);
#endif
#ifdef ATT_REP_COMPUTE
    for (int arep = 0; arep < 2; ++arep)
#endif
    if (wv * 32 < nvalid) {
        float m = -1e30f, l = 0.f; f32x16 O0 = {}, O1 = {};
        const int qrel = tt & 255;
#pragma unroll
        for (int hk = 0; hk < 2; ++hk) {
            if (own && hk * 4 > wv) continue;
            f32x16 S[4];
#pragma unroll
            for (int kt = 0; kt < 4; ++kt) S[kt] = (f32x16){};
#pragma unroll
            for (int d0 = 0; d0 < 4; ++d0) {
#pragma unroll
                for (int kt = 0; kt < 4; ++kt) { const bf16x8 kf = *(const LAS bf16x8*)(Kl + (hk * 128 + kt * 32 + r) * AT_KROW + d0 * 32 + hh * 16);
                    S[kt] = __builtin_amdgcn_mfma_f32_32x32x16_bf16(kf, qf[d0], S[kt], 0, 0, 0); }
                if (d0 & 1) __builtin_amdgcn_sched_barrier(0); }
            if (own) {
                asm volatile("; causal masking (own block only)" ::: "memory");
#pragma unroll
                for (int kt = 0; kt < 4; ++kt)
#pragma unroll
                    for (int rg = 0; rg < 16; ++rg) { const int key = hk * 128 + kt * 32 + (rg & 3) + 8 * (rg >> 2) + 4 * hh; if (key > qrel) S[kt][rg] = -1e30f; } }
            float mx = S[0][0];
#pragma unroll
            for (int kt = 0; kt < 4; ++kt)
#pragma unroll
                for (int rg = 0; rg < 16; ++rg) mx = fmaxf(mx, S[kt][rg]);
            mx = fmaxf(mx, __shfl_xor(mx, 32));
            const float mn = fmaxf(m, mx), alpha = __builtin_amdgcn_exp2f(m - mn); m = mn; l *= alpha;
#pragma unroll
            for (int rg = 0; rg < 16; ++rg) { O0[rg] *= alpha; O1[rg] *= alpha; }
            float ls = 0.f;
#pragma unroll
            for (int kt = 0; kt < 4; ++kt) {
                unsigned pw[8];
#pragma unroll
                for (int rg = 0; rg < 16; rg += 2) { const float p0 = __builtin_amdgcn_exp2f(S[kt][rg] - mn), p1 = __builtin_amdgcn_exp2f(S[kt][rg + 1] - mn); ls += p0 + p1; pw[rg >> 1] = cvtpk(p0, p1); }
#pragma unroll
                for (int s = 0; s < 2; ++s) {
                    const v4u pv = {pw[4 * s], pw[4 * s + 1], pw[4 * s + 2], pw[4 * s + 3]}; const bf16x8 pf = __builtin_bit_cast(bf16x8, pv);
                    const int kb = (hk * 128 + kt * 32 + 16 * s + 4 * hh) * 2;
                    { const LAS unsigned char* vp = Vl + r * AT_VROW + kb; const v2u lo = *(const LAS v2u*)vp, hi = *(const LAS v2u*)(vp + 16);
                      const v4u vv = {lo.x, lo.y, hi.x, hi.y}; O0 = __builtin_amdgcn_mfma_f32_32x32x16_bf16(__builtin_bit_cast(bf16x8, vv), pf, O0, 0, 0, 0); }
                    { const LAS unsigned char* vp = Vl + (32 + r) * AT_VROW + kb; const v2u lo = *(const LAS v2u*)vp, hi = *(const LAS v2u*)(vp + 16);
                      const v4u vv = {lo.x, lo.y, hi.x, hi.y}; O1 = __builtin_amdgcn_mfma_f32_32x32x16_bf16(__builtin_bit_cast(bf16x8, vv), pf, O1, 0, 0, 0); } } }
            l += ls;
        }
        l += __shfl_xor(l, 32);
        if (valid) {
            const float rl = 1.f / l;
            bf16* op = (slot < 2 ? WSP(bf16, WS_OP01) + (((size_t)t * NH + h) * 2 + slot) * 64 : WSP(bf16, WS_OP23) + (((size_t)t * NH + h) * 2 + (slot - 2)) * 64) + 4 * hh;
#pragma unroll
            for (int g4 = 0; g4 < 4; ++g4) { v2u w0, w1; w0.x = cvtpk(O0[4 * g4] * rl, O0[4 * g4 + 1] * rl); w0.y = cvtpk(O0[4 * g4 + 2] * rl, O0[4 * g4 + 3] * rl);
                w1.x = cvtpk(O1[4 * g4] * rl, O1[4 * g4 + 1] * rl); w1.y = cvtpk(O1[4 * g4 + 2] * rl, O1[4 * g4 + 3] * rl);
                *(v2u*)(op + 8 * g4) = w0; *(v2u*)(op + 32 + 8 * g4) = w1; }
            if (hh == 0) WSP(float, WS_LSE)[((size_t)t * NH + h) * 4 + slot] = m + log2f(l);
        }
    }
    __syncthreads();
}
__device__ __forceinline__ void attn_items(Frame& F) {
    LAS int* pre = (LAS int*)(F.lds + 72 * 1024);
    const unsigned* bcnt = (const unsigned*)(F.ctl + CW_BCNT);
    LAS int* cntl = pre + 520;
    for (int i = F.tid; i < 512; i += NWAVES * 64) cntl[i] = (int)__hip_atomic_load((gu32*)(F.ctl + CW_BCNT) + i, RLX_AGENT);
    __syncthreads();
    if (F.tid == 0) { int a = 0; for (int i = 0; i < 512; ++i) { pre[i] = a; a += (cntl[i] + 255) >> 8; } pre[512] = a; }
    __syncthreads();
    const int total = 512 + pre[512];
    for (int it = (int)blockIdx.x; it < total; it += F.G) {
        int bh, j, n; bool own; const unsigned* lst;
        if (it < 512) { bh = it >> 5; j = it & 31; own = true; lst = nullptr; n = 256; }
        else { const int s = it - 512; int lo = 0, hi = 512;
            while (hi - lo > 1) { const int mid = (lo + hi) >> 1; if (pre[mid] <= s) lo = mid; else hi = mid; }
            const int bucket = lo, tile = s - pre[bucket]; n = cntl[bucket] - tile * 256; n = n > 256 ? 256 : n; bh = bucket >> 5; j = bucket & 31; own = false;
            lst = WSP(unsigned, WS_ALIST) + (size_t)bucket * ALCAP + tile * 256; }
        const int b_ = __builtin_amdgcn_readfirstlane(bh >> 3), h_ = __builtin_amdgcn_readfirstlane(bh & 7), j_ = __builtin_amdgcn_readfirstlane(j), n_ = __builtin_amdgcn_readfirstlane(n);
        attn_item(F, b_, h_, j_, own, lst, n_);
    }
}
__device__ __forceinline__ void attn_combine(Frame& F) {
    if (F.G == 256 && blockIdx.x < 128) return;
    const int nb = F.G == 256 ? 128 : F.G, bi = F.G == 256 ? (int)blockIdx.x - 128 : F.vcu;
    const int gw = bi * NWAVES + F.wave, NGW = nb * NWAVES, L = F.lane, h = L >> 3, ch = L & 7;
    const float* lse = WSP(float, WS_LSE); bf16* YA = WSP(bf16, WS_YA);
    for (int t = gw; t < T; t += NGW) {
        const size_t th = (size_t)t * NH + h;
        const f32x4 ls = *(const f32x4*)(lse + th * 4);
        const float mx = fmaxf(fmaxf(ls[0], ls[1]), fmaxf(ls[2], ls[3]));
        const float w0 = __builtin_amdgcn_exp2f(ls[0] - mx), w1 = __builtin_amdgcn_exp2f(ls[1] - mx), w2 = __builtin_amdgcn_exp2f(ls[2] - mx), w3 = __builtin_amdgcn_exp2f(ls[3] - mx), inv = 1.f / (w0 + w1 + w2 + w3);
        const v4u a0 = __builtin_nontemporal_load((const v4u*)(WSP(bf16, WS_OP01) + (th * 2 + 0) * 64 + ch * 8)), a1 = __builtin_nontemporal_load((const v4u*)(WSP(bf16, WS_OP01) + (th * 2 + 1) * 64 + ch * 8));
        const v4u a2 = __builtin_nontemporal_load((const v4u*)(WSP(bf16, WS_OP23) + (th * 2 + 0) * 64 + ch * 8)), a3 = __builtin_nontemporal_load((const v4u*)(WSP(bf16, WS_OP23) + (th * 2 + 1) * 64 + ch * 8));
        float o[8];
        const unsigned x0[4] = {a0.x, a0.y, a0.z, a0.w}, x1[4] = {a1.x, a1.y, a1.z, a1.w}, x2[4] = {a2.x, a2.y, a2.z, a2.w}, x3[4] = {a3.x, a3.y, a3.z, a3.w};
#pragma unroll
        for (int i = 0; i < 4; ++i) {
            float lo_ = w3 * bflo(x3[i]), hi_ = w3 * bfhi(x3[i]);
            if (ls[0] > -1e29f) { lo_ += w0 * bflo(x0[i]); hi_ += w0 * bfhi(x0[i]); }
            if (ls[1] > -1e29f) { lo_ += w1 * bflo(x1[i]); hi_ += w1 * bfhi(x1[i]); }
            if (ls[2] > -1e29f) { lo_ += w2 * bflo(x2[i]); hi_ += w2 * bfhi(x2[i]); }
            o[2 * i] = lo_ * inv; o[2 * i + 1] = hi_ * inv; }
        v4u w; w.x = cvtpk(o[0], o[1]); w.y = cvtpk(o[2], o[3]); w.z = cvtpk(o[4], o[5]); w.w = cvtpk(o[6], o[7]);
        *(v4u*)(YA + (size_t)t * AW + h * 64 + ch * 8) = w;
    }
}
struct S5Order { static constexpr bool GATHER = false; int G, c;
    __device__ __forceinline__ void a_ready(const pg8::Unit&) const {}
    __device__ __forceinline__ void done(const pg8::Unit&) const {}
    __device__ __forceinline__ bool next(int i, pg8::Unit& u) const { const int L = i * G + c; if (L >= NG * 4) return false; const int g = L >> 2, rt = L & 3;
        u.arow = g * 1024 + rt * 256; u.brow = g * 256; u.pm = rt; u.pn = 0; u.e = g; u.nrow = 256; u.kind = 0; u.aux = 0; return true; } };
struct EpiS5A { float* E;
    __device__ __forceinline__ void operator()(const pg8::f32x4 (&acc)[2][2][4][2], const pg8::Unit& u, int wr, int wc, int fr, int fq) const {
        asm volatile("" : "+v"(fr), "+v"(fq));
#pragma unroll
        for (int ai = 0; ai < 2; ++ai)
#pragma unroll
            for (int m = 0; m < 4; ++m) { float* p = E + (size_t)(u.arow + ai * 128 + wr * 64 + m * 16 + fr) * 128 + wc * 32 + 8 * fq;
                *(pg8::f32x4*)p = acc[ai][0][m][0]; *(pg8::f32x4*)(p + 4) = acc[ai][0][m][1]; }
    }
};
struct EpiS5C { bf16* YG;
    __device__ __forceinline__ void operator()(const pg8::f32x4 (&acc)[2][2][4][2], const pg8::Unit& u, int wr, int wc, int fr, int fq) const {
        asm volatile("" : "+v"(fr), "+v"(fq));
        const int g = u.e, n0 = wc * 32 + 8 * fq, t0 = n0 >> 4, co0 = n0 & 15;
#pragma unroll
        for (int ai = 0; ai < 2; ++ai)
#pragma unroll
            for (int m = 0; m < 4; ++m) { const int row = u.pm * 256 + ai * 128 + wr * 64 + m * 16 + fr, b = row >> 9, c = row & 511;
                bf16* yp = YG + (size_t)(b * SEQ + 16 * c + t0) * SW + 16 * g + co0;
#pragma unroll
                for (int bj = 0; bj < 2; ++bj) {
                    const pg8::f32x4 v0 = acc[ai][bj][m][0], v1 = acc[ai][bj][m][1];
                    v4u w; w.x = pk2(gelu_tanh(v0[0]), gelu_tanh(v0[1])); w.y = pk2(gelu_tanh(v0[2]), gelu_tanh(v0[3]));
                    w.z = pk2(gelu_tanh(v1[0]), gelu_tanh(v1[1])); w.w = pk2(gelu_tanh(v1[2]), gelu_tanh(v1[3]));
                    *(v4u*)(yp + (size_t)bj * 8 * SW) = w; }
                __builtin_amdgcn_sched_barrier(0); }
    }
};
__device__ __forceinline__ void s5_fill_kt(Frame& F) {
    const int gt = F.vcu * (NWAVES * 64) + F.tid, NGT = F.G * NWAVES * 64;
    const float* P5 = WSP(float, WS_S5P); const float* PWr = P5 + 131072; const float* PWi = PWr + 2048 * 17; const float* par = WSP(float, WS_PAR);
    float* KT = WSP(float, WS_S5KT);
    for (int i = gt; i < NG * 16 * 256; i += NGT) { const int ci = i & 15, co = (i >> 4) & 15, tau = (i >> 8) & 15, g = i >> 12; float a = 0.f;
        for (int p = 0; p < 64; ++p) { const int gp = g * 64 + p;
            const float qr = P5[8192 + gp], qi = P5[8192 + 2048 + gp], b_r = par[PAR_BRE + gp * 16 + ci], b_i = par[PAR_BIM + gp * 16 + ci];
            const float bbr = qr * b_r - qi * b_i, bbi = qr * b_i + qi * b_r, wr_ = PWr[gp * 17 + tau], wi_ = PWi[gp * 17 + tau];
            const float xr = wr_ * bbr - wi_ * bbi, xi = wr_ * bbi + wi_ * bbr;
            const float cr = par[PAR_CRE + (g * 16 + co) * 64 + p], ci_ = par[PAR_CIM + (g * 16 + co) * 64 + p];
            a += cr * xr - ci_ * xi; }
        KT[i] = a; }
}
__device__ __forceinline__ void s5_fill_wc(Frame& F) {
    const int gt = F.vcu * (NWAVES * 64) + F.tid, NGT = F.G * NWAVES * 64;
    const float* P5 = WSP(float, WS_S5P); const float* PWr = P5 + 131072; const float* PWi = PWr + 2048 * 17; const float* KT = WSP(float, WS_S5KT); const float* par = WSP(float, WS_PAR);
    bf16* Wc = WSP(bf16, WS_S5WC);
    for (int i = gt; i < NG * 256 * 384; i += NGT) { const int k = i % 384, n = (i / 384) & 255, g = i / (384 * 256), t = n >> 4, co = n & 15; float val = 0.f;
        if (k < 256) { const int s_ = k >> 4, ci = k & 15;
            if (s_ <= t) val = KT[((g * 16 + (t - s_)) * 16 + co) * 16 + ci];
            if (s_ == t && ci == co) val += par[PAR_SD + g * 16 + co]; }
        else { const int p = (k - 256) & 63, gp = g * 64 + p; const float cr = par[PAR_CRE + (g * 16 + co) * 64 + p], ci_ = par[PAR_CIM + (g * 16 + co) * 64 + p];
            const float wr_ = PWr[gp * 17 + t + 1], wi_ = PWi[gp * 17 + t + 1];
            val = (k < 320) ? (cr * wr_ - ci_ * wi_) : -(cr * wi_ + ci_ * wr_); }
        Wc[((size_t)(g * 256 + perm8(n))) * 384 + k] = (bf16)f2bf(val); }
}
__device__ __forceinline__ void s5_carry(Frame& F) {
    const float* P5 = WSP(float, WS_S5P); const float* PWr = P5 + 131072; const float* PWi = PWr + 2048 * 17; const float* E = WSP(float, WS_S5E); bf16* UA = WSP(bf16, WS_UA);
    LAS float* Z = (LAS float*)(F.lds);
    const int seg = F.wave, p = F.lane;
    for (int bg = F.vcu; bg < BATCH * NG; bg += F.G) { const int b = bg / NG, g = bg % NG, gp = g * 64 + p;
        const float ar = PWr[gp * 17 + 16], ai = PWi[gp * 17 + 16];
        const size_t row0 = (size_t)g * 1024 + b * 512 + seg * 64;
        float zr = 0.f, zi = 0.f;
        for (int c0 = 0; c0 < 64; c0 += 8) { float er[8], ei[8];
#pragma unroll
            for (int k = 0; k < 8; ++k) { er[k] = E[(row0 + c0 + k) * 128 + p]; ei[k] = E[(row0 + c0 + k) * 128 + 64 + p]; }
#pragma unroll
            for (int k = 0; k < 8; ++k) { const float nr = ar * zr - ai * zi + er[k], ni = ar * zi + ai * zr + ei[k]; zr = nr; zi = ni; } }
        Z[(seg * 64 + p) * 2] = zr; Z[(seg * 64 + p) * 2 + 1] = zi;
        __syncthreads();
        if (seg == 0) { float br = ar, bi = ai;
#pragma unroll
            for (int k = 0; k < 6; ++k) { const float tr = br * br - bi * bi, ti = 2.f * br * bi; br = tr; bi = ti; }
            float sr = 0.f, si = 0.f;
            for (int sg = 0; sg < 8; ++sg) { const float xr = Z[(sg * 64 + p) * 2], xi = Z[(sg * 64 + p) * 2 + 1]; Z[(sg * 64 + p) * 2] = sr; Z[(sg * 64 + p) * 2 + 1] = si;
                const float nr = br * sr - bi * si + xr, ni = br * si + bi * sr + xi; sr = nr; si = ni; } }
        __syncthreads();
        float sr = Z[(seg * 64 + p) * 2], si = Z[(seg * 64 + p) * 2 + 1];
        for (int c0 = 0; c0 < 64; c0 += 8) { float er[8], ei[8];
#pragma unroll
            for (int k = 0; k < 8; ++k) { er[k] = E[(row0 + c0 + k) * 128 + p]; ei[k] = E[(row0 + c0 + k) * 128 + 64 + p]; }
#pragma unroll
            for (int k = 0; k < 8; ++k) { bf16* up = UA + (row0 + c0 + k) * 384 + 256 + p; up[0] = (bf16)f2bf(sr); up[64] = (bf16)f2bf(si);
                const float nr = ar * sr - ai * si + er[k], ni = ar * si + ai * sr + ei[k]; sr = nr; si = ni; } }
        __syncthreads();
    }
}
constexpr int SCR_OFF = LDSCTL_OFF + 512;
#ifndef MOE_LAG
#define MOE_LAG 2
#endif
constexpr int MT_SEG = 100, MT_MAXSEG = 72, MT_ULIST = 400, MT_MAXU = 16;
__device__ __forceinline__ void phase_rows(Frame& F, bool dry = false) {
    LAS float* h2t = (LAS float*)(F.lds);
    LAS float* lg = (LAS float*)(F.lds + 65536);
    LAS float* gtm = (LAS float*)(F.lds + 131072);
    LAS float* pg2 = gtm + 2 * D; LAS float* shf = pg2 + 2 * D;
    LAS unsigned* hist = (LAS unsigned*)(F.lds + SCR_OFF); LAS unsigned* base = hist + 32; LAS int* rec_e = (LAS int*)(base + 32); LAS int* rec_lp = rec_e + 256;
    const float* adaf = WSP(float, WS_ADAF); const float* par = WSP(float, WS_PAR);
    const int L = F.lane, wv = F.wave;
    for (int i = F.tid; i < 2 * D; i += NWAVES * 64) { const int b = i >> 10, k = i & (D - 1);
        gtm[i] = adaf[b * 6 * D + 2 * D + k] * par[PAR_MPG + k];
        pg2[i] = par[PAR_FPRE + k] * (1.f + adaf[b * 6 * D + 4 * D + k]); shf[i] = adaf[b * 6 * D + 3 * D + k]; }
    f32x4 wreg[16];
#pragma unroll
    for (int j = 0; j < 4; ++j)
#pragma unroll
        for (int i = 0; i < 4; ++i) wreg[j * 4 + i] = *(const f32x4*)(par + PAR_RW + (4 * L + 256 * j + i) * NE + 4 * wv);
    if (F.tid < 32) hist[F.tid] = 0u;
    __syncthreads();
    const bf16* mix = WSP(bf16, WS_MIX); bf16* H2 = WSP(bf16, WS_H2); bf16* X1B = WSP(bf16, WS_X1B);
    int* tok_e = WSP(int, WS_ROUTE); float* tok_w = (float*)(tok_e + T * 4); int* tok_pos = tok_e + 2 * T * 4;
    unsigned* gcnt = (unsigned*)(F.ctl + CW_ECNT);
    for (int t0 = F.vcu * 16; t0 < T; t0 += F.G * 16) {
        {
            const int t = t0 + 2 * wv, b = t >> 13;
            f32x4 mv[2][4], xv[2][4];
#pragma unroll
            for (int q = 0; q < 2; ++q) { const GAS v2u* mr = (const GAS v2u*)(mix + (size_t)(t + q) * D) + L; const GAS f32x4* xr = (const GAS f32x4*)(F.in[0] + (size_t)(t + q) * D) + L;
#pragma unroll
                for (int j = 0; j < 4; ++j) { const v2u mw = __builtin_nontemporal_load(mr + 64 * j); mv[q][j] = (f32x4){bflo(mw.x), bfhi(mw.x), bflo(mw.y), bfhi(mw.y)}; xv[q][j] = __builtin_nontemporal_load(xr + 64 * j); } }
#pragma unroll
            for (int q = 0; q < 2; ++q) { float s = 0.f;
#pragma unroll
                for (int j = 0; j < 4; ++j) s += (mv[q][j].x * mv[q][j].x + mv[q][j].y * mv[q][j].y) + (mv[q][j].z * mv[q][j].z + mv[q][j].w * mv[q][j].w);
                const float r1 = 1.f / sqrtf(wave_sum(s) * (1.f / D) + NORM_EPS);
                float s2 = 0.f; GAS v2u* orow = (GAS v2u*)(X1B + (size_t)(t + q) * D) + L;
#pragma unroll
                for (int j = 0; j < 4; ++j) { const f32x4 g = *(const LAS f32x4*)(gtm + b * D + 4 * L + 256 * j);
                    xv[q][j] = xv[q][j] + g * (mv[q][j] * r1); { v2u w; w.x = pk2(xv[q][j].x, xv[q][j].y); w.y = pk2(xv[q][j].z, xv[q][j].w); __builtin_nontemporal_store(w, orow + 64 * j); }
                    s2 += (xv[q][j].x * xv[q][j].x + xv[q][j].y * xv[q][j].y) + (xv[q][j].z * xv[q][j].z + xv[q][j].w * xv[q][j].w); }
                const float r2 = 1.f / sqrtf(wave_sum(s2) * (1.f / D) + NORM_EPS);
#ifdef MOE_F8
                GAS unsigned* h4 = (GAS unsigned*)(WSP(unsigned char, WS_H2) + (size_t)(t + q) * D) + L;
#pragma unroll
                for (int j = 0; j < 4; ++j) { const f32x4 a = *(const LAS f32x4*)(pg2 + b * D + 4 * L + 256 * j), c = *(const LAS f32x4*)(shf + b * D + 4 * L + 256 * j);
                    const f32x4 h = xv[q][j] * r2 * a + c;
                    h4[64 * j] = pk4_fp8(8.f * h.x, 8.f * h.y, 8.f * h.z, 8.f * h.w);
                    *(LAS f32x4*)(h2t + (2 * wv + q) * D + 4 * L + 256 * j) = h; } }
#else
                GAS unsigned long long* h8 = (GAS unsigned long long*)(H2 + (size_t)(t + q) * D) + L;
#pragma unroll
                for (int j = 0; j < 4; ++j) { const f32x4 a = *(const LAS f32x4*)(pg2 + b * D + 4 * L + 256 * j), c = *(const LAS f32x4*)(shf + b * D + 4 * L + 256 * j);
                    const f32x4 h = xv[q][j] * r2 * a + c;
                    h8[64 * j] = (unsigned long long)pk2(h.x, h.y) | ((unsigned long long)pk2(h.z, h.w) << 32);
                    *(LAS f32x4*)(h2t + (2 * wv + q) * D + 4 * L + 256 * j) = h; } }
#endif
        }
        __syncthreads();
        {
            const int hi = (L >> 5) & 1, h2b = (L >> 4) & 1;
#pragma unroll 2
            for (int tk = 0; tk < 16; ++tk) {
                f32x4 a = {0.f, 0.f, 0.f, 0.f};
#pragma unroll
                for (int j = 0; j < 4; ++j) { const f32x4 h = *(const LAS f32x4*)(h2t + tk * D + 4 * L + 256 * j);
                    a += wreg[j * 4 + 0] * h.x; a += wreg[j * 4 + 1] * h.y; a += wreg[j * 4 + 2] * h.z; a += wreg[j * 4 + 3] * h.w; }
                const float m0 = hi ? a.z : a.x, o0 = hi ? a.x : a.z, m1 = hi ? a.w : a.y, o1 = hi ? a.y : a.w;
                const float v0 = m0 + __shfl_xor(o0, 32), v1 = m1 + __shfl_xor(o1, 32);
                float v = (h2b ? v1 : v0) + __shfl_xor(h2b ? v0 : v1, 16);
                v += __shfl_xor(v, 8); v += __shfl_xor(v, 4); v += __shfl_xor(v, 2); v += __shfl_xor(v, 1);
                if ((L & 15) == 0) lg[tk * NE + 4 * wv + 2 * hi + h2b] = v;
            }
        }
        __syncthreads();
        {
            const int e = L & 31, half = L >> 5, tl = 2 * wv + half, t = t0 + tl;
            float val = lg[tl * NE + e] + par[PAR_RB + e];
            int se[4]; float sv[4];
#pragma unroll
            for (int r = 0; r < 4; ++r) { float mx = val;
                mx = fmaxf(mx, __shfl_xor(mx, 16)); mx = fmaxf(mx, __shfl_xor(mx, 8)); mx = fmaxf(mx, __shfl_xor(mx, 4)); mx = fmaxf(mx, __shfl_xor(mx, 2)); mx = fmaxf(mx, __shfl_xor(mx, 1));
                const unsigned long long bal = __ballot(val == mx); const unsigned hm = half ? (unsigned)(bal >> 32) : (unsigned)bal; const int win = __ffs((int)hm) - 1;
                se[r] = win; sv[r] = mx; if (e == win) val = -3e38f; }
            const float e1 = __expf(sv[1] - sv[0]), e2 = __expf(sv[2] - sv[0]), e3 = __expf(sv[3] - sv[0]), inv = 1.f / (1.f + e1 + e2 + e3);
            if (e < 4) { const int ex = e == 0 ? se[0] : (e == 1 ? se[1] : (e == 2 ? se[2] : se[3]));
                const float wgt = (e == 0 ? 1.f : (e == 1 ? e1 : (e == 2 ? e2 : e3))) * inv;
                tok_e[t * 4 + e] = ex; tok_w[t * 4 + e] = wgt;
                const unsigned lp = dry ? 0u : __hip_atomic_fetch_add(hist + ex, 1u, __ATOMIC_RELAXED, __HIP_MEMORY_SCOPE_WORKGROUP);
                rec_e[tl * 4 + e] = ex; rec_lp[tl * 4 + e] = (int)lp; }
        }
        __syncthreads();
        if (F.tid < 32) { const unsigned h = hist[F.tid]; base[F.tid] = h ? __hip_atomic_fetch_add(gcnt + F.tid, h, RLX_AGENT) : 0u; }
        __syncthreads();
        if (!dry && F.tid < 64) { const int e_ = rec_e[F.tid], pos_ = (int)base[e_] + rec_lp[F.tid]; tok_pos[(t0 + (F.tid >> 2)) * 4 + (F.tid & 3)] = pos_;
            WSP(int, WS_ELIST)[e_ * ELCAP + pos_] = t0 + (F.tid >> 2); }
        if (F.tid < 32) hist[F.tid] = 0u;
        __syncthreads();
    }
}

__device__ __forceinline__ void moe_tables(Frame& F, int nct = 0, int brows = 0) {
    LAS int* cnt = (LAS int*)(F.lds + SCR_OFF); LAS int* off = cnt + 32; LAS int* tpre = off + 32;
    if (F.tid < NE) cnt[F.tid] = (int)__hip_atomic_load(F.ctl + CW_ECNT + F.tid, RLX_AGENT);
    __syncthreads();
    if (F.tid == 0) { int o = 0, tp = 0;
        for (int e = 0; e < NE; ++e) { const int c = cnt[e]; off[e] = o; tpre[e] = tp; o += c; tp += (c + 255) >> 8; }
        tpre[NE] = tp;
        LAS int* sg = cnt + MT_SEG; const int n = (tp + 31) >> 5; int ns = 0, pos = 0;
        for (int g = 0; g < n; ++g) { const int tg = (tp - 32 * g) < 32 ? (tp - 32 * g) : 32;
            sg[1 + ns] = pos; sg[1 + MT_MAXSEG + ns] = 0; sg[1 + 2 * MT_MAXSEG + ns] = g; ++ns; pos += 8 * tg; sg[1 + 3 * MT_MAXSEG + g] = pos;
            if (g >= MOE_LAG) { sg[1 + ns] = pos; sg[1 + MT_MAXSEG + ns] = 1; sg[1 + 2 * MT_MAXSEG + ns] = g - MOE_LAG; ++ns; pos += 4 * 32; } }
        for (int g = (n > MOE_LAG ? n - MOE_LAG : 0); g < n; ++g) { const int tg = (tp - 32 * g) < 32 ? (tp - 32 * g) : 32; sg[1 + ns] = pos; sg[1 + MT_MAXSEG + ns] = 1; sg[1 + 2 * MT_MAXSEG + ns] = g; ++ns; pos += 4 * tg; }
        sg[1 + ns] = pos; sg[0] = ns; }
    __syncthreads();
    if (nct > 0 && F.G == 256 && F.tid < MT_MAXU) {
        LAS int* ul = cnt + MT_ULIST + 8 * F.tid; const int i = F.tid, c = (int)blockIdx.x, xcd = c & 7, slot = c >> 3, rpx = 32 / nct;
        const int rtg = (i * 8 + xcd) * rpx + slot / nct, pn = slot % nct;
        if (rtg >= tpre[NE]) { ul[0] = -1; }
        else { int e = 0; for (int k = 1; k < NE; ++k) if (tpre[k] <= rtg) e = k;
            const int rt = rtg - tpre[e], nr = cnt[e] - rt * 256;
            ul[0] = off[e] + rt * 256; ul[1] = e * brows + pn * 256; ul[2] = rt; ul[3] = pn; ul[4] = e; ul[5] = nr > 256 ? 256 : nr; } }
    __syncthreads();
}
template <bool GA> struct MoeOrder {
    static constexpr bool GATHER = GA;
#if defined(T_ACQ)
    __device__ __forceinline__ void a_ready(const pg8::Unit&) const { if (!GA) { if (threadIdx.x < 64) { __builtin_amdgcn_fence(__ATOMIC_ACQUIRE, "agent"); asm volatile("s_waitcnt vmcnt(0)" ::: "memory"); } asm volatile("" ::: "memory"); __builtin_amdgcn_s_barrier(); asm volatile("" ::: "memory"); } }
#else
    __device__ __forceinline__ void a_ready(const pg8::Unit&) const {}
#endif
#if defined(T_DRAIN)
    __device__ __forceinline__ void done(const pg8::Unit&) const { if (GA) asm volatile("s_waitcnt vmcnt(0)" ::: "memory"); }
#else
    __device__ __forceinline__ void done(const pg8::Unit&) const {}
#endif
    const LAS int* tab; const int* elist; int nct, brows, G, c;
    __device__ __forceinline__ bool next(int i, pg8::Unit& u) const {
        if (G == 256) { if (i >= MT_MAXU) return false; const LAS int* ul = tab + MT_ULIST + 8 * i; const int a0 = ul[0]; if (a0 < 0) return false;
            u.arow = __builtin_amdgcn_readfirstlane(a0); u.brow = __builtin_amdgcn_readfirstlane(ul[1]); u.pm = __builtin_amdgcn_readfirstlane(ul[2]); u.pn = __builtin_amdgcn_readfirstlane(ul[3]);
            u.e = __builtin_amdgcn_readfirstlane(ul[4]); u.nrow = __builtin_amdgcn_readfirstlane(ul[5]); u.kind = 0; u.aux = 0; return true; }
        int rtg, pn;
        if (false) { const int xcd = c & 7, slot = c >> 3, rpx = 32 / nct;
            rtg = (i * 8 + xcd) * rpx + slot / nct; pn = slot % nct; if (rtg >= tab[64 + NE]) return false; }
        else { const int L = i * G + c, total = tab[64 + NE] * nct; if (L >= total) return false; rtg = L / nct; pn = L % nct; }
        int e = 0;
        for (int k = 1; k < NE; ++k) if (tab[64 + k] <= rtg) e = k;
        const int rt = rtg - tab[64 + e], cnt = tab[e], off = tab[32 + e];
        u.e = __builtin_amdgcn_readfirstlane(e); u.pm = __builtin_amdgcn_readfirstlane(rt); u.pn = pn; u.arow = __builtin_amdgcn_readfirstlane(off + rt * 256); u.brow = __builtin_amdgcn_readfirstlane(e * brows + pn * 256);
        const int nr = cnt - rt * 256; u.nrow = __builtin_amdgcn_readfirstlane(nr > 256 ? 256 : nr); u.kind = 0; u.aux = 0; return true;
    }
    __device__ __forceinline__ int arow_of(const pg8::Unit& u, int r) const { return r < u.nrow ? elist[u.e * ELCAP + u.pm * 256 + r] : 0; }
};
struct EpiGU { bf16* H1; const float* bg; const float* bu;
    __device__ __forceinline__ void operator()(const pg8::f32x4 (&acc)[2][2][4][2], const pg8::Unit& u, int wr, int wc, int fr, int fq) const {
        asm volatile("" : "+v"(fr), "+v"(fq));
        const int f0 = u.pn * 128 + wc * 32 + 8 * fq;
#pragma unroll
        for (int ai = 0; ai < 2; ++ai) {
            int fb = f0; asm volatile("" : "+v"(fb));
            const pg8::f32x4 g0 = *(const pg8::f32x4*)(bg + u.e * FF + fb), g1 = *(const pg8::f32x4*)(bg + u.e * FF + fb + 4);
            const pg8::f32x4 u0 = *(const pg8::f32x4*)(bu + u.e * FF + fb), u1 = *(const pg8::f32x4*)(bu + u.e * FF + fb + 4);
#pragma unroll
            for (int m = 0; m < 4; ++m) { const int r = ai * 128 + wr * 64 + m * 16 + fr;
                const pg8::f32x4 a0 = acc[ai][0][m][0] + g0, a1 = acc[ai][0][m][1] + g1, b0 = acc[ai][1][m][0] + u0, b1 = acc[ai][1][m][1] + u1;
                float gg[8] = {a0[0], a0[1], a0[2], a0[3], a1[0], a1[1], a1[2], a1[3]}, uu[8] = {b0[0], b0[1], b0[2], b0[3], b1[0], b1[1], b1[2], b1[3]}, o[8];
#pragma unroll
                for (int i = 0; i < 8; ++i) { const float g = fminf(gg[i], 7.f), up = fminf(fmaxf(uu[i], -7.f), 7.f); o[i] = g * sigmoidf_(1.702f * g) * (up + 1.f); }
                v4u w; w.x = pk2(o[0], o[1]); w.y = pk2(o[2], o[3]); w.z = pk2(o[4], o[5]); w.w = pk2(o[6], o[7]);
#ifdef T_SC1
                if (r < u.nrow) __builtin_amdgcn_raw_buffer_store_b128(w, __builtin_amdgcn_make_buffer_rsrc(H1, 0, (int)((size_t)T * TOPK * FF * 2), 0x00020000), (unsigned)((u.arow + r) * (FF * 2) + fb * 2), 0, 16); } }
#else
                if (r < u.nrow) *(v4u*)(H1 + (size_t)(u.arow + r) * FF + fb) = w; } }
#endif
    }
};
struct EpiDn { bf16* YB; const float* bd;
    __device__ __forceinline__ void operator()(const pg8::f32x4 (&acc)[2][2][4][2], const pg8::Unit& u, int wr, int wc, int fr, int fq) const {
        const int c0 = u.pn * 256 + wc * 32 + 8 * fq;
#pragma unroll
        for (int bj = 0; bj < 2; ++bj) { const pg8::f32x4 d0 = *(const pg8::f32x4*)(bd + u.e * D + c0 + bj * 128), d1 = *(const pg8::f32x4*)(bd + u.e * D + c0 + bj * 128 + 4);
#pragma unroll
            for (int ai = 0; ai < 2; ++ai)
#pragma unroll
                for (int m = 0; m < 4; ++m) { const int r = ai * 128 + wr * 64 + m * 16 + fr;
                    const pg8::f32x4 a0 = acc[ai][bj][m][0] + d0, a1 = acc[ai][bj][m][1] + d1;
                    v4u w; w.x = pk2(a0[0], a0[1]); w.y = pk2(a0[2], a0[3]); w.z = pk2(a1[0], a1[1]); w.w = pk2(a1[2], a1[3]);
                    if (r < u.nrow) *(v4u*)(YB + (size_t)(u.arow + r) * D + c0 + bj * 128) = w; } }
    }
};
constexpr float YB_SCALE = 16.f;
struct EpiGU8 { unsigned char* H1; const float* bg; const float* bu; const float* wscp;
    static constexpr bool BIAS_LDS = true;
    __device__ __forceinline__ void stage_bias(PG8_LAS unsigned char* dst, const pg8::Unit& u, int wid, int lane) const {
        if (wid < 4) { const float* src = (wid < 2 ? bg : bu) + u.e * FF + u.pn * 128 + (wid & 1) * 64 + lane;
            __builtin_amdgcn_global_load_lds((const unsigned*)src, (PG8_LAS unsigned*)(dst + wid * 256), 4, 0, 0); } }
    __device__ __forceinline__ void operator()(const pg8::f32x4 (&acc)[2][2][4][2], const pg8::Unit& u, int wr, int wc, int fr, int fq, const PG8_LAS float* bl) const {
        asm volatile("" : "+v"(fr), "+v"(fq));
        const int fl = wc * 32 + 8 * fq, f0 = u.pn * 128 + fl; const float sr = 0.125f / *wscp;
        const pg8::f32x4 g0 = *(const PG8_LAS pg8::f32x4*)(bl + fl), g1 = *(const PG8_LAS pg8::f32x4*)(bl + fl + 4), u0 = *(const PG8_LAS pg8::f32x4*)(bl + 128 + fl), u1 = *(const PG8_LAS pg8::f32x4*)(bl + 128 + fl + 4);
#pragma unroll
        for (int ai = 0; ai < 2; ++ai)
#pragma unroll
            for (int m = 0; m < 4; ++m) { const int r = ai * 128 + wr * 64 + m * 16 + fr;
                const pg8::f32x4 a0 = acc[ai][0][m][0] * sr + g0, a1 = acc[ai][0][m][1] * sr + g1, b0 = acc[ai][1][m][0] * sr + u0, b1 = acc[ai][1][m][1] * sr + u1;
                float gg[8] = {a0[0], a0[1], a0[2], a0[3], a1[0], a1[1], a1[2], a1[3]}, uu[8] = {b0[0], b0[1], b0[2], b0[3], b1[0], b1[1], b1[2], b1[3]}, o[8];
#pragma unroll
                for (int i = 0; i < 8; ++i) { const float g = fminf(gg[i], 7.f), up = fminf(fmaxf(uu[i], -7.f), 7.f); o[i] = 8.f * (g * sigmoidf_(1.702f * g) * (up + 1.f)); }
                v2u w; w.x = pk4_fp8(o[0], o[1], o[2], o[3]); w.y = pk4_fp8(o[4], o[5], o[6], o[7]);
                if (r < u.nrow) *(v2u*)(H1 + (size_t)(u.arow + r) * FF + f0) = w; }
    }
};
struct EpiDn8 { bf16* YB; const float* bd; const float* wscp;
    static constexpr bool BIAS_LDS = true;
    __device__ __forceinline__ void stage_bias(PG8_LAS unsigned char* dst, const pg8::Unit& u, int wid, int lane) const {
        if (wid < 4) { const float* src = bd + u.e * D + u.pn * 256 + wid * 64 + lane;
            __builtin_amdgcn_global_load_lds((const unsigned*)src, (PG8_LAS unsigned*)(dst + wid * 256), 4, 0, 0); } }
    __device__ __forceinline__ void operator()(const pg8::f32x4 (&acc)[2][2][4][2], const pg8::Unit& u, int wr, int wc, int fr, int fq, const PG8_LAS float* bl) const {
        const int cl = wc * 32 + 8 * fq, c0 = u.pn * 256 + cl; const float sc = 0.125f / *wscp;
#pragma unroll
        for (int bj = 0; bj < 2; ++bj) { const pg8::f32x4 d0 = *(const PG8_LAS pg8::f32x4*)(bl + cl + bj * 128), d1 = *(const PG8_LAS pg8::f32x4*)(bl + cl + bj * 128 + 4);
#pragma unroll
            for (int ai = 0; ai < 2; ++ai)
#pragma unroll
                for (int m = 0; m < 4; ++m) { const int r = ai * 128 + wr * 64 + m * 16 + fr;
                    const pg8::f32x4 a0 = (acc[ai][bj][m][0] * sc + d0) * YB_SCALE, a1 = (acc[ai][bj][m][1] * sc + d1) * YB_SCALE;
                    v2u w; w.x = pk4_fp8(a0[0], a0[1], a0[2], a0[3]); w.y = pk4_fp8(a1[0], a1[1], a1[2], a1[3]);
                    if (r < u.nrow) *(v2u*)((unsigned char*)YB + (size_t)(u.arow + r) * D + c0 + bj * 128) = w; } }
    }
};
constexpr int CW_RDY = 8448;
constexpr int H2ROW0 = (int)(WS_H2 / 2048), H1ROW0 = (int)(WS_H1 / 2048), DN_BROW0 = (int)((WS_WDN_T - WS_WGU_T) / 2048);
struct MoeFused {
    static constexpr bool GATHER = true;
    const LAS int* tab; const int* elist; gu32* ctl; int G, c, base;
    __device__ __forceinline__ bool next(int i, pg8::Unit& u) const {
        const LAS int* sg = tab + MT_SEG; const int ns = sg[0], L = (base + i) * G + c; if (L >= sg[1 + ns]) return false;
        int s = 0; for (int k = 1; k < ns; ++k) if (sg[1 + k] <= L) s = k;
        if (i > 0 && sg[1 + MT_MAXSEG + s] == 1 && L - sg[1 + 3 * MT_MAXSEG + sg[1 + 2 * MT_MAXSEG + s]] < G) return false;
        const int kind = sg[1 + MT_MAXSEG + s], g = sg[1 + 2 * MT_MAXSEG + s], ui = L - sg[1 + s], TT = tab[64 + NE], tg = (TT - 32 * g) < 32 ? (TT - 32 * g) : 32;
        int rt, pn;
        if (kind == 0) { if (tg == 32) { const int xcd = ui & 7, slot = ui >> 3; rt = xcd * 4 + (slot >> 3); pn = slot & 7; } else { rt = ui >> 3; pn = ui & 7; } }
        else { if (tg == 32) { const int xcd = ui & 7, slot = ui >> 3; rt = xcd * 4 + (slot >> 2); pn = slot & 3; } else { rt = ui >> 2; pn = ui & 3; } }
        const int rtg = 32 * g + rt; int e = 0;
        for (int k = 1; k < NE; ++k) if (tab[64 + k] <= rtg) e = k;
        const int rte = rtg - tab[64 + e], cnt = tab[e], off = tab[32 + e], nr = cnt - rte * 256;
        u.e = __builtin_amdgcn_readfirstlane(e); u.pm = __builtin_amdgcn_readfirstlane(rte); u.pn = __builtin_amdgcn_readfirstlane(pn); u.kind = __builtin_amdgcn_readfirstlane(kind); u.aux = __builtin_amdgcn_readfirstlane(rtg);
        u.arow = __builtin_amdgcn_readfirstlane(off + rte * 256); u.nrow = __builtin_amdgcn_readfirstlane(nr > 256 ? 256 : nr);
        u.brow = __builtin_amdgcn_readfirstlane(kind == 0 ? e * 2048 + pn * 256 : DN_BROW0 + e * 1024 + pn * 256); return true;
    }
    __device__ __forceinline__ int arow_of(const pg8::Unit& u, int r) const { return u.kind == 0 ? H2ROW0 + (r < u.nrow ? elist[u.e * ELCAP + u.pm * 256 + r] : 0) : H1ROW0 + u.arow + (r < u.nrow ? r : 0); }
    __device__ __forceinline__ void a_ready(const pg8::Unit& u) const {
        if (u.kind != 1) return;
        if (threadIdx.x < 64) {
            gu32* w = ctl + CW_RDY + u.aux; const unsigned long long t0 = __builtin_amdgcn_s_memrealtime();
            while ((unsigned)__builtin_amdgcn_readfirstlane(__hip_atomic_load(w, RLX_AGENT)) < 64u) {
                if (__builtin_amdgcn_s_memrealtime() - t0 > 2000000ull) { if (threadIdx.x == 0) __hip_atomic_store(ctl + CW_TMO, 1u, RLX_AGENT); break; }
                __builtin_amdgcn_s_sleep(2); }
#ifdef MOE_DELAY
            { const unsigned long long t1 = __builtin_amdgcn_s_memrealtime(); while (__builtin_amdgcn_s_memrealtime() - t1 < 2000ull) __builtin_amdgcn_s_sleep(8); }
#endif
            __builtin_amdgcn_fence(__ATOMIC_ACQUIRE, "agent");
            asm volatile("s_waitcnt vmcnt(0)" ::: "memory");
        }
        asm volatile("" ::: "memory"); __builtin_amdgcn_s_barrier(); asm volatile("" ::: "memory");
    }
    __device__ __forceinline__ void done(const pg8::Unit& u) const {
        if (u.kind != 0) return;
#ifndef DIAG_NODRAIN
        asm volatile("s_waitcnt vmcnt(0)" ::: "memory");
#endif
#if defined(MOE_REL)
        __builtin_amdgcn_fence(__ATOMIC_RELEASE, "agent"); asm volatile("s_waitcnt vmcnt(0)" ::: "memory");
#endif
        if ((threadIdx.x & 63) == 0) __hip_atomic_fetch_add(ctl + CW_RDY + u.aux, 1u, RLX_AGENT);
    }
};
struct EpiMoe { bf16* H1; bf16* YB; const float* bg; const float* bu; const float* bd;
    __device__ __forceinline__ void operator()(const pg8::f32x4 (&acc)[2][2][4][2], const pg8::Unit& u, int wr, int wc, int fr, int fq) const {
        asm volatile("" : "+v"(fr), "+v"(fq));
        if (u.kind == 0) {
            const int f0 = u.pn * 128 + wc * 32 + 8 * fq;
            const __amdgpu_buffer_rsrc_t h1rs = __builtin_amdgcn_make_buffer_rsrc(H1, 0, (int)((size_t)T * TOPK * FF * 2), 0x00020000);
#pragma unroll
            for (int ai = 0; ai < 2; ++ai) {
                int fb = f0; asm volatile("" : "+v"(fb));
                const pg8::f32x4 g0 = *(const pg8::f32x4*)(bg + u.e * FF + fb), g1 = *(const pg8::f32x4*)(bg + u.e * FF + fb + 4);
                const pg8::f32x4 u0 = *(const pg8::f32x4*)(bu + u.e * FF + fb), u1 = *(const pg8::f32x4*)(bu + u.e * FF + fb + 4);
#pragma unroll
                for (int m = 0; m < 4; ++m) { const int r = ai * 128 + wr * 64 + m * 16 + fr;
                    const pg8::f32x4 a0 = acc[ai][0][m][0] + g0, a1 = acc[ai][0][m][1] + g1, b0 = acc[ai][1][m][0] + u0, b1 = acc[ai][1][m][1] + u1;
                    float gg[8] = {a0[0], a0[1], a0[2], a0[3], a1[0], a1[1], a1[2], a1[3]}, uu[8] = {b0[0], b0[1], b0[2], b0[3], b1[0], b1[1], b1[2], b1[3]}, o[8];
#pragma unroll
                    for (int i = 0; i < 8; ++i) { const float g = fminf(gg[i], 7.f), up = fminf(fmaxf(uu[i], -7.f), 7.f); o[i] = g * sigmoidf_(1.702f * g) * (up + 1.f); }
#ifdef MOE_PLAIN
                    if (r < u.nrow) { v4u w; w.x = pk2(o[0], o[1]); w.y = pk2(o[2], o[3]); w.z = pk2(o[4], o[5]); w.w = pk2(o[6], o[7]); *(GAS v4u*)(H1 + (size_t)(u.arow + r) * FF + fb) = w; } } }
#else
                    if (r < u.nrow) { v4u w; w.x = pk2(o[0], o[1]); w.y = pk2(o[2], o[3]); w.z = pk2(o[4], o[5]); w.w = pk2(o[6], o[7]);
                        __builtin_amdgcn_raw_buffer_store_b128(w, h1rs, (unsigned)((u.arow + r) * (FF * 2) + fb * 2), 0, 16); } } }
#endif
        } else {
            const int c0 = u.pn * 256 + wc * 32 + 8 * fq;
#pragma unroll
            for (int bj = 0; bj < 2; ++bj) { const pg8::f32x4 d0 = *(const pg8::f32x4*)(bd + u.e * D + c0 + bj * 128), d1 = *(const pg8::f32x4*)(bd + u.e * D + c0 + bj * 128 + 4);
#pragma unroll
                for (int ai = 0; ai < 2; ++ai)
#pragma unroll
                    for (int m = 0; m < 4; ++m) { const int r = ai * 128 + wr * 64 + m * 16 + fr;
                        const pg8::f32x4 a0 = acc[ai][bj][m][0] + d0, a1 = acc[ai][bj][m][1] + d1;
                        v4u w; w.x = pk2(a0[0], a0[1]); w.y = pk2(a0[2], a0[3]); w.z = pk2(a1[0], a1[1]); w.w = pk2(a1[2], a1[3]);
                        if (r < u.nrow) *(GAS v4u*)(YB + (size_t)(u.arow + r) * D + c0 + bj * 128) = w; } }
        }
    }
};
__device__ __forceinline__ void phase_final(Frame& F, bool dry = false) {
    moe_tables(F);
    const LAS int* off = (const LAS int*)(F.lds + SCR_OFF) + 32;
    LAS float* gtf = (LAS float*)(F.lds);
    const float* adaf = WSP(float, WS_ADAF);
    for (int i = F.tid; i < 2 * D; i += NWAVES * 64) { const int b = i >> 10, k = i & (D - 1); gtf[i] = adaf[b * 6 * D + 5 * D + k] * WSP(float, WS_PAR)[PAR_FPOST + k]; }
    __syncthreads();
    const int gw = F.vcu * NWAVES + F.wave, NGW = F.G * NWAVES, L = F.lane;
    const int* tok_e = WSP(int, WS_ROUTE); const float* tok_w = (const float*)(tok_e + T * 4); const int* tok_pos = tok_e + 2 * T * 4;
    const bf16* YB = WSP(bf16, WS_YB);
    for (int t = gw * 2; t < T; t += NGW * 2) { const int b = t >> 13;
        int row_l = 0; float w_l = 0.f;
        if (L < 8) { const int idx = (t + (L >> 2)) * 4 + (L & 3); row_l = off[tok_e[idx]] + tok_pos[idx]; w_l = tok_w[idx]; }
        unsigned yv[2][4][4]; f32x4 x1v[2][4]; float wk[2][4];
#pragma unroll
        for (int q = 0; q < 2; ++q) {
#pragma unroll
            for (int k = 0; k < 4; ++k) { const int row = __shfl(row_l, q * 4 + k); wk[q][k] = __shfl(w_l, q * 4 + k);
                const GAS unsigned* yr = (const GAS unsigned*)((const unsigned char*)YB + (size_t)row * D) + L;
#pragma unroll
                for (int j = 0; j < 4; ++j) yv[q][k][j] = __builtin_nontemporal_load(yr + 64 * j);
#ifdef DRY14_NOYB
                if (dry) { _Pragma("unroll") for (int j = 0; j < 4; ++j) yv[q][k][j] = 0x38383838u; }
#endif
            }
            const GAS v2u* xr = (const GAS v2u*)(WSP(bf16, WS_X1B) + (size_t)(t + q) * D) + L;
#pragma unroll
            for (int j = 0; j < 4; ++j) { const v2u xw = __builtin_nontemporal_load(xr + 64 * j); x1v[q][j] = (f32x4){bflo(xw.x), bfhi(xw.x), bflo(xw.y), bfhi(xw.y)}; } }
#pragma unroll
        for (int q = 0; q < 2; ++q) {
            f32x4 y[4];
#pragma unroll
            for (int j = 0; j < 4; ++j) y[j] = (f32x4){0.f, 0.f, 0.f, 0.f};
#pragma unroll
            for (int k = 0; k < 4; ++k)
#pragma unroll
                for (int j = 0; j < 4; ++j) { const unsigned x = yv[q][k][j]; const float w = wk[q][k] * (1.f / YB_SCALE);
                    y[j].x += w * __builtin_amdgcn_cvt_f32_fp8((int)x, 0); y[j].y += w * __builtin_amdgcn_cvt_f32_fp8((int)x, 1); y[j].z += w * __builtin_amdgcn_cvt_f32_fp8((int)x, 2); y[j].w += w * __builtin_amdgcn_cvt_f32_fp8((int)x, 3); }
            float s = 0.f;
#pragma unroll
            for (int j = 0; j < 4; ++j) s += (y[j].x * y[j].x + y[j].y * y[j].y) + (y[j].z * y[j].z + y[j].w * y[j].w);
            const float r = 1.f / sqrtf(wave_sum(s) * (1.f / D) + NORM_EPS);
            GAS f32x4* wrow = dry ? (GAS f32x4*)(WSP(float, WS_WGU_T) + (size_t)(t + q) * D) + L : (GAS f32x4*)(F.out + (size_t)(t + q) * D) + L;
#pragma unroll
            for (int j = 0; j < 4; ++j) { const f32x4 g = *(const LAS f32x4*)(gtf + b * D + 4 * L + 256 * j); __builtin_nontemporal_store(x1v[q][j] + g * (y[j] * r), wrow + 64 * j); }
        }
    }
}
__device__ __forceinline__ bool opaque_ws(Frame& F) { asm volatile("" : "+s"(F.ws)); return true; }
#ifndef MK_N_LAUNCHES
#define MK_N_LAUNCHES 1
#endif
constexpr int N_PHASES = 15;
struct Args { const float* in[30]; float* out; unsigned char* ws; int ph_lo, ph_hi; };
__global__ void __launch_bounds__(NWAVES * 64, 2) mega_fwd(Args args) {
    extern __shared__ __attribute__((aligned(16))) unsigned char lds[];
    Frame F;
    F.lds = (LAS unsigned char*)lds;
    F.MISC = (volatile LAS unsigned*)(F.lds + MISC_OFF);
    F.tid = threadIdx.x; F.lane = F.tid & 63; F.wave = __builtin_amdgcn_readfirstlane(F.tid >> 6);
    F.G = gridDim.x; { const int bx = blockIdx.x; F.vcu = (F.G % 8 == 0) ? (bx % 8) * (F.G / 8) + bx / 8 : bx; }
    F.ws = args.ws; F.ctl = (gu32*)(args.ws + WS_CTL); F.out = args.out;
#pragma unroll
    for (int i = 0; i < 30; ++i) F.in[i] = args.in[i];
    for (int u = F.tid; u < (LDS_BYTES - LDSCTL_OFF) / 4; u += NWAVES * 64) ((LAS unsigned*)(F.lds + LDSCTL_OFF))[u] = 0u;
    __syncthreads();
    XcdBarrier bar; bar.bar = (unsigned*)(F.ctl + CW_BAR); bar.x = 0; bar.st = nullptr;
    if (MK_N_LAUNCHES == 1) bar = xcd_barrier_post((unsigned*)(F.ctl + CW_BAR), F.MISC + 8);
    const int lo = args.ph_lo, hi = args.ph_hi;
#ifndef PHMASK
#define PHMASK 0x7fff
#endif
#define IN(k) (((PHMASK >> (k)) & 1) && lo <= (k) && (k) < hi)
#ifdef DBG_A
#define STAMP(k) do { if (blockIdx.x == 0 && F.tid == 0) ((unsigned long long*)(F.ctl + 2048))[k] = __builtin_amdgcn_s_memrealtime(); } while (0)
#else
#define STAMP(k) do {} while (0)
#endif
#ifndef REP_PHASE
#define REP_PHASE -1
#endif
#define REPL(k) for (int rep_ = 0; rep_ < (REP_PHASE == (k) ? 2 : 1); ++rep_) if (opaque_ws(F))
#ifdef DBL_BAR
#define SEAM(k) do { if (IN(k)) { xcd_barrier(bar); xcd_barrier(bar); } STAMP((k) + 1); } while (0)
#else
#define SEAM(k) do { if (IN(k)) xcd_barrier(bar); STAMP((k) + 1); } while (0)
#endif
    PG8_LAS unsigned char* ring = F.lds + RING_OFF;
    const int bx = (int)blockIdx.x;

    STAMP(0);
    if (IN(0)) REPL(0) { phase0(F); } SEAM(0);
    if (IN(1)) REPL(1) { phase1(F); } SEAM(1);
    if (IN(2)) REPL(2) {
#ifdef G1_MIX
        {
            pg8::Gemm g{WSP(bf16, WS_XN8), WSP(bf16, WS_WIN8), D / 2, D / 2, D / 2}; pg8::ColSubsetOrder S; S.d.init(T, 12 * 256, F.G, bx); S.base = 0; S.split = 2; S.skip = 4;
            EpiG1 E{WSP(bf16, WS_UA), WSP(bf16, WS_Q), WSP(bf16, WS_K), WSP(bf16, WS_V), WSP(bf16, WS_VT), WSP(bf16, WS_GS), WSP(bf16, WS_GA),
                    WSP(float, WS_ROPE), WSP(float, WS_ROPE) + (size_t)T * 32, (float*)(F.ctl + CW_KM), WSP(float, WS_PAR) + PAR_WSC1, true};
            pg8::gemm_phase<EpiG1, pg8::ColSubsetOrder, true>(ring, g, S, E); }
        {
            pg8::Gemm g{WSP(bf16, WS_XN), WSP(bf16, WS_WIN_T), D, D, D}; pg8::ColSubsetOrder S; S.d.init(T, 4 * 256, F.G, bx); S.base = 2; S.split = 4; S.skip = 0;
            EpiG1 E{WSP(bf16, WS_UA), WSP(bf16, WS_Q), WSP(bf16, WS_K), WSP(bf16, WS_V), WSP(bf16, WS_VT), WSP(bf16, WS_GS), WSP(bf16, WS_GA),
                    WSP(float, WS_ROPE), WSP(float, WS_ROPE) + (size_t)T * 32, (float*)(F.ctl + CW_KM), WSP(float, WS_PAR) + PAR_WSC1, false};
            pg8::gemm_phase<EpiG1, pg8::ColSubsetOrder, false>(ring, g, S, E); }
#else
#ifdef G1_F8
        pg8::Gemm g{WSP(bf16, WS_XN), WSP(bf16, WS_WIN_T), D / 2, D / 2, D / 2}; pg8::DenseOrder S; S.init(T, INW, F.G, bx);
#else
        pg8::Gemm g{WSP(bf16, WS_XN), WSP(bf16, WS_WIN_T), D, D, D}; pg8::DenseOrder S; S.init(T, INW, F.G, bx);
#endif
        EpiG1 E{WSP(bf16, WS_UA), WSP(bf16, WS_Q), WSP(bf16, WS_K), WSP(bf16, WS_V), WSP(bf16, WS_VT), WSP(bf16, WS_GS), WSP(bf16, WS_GA),
                WSP(float, WS_ROPE), WSP(float, WS_ROPE) + (size_t)T * 32, (float*)(F.ctl + CW_KM), WSP(float, WS_PAR) + PAR_WSC1,
#ifdef G1_F8
                true};
#else
                false};
#endif
#ifdef G1_F8
        pg8::gemm_phase<EpiG1, pg8::DenseOrder, true>(ring, g, S, E);
#else
        pg8::gemm_phase(ring, g, S, E);
#endif
#endif
        s5_fill_kt(F);
    } SEAM(2);
    if (IN(3)) REPL(3) {
        pg8::Gemm g{WSP(bf16, WS_UA), WSP(bf16, WS_S5M1), 384, 256, 256}; S5Order S{F.G, bx}; EpiS5A E{WSP(float, WS_S5E)};
        pg8::gemm_phase(ring, g, S, E);
        s5_fill_wc(F);
        attn_gate(F);
#ifdef MOE_F8
        moe_convert_idle(F, MOE_ITEMS_P0, MOE_ITEMS_P3);
#endif
    } SEAM(3);
    if (IN(4)) REPL(4) { attn_items(F); s5_carry(F); } SEAM(4);
    if (IN(5)) REPL(5) {
        pg8::Gemm g{WSP(bf16, WS_UA), WSP(bf16, WS_S5WC), 384, 384, 384}; S5Order S{F.G, bx}; EpiS5C E{WSP(bf16, WS_YG)};
        pg8::gemm_phase(ring, g, S, E);
        attn_combine(F);
#ifdef MOE_F8
        moe_convert_idle(F, MOE_ITEMS_P0 + MOE_ITEMS_P3, MOE_ITEMS_P5);
#endif
    } SEAM(5);
    if (IN(6)) REPL(6) {
        pg8::Gemm g{WSP(bf16, WS_YG), WSP(bf16, WS_WGLU_T), SW, SW, SW}; pg8::DenseOrder S; S.init(T, SW, F.G, bx);
        EpiEw<0> E{WSP(bf16, WS_Y2), WSP(bf16, WS_YG), nullptr, nullptr, SW};
        pg8::gemm_phase(ring, g, S, E);
#ifdef MOE_F8
        moe_convert_idle(F, MOE_ITEMS_P0 + MOE_ITEMS_P3 + MOE_ITEMS_P5, MOE_ITEMS_P6);
#endif
    } SEAM(6);
    if (IN(7)) REPL(7) {
        pg8::Gemm g{WSP(bf16, WS_Y2), WSP(bf16, WS_WSB_T), SW, SW, SW}; pg8::DenseOrder S; S.init(T, D, F.G, bx);
        EpiEw<1> E{WSP(bf16, WS_M1), WSP(bf16, WS_GS), nullptr, nullptr, D};
        pg8::gemm_phase(ring, g, S, E);
    }
    if (IN(7)) { asm volatile("s_waitcnt vmcnt(0)" ::: "memory"); __syncthreads(); if (F.tid < 64) { __builtin_amdgcn_fence(__ATOMIC_ACQUIRE, "agent"); asm volatile("s_waitcnt vmcnt(0)" ::: "memory"); } __syncthreads(); STAMP(8); }
    if (IN(8)) REPL(8) {
        pg8::Gemm g{WSP(bf16, WS_YA), WSP(bf16, WS_WAB_T), AW, AW, AW}; pg8::DenseOrder S; S.init(T, D, F.G, bx);
        EpiEw<2> E{WSP(bf16, WS_XN), WSP(bf16, WS_GA), WSP(bf16, WS_M1), nullptr, D};
        pg8::gemm_phase(ring, g, S, E);
    } SEAM(8);
    if (IN(9)) REPL(9) {
        pg8::Gemm g{WSP(bf16, WS_XN), WSP(bf16, WS_WOUT_T), D, D, D}; pg8::DenseOrder S; S.init(T, D, F.G, bx);
        EpiEw<4> E{WSP(bf16, WS_MIX), nullptr, nullptr, nullptr, D};
        pg8::gemm_phase(ring, g, S, E);
    } SEAM(9);
    if (IN(10)) REPL(10) { phase_rows(F, REP_PHASE == 10 && rep_ == 0); } SEAM(10);
#ifndef MOE_FUSED
#ifdef MOE_F8
    if (IN(12)) REPL(12) {
        moe_tables(F, 8, 2048);
        pg8::Gemm g{WSP(bf16, WS_H2), WSP(bf16, WS_WGU_T), D / 2, D / 2, D / 2}; MoeOrder<true> S{(const LAS int*)(F.lds + SCR_OFF), WSP(int, WS_ELIST), 8, 2048, F.G, bx};
        EpiGU8 E{WSP(unsigned char, WS_H1), WSP(float, WS_PAR) + PAR_BG, WSP(float, WS_PAR) + PAR_BU, WSP(float, WS_PAR) + PAR_WSC};
        pg8::gemm_phase<EpiGU8, MoeOrder<true>, true>(ring, g, S, E);
    } SEAM(12);
    if (IN(13)) REPL(13) {
        moe_tables(F, 4, 1024);
        pg8::Gemm g{WSP(bf16, WS_H1), WSP(bf16, WS_WDN_T), FF / 2, FF / 2, FF / 2}; MoeOrder<false> S{(const LAS int*)(F.lds + SCR_OFF), nullptr, 4, 1024, F.G, bx};
        EpiDn8 E{WSP(bf16, WS_YB), WSP(float, WS_PAR) + PAR_BD, WSP(float, WS_PAR) + PAR_WSC};
        pg8::gemm_phase<EpiDn8, MoeOrder<false>, true>(ring, g, S, E);
    } SEAM(13);
#else
    if (IN(12)) REPL(12) {
        moe_tables(F, 8, 2048);
        pg8::Gemm g{WSP(bf16, WS_H2), WSP(bf16, WS_WGU_T), D, D, D}; MoeOrder<true> S{(const LAS int*)(F.lds + SCR_OFF), WSP(int, WS_ELIST), 8, 2048, F.G, bx};
        EpiGU E{WSP(bf16, WS_H1), WSP(float, WS_PAR) + PAR_BG, WSP(float, WS_PAR) + PAR_BU};
        pg8::gemm_phase(ring, g, S, E);
    } SEAM(12);
    if (IN(13)) REPL(13) {
        moe_tables(F, 4, 1024);
        pg8::Gemm g{WSP(bf16, WS_H1), WSP(bf16, WS_WDN_T), FF, FF, FF}; MoeOrder<false> S{(const LAS int*)(F.lds + SCR_OFF), nullptr, 4, 1024, F.G, bx};
        EpiDn E{WSP(bf16, WS_YB), WSP(float, WS_PAR) + PAR_BD};
        pg8::gemm_phase(ring, g, S, E);
    } SEAM(13);
#endif
#else
    if (IN(12)) REPL(12) {
        moe_tables(F);
        pg8::Gemm g{(const bf16*)F.ws, WSP(bf16, WS_WGU_T), D, D, D};
        EpiMoe E{WSP(bf16, WS_H1), WSP(bf16, WS_YB), WSP(float, WS_PAR) + PAR_BG, WSP(float, WS_PAR) + PAR_BU, WSP(float, WS_PAR) + PAR_BD};
        for (int base = 0;;) { MoeFused S{(const LAS int*)(F.lds + SCR_OFF), WSP(int, WS_ELIST), F.ctl, F.G, bx, base};
            const int nd = pg8::gemm_phase(ring, g, S, E); if (nd == 0) break; base += nd; }
    } SEAM(12);
#endif
    if (IN(14)) REPL(14) { phase_final(F, REP_PHASE == 14 && rep_ == 0); }
#undef IN
#undef SEAM
}

extern "C" void kernel_launch(void* const* d_in, const int* in_sizes, int n_in, void* d_out, int out_size, void* d_ws, size_t ws_size, hipStream_t stream) {
    static int grid = 0;
    if (grid == 0) {
        if (n_in != 30 || in_sizes[0] != T * D || out_size != T * D || ws_size < WS_END) { fprintf(stderr, "kernel_launch: unexpected shapes (n_in %d, in0 %d, out %d, ws %zu)\n", n_in, n_in > 0 ? in_sizes[0] : -1, out_size, ws_size); grid = -1; return; }
        int dev = 0, cus = 0, per_cu = 0;
        if (hipGetDevice(&dev) != hipSuccess || hipDeviceGetAttribute(&cus, hipDeviceAttributeMultiprocessorCount, dev) != hipSuccess) { grid = -1; return; }
        if (hipFuncSetAttribute((const void*)mega_fwd, hipFuncAttributeMaxDynamicSharedMemorySize, LDS_BYTES) != hipSuccess) { fprintf(stderr, "kernel_launch: hipFuncSetAttribute failed\n"); grid = -1; return; }
        if (hipOccupancyMaxActiveBlocksPerMultiprocessor(&per_cu, (const void*)mega_fwd, NWAVES * 64, LDS_BYTES) != hipSuccess || per_cu < 1) { fprintf(stderr, "kernel_launch: occupancy query says %d\n", per_cu); }
        (void)hipGetLastError();
        grid = cus;
    }
    if (grid < 0) return;
    (void)hipMemsetAsync((char*)d_ws + WS_CTL, 0, CTL_ZERO_USED, stream);
    Args a{};
    for (int i = 0; i < 30; ++i) a.in[i] = (const float*)d_in[i];
    a.out = (float*)d_out; a.ws = (unsigned char*)d_ws;
#ifndef PLAIN_LAUNCH
    if (MK_N_LAUNCHES == 1) { a.ph_lo = 0; a.ph_hi = N_PHASES; void* kargs[] = {(void*)&a};
        const hipError_t e = hipLaunchCooperativeKernel((const void*)mega_fwd, dim3(grid), dim3(NWAVES * 64), kargs, LDS_BYTES, stream);
        if (e != hipSuccess) fprintf(stderr, "kernel_launch: cooperative launch failed: %s\n", hipGetErrorString(e)); }
#else
    if (MK_N_LAUNCHES == 1) { a.ph_lo = 0; a.ph_hi = N_PHASES; hipLaunchKernelGGL(mega_fwd, dim3(grid), dim3(NWAVES * 64), LDS_BYTES, stream, a); }
#endif
    else for (int p = 0; p < N_PHASES; ++p) { a.ph_lo = p; a.ph_hi = p + 1; hipLaunchKernelGGL(mega_fwd, dim3(grid), dim3(NWAVES * 64), LDS_BYTES, stream, a); }
}
```

```cpp
#include <hip/hip_runtime.h>
#include <cstdio>
#include <cstdint>
#define MK_N_LAUNCHES 1
namespace pg8 {
#define PG8_LAS __attribute__((address_space(3)))
typedef unsigned short bf16_t;
typedef short bf16x8 __attribute__((ext_vector_type(8)));
typedef float f32x4 __attribute__((ext_vector_type(4)));
typedef unsigned u32x4 __attribute__((ext_vector_type(4)));
typedef unsigned u32x2 __attribute__((ext_vector_type(2)));
typedef int v4i32 __attribute__((ext_vector_type(4)));
typedef int v8i32 __attribute__((ext_vector_type(8)));
constexpr int BIAS_LDS_OFF = 156 * 1024;
constexpr int BM = 256, BK = 64, HALF = 128, HTB = HALF * BK * 2  , STAGE_BYTES = 8 * HTB, NXCD = 8, WGM = 8;

__host__ __device__ __forceinline__ int lds_byte(int r, int c) { const int st = (r >> 4) * 2 + (c >> 5), rr = r & 15, cc = c & 31, ob = rr * 64 + cc * 2; return st * 1024 + (ob ^ (((ob >> 9) & 1) << 5)); }
__host__ __device__ __forceinline__ void stage_rc(int b, int& R, int& C) { const int st = b / 1024, sb = b % 1024, swz = sb ^ (((sb >> 9) & 1) << 5); R = (st >> 1) * 16 + swz / 64; C = (st & 1) * 32 + (swz % 64) / 2; }

struct Unit { int arow, brow, pm, pn, e, nrow, kind, aux; };
struct Gemm { const bf16_t* A; const bf16_t* Bt; int lda, ldb, K; };

struct DenseOrder {
    static constexpr bool GATHER = false;
    __device__ __forceinline__ void a_ready(const Unit&) const {}
    __device__ __forceinline__ void done(const Unit&) const {}
    int nM, nN, nwg, G, c;
    __device__ __forceinline__ void init(int M, int N, int G_, int c_) { nM = M / BM; nN = N / BM; nwg = nM * nN; G = G_; c = c_; }
    __device__ __forceinline__ bool next(int i, Unit& u) const {
        const long L = (long)i * G + c; if (L >= nwg) return false;
        int wgid = (int)L; { const int q = nwg / NXCD, r = nwg % NXCD, xcd = wgid % NXCD, off = wgid / NXCD; wgid = (xcd < r ? xcd * (q + 1) : r * (q + 1) + (xcd - r) * q) + off; }
        const int nig = WGM * nN, gid = wgid / nig, fm = gid * WGM, gsz = (nM - fm) < WGM ? (nM - fm) : WGM;
        u.pm = fm + ((wgid % nig) % gsz); u.pn = (wgid % nig) / gsz; u.arow = u.pm * BM; u.brow = u.pn * BM; u.e = 0; u.nrow = BM; u.kind = 0; u.aux = 0; return true;
    }
};

struct ColSubsetOrder {
    static constexpr bool GATHER = false;
    DenseOrder d; int base, split, skip;
    __device__ __forceinline__ void a_ready(const Unit&) const {}
    __device__ __forceinline__ void done(const Unit&) const {}
    __device__ __forceinline__ bool next(int i, Unit& u) const { if (!d.next(i, u)) return false; const int pa = base + (u.pn < split ? u.pn : u.pn + skip); u.pn = pa; u.brow = pa * BM; return true; }
};

template <class T_> struct has_bias_lds { template <class U_> static constexpr bool get(decltype(U_::BIAS_LDS)*) { return U_::BIAS_LDS; } template <class U_> static constexpr bool get(...) { return false; } static constexpr bool value = get<T_>(nullptr); };
template <class Epi, class Sched, bool F8 = false>
__device__ __forceinline__ int gemm_phase(PG8_LAS unsigned char* lds, const Gemm g, const Sched& S, const Epi& E) {
    const int tid = threadIdx.x, wid = __builtin_amdgcn_readfirstlane(tid >> 6), lane = tid & 63, wr = wid >> 2, wc = wid & 3, fr = lane & 15, fq = lane >> 4;
    const int K = g.K, nt = K / BK;
    PG8_LAS unsigned char* biaslds = lds + BIAS_LDS_OFF;
    constexpr bool GA = Sched::GATHER;
    unsigned voffA[2], voffB[2]; int gR[2]; unsigned gC[2];
#pragma unroll
    for (int i = 0; i < 2; ++i) { int R, C; stage_rc(tid * 16 + i * 8192, R, C); gR[i] = R; gC[i] = (unsigned)C * 2u;
        voffA[i] = (unsigned)(R * g.lda + C) * 2u; voffB[i] = (unsigned)(R * g.ldb + C) * 2u; }
    unsigned gA_cur[2][2], gA_nxt[2][2];
#define PG8_GATH(dst, un) do { _Pragma("unroll") for (int _h = 0; _h < 2; ++_h) _Pragma("unroll") for (int _i = 0; _i < 2; ++_i) dst[_h][_i] = (unsigned)S.arow_of(un, _h * HALF + gR[_i]) * (unsigned)(g.lda * 2) + gC[_i]; } while (0)
#define PG8_STAGE_A(bufoff, h, kbytes, nx) do { if constexpr (GA) { const char* gb_ = (const char*)g.A + (kbytes); _Pragma("unroll") for (int _i = 0; _i < 2; ++_i) { const unsigned vo_ = (nx) ? gA_nxt[h][_i] : gA_cur[h][_i]; \
        __builtin_amdgcn_global_load_lds((const unsigned*)(gb_ + vo_), (PG8_LAS unsigned*)(lds + (bufoff) + ldsw + _i * 8192), 16, 0, 0); } } \
    else { const char* gb_ = ((nx) ? nA : cA) + (kbytes) + (h) * hstepA; PG8_STAGE(bufoff, gb_, voffA); } } while (0)
    const size_t kstep = (size_t)(BK * 2);
    const size_t hstepA = (size_t)HALF * g.lda * 2, hstepB = (size_t)HALF * g.ldb * 2;
    const size_t rowA = (size_t)g.lda * 2, rowB = (size_t)g.ldb * 2;
    const unsigned ldsw = (unsigned)wid * 1024u;
    const int aoff = lds_byte(wr * 64 + fr, fq * 8), boff = lds_byte(wc * 32 + fr, fq * 8);
#define PG8_SA(b, h) (((b) * 2 + (h)) * HTB)
#define PG8_SB(b, h) ((4 + (b) * 2 + (h)) * HTB)
#define PG8_STAGE(bufoff, gbase, voff) do { _Pragma("unroll") for (int _i = 0; _i < 2; ++_i) \
        __builtin_amdgcn_global_load_lds((const unsigned*)((const char*)(gbase) + (voff)[_i]), (PG8_LAS unsigned*)(lds + (bufoff) + ldsw + _i * 8192), 16, 0, 0); } while (0)
#define PG8_LDA(dst, b, h) do { _Pragma("unroll") for (int m = 0; m < 4; ++m) { if constexpr (F8) { const v4i32 lo_ = *(const PG8_LAS v4i32*)(lds + PG8_SA(b, h) + aoff + m * 2048), hi_ = *(const PG8_LAS v4i32*)(lds + PG8_SA(b, h) + aoff + m * 2048 + 1024); dst##8[m] = __builtin_shufflevector(lo_, hi_, 0, 1, 2, 3, 4, 5, 6, 7); } \
        else { _Pragma("unroll") for (int k = 0; k < 2; ++k) dst[m][k] = *(const PG8_LAS bf16x8*)(lds + PG8_SA(b, h) + aoff + m * 2048 + k * 1024); } } } while (0)
#define PG8_LDB(dst, b, h) do { _Pragma("unroll") for (int n = 0; n < 2; ++n) { if constexpr (F8) { const v4i32 lo_ = *(const PG8_LAS v4i32*)(lds + PG8_SB(b, h) + boff + n * 2048), hi_ = *(const PG8_LAS v4i32*)(lds + PG8_SB(b, h) + boff + n * 2048 + 1024); dst##8[n] = __builtin_shufflevector(lo_, hi_, 0, 1, 2, 3, 4, 5, 6, 7); } \
        else { _Pragma("unroll") for (int k = 0; k < 2; ++k) dst[n][k] = *(const PG8_LAS bf16x8*)(lds + PG8_SB(b, h) + boff + n * 2048 + k * 1024); } } } while (0)
#define PG8_MMA(ai, bj, At, Bt) do { __builtin_amdgcn_s_setprio(1); _Pragma("unroll") for (int m = 0; m < 4; ++m) _Pragma("unroll") for (int n = 0; n < 2; ++n) { \
        if constexpr (F8) { asm("v_mfma_scale_f32_16x16x128_f8f6f4 %0, %1, %2, %0, %3, %3 op_sel_hi:[0,0,0]" : "+v"(acc[ai][bj][m][n]) : "v"(Bt##8[n]), "v"(At##8[m]), "v"(one_scale)); } \
        else { _Pragma("unroll") for (int k = 0; k < 2; ++k) acc[ai][bj][m][n] = __builtin_amdgcn_mfma_f32_16x16x32_bf16(Bt[n][k], At[m][k], acc[ai][bj][m][n], 0, 0, 0); } } \
        __builtin_amdgcn_s_setprio(0); } while (0)
#define PG8_WAIT_V(n) asm volatile("s_waitcnt vmcnt(" #n ")" ::: "memory")
#define PG8_WAIT_L(n) asm volatile("s_waitcnt lgkmcnt(" #n ")" ::: "memory")
#define PG8_BAR __builtin_amdgcn_s_barrier()
#define PG8_SCHED __builtin_amdgcn_sched_barrier(0)
    Unit cur, nxt; int ui = 0;
    if (!S.next(0, cur)) return 0;
    f32x4 acc[2][2][4][2];
#pragma unroll
    for (int a = 0; a < 2; ++a)
#pragma unroll
        for (int b = 0; b < 2; ++b)
#pragma unroll
            for (int m = 0; m < 4; ++m)
#pragma unroll
                for (int n = 0; n < 2; ++n) acc[a][b][m][n] = (f32x4){0.f, 0.f, 0.f, 0.f};
    const int one_scale = 0x7f7f7f7f;
    bf16x8 At[4][2], B0[2][2], B1[2][2];
    v8i32 At8[4], B08[2], B18[2];
    const char* cA = GA ? (const char*)g.A : (const char*)g.A + (size_t)cur.arow * rowA; const char* cB = (const char*)g.Bt + (size_t)cur.brow * rowB; const char* nA = cA;
    if constexpr (GA) { PG8_GATH(gA_cur, cur); }
    S.a_ready(cur);
    PG8_STAGE(PG8_SB(0, 0), cB, voffB); PG8_STAGE(PG8_SB(0, 1), cB + hstepB, voffB); PG8_STAGE_A(PG8_SA(0, 0), 0, 0, false); PG8_STAGE_A(PG8_SA(0, 1), 1, 0, false);
    if (wr == 1) PG8_BAR;
    PG8_WAIT_V(2); PG8_BAR;
    PG8_STAGE(PG8_SB(1, 0), cB + kstep, voffB); PG8_STAGE_A(PG8_SA(1, 0), 0, kstep, false); PG8_STAGE(PG8_SB(1, 1), cB + hstepB + kstep, voffB);
    PG8_WAIT_V(6); PG8_BAR;
    for (;;) {
        const bool has_next = S.next(ui + 1, nxt);
        if constexpr (has_bias_lds<Epi>::value) E.stage_bias(biaslds + (ui & 1) * 1024, cur, wid, lane);
        nA = GA ? cA : (has_next ? (const char*)g.A + (size_t)nxt.arow * rowA : cA); const char* nB = has_next ? (const char*)g.Bt + (size_t)nxt.brow * rowB : cB;
        if constexpr (GA) { if (has_next) { PG8_GATH(gA_nxt, nxt); } else { _Pragma("unroll") for (int _h = 0; _h < 2; ++_h) _Pragma("unroll") for (int _i = 0; _i < 2; ++_i) gA_nxt[_h][_i] = gA_cur[_h][_i]; } }
#pragma unroll 1
        for (int t = 0; t < nt; t += 2) {
            const bool last = (t == nt - 2);
            if (last && has_next) S.a_ready(nxt);
            const size_t k1 = (size_t)(t + 1) * kstep, k2 = last ? (size_t)0 : (size_t)(t + 2) * kstep, k3 = k2 + kstep;
            const char* b2 = last ? nB : cB + (size_t)(t + 2) * kstep; const char* b3 = b2 + kstep;
            PG8_LDB(B0, 0, 0); PG8_LDB(B1, 0, 1); PG8_SCHED; PG8_LDA(At, 0, 0); PG8_STAGE_A(PG8_SA(1, 1), 1, k1, false);
            PG8_WAIT_V(8); PG8_WAIT_L(0); PG8_BAR; PG8_MMA(0, 0, At, B0); PG8_MMA(0, 1, At, B1); PG8_BAR; PG8_SCHED;
            PG8_LDA(At, 0, 1); PG8_STAGE(PG8_SB(0, 0), b2, voffB); PG8_STAGE(PG8_SB(0, 1), b2 + hstepB, voffB); PG8_STAGE_A(PG8_SA(0, 0), 0, k2, last);
            PG8_WAIT_V(8); PG8_WAIT_L(0); PG8_BAR; PG8_MMA(1, 0, At, B0); PG8_MMA(1, 1, At, B1); PG8_BAR; PG8_SCHED;
            PG8_LDB(B0, 1, 0); PG8_LDB(B1, 1, 1); PG8_SCHED; PG8_LDA(At, 1, 0); PG8_STAGE_A(PG8_SA(0, 1), 1, k2, last);
            PG8_WAIT_V(8); PG8_WAIT_L(0); PG8_BAR; PG8_MMA(0, 0, At, B0); PG8_MMA(0, 1, At, B1); PG8_BAR; PG8_SCHED;
            PG8_LDA(At, 1, 1); PG8_STAGE(PG8_SB(1, 0), b3, voffB); PG8_STAGE(PG8_SB(1, 1), b3 + hstepB, voffB); PG8_STAGE_A(PG8_SA(1, 0), 0, k3, last);
            PG8_WAIT_V(8); PG8_WAIT_L(0); PG8_BAR; PG8_MMA(1, 0, At, B0); PG8_MMA(1, 1, At, B1); PG8_BAR; PG8_SCHED;
        }
        if (wr == 0) PG8_BAR;
        if constexpr (has_bias_lds<Epi>::value) E(acc, cur, wr, wc, fr, fq, (const PG8_LAS float*)(biaslds + (ui & 1) * 1024)); else E(acc, cur, wr, wc, fr, fq);
        S.done(cur);
        if (!has_next) break;
#pragma unroll
        for (int a = 0; a < 2; ++a)
#pragma unroll
            for (int b = 0; b < 2; ++b)
#pragma unroll
                for (int m = 0; m < 4; ++m)
#pragma unroll
                    for (int n = 0; n < 2; ++n) acc[a][b][m][n] = (f32x4){0.f, 0.f, 0.f, 0.f};
        cur = nxt; cA = nA; cB = nB; ++ui;
        if constexpr (GA) { _Pragma("unroll") for (int _h = 0; _h < 2; ++_h) _Pragma("unroll") for (int _i = 0; _i < 2; ++_i) gA_cur[_h][_i] = gA_nxt[_h][_i]; }
        if (wr == 1) PG8_BAR;
    }
    PG8_WAIT_V(0);
    PG8_BAR;
    const int n_done_ = ui + 1;
#undef PG8_SA
#undef PG8_SB
#undef PG8_STAGE
#undef PG8_STAGE_A
#undef PG8_GATH
#undef PG8_LDA
#undef PG8_LDB
#undef PG8_MMA
#undef PG8_WAIT_V
#undef PG8_WAIT_L
#undef PG8_BAR
#undef PG8_SCHED
    return n_done_;
}
}
constexpr int NWAVES = 8;
constexpr int BATCH = 2, SEQ = 8192, T = BATCH * SEQ, D = 1024, NH = 8, HD = 64, AW = 512, SW = 512, NG = 32, NP = 64, GS16 = 16;
constexpr int NE = 32, FF = 1024, INW = 4096, TOPK = 4, NBLK = SEQ / 256;
constexpr float NORM_EPS = 1e-6f;
constexpr float C2 = 0.125f * 1.4426950408889634f;
constexpr int XROWS = T * TOPK + 256;

constexpr size_t MiB = 1u << 20;
constexpr size_t WS_CTL = 0, CTL_ZERO_BYTES = 1 * MiB;
constexpr size_t WS_ADA = 1 * MiB;
constexpr size_t WS_ADAF = WS_ADA + 832 * 1024;
constexpr size_t WS_ROPE = 2 * MiB;
constexpr size_t WS_S5P = 6 * MiB;
constexpr size_t WS_S5KT = 7 * MiB;
constexpr size_t WS_S5M1 = 10 * MiB;
constexpr size_t WS_S5WC = 506 * MiB;
constexpr size_t WS_S5E = 408 * MiB;
constexpr size_t WS_ROUTE = 9 * MiB;
constexpr size_t WS_ELIST = 14 * MiB; constexpr int ELCAP = T;
constexpr size_t WS_HSC = WS_ROUTE + 768 * 1024;
constexpr int PAR_WSC = 270000, PAR_WSC1 = 270001;
#ifndef MOE_BF16
#define MOE_F8 1
#endif
constexpr size_t WS_WIN_T = 18 * MiB, WS_WGLU_T = 26 * MiB, WS_WSB_T = 27 * MiB, WS_WAB_T = 28 * MiB, WS_WOUT_T = 29 * MiB;
constexpr size_t WS_PAR = 16 * MiB;
constexpr int PAR_MPG = 0, PAR_FPRE = 1024, PAR_FPOST = 2048, PAR_RB = 3072, PAR_RW = 4096, PAR_BG = 36864, PAR_BU = 69632, PAR_BD = 102400, PAR_CRE = 135168, PAR_CIM = 167936, PAR_SD = 200704, PAR_BRE = 201728, PAR_BIM = 234496;
constexpr size_t WS_WGU_T = 32 * MiB, WS_WDN_T = 160 * MiB;
constexpr size_t WS_XN = 224 * MiB;
constexpr size_t WS_UA = 256 * MiB, WS_Q = 280 * MiB, WS_K = 296 * MiB, WS_V = 312 * MiB, WS_VT = 328 * MiB;
constexpr size_t WS_MIX = 256 * MiB;
constexpr size_t WS_GS = 344 * MiB, WS_GA = 376 * MiB;
constexpr size_t WS_YG = 408 * MiB, WS_Y2 = 424 * MiB, WS_YA = 440 * MiB;
constexpr size_t WS_M1 = 456 * MiB;
constexpr size_t WS_H2 = 480 * MiB;
constexpr size_t WS_WIN8 = 96 * MiB, WS_XN8 = 100 * MiB;
constexpr size_t WS_X1B = 416 * MiB;
constexpr size_t WS_XG = 224 * MiB, WS_YB = 224 * MiB;
constexpr size_t WS_H1 = 352 * MiB;
constexpr size_t WS_END = 512 * MiB;
static_assert(WS_YB + (size_t)T * TOPK * D * 2 <= WS_H1 && WS_H1 + (size_t)T * TOPK * FF * 2 <= WS_H2 && WS_H2 + (size_t)T * D * 2 <= WS_END, "ws map");
constexpr int CW_TMO = 0, CW_CODE = 1, CW_BAR = 4096, CW_ECNT = 8192, CW_KM = 16384;
constexpr size_t CTL_ZERO_USED = (size_t)(CW_KM + BATCH * NH * NBLK * HD) * 4;
static_assert(CTL_ZERO_USED <= CTL_ZERO_BYTES, "ctl");

constexpr int RING_OFF = 0, RING_BYTES = 131072;
constexpr int LDSCTL_OFF = 152 * 1024, MISC_OFF = LDSCTL_OFF + 320;
constexpr int LDS_BYTES = 158 * 1024;

#define GAS __attribute__((address_space(1)))
#define LAS __attribute__((address_space(3)))
typedef unsigned short bf16;
typedef unsigned v4u __attribute__((ext_vector_type(4)));
typedef unsigned v2u __attribute__((ext_vector_type(2)));
typedef float f32x4 __attribute__((ext_vector_type(4)));
typedef GAS unsigned gu32;
#define RLX_AGENT __ATOMIC_RELAXED, __HIP_MEMORY_SCOPE_AGENT
#define LDS_WAIT() asm volatile("s_waitcnt lgkmcnt(0)" ::: "memory")
#define VM_WAIT() asm volatile("s_waitcnt vmcnt(0)" ::: "memory")
__device__ __forceinline__ unsigned f2bf(float f) { unsigned u = __builtin_bit_cast(unsigned, f); return (u + 0x7fffu + ((u >> 16) & 1u)) >> 16; }
__device__ __forceinline__ unsigned pk2(float lo, float hi) { typedef float f32x2_t __attribute__((ext_vector_type(2))); typedef __bf16 bf16x2_t __attribute__((ext_vector_type(2)));
    f32x2_t v = {lo, hi}; bf16x2_t r = __builtin_convertvector(v, bf16x2_t); return __builtin_bit_cast(unsigned, r); }
#ifdef WT_STORES
__device__ __forceinline__ void st16(void* p, v4u v) { asm volatile("global_store_dwordx4 %0, %1, off sc1\n\ts_nop 1" :: "v"(p), "v"(v) : "memory"); }
__device__ __forceinline__ void st8(void* p, v2u v) { asm volatile("global_store_dwordx2 %0, %1, off sc1\n\ts_nop 1" :: "v"(p), "v"(v) : "memory"); }
#else
__device__ __forceinline__ void st16(void* p, v4u v) { *(v4u*)p = v; }
__device__ __forceinline__ void st8(void* p, v2u v) { *(v2u*)p = v; }
#endif
__device__ __forceinline__ unsigned pk4_fp8(float a, float b, float c, float d) {
    a = fminf(fmaxf(a, -448.f), 448.f); b = fminf(fmaxf(b, -448.f), 448.f); c = fminf(fmaxf(c, -448.f), 448.f); d = fminf(fmaxf(d, -448.f), 448.f);
    int w = 0; w = __builtin_amdgcn_cvt_pk_fp8_f32(a, b, w, false); w = __builtin_amdgcn_cvt_pk_fp8_f32(c, d, w, true); return (unsigned)w; }
__device__ __forceinline__ float bflo(unsigned w) { return __builtin_bit_cast(float, w << 16); }
__device__ __forceinline__ float bfhi(unsigned w) { return __builtin_bit_cast(float, w & 0xffff0000u); }
__device__ __forceinline__ float bf2f(bf16 h) { return __builtin_bit_cast(float, (unsigned)h << 16); }
__device__ __forceinline__ float sigmoidf_(float x) { return 1.f / (1.f + __expf(-x)); }
__device__ __forceinline__ float gelu_tanh(float x) { const float u = 1.5957691216057308f * (x + 0.044715f * x * x * x); return x / (1.f + __expf(-u)); }

#define XB_TMO      128
#define XB_XCNT(j)  (256  + 64 * (j))
#define XB_XSUB(j)  (1280 + 64 * (j))
#define XB_XGEN(j)  (2304 + 64 * (j))
#define XB_TOP      3328
#define XB_TOPGEN   3392
#define XCD_BAR_WORDS 3456
#define XB_SPIN_CAP (1u << 18)
__device__ __forceinline__ unsigned xb_ld(unsigned* p)              { return __hip_atomic_load(p, __ATOMIC_RELAXED, __HIP_MEMORY_SCOPE_AGENT); }
__device__ __forceinline__ unsigned xb_add(unsigned* p, unsigned v) { return __hip_atomic_fetch_add(p, v, __ATOMIC_RELAXED, __HIP_MEMORY_SCOPE_AGENT); }
__device__ __forceinline__ unsigned xb_xcc_id() { return (unsigned)__builtin_amdgcn_s_getreg((3 << 11) | 20) & 0xFu; }
#define XB_SPIN(cond, bar) do { unsigned _sp = 0; while (cond) { __builtin_amdgcn_s_sleep(1); \
    if ((++_sp & 255u) == 0u) { if (xb_ld(&(bar)[XB_TMO])) break; if (_sp > XB_SPIN_CAP) { atomicAdd(&(bar)[XB_TMO], 1u); break; } } } } while (0)
struct XcdBarrier { unsigned* bar; unsigned x; volatile LAS unsigned* st; };
__device__ __forceinline__ XcdBarrier xcd_barrier_post(unsigned* bar, volatile LAS unsigned* st) {
    XcdBarrier b; b.bar = bar; b.x = xb_xcc_id(); b.st = st;
    if (threadIdx.x == 0) (void)xb_add(&bar[XB_XCNT(b.x)], 1u);
    return b;
}
__device__ __forceinline__ void xcd_barrier_complete(unsigned* bar, unsigned x, unsigned& nloc, unsigned& nx) {
    const unsigned G = gridDim.x * gridDim.y * gridDim.z;
    unsigned sum, cnt, mine, sp = 0u;
    for (;;) {
        sum = 0u; cnt = 0u; mine = 0u;
#pragma unroll
        for (unsigned j = 0; j < 16; ++j) { const unsigned c = xb_ld(&bar[XB_XCNT(j)]); sum += c; cnt += (c > 0u) ? 1u : 0u; mine = (j == x) ? c : mine; }
        if (sum == G) break;
        __builtin_amdgcn_s_sleep(1);
        if ((++sp & 255u) == 0u) { if (xb_ld(&bar[XB_TMO])) break; if (sp > XB_SPIN_CAP) { atomicAdd(&bar[XB_TMO], 1u); break; } }
    }
    nloc = mine > 0u ? mine : 1u; nx = cnt > 0u ? cnt : 1u;
}
__device__ __forceinline__ void xcd_barrier(const XcdBarrier& b) {
    asm volatile("s_waitcnt vmcnt(0)" ::: "memory");
    __syncthreads();
    if (threadIdx.x == 0) {
        unsigned* bar = b.bar;
        __builtin_amdgcn_s_waitcnt(0);
        unsigned nloc = b.st[0], nx = b.st[1];
        if (nloc == 0u) { xcd_barrier_complete(bar, b.x, nloc, nx); b.st[0] = nloc; b.st[1] = nx; }
        const unsigned old = xb_add(&bar[XB_XSUB(b.x)], 1u);
        const unsigned gen = old / nloc;
        if (old + 1u == (gen + 1u) * nloc) {
            __builtin_amdgcn_fence(__ATOMIC_RELEASE, "agent");
            asm volatile("s_waitcnt vmcnt(0)" ::: "memory");
            const unsigned og = xb_add(&bar[XB_TOP], 1u);
            const unsigned tg = og / nx;
            if (og + 1u == (tg + 1u) * nx) xb_add(&bar[XB_TOPGEN], 1u);
            else XB_SPIN(xb_ld(&bar[XB_TOPGEN]) == tg, bar);
            __builtin_amdgcn_fence(__ATOMIC_ACQUIRE, "agent");
            xb_add(&bar[XB_XGEN(b.x)], 1u);
            asm volatile("s_waitcnt vmcnt(0)" ::: "memory");
        } else {
            XB_SPIN(xb_ld(&bar[XB_XGEN(b.x)]) == gen, bar);
            __builtin_amdgcn_fence(__ATOMIC_ACQUIRE, "agent");
            asm volatile("s_waitcnt vmcnt(0)" ::: "memory");
        }
    }
    __syncthreads();
}

__device__ __forceinline__ float wave_sum(float v) {
#pragma unroll
    for (int o = 1; o < 64; o <<= 1) v += __shfl_xor(v, o);
    return v;
}
__device__ __forceinline__ float wave_max(float v) {
#pragma unroll
    for (int o = 1; o < 64; o <<= 1) v = fmaxf(v, __shfl_xor(v, o));
    return v;
}
struct Frame {
    LAS unsigned char* lds;
    volatile LAS unsigned* MISC;
    gu32* ctl;
    int tid, lane, wave;
    int vcu, G;
    unsigned char* ws;
    const float* in[30];
    float* out;
};
#define WSP(T_, off) ((T_*)(F.ws + (off)))

__device__ __forceinline__ int perm8(int c) { return (c & ~31) + 16 * ((c >> 2) & 1) + 4 * ((c >> 3) & 3) + (c & 3); }
struct MapP8 { int off; __device__ __forceinline__ int operator()(int n) const { return off + perm8(n); } };
struct MapWin { __device__ __forceinline__ int operator()(int c) const {
    if (c < 512 || c >= 1536) return perm8(c);
    const int base = (c < 1024) ? 512 : 1024, cc = c - base, head = cc >> 6, d = cc & 63, pnq = head >> 2, hh = head & 3, n = d >> 5, dd = d & 31;
    const int wc = 2 * (hh & 1) + (dd >> 4), bj = hh >> 1, j = dd & 15;
    return base + 256 * pnq + 128 * bj + 32 * wc + 16 * n + j; } };
struct MapGU { int e, up; __device__ __forceinline__ int operator()(int f) const { return e * 2048 + (f >> 7) * 256 + up * 128 + perm8(f & 127); } };

template <class RowMap>
__device__ __forceinline__ void p0_transpose_item(const float* W, int K, int N, bf16* WT, LAS float* scr, int item, int lane, const RowMap rm) {
    const int nblk = N / 64, kb = item / nblk, nb = item % nblk, k0 = 64 * kb, n0 = 64 * nb;
    const int lr = lane >> 4, lc = 4 * (lane & 15);
    f32x4 v[16];
#pragma unroll
    for (int i = 0; i < 16; ++i) v[i] = __builtin_nontemporal_load((const GAS f32x4*)(W + (size_t)(k0 + 4 * i + lr) * N + n0 + lc));
#pragma unroll
    for (int i = 0; i < 16; ++i) { LAS float* d = scr + (4 * i + lr) * 65 + lc; d[0] = v[i].x; d[1] = v[i].y; d[2] = v[i].z; d[3] = v[i].w; }
    LDS_WAIT(); asm volatile("" ::: "memory");
    const int c = lane & 7;
#pragma unroll
    for (int j = 0; j < 8; ++j) { const int n = (lane >> 3) + 8 * j; const LAS float* s = scr + (8 * c) * 65 + n;
        v4u o; o.x = pk2(s[0 * 65], s[1 * 65]); o.y = pk2(s[2 * 65], s[3 * 65]); o.z = pk2(s[4 * 65], s[5 * 65]); o.w = pk2(s[6 * 65], s[7 * 65]);
        __builtin_nontemporal_store(o, (GAS v4u*)(WT + (size_t)rm(n0 + n) * K + k0 + 8 * c)); }
    LDS_WAIT(); asm volatile("" ::: "memory");
}

template <class RowMap>
__device__ __forceinline__ void p0_transpose_item_f8(const float* W, int K, int N, unsigned char* WT, LAS float* scr, int item, int lane, const RowMap rm, float wsc) {
    const int nblk = N / 64, kb = item / nblk, nb = item % nblk, k0 = 64 * kb, n0 = 64 * nb;
    const int lr = lane >> 4, lc = 4 * (lane & 15);
    f32x4 v[16];
#pragma unroll
    for (int i = 0; i < 16; ++i) v[i] = __builtin_nontemporal_load((const GAS f32x4*)(W + (size_t)(k0 + 4 * i + lr) * N + n0 + lc));
#pragma unroll
    for (int i = 0; i < 16; ++i) { LAS float* d = scr + (4 * i + lr) * 65 + lc; d[0] = v[i].x * wsc; d[1] = v[i].y * wsc; d[2] = v[i].z * wsc; d[3] = v[i].w * wsc; }
    LDS_WAIT(); asm volatile("" ::: "memory");
    const int c = lane & 3;
#pragma unroll
    for (int j = 0; j < 4; ++j) { const int n = (lane >> 2) + 16 * j; const LAS float* s = scr + (16 * c) * 65 + n;
        v4u o; o.x = pk4_fp8(s[0 * 65], s[1 * 65], s[2 * 65], s[3 * 65]); o.y = pk4_fp8(s[4 * 65], s[5 * 65], s[6 * 65], s[7 * 65]);
        o.z = pk4_fp8(s[8 * 65], s[9 * 65], s[10 * 65], s[11 * 65]); o.w = pk4_fp8(s[12 * 65], s[13 * 65], s[14 * 65], s[15 * 65]);
        __builtin_nontemporal_store(o, (GAS v4u*)(WT + (size_t)rm(n0 + n) * K + k0 + 16 * c)); }
    LDS_WAIT(); asm volatile("" ::: "memory");
}

__device__ __forceinline__ void p0_moe_load(const float* W, int item, int lane, f32x4 (&v)[16]) {
    const int kb = item >> 4, nb = item & 15, k0 = 64 * kb, n0 = 64 * nb, lr = lane >> 4, lc = 4 * (lane & 15);
#pragma unroll
    for (int i = 0; i < 16; ++i) v[i] = __builtin_nontemporal_load((const GAS f32x4*)(W + (size_t)(k0 + 4 * i + lr) * 1024 + n0 + lc));
}
__device__ __forceinline__ void p0_moe_finish(unsigned char* WT, int rowbase, int kind, int item, LAS float* scr, int lane, const f32x4 (&v)[16], float wsc) {
    const int kb = item >> 4, nb = item & 15, k0 = 64 * kb, n0 = 64 * nb, lr = lane >> 4, lc = 4 * (lane & 15);
#pragma unroll
    for (int i = 0; i < 16; ++i) { LAS float* d = scr + (4 * i + lr) * 65 + lc; d[0] = v[i].x * wsc; d[1] = v[i].y * wsc; d[2] = v[i].z * wsc; d[3] = v[i].w * wsc; }
    LDS_WAIT(); asm volatile("" ::: "memory");
    const int c = lane & 3;
#pragma unroll
    for (int j = 0; j < 4; ++j) { const int n = n0 + (lane >> 2) + 16 * j; const LAS float* s = scr + (16 * c) * 65 + (n - n0);
        const int row = rowbase + (kind < 2 ? (n >> 7) * 256 + kind * 128 + perm8(n & 127) : perm8(n));
        v4u o; o.x = pk4_fp8(s[0 * 65], s[1 * 65], s[2 * 65], s[3 * 65]); o.y = pk4_fp8(s[4 * 65], s[5 * 65], s[6 * 65], s[7 * 65]);
        o.z = pk4_fp8(s[8 * 65], s[9 * 65], s[10 * 65], s[11 * 65]); o.w = pk4_fp8(s[12 * 65], s[13 * 65], s[14 * 65], s[15 * 65]);
        __builtin_nontemporal_store(o, (GAS v4u*)(WT + (size_t)row * 1024 + k0 + 16 * c)); }
    LDS_WAIT(); asm volatile("" ::: "memory");
}

constexpr int MOE_ITEMS_ALL = 3 * NE * 256, MOE_ITEMS_P3 = 2048, MOE_ITEMS_P5 = 2048, MOE_ITEMS_P6 = 6144, MOE_ITEMS_P0 = MOE_ITEMS_ALL - MOE_ITEMS_P3 - MOE_ITEMS_P5 - MOE_ITEMS_P6;
__device__ __forceinline__ void p0_moe_range(Frame& F, int first, int count, int gw, int ngw, float wsc) {
    LAS float* scr = (LAS float*)(F.lds + RING_OFF + F.wave * 16640);
    const float* wg = F.in[24]; const float* wu = F.in[26]; const float* wd = F.in[28];
    unsigned char* tgu = WSP(unsigned char, WS_WGU_T); unsigned char* tdn = WSP(unsigned char, WS_WDN_T);
#define P0_DEC(r_, W_, WT_, rb_, kd_, it_) const int mat_##r_ = (first + (r_)) >> 8, it_ = (first + (r_)) & 255, kd_ = mat_##r_ >> 5, e_##r_ = mat_##r_ & 31; \
    const float* W_ = (kd_ == 0 ? wg : (kd_ == 1 ? wu : wd)) + (size_t)e_##r_ * D * FF; unsigned char* WT_ = kd_ < 2 ? tgu : tdn; const int rb_ = kd_ < 2 ? e_##r_ * 2048 : e_##r_ * 1024;
    f32x4 va[16], vb[16]; int r = gw;
    if (r < count) { P0_DEC(r, W0, T0, b0, k0_, i0); (void)T0; (void)b0; (void)k0_; p0_moe_load(W0, i0, F.lane, va); }
    while (r < count) {
        { const int rn = r + ngw; if (rn < count) { P0_DEC(rn, W1, T1, b1, k1_, i1); (void)T1; (void)b1; (void)k1_; p0_moe_load(W1, i1, F.lane, vb); } }
        { P0_DEC(r, W2, T2, b2, k2_, i2); (void)W2; p0_moe_finish(T2, b2, k2_, i2, scr, F.lane, va, wsc); }
        r += ngw; if (r >= count) break;
        { const int rn = r + ngw; if (rn < count) { P0_DEC(rn, W3, T3, b3, k3_, i3); (void)T3; (void)b3; (void)k3_; p0_moe_load(W3, i3, F.lane, va); } }
        { P0_DEC(r, W4, T4, b4, k4_, i4); (void)W4; p0_moe_finish(T4, b4, k4_, i4, scr, F.lane, vb, wsc); }
        r += ngw;
    }
#undef P0_DEC
}
__device__ __forceinline__ void moe_convert_idle(Frame& F, int first, int count) {
    if (F.G != 256) { if (blockIdx.x == 0) { } }
    const int nb = F.G == 256 ? 128 : F.G, bi = F.G == 256 ? (int)blockIdx.x - 128 : (int)blockIdx.x;
    if (bi < 0) return;
    p0_moe_range(F, first, count, bi * NWAVES + F.wave, nb * NWAVES, WSP(float, WS_PAR)[PAR_WSC]);
}

__device__ __forceinline__ void phase0(Frame& F) {
    LAS float* scr = (LAS float*)(F.lds + RING_OFF + F.wave * 16640);
    const int gw = F.vcu * NWAVES + F.wave, NGW = F.G * NWAVES;
#ifdef MOE_F8
    float wsc;
    { float am = 0.f;
      for (int j = F.tid; j < 2048; j += NWAVES * 64) { const size_t o = (size_t)j * 16384 + 37 * (j & 63);
          am = fmaxf(am, fmaxf(fabsf(F.in[24][o]), fmaxf(fabsf(F.in[26][o]), fabsf(F.in[28][o])))); }
      am = wave_max(am); LAS float* red = (LAS float*)(F.lds + LDSCTL_OFF + 64);
      if (F.lane == 0) red[F.wave] = am;
      __syncthreads();
      am = red[0];
#pragma unroll
      for (int w = 1; w < NWAVES; ++w) am = fmaxf(am, red[w]);
      wsc = exp2f(floorf(log2f(448.f / (fmaxf(am, 1e-30f) * 8.f))));
      if (blockIdx.x == 0 && F.tid == 0) WSP(float, WS_PAR)[PAR_WSC] = wsc;
      __syncthreads(); }
#endif
#if defined(G1_F8) || defined(G1_MIX)
    float wsc1;
    { float am = 0.f;
      for (int j = F.tid; j < 2048; j += NWAVES * 64) am = fmaxf(am, fabsf(F.in[9][(size_t)j * 2048 + 37 * (j & 31)]));
      am = wave_max(am); LAS float* red = (LAS float*)(F.lds + LDSCTL_OFF + 64);
      if (F.lane == 0) red[F.wave] = am;
      __syncthreads();
      am = red[0];
#pragma unroll
      for (int w = 1; w < NWAVES; ++w) am = fmaxf(am, red[w]);
      wsc1 = exp2f(floorf(log2f(448.f / (fmaxf(am, 1e-30f) * 8.f))));
      if (blockIdx.x == 0 && F.tid == 0) WSP(float, WS_PAR)[PAR_WSC1] = wsc1;
      __syncthreads(); }
#endif
    constexpr int I_WIN = 16 * 64, I_GLU = 8 * 8, I_SB = 8 * 16, I_AB = 8 * 16, I_OUT = 16 * 16, I_E = 16 * 16;
    constexpr int I_SMALL = I_WIN + I_GLU + I_SB + I_AB + I_OUT, I_MOE = 3 * NE * I_E, I_ADA = 16 * 96;
    constexpr int NITEMS = I_SMALL + I_MOE + I_ADA;
    for (int it = gw; it < NITEMS; it += NGW) {
        int r = it;
#if defined(G1_MIX)
        if (r < I_WIN) { p0_transpose_item(F.in[9], D, INW, WSP(bf16, WS_WIN_T), scr, r, F.lane, MapWin{}); p0_transpose_item_f8(F.in[9], D, INW, WSP(unsigned char, WS_WIN8), scr, r, F.lane, MapWin{}, wsc1); continue; } r -= I_WIN;
#elif defined(G1_F8)
        if (r < I_WIN) { p0_transpose_item_f8(F.in[9], D, INW, WSP(unsigned char, WS_WIN_T), scr, r, F.lane, MapWin{}, wsc1); continue; } r -= I_WIN;
#else
        if (r < I_WIN) { p0_transpose_item(F.in[9], D, INW, WSP(bf16, WS_WIN_T), scr, r, F.lane, MapWin{}); continue; } r -= I_WIN;
#endif
        if (r < I_GLU) { p0_transpose_item(F.in[18], SW, SW, WSP(bf16, WS_WGLU_T), scr, r, F.lane, MapP8{0}); continue; } r -= I_GLU;
        if (r < I_SB) { p0_transpose_item(F.in[19], SW, D, WSP(bf16, WS_WSB_T), scr, r, F.lane, MapP8{0}); continue; } r -= I_SB;
        if (r < I_AB) { p0_transpose_item(F.in[20], AW, D, WSP(bf16, WS_WAB_T), scr, r, F.lane, MapP8{0}); continue; } r -= I_AB;
        if (r < I_OUT) { p0_transpose_item(F.in[21], D, D, WSP(bf16, WS_WOUT_T), scr, r, F.lane, MapP8{0}); continue; } r -= I_OUT;
        if (r < I_MOE) {
#ifdef MOE_F8
            continue;
#endif
            const int mat = r / I_E, item = r % I_E, kind = mat / NE, e = mat % NE;
#ifdef MOE_F8
            if (kind == 0) p0_transpose_item_f8(F.in[24] + (size_t)e * D * FF, D, FF, WSP(unsigned char, WS_WGU_T), scr, item, F.lane, MapGU{e, 0}, wsc);
            else if (kind == 1) p0_transpose_item_f8(F.in[26] + (size_t)e * D * FF, D, FF, WSP(unsigned char, WS_WGU_T), scr, item, F.lane, MapGU{e, 1}, wsc);
            else p0_transpose_item_f8(F.in[28] + (size_t)e * FF * D, FF, D, WSP(unsigned char, WS_WDN_T), scr, item, F.lane, MapP8{e * 1024}, wsc);
#else
            if (kind == 0) p0_transpose_item(F.in[24] + (size_t)e * D * FF, D, FF, WSP(bf16, WS_WGU_T), scr, item, F.lane, MapGU{e, 0});
            else if (kind == 1) p0_transpose_item(F.in[26] + (size_t)e * D * FF, D, FF, WSP(bf16, WS_WGU_T), scr, item, F.lane, MapGU{e, 1});
            else p0_transpose_item(F.in[28] + (size_t)e * FF * D, FF, D, WSP(bf16, WS_WDN_T), scr, item, F.lane, MapP8{e * 1024});
#endif
            continue; }
        r -= I_MOE;
        {
            const int ks = r / 96, cc = r % 96, n = cc * 64 + F.lane;
            const float* cvec = F.in[1]; const float* aw = F.in[3];
            float a0 = 0.f, a1 = 0.f;
            for (int k = ks * 64; k < ks * 64 + 64; ++k) {
                const float c0 = cvec[k], c1 = cvec[D + k];
                const float s0 = c0 / (1.f + __expf(-c0)), s1 = c1 / (1.f + __expf(-c1));
                const float w = __builtin_nontemporal_load(aw + (size_t)k * (6 * D) + n);
                a0 += s0 * w; a1 += s1 * w; }
            float* part = WSP(float, WS_ADA);
            part[(ks * 2 + 0) * (6 * D) + n] = a0; part[(ks * 2 + 1) * (6 * D) + n] = a1;
        }
    }
#ifdef MOE_F8
    p0_moe_range(F, 0, MOE_ITEMS_P0, gw, NGW, wsc);
#endif
    const int gt = F.vcu * (NWAVES * 64) + F.tid, NGT = F.G * NWAVES * 64;
    { const int* pos = (const int*)F.in[2]; float* rc = WSP(float, WS_ROPE); float* rs = rc + (size_t)T * 32;
      for (int i = gt; i < T * 32; i += NGT) { const int t = i >> 5, p = i & 31;
          const float invf = exp2f(-(float)p * (13.287712379549449f / 32.f));
          const double ang = (double)pos[t] * (double)invf; double rev = ang * 0.15915494309189535; rev -= floor(rev);
          const float fr = (float)rev;
          rc[i] = __builtin_amdgcn_cosf(fr); rs[i] = __builtin_amdgcn_sinf(fr); } }
    { float* P5 = WSP(float, WS_S5P);
      for (int i = gt; i < NG * NP; i += NGT) { const int g = i >> 6;
          const float dt = __expf(F.in[12][g]); const float lr = F.in[10][i], li = F.in[11][i];
          const float er = __expf(lr * dt); const double ang = (double)li * (double)dt; double rev = ang * 0.15915494309189535; rev -= floor(rev);
          const float cs = __builtin_amdgcn_cosf((float)rev), sn = __builtin_amdgcn_sinf((float)rev);
          float br = er * cs, bi = er * sn;
          P5[i] = br; P5[2048 + i] = bi;
          const float nr = br - 1.f, ni = bi, den = lr * lr + li * li;
          const float qr = (nr * lr + ni * li) / den, qi = (ni * lr - nr * li) / den;
          P5[8192 + i] = qr; P5[8192 + 2048 + i] = qi;
          float pr = br, pi_ = bi;
#pragma unroll
          for (int s = 0; s < 8; ++s) { const float tr = pr * pr - pi_ * pi_, ti = 2.f * pr * pi_; pr = tr; pi_ = ti; }
          P5[4096 + i] = pr; P5[6144 + i] = pi_;
          float* PW = P5 + 131072;
          float wr_ = 1.f, wi_ = 0.f;
#pragma unroll
          for (int k = 0; k <= 16; ++k) { PW[i * 17 + k] = wr_; PW[2048 * 17 + i * 17 + k] = wi_; const float tr = wr_ * br - wi_ * bi, ti = wr_ * bi + wi_ * br; wr_ = tr; wi_ = ti; } }
    }
}

__device__ __forceinline__ void phase1(Frame& F) {
    LAS float* A1 = (LAS float*)(F.lds + RING_OFF); LAS float* A2 = A1 + 2 * D;
    const float* part = WSP(float, WS_ADA); const float* ab = F.in[4]; const float* pg = F.in[5];
    for (int k = F.tid; k < D; k += NWAVES * 64)
#pragma unroll
        for (int b = 0; b < 2; ++b) { float sh = ab[k], sc = ab[D + k];
            for (int ks = 0; ks < 16; ++ks) { sh += part[(ks * 2 + b) * (6 * D) + k]; sc += part[(ks * 2 + b) * (6 * D) + D + k]; }
            A1[b * D + k] = pg[k] * (1.f + sc); A2[b * D + k] = sh; }
    const int gt = F.vcu * (NWAVES * 64) + F.tid, NGT = F.G * NWAVES * 64;
    { float* adaf = WSP(float, WS_ADAF);
      for (int n = gt; n < 2 * 6 * D; n += NGT) { const int b = n / (6 * D), j = n % (6 * D); float a = ab[j];
          for (int ks = 0; ks < 16; ++ks) a += part[(ks * 2 + b) * (6 * D) + j];
          adaf[n] = a; } }
    { float* par = WSP(float, WS_PAR);
      for (int i = gt; i < 32768; i += NGT) { par[PAR_RW + i] = F.in[22][i]; par[PAR_BG + i] = F.in[25][i]; par[PAR_BU + i] = F.in[27][i]; par[PAR_BD + i] = F.in[29][i];
          par[PAR_CRE + i] = F.in[15][i]; par[PAR_CIM + i] = F.in[16][i]; par[PAR_BRE + i] = F.in[13][i]; par[PAR_BIM + i] = F.in[14][i];
          if (i < 1024) { par[PAR_MPG + i] = F.in[6][i]; par[PAR_FPRE + i] = F.in[7][i]; par[PAR_FPOST + i] = F.in[8][i]; }
          if (i < 512) par[PAR_SD + i] = F.in[17][i];
          if (i < 32) par[PAR_RB + i] = F.in[23][i]; } }
    { const float* P5 = WSP(float, WS_S5P); const float* PWr = P5 + 131072; const float* PWi = PWr + 2048 * 17;
      bf16* M1t = WSP(bf16, WS_S5M1);
      for (int i = gt; i < NG * 256 * 256; i += NGT) { const int k = i & 255, n = (i >> 8) & 255, g = i >> 16; float val = 0.f;
          if (n < 128) { const int p = n & 63, gp = g * 64 + p, s_ = k >> 4, ci = k & 15;
              const float qr = P5[8192 + gp], qi = P5[8192 + 2048 + gp], b_r = F.in[13][gp * 16 + ci], b_i = F.in[14][gp * 16 + ci];
              const float bbr = qr * b_r - qi * b_i, bbi = qr * b_i + qi * b_r, wr_ = PWr[gp * 17 + 15 - s_], wi_ = PWi[gp * 17 + 15 - s_];
              val = (n < 64) ? (wr_ * bbr - wi_ * bbi) : (wr_ * bbi + wi_ * bbr); }
          M1t[((size_t)(g * 256 + perm8(n))) * 256 + k] = (bf16)f2bf(val); }
    }
    __syncthreads();
    const int gw = F.vcu * NWAVES + F.wave, NGW = F.G * NWAVES;
    bf16* XN = WSP(bf16, WS_XN);
    for (int m0 = gw * 2; m0 < T; m0 += NGW * 2) {
        const int b = m0 >> 13;
        f32x4 v[2][4];
#pragma unroll
        for (int q = 0; q < 2; ++q) { const GAS f32x4* xr = (const GAS f32x4*)(F.in[0] + (size_t)(m0 + q) * D) + F.lane;
#pragma unroll
            for (int j = 0; j < 4; ++j) v[q][j] = __builtin_nontemporal_load(xr + 64 * j); }
#pragma unroll
        for (int q = 0; q < 2; ++q) { float s = 0.f;
#pragma unroll
            for (int j = 0; j < 4; ++j) s += (v[q][j].x * v[q][j].x + v[q][j].y * v[q][j].y) + (v[q][j].z * v[q][j].z + v[q][j].w * v[q][j].w);
            const float rstd = 1.f / sqrtf(wave_sum(s) * (1.f / D) + NORM_EPS);
#ifdef G1_F8
            GAS unsigned* o4 = (GAS unsigned*)((unsigned char*)XN + (size_t)(m0 + q) * D) + F.lane;
#pragma unroll
            for (int j = 0; j < 4; ++j) { const f32x4 a1 = *(const LAS f32x4*)(A1 + b * D + 4 * F.lane + 256 * j), a2 = *(const LAS f32x4*)(A2 + b * D + 4 * F.lane + 256 * j);
                const f32x4 o = v[q][j] * rstd * a1 + a2;
                o4[64 * j] = pk4_fp8(8.f * o.x, 8.f * o.y, 8.f * o.z, 8.f * o.w); } }
#else
            GAS unsigned long long* o8 = (GAS unsigned long long*)(XN + (size_t)(m0 + q) * D) + F.lane;
#pragma unroll
            for (int j = 0; j < 4; ++j) { const f32x4 a1 = *(const LAS f32x4*)(A1 + b * D + 4 * F.lane + 256 * j), a2 = *(const LAS f32x4*)(A2 + b * D + 4 * F.lane + 256 * j);
                const f32x4 o = v[q][j] * rstd * a1 + a2;
                o8[64 * j] = (unsigned long long)pk2(o.x, o.y) | ((unsigned long long)pk2(o.z, o.w) << 32);
#ifdef G1_MIX
                ((GAS unsigned*)(WSP(unsigned char, WS_XN8) + (size_t)(m0 + q) * D) + F.lane)[64 * j] = pk4_fp8(8.f * o.x, 8.f * o.y, 8.f * o.z, 8.f * o.w);
#endif
            } }
#endif
    }
    __syncthreads();
}

struct EpiG1 {
    bf16 *UA, *Q, *K, *V, *VT, *GSp, *GAp; const float *rc, *rs; float* km; const float* wscp; bool f8;
    __device__ __forceinline__ void operator()(const pg8::f32x4 (&acc0)[2][2][4][2], const pg8::Unit& u, int wr, int wc, int fr, int fq) const {
        pg8::f32x4 (&acc)[2][2][4][2] = const_cast<pg8::f32x4 (&)[2][2][4][2]>(acc0);
#if defined(G1_F8) || defined(G1_MIX)
        if (f8) { const float s_ = 0.125f / *wscp;
#pragma unroll
            for (int a = 0; a < 2; ++a)
#pragma unroll
                for (int b = 0; b < 2; ++b)
#pragma unroll
                    for (int m = 0; m < 4; ++m)
#pragma unroll
                        for (int n = 0; n < 2; ++n) acc[a][b][m][n] = acc[a][b][m][n] * s_; }
#endif
        asm volatile("" : "+v"(fr), "+v"(fq));
        const int pn = u.pn, row0 = u.pm * 256 + wr * 64 + fr;
        if (pn < 2) {
#pragma unroll
            for (int ai = 0; ai < 2; ++ai)
#pragma unroll
                for (int m = 0; m < 4; ++m) { const int t = row0 + ai * 128 + m * 16, b = t >> 13, tt = t & (SEQ - 1), c = tt >> 4, s = tt & 15;
#pragma unroll
                    for (int bj = 0; bj < 2; ++bj) { const int ch = pn * 256 + bj * 128 + wc * 32 + 8 * fq, g = ch >> 4, ci = ch & 15;
                        const pg8::f32x4 v0 = acc[ai][bj][m][0], v1 = acc[ai][bj][m][1];
                        v4u w; w.x = pk2(v0[0], v0[1]); w.y = pk2(v0[2], v0[3]); w.z = pk2(v1[0], v1[1]); w.w = pk2(v1[2], v1[3]);
                        st16(UA + ((size_t)(g * 1024 + b * 512 + c) * 384 + 16 * s + ci), w); } }
        } else if (pn < 6) {
            const bool isk = pn >= 4; bf16* X = isk ? K : Q; const float sc = isk ? 1.f : C2;
            const int p0 = 16 * (wc & 1) + 4 * fq;
#pragma unroll
            for (int bj = 0; bj < 2; ++bj) {
                const int head = 4 * (pn & 1) + 2 * bj + (wc >> 1);
                int rowb = row0; asm volatile("" : "+v"(rowb));
                float ks[2][4];
#pragma unroll
                for (int b = 0; b < 2; ++b)
#pragma unroll
                    for (int i = 0; i < 4; ++i) ks[b][i] = 0.f;
#pragma unroll
                for (int ai = 0; ai < 2; ++ai)
#pragma unroll
                    for (int m = 0; m < 4; ++m) { const int t = rowb + ai * 128 + m * 16;
                        const pg8::f32x4 cs = *(const pg8::f32x4*)(rc + (size_t)t * 32 + p0), sn = *(const pg8::f32x4*)(rs + (size_t)t * 32 + p0);
                        const pg8::f32x4 t1 = acc[ai][bj][m][0], t2 = acc[ai][bj][m][1];
                        const pg8::f32x4 o1 = t1 * cs - t2 * sn, o2 = t2 * cs + t1 * sn;
                        v2u w1, w2; w1.x = pk2(o1[0] * sc, o1[1] * sc); w1.y = pk2(o1[2] * sc, o1[3] * sc); w2.x = pk2(o2[0] * sc, o2[1] * sc); w2.y = pk2(o2[2] * sc, o2[3] * sc);
                        bf16* dst = X + (size_t)t * AW + head * 64 + p0;
                        st8(dst, w1); st8(dst + 32, w2);
#pragma unroll
                        for (int i = 0; i < 4; ++i) { ks[0][i] += o1[i]; ks[1][i] += o2[i]; }
                        __builtin_amdgcn_sched_barrier(0); }
                if (isk) {
                    const int b = u.pm >> 5, blk = u.pm & 31;
#pragma unroll
                    for (int n = 0; n < 2; ++n)
#pragma unroll
                        for (int i = 0; i < 4; ++i) { float v = ks[n][i];
                            v += __shfl_xor(v, 1); v += __shfl_xor(v, 2); v += __shfl_xor(v, 4); v += __shfl_xor(v, 8);
                            if (fr == 0) atomicAdd(km + ((size_t)((b * NH + head) * NBLK + blk) * HD + 32 * n + p0 + i), v); }
                }
            }
        } else if (pn < 8) {
#pragma unroll
            for (int ai = 0; ai < 2; ++ai)
#pragma unroll
                for (int m = 0; m < 4; ++m) { const int t = row0 + ai * 128 + m * 16, b = t >> 13, tt = t & (SEQ - 1);
#pragma unroll
                    for (int bj = 0; bj < 2; ++bj) { const int cv = (pn - 6) * 256 + bj * 128 + wc * 32 + 8 * fq, head = cv >> 6, d = cv & 63;
                        const pg8::f32x4 v0 = acc[ai][bj][m][0], v1 = acc[ai][bj][m][1];
                        v4u w; w.x = pk2(v0[0], v0[1]); w.y = pk2(v0[2], v0[3]); w.z = pk2(v1[0], v1[1]); w.w = pk2(v1[2], v1[3]);
                        bf16* vt = VT + ((size_t)((b * NH + head) * HD + d) * SEQ + tt);
                        vt[0 * SEQ] = (bf16)(w.x & 0xffff); vt[1 * SEQ] = (bf16)(w.x >> 16); vt[2 * SEQ] = (bf16)(w.y & 0xffff); vt[3 * SEQ] = (bf16)(w.y >> 16);
                        vt[4 * SEQ] = (bf16)(w.z & 0xffff); vt[5 * SEQ] = (bf16)(w.z >> 16); vt[6 * SEQ] = (bf16)(w.w & 0xffff); vt[7 * SEQ] = (bf16)(w.w >> 16); } }
        } else {
            bf16* Gp = (pn < 12) ? GSp : GAp; const int cb = ((pn - 8) & 3) * 256;
#pragma unroll
            for (int ai = 0; ai < 2; ++ai)
#pragma unroll
                for (int m = 0; m < 4; ++m) { const int t = row0 + ai * 128 + m * 16;
#pragma unroll
                    for (int bj = 0; bj < 2; ++bj) { const int col = cb + bj * 128 + wc * 32 + 8 * fq;
                        const pg8::f32x4 v0 = acc[ai][bj][m][0], v1 = acc[ai][bj][m][1];
                        v4u w; w.x = pk2(sigmoidf_(v0[0]), sigmoidf_(v0[1])); w.y = pk2(sigmoidf_(v0[2]), sigmoidf_(v0[3]));
                        w.z = pk2(sigmoidf_(v1[0]), sigmoidf_(v1[1])); w.w = pk2(sigmoidf_(v1[2]), sigmoidf_(v1[3]));
                        __builtin_nontemporal_store(w, (v4u*)(Gp + (size_t)t * D + col)); } }
        }
    }
};

template <int MODE> struct EpiEw {
    bf16* O; const bf16* X1; const bf16* X2; float* Of; int ld;
    __device__ __forceinline__ void operator()(const pg8::f32x4 (&acc)[2][2][4][2], const pg8::Unit& u, int wr, int wc, int fr, int fq) const {
        const int row0 = u.pm * 256 + wr * 64 + fr, col0 = u.pn * 256 + wc * 32 + 8 * fq;
#pragma unroll
        for (int ai = 0; ai < 2; ++ai)
#pragma unroll
            for (int m = 0; m < 4; ++m) { const size_t rb = (size_t)(row0 + ai * 128 + m * 16) * ld + col0;
#pragma unroll
                for (int bj = 0; bj < 2; ++bj) { const size_t off = rb + bj * 128;
                    const pg8::f32x4 v0 = acc[ai][bj][m][0], v1 = acc[ai][bj][m][1];
                    if (MODE == 3) { *(pg8::f32x4*)(Of + off) = v0; *(pg8::f32x4*)(Of + off + 4) = v1; }
                    else if (MODE == 4) { v4u w; w.x = pk2(v0[0], v0[1]); w.y = pk2(v0[2], v0[3]); w.z = pk2(v1[0], v1[1]); w.w = pk2(v1[2], v1[3]); st16(O + off, w); }
                    else {
                        const v4u x = __builtin_nontemporal_load((const v4u*)(X1 + off));
                        float r[8] = {v0[0], v0[1], v0[2], v0[3], v1[0], v1[1], v1[2], v1[3]};
                        const float xv[8] = {bflo(x.x), bfhi(x.x), bflo(x.y), bfhi(x.y), bflo(x.z), bfhi(x.z), bflo(x.w), bfhi(x.w)};
                        if (MODE == 0) {
#pragma unroll
                            for (int i = 0; i < 8; ++i) r[i] = xv[i] * sigmoidf_(r[i]);
                        } else if (MODE == 1) {
#pragma unroll
                            for (int i = 0; i < 8; ++i) r[i] = xv[i] * r[i];
                        } else {
                            const v4u y = __builtin_nontemporal_load((const v4u*)(X2 + off));
                            const float yv[8] = {bflo(y.x), bfhi(y.x), bflo(y.y), bfhi(y.y), bflo(y.z), bfhi(y.z), bflo(y.w), bfhi(y.w)};
#pragma unroll
                            for (int i = 0; i < 8; ++i) r[i] = yv[i] + xv[i] * r[i];
                        }
                        v4u w; w.x = pk2(r[0], r[1]); w.y = pk2(r[2], r[3]); w.z = pk2(r[4], r[5]); w.w = pk2(r[6], r[7]);
                        st16(O + off, w); } } }
    }
};

typedef short bf16x8 __attribute__((ext_vector_type(8)));
typedef float f32x16 __attribute__((ext_vector_type(16)));
constexpr size_t WS_ALIST = 456 * MiB;
constexpr size_t WS_OP01 = 224 * MiB;
constexpr size_t WS_OP23 = 472 * MiB;
constexpr size_t WS_LSE = 504 * MiB;
constexpr int CW_BCNT = 12288;
constexpr int ALCAP = 8192;

__device__ __forceinline__ void attn_gate(Frame& F) {
    const int gw = F.vcu * NWAVES + F.wave, NGW = F.G * NWAVES, L = F.lane;
    const bf16* Q = WSP(bf16, WS_Q); const float* km = (const float*)(F.ctl + CW_KM);
    unsigned* bcnt = (unsigned*)(F.ctl + CW_BCNT); unsigned* list = WSP(unsigned, WS_ALIST); float* lse = WSP(float, WS_LSE);
    for (int w = gw; w < BATCH * NH * (SEQ / 64); w += NGW) {
        const int bh = w >> 7, b = bh >> 3, h = bh & 7, tt = (w & 127) * 64 + L, t = b * SEQ + tt, blk = tt >> 8;
        float q[64];
        { const v4u* qp = (const v4u*)(Q + (size_t)t * AW + h * 64);
#pragma unroll
          for (int i = 0; i < 8; ++i) { const v4u x = qp[i]; q[8 * i] = bflo(x.x); q[8 * i + 1] = bfhi(x.x); q[8 * i + 2] = bflo(x.y); q[8 * i + 3] = bfhi(x.y);
              q[8 * i + 4] = bflo(x.z); q[8 * i + 5] = bfhi(x.z); q[8 * i + 6] = bflo(x.w); q[8 * i + 7] = bfhi(x.w); } }
        float v0 = -3e38f, v1 = -3e38f, v2 = -3e38f; int i0 = -1, i1 = -1, i2 = -1;
        for (int j = 0; j < blk; ++j) { const float* kp = km + (size_t)((b * NH + h) * NBLK + j) * HD; float g = 0.f;
#pragma unroll
            for (int d = 0; d < 64; ++d) g += q[d] * kp[d];
            if (g > v0) { v2 = v1; i2 = i1; v1 = v0; i1 = i0; v0 = g; i0 = j; }
            else if (g > v1) { v2 = v1; i2 = i1; v1 = g; i1 = j; }
            else if (g > v2) { v2 = g; i2 = j; } }
        float* lp = lse + ((size_t)t * NH + h) * 4;
        if (i0 < 0) lp[0] = -1e30f; if (i1 < 0) lp[1] = -1e30f; if (i2 < 0) lp[2] = -1e30f;
        for (int j = 0; j < blk; ++j) {
            const bool sel = (i0 == j) || (i1 == j) || (i2 == j);
            const unsigned long long mask = __ballot(sel);
            if (mask) { const int leader = __ffsll((long long)mask) - 1; const int bucket = (b * NH + h) * NBLK + j;
                unsigned base = 0u;
                if (L == leader) base = __hip_atomic_fetch_add(bcnt + bucket, (unsigned)__popcll(mask), RLX_AGENT);
                base = (unsigned)__shfl((int)base, leader);
                if (sel) { const unsigned pos = base + (unsigned)__popcll(mask & ((1ull << L) - 1ull)); const unsigned slot = (i0 == j) ? 0u : ((i1 == j) ? 1u : 2u);
                    list[(size_t)bucket * ALCAP + pos] = ((unsigned)tt << 2) | slot; } }
        }
    }
}

__device__ __forceinline__ unsigned cvtpk(float lo, float hi) { typedef float f32x2_t __attribute__((ext_vector_type(2))); typedef __bf16 bf16x2_t __attribute__((ext_vector_type(2)));
    f32x2_t v = {lo, hi}; bf16x2_t r = __builtin_convertvector(v, bf16x2_t); return __builtin_bit_cast(unsigned, r); }

constexpr int AT_KROW = 144, AT_VROW = 520, AT_KOFF = 0, AT_VOFF = 256 * AT_KROW;
__device__ __forceinline__ void attn_item(Frame& F, int b, int h, int j, bool own, const unsigned* lst, int nvalid) {
    const int tid = F.tid, L = F.lane, r = L & 31, hh = L >> 5, wv = F.wave;
    LAS unsigned char* Kl = F.lds + AT_KOFF; LAS unsigned char* Vl = F.lds + AT_VOFF;
    const bf16* Kg = WSP(bf16, WS_K) + ((size_t)(b * SEQ + j * 256)) * AW + h * 64;
    const bf16* Vg = WSP(bf16, WS_VT) + ((size_t)((b * NH + h) * HD)) * SEQ + j * 256;
    v4u kr[4], vr[4];
#pragma unroll
    for (int i = 0; i < 4; ++i) { const int idx = tid + 512 * i; kr[i] = *(const v4u*)(Kg + (size_t)(idx >> 3) * AW + (idx & 7) * 8); vr[i] = *(const v4u*)(Vg + (size_t)(idx >> 5) * SEQ + (idx & 31) * 8); }
    const int qi = wv * 32 + r; const bool valid = qi < nvalid;
    unsigned ent; if (own) ent = ((unsigned)(j * 256 + qi) << 2) | 3u; else ent = lst[valid ? qi : 0];
    const int tt = (int)(ent >> 2), slot = (int)(ent & 3u), t = b * SEQ + tt;
    bf16x8 qf[4];
    { const bf16* qp = WSP(bf16, WS_Q) + (size_t)t * AW + h * 64 + hh * 8;
#pragma unroll
      for (int d0 = 0; d0 < 4; ++d0) qf[d0] = *(const bf16x8*)(qp + d0 * 16); }
#pragma unroll
    for (int i = 0; i < 4; ++i) { const int idx = tid + 512 * i; *(LAS v4u*)(Kl + (idx >> 3) * AT_KROW + (idx & 7) * 16) = kr[i]; *(LAS v4u*)(Vl + (idx >> 5) * AT_VROW + (idx & 31) * 16) = vr[i]; }
    __syncthreads();
#ifdef ATT_STAGGER
    if (wv >= 4) __builtin_amdgcn_s_sleep(ATT_STAGGER);
#endif
#ifdef ATT_REP_COMPUTE
    for (int arep = 0; arep < 2; ++arep)
#endif
    if (wv * 32 < nvalid) {
        float m = -1e30f, l = 0.f; f32x16 O0 = {}, O1 = {};
        const int qrel = tt & 255;
#pragma unroll
        for (int hk = 0; hk < 2; ++hk) {
            if (own && hk * 4 > wv) continue;
            f32x16 S[4];
#pragma unroll
            for (int kt = 0; kt < 4; ++kt) S[kt] = (f32x16){};
#pragma unroll
            for (int d0 = 0; d0 < 4; ++d0) {
#pragma unroll
                for (int kt = 0; kt < 4; ++kt) { const bf16x8 kf = *(const LAS bf16x8*)(Kl + (hk * 128 + kt * 32 + r) * AT_KROW + d0 * 32 + hh * 16);
                    S[kt] = __builtin_amdgcn_mfma_f32_32x32x16_bf16(kf, qf[d0], S[kt], 0, 0, 0); }
                if (d0 & 1) __builtin_amdgcn_sched_barrier(0); }
            if (own) {
                asm volatile("; causal masking (own block only)" ::: "memory");
#pragma unroll
                for (int kt = 0; kt < 4; ++kt)
#pragma unroll
                    for (int rg = 0; rg < 16; ++rg) { const int key = hk * 128 + kt * 32 + (rg & 3) + 8 * (rg >> 2) + 4 * hh; if (key > qrel) S[kt][rg] = -1e30f; } }
            float mx = S[0][0];
#pragma unroll
            for (int kt = 0; kt < 4; ++kt)
#pragma unroll
                for (int rg = 0; rg < 16; ++rg) mx = fmaxf(mx, S[kt][rg]);
            mx = fmaxf(mx, __shfl_xor(mx, 32));
            const float mn = fmaxf(m, mx), alpha = __builtin_amdgcn_exp2f(m - mn); m = mn; l *= alpha;
#pragma unroll
            for (int rg = 0; rg < 16; ++rg) { O0[rg] *= alpha; O1[rg] *= alpha; }
            float ls = 0.f;
#pragma unroll
            for (int kt = 0; kt < 4; ++kt) {
                unsigned pw[8];
#pragma unroll
                for (int rg = 0; rg < 16; rg += 2) { const float p0 = __builtin_amdgcn_exp2f(S[kt][rg] - mn), p1 = __builtin_amdgcn_exp2f(S[kt][rg + 1] - mn); ls += p0 + p1; pw[rg >> 1] = cvtpk(p0, p1); }
#pragma unroll
                for (int s = 0; s < 2; ++s) {
                    const v4u pv = {pw[4 * s], pw[4 * s + 1], pw[4 * s + 2], pw[4 * s + 3]}; const bf16x8 pf = __builtin_bit_cast(bf16x8, pv);
                    const int kb = (hk * 128 + kt * 32 + 16 * s + 4 * hh) * 2;
                    { const LAS unsigned char* vp = Vl + r * AT_VROW + kb; const v2u lo = *(const LAS v2u*)vp, hi = *(const LAS v2u*)(vp + 16);
                      const v4u vv = {lo.x, lo.y, hi.x, hi.y}; O0 = __builtin_amdgcn_mfma_f32_32x32x16_bf16(__builtin_bit_cast(bf16x8, vv), pf, O0, 0, 0, 0); }
                    { const LAS unsigned char* vp = Vl + (32 + r) * AT_VROW + kb; const v2u lo = *(const LAS v2u*)vp, hi = *(const LAS v2u*)(vp + 16);
                      const v4u vv = {lo.x, lo.y, hi.x, hi.y}; O1 = __builtin_amdgcn_mfma_f32_32x32x16_bf16(__builtin_bit_cast(bf16x8, vv), pf, O1, 0, 0, 0); } } }
            l += ls;
        }
        l += __shfl_xor(l, 32);
        if (valid) {
            const float rl = 1.f / l;
            bf16* op = (slot < 2 ? WSP(bf16, WS_OP01) + (((size_t)t * NH + h) * 2 + slot) * 64 : WSP(bf16, WS_OP23) + (((size_t)t * NH + h) * 2 + (slot - 2)) * 64) + 4 * hh;
#pragma unroll
            for (int g4 = 0; g4 < 4; ++g4) { v2u w0, w1; w0.x = cvtpk(O0[4 * g4] * rl, O0[4 * g4 + 1] * rl); w0.y = cvtpk(O0[4 * g4 + 2] * rl, O0[4 * g4 + 3] * rl);
                w1.x = cvtpk(O1[4 * g4] * rl, O1[4 * g4 + 1] * rl); w1.y = cvtpk(O1[4 * g4 + 2] * rl, O1[4 * g4 + 3] * rl);
                *(v2u*)(op + 8 * g4) = w0; *(v2u*)(op + 32 + 8 * g4) = w1; }
            if (hh == 0) WSP(float, WS_LSE)[((size_t)t * NH + h) * 4 + slot] = m + log2f(l);
        }
    }
    __syncthreads();
}
__device__ __forceinline__ void attn_items(Frame& F) {
    LAS int* pre = (LAS int*)(F.lds + 72 * 1024);
    const unsigned* bcnt = (const unsigned*)(F.ctl + CW_BCNT);
    LAS int* cntl = pre + 520;
    for (int i = F.tid; i < 512; i += NWAVES * 64) cntl[i] = (int)__hip_atomic_load((gu32*)(F.ctl + CW_BCNT) + i, RLX_AGENT);
    __syncthreads();
    if (F.wave == 0) {
        int c8[8], s = 0;
#pragma unroll
        for (int k = 0; k < 8; ++k) { c8[k] = (cntl[F.lane * 8 + k] + 255) >> 8; s += c8[k]; }
        int inc = s;
#pragma unroll
        for (int o = 1; o < 64; o <<= 1) { const int v = __shfl_up(inc, o); if (F.lane >= o) inc += v; }
        int run = inc - s;
#pragma unroll
        for (int k = 0; k < 8; ++k) { pre[F.lane * 8 + k] = run; run += c8[k]; }
        if (F.lane == 63) pre[512] = run; }
    __syncthreads();
    const int total = 512 + pre[512];
    for (int it = (int)blockIdx.x; it < total; it += F.G) {
        int bh, j, n; bool own; const unsigned* lst;
        if (it < 512) { bh = it >> 5; j = it & 31; own = true; lst = nullptr; n = 256; }
        else { const int s = it - 512; int lo = 0, hi = 512;
            while (hi - lo > 1) { const int mid = (lo + hi) >> 1; if (pre[mid] <= s) lo = mid; else hi = mid; }
            const int bucket = lo, tile = s - pre[bucket]; n = cntl[bucket] - tile * 256; n = n > 256 ? 256 : n; bh = bucket >> 5; j = bucket & 31; own = false;
            lst = WSP(unsigned, WS_ALIST) + (size_t)bucket * ALCAP + tile * 256; }
        const int b_ = __builtin_amdgcn_readfirstlane(bh >> 3), h_ = __builtin_amdgcn_readfirstlane(bh & 7), j_ = __builtin_amdgcn_readfirstlane(j), n_ = __builtin_amdgcn_readfirstlane(n);
        attn_item(F, b_, h_, j_, own, lst, n_);
    }
}
__device__ __forceinline__ void attn_combine(Frame& F) {
    if (F.G == 256 && blockIdx.x < 128) return;
    const int nb = F.G == 256 ? 128 : F.G, bi = F.G == 256 ? (int)blockIdx.x - 128 : F.vcu;
    const int gw = bi * NWAVES + F.wave, NGW = nb * NWAVES, L = F.lane, h = L >> 3, ch = L & 7;
    const float* lse = WSP(float, WS_LSE); bf16* YA = WSP(bf16, WS_YA);
    for (int t = gw; t < T; t += NGW) {
        const size_t th = (size_t)t * NH + h;
        const f32x4 ls = *(const f32x4*)(lse + th * 4);
        const float mx = fmaxf(fmaxf(ls[0], ls[1]), fmaxf(ls[2], ls[3]));
        const float w0 = __builtin_amdgcn_exp2f(ls[0] - mx), w1 = __builtin_amdgcn_exp2f(ls[1] - mx), w2 = __builtin_amdgcn_exp2f(ls[2] - mx), w3 = __builtin_amdgcn_exp2f(ls[3] - mx), inv = 1.f / (w0 + w1 + w2 + w3);
        const v4u a0 = __builtin_nontemporal_load((const v4u*)(WSP(bf16, WS_OP01) + (th * 2 + 0) * 64 + ch * 8)), a1 = __builtin_nontemporal_load((const v4u*)(WSP(bf16, WS_OP01) + (th * 2 + 1) * 64 + ch * 8));
        const v4u a2 = __builtin_nontemporal_load((const v4u*)(WSP(bf16, WS_OP23) + (th * 2 + 0) * 64 + ch * 8)), a3 = __builtin_nontemporal_load((const v4u*)(WSP(bf16, WS_OP23) + (th * 2 + 1) * 64 + ch * 8));
        float o[8];
        const unsigned x0[4] = {a0.x, a0.y, a0.z, a0.w}, x1[4] = {a1.x, a1.y, a1.z, a1.w}, x2[4] = {a2.x, a2.y, a2.z, a2.w}, x3[4] = {a3.x, a3.y, a3.z, a3.w};
#pragma unroll
        for (int i = 0; i < 4; ++i) {
            float lo_ = w3 * bflo(x3[i]), hi_ = w3 * bfhi(x3[i]);
            if (ls[0] > -1e29f) { lo_ += w0 * bflo(x0[i]); hi_ += w0 * bfhi(x0[i]); }
            if (ls[1] > -1e29f) { lo_ += w1 * bflo(x1[i]); hi_ += w1 * bfhi(x1[i]); }
            if (ls[2] > -1e29f) { lo_ += w2 * bflo(x2[i]); hi_ += w2 * bfhi(x2[i]); }
            o[2 * i] = lo_ * inv; o[2 * i + 1] = hi_ * inv; }
        v4u w; w.x = cvtpk(o[0], o[1]); w.y = cvtpk(o[2], o[3]); w.z = cvtpk(o[4], o[5]); w.w = cvtpk(o[6], o[7]);
        *(v4u*)(YA + (size_t)t * AW + h * 64 + ch * 8) = w;
    }
}
struct S5Order { static constexpr bool GATHER = false; int G, c;
    __device__ __forceinline__ void a_ready(const pg8::Unit&) const {}
    __device__ __forceinline__ void done(const pg8::Unit&) const {}
    __device__ __forceinline__ bool next(int i, pg8::Unit& u) const { const int L = i * G + c; if (L >= NG * 4) return false; const int g = L >> 2, rt = L & 3;
        u.arow = g * 1024 + rt * 256; u.brow = g * 256; u.pm = rt; u.pn = 0; u.e = g; u.nrow = 256; u.kind = 0; u.aux = 0; return true; } };
struct EpiS5A { float* E;
    __device__ __forceinline__ void operator()(const pg8::f32x4 (&acc)[2][2][4][2], const pg8::Unit& u, int wr, int wc, int fr, int fq) const {
        asm volatile("" : "+v"(fr), "+v"(fq));
#pragma unroll
        for (int ai = 0; ai < 2; ++ai)
#pragma unroll
            for (int m = 0; m < 4; ++m) { float* p = E + (size_t)(u.arow + ai * 128 + wr * 64 + m * 16 + fr) * 128 + wc * 32 + 8 * fq;
                *(pg8::f32x4*)p = acc[ai][0][m][0]; *(pg8::f32x4*)(p + 4) = acc[ai][0][m][1]; }
    }
};
struct EpiS5C { bf16* YG;
    __device__ __forceinline__ void operator()(const pg8::f32x4 (&acc)[2][2][4][2], const pg8::Unit& u, int wr, int wc, int fr, int fq) const {
        asm volatile("" : "+v"(fr), "+v"(fq));
        const int g = u.e, n0 = wc * 32 + 8 * fq, t0 = n0 >> 4, co0 = n0 & 15;
#pragma unroll
        for (int ai = 0; ai < 2; ++ai)
#pragma unroll
            for (int m = 0; m < 4; ++m) { const int row = u.pm * 256 + ai * 128 + wr * 64 + m * 16 + fr, b = row >> 9, c = row & 511;
                bf16* yp = YG + (size_t)(b * SEQ + 16 * c + t0) * SW + 16 * g + co0;
#pragma unroll
                for (int bj = 0; bj < 2; ++bj) {
                    const pg8::f32x4 v0 = acc[ai][bj][m][0], v1 = acc[ai][bj][m][1];
                    v4u w; w.x = pk2(gelu_tanh(v0[0]), gelu_tanh(v0[1])); w.y = pk2(gelu_tanh(v0[2]), gelu_tanh(v0[3]));
                    w.z = pk2(gelu_tanh(v1[0]), gelu_tanh(v1[1])); w.w = pk2(gelu_tanh(v1[2]), gelu_tanh(v1[3]));
                    *(v4u*)(yp + (size_t)bj * 8 * SW) = w; }
                __builtin_amdgcn_sched_barrier(0); }
    }
};
__device__ __forceinline__ void s5_fill_kt(Frame& F) {
    const int gt = F.vcu * (NWAVES * 64) + F.tid, NGT = F.G * NWAVES * 64;
    const float* P5 = WSP(float, WS_S5P); const float* PWr = P5 + 131072; const float* PWi = PWr + 2048 * 17; const float* par = WSP(float, WS_PAR);
    float* KT = WSP(float, WS_S5KT);
    for (int i = gt; i < NG * 16 * 256; i += NGT) { const int ci = i & 15, co = (i >> 4) & 15, tau = (i >> 8) & 15, g = i >> 12; float a = 0.f;
        for (int p = 0; p < 64; ++p) { const int gp = g * 64 + p;
            const float qr = P5[8192 + gp], qi = P5[8192 + 2048 + gp], b_r = par[PAR_BRE + gp * 16 + ci], b_i = par[PAR_BIM + gp * 16 + ci];
            const float bbr = qr * b_r - qi * b_i, bbi = qr * b_i + qi * b_r, wr_ = PWr[gp * 17 + tau], wi_ = PWi[gp * 17 + tau];
            const float xr = wr_ * bbr - wi_ * bbi, xi = wr_ * bbi + wi_ * bbr;
            const float cr = par[PAR_CRE + (g * 16 + co) * 64 + p], ci_ = par[PAR_CIM + (g * 16 + co) * 64 + p];
            a += cr * xr - ci_ * xi; }
        KT[i] = a; }
}
__device__ __forceinline__ void s5_fill_wc(Frame& F) {
    const int gt = F.vcu * (NWAVES * 64) + F.tid, NGT = F.G * NWAVES * 64;
    const float* P5 = WSP(float, WS_S5P); const float* PWr = P5 + 131072; const float* PWi = PWr + 2048 * 17; const float* KT = WSP(float, WS_S5KT); const float* par = WSP(float, WS_PAR);
    bf16* Wc = WSP(bf16, WS_S5WC);
    for (int i = gt; i < NG * 256 * 384; i += NGT) { const int k = i % 384, n = (i / 384) & 255, g = i / (384 * 256), t = n >> 4, co = n & 15; float val = 0.f;
        if (k < 256) { const int s_ = k >> 4, ci = k & 15;
            if (s_ <= t) val = KT[((g * 16 + (t - s_)) * 16 + co) * 16 + ci];
            if (s_ == t && ci == co) val += par[PAR_SD + g * 16 + co]; }
        else { const int p = (k - 256) & 63, gp = g * 64 + p; const float cr = par[PAR_CRE + (g * 16 + co) * 64 + p], ci_ = par[PAR_CIM + (g * 16 + co) * 64 + p];
            const float wr_ = PWr[gp * 17 + t + 1], wi_ = PWi[gp * 17 + t + 1];
            val = (k < 320) ? (cr * wr_ - ci_ * wi_) : -(cr * wi_ + ci_ * wr_); }
        Wc[((size_t)(g * 256 + perm8(n))) * 384 + k] = (bf16)f2bf(val); }
}
__device__ __forceinline__ void s5_carry(Frame& F) {
    const float* P5 = WSP(float, WS_S5P); const float* PWr = P5 + 131072; const float* PWi = PWr + 2048 * 17; const float* E = WSP(float, WS_S5E); bf16* UA = WSP(bf16, WS_UA);
    LAS float* Z = (LAS float*)(F.lds);
    const int seg = F.wave, p = F.lane;
    for (int bg = F.vcu; bg < BATCH * NG; bg += F.G) { const int b = bg / NG, g = bg % NG, gp = g * 64 + p;
        const float ar = PWr[gp * 17 + 16], ai = PWi[gp * 17 + 16];
        const size_t row0 = (size_t)g * 1024 + b * 512 + seg * 64;
        float zr = 0.f, zi = 0.f;
        for (int c0 = 0; c0 < 64; c0 += 8) { float er[8], ei[8];
#pragma unroll
            for (int k = 0; k < 8; ++k) { er[k] = E[(row0 + c0 + k) * 128 + p]; ei[k] = E[(row0 + c0 + k) * 128 + 64 + p]; }
#pragma unroll
            for (int k = 0; k < 8; ++k) { const float nr = ar * zr - ai * zi + er[k], ni = ar * zi + ai * zr + ei[k]; zr = nr; zi = ni; } }
        Z[(seg * 64 + p) * 2] = zr; Z[(seg * 64 + p) * 2 + 1] = zi;
        __syncthreads();
        if (seg == 0) { float br = ar, bi = ai;
#pragma unroll
            for (int k = 0; k < 6; ++k) { const float tr = br * br - bi * bi, ti = 2.f * br * bi; br = tr; bi = ti; }
            float sr = 0.f, si = 0.f;
            for (int sg = 0; sg < 8; ++sg) { const float xr = Z[(sg * 64 + p) * 2], xi = Z[(sg * 64 + p) * 2 + 1]; Z[(sg * 64 + p) * 2] = sr; Z[(sg * 64 + p) * 2 + 1] = si;
                const float nr = br * sr - bi * si + xr, ni = br * si + bi * sr + xi; sr = nr; si = ni; } }
        __syncthreads();
        float sr = Z[(seg * 64 + p) * 2], si = Z[(seg * 64 + p) * 2 + 1];
        for (int c0 = 0; c0 < 64; c0 += 8) { float er[8], ei[8];
#pragma unroll
            for (int k = 0; k < 8; ++k) { er[k] = E[(row0 + c0 + k) * 128 + p]; ei[k] = E[(row0 + c0 + k) * 128 + 64 + p]; }
#pragma unroll
            for (int k = 0; k < 8; ++k) { bf16* up = UA + (row0 + c0 + k) * 384 + 256 + p; up[0] = (bf16)f2bf(sr); up[64] = (bf16)f2bf(si);
                const float nr = ar * sr - ai * si + er[k], ni = ar * si + ai * sr + ei[k]; sr = nr; si = ni; } }
        __syncthreads();
    }
}
constexpr int SCR_OFF = LDSCTL_OFF + 512;
#ifndef MOE_LAG
#define MOE_LAG 2
#endif
constexpr int MT_SEG = 100, MT_MAXSEG = 72, MT_ULIST = 400, MT_MAXU = 16;
__device__ __forceinline__ void phase_rows(Frame& F, bool dry = false) {
    LAS float* h2t = (LAS float*)(F.lds);
    LAS float* lg = (LAS float*)(F.lds + 65536);
    LAS float* gtm = (LAS float*)(F.lds + 131072);
    LAS float* pg2 = gtm + 2 * D; LAS float* shf = pg2 + 2 * D;
    LAS unsigned* hist = (LAS unsigned*)(F.lds + SCR_OFF); LAS unsigned* base = hist + 32; LAS int* rec_e = (LAS int*)(base + 32); LAS int* rec_lp = rec_e + 256;
    const float* adaf = WSP(float, WS_ADAF); const float* par = WSP(float, WS_PAR);
    const int L = F.lane, wv = F.wave;
    for (int i = F.tid; i < 2 * D; i += NWAVES * 64) { const int b = i >> 10, k = i & (D - 1);
        gtm[i] = adaf[b * 6 * D + 2 * D + k] * par[PAR_MPG + k];
        pg2[i] = par[PAR_FPRE + k] * (1.f + adaf[b * 6 * D + 4 * D + k]); shf[i] = adaf[b * 6 * D + 3 * D + k]; }
    f32x4 wreg[16];
#pragma unroll
    for (int j = 0; j < 4; ++j)
#pragma unroll
        for (int i = 0; i < 4; ++i) wreg[j * 4 + i] = *(const f32x4*)(par + PAR_RW + (4 * L + 256 * j + i) * NE + 4 * wv);
    if (F.tid < 32) hist[F.tid] = 0u;
    __syncthreads();
    const bf16* mix = WSP(bf16, WS_MIX); bf16* H2 = WSP(bf16, WS_H2); bf16* X1B = WSP(bf16, WS_X1B);
    int* tok_e = WSP(int, WS_ROUTE); float* tok_w = (float*)(tok_e + T * 4); int* tok_pos = tok_e + 2 * T * 4;
    unsigned* gcnt = (unsigned*)(F.ctl + CW_ECNT);
    for (int t0 = F.vcu * 16; t0 < T; t0 += F.G * 16) {
        {
            const int t = t0 + 2 * wv, b = t >> 13;
            f32x4 mv[2][4], xv[2][4];
#pragma unroll
            for (int q = 0; q < 2; ++q) { const GAS v2u* mr = (const GAS v2u*)(mix + (size_t)(t + q) * D) + L; const GAS f32x4* xr = (const GAS f32x4*)(F.in[0] + (size_t)(t + q) * D) + L;
#pragma unroll
                for (int j = 0; j < 4; ++j) { const v2u mw = __builtin_nontemporal_load(mr + 64 * j); mv[q][j] = (f32x4){bflo(mw.x), bfhi(mw.x), bflo(mw.y), bfhi(mw.y)}; xv[q][j] = __builtin_nontemporal_load(xr + 64 * j); } }
#pragma unroll
            for (int q = 0; q < 2; ++q) { float s = 0.f;
#pragma unroll
                for (int j = 0; j < 4; ++j) s += (mv[q][j].x * mv[q][j].x + mv[q][j].y * mv[q][j].y) + (mv[q][j].z * mv[q][j].z + mv[q][j].w * mv[q][j].w);
                const float r1 = 1.f / sqrtf(wave_sum(s) * (1.f / D) + NORM_EPS);
                float s2 = 0.f; GAS v2u* orow = (GAS v2u*)(X1B + (size_t)(t + q) * D) + L;
#pragma unroll
                for (int j = 0; j < 4; ++j) { const f32x4 g = *(const LAS f32x4*)(gtm + b * D + 4 * L + 256 * j);
                    xv[q][j] = xv[q][j] + g * (mv[q][j] * r1); { v2u w; w.x = pk2(xv[q][j].x, xv[q][j].y); w.y = pk2(xv[q][j].z, xv[q][j].w); __builtin_nontemporal_store(w, orow + 64 * j); }
                    s2 += (xv[q][j].x * xv[q][j].x + xv[q][j].y * xv[q][j].y) + (xv[q][j].z * xv[q][j].z + xv[q][j].w * xv[q][j].w); }
                const float r2 = 1.f / sqrtf(wave_sum(s2) * (1.f / D) + NORM_EPS);
#ifdef MOE_F8
                GAS unsigned* h4 = (GAS unsigned*)(WSP(unsigned char, WS_H2) + (size_t)(t + q) * D) + L;
#pragma unroll
                for (int j = 0; j < 4; ++j) { const f32x4 a = *(const LAS f32x4*)(pg2 + b * D + 4 * L + 256 * j), c = *(const LAS f32x4*)(shf + b * D + 4 * L + 256 * j);
                    const f32x4 h = xv[q][j] * r2 * a + c;
                    h4[64 * j] = pk4_fp8(8.f * h.x, 8.f * h.y, 8.f * h.z, 8.f * h.w);
                    *(LAS f32x4*)(h2t + (2 * wv + q) * D + 4 * L + 256 * j) = h; } }
#else
                GAS unsigned long long* h8 = (GAS unsigned long long*)(H2 + (size_t)(t + q) * D) + L;
#pragma unroll
                for (int j = 0; j < 4; ++j) { const f32x4 a = *(const LAS f32x4*)(pg2 + b * D + 4 * L + 256 * j), c = *(const LAS f32x4*)(shf + b * D + 4 * L + 256 * j);
                    const f32x4 h = xv[q][j] * r2 * a + c;
                    h8[64 * j] = (unsigned long long)pk2(h.x, h.y) | ((unsigned long long)pk2(h.z, h.w) << 32);
                    *(LAS f32x4*)(h2t + (2 * wv + q) * D + 4 * L + 256 * j) = h; } }
#endif
        }
        __syncthreads();
        {
            const int hi = (L >> 5) & 1, h2b = (L >> 4) & 1;
#pragma unroll 2
            for (int tk = 0; tk < 16; ++tk) {
                f32x4 a = {0.f, 0.f, 0.f, 0.f};
#pragma unroll
                for (int j = 0; j < 4; ++j) { const f32x4 h = *(const LAS f32x4*)(h2t + tk * D + 4 * L + 256 * j);
                    a += wreg[j * 4 + 0] * h.x; a += wreg[j * 4 + 1] * h.y; a += wreg[j * 4 + 2] * h.z; a += wreg[j * 4 + 3] * h.w; }
                const float m0 = hi ? a.z : a.x, o0 = hi ? a.x : a.z, m1 = hi ? a.w : a.y, o1 = hi ? a.y : a.w;
                const float v0 = m0 + __shfl_xor(o0, 32), v1 = m1 + __shfl_xor(o1, 32);
                float v = (h2b ? v1 : v0) + __shfl_xor(h2b ? v0 : v1, 16);
                v += __shfl_xor(v, 8); v += __shfl_xor(v, 4); v += __shfl_xor(v, 2); v += __shfl_xor(v, 1);
                if ((L & 15) == 0) lg[tk * NE + 4 * wv + 2 * hi + h2b] = v;
            }
        }
        __syncthreads();
        {
            const int e = L & 31, half = L >> 5, tl = 2 * wv + half, t = t0 + tl;
            float val = lg[tl * NE + e] + par[PAR_RB + e];
            int se[4]; float sv[4];
#pragma unroll
            for (int r = 0; r < 4; ++r) { float mx = val;
                mx = fmaxf(mx, __shfl_xor(mx, 16)); mx = fmaxf(mx, __shfl_xor(mx, 8)); mx = fmaxf(mx, __shfl_xor(mx, 4)); mx = fmaxf(mx, __shfl_xor(mx, 2)); mx = fmaxf(mx, __shfl_xor(mx, 1));
                const unsigned long long bal = __ballot(val == mx); const unsigned hm = half ? (unsigned)(bal >> 32) : (unsigned)bal; const int win = __ffs((int)hm) - 1;
                se[r] = win; sv[r] = mx; if (e == win) val = -3e38f; }
            const float e1 = __expf(sv[1] - sv[0]), e2 = __expf(sv[2] - sv[0]), e3 = __expf(sv[3] - sv[0]), inv = 1.f / (1.f + e1 + e2 + e3);
            if (e < 4) { const int ex = e == 0 ? se[0] : (e == 1 ? se[1] : (e == 2 ? se[2] : se[3]));
                const float wgt = (e == 0 ? 1.f : (e == 1 ? e1 : (e == 2 ? e2 : e3))) * inv;
                tok_e[t * 4 + e] = ex; tok_w[t * 4 + e] = wgt;
                const unsigned lp = dry ? 0u : __hip_atomic_fetch_add(hist + ex, 1u, __ATOMIC_RELAXED, __HIP_MEMORY_SCOPE_WORKGROUP);
                rec_e[tl * 4 + e] = ex; rec_lp[tl * 4 + e] = (int)lp; }
        }
        __syncthreads();
        if (F.tid < 32) { const unsigned h = hist[F.tid]; base[F.tid] = h ? __hip_atomic_fetch_add(gcnt + F.tid, h, RLX_AGENT) : 0u; }
        __syncthreads();
        if (!dry && F.tid < 64) { const int e_ = rec_e[F.tid], pos_ = (int)base[e_] + rec_lp[F.tid]; tok_pos[(t0 + (F.tid >> 2)) * 4 + (F.tid & 3)] = pos_;
            WSP(int, WS_ELIST)[e_ * ELCAP + pos_] = t0 + (F.tid >> 2); }
        if (F.tid < 32) hist[F.tid] = 0u;
        __syncthreads();
    }
}

__device__ __forceinline__ void moe_tables(Frame& F, int nct = 0, int brows = 0) {
    LAS int* cnt = (LAS int*)(F.lds + SCR_OFF); LAS int* off = cnt + 32; LAS int* tpre = off + 32;
    if (F.tid < NE) cnt[F.tid] = (int)__hip_atomic_load(F.ctl + CW_ECNT + F.tid, RLX_AGENT);
    __syncthreads();
    if (F.tid == 0) { int o = 0, tp = 0;
        for (int e = 0; e < NE; ++e) { const int c = cnt[e]; off[e] = o; tpre[e] = tp; o += c; tp += (c + 255) >> 8; }
        tpre[NE] = tp;
#ifdef MOE_FUSED
        LAS int* sg = cnt + MT_SEG; const int n = (tp + 31) >> 5; int ns = 0, pos = 0;
        for (int g = 0; g < n; ++g) { const int tg = (tp - 32 * g) < 32 ? (tp - 32 * g) : 32;
            sg[1 + ns] = pos; sg[1 + MT_MAXSEG + ns] = 0; sg[1 + 2 * MT_MAXSEG + ns] = g; ++ns; pos += 8 * tg; sg[1 + 3 * MT_MAXSEG + g] = pos;
            if (g >= MOE_LAG) { sg[1 + ns] = pos; sg[1 + MT_MAXSEG + ns] = 1; sg[1 + 2 * MT_MAXSEG + ns] = g - MOE_LAG; ++ns; pos += 4 * 32; } }
        for (int g = (n > MOE_LAG ? n - MOE_LAG : 0); g < n; ++g) { const int tg = (tp - 32 * g) < 32 ? (tp - 32 * g) : 32; sg[1 + ns] = pos; sg[1 + MT_MAXSEG + ns] = 1; sg[1 + 2 * MT_MAXSEG + ns] = g; ++ns; pos += 4 * tg; }
        sg[1 + ns] = pos; sg[0] = ns;
#endif
    }
    __syncthreads();
    if (nct > 0 && F.G == 256 && F.tid < MT_MAXU) {
        LAS int* ul = cnt + MT_ULIST + 8 * F.tid; const int i = F.tid, c = (int)blockIdx.x, xcd = c & 7, slot = c >> 3, rpx = 32 / nct;
        const int rtg = (i * 8 + xcd) * rpx + slot / nct, pn = slot % nct;
        if (rtg >= tpre[NE]) { ul[0] = -1; }
        else { int e = 0; for (int k = 1; k < NE; ++k) if (tpre[k] <= rtg) e = k;
            const int rt = rtg - tpre[e], nr = cnt[e] - rt * 256;
            ul[0] = off[e] + rt * 256; ul[1] = e * brows + pn * 256; ul[2] = rt; ul[3] = pn; ul[4] = e; ul[5] = nr > 256 ? 256 : nr; } }
    __syncthreads();
}
template <bool GA> struct MoeOrder {
    static constexpr bool GATHER = GA;
#if defined(T_ACQ)
    __device__ __forceinline__ void a_ready(const pg8::Unit&) const { if (!GA) { if (threadIdx.x < 64) { __builtin_amdgcn_fence(__ATOMIC_ACQUIRE, "agent"); asm volatile("s_waitcnt vmcnt(0)" ::: "memory"); } asm volatile("" ::: "memory"); __builtin_amdgcn_s_barrier(); asm volatile("" ::: "memory"); } }
#else
    __device__ __forceinline__ void a_ready(const pg8::Unit&) const {}
#endif
#if defined(T_DRAIN)
    __device__ __forceinline__ void done(const pg8::Unit&) const { if (GA) asm volatile("s_waitcnt vmcnt(0)" ::: "memory"); }
#else
    __device__ __forceinline__ void done(const pg8::Unit&) const {}
#endif
    const LAS int* tab; const int* elist; int nct, brows, G, c;
    __device__ __forceinline__ bool next(int i, pg8::Unit& u) const {
        if (G == 256) { if (i >= MT_MAXU) return false; const LAS int* ul = tab + MT_ULIST + 8 * i; const int a0 = ul[0]; if (a0 < 0) return false;
            u.arow = __builtin_amdgcn_readfirstlane(a0); u.brow = __builtin_amdgcn_readfirstlane(ul[1]); u.pm = __builtin_amdgcn_readfirstlane(ul[2]); u.pn = __builtin_amdgcn_readfirstlane(ul[3]);
            u.e = __builtin_amdgcn_readfirstlane(ul[4]); u.nrow = __builtin_amdgcn_readfirstlane(ul[5]); u.kind = 0; u.aux = 0; return true; }
        int rtg, pn;
        if (false) { const int xcd = c & 7, slot = c >> 3, rpx = 32 / nct;
            rtg = (i * 8 + xcd) * rpx + slot / nct; pn = slot % nct; if (rtg >= tab[64 + NE]) return false; }
        else { const int L = i * G + c, total = tab[64 + NE] * nct; if (L >= total) return false; rtg = L / nct; pn = L % nct; }
        int e = 0;
        for (int k = 1; k < NE; ++k) if (tab[64 + k] <= rtg) e = k;
        const int rt = rtg - tab[64 + e], cnt = tab[e], off = tab[32 + e];
        u.e = __builtin_amdgcn_readfirstlane(e); u.pm = __builtin_amdgcn_readfirstlane(rt); u.pn = pn; u.arow = __builtin_amdgcn_readfirstlane(off + rt * 256); u.brow = __builtin_amdgcn_readfirstlane(e * brows + pn * 256);
        const int nr = cnt - rt * 256; u.nrow = __builtin_amdgcn_readfirstlane(nr > 256 ? 256 : nr); u.kind = 0; u.aux = 0; return true;
    }
    __device__ __forceinline__ int arow_of(const pg8::Unit& u, int r) const { return r < u.nrow ? elist[u.e * ELCAP + u.pm * 256 + r] : 0; }
};
struct EpiGU { bf16* H1; const float* bg; const float* bu;
    __device__ __forceinline__ void operator()(const pg8::f32x4 (&acc)[2][2][4][2], const pg8::Unit& u, int wr, int wc, int fr, int fq) const {
        asm volatile("" : "+v"(fr), "+v"(fq));
        const int f0 = u.pn * 128 + wc * 32 + 8 * fq;
#pragma unroll
        for (int ai = 0; ai < 2; ++ai) {
            int fb = f0; asm volatile("" : "+v"(fb));
            const pg8::f32x4 g0 = *(const pg8::f32x4*)(bg + u.e * FF + fb), g1 = *(const pg8::f32x4*)(bg + u.e * FF + fb + 4);
            const pg8::f32x4 u0 = *(const pg8::f32x4*)(bu + u.e * FF + fb), u1 = *(const pg8::f32x4*)(bu + u.e * FF + fb + 4);
#pragma unroll
            for (int m = 0; m < 4; ++m) { const int r = ai * 128 + wr * 64 + m * 16 + fr;
                const pg8::f32x4 a0 = acc[ai][0][m][0] + g0, a1 = acc[ai][0][m][1] + g1, b0 = acc[ai][1][m][0] + u0, b1 = acc[ai][1][m][1] + u1;
                float gg[8] = {a0[0], a0[1], a0[2], a0[3], a1[0], a1[1], a1[2], a1[3]}, uu[8] = {b0[0], b0[1], b0[2], b0[3], b1[0], b1[1], b1[2], b1[3]}, o[8];
#pragma unroll
                for (int i = 0; i < 8; ++i) { const float g = fminf(gg[i], 7.f), up = fminf(fmaxf(uu[i], -7.f), 7.f); o[i] = g * sigmoidf_(1.702f * g) * (up + 1.f); }
                v4u w; w.x = pk2(o[0], o[1]); w.y = pk2(o[2], o[3]); w.z = pk2(o[4], o[5]); w.w = pk2(o[6], o[7]);
#ifdef T_SC1
                if (r < u.nrow) __builtin_amdgcn_raw_buffer_store_b128(w, __builtin_amdgcn_make_buffer_rsrc(H1, 0, (int)((size_t)T * TOPK * FF * 2), 0x00020000), (unsigned)((u.arow + r) * (FF * 2) + fb * 2), 0, 16); } }
#else
                if (r < u.nrow) *(v4u*)(H1 + (size_t)(u.arow + r) * FF + fb) = w; } }
#endif
    }
};
struct EpiDn { bf16* YB; const float* bd;
    __device__ __forceinline__ void operator()(const pg8::f32x4 (&acc)[2][2][4][2], const pg8::Unit& u, int wr, int wc, int fr, int fq) const {
        const int c0 = u.pn * 256 + wc * 32 + 8 * fq;
#pragma unroll
        for (int bj = 0; bj < 2; ++bj) { const pg8::f32x4 d0 = *(const pg8::f32x4*)(bd + u.e * D + c0 + bj * 128), d1 = *(const pg8::f32x4*)(bd + u.e * D + c0 + bj * 128 + 4);
#pragma unroll
            for (int ai = 0; ai < 2; ++ai)
#pragma unroll
                for (int m = 0; m < 4; ++m) { const int r = ai * 128 + wr * 64 + m * 16 + fr;
                    const pg8::f32x4 a0 = acc[ai][bj][m][0] + d0, a1 = acc[ai][bj][m][1] + d1;
                    v4u w; w.x = pk2(a0[0], a0[1]); w.y = pk2(a0[2], a0[3]); w.z = pk2(a1[0], a1[1]); w.w = pk2(a1[2], a1[3]);
                    if (r < u.nrow) *(v4u*)(YB + (size_t)(u.arow + r) * D + c0 + bj * 128) = w; } }
    }
};
constexpr float YB_SCALE = 16.f;
struct EpiGU8 { unsigned char* H1; const float* bg; const float* bu; const float* wscp;
    static constexpr bool BIAS_LDS = true;
    __device__ __forceinline__ void stage_bias(PG8_LAS unsigned char* dst, const pg8::Unit& u, int wid, int lane) const {
        if (wid < 4) { const float* src = (wid < 2 ? bg : bu) + u.e * FF + u.pn * 128 + (wid & 1) * 64 + lane;
            __builtin_amdgcn_global_load_lds((const unsigned*)src, (PG8_LAS unsigned*)(dst + wid * 256), 4, 0, 0); } }
    __device__ __forceinline__ void operator()(const pg8::f32x4 (&acc)[2][2][4][2], const pg8::Unit& u, int wr, int wc, int fr, int fq, const PG8_LAS float* bl) const {
        asm volatile("" : "+v"(fr), "+v"(fq));
        const int fl = wc * 32 + 8 * fq, f0 = u.pn * 128 + fl; const float sr = 0.125f / *wscp;
        const pg8::f32x4 g0 = *(const PG8_LAS pg8::f32x4*)(bl + fl), g1 = *(const PG8_LAS pg8::f32x4*)(bl + fl + 4), u0 = *(const PG8_LAS pg8::f32x4*)(bl + 128 + fl), u1 = *(const PG8_LAS pg8::f32x4*)(bl + 128 + fl + 4);
#pragma unroll
        for (int ai = 0; ai < 2; ++ai)
#pragma unroll
            for (int m = 0; m < 4; ++m) { const int r = ai * 128 + wr * 64 + m * 16 + fr;
                const pg8::f32x4 a0 = acc[ai][0][m][0] * sr + g0, a1 = acc[ai][0][m][1] * sr + g1, b0 = acc[ai][1][m][0] * sr + u0, b1 = acc[ai][1][m][1] * sr + u1;
                float gg[8] = {a0[0], a0[1], a0[2], a0[3], a1[0], a1[1], a1[2], a1[3]}, uu[8] = {b0[0], b0[1], b0[2], b0[3], b1[0], b1[1], b1[2], b1[3]}, o[8];
#pragma unroll
                for (int i = 0; i < 8; ++i) { const float g = fminf(gg[i], 7.f), up = fminf(fmaxf(uu[i], -7.f), 7.f); o[i] = 8.f * (g * sigmoidf_(1.702f * g) * (up + 1.f)); }
                v2u w; w.x = pk4_fp8(o[0], o[1], o[2], o[3]); w.y = pk4_fp8(o[4], o[5], o[6], o[7]);
                if (r < u.nrow) *(v2u*)(H1 + (size_t)(u.arow + r) * FF + f0) = w; }
    }
};
struct EpiDn8 { bf16* YB; const float* bd; const float* wscp;
    static constexpr bool BIAS_LDS = true;
    __device__ __forceinline__ void stage_bias(PG8_LAS unsigned char* dst, const pg8::Unit& u, int wid, int lane) const {
        if (wid < 4) { const float* src = bd + u.e * D + u.pn * 256 + wid * 64 + lane;
            __builtin_amdgcn_global_load_lds((const unsigned*)src, (PG8_LAS unsigned*)(dst + wid * 256), 4, 0, 0); } }
    __device__ __forceinline__ void operator()(const pg8::f32x4 (&acc)[2][2][4][2], const pg8::Unit& u, int wr, int wc, int fr, int fq, const PG8_LAS float* bl) const {
        const int cl = wc * 32 + 8 * fq, c0 = u.pn * 256 + cl; const float sc = 0.125f / *wscp;
#pragma unroll
        for (int bj = 0; bj < 2; ++bj) { const pg8::f32x4 d0 = *(const PG8_LAS pg8::f32x4*)(bl + cl + bj * 128), d1 = *(const PG8_LAS pg8::f32x4*)(bl + cl + bj * 128 + 4);
#pragma unroll
            for (int ai = 0; ai < 2; ++ai)
#pragma unroll
                for (int m = 0; m < 4; ++m) { const int r = ai * 128 + wr * 64 + m * 16 + fr;
                    const pg8::f32x4 a0 = (acc[ai][bj][m][0] * sc + d0) * YB_SCALE, a1 = (acc[ai][bj][m][1] * sc + d1) * YB_SCALE;
                    v2u w; w.x = pk4_fp8(a0[0], a0[1], a0[2], a0[3]); w.y = pk4_fp8(a1[0], a1[1], a1[2], a1[3]);
                    if (r < u.nrow) *(v2u*)((unsigned char*)YB + (size_t)(u.arow + r) * D + c0 + bj * 128) = w; } }
    }
};
constexpr int CW_RDY = 8448;
constexpr int H2ROW0 = (int)(WS_H2 / 2048), H1ROW0 = (int)(WS_H1 / 2048), DN_BROW0 = (int)((WS_WDN_T - WS_WGU_T) / 2048);
struct MoeFused {
    static constexpr bool GATHER = true;
    const LAS int* tab; const int* elist; gu32* ctl; int G, c, base;
    __device__ __forceinline__ bool next(int i, pg8::Unit& u) const {
        const LAS int* sg = tab + MT_SEG; const int ns = sg[0], L = (base + i) * G + c; if (L >= sg[1 + ns]) return false;
        int s = 0; for (int k = 1; k < ns; ++k) if (sg[1 + k] <= L) s = k;
        if (i > 0 && sg[1 + MT_MAXSEG + s] == 1 && L - sg[1 + 3 * MT_MAXSEG + sg[1 + 2 * MT_MAXSEG + s]] < G) return false;
        const int kind = sg[1 + MT_MAXSEG + s], g = sg[1 + 2 * MT_MAXSEG + s], ui = L - sg[1 + s], TT = tab[64 + NE], tg = (TT - 32 * g) < 32 ? (TT - 32 * g) : 32;
        int rt, pn;
        if (kind == 0) { if (tg == 32) { const int xcd = ui & 7, slot = ui >> 3; rt = xcd * 4 + (slot >> 3); pn = slot & 7; } else { rt = ui >> 3; pn = ui & 7; } }
        else { if (tg == 32) { const int xcd = ui & 7, slot = ui >> 3; rt = xcd * 4 + (slot >> 2); pn = slot & 3; } else { rt = ui >> 2; pn = ui & 3; } }
        const int rtg = 32 * g + rt; int e = 0;
        for (int k = 1; k < NE; ++k) if (tab[64 + k] <= rtg) e = k;
        const int rte = rtg - tab[64 + e], cnt = tab[e], off = tab[32 + e], nr = cnt - rte * 256;
        u.e = __builtin_amdgcn_readfirstlane(e); u.pm = __builtin_amdgcn_readfirstlane(rte); u.pn = __builtin_amdgcn_readfirstlane(pn); u.kind = __builtin_amdgcn_readfirstlane(kind); u.aux = __builtin_amdgcn_readfirstlane(rtg);
        u.arow = __builtin_amdgcn_readfirstlane(off + rte * 256); u.nrow = __builtin_amdgcn_readfirstlane(nr > 256 ? 256 : nr);
        u.brow = __builtin_amdgcn_readfirstlane(kind == 0 ? e * 2048 + pn * 256 : DN_BROW0 + e * 1024 + pn * 256); return true;
    }
    __device__ __forceinline__ int arow_of(const pg8::Unit& u, int r) const { return u.kind == 0 ? H2ROW0 + (r < u.nrow ? elist[u.e * ELCAP + u.pm * 256 + r] : 0) : H1ROW0 + u.arow + (r < u.nrow ? r : 0); }
    __device__ __forceinline__ void a_ready(const pg8::Unit& u) const {
        if (u.kind != 1) return;
        if (threadIdx.x < 64) {
            gu32* w = ctl + CW_RDY + u.aux; const unsigned long long t0 = __builtin_amdgcn_s_memrealtime();
            while ((unsigned)__builtin_amdgcn_readfirstlane(__hip_atomic_load(w, RLX_AGENT)) < 64u) {
                if (__builtin_amdgcn_s_memrealtime() - t0 > 2000000ull) { if (threadIdx.x == 0) __hip_atomic_store(ctl + CW_TMO, 1u, RLX_AGENT); break; }
                __builtin_amdgcn_s_sleep(2); }
#ifdef MOE_DELAY
            { const unsigned long long t1 = __builtin_amdgcn_s_memrealtime(); while (__builtin_amdgcn_s_memrealtime() - t1 < 2000ull) __builtin_amdgcn_s_sleep(8); }
#endif
            __builtin_amdgcn_fence(__ATOMIC_ACQUIRE, "agent");
            asm volatile("s_waitcnt vmcnt(0)" ::: "memory");
        }
        asm volatile("" ::: "memory"); __builtin_amdgcn_s_barrier(); asm volatile("" ::: "memory");
    }
    __device__ __forceinline__ void done(const pg8::Unit& u) const {
        if (u.kind != 0) return;
#ifndef DIAG_NODRAIN
        asm volatile("s_waitcnt vmcnt(0)" ::: "memory");
#endif
#if defined(MOE_REL)
        __builtin_amdgcn_fence(__ATOMIC_RELEASE, "agent"); asm volatile("s_waitcnt vmcnt(0)" ::: "memory");
#endif
        if ((threadIdx.x & 63) == 0) __hip_atomic_fetch_add(ctl + CW_RDY + u.aux, 1u, RLX_AGENT);
    }
};
struct EpiMoe { bf16* H1; bf16* YB; const float* bg; const float* bu; const float* bd;
    __device__ __forceinline__ void operator()(const pg8::f32x4 (&acc)[2][2][4][2], const pg8::Unit& u, int wr, int wc, int fr, int fq) const {
        asm volatile("" : "+v"(fr), "+v"(fq));
        if (u.kind == 0) {
            const int f0 = u.pn * 128 + wc * 32 + 8 * fq;
            const __amdgpu_buffer_rsrc_t h1rs = __builtin_amdgcn_make_buffer_rsrc(H1, 0, (int)((size_t)T * TOPK * FF * 2), 0x00020000);
#pragma unroll
            for (int ai = 0; ai < 2; ++ai) {
                int fb = f0; asm volatile("" : "+v"(fb));
                const pg8::f32x4 g0 = *(const pg8::f32x4*)(bg + u.e * FF + fb), g1 = *(const pg8::f32x4*)(bg + u.e * FF + fb + 4);
                const pg8::f32x4 u0 = *(const pg8::f32x4*)(bu + u.e * FF + fb), u1 = *(const pg8::f32x4*)(bu + u.e * FF + fb + 4);
#pragma unroll
                for (int m = 0; m < 4; ++m) { const int r = ai * 128 + wr * 64 + m * 16 + fr;
                    const pg8::f32x4 a0 = acc[ai][0][m][0] + g0, a1 = acc[ai][0][m][1] + g1, b0 = acc[ai][1][m][0] + u0, b1 = acc[ai][1][m][1] + u1;
                    float gg[8] = {a0[0], a0[1], a0[2], a0[3], a1[0], a1[1], a1[2], a1[3]}, uu[8] = {b0[0], b0[1], b0[2], b0[3], b1[0], b1[1], b1[2], b1[3]}, o[8];
#pragma unroll
                    for (int i = 0; i < 8; ++i) { const float g = fminf(gg[i], 7.f), up = fminf(fmaxf(uu[i], -7.f), 7.f); o[i] = g * sigmoidf_(1.702f * g) * (up + 1.f); }
#ifdef MOE_PLAIN
                    if (r < u.nrow) { v4u w; w.x = pk2(o[0], o[1]); w.y = pk2(o[2], o[3]); w.z = pk2(o[4], o[5]); w.w = pk2(o[6], o[7]); *(GAS v4u*)(H1 + (size_t)(u.arow + r) * FF + fb) = w; } } }
#else
                    if (r < u.nrow) { v4u w; w.x = pk2(o[0], o[1]); w.y = pk2(o[2], o[3]); w.z = pk2(o[4], o[5]); w.w = pk2(o[6], o[7]);
                        __builtin_amdgcn_raw_buffer_store_b128(w, h1rs, (unsigned)((u.arow + r) * (FF * 2) + fb * 2), 0, 16); } } }
#endif
        } else {
            const int c0 = u.pn * 256 + wc * 32 + 8 * fq;
#pragma unroll
            for (int bj = 0; bj < 2; ++bj) { const pg8::f32x4 d0 = *(const pg8::f32x4*)(bd + u.e * D + c0 + bj * 128), d1 = *(const pg8::f32x4*)(bd + u.e * D + c0 + bj * 128 + 4);
#pragma unroll
                for (int ai = 0; ai < 2; ++ai)
#pragma unroll
                    for (int m = 0; m < 4; ++m) { const int r = ai * 128 + wr * 64 + m * 16 + fr;
                        const pg8::f32x4 a0 = acc[ai][bj][m][0] + d0, a1 = acc[ai][bj][m][1] + d1;
                        v4u w; w.x = pk2(a0[0], a0[1]); w.y = pk2(a0[2], a0[3]); w.z = pk2(a1[0], a1[1]); w.w = pk2(a1[2], a1[3]);
                        if (r < u.nrow) *(GAS v4u*)(YB + (size_t)(u.arow + r) * D + c0 + bj * 128) = w; } }
        }
    }
};
__device__ __forceinline__ void phase_final(Frame& F, bool dry = false) {
    moe_tables(F);
    const LAS int* off = (const LAS int*)(F.lds + SCR_OFF) + 32;
    LAS float* gtf = (LAS float*)(F.lds);
    const float* adaf = WSP(float, WS_ADAF);
    for (int i = F.tid; i < 2 * D; i += NWAVES * 64) { const int b = i >> 10, k = i & (D - 1); gtf[i] = adaf[b * 6 * D + 5 * D + k] * WSP(float, WS_PAR)[PAR_FPOST + k]; }
    __syncthreads();
    const int gw = F.vcu * NWAVES + F.wave, NGW = F.G * NWAVES, L = F.lane;
    const int* tok_e = WSP(int, WS_ROUTE); const float* tok_w = (const float*)(tok_e + T * 4); const int* tok_pos = tok_e + 2 * T * 4;
    const bf16* YB = WSP(bf16, WS_YB);
    for (int t = gw * 2; t < T; t += NGW * 2) { const int b = t >> 13;
        int row_l = 0; float w_l = 0.f;
        if (L < 8) { const int idx = (t + (L >> 2)) * 4 + (L & 3); row_l = off[tok_e[idx]] + tok_pos[idx]; w_l = tok_w[idx]; }
        unsigned yv[2][4][4]; f32x4 x1v[2][4]; float wk[2][4];
#pragma unroll
        for (int q = 0; q < 2; ++q) {
#pragma unroll
            for (int k = 0; k < 4; ++k) { const int row = __shfl(row_l, q * 4 + k); wk[q][k] = __shfl(w_l, q * 4 + k);
                const GAS unsigned* yr = (const GAS unsigned*)((const unsigned char*)YB + (size_t)row * D) + L;
#pragma unroll
                for (int j = 0; j < 4; ++j) yv[q][k][j] = __builtin_nontemporal_load(yr + 64 * j);
#ifdef DRY14_NOYB
                if (dry) { _Pragma("unroll") for (int j = 0; j < 4; ++j) yv[q][k][j] = 0x38383838u; }
#endif
            }
            const GAS v2u* xr = (const GAS v2u*)(WSP(bf16, WS_X1B) + (size_t)(t + q) * D) + L;
#pragma unroll
            for (int j = 0; j < 4; ++j) { const v2u xw = __builtin_nontemporal_load(xr + 64 * j); x1v[q][j] = (f32x4){bflo(xw.x), bfhi(xw.x), bflo(xw.y), bfhi(xw.y)}; } }
#pragma unroll
        for (int q = 0; q < 2; ++q) {
            f32x4 y[4];
#pragma unroll
            for (int j = 0; j < 4; ++j) y[j] = (f32x4){0.f, 0.f, 0.f, 0.f};
#pragma unroll
            for (int k = 0; k < 4; ++k)
#pragma unroll
                for (int j = 0; j < 4; ++j) { const unsigned x = yv[q][k][j]; const float w = wk[q][k] * (1.f / YB_SCALE);
                    y[j].x += w * __builtin_amdgcn_cvt_f32_fp8((int)x, 0); y[j].y += w * __builtin_amdgcn_cvt_f32_fp8((int)x, 1); y[j].z += w * __builtin_amdgcn_cvt_f32_fp8((int)x, 2); y[j].w += w * __builtin_amdgcn_cvt_f32_fp8((int)x, 3); }
            float s = 0.f;
#pragma unroll
            for (int j = 0; j < 4; ++j) s += (y[j].x * y[j].x + y[j].y * y[j].y) + (y[j].z * y[j].z + y[j].w * y[j].w);
            const float r = 1.f / sqrtf(wave_sum(s) * (1.f / D) + NORM_EPS);
            GAS f32x4* wrow = dry ? (GAS f32x4*)(WSP(float, WS_WGU_T) + (size_t)(t + q) * D) + L : (GAS f32x4*)(F.out + (size_t)(t + q) * D) + L;
#pragma unroll
            for (int j = 0; j < 4; ++j) { const f32x4 g = *(const LAS f32x4*)(gtf + b * D + 4 * L + 256 * j); __builtin_nontemporal_store(x1v[q][j] + g * (y[j] * r), wrow + 64 * j); }
        }
    }
}
__device__ __forceinline__ bool opaque_ws(Frame& F) { asm volatile("" : "+s"(F.ws)); return true; }
#ifndef MK_N_LAUNCHES
#define MK_N_LAUNCHES 1
#endif
constexpr int N_PHASES = 15;
struct Args { const float* in[30]; float* out; unsigned char* ws; int ph_lo, ph_hi; };
__global__ void __launch_bounds__(NWAVES * 64, 2) mega_fwd(Args args) {
    extern __shared__ __attribute__((aligned(16))) unsigned char lds[];
    Frame F;
    F.lds = (LAS unsigned char*)lds;
    F.MISC = (volatile LAS unsigned*)(F.lds + MISC_OFF);
    F.tid = threadIdx.x; F.lane = F.tid & 63; F.wave = __builtin_amdgcn_readfirstlane(F.tid >> 6);
    F.G = gridDim.x; { const int bx = blockIdx.x; F.vcu = (F.G % 8 == 0) ? (bx % 8) * (F.G / 8) + bx / 8 : bx; }
    F.ws = args.ws; F.ctl = (gu32*)(args.ws + WS_CTL); F.out = args.out;
#pragma unroll
    for (int i = 0; i < 30; ++i) F.in[i] = args.in[i];
    for (int u = F.tid; u < (LDS_BYTES - LDSCTL_OFF) / 4; u += NWAVES * 64) ((LAS unsigned*)(F.lds + LDSCTL_OFF))[u] = 0u;
    __syncthreads();
    XcdBarrier bar; bar.bar = (unsigned*)(F.ctl + CW_BAR); bar.x = 0; bar.st = nullptr;
    if (MK_N_LAUNCHES == 1) bar = xcd_barrier_post((unsigned*)(F.ctl + CW_BAR), F.MISC + 8);
    const int lo = args.ph_lo, hi = args.ph_hi;
#ifndef PHMASK
#define PHMASK 0x7fff
#endif
#define IN(k) (((PHMASK >> (k)) & 1) && lo <= (k) && (k) < hi)
#ifdef DBG_A
#define STAMP(k) do { if (blockIdx.x == 0 && F.tid == 0) ((unsigned long long*)(F.ctl + 2048))[k] = __builtin_amdgcn_s_memrealtime(); } while (0)
#else
#define STAMP(k) do {} while (0)
#endif
#ifndef REP_PHASE
#define REP_PHASE -1
#endif
#ifndef REP_MASK
#define REP_MASK 0
#endif
#define REPL(k) for (int rep_ = 0; rep_ < ((REP_PHASE == (k) || ((REP_MASK >> (k)) & 1)) ? 2 : 1); ++rep_) if (opaque_ws(F))
#ifdef DBL_BAR
#define SEAM(k) do { if (IN(k)) { xcd_barrier(bar); xcd_barrier(bar); } STAMP((k) + 1); } while (0)
#else
#define SEAM(k) do { if (IN(k)) xcd_barrier(bar); STAMP((k) + 1); } while (0)
#endif
    PG8_LAS unsigned char* ring = F.lds + RING_OFF;
    const int bx = (int)blockIdx.x;

    STAMP(0);
#ifdef DIAG_WARM
    { typedef float f4_ __attribute__((ext_vector_type(4))); typedef short s8_ __attribute__((ext_vector_type(8))); f4_ a_ = {0.f, 0.f, 0.f, 0.f}; s8_ x_ = {1, 2, 3, 4, 5, 6, 7, 8};
      const unsigned long long t0_ = __builtin_amdgcn_s_memrealtime();
      while (__builtin_amdgcn_s_memrealtime() - t0_ < (unsigned long long)(DIAG_WARM * 100)) { _Pragma("unroll") for (int i_ = 0; i_ < 16; ++i_) a_ = __builtin_amdgcn_mfma_f32_16x16x32_bf16(x_, x_, a_, 0, 0, 0); }
      if (a_[0] == 12345.f) F.out[0] = a_[1]; }
#endif
    if (IN(0)) REPL(0) { phase0(F); } SEAM(0);
    if (IN(1)) REPL(1) { phase1(F); } SEAM(1);
    if (IN(2)) REPL(2) {
#ifdef G1_MIX
        {
            pg8::Gemm g{WSP(bf16, WS_XN8), WSP(bf16, WS_WIN8), D / 2, D / 2, D / 2}; pg8::ColSubsetOrder S;
#ifdef G1_MIX_GATES
            S.d.init(T, 8 * 256, F.G, bx); S.base = 8; S.split = 8; S.skip = 0;
#else
            S.d.init(T, 12 * 256, F.G, bx); S.base = 0; S.split = 2; S.skip = 4;
#endif
            EpiG1 E{WSP(bf16, WS_UA), WSP(bf16, WS_Q), WSP(bf16, WS_K), WSP(bf16, WS_V), WSP(bf16, WS_VT), WSP(bf16, WS_GS), WSP(bf16, WS_GA),
                    WSP(float, WS_ROPE), WSP(float, WS_ROPE) + (size_t)T * 32, (float*)(F.ctl + CW_KM), WSP(float, WS_PAR) + PAR_WSC1, true};
            pg8::gemm_phase<EpiG1, pg8::ColSubsetOrder, true>(ring, g, S, E); }
        {
            pg8::Gemm g{WSP(bf16, WS_XN), WSP(bf16, WS_WIN_T), D, D, D}; pg8::ColSubsetOrder S;
#ifdef G1_MIX_GATES
            S.d.init(T, 8 * 256, F.G, bx); S.base = 0; S.split = 8; S.skip = 0;
#else
            S.d.init(T, 4 * 256, F.G, bx); S.base = 2; S.split = 4; S.skip = 0;
#endif
            EpiG1 E{WSP(bf16, WS_UA), WSP(bf16, WS_Q), WSP(bf16, WS_K), WSP(bf16, WS_V), WSP(bf16, WS_VT), WSP(bf16, WS_GS), WSP(bf16, WS_GA),
                    WSP(float, WS_ROPE), WSP(float, WS_ROPE) + (size_t)T * 32, (float*)(F.ctl + CW_KM), WSP(float, WS_PAR) + PAR_WSC1, false};
            pg8::gemm_phase<EpiG1, pg8::ColSubsetOrder, false>(ring, g, S, E); }
#else
#ifdef G1_F8
        pg8::Gemm g{WSP(bf16, WS_XN), WSP(bf16, WS_WIN_T), D / 2, D / 2, D / 2}; pg8::DenseOrder S; S.init(T, INW, F.G, bx);
#else
        pg8::Gemm g{WSP(bf16, WS_XN), WSP(bf16, WS_WIN_T), D, D, D}; pg8::DenseOrder S; S.init(T, INW, F.G, bx);
#endif
        EpiG1 E{WSP(bf16, WS_UA), WSP(bf16, WS_Q), WSP(bf16, WS_K), WSP(bf16, WS_V), WSP(bf16, WS_VT), WSP(bf16, WS_GS), WSP(bf16, WS_GA),
                WSP(float, WS_ROPE), WSP(float, WS_ROPE) + (size_t)T * 32, (float*)(F.ctl + CW_KM), WSP(float, WS_PAR) + PAR_WSC1,
#ifdef G1_F8
                true};
#else
                false};
#endif
#ifdef G1_F8
        pg8::gemm_phase<EpiG1, pg8::DenseOrder, true>(ring, g, S, E);
#else
        pg8::gemm_phase(ring, g, S, E);
#endif
#endif
        s5_fill_kt(F);
    } SEAM(2);
    if (IN(3)) REPL(3) {
        pg8::Gemm g{WSP(bf16, WS_UA), WSP(bf16, WS_S5M1), 384, 256, 256}; S5Order S{F.G, bx}; EpiS5A E{WSP(float, WS_S5E)};
        pg8::gemm_phase(ring, g, S, E);
        s5_fill_wc(F);
        attn_gate(F);
#ifdef MOE_F8
        moe_convert_idle(F, MOE_ITEMS_P0, MOE_ITEMS_P3);
#endif
    } SEAM(3);
    if (IN(4)) REPL(4) { attn_items(F); s5_carry(F); } SEAM(4);
    if (IN(5)) REPL(5) {
        pg8::Gemm g{WSP(bf16, WS_UA), WSP(bf16, WS_S5WC), 384, 384, 384}; S5Order S{F.G, bx}; EpiS5C E{WSP(bf16, WS_YG)};
        pg8::gemm_phase(ring, g, S, E);
        attn_combine(F);
#ifdef MOE_F8
        moe_convert_idle(F, MOE_ITEMS_P0 + MOE_ITEMS_P3, MOE_ITEMS_P5);
#endif
    } SEAM(5);
    if (IN(6)) REPL(6) {
        pg8::Gemm g{WSP(bf16, WS_YG), WSP(bf16, WS_WGLU_T), SW, SW, SW}; pg8::DenseOrder S; S.init(T, SW, F.G, bx);
        EpiEw<0> E{WSP(bf16, WS_Y2), WSP(bf16, WS_YG), nullptr, nullptr, SW};
        pg8::gemm_phase(ring, g, S, E);
#ifdef MOE_F8
        moe_convert_idle(F, MOE_ITEMS_P0 + MOE_ITEMS_P3 + MOE_ITEMS_P5, MOE_ITEMS_P6);
#endif
    } SEAM(6);
    if (IN(7)) REPL(7) {
        pg8::Gemm g{WSP(bf16, WS_Y2), WSP(bf16, WS_WSB_T), SW, SW, SW}; pg8::DenseOrder S; S.init(T, D, F.G, bx);
        EpiEw<1> E{WSP(bf16, WS_M1), WSP(bf16, WS_GS), nullptr, nullptr, D};
        pg8::gemm_phase(ring, g, S, E);
    }
    if (IN(7)) { asm volatile("s_waitcnt vmcnt(0)" ::: "memory"); __syncthreads(); if (F.tid < 64) { __builtin_amdgcn_fence(__ATOMIC_ACQUIRE, "agent"); asm volatile("s_waitcnt vmcnt(0)" ::: "memory"); } __syncthreads(); STAMP(8); }
    if (IN(8)) REPL(8) {
        pg8::Gemm g{WSP(bf16, WS_YA), WSP(bf16, WS_WAB_T), AW, AW, AW}; pg8::DenseOrder S; S.init(T, D, F.G, bx);
        EpiEw<2> E{WSP(bf16, WS_XN), WSP(bf16, WS_GA), WSP(bf16, WS_M1), nullptr, D};
        pg8::gemm_phase(ring, g, S, E);
    } SEAM(8);
    if (IN(9)) REPL(9) {
        pg8::Gemm g{WSP(bf16, WS_XN), WSP(bf16, WS_WOUT_T), D, D, D}; pg8::DenseOrder S; S.init(T, D, F.G, bx);
        EpiEw<4> E{WSP(bf16, WS_MIX), nullptr, nullptr, nullptr, D};
        pg8::gemm_phase(ring, g, S, E);
    } SEAM(9);
    if (IN(10)) REPL(10) { phase_rows(F, (REP_PHASE == 10 || ((REP_MASK >> 10) & 1)) && rep_ == 0); } SEAM(10);
#ifndef MOE_FUSED
#ifdef MOE_F8
    if (IN(12)) REPL(12) {
        moe_tables(F, 8, 2048);
        pg8::Gemm g{WSP(bf16, WS_H2), WSP(bf16, WS_WGU_T), D / 2, D / 2, D / 2}; MoeOrder<true> S{(const LAS int*)(F.lds + SCR_OFF), WSP(int, WS_ELIST), 8, 2048, F.G, bx};
        EpiGU8 E{WSP(unsigned char, WS_H1), WSP(float, WS_PAR) + PAR_BG, WSP(float, WS_PAR) + PAR_BU, WSP(float, WS_PAR) + PAR_WSC};
        pg8::gemm_phase<EpiGU8, MoeOrder<true>, true>(ring, g, S, E);
    } SEAM(12);
    if (IN(13)) REPL(13) {
        moe_tables(F, 4, 1024);
        pg8::Gemm g{WSP(bf16, WS_H1), WSP(bf16, WS_WDN_T), FF / 2, FF / 2, FF / 2}; MoeOrder<false> S{(const LAS int*)(F.lds + SCR_OFF), nullptr, 4, 1024, F.G, bx};
        EpiDn8 E{WSP(bf16, WS_YB), WSP(float, WS_PAR) + PAR_BD, WSP(float, WS_PAR) + PAR_WSC};
        pg8::gemm_phase<EpiDn8, MoeOrder<false>, true>(ring, g, S, E);
    } SEAM(13);
#else
    if (IN(12)) REPL(12) {
        moe_tables(F, 8, 2048);
        pg8::Gemm g{WSP(bf16, WS_H2), WSP(bf16, WS_WGU_T), D, D, D}; MoeOrder<true> S{(const LAS int*)(F.lds + SCR_OFF), WSP(int, WS_ELIST), 8, 2048, F.G, bx};
        EpiGU E{WSP(bf16, WS_H1), WSP(float, WS_PAR) + PAR_BG, WSP(float, WS_PAR) + PAR_BU};
        pg8::gemm_phase(ring, g, S, E);
    } SEAM(12);
    if (IN(13)) REPL(13) {
        moe_tables(F, 4, 1024);
        pg8::Gemm g{WSP(bf16, WS_H1), WSP(bf16, WS_WDN_T), FF, FF, FF}; MoeOrder<false> S{(const LAS int*)(F.lds + SCR_OFF), nullptr, 4, 1024, F.G, bx};
        EpiDn E{WSP(bf16, WS_YB), WSP(float, WS_PAR) + PAR_BD};
        pg8::gemm_phase(ring, g, S, E);
    } SEAM(13);
#endif
#else
    if (IN(12)) REPL(12) {
        moe_tables(F);
        pg8::Gemm g{(const bf16*)F.ws, WSP(bf16, WS_WGU_T), D, D, D};
        EpiMoe E{WSP(bf16, WS_H1), WSP(bf16, WS_YB), WSP(float, WS_PAR) + PAR_BG, WSP(float, WS_PAR) + PAR_BU, WSP(float, WS_PAR) + PAR_BD};
        for (int base = 0;;) { MoeFused S{(const LAS int*)(F.lds + SCR_OFF), WSP(int, WS_ELIST), F.ctl, F.G, bx, base};
            const int nd = pg8::gemm_phase(ring, g, S, E); if (nd == 0) break; base += nd; }
    } SEAM(12);
#endif
    if (IN(14)) REPL(14) { phase_final(F, (REP_PHASE == 14 || ((REP_MASK >> 14) & 1)) && rep_ == 0); }
#undef IN
#undef SEAM
}

extern "C" void kernel_launch(void* const* d_in, const int* in_sizes, int n_in, void* d_out, int out_size, void* d_ws, size_t ws_size, hipStream_t stream) {
    static int grid = 0;
    if (grid == 0) {
        if (n_in != 30 || in_sizes[0] != T * D || out_size != T * D || ws_size < WS_END) { fprintf(stderr, "kernel_launch: unexpected shapes (n_in %d, in0 %d, out %d, ws %zu)\n", n_in, n_in > 0 ? in_sizes[0] : -1, out_size, ws_size); grid = -1; return; }
        int dev = 0, cus = 0, per_cu = 0;
        if (hipGetDevice(&dev) != hipSuccess || hipDeviceGetAttribute(&cus, hipDeviceAttributeMultiprocessorCount, dev) != hipSuccess) { grid = -1; return; }
        if (hipFuncSetAttribute((const void*)mega_fwd, hipFuncAttributeMaxDynamicSharedMemorySize, LDS_BYTES) != hipSuccess) { fprintf(stderr, "kernel_launch: hipFuncSetAttribute failed\n"); grid = -1; return; }
        if (hipOccupancyMaxActiveBlocksPerMultiprocessor(&per_cu, (const void*)mega_fwd, NWAVES * 64, LDS_BYTES) != hipSuccess || per_cu < 1) { fprintf(stderr, "kernel_launch: occupancy query says %d\n", per_cu); }
        (void)hipGetLastError();
        grid = cus;
    }
    if (grid < 0) return;
    (void)hipMemsetAsync((char*)d_ws + WS_CTL, 0, CTL_ZERO_USED, stream);
    Args a{};
    for (int i = 0; i < 30; ++i) a.in[i] = (const float*)d_in[i];
    a.out = (float*)d_out; a.ws = (unsigned char*)d_ws;
#ifndef PLAIN_LAUNCH
    if (MK_N_LAUNCHES == 1) { a.ph_lo = 0; a.ph_hi = N_PHASES; void* kargs[] = {(void*)&a};
        const hipError_t e = hipLaunchCooperativeKernel((const void*)mega_fwd, dim3(grid), dim3(NWAVES * 64), kargs, LDS_BYTES, stream);
        if (e != hipSuccess) fprintf(stderr, "kernel_launch: cooperative launch failed: %s\n", hipGetErrorString(e)); }
#else
    if (MK_N_LAUNCHES == 1) { a.ph_lo = 0; a.ph_hi = N_PHASES; hipLaunchKernelGGL(mega_fwd, dim3(grid), dim3(NWAVES * 64), LDS_BYTES, stream, a); }
#endif
    else for (int p = 0; p < N_PHASES; ++p) { a.ph_lo = p; a.ph_hi = p + 1; hipLaunchKernelGGL(mega_fwd, dim3(grid), dim3(NWAVES * 64), LDS_BYTES, stream, a); }
}
```

```cpp
#include <hip/hip_runtime.h>
#include <cstdio>
#include <cstdint>
#define MK_N_LAUNCHES 1
namespace pg8 {
#define PG8_LAS __attribute__((address_space(3)))
typedef unsigned short bf16_t;
typedef short bf16x8 __attribute__((ext_vector_type(8)));
typedef float f32x4 __attribute__((ext_vector_type(4)));
typedef unsigned u32x4 __attribute__((ext_vector_type(4)));
typedef unsigned u32x2 __attribute__((ext_vector_type(2)));
typedef int v4i32 __attribute__((ext_vector_type(4)));
typedef int v8i32 __attribute__((ext_vector_type(8)));
constexpr int BIAS_LDS_OFF = 156 * 1024;
constexpr int BM = 256, BK = 64, HALF = 128, HTB = HALF * BK * 2  , STAGE_BYTES = 8 * HTB, NXCD = 8, WGM = 8;

__host__ __device__ __forceinline__ int lds_byte(int r, int c) { const int st = (r >> 4) * 2 + (c >> 5), rr = r & 15, cc = c & 31, ob = rr * 64 + cc * 2; return st * 1024 + (ob ^ (((ob >> 9) & 1) << 5)); }
__host__ __device__ __forceinline__ void stage_rc(int b, int& R, int& C) { const int st = b / 1024, sb = b % 1024, swz = sb ^ (((sb >> 9) & 1) << 5); R = (st >> 1) * 16 + swz / 64; C = (st & 1) * 32 + (swz % 64) / 2; }

struct Unit { int arow, brow, pm, pn, e, nrow, kind, aux; };
struct Gemm { const bf16_t* A; const bf16_t* Bt; int lda, ldb, K; };

struct DenseOrder {
    static constexpr bool GATHER = false;
    __device__ __forceinline__ void a_ready(const Unit&) const {}
    __device__ __forceinline__ void done(const Unit&) const {}
    int nM, nN, nwg, G, c;
    __device__ __forceinline__ void init(int M, int N, int G_, int c_) { nM = M / BM; nN = N / BM; nwg = nM * nN; G = G_; c = c_; }
    __device__ __forceinline__ bool next(int i, Unit& u) const {
        const long L = (long)i * G + c; if (L >= nwg) return false;
        int wgid = (int)L; { const int q = nwg / NXCD, r = nwg % NXCD, xcd = wgid % NXCD, off = wgid / NXCD; wgid = (xcd < r ? xcd * (q + 1) : r * (q + 1) + (xcd - r) * q) + off; }
        const int nig = WGM * nN, gid = wgid / nig, fm = gid * WGM, gsz = (nM - fm) < WGM ? (nM - fm) : WGM;
        u.pm = fm + ((wgid % nig) % gsz); u.pn = (wgid % nig) / gsz; u.arow = u.pm * BM; u.brow = u.pn * BM; u.e = 0; u.nrow = BM; u.kind = 0; u.aux = 0; return true;
    }
};

struct ColSubsetOrder {
    static constexpr bool GATHER = false;
    DenseOrder d; int base, split, skip;
    __device__ __forceinline__ void a_ready(const Unit&) const {}
    __device__ __forceinline__ void done(const Unit&) const {}
    __device__ __forceinline__ bool next(int i, Unit& u) const { if (!d.next(i, u)) return false; const int pa = base + (u.pn < split ? u.pn : u.pn + skip); u.pn = pa; u.brow = pa * BM; return true; }
};

template <class T_> struct has_bias_lds { template <class U_> static constexpr bool get(decltype(U_::BIAS_LDS)*) { return U_::BIAS_LDS; } template <class U_> static constexpr bool get(...) { return false; } static constexpr bool value = get<T_>(nullptr); };
template <class Epi, class Sched, bool F8 = false>
__device__ __forceinline__ int gemm_phase(PG8_LAS unsigned char* lds, const Gemm g, const Sched& S, const Epi& E) {
    const int tid = threadIdx.x, wid = __builtin_amdgcn_readfirstlane(tid >> 6), lane = tid & 63, wr = wid >> 2, wc = wid & 3, fr = lane & 15, fq = lane >> 4;
    const int K = g.K, nt = K / BK;
    PG8_LAS unsigned char* biaslds = lds + BIAS_LDS_OFF;
    constexpr bool GA = Sched::GATHER;
    unsigned voffA[2], voffB[2]; int gR[2]; unsigned gC[2];
#pragma unroll
    for (int i = 0; i < 2; ++i) { int R, C; stage_rc(tid * 16 + i * 8192, R, C); gR[i] = R; gC[i] = (unsigned)C * 2u;
        voffA[i] = (unsigned)(R * g.lda + C) * 2u; voffB[i] = (unsigned)(R * g.ldb + C) * 2u; }
    unsigned gA_cur[2][2], gA_nxt[2][2];
#define PG8_GATH(dst, un) do { _Pragma("unroll") for (int _h = 0; _h < 2; ++_h) _Pragma("unroll") for (int _i = 0; _i < 2; ++_i) dst[_h][_i] = (unsigned)S.arow_of(un, _h * HALF + gR[_i]) * (unsigned)(g.lda * 2) + gC[_i]; } while (0)
#define PG8_STAGE_A(bufoff, h, kbytes, nx) do { if constexpr (GA) { const char* gb_ = (const char*)g.A + (kbytes); _Pragma("unroll") for (int _i = 0; _i < 2; ++_i) { const unsigned vo_ = (nx) ? gA_nxt[h][_i] : gA_cur[h][_i]; \
        __builtin_amdgcn_global_load_lds((const unsigned*)(gb_ + vo_), (PG8_LAS unsigned*)(lds + (bufoff) + ldsw + _i * 8192), 16, 0, 0); } } \
    else { const char* gb_ = ((nx) ? nA : cA) + (kbytes) + (h) * hstepA; PG8_STAGE(bufoff, gb_, voffA); } } while (0)
    const size_t kstep = (size_t)(BK * 2);
    const size_t hstepA = (size_t)HALF * g.lda * 2, hstepB = (size_t)HALF * g.ldb * 2;
    const size_t rowA = (size_t)g.lda * 2, rowB = (size_t)g.ldb * 2;
    const unsigned ldsw = (unsigned)wid * 1024u;
    const int aoff = lds_byte(wr * 64 + fr, fq * 8), boff = lds_byte(wc * 32 + fr, fq * 8);
#define PG8_SA(b, h) (((b) * 2 + (h)) * HTB)
#define PG8_SB(b, h) ((4 + (b) * 2 + (h)) * HTB)
#define PG8_STAGE(bufoff, gbase, voff) do { _Pragma("unroll") for (int _i = 0; _i < 2; ++_i) \
        __builtin_amdgcn_global_load_lds((const unsigned*)((const char*)(gbase) + (voff)[_i]), (PG8_LAS unsigned*)(lds + (bufoff) + ldsw + _i * 8192), 16, 0, 0); } while (0)
#define PG8_LDA(dst, b, h) do { _Pragma("unroll") for (int m = 0; m < 4; ++m) { if constexpr (F8) { const v4i32 lo_ = *(const PG8_LAS v4i32*)(lds + PG8_SA(b, h) + aoff + m * 2048), hi_ = *(const PG8_LAS v4i32*)(lds + PG8_SA(b, h) + aoff + m * 2048 + 1024); dst##8[m] = __builtin_shufflevector(lo_, hi_, 0, 1, 2, 3, 4, 5, 6, 7); } \
        else { _Pragma("unroll") for (int k = 0; k < 2; ++k) dst[m][k] = *(const PG8_LAS bf16x8*)(lds + PG8_SA(b, h) + aoff + m * 2048 + k * 1024); } } } while (0)
#define PG8_LDB(dst, b, h) do { _Pragma("unroll") for (int n = 0; n < 2; ++n) { if constexpr (F8) { const v4i32 lo_ = *(const PG8_LAS v4i32*)(lds + PG8_SB(b, h) + boff + n * 2048), hi_ = *(const PG8_LAS v4i32*)(lds + PG8_SB(b, h) + boff + n * 2048 + 1024); dst##8[n] = __builtin_shufflevector(lo_, hi_, 0, 1, 2, 3, 4, 5, 6, 7); } \
        else { _Pragma("unroll") for (int k = 0; k < 2; ++k) dst[n][k] = *(const PG8_LAS bf16x8*)(lds + PG8_SB(b, h) + boff + n * 2048 + k * 1024); } } } while (0)
#define PG8_MMA(ai, bj, At, Bt) do { __builtin_amdgcn_s_setprio(1); _Pragma("unroll") for (int m = 0; m < 4; ++m) _Pragma("unroll") for (int n = 0; n < 2; ++n) { \
        if constexpr (F8) { asm("v_mfma_scale_f32_16x16x128_f8f6f4 %0, %1, %2, %0, %3, %3 op_sel_hi:[0,0,0]" : "+v"(acc[ai][bj][m][n]) : "v"(Bt##8[n]), "v"(At##8[m]), "v"(one_scale)); } \
        else { _Pragma("unroll") for (int k = 0; k < 2; ++k) acc[ai][bj][m][n] = __builtin_amdgcn_mfma_f32_16x16x32_bf16(Bt[n][k], At[m][k], acc[ai][bj][m][n], 0, 0, 0); } } \
        __builtin_amdgcn_s_setprio(0); } while (0)
#define PG8_WAIT_V(n) asm volatile("s_waitcnt vmcnt(" #n ")" ::: "memory")
#define PG8_WAIT_L(n) asm volatile("s_waitcnt lgkmcnt(" #n ")" ::: "memory")
#define PG8_BAR __builtin_amdgcn_s_barrier()
#define PG8_SCHED __builtin_amdgcn_sched_barrier(0)
    Unit cur, nxt; int ui = 0;
    if (!S.next(0, cur)) return 0;
    f32x4 acc[2][2][4][2];
#pragma unroll
    for (int a = 0; a < 2; ++a)
#pragma unroll
        for (int b = 0; b < 2; ++b)
#pragma unroll
            for (int m = 0; m < 4; ++m)
#pragma unroll
                for (int n = 0; n < 2; ++n) acc[a][b][m][n] = (f32x4){0.f, 0.f, 0.f, 0.f};
    const int one_scale = 0x7f7f7f7f;
    bf16x8 At[4][2], B0[2][2], B1[2][2];
    v8i32 At8[4], B08[2], B18[2];
    const char* cA = GA ? (const char*)g.A : (const char*)g.A + (size_t)cur.arow * rowA; const char* cB = (const char*)g.Bt + (size_t)cur.brow * rowB; const char* nA = cA;
    if constexpr (GA) { PG8_GATH(gA_cur, cur); }
    S.a_ready(cur);
    PG8_STAGE(PG8_SB(0, 0), cB, voffB); PG8_STAGE(PG8_SB(0, 1), cB + hstepB, voffB); PG8_STAGE_A(PG8_SA(0, 0), 0, 0, false); PG8_STAGE_A(PG8_SA(0, 1), 1, 0, false);
    if (wr == 1) PG8_BAR;
    PG8_WAIT_V(2); PG8_BAR;
    PG8_STAGE(PG8_SB(1, 0), cB + kstep, voffB); PG8_STAGE_A(PG8_SA(1, 0), 0, kstep, false); PG8_STAGE(PG8_SB(1, 1), cB + hstepB + kstep, voffB);
    PG8_WAIT_V(6); PG8_BAR;
    for (;;) {
        const bool has_next = S.next(ui + 1, nxt);
        if constexpr (has_bias_lds<Epi>::value) E.stage_bias(biaslds + (ui & 1) * 1024, cur, wid, lane);
        nA = GA ? cA : (has_next ? (const char*)g.A + (size_t)nxt.arow * rowA : cA); const char* nB = has_next ? (const char*)g.Bt + (size_t)nxt.brow * rowB : cB;
        if constexpr (GA) { if (has_next) { PG8_GATH(gA_nxt, nxt); } else { _Pragma("unroll") for (int _h = 0; _h < 2; ++_h) _Pragma("unroll") for (int _i = 0; _i < 2; ++_i) gA_nxt[_h][_i] = gA_cur[_h][_i]; } }
#pragma unroll 1
        for (int t = 0; t < nt; t += 2) {
            const bool last = (t == nt - 2);
            if (last && has_next) S.a_ready(nxt);
            const size_t k1 = (size_t)(t + 1) * kstep, k2 = last ? (size_t)0 : (size_t)(t + 2) * kstep, k3 = k2 + kstep;
            const char* b2 = last ? nB : cB + (size_t)(t + 2) * kstep; const char* b3 = b2 + kstep;
            PG8_LDB(B0, 0, 0); PG8_LDB(B1, 0, 1); PG8_SCHED; PG8_LDA(At, 0, 0); PG8_STAGE_A(PG8_SA(1, 1), 1, k1, false);
            PG8_WAIT_V(8); PG8_WAIT_L(0); PG8_BAR; PG8_MMA(0, 0, At, B0); PG8_MMA(0, 1, At, B1); PG8_BAR; PG8_SCHED;
            PG8_LDA(At, 0, 1); PG8_STAGE(PG8_SB(0, 0), b2, voffB); PG8_STAGE(PG8_SB(0, 1), b2 + hstepB, voffB); PG8_STAGE_A(PG8_SA(0, 0), 0, k2, last);
            PG8_WAIT_V(8); PG8_WAIT_L(0); PG8_BAR; PG8_MMA(1, 0, At, B0); PG8_MMA(1, 1, At, B1); PG8_BAR; PG8_SCHED;
            PG8_LDB(B0, 1, 0); PG8_LDB(B1, 1, 1); PG8_SCHED; PG8_LDA(At, 1, 0); PG8_STAGE_A(PG8_SA(0, 1), 1, k2, last);
            PG8_WAIT_V(8); PG8_WAIT_L(0); PG8_BAR; PG8_MMA(0, 0, At, B0); PG8_MMA(0, 1, At, B1); PG8_BAR; PG8_SCHED;
            PG8_LDA(At, 1, 1); PG8_STAGE(PG8_SB(1, 0), b3, voffB); PG8_STAGE(PG8_SB(1, 1), b3 + hstepB, voffB); PG8_STAGE_A(PG8_SA(1, 0), 0, k3, last);
            PG8_WAIT_V(8); PG8_WAIT_L(0); PG8_BAR; PG8_MMA(1, 0, At, B0); PG8_MMA(1, 1, At, B1); PG8_BAR; PG8_SCHED;
        }
        if (wr == 0) PG8_BAR;
        if constexpr (has_bias_lds<Epi>::value) E(acc, cur, wr, wc, fr, fq, (const PG8_LAS float*)(biaslds + (ui & 1) * 1024)); else E(acc, cur, wr, wc, fr, fq);
        S.done(cur);
        if (!has_next) break;
#pragma unroll
        for (int a = 0; a < 2; ++a)
#pragma unroll
            for (int b = 0; b < 2; ++b)
#pragma unroll
                for (int m = 0; m < 4; ++m)
#pragma unroll
                    for (int n = 0; n < 2; ++n) acc[a][b][m][n] = (f32x4){0.f, 0.f, 0.f, 0.f};
        cur = nxt; cA = nA; cB = nB; ++ui;
        if constexpr (GA) { _Pragma("unroll") for (int _h = 0; _h < 2; ++_h) _Pragma("unroll") for (int _i = 0; _i < 2; ++_i) gA_cur[_h][_i] = gA_nxt[_h][_i]; }
        if (wr == 1) PG8_BAR;
    }
    PG8_WAIT_V(0);
    PG8_BAR;
    const int n_done_ = ui + 1;
#undef PG8_SA
#undef PG8_SB
#undef PG8_STAGE
#undef PG8_STAGE_A
#undef PG8_GATH
#undef PG8_LDA
#undef PG8_LDB
#undef PG8_MMA
#undef PG8_WAIT_V
#undef PG8_WAIT_L
#undef PG8_BAR
#undef PG8_SCHED
    return n_done_;
}
}
constexpr int NWAVES = 8;
constexpr int BATCH = 2, SEQ = 8192, T = BATCH * SEQ, D = 1024, NH = 8, HD = 64, AW = 512, SW = 512, NG = 32, NP = 64, GS16 = 16;
constexpr int NE = 32, FF = 1024, INW = 4096, TOPK = 4, NBLK = SEQ / 256;
constexpr float NORM_EPS = 1e-6f;
constexpr float C2 = 0.125f * 1.4426950408889634f;
constexpr int XROWS = T * TOPK + 256;

constexpr size_t MiB = 1u << 20;
constexpr size_t WS_CTL = 0, CTL_ZERO_BYTES = 1 * MiB;
constexpr size_t WS_ADA = 1 * MiB;
constexpr size_t WS_ADAF = WS_ADA + 832 * 1024;
constexpr size_t WS_ROPE = 2 * MiB;
constexpr size_t WS_S5P = 6 * MiB;
constexpr size_t WS_S5KT = 7 * MiB;
constexpr size_t WS_S5M1 = 10 * MiB;
constexpr size_t WS_S5WC = 506 * MiB;
constexpr size_t WS_S5E = 408 * MiB;
constexpr size_t WS_ROUTE = 9 * MiB;
constexpr size_t WS_ELIST = 14 * MiB; constexpr int ELCAP = T;
constexpr size_t WS_HSC = WS_ROUTE + 768 * 1024;
constexpr int PAR_WSC = 270000, PAR_WSC1 = 270001;
#ifndef MOE_BF16
#define MOE_F8 1
#endif
constexpr size_t WS_WIN_T = 18 * MiB, WS_WGLU_T = 26 * MiB, WS_WSB_T = 27 * MiB, WS_WAB_T = 28 * MiB, WS_WOUT_T = 29 * MiB;
constexpr size_t WS_PAR = 16 * MiB;
constexpr int PAR_MPG = 0, PAR_FPRE = 1024, PAR_FPOST = 2048, PAR_RB = 3072, PAR_RW = 4096, PAR_BG = 36864, PAR_BU = 69632, PAR_BD = 102400, PAR_CRE = 135168, PAR_CIM = 167936, PAR_SD = 200704, PAR_BRE = 201728, PAR_BIM = 234496;
constexpr size_t WS_WGU_T = 32 * MiB, WS_WDN_T = 160 * MiB;
constexpr size_t WS_XN = 224 * MiB;
constexpr size_t WS_UA = 256 * MiB, WS_Q = 280 * MiB, WS_K = 296 * MiB, WS_V = 312 * MiB, WS_VT = 328 * MiB;
constexpr size_t WS_MIX = 256 * MiB;
constexpr size_t WS_GS = 344 * MiB, WS_GA = 376 * MiB;
constexpr size_t WS_YG = 408 * MiB, WS_Y2 = 424 * MiB, WS_YA = 440 * MiB;
constexpr size_t WS_M1 = 456 * MiB;
constexpr size_t WS_H2 = 480 * MiB;
constexpr size_t WS_WIN8 = 96 * MiB, WS_XN8 = 100 * MiB;
constexpr size_t WS_X1B = 416 * MiB;
constexpr size_t WS_XG = 224 * MiB, WS_YB = 224 * MiB;
constexpr size_t WS_H1 = 352 * MiB;
constexpr size_t WS_END = 512 * MiB;
static_assert(WS_YB + (size_t)T * TOPK * D * 2 <= WS_H1 && WS_H1 + (size_t)T * TOPK * FF * 2 <= WS_H2 && WS_H2 + (size_t)T * D * 2 <= WS_END, "ws map");
constexpr int CW_TMO = 0, CW_CODE = 1, CW_BAR = 4096, CW_ECNT = 8192, CW_KM = 16384;
constexpr size_t CTL_ZERO_USED = (size_t)(CW_KM + BATCH * NH * NBLK * HD) * 4;
static_assert(CTL_ZERO_USED <= CTL_ZERO_BYTES, "ctl");

constexpr int RING_OFF = 0, RING_BYTES = 131072;
constexpr int LDSCTL_OFF = 152 * 1024, MISC_OFF = LDSCTL_OFF + 320;
constexpr int LDS_BYTES = 158 * 1024;

#define GAS __attribute__((address_space(1)))
#define LAS __attribute__((address_space(3)))
typedef unsigned short bf16;
typedef unsigned v4u __attribute__((ext_vector_type(4)));
typedef unsigned v2u __attribute__((ext_vector_type(2)));
typedef float f32x4 __attribute__((ext_vector_type(4)));
typedef GAS unsigned gu32;
#define RLX_AGENT __ATOMIC_RELAXED, __HIP_MEMORY_SCOPE_AGENT
#define LDS_WAIT() asm volatile("s_waitcnt lgkmcnt(0)" ::: "memory")
#define VM_WAIT() asm volatile("s_waitcnt vmcnt(0)" ::: "memory")
__device__ __forceinline__ unsigned f2bf(float f) { unsigned u = __builtin_bit_cast(unsigned, f); return (u + 0x7fffu + ((u >> 16) & 1u)) >> 16; }
__device__ __forceinline__ unsigned pk2(float lo, float hi) { typedef float f32x2_t __attribute__((ext_vector_type(2))); typedef __bf16 bf16x2_t __attribute__((ext_vector_type(2)));
    f32x2_t v = {lo, hi}; bf16x2_t r = __builtin_convertvector(v, bf16x2_t); return __builtin_bit_cast(unsigned, r); }
#ifdef WT_STORES
__device__ __forceinline__ void st16(void* p, v4u v) { asm volatile("global_store_dwordx4 %0, %1, off sc1\n\ts_nop 1" :: "v"(p), "v"(v) : "memory"); }
__device__ __forceinline__ void st8(void* p, v2u v) { asm volatile("global_store_dwordx2 %0, %1, off sc1\n\ts_nop 1" :: "v"(p), "v"(v) : "memory"); }
#else
__device__ __forceinline__ void st16(void* p, v4u v) { *(v4u*)p = v; }
__device__ __forceinline__ void st8(void* p, v2u v) { *(v2u*)p = v; }
#endif
__device__ __forceinline__ unsigned pk4_fp8(float a, float b, float c, float d) {
    a = fminf(fmaxf(a, -448.f), 448.f); b = fminf(fmaxf(b, -448.f), 448.f); c = fminf(fmaxf(c, -448.f), 448.f); d = fminf(fmaxf(d, -448.f), 448.f);
    int w = 0; w = __builtin_amdgcn_cvt_pk_fp8_f32(a, b, w, false); w = __builtin_amdgcn_cvt_pk_fp8_f32(c, d, w, true); return (unsigned)w; }
__device__ __forceinline__ float bflo(unsigned w) { return __builtin_bit_cast(float, w << 16); }
__device__ __forceinline__ float bfhi(unsigned w) { return __builtin_bit_cast(float, w & 0xffff0000u); }
__device__ __forceinline__ float bf2f(bf16 h) { return __builtin_bit_cast(float, (unsigned)h << 16); }
__device__ __forceinline__ float sigmoidf_(float x) { return 1.f / (1.f + __expf(-x)); }
__device__ __forceinline__ float gelu_tanh(float x) { const float u = 1.5957691216057308f * (x + 0.044715f * x * x * x); return x / (1.f + __expf(-u)); }

#define XB_TMO      128
#define XB_XCNT(j)  (256  + 64 * (j))
#define XB_XSUB(j)  (1280 + 64 * (j))
#define XB_XGEN(j)  (2304 + 64 * (j))
#define XB_TOP      3328
#define XB_TOPGEN   3392
#define XCD_BAR_WORDS 3456
#define XB_SPIN_CAP (1u << 18)
__device__ __forceinline__ unsigned xb_ld(unsigned* p)              { return __hip_atomic_load(p, __ATOMIC_RELAXED, __HIP_MEMORY_SCOPE_AGENT); }
__device__ __forceinline__ unsigned xb_add(unsigned* p, unsigned v) { return __hip_atomic_fetch_add(p, v, __ATOMIC_RELAXED, __HIP_MEMORY_SCOPE_AGENT); }
__device__ __forceinline__ unsigned xb_xcc_id() { return (unsigned)__builtin_amdgcn_s_getreg((3 << 11) | 20) & 0xFu; }
#define XB_SPIN(cond, bar) do { unsigned _sp = 0; while (cond) { __builtin_amdgcn_s_sleep(1); \
    if ((++_sp & 255u) == 0u) { if (xb_ld(&(bar)[XB_TMO])) break; if (_sp > XB_SPIN_CAP) { atomicAdd(&(bar)[XB_TMO], 1u); break; } } } } while (0)
struct XcdBarrier { unsigned* bar; unsigned x; volatile LAS unsigned* st; };
__device__ __forceinline__ XcdBarrier xcd_barrier_post(unsigned* bar, volatile LAS unsigned* st) {
    XcdBarrier b; b.bar = bar; b.x = xb_xcc_id(); b.st = st;
    if (threadIdx.x == 0) (void)xb_add(&bar[XB_XCNT(b.x)], 1u);
    return b;
}
__device__ __forceinline__ void xcd_barrier_complete(unsigned* bar, unsigned x, unsigned& nloc, unsigned& nx) {
    const unsigned G = gridDim.x * gridDim.y * gridDim.z;
    unsigned sum, cnt, mine, sp = 0u;
    for (;;) {
        sum = 0u; cnt = 0u; mine = 0u;
#pragma unroll
        for (unsigned j = 0; j < 16; ++j) { const unsigned c = xb_ld(&bar[XB_XCNT(j)]); sum += c; cnt += (c > 0u) ? 1u : 0u; mine = (j == x) ? c : mine; }
        if (sum == G) break;
        __builtin_amdgcn_s_sleep(1);
        if ((++sp & 255u) == 0u) { if (xb_ld(&bar[XB_TMO])) break; if (sp > XB_SPIN_CAP) { atomicAdd(&bar[XB_TMO], 1u); break; } }
    }
    nloc = mine > 0u ? mine : 1u; nx = cnt > 0u ? cnt : 1u;
}
__device__ __forceinline__ void xcd_barrier(const XcdBarrier& b) {
    asm volatile("s_waitcnt vmcnt(0)" ::: "memory");
    __syncthreads();
    if (threadIdx.x == 0) {
        unsigned* bar = b.bar;
        __builtin_amdgcn_s_waitcnt(0);
        unsigned nloc = b.st[0], nx = b.st[1];
        if (nloc == 0u) { xcd_barrier_complete(bar, b.x, nloc, nx); b.st[0] = nloc; b.st[1] = nx; }
        const unsigned old = xb_add(&bar[XB_XSUB(b.x)], 1u);
        const unsigned gen = old / nloc;
        if (old + 1u == (gen + 1u) * nloc) {
            __builtin_amdgcn_fence(__ATOMIC_RELEASE, "agent");
            asm volatile("s_waitcnt vmcnt(0)" ::: "memory");
            const unsigned og = xb_add(&bar[XB_TOP], 1u);
            const unsigned tg = og / nx;
            if (og + 1u == (tg + 1u) * nx) xb_add(&bar[XB_TOPGEN], 1u);
            else XB_SPIN(xb_ld(&bar[XB_TOPGEN]) == tg, bar);
            __builtin_amdgcn_fence(__ATOMIC_ACQUIRE, "agent");
            xb_add(&bar[XB_XGEN(b.x)], 1u);
            asm volatile("s_waitcnt vmcnt(0)" ::: "memory");
        } else {
            XB_SPIN(xb_ld(&bar[XB_XGEN(b.x)]) == gen, bar);
            __builtin_amdgcn_fence(__ATOMIC_ACQUIRE, "agent");
            asm volatile("s_waitcnt vmcnt(0)" ::: "memory");
        }
    }
    __syncthreads();
}

__device__ __forceinline__ float wave_sum(float v) {
#pragma unroll
    for (int o = 1; o < 64; o <<= 1) v += __shfl_xor(v, o);
    return v;
}
__device__ __forceinline__ float wave_max(float v) {
#pragma unroll
    for (int o = 1; o < 64; o <<= 1) v = fmaxf(v, __shfl_xor(v, o));
    return v;
}
struct Frame {
    LAS unsigned char* lds;
    volatile LAS unsigned* MISC;
    gu32* ctl;
    int tid, lane, wave;
    int vcu, G;
    unsigned char* ws;
    const float* in[30];
    float* out;
};
#define WSP(T_, off) ((T_*)(F.ws + (off)))

__device__ __forceinline__ int perm8(int c) { return (c & ~31) + 16 * ((c >> 2) & 1) + 4 * ((c >> 3) & 3) + (c & 3); }
struct MapP8 { int off; __device__ __forceinline__ int operator()(int n) const { return off + perm8(n); } };
struct MapWin { __device__ __forceinline__ int operator()(int c) const {
    if (c < 512 || c >= 1536) return perm8(c);
    const int base = (c < 1024) ? 512 : 1024, cc = c - base, head = cc >> 6, d = cc & 63, pnq = head >> 2, hh = head & 3, n = d >> 5, dd = d & 31;
    const int wc = 2 * (hh & 1) + (dd >> 4), bj = hh >> 1, j = dd & 15;
    return base + 256 * pnq + 128 * bj + 32 * wc + 16 * n + j; } };
struct MapGU { int e, up; __device__ __forceinline__ int operator()(int f) const { return e * 2048 + (f >> 7) * 256 + up * 128 + perm8(f & 127); } };

template <class RowMap>
__device__ __forceinline__ void p0_transpose_item(const float* W, int K, int N, bf16* WT, LAS float* scr, int item, int lane, const RowMap rm) {
    const int nblk = N / 64, kb = item / nblk, nb = item % nblk, k0 = 64 * kb, n0 = 64 * nb;
    const int lr = lane >> 4, lc = 4 * (lane & 15);
    f32x4 v[16];
#pragma unroll
    for (int i = 0; i < 16; ++i) v[i] = __builtin_nontemporal_load((const GAS f32x4*)(W + (size_t)(k0 + 4 * i + lr) * N + n0 + lc));
#pragma unroll
    for (int i = 0; i < 16; ++i) { LAS float* d = scr + (4 * i + lr) * 65 + lc; d[0] = v[i].x; d[1] = v[i].y; d[2] = v[i].z; d[3] = v[i].w; }
    LDS_WAIT(); asm volatile("" ::: "memory");
    const int c = lane & 7;
#pragma unroll
    for (int j = 0; j < 8; ++j) { const int n = (lane >> 3) + 8 * j; const LAS float* s = scr + (8 * c) * 65 + n;
        v4u o; o.x = pk2(s[0 * 65], s[1 * 65]); o.y = pk2(s[2 * 65], s[3 * 65]); o.z = pk2(s[4 * 65], s[5 * 65]); o.w = pk2(s[6 * 65], s[7 * 65]);
        __builtin_nontemporal_store(o, (GAS v4u*)(WT + (size_t)rm(n0 + n) * K + k0 + 8 * c)); }
    LDS_WAIT(); asm volatile("" ::: "memory");
}

template <class RowMap>
__device__ __forceinline__ void p0_transpose_item_f8(const float* W, int K, int N, unsigned char* WT, LAS float* scr, int item, int lane, const RowMap rm, float wsc) {
    const int nblk = N / 64, kb = item / nblk, nb = item % nblk, k0 = 64 * kb, n0 = 64 * nb;
    const int lr = lane >> 4, lc = 4 * (lane & 15);
    f32x4 v[16];
#pragma unroll
    for (int i = 0; i < 16; ++i) v[i] = __builtin_nontemporal_load((const GAS f32x4*)(W + (size_t)(k0 + 4 * i + lr) * N + n0 + lc));
#pragma unroll
    for (int i = 0; i < 16; ++i) { LAS float* d = scr + (4 * i + lr) * 65 + lc; d[0] = v[i].x * wsc; d[1] = v[i].y * wsc; d[2] = v[i].z * wsc; d[3] = v[i].w * wsc; }
    LDS_WAIT(); asm volatile("" ::: "memory");
    const int c = lane & 3;
#pragma unroll
    for (int j = 0; j < 4; ++j) { const int n = (lane >> 2) + 16 * j; const LAS float* s = scr + (16 * c) * 65 + n;
        v4u o; o.x = pk4_fp8(s[0 * 65], s[1 * 65], s[2 * 65], s[3 * 65]); o.y = pk4_fp8(s[4 * 65], s[5 * 65], s[6 * 65], s[7 * 65]);
        o.z = pk4_fp8(s[8 * 65], s[9 * 65], s[10 * 65], s[11 * 65]); o.w = pk4_fp8(s[12 * 65], s[13 * 65], s[14 * 65], s[15 * 65]);
        __builtin_nontemporal_store(o, (GAS v4u*)(WT + (size_t)rm(n0 + n) * K + k0 + 16 * c)); }
    LDS_WAIT(); asm volatile("" ::: "memory");
}

__device__ __forceinline__ void p0_moe_load(const float* W, int item, int lane, f32x4 (&v)[16]) {
    const int kb = item >> 4, nb = item & 15, k0 = 64 * kb, n0 = 64 * nb, lr = lane >> 4, lc = 4 * (lane & 15);
#pragma unroll
    for (int i = 0; i < 16; ++i) v[i] = __builtin_nontemporal_load((const GAS f32x4*)(W + (size_t)(k0 + 4 * i + lr) * 1024 + n0 + lc));
}
__device__ __forceinline__ void p0_moe_finish(unsigned char* WT, int rowbase, int kind, int item, LAS float* scr, int lane, const f32x4 (&v)[16], float wsc) {
    const int kb = item >> 4, nb = item & 15, k0 = 64 * kb, n0 = 64 * nb, lr = lane >> 4, lc = 4 * (lane & 15);
#pragma unroll
    for (int i = 0; i < 16; ++i) { LAS float* d = scr + (4 * i + lr) * 65 + lc; d[0] = v[i].x * wsc; d[1] = v[i].y * wsc; d[2] = v[i].z * wsc; d[3] = v[i].w * wsc; }
    LDS_WAIT(); asm volatile("" ::: "memory");
    const int c = lane & 3;
#pragma unroll
    for (int j = 0; j < 4; ++j) { const int n = n0 + (lane >> 2) + 16 * j; const LAS float* s = scr + (16 * c) * 65 + (n - n0);
        const int row = rowbase + (kind < 2 ? (n >> 7) * 256 + kind * 128 + perm8(n & 127) : perm8(n));
        v4u o; o.x = pk4_fp8(s[0 * 65], s[1 * 65], s[2 * 65], s[3 * 65]); o.y = pk4_fp8(s[4 * 65], s[5 * 65], s[6 * 65], s[7 * 65]);
        o.z = pk4_fp8(s[8 * 65], s[9 * 65], s[10 * 65], s[11 * 65]); o.w = pk4_fp8(s[12 * 65], s[13 * 65], s[14 * 65], s[15 * 65]);
        __builtin_nontemporal_store(o, (GAS v4u*)(WT + (size_t)row * 1024 + k0 + 16 * c)); }
    LDS_WAIT(); asm volatile("" ::: "memory");
}

constexpr int MOE_ITEMS_ALL = 3 * NE * 256, MOE_ITEMS_P3 = 2048, MOE_ITEMS_P5 = 2048, MOE_ITEMS_P6 = 6144, MOE_ITEMS_P0 = MOE_ITEMS_ALL - MOE_ITEMS_P3 - MOE_ITEMS_P5 - MOE_ITEMS_P6;
__device__ __forceinline__ void p0_moe_range(Frame& F, int first, int count, int gw, int ngw, float wsc) {
    LAS float* scr = (LAS float*)(F.lds + RING_OFF + F.wave * 16640);
    const float* wg = F.in[24]; const float* wu = F.in[26]; const float* wd = F.in[28];
    unsigned char* tgu = WSP(unsigned char, WS_WGU_T); unsigned char* tdn = WSP(unsigned char, WS_WDN_T);
#define P0_DEC(r_, W_, WT_, rb_, kd_, it_) const int mat_##r_ = (first + (r_)) >> 8, it_ = (first + (r_)) & 255, kd_ = mat_##r_ >> 5, e_##r_ = mat_##r_ & 31; \
    const float* W_ = (kd_ == 0 ? wg : (kd_ == 1 ? wu : wd)) + (size_t)e_##r_ * D * FF; unsigned char* WT_ = kd_ < 2 ? tgu : tdn; const int rb_ = kd_ < 2 ? e_##r_ * 2048 : e_##r_ * 1024;
    f32x4 va[16], vb[16]; int r = gw;
    if (r < count) { P0_DEC(r, W0, T0, b0, k0_, i0); (void)T0; (void)b0; (void)k0_; p0_moe_load(W0, i0, F.lane, va); }
    while (r < count) {
        { const int rn = r + ngw; if (rn < count) { P0_DEC(rn, W1, T1, b1, k1_, i1); (void)T1; (void)b1; (void)k1_; p0_moe_load(W1, i1, F.lane, vb); } }
        { P0_DEC(r, W2, T2, b2, k2_, i2); (void)W2; p0_moe_finish(T2, b2, k2_, i2, scr, F.lane, va, wsc); }
        r += ngw; if (r >= count) break;
        { const int rn = r + ngw; if (rn < count) { P0_DEC(rn, W3, T3, b3, k3_, i3); (void)T3; (void)b3; (void)k3_; p0_moe_load(W3, i3, F.lane, va); } }
        { P0_DEC(r, W4, T4, b4, k4_, i4); (void)W4; p0_moe_finish(T4, b4, k4_, i4, scr, F.lane, vb, wsc); }
        r += ngw;
    }
#undef P0_DEC
}
__device__ __forceinline__ void moe_convert_idle(Frame& F, int first, int count) {
    if (F.G != 256) { if (blockIdx.x == 0) { } }
    const int nb = F.G == 256 ? 128 : F.G, bi = F.G == 256 ? (int)blockIdx.x - 128 : (int)blockIdx.x;
    if (bi < 0) return;
    p0_moe_range(F, first, count, bi * NWAVES + F.wave, nb * NWAVES, WSP(float, WS_PAR)[PAR_WSC]);
}

__device__ __forceinline__ void phase0(Frame& F) {
    LAS float* scr = (LAS float*)(F.lds + RING_OFF + F.wave * 16640);
    const int gw = F.vcu * NWAVES + F.wave, NGW = F.G * NWAVES;
#ifdef MOE_F8
    float wsc;
    { float am = 0.f;
      for (int j = F.tid; j < 2048; j += NWAVES * 64) { const size_t o = (size_t)j * 16384 + 37 * (j & 63);
          am = fmaxf(am, fmaxf(fabsf(F.in[24][o]), fmaxf(fabsf(F.in[26][o]), fabsf(F.in[28][o])))); }
      am = wave_max(am); LAS float* red = (LAS float*)(F.lds + LDSCTL_OFF + 64);
      if (F.lane == 0) red[F.wave] = am;
      __syncthreads();
      am = red[0];
#pragma unroll
      for (int w = 1; w < NWAVES; ++w) am = fmaxf(am, red[w]);
      wsc = exp2f(floorf(log2f(448.f / (fmaxf(am, 1e-30f) * 8.f))));
      if (blockIdx.x == 0 && F.tid == 0) WSP(float, WS_PAR)[PAR_WSC] = wsc;
      __syncthreads(); }
#endif
#if defined(G1_F8) || defined(G1_MIX)
    float wsc1;
    { float am = 0.f;
      for (int j = F.tid; j < 2048; j += NWAVES * 64) am = fmaxf(am, fabsf(F.in[9][(size_t)j * 2048 + 37 * (j & 31)]));
      am = wave_max(am); LAS float* red = (LAS float*)(F.lds + LDSCTL_OFF + 64);
      if (F.lane == 0) red[F.wave] = am;
      __syncthreads();
      am = red[0];
#pragma unroll
      for (int w = 1; w < NWAVES; ++w) am = fmaxf(am, red[w]);
      wsc1 = exp2f(floorf(log2f(448.f / (fmaxf(am, 1e-30f) * 8.f))));
      if (blockIdx.x == 0 && F.tid == 0) WSP(float, WS_PAR)[PAR_WSC1] = wsc1;
      __syncthreads(); }
#endif
    constexpr int I_WIN = 16 * 64, I_GLU = 8 * 8, I_SB = 8 * 16, I_AB = 8 * 16, I_OUT = 16 * 16, I_E = 16 * 16;
    constexpr int I_SMALL = I_WIN + I_GLU + I_SB + I_AB + I_OUT, I_MOE = 3 * NE * I_E, I_ADA = 16 * 96;
    constexpr int NITEMS = I_SMALL + I_MOE + I_ADA;
    for (int it = gw; it < NITEMS; it += NGW) {
        int r = it;
#if defined(G1_MIX)
        if (r < I_WIN) { p0_transpose_item(F.in[9], D, INW, WSP(bf16, WS_WIN_T), scr, r, F.lane, MapWin{}); p0_transpose_item_f8(F.in[9], D, INW, WSP(unsigned char, WS_WIN8), scr, r, F.lane, MapWin{}, wsc1); continue; } r -= I_WIN;
#elif defined(G1_F8)
        if (r < I_WIN) { p0_transpose_item_f8(F.in[9], D, INW, WSP(unsigned char, WS_WIN_T), scr, r, F.lane, MapWin{}, wsc1); continue; } r -= I_WIN;
#else
        if (r < I_WIN) { p0_transpose_item(F.in[9], D, INW, WSP(bf16, WS_WIN_T), scr, r, F.lane, MapWin{}); continue; } r -= I_WIN;
#endif
        if (r < I_GLU) { p0_transpose_item(F.in[18], SW, SW, WSP(bf16, WS_WGLU_T), scr, r, F.lane, MapP8{0}); continue; } r -= I_GLU;
        if (r < I_SB) { p0_transpose_item(F.in[19], SW, D, WSP(bf16, WS_WSB_T), scr, r, F.lane, MapP8{0}); continue; } r -= I_SB;
        if (r < I_AB) { p0_transpose_item(F.in[20], AW, D, WSP(bf16, WS_WAB_T), scr, r, F.lane, MapP8{0}); continue; } r -= I_AB;
        if (r < I_OUT) { p0_transpose_item(F.in[21], D, D, WSP(bf16, WS_WOUT_T), scr, r, F.lane, MapP8{0}); continue; } r -= I_OUT;
        if (r < I_MOE) {
#ifdef MOE_F8
            continue;
#endif
            const int mat = r / I_E, item = r % I_E, kind = mat / NE, e = mat % NE;
#ifdef MOE_F8
            if (kind == 0) p0_transpose_item_f8(F.in[24] + (size_t)e * D * FF, D, FF, WSP(unsigned char, WS_WGU_T), scr, item, F.lane, MapGU{e, 0}, wsc);
            else if (kind == 1) p0_transpose_item_f8(F.in[26] + (size_t)e * D * FF, D, FF, WSP(unsigned char, WS_WGU_T), scr, item, F.lane, MapGU{e, 1}, wsc);
            else p0_transpose_item_f8(F.in[28] + (size_t)e * FF * D, FF, D, WSP(unsigned char, WS_WDN_T), scr, item, F.lane, MapP8{e * 1024}, wsc);
#else
            if (kind == 0) p0_transpose_item(F.in[24] + (size_t)e * D * FF, D, FF, WSP(bf16, WS_WGU_T), scr, item, F.lane, MapGU{e, 0});
            else if (kind == 1) p0_transpose_item(F.in[26] + (size_t)e * D * FF, D, FF, WSP(bf16, WS_WGU_T), scr, item, F.lane, MapGU{e, 1});
            else p0_transpose_item(F.in[28] + (size_t)e * FF * D, FF, D, WSP(bf16, WS_WDN_T), scr, item, F.lane, MapP8{e * 1024});
#endif
            continue; }
        r -= I_MOE;
        {
            const int ks = r / 96, cc = r % 96, n = cc * 64 + F.lane;
            const float* cvec = F.in[1]; const float* aw = F.in[3];
            float a0 = 0.f, a1 = 0.f;
            for (int k = ks * 64; k < ks * 64 + 64; ++k) {
                const float c0 = cvec[k], c1 = cvec[D + k];
                const float s0 = c0 / (1.f + __expf(-c0)), s1 = c1 / (1.f + __expf(-c1));
                const float w = __builtin_nontemporal_load(aw + (size_t)k * (6 * D) + n);
                a0 += s0 * w; a1 += s1 * w; }
            float* part = WSP(float, WS_ADA);
            part[(ks * 2 + 0) * (6 * D) + n] = a0; part[(ks * 2 + 1) * (6 * D) + n] = a1;
        }
    }
#ifdef MOE_F8
    p0_moe_range(F, 0, MOE_ITEMS_P0, gw, NGW, wsc);
#endif
    const int gt = F.vcu * (NWAVES * 64) + F.tid, NGT = F.G * NWAVES * 64;
    { const int* pos = (const int*)F.in[2]; float* rc = WSP(float, WS_ROPE); float* rs = rc + (size_t)T * 32;
      for (int i = gt; i < T * 32; i += NGT) { const int t = i >> 5, p = i & 31;
          const float invf = exp2f(-(float)p * (13.287712379549449f / 32.f));
          const double ang = (double)pos[t] * (double)invf; double rev = ang * 0.15915494309189535; rev -= floor(rev);
          const float fr = (float)rev;
          rc[i] = __builtin_amdgcn_cosf(fr); rs[i] = __builtin_amdgcn_sinf(fr); } }
    { float* P5 = WSP(float, WS_S5P);
      for (int i = gt; i < NG * NP; i += NGT) { const int g = i >> 6;
          const float dt = __expf(F.in[12][g]); const float lr = F.in[10][i], li = F.in[11][i];
          const float er = __expf(lr * dt); const double ang = (double)li * (double)dt; double rev = ang * 0.15915494309189535; rev -= floor(rev);
          const float cs = __builtin_amdgcn_cosf((float)rev), sn = __builtin_amdgcn_sinf((float)rev);
          float br = er * cs, bi = er * sn;
          P5[i] = br; P5[2048 + i] = bi;
          const float nr = br - 1.f, ni = bi, den = lr * lr + li * li;
          const float qr = (nr * lr + ni * li) / den, qi = (ni * lr - nr * li) / den;
          P5[8192 + i] = qr; P5[8192 + 2048 + i] = qi;
          float pr = br, pi_ = bi;
#pragma unroll
          for (int s = 0; s < 8; ++s) { const float tr = pr * pr - pi_ * pi_, ti = 2.f * pr * pi_; pr = tr; pi_ = ti; }
          P5[4096 + i] = pr; P5[6144 + i] = pi_;
          float* PW = P5 + 131072;
          float wr_ = 1.f, wi_ = 0.f;
#pragma unroll
          for (int k = 0; k <= 16; ++k) { PW[i * 17 + k] = wr_; PW[2048 * 17 + i * 17 + k] = wi_; const float tr = wr_ * br - wi_ * bi, ti = wr_ * bi + wi_ * br; wr_ = tr; wi_ = ti; } }
    }
}

__device__ __forceinline__ void phase1(Frame& F) {
    LAS float* A1 = (LAS float*)(F.lds + RING_OFF); LAS float* A2 = A1 + 2 * D;
    const float* part = WSP(float, WS_ADA); const float* ab = F.in[4]; const float* pg = F.in[5];
    for (int k = F.tid; k < D; k += NWAVES * 64)
#pragma unroll
        for (int b = 0; b < 2; ++b) { float sh = ab[k], sc = ab[D + k];
            for (int ks = 0; ks < 16; ++ks) { sh += part[(ks * 2 + b) * (6 * D) + k]; sc += part[(ks * 2 + b) * (6 * D) + D + k]; }
            A1[b * D + k] = pg[k] * (1.f + sc); A2[b * D + k] = sh; }
    const int gt = F.vcu * (NWAVES * 64) + F.tid, NGT = F.G * NWAVES * 64;
    { float* adaf = WSP(float, WS_ADAF);
      for (int n = gt; n < 2 * 6 * D; n += NGT) { const int b = n / (6 * D), j = n % (6 * D); float a = ab[j];
          for (int ks = 0; ks < 16; ++ks) a += part[(ks * 2 + b) * (6 * D) + j];
          adaf[n] = a; } }
    { float* par = WSP(float, WS_PAR);
      for (int i = gt; i < 32768; i += NGT) { par[PAR_RW + i] = F.in[22][i]; par[PAR_BG + i] = F.in[25][i]; par[PAR_BU + i] = F.in[27][i]; par[PAR_BD + i] = F.in[29][i];
          par[PAR_CRE + i] = F.in[15][i]; par[PAR_CIM + i] = F.in[16][i]; par[PAR_BRE + i] = F.in[13][i]; par[PAR_BIM + i] = F.in[14][i];
          if (i < 1024) { par[PAR_MPG + i] = F.in[6][i]; par[PAR_FPRE + i] = F.in[7][i]; par[PAR_FPOST + i] = F.in[8][i]; }
          if (i < 512) par[PAR_SD + i] = F.in[17][i];
          if (i < 32) par[PAR_RB + i] = F.in[23][i]; } }
    { const float* P5 = WSP(float, WS_S5P); const float* PWr = P5 + 131072; const float* PWi = PWr + 2048 * 17;
      bf16* M1t = WSP(bf16, WS_S5M1);
      for (int i = gt; i < NG * 256 * 256; i += NGT) { const int k = i & 255, n = (i >> 8) & 255, g = i >> 16; float val = 0.f;
          if (n < 128) { const int p = n & 63, gp = g * 64 + p, s_ = k >> 4, ci = k & 15;
              const float qr = P5[8192 + gp], qi = P5[8192 + 2048 + gp], b_r = F.in[13][gp * 16 + ci], b_i = F.in[14][gp * 16 + ci];
              const float bbr = qr * b_r - qi * b_i, bbi = qr * b_i + qi * b_r, wr_ = PWr[gp * 17 + 15 - s_], wi_ = PWi[gp * 17 + 15 - s_];
              val = (n < 64) ? (wr_ * bbr - wi_ * bbi) : (wr_ * bbi + wi_ * bbr); }
          M1t[((size_t)(g * 256 + perm8(n))) * 256 + k] = (bf16)f2bf(val); }
    }
    __syncthreads();
    const int gw = F.vcu * NWAVES + F.wave, NGW = F.G * NWAVES;
    bf16* XN = WSP(bf16, WS_XN);
    for (int m0 = gw * 2; m0 < T; m0 += NGW * 2) {
        const int b = m0 >> 13;
        f32x4 v[2][4];
#pragma unroll
        for (int q = 0; q < 2; ++q) { const GAS f32x4* xr = (const GAS f32x4*)(F.in[0] + (size_t)(m0 + q) * D) + F.lane;
#pragma unroll
            for (int j = 0; j < 4; ++j) v[q][j] = __builtin_nontemporal_load(xr + 64 * j); }
#pragma unroll
        for (int q = 0; q < 2; ++q) { float s = 0.f;
#pragma unroll
            for (int j = 0; j < 4; ++j) s += (v[q][j].x * v[q][j].x + v[q][j].y * v[q][j].y) + (v[q][j].z * v[q][j].z + v[q][j].w * v[q][j].w);
            const float rstd = 1.f / sqrtf(wave_sum(s) * (1.f / D) + NORM_EPS);
#ifdef G1_F8
            GAS unsigned* o4 = (GAS unsigned*)((unsigned char*)XN + (size_t)(m0 + q) * D) + F.lane;
#pragma unroll
            for (int j = 0; j < 4; ++j) { const f32x4 a1 = *(const LAS f32x4*)(A1 + b * D + 4 * F.lane + 256 * j), a2 = *(const LAS f32x4*)(A2 + b * D + 4 * F.lane + 256 * j);
                const f32x4 o = v[q][j] * rstd * a1 + a2;
                o4[64 * j] = pk4_fp8(8.f * o.x, 8.f * o.y, 8.f * o.z, 8.f * o.w); } }
#else
            GAS unsigned long long* o8 = (GAS unsigned long long*)(XN + (size_t)(m0 + q) * D) + F.lane;
#pragma unroll
            for (int j = 0; j < 4; ++j) { const f32x4 a1 = *(const LAS f32x4*)(A1 + b * D + 4 * F.lane + 256 * j), a2 = *(const LAS f32x4*)(A2 + b * D + 4 * F.lane + 256 * j);
                const f32x4 o = v[q][j] * rstd * a1 + a2;
                o8[64 * j] = (unsigned long long)pk2(o.x, o.y) | ((unsigned long long)pk2(o.z, o.w) << 32);
#ifdef G1_MIX
                ((GAS unsigned*)(WSP(unsigned char, WS_XN8) + (size_t)(m0 + q) * D) + F.lane)[64 * j] = pk4_fp8(8.f * o.x, 8.f * o.y, 8.f * o.z, 8.f * o.w);
#endif
            } }
#endif
    }
    __syncthreads();
}

struct EpiG1 {
    bf16 *UA, *Q, *K, *V, *VT, *GSp, *GAp; const float *rc, *rs; float* km; const float* wscp; bool f8;
    __device__ __forceinline__ void operator()(const pg8::f32x4 (&acc0)[2][2][4][2], const pg8::Unit& u, int wr, int wc, int fr, int fq) const {
        pg8::f32x4 (&acc)[2][2][4][2] = const_cast<pg8::f32x4 (&)[2][2][4][2]>(acc0);
#if defined(G1_F8) || defined(G1_MIX)
        if (f8) { const float s_ = 0.125f / *wscp;
#pragma unroll
            for (int a = 0; a < 2; ++a)
#pragma unroll
                for (int b = 0; b < 2; ++b)
#pragma unroll
                    for (int m = 0; m < 4; ++m)
#pragma unroll
                        for (int n = 0; n < 2; ++n) acc[a][b][m][n] = acc[a][b][m][n] * s_; }
#endif
        asm volatile("" : "+v"(fr), "+v"(fq));
        const int pn = u.pn, row0 = u.pm * 256 + wr * 64 + fr;
        if (pn < 2) {
#pragma unroll
            for (int ai = 0; ai < 2; ++ai)
#pragma unroll
                for (int m = 0; m < 4; ++m) { const int t = row0 + ai * 128 + m * 16, b = t >> 13, tt = t & (SEQ - 1), c = tt >> 4, s = tt & 15;
#pragma unroll
                    for (int bj = 0; bj < 2; ++bj) { const int ch = pn * 256 + bj * 128 + wc * 32 + 8 * fq, g = ch >> 4, ci = ch & 15;
                        const pg8::f32x4 v0 = acc[ai][bj][m][0], v1 = acc[ai][bj][m][1];
                        v4u w; w.x = pk2(v0[0], v0[1]); w.y = pk2(v0[2], v0[3]); w.z = pk2(v1[0], v1[1]); w.w = pk2(v1[2], v1[3]);
                        st16(UA + ((size_t)(g * 1024 + b * 512 + c) * 384 + 16 * s + ci), w); } }
        } else if (pn < 6) {
            const bool isk = pn >= 4; bf16* X = isk ? K : Q; const float sc = isk ? 1.f : C2;
            const int p0 = 16 * (wc & 1) + 4 * fq;
#pragma unroll
            for (int bj = 0; bj < 2; ++bj) {
                const int head = 4 * (pn & 1) + 2 * bj + (wc >> 1);
                int rowb = row0; asm volatile("" : "+v"(rowb));
                float ks[2][4];
#pragma unroll
                for (int b = 0; b < 2; ++b)
#pragma unroll
                    for (int i = 0; i < 4; ++i) ks[b][i] = 0.f;
#pragma unroll
                for (int ai = 0; ai < 2; ++ai)
#pragma unroll
                    for (int m = 0; m < 4; ++m) { const int t = rowb + ai * 128 + m * 16;
                        const pg8::f32x4 cs = *(const pg8::f32x4*)(rc + (size_t)t * 32 + p0), sn = *(const pg8::f32x4*)(rs + (size_t)t * 32 + p0);
                        const pg8::f32x4 t1 = acc[ai][bj][m][0], t2 = acc[ai][bj][m][1];
                        const pg8::f32x4 o1 = t1 * cs - t2 * sn, o2 = t2 * cs + t1 * sn;
                        v2u w1, w2; w1.x = pk2(o1[0] * sc, o1[1] * sc); w1.y = pk2(o1[2] * sc, o1[3] * sc); w2.x = pk2(o2[0] * sc, o2[1] * sc); w2.y = pk2(o2[2] * sc, o2[3] * sc);
                        bf16* dst = X + (size_t)t * AW + head * 64 + p0;
                        st8(dst, w1); st8(dst + 32, w2);
#pragma unroll
                        for (int i = 0; i < 4; ++i) { ks[0][i] += o1[i]; ks[1][i] += o2[i]; }
                        __builtin_amdgcn_sched_barrier(0); }
                if (isk) {
                    const int b = u.pm >> 5, blk = u.pm & 31;
#pragma unroll
                    for (int n = 0; n < 2; ++n)
#pragma unroll
                        for (int i = 0; i < 4; ++i) { float v = ks[n][i];
                            v += __shfl_xor(v, 1); v += __shfl_xor(v, 2); v += __shfl_xor(v, 4); v += __shfl_xor(v, 8);
                            if (fr == 0) atomicAdd(km + ((size_t)((b * NH + head) * NBLK + blk) * HD + 32 * n + p0 + i), v); }
                }
            }
        } else if (pn < 8) {
#pragma unroll
            for (int ai = 0; ai < 2; ++ai)
#pragma unroll
                for (int m = 0; m < 4; ++m) { const int t = row0 + ai * 128 + m * 16, b = t >> 13, tt = t & (SEQ - 1);
#pragma unroll
                    for (int bj = 0; bj < 2; ++bj) { const int cv = (pn - 6) * 256 + bj * 128 + wc * 32 + 8 * fq, head = cv >> 6, d = cv & 63;
                        const pg8::f32x4 v0 = acc[ai][bj][m][0], v1 = acc[ai][bj][m][1];
                        v4u w; w.x = pk2(v0[0], v0[1]); w.y = pk2(v0[2], v0[3]); w.z = pk2(v1[0], v1[1]); w.w = pk2(v1[2], v1[3]);
                        bf16* vt = VT + ((size_t)((b * NH + head) * HD + d) * SEQ + tt);
                        vt[0 * SEQ] = (bf16)(w.x & 0xffff); vt[1 * SEQ] = (bf16)(w.x >> 16); vt[2 * SEQ] = (bf16)(w.y & 0xffff); vt[3 * SEQ] = (bf16)(w.y >> 16);
                        vt[4 * SEQ] = (bf16)(w.z & 0xffff); vt[5 * SEQ] = (bf16)(w.z >> 16); vt[6 * SEQ] = (bf16)(w.w & 0xffff); vt[7 * SEQ] = (bf16)(w.w >> 16); } }
        } else {
            bf16* Gp = (pn < 12) ? GSp : GAp; const int cb = ((pn - 8) & 3) * 256;
#pragma unroll
            for (int ai = 0; ai < 2; ++ai)
#pragma unroll
                for (int m = 0; m < 4; ++m) { const int t = row0 + ai * 128 + m * 16;
#pragma unroll
                    for (int bj = 0; bj < 2; ++bj) { const int col = cb + bj * 128 + wc * 32 + 8 * fq;
                        const pg8::f32x4 v0 = acc[ai][bj][m][0], v1 = acc[ai][bj][m][1];
                        v4u w; w.x = pk2(sigmoidf_(v0[0]), sigmoidf_(v0[1])); w.y = pk2(sigmoidf_(v0[2]), sigmoidf_(v0[3]));
                        w.z = pk2(sigmoidf_(v1[0]), sigmoidf_(v1[1])); w.w = pk2(sigmoidf_(v1[2]), sigmoidf_(v1[3]));
                        __builtin_nontemporal_store(w, (v4u*)(Gp + (size_t)t * D + col)); } }
        }
    }
};

template <int MODE> struct EpiEw {
    bf16* O; const bf16* X1; const bf16* X2; float* Of; int ld;
    __device__ __forceinline__ void operator()(const pg8::f32x4 (&acc)[2][2][4][2], const pg8::Unit& u, int wr, int wc, int fr, int fq) const {
        const int row0 = u.pm * 256 + wr * 64 + fr, col0 = u.pn * 256 + wc * 32 + 8 * fq;
#pragma unroll
        for (int ai = 0; ai < 2; ++ai)
#pragma unroll
            for (int m = 0; m < 4; ++m) { const size_t rb = (size_t)(row0 + ai * 128 + m * 16) * ld + col0;
#pragma unroll
                for (int bj = 0; bj < 2; ++bj) { const size_t off = rb + bj * 128;
                    const pg8::f32x4 v0 = acc[ai][bj][m][0], v1 = acc[ai][bj][m][1];
                    if (MODE == 3) { *(pg8::f32x4*)(Of + off) = v0; *(pg8::f32x4*)(Of + off + 4) = v1; }
                    else if (MODE == 4) { v4u w; w.x = pk2(v0[0], v0[1]); w.y = pk2(v0[2], v0[3]); w.z = pk2(v1[0], v1[1]); w.w = pk2(v1[2], v1[3]); st16(O + off, w); }
                    else {
                        const v4u x = __builtin_nontemporal_load((const v4u*)(X1 + off));
                        float r[8] = {v0[0], v0[1], v0[2], v0[3], v1[0], v1[1], v1[2], v1[3]};
                        const float xv[8] = {bflo(x.x), bfhi(x.x), bflo(x.y), bfhi(x.y), bflo(x.z), bfhi(x.z), bflo(x.w), bfhi(x.w)};
                        if (MODE == 0) {
#pragma unroll
                            for (int i = 0; i < 8; ++i) r[i] = xv[i] * sigmoidf_(r[i]);
                        } else if (MODE == 1) {
#pragma unroll
                            for (int i = 0; i < 8; ++i) r[i] = xv[i] * r[i];
                        } else {
                            const v4u y = __builtin_nontemporal_load((const v4u*)(X2 + off));
                            const float yv[8] = {bflo(y.x), bfhi(y.x), bflo(y.y), bfhi(y.y), bflo(y.z), bfhi(y.z), bflo(y.w), bfhi(y.w)};
#pragma unroll
                            for (int i = 0; i < 8; ++i) r[i] = yv[i] + xv[i] * r[i];
                        }
                        v4u w; w.x = pk2(r[0], r[1]); w.y = pk2(r[2], r[3]); w.z = pk2(r[4], r[5]); w.w = pk2(r[6], r[7]);
                        st16(O + off, w); } } }
    }
};

typedef short bf16x8 __attribute__((ext_vector_type(8)));
typedef float f32x16 __attribute__((ext_vector_type(16)));
constexpr size_t WS_ALIST = 456 * MiB;
constexpr size_t WS_OP01 = 224 * MiB;
constexpr size_t WS_OP23 = 472 * MiB;
constexpr size_t WS_LSE = 504 * MiB;
constexpr int CW_BCNT = 12288;
constexpr int ALCAP = 8192;

__device__ __forceinline__ void attn_gate(Frame& F) {
    const int gw = F.vcu * NWAVES + F.wave, NGW = F.G * NWAVES, L = F.lane;
    const bf16* Q = WSP(bf16, WS_Q); const float* km = (const float*)(F.ctl + CW_KM);
    unsigned* bcnt = (unsigned*)(F.ctl + CW_BCNT); unsigned* list = WSP(unsigned, WS_ALIST); float* lse = WSP(float, WS_LSE);
    LAS float* kml = (LAS float*)(F.lds);
    for (int w0 = F.vcu * NWAVES; w0 < BATCH * NH * (SEQ / 64); w0 += NGW) {
        const int w = w0 + F.wave, bh = w0 >> 7;
        __syncthreads();
        { const f32x4 x = *(const f32x4*)(km + (size_t)bh * NBLK * HD + F.tid * 4); *(LAS f32x4*)(kml + F.tid * 4) = x; }
        __syncthreads();
        const int b = bh >> 3, h = bh & 7, tt = (w & 127) * 64 + L, t = b * SEQ + tt, blk = __builtin_amdgcn_readfirstlane(tt >> 8);
        float q[64];
        { const v4u* qp = (const v4u*)(Q + (size_t)t * AW + h * 64);
#pragma unroll
          for (int i = 0; i < 8; ++i) { const v4u x = qp[i]; q[8 * i] = bflo(x.x); q[8 * i + 1] = bfhi(x.x); q[8 * i + 2] = bflo(x.y); q[8 * i + 3] = bfhi(x.y);
              q[8 * i + 4] = bflo(x.z); q[8 * i + 5] = bfhi(x.z); q[8 * i + 6] = bflo(x.w); q[8 * i + 7] = bfhi(x.w); } }
        float v0 = -3e38f, v1 = -3e38f, v2 = -3e38f; int i0 = -1, i1 = -1, i2 = -1;
        for (int j = 0; j < blk; ++j) { const LAS float* kp = kml + j * HD; float g = 0.f;
#pragma unroll
            for (int d = 0; d < 64; d += 4) { const f32x4 k4 = *(const LAS f32x4*)(kp + d); g += q[d] * k4[0]; g += q[d + 1] * k4[1]; g += q[d + 2] * k4[2]; g += q[d + 3] * k4[3]; }
            if (g > v0) { v2 = v1; i2 = i1; v1 = v0; i1 = i0; v0 = g; i0 = j; }
            else if (g > v1) { v2 = v1; i2 = i1; v1 = g; i1 = j; }
            else if (g > v2) { v2 = g; i2 = j; } }
        float* lp = lse + ((size_t)t * NH + h) * 4;
        if (i0 < 0) lp[0] = -1e30f; if (i1 < 0) lp[1] = -1e30f; if (i2 < 0) lp[2] = -1e30f;
        int mycnt = 0;
        for (int j = 0; j < blk; ++j) { const bool sel = (i0 == j) || (i1 == j) || (i2 == j); const unsigned long long mask = __ballot(sel); if (L == j) mycnt = __popcll(mask); }
        unsigned mybase = 0u;
        if (mycnt > 0) mybase = __hip_atomic_fetch_add(bcnt + bh * NBLK + L, (unsigned)mycnt, RLX_AGENT);
        for (int j = 0; j < blk; ++j) {
            const bool sel = (i0 == j) || (i1 == j) || (i2 == j);
            const unsigned long long mask = __ballot(sel);
            const unsigned base = (unsigned)__builtin_amdgcn_readlane((int)mybase, j);
            if (sel) { const unsigned pos = base + (unsigned)__popcll(mask & ((1ull << L) - 1ull)); const unsigned slot = (i0 == j) ? 0u : ((i1 == j) ? 1u : 2u);
                list[(size_t)(bh * NBLK + j) * ALCAP + pos] = ((unsigned)tt << 2) | slot; }
        }
    }
    __syncthreads();
}

__device__ __forceinline__ unsigned cvtpk(float lo, float hi) { typedef float f32x2_t __attribute__((ext_vector_type(2))); typedef __bf16 bf16x2_t __attribute__((ext_vector_type(2)));
    f32x2_t v = {lo, hi}; bf16x2_t r = __builtin_convertvector(v, bf16x2_t); return __builtin_bit_cast(unsigned, r); }

constexpr int AT_KROW = 144, AT_VROW = 520, AT_KOFF = 0, AT_VOFF = 256 * AT_KROW;
__device__ __forceinline__ void attn_item(Frame& F, int b, int h, int j, bool own, const unsigned* lst, int nvalid) {
    const int tid = F.tid, L = F.lane, r = L & 31, hh = L >> 5, wv = F.wave;
    LAS unsigned char* Kl = F.lds + AT_KOFF; LAS unsigned char* Vl = F.lds + AT_VOFF;
    const bf16* Kg = WSP(bf16, WS_K) + ((size_t)(b * SEQ + j * 256)) * AW + h * 64;
    const bf16* Vg = WSP(bf16, WS_VT) + ((size_t)((b * NH + h) * HD)) * SEQ + j * 256;
    v4u kr[4], vr[4];
#pragma unroll
    for (int i = 0; i < 4; ++i) { const int idx = tid + 512 * i; kr[i] = *(const v4u*)(Kg + (size_t)(idx >> 3) * AW + (idx & 7) * 8); vr[i] = *(const v4u*)(Vg + (size_t)(idx >> 5) * SEQ + (idx & 31) * 8); }
    const int qi = wv * 32 + r; const bool valid = qi < nvalid;
    unsigned ent; if (own) ent = ((unsigned)(j * 256 + qi) << 2) | 3u; else ent = lst[valid ? qi : 0];
    const int tt = (int)(ent >> 2), slot = (int)(ent & 3u), t = b * SEQ + tt;
    bf16x8 qf[4];
    { const bf16* qp = WSP(bf16, WS_Q) + (size_t)t * AW + h * 64 + hh * 8;
#pragma unroll
      for (int d0 = 0; d0 < 4; ++d0) qf[d0] = *(const bf16x8*)(qp + d0 * 16); }
#pragma unroll
    for (int i = 0; i < 4; ++i) { const int idx = tid + 512 * i; *(LAS v4u*)(Kl + (idx >> 3) * AT_KROW + (idx & 7) * 16) = kr[i]; *(LAS v4u*)(Vl + (idx >> 5) * AT_VROW + (idx & 31) * 16) = vr[i]; }
    __syncthreads();
#ifdef ATT_STAGGER
    if (wv >= 4) __builtin_amdgcn_s_sleep(ATT_STAGGER);
#endif
#ifdef ATT_REP_COMPUTE
    for (int arep = 0; arep < 2; ++arep)
#endif
    if (wv * 32 < nvalid) {
        float m = -1e30f, l = 0.f; f32x16 O0 = {}, O1 = {};
        const int qrel = tt & 255;
#pragma unroll
        for (int hk = 0; hk < 2; ++hk) {
            if (own && hk * 4 > wv) continue;
            f32x16 S[4];
#pragma unroll
            for (int kt = 0; kt < 4; ++kt) S[kt] = (f32x16){};
#pragma unroll
            for (int d0 = 0; d0 < 4; ++d0) {
#pragma unroll
                for (int kt = 0; kt < 4; ++kt) { const bf16x8 kf = *(const LAS bf16x8*)(Kl + (hk * 128 + kt * 32 + r) * AT_KROW + d0 * 32 + hh * 16);
                    S[kt] = __builtin_amdgcn_mfma_f32_32x32x16_bf16(kf, qf[d0], S[kt], 0, 0, 0); }
                if (d0 & 1) __builtin_amdgcn_sched_barrier(0); }
            if (own) {
                asm volatile("; causal masking (own block only)" ::: "memory");
#pragma unroll
                for (int kt = 0; kt < 4; ++kt)
#pragma unroll
                    for (int rg = 0; rg < 16; ++rg) { const int key = hk * 128 + kt * 32 + (rg & 3) + 8 * (rg >> 2) + 4 * hh; if (key > qrel) S[kt][rg] = -1e30f; } }
            float mx = S[0][0];
#pragma unroll
            for (int kt = 0; kt < 4; ++kt)
#pragma unroll
                for (int rg = 0; rg < 16; ++rg) mx = fmaxf(mx, S[kt][rg]);
            mx = fmaxf(mx, __shfl_xor(mx, 32));
            const float mn = fmaxf(m, mx), alpha = __builtin_amdgcn_exp2f(m - mn); m = mn; l *= alpha;
#pragma unroll
            for (int rg = 0; rg < 16; ++rg) { O0[rg] *= alpha; O1[rg] *= alpha; }
            float ls = 0.f;
#pragma unroll
            for (int kt = 0; kt < 4; ++kt) {
                unsigned pw[8];
#pragma unroll
                for (int rg = 0; rg < 16; rg += 2) { const float p0 = __builtin_amdgcn_exp2f(S[kt][rg] - mn), p1 = __builtin_amdgcn_exp2f(S[kt][rg + 1] - mn); ls += p0 + p1; pw[rg >> 1] = cvtpk(p0, p1); }
#pragma unroll
                for (int s = 0; s < 2; ++s) {
                    const v4u pv = {pw[4 * s], pw[4 * s + 1], pw[4 * s + 2], pw[4 * s + 3]}; const bf16x8 pf = __builtin_bit_cast(bf16x8, pv);
                    const int kb = (hk * 128 + kt * 32 + 16 * s + 4 * hh) * 2;
                    { const LAS unsigned char* vp = Vl + r * AT_VROW + kb; const v2u lo = *(const LAS v2u*)vp, hi = *(const LAS v2u*)(vp + 16);
                      const v4u vv = {lo.x, lo.y, hi.x, hi.y}; O0 = __builtin_amdgcn_mfma_f32_32x32x16_bf16(__builtin_bit_cast(bf16x8, vv), pf, O0, 0, 0, 0); }
                    { const LAS unsigned char* vp = Vl + (32 + r) * AT_VROW + kb; const v2u lo = *(const LAS v2u*)vp, hi = *(const LAS v2u*)(vp + 16);
                      const v4u vv = {lo.x, lo.y, hi.x, hi.y}; O1 = __builtin_amdgcn_mfma_f32_32x32x16_bf16(__builtin_bit_cast(bf16x8, vv), pf, O1, 0, 0, 0); } } }
            l += ls;
        }
        l += __shfl_xor(l, 32);
        if (valid) {
            const float rl = 1.f / l;
            bf16* op = (slot < 2 ? WSP(bf16, WS_OP01) + (((size_t)t * NH + h) * 2 + slot) * 64 : WSP(bf16, WS_OP23) + (((size_t)t * NH + h) * 2 + (slot - 2)) * 64) + 4 * hh;
#pragma unroll
            for (int g4 = 0; g4 < 4; ++g4) { v2u w0, w1; w0.x = cvtpk(O0[4 * g4] * rl, O0[4 * g4 + 1] * rl); w0.y = cvtpk(O0[4 * g4 + 2] * rl, O0[4 * g4 + 3] * rl);
                w1.x = cvtpk(O1[4 * g4] * rl, O1[4 * g4 + 1] * rl); w1.y = cvtpk(O1[4 * g4 + 2] * rl, O1[4 * g4 + 3] * rl);
                *(v2u*)(op + 8 * g4) = w0; *(v2u*)(op + 32 + 8 * g4) = w1; }
            if (hh == 0) WSP(float, WS_LSE)[((size_t)t * NH + h) * 4 + slot] = m + log2f(l);
        }
    }
    __syncthreads();
}
__device__ __forceinline__ void attn_items(Frame& F) {
    LAS int* pre = (LAS int*)(F.lds + 72 * 1024);
    const unsigned* bcnt = (const unsigned*)(F.ctl + CW_BCNT);
    LAS int* cntl = pre + 520;
    for (int i = F.tid; i < 512; i += NWAVES * 64) cntl[i] = (int)__hip_atomic_load((gu32*)(F.ctl + CW_BCNT) + i, RLX_AGENT);
    __syncthreads();
    if (F.wave == 0) {
        int c8[8], s = 0;
#pragma unroll
        for (int k = 0; k < 8; ++k) { c8[k] = (cntl[F.lane * 8 + k] + 255) >> 8; s += c8[k]; }
        int inc = s;
#pragma unroll
        for (int o = 1; o < 64; o <<= 1) { const int v = __shfl_up(inc, o); if (F.lane >= o) inc += v; }
        int run = inc - s;
#pragma unroll
        for (int k = 0; k < 8; ++k) { pre[F.lane * 8 + k] = run; run += c8[k]; }
        if (F.lane == 63) pre[512] = run; }
    __syncthreads();
    const int total = 512 + pre[512];
    for (int it = (int)blockIdx.x; it < total; it += F.G) {
        int bh, j, n; bool own; const unsigned* lst;
        if (it < 512) { bh = it >> 5; j = it & 31; own = true; lst = nullptr; n = 256; }
        else { const int s = it - 512; int lo = 0, hi = 512;
            while (hi - lo > 1) { const int mid = (lo + hi) >> 1; if (pre[mid] <= s) lo = mid; else hi = mid; }
            const int bucket = lo, tile = s - pre[bucket]; n = cntl[bucket] - tile * 256; n = n > 256 ? 256 : n; bh = bucket >> 5; j = bucket & 31; own = false;
            lst = WSP(unsigned, WS_ALIST) + (size_t)bucket * ALCAP + tile * 256; }
        const int b_ = __builtin_amdgcn_readfirstlane(bh >> 3), h_ = __builtin_amdgcn_readfirstlane(bh & 7), j_ = __builtin_amdgcn_readfirstlane(j), n_ = __builtin_amdgcn_readfirstlane(n);
        attn_item(F, b_, h_, j_, own, lst, n_);
    }
}
__device__ __forceinline__ void attn_combine(Frame& F) {
    if (F.G == 256 && blockIdx.x < 128) return;
    const int nb = F.G == 256 ? 128 : F.G, bi = F.G == 256 ? (int)blockIdx.x - 128 : F.vcu;
    const int gw = bi * NWAVES + F.wave, NGW = nb * NWAVES, L = F.lane, h = L >> 3, ch = L & 7;
    const float* lse = WSP(float, WS_LSE); bf16* YA = WSP(bf16, WS_YA);
    for (int t = gw; t < T; t += NGW) {
        const size_t th = (size_t)t * NH + h;
        const f32x4 ls = *(const f32x4*)(lse + th * 4);
        const float mx = fmaxf(fmaxf(ls[0], ls[1]), fmaxf(ls[2], ls[3]));
        const float w0 = __builtin_amdgcn_exp2f(ls[0] - mx), w1 = __builtin_amdgcn_exp2f(ls[1] - mx), w2 = __builtin_amdgcn_exp2f(ls[2] - mx), w3 = __builtin_amdgcn_exp2f(ls[3] - mx), inv = 1.f / (w0 + w1 + w2 + w3);
        const v4u a0 = __builtin_nontemporal_load((const v4u*)(WSP(bf16, WS_OP01) + (th * 2 + 0) * 64 + ch * 8)), a1 = __builtin_nontemporal_load((const v4u*)(WSP(bf16, WS_OP01) + (th * 2 + 1) * 64 + ch * 8));
        const v4u a2 = __builtin_nontemporal_load((const v4u*)(WSP(bf16, WS_OP23) + (th * 2 + 0) * 64 + ch * 8)), a3 = __builtin_nontemporal_load((const v4u*)(WSP(bf16, WS_OP23) + (th * 2 + 1) * 64 + ch * 8));
        float o[8];
        const unsigned x0[4] = {a0.x, a0.y, a0.z, a0.w}, x1[4] = {a1.x, a1.y, a1.z, a1.w}, x2[4] = {a2.x, a2.y, a2.z, a2.w}, x3[4] = {a3.x, a3.y, a3.z, a3.w};
#pragma unroll
        for (int i = 0; i < 4; ++i) {
            float lo_ = w3 * bflo(x3[i]), hi_ = w3 * bfhi(x3[i]);
            if (ls[0] > -1e29f) { lo_ += w0 * bflo(x0[i]); hi_ += w0 * bfhi(x0[i]); }
            if (ls[1] > -1e29f) { lo_ += w1 * bflo(x1[i]); hi_ += w1 * bfhi(x1[i]); }
            if (ls[2] > -1e29f) { lo_ += w2 * bflo(x2[i]); hi_ += w2 * bfhi(x2[i]); }
            o[2 * i] = lo_ * inv; o[2 * i + 1] = hi_ * inv; }
        v4u w; w.x = cvtpk(o[0], o[1]); w.y = cvtpk(o[2], o[3]); w.z = cvtpk(o[4], o[5]); w.w = cvtpk(o[6], o[7]);
        *(v4u*)(YA + (size_t)t * AW + h * 64 + ch * 8) = w;
    }
}
struct S5Order { static constexpr bool GATHER = false; int G, c;
    __device__ __forceinline__ void a_ready(const pg8::Unit&) const {}
    __device__ __forceinline__ void done(const pg8::Unit&) const {}
    __device__ __forceinline__ bool next(int i, pg8::Unit& u) const { const int L = i * G + c; if (L >= NG * 4) return false; const int g = L >> 2, rt = L & 3;
        u.arow = g * 1024 + rt * 256; u.brow = g * 256; u.pm = rt; u.pn = 0; u.e = g; u.nrow = 256; u.kind = 0; u.aux = 0; return true; } };
struct EpiS5A { float* E;
    __device__ __forceinline__ void operator()(const pg8::f32x4 (&acc)[2][2][4][2], const pg8::Unit& u, int wr, int wc, int fr, int fq) const {
        asm volatile("" : "+v"(fr), "+v"(fq));
#pragma unroll
        for (int ai = 0; ai < 2; ++ai)
#pragma unroll
            for (int m = 0; m < 4; ++m) { float* p = E + (size_t)(u.arow + ai * 128 + wr * 64 + m * 16 + fr) * 128 + wc * 32 + 8 * fq;
                *(pg8::f32x4*)p = acc[ai][0][m][0]; *(pg8::f32x4*)(p + 4) = acc[ai][0][m][1]; }
    }
};
struct EpiS5C { bf16* YG;
    __device__ __forceinline__ void operator()(const pg8::f32x4 (&acc)[2][2][4][2], const pg8::Unit& u, int wr, int wc, int fr, int fq) const {
        asm volatile("" : "+v"(fr), "+v"(fq));
        const int g = u.e, n0 = wc * 32 + 8 * fq, t0 = n0 >> 4, co0 = n0 & 15;
#pragma unroll
        for (int ai = 0; ai < 2; ++ai)
#pragma unroll
            for (int m = 0; m < 4; ++m) { const int row = u.pm * 256 + ai * 128 + wr * 64 + m * 16 + fr, b = row >> 9, c = row & 511;
                bf16* yp = YG + (size_t)(b * SEQ + 16 * c + t0) * SW + 16 * g + co0;
#pragma unroll
                for (int bj = 0; bj < 2; ++bj) {
                    const pg8::f32x4 v0 = acc[ai][bj][m][0], v1 = acc[ai][bj][m][1];
                    v4u w; w.x = pk2(gelu_tanh(v0[0]), gelu_tanh(v0[1])); w.y = pk2(gelu_tanh(v0[2]), gelu_tanh(v0[3]));
                    w.z = pk2(gelu_tanh(v1[0]), gelu_tanh(v1[1])); w.w = pk2(gelu_tanh(v1[2]), gelu_tanh(v1[3]));
                    *(v4u*)(yp + (size_t)bj * 8 * SW) = w; }
                __builtin_amdgcn_sched_barrier(0); }
    }
};
__device__ __forceinline__ void s5_fill_kt(Frame& F) {
    const int gt = F.vcu * (NWAVES * 64) + F.tid, NGT = F.G * NWAVES * 64;
    const float* P5 = WSP(float, WS_S5P); const float* PWr = P5 + 131072; const float* PWi = PWr + 2048 * 17; const float* par = WSP(float, WS_PAR);
    float* KT = WSP(float, WS_S5KT);
    for (int i = gt; i < NG * 16 * 256; i += NGT) { const int ci = i & 15, co = (i >> 4) & 15, tau = (i >> 8) & 15, g = i >> 12; float a = 0.f;
        for (int p = 0; p < 64; ++p) { const int gp = g * 64 + p;
            const float qr = P5[8192 + gp], qi = P5[8192 + 2048 + gp], b_r = par[PAR_BRE + gp * 16 + ci], b_i = par[PAR_BIM + gp * 16 + ci];
            const float bbr = qr * b_r - qi * b_i, bbi = qr * b_i + qi * b_r, wr_ = PWr[gp * 17 + tau], wi_ = PWi[gp * 17 + tau];
            const float xr = wr_ * bbr - wi_ * bbi, xi = wr_ * bbi + wi_ * bbr;
            const float cr = par[PAR_CRE + (g * 16 + co) * 64 + p], ci_ = par[PAR_CIM + (g * 16 + co) * 64 + p];
            a += cr * xr - ci_ * xi; }
        KT[i] = a; }
}
__device__ __forceinline__ void s5_fill_wc(Frame& F) {
    const int gt = F.vcu * (NWAVES * 64) + F.tid, NGT = F.G * NWAVES * 64;
    const float* P5 = WSP(float, WS_S5P); const float* PWr = P5 + 131072; const float* PWi = PWr + 2048 * 17; const float* KT = WSP(float, WS_S5KT); const float* par = WSP(float, WS_PAR);
    bf16* Wc = WSP(bf16, WS_S5WC);
    for (int i = gt; i < NG * 256 * 384; i += NGT) { const int k = i % 384, n = (i / 384) & 255, g = i / (384 * 256), t = n >> 4, co = n & 15; float val = 0.f;
        if (k < 256) { const int s_ = k >> 4, ci = k & 15;
            if (s_ <= t) val = KT[((g * 16 + (t - s_)) * 16 + co) * 16 + ci];
            if (s_ == t && ci == co) val += par[PAR_SD + g * 16 + co]; }
        else { const int p = (k - 256) & 63, gp = g * 64 + p; const float cr = par[PAR_CRE + (g * 16 + co) * 64 + p], ci_ = par[PAR_CIM + (g * 16 + co) * 64 + p];
            const float wr_ = PWr[gp * 17 + t + 1], wi_ = PWi[gp * 17 + t + 1];
            val = (k < 320) ? (cr * wr_ - ci_ * wi_) : -(cr * wi_ + ci_ * wr_); }
        Wc[((size_t)(g * 256 + perm8(n))) * 384 + k] = (bf16)f2bf(val); }
}
__device__ __forceinline__ void s5_carry(Frame& F) {
    const float* P5 = WSP(float, WS_S5P); const float* PWr = P5 + 131072; const float* PWi = PWr + 2048 * 17; const float* E = WSP(float, WS_S5E); bf16* UA = WSP(bf16, WS_UA);
    LAS float* Z = (LAS float*)(F.lds);
    const int seg = F.wave, p = F.lane;
    for (int bg = F.vcu; bg < BATCH * NG; bg += F.G) { const int b = bg / NG, g = bg % NG, gp = g * 64 + p;
        const float ar = PWr[gp * 17 + 16], ai = PWi[gp * 17 + 16];
        const size_t row0 = (size_t)g * 1024 + b * 512 + seg * 64;
        float zr = 0.f, zi = 0.f;
        for (int c0 = 0; c0 < 64; c0 += 8) { float er[8], ei[8];
#pragma unroll
            for (int k = 0; k < 8; ++k) { er[k] = E[(row0 + c0 + k) * 128 + p]; ei[k] = E[(row0 + c0 + k) * 128 + 64 + p]; }
#pragma unroll
            for (int k = 0; k < 8; ++k) { const float nr = ar * zr - ai * zi + er[k], ni = ar * zi + ai * zr + ei[k]; zr = nr; zi = ni; } }
        Z[(seg * 64 + p) * 2] = zr; Z[(seg * 64 + p) * 2 + 1] = zi;
        __syncthreads();
        if (seg == 0) { float br = ar, bi = ai;
#pragma unroll
            for (int k = 0; k < 6; ++k) { const float tr = br * br - bi * bi, ti = 2.f * br * bi; br = tr; bi = ti; }
            float sr = 0.f, si = 0.f;
            for (int sg = 0; sg < 8; ++sg) { const float xr = Z[(sg * 64 + p) * 2], xi = Z[(sg * 64 + p) * 2 + 1]; Z[(sg * 64 + p) * 2] = sr; Z[(sg * 64 + p) * 2 + 1] = si;
                const float nr = br * sr - bi * si + xr, ni = br * si + bi * sr + xi; sr = nr; si = ni; } }
        __syncthreads();
        float sr = Z[(seg * 64 + p) * 2], si = Z[(seg * 64 + p) * 2 + 1];
        for (int c0 = 0; c0 < 64; c0 += 8) { float er[8], ei[8];
#pragma unroll
            for (int k = 0; k < 8; ++k) { er[k] = E[(row0 + c0 + k) * 128 + p]; ei[k] = E[(row0 + c0 + k) * 128 + 64 + p]; }
#pragma unroll
            for (int k = 0; k < 8; ++k) { bf16* up = UA + (row0 + c0 + k) * 384 + 256 + p; up[0] = (bf16)f2bf(sr); up[64] = (bf16)f2bf(si);
                const float nr = ar * sr - ai * si + er[k], ni = ar * si + ai * sr + ei[k]; sr = nr; si = ni; } }
        __syncthreads();
    }
}
constexpr int SCR_OFF = LDSCTL_OFF + 512;
#ifndef MOE_LAG
#define MOE_LAG 2
#endif
constexpr int MT_SEG = 100, MT_MAXSEG = 72, MT_ULIST = 400, MT_MAXU = 16;
__device__ __forceinline__ void phase_rows(Frame& F, bool dry = false) {
    LAS float* h2t = (LAS float*)(F.lds);
    LAS float* lg = (LAS float*)(F.lds + 65536);
    LAS float* gtm = (LAS float*)(F.lds + 131072);
    LAS float* pg2 = gtm + 2 * D; LAS float* shf = pg2 + 2 * D;
    LAS unsigned* hist = (LAS unsigned*)(F.lds + SCR_OFF); LAS unsigned* base = hist + 32; LAS int* rec_e = (LAS int*)(base + 32); LAS int* rec_lp = rec_e + 256;
    const float* adaf = WSP(float, WS_ADAF); const float* par = WSP(float, WS_PAR);
    const int L = F.lane, wv = F.wave;
    for (int i = F.tid; i < 2 * D; i += NWAVES * 64) { const int b = i >> 10, k = i & (D - 1);
        gtm[i] = adaf[b * 6 * D + 2 * D + k] * par[PAR_MPG + k];
        pg2[i] = par[PAR_FPRE + k] * (1.f + adaf[b * 6 * D + 4 * D + k]); shf[i] = adaf[b * 6 * D + 3 * D + k]; }
    f32x4 wreg[16];
#pragma unroll
    for (int j = 0; j < 4; ++j)
#pragma unroll
        for (int i = 0; i < 4; ++i) wreg[j * 4 + i] = *(const f32x4*)(par + PAR_RW + (4 * L + 256 * j + i) * NE + 4 * wv);
    if (F.tid < 32) hist[F.tid] = 0u;
    __syncthreads();
    const bf16* mix = WSP(bf16, WS_MIX); bf16* H2 = WSP(bf16, WS_H2); bf16* X1B = WSP(bf16, WS_X1B);
    int* tok_e = WSP(int, WS_ROUTE); float* tok_w = (float*)(tok_e + T * 4); int* tok_pos = tok_e + 2 * T * 4;
    unsigned* gcnt = (unsigned*)(F.ctl + CW_ECNT);
    for (int t0 = F.vcu * 16; t0 < T; t0 += F.G * 16) {
        {
            const int t = t0 + 2 * wv, b = t >> 13;
            f32x4 mv[2][4], xv[2][4];
#pragma unroll
            for (int q = 0; q < 2; ++q) { const GAS v2u* mr = (const GAS v2u*)(mix + (size_t)(t + q) * D) + L; const GAS f32x4* xr = (const GAS f32x4*)(F.in[0] + (size_t)(t + q) * D) + L;
#pragma unroll
                for (int j = 0; j < 4; ++j) { const v2u mw = __builtin_nontemporal_load(mr + 64 * j); mv[q][j] = (f32x4){bflo(mw.x), bfhi(mw.x), bflo(mw.y), bfhi(mw.y)}; xv[q][j] = __builtin_nontemporal_load(xr + 64 * j); } }
#pragma unroll
            for (int q = 0; q < 2; ++q) { float s = 0.f;
#pragma unroll
                for (int j = 0; j < 4; ++j) s += (mv[q][j].x * mv[q][j].x + mv[q][j].y * mv[q][j].y) + (mv[q][j].z * mv[q][j].z + mv[q][j].w * mv[q][j].w);
                const float r1 = 1.f / sqrtf(wave_sum(s) * (1.f / D) + NORM_EPS);
                float s2 = 0.f; GAS v2u* orow = (GAS v2u*)(X1B + (size_t)(t + q) * D) + L;
#pragma unroll
                for (int j = 0; j < 4; ++j) { const f32x4 g = *(const LAS f32x4*)(gtm + b * D + 4 * L + 256 * j);
                    xv[q][j] = xv[q][j] + g * (mv[q][j] * r1); { v2u w; w.x = pk2(xv[q][j].x, xv[q][j].y); w.y = pk2(xv[q][j].z, xv[q][j].w); __builtin_nontemporal_store(w, orow + 64 * j); }
                    s2 += (xv[q][j].x * xv[q][j].x + xv[q][j].y * xv[q][j].y) + (xv[q][j].z * xv[q][j].z + xv[q][j].w * xv[q][j].w); }
                const float r2 = 1.f / sqrtf(wave_sum(s2) * (1.f / D) + NORM_EPS);
#ifdef MOE_F8
                GAS unsigned* h4 = (GAS unsigned*)(WSP(unsigned char, WS_H2) + (size_t)(t + q) * D) + L;
#pragma unroll
                for (int j = 0; j < 4; ++j) { const f32x4 a = *(const LAS f32x4*)(pg2 + b * D + 4 * L + 256 * j), c = *(const LAS f32x4*)(shf + b * D + 4 * L + 256 * j);
                    const f32x4 h = xv[q][j] * r2 * a + c;
                    h4[64 * j] = pk4_fp8(8.f * h.x, 8.f * h.y, 8.f * h.z, 8.f * h.w);
                    *(LAS f32x4*)(h2t + (2 * wv + q) * D + 4 * L + 256 * j) = h; } }
#else
                GAS unsigned long long* h8 = (GAS unsigned long long*)(H2 + (size_t)(t + q) * D) + L;
#pragma unroll
                for (int j = 0; j < 4; ++j) { const f32x4 a = *(const LAS f32x4*)(pg2 + b * D + 4 * L + 256 * j), c = *(const LAS f32x4*)(shf + b * D + 4 * L + 256 * j);
                    const f32x4 h = xv[q][j] * r2 * a + c;
                    h8[64 * j] = (unsigned long long)pk2(h.x, h.y) | ((unsigned long long)pk2(h.z, h.w) << 32);
                    *(LAS f32x4*)(h2t + (2 * wv + q) * D + 4 * L + 256 * j) = h; } }
#endif
        }
        __syncthreads();
        {
            const int hi = (L >> 5) & 1, h2b = (L >> 4) & 1;
#pragma unroll 2
            for (int tk = 0; tk < 16; ++tk) {
                f32x4 a = {0.f, 0.f, 0.f, 0.f};
#pragma unroll
                for (int j = 0; j < 4; ++j) { const f32x4 h = *(const LAS f32x4*)(h2t + tk * D + 4 * L + 256 * j);
                    a += wreg[j * 4 + 0] * h.x; a += wreg[j * 4 + 1] * h.y; a += wreg[j * 4 + 2] * h.z; a += wreg[j * 4 + 3] * h.w; }
                const float m0 = hi ? a.z : a.x, o0 = hi ? a.x : a.z, m1 = hi ? a.w : a.y, o1 = hi ? a.y : a.w;
                const float v0 = m0 + __shfl_xor(o0, 32), v1 = m1 + __shfl_xor(o1, 32);
                float v = (h2b ? v1 : v0) + __shfl_xor(h2b ? v0 : v1, 16);
                v += __shfl_xor(v, 8); v += __shfl_xor(v, 4); v += __shfl_xor(v, 2); v += __shfl_xor(v, 1);
                if ((L & 15) == 0) lg[tk * NE + 4 * wv + 2 * hi + h2b] = v;
            }
        }
        __syncthreads();
        {
            const int e = L & 31, half = L >> 5, tl = 2 * wv + half, t = t0 + tl;
            float val = lg[tl * NE + e] + par[PAR_RB + e];
            int se[4]; float sv[4];
#pragma unroll
            for (int r = 0; r < 4; ++r) { float mx = val;
                mx = fmaxf(mx, __shfl_xor(mx, 16)); mx = fmaxf(mx, __shfl_xor(mx, 8)); mx = fmaxf(mx, __shfl_xor(mx, 4)); mx = fmaxf(mx, __shfl_xor(mx, 2)); mx = fmaxf(mx, __shfl_xor(mx, 1));
                const unsigned long long bal = __ballot(val == mx); const unsigned hm = half ? (unsigned)(bal >> 32) : (unsigned)bal; const int win = __ffs((int)hm) - 1;
                se[r] = win; sv[r] = mx; if (e == win) val = -3e38f; }
            const float e1 = __expf(sv[1] - sv[0]), e2 = __expf(sv[2] - sv[0]), e3 = __expf(sv[3] - sv[0]), inv = 1.f / (1.f + e1 + e2 + e3);
            if (e < 4) { const int ex = e == 0 ? se[0] : (e == 1 ? se[1] : (e == 2 ? se[2] : se[3]));
                const float wgt = (e == 0 ? 1.f : (e == 1 ? e1 : (e == 2 ? e2 : e3))) * inv;
                tok_e[t * 4 + e] = ex; tok_w[t * 4 + e] = wgt;
                const unsigned lp = dry ? 0u : __hip_atomic_fetch_add(hist + ex, 1u, __ATOMIC_RELAXED, __HIP_MEMORY_SCOPE_WORKGROUP);
                rec_e[tl * 4 + e] = ex; rec_lp[tl * 4 + e] = (int)lp; }
        }
        __syncthreads();
        if (F.tid < 32) { const unsigned h = hist[F.tid]; base[F.tid] = h ? __hip_atomic_fetch_add(gcnt + F.tid, h, RLX_AGENT) : 0u; }
        __syncthreads();
        if (!dry && F.tid < 64) { const int e_ = rec_e[F.tid], pos_ = (int)base[e_] + rec_lp[F.tid]; tok_pos[(t0 + (F.tid >> 2)) * 4 + (F.tid & 3)] = pos_;
            WSP(int, WS_ELIST)[e_ * ELCAP + pos_] = t0 + (F.tid >> 2); }
        if (F.tid < 32) hist[F.tid] = 0u;
        __syncthreads();
    }
}

__device__ __forceinline__ void moe_tables(Frame& F, int nct = 0, int brows = 0) {
    LAS int* cnt = (LAS int*)(F.lds + SCR_OFF); LAS int* off = cnt + 32; LAS int* tpre = off + 32;
    if (F.tid < NE) cnt[F.tid] = (int)__hip_atomic_load(F.ctl + CW_ECNT + F.tid, RLX_AGENT);
    __syncthreads();
    if (F.tid < 64) {
        const int c = F.tid < NE ? cnt[F.tid] : 0, tl = (c + 255) >> 8; int io = c, it = tl;
#pragma unroll
        for (int o = 1; o < 32; o <<= 1) { const int v = __shfl_up(io, o), w = __shfl_up(it, o); if ((int)F.tid >= o) { io += v; it += w; } }
        if (F.tid < NE) { off[F.tid] = io - c; tpre[F.tid] = it - tl; } if (F.tid == NE - 1) tpre[NE] = it; }
    if (F.tid == 0) {
#ifdef MOE_FUSED
        const int tp = 0;
        LAS int* sg = cnt + MT_SEG; const int n = (tp + 31) >> 5; int ns = 0, pos = 0;
        for (int g = 0; g < n; ++g) { const int tg = (tp - 32 * g) < 32 ? (tp - 32 * g) : 32;
            sg[1 + ns] = pos; sg[1 + MT_MAXSEG + ns] = 0; sg[1 + 2 * MT_MAXSEG + ns] = g; ++ns; pos += 8 * tg; sg[1 + 3 * MT_MAXSEG + g] = pos;
            if (g >= MOE_LAG) { sg[1 + ns] = pos; sg[1 + MT_MAXSEG + ns] = 1; sg[1 + 2 * MT_MAXSEG + ns] = g - MOE_LAG; ++ns; pos += 4 * 32; } }
        for (int g = (n > MOE_LAG ? n - MOE_LAG : 0); g < n; ++g) { const int tg = (tp - 32 * g) < 32 ? (tp - 32 * g) : 32; sg[1 + ns] = pos; sg[1 + MT_MAXSEG + ns] = 1; sg[1 + 2 * MT_MAXSEG + ns] = g; ++ns; pos += 4 * tg; }
        sg[1 + ns] = pos; sg[0] = ns;
#endif
    }
    __syncthreads();
    if (nct > 0 && F.G == 256 && F.tid < MT_MAXU) {
        LAS int* ul = cnt + MT_ULIST + 8 * F.tid; const int i = F.tid, c = (int)blockIdx.x, xcd = c & 7, slot = c >> 3, rpx = 32 / nct;
        const int rtg = (i * 8 + xcd) * rpx + slot / nct, pn = slot % nct;
        if (rtg >= tpre[NE]) { ul[0] = -1; }
        else { int e = 0;
#pragma unroll
            for (int st = 16; st >= 1; st >>= 1) if (e + st < NE && tpre[e + st] <= rtg) e += st;
            const int rt = rtg - tpre[e], nr = cnt[e] - rt * 256;
            ul[0] = off[e] + rt * 256; ul[1] = e * brows + pn * 256; ul[2] = rt; ul[3] = pn; ul[4] = e; ul[5] = nr > 256 ? 256 : nr; } }
    __syncthreads();
}
template <bool GA> struct MoeOrder {
    static constexpr bool GATHER = GA;
#if defined(T_ACQ)
    __device__ __forceinline__ void a_ready(const pg8::Unit&) const { if (!GA) { if (threadIdx.x < 64) { __builtin_amdgcn_fence(__ATOMIC_ACQUIRE, "agent"); asm volatile("s_waitcnt vmcnt(0)" ::: "memory"); } asm volatile("" ::: "memory"); __builtin_amdgcn_s_barrier(); asm volatile("" ::: "memory"); } }
#else
    __device__ __forceinline__ void a_ready(const pg8::Unit&) const {}
#endif
#if defined(T_DRAIN)
    __device__ __forceinline__ void done(const pg8::Unit&) const { if (GA) asm volatile("s_waitcnt vmcnt(0)" ::: "memory"); }
#else
    __device__ __forceinline__ void done(const pg8::Unit&) const {}
#endif
    const LAS int* tab; const int* elist; int nct, brows, G, c;
    __device__ __forceinline__ bool next(int i, pg8::Unit& u) const {
        if (G == 256) { if (i >= MT_MAXU) return false; const LAS int* ul = tab + MT_ULIST + 8 * i; const int a0 = ul[0]; if (a0 < 0) return false;
            u.arow = __builtin_amdgcn_readfirstlane(a0); u.brow = __builtin_amdgcn_readfirstlane(ul[1]); u.pm = __builtin_amdgcn_readfirstlane(ul[2]); u.pn = __builtin_amdgcn_readfirstlane(ul[3]);
            u.e = __builtin_amdgcn_readfirstlane(ul[4]); u.nrow = __builtin_amdgcn_readfirstlane(ul[5]); u.kind = 0; u.aux = 0; return true; }
        int rtg, pn;
        if (false) { const int xcd = c & 7, slot = c >> 3, rpx = 32 / nct;
            rtg = (i * 8 + xcd) * rpx + slot / nct; pn = slot % nct; if (rtg >= tab[64 + NE]) return false; }
        else { const int L = i * G + c, total = tab[64 + NE] * nct; if (L >= total) return false; rtg = L / nct; pn = L % nct; }
        int e = 0;
        for (int k = 1; k < NE; ++k) if (tab[64 + k] <= rtg) e = k;
        const int rt = rtg - tab[64 + e], cnt = tab[e], off = tab[32 + e];
        u.e = __builtin_amdgcn_readfirstlane(e); u.pm = __builtin_amdgcn_readfirstlane(rt); u.pn = pn; u.arow = __builtin_amdgcn_readfirstlane(off + rt * 256); u.brow = __builtin_amdgcn_readfirstlane(e * brows + pn * 256);
        const int nr = cnt - rt * 256; u.nrow = __builtin_amdgcn_readfirstlane(nr > 256 ? 256 : nr); u.kind = 0; u.aux = 0; return true;
    }
    __device__ __forceinline__ int arow_of(const pg8::Unit& u, int r) const { return r < u.nrow ? elist[u.e * ELCAP + u.pm * 256 + r] : 0; }
};
struct EpiGU { bf16* H1; const float* bg; const float* bu;
    __device__ __forceinline__ void operator()(const pg8::f32x4 (&acc)[2][2][4][2], const pg8::Unit& u, int wr, int wc, int fr, int fq) const {
        asm volatile("" : "+v"(fr), "+v"(fq));
        const int f0 = u.pn * 128 + wc * 32 + 8 * fq;
#pragma unroll
        for (int ai = 0; ai < 2; ++ai) {
            int fb = f0; asm volatile("" : "+v"(fb));
            const pg8::f32x4 g0 = *(const pg8::f32x4*)(bg + u.e * FF + fb), g1 = *(const pg8::f32x4*)(bg + u.e * FF + fb + 4);
            const pg8::f32x4 u0 = *(const pg8::f32x4*)(bu + u.e * FF + fb), u1 = *(const pg8::f32x4*)(bu + u.e * FF + fb + 4);
#pragma unroll
            for (int m = 0; m < 4; ++m) { const int r = ai * 128 + wr * 64 + m * 16 + fr;
                const pg8::f32x4 a0 = acc[ai][0][m][0] + g0, a1 = acc[ai][0][m][1] + g1, b0 = acc[ai][1][m][0] + u0, b1 = acc[ai][1][m][1] + u1;
                float gg[8] = {a0[0], a0[1], a0[2], a0[3], a1[0], a1[1], a1[2], a1[3]}, uu[8] = {b0[0], b0[1], b0[2], b0[3], b1[0], b1[1], b1[2], b1[3]}, o[8];
#pragma unroll
                for (int i = 0; i < 8; ++i) { const float g = fminf(gg[i], 7.f), up = fminf(fmaxf(uu[i], -7.f), 7.f); o[i] = g * sigmoidf_(1.702f * g) * (up + 1.f); }
                v4u w; w.x = pk2(o[0], o[1]); w.y = pk2(o[2], o[3]); w.z = pk2(o[4], o[5]); w.w = pk2(o[6], o[7]);
#ifdef T_SC1
                if (r < u.nrow) __builtin_amdgcn_raw_buffer_store_b128(w, __builtin_amdgcn_make_buffer_rsrc(H1, 0, (int)((size_t)T * TOPK * FF * 2), 0x00020000), (unsigned)((u.arow + r) * (FF * 2) + fb * 2), 0, 16); } }
#else
                if (r < u.nrow) *(v4u*)(H1 + (size_t)(u.arow + r) * FF + fb) = w; } }
#endif
    }
};
struct EpiDn { bf16* YB; const float* bd;
    __device__ __forceinline__ void operator()(const pg8::f32x4 (&acc)[2][2][4][2], const pg8::Unit& u, int wr, int wc, int fr, int fq) const {
        const int c0 = u.pn * 256 + wc * 32 + 8 * fq;
#pragma unroll
        for (int bj = 0; bj < 2; ++bj) { const pg8::f32x4 d0 = *(const pg8::f32x4*)(bd + u.e * D + c0 + bj * 128), d1 = *(const pg8::f32x4*)(bd + u.e * D + c0 + bj * 128 + 4);
#pragma unroll
            for (int ai = 0; ai < 2; ++ai)
#pragma unroll
                for (int m = 0; m < 4; ++m) { const int r = ai * 128 + wr * 64 + m * 16 + fr;
                    const pg8::f32x4 a0 = acc[ai][bj][m][0] + d0, a1 = acc[ai][bj][m][1] + d1;
                    v4u w; w.x = pk2(a0[0], a0[1]); w.y = pk2(a0[2], a0[3]); w.z = pk2(a1[0], a1[1]); w.w = pk2(a1[2], a1[3]);
                    if (r < u.nrow) *(v4u*)(YB + (size_t)(u.arow + r) * D + c0 + bj * 128) = w; } }
    }
};
constexpr float YB_SCALE = 16.f;
struct EpiGU8 { unsigned char* H1; const float* bg; const float* bu; const float* wscp;
    static constexpr bool BIAS_LDS = true;
    __device__ __forceinline__ void stage_bias(PG8_LAS unsigned char* dst, const pg8::Unit& u, int wid, int lane) const {
        if (wid < 4) { const float* src = (wid < 2 ? bg : bu) + u.e * FF + u.pn * 128 + (wid & 1) * 64 + lane;
            __builtin_amdgcn_global_load_lds((const unsigned*)src, (PG8_LAS unsigned*)(dst + wid * 256), 4, 0, 0); } }
    __device__ __forceinline__ void operator()(const pg8::f32x4 (&acc)[2][2][4][2], const pg8::Unit& u, int wr, int wc, int fr, int fq, const PG8_LAS float* bl) const {
        asm volatile("" : "+v"(fr), "+v"(fq));
        const int fl = wc * 32 + 8 * fq, f0 = u.pn * 128 + fl; const float sr = 0.125f / *wscp;
        const pg8::f32x4 g0 = *(const PG8_LAS pg8::f32x4*)(bl + fl), g1 = *(const PG8_LAS pg8::f32x4*)(bl + fl + 4), u0 = *(const PG8_LAS pg8::f32x4*)(bl + 128 + fl), u1 = *(const PG8_LAS pg8::f32x4*)(bl + 128 + fl + 4);
#pragma unroll
        for (int ai = 0; ai < 2; ++ai)
#pragma unroll
            for (int m = 0; m < 4; ++m) { const int r = ai * 128 + wr * 64 + m * 16 + fr;
                const pg8::f32x4 a0 = acc[ai][0][m][0] * sr + g0, a1 = acc[ai][0][m][1] * sr + g1, b0 = acc[ai][1][m][0] * sr + u0, b1 = acc[ai][1][m][1] * sr + u1;
                float gg[8] = {a0[0], a0[1], a0[2], a0[3], a1[0], a1[1], a1[2], a1[3]}, uu[8] = {b0[0], b0[1], b0[2], b0[3], b1[0], b1[1], b1[2], b1[3]}, o[8];
#pragma unroll
                for (int i = 0; i < 8; ++i) { const float g = fminf(gg[i], 7.f), up = fminf(fmaxf(uu[i], -7.f), 7.f); o[i] = 8.f * (g * sigmoidf_(1.702f * g) * (up + 1.f)); }
                v2u w; w.x = pk4_fp8(o[0], o[1], o[2], o[3]); w.y = pk4_fp8(o[4], o[5], o[6], o[7]);
                if (r < u.nrow) *(v2u*)(H1 + (size_t)(u.arow + r) * FF + f0) = w; }
    }
};
struct EpiDn8 { bf16* YB; const float* bd; const float* wscp;
    static constexpr bool BIAS_LDS = true;
    __device__ __forceinline__ void stage_bias(PG8_LAS unsigned char* dst, const pg8::Unit& u, int wid, int lane) const {
        if (wid < 4) { const float* src = bd + u.e * D + u.pn * 256 + wid * 64 + lane;
            __builtin_amdgcn_global_load_lds((const unsigned*)src, (PG8_LAS unsigned*)(dst + wid * 256), 4, 0, 0); } }
    __device__ __forceinline__ void operator()(const pg8::f32x4 (&acc)[2][2][4][2], const pg8::Unit& u, int wr, int wc, int fr, int fq, const PG8_LAS float* bl) const {
        const int cl = wc * 32 + 8 * fq, c0 = u.pn * 256 + cl; const float sc = 0.125f / *wscp;
#pragma unroll
        for (int bj = 0; bj < 2; ++bj) { const pg8::f32x4 d0 = *(const PG8_LAS pg8::f32x4*)(bl + cl + bj * 128), d1 = *(const PG8_LAS pg8::f32x4*)(bl + cl + bj * 128 + 4);
#pragma unroll
            for (int ai = 0; ai < 2; ++ai)
#pragma unroll
                for (int m = 0; m < 4; ++m) { const int r = ai * 128 + wr * 64 + m * 16 + fr;
                    const pg8::f32x4 a0 = (acc[ai][bj][m][0] * sc + d0) * YB_SCALE, a1 = (acc[ai][bj][m][1] * sc + d1) * YB_SCALE;
                    v2u w; w.x = pk4_fp8(a0[0], a0[1], a0[2], a0[3]); w.y = pk4_fp8(a1[0], a1[1], a1[2], a1[3]);
                    if (r < u.nrow) *(v2u*)((unsigned char*)YB + (size_t)(u.arow + r) * D + c0 + bj * 128) = w; } }
    }
};
constexpr int CW_RDY = 8448;
constexpr int H2ROW0 = (int)(WS_H2 / 2048), H1ROW0 = (int)(WS_H1 / 2048), DN_BROW0 = (int)((WS_WDN_T - WS_WGU_T) / 2048);
struct MoeFused {
    static constexpr bool GATHER = true;
    const LAS int* tab; const int* elist; gu32* ctl; int G, c, base;
    __device__ __forceinline__ bool next(int i, pg8::Unit& u) const {
        const LAS int* sg = tab + MT_SEG; const int ns = sg[0], L = (base + i) * G + c; if (L >= sg[1 + ns]) return false;
        int s = 0; for (int k = 1; k < ns; ++k) if (sg[1 + k] <= L) s = k;
        if (i > 0 && sg[1 + MT_MAXSEG + s] == 1 && L - sg[1 + 3 * MT_MAXSEG + sg[1 + 2 * MT_MAXSEG + s]] < G) return false;
        const int kind = sg[1 + MT_MAXSEG + s], g = sg[1 + 2 * MT_MAXSEG + s], ui = L - sg[1 + s], TT = tab[64 + NE], tg = (TT - 32 * g) < 32 ? (TT - 32 * g) : 32;
        int rt, pn;
        if (kind == 0) { if (tg == 32) { const int xcd = ui & 7, slot = ui >> 3; rt = xcd * 4 + (slot >> 3); pn = slot & 7; } else { rt = ui >> 3; pn = ui & 7; } }
        else { if (tg == 32) { const int xcd = ui & 7, slot = ui >> 3; rt = xcd * 4 + (slot >> 2); pn = slot & 3; } else { rt = ui >> 2; pn = ui & 3; } }
        const int rtg = 32 * g + rt; int e = 0;
        for (int k = 1; k < NE; ++k) if (tab[64 + k] <= rtg) e = k;
        const int rte = rtg - tab[64 + e], cnt = tab[e], off = tab[32 + e], nr = cnt - rte * 256;
        u.e = __builtin_amdgcn_readfirstlane(e); u.pm = __builtin_amdgcn_readfirstlane(rte); u.pn = __builtin_amdgcn_readfirstlane(pn); u.kind = __builtin_amdgcn_readfirstlane(kind); u.aux = __builtin_amdgcn_readfirstlane(rtg);
        u.arow = __builtin_amdgcn_readfirstlane(off + rte * 256); u.nrow = __builtin_amdgcn_readfirstlane(nr > 256 ? 256 : nr);
        u.brow = __builtin_amdgcn_readfirstlane(kind == 0 ? e * 2048 + pn * 256 : DN_BROW0 + e * 1024 + pn * 256); return true;
    }
    __device__ __forceinline__ int arow_of(const pg8::Unit& u, int r) const { return u.kind == 0 ? H2ROW0 + (r < u.nrow ? elist[u.e * ELCAP + u.pm * 256 + r] : 0) : H1ROW0 + u.arow + (r < u.nrow ? r : 0); }
    __device__ __forceinline__ void a_ready(const pg8::Unit& u) const {
        if (u.kind != 1) return;
        if (threadIdx.x < 64) {
            gu32* w = ctl + CW_RDY + u.aux; const unsigned long long t0 = __builtin_amdgcn_s_memrealtime();
            while ((unsigned)__builtin_amdgcn_readfirstlane(__hip_atomic_load(w, RLX_AGENT)) < 64u) {
                if (__builtin_amdgcn_s_memrealtime() - t0 > 2000000ull) { if (threadIdx.x == 0) __hip_atomic_store(ctl + CW_TMO, 1u, RLX_AGENT); break; }
                __builtin_amdgcn_s_sleep(2); }
#ifdef MOE_DELAY
            { const unsigned long long t1 = __builtin_amdgcn_s_memrealtime(); while (__builtin_amdgcn_s_memrealtime() - t1 < 2000ull) __builtin_amdgcn_s_sleep(8); }
#endif
            __builtin_amdgcn_fence(__ATOMIC_ACQUIRE, "agent");
            asm volatile("s_waitcnt vmcnt(0)" ::: "memory");
        }
        asm volatile("" ::: "memory"); __builtin_amdgcn_s_barrier(); asm volatile("" ::: "memory");
    }
    __device__ __forceinline__ void done(const pg8::Unit& u) const {
        if (u.kind != 0) return;
#ifndef DIAG_NODRAIN
        asm volatile("s_waitcnt vmcnt(0)" ::: "memory");
#endif
#if defined(MOE_REL)
        __builtin_amdgcn_fence(__ATOMIC_RELEASE, "agent"); asm volatile("s_waitcnt vmcnt(0)" ::: "memory");
#endif
        if ((threadIdx.x & 63) == 0) __hip_atomic_fetch_add(ctl + CW_RDY + u.aux, 1u, RLX_AGENT);
    }
};
struct EpiMoe { bf16* H1; bf16* YB; const float* bg; const float* bu; const float* bd;
    __device__ __forceinline__ void operator()(const pg8::f32x4 (&acc)[2][2][4][2], const pg8::Unit& u, int wr, int wc, int fr, int fq) const {
        asm volatile("" : "+v"(fr), "+v"(fq));
        if (u.kind == 0) {
            const int f0 = u.pn * 128 + wc * 32 + 8 * fq;
            const __amdgpu_buffer_rsrc_t h1rs = __builtin_amdgcn_make_buffer_rsrc(H1, 0, (int)((size_t)T * TOPK * FF * 2), 0x00020000);
#pragma unroll
            for (int ai = 0; ai < 2; ++ai) {
                int fb = f0; asm volatile("" : "+v"(fb));
                const pg8::f32x4 g0 = *(const pg8::f32x4*)(bg + u.e * FF + fb), g1 = *(const pg8::f32x4*)(bg + u.e * FF + fb + 4);
                const pg8::f32x4 u0 = *(const pg8::f32x4*)(bu + u.e * FF + fb), u1 = *(const pg8::f32x4*)(bu + u.e * FF + fb + 4);
#pragma unroll
                for (int m = 0; m < 4; ++m) { const int r = ai * 128 + wr * 64 + m * 16 + fr;
                    const pg8::f32x4 a0 = acc[ai][0][m][0] + g0, a1 = acc[ai][0][m][1] + g1, b0 = acc[ai][1][m][0] + u0, b1 = acc[ai][1][m][1] + u1;
                    float gg[8] = {a0[0], a0[1], a0[2], a0[3], a1[0], a1[1], a1[2], a1[3]}, uu[8] = {b0[0], b0[1], b0[2], b0[3], b1[0], b1[1], b1[2], b1[3]}, o[8];
#pragma unroll
                    for (int i = 0; i < 8; ++i) { const float g = fminf(gg[i], 7.f), up = fminf(fmaxf(uu[i], -7.f), 7.f); o[i] = g * sigmoidf_(1.702f * g) * (up + 1.f); }
#ifdef MOE_PLAIN
                    if (r < u.nrow) { v4u w; w.x = pk2(o[0], o[1]); w.y = pk2(o[2], o[3]); w.z = pk2(o[4], o[5]); w.w = pk2(o[6], o[7]); *(GAS v4u*)(H1 + (size_t)(u.arow + r) * FF + fb) = w; } } }
#else
                    if (r < u.nrow) { v4u w; w.x = pk2(o[0], o[1]); w.y = pk2(o[2], o[3]); w.z = pk2(o[4], o[5]); w.w = pk2(o[6], o[7]);
                        __builtin_amdgcn_raw_buffer_store_b128(w, h1rs, (unsigned)((u.arow + r) * (FF * 2) + fb * 2), 0, 16); } } }
#endif
        } else {
            const int c0 = u.pn * 256 + wc * 32 + 8 * fq;
#pragma unroll
            for (int bj = 0; bj < 2; ++bj) { const pg8::f32x4 d0 = *(const pg8::f32x4*)(bd + u.e * D + c0 + bj * 128), d1 = *(const pg8::f32x4*)(bd + u.e * D + c0 + bj * 128 + 4);
#pragma unroll
                for (int ai = 0; ai < 2; ++ai)
#pragma unroll
                    for (int m = 0; m < 4; ++m) { const int r = ai * 128 + wr * 64 + m * 16 + fr;
                        const pg8::f32x4 a0 = acc[ai][bj][m][0] + d0, a1 = acc[ai][bj][m][1] + d1;
                        v4u w; w.x = pk2(a0[0], a0[1]); w.y = pk2(a0[2], a0[3]); w.z = pk2(a1[0], a1[1]); w.w = pk2(a1[2], a1[3]);
                        if (r < u.nrow) *(GAS v4u*)(YB + (size_t)(u.arow + r) * D + c0 + bj * 128) = w; } }
        }
    }
};
__device__ __forceinline__ void phase_final(Frame& F, bool dry = false) {
    moe_tables(F);
    const LAS int* off = (const LAS int*)(F.lds + SCR_OFF) + 32;
    LAS float* gtf = (LAS float*)(F.lds);
    const float* adaf = WSP(float, WS_ADAF);
    for (int i = F.tid; i < 2 * D; i += NWAVES * 64) { const int b = i >> 10, k = i & (D - 1); gtf[i] = adaf[b * 6 * D + 5 * D + k] * WSP(float, WS_PAR)[PAR_FPOST + k]; }
    __syncthreads();
    const int gw = F.vcu * NWAVES + F.wave, NGW = F.G * NWAVES, L = F.lane;
    const int* tok_e = WSP(int, WS_ROUTE); const float* tok_w = (const float*)(tok_e + T * 4); const int* tok_pos = tok_e + 2 * T * 4;
    const bf16* YB = WSP(bf16, WS_YB);
    for (int t = gw * 2; t < T; t += NGW * 2) { const int b = t >> 13;
        int row_l = 0; float w_l = 0.f;
        if (L < 8) { const int idx = (t + (L >> 2)) * 4 + (L & 3); row_l = off[tok_e[idx]] + tok_pos[idx]; w_l = tok_w[idx]; }
        unsigned yv[2][4][4]; f32x4 x1v[2][4]; float wk[2][4];
#pragma unroll
        for (int q = 0; q < 2; ++q) {
#pragma unroll
            for (int k = 0; k < 4; ++k) { const int row = __shfl(row_l, q * 4 + k); wk[q][k] = __shfl(w_l, q * 4 + k);
                const GAS unsigned* yr = (const GAS unsigned*)((const unsigned char*)YB + (size_t)row * D) + L;
#pragma unroll
                for (int j = 0; j < 4; ++j) yv[q][k][j] = __builtin_nontemporal_load(yr + 64 * j);
#ifdef DRY14_NOYB
                if (dry) { _Pragma("unroll") for (int j = 0; j < 4; ++j) yv[q][k][j] = 0x38383838u; }
#endif
            }
            const GAS v2u* xr = (const GAS v2u*)(WSP(bf16, WS_X1B) + (size_t)(t + q) * D) + L;
#pragma unroll
            for (int j = 0; j < 4; ++j) { const v2u xw = __builtin_nontemporal_load(xr + 64 * j); x1v[q][j] = (f32x4){bflo(xw.x), bfhi(xw.x), bflo(xw.y), bfhi(xw.y)}; } }
#pragma unroll
        for (int q = 0; q < 2; ++q) {
            f32x4 y[4];
#pragma unroll
            for (int j = 0; j < 4; ++j) y[j] = (f32x4){0.f, 0.f, 0.f, 0.f};
#pragma unroll
            for (int k = 0; k < 4; ++k)
#pragma unroll
                for (int j = 0; j < 4; ++j) { const unsigned x = yv[q][k][j]; const float w = wk[q][k] * (1.f / YB_SCALE);
                    y[j].x += w * __builtin_amdgcn_cvt_f32_fp8((int)x, 0); y[j].y += w * __builtin_amdgcn_cvt_f32_fp8((int)x, 1); y[j].z += w * __builtin_amdgcn_cvt_f32_fp8((int)x, 2); y[j].w += w * __builtin_amdgcn_cvt_f32_fp8((int)x, 3); }
            float s = 0.f;
#pragma unroll
            for (int j = 0; j < 4; ++j) s += (y[j].x * y[j].x + y[j].y * y[j].y) + (y[j].z * y[j].z + y[j].w * y[j].w);
            const float r = 1.f / sqrtf(wave_sum(s) * (1.f / D) + NORM_EPS);
            GAS f32x4* wrow = dry ? (GAS f32x4*)(WSP(float, WS_WGU_T) + (size_t)(t + q) * D) + L : (GAS f32x4*)(F.out + (size_t)(t + q) * D) + L;
#pragma unroll
            for (int j = 0; j < 4; ++j) { const f32x4 g = *(const LAS f32x4*)(gtf + b * D + 4 * L + 256 * j); __builtin_nontemporal_store(x1v[q][j] + g * (y[j] * r), wrow + 64 * j); }
        }
    }
}
__device__ __forceinline__ bool opaque_ws(Frame& F) { asm volatile("" : "+s"(F.ws)); return true; }
#ifndef MK_N_LAUNCHES
#define MK_N_LAUNCHES 1
#endif
constexpr int N_PHASES = 15;
struct Args { const float* in[30]; float* out; unsigned char* ws; int ph_lo, ph_hi; };
__global__ void __launch_bounds__(NWAVES * 64, 2) mega_fwd(Args args) {
    extern __shared__ __attribute__((aligned(16))) unsigned char lds[];
    Frame F;
    F.lds = (LAS unsigned char*)lds;
    F.MISC = (volatile LAS unsigned*)(F.lds + MISC_OFF);
    F.tid = threadIdx.x; F.lane = F.tid & 63; F.wave = __builtin_amdgcn_readfirstlane(F.tid >> 6);
    F.G = gridDim.x; { const int bx = blockIdx.x; F.vcu = (F.G % 8 == 0) ? (bx % 8) * (F.G / 8) + bx / 8 : bx; }
    F.ws = args.ws; F.ctl = (gu32*)(args.ws + WS_CTL); F.out = args.out;
#pragma unroll
    for (int i = 0; i < 30; ++i) F.in[i] = args.in[i];
    for (int u = F.tid; u < (LDS_BYTES - LDSCTL_OFF) / 4; u += NWAVES * 64) ((LAS unsigned*)(F.lds + LDSCTL_OFF))[u] = 0u;
    __syncthreads();
    XcdBarrier bar; bar.bar = (unsigned*)(F.ctl + CW_BAR); bar.x = 0; bar.st = nullptr;
    if (MK_N_LAUNCHES == 1) bar = xcd_barrier_post((unsigned*)(F.ctl + CW_BAR), F.MISC + 8);
    const int lo = args.ph_lo, hi = args.ph_hi;
#ifndef PHMASK
#define PHMASK 0x7fff
#endif
#define IN(k) (((PHMASK >> (k)) & 1) && lo <= (k) && (k) < hi)
#ifdef TPROBE
#ifndef TPROBE_MULT
#define TPROBE_MULT 2
#endif
#define TP_SLOT ((volatile LAS unsigned long long*)(F.lds + LDSCTL_OFF + 3584))
#define STAMP(k) do { if ((k) == TPROBE && blockIdx.x == 0 && F.tid == 0) TP_SLOT[1] = __builtin_amdgcn_s_memrealtime(); if ((k) == 0 && blockIdx.x == 0 && F.tid == 0) TP_SLOT[0] = __builtin_amdgcn_s_memrealtime(); } while (0)
#elif defined(DBG_A)
#define STAMP(k) do { if (blockIdx.x == 0 && F.tid == 0) ((unsigned long long*)(F.ctl + 2048))[k] = __builtin_amdgcn_s_memrealtime(); } while (0)
#else
#define STAMP(k) do {} while (0)
#endif
#ifndef REP_PHASE
#define REP_PHASE -1
#endif
#ifndef REP_MASK
#define REP_MASK 0
#endif
#define REPL(k) for (int rep_ = 0; rep_ < ((REP_PHASE == (k) || ((REP_MASK >> (k)) & 1)) ? 2 : 1); ++rep_) if (opaque_ws(F))
#ifdef DBL_BAR
#define SEAM(k) do { if (IN(k)) { xcd_barrier(bar); xcd_barrier(bar); } STAMP((k) + 1); } while (0)
#else
#define SEAM(k) do { if (IN(k)) xcd_barrier(bar); STAMP((k) + 1); } while (0)
#endif
    PG8_LAS unsigned char* ring = F.lds + RING_OFF;
    const int bx = (int)blockIdx.x;

    STAMP(0);
#ifdef DIAG_WARM
    { typedef float f4_ __attribute__((ext_vector_type(4))); typedef short s8_ __attribute__((ext_vector_type(8))); f4_ a_ = {0.f, 0.f, 0.f, 0.f}; s8_ x_ = {1, 2, 3, 4, 5, 6, 7, 8};
      const unsigned long long t0_ = __builtin_amdgcn_s_memrealtime();
      while (__builtin_amdgcn_s_memrealtime() - t0_ < (unsigned long long)(DIAG_WARM * 100)) { _Pragma("unroll") for (int i_ = 0; i_ < 16; ++i_) a_ = __builtin_amdgcn_mfma_f32_16x16x32_bf16(x_, x_, a_, 0, 0, 0); }
      if (a_[0] == 12345.f) F.out[0] = a_[1]; }
#endif
    if (IN(0)) REPL(0) { phase0(F); } SEAM(0);
    if (IN(1)) REPL(1) { phase1(F); } SEAM(1);
    if (IN(2)) REPL(2) {
#ifdef G1_MIX
        {
            pg8::Gemm g{WSP(bf16, WS_XN8), WSP(bf16, WS_WIN8), D / 2, D / 2, D / 2}; pg8::ColSubsetOrder S;
#ifdef G1_MIX_GATES
            S.d.init(T, 8 * 256, F.G, bx); S.base = 8; S.split = 8; S.skip = 0;
#else
            S.d.init(T, 12 * 256, F.G, bx); S.base = 0; S.split = 2; S.skip = 4;
#endif
            EpiG1 E{WSP(bf16, WS_UA), WSP(bf16, WS_Q), WSP(bf16, WS_K), WSP(bf16, WS_V), WSP(bf16, WS_VT), WSP(bf16, WS_GS), WSP(bf16, WS_GA),
                    WSP(float, WS_ROPE), WSP(float, WS_ROPE) + (size_t)T * 32, (float*)(F.ctl + CW_KM), WSP(float, WS_PAR) + PAR_WSC1, true};
            pg8::gemm_phase<EpiG1, pg8::ColSubsetOrder, true>(ring, g, S, E); }
        {
            pg8::Gemm g{WSP(bf16, WS_XN), WSP(bf16, WS_WIN_T), D, D, D}; pg8::ColSubsetOrder S;
#ifdef G1_MIX_GATES
            S.d.init(T, 8 * 256, F.G, bx); S.base = 0; S.split = 8; S.skip = 0;
#else
            S.d.init(T, 4 * 256, F.G, bx); S.base = 2; S.split = 4; S.skip = 0;
#endif
            EpiG1 E{WSP(bf16, WS_UA), WSP(bf16, WS_Q), WSP(bf16, WS_K), WSP(bf16, WS_V), WSP(bf16, WS_VT), WSP(bf16, WS_GS), WSP(bf16, WS_GA),
                    WSP(float, WS_ROPE), WSP(float, WS_ROPE) + (size_t)T * 32, (float*)(F.ctl + CW_KM), WSP(float, WS_PAR) + PAR_WSC1, false};
            pg8::gemm_phase<EpiG1, pg8::ColSubsetOrder, false>(ring, g, S, E); }
#else
#ifdef G1_F8
        pg8::Gemm g{WSP(bf16, WS_XN), WSP(bf16, WS_WIN_T), D / 2, D / 2, D / 2}; pg8::DenseOrder S; S.init(T, INW, F.G, bx);
#else
        pg8::Gemm g{WSP(bf16, WS_XN), WSP(bf16, WS_WIN_T), D, D, D}; pg8::DenseOrder S; S.init(T, INW, F.G, bx);
#endif
        EpiG1 E{WSP(bf16, WS_UA), WSP(bf16, WS_Q), WSP(bf16, WS_K), WSP(bf16, WS_V), WSP(bf16, WS_VT), WSP(bf16, WS_GS), WSP(bf16, WS_GA),
                WSP(float, WS_ROPE), WSP(float, WS_ROPE) + (size_t)T * 32, (float*)(F.ctl + CW_KM), WSP(float, WS_PAR) + PAR_WSC1,
#ifdef G1_F8
                true};
#else
                false};
#endif
#ifdef G1_F8
        pg8::gemm_phase<EpiG1, pg8::DenseOrder, true>(ring, g, S, E);
#else
        pg8::gemm_phase(ring, g, S, E);
#endif
#endif
        s5_fill_kt(F);
    } SEAM(2);
    if (IN(3)) REPL(3) {
        pg8::Gemm g{WSP(bf16, WS_UA), WSP(bf16, WS_S5M1), 384, 256, 256}; S5Order S{F.G, bx}; EpiS5A E{WSP(float, WS_S5E)};
        pg8::gemm_phase(ring, g, S, E);
        s5_fill_wc(F);
        attn_gate(F);
#ifdef MOE_F8
        moe_convert_idle(F, MOE_ITEMS_P0, MOE_ITEMS_P3);
#endif
    } SEAM(3);
    if (IN(4)) REPL(4) { attn_items(F); s5_carry(F); } SEAM(4);
    if (IN(5)) REPL(5) {
        pg8::Gemm g{WSP(bf16, WS_UA), WSP(bf16, WS_S5WC), 384, 384, 384}; S5Order S{F.G, bx}; EpiS5C E{WSP(bf16, WS_YG)};
        pg8::gemm_phase(ring, g, S, E);
        attn_combine(F);
#ifdef MOE_F8
        moe_convert_idle(F, MOE_ITEMS_P0 + MOE_ITEMS_P3, MOE_ITEMS_P5);
#endif
    } SEAM(5);
    if (IN(6)) REPL(6) {
        pg8::Gemm g{WSP(bf16, WS_YG), WSP(bf16, WS_WGLU_T), SW, SW, SW}; pg8::DenseOrder S; S.init(T, SW, F.G, bx);
        EpiEw<0> E{WSP(bf16, WS_Y2), WSP(bf16, WS_YG), nullptr, nullptr, SW};
        pg8::gemm_phase(ring, g, S, E);
#ifdef MOE_F8
        moe_convert_idle(F, MOE_ITEMS_P0 + MOE_ITEMS_P3 + MOE_ITEMS_P5, MOE_ITEMS_P6);
#endif
    } SEAM(6);
    if (IN(7)) REPL(7) {
        pg8::Gemm g{WSP(bf16, WS_Y2), WSP(bf16, WS_WSB_T), SW, SW, SW}; pg8::DenseOrder S; S.init(T, D, F.G, bx);
        EpiEw<1> E{WSP(bf16, WS_M1), WSP(bf16, WS_GS), nullptr, nullptr, D};
        pg8::gemm_phase(ring, g, S, E);
    }
    if (IN(7)) { asm volatile("s_waitcnt vmcnt(0)" ::: "memory"); __syncthreads(); if (F.tid < 64) { __builtin_amdgcn_fence(__ATOMIC_ACQUIRE, "agent"); asm volatile("s_waitcnt vmcnt(0)" ::: "memory"); } __syncthreads(); STAMP(8); }
    if (IN(8)) REPL(8) {
        pg8::Gemm g{WSP(bf16, WS_YA), WSP(bf16, WS_WAB_T), AW, AW, AW}; pg8::DenseOrder S; S.init(T, D, F.G, bx);
        EpiEw<2> E{WSP(bf16, WS_XN), WSP(bf16, WS_GA), WSP(bf16, WS_M1), nullptr, D};
        pg8::gemm_phase(ring, g, S, E);
    } SEAM(8);
    if (IN(9)) REPL(9) {
        pg8::Gemm g{WSP(bf16, WS_XN), WSP(bf16, WS_WOUT_T), D, D, D}; pg8::DenseOrder S; S.init(T, D, F.G, bx);
        EpiEw<4> E{WSP(bf16, WS_MIX), nullptr, nullptr, nullptr, D};
        pg8::gemm_phase(ring, g, S, E);
    } SEAM(9);
    if (IN(10)) REPL(10) { phase_rows(F, (REP_PHASE == 10 || ((REP_MASK >> 10) & 1)) && rep_ == 0); } SEAM(10);
#ifndef MOE_FUSED
#ifdef MOE_F8
    if (IN(12)) REPL(12) {
        moe_tables(F, 8, 2048);
        pg8::Gemm g{WSP(bf16, WS_H2), WSP(bf16, WS_WGU_T), D / 2, D / 2, D / 2}; MoeOrder<true> S{(const LAS int*)(F.lds + SCR_OFF), WSP(int, WS_ELIST), 8, 2048, F.G, bx};
        EpiGU8 E{WSP(unsigned char, WS_H1), WSP(float, WS_PAR) + PAR_BG, WSP(float, WS_PAR) + PAR_BU, WSP(float, WS_PAR) + PAR_WSC};
        pg8::gemm_phase<EpiGU8, MoeOrder<true>, true>(ring, g, S, E);
    } SEAM(12);
    if (IN(13)) REPL(13) {
        moe_tables(F, 4, 1024);
        pg8::Gemm g{WSP(bf16, WS_H1), WSP(bf16, WS_WDN_T), FF / 2, FF / 2, FF / 2}; MoeOrder<false> S{(const LAS int*)(F.lds + SCR_OFF), nullptr, 4, 1024, F.G, bx};
        EpiDn8 E{WSP(bf16, WS_YB), WSP(float, WS_PAR) + PAR_BD, WSP(float, WS_PAR) + PAR_WSC};
        pg8::gemm_phase<EpiDn8, MoeOrder<false>, true>(ring, g, S, E);
    } SEAM(13);
#else
    if (IN(12)) REPL(12) {
        moe_tables(F, 8, 2048);
        pg8::Gemm g{WSP(bf16, WS_H2), WSP(bf16, WS_WGU_T), D, D, D}; MoeOrder<true> S{(const LAS int*)(F.lds + SCR_OFF), WSP(int, WS_ELIST), 8, 2048, F.G, bx};
        EpiGU E{WSP(bf16, WS_H1), WSP(float, WS_PAR) + PAR_BG, WSP(float, WS_PAR) + PAR_BU};
        pg8::gemm_phase(ring, g, S, E);
    } SEAM(12);
    if (IN(13)) REPL(13) {
        moe_tables(F, 4, 1024);
        pg8::Gemm g{WSP(bf16, WS_H1), WSP(bf16, WS_WDN_T), FF, FF, FF}; MoeOrder<false> S{(const LAS int*)(F.lds + SCR_OFF), nullptr, 4, 1024, F.G, bx};
        EpiDn E{WSP(bf16, WS_YB), WSP(float, WS_PAR) + PAR_BD};
        pg8::gemm_phase(ring, g, S, E);
    } SEAM(13);
#endif
#else
    if (IN(12)) REPL(12) {
        moe_tables(F);
        pg8::Gemm g{(const bf16*)F.ws, WSP(bf16, WS_WGU_T), D, D, D};
        EpiMoe E{WSP(bf16, WS_H1), WSP(bf16, WS_YB), WSP(float, WS_PAR) + PAR_BG, WSP(float, WS_PAR) + PAR_BU, WSP(float, WS_PAR) + PAR_BD};
        for (int base = 0;;) { MoeFused S{(const LAS int*)(F.lds + SCR_OFF), WSP(int, WS_ELIST), F.ctl, F.G, bx, base};
            const int nd = pg8::gemm_phase(ring, g, S, E); if (nd == 0) break; base += nd; }
    } SEAM(12);
#endif
    if (IN(14)) REPL(14) { phase_final(F, (REP_PHASE == 14 || ((REP_MASK >> 14) & 1)) && rep_ == 0); }
#ifdef TPROBE
    if (blockIdx.x == 0 && F.tid == 0) { const unsigned long long t0_ = TP_SLOT[0], tk_ = TP_SLOT[1], te_ = __builtin_amdgcn_s_memrealtime();
        while (__builtin_amdgcn_s_memrealtime() - te_ < (tk_ - t0_) * TPROBE_MULT) __builtin_amdgcn_s_sleep(8); }
#endif
#undef IN
#undef SEAM
}

extern "C" void kernel_launch(void* const* d_in, const int* in_sizes, int n_in, void* d_out, int out_size, void* d_ws, size_t ws_size, hipStream_t stream) {
    static int grid = 0;
    if (grid == 0) {
        if (n_in != 30 || in_sizes[0] != T * D || out_size != T * D || ws_size < WS_END) { fprintf(stderr, "kernel_launch: unexpected shapes (n_in %d, in0 %d, out %d, ws %zu)\n", n_in, n_in > 0 ? in_sizes[0] : -1, out_size, ws_size); grid = -1; return; }
        int dev = 0, cus = 0, per_cu = 0;
        if (hipGetDevice(&dev) != hipSuccess || hipDeviceGetAttribute(&cus, hipDeviceAttributeMultiprocessorCount, dev) != hipSuccess) { grid = -1; return; }
        if (hipFuncSetAttribute((const void*)mega_fwd, hipFuncAttributeMaxDynamicSharedMemorySize, LDS_BYTES) != hipSuccess) { fprintf(stderr, "kernel_launch: hipFuncSetAttribute failed\n"); grid = -1; return; }
        if (hipOccupancyMaxActiveBlocksPerMultiprocessor(&per_cu, (const void*)mega_fwd, NWAVES * 64, LDS_BYTES) != hipSuccess || per_cu < 1) { fprintf(stderr, "kernel_launch: occupancy query says %d\n", per_cu); }
        (void)hipGetLastError();
        grid = cus;
    }
    if (grid < 0) return;
    (void)hipMemsetAsync((char*)d_ws + WS_CTL, 0, CTL_ZERO_USED, stream);
    Args a{};
    for (int i = 0; i < 30; ++i) a.in[i] = (const float*)d_in[i];
    a.out = (float*)d_out; a.ws = (unsigned char*)d_ws;
#ifndef PLAIN_LAUNCH
    if (MK_N_LAUNCHES == 1) { a.ph_lo = 0; a.ph_hi = N_PHASES; void* kargs[] = {(void*)&a};
        const hipError_t e = hipLaunchCooperativeKernel((const void*)mega_fwd, dim3(grid), dim3(NWAVES * 64), kargs, LDS_BYTES, stream);
        if (e != hipSuccess) fprintf(stderr, "kernel_launch: cooperative launch failed: %s\n", hipGetErrorString(e)); }
#else
    if (MK_N_LAUNCHES == 1) { a.ph_lo = 0; a.ph_hi = N_PHASES; hipLaunchKernelGGL(mega_fwd, dim3(grid), dim3(NWAVES * 64), LDS_BYTES, stream, a); }
#endif
    else for (int p = 0; p < N_PHASES; ++p) { a.ph_lo = p; a.ph_hi = p + 1; hipLaunchKernelGGL(mega_fwd, dim3(grid), dim3(NWAVES * 64), LDS_BYTES, stream, a); }
}
```

```cpp
#include <hip/hip_runtime.h>
#include <cstdio>
#include <cstdint>
#define MK_N_LAUNCHES 1
namespace pg8 {
#define PG8_LAS __attribute__((address_space(3)))
typedef unsigned short bf16_t;
typedef short bf16x8 __attribute__((ext_vector_type(8)));
typedef float f32x4 __attribute__((ext_vector_type(4)));
typedef unsigned u32x4 __attribute__((ext_vector_type(4)));
typedef unsigned u32x2 __attribute__((ext_vector_type(2)));
typedef int v4i32 __attribute__((ext_vector_type(4)));
typedef int v8i32 __attribute__((ext_vector_type(8)));
constexpr int BIAS_LDS_OFF = 156 * 1024;
constexpr int BM = 256, BK = 64, HALF = 128, HTB = HALF * BK * 2  , STAGE_BYTES = 8 * HTB, NXCD = 8, WGM = 8;

__host__ __device__ __forceinline__ int lds_byte(int r, int c) { const int st = (r >> 4) * 2 + (c >> 5), rr = r & 15, cc = c & 31, ob = rr * 64 + cc * 2; return st * 1024 + (ob ^ (((ob >> 9) & 1) << 5)); }
__host__ __device__ __forceinline__ void stage_rc(int b, int& R, int& C) { const int st = b / 1024, sb = b % 1024, swz = sb ^ (((sb >> 9) & 1) << 5); R = (st >> 1) * 16 + swz / 64; C = (st & 1) * 32 + (swz % 64) / 2; }

struct Unit { int arow, brow, pm, pn, e, nrow, kind, aux; };
struct Gemm { const bf16_t* A; const bf16_t* Bt; int lda, ldb, K; };

struct DenseOrder {
    static constexpr bool GATHER = false;
    __device__ __forceinline__ void a_ready(const Unit&) const {}
    __device__ __forceinline__ void done(const Unit&) const {}
    int nM, nN, nwg, G, c;
    __device__ __forceinline__ void init(int M, int N, int G_, int c_) { nM = M / BM; nN = N / BM; nwg = nM * nN; G = G_; c = c_; }
    __device__ __forceinline__ bool next(int i, Unit& u) const {
        const long L = (long)i * G + c; if (L >= nwg) return false;
        int wgid = (int)L; { const int q = nwg / NXCD, r = nwg % NXCD, xcd = wgid % NXCD, off = wgid / NXCD; wgid = (xcd < r ? xcd * (q + 1) : r * (q + 1) + (xcd - r) * q) + off; }
        const int nig = WGM * nN, gid = wgid / nig, fm = gid * WGM, gsz = (nM - fm) < WGM ? (nM - fm) : WGM;
        u.pm = fm + ((wgid % nig) % gsz); u.pn = (wgid % nig) / gsz; u.arow = u.pm * BM; u.brow = u.pn * BM; u.e = 0; u.nrow = BM; u.kind = 0; u.aux = 0; return true;
    }
};

struct ColSubsetOrder {
    static constexpr bool GATHER = false;
    DenseOrder d; int base, split, skip;
    __device__ __forceinline__ void a_ready(const Unit&) const {}
    __device__ __forceinline__ void done(const Unit&) const {}
    __device__ __forceinline__ bool next(int i, Unit& u) const { if (!d.next(i, u)) return false; const int pa = base + (u.pn < split ? u.pn : u.pn + skip); u.pn = pa; u.brow = pa * BM; return true; }
};

template <class T_> struct has_bias_lds { template <class U_> static constexpr bool get(decltype(U_::BIAS_LDS)*) { return U_::BIAS_LDS; } template <class U_> static constexpr bool get(...) { return false; } static constexpr bool value = get<T_>(nullptr); };
template <class Epi, class Sched, bool F8 = false>
__device__ __forceinline__ int gemm_phase(PG8_LAS unsigned char* lds, const Gemm g, const Sched& S, const Epi& E) {
    const int tid = threadIdx.x, wid = __builtin_amdgcn_readfirstlane(tid >> 6), lane = tid & 63, wr = wid >> 2, wc = wid & 3, fr = lane & 15, fq = lane >> 4;
    const int K = g.K, nt = K / BK;
    PG8_LAS unsigned char* biaslds = lds + BIAS_LDS_OFF;
    constexpr bool GA = Sched::GATHER;
    unsigned voffA[2], voffB[2]; int gR[2]; unsigned gC[2];
#pragma unroll
    for (int i = 0; i < 2; ++i) { int R, C; stage_rc(tid * 16 + i * 8192, R, C); gR[i] = R; gC[i] = (unsigned)C * 2u;
        voffA[i] = (unsigned)(R * g.lda + C) * 2u; voffB[i] = (unsigned)(R * g.ldb + C) * 2u; }
    unsigned gA_cur[2][2], gA_nxt[2][2];
#define PG8_GATH(dst, un) do { _Pragma("unroll") for (int _h = 0; _h < 2; ++_h) _Pragma("unroll") for (int _i = 0; _i < 2; ++_i) dst[_h][_i] = (unsigned)S.arow_of(un, _h * HALF + gR[_i]) * (unsigned)(g.lda * 2) + gC[_i]; } while (0)
#define PG8_STAGE_A(bufoff, h, kbytes, nx) do { if constexpr (GA) { const char* gb_ = (const char*)g.A + (kbytes); _Pragma("unroll") for (int _i = 0; _i < 2; ++_i) { const unsigned vo_ = (nx) ? gA_nxt[h][_i] : gA_cur[h][_i]; \
        __builtin_amdgcn_global_load_lds((const unsigned*)(gb_ + vo_), (PG8_LAS unsigned*)(lds + (bufoff) + ldsw + _i * 8192), 16, 0, 0); } } \
    else { const char* gb_ = ((nx) ? nA : cA) + (kbytes) + (h) * hstepA; PG8_STAGE(bufoff, gb_, voffA); } } while (0)
    const size_t kstep = (size_t)(BK * 2);
    const size_t hstepA = (size_t)HALF * g.lda * 2, hstepB = (size_t)HALF * g.ldb * 2;
    const size_t rowA = (size_t)g.lda * 2, rowB = (size_t)g.ldb * 2;
    const unsigned ldsw = (unsigned)wid * 1024u;
    const int aoff = lds_byte(wr * 64 + fr, fq * 8), boff = lds_byte(wc * 32 + fr, fq * 8);
#define PG8_SA(b, h) (((b) * 2 + (h)) * HTB)
#define PG8_SB(b, h) ((4 + (b) * 2 + (h)) * HTB)
#define PG8_STAGE(bufoff, gbase, voff) do { _Pragma("unroll") for (int _i = 0; _i < 2; ++_i) \
        __builtin_amdgcn_global_load_lds((const unsigned*)((const char*)(gbase) + (voff)[_i]), (PG8_LAS unsigned*)(lds + (bufoff) + ldsw + _i * 8192), 16, 0, 0); } while (0)
#define PG8_LDA(dst, b, h) do { _Pragma("unroll") for (int m = 0; m < 4; ++m) { if constexpr (F8) { const v4i32 lo_ = *(const PG8_LAS v4i32*)(lds + PG8_SA(b, h) + aoff + m * 2048), hi_ = *(const PG8_LAS v4i32*)(lds + PG8_SA(b, h) + aoff + m * 2048 + 1024); dst##8[m] = __builtin_shufflevector(lo_, hi_, 0, 1, 2, 3, 4, 5, 6, 7); } \
        else { _Pragma("unroll") for (int k = 0; k < 2; ++k) dst[m][k] = *(const PG8_LAS bf16x8*)(lds + PG8_SA(b, h) + aoff + m * 2048 + k * 1024); } } } while (0)
#define PG8_LDB(dst, b, h) do { _Pragma("unroll") for (int n = 0; n < 2; ++n) { if constexpr (F8) { const v4i32 lo_ = *(const PG8_LAS v4i32*)(lds + PG8_SB(b, h) + boff + n * 2048), hi_ = *(const PG8_LAS v4i32*)(lds + PG8_SB(b, h) + boff + n * 2048 + 1024); dst##8[n] = __builtin_shufflevector(lo_, hi_, 0, 1, 2, 3, 4, 5, 6, 7); } \
        else { _Pragma("unroll") for (int k = 0; k < 2; ++k) dst[n][k] = *(const PG8_LAS bf16x8*)(lds + PG8_SB(b, h) + boff + n * 2048 + k * 1024); } } } while (0)
#define PG8_MMA(ai, bj, At, Bt) do { __builtin_amdgcn_s_setprio(1); _Pragma("unroll") for (int m = 0; m < 4; ++m) _Pragma("unroll") for (int n = 0; n < 2; ++n) { \
        if constexpr (F8) { asm("v_mfma_scale_f32_16x16x128_f8f6f4 %0, %1, %2, %0, %3, %3 op_sel_hi:[0,0,0]" : "+v"(acc[ai][bj][m][n]) : "v"(Bt##8[n]), "v"(At##8[m]), "v"(one_scale)); } \
        else { _Pragma("unroll") for (int k = 0; k < 2; ++k) acc[ai][bj][m][n] = __builtin_amdgcn_mfma_f32_16x16x32_bf16(Bt[n][k], At[m][k], acc[ai][bj][m][n], 0, 0, 0); } } \
        __builtin_amdgcn_s_setprio(0); } while (0)
#define PG8_WAIT_V(n) asm volatile("s_waitcnt vmcnt(" #n ")" ::: "memory")
#define PG8_WAIT_L(n) asm volatile("s_waitcnt lgkmcnt(" #n ")" ::: "memory")
#define PG8_BAR __builtin_amdgcn_s_barrier()
#define PG8_SCHED __builtin_amdgcn_sched_barrier(0)
    Unit cur, nxt; int ui = 0;
    if (!S.next(0, cur)) return 0;
    f32x4 acc[2][2][4][2];
#pragma unroll
    for (int a = 0; a < 2; ++a)
#pragma unroll
        for (int b = 0; b < 2; ++b)
#pragma unroll
            for (int m = 0; m < 4; ++m)
#pragma unroll
                for (int n = 0; n < 2; ++n) acc[a][b][m][n] = (f32x4){0.f, 0.f, 0.f, 0.f};
    const int one_scale = 0x7f7f7f7f;
    bf16x8 At[4][2], B0[2][2], B1[2][2];
    v8i32 At8[4], B08[2], B18[2];
    const char* cA = GA ? (const char*)g.A : (const char*)g.A + (size_t)cur.arow * rowA; const char* cB = (const char*)g.Bt + (size_t)cur.brow * rowB; const char* nA = cA;
    if constexpr (GA) { PG8_GATH(gA_cur, cur); }
    S.a_ready(cur);
    PG8_STAGE(PG8_SB(0, 0), cB, voffB); PG8_STAGE(PG8_SB(0, 1), cB + hstepB, voffB); PG8_STAGE_A(PG8_SA(0, 0), 0, 0, false); PG8_STAGE_A(PG8_SA(0, 1), 1, 0, false);
    if (wr == 1) PG8_BAR;
    PG8_WAIT_V(2); PG8_BAR;
    PG8_STAGE(PG8_SB(1, 0), cB + kstep, voffB); PG8_STAGE_A(PG8_SA(1, 0), 0, kstep, false); PG8_STAGE(PG8_SB(1, 1), cB + hstepB + kstep, voffB);
    PG8_WAIT_V(6); PG8_BAR;
    for (;;) {
        const bool has_next = S.next(ui + 1, nxt);
        if constexpr (has_bias_lds<Epi>::value) E.stage_bias(biaslds + (ui & 1) * 1024, cur, wid, lane);
        nA = GA ? cA : (has_next ? (const char*)g.A + (size_t)nxt.arow * rowA : cA); const char* nB = has_next ? (const char*)g.Bt + (size_t)nxt.brow * rowB : cB;
        if constexpr (GA) { if (has_next) { PG8_GATH(gA_nxt, nxt); } else { _Pragma("unroll") for (int _h = 0; _h < 2; ++_h) _Pragma("unroll") for (int _i = 0; _i < 2; ++_i) gA_nxt[_h][_i] = gA_cur[_h][_i]; } }
#pragma unroll 1
        for (int t = 0; t < nt; t += 2) {
            const bool last = (t == nt - 2);
            if (last && has_next) S.a_ready(nxt);
            const size_t k1 = (size_t)(t + 1) * kstep, k2 = last ? (size_t)0 : (size_t)(t + 2) * kstep, k3 = k2 + kstep;
            const char* b2 = last ? nB : cB + (size_t)(t + 2) * kstep; const char* b3 = b2 + kstep;
            PG8_LDB(B0, 0, 0); PG8_LDB(B1, 0, 1); PG8_SCHED; PG8_LDA(At, 0, 0); PG8_STAGE_A(PG8_SA(1, 1), 1, k1, false);
            PG8_WAIT_V(8); PG8_WAIT_L(0); PG8_BAR; PG8_MMA(0, 0, At, B0); PG8_MMA(0, 1, At, B1); PG8_BAR; PG8_SCHED;
            PG8_LDA(At, 0, 1); PG8_STAGE(PG8_SB(0, 0), b2, voffB); PG8_STAGE(PG8_SB(0, 1), b2 + hstepB, voffB); PG8_STAGE_A(PG8_SA(0, 0), 0, k2, last);
            PG8_WAIT_V(8); PG8_WAIT_L(0); PG8_BAR; PG8_MMA(1, 0, At, B0); PG8_MMA(1, 1, At, B1); PG8_BAR; PG8_SCHED;
            PG8_LDB(B0, 1, 0); PG8_LDB(B1, 1, 1); PG8_SCHED; PG8_LDA(At, 1, 0); PG8_STAGE_A(PG8_SA(0, 1), 1, k2, last);
            PG8_WAIT_V(8); PG8_WAIT_L(0); PG8_BAR; PG8_MMA(0, 0, At, B0); PG8_MMA(0, 1, At, B1); PG8_BAR; PG8_SCHED;
            PG8_LDA(At, 1, 1); PG8_STAGE(PG8_SB(1, 0), b3, voffB); PG8_STAGE(PG8_SB(1, 1), b3 + hstepB, voffB); PG8_STAGE_A(PG8_SA(1, 0), 0, k3, last);
            PG8_WAIT_V(8); PG8_WAIT_L(0); PG8_BAR; PG8_MMA(1, 0, At, B0); PG8_MMA(1, 1, At, B1); PG8_BAR; PG8_SCHED;
        }
        if (wr == 0) PG8_BAR;
        if constexpr (has_bias_lds<Epi>::value) E(acc, cur, wr, wc, fr, fq, (const PG8_LAS float*)(biaslds + (ui & 1) * 1024)); else E(acc, cur, wr, wc, fr, fq);
        S.done(cur);
        if (!has_next) break;
#pragma unroll
        for (int a = 0; a < 2; ++a)
#pragma unroll
            for (int b = 0; b < 2; ++b)
#pragma unroll
                for (int m = 0; m < 4; ++m)
#pragma unroll
                    for (int n = 0; n < 2; ++n) acc[a][b][m][n] = (f32x4){0.f, 0.f, 0.f, 0.f};
        cur = nxt; cA = nA; cB = nB; ++ui;
        if constexpr (GA) { _Pragma("unroll") for (int _h = 0; _h < 2; ++_h) _Pragma("unroll") for (int _i = 0; _i < 2; ++_i) gA_cur[_h][_i] = gA_nxt[_h][_i]; }
        if (wr == 1) PG8_BAR;
    }
    PG8_WAIT_V(0);
    PG8_BAR;
    const int n_done_ = ui + 1;
#undef PG8_SA
#undef PG8_SB
#undef PG8_STAGE
#undef PG8_STAGE_A
#undef PG8_GATH
#undef PG8_LDA
#undef PG8_LDB
#undef PG8_MMA
#undef PG8_WAIT_V
#undef PG8_WAIT_L
#undef PG8_BAR
#undef PG8_SCHED
    return n_done_;
}
}
constexpr int NWAVES = 8;
constexpr int BATCH = 2, SEQ = 8192, T = BATCH * SEQ, D = 1024, NH = 8, HD = 64, AW = 512, SW = 512, NG = 32, NP = 64, GS16 = 16;
constexpr int NE = 32, FF = 1024, INW = 4096, TOPK = 4, NBLK = SEQ / 256;
constexpr float NORM_EPS = 1e-6f;
constexpr float C2 = 0.125f * 1.4426950408889634f;
constexpr int XROWS = T * TOPK + 256;

constexpr size_t MiB = 1u << 20;
constexpr size_t WS_CTL = 0, CTL_ZERO_BYTES = 1 * MiB;
constexpr size_t WS_ADA = 1 * MiB;
constexpr size_t WS_ADAF = WS_ADA + 832 * 1024;
constexpr size_t WS_ROPE = 2 * MiB;
constexpr size_t WS_S5P = 6 * MiB;
constexpr size_t WS_S5KT = 7 * MiB;
constexpr size_t WS_S5M1 = 10 * MiB;
constexpr size_t WS_S5WC = 506 * MiB;
constexpr size_t WS_S5E = 408 * MiB;
constexpr size_t WS_ROUTE = 9 * MiB;
constexpr size_t WS_ELIST = 14 * MiB; constexpr int ELCAP = T;
constexpr size_t WS_HSC = WS_ROUTE + 768 * 1024;
constexpr int PAR_WSC = 270000, PAR_WSC1 = 270001;
#ifndef MOE_BF16
#define MOE_F8 1
#endif
constexpr size_t WS_WIN_T = 18 * MiB, WS_WGLU_T = 26 * MiB, WS_WSB_T = 27 * MiB, WS_WAB_T = 28 * MiB, WS_WOUT_T = 29 * MiB;
constexpr size_t WS_PAR = 16 * MiB;
constexpr int PAR_MPG = 0, PAR_FPRE = 1024, PAR_FPOST = 2048, PAR_RB = 3072, PAR_RW = 4096, PAR_BG = 36864, PAR_BU = 69632, PAR_BD = 102400, PAR_CRE = 135168, PAR_CIM = 167936, PAR_SD = 200704, PAR_BRE = 201728, PAR_BIM = 234496;
constexpr size_t WS_WGU_T = 32 * MiB, WS_WDN_T = 160 * MiB;
constexpr size_t WS_XN = 224 * MiB;
constexpr size_t WS_UA = 256 * MiB, WS_Q = 280 * MiB, WS_K = 296 * MiB, WS_V = 312 * MiB, WS_VT = 328 * MiB;
constexpr size_t WS_MIX = 256 * MiB;
constexpr size_t WS_GS = 344 * MiB, WS_GA = 376 * MiB;
constexpr size_t WS_YG = 408 * MiB, WS_Y2 = 424 * MiB, WS_YA = 440 * MiB;
constexpr size_t WS_M1 = 456 * MiB;
constexpr size_t WS_H2 = 480 * MiB;
constexpr size_t WS_WIN8 = 96 * MiB, WS_XN8 = 100 * MiB;
constexpr size_t WS_X1B = 416 * MiB;
constexpr size_t WS_XG = 224 * MiB, WS_YB = 224 * MiB;
constexpr size_t WS_H1 = 352 * MiB;
constexpr size_t WS_END = 512 * MiB;
static_assert(WS_YB + (size_t)T * TOPK * D * 2 <= WS_H1 && WS_H1 + (size_t)T * TOPK * FF * 2 <= WS_H2 && WS_H2 + (size_t)T * D * 2 <= WS_END, "ws map");
constexpr int CW_TMO = 0, CW_CODE = 1, CW_BAR = 4096, CW_ECNT = 8192, CW_KM = 16384;
constexpr size_t CTL_ZERO_USED = (size_t)(CW_KM + BATCH * NH * NBLK * HD) * 4;
static_assert(CTL_ZERO_USED <= CTL_ZERO_BYTES, "ctl");

constexpr int RING_OFF = 0, RING_BYTES = 131072;
constexpr int LDSCTL_OFF = 152 * 1024, MISC_OFF = LDSCTL_OFF + 320;
constexpr int LDS_BYTES = 158 * 1024;

#define GAS __attribute__((address_space(1)))
#define LAS __attribute__((address_space(3)))
typedef unsigned short bf16;
typedef unsigned v4u __attribute__((ext_vector_type(4)));
typedef unsigned v2u __attribute__((ext_vector_type(2)));
typedef float f32x4 __attribute__((ext_vector_type(4)));
typedef GAS unsigned gu32;
#define RLX_AGENT __ATOMIC_RELAXED, __HIP_MEMORY_SCOPE_AGENT
#define LDS_WAIT() asm volatile("s_waitcnt lgkmcnt(0)" ::: "memory")
#define VM_WAIT() asm volatile("s_waitcnt vmcnt(0)" ::: "memory")
__device__ __forceinline__ unsigned f2bf(float f) { unsigned u = __builtin_bit_cast(unsigned, f); return (u + 0x7fffu + ((u >> 16) & 1u)) >> 16; }
__device__ __forceinline__ unsigned pk2(float lo, float hi) { typedef float f32x2_t __attribute__((ext_vector_type(2))); typedef __bf16 bf16x2_t __attribute__((ext_vector_type(2)));
    f32x2_t v = {lo, hi}; bf16x2_t r = __builtin_convertvector(v, bf16x2_t); return __builtin_bit_cast(unsigned, r); }
#ifdef WT_STORES
__device__ __forceinline__ void st16(void* p, v4u v) { asm volatile("global_store_dwordx4 %0, %1, off sc1\n\ts_nop 1" :: "v"(p), "v"(v) : "memory"); }
__device__ __forceinline__ void st8(void* p, v2u v) { asm volatile("global_store_dwordx2 %0, %1, off sc1\n\ts_nop 1" :: "v"(p), "v"(v) : "memory"); }
#else
__device__ __forceinline__ void st16(void* p, v4u v) { *(v4u*)p = v; }
__device__ __forceinline__ void st8(void* p, v2u v) { *(v2u*)p = v; }
#endif
__device__ __forceinline__ unsigned pk4_fp8(float a, float b, float c, float d) {
    a = fminf(fmaxf(a, -448.f), 448.f); b = fminf(fmaxf(b, -448.f), 448.f); c = fminf(fmaxf(c, -448.f), 448.f); d = fminf(fmaxf(d, -448.f), 448.f);
    int w = 0; w = __builtin_amdgcn_cvt_pk_fp8_f32(a, b, w, false); w = __builtin_amdgcn_cvt_pk_fp8_f32(c, d, w, true); return (unsigned)w; }
__device__ __forceinline__ float bflo(unsigned w) { return __builtin_bit_cast(float, w << 16); }
__device__ __forceinline__ float bfhi(unsigned w) { return __builtin_bit_cast(float, w & 0xffff0000u); }
__device__ __forceinline__ float bf2f(bf16 h) { return __builtin_bit_cast(float, (unsigned)h << 16); }
__device__ __forceinline__ float sigmoidf_(float x) { return 1.f / (1.f + __expf(-x)); }
__device__ __forceinline__ float gelu_tanh(float x) { const float u = 1.5957691216057308f * (x + 0.044715f * x * x * x); return x / (1.f + __expf(-u)); }

#define XB_TMO      128
#define XB_XCNT(j)  (256  + 64 * (j))
#define XB_XSUB(j)  (1280 + 64 * (j))
#define XB_XGEN(j)  (2304 + 64 * (j))
#define XB_TOP      3328
#define XB_TOPGEN   3392
#define XCD_BAR_WORDS 3456
#define XB_SPIN_CAP (1u << 18)
__device__ __forceinline__ unsigned xb_ld(unsigned* p)              { return __hip_atomic_load(p, __ATOMIC_RELAXED, __HIP_MEMORY_SCOPE_AGENT); }
__device__ __forceinline__ unsigned xb_add(unsigned* p, unsigned v) { return __hip_atomic_fetch_add(p, v, __ATOMIC_RELAXED, __HIP_MEMORY_SCOPE_AGENT); }
__device__ __forceinline__ unsigned xb_xcc_id() { return (unsigned)__builtin_amdgcn_s_getreg((3 << 11) | 20) & 0xFu; }
#define XB_SPIN(cond, bar) do { unsigned _sp = 0; while (cond) { __builtin_amdgcn_s_sleep(1); \
    if ((++_sp & 255u) == 0u) { if (xb_ld(&(bar)[XB_TMO])) break; if (_sp > XB_SPIN_CAP) { atomicAdd(&(bar)[XB_TMO], 1u); break; } } } } while (0)
struct XcdBarrier { unsigned* bar; unsigned x; volatile LAS unsigned* st; };
__device__ __forceinline__ XcdBarrier xcd_barrier_post(unsigned* bar, volatile LAS unsigned* st) {
    XcdBarrier b; b.bar = bar; b.x = xb_xcc_id(); b.st = st;
    if (threadIdx.x == 0) (void)xb_add(&bar[XB_XCNT(b.x)], 1u);
    return b;
}
__device__ __forceinline__ void xcd_barrier_complete(unsigned* bar, unsigned x, unsigned& nloc, unsigned& nx) {
    const unsigned G = gridDim.x * gridDim.y * gridDim.z;
    unsigned sum, cnt, mine, sp = 0u;
    for (;;) {
        sum = 0u; cnt = 0u; mine = 0u;
#pragma unroll
        for (unsigned j = 0; j < 16; ++j) { const unsigned c = xb_ld(&bar[XB_XCNT(j)]); sum += c; cnt += (c > 0u) ? 1u : 0u; mine = (j == x) ? c : mine; }
        if (sum == G) break;
        __builtin_amdgcn_s_sleep(1);
        if ((++sp & 255u) == 0u) { if (xb_ld(&bar[XB_TMO])) break; if (sp > XB_SPIN_CAP) { atomicAdd(&bar[XB_TMO], 1u); break; } }
    }
    nloc = mine > 0u ? mine : 1u; nx = cnt > 0u ? cnt : 1u;
}
__device__ __forceinline__ void xcd_barrier(const XcdBarrier& b) {
    asm volatile("s_waitcnt vmcnt(0)" ::: "memory");
    __syncthreads();
    if (threadIdx.x == 0) {
        unsigned* bar = b.bar;
        __builtin_amdgcn_s_waitcnt(0);
        unsigned nloc = b.st[0], nx = b.st[1];
        if (nloc == 0u) { xcd_barrier_complete(bar, b.x, nloc, nx); b.st[0] = nloc; b.st[1] = nx; }
        const unsigned old = xb_add(&bar[XB_XSUB(b.x)], 1u);
        const unsigned gen = old / nloc;
        if (old + 1u == (gen + 1u) * nloc) {
            __builtin_amdgcn_fence(__ATOMIC_RELEASE, "agent");
            asm volatile("s_waitcnt vmcnt(0)" ::: "memory");
            const unsigned og = xb_add(&bar[XB_TOP], 1u);
            const unsigned tg = og / nx;
            if (og + 1u == (tg + 1u) * nx) xb_add(&bar[XB_TOPGEN], 1u);
            else XB_SPIN(xb_ld(&bar[XB_TOPGEN]) == tg, bar);
            __builtin_amdgcn_fence(__ATOMIC_ACQUIRE, "agent");
            xb_add(&bar[XB_XGEN(b.x)], 1u);
            asm volatile("s_waitcnt vmcnt(0)" ::: "memory");
        } else {
            XB_SPIN(xb_ld(&bar[XB_XGEN(b.x)]) == gen, bar);
            __builtin_amdgcn_fence(__ATOMIC_ACQUIRE, "agent");
            asm volatile("s_waitcnt vmcnt(0)" ::: "memory");
        }
    }
    __syncthreads();
}

__device__ __forceinline__ float wave_sum(float v) {
#pragma unroll
    for (int o = 1; o < 64; o <<= 1) v += __shfl_xor(v, o);
    return v;
}
__device__ __forceinline__ float wave_max(float v) {
#pragma unroll
    for (int o = 1; o < 64; o <<= 1) v = fmaxf(v, __shfl_xor(v, o));
    return v;
}
struct Frame {
    LAS unsigned char* lds;
    volatile LAS unsigned* MISC;
    gu32* ctl;
    int tid, lane, wave;
    int vcu, G;
    unsigned char* ws;
    const float* in[30];
    float* out;
};
#define WSP(T_, off) ((T_*)(F.ws + (off)))

__device__ __forceinline__ int perm8(int c) { return (c & ~31) + 16 * ((c >> 2) & 1) + 4 * ((c >> 3) & 3) + (c & 3); }
struct MapP8 { int off; __device__ __forceinline__ int operator()(int n) const { return off + perm8(n); } };
struct MapWin { __device__ __forceinline__ int operator()(int c) const {
    if (c < 512 || c >= 1536) return perm8(c);
    const int base = (c < 1024) ? 512 : 1024, cc = c - base, head = cc >> 6, d = cc & 63, pnq = head >> 2, hh = head & 3, n = d >> 5, dd = d & 31;
    const int wc = 2 * (hh & 1) + (dd >> 4), bj = hh >> 1, j = dd & 15;
    return base + 256 * pnq + 128 * bj + 32 * wc + 16 * n + j; } };
struct MapGU { int e, up; __device__ __forceinline__ int operator()(int f) const { return e * 2048 + (f >> 7) * 256 + up * 128 + perm8(f & 127); } };

template <class RowMap>
__device__ __forceinline__ void p0_transpose_item(const float* W, int K, int N, bf16* WT, LAS float* scr, int item, int lane, const RowMap rm) {
    const int nblk = N / 64, kb = item / nblk, nb = item % nblk, k0 = 64 * kb, n0 = 64 * nb;
    const int lr = lane >> 4, lc = 4 * (lane & 15);
    f32x4 v[16];
#pragma unroll
    for (int i = 0; i < 16; ++i) v[i] = __builtin_nontemporal_load((const GAS f32x4*)(W + (size_t)(k0 + 4 * i + lr) * N + n0 + lc));
#pragma unroll
    for (int i = 0; i < 16; ++i) { LAS float* d = scr + (4 * i + lr) * 65 + lc; d[0] = v[i].x; d[1] = v[i].y; d[2] = v[i].z; d[3] = v[i].w; }
    LDS_WAIT(); asm volatile("" ::: "memory");
    const int c = lane & 7;
#pragma unroll
    for (int j = 0; j < 8; ++j) { const int n = (lane >> 3) + 8 * j; const LAS float* s = scr + (8 * c) * 65 + n;
        v4u o; o.x = pk2(s[0 * 65], s[1 * 65]); o.y = pk2(s[2 * 65], s[3 * 65]); o.z = pk2(s[4 * 65], s[5 * 65]); o.w = pk2(s[6 * 65], s[7 * 65]);
        __builtin_nontemporal_store(o, (GAS v4u*)(WT + (size_t)rm(n0 + n) * K + k0 + 8 * c)); }
    LDS_WAIT(); asm volatile("" ::: "memory");
}

template <class RowMap>
__device__ __forceinline__ void p0_transpose_item_f8(const float* W, int K, int N, unsigned char* WT, LAS float* scr, int item, int lane, const RowMap rm, float wsc) {
    const int nblk = N / 64, kb = item / nblk, nb = item % nblk, k0 = 64 * kb, n0 = 64 * nb;
    const int lr = lane >> 4, lc = 4 * (lane & 15);
    f32x4 v[16];
#pragma unroll
    for (int i = 0; i < 16; ++i) v[i] = __builtin_nontemporal_load((const GAS f32x4*)(W + (size_t)(k0 + 4 * i + lr) * N + n0 + lc));
#pragma unroll
    for (int i = 0; i < 16; ++i) { LAS float* d = scr + (4 * i + lr) * 65 + lc; d[0] = v[i].x * wsc; d[1] = v[i].y * wsc; d[2] = v[i].z * wsc; d[3] = v[i].w * wsc; }
    LDS_WAIT(); asm volatile("" ::: "memory");
    const int c = lane & 3;
#pragma unroll
    for (int j = 0; j < 4; ++j) { const int n = (lane >> 2) + 16 * j; const LAS float* s = scr + (16 * c) * 65 + n;
        v4u o; o.x = pk4_fp8(s[0 * 65], s[1 * 65], s[2 * 65], s[3 * 65]); o.y = pk4_fp8(s[4 * 65], s[5 * 65], s[6 * 65], s[7 * 65]);
        o.z = pk4_fp8(s[8 * 65], s[9 * 65], s[10 * 65], s[11 * 65]); o.w = pk4_fp8(s[12 * 65], s[13 * 65], s[14 * 65], s[15 * 65]);
        __builtin_nontemporal_store(o, (GAS v4u*)(WT + (size_t)rm(n0 + n) * K + k0 + 16 * c)); }
    LDS_WAIT(); asm volatile("" ::: "memory");
}

__device__ __forceinline__ void p0_moe_load(const float* W, int item, int lane, f32x4 (&v)[16]) {
    const int kb = item >> 4, nb = item & 15, k0 = 64 * kb, n0 = 64 * nb, lr = lane >> 4, lc = 4 * (lane & 15);
#pragma unroll
    for (int i = 0; i < 16; ++i) v[i] = __builtin_nontemporal_load((const GAS f32x4*)(W + (size_t)(k0 + 4 * i + lr) * 1024 + n0 + lc));
}
__device__ __forceinline__ void p0_moe_finish(unsigned char* WT, int rowbase, int kind, int item, LAS float* scr, int lane, const f32x4 (&v)[16], float wsc) {
    const int kb = item >> 4, nb = item & 15, k0 = 64 * kb, n0 = 64 * nb, lr = lane >> 4, lc = 4 * (lane & 15);
#pragma unroll
    for (int i = 0; i < 16; ++i) { LAS float* d = scr + (4 * i + lr) * 65 + lc; d[0] = v[i].x * wsc; d[1] = v[i].y * wsc; d[2] = v[i].z * wsc; d[3] = v[i].w * wsc; }
    LDS_WAIT(); asm volatile("" ::: "memory");
    const int c = lane & 3;
#pragma unroll
    for (int j = 0; j < 4; ++j) { const int n = n0 + (lane >> 2) + 16 * j; const LAS float* s = scr + (16 * c) * 65 + (n - n0);
        const int row = rowbase + (kind < 2 ? (n >> 7) * 256 + kind * 128 + perm8(n & 127) : perm8(n));
        v4u o; o.x = pk4_fp8(s[0 * 65], s[1 * 65], s[2 * 65], s[3 * 65]); o.y = pk4_fp8(s[4 * 65], s[5 * 65], s[6 * 65], s[7 * 65]);
        o.z = pk4_fp8(s[8 * 65], s[9 * 65], s[10 * 65], s[11 * 65]); o.w = pk4_fp8(s[12 * 65], s[13 * 65], s[14 * 65], s[15 * 65]);
        __builtin_nontemporal_store(o, (GAS v4u*)(WT + (size_t)row * 1024 + k0 + 16 * c)); }
    LDS_WAIT(); asm volatile("" ::: "memory");
}

constexpr int MOE_ITEMS_ALL = 3 * NE * 256, MOE_ITEMS_P3 = 2048, MOE_ITEMS_P5 = 2048, MOE_ITEMS_P6 = 6144, MOE_ITEMS_P0 = MOE_ITEMS_ALL - MOE_ITEMS_P3 - MOE_ITEMS_P5 - MOE_ITEMS_P6;
__device__ __forceinline__ void p0_moe_range(Frame& F, int first, int count, int gw, int ngw, float wsc) {
    LAS float* scr = (LAS float*)(F.lds + RING_OFF + F.wave * 16640);
    const float* wg = F.in[24]; const float* wu = F.in[26]; const float* wd = F.in[28];
    unsigned char* tgu = WSP(unsigned char, WS_WGU_T); unsigned char* tdn = WSP(unsigned char, WS_WDN_T);
#define P0_DEC(r_, W_, WT_, rb_, kd_, it_) const int mat_##r_ = (first + (r_)) >> 8, it_ = (first + (r_)) & 255, kd_ = mat_##r_ >> 5, e_##r_ = mat_##r_ & 31; \
    const float* W_ = (kd_ == 0 ? wg : (kd_ == 1 ? wu : wd)) + (size_t)e_##r_ * D * FF; unsigned char* WT_ = kd_ < 2 ? tgu : tdn; const int rb_ = kd_ < 2 ? e_##r_ * 2048 : e_##r_ * 1024;
    f32x4 va[16], vb[16]; int r = gw;
    if (r < count) { P0_DEC(r, W0, T0, b0, k0_, i0); (void)T0; (void)b0; (void)k0_; p0_moe_load(W0, i0, F.lane, va); }
    while (r < count) {
        { const int rn = r + ngw; if (rn < count) { P0_DEC(rn, W1, T1, b1, k1_, i1); (void)T1; (void)b1; (void)k1_; p0_moe_load(W1, i1, F.lane, vb); } }
        { P0_DEC(r, W2, T2, b2, k2_, i2); (void)W2; p0_moe_finish(T2, b2, k2_, i2, scr, F.lane, va, wsc); }
        r += ngw; if (r >= count) break;
        { const int rn = r + ngw; if (rn < count) { P0_DEC(rn, W3, T3, b3, k3_, i3); (void)T3; (void)b3; (void)k3_; p0_moe_load(W3, i3, F.lane, va); } }
        { P0_DEC(r, W4, T4, b4, k4_, i4); (void)W4; p0_moe_finish(T4, b4, k4_, i4, scr, F.lane, vb, wsc); }
        r += ngw;
    }
#undef P0_DEC
}
__device__ __forceinline__ void moe_convert_idle(Frame& F, int first, int count) {
    if (F.G != 256) { if (blockIdx.x == 0) { } }
    const int nb = F.G == 256 ? 128 : F.G, bi = F.G == 256 ? (int)blockIdx.x - 128 : (int)blockIdx.x;
    if (bi < 0) return;
    p0_moe_range(F, first, count, bi * NWAVES + F.wave, nb * NWAVES, WSP(float, WS_PAR)[PAR_WSC]);
}

__device__ __forceinline__ void phase0(Frame& F) {
    LAS float* scr = (LAS float*)(F.lds + RING_OFF + F.wave * 16640);
    const int gw = F.vcu * NWAVES + F.wave, NGW = F.G * NWAVES;
#ifdef MOE_F8
    float wsc;
    { float am = 0.f;
      for (int j = F.tid; j < 2048; j += NWAVES * 64) { const size_t o = (size_t)j * 16384 + 37 * (j & 63);
          am = fmaxf(am, fmaxf(fabsf(F.in[24][o]), fmaxf(fabsf(F.in[26][o]), fabsf(F.in[28][o])))); }
      am = wave_max(am); LAS float* red = (LAS float*)(F.lds + LDSCTL_OFF + 64);
      if (F.lane == 0) red[F.wave] = am;
      __syncthreads();
      am = red[0];
#pragma unroll
      for (int w = 1; w < NWAVES; ++w) am = fmaxf(am, red[w]);
      wsc = exp2f(floorf(log2f(448.f / (fmaxf(am, 1e-30f) * 8.f))));
      if (blockIdx.x == 0 && F.tid == 0) WSP(float, WS_PAR)[PAR_WSC] = wsc;
      __syncthreads(); }
#endif
#if defined(G1_F8) || defined(G1_MIX)
    float wsc1;
    { float am = 0.f;
      for (int j = F.tid; j < 2048; j += NWAVES * 64) am = fmaxf(am, fabsf(F.in[9][(size_t)j * 2048 + 37 * (j & 31)]));
      am = wave_max(am); LAS float* red = (LAS float*)(F.lds + LDSCTL_OFF + 64);
      if (F.lane == 0) red[F.wave] = am;
      __syncthreads();
      am = red[0];
#pragma unroll
      for (int w = 1; w < NWAVES; ++w) am = fmaxf(am, red[w]);
      wsc1 = exp2f(floorf(log2f(448.f / (fmaxf(am, 1e-30f) * 8.f))));
      if (blockIdx.x == 0 && F.tid == 0) WSP(float, WS_PAR)[PAR_WSC1] = wsc1;
      __syncthreads(); }
#endif
    constexpr int I_WIN = 16 * 64, I_GLU = 8 * 8, I_SB = 8 * 16, I_AB = 8 * 16, I_OUT = 16 * 16, I_E = 16 * 16;
    constexpr int I_SMALL = I_WIN + I_GLU + I_SB + I_AB + I_OUT, I_MOE = 3 * NE * I_E, I_ADA = 16 * 96;
    constexpr int NITEMS = I_SMALL + I_MOE + I_ADA;
    for (int it = gw; it < NITEMS; it += NGW) {
        int r = it;
#if defined(G1_MIX)
        if (r < I_WIN) { p0_transpose_item(F.in[9], D, INW, WSP(bf16, WS_WIN_T), scr, r, F.lane, MapWin{}); p0_transpose_item_f8(F.in[9], D, INW, WSP(unsigned char, WS_WIN8), scr, r, F.lane, MapWin{}, wsc1); continue; } r -= I_WIN;
#elif defined(G1_F8)
        if (r < I_WIN) { p0_transpose_item_f8(F.in[9], D, INW, WSP(unsigned char, WS_WIN_T), scr, r, F.lane, MapWin{}, wsc1); continue; } r -= I_WIN;
#else
        if (r < I_WIN) { p0_transpose_item(F.in[9], D, INW, WSP(bf16, WS_WIN_T), scr, r, F.lane, MapWin{}); continue; } r -= I_WIN;
#endif
        if (r < I_GLU) { p0_transpose_item(F.in[18], SW, SW, WSP(bf16, WS_WGLU_T), scr, r, F.lane, MapP8{0}); continue; } r -= I_GLU;
        if (r < I_SB) { p0_transpose_item(F.in[19], SW, D, WSP(bf16, WS_WSB_T), scr, r, F.lane, MapP8{0}); continue; } r -= I_SB;
        if (r < I_AB) { p0_transpose_item(F.in[20], AW, D, WSP(bf16, WS_WAB_T), scr, r, F.lane, MapP8{0}); continue; } r -= I_AB;
        if (r < I_OUT) { p0_transpose_item(F.in[21], D, D, WSP(bf16, WS_WOUT_T), scr, r, F.lane, MapP8{0}); continue; } r -= I_OUT;
        if (r < I_MOE) {
#ifdef MOE_F8
            continue;
#endif
            const int mat = r / I_E, item = r % I_E, kind = mat / NE, e = mat % NE;
#ifdef MOE_F8
            if (kind == 0) p0_transpose_item_f8(F.in[24] + (size_t)e * D * FF, D, FF, WSP(unsigned char, WS_WGU_T), scr, item, F.lane, MapGU{e, 0}, wsc);
            else if (kind == 1) p0_transpose_item_f8(F.in[26] + (size_t)e * D * FF, D, FF, WSP(unsigned char, WS_WGU_T), scr, item, F.lane, MapGU{e, 1}, wsc);
            else p0_transpose_item_f8(F.in[28] + (size_t)e * FF * D, FF, D, WSP(unsigned char, WS_WDN_T), scr, item, F.lane, MapP8{e * 1024}, wsc);
#else
            if (kind == 0) p0_transpose_item(F.in[24] + (size_t)e * D * FF, D, FF, WSP(bf16, WS_WGU_T), scr, item, F.lane, MapGU{e, 0});
            else if (kind == 1) p0_transpose_item(F.in[26] + (size_t)e * D * FF, D, FF, WSP(bf16, WS_WGU_T), scr, item, F.lane, MapGU{e, 1});
            else p0_transpose_item(F.in[28] + (size_t)e * FF * D, FF, D, WSP(bf16, WS_WDN_T), scr, item, F.lane, MapP8{e * 1024});
#endif
            continue; }
        r -= I_MOE;
        {
            const int ks = r / 96, cc = r % 96, n = cc * 64 + F.lane;
            const float* cvec = F.in[1]; const float* aw = F.in[3];
            float a0 = 0.f, a1 = 0.f;
            for (int k0 = ks * 64; k0 < ks * 64 + 64; k0 += 16) {
                float w[16];
#pragma unroll
                for (int i = 0; i < 16; ++i) w[i] = __builtin_nontemporal_load(aw + (size_t)(k0 + i) * (6 * D) + n);
#pragma unroll
                for (int i = 0; i < 16; ++i) { const float c0 = cvec[k0 + i], c1 = cvec[D + k0 + i];
                    const float s0 = c0 / (1.f + __expf(-c0)), s1 = c1 / (1.f + __expf(-c1));
                    a0 += s0 * w[i]; a1 += s1 * w[i]; } }
            float* part = WSP(float, WS_ADA);
            part[(ks * 2 + 0) * (6 * D) + n] = a0; part[(ks * 2 + 1) * (6 * D) + n] = a1;
        }
    }
#ifdef MOE_F8
    p0_moe_range(F, 0, MOE_ITEMS_P0, gw, NGW, wsc);
#endif
    const int gt = F.vcu * (NWAVES * 64) + F.tid, NGT = F.G * NWAVES * 64;
    { const int* pos = (const int*)F.in[2]; float* rc = WSP(float, WS_ROPE); float* rs = rc + (size_t)T * 32;
      for (int i = gt; i < T * 32; i += NGT) { const int t = i >> 5, p = i & 31;
          const float invf = exp2f(-(float)p * (13.287712379549449f / 32.f));
          const double ang = (double)pos[t] * (double)invf; double rev = ang * 0.15915494309189535; rev -= floor(rev);
          const float fr = (float)rev;
          rc[i] = __builtin_amdgcn_cosf(fr); rs[i] = __builtin_amdgcn_sinf(fr); } }
    { float* P5 = WSP(float, WS_S5P);
      for (int i = gt; i < NG * NP; i += NGT) { const int g = i >> 6;
          const float dt = __expf(F.in[12][g]); const float lr = F.in[10][i], li = F.in[11][i];
          const float er = __expf(lr * dt); const double ang = (double)li * (double)dt; double rev = ang * 0.15915494309189535; rev -= floor(rev);
          const float cs = __builtin_amdgcn_cosf((float)rev), sn = __builtin_amdgcn_sinf((float)rev);
          float br = er * cs, bi = er * sn;
          P5[i] = br; P5[2048 + i] = bi;
          const float nr = br - 1.f, ni = bi, den = lr * lr + li * li;
          const float qr = (nr * lr + ni * li) / den, qi = (ni * lr - nr * li) / den;
          P5[8192 + i] = qr; P5[8192 + 2048 + i] = qi;
          float pr = br, pi_ = bi;
#pragma unroll
          for (int s = 0; s < 8; ++s) { const float tr = pr * pr - pi_ * pi_, ti = 2.f * pr * pi_; pr = tr; pi_ = ti; }
          P5[4096 + i] = pr; P5[6144 + i] = pi_;
          float* PW = P5 + 131072;
          float wr_ = 1.f, wi_ = 0.f;
#pragma unroll
          for (int k = 0; k <= 16; ++k) { PW[i * 17 + k] = wr_; PW[2048 * 17 + i * 17 + k] = wi_; const float tr = wr_ * br - wi_ * bi, ti = wr_ * bi + wi_ * br; wr_ = tr; wi_ = ti; } }
    }
}

__device__ __forceinline__ void phase1(Frame& F) {
    LAS float* A1 = (LAS float*)(F.lds + RING_OFF); LAS float* A2 = A1 + 2 * D;
    const float* part = WSP(float, WS_ADA); const float* ab = F.in[4]; const float* pg = F.in[5];
    for (int k = F.tid; k < D; k += NWAVES * 64)
#pragma unroll
        for (int b = 0; b < 2; ++b) { float sh = ab[k], sc = ab[D + k];
            for (int ks = 0; ks < 16; ++ks) { sh += part[(ks * 2 + b) * (6 * D) + k]; sc += part[(ks * 2 + b) * (6 * D) + D + k]; }
            A1[b * D + k] = pg[k] * (1.f + sc); A2[b * D + k] = sh; }
    const int gt = F.vcu * (NWAVES * 64) + F.tid, NGT = F.G * NWAVES * 64;
    { float* adaf = WSP(float, WS_ADAF);
      for (int n = gt; n < 2 * 6 * D; n += NGT) { const int b = n / (6 * D), j = n % (6 * D); float a = ab[j];
          for (int ks = 0; ks < 16; ++ks) a += part[(ks * 2 + b) * (6 * D) + j];
          adaf[n] = a; } }
    { float* par = WSP(float, WS_PAR);
      for (int i = gt; i < 32768; i += NGT) { par[PAR_RW + i] = F.in[22][i]; par[PAR_BG + i] = F.in[25][i]; par[PAR_BU + i] = F.in[27][i]; par[PAR_BD + i] = F.in[29][i];
          par[PAR_CRE + i] = F.in[15][i]; par[PAR_CIM + i] = F.in[16][i]; par[PAR_BRE + i] = F.in[13][i]; par[PAR_BIM + i] = F.in[14][i];
          if (i < 1024) { par[PAR_MPG + i] = F.in[6][i]; par[PAR_FPRE + i] = F.in[7][i]; par[PAR_FPOST + i] = F.in[8][i]; }
          if (i < 512) par[PAR_SD + i] = F.in[17][i];
          if (i < 32) par[PAR_RB + i] = F.in[23][i]; } }
    { const float* P5 = WSP(float, WS_S5P); const float* PWr = P5 + 131072; const float* PWi = PWr + 2048 * 17;
      bf16* M1t = WSP(bf16, WS_S5M1);
      for (int i = gt; i < NG * 256 * 256; i += NGT) { const int k = i & 255, n = (i >> 8) & 255, g = i >> 16; float val = 0.f;
          if (n < 128) { const int p = n & 63, gp = g * 64 + p, s_ = k >> 4, ci = k & 15;
              const float qr = P5[8192 + gp], qi = P5[8192 + 2048 + gp], b_r = F.in[13][gp * 16 + ci], b_i = F.in[14][gp * 16 + ci];
              const float bbr = qr * b_r - qi * b_i, bbi = qr * b_i + qi * b_r, wr_ = PWr[gp * 17 + 15 - s_], wi_ = PWi[gp * 17 + 15 - s_];
              val = (n < 64) ? (wr_ * bbr - wi_ * bbi) : (wr_ * bbi + wi_ * bbr); }
          M1t[((size_t)(g * 256 + perm8(n))) * 256 + k] = (bf16)f2bf(val); }
    }
    __syncthreads();
    const int gw = F.vcu * NWAVES + F.wave, NGW = F.G * NWAVES;
    bf16* XN = WSP(bf16, WS_XN);
    for (int m0 = gw * 2; m0 < T; m0 += NGW * 2) {
        const int b = m0 >> 13;
        f32x4 v[2][4];
#pragma unroll
        for (int q = 0; q < 2; ++q) { const GAS f32x4* xr = (const GAS f32x4*)(F.in[0] + (size_t)(m0 + q) * D) + F.lane;
#pragma unroll
            for (int j = 0; j < 4; ++j) v[q][j] = __builtin_nontemporal_load(xr + 64 * j); }
#pragma unroll
        for (int q = 0; q < 2; ++q) { float s = 0.f;
#pragma unroll
            for (int j = 0; j < 4; ++j) s += (v[q][j].x * v[q][j].x + v[q][j].y * v[q][j].y) + (v[q][j].z * v[q][j].z + v[q][j].w * v[q][j].w);
            const float rstd = 1.f / sqrtf(wave_sum(s) * (1.f / D) + NORM_EPS);
#ifdef G1_F8
            GAS unsigned* o4 = (GAS unsigned*)((unsigned char*)XN + (size_t)(m0 + q) * D) + F.lane;
#pragma unroll
            for (int j = 0; j < 4; ++j) { const f32x4 a1 = *(const LAS f32x4*)(A1 + b * D + 4 * F.lane + 256 * j), a2 = *(const LAS f32x4*)(A2 + b * D + 4 * F.lane + 256 * j);
                const f32x4 o = v[q][j] * rstd * a1 + a2;
                o4[64 * j] = pk4_fp8(8.f * o.x, 8.f * o.y, 8.f * o.z, 8.f * o.w); } }
#else
            GAS unsigned long long* o8 = (GAS unsigned long long*)(XN + (size_t)(m0 + q) * D) + F.lane;
#pragma unroll
            for (int j = 0; j < 4; ++j) { const f32x4 a1 = *(const LAS f32x4*)(A1 + b * D + 4 * F.lane + 256 * j), a2 = *(const LAS f32x4*)(A2 + b * D + 4 * F.lane + 256 * j);
                const f32x4 o = v[q][j] * rstd * a1 + a2;
                o8[64 * j] = (unsigned long long)pk2(o.x, o.y) | ((unsigned long long)pk2(o.z, o.w) << 32);
#ifdef G1_MIX
                ((GAS unsigned*)(WSP(unsigned char, WS_XN8) + (size_t)(m0 + q) * D) + F.lane)[64 * j] = pk4_fp8(8.f * o.x, 8.f * o.y, 8.f * o.z, 8.f * o.w);
#endif
            } }
#endif
    }
    __syncthreads();
}

struct EpiG1 {
    bf16 *UA, *Q, *K, *V, *VT, *GSp, *GAp; const float *rc, *rs; float* km; const float* wscp; bool f8;
    __device__ __forceinline__ void operator()(const pg8::f32x4 (&acc0)[2][2][4][2], const pg8::Unit& u, int wr, int wc, int fr, int fq) const {
        pg8::f32x4 (&acc)[2][2][4][2] = const_cast<pg8::f32x4 (&)[2][2][4][2]>(acc0);
#if defined(G1_F8) || defined(G1_MIX)
        if (f8) { const float s_ = 0.125f / *wscp;
#pragma unroll
            for (int a = 0; a < 2; ++a)
#pragma unroll
                for (int b = 0; b < 2; ++b)
#pragma unroll
                    for (int m = 0; m < 4; ++m)
#pragma unroll
                        for (int n = 0; n < 2; ++n) acc[a][b][m][n] = acc[a][b][m][n] * s_; }
#endif
        asm volatile("" : "+v"(fr), "+v"(fq));
        const int pn = u.pn, row0 = u.pm * 256 + wr * 64 + fr;
        if (pn < 2) {
#pragma unroll
            for (int ai = 0; ai < 2; ++ai)
#pragma unroll
                for (int m = 0; m < 4; ++m) { const int t = row0 + ai * 128 + m * 16, b = t >> 13, tt = t & (SEQ - 1), c = tt >> 4, s = tt & 15;
#pragma unroll
                    for (int bj = 0; bj < 2; ++bj) { const int ch = pn * 256 + bj * 128 + wc * 32 + 8 * fq, g = ch >> 4, ci = ch & 15;
                        const pg8::f32x4 v0 = acc[ai][bj][m][0], v1 = acc[ai][bj][m][1];
                        v4u w; w.x = pk2(v0[0], v0[1]); w.y = pk2(v0[2], v0[3]); w.z = pk2(v1[0], v1[1]); w.w = pk2(v1[2], v1[3]);
                        st16(UA + ((size_t)(g * 1024 + b * 512 + c) * 384 + 16 * s + ci), w); } }
        } else if (pn < 6) {
            const bool isk = pn >= 4; bf16* X = isk ? K : Q; const float sc = isk ? 1.f : C2;
            const int p0 = 16 * (wc & 1) + 4 * fq;
#pragma unroll
            for (int bj = 0; bj < 2; ++bj) {
                const int head = 4 * (pn & 1) + 2 * bj + (wc >> 1);
                int rowb = row0; asm volatile("" : "+v"(rowb));
                float ks[2][4];
#pragma unroll
                for (int b = 0; b < 2; ++b)
#pragma unroll
                    for (int i = 0; i < 4; ++i) ks[b][i] = 0.f;
#pragma unroll
                for (int ai = 0; ai < 2; ++ai)
#pragma unroll
                    for (int m = 0; m < 4; ++m) { const int t = rowb + ai * 128 + m * 16;
                        const pg8::f32x4 cs = *(const pg8::f32x4*)(rc + (size_t)t * 32 + p0), sn = *(const pg8::f32x4*)(rs + (size_t)t * 32 + p0);
                        const pg8::f32x4 t1 = acc[ai][bj][m][0], t2 = acc[ai][bj][m][1];
                        const pg8::f32x4 o1 = t1 * cs - t2 * sn, o2 = t2 * cs + t1 * sn;
                        v2u w1, w2; w1.x = pk2(o1[0] * sc, o1[1] * sc); w1.y = pk2(o1[2] * sc, o1[3] * sc); w2.x = pk2(o2[0] * sc, o2[1] * sc); w2.y = pk2(o2[2] * sc, o2[3] * sc);
                        bf16* dst = X + (size_t)t * AW + head * 64 + p0;
                        st8(dst, w1); st8(dst + 32, w2);
#pragma unroll
                        for (int i = 0; i < 4; ++i) { ks[0][i] += o1[i]; ks[1][i] += o2[i]; }
                        __builtin_amdgcn_sched_barrier(0); }
                if (isk) {
                    const int b = u.pm >> 5, blk = u.pm & 31;
#pragma unroll
                    for (int n = 0; n < 2; ++n)
#pragma unroll
                        for (int i = 0; i < 4; ++i) { float v = ks[n][i];
                            v += __shfl_xor(v, 1); v += __shfl_xor(v, 2); v += __shfl_xor(v, 4); v += __shfl_xor(v, 8);
                            if (fr == 0) atomicAdd(km + ((size_t)((b * NH + head) * NBLK + blk) * HD + 32 * n + p0 + i), v); }
                }
            }
        } else if (pn < 8) {
#pragma unroll
            for (int ai = 0; ai < 2; ++ai)
#pragma unroll
                for (int m = 0; m < 4; ++m) { const int t = row0 + ai * 128 + m * 16, b = t >> 13, tt = t & (SEQ - 1);
#pragma unroll
                    for (int bj = 0; bj < 2; ++bj) { const int cv = (pn - 6) * 256 + bj * 128 + wc * 32 + 8 * fq, head = cv >> 6, d = cv & 63;
                        const pg8::f32x4 v0 = acc[ai][bj][m][0], v1 = acc[ai][bj][m][1];
                        v4u w; w.x = pk2(v0[0], v0[1]); w.y = pk2(v0[2], v0[3]); w.z = pk2(v1[0], v1[1]); w.w = pk2(v1[2], v1[3]);
                        bf16* vt = VT + ((size_t)((b * NH + head) * HD + d) * SEQ + tt);
                        vt[0 * SEQ] = (bf16)(w.x & 0xffff); vt[1 * SEQ] = (bf16)(w.x >> 16); vt[2 * SEQ] = (bf16)(w.y & 0xffff); vt[3 * SEQ] = (bf16)(w.y >> 16);
                        vt[4 * SEQ] = (bf16)(w.z & 0xffff); vt[5 * SEQ] = (bf16)(w.z >> 16); vt[6 * SEQ] = (bf16)(w.w & 0xffff); vt[7 * SEQ] = (bf16)(w.w >> 16); } }
        } else {
            bf16* Gp = (pn < 12) ? GSp : GAp; const int cb = ((pn - 8) & 3) * 256;
#pragma unroll
            for (int ai = 0; ai < 2; ++ai)
#pragma unroll
                for (int m = 0; m < 4; ++m) { const int t = row0 + ai * 128 + m * 16;
#pragma unroll
                    for (int bj = 0; bj < 2; ++bj) { const int col = cb + bj * 128 + wc * 32 + 8 * fq;
                        const pg8::f32x4 v0 = acc[ai][bj][m][0], v1 = acc[ai][bj][m][1];
                        v4u w; w.x = pk2(sigmoidf_(v0[0]), sigmoidf_(v0[1])); w.y = pk2(sigmoidf_(v0[2]), sigmoidf_(v0[3]));
                        w.z = pk2(sigmoidf_(v1[0]), sigmoidf_(v1[1])); w.w = pk2(sigmoidf_(v1[2]), sigmoidf_(v1[3]));
                        __builtin_nontemporal_store(w, (v4u*)(Gp + (size_t)t * D + col)); } }
        }
    }
};

template <int MODE> struct EpiEw {
    bf16* O; const bf16* X1; const bf16* X2; float* Of; int ld;
    __device__ __forceinline__ void operator()(const pg8::f32x4 (&acc)[2][2][4][2], const pg8::Unit& u, int wr, int wc, int fr, int fq) const {
        const int row0 = u.pm * 256 + wr * 64 + fr, col0 = u.pn * 256 + wc * 32 + 8 * fq;
#pragma unroll
        for (int ai = 0; ai < 2; ++ai)
#pragma unroll
            for (int m = 0; m < 4; ++m) { const size_t rb = (size_t)(row0 + ai * 128 + m * 16) * ld + col0;
#pragma unroll
                for (int bj = 0; bj < 2; ++bj) { const size_t off = rb + bj * 128;
                    const pg8::f32x4 v0 = acc[ai][bj][m][0], v1 = acc[ai][bj][m][1];
                    if (MODE == 3) { *(pg8::f32x4*)(Of + off) = v0; *(pg8::f32x4*)(Of + off + 4) = v1; }
                    else if (MODE == 4) { v4u w; w.x = pk2(v0[0], v0[1]); w.y = pk2(v0[2], v0[3]); w.z = pk2(v1[0], v1[1]); w.w = pk2(v1[2], v1[3]); st16(O + off, w); }
                    else {
                        const v4u x = __builtin_nontemporal_load((const v4u*)(X1 + off));
                        float r[8] = {v0[0], v0[1], v0[2], v0[3], v1[0], v1[1], v1[2], v1[3]};
                        const float xv[8] = {bflo(x.x), bfhi(x.x), bflo(x.y), bfhi(x.y), bflo(x.z), bfhi(x.z), bflo(x.w), bfhi(x.w)};
                        if (MODE == 0) {
#pragma unroll
                            for (int i = 0; i < 8; ++i) r[i] = xv[i] * sigmoidf_(r[i]);
                        } else if (MODE == 1) {
#pragma unroll
                            for (int i = 0; i < 8; ++i) r[i] = xv[i] * r[i];
                        } else {
                            const v4u y = __builtin_nontemporal_load((const v4u*)(X2 + off));
                            const float yv[8] = {bflo(y.x), bfhi(y.x), bflo(y.y), bfhi(y.y), bflo(y.z), bfhi(y.z), bflo(y.w), bfhi(y.w)};
#pragma unroll
                            for (int i = 0; i < 8; ++i) r[i] = yv[i] + xv[i] * r[i];
                        }
                        v4u w; w.x = pk2(r[0], r[1]); w.y = pk2(r[2], r[3]); w.z = pk2(r[4], r[5]); w.w = pk2(r[6], r[7]);
                        st16(O + off, w); } } }
    }
};

typedef short bf16x8 __attribute__((ext_vector_type(8)));
typedef float f32x16 __attribute__((ext_vector_type(16)));
constexpr size_t WS_ALIST = 456 * MiB;
constexpr size_t WS_OP01 = 224 * MiB;
constexpr size_t WS_OP23 = 472 * MiB;
constexpr size_t WS_LSE = 504 * MiB;
constexpr int CW_BCNT = 12288;
constexpr int ALCAP = 8192;

__device__ __forceinline__ void attn_gate(Frame& F) {
    const int gw = F.vcu * NWAVES + F.wave, NGW = F.G * NWAVES, L = F.lane;
    const bf16* Q = WSP(bf16, WS_Q); const float* km = (const float*)(F.ctl + CW_KM);
    unsigned* bcnt = (unsigned*)(F.ctl + CW_BCNT); unsigned* list = WSP(unsigned, WS_ALIST); float* lse = WSP(float, WS_LSE);
    LAS float* kml = (LAS float*)(F.lds);
    for (int w0 = F.vcu * NWAVES; w0 < BATCH * NH * (SEQ / 64); w0 += NGW) {
        const int w = w0 + F.wave, bh = w0 >> 7;
        __syncthreads();
        { const f32x4 x = *(const f32x4*)(km + (size_t)bh * NBLK * HD + F.tid * 4); *(LAS f32x4*)(kml + F.tid * 4) = x; }
        __syncthreads();
        const int b = bh >> 3, h = bh & 7, tt = (w & 127) * 64 + L, t = b * SEQ + tt, blk = __builtin_amdgcn_readfirstlane(tt >> 8);
        float q[64];
        { const v4u* qp = (const v4u*)(Q + (size_t)t * AW + h * 64);
#pragma unroll
          for (int i = 0; i < 8; ++i) { const v4u x = qp[i]; q[8 * i] = bflo(x.x); q[8 * i + 1] = bfhi(x.x); q[8 * i + 2] = bflo(x.y); q[8 * i + 3] = bfhi(x.y);
              q[8 * i + 4] = bflo(x.z); q[8 * i + 5] = bfhi(x.z); q[8 * i + 6] = bflo(x.w); q[8 * i + 7] = bfhi(x.w); } }
        float v0 = -3e38f, v1 = -3e38f, v2 = -3e38f; int i0 = -1, i1 = -1, i2 = -1;
        for (int j = 0; j < blk; ++j) { const LAS float* kp = kml + j * HD; float g = 0.f;
#pragma unroll
            for (int d = 0; d < 64; d += 4) { const f32x4 k4 = *(const LAS f32x4*)(kp + d); g += q[d] * k4[0]; g += q[d + 1] * k4[1]; g += q[d + 2] * k4[2]; g += q[d + 3] * k4[3]; }
            if (g > v0) { v2 = v1; i2 = i1; v1 = v0; i1 = i0; v0 = g; i0 = j; }
            else if (g > v1) { v2 = v1; i2 = i1; v1 = g; i1 = j; }
            else if (g > v2) { v2 = g; i2 = j; } }
        float* lp = lse + ((size_t)t * NH + h) * 4;
        if (i0 < 0) lp[0] = -1e30f; if (i1 < 0) lp[1] = -1e30f; if (i2 < 0) lp[2] = -1e30f;
        int mycnt = 0;
        for (int j = 0; j < blk; ++j) { const bool sel = (i0 == j) || (i1 == j) || (i2 == j); const unsigned long long mask = __ballot(sel); if (L == j) mycnt = __popcll(mask); }
        unsigned mybase = 0u;
        if (mycnt > 0) mybase = __hip_atomic_fetch_add(bcnt + bh * NBLK + L, (unsigned)mycnt, RLX_AGENT);
        for (int j = 0; j < blk; ++j) {
            const bool sel = (i0 == j) || (i1 == j) || (i2 == j);
            const unsigned long long mask = __ballot(sel);
            const unsigned base = (unsigned)__builtin_amdgcn_readlane((int)mybase, j);
            if (sel) { const unsigned pos = base + (unsigned)__popcll(mask & ((1ull << L) - 1ull)); const unsigned slot = (i0 == j) ? 0u : ((i1 == j) ? 1u : 2u);
                list[(size_t)(bh * NBLK + j) * ALCAP + pos] = ((unsigned)tt << 2) | slot; }
        }
    }
    __syncthreads();
}

__device__ __forceinline__ unsigned cvtpk(float lo, float hi) { typedef float f32x2_t __attribute__((ext_vector_type(2))); typedef __bf16 bf16x2_t __attribute__((ext_vector_type(2)));
    f32x2_t v = {lo, hi}; bf16x2_t r = __builtin_convertvector(v, bf16x2_t); return __builtin_bit_cast(unsigned, r); }

constexpr int AT_KROW = 144, AT_VROW = 520, AT_KOFF = 0, AT_VOFF = 256 * AT_KROW;
__device__ __forceinline__ void attn_item(Frame& F, int b, int h, int j, bool own, const unsigned* lst, int nvalid) {
    const int tid = F.tid, L = F.lane, r = L & 31, hh = L >> 5, wv = F.wave;
    LAS unsigned char* Kl = F.lds + AT_KOFF; LAS unsigned char* Vl = F.lds + AT_VOFF;
    const bf16* Kg = WSP(bf16, WS_K) + ((size_t)(b * SEQ + j * 256)) * AW + h * 64;
    const bf16* Vg = WSP(bf16, WS_VT) + ((size_t)((b * NH + h) * HD)) * SEQ + j * 256;
    v4u kr[4], vr[4];
#pragma unroll
    for (int i = 0; i < 4; ++i) { const int idx = tid + 512 * i; kr[i] = *(const v4u*)(Kg + (size_t)(idx >> 3) * AW + (idx & 7) * 8); vr[i] = *(const v4u*)(Vg + (size_t)(idx >> 5) * SEQ + (idx & 31) * 8); }
    const int qi = wv * 32 + r; const bool valid = qi < nvalid;
    unsigned ent; if (own) ent = ((unsigned)(j * 256 + qi) << 2) | 3u; else ent = lst[valid ? qi : 0];
    const int tt = (int)(ent >> 2), slot = (int)(ent & 3u), t = b * SEQ + tt;
    bf16x8 qf[4];
    { const bf16* qp = WSP(bf16, WS_Q) + (size_t)t * AW + h * 64 + hh * 8;
#pragma unroll
      for (int d0 = 0; d0 < 4; ++d0) qf[d0] = *(const bf16x8*)(qp + d0 * 16); }
#pragma unroll
    for (int i = 0; i < 4; ++i) { const int idx = tid + 512 * i; *(LAS v4u*)(Kl + (idx >> 3) * AT_KROW + (idx & 7) * 16) = kr[i]; *(LAS v4u*)(Vl + (idx >> 5) * AT_VROW + (idx & 31) * 16) = vr[i]; }
    __syncthreads();
#ifdef ATT_STAGGER
    if (wv >= 4) __builtin_amdgcn_s_sleep(ATT_STAGGER);
#endif
#ifdef ATT_REP_COMPUTE
    for (int arep = 0; arep < 2; ++arep)
#endif
    if (wv * 32 < nvalid) {
        float m = -1e30f, l = 0.f; f32x16 O0 = {}, O1 = {};
        const int qrel = tt & 255;
#pragma unroll
        for (int hk = 0; hk < 2; ++hk) {
            if (own && hk * 4 > wv) continue;
            f32x16 S[4];
#pragma unroll
            for (int kt = 0; kt < 4; ++kt) S[kt] = (f32x16){};
#pragma unroll
            for (int d0 = 0; d0 < 4; ++d0) {
#pragma unroll
                for (int kt = 0; kt < 4; ++kt) { const bf16x8 kf = *(const LAS bf16x8*)(Kl + (hk * 128 + kt * 32 + r) * AT_KROW + d0 * 32 + hh * 16);
                    S[kt] = __builtin_amdgcn_mfma_f32_32x32x16_bf16(kf, qf[d0], S[kt], 0, 0, 0); }
                if (d0 & 1) __builtin_amdgcn_sched_barrier(0); }
            if (own) {
                asm volatile("; causal masking (own block only)" ::: "memory");
#pragma unroll
                for (int kt = 0; kt < 4; ++kt)
#pragma unroll
                    for (int rg = 0; rg < 16; ++rg) { const int key = hk * 128 + kt * 32 + (rg & 3) + 8 * (rg >> 2) + 4 * hh; if (key > qrel) S[kt][rg] = -1e30f; } }
            float mx = S[0][0];
#pragma unroll
            for (int kt = 0; kt < 4; ++kt)
#pragma unroll
                for (int rg = 0; rg < 16; ++rg) mx = fmaxf(mx, S[kt][rg]);
            mx = fmaxf(mx, __shfl_xor(mx, 32));
            const float mn = fmaxf(m, mx), alpha = __builtin_amdgcn_exp2f(m - mn); m = mn; l *= alpha;
#pragma unroll
            for (int rg = 0; rg < 16; ++rg) { O0[rg] *= alpha; O1[rg] *= alpha; }
            float ls = 0.f;
#pragma unroll
            for (int kt = 0; kt < 4; ++kt) {
                unsigned pw[8];
#pragma unroll
                for (int rg = 0; rg < 16; rg += 2) { const float p0 = __builtin_amdgcn_exp2f(S[kt][rg] - mn), p1 = __builtin_amdgcn_exp2f(S[kt][rg + 1] - mn); ls += p0 + p1; pw[rg >> 1] = cvtpk(p0, p1); }
#pragma unroll
                for (int s = 0; s < 2; ++s) {
                    const v4u pv = {pw[4 * s], pw[4 * s + 1], pw[4 * s + 2], pw[4 * s + 3]}; const bf16x8 pf = __builtin_bit_cast(bf16x8, pv);
                    const int kb = (hk * 128 + kt * 32 + 16 * s + 4 * hh) * 2;
                    { const LAS unsigned char* vp = Vl + r * AT_VROW + kb; const v2u lo = *(const LAS v2u*)vp, hi = *(const LAS v2u*)(vp + 16);
                      const v4u vv = {lo.x, lo.y, hi.x, hi.y}; O0 = __builtin_amdgcn_mfma_f32_32x32x16_bf16(__builtin_bit_cast(bf16x8, vv), pf, O0, 0, 0, 0); }
                    { const LAS unsigned char* vp = Vl + (32 + r) * AT_VROW + kb; const v2u lo = *(const LAS v2u*)vp, hi = *(const LAS v2u*)(vp + 16);
                      const v4u vv = {lo.x, lo.y, hi.x, hi.y}; O1 = __builtin_amdgcn_mfma_f32_32x32x16_bf16(__builtin_bit_cast(bf16x8, vv), pf, O1, 0, 0, 0); } } }
            l += ls;
        }
        l += __shfl_xor(l, 32);
        if (valid) {
            const float rl = 1.f / l;
            bf16* op = (slot < 2 ? WSP(bf16, WS_OP01) + (((size_t)t * NH + h) * 2 + slot) * 64 : WSP(bf16, WS_OP23) + (((size_t)t * NH + h) * 2 + (slot - 2)) * 64) + 4 * hh;
#pragma unroll
            for (int g4 = 0; g4 < 4; ++g4) { v2u w0, w1; w0.x = cvtpk(O0[4 * g4] * rl, O0[4 * g4 + 1] * rl); w0.y = cvtpk(O0[4 * g4 + 2] * rl, O0[4 * g4 + 3] * rl);
                w1.x = cvtpk(O1[4 * g4] * rl, O1[4 * g4 + 1] * rl); w1.y = cvtpk(O1[4 * g4 + 2] * rl, O1[4 * g4 + 3] * rl);
                *(v2u*)(op + 8 * g4) = w0; *(v2u*)(op + 32 + 8 * g4) = w1; }
            if (hh == 0) WSP(float, WS_LSE)[((size_t)t * NH + h) * 4 + slot] = m + log2f(l);
        }
    }
    __syncthreads();
}
__device__ __forceinline__ void attn_items(Frame& F) {
    LAS int* pre = (LAS int*)(F.lds + 72 * 1024);
    const unsigned* bcnt = (const unsigned*)(F.ctl + CW_BCNT);
    LAS int* cntl = pre + 520;
    for (int i = F.tid; i < 512; i += NWAVES * 64) cntl[i] = (int)__hip_atomic_load((gu32*)(F.ctl + CW_BCNT) + i, RLX_AGENT);
    __syncthreads();
    if (F.wave == 0) {
        int c8[8], s = 0;
#pragma unroll
        for (int k = 0; k < 8; ++k) { c8[k] = (cntl[F.lane * 8 + k] + 255) >> 8; s += c8[k]; }
        int inc = s;
#pragma unroll
        for (int o = 1; o < 64; o <<= 1) { const int v = __shfl_up(inc, o); if (F.lane >= o) inc += v; }
        int run = inc - s;
#pragma unroll
        for (int k = 0; k < 8; ++k) { pre[F.lane * 8 + k] = run; run += c8[k]; }
        if (F.lane == 63) pre[512] = run; }
    __syncthreads();
    const int total = 512 + pre[512];
    for (int it = (int)blockIdx.x; it < total; it += F.G) {
        int bh, j, n; bool own; const unsigned* lst;
        if (it < 512) { bh = it >> 5; j = it & 31; own = true; lst = nullptr; n = 256; }
        else { const int s = it - 512; int lo = 0, hi = 512;
            while (hi - lo > 1) { const int mid = (lo + hi) >> 1; if (pre[mid] <= s) lo = mid; else hi = mid; }
            const int bucket = lo, tile = s - pre[bucket]; n = cntl[bucket] - tile * 256; n = n > 256 ? 256 : n; bh = bucket >> 5; j = bucket & 31; own = false;
            lst = WSP(unsigned, WS_ALIST) + (size_t)bucket * ALCAP + tile * 256; }
        const int b_ = __builtin_amdgcn_readfirstlane(bh >> 3), h_ = __builtin_amdgcn_readfirstlane(bh & 7), j_ = __builtin_amdgcn_readfirstlane(j), n_ = __builtin_amdgcn_readfirstlane(n);
        attn_item(F, b_, h_, j_, own, lst, n_);
    }
}
__device__ __forceinline__ void attn_combine(Frame& F) {
    if (F.G == 256 && blockIdx.x < 128) return;
    const int nb = F.G == 256 ? 128 : F.G, bi = F.G == 256 ? (int)blockIdx.x - 128 : F.vcu;
    const int gw = bi * NWAVES + F.wave, NGW = nb * NWAVES, L = F.lane, h = L >> 3, ch = L & 7;
    const float* lse = WSP(float, WS_LSE); bf16* YA = WSP(bf16, WS_YA);
    for (int t = gw; t < T; t += NGW) {
        const size_t th = (size_t)t * NH + h;
        const f32x4 ls = *(const f32x4*)(lse + th * 4);
        const float mx = fmaxf(fmaxf(ls[0], ls[1]), fmaxf(ls[2], ls[3]));
        const float w0 = __builtin_amdgcn_exp2f(ls[0] - mx), w1 = __builtin_amdgcn_exp2f(ls[1] - mx), w2 = __builtin_amdgcn_exp2f(ls[2] - mx), w3 = __builtin_amdgcn_exp2f(ls[3] - mx), inv = 1.f / (w0 + w1 + w2 + w3);
        const v4u a0 = __builtin_nontemporal_load((const v4u*)(WSP(bf16, WS_OP01) + (th * 2 + 0) * 64 + ch * 8)), a1 = __builtin_nontemporal_load((const v4u*)(WSP(bf16, WS_OP01) + (th * 2 + 1) * 64 + ch * 8));
        const v4u a2 = __builtin_nontemporal_load((const v4u*)(WSP(bf16, WS_OP23) + (th * 2 + 0) * 64 + ch * 8)), a3 = __builtin_nontemporal_load((const v4u*)(WSP(bf16, WS_OP23) + (th * 2 + 1) * 64 + ch * 8));
        float o[8];
        const unsigned x0[4] = {a0.x, a0.y, a0.z, a0.w}, x1[4] = {a1.x, a1.y, a1.z, a1.w}, x2[4] = {a2.x, a2.y, a2.z, a2.w}, x3[4] = {a3.x, a3.y, a3.z, a3.w};
#pragma unroll
        for (int i = 0; i < 4; ++i) {
            float lo_ = w3 * bflo(x3[i]), hi_ = w3 * bfhi(x3[i]);
            if (ls[0] > -1e29f) { lo_ += w0 * bflo(x0[i]); hi_ += w0 * bfhi(x0[i]); }
            if (ls[1] > -1e29f) { lo_ += w1 * bflo(x1[i]); hi_ += w1 * bfhi(x1[i]); }
            if (ls[2] > -1e29f) { lo_ += w2 * bflo(x2[i]); hi_ += w2 * bfhi(x2[i]); }
            o[2 * i] = lo_ * inv; o[2 * i + 1] = hi_ * inv; }
        v4u w; w.x = cvtpk(o[0], o[1]); w.y = cvtpk(o[2], o[3]); w.z = cvtpk(o[4], o[5]); w.w = cvtpk(o[6], o[7]);
        *(v4u*)(YA + (size_t)t * AW + h * 64 + ch * 8) = w;
    }
}
struct S5Order { static constexpr bool GATHER = false; int G, c;
    __device__ __forceinline__ void a_ready(const pg8::Unit&) const {}
    __device__ __forceinline__ void done(const pg8::Unit&) const {}
    __device__ __forceinline__ bool next(int i, pg8::Unit& u) const { const int L = i * G + c; if (L >= NG * 4) return false; const int g = L >> 2, rt = L & 3;
        u.arow = g * 1024 + rt * 256; u.brow = g * 256; u.pm = rt; u.pn = 0; u.e = g; u.nrow = 256; u.kind = 0; u.aux = 0; return true; } };
struct EpiS5A { float* E;
    __device__ __forceinline__ void operator()(const pg8::f32x4 (&acc)[2][2][4][2], const pg8::Unit& u, int wr, int wc, int fr, int fq) const {
        asm volatile("" : "+v"(fr), "+v"(fq));
#pragma unroll
        for (int ai = 0; ai < 2; ++ai)
#pragma unroll
            for (int m = 0; m < 4; ++m) { float* p = E + (size_t)(u.arow + ai * 128 + wr * 64 + m * 16 + fr) * 128 + wc * 32 + 8 * fq;
                *(pg8::f32x4*)p = acc[ai][0][m][0]; *(pg8::f32x4*)(p + 4) = acc[ai][0][m][1]; }
    }
};
struct EpiS5C { bf16* YG;
    __device__ __forceinline__ void operator()(const pg8::f32x4 (&acc)[2][2][4][2], const pg8::Unit& u, int wr, int wc, int fr, int fq) const {
        asm volatile("" : "+v"(fr), "+v"(fq));
        const int g = u.e, n0 = wc * 32 + 8 * fq, t0 = n0 >> 4, co0 = n0 & 15;
#pragma unroll
        for (int ai = 0; ai < 2; ++ai)
#pragma unroll
            for (int m = 0; m < 4; ++m) { const int row = u.pm * 256 + ai * 128 + wr * 64 + m * 16 + fr, b = row >> 9, c = row & 511;
                bf16* yp = YG + (size_t)(b * SEQ + 16 * c + t0) * SW + 16 * g + co0;
#pragma unroll
                for (int bj = 0; bj < 2; ++bj) {
                    const pg8::f32x4 v0 = acc[ai][bj][m][0], v1 = acc[ai][bj][m][1];
                    v4u w; w.x = pk2(gelu_tanh(v0[0]), gelu_tanh(v0[1])); w.y = pk2(gelu_tanh(v0[2]), gelu_tanh(v0[3]));
                    w.z = pk2(gelu_tanh(v1[0]), gelu_tanh(v1[1])); w.w = pk2(gelu_tanh(v1[2]), gelu_tanh(v1[3]));
                    *(v4u*)(yp + (size_t)bj * 8 * SW) = w; }
                __builtin_amdgcn_sched_barrier(0); }
    }
};
__device__ __forceinline__ void s5_fill_kt(Frame& F) {
    const int gt = F.vcu * (NWAVES * 64) + F.tid, NGT = F.G * NWAVES * 64;
    const float* P5 = WSP(float, WS_S5P); const float* PWr = P5 + 131072; const float* PWi = PWr + 2048 * 17; const float* par = WSP(float, WS_PAR);
    float* KT = WSP(float, WS_S5KT);
    for (int i = gt; i < NG * 16 * 256; i += NGT) { const int ci = i & 15, co = (i >> 4) & 15, tau = (i >> 8) & 15, g = i >> 12; float a = 0.f;
#pragma unroll 8
        for (int p = 0; p < 64; ++p) { const int gp = g * 64 + p;
            const float qr = P5[8192 + gp], qi = P5[8192 + 2048 + gp], b_r = par[PAR_BRE + gp * 16 + ci], b_i = par[PAR_BIM + gp * 16 + ci];
            const float bbr = qr * b_r - qi * b_i, bbi = qr * b_i + qi * b_r, wr_ = PWr[gp * 17 + tau], wi_ = PWi[gp * 17 + tau];
            const float xr = wr_ * bbr - wi_ * bbi, xi = wr_ * bbi + wi_ * bbr;
            const float cr = par[PAR_CRE + (g * 16 + co) * 64 + p], ci_ = par[PAR_CIM + (g * 16 + co) * 64 + p];
            a += cr * xr - ci_ * xi; }
        KT[i] = a; }
}
__device__ __forceinline__ void s5_fill_wc(Frame& F) {
    const int gw = F.vcu * NWAVES + F.wave, NGW = F.G * NWAVES, L = F.lane;
    const float* P5 = WSP(float, WS_S5P); const float* PWr = P5 + 131072; const float* PWi = PWr + 2048 * 17; const float* KT = WSP(float, WS_S5KT); const float* par = WSP(float, WS_PAR);
    bf16* Wc = WSP(bf16, WS_S5WC);
#pragma unroll 2
    for (int r = gw; r < NG * 256; r += NGW) { const int n = r & 255, g = r >> 8, t = n >> 4, co = n & 15, ci = L & 15, gp = g * 64 + L;
        float v[6];
#pragma unroll
        for (int kk = 0; kk < 4; ++kk) { const int s_ = (L >> 4) + 4 * kk; v[kk] = (s_ <= t) ? KT[((g * 16 + (t - s_)) * 16 + co) * 16 + ci] : 0.f;
            if (s_ == t && ci == co) v[kk] += par[PAR_SD + g * 16 + co]; }
        { const float cr = par[PAR_CRE + (g * 16 + co) * 64 + L], ci_ = par[PAR_CIM + (g * 16 + co) * 64 + L], wr_ = PWr[gp * 17 + t + 1], wi_ = PWi[gp * 17 + t + 1];
          v[4] = cr * wr_ - ci_ * wi_; v[5] = -(cr * wi_ + ci_ * wr_); }
        bf16* row = Wc + ((size_t)(g * 256 + perm8(n))) * 384 + L;
#pragma unroll
        for (int kk = 0; kk < 6; ++kk) row[64 * kk] = (bf16)f2bf(v[kk]); }
}
__device__ __forceinline__ void s5_carry(Frame& F) {
    const float* P5 = WSP(float, WS_S5P); const float* PWr = P5 + 131072; const float* PWi = PWr + 2048 * 17; const float* E = WSP(float, WS_S5E); bf16* UA = WSP(bf16, WS_UA);
    LAS float* Z = (LAS float*)(F.lds);
    const int seg = F.wave, p = F.lane;
    for (int bg = F.vcu; bg < BATCH * NG; bg += F.G) { const int b = bg / NG, g = bg % NG, gp = g * 64 + p;
        const float ar = PWr[gp * 17 + 16], ai = PWi[gp * 17 + 16];
        const size_t row0 = (size_t)g * 1024 + b * 512 + seg * 64;
        float zr = 0.f, zi = 0.f;
        for (int c0 = 0; c0 < 64; c0 += 8) { float er[8], ei[8];
#pragma unroll
            for (int k = 0; k < 8; ++k) { er[k] = E[(row0 + c0 + k) * 128 + p]; ei[k] = E[(row0 + c0 + k) * 128 + 64 + p]; }
#pragma unroll
            for (int k = 0; k < 8; ++k) { const float nr = ar * zr - ai * zi + er[k], ni = ar * zi + ai * zr + ei[k]; zr = nr; zi = ni; } }
        Z[(seg * 64 + p) * 2] = zr; Z[(seg * 64 + p) * 2 + 1] = zi;
        __syncthreads();
        if (seg == 0) { float br = ar, bi = ai;
#pragma unroll
            for (int k = 0; k < 6; ++k) { const float tr = br * br - bi * bi, ti = 2.f * br * bi; br = tr; bi = ti; }
            float sr = 0.f, si = 0.f;
            for (int sg = 0; sg < 8; ++sg) { const float xr = Z[(sg * 64 + p) * 2], xi = Z[(sg * 64 + p) * 2 + 1]; Z[(sg * 64 + p) * 2] = sr; Z[(sg * 64 + p) * 2 + 1] = si;
                const float nr = br * sr - bi * si + xr, ni = br * si + bi * sr + xi; sr = nr; si = ni; } }
        __syncthreads();
        float sr = Z[(seg * 64 + p) * 2], si = Z[(seg * 64 + p) * 2 + 1];
        for (int c0 = 0; c0 < 64; c0 += 8) { float er[8], ei[8];
#pragma unroll
            for (int k = 0; k < 8; ++k) { er[k] = E[(row0 + c0 + k) * 128 + p]; ei[k] = E[(row0 + c0 + k) * 128 + 64 + p]; }
#pragma unroll
            for (int k = 0; k < 8; ++k) { bf16* up = UA + (row0 + c0 + k) * 384 + 256 + p; up[0] = (bf16)f2bf(sr); up[64] = (bf16)f2bf(si);
                const float nr = ar * sr - ai * si + er[k], ni = ar * si + ai * sr + ei[k]; sr = nr; si = ni; } }
        __syncthreads();
    }
}
constexpr int SCR_OFF = LDSCTL_OFF + 512;
#ifndef MOE_LAG
#define MOE_LAG 2
#endif
constexpr int MT_SEG = 100, MT_MAXSEG = 72, MT_ULIST = 400, MT_MAXU = 16;
__device__ __forceinline__ void phase_rows(Frame& F, bool dry = false) {
    LAS float* h2t = (LAS float*)(F.lds);
    LAS float* lg = (LAS float*)(F.lds + 65536);
    LAS float* gtm = (LAS float*)(F.lds + 131072);
    LAS float* pg2 = gtm + 2 * D; LAS float* shf = pg2 + 2 * D;
    LAS unsigned* hist = (LAS unsigned*)(F.lds + SCR_OFF); LAS unsigned* base = hist + 32; LAS int* rec_e = (LAS int*)(base + 32); LAS int* rec_lp = rec_e + 256;
    const float* adaf = WSP(float, WS_ADAF); const float* par = WSP(float, WS_PAR);
    const int L = F.lane, wv = F.wave;
    for (int i = F.tid; i < 2 * D; i += NWAVES * 64) { const int b = i >> 10, k = i & (D - 1);
        gtm[i] = adaf[b * 6 * D + 2 * D + k] * par[PAR_MPG + k];
        pg2[i] = par[PAR_FPRE + k] * (1.f + adaf[b * 6 * D + 4 * D + k]); shf[i] = adaf[b * 6 * D + 3 * D + k]; }
    f32x4 wreg[16];
#pragma unroll
    for (int j = 0; j < 4; ++j)
#pragma unroll
        for (int i = 0; i < 4; ++i) wreg[j * 4 + i] = *(const f32x4*)(par + PAR_RW + (4 * L + 256 * j + i) * NE + 4 * wv);
    if (F.tid < 32) hist[F.tid] = 0u;
    __syncthreads();
    const bf16* mix = WSP(bf16, WS_MIX); bf16* H2 = WSP(bf16, WS_H2); bf16* X1B = WSP(bf16, WS_X1B);
    int* tok_e = WSP(int, WS_ROUTE); float* tok_w = (float*)(tok_e + T * 4); int* tok_pos = tok_e + 2 * T * 4;
    unsigned* gcnt = (unsigned*)(F.ctl + CW_ECNT);
    for (int t0 = F.vcu * 16; t0 < T; t0 += F.G * 16) {
        {
            const int t = t0 + 2 * wv, b = t >> 13;
            f32x4 mv[2][4], xv[2][4];
#pragma unroll
            for (int q = 0; q < 2; ++q) { const GAS v2u* mr = (const GAS v2u*)(mix + (size_t)(t + q) * D) + L; const GAS f32x4* xr = (const GAS f32x4*)(F.in[0] + (size_t)(t + q) * D) + L;
#pragma unroll
                for (int j = 0; j < 4; ++j) { const v2u mw = __builtin_nontemporal_load(mr + 64 * j); mv[q][j] = (f32x4){bflo(mw.x), bfhi(mw.x), bflo(mw.y), bfhi(mw.y)}; xv[q][j] = __builtin_nontemporal_load(xr + 64 * j); } }
#pragma unroll
            for (int q = 0; q < 2; ++q) { float s = 0.f;
#pragma unroll
                for (int j = 0; j < 4; ++j) s += (mv[q][j].x * mv[q][j].x + mv[q][j].y * mv[q][j].y) + (mv[q][j].z * mv[q][j].z + mv[q][j].w * mv[q][j].w);
                const float r1 = 1.f / sqrtf(wave_sum(s) * (1.f / D) + NORM_EPS);
                float s2 = 0.f; GAS v2u* orow = (GAS v2u*)(X1B + (size_t)(t + q) * D) + L;
#pragma unroll
                for (int j = 0; j < 4; ++j) { const f32x4 g = *(const LAS f32x4*)(gtm + b * D + 4 * L + 256 * j);
                    xv[q][j] = xv[q][j] + g * (mv[q][j] * r1); { v2u w; w.x = pk2(xv[q][j].x, xv[q][j].y); w.y = pk2(xv[q][j].z, xv[q][j].w); __builtin_nontemporal_store(w, orow + 64 * j); }
                    s2 += (xv[q][j].x * xv[q][j].x + xv[q][j].y * xv[q][j].y) + (xv[q][j].z * xv[q][j].z + xv[q][j].w * xv[q][j].w); }
                const float r2 = 1.f / sqrtf(wave_sum(s2) * (1.f / D) + NORM_EPS);
#ifdef MOE_F8
                GAS unsigned* h4 = (GAS unsigned*)(WSP(unsigned char, WS_H2) + (size_t)(t + q) * D) + L;
#pragma unroll
                for (int j = 0; j < 4; ++j) { const f32x4 a = *(const LAS f32x4*)(pg2 + b * D + 4 * L + 256 * j), c = *(const LAS f32x4*)(shf + b * D + 4 * L + 256 * j);
                    const f32x4 h = xv[q][j] * r2 * a + c;
                    h4[64 * j] = pk4_fp8(8.f * h.x, 8.f * h.y, 8.f * h.z, 8.f * h.w);
                    *(LAS f32x4*)(h2t + (2 * wv + q) * D + 4 * L + 256 * j) = h; } }
#else
                GAS unsigned long long* h8 = (GAS unsigned long long*)(H2 + (size_t)(t + q) * D) + L;
#pragma unroll
                for (int j = 0; j < 4; ++j) { const f32x4 a = *(const LAS f32x4*)(pg2 + b * D + 4 * L + 256 * j), c = *(const LAS f32x4*)(shf + b * D + 4 * L + 256 * j);
                    const f32x4 h = xv[q][j] * r2 * a + c;
                    h8[64 * j] = (unsigned long long)pk2(h.x, h.y) | ((unsigned long long)pk2(h.z, h.w) << 32);
                    *(LAS f32x4*)(h2t + (2 * wv + q) * D + 4 * L + 256 * j) = h; } }
#endif
        }
        __syncthreads();
        {
            const int hi = (L >> 5) & 1, h2b = (L >> 4) & 1;
#pragma unroll 2
            for (int tk = 0; tk < 16; ++tk) {
                f32x4 a = {0.f, 0.f, 0.f, 0.f};
#pragma unroll
                for (int j = 0; j < 4; ++j) { const f32x4 h = *(const LAS f32x4*)(h2t + tk * D + 4 * L + 256 * j);
                    a += wreg[j * 4 + 0] * h.x; a += wreg[j * 4 + 1] * h.y; a += wreg[j * 4 + 2] * h.z; a += wreg[j * 4 + 3] * h.w; }
                const float m0 = hi ? a.z : a.x, o0 = hi ? a.x : a.z, m1 = hi ? a.w : a.y, o1 = hi ? a.y : a.w;
                const float v0 = m0 + __shfl_xor(o0, 32), v1 = m1 + __shfl_xor(o1, 32);
                float v = (h2b ? v1 : v0) + __shfl_xor(h2b ? v0 : v1, 16);
                v += __shfl_xor(v, 8); v += __shfl_xor(v, 4); v += __shfl_xor(v, 2); v += __shfl_xor(v, 1);
                if ((L & 15) == 0) lg[tk * NE + 4 * wv + 2 * hi + h2b] = v;
            }
        }
        __syncthreads();
        {
            const int e = L & 31, half = L >> 5, tl = 2 * wv + half, t = t0 + tl;
            float val = lg[tl * NE + e] + par[PAR_RB + e];
            int se[4]; float sv[4];
#pragma unroll
            for (int r = 0; r < 4; ++r) { float mx = val;
                mx = fmaxf(mx, __shfl_xor(mx, 16)); mx = fmaxf(mx, __shfl_xor(mx, 8)); mx = fmaxf(mx, __shfl_xor(mx, 4)); mx = fmaxf(mx, __shfl_xor(mx, 2)); mx = fmaxf(mx, __shfl_xor(mx, 1));
                const unsigned long long bal = __ballot(val == mx); const unsigned hm = half ? (unsigned)(bal >> 32) : (unsigned)bal; const int win = __ffs((int)hm) - 1;
                se[r] = win; sv[r] = mx; if (e == win) val = -3e38f; }
            const float e1 = __expf(sv[1] - sv[0]), e2 = __expf(sv[2] - sv[0]), e3 = __expf(sv[3] - sv[0]), inv = 1.f / (1.f + e1 + e2 + e3);
            if (e < 4) { const int ex = e == 0 ? se[0] : (e == 1 ? se[1] : (e == 2 ? se[2] : se[3]));
                const float wgt = (e == 0 ? 1.f : (e == 1 ? e1 : (e == 2 ? e2 : e3))) * inv;
                tok_e[t * 4 + e] = ex; tok_w[t * 4 + e] = wgt;
                const unsigned lp = dry ? 0u : __hip_atomic_fetch_add(hist + ex, 1u, __ATOMIC_RELAXED, __HIP_MEMORY_SCOPE_WORKGROUP);
                rec_e[tl * 4 + e] = ex; rec_lp[tl * 4 + e] = (int)lp; }
        }
        __syncthreads();
        if (F.tid < 32) { const unsigned h = hist[F.tid]; base[F.tid] = h ? __hip_atomic_fetch_add(gcnt + F.tid, h, RLX_AGENT) : 0u; }
        __syncthreads();
        if (!dry && F.tid < 64) { const int e_ = rec_e[F.tid], pos_ = (int)base[e_] + rec_lp[F.tid]; tok_pos[(t0 + (F.tid >> 2)) * 4 + (F.tid & 3)] = pos_;
            WSP(int, WS_ELIST)[e_ * ELCAP + pos_] = t0 + (F.tid >> 2); }
        if (F.tid < 32) hist[F.tid] = 0u;
        __syncthreads();
    }
}

__device__ __forceinline__ void moe_tables(Frame& F, int nct = 0, int brows = 0) {
    LAS int* cnt = (LAS int*)(F.lds + SCR_OFF); LAS int* off = cnt + 32; LAS int* tpre = off + 32;
    if (F.tid < NE) cnt[F.tid] = (int)__hip_atomic_load(F.ctl + CW_ECNT + F.tid, RLX_AGENT);
    __syncthreads();
    if (F.tid < 64) {
        const int c = F.tid < NE ? cnt[F.tid] : 0, tl = (c + 255) >> 8; int io = c, it = tl;
#pragma unroll
        for (int o = 1; o < 32; o <<= 1) { const int v = __shfl_up(io, o), w = __shfl_up(it, o); if ((int)F.tid >= o) { io += v; it += w; } }
        if (F.tid < NE) { off[F.tid] = io - c; tpre[F.tid] = it - tl; } if (F.tid == NE - 1) tpre[NE] = it; }
    if (F.tid == 0) {
#ifdef MOE_FUSED
        const int tp = 0;
        LAS int* sg = cnt + MT_SEG; const int n = (tp + 31) >> 5; int ns = 0, pos = 0;
        for (int g = 0; g < n; ++g) { const int tg = (tp - 32 * g) < 32 ? (tp - 32 * g) : 32;
            sg[1 + ns] = pos; sg[1 + MT_MAXSEG + ns] = 0; sg[1 + 2 * MT_MAXSEG + ns] = g; ++ns; pos += 8 * tg; sg[1 + 3 * MT_MAXSEG + g] = pos;
            if (g >= MOE_LAG) { sg[1 + ns] = pos; sg[1 + MT_MAXSEG + ns] = 1; sg[1 + 2 * MT_MAXSEG + ns] = g - MOE_LAG; ++ns; pos += 4 * 32; } }
        for (int g = (n > MOE_LAG ? n - MOE_LAG : 0); g < n; ++g) { const int tg = (tp - 32 * g) < 32 ? (tp - 32 * g) : 32; sg[1 + ns] = pos; sg[1 + MT_MAXSEG + ns] = 1; sg[1 + 2 * MT_MAXSEG + ns] = g; ++ns; pos += 4 * tg; }
        sg[1 + ns] = pos; sg[0] = ns;
#endif
    }
    __syncthreads();
    if (nct > 0 && F.G == 256 && F.tid < MT_MAXU) {
        LAS int* ul = cnt + MT_ULIST + 8 * F.tid; const int i = F.tid, c = (int)blockIdx.x, xcd = c & 7, slot = c >> 3, rpx = 32 / nct;
        const int rtg = (i * 8 + xcd) * rpx + slot / nct, pn = slot % nct;
        if (rtg >= tpre[NE]) { ul[0] = -1; }
        else { int e = 0;
#pragma unroll
            for (int st = 16; st >= 1; st >>= 1) if (e + st < NE && tpre[e + st] <= rtg) e += st;
            const int rt = rtg - tpre[e], nr = cnt[e] - rt * 256;
            ul[0] = off[e] + rt * 256; ul[1] = e * brows + pn * 256; ul[2] = rt; ul[3] = pn; ul[4] = e; ul[5] = nr > 256 ? 256 : nr; } }
    __syncthreads();
}
template <bool GA> struct MoeOrder {
    static constexpr bool GATHER = GA;
#if defined(T_ACQ)
    __device__ __forceinline__ void a_ready(const pg8::Unit&) const { if (!GA) { if (threadIdx.x < 64) { __builtin_amdgcn_fence(__ATOMIC_ACQUIRE, "agent"); asm volatile("s_waitcnt vmcnt(0)" ::: "memory"); } asm volatile("" ::: "memory"); __builtin_amdgcn_s_barrier(); asm volatile("" ::: "memory"); } }
#else
    __device__ __forceinline__ void a_ready(const pg8::Unit&) const {}
#endif
#if defined(T_DRAIN)
    __device__ __forceinline__ void done(const pg8::Unit&) const { if (GA) asm volatile("s_waitcnt vmcnt(0)" ::: "memory"); }
#else
    __device__ __forceinline__ void done(const pg8::Unit&) const {}
#endif
    const LAS int* tab; const int* elist; int nct, brows, G, c;
    __device__ __forceinline__ bool next(int i, pg8::Unit& u) const {
        if (G == 256) { if (i >= MT_MAXU) return false; const LAS int* ul = tab + MT_ULIST + 8 * i; const int a0 = ul[0]; if (a0 < 0) return false;
            u.arow = __builtin_amdgcn_readfirstlane(a0); u.brow = __builtin_amdgcn_readfirstlane(ul[1]); u.pm = __builtin_amdgcn_readfirstlane(ul[2]); u.pn = __builtin_amdgcn_readfirstlane(ul[3]);
            u.e = __builtin_amdgcn_readfirstlane(ul[4]); u.nrow = __builtin_amdgcn_readfirstlane(ul[5]); u.kind = 0; u.aux = 0; return true; }
        int rtg, pn;
        if (false) { const int xcd = c & 7, slot = c >> 3, rpx = 32 / nct;
            rtg = (i * 8 + xcd) * rpx + slot / nct; pn = slot % nct; if (rtg >= tab[64 + NE]) return false; }
        else { const int L = i * G + c, total = tab[64 + NE] * nct; if (L >= total) return false; rtg = L / nct; pn = L % nct; }
        int e = 0;
        for (int k = 1; k < NE; ++k) if (tab[64 + k] <= rtg) e = k;
        const int rt = rtg - tab[64 + e], cnt = tab[e], off = tab[32 + e];
        u.e = __builtin_amdgcn_readfirstlane(e); u.pm = __builtin_amdgcn_readfirstlane(rt); u.pn = pn; u.arow = __builtin_amdgcn_readfirstlane(off + rt * 256); u.brow = __builtin_amdgcn_readfirstlane(e * brows + pn * 256);
        const int nr = cnt - rt * 256; u.nrow = __builtin_amdgcn_readfirstlane(nr > 256 ? 256 : nr); u.kind = 0; u.aux = 0; return true;
    }
    __device__ __forceinline__ int arow_of(const pg8::Unit& u, int r) const { return r < u.nrow ? elist[u.e * ELCAP + u.pm * 256 + r] : 0; }
};
struct EpiGU { bf16* H1; const float* bg; const float* bu;
    __device__ __forceinline__ void operator()(const pg8::f32x4 (&acc)[2][2][4][2], const pg8::Unit& u, int wr, int wc, int fr, int fq) const {
        asm volatile("" : "+v"(fr), "+v"(fq));
        const int f0 = u.pn * 128 + wc * 32 + 8 * fq;
#pragma unroll
        for (int ai = 0; ai < 2; ++ai) {
            int fb = f0; asm volatile("" : "+v"(fb));
            const pg8::f32x4 g0 = *(const pg8::f32x4*)(bg + u.e * FF + fb), g1 = *(const pg8::f32x4*)(bg + u.e * FF + fb + 4);
            const pg8::f32x4 u0 = *(const pg8::f32x4*)(bu + u.e * FF + fb), u1 = *(const pg8::f32x4*)(bu + u.e * FF + fb + 4);
#pragma unroll
            for (int m = 0; m < 4; ++m) { const int r = ai * 128 + wr * 64 + m * 16 + fr;
                const pg8::f32x4 a0 = acc[ai][0][m][0] + g0, a1 = acc[ai][0][m][1] + g1, b0 = acc[ai][1][m][0] + u0, b1 = acc[ai][1][m][1] + u1;
                float gg[8] = {a0[0], a0[1], a0[2], a0[3], a1[0], a1[1], a1[2], a1[3]}, uu[8] = {b0[0], b0[1], b0[2], b0[3], b1[0], b1[1], b1[2], b1[3]}, o[8];
#pragma unroll
                for (int i = 0; i < 8; ++i) { const float g = fminf(gg[i], 7.f), up = fminf(fmaxf(uu[i], -7.f), 7.f); o[i] = g * sigmoidf_(1.702f * g) * (up + 1.f); }
                v4u w; w.x = pk2(o[0], o[1]); w.y = pk2(o[2], o[3]); w.z = pk2(o[4], o[5]); w.w = pk2(o[6], o[7]);
#ifdef T_SC1
                if (r < u.nrow) __builtin_amdgcn_raw_buffer_store_b128(w, __builtin_amdgcn_make_buffer_rsrc(H1, 0, (int)((size_t)T * TOPK * FF * 2), 0x00020000), (unsigned)((u.arow + r) * (FF * 2) + fb * 2), 0, 16); } }
#else
                if (r < u.nrow) *(v4u*)(H1 + (size_t)(u.arow + r) * FF + fb) = w; } }
#endif
    }
};
struct EpiDn { bf16* YB; const float* bd;
    __device__ __forceinline__ void operator()(const pg8::f32x4 (&acc)[2][2][4][2], const pg8::Unit& u, int wr, int wc, int fr, int fq) const {
        const int c0 = u.pn * 256 + wc * 32 + 8 * fq;
#pragma unroll
        for (int bj = 0; bj < 2; ++bj) { const pg8::f32x4 d0 = *(const pg8::f32x4*)(bd + u.e * D + c0 + bj * 128), d1 = *(const pg8::f32x4*)(bd + u.e * D + c0 + bj * 128 + 4);
#pragma unroll
            for (int ai = 0; ai < 2; ++ai)
#pragma unroll
                for (int m = 0; m < 4; ++m) { const int r = ai * 128 + wr * 64 + m * 16 + fr;
                    const pg8::f32x4 a0 = acc[ai][bj][m][0] + d0, a1 = acc[ai][bj][m][1] + d1;
                    v4u w; w.x = pk2(a0[0], a0[1]); w.y = pk2(a0[2], a0[3]); w.z = pk2(a1[0], a1[1]); w.w = pk2(a1[2], a1[3]);
                    if (r < u.nrow) *(v4u*)(YB + (size_t)(u.arow + r) * D + c0 + bj * 128) = w; } }
    }
};
constexpr float YB_SCALE = 16.f;
struct EpiGU8 { unsigned char* H1; const float* bg; const float* bu; const float* wscp;
    static constexpr bool BIAS_LDS = true;
    __device__ __forceinline__ void stage_bias(PG8_LAS unsigned char* dst, const pg8::Unit& u, int wid, int lane) const {
        if (wid < 4) { const float* src = (wid < 2 ? bg : bu) + u.e * FF + u.pn * 128 + (wid & 1) * 64 + lane;
            __builtin_amdgcn_global_load_lds((const unsigned*)src, (PG8_LAS unsigned*)(dst + wid * 256), 4, 0, 0); } }
    __device__ __forceinline__ void operator()(const pg8::f32x4 (&acc)[2][2][4][2], const pg8::Unit& u, int wr, int wc, int fr, int fq, const PG8_LAS float* bl) const {
        asm volatile("" : "+v"(fr), "+v"(fq));
        const int fl = wc * 32 + 8 * fq, f0 = u.pn * 128 + fl; const float sr = 0.125f / *wscp;
        const pg8::f32x4 g0 = *(const PG8_LAS pg8::f32x4*)(bl + fl), g1 = *(const PG8_LAS pg8::f32x4*)(bl + fl + 4), u0 = *(const PG8_LAS pg8::f32x4*)(bl + 128 + fl), u1 = *(const PG8_LAS pg8::f32x4*)(bl + 128 + fl + 4);
#pragma unroll
        for (int ai = 0; ai < 2; ++ai)
#pragma unroll
            for (int m = 0; m < 4; ++m) { const int r = ai * 128 + wr * 64 + m * 16 + fr;
                const pg8::f32x4 a0 = acc[ai][0][m][0] * sr + g0, a1 = acc[ai][0][m][1] * sr + g1, b0 = acc[ai][1][m][0] * sr + u0, b1 = acc[ai][1][m][1] * sr + u1;
                float gg[8] = {a0[0], a0[1], a0[2], a0[3], a1[0], a1[1], a1[2], a1[3]}, uu[8] = {b0[0], b0[1], b0[2], b0[3], b1[0], b1[1], b1[2], b1[3]}, o[8];
#pragma unroll
                for (int i = 0; i < 8; ++i) { const float g = fminf(gg[i], 7.f), up = fminf(fmaxf(uu[i], -7.f), 7.f); o[i] = 8.f * (g * sigmoidf_(1.702f * g) * (up + 1.f)); }
                v2u w; w.x = pk4_fp8(o[0], o[1], o[2], o[3]); w.y = pk4_fp8(o[4], o[5], o[6], o[7]);
                if (r < u.nrow) *(v2u*)(H1 + (size_t)(u.arow + r) * FF + f0) = w; }
    }
};
struct EpiDn8 { bf16* YB; const float* bd; const float* wscp;
    static constexpr bool BIAS_LDS = true;
    __device__ __forceinline__ void stage_bias(PG8_LAS unsigned char* dst, const pg8::Unit& u, int wid, int lane) const {
        if (wid < 4) { const float* src = bd + u.e * D + u.pn * 256 + wid * 64 + lane;
            __builtin_amdgcn_global_load_lds((const unsigned*)src, (PG8_LAS unsigned*)(dst + wid * 256), 4, 0, 0); } }
    __device__ __forceinline__ void operator()(const pg8::f32x4 (&acc)[2][2][4][2], const pg8::Unit& u, int wr, int wc, int fr, int fq, const PG8_LAS float* bl) const {
        const int cl = wc * 32 + 8 * fq, c0 = u.pn * 256 + cl; const float sc = 0.125f / *wscp;
#pragma unroll
        for (int bj = 0; bj < 2; ++bj) { const pg8::f32x4 d0 = *(const PG8_LAS pg8::f32x4*)(bl + cl + bj * 128), d1 = *(const PG8_LAS pg8::f32x4*)(bl + cl + bj * 128 + 4);
#pragma unroll
            for (int ai = 0; ai < 2; ++ai)
#pragma unroll
                for (int m = 0; m < 4; ++m) { const int r = ai * 128 + wr * 64 + m * 16 + fr;
                    const pg8::f32x4 a0 = (acc[ai][bj][m][0] * sc + d0) * YB_SCALE, a1 = (acc[ai][bj][m][1] * sc + d1) * YB_SCALE;
                    v2u w; w.x = pk4_fp8(a0[0], a0[1], a0[2], a0[3]); w.y = pk4_fp8(a1[0], a1[1], a1[2], a1[3]);
                    if (r < u.nrow) *(v2u*)((unsigned char*)YB + (size_t)(u.arow + r) * D + c0 + bj * 128) = w; } }
    }
};
constexpr int CW_RDY = 8448;
constexpr int H2ROW0 = (int)(WS_H2 / 2048), H1ROW0 = (int)(WS_H1 / 2048), DN_BROW0 = (int)((WS_WDN_T - WS_WGU_T) / 2048);
struct MoeFused {
    static constexpr bool GATHER = true;
    const LAS int* tab; const int* elist; gu32* ctl; int G, c, base;
    __device__ __forceinline__ bool next(int i, pg8::Unit& u) const {
        const LAS int* sg = tab + MT_SEG; const int ns = sg[0], L = (base + i) * G + c; if (L >= sg[1 + ns]) return false;
        int s = 0; for (int k = 1; k < ns; ++k) if (sg[1 + k] <= L) s = k;
        if (i > 0 && sg[1 + MT_MAXSEG + s] == 1 && L - sg[1 + 3 * MT_MAXSEG + sg[1 + 2 * MT_MAXSEG + s]] < G) return false;
        const int kind = sg[1 + MT_MAXSEG + s], g = sg[1 + 2 * MT_MAXSEG + s], ui = L - sg[1 + s], TT = tab[64 + NE], tg = (TT - 32 * g) < 32 ? (TT - 32 * g) : 32;
        int rt, pn;
        if (kind == 0) { if (tg == 32) { const int xcd = ui & 7, slot = ui >> 3; rt = xcd * 4 + (slot >> 3); pn = slot & 7; } else { rt = ui >> 3; pn = ui & 7; } }
        else { if (tg == 32) { const int xcd = ui & 7, slot = ui >> 3; rt = xcd * 4 + (slot >> 2); pn = slot & 3; } else { rt = ui >> 2; pn = ui & 3; } }
        const int rtg = 32 * g + rt; int e = 0;
        for (int k = 1; k < NE; ++k) if (tab[64 + k] <= rtg) e = k;
        const int rte = rtg - tab[64 + e], cnt = tab[e], off = tab[32 + e], nr = cnt - rte * 256;
        u.e = __builtin_amdgcn_readfirstlane(e); u.pm = __builtin_amdgcn_readfirstlane(rte); u.pn = __builtin_amdgcn_readfirstlane(pn); u.kind = __builtin_amdgcn_readfirstlane(kind); u.aux = __builtin_amdgcn_readfirstlane(rtg);
        u.arow = __builtin_amdgcn_readfirstlane(off + rte * 256); u.nrow = __builtin_amdgcn_readfirstlane(nr > 256 ? 256 : nr);
        u.brow = __builtin_amdgcn_readfirstlane(kind == 0 ? e * 2048 + pn * 256 : DN_BROW0 + e * 1024 + pn * 256); return true;
    }
    __device__ __forceinline__ int arow_of(const pg8::Unit& u, int r) const { return u.kind == 0 ? H2ROW0 + (r < u.nrow ? elist[u.e * ELCAP + u.pm * 256 + r] : 0) : H1ROW0 + u.arow + (r < u.nrow ? r : 0); }
    __device__ __forceinline__ void a_ready(const pg8::Unit& u) const {
        if (u.kind != 1) return;
        if (threadIdx.x < 64) {
            gu32* w = ctl + CW_RDY + u.aux; const unsigned long long t0 = __builtin_amdgcn_s_memrealtime();
            while ((unsigned)__builtin_amdgcn_readfirstlane(__hip_atomic_load(w, RLX_AGENT)) < 64u) {
                if (__builtin_amdgcn_s_memrealtime() - t0 > 2000000ull) { if (threadIdx.x == 0) __hip_atomic_store(ctl + CW_TMO, 1u, RLX_AGENT); break; }
                __builtin_amdgcn_s_sleep(2); }
#ifdef MOE_DELAY
            { const unsigned long long t1 = __builtin_amdgcn_s_memrealtime(); while (__builtin_amdgcn_s_memrealtime() - t1 < 2000ull) __builtin_amdgcn_s_sleep(8); }
#endif
            __builtin_amdgcn_fence(__ATOMIC_ACQUIRE, "agent");
            asm volatile("s_waitcnt vmcnt(0)" ::: "memory");
        }
        asm volatile("" ::: "memory"); __builtin_amdgcn_s_barrier(); asm volatile("" ::: "memory");
    }
    __device__ __forceinline__ void done(const pg8::Unit& u) const {
        if (u.kind != 0) return;
#ifndef DIAG_NODRAIN
        asm volatile("s_waitcnt vmcnt(0)" ::: "memory");
#endif
#if defined(MOE_REL)
        __builtin_amdgcn_fence(__ATOMIC_RELEASE, "agent"); asm volatile("s_waitcnt vmcnt(0)" ::: "memory");
#endif
        if ((threadIdx.x & 63) == 0) __hip_atomic_fetch_add(ctl + CW_RDY + u.aux, 1u, RLX_AGENT);
    }
};
struct EpiMoe { bf16* H1; bf16* YB; const float* bg; const float* bu; const float* bd;
    __device__ __forceinline__ void operator()(const pg8::f32x4 (&acc)[2][2][4][2], const pg8::Unit& u, int wr, int wc, int fr, int fq) const {
        asm volatile("" : "+v"(fr), "+v"(fq));
        if (u.kind == 0) {
            const int f0 = u.pn * 128 + wc * 32 + 8 * fq;
            const __amdgpu_buffer_rsrc_t h1rs = __builtin_amdgcn_make_buffer_rsrc(H1, 0, (int)((size_t)T * TOPK * FF * 2), 0x00020000);
#pragma unroll
            for (int ai = 0; ai < 2; ++ai) {
                int fb = f0; asm volatile("" : "+v"(fb));
                const pg8::f32x4 g0 = *(const pg8::f32x4*)(bg + u.e * FF + fb), g1 = *(const pg8::f32x4*)(bg + u.e * FF + fb + 4);
                const pg8::f32x4 u0 = *(const pg8::f32x4*)(bu + u.e * FF + fb), u1 = *(const pg8::f32x4*)(bu + u.e * FF + fb + 4);
#pragma unroll
                for (int m = 0; m < 4; ++m) { const int r = ai * 128 + wr * 64 + m * 16 + fr;
                    const pg8::f32x4 a0 = acc[ai][0][m][0] + g0, a1 = acc[ai][0][m][1] + g1, b0 = acc[ai][1][m][0] + u0, b1 = acc[ai][1][m][1] + u1;
                    float gg[8] = {a0[0], a0[1], a0[2], a0[3], a1[0], a1[1], a1[2], a1[3]}, uu[8] = {b0[0], b0[1], b0[2], b0[3], b1[0], b1[1], b1[2], b1[3]}, o[8];
#pragma unroll
                    for (int i = 0; i < 8; ++i) { const float g = fminf(gg[i], 7.f), up = fminf(fmaxf(uu[i], -7.f), 7.f); o[i] = g * sigmoidf_(1.702f * g) * (up + 1.f); }
#ifdef MOE_PLAIN
                    if (r < u.nrow) { v4u w; w.x = pk2(o[0], o[1]); w.y = pk2(o[2], o[3]); w.z = pk2(o[4], o[5]); w.w = pk2(o[6], o[7]); *(GAS v4u*)(H1 + (size_t)(u.arow + r) * FF + fb) = w; } } }
#else
                    if (r < u.nrow) { v4u w; w.x = pk2(o[0], o[1]); w.y = pk2(o[2], o[3]); w.z = pk2(o[4], o[5]); w.w = pk2(o[6], o[7]);
                        __builtin_amdgcn_raw_buffer_store_b128(w, h1rs, (unsigned)((u.arow + r) * (FF * 2) + fb * 2), 0, 16); } } }
#endif
        } else {
            const int c0 = u.pn * 256 + wc * 32 + 8 * fq;
#pragma unroll
            for (int bj = 0; bj < 2; ++bj) { const pg8::f32x4 d0 = *(const pg8::f32x4*)(bd + u.e * D + c0 + bj * 128), d1 = *(const pg8::f32x4*)(bd + u.e * D + c0 + bj * 128 + 4);
#pragma unroll
                for (int ai = 0; ai < 2; ++ai)
#pragma unroll
                    for (int m = 0; m < 4; ++m) { const int r = ai * 128 + wr * 64 + m * 16 + fr;
                        const pg8::f32x4 a0 = acc[ai][bj][m][0] + d0, a1 = acc[ai][bj][m][1] + d1;
                        v4u w; w.x = pk2(a0[0], a0[1]); w.y = pk2(a0[2], a0[3]); w.z = pk2(a1[0], a1[1]); w.w = pk2(a1[2], a1[3]);
                        if (r < u.nrow) *(GAS v4u*)(YB + (size_t)(u.arow + r) * D + c0 + bj * 128) = w; } }
        }
    }
};
__device__ __forceinline__ void phase_final(Frame& F, bool dry = false) {
    moe_tables(F);
    const LAS int* off = (const LAS int*)(F.lds + SCR_OFF) + 32;
    LAS float* gtf = (LAS float*)(F.lds);
    const float* adaf = WSP(float, WS_ADAF);
    for (int i = F.tid; i < 2 * D; i += NWAVES * 64) { const int b = i >> 10, k = i & (D - 1); gtf[i] = adaf[b * 6 * D + 5 * D + k] * WSP(float, WS_PAR)[PAR_FPOST + k]; }
    __syncthreads();
    const int gw = F.vcu * NWAVES + F.wave, NGW = F.G * NWAVES, L = F.lane;
    const int* tok_e = WSP(int, WS_ROUTE); const float* tok_w = (const float*)(tok_e + T * 4); const int* tok_pos = tok_e + 2 * T * 4;
    const bf16* YB = WSP(bf16, WS_YB);
    for (int t = gw * 2; t < T; t += NGW * 2) { const int b = t >> 13;
        int row_l = 0; float w_l = 0.f;
        if (L < 8) { const int idx = (t + (L >> 2)) * 4 + (L & 3); row_l = off[tok_e[idx]] + tok_pos[idx]; w_l = tok_w[idx]; }
        unsigned yv[2][4][4]; f32x4 x1v[2][4]; float wk[2][4];
#pragma unroll
        for (int q = 0; q < 2; ++q) {
#pragma unroll
            for (int k = 0; k < 4; ++k) { const int row = __shfl(row_l, q * 4 + k); wk[q][k] = __shfl(w_l, q * 4 + k);
                const GAS unsigned* yr = (const GAS unsigned*)((const unsigned char*)YB + (size_t)row * D) + L;
#pragma unroll
                for (int j = 0; j < 4; ++j) yv[q][k][j] = __builtin_nontemporal_load(yr + 64 * j);
#ifdef DRY14_NOYB
                if (dry) { _Pragma("unroll") for (int j = 0; j < 4; ++j) yv[q][k][j] = 0x38383838u; }
#endif
            }
            const GAS v2u* xr = (const GAS v2u*)(WSP(bf16, WS_X1B) + (size_t)(t + q) * D) + L;
#pragma unroll
            for (int j = 0; j < 4; ++j) { const v2u xw = __builtin_nontemporal_load(xr + 64 * j); x1v[q][j] = (f32x4){bflo(xw.x), bfhi(xw.x), bflo(xw.y), bfhi(xw.y)}; } }
#pragma unroll
        for (int q = 0; q < 2; ++q) {
            f32x4 y[4];
#pragma unroll
            for (int j = 0; j < 4; ++j) y[j] = (f32x4){0.f, 0.f, 0.f, 0.f};
#pragma unroll
            for (int k = 0; k < 4; ++k)
#pragma unroll
                for (int j = 0; j < 4; ++j) { const unsigned x = yv[q][k][j]; const float w = wk[q][k] * (1.f / YB_SCALE);
                    y[j].x += w * __builtin_amdgcn_cvt_f32_fp8((int)x, 0); y[j].y += w * __builtin_amdgcn_cvt_f32_fp8((int)x, 1); y[j].z += w * __builtin_amdgcn_cvt_f32_fp8((int)x, 2); y[j].w += w * __builtin_amdgcn_cvt_f32_fp8((int)x, 3); }
            float s = 0.f;
#pragma unroll
            for (int j = 0; j < 4; ++j) s += (y[j].x * y[j].x + y[j].y * y[j].y) + (y[j].z * y[j].z + y[j].w * y[j].w);
            const float r = 1.f / sqrtf(wave_sum(s) * (1.f / D) + NORM_EPS);
            GAS f32x4* wrow = dry ? (GAS f32x4*)(WSP(float, WS_WGU_T) + (size_t)(t + q) * D) + L : (GAS f32x4*)(F.out + (size_t)(t + q) * D) + L;
#pragma unroll
            for (int j = 0; j < 4; ++j) { const f32x4 g = *(const LAS f32x4*)(gtf + b * D + 4 * L + 256 * j); __builtin_nontemporal_store(x1v[q][j] + g * (y[j] * r), wrow + 64 * j); }
        }
    }
}
__device__ __forceinline__ bool opaque_ws(Frame& F) { asm volatile("" : "+s"(F.ws)); return true; }
#ifndef MK_N_LAUNCHES
#define MK_N_LAUNCHES 1
#endif
constexpr int N_PHASES = 15;
struct Args { const float* in[30]; float* out; unsigned char* ws; int ph_lo, ph_hi; };
__global__ void __launch_bounds__(NWAVES * 64, 2) mega_fwd(Args args) {
    extern __shared__ __attribute__((aligned(16))) unsigned char lds[];
    Frame F;
    F.lds = (LAS unsigned char*)lds;
    F.MISC = (volatile LAS unsigned*)(F.lds + MISC_OFF);
    F.tid = threadIdx.x; F.lane = F.tid & 63; F.wave = __builtin_amdgcn_readfirstlane(F.tid >> 6);
    F.G = gridDim.x; { const int bx = blockIdx.x; F.vcu = (F.G % 8 == 0) ? (bx % 8) * (F.G / 8) + bx / 8 : bx; }
    F.ws = args.ws; F.ctl = (gu32*)(args.ws + WS_CTL); F.out = args.out;
#pragma unroll
    for (int i = 0; i < 30; ++i) F.in[i] = args.in[i];
    for (int u = F.tid; u < (LDS_BYTES - LDSCTL_OFF) / 4; u += NWAVES * 64) ((LAS unsigned*)(F.lds + LDSCTL_OFF))[u] = 0u;
    __syncthreads();
    XcdBarrier bar; bar.bar = (unsigned*)(F.ctl + CW_BAR); bar.x = 0; bar.st = nullptr;
    if (MK_N_LAUNCHES == 1) bar = xcd_barrier_post((unsigned*)(F.ctl + CW_BAR), F.MISC + 8);
    const int lo = args.ph_lo, hi = args.ph_hi;
#ifndef PHMASK
#define PHMASK 0x7fff
#endif
#define IN(k) (((PHMASK >> (k)) & 1) && lo <= (k) && (k) < hi)
#ifdef TPROBE
#ifndef TPROBE_MULT
#define TPROBE_MULT 2
#endif
#define TP_SLOT ((volatile LAS unsigned long long*)(F.lds + LDSCTL_OFF + 3584))
#define STAMP(k) do { if ((k) == TPROBE && blockIdx.x == 0 && F.tid == 0) TP_SLOT[1] = __builtin_amdgcn_s_memrealtime(); if ((k) == 0 && blockIdx.x == 0 && F.tid == 0) TP_SLOT[0] = __builtin_amdgcn_s_memrealtime(); } while (0)
#elif defined(DBG_A)
#define STAMP(k) do { if (blockIdx.x == 0 && F.tid == 0) ((unsigned long long*)(F.ctl + 2048))[k] = __builtin_amdgcn_s_memrealtime(); } while (0)
#else
#define STAMP(k) do {} while (0)
#endif
#ifndef REP_PHASE
#define REP_PHASE -1
#endif
#ifndef REP_MASK
#define REP_MASK 0
#endif
#define REPL(k) for (int rep_ = 0; rep_ < ((REP_PHASE == (k) || ((REP_MASK >> (k)) & 1)) ? 2 : 1); ++rep_) if (opaque_ws(F))
#ifdef DBL_BAR
#define SEAM(k) do { if (IN(k)) { xcd_barrier(bar); xcd_barrier(bar); } STAMP((k) + 1); } while (0)
#else
#define SEAM(k) do { if (IN(k)) xcd_barrier(bar); STAMP((k) + 1); } while (0)
#endif
    PG8_LAS unsigned char* ring = F.lds + RING_OFF;
    const int bx = (int)blockIdx.x;

    STAMP(0);
#ifdef DIAG_WARM
    { typedef float f4_ __attribute__((ext_vector_type(4))); typedef short s8_ __attribute__((ext_vector_type(8))); f4_ a_ = {0.f, 0.f, 0.f, 0.f}; s8_ x_ = {1, 2, 3, 4, 5, 6, 7, 8};
      const unsigned long long t0_ = __builtin_amdgcn_s_memrealtime();
      while (__builtin_amdgcn_s_memrealtime() - t0_ < (unsigned long long)(DIAG_WARM * 100)) { _Pragma("unroll") for (int i_ = 0; i_ < 16; ++i_) a_ = __builtin_amdgcn_mfma_f32_16x16x32_bf16(x_, x_, a_, 0, 0, 0); }
      if (a_[0] == 12345.f) F.out[0] = a_[1]; }
#endif
    if (IN(0)) REPL(0) { phase0(F); } SEAM(0);
    if (IN(1)) REPL(1) { phase1(F); } SEAM(1);
    if (IN(2)) REPL(2) {
#ifdef G1_MIX
        {
            pg8::Gemm g{WSP(bf16, WS_XN8), WSP(bf16, WS_WIN8), D / 2, D / 2, D / 2}; pg8::ColSubsetOrder S;
#ifdef G1_MIX_GATES
            S.d.init(T, 8 * 256, F.G, bx); S.base = 8; S.split = 8; S.skip = 0;
#else
            S.d.init(T, 12 * 256, F.G, bx); S.base = 0; S.split = 2; S.skip = 4;
#endif
            EpiG1 E{WSP(bf16, WS_UA), WSP(bf16, WS_Q), WSP(bf16, WS_K), WSP(bf16, WS_V), WSP(bf16, WS_VT), WSP(bf16, WS_GS), WSP(bf16, WS_GA),
                    WSP(float, WS_ROPE), WSP(float, WS_ROPE) + (size_t)T * 32, (float*)(F.ctl + CW_KM), WSP(float, WS_PAR) + PAR_WSC1, true};
            pg8::gemm_phase<EpiG1, pg8::ColSubsetOrder, true>(ring, g, S, E); }
        {
            pg8::Gemm g{WSP(bf16, WS_XN), WSP(bf16, WS_WIN_T), D, D, D}; pg8::ColSubsetOrder S;
#ifdef G1_MIX_GATES
            S.d.init(T, 8 * 256, F.G, bx); S.base = 0; S.split = 8; S.skip = 0;
#else
            S.d.init(T, 4 * 256, F.G, bx); S.base = 2; S.split = 4; S.skip = 0;
#endif
            EpiG1 E{WSP(bf16, WS_UA), WSP(bf16, WS_Q), WSP(bf16, WS_K), WSP(bf16, WS_V), WSP(bf16, WS_VT), WSP(bf16, WS_GS), WSP(bf16, WS_GA),
                    WSP(float, WS_ROPE), WSP(float, WS_ROPE) + (size_t)T * 32, (float*)(F.ctl + CW_KM), WSP(float, WS_PAR) + PAR_WSC1, false};
            pg8::gemm_phase<EpiG1, pg8::ColSubsetOrder, false>(ring, g, S, E); }
#else
#ifdef G1_F8
        pg8::Gemm g{WSP(bf16, WS_XN), WSP(bf16, WS_WIN_T), D / 2, D / 2, D / 2}; pg8::DenseOrder S; S.init(T, INW, F.G, bx);
#else
        pg8::Gemm g{WSP(bf16, WS_XN), WSP(bf16, WS_WIN_T), D, D, D}; pg8::DenseOrder S; S.init(T, INW, F.G, bx);
#endif
        EpiG1 E{WSP(bf16, WS_UA), WSP(bf16, WS_Q), WSP(bf16, WS_K), WSP(bf16, WS_V), WSP(bf16, WS_VT), WSP(bf16, WS_GS), WSP(bf16, WS_GA),
                WSP(float, WS_ROPE), WSP(float, WS_ROPE) + (size_t)T * 32, (float*)(F.ctl + CW_KM), WSP(float, WS_PAR) + PAR_WSC1,
#ifdef G1_F8
                true};
#else
                false};
#endif
#ifdef G1_F8
        pg8::gemm_phase<EpiG1, pg8::DenseOrder, true>(ring, g, S, E);
#else
        pg8::gemm_phase(ring, g, S, E);
#endif
#endif
        s5_fill_kt(F);
    } SEAM(2);
    if (IN(3)) REPL(3) {
        pg8::Gemm g{WSP(bf16, WS_UA), WSP(bf16, WS_S5M1), 384, 256, 256}; S5Order S{F.G, bx}; EpiS5A E{WSP(float, WS_S5E)};
        pg8::gemm_phase(ring, g, S, E);
        s5_fill_wc(F);
        attn_gate(F);
#ifdef MOE_F8
        moe_convert_idle(F, MOE_ITEMS_P0, MOE_ITEMS_P3);
#endif
    } SEAM(3);
    if (IN(4)) REPL(4) { attn_items(F); s5_carry(F); } SEAM(4);
    if (IN(5)) REPL(5) {
        pg8::Gemm g{WSP(bf16, WS_UA), WSP(bf16, WS_S5WC), 384, 384, 384}; S5Order S{F.G, bx}; EpiS5C E{WSP(bf16, WS_YG)};
        pg8::gemm_phase(ring, g, S, E);
        attn_combine(F);
#ifdef MOE_F8
        moe_convert_idle(F, MOE_ITEMS_P0 + MOE_ITEMS_P3, MOE_ITEMS_P5);
#endif
    } SEAM(5);
    if (IN(6)) REPL(6) {
        pg8::Gemm g{WSP(bf16, WS_YG), WSP(bf16, WS_WGLU_T), SW, SW, SW}; pg8::DenseOrder S; S.init(T, SW, F.G, bx);
        EpiEw<0> E{WSP(bf16, WS_Y2), WSP(bf16, WS_YG), nullptr, nullptr, SW};
        pg8::gemm_phase(ring, g, S, E);
#ifdef MOE_F8
        moe_convert_idle(F, MOE_ITEMS_P0 + MOE_ITEMS_P3 + MOE_ITEMS_P5, MOE_ITEMS_P6);
#endif
    } SEAM(6);
    if (IN(7)) REPL(7) {
        pg8::Gemm g{WSP(bf16, WS_Y2), WSP(bf16, WS_WSB_T), SW, SW, SW}; pg8::DenseOrder S; S.init(T, D, F.G, bx);
        EpiEw<1> E{WSP(bf16, WS_M1), WSP(bf16, WS_GS), nullptr, nullptr, D};
        pg8::gemm_phase(ring, g, S, E);
    }
    if (IN(7)) { asm volatile("s_waitcnt vmcnt(0)" ::: "memory"); __syncthreads(); if (F.tid < 64) { __builtin_amdgcn_fence(__ATOMIC_ACQUIRE, "agent"); asm volatile("s_waitcnt vmcnt(0)" ::: "memory"); } __syncthreads(); STAMP(8); }
    if (IN(8)) REPL(8) {
        pg8::Gemm g{WSP(bf16, WS_YA), WSP(bf16, WS_WAB_T), AW, AW, AW}; pg8::DenseOrder S; S.init(T, D, F.G, bx);
        EpiEw<2> E{WSP(bf16, WS_XN), WSP(bf16, WS_GA), WSP(bf16, WS_M1), nullptr, D};
        pg8::gemm_phase(ring, g, S, E);
    } SEAM(8);
    if (IN(9)) REPL(9) {
        pg8::Gemm g{WSP(bf16, WS_XN), WSP(bf16, WS_WOUT_T), D, D, D}; pg8::DenseOrder S; S.init(T, D, F.G, bx);
        EpiEw<4> E{WSP(bf16, WS_MIX), nullptr, nullptr, nullptr, D};
        pg8::gemm_phase(ring, g, S, E);
    } SEAM(9);
    if (IN(10)) REPL(10) { phase_rows(F, (REP_PHASE == 10 || ((REP_MASK >> 10) & 1)) && rep_ == 0); } SEAM(10);
#ifndef MOE_FUSED
#ifdef MOE_F8
    if (IN(12)) REPL(12) {
        moe_tables(F, 8, 2048);
        pg8::Gemm g{WSP(bf16, WS_H2), WSP(bf16, WS_WGU_T), D / 2, D / 2, D / 2}; MoeOrder<true> S{(const LAS int*)(F.lds + SCR_OFF), WSP(int, WS_ELIST), 8, 2048, F.G, bx};
        EpiGU8 E{WSP(unsigned char, WS_H1), WSP(float, WS_PAR) + PAR_BG, WSP(float, WS_PAR) + PAR_BU, WSP(float, WS_PAR) + PAR_WSC};
        pg8::gemm_phase<EpiGU8, MoeOrder<true>, true>(ring, g, S, E);
    } SEAM(12);
    if (IN(13)) REPL(13) {
        moe_tables(F, 4, 1024);
        pg8::Gemm g{WSP(bf16, WS_H1), WSP(bf16, WS_WDN_T), FF / 2, FF / 2, FF / 2}; MoeOrder<false> S{(const LAS int*)(F.lds + SCR_OFF), nullptr, 4, 1024, F.G, bx};
        EpiDn8 E{WSP(bf16, WS_YB), WSP(float, WS_PAR) + PAR_BD, WSP(float, WS_PAR) + PAR_WSC};
        pg8::gemm_phase<EpiDn8, MoeOrder<false>, true>(ring, g, S, E);
    } SEAM(13);
#else
    if (IN(12)) REPL(12) {
        moe_tables(F, 8, 2048);
        pg8::Gemm g{WSP(bf16, WS_H2), WSP(bf16, WS_WGU_T), D, D, D}; MoeOrder<true> S{(const LAS int*)(F.lds + SCR_OFF), WSP(int, WS_ELIST), 8, 2048, F.G, bx};
        EpiGU E{WSP(bf16, WS_H1), WSP(float, WS_PAR) + PAR_BG, WSP(float, WS_PAR) + PAR_BU};
        pg8::gemm_phase(ring, g, S, E);
    } SEAM(12);
    if (IN(13)) REPL(13) {
        moe_tables(F, 4, 1024);
        pg8::Gemm g{WSP(bf16, WS_H1), WSP(bf16, WS_WDN_T), FF, FF, FF}; MoeOrder<false> S{(const LAS int*)(F.lds + SCR_OFF), nullptr, 4, 1024, F.G, bx};
        EpiDn E{WSP(bf16, WS_YB), WSP(float, WS_PAR) + PAR_BD};
        pg8::gemm_phase(ring, g, S, E);
    } SEAM(13);
#endif
#else
    if (IN(12)) REPL(12) {
        moe_tables(F);
        pg8::Gemm g{(const bf16*)F.ws, WSP(bf16, WS_WGU_T), D, D, D};
        EpiMoe E{WSP(bf16, WS_H1), WSP(bf16, WS_YB), WSP(float, WS_PAR) + PAR_BG, WSP(float, WS_PAR) + PAR_BU, WSP(float, WS_PAR) + PAR_BD};
        for (int base = 0;;) { MoeFused S{(const LAS int*)(F.lds + SCR_OFF), WSP(int, WS_ELIST), F.ctl, F.G, bx, base};
            const int nd = pg8::gemm_phase(ring, g, S, E); if (nd == 0) break; base += nd; }
    } SEAM(12);
#endif
    if (IN(14)) REPL(14) { phase_final(F, (REP_PHASE == 14 || ((REP_MASK >> 14) & 1)) && rep_ == 0); }
#ifdef TPROBE
    if (blockIdx.x == 0 && F.tid == 0) { const unsigned long long t0_ = TP_SLOT[0], tk_ = TP_SLOT[1], te_ = __builtin_amdgcn_s_memrealtime();
        while (__builtin_amdgcn_s_memrealtime() - te_ < (tk_ - t0_) * TPROBE_MULT) __builtin_amdgcn_s_sleep(8); }
#endif
#undef IN
#undef SEAM
}

extern "C" void kernel_launch(void* const* d_in, const int* in_sizes, int n_in, void* d_out, int out_size, void* d_ws, size_t ws_size, hipStream_t stream) {
    static int grid = 0;
    if (grid == 0) {
        if (n_in != 30 || in_sizes[0] != T * D || out_size != T * D || ws_size < WS_END) { fprintf(stderr, "kernel_launch: unexpected shapes (n_in %d, in0 %d, out %d, ws %zu)\n", n_in, n_in > 0 ? in_sizes[0] : -1, out_size, ws_size); grid = -1; return; }
        int dev = 0, cus = 0, per_cu = 0;
        if (hipGetDevice(&dev) != hipSuccess || hipDeviceGetAttribute(&cus, hipDeviceAttributeMultiprocessorCount, dev) != hipSuccess) { grid = -1; return; }
        if (hipFuncSetAttribute((const void*)mega_fwd, hipFuncAttributeMaxDynamicSharedMemorySize, LDS_BYTES) != hipSuccess) { fprintf(stderr, "kernel_launch: hipFuncSetAttribute failed\n"); grid = -1; return; }
        if (hipOccupancyMaxActiveBlocksPerMultiprocessor(&per_cu, (const void*)mega_fwd, NWAVES * 64, LDS_BYTES) != hipSuccess || per_cu < 1) { fprintf(stderr, "kernel_launch: occupancy query says %d\n", per_cu); }
        (void)hipGetLastError();
        grid = cus;
    }
    if (grid < 0) return;
    (void)hipMemsetAsync((char*)d_ws + WS_CTL, 0, CTL_ZERO_USED, stream);
    Args a{};
    for (int i = 0; i < 30; ++i) a.in[i] = (const float*)d_in[i];
    a.out = (float*)d_out; a.ws = (unsigned char*)d_ws;
#ifndef PLAIN_LAUNCH
    if (MK_N_LAUNCHES == 1) { a.ph_lo = 0; a.ph_hi = N_PHASES; void* kargs[] = {(void*)&a};
        const hipError_t e = hipLaunchCooperativeKernel((const void*)mega_fwd, dim3(grid), dim3(NWAVES * 64), kargs, LDS_BYTES, stream);
        if (e != hipSuccess) fprintf(stderr, "kernel_launch: cooperative launch failed: %s\n", hipGetErrorString(e)); }
#else
    if (MK_N_LAUNCHES == 1) { a.ph_lo = 0; a.ph_hi = N_PHASES; hipLaunchKernelGGL(mega_fwd, dim3(grid), dim3(NWAVES * 64), LDS_BYTES, stream, a); }
#endif
    else for (int p = 0; p < N_PHASES; ++p) { a.ph_lo = p; a.ph_hi = p + 1; hipLaunchKernelGGL(mega_fwd, dim3(grid), dim3(NWAVES * 64), LDS_BYTES, stream, a); }
}
```

```cpp
#include <hip/hip_runtime.h>
#include <cstdio>
#include <cstdint>
#define MK_N_LAUNCHES 1
namespace pg8 {
#define PG8_LAS __attribute__((address_space(3)))
typedef unsigned short bf16_t;
typedef short bf16x8 __attribute__((ext_vector_type(8)));
typedef float f32x4 __attribute__((ext_vector_type(4)));
typedef unsigned u32x4 __attribute__((ext_vector_type(4)));
typedef unsigned u32x2 __attribute__((ext_vector_type(2)));
typedef int v4i32 __attribute__((ext_vector_type(4)));
typedef int v8i32 __attribute__((ext_vector_type(8)));
constexpr int BIAS_LDS_OFF = 156 * 1024;
constexpr int BM = 256, BK = 64, HALF = 128, HTB = HALF * BK * 2  , STAGE_BYTES = 8 * HTB, NXCD = 8, WGM = 8;

__host__ __device__ __forceinline__ int lds_byte(int r, int c) { const int st = (r >> 4) * 2 + (c >> 5), rr = r & 15, cc = c & 31, ob = rr * 64 + cc * 2; return st * 1024 + (ob ^ (((ob >> 9) & 1) << 5)); }
__host__ __device__ __forceinline__ void stage_rc(int b, int& R, int& C) { const int st = b / 1024, sb = b % 1024, swz = sb ^ (((sb >> 9) & 1) << 5); R = (st >> 1) * 16 + swz / 64; C = (st & 1) * 32 + (swz % 64) / 2; }

struct Unit { int arow, brow, pm, pn, e, nrow, kind, aux; };
struct Gemm { const bf16_t* A; const bf16_t* Bt; int lda, ldb, K; };

struct DenseOrder {
    static constexpr bool GATHER = false;
    __device__ __forceinline__ void a_ready(const Unit&) const {}
    __device__ __forceinline__ void done(const Unit&) const {}
    int nM, nN, nwg, G, c;
    __device__ __forceinline__ void init(int M, int N, int G_, int c_) { nM = M / BM; nN = N / BM; nwg = nM * nN; G = G_; c = c_; }
    __device__ __forceinline__ bool next(int i, Unit& u) const {
        const long L = (long)i * G + c; if (L >= nwg) return false;
        int wgid = (int)L; { const int q = nwg / NXCD, r = nwg % NXCD, xcd = wgid % NXCD, off = wgid / NXCD; wgid = (xcd < r ? xcd * (q + 1) : r * (q + 1) + (xcd - r) * q) + off; }
        const int nig = WGM * nN, gid = wgid / nig, fm = gid * WGM, gsz = (nM - fm) < WGM ? (nM - fm) : WGM;
        u.pm = fm + ((wgid % nig) % gsz); u.pn = (wgid % nig) / gsz; u.arow = u.pm * BM; u.brow = u.pn * BM; u.e = 0; u.nrow = BM; u.kind = 0; u.aux = 0; return true;
    }
};

struct ColSubsetOrder {
    static constexpr bool GATHER = false;
    DenseOrder d; int base, split, skip;
    __device__ __forceinline__ void a_ready(const Unit&) const {}
    __device__ __forceinline__ void done(const Unit&) const {}
    __device__ __forceinline__ bool next(int i, Unit& u) const { if (!d.next(i, u)) return false; const int pa = base + (u.pn < split ? u.pn : u.pn + skip); u.pn = pa; u.brow = pa * BM; return true; }
};

template <class T_> struct has_bias_lds { template <class U_> static constexpr bool get(decltype(U_::BIAS_LDS)*) { return U_::BIAS_LDS; } template <class U_> static constexpr bool get(...) { return false; } static constexpr bool value = get<T_>(nullptr); };
template <class Epi, class Sched, bool F8 = false>
__device__ __forceinline__ int gemm_phase(PG8_LAS unsigned char* lds, const Gemm g, const Sched& S, const Epi& E) {
    const int tid = threadIdx.x, wid = __builtin_amdgcn_readfirstlane(tid >> 6), lane = tid & 63, wr = wid >> 2, wc = wid & 3, fr = lane & 15, fq = lane >> 4;
    const int K = g.K, nt = K / BK;
    PG8_LAS unsigned char* biaslds = lds + BIAS_LDS_OFF;
    constexpr bool GA = Sched::GATHER;
    unsigned voffA[2], voffB[2]; int gR[2]; unsigned gC[2];
#pragma unroll
    for (int i = 0; i < 2; ++i) { int R, C; stage_rc(tid * 16 + i * 8192, R, C); gR[i] = R; gC[i] = (unsigned)C * 2u;
        voffA[i] = (unsigned)(R * g.lda + C) * 2u; voffB[i] = (unsigned)(R * g.ldb + C) * 2u; }
    unsigned gA_cur[2][2], gA_nxt[2][2];
#define PG8_GATH(dst, un) do { _Pragma("unroll") for (int _h = 0; _h < 2; ++_h) _Pragma("unroll") for (int _i = 0; _i < 2; ++_i) dst[_h][_i] = (unsigned)S.arow_of(un, _h * HALF + gR[_i]) * (unsigned)(g.lda * 2) + gC[_i]; } while (0)
#define PG8_STAGE_A(bufoff, h, kbytes, nx) do { if constexpr (GA) { const char* gb_ = (const char*)g.A + (kbytes); _Pragma("unroll") for (int _i = 0; _i < 2; ++_i) { const unsigned vo_ = (nx) ? gA_nxt[h][_i] : gA_cur[h][_i]; \
        __builtin_amdgcn_global_load_lds((const unsigned*)(gb_ + vo_), (PG8_LAS unsigned*)(lds + (bufoff) + ldsw + _i * 8192), 16, 0, 0); } } \
    else { const char* gb_ = ((nx) ? nA : cA) + (kbytes) + (h) * hstepA; PG8_STAGE(bufoff, gb_, voffA); } } while (0)
    const size_t kstep = (size_t)(BK * 2);
    const size_t hstepA = (size_t)HALF * g.lda * 2, hstepB = (size_t)HALF * g.ldb * 2;
    const size_t rowA = (size_t)g.lda * 2, rowB = (size_t)g.ldb * 2;
    const unsigned ldsw = (unsigned)wid * 1024u;
    const int aoff = lds_byte(wr * 64 + fr, fq * 8), boff = lds_byte(wc * 32 + fr, fq * 8);
#define PG8_SA(b, h) (((b) * 2 + (h)) * HTB)
#define PG8_SB(b, h) ((4 + (b) * 2 + (h)) * HTB)
#define PG8_STAGE(bufoff, gbase, voff) do { _Pragma("unroll") for (int _i = 0; _i < 2; ++_i) \
        __builtin_amdgcn_global_load_lds((const unsigned*)((const char*)(gbase) + (voff)[_i]), (PG8_LAS unsigned*)(lds + (bufoff) + ldsw + _i * 8192), 16, 0, 0); } while (0)
#define PG8_LDA(dst, b, h) do { _Pragma("unroll") for (int m = 0; m < 4; ++m) { if constexpr (F8) { const v4i32 lo_ = *(const PG8_LAS v4i32*)(lds + PG8_SA(b, h) + aoff + m * 2048), hi_ = *(const PG8_LAS v4i32*)(lds + PG8_SA(b, h) + aoff + m * 2048 + 1024); dst##8[m] = __builtin_shufflevector(lo_, hi_, 0, 1, 2, 3, 4, 5, 6, 7); } \
        else { _Pragma("unroll") for (int k = 0; k < 2; ++k) dst[m][k] = *(const PG8_LAS bf16x8*)(lds + PG8_SA(b, h) + aoff + m * 2048 + k * 1024); } } } while (0)
#define PG8_LDB(dst, b, h) do { _Pragma("unroll") for (int n = 0; n < 2; ++n) { if constexpr (F8) { const v4i32 lo_ = *(const PG8_LAS v4i32*)(lds + PG8_SB(b, h) + boff + n * 2048), hi_ = *(const PG8_LAS v4i32*)(lds + PG8_SB(b, h) + boff + n * 2048 + 1024); dst##8[n] = __builtin_shufflevector(lo_, hi_, 0, 1, 2, 3, 4, 5, 6, 7); } \
        else { _Pragma("unroll") for (int k = 0; k < 2; ++k) dst[n][k] = *(const PG8_LAS bf16x8*)(lds + PG8_SB(b, h) + boff + n * 2048 + k * 1024); } } } while (0)
#define PG8_MMA(ai, bj, At, Bt) do { __builtin_amdgcn_s_setprio(1); _Pragma("unroll") for (int m = 0; m < 4; ++m) _Pragma("unroll") for (int n = 0; n < 2; ++n) { \
        if constexpr (F8) { asm("v_mfma_scale_f32_16x16x128_f8f6f4 %0, %1, %2, %0, %3, %3 op_sel_hi:[0,0,0]" : "+v"(acc[ai][bj][m][n]) : "v"(Bt##8[n]), "v"(At##8[m]), "v"(one_scale)); } \
        else { _Pragma("unroll") for (int k = 0; k < 2; ++k) acc[ai][bj][m][n] = __builtin_amdgcn_mfma_f32_16x16x32_bf16(Bt[n][k], At[m][k], acc[ai][bj][m][n], 0, 0, 0); } } \
        __builtin_amdgcn_s_setprio(0); } while (0)
#define PG8_WAIT_V(n) asm volatile("s_waitcnt vmcnt(" #n ")" ::: "memory")
#define PG8_WAIT_L(n) asm volatile("s_waitcnt lgkmcnt(" #n ")" ::: "memory")
#define PG8_BAR __builtin_amdgcn_s_barrier()
#define PG8_SCHED __builtin_amdgcn_sched_barrier(0)
    Unit cur, nxt; int ui = 0;
    if (!S.next(0, cur)) return 0;
    f32x4 acc[2][2][4][2];
#pragma unroll
    for (int a = 0; a < 2; ++a)
#pragma unroll
        for (int b = 0; b < 2; ++b)
#pragma unroll
            for (int m = 0; m < 4; ++m)
#pragma unroll
                for (int n = 0; n < 2; ++n) acc[a][b][m][n] = (f32x4){0.f, 0.f, 0.f, 0.f};
    const int one_scale = 0x7f7f7f7f;
    bf16x8 At[4][2], B0[2][2], B1[2][2];
    v8i32 At8[4], B08[2], B18[2];
    const char* cA = GA ? (const char*)g.A : (const char*)g.A + (size_t)cur.arow * rowA; const char* cB = (const char*)g.Bt + (size_t)cur.brow * rowB; const char* nA = cA;
    if constexpr (GA) { PG8_GATH(gA_cur, cur); }
    S.a_ready(cur);
    PG8_STAGE(PG8_SB(0, 0), cB, voffB); PG8_STAGE(PG8_SB(0, 1), cB + hstepB, voffB); PG8_STAGE_A(PG8_SA(0, 0), 0, 0, false); PG8_STAGE_A(PG8_SA(0, 1), 1, 0, false);
    if (wr == 1) PG8_BAR;
    PG8_WAIT_V(2); PG8_BAR;
    PG8_STAGE(PG8_SB(1, 0), cB + kstep, voffB); PG8_STAGE_A(PG8_SA(1, 0), 0, kstep, false); PG8_STAGE(PG8_SB(1, 1), cB + hstepB + kstep, voffB);
    PG8_WAIT_V(6); PG8_BAR;
    for (;;) {
        const bool has_next = S.next(ui + 1, nxt);
        if constexpr (has_bias_lds<Epi>::value) E.stage_bias(biaslds + (ui & 1) * 1024, cur, wid, lane);
        nA = GA ? cA : (has_next ? (const char*)g.A + (size_t)nxt.arow * rowA : cA); const char* nB = has_next ? (const char*)g.Bt + (size_t)nxt.brow * rowB : cB;
        if constexpr (GA) { if (has_next) { PG8_GATH(gA_nxt, nxt); } else { _Pragma("unroll") for (int _h = 0; _h < 2; ++_h) _Pragma("unroll") for (int _i = 0; _i < 2; ++_i) gA_nxt[_h][_i] = gA_cur[_h][_i]; } }
#pragma unroll 1
        for (int t = 0; t < nt; t += 2) {
            const bool last = (t == nt - 2);
            if (last && has_next) S.a_ready(nxt);
            const size_t k1 = (size_t)(t + 1) * kstep, k2 = last ? (size_t)0 : (size_t)(t + 2) * kstep, k3 = k2 + kstep;
            const char* b2 = last ? nB : cB + (size_t)(t + 2) * kstep; const char* b3 = b2 + kstep;
            PG8_LDB(B0, 0, 0); PG8_LDB(B1, 0, 1); PG8_SCHED; PG8_LDA(At, 0, 0); PG8_STAGE_A(PG8_SA(1, 1), 1, k1, false);
            PG8_WAIT_V(8); PG8_WAIT_L(0); PG8_BAR; PG8_MMA(0, 0, At, B0); PG8_MMA(0, 1, At, B1); PG8_BAR; PG8_SCHED;
            PG8_LDA(At, 0, 1); PG8_STAGE(PG8_SB(0, 0), b2, voffB); PG8_STAGE(PG8_SB(0, 1), b2 + hstepB, voffB); PG8_STAGE_A(PG8_SA(0, 0), 0, k2, last);
            PG8_WAIT_V(8); PG8_WAIT_L(0); PG8_BAR; PG8_MMA(1, 0, At, B0); PG8_MMA(1, 1, At, B1); PG8_BAR; PG8_SCHED;
            PG8_LDB(B0, 1, 0); PG8_LDB(B1, 1, 1); PG8_SCHED; PG8_LDA(At, 1, 0); PG8_STAGE_A(PG8_SA(0, 1), 1, k2, last);
            PG8_WAIT_V(8); PG8_WAIT_L(0); PG8_BAR; PG8_MMA(0, 0, At, B0); PG8_MMA(0, 1, At, B1); PG8_BAR; PG8_SCHED;
            PG8_LDA(At, 1, 1); PG8_STAGE(PG8_SB(1, 0), b3, voffB); PG8_STAGE(PG8_SB(1, 1), b3 + hstepB, voffB); PG8_STAGE_A(PG8_SA(1, 0), 0, k3, last);
            PG8_WAIT_V(8); PG8_WAIT_L(0); PG8_BAR; PG8_MMA(1, 0, At, B0); PG8_MMA(1, 1, At, B1); PG8_BAR; PG8_SCHED;
        }
        if (wr == 0) PG8_BAR;
        if constexpr (has_bias_lds<Epi>::value) E(acc, cur, wr, wc, fr, fq, (const PG8_LAS float*)(biaslds + (ui & 1) * 1024)); else E(acc, cur, wr, wc, fr, fq);
        S.done(cur);
        if (!has_next) break;
#pragma unroll
        for (int a = 0; a < 2; ++a)
#pragma unroll
            for (int b = 0; b < 2; ++b)
#pragma unroll
                for (int m = 0; m < 4; ++m)
#pragma unroll
                    for (int n = 0; n < 2; ++n) acc[a][b][m][n] = (f32x4){0.f, 0.f, 0.f, 0.f};
        cur = nxt; cA = nA; cB = nB; ++ui;
        if constexpr (GA) { _Pragma("unroll") for (int _h = 0; _h < 2; ++_h) _Pragma("unroll") for (int _i = 0; _i < 2; ++_i) gA_cur[_h][_i] = gA_nxt[_h][_i]; }
        if (wr == 1) PG8_BAR;
    }
    PG8_WAIT_V(0);
    PG8_BAR;
    const int n_done_ = ui + 1;
#undef PG8_SA
#undef PG8_SB
#undef PG8_STAGE
#undef PG8_STAGE_A
#undef PG8_GATH
#undef PG8_LDA
#undef PG8_LDB
#undef PG8_MMA
#undef PG8_WAIT_V
#undef PG8_WAIT_L
#undef PG8_BAR
#undef PG8_SCHED
    return n_done_;
}
}
constexpr int NWAVES = 8;
constexpr int BATCH = 2, SEQ = 8192, T = BATCH * SEQ, D = 1024, NH = 8, HD = 64, AW = 512, SW = 512, NG = 32, NP = 64, GS16 = 16;
constexpr int NE = 32, FF = 1024, INW = 4096, TOPK = 4, NBLK = SEQ / 256;
constexpr float NORM_EPS = 1e-6f;
constexpr float C2 = 0.125f * 1.4426950408889634f;
constexpr int XROWS = T * TOPK + 256;

constexpr size_t MiB = 1u << 20;
constexpr size_t WS_CTL = 0, CTL_ZERO_BYTES = 1 * MiB;
constexpr size_t WS_ADA = 1 * MiB;
constexpr size_t WS_ADAF = WS_ADA + 832 * 1024;
constexpr size_t WS_ROPE = 2 * MiB;
constexpr size_t WS_S5P = 6 * MiB;
constexpr size_t WS_S5KT = 7 * MiB;
constexpr size_t WS_S5M1 = 10 * MiB;
constexpr size_t WS_S5WC = 506 * MiB;
constexpr size_t WS_S5E = 408 * MiB;
constexpr size_t WS_ROUTE = 9 * MiB;
constexpr size_t WS_ELIST = 14 * MiB; constexpr int ELCAP = T;
constexpr size_t WS_HSC = WS_ROUTE + 768 * 1024;
constexpr int PAR_WSC = 270000, PAR_WSC1 = 270001;
#ifndef MOE_BF16
#define MOE_F8 1
#endif
constexpr size_t WS_WIN_T = 18 * MiB, WS_WGLU_T = 26 * MiB, WS_WSB_T = 27 * MiB, WS_WAB_T = 28 * MiB, WS_WOUT_T = 29 * MiB;
constexpr size_t WS_PAR = 16 * MiB;
constexpr int PAR_MPG = 0, PAR_FPRE = 1024, PAR_FPOST = 2048, PAR_RB = 3072, PAR_RW = 4096, PAR_BG = 36864, PAR_BU = 69632, PAR_BD = 102400, PAR_CRE = 135168, PAR_CIM = 167936, PAR_SD = 200704, PAR_BRE = 201728, PAR_BIM = 234496;
constexpr size_t WS_WGU_T = 32 * MiB, WS_WDN_T = 160 * MiB;
constexpr size_t WS_XN = 224 * MiB;
constexpr size_t WS_UA = 256 * MiB, WS_Q = 280 * MiB, WS_K = 296 * MiB, WS_V = 312 * MiB, WS_VT = 328 * MiB;
constexpr size_t WS_MIX = 256 * MiB;
constexpr size_t WS_GS = 344 * MiB, WS_GA = 376 * MiB;
constexpr size_t WS_YG = 408 * MiB, WS_Y2 = 424 * MiB, WS_YA = 440 * MiB;
constexpr size_t WS_M1 = 456 * MiB;
constexpr size_t WS_H2 = 480 * MiB;
constexpr size_t WS_WIN8 = 96 * MiB, WS_XN8 = 100 * MiB;
constexpr size_t WS_X1B = 416 * MiB;
constexpr size_t WS_XG = 224 * MiB, WS_YB = 224 * MiB;
constexpr size_t WS_H1 = 352 * MiB;
constexpr size_t WS_END = 512 * MiB;
static_assert(WS_YB + (size_t)T * TOPK * D * 2 <= WS_H1 && WS_H1 + (size_t)T * TOPK * FF * 2 <= WS_H2 && WS_H2 + (size_t)T * D * 2 <= WS_END, "ws map");
constexpr int CW_TMO = 0, CW_CODE = 1, CW_BAR = 4096, CW_ECNT = 10240, ECNT_STRIDE = 32, CW_KM = 16384;
constexpr size_t CTL_ZERO_USED = (size_t)(CW_KM + BATCH * NH * NBLK * HD) * 4;
static_assert(CTL_ZERO_USED <= CTL_ZERO_BYTES, "ctl");

constexpr int RING_OFF = 0, RING_BYTES = 131072;
constexpr int LDSCTL_OFF = 152 * 1024, MISC_OFF = LDSCTL_OFF + 320;
constexpr int LDS_BYTES = 158 * 1024;

#define GAS __attribute__((address_space(1)))
#define LAS __attribute__((address_space(3)))
typedef unsigned short bf16;
typedef unsigned v4u __attribute__((ext_vector_type(4)));
typedef unsigned v2u __attribute__((ext_vector_type(2)));
typedef float f32x4 __attribute__((ext_vector_type(4)));
typedef GAS unsigned gu32;
#define RLX_AGENT __ATOMIC_RELAXED, __HIP_MEMORY_SCOPE_AGENT
#define LDS_WAIT() asm volatile("s_waitcnt lgkmcnt(0)" ::: "memory")
#define VM_WAIT() asm volatile("s_waitcnt vmcnt(0)" ::: "memory")
__device__ __forceinline__ unsigned f2bf(float f) { unsigned u = __builtin_bit_cast(unsigned, f); return (u + 0x7fffu + ((u >> 16) & 1u)) >> 16; }
__device__ __forceinline__ unsigned pk2(float lo, float hi) { typedef float f32x2_t __attribute__((ext_vector_type(2))); typedef __bf16 bf16x2_t __attribute__((ext_vector_type(2)));
    f32x2_t v = {lo, hi}; bf16x2_t r = __builtin_convertvector(v, bf16x2_t); return __builtin_bit_cast(unsigned, r); }
#ifdef WT_STORES
__device__ __forceinline__ void st16(void* p, v4u v) { asm volatile("global_store_dwordx4 %0, %1, off sc1\n\ts_nop 1" :: "v"(p), "v"(v) : "memory"); }
__device__ __forceinline__ void st8(void* p, v2u v) { asm volatile("global_store_dwordx2 %0, %1, off sc1\n\ts_nop 1" :: "v"(p), "v"(v) : "memory"); }
#else
__device__ __forceinline__ void st16(void* p, v4u v) { *(v4u*)p = v; }
__device__ __forceinline__ void st8(void* p, v2u v) { *(v2u*)p = v; }
#endif
__device__ __forceinline__ unsigned pk4_fp8(float a, float b, float c, float d) {
    a = fminf(fmaxf(a, -448.f), 448.f); b = fminf(fmaxf(b, -448.f), 448.f); c = fminf(fmaxf(c, -448.f), 448.f); d = fminf(fmaxf(d, -448.f), 448.f);
    int w = 0; w = __builtin_amdgcn_cvt_pk_fp8_f32(a, b, w, false); w = __builtin_amdgcn_cvt_pk_fp8_f32(c, d, w, true); return (unsigned)w; }
__device__ __forceinline__ float bflo(unsigned w) { return __builtin_bit_cast(float, w << 16); }
__device__ __forceinline__ float bfhi(unsigned w) { return __builtin_bit_cast(float, w & 0xffff0000u); }
__device__ __forceinline__ float bf2f(bf16 h) { return __builtin_bit_cast(float, (unsigned)h << 16); }
__device__ __forceinline__ float sigmoidf_(float x) { return 1.f / (1.f + __expf(-x)); }
__device__ __forceinline__ float gelu_tanh(float x) { const float u = 1.5957691216057308f * (x + 0.044715f * x * x * x); return x / (1.f + __expf(-u)); }

#define XB_TMO      128
#define XB_XCNT(j)  (256  + 64 * (j))
#define XB_XSUB(j)  (1280 + 64 * (j))
#define XB_XGEN(j)  (2304 + 64 * (j))
#define XB_TOP      3328
#define XB_TOPGEN   3392
#define XCD_BAR_WORDS 3456
#define XB_SPIN_CAP (1u << 18)
__device__ __forceinline__ unsigned xb_ld(unsigned* p)              { return __hip_atomic_load(p, __ATOMIC_RELAXED, __HIP_MEMORY_SCOPE_AGENT); }
__device__ __forceinline__ unsigned xb_add(unsigned* p, unsigned v) { return __hip_atomic_fetch_add(p, v, __ATOMIC_RELAXED, __HIP_MEMORY_SCOPE_AGENT); }
__device__ __forceinline__ unsigned xb_xcc_id() { return (unsigned)__builtin_amdgcn_s_getreg((3 << 11) | 20) & 0xFu; }
#define XB_SPIN(cond, bar) do { unsigned _sp = 0; while (cond) { __builtin_amdgcn_s_sleep(1); \
    if ((++_sp & 255u) == 0u) { if (xb_ld(&(bar)[XB_TMO])) break; if (_sp > XB_SPIN_CAP) { atomicAdd(&(bar)[XB_TMO], 1u); break; } } } } while (0)
struct XcdBarrier { unsigned* bar; unsigned x; volatile LAS unsigned* st; };
__device__ __forceinline__ XcdBarrier xcd_barrier_post(unsigned* bar, volatile LAS unsigned* st) {
    XcdBarrier b; b.bar = bar; b.x = xb_xcc_id(); b.st = st;
    if (threadIdx.x == 0) (void)xb_add(&bar[XB_XCNT(b.x)], 1u);
    return b;
}
__device__ __forceinline__ void xcd_barrier_complete(unsigned* bar, unsigned x, unsigned& nloc, unsigned& nx) {
    const unsigned G = gridDim.x * gridDim.y * gridDim.z;
    unsigned sum, cnt, mine, sp = 0u;
    for (;;) {
        sum = 0u; cnt = 0u; mine = 0u;
#pragma unroll
        for (unsigned j = 0; j < 16; ++j) { const unsigned c = xb_ld(&bar[XB_XCNT(j)]); sum += c; cnt += (c > 0u) ? 1u : 0u; mine = (j == x) ? c : mine; }
        if (sum == G) break;
        __builtin_amdgcn_s_sleep(1);
        if ((++sp & 255u) == 0u) { if (xb_ld(&bar[XB_TMO])) break; if (sp > XB_SPIN_CAP) { atomicAdd(&bar[XB_TMO], 1u); break; } }
    }
    nloc = mine > 0u ? mine : 1u; nx = cnt > 0u ? cnt : 1u;
}
__device__ __forceinline__ void xcd_barrier(const XcdBarrier& b) {
    asm volatile("s_waitcnt vmcnt(0)" ::: "memory");
    __syncthreads();
    if (threadIdx.x == 0) {
        unsigned* bar = b.bar;
        __builtin_amdgcn_s_waitcnt(0);
        unsigned nloc = b.st[0], nx = b.st[1];
        if (nloc == 0u) { xcd_barrier_complete(bar, b.x, nloc, nx); b.st[0] = nloc; b.st[1] = nx; }
        const unsigned old = xb_add(&bar[XB_XSUB(b.x)], 1u);
        const unsigned gen = old / nloc;
        if (old + 1u == (gen + 1u) * nloc) {
            __builtin_amdgcn_fence(__ATOMIC_RELEASE, "agent");
            asm volatile("s_waitcnt vmcnt(0)" ::: "memory");
            const unsigned og = xb_add(&bar[XB_TOP], 1u);
            const unsigned tg = og / nx;
            if (og + 1u == (tg + 1u) * nx) xb_add(&bar[XB_TOPGEN], 1u);
            else XB_SPIN(xb_ld(&bar[XB_TOPGEN]) == tg, bar);
            __builtin_amdgcn_fence(__ATOMIC_ACQUIRE, "agent");
            xb_add(&bar[XB_XGEN(b.x)], 1u);
            asm volatile("s_waitcnt vmcnt(0)" ::: "memory");
        } else {
            XB_SPIN(xb_ld(&bar[XB_XGEN(b.x)]) == gen, bar);
            __builtin_amdgcn_fence(__ATOMIC_ACQUIRE, "agent");
            asm volatile("s_waitcnt vmcnt(0)" ::: "memory");
        }
    }
    __syncthreads();
}

__device__ __forceinline__ float wave_sum(float v) {
#pragma unroll
    for (int o = 1; o < 64; o <<= 1) v += __shfl_xor(v, o);
    return v;
}
__device__ __forceinline__ float wave_max(float v) {
#pragma unroll
    for (int o = 1; o < 64; o <<= 1) v = fmaxf(v, __shfl_xor(v, o));
    return v;
}
struct Frame {
    LAS unsigned char* lds;
    volatile LAS unsigned* MISC;
    gu32* ctl;
    int tid, lane, wave;
    int vcu, G;
    unsigned char* ws;
    const float* in[30];
    float* out;
};
#define WSP(T_, off) ((T_*)(F.ws + (off)))

__device__ __forceinline__ int perm8(int c) { return (c & ~31) + 16 * ((c >> 2) & 1) + 4 * ((c >> 3) & 3) + (c & 3); }
struct MapP8 { int off; __device__ __forceinline__ int operator()(int n) const { return off + perm8(n); } };
struct MapWin { __device__ __forceinline__ int operator()(int c) const {
    if (c < 512 || c >= 1536) return perm8(c);
    const int base = (c < 1024) ? 512 : 1024, cc = c - base, head = cc >> 6, d = cc & 63, pnq = head >> 2, hh = head & 3, n = d >> 5, dd = d & 31;
    const int wc = 2 * (hh & 1) + (dd >> 4), bj = hh >> 1, j = dd & 15;
    return base + 256 * pnq + 128 * bj + 32 * wc + 16 * n + j; } };
struct MapGU { int e, up; __device__ __forceinline__ int operator()(int f) const { return e * 2048 + (f >> 7) * 256 + up * 128 + perm8(f & 127); } };

template <class RowMap>
__device__ __forceinline__ void p0_transpose_item(const float* W, int K, int N, bf16* WT, LAS float* scr, int item, int lane, const RowMap rm) {
    const int nblk = N / 64, kb = item / nblk, nb = item % nblk, k0 = 64 * kb, n0 = 64 * nb;
    const int lr = lane >> 4, lc = 4 * (lane & 15);
    f32x4 v[16];
#pragma unroll
    for (int i = 0; i < 16; ++i) v[i] = __builtin_nontemporal_load((const GAS f32x4*)(W + (size_t)(k0 + 4 * i + lr) * N + n0 + lc));
#pragma unroll
    for (int i = 0; i < 16; ++i) { LAS float* d = scr + (4 * i + lr) * 65 + lc; d[0] = v[i].x; d[1] = v[i].y; d[2] = v[i].z; d[3] = v[i].w; }
    LDS_WAIT(); asm volatile("" ::: "memory");
    const int c = lane & 7;
#pragma unroll
    for (int j = 0; j < 8; ++j) { const int n = (lane >> 3) + 8 * j; const LAS float* s = scr + (8 * c) * 65 + n;
        v4u o; o.x = pk2(s[0 * 65], s[1 * 65]); o.y = pk2(s[2 * 65], s[3 * 65]); o.z = pk2(s[4 * 65], s[5 * 65]); o.w = pk2(s[6 * 65], s[7 * 65]);
        __builtin_nontemporal_store(o, (GAS v4u*)(WT + (size_t)rm(n0 + n) * K + k0 + 8 * c)); }
    LDS_WAIT(); asm volatile("" ::: "memory");
}

template <class RowMap>
__device__ __forceinline__ void p0_transpose_item_f8(const float* W, int K, int N, unsigned char* WT, LAS float* scr, int item, int lane, const RowMap rm, float wsc) {
    const int nblk = N / 64, kb = item / nblk, nb = item % nblk, k0 = 64 * kb, n0 = 64 * nb;
    const int lr = lane >> 4, lc = 4 * (lane & 15);
    f32x4 v[16];
#pragma unroll
    for (int i = 0; i < 16; ++i) v[i] = __builtin_nontemporal_load((const GAS f32x4*)(W + (size_t)(k0 + 4 * i + lr) * N + n0 + lc));
#pragma unroll
    for (int i = 0; i < 16; ++i) { LAS float* d = scr + (4 * i + lr) * 65 + lc; d[0] = v[i].x * wsc; d[1] = v[i].y * wsc; d[2] = v[i].z * wsc; d[3] = v[i].w * wsc; }
    LDS_WAIT(); asm volatile("" ::: "memory");
    const int c = lane & 3;
#pragma unroll
    for (int j = 0; j < 4; ++j) { const int n = (lane >> 2) + 16 * j; const LAS float* s = scr + (16 * c) * 65 + n;
        v4u o; o.x = pk4_fp8(s[0 * 65], s[1 * 65], s[2 * 65], s[3 * 65]); o.y = pk4_fp8(s[4 * 65], s[5 * 65], s[6 * 65], s[7 * 65]);
        o.z = pk4_fp8(s[8 * 65], s[9 * 65], s[10 * 65], s[11 * 65]); o.w = pk4_fp8(s[12 * 65], s[13 * 65], s[14 * 65], s[15 * 65]);
        __builtin_nontemporal_store(o, (GAS v4u*)(WT + (size_t)rm(n0 + n) * K + k0 + 16 * c)); }
    LDS_WAIT(); asm volatile("" ::: "memory");
}

__device__ __forceinline__ void p0_moe_load(const float* W, int item, int lane, f32x4 (&v)[16]) {
    const int kb = item >> 4, nb = item & 15, k0 = 64 * kb, n0 = 64 * nb, lr = lane >> 4, lc = 4 * (lane & 15);
#pragma unroll
    for (int i = 0; i < 16; ++i) v[i] = __builtin_nontemporal_load((const GAS f32x4*)(W + (size_t)(k0 + 4 * i + lr) * 1024 + n0 + lc));
}
__device__ __forceinline__ void p0_moe_finish(unsigned char* WT, int rowbase, int kind, int item, LAS float* scr, int lane, const f32x4 (&v)[16], float wsc) {
    const int kb = item >> 4, nb = item & 15, k0 = 64 * kb, n0 = 64 * nb, lr = lane >> 4, lc = 4 * (lane & 15);
#pragma unroll
    for (int i = 0; i < 16; ++i) { LAS float* d = scr + (4 * i + lr) * 65 + lc; d[0] = v[i].x * wsc; d[1] = v[i].y * wsc; d[2] = v[i].z * wsc; d[3] = v[i].w * wsc; }
    LDS_WAIT(); asm volatile("" ::: "memory");
    const int c = lane & 3;
#pragma unroll
    for (int j = 0; j < 4; ++j) { const int n = n0 + (lane >> 2) + 16 * j; const LAS float* s = scr + (16 * c) * 65 + (n - n0);
        const int row = rowbase + (kind < 2 ? (n >> 7) * 256 + kind * 128 + perm8(n & 127) : perm8(n));
        v4u o; o.x = pk4_fp8(s[0 * 65], s[1 * 65], s[2 * 65], s[3 * 65]); o.y = pk4_fp8(s[4 * 65], s[5 * 65], s[6 * 65], s[7 * 65]);
        o.z = pk4_fp8(s[8 * 65], s[9 * 65], s[10 * 65], s[11 * 65]); o.w = pk4_fp8(s[12 * 65], s[13 * 65], s[14 * 65], s[15 * 65]);
        __builtin_nontemporal_store(o, (GAS v4u*)(WT + (size_t)row * 1024 + k0 + 16 * c)); }
    LDS_WAIT(); asm volatile("" ::: "memory");
}

constexpr int MOE_ITEMS_ALL = 3 * NE * 256, MOE_ITEMS_P3 = 2048, MOE_ITEMS_P5 = 2048, MOE_ITEMS_P6 = 6144, MOE_ITEMS_P0 = MOE_ITEMS_ALL - MOE_ITEMS_P3 - MOE_ITEMS_P5 - MOE_ITEMS_P6;
__device__ __forceinline__ void p0_moe_range(Frame& F, int first, int count, int gw, int ngw, float wsc) {
    LAS float* scr = (LAS float*)(F.lds + RING_OFF + F.wave * 16640);
    const float* wg = F.in[24]; const float* wu = F.in[26]; const float* wd = F.in[28];
    unsigned char* tgu = WSP(unsigned char, WS_WGU_T); unsigned char* tdn = WSP(unsigned char, WS_WDN_T);
#define P0_DEC(r_, W_, WT_, rb_, kd_, it_) const int mat_##r_ = (first + (r_)) >> 8, it_ = (first + (r_)) & 255, kd_ = mat_##r_ >> 5, e_##r_ = mat_##r_ & 31; \
    const float* W_ = (kd_ == 0 ? wg : (kd_ == 1 ? wu : wd)) + (size_t)e_##r_ * D * FF; unsigned char* WT_ = kd_ < 2 ? tgu : tdn; const int rb_ = kd_ < 2 ? e_##r_ * 2048 : e_##r_ * 1024;
    f32x4 va[16], vb[16]; int r = gw;
    if (r < count) { P0_DEC(r, W0, T0, b0, k0_, i0); (void)T0; (void)b0; (void)k0_; p0_moe_load(W0, i0, F.lane, va); }
    while (r < count) {
        { const int rn = r + ngw; if (rn < count) { P0_DEC(rn, W1, T1, b1, k1_, i1); (void)T1; (void)b1; (void)k1_; p0_moe_load(W1, i1, F.lane, vb); } }
        { P0_DEC(r, W2, T2, b2, k2_, i2); (void)W2; p0_moe_finish(T2, b2, k2_, i2, scr, F.lane, va, wsc); }
        r += ngw; if (r >= count) break;
        { const int rn = r + ngw; if (rn < count) { P0_DEC(rn, W3, T3, b3, k3_, i3); (void)T3; (void)b3; (void)k3_; p0_moe_load(W3, i3, F.lane, va); } }
        { P0_DEC(r, W4, T4, b4, k4_, i4); (void)W4; p0_moe_finish(T4, b4, k4_, i4, scr, F.lane, vb, wsc); }
        r += ngw;
    }
#undef P0_DEC
}
__device__ __forceinline__ void moe_convert_idle(Frame& F, int first, int count) {
    if (F.G != 256) { if (blockIdx.x == 0) { } }
    const int nb = F.G == 256 ? 128 : F.G, bi = F.G == 256 ? (int)blockIdx.x - 128 : (int)blockIdx.x;
    if (bi < 0) return;
    p0_moe_range(F, first, count, bi * NWAVES + F.wave, nb * NWAVES, WSP(float, WS_PAR)[PAR_WSC]);
}

__device__ __forceinline__ void phase0(Frame& F) {
    LAS float* scr = (LAS float*)(F.lds + RING_OFF + F.wave * 16640);
    const int gw = F.vcu * NWAVES + F.wave, NGW = F.G * NWAVES;
#ifdef MOE_F8
    float wsc;
    { float am = 0.f;
      for (int j = F.tid; j < 2048; j += NWAVES * 64) { const size_t o = (size_t)j * 16384 + 37 * (j & 63);
          am = fmaxf(am, fmaxf(fabsf(F.in[24][o]), fmaxf(fabsf(F.in[26][o]), fabsf(F.in[28][o])))); }
      am = wave_max(am); LAS float* red = (LAS float*)(F.lds + LDSCTL_OFF + 64);
      if (F.lane == 0) red[F.wave] = am;
      __syncthreads();
      am = red[0];
#pragma unroll
      for (int w = 1; w < NWAVES; ++w) am = fmaxf(am, red[w]);
      wsc = exp2f(floorf(log2f(448.f / (fmaxf(am, 1e-30f) * 8.f))));
      if (blockIdx.x == 0 && F.tid == 0) WSP(float, WS_PAR)[PAR_WSC] = wsc;
      __syncthreads(); }
#endif
#if defined(G1_F8) || defined(G1_MIX)
    float wsc1;
    { float am = 0.f;
      for (int j = F.tid; j < 2048; j += NWAVES * 64) am = fmaxf(am, fabsf(F.in[9][(size_t)j * 2048 + 37 * (j & 31)]));
      am = wave_max(am); LAS float* red = (LAS float*)(F.lds + LDSCTL_OFF + 64);
      if (F.lane == 0) red[F.wave] = am;
      __syncthreads();
      am = red[0];
#pragma unroll
      for (int w = 1; w < NWAVES; ++w) am = fmaxf(am, red[w]);
      wsc1 = exp2f(floorf(log2f(448.f / (fmaxf(am, 1e-30f) * 8.f))));
      if (blockIdx.x == 0 && F.tid == 0) WSP(float, WS_PAR)[PAR_WSC1] = wsc1;
      __syncthreads(); }
#endif
    constexpr int I_WIN = 16 * 64, I_GLU = 8 * 8, I_SB = 8 * 16, I_AB = 8 * 16, I_OUT = 16 * 16, I_E = 16 * 16;
    constexpr int I_SMALL = I_WIN + I_GLU + I_SB + I_AB + I_OUT, I_MOE = 3 * NE * I_E, I_ADA = 16 * 96;
    constexpr int NITEMS = I_SMALL + I_MOE + I_ADA;
    for (int it = gw; it < NITEMS; it += NGW) {
        int r = it;
#if defined(G1_MIX)
        if (r < I_WIN) { p0_transpose_item(F.in[9], D, INW, WSP(bf16, WS_WIN_T), scr, r, F.lane, MapWin{}); p0_transpose_item_f8(F.in[9], D, INW, WSP(unsigned char, WS_WIN8), scr, r, F.lane, MapWin{}, wsc1); continue; } r -= I_WIN;
#elif defined(G1_F8)
        if (r < I_WIN) { p0_transpose_item_f8(F.in[9], D, INW, WSP(unsigned char, WS_WIN_T), scr, r, F.lane, MapWin{}, wsc1); continue; } r -= I_WIN;
#else
        if (r < I_WIN) { p0_transpose_item(F.in[9], D, INW, WSP(bf16, WS_WIN_T), scr, r, F.lane, MapWin{}); continue; } r -= I_WIN;
#endif
        if (r < I_GLU) { p0_transpose_item(F.in[18], SW, SW, WSP(bf16, WS_WGLU_T), scr, r, F.lane, MapP8{0}); continue; } r -= I_GLU;
        if (r < I_SB) { p0_transpose_item(F.in[19], SW, D, WSP(bf16, WS_WSB_T), scr, r, F.lane, MapP8{0}); continue; } r -= I_SB;
        if (r < I_AB) { p0_transpose_item(F.in[20], AW, D, WSP(bf16, WS_WAB_T), scr, r, F.lane, MapP8{0}); continue; } r -= I_AB;
        if (r < I_OUT) { p0_transpose_item(F.in[21], D, D, WSP(bf16, WS_WOUT_T), scr, r, F.lane, MapP8{0}); continue; } r -= I_OUT;
        if (r < I_MOE) {
#ifdef MOE_F8
            continue;
#endif
            const int mat = r / I_E, item = r % I_E, kind = mat / NE, e = mat % NE;
#ifdef MOE_F8
            if (kind == 0) p0_transpose_item_f8(F.in[24] + (size_t)e * D * FF, D, FF, WSP(unsigned char, WS_WGU_T), scr, item, F.lane, MapGU{e, 0}, wsc);
            else if (kind == 1) p0_transpose_item_f8(F.in[26] + (size_t)e * D * FF, D, FF, WSP(unsigned char, WS_WGU_T), scr, item, F.lane, MapGU{e, 1}, wsc);
            else p0_transpose_item_f8(F.in[28] + (size_t)e * FF * D, FF, D, WSP(unsigned char, WS_WDN_T), scr, item, F.lane, MapP8{e * 1024}, wsc);
#else
            if (kind == 0) p0_transpose_item(F.in[24] + (size_t)e * D * FF, D, FF, WSP(bf16, WS_WGU_T), scr, item, F.lane, MapGU{e, 0});
            else if (kind == 1) p0_transpose_item(F.in[26] + (size_t)e * D * FF, D, FF, WSP(bf16, WS_WGU_T), scr, item, F.lane, MapGU{e, 1});
            else p0_transpose_item(F.in[28] + (size_t)e * FF * D, FF, D, WSP(bf16, WS_WDN_T), scr, item, F.lane, MapP8{e * 1024});
#endif
            continue; }
        r -= I_MOE;
        {
            const int ks = r / 96, cc = r % 96, n = cc * 64 + F.lane;
            const float* cvec = F.in[1]; const float* aw = F.in[3];
            float a0 = 0.f, a1 = 0.f;
            for (int k0 = ks * 64; k0 < ks * 64 + 64; k0 += 16) {
                float w[16];
#pragma unroll
                for (int i = 0; i < 16; ++i) w[i] = __builtin_nontemporal_load(aw + (size_t)(k0 + i) * (6 * D) + n);
#pragma unroll
                for (int i = 0; i < 16; ++i) { const float c0 = cvec[k0 + i], c1 = cvec[D + k0 + i];
                    const float s0 = c0 / (1.f + __expf(-c0)), s1 = c1 / (1.f + __expf(-c1));
                    a0 += s0 * w[i]; a1 += s1 * w[i]; } }
            float* part = WSP(float, WS_ADA);
            part[(ks * 2 + 0) * (6 * D) + n] = a0; part[(ks * 2 + 1) * (6 * D) + n] = a1;
        }
    }
#ifdef MOE_F8
    p0_moe_range(F, 0, MOE_ITEMS_P0, gw, NGW, wsc);
#endif
    const int gt = F.vcu * (NWAVES * 64) + F.tid, NGT = F.G * NWAVES * 64;
    { const int* pos = (const int*)F.in[2]; float* rc = WSP(float, WS_ROPE); float* rs = rc + (size_t)T * 32;
      for (int i = gt; i < T * 32; i += NGT) { const int t = i >> 5, p = i & 31;
          const float invf = exp2f(-(float)p * (13.287712379549449f / 32.f));
          const double ang = (double)pos[t] * (double)invf; double rev = ang * 0.15915494309189535; rev -= floor(rev);
          const float fr = (float)rev;
          rc[i] = __builtin_amdgcn_cosf(fr); rs[i] = __builtin_amdgcn_sinf(fr); } }
    { float* P5 = WSP(float, WS_S5P);
      for (int i = gt; i < NG * NP; i += NGT) { const int g = i >> 6;
          const float dt = __expf(F.in[12][g]); const float lr = F.in[10][i], li = F.in[11][i];
          const float er = __expf(lr * dt); const double ang = (double)li * (double)dt; double rev = ang * 0.15915494309189535; rev -= floor(rev);
          const float cs = __builtin_amdgcn_cosf((float)rev), sn = __builtin_amdgcn_sinf((float)rev);
          float br = er * cs, bi = er * sn;
          P5[i] = br; P5[2048 + i] = bi;
          const float nr = br - 1.f, ni = bi, den = lr * lr + li * li;
          const float qr = (nr * lr + ni * li) / den, qi = (ni * lr - nr * li) / den;
          P5[8192 + i] = qr; P5[8192 + 2048 + i] = qi;
          float pr = br, pi_ = bi;
#pragma unroll
          for (int s = 0; s < 8; ++s) { const float tr = pr * pr - pi_ * pi_, ti = 2.f * pr * pi_; pr = tr; pi_ = ti; }
          P5[4096 + i] = pr; P5[6144 + i] = pi_;
          float* PW = P5 + 131072;
          float wr_ = 1.f, wi_ = 0.f;
#pragma unroll
          for (int k = 0; k <= 16; ++k) { PW[i * 17 + k] = wr_; PW[2048 * 17 + i * 17 + k] = wi_; const float tr = wr_ * br - wi_ * bi, ti = wr_ * bi + wi_ * br; wr_ = tr; wi_ = ti; } }
    }
}

__device__ __forceinline__ void phase1(Frame& F) {
    LAS float* A1 = (LAS float*)(F.lds + RING_OFF); LAS float* A2 = A1 + 2 * D;
    const float* part = WSP(float, WS_ADA); const float* ab = F.in[4]; const float* pg = F.in[5];
    for (int k = F.tid; k < D; k += NWAVES * 64)
#pragma unroll
        for (int b = 0; b < 2; ++b) { float sh = ab[k], sc = ab[D + k];
            for (int ks = 0; ks < 16; ++ks) { sh += part[(ks * 2 + b) * (6 * D) + k]; sc += part[(ks * 2 + b) * (6 * D) + D + k]; }
            A1[b * D + k] = pg[k] * (1.f + sc); A2[b * D + k] = sh; }
    const int gt = F.vcu * (NWAVES * 64) + F.tid, NGT = F.G * NWAVES * 64;
    { float* adaf = WSP(float, WS_ADAF);
      for (int n = gt; n < 2 * 6 * D; n += NGT) { const int b = n / (6 * D), j = n % (6 * D); float a = ab[j];
          for (int ks = 0; ks < 16; ++ks) a += part[(ks * 2 + b) * (6 * D) + j];
          adaf[n] = a; } }
    { float* par = WSP(float, WS_PAR);
      for (int i = gt; i < 32768; i += NGT) { par[PAR_RW + i] = F.in[22][i]; par[PAR_BG + i] = F.in[25][i]; par[PAR_BU + i] = F.in[27][i]; par[PAR_BD + i] = F.in[29][i];
          par[PAR_CRE + i] = F.in[15][i]; par[PAR_CIM + i] = F.in[16][i]; par[PAR_BRE + i] = F.in[13][i]; par[PAR_BIM + i] = F.in[14][i];
          if (i < 1024) { par[PAR_MPG + i] = F.in[6][i]; par[PAR_FPRE + i] = F.in[7][i]; par[PAR_FPOST + i] = F.in[8][i]; }
          if (i < 512) par[PAR_SD + i] = F.in[17][i];
          if (i < 32) par[PAR_RB + i] = F.in[23][i]; } }
    { const float* P5 = WSP(float, WS_S5P); const float* PWr = P5 + 131072; const float* PWi = PWr + 2048 * 17;
      bf16* M1t = WSP(bf16, WS_S5M1);
      for (int i = gt; i < NG * 256 * 256; i += NGT) { const int k = i & 255, n = (i >> 8) & 255, g = i >> 16; float val = 0.f;
          if (n < 128) { const int p = n & 63, gp = g * 64 + p, s_ = k >> 4, ci = k & 15;
              const float qr = P5[8192 + gp], qi = P5[8192 + 2048 + gp], b_r = F.in[13][gp * 16 + ci], b_i = F.in[14][gp * 16 + ci];
              const float bbr = qr * b_r - qi * b_i, bbi = qr * b_i + qi * b_r, wr_ = PWr[gp * 17 + 15 - s_], wi_ = PWi[gp * 17 + 15 - s_];
              val = (n < 64) ? (wr_ * bbr - wi_ * bbi) : (wr_ * bbi + wi_ * bbr); }
          M1t[((size_t)(g * 256 + perm8(n))) * 256 + k] = (bf16)f2bf(val); }
    }
    __syncthreads();
    const int gw = F.vcu * NWAVES + F.wave, NGW = F.G * NWAVES;
    bf16* XN = WSP(bf16, WS_XN);
    for (int m0 = gw * 2; m0 < T; m0 += NGW * 2) {
        const int b = m0 >> 13;
        f32x4 v[2][4];
#pragma unroll
        for (int q = 0; q < 2; ++q) { const GAS f32x4* xr = (const GAS f32x4*)(F.in[0] + (size_t)(m0 + q) * D) + F.lane;
#pragma unroll
            for (int j = 0; j < 4; ++j) v[q][j] = __builtin_nontemporal_load(xr + 64 * j); }
#pragma unroll
        for (int q = 0; q < 2; ++q) { float s = 0.f;
#pragma unroll
            for (int j = 0; j < 4; ++j) s += (v[q][j].x * v[q][j].x + v[q][j].y * v[q][j].y) + (v[q][j].z * v[q][j].z + v[q][j].w * v[q][j].w);
            const float rstd = 1.f / sqrtf(wave_sum(s) * (1.f / D) + NORM_EPS);
#ifdef G1_F8
            GAS unsigned* o4 = (GAS unsigned*)((unsigned char*)XN + (size_t)(m0 + q) * D) + F.lane;
#pragma unroll
            for (int j = 0; j < 4; ++j) { const f32x4 a1 = *(const LAS f32x4*)(A1 + b * D + 4 * F.lane + 256 * j), a2 = *(const LAS f32x4*)(A2 + b * D + 4 * F.lane + 256 * j);
                const f32x4 o = v[q][j] * rstd * a1 + a2;
                o4[64 * j] = pk4_fp8(8.f * o.x, 8.f * o.y, 8.f * o.z, 8.f * o.w); } }
#else
            GAS unsigned long long* o8 = (GAS unsigned long long*)(XN + (size_t)(m0 + q) * D) + F.lane;
#pragma unroll
            for (int j = 0; j < 4; ++j) { const f32x4 a1 = *(const LAS f32x4*)(A1 + b * D + 4 * F.lane + 256 * j), a2 = *(const LAS f32x4*)(A2 + b * D + 4 * F.lane + 256 * j);
                const f32x4 o = v[q][j] * rstd * a1 + a2;
                o8[64 * j] = (unsigned long long)pk2(o.x, o.y) | ((unsigned long long)pk2(o.z, o.w) << 32);
#ifdef G1_MIX
                ((GAS unsigned*)(WSP(unsigned char, WS_XN8) + (size_t)(m0 + q) * D) + F.lane)[64 * j] = pk4_fp8(8.f * o.x, 8.f * o.y, 8.f * o.z, 8.f * o.w);
#endif
            } }
#endif
    }
    __syncthreads();
}

struct EpiG1 {
    bf16 *UA, *Q, *K, *V, *VT, *GSp, *GAp; const float *rc, *rs; float* km; const float* wscp; bool f8;
    __device__ __forceinline__ void operator()(const pg8::f32x4 (&acc0)[2][2][4][2], const pg8::Unit& u, int wr, int wc, int fr, int fq) const {
        pg8::f32x4 (&acc)[2][2][4][2] = const_cast<pg8::f32x4 (&)[2][2][4][2]>(acc0);
#if defined(G1_F8) || defined(G1_MIX)
        if (f8) { const float s_ = 0.125f / *wscp;
#pragma unroll
            for (int a = 0; a < 2; ++a)
#pragma unroll
                for (int b = 0; b < 2; ++b)
#pragma unroll
                    for (int m = 0; m < 4; ++m)
#pragma unroll
                        for (int n = 0; n < 2; ++n) acc[a][b][m][n] = acc[a][b][m][n] * s_; }
#endif
        asm volatile("" : "+v"(fr), "+v"(fq));
        const int pn = u.pn, row0 = u.pm * 256 + wr * 64 + fr;
        if (pn < 2) {
#pragma unroll
            for (int ai = 0; ai < 2; ++ai)
#pragma unroll
                for (int m = 0; m < 4; ++m) { const int t = row0 + ai * 128 + m * 16, b = t >> 13, tt = t & (SEQ - 1), c = tt >> 4, s = tt & 15;
#pragma unroll
                    for (int bj = 0; bj < 2; ++bj) { const int ch = pn * 256 + bj * 128 + wc * 32 + 8 * fq, g = ch >> 4, ci = ch & 15;
                        const pg8::f32x4 v0 = acc[ai][bj][m][0], v1 = acc[ai][bj][m][1];
                        v4u w; w.x = pk2(v0[0], v0[1]); w.y = pk2(v0[2], v0[3]); w.z = pk2(v1[0], v1[1]); w.w = pk2(v1[2], v1[3]);
                        st16(UA + ((size_t)(g * 1024 + b * 512 + c) * 384 + 16 * s + ci), w); } }
        } else if (pn < 6) {
            const bool isk = pn >= 4; bf16* X = isk ? K : Q; const float sc = isk ? 1.f : C2;
            const int p0 = 16 * (wc & 1) + 4 * fq;
#pragma unroll
            for (int bj = 0; bj < 2; ++bj) {
                const int head = 4 * (pn & 1) + 2 * bj + (wc >> 1);
                int rowb = row0; asm volatile("" : "+v"(rowb));
                float ks[2][4];
#pragma unroll
                for (int b = 0; b < 2; ++b)
#pragma unroll
                    for (int i = 0; i < 4; ++i) ks[b][i] = 0.f;
#pragma unroll
                for (int ai = 0; ai < 2; ++ai)
#pragma unroll
                    for (int m = 0; m < 4; ++m) { const int t = rowb + ai * 128 + m * 16;
                        const pg8::f32x4 cs = *(const pg8::f32x4*)(rc + (size_t)t * 32 + p0), sn = *(const pg8::f32x4*)(rs + (size_t)t * 32 + p0);
                        const pg8::f32x4 t1 = acc[ai][bj][m][0], t2 = acc[ai][bj][m][1];
                        const pg8::f32x4 o1 = t1 * cs - t2 * sn, o2 = t2 * cs + t1 * sn;
                        v2u w1, w2; w1.x = pk2(o1[0] * sc, o1[1] * sc); w1.y = pk2(o1[2] * sc, o1[3] * sc); w2.x = pk2(o2[0] * sc, o2[1] * sc); w2.y = pk2(o2[2] * sc, o2[3] * sc);
                        bf16* dst = X + (size_t)t * AW + head * 64 + p0;
                        st8(dst, w1); st8(dst + 32, w2);
#pragma unroll
                        for (int i = 0; i < 4; ++i) { ks[0][i] += o1[i]; ks[1][i] += o2[i]; }
                        __builtin_amdgcn_sched_barrier(0); }
                if (isk) {
                    const int b = u.pm >> 5, blk = u.pm & 31;
#pragma unroll
                    for (int n = 0; n < 2; ++n)
#pragma unroll
                        for (int i = 0; i < 4; ++i) { float v = ks[n][i];
                            v += __shfl_xor(v, 1); v += __shfl_xor(v, 2); v += __shfl_xor(v, 4); v += __shfl_xor(v, 8);
                            if (fr == 0) atomicAdd(km + ((size_t)((b * NH + head) * NBLK + blk) * HD + 32 * n + p0 + i), v); }
                }
            }
        } else if (pn < 8) {
#pragma unroll
            for (int ai = 0; ai < 2; ++ai)
#pragma unroll
                for (int m = 0; m < 4; ++m) { const int t = row0 + ai * 128 + m * 16, b = t >> 13, tt = t & (SEQ - 1);
#pragma unroll
                    for (int bj = 0; bj < 2; ++bj) { const int cv = (pn - 6) * 256 + bj * 128 + wc * 32 + 8 * fq, head = cv >> 6, d = cv & 63;
                        const pg8::f32x4 v0 = acc[ai][bj][m][0], v1 = acc[ai][bj][m][1];
                        v4u w; w.x = pk2(v0[0], v0[1]); w.y = pk2(v0[2], v0[3]); w.z = pk2(v1[0], v1[1]); w.w = pk2(v1[2], v1[3]);
                        bf16* vt = VT + ((size_t)((b * NH + head) * HD + d) * SEQ + tt);
                        vt[0 * SEQ] = (bf16)(w.x & 0xffff); vt[1 * SEQ] = (bf16)(w.x >> 16); vt[2 * SEQ] = (bf16)(w.y & 0xffff); vt[3 * SEQ] = (bf16)(w.y >> 16);
                        vt[4 * SEQ] = (bf16)(w.z & 0xffff); vt[5 * SEQ] = (bf16)(w.z >> 16); vt[6 * SEQ] = (bf16)(w.w & 0xffff); vt[7 * SEQ] = (bf16)(w.w >> 16); } }
        } else {
            bf16* Gp = (pn < 12) ? GSp : GAp; const int cb = ((pn - 8) & 3) * 256;
#pragma unroll
            for (int ai = 0; ai < 2; ++ai)
#pragma unroll
                for (int m = 0; m < 4; ++m) { const int t = row0 + ai * 128 + m * 16;
#pragma unroll
                    for (int bj = 0; bj < 2; ++bj) { const int col = cb + bj * 128 + wc * 32 + 8 * fq;
                        const pg8::f32x4 v0 = acc[ai][bj][m][0], v1 = acc[ai][bj][m][1];
                        v4u w; w.x = pk2(sigmoidf_(v0[0]), sigmoidf_(v0[1])); w.y = pk2(sigmoidf_(v0[2]), sigmoidf_(v0[3]));
                        w.z = pk2(sigmoidf_(v1[0]), sigmoidf_(v1[1])); w.w = pk2(sigmoidf_(v1[2]), sigmoidf_(v1[3]));
                        __builtin_nontemporal_store(w, (v4u*)(Gp + (size_t)t * D + col)); } }
        }
    }
};

template <int MODE> struct EpiEw {
    bf16* O; const bf16* X1; const bf16* X2; float* Of; int ld;
    __device__ __forceinline__ void operator()(const pg8::f32x4 (&acc)[2][2][4][2], const pg8::Unit& u, int wr, int wc, int fr, int fq) const {
        const int row0 = u.pm * 256 + wr * 64 + fr, col0 = u.pn * 256 + wc * 32 + 8 * fq;
#pragma unroll
        for (int ai = 0; ai < 2; ++ai)
#pragma unroll
            for (int m = 0; m < 4; ++m) { const size_t rb = (size_t)(row0 + ai * 128 + m * 16) * ld + col0;
#pragma unroll
                for (int bj = 0; bj < 2; ++bj) { const size_t off = rb + bj * 128;
                    const pg8::f32x4 v0 = acc[ai][bj][m][0], v1 = acc[ai][bj][m][1];
                    if (MODE == 3) { *(pg8::f32x4*)(Of + off) = v0; *(pg8::f32x4*)(Of + off + 4) = v1; }
                    else if (MODE == 4) { v4u w; w.x = pk2(v0[0], v0[1]); w.y = pk2(v0[2], v0[3]); w.z = pk2(v1[0], v1[1]); w.w = pk2(v1[2], v1[3]); st16(O + off, w); }
                    else {
                        const v4u x = __builtin_nontemporal_load((const v4u*)(X1 + off));
                        float r[8] = {v0[0], v0[1], v0[2], v0[3], v1[0], v1[1], v1[2], v1[3]};
                        const float xv[8] = {bflo(x.x), bfhi(x.x), bflo(x.y), bfhi(x.y), bflo(x.z), bfhi(x.z), bflo(x.w), bfhi(x.w)};
                        if (MODE == 0) {
#pragma unroll
                            for (int i = 0; i < 8; ++i) r[i] = xv[i] * sigmoidf_(r[i]);
                        } else if (MODE == 1) {
#pragma unroll
                            for (int i = 0; i < 8; ++i) r[i] = xv[i] * r[i];
                        } else {
                            const v4u y = __builtin_nontemporal_load((const v4u*)(X2 + off));
                            const float yv[8] = {bflo(y.x), bfhi(y.x), bflo(y.y), bfhi(y.y), bflo(y.z), bfhi(y.z), bflo(y.w), bfhi(y.w)};
#pragma unroll
                            for (int i = 0; i < 8; ++i) r[i] = yv[i] + xv[i] * r[i];
                        }
                        v4u w; w.x = pk2(r[0], r[1]); w.y = pk2(r[2], r[3]); w.z = pk2(r[4], r[5]); w.w = pk2(r[6], r[7]);
                        st16(O + off, w); } } }
    }
};

typedef short bf16x8 __attribute__((ext_vector_type(8)));
typedef float f32x16 __attribute__((ext_vector_type(16)));
constexpr size_t WS_ALIST = 456 * MiB;
constexpr size_t WS_OP01 = 224 * MiB;
constexpr size_t WS_OP23 = 472 * MiB;
constexpr size_t WS_LSE = 504 * MiB;
constexpr int CW_BCNT = 12288;
constexpr int ALCAP = 8192;

__device__ __forceinline__ void attn_gate(Frame& F) {
    const int gw = F.vcu * NWAVES + F.wave, NGW = F.G * NWAVES, L = F.lane;
    const bf16* Q = WSP(bf16, WS_Q); const float* km = (const float*)(F.ctl + CW_KM);
    unsigned* bcnt = (unsigned*)(F.ctl + CW_BCNT); unsigned* list = WSP(unsigned, WS_ALIST); float* lse = WSP(float, WS_LSE);
    LAS float* kml = (LAS float*)(F.lds);
    for (int w0 = F.vcu * NWAVES; w0 < BATCH * NH * (SEQ / 64); w0 += NGW) {
        const int w = w0 + F.wave, bh = w0 >> 7;
        __syncthreads();
        { const f32x4 x = *(const f32x4*)(km + (size_t)bh * NBLK * HD + F.tid * 4); *(LAS f32x4*)(kml + F.tid * 4) = x; }
        __syncthreads();
        const int b = bh >> 3, h = bh & 7, tt = (w & 127) * 64 + L, t = b * SEQ + tt, blk = __builtin_amdgcn_readfirstlane(tt >> 8);
        float q[64];
        { const v4u* qp = (const v4u*)(Q + (size_t)t * AW + h * 64);
#pragma unroll
          for (int i = 0; i < 8; ++i) { const v4u x = qp[i]; q[8 * i] = bflo(x.x); q[8 * i + 1] = bfhi(x.x); q[8 * i + 2] = bflo(x.y); q[8 * i + 3] = bfhi(x.y);
              q[8 * i + 4] = bflo(x.z); q[8 * i + 5] = bfhi(x.z); q[8 * i + 6] = bflo(x.w); q[8 * i + 7] = bfhi(x.w); } }
        float v0 = -3e38f, v1 = -3e38f, v2 = -3e38f; int i0 = -1, i1 = -1, i2 = -1;
        for (int j = 0; j < blk; ++j) { const LAS float* kp = kml + j * HD; float g = 0.f;
#pragma unroll
            for (int d = 0; d < 64; d += 4) { const f32x4 k4 = *(const LAS f32x4*)(kp + d); g += q[d] * k4[0]; g += q[d + 1] * k4[1]; g += q[d + 2] * k4[2]; g += q[d + 3] * k4[3]; }
            if (g > v0) { v2 = v1; i2 = i1; v1 = v0; i1 = i0; v0 = g; i0 = j; }
            else if (g > v1) { v2 = v1; i2 = i1; v1 = g; i1 = j; }
            else if (g > v2) { v2 = g; i2 = j; } }
        float* lp = lse + ((size_t)t * NH + h) * 4;
        if (i0 < 0) lp[0] = -1e30f; if (i1 < 0) lp[1] = -1e30f; if (i2 < 0) lp[2] = -1e30f;
        int mycnt = 0;
        for (int j = 0; j < blk; ++j) { const bool sel = (i0 == j) || (i1 == j) || (i2 == j); const unsigned long long mask = __ballot(sel); if (L == j) mycnt = __popcll(mask); }
        unsigned mybase = 0u;
        if (mycnt > 0) mybase = __hip_atomic_fetch_add(bcnt + bh * NBLK + L, (unsigned)mycnt, RLX_AGENT);
        for (int j = 0; j < blk; ++j) {
            const bool sel = (i0 == j) || (i1 == j) || (i2 == j);
            const unsigned long long mask = __ballot(sel);
            const unsigned base = (unsigned)__builtin_amdgcn_readlane((int)mybase, j);
            if (sel) { const unsigned pos = base + (unsigned)__popcll(mask & ((1ull << L) - 1ull)); const unsigned slot = (i0 == j) ? 0u : ((i1 == j) ? 1u : 2u);
                list[(size_t)(bh * NBLK + j) * ALCAP + pos] = ((unsigned)tt << 2) | slot; }
        }
    }
    __syncthreads();
}

__device__ __forceinline__ unsigned cvtpk(float lo, float hi) { typedef float f32x2_t __attribute__((ext_vector_type(2))); typedef __bf16 bf16x2_t __attribute__((ext_vector_type(2)));
    f32x2_t v = {lo, hi}; bf16x2_t r = __builtin_convertvector(v, bf16x2_t); return __builtin_bit_cast(unsigned, r); }

constexpr int AT_KROW = 144, AT_VROW = 520, AT_KOFF = 0, AT_VOFF = 256 * AT_KROW;
__device__ __forceinline__ void attn_item(Frame& F, int b, int h, int j, bool own, const unsigned* lst, int nvalid) {
    const int tid = F.tid, L = F.lane, r = L & 31, hh = L >> 5, wv = F.wave;
    LAS unsigned char* Kl = F.lds + AT_KOFF; LAS unsigned char* Vl = F.lds + AT_VOFF;
    const bf16* Kg = WSP(bf16, WS_K) + ((size_t)(b * SEQ + j * 256)) * AW + h * 64;
    const bf16* Vg = WSP(bf16, WS_VT) + ((size_t)((b * NH + h) * HD)) * SEQ + j * 256;
    v4u kr[4], vr[4];
#pragma unroll
    for (int i = 0; i < 4; ++i) { const int idx = tid + 512 * i; kr[i] = *(const v4u*)(Kg + (size_t)(idx >> 3) * AW + (idx & 7) * 8); vr[i] = *(const v4u*)(Vg + (size_t)(idx >> 5) * SEQ + (idx & 31) * 8); }
    const int qi = wv * 32 + r; const bool valid = qi < nvalid;
    unsigned ent; if (own) ent = ((unsigned)(j * 256 + qi) << 2) | 3u; else ent = lst[valid ? qi : 0];
    const int tt = (int)(ent >> 2), slot = (int)(ent & 3u), t = b * SEQ + tt;
    bf16x8 qf[4];
    { const bf16* qp = WSP(bf16, WS_Q) + (size_t)t * AW + h * 64 + hh * 8;
#pragma unroll
      for (int d0 = 0; d0 < 4; ++d0) qf[d0] = *(const bf16x8*)(qp + d0 * 16); }
#pragma unroll
    for (int i = 0; i < 4; ++i) { const int idx = tid + 512 * i; *(LAS v4u*)(Kl + (idx >> 3) * AT_KROW + (idx & 7) * 16) = kr[i]; *(LAS v4u*)(Vl + (idx >> 5) * AT_VROW + (idx & 31) * 16) = vr[i]; }
    __syncthreads();
#ifdef ATT_STAGGER
    if (wv >= 4) __builtin_amdgcn_s_sleep(ATT_STAGGER);
#endif
#ifdef ATT_REP_COMPUTE
    for (int arep = 0; arep < 2; ++arep)
#endif
    if (wv * 32 < nvalid) {
        float m = -1e30f, l = 0.f; f32x16 O0 = {}, O1 = {};
        const int qrel = tt & 255;
#pragma unroll
        for (int hk = 0; hk < 2; ++hk) {
            if (own && hk * 4 > wv) continue;
            f32x16 S[4];
#pragma unroll
            for (int kt = 0; kt < 4; ++kt) S[kt] = (f32x16){};
#pragma unroll
            for (int d0 = 0; d0 < 4; ++d0) {
#pragma unroll
                for (int kt = 0; kt < 4; ++kt) { const bf16x8 kf = *(const LAS bf16x8*)(Kl + (hk * 128 + kt * 32 + r) * AT_KROW + d0 * 32 + hh * 16);
                    S[kt] = __builtin_amdgcn_mfma_f32_32x32x16_bf16(kf, qf[d0], S[kt], 0, 0, 0); }
                if (d0 & 1) __builtin_amdgcn_sched_barrier(0); }
            if (own) {
                asm volatile("; causal masking (own block only)" ::: "memory");
#pragma unroll
                for (int kt = 0; kt < 4; ++kt)
#pragma unroll
                    for (int rg = 0; rg < 16; ++rg) { const int key = hk * 128 + kt * 32 + (rg & 3) + 8 * (rg >> 2) + 4 * hh; if (key > qrel) S[kt][rg] = -1e30f; } }
            float mx = S[0][0];
#pragma unroll
            for (int kt = 0; kt < 4; ++kt)
#pragma unroll
                for (int rg = 0; rg < 16; ++rg) mx = fmaxf(mx, S[kt][rg]);
            mx = fmaxf(mx, __shfl_xor(mx, 32));
            const float mn = fmaxf(m, mx), alpha = __builtin_amdgcn_exp2f(m - mn); m = mn; l *= alpha;
#pragma unroll
            for (int rg = 0; rg < 16; ++rg) { O0[rg] *= alpha; O1[rg] *= alpha; }
            float ls = 0.f;
#pragma unroll
            for (int kt = 0; kt < 4; ++kt) {
                unsigned pw[8];
#pragma unroll
                for (int rg = 0; rg < 16; rg += 2) { const float p0 = __builtin_amdgcn_exp2f(S[kt][rg] - mn), p1 = __builtin_amdgcn_exp2f(S[kt][rg + 1] - mn); ls += p0 + p1; pw[rg >> 1] = cvtpk(p0, p1); }
#pragma unroll
                for (int s = 0; s < 2; ++s) {
                    const v4u pv = {pw[4 * s], pw[4 * s + 1], pw[4 * s + 2], pw[4 * s + 3]}; const bf16x8 pf = __builtin_bit_cast(bf16x8, pv);
                    const int kb = (hk * 128 + kt * 32 + 16 * s + 4 * hh) * 2;
                    { const LAS unsigned char* vp = Vl + r * AT_VROW + kb; const v2u lo = *(const LAS v2u*)vp, hi = *(const LAS v2u*)(vp + 16);
                      const v4u vv = {lo.x, lo.y, hi.x, hi.y}; O0 = __builtin_amdgcn_mfma_f32_32x32x16_bf16(__builtin_bit_cast(bf16x8, vv), pf, O0, 0, 0, 0); }
                    { const LAS unsigned char* vp = Vl + (32 + r) * AT_VROW + kb; const v2u lo = *(const LAS v2u*)vp, hi = *(const LAS v2u*)(vp + 16);
                      const v4u vv = {lo.x, lo.y, hi.x, hi.y}; O1 = __builtin_amdgcn_mfma_f32_32x32x16_bf16(__builtin_bit_cast(bf16x8, vv), pf, O1, 0, 0, 0); } } }
            l += ls;
        }
        l += __shfl_xor(l, 32);
        if (valid) {
            const float rl = 1.f / l;
            bf16* op = (slot < 2 ? WSP(bf16, WS_OP01) + (((size_t)t * NH + h) * 2 + slot) * 64 : WSP(bf16, WS_OP23) + (((size_t)t * NH + h) * 2 + (slot - 2)) * 64) + 4 * hh;
#pragma unroll
            for (int g4 = 0; g4 < 4; ++g4) { v2u w0, w1; w0.x = cvtpk(O0[4 * g4] * rl, O0[4 * g4 + 1] * rl); w0.y = cvtpk(O0[4 * g4 + 2] * rl, O0[4 * g4 + 3] * rl);
                w1.x = cvtpk(O1[4 * g4] * rl, O1[4 * g4 + 1] * rl); w1.y = cvtpk(O1[4 * g4 + 2] * rl, O1[4 * g4 + 3] * rl);
                *(v2u*)(op + 8 * g4) = w0; *(v2u*)(op + 32 + 8 * g4) = w1; }
            if (hh == 0) WSP(float, WS_LSE)[((size_t)t * NH + h) * 4 + slot] = m + log2f(l);
        }
    }
    __syncthreads();
}
__device__ __forceinline__ void attn_items(Frame& F) {
    LAS int* pre = (LAS int*)(F.lds + 72 * 1024);
    const unsigned* bcnt = (const unsigned*)(F.ctl + CW_BCNT);
    LAS int* cntl = pre + 520;
    for (int i = F.tid; i < 512; i += NWAVES * 64) cntl[i] = (int)__hip_atomic_load((gu32*)(F.ctl + CW_BCNT) + i, RLX_AGENT);
    __syncthreads();
    if (F.wave == 0) {
        int c8[8], s = 0;
#pragma unroll
        for (int k = 0; k < 8; ++k) { c8[k] = (cntl[F.lane * 8 + k] + 255) >> 8; s += c8[k]; }
        int inc = s;
#pragma unroll
        for (int o = 1; o < 64; o <<= 1) { const int v = __shfl_up(inc, o); if (F.lane >= o) inc += v; }
        int run = inc - s;
#pragma unroll
        for (int k = 0; k < 8; ++k) { pre[F.lane * 8 + k] = run; run += c8[k]; }
        if (F.lane == 63) pre[512] = run; }
    __syncthreads();
    const int total = 512 + pre[512];
    for (int it = (int)blockIdx.x; it < total; it += F.G) {
        int bh, j, n; bool own; const unsigned* lst;
        if (it < 512) { bh = it >> 5; j = it & 31; own = true; lst = nullptr; n = 256; }
        else { const int s = it - 512; int lo = 0, hi = 512;
            while (hi - lo > 1) { const int mid = (lo + hi) >> 1; if (pre[mid] <= s) lo = mid; else hi = mid; }
            const int bucket = lo, tile = s - pre[bucket]; n = cntl[bucket] - tile * 256; n = n > 256 ? 256 : n; bh = bucket >> 5; j = bucket & 31; own = false;
            lst = WSP(unsigned, WS_ALIST) + (size_t)bucket * ALCAP + tile * 256; }
        const int b_ = __builtin_amdgcn_readfirstlane(bh >> 3), h_ = __builtin_amdgcn_readfirstlane(bh & 7), j_ = __builtin_amdgcn_readfirstlane(j), n_ = __builtin_amdgcn_readfirstlane(n);
        attn_item(F, b_, h_, j_, own, lst, n_);
    }
}
__device__ __forceinline__ void attn_combine(Frame& F) {
    if (F.G == 256 && blockIdx.x < 128) return;
    const int nb = F.G == 256 ? 128 : F.G, bi = F.G == 256 ? (int)blockIdx.x - 128 : F.vcu;
    const int gw = bi * NWAVES + F.wave, NGW = nb * NWAVES, L = F.lane, h = L >> 3, ch = L & 7;
    const float* lse = WSP(float, WS_LSE); bf16* YA = WSP(bf16, WS_YA);
    for (int t = gw; t < T; t += NGW) {
        const size_t th = (size_t)t * NH + h;
        const f32x4 ls = *(const f32x4*)(lse + th * 4);
        const float mx = fmaxf(fmaxf(ls[0], ls[1]), fmaxf(ls[2], ls[3]));
        const float w0 = __builtin_amdgcn_exp2f(ls[0] - mx), w1 = __builtin_amdgcn_exp2f(ls[1] - mx), w2 = __builtin_amdgcn_exp2f(ls[2] - mx), w3 = __builtin_amdgcn_exp2f(ls[3] - mx), inv = 1.f / (w0 + w1 + w2 + w3);
        const v4u a0 = __builtin_nontemporal_load((const v4u*)(WSP(bf16, WS_OP01) + (th * 2 + 0) * 64 + ch * 8)), a1 = __builtin_nontemporal_load((const v4u*)(WSP(bf16, WS_OP01) + (th * 2 + 1) * 64 + ch * 8));
        const v4u a2 = __builtin_nontemporal_load((const v4u*)(WSP(bf16, WS_OP23) + (th * 2 + 0) * 64 + ch * 8)), a3 = __builtin_nontemporal_load((const v4u*)(WSP(bf16, WS_OP23) + (th * 2 + 1) * 64 + ch * 8));
        float o[8];
        const unsigned x0[4] = {a0.x, a0.y, a0.z, a0.w}, x1[4] = {a1.x, a1.y, a1.z, a1.w}, x2[4] = {a2.x, a2.y, a2.z, a2.w}, x3[4] = {a3.x, a3.y, a3.z, a3.w};
#pragma unroll
        for (int i = 0; i < 4; ++i) {
            float lo_ = w3 * bflo(x3[i]), hi_ = w3 * bfhi(x3[i]);
            if (ls[0] > -1e29f) { lo_ += w0 * bflo(x0[i]); hi_ += w0 * bfhi(x0[i]); }
            if (ls[1] > -1e29f) { lo_ += w1 * bflo(x1[i]); hi_ += w1 * bfhi(x1[i]); }
            if (ls[2] > -1e29f) { lo_ += w2 * bflo(x2[i]); hi_ += w2 * bfhi(x2[i]); }
            o[2 * i] = lo_ * inv; o[2 * i + 1] = hi_ * inv; }
        v4u w; w.x = cvtpk(o[0], o[1]); w.y = cvtpk(o[2], o[3]); w.z = cvtpk(o[4], o[5]); w.w = cvtpk(o[6], o[7]);
        *(v4u*)(YA + (size_t)t * AW + h * 64 + ch * 8) = w;
    }
}
struct S5Order { static constexpr bool GATHER = false; int G, c;
    __device__ __forceinline__ void a_ready(const pg8::Unit&) const {}
    __device__ __forceinline__ void done(const pg8::Unit&) const {}
    __device__ __forceinline__ bool next(int i, pg8::Unit& u) const { const int L = i * G + c; if (L >= NG * 4) return false; const int g = L >> 2, rt = L & 3;
        u.arow = g * 1024 + rt * 256; u.brow = g * 256; u.pm = rt; u.pn = 0; u.e = g; u.nrow = 256; u.kind = 0; u.aux = 0; return true; } };
struct EpiS5A { float* E;
    __device__ __forceinline__ void operator()(const pg8::f32x4 (&acc)[2][2][4][2], const pg8::Unit& u, int wr, int wc, int fr, int fq) const {
        asm volatile("" : "+v"(fr), "+v"(fq));
#pragma unroll
        for (int ai = 0; ai < 2; ++ai)
#pragma unroll
            for (int m = 0; m < 4; ++m) { float* p = E + (size_t)(u.arow + ai * 128 + wr * 64 + m * 16 + fr) * 128 + wc * 32 + 8 * fq;
                *(pg8::f32x4*)p = acc[ai][0][m][0]; *(pg8::f32x4*)(p + 4) = acc[ai][0][m][1]; }
    }
};
struct EpiS5C { bf16* YG;
    __device__ __forceinline__ void operator()(const pg8::f32x4 (&acc)[2][2][4][2], const pg8::Unit& u, int wr, int wc, int fr, int fq) const {
        asm volatile("" : "+v"(fr), "+v"(fq));
        const int g = u.e, n0 = wc * 32 + 8 * fq, t0 = n0 >> 4, co0 = n0 & 15;
#pragma unroll
        for (int ai = 0; ai < 2; ++ai)
#pragma unroll
            for (int m = 0; m < 4; ++m) { const int row = u.pm * 256 + ai * 128 + wr * 64 + m * 16 + fr, b = row >> 9, c = row & 511;
                bf16* yp = YG + (size_t)(b * SEQ + 16 * c + t0) * SW + 16 * g + co0;
#pragma unroll
                for (int bj = 0; bj < 2; ++bj) {
                    const pg8::f32x4 v0 = acc[ai][bj][m][0], v1 = acc[ai][bj][m][1];
                    v4u w; w.x = pk2(gelu_tanh(v0[0]), gelu_tanh(v0[1])); w.y = pk2(gelu_tanh(v0[2]), gelu_tanh(v0[3]));
                    w.z = pk2(gelu_tanh(v1[0]), gelu_tanh(v1[1])); w.w = pk2(gelu_tanh(v1[2]), gelu_tanh(v1[3]));
                    *(v4u*)(yp + (size_t)bj * 8 * SW) = w; }
                __builtin_amdgcn_sched_barrier(0); }
    }
};
__device__ __forceinline__ void s5_fill_kt(Frame& F) {
    const int gt = F.vcu * (NWAVES * 64) + F.tid, NGT = F.G * NWAVES * 64;
    const float* P5 = WSP(float, WS_S5P); const float* PWr = P5 + 131072; const float* PWi = PWr + 2048 * 17; const float* par = WSP(float, WS_PAR);
    float* KT = WSP(float, WS_S5KT);
    for (int i = gt; i < NG * 16 * 256; i += NGT) { const int ci = i & 15, co = (i >> 4) & 15, tau = (i >> 8) & 15, g = i >> 12; float a = 0.f;
#pragma unroll 8
        for (int p = 0; p < 64; ++p) { const int gp = g * 64 + p;
            const float qr = P5[8192 + gp], qi = P5[8192 + 2048 + gp], b_r = par[PAR_BRE + gp * 16 + ci], b_i = par[PAR_BIM + gp * 16 + ci];
            const float bbr = qr * b_r - qi * b_i, bbi = qr * b_i + qi * b_r, wr_ = PWr[gp * 17 + tau], wi_ = PWi[gp * 17 + tau];
            const float xr = wr_ * bbr - wi_ * bbi, xi = wr_ * bbi + wi_ * bbr;
            const float cr = par[PAR_CRE + (g * 16 + co) * 64 + p], ci_ = par[PAR_CIM + (g * 16 + co) * 64 + p];
            a += cr * xr - ci_ * xi; }
        KT[i] = a; }
}
__device__ __forceinline__ void s5_fill_wc(Frame& F) {
    const int gw = F.vcu * NWAVES + F.wave, NGW = F.G * NWAVES, L = F.lane;
    const float* P5 = WSP(float, WS_S5P); const float* PWr = P5 + 131072; const float* PWi = PWr + 2048 * 17; const float* KT = WSP(float, WS_S5KT); const float* par = WSP(float, WS_PAR);
    bf16* Wc = WSP(bf16, WS_S5WC);
#pragma unroll 2
    for (int r = gw; r < NG * 256; r += NGW) { const int n = r & 255, g = r >> 8, t = n >> 4, co = n & 15, ci = L & 15, gp = g * 64 + L;
        float v[6];
#pragma unroll
        for (int kk = 0; kk < 4; ++kk) { const int s_ = (L >> 4) + 4 * kk; v[kk] = (s_ <= t) ? KT[((g * 16 + (t - s_)) * 16 + co) * 16 + ci] : 0.f;
            if (s_ == t && ci == co) v[kk] += par[PAR_SD + g * 16 + co]; }
        { const float cr = par[PAR_CRE + (g * 16 + co) * 64 + L], ci_ = par[PAR_CIM + (g * 16 + co) * 64 + L], wr_ = PWr[gp * 17 + t + 1], wi_ = PWi[gp * 17 + t + 1];
          v[4] = cr * wr_ - ci_ * wi_; v[5] = -(cr * wi_ + ci_ * wr_); }
        bf16* row = Wc + ((size_t)(g * 256 + perm8(n))) * 384 + L;
#pragma unroll
        for (int kk = 0; kk < 6; ++kk) row[64 * kk] = (bf16)f2bf(v[kk]); }
}
__device__ __forceinline__ void s5_carry(Frame& F) {
    const float* P5 = WSP(float, WS_S5P); const float* PWr = P5 + 131072; const float* PWi = PWr + 2048 * 17; const float* E = WSP(float, WS_S5E); bf16* UA = WSP(bf16, WS_UA);
    LAS float* Z = (LAS float*)(F.lds);
    const int seg = F.wave, p = F.lane;
    for (int bg = F.vcu; bg < BATCH * NG; bg += F.G) { const int b = bg / NG, g = bg % NG, gp = g * 64 + p;
        const float ar = PWr[gp * 17 + 16], ai = PWi[gp * 17 + 16];
        const size_t row0 = (size_t)g * 1024 + b * 512 + seg * 64;
        float zr = 0.f, zi = 0.f;
        for (int c0 = 0; c0 < 64; c0 += 8) { float er[8], ei[8];
#pragma unroll
            for (int k = 0; k < 8; ++k) { er[k] = E[(row0 + c0 + k) * 128 + p]; ei[k] = E[(row0 + c0 + k) * 128 + 64 + p]; }
#pragma unroll
            for (int k = 0; k < 8; ++k) { const float nr = ar * zr - ai * zi + er[k], ni = ar * zi + ai * zr + ei[k]; zr = nr; zi = ni; } }
        Z[(seg * 64 + p) * 2] = zr; Z[(seg * 64 + p) * 2 + 1] = zi;
        __syncthreads();
        if (seg == 0) { float br = ar, bi = ai;
#pragma unroll
            for (int k = 0; k < 6; ++k) { const float tr = br * br - bi * bi, ti = 2.f * br * bi; br = tr; bi = ti; }
            float sr = 0.f, si = 0.f;
            for (int sg = 0; sg < 8; ++sg) { const float xr = Z[(sg * 64 + p) * 2], xi = Z[(sg * 64 + p) * 2 + 1]; Z[(sg * 64 + p) * 2] = sr; Z[(sg * 64 + p) * 2 + 1] = si;
                const float nr = br * sr - bi * si + xr, ni = br * si + bi * sr + xi; sr = nr; si = ni; } }
        __syncthreads();
        float sr = Z[(seg * 64 + p) * 2], si = Z[(seg * 64 + p) * 2 + 1];
        for (int c0 = 0; c0 < 64; c0 += 8) { float er[8], ei[8];
#pragma unroll
            for (int k = 0; k < 8; ++k) { er[k] = E[(row0 + c0 + k) * 128 + p]; ei[k] = E[(row0 + c0 + k) * 128 + 64 + p]; }
#pragma unroll
            for (int k = 0; k < 8; ++k) { bf16* up = UA + (row0 + c0 + k) * 384 + 256 + p; up[0] = (bf16)f2bf(sr); up[64] = (bf16)f2bf(si);
                const float nr = ar * sr - ai * si + er[k], ni = ar * si + ai * sr + ei[k]; sr = nr; si = ni; } }
        __syncthreads();
    }
}
constexpr int SCR_OFF = LDSCTL_OFF + 512;
#ifndef MOE_LAG
#define MOE_LAG 2
#endif
constexpr int MT_SEG = 100, MT_MAXSEG = 72, MT_ULIST = 400, MT_MAXU = 16;
__device__ __forceinline__ void phase_rows(Frame& F, bool dry = false) {
    LAS float* h2t = (LAS float*)(F.lds);
    LAS float* lg = (LAS float*)(F.lds + 65536);
    LAS float* gtm = (LAS float*)(F.lds + 131072);
    LAS float* pg2 = gtm + 2 * D; LAS float* shf = pg2 + 2 * D;
    LAS unsigned* hist = (LAS unsigned*)(F.lds + SCR_OFF); LAS unsigned* base = hist + 32; LAS int* rec_e = (LAS int*)(base + 32); LAS int* rec_lp = rec_e + 256; LAS int* bt0 = rec_lp + 256;
    const float* adaf = WSP(float, WS_ADAF); const float* par = WSP(float, WS_PAR);
    const int L = F.lane, wv = F.wave;
    for (int i = F.tid; i < 2 * D; i += NWAVES * 64) { const int b = i >> 10, k = i & (D - 1);
        gtm[i] = adaf[b * 6 * D + 2 * D + k] * par[PAR_MPG + k];
        pg2[i] = par[PAR_FPRE + k] * (1.f + adaf[b * 6 * D + 4 * D + k]); shf[i] = adaf[b * 6 * D + 3 * D + k]; }
    f32x4 wreg[16];
#pragma unroll
    for (int j = 0; j < 4; ++j)
#pragma unroll
        for (int i = 0; i < 4; ++i) wreg[j * 4 + i] = *(const f32x4*)(par + PAR_RW + (4 * L + 256 * j + i) * NE + 4 * wv);
    if (F.tid < 32) hist[F.tid] = 0u;
    __syncthreads();
    const bf16* mix = WSP(bf16, WS_MIX); bf16* H2 = WSP(bf16, WS_H2); bf16* X1B = WSP(bf16, WS_X1B);
    int* tok_e = WSP(int, WS_ROUTE); float* tok_w = (float*)(tok_e + T * 4); int* tok_pos = tok_e + 2 * T * 4;
    unsigned* gcnt = (unsigned*)(F.ctl + CW_ECNT);
    v2u mraw[2][4]; f32x4 xraw[2][4];
#define ROWS_FETCH(tb_) do { const int tf_ = (tb_) + 2 * wv; _Pragma("unroll") for (int q = 0; q < 2; ++q) { \
        const GAS v2u* mr = (const GAS v2u*)(mix + (size_t)(tf_ + q) * D) + L; const GAS f32x4* xr = (const GAS f32x4*)(F.in[0] + (size_t)(tf_ + q) * D) + L; \
        _Pragma("unroll") for (int j = 0; j < 4; ++j) { mraw[q][j] = __builtin_nontemporal_load(mr + 64 * j); xraw[q][j] = __builtin_nontemporal_load(xr + 64 * j); } } } while (0)
    if (F.vcu * 16 < T) ROWS_FETCH(F.vcu * 16);
    int nbat = 0;
    for (int t0 = F.vcu * 16; t0 < T; t0 += F.G * 16) {
        const int tn = t0 + F.G * 16;
        {
            const int t = t0 + 2 * wv, b = t >> 13;
            f32x4 mv[2][4], xv[2][4];
#pragma unroll
            for (int q = 0; q < 2; ++q)
#pragma unroll
                for (int j = 0; j < 4; ++j) { const v2u mw = mraw[q][j]; mv[q][j] = (f32x4){bflo(mw.x), bfhi(mw.x), bflo(mw.y), bfhi(mw.y)}; xv[q][j] = xraw[q][j]; }
#pragma unroll
            for (int q = 0; q < 2; ++q) { float s = 0.f;
#pragma unroll
                for (int j = 0; j < 4; ++j) s += (mv[q][j].x * mv[q][j].x + mv[q][j].y * mv[q][j].y) + (mv[q][j].z * mv[q][j].z + mv[q][j].w * mv[q][j].w);
                const float r1 = 1.f / sqrtf(wave_sum(s) * (1.f / D) + NORM_EPS);
                float s2 = 0.f; GAS v2u* orow = (GAS v2u*)(X1B + (size_t)(t + q) * D) + L;
#pragma unroll
                for (int j = 0; j < 4; ++j) { const f32x4 g = *(const LAS f32x4*)(gtm + b * D + 4 * L + 256 * j);
                    xv[q][j] = xv[q][j] + g * (mv[q][j] * r1); { v2u w; w.x = pk2(xv[q][j].x, xv[q][j].y); w.y = pk2(xv[q][j].z, xv[q][j].w); __builtin_nontemporal_store(w, orow + 64 * j); }
                    s2 += (xv[q][j].x * xv[q][j].x + xv[q][j].y * xv[q][j].y) + (xv[q][j].z * xv[q][j].z + xv[q][j].w * xv[q][j].w); }
                const float r2 = 1.f / sqrtf(wave_sum(s2) * (1.f / D) + NORM_EPS);
#ifdef MOE_F8
                GAS unsigned* h4 = (GAS unsigned*)(WSP(unsigned char, WS_H2) + (size_t)(t + q) * D) + L;
#pragma unroll
                for (int j = 0; j < 4; ++j) { const f32x4 a = *(const LAS f32x4*)(pg2 + b * D + 4 * L + 256 * j), c = *(const LAS f32x4*)(shf + b * D + 4 * L + 256 * j);
                    const f32x4 h = xv[q][j] * r2 * a + c;
                    h4[64 * j] = pk4_fp8(8.f * h.x, 8.f * h.y, 8.f * h.z, 8.f * h.w);
                    *(LAS f32x4*)(h2t + (2 * wv + q) * D + 4 * L + 256 * j) = h; } }
#else
                GAS unsigned long long* h8 = (GAS unsigned long long*)(H2 + (size_t)(t + q) * D) + L;
#pragma unroll
                for (int j = 0; j < 4; ++j) { const f32x4 a = *(const LAS f32x4*)(pg2 + b * D + 4 * L + 256 * j), c = *(const LAS f32x4*)(shf + b * D + 4 * L + 256 * j);
                    const f32x4 h = xv[q][j] * r2 * a + c;
                    h8[64 * j] = (unsigned long long)pk2(h.x, h.y) | ((unsigned long long)pk2(h.z, h.w) << 32);
                    *(LAS f32x4*)(h2t + (2 * wv + q) * D + 4 * L + 256 * j) = h; } }
#endif
        }
        __syncthreads();
        if (tn < T) ROWS_FETCH(tn);
        {
            const int hi = (L >> 5) & 1, h2b = (L >> 4) & 1;
#pragma unroll 2
            for (int tk = 0; tk < 16; ++tk) {
                f32x4 a = {0.f, 0.f, 0.f, 0.f};
#pragma unroll
                for (int j = 0; j < 4; ++j) { const f32x4 h = *(const LAS f32x4*)(h2t + tk * D + 4 * L + 256 * j);
                    a += wreg[j * 4 + 0] * h.x; a += wreg[j * 4 + 1] * h.y; a += wreg[j * 4 + 2] * h.z; a += wreg[j * 4 + 3] * h.w; }
                const float m0 = hi ? a.z : a.x, o0 = hi ? a.x : a.z, m1 = hi ? a.w : a.y, o1 = hi ? a.y : a.w;
                const float v0 = m0 + __shfl_xor(o0, 32), v1 = m1 + __shfl_xor(o1, 32);
                float v = (h2b ? v1 : v0) + __shfl_xor(h2b ? v0 : v1, 16);
                v += __shfl_xor(v, 8); v += __shfl_xor(v, 4); v += __shfl_xor(v, 2); v += __shfl_xor(v, 1);
                if ((L & 15) == 0) lg[tk * NE + 4 * wv + 2 * hi + h2b] = v;
            }
        }
        __syncthreads();
        {
            const int e = L & 31, half = L >> 5, tl = 2 * wv + half, t = t0 + tl;
            float val = lg[tl * NE + e] + par[PAR_RB + e];
            int se[4]; float sv[4];
#pragma unroll
            for (int r = 0; r < 4; ++r) { float mx = val;
                mx = fmaxf(mx, __shfl_xor(mx, 16)); mx = fmaxf(mx, __shfl_xor(mx, 8)); mx = fmaxf(mx, __shfl_xor(mx, 4)); mx = fmaxf(mx, __shfl_xor(mx, 2)); mx = fmaxf(mx, __shfl_xor(mx, 1));
                const unsigned long long bal = __ballot(val == mx); const unsigned hm = half ? (unsigned)(bal >> 32) : (unsigned)bal; const int win = __ffs((int)hm) - 1;
                se[r] = win; sv[r] = mx; if (e == win) val = -3e38f; }
            const float e1 = __expf(sv[1] - sv[0]), e2 = __expf(sv[2] - sv[0]), e3 = __expf(sv[3] - sv[0]), inv = 1.f / (1.f + e1 + e2 + e3);
            if (e < 4) { const int ex = e == 0 ? se[0] : (e == 1 ? se[1] : (e == 2 ? se[2] : se[3]));
                const float wgt = (e == 0 ? 1.f : (e == 1 ? e1 : (e == 2 ? e2 : e3))) * inv;
                tok_e[t * 4 + e] = ex; tok_w[t * 4 + e] = wgt;
                const unsigned lp = dry ? 0u : __hip_atomic_fetch_add(hist + ex, 1u, __ATOMIC_RELAXED, __HIP_MEMORY_SCOPE_WORKGROUP);
                rec_e[nbat * 64 + tl * 4 + e] = ex; rec_lp[nbat * 64 + tl * 4 + e] = (int)lp; }
            if (F.tid == 0) bt0[nbat] = t0;
        }
        __syncthreads();
        ++nbat;
        if (nbat == 4 || tn >= T) {
            if (wv == 0) { unsigned bs = 0u; const unsigned h = F.tid < 32 ? hist[F.tid] : 0u; if (h && !dry) bs = __hip_atomic_fetch_add(gcnt + F.tid * ECNT_STRIDE, h, RLX_AGENT);
                if (F.tid < 32) base[F.tid] = bs; }
            __syncthreads();
            if (!dry && (int)F.tid < nbat * 64) { const int i = F.tid, e_ = rec_e[i], pos_ = (int)base[e_] + rec_lp[i], tk_ = bt0[i >> 6] + ((i & 63) >> 2); tok_pos[tk_ * 4 + (i & 3)] = pos_;
                WSP(int, WS_ELIST)[e_ * ELCAP + pos_] = tk_; }
            __syncthreads();
            if (F.tid < 32) hist[F.tid] = 0u;
            nbat = 0;
            __syncthreads();
        }
    }
}

__device__ __forceinline__ void moe_tables(Frame& F, int nct = 0, int brows = 0) {
    LAS int* cnt = (LAS int*)(F.lds + SCR_OFF); LAS int* off = cnt + 32; LAS int* tpre = off + 32;
    if (F.tid < NE) cnt[F.tid] = (int)__hip_atomic_load(F.ctl + CW_ECNT + F.tid * ECNT_STRIDE, RLX_AGENT);
    __syncthreads();
    if (F.tid < 64) {
        const int c = F.tid < NE ? cnt[F.tid] : 0, tl = (c + 255) >> 8; int io = c, it = tl;
#pragma unroll
        for (int o = 1; o < 32; o <<= 1) { const int v = __shfl_up(io, o), w = __shfl_up(it, o); if ((int)F.tid >= o) { io += v; it += w; } }
        if (F.tid < NE) { off[F.tid] = io - c; tpre[F.tid] = it - tl; } if (F.tid == NE - 1) tpre[NE] = it; }
    if (F.tid == 0) {
#ifdef MOE_FUSED
        const int tp = 0;
        LAS int* sg = cnt + MT_SEG; const int n = (tp + 31) >> 5; int ns = 0, pos = 0;
        for (int g = 0; g < n; ++g) { const int tg = (tp - 32 * g) < 32 ? (tp - 32 * g) : 32;
            sg[1 + ns] = pos; sg[1 + MT_MAXSEG + ns] = 0; sg[1 + 2 * MT_MAXSEG + ns] = g; ++ns; pos += 8 * tg; sg[1 + 3 * MT_MAXSEG + g] = pos;
            if (g >= MOE_LAG) { sg[1 + ns] = pos; sg[1 + MT_MAXSEG + ns] = 1; sg[1 + 2 * MT_MAXSEG + ns] = g - MOE_LAG; ++ns; pos += 4 * 32; } }
        for (int g = (n > MOE_LAG ? n - MOE_LAG : 0); g < n; ++g) { const int tg = (tp - 32 * g) < 32 ? (tp - 32 * g) : 32; sg[1 + ns] = pos; sg[1 + MT_MAXSEG + ns] = 1; sg[1 + 2 * MT_MAXSEG + ns] = g; ++ns; pos += 4 * tg; }
        sg[1 + ns] = pos; sg[0] = ns;
#endif
    }
    __syncthreads();
    if (nct > 0 && F.G == 256 && F.tid < MT_MAXU) {
        LAS int* ul = cnt + MT_ULIST + 8 * F.tid; const int i = F.tid, c = (int)blockIdx.x, xcd = c & 7, slot = c >> 3, rpx = 32 / nct;
        const int rtg = (i * 8 + xcd) * rpx + slot / nct, pn = slot % nct;
        if (rtg >= tpre[NE]) { ul[0] = -1; }
        else { int e = 0;
#pragma unroll
            for (int st = 16; st >= 1; st >>= 1) if (e + st < NE && tpre[e + st] <= rtg) e += st;
            const int rt = rtg - tpre[e], nr = cnt[e] - rt * 256;
            ul[0] = off[e] + rt * 256; ul[1] = e * brows + pn * 256; ul[2] = rt; ul[3] = pn; ul[4] = e; ul[5] = nr > 256 ? 256 : nr; } }
    __syncthreads();
}
template <bool GA> struct MoeOrder {
    static constexpr bool GATHER = GA;
#if defined(T_ACQ)
    __device__ __forceinline__ void a_ready(const pg8::Unit&) const { if (!GA) { if (threadIdx.x < 64) { __builtin_amdgcn_fence(__ATOMIC_ACQUIRE, "agent"); asm volatile("s_waitcnt vmcnt(0)" ::: "memory"); } asm volatile("" ::: "memory"); __builtin_amdgcn_s_barrier(); asm volatile("" ::: "memory"); } }
#else
    __device__ __forceinline__ void a_ready(const pg8::Unit&) const {}
#endif
#if defined(T_DRAIN)
    __device__ __forceinline__ void done(const pg8::Unit&) const { if (GA) asm volatile("s_waitcnt vmcnt(0)" ::: "memory"); }
#else
    __device__ __forceinline__ void done(const pg8::Unit&) const {}
#endif
    const LAS int* tab; const int* elist; int nct, brows, G, c;
    __device__ __forceinline__ bool next(int i, pg8::Unit& u) const {
        if (G == 256) { if (i >= MT_MAXU) return false; const LAS int* ul = tab + MT_ULIST + 8 * i; const int a0 = ul[0]; if (a0 < 0) return false;
            u.arow = __builtin_amdgcn_readfirstlane(a0); u.brow = __builtin_amdgcn_readfirstlane(ul[1]); u.pm = __builtin_amdgcn_readfirstlane(ul[2]); u.pn = __builtin_amdgcn_readfirstlane(ul[3]);
            u.e = __builtin_amdgcn_readfirstlane(ul[4]); u.nrow = __builtin_amdgcn_readfirstlane(ul[5]); u.kind = 0; u.aux = 0; return true; }
        int rtg, pn;
        if (false) { const int xcd = c & 7, slot = c >> 3, rpx = 32 / nct;
            rtg = (i * 8 + xcd) * rpx + slot / nct; pn = slot % nct; if (rtg >= tab[64 + NE]) return false; }
        else { const int L = i * G + c, total = tab[64 + NE] * nct; if (L >= total) return false; rtg = L / nct; pn = L % nct; }
        int e = 0;
        for (int k = 1; k < NE; ++k) if (tab[64 + k] <= rtg) e = k;
        const int rt = rtg - tab[64 + e], cnt = tab[e], off = tab[32 + e];
        u.e = __builtin_amdgcn_readfirstlane(e); u.pm = __builtin_amdgcn_readfirstlane(rt); u.pn = pn; u.arow = __builtin_amdgcn_readfirstlane(off + rt * 256); u.brow = __builtin_amdgcn_readfirstlane(e * brows + pn * 256);
        const int nr = cnt - rt * 256; u.nrow = __builtin_amdgcn_readfirstlane(nr > 256 ? 256 : nr); u.kind = 0; u.aux = 0; return true;
    }
    __device__ __forceinline__ int arow_of(const pg8::Unit& u, int r) const { return r < u.nrow ? elist[u.e * ELCAP + u.pm * 256 + r] : 0; }
};
struct EpiGU { bf16* H1; const float* bg; const float* bu;
    __device__ __forceinline__ void operator()(const pg8::f32x4 (&acc)[2][2][4][2], const pg8::Unit& u, int wr, int wc, int fr, int fq) const {
        asm volatile("" : "+v"(fr), "+v"(fq));
        const int f0 = u.pn * 128 + wc * 32 + 8 * fq;
#pragma unroll
        for (int ai = 0; ai < 2; ++ai) {
            int fb = f0; asm volatile("" : "+v"(fb));
            const pg8::f32x4 g0 = *(const pg8::f32x4*)(bg + u.e * FF + fb), g1 = *(const pg8::f32x4*)(bg + u.e * FF + fb + 4);
            const pg8::f32x4 u0 = *(const pg8::f32x4*)(bu + u.e * FF + fb), u1 = *(const pg8::f32x4*)(bu + u.e * FF + fb + 4);
#pragma unroll
            for (int m = 0; m < 4; ++m) { const int r = ai * 128 + wr * 64 + m * 16 + fr;
                const pg8::f32x4 a0 = acc[ai][0][m][0] + g0, a1 = acc[ai][0][m][1] + g1, b0 = acc[ai][1][m][0] + u0, b1 = acc[ai][1][m][1] + u1;
                float gg[8] = {a0[0], a0[1], a0[2], a0[3], a1[0], a1[1], a1[2], a1[3]}, uu[8] = {b0[0], b0[1], b0[2], b0[3], b1[0], b1[1], b1[2], b1[3]}, o[8];
#pragma unroll
                for (int i = 0; i < 8; ++i) { const float g = fminf(gg[i], 7.f), up = fminf(fmaxf(uu[i], -7.f), 7.f); o[i] = g * sigmoidf_(1.702f * g) * (up + 1.f); }
                v4u w; w.x = pk2(o[0], o[1]); w.y = pk2(o[2], o[3]); w.z = pk2(o[4], o[5]); w.w = pk2(o[6], o[7]);
#ifdef T_SC1
                if (r < u.nrow) __builtin_amdgcn_raw_buffer_store_b128(w, __builtin_amdgcn_make_buffer_rsrc(H1, 0, (int)((size_t)T * TOPK * FF * 2), 0x00020000), (unsigned)((u.arow + r) * (FF * 2) + fb * 2), 0, 16); } }
#else
                if (r < u.nrow) *(v4u*)(H1 + (size_t)(u.arow + r) * FF + fb) = w; } }
#endif
    }
};
struct EpiDn { bf16* YB; const float* bd;
    __device__ __forceinline__ void operator()(const pg8::f32x4 (&acc)[2][2][4][2], const pg8::Unit& u, int wr, int wc, int fr, int fq) const {
        const int c0 = u.pn * 256 + wc * 32 + 8 * fq;
#pragma unroll
        for (int bj = 0; bj < 2; ++bj) { const pg8::f32x4 d0 = *(const pg8::f32x4*)(bd + u.e * D + c0 + bj * 128), d1 = *(const pg8::f32x4*)(bd + u.e * D + c0 + bj * 128 + 4);
#pragma unroll
            for (int ai = 0; ai < 2; ++ai)
#pragma unroll
                for (int m = 0; m < 4; ++m) { const int r = ai * 128 + wr * 64 + m * 16 + fr;
                    const pg8::f32x4 a0 = acc[ai][bj][m][0] + d0, a1 = acc[ai][bj][m][1] + d1;
                    v4u w; w.x = pk2(a0[0], a0[1]); w.y = pk2(a0[2], a0[3]); w.z = pk2(a1[0], a1[1]); w.w = pk2(a1[2], a1[3]);
                    if (r < u.nrow) *(v4u*)(YB + (size_t)(u.arow + r) * D + c0 + bj * 128) = w; } }
    }
};
constexpr float YB_SCALE = 16.f;
struct EpiGU8 { unsigned char* H1; const float* bg; const float* bu; const float* wscp;
    static constexpr bool BIAS_LDS = true;
    __device__ __forceinline__ void stage_bias(PG8_LAS unsigned char* dst, const pg8::Unit& u, int wid, int lane) const {
        if (wid < 4) { const float* src = (wid < 2 ? bg : bu) + u.e * FF + u.pn * 128 + (wid & 1) * 64 + lane;
            __builtin_amdgcn_global_load_lds((const unsigned*)src, (PG8_LAS unsigned*)(dst + wid * 256), 4, 0, 0); } }
    __device__ __forceinline__ void operator()(const pg8::f32x4 (&acc)[2][2][4][2], const pg8::Unit& u, int wr, int wc, int fr, int fq, const PG8_LAS float* bl) const {
        asm volatile("" : "+v"(fr), "+v"(fq));
        const int fl = wc * 32 + 8 * fq, f0 = u.pn * 128 + fl; const float sr = 0.125f / *wscp;
        const pg8::f32x4 g0 = *(const PG8_LAS pg8::f32x4*)(bl + fl), g1 = *(const PG8_LAS pg8::f32x4*)(bl + fl + 4), u0 = *(const PG8_LAS pg8::f32x4*)(bl + 128 + fl), u1 = *(const PG8_LAS pg8::f32x4*)(bl + 128 + fl + 4);
#pragma unroll
        for (int ai = 0; ai < 2; ++ai)
#pragma unroll
            for (int m = 0; m < 4; ++m) { const int r = ai * 128 + wr * 64 + m * 16 + fr;
                const pg8::f32x4 a0 = acc[ai][0][m][0] * sr + g0, a1 = acc[ai][0][m][1] * sr + g1, b0 = acc[ai][1][m][0] * sr + u0, b1 = acc[ai][1][m][1] * sr + u1;
                float gg[8] = {a0[0], a0[1], a0[2], a0[3], a1[0], a1[1], a1[2], a1[3]}, uu[8] = {b0[0], b0[1], b0[2], b0[3], b1[0], b1[1], b1[2], b1[3]}, o[8];
#pragma unroll
                for (int i = 0; i < 8; ++i) { const float g = fminf(gg[i], 7.f), up = fminf(fmaxf(uu[i], -7.f), 7.f); o[i] = 8.f * (g * sigmoidf_(1.702f * g) * (up + 1.f)); }
                v2u w; w.x = pk4_fp8(o[0], o[1], o[2], o[3]); w.y = pk4_fp8(o[4], o[5], o[6], o[7]);
                if (r < u.nrow) *(v2u*)(H1 + (size_t)(u.arow + r) * FF + f0) = w; }
    }
};
struct EpiDn8 { bf16* YB; const float* bd; const float* wscp;
    static constexpr bool BIAS_LDS = true;
    __device__ __forceinline__ void stage_bias(PG8_LAS unsigned char* dst, const pg8::Unit& u, int wid, int lane) const {
        if (wid < 4) { const float* src = bd + u.e * D + u.pn * 256 + wid * 64 + lane;
            __builtin_amdgcn_global_load_lds((const unsigned*)src, (PG8_LAS unsigned*)(dst + wid * 256), 4, 0, 0); } }
    __device__ __forceinline__ void operator()(const pg8::f32x4 (&acc)[2][2][4][2], const pg8::Unit& u, int wr, int wc, int fr, int fq, const PG8_LAS float* bl) const {
        const int cl = wc * 32 + 8 * fq, c0 = u.pn * 256 + cl; const float sc = 0.125f / *wscp;
#pragma unroll
        for (int bj = 0; bj < 2; ++bj) { const pg8::f32x4 d0 = *(const PG8_LAS pg8::f32x4*)(bl + cl + bj * 128), d1 = *(const PG8_LAS pg8::f32x4*)(bl + cl + bj * 128 + 4);
#pragma unroll
            for (int ai = 0; ai < 2; ++ai)
#pragma unroll
                for (int m = 0; m < 4; ++m) { const int r = ai * 128 + wr * 64 + m * 16 + fr;
                    const pg8::f32x4 a0 = (acc[ai][bj][m][0] * sc + d0) * YB_SCALE, a1 = (acc[ai][bj][m][1] * sc + d1) * YB_SCALE;
                    v2u w; w.x = pk4_fp8(a0[0], a0[1], a0[2], a0[3]); w.y = pk4_fp8(a1[0], a1[1], a1[2], a1[3]);
                    if (r < u.nrow) *(v2u*)((unsigned char*)YB + (size_t)(u.arow + r) * D + c0 + bj * 128) = w; } }
    }
};
constexpr int CW_RDY = 8448;
constexpr int H2ROW0 = (int)(WS_H2 / 2048), H1ROW0 = (int)(WS_H1 / 2048), DN_BROW0 = (int)((WS_WDN_T - WS_WGU_T) / 2048);
struct MoeFused {
    static constexpr bool GATHER = true;
    const LAS int* tab; const int* elist; gu32* ctl; int G, c, base;
    __device__ __forceinline__ bool next(int i, pg8::Unit& u) const {
        const LAS int* sg = tab + MT_SEG; const int ns = sg[0], L = (base + i) * G + c; if (L >= sg[1 + ns]) return false;
        int s = 0; for (int k = 1; k < ns; ++k) if (sg[1 + k] <= L) s = k;
        if (i > 0 && sg[1 + MT_MAXSEG + s] == 1 && L - sg[1 + 3 * MT_MAXSEG + sg[1 + 2 * MT_MAXSEG + s]] < G) return false;
        const int kind = sg[1 + MT_MAXSEG + s], g = sg[1 + 2 * MT_MAXSEG + s], ui = L - sg[1 + s], TT = tab[64 + NE], tg = (TT - 32 * g) < 32 ? (TT - 32 * g) : 32;
        int rt, pn;
        if (kind == 0) { if (tg == 32) { const int xcd = ui & 7, slot = ui >> 3; rt = xcd * 4 + (slot >> 3); pn = slot & 7; } else { rt = ui >> 3; pn = ui & 7; } }
        else { if (tg == 32) { const int xcd = ui & 7, slot = ui >> 3; rt = xcd * 4 + (slot >> 2); pn = slot & 3; } else { rt = ui >> 2; pn = ui & 3; } }
        const int rtg = 32 * g + rt; int e = 0;
        for (int k = 1; k < NE; ++k) if (tab[64 + k] <= rtg) e = k;
        const int rte = rtg - tab[64 + e], cnt = tab[e], off = tab[32 + e], nr = cnt - rte * 256;
        u.e = __builtin_amdgcn_readfirstlane(e); u.pm = __builtin_amdgcn_readfirstlane(rte); u.pn = __builtin_amdgcn_readfirstlane(pn); u.kind = __builtin_amdgcn_readfirstlane(kind); u.aux = __builtin_amdgcn_readfirstlane(rtg);
        u.arow = __builtin_amdgcn_readfirstlane(off + rte * 256); u.nrow = __builtin_amdgcn_readfirstlane(nr > 256 ? 256 : nr);
        u.brow = __builtin_amdgcn_readfirstlane(kind == 0 ? e * 2048 + pn * 256 : DN_BROW0 + e * 1024 + pn * 256); return true;
    }
    __device__ __forceinline__ int arow_of(const pg8::Unit& u, int r) const { return u.kind == 0 ? H2ROW0 + (r < u.nrow ? elist[u.e * ELCAP + u.pm * 256 + r] : 0) : H1ROW0 + u.arow + (r < u.nrow ? r : 0); }
    __device__ __forceinline__ void a_ready(const pg8::Unit& u) const {
        if (u.kind != 1) return;
        if (threadIdx.x < 64) {
            gu32* w = ctl + CW_RDY + u.aux; const unsigned long long t0 = __builtin_amdgcn_s_memrealtime();
            while ((unsigned)__builtin_amdgcn_readfirstlane(__hip_atomic_load(w, RLX_AGENT)) < 64u) {
                if (__builtin_amdgcn_s_memrealtime() - t0 > 2000000ull) { if (threadIdx.x == 0) __hip_atomic_store(ctl + CW_TMO, 1u, RLX_AGENT); break; }
                __builtin_amdgcn_s_sleep(2); }
#ifdef MOE_DELAY
            { const unsigned long long t1 = __builtin_amdgcn_s_memrealtime(); while (__builtin_amdgcn_s_memrealtime() - t1 < 2000ull) __builtin_amdgcn_s_sleep(8); }
#endif
            __builtin_amdgcn_fence(__ATOMIC_ACQUIRE, "agent");
            asm volatile("s_waitcnt vmcnt(0)" ::: "memory");
        }
        asm volatile("" ::: "memory"); __builtin_amdgcn_s_barrier(); asm volatile("" ::: "memory");
    }
    __device__ __forceinline__ void done(const pg8::Unit& u) const {
        if (u.kind != 0) return;
#ifndef DIAG_NODRAIN
        asm volatile("s_waitcnt vmcnt(0)" ::: "memory");
#endif
#if defined(MOE_REL)
        __builtin_amdgcn_fence(__ATOMIC_RELEASE, "agent"); asm volatile("s_waitcnt vmcnt(0)" ::: "memory");
#endif
        if ((threadIdx.x & 63) == 0) __hip_atomic_fetch_add(ctl + CW_RDY + u.aux, 1u, RLX_AGENT);
    }
};
struct EpiMoe { bf16* H1; bf16* YB; const float* bg; const float* bu; const float* bd;
    __device__ __forceinline__ void operator()(const pg8::f32x4 (&acc)[2][2][4][2], const pg8::Unit& u, int wr, int wc, int fr, int fq) const {
        asm volatile("" : "+v"(fr), "+v"(fq));
        if (u.kind == 0) {
            const int f0 = u.pn * 128 + wc * 32 + 8 * fq;
            const __amdgpu_buffer_rsrc_t h1rs = __builtin_amdgcn_make_buffer_rsrc(H1, 0, (int)((size_t)T * TOPK * FF * 2), 0x00020000);
#pragma unroll
            for (int ai = 0; ai < 2; ++ai) {
                int fb = f0; asm volatile("" : "+v"(fb));
                const pg8::f32x4 g0 = *(const pg8::f32x4*)(bg + u.e * FF + fb), g1 = *(const pg8::f32x4*)(bg + u.e * FF + fb + 4);
                const pg8::f32x4 u0 = *(const pg8::f32x4*)(bu + u.e * FF + fb), u1 = *(const pg8::f32x4*)(bu + u.e * FF + fb + 4);
#pragma unroll
                for (int m = 0; m < 4; ++m) { const int r = ai * 128 + wr * 64 + m * 16 + fr;
                    const pg8::f32x4 a0 = acc[ai][0][m][0] + g0, a1 = acc[ai][0][m][1] + g1, b0 = acc[ai][1][m][0] + u0, b1 = acc[ai][1][m][1] + u1;
                    float gg[8] = {a0[0], a0[1], a0[2], a0[3], a1[0], a1[1], a1[2], a1[3]}, uu[8] = {b0[0], b0[1], b0[2], b0[3], b1[0], b1[1], b1[2], b1[3]}, o[8];
#pragma unroll
                    for (int i = 0; i < 8; ++i) { const float g = fminf(gg[i], 7.f), up = fminf(fmaxf(uu[i], -7.f), 7.f); o[i] = g * sigmoidf_(1.702f * g) * (up + 1.f); }
#ifdef MOE_PLAIN
                    if (r < u.nrow) { v4u w; w.x = pk2(o[0], o[1]); w.y = pk2(o[2], o[3]); w.z = pk2(o[4], o[5]); w.w = pk2(o[6], o[7]); *(GAS v4u*)(H1 + (size_t)(u.arow + r) * FF + fb) = w; } } }
#else
                    if (r < u.nrow) { v4u w; w.x = pk2(o[0], o[1]); w.y = pk2(o[2], o[3]); w.z = pk2(o[4], o[5]); w.w = pk2(o[6], o[7]);
                        __builtin_amdgcn_raw_buffer_store_b128(w, h1rs, (unsigned)((u.arow + r) * (FF * 2) + fb * 2), 0, 16); } } }
#endif
        } else {
            const int c0 = u.pn * 256 + wc * 32 + 8 * fq;
#pragma unroll
            for (int bj = 0; bj < 2; ++bj) { const pg8::f32x4 d0 = *(const pg8::f32x4*)(bd + u.e * D + c0 + bj * 128), d1 = *(const pg8::f32x4*)(bd + u.e * D + c0 + bj * 128 + 4);
#pragma unroll
                for (int ai = 0; ai < 2; ++ai)
#pragma unroll
                    for (int m = 0; m < 4; ++m) { const int r = ai * 128 + wr * 64 + m * 16 + fr;
                        const pg8::f32x4 a0 = acc[ai][bj][m][0] + d0, a1 = acc[ai][bj][m][1] + d1;
                        v4u w; w.x = pk2(a0[0], a0[1]); w.y = pk2(a0[2], a0[3]); w.z = pk2(a1[0], a1[1]); w.w = pk2(a1[2], a1[3]);
                        if (r < u.nrow) *(GAS v4u*)(YB + (size_t)(u.arow + r) * D + c0 + bj * 128) = w; } }
        }
    }
};
__device__ __forceinline__ void phase_final(Frame& F, bool dry = false) {
    moe_tables(F);
    const LAS int* off = (const LAS int*)(F.lds + SCR_OFF) + 32;
    LAS float* gtf = (LAS float*)(F.lds);
    const float* adaf = WSP(float, WS_ADAF);
    for (int i = F.tid; i < 2 * D; i += NWAVES * 64) { const int b = i >> 10, k = i & (D - 1); gtf[i] = adaf[b * 6 * D + 5 * D + k] * WSP(float, WS_PAR)[PAR_FPOST + k]; }
    __syncthreads();
    const int gw = F.vcu * NWAVES + F.wave, NGW = F.G * NWAVES, L = F.lane;
    const int* tok_e = WSP(int, WS_ROUTE); const float* tok_w = (const float*)(tok_e + T * 4); const int* tok_pos = tok_e + 2 * T * 4;
    const bf16* YB = WSP(bf16, WS_YB);
    for (int t = gw * 2; t < T; t += NGW * 2) { const int b = t >> 13;
        int row_l = 0; float w_l = 0.f;
        if (L < 8) { const int idx = (t + (L >> 2)) * 4 + (L & 3); row_l = off[tok_e[idx]] + tok_pos[idx]; w_l = tok_w[idx]; }
        unsigned yv[2][4][4]; f32x4 x1v[2][4]; float wk[2][4];
#pragma unroll
        for (int q = 0; q < 2; ++q) {
#pragma unroll
            for (int k = 0; k < 4; ++k) { const int row = __shfl(row_l, q * 4 + k); wk[q][k] = __shfl(w_l, q * 4 + k);
                const GAS unsigned* yr = (const GAS unsigned*)((const unsigned char*)YB + (size_t)row * D) + L;
#pragma unroll
                for (int j = 0; j < 4; ++j) yv[q][k][j] = __builtin_nontemporal_load(yr + 64 * j);
#ifdef DRY14_NOYB
                if (dry) { _Pragma("unroll") for (int j = 0; j < 4; ++j) yv[q][k][j] = 0x38383838u; }
#endif
            }
            const GAS v2u* xr = (const GAS v2u*)(WSP(bf16, WS_X1B) + (size_t)(t + q) * D) + L;
#pragma unroll
            for (int j = 0; j < 4; ++j) { const v2u xw = __builtin_nontemporal_load(xr + 64 * j); x1v[q][j] = (f32x4){bflo(xw.x), bfhi(xw.x), bflo(xw.y), bfhi(xw.y)}; } }
#pragma unroll
        for (int q = 0; q < 2; ++q) {
            f32x4 y[4];
#pragma unroll
            for (int j = 0; j < 4; ++j) y[j] = (f32x4){0.f, 0.f, 0.f, 0.f};
#pragma unroll
            for (int k = 0; k < 4; ++k)
#pragma unroll
                for (int j = 0; j < 4; ++j) { const unsigned x = yv[q][k][j]; const float w = wk[q][k] * (1.f / YB_SCALE);
                    y[j].x += w * __builtin_amdgcn_cvt_f32_fp8((int)x, 0); y[j].y += w * __builtin_amdgcn_cvt_f32_fp8((int)x, 1); y[j].z += w * __builtin_amdgcn_cvt_f32_fp8((int)x, 2); y[j].w += w * __builtin_amdgcn_cvt_f32_fp8((int)x, 3); }
            float s = 0.f;
#pragma unroll
            for (int j = 0; j < 4; ++j) s += (y[j].x * y[j].x + y[j].y * y[j].y) + (y[j].z * y[j].z + y[j].w * y[j].w);
            const float r = 1.f / sqrtf(wave_sum(s) * (1.f / D) + NORM_EPS);
            GAS f32x4* wrow = dry ? (GAS f32x4*)(WSP(float, WS_WGU_T) + (size_t)(t + q) * D) + L : (GAS f32x4*)(F.out + (size_t)(t + q) * D) + L;
#pragma unroll
            for (int j = 0; j < 4; ++j) { const f32x4 g = *(const LAS f32x4*)(gtf + b * D + 4 * L + 256 * j); __builtin_nontemporal_store(x1v[q][j] + g * (y[j] * r), wrow + 64 * j); }
        }
    }
}
__device__ __forceinline__ bool opaque_ws(Frame& F) { asm volatile("" : "+s"(F.ws)); return true; }
#ifndef MK_N_LAUNCHES
#define MK_N_LAUNCHES 1
#endif
constexpr int N_PHASES = 15;
struct Args { const float* in[30]; float* out; unsigned char* ws; int ph_lo, ph_hi; };
__global__ void __launch_bounds__(NWAVES * 64, 2) mega_fwd(Args args) {
    extern __shared__ __attribute__((aligned(16))) unsigned char lds[];
    Frame F;
    F.lds = (LAS unsigned char*)lds;
    F.MISC = (volatile LAS unsigned*)(F.lds + MISC_OFF);
    F.tid = threadIdx.x; F.lane = F.tid & 63; F.wave = __builtin_amdgcn_readfirstlane(F.tid >> 6);
    F.G = gridDim.x; { const int bx = blockIdx.x; F.vcu = (F.G % 8 == 0) ? (bx % 8) * (F.G / 8) + bx / 8 : bx; }
    F.ws = args.ws; F.ctl = (gu32*)(args.ws + WS_CTL); F.out = args.out;
#pragma unroll
    for (int i = 0; i < 30; ++i) F.in[i] = args.in[i];
    for (int u = F.tid; u < (LDS_BYTES - LDSCTL_OFF) / 4; u += NWAVES * 64) ((LAS unsigned*)(F.lds + LDSCTL_OFF))[u] = 0u;
    __syncthreads();
    XcdBarrier bar; bar.bar = (unsigned*)(F.ctl + CW_BAR); bar.x = 0; bar.st = nullptr;
    if (MK_N_LAUNCHES == 1) bar = xcd_barrier_post((unsigned*)(F.ctl + CW_BAR), F.MISC + 8);
    const int lo = args.ph_lo, hi = args.ph_hi;
#ifndef PHMASK
#define PHMASK 0x7fff
#endif
#define IN(k) (((PHMASK >> (k)) & 1) && lo <= (k) && (k) < hi)
#ifdef TPROBE
#ifndef TPROBE_MULT
#define TPROBE_MULT 2
#endif
#define TP_SLOT ((volatile LAS unsigned long long*)(F.lds + LDSCTL_OFF + 3584))
#define STAMP(k) do { if ((k) == TPROBE && blockIdx.x == 0 && F.tid == 0) TP_SLOT[1] = __builtin_amdgcn_s_memrealtime(); if ((k) == 0 && blockIdx.x == 0 && F.tid == 0) TP_SLOT[0] = __builtin_amdgcn_s_memrealtime(); } while (0)
#elif defined(DBG_A)
#define STAMP(k) do { if (blockIdx.x == 0 && F.tid == 0) ((unsigned long long*)(F.ctl + 2048))[k] = __builtin_amdgcn_s_memrealtime(); } while (0)
#else
#define STAMP(k) do {} while (0)
#endif
#ifndef REP_PHASE
#define REP_PHASE -1
#endif
#ifndef REP_MASK
#define REP_MASK 0
#endif
#define REPL(k) for (int rep_ = 0; rep_ < ((REP_PHASE == (k) || ((REP_MASK >> (k)) & 1)) ? 2 : 1); ++rep_) if (opaque_ws(F))
#ifdef DBL_BAR
#define SEAM(k) do { if (IN(k)) { xcd_barrier(bar); xcd_barrier(bar); } STAMP((k) + 1); } while (0)
#else
#define SEAM(k) do { if (IN(k)) xcd_barrier(bar); STAMP((k) + 1); } while (0)
#endif
    PG8_LAS unsigned char* ring = F.lds + RING_OFF;
    const int bx = (int)blockIdx.x;

    STAMP(0);
#ifdef DIAG_WARM
    { typedef float f4_ __attribute__((ext_vector_type(4))); typedef short s8_ __attribute__((ext_vector_type(8))); f4_ a_ = {0.f, 0.f, 0.f, 0.f}; s8_ x_ = {1, 2, 3, 4, 5, 6, 7, 8};
      const unsigned long long t0_ = __builtin_amdgcn_s_memrealtime();
      while (__builtin_amdgcn_s_memrealtime() - t0_ < (unsigned long long)(DIAG_WARM * 100)) { _Pragma("unroll") for (int i_ = 0; i_ < 16; ++i_) a_ = __builtin_amdgcn_mfma_f32_16x16x32_bf16(x_, x_, a_, 0, 0, 0); }
      if (a_[0] == 12345.f) F.out[0] = a_[1]; }
#endif
    if (IN(0)) REPL(0) { phase0(F); } SEAM(0);
    if (IN(1)) REPL(1) { phase1(F); } SEAM(1);
    if (IN(2)) REPL(2) {
#ifdef G1_MIX
        {
            pg8::Gemm g{WSP(bf16, WS_XN8), WSP(bf16, WS_WIN8), D / 2, D / 2, D / 2}; pg8::ColSubsetOrder S;
#ifdef G1_MIX_GATES
            S.d.init(T, 8 * 256, F.G, bx); S.base = 8; S.split = 8; S.skip = 0;
#else
            S.d.init(T, 12 * 256, F.G, bx); S.base = 0; S.split = 2; S.skip = 4;
#endif
            EpiG1 E{WSP(bf16, WS_UA), WSP(bf16, WS_Q), WSP(bf16, WS_K), WSP(bf16, WS_V), WSP(bf16, WS_VT), WSP(bf16, WS_GS), WSP(bf16, WS_GA),
                    WSP(float, WS_ROPE), WSP(float, WS_ROPE) + (size_t)T * 32, (float*)(F.ctl + CW_KM), WSP(float, WS_PAR) + PAR_WSC1, true};
            pg8::gemm_phase<EpiG1, pg8::ColSubsetOrder, true>(ring, g, S, E); }
        {
            pg8::Gemm g{WSP(bf16, WS_XN), WSP(bf16, WS_WIN_T), D, D, D}; pg8::ColSubsetOrder S;
#ifdef G1_MIX_GATES
            S.d.init(T, 8 * 256, F.G, bx); S.base = 0; S.split = 8; S.skip = 0;
#else
            S.d.init(T, 4 * 256, F.G, bx); S.base = 2; S.split = 4; S.skip = 0;
#endif
            EpiG1 E{WSP(bf16, WS_UA), WSP(bf16, WS_Q), WSP(bf16, WS_K), WSP(bf16, WS_V), WSP(bf16, WS_VT), WSP(bf16, WS_GS), WSP(bf16, WS_GA),
                    WSP(float, WS_ROPE), WSP(float, WS_ROPE) + (size_t)T * 32, (float*)(F.ctl + CW_KM), WSP(float, WS_PAR) + PAR_WSC1, false};
            pg8::gemm_phase<EpiG1, pg8::ColSubsetOrder, false>(ring, g, S, E); }
#else
#ifdef G1_F8
        pg8::Gemm g{WSP(bf16, WS_XN), WSP(bf16, WS_WIN_T), D / 2, D / 2, D / 2}; pg8::DenseOrder S; S.init(T, INW, F.G, bx);
#else
        pg8::Gemm g{WSP(bf16, WS_XN), WSP(bf16, WS_WIN_T), D, D, D}; pg8::DenseOrder S; S.init(T, INW, F.G, bx);
#endif
        EpiG1 E{WSP(bf16, WS_UA), WSP(bf16, WS_Q), WSP(bf16, WS_K), WSP(bf16, WS_V), WSP(bf16, WS_VT), WSP(bf16, WS_GS), WSP(bf16, WS_GA),
                WSP(float, WS_ROPE), WSP(float, WS_ROPE) + (size_t)T * 32, (float*)(F.ctl + CW_KM), WSP(float, WS_PAR) + PAR_WSC1,
#ifdef G1_F8
                true};
#else
                false};
#endif
#ifdef G1_F8
        pg8::gemm_phase<EpiG1, pg8::DenseOrder, true>(ring, g, S, E);
#else
        pg8::gemm_phase(ring, g, S, E);
#endif
#endif
        s5_fill_kt(F);
    } SEAM(2);
    if (IN(3)) REPL(3) {
        pg8::Gemm g{WSP(bf16, WS_UA), WSP(bf16, WS_S5M1), 384, 256, 256}; S5Order S{F.G, bx}; EpiS5A E{WSP(float, WS_S5E)};
        pg8::gemm_phase(ring, g, S, E);
        s5_fill_wc(F);
        attn_gate(F);
#ifdef MOE_F8
        moe_convert_idle(F, MOE_ITEMS_P0, MOE_ITEMS_P3);
#endif
    } SEAM(3);
    if (IN(4)) REPL(4) { attn_items(F); s5_carry(F); } SEAM(4);
    if (IN(5)) REPL(5) {
        pg8::Gemm g{WSP(bf16, WS_UA), WSP(bf16, WS_S5WC), 384, 384, 384}; S5Order S{F.G, bx}; EpiS5C E{WSP(bf16, WS_YG)};
        pg8::gemm_phase(ring, g, S, E);
        attn_combine(F);
#ifdef MOE_F8
        moe_convert_idle(F, MOE_ITEMS_P0 + MOE_ITEMS_P3, MOE_ITEMS_P5);
#endif
    } SEAM(5);
    if (IN(6)) REPL(6) {
        pg8::Gemm g{WSP(bf16, WS_YG), WSP(bf16, WS_WGLU_T), SW, SW, SW}; pg8::DenseOrder S; S.init(T, SW, F.G, bx);
        EpiEw<0> E{WSP(bf16, WS_Y2), WSP(bf16, WS_YG), nullptr, nullptr, SW};
        pg8::gemm_phase(ring, g, S, E);
#ifdef MOE_F8
        moe_convert_idle(F, MOE_ITEMS_P0 + MOE_ITEMS_P3 + MOE_ITEMS_P5, MOE_ITEMS_P6);
#endif
    } SEAM(6);
    if (IN(7)) REPL(7) {
        pg8::Gemm g{WSP(bf16, WS_Y2), WSP(bf16, WS_WSB_T), SW, SW, SW}; pg8::DenseOrder S; S.init(T, D, F.G, bx);
        EpiEw<1> E{WSP(bf16, WS_M1), WSP(bf16, WS_GS), nullptr, nullptr, D};
        pg8::gemm_phase(ring, g, S, E);
    }
    if (IN(7)) { asm volatile("s_waitcnt vmcnt(0)" ::: "memory"); __syncthreads(); if (F.tid < 64) { __builtin_amdgcn_fence(__ATOMIC_ACQUIRE, "agent"); asm volatile("s_waitcnt vmcnt(0)" ::: "memory"); } __syncthreads(); STAMP(8); }
    if (IN(8)) REPL(8) {
        pg8::Gemm g{WSP(bf16, WS_YA), WSP(bf16, WS_WAB_T), AW, AW, AW}; pg8::DenseOrder S; S.init(T, D, F.G, bx);
        EpiEw<2> E{WSP(bf16, WS_XN), WSP(bf16, WS_GA), WSP(bf16, WS_M1), nullptr, D};
        pg8::gemm_phase(ring, g, S, E);
    } SEAM(8);
    if (IN(9)) REPL(9) {
        pg8::Gemm g{WSP(bf16, WS_XN), WSP(bf16, WS_WOUT_T), D, D, D}; pg8::DenseOrder S; S.init(T, D, F.G, bx);
        EpiEw<4> E{WSP(bf16, WS_MIX), nullptr, nullptr, nullptr, D};
        pg8::gemm_phase(ring, g, S, E);
    } SEAM(9);
    if (IN(10)) REPL(10) { phase_rows(F, (REP_PHASE == 10 || ((REP_MASK >> 10) & 1)) && rep_ == 0); } SEAM(10);
#ifndef MOE_FUSED
#ifdef MOE_F8
    if (IN(12)) REPL(12) {
        moe_tables(F, 8, 2048);
        pg8::Gemm g{WSP(bf16, WS_H2), WSP(bf16, WS_WGU_T), D / 2, D / 2, D / 2}; MoeOrder<true> S{(const LAS int*)(F.lds + SCR_OFF), WSP(int, WS_ELIST), 8, 2048, F.G, bx};
        EpiGU8 E{WSP(unsigned char, WS_H1), WSP(float, WS_PAR) + PAR_BG, WSP(float, WS_PAR) + PAR_BU, WSP(float, WS_PAR) + PAR_WSC};
        pg8::gemm_phase<EpiGU8, MoeOrder<true>, true>(ring, g, S, E);
    } SEAM(12);
    if (IN(13)) REPL(13) {
        moe_tables(F, 4, 1024);
        pg8::Gemm g{WSP(bf16, WS_H1), WSP(bf16, WS_WDN_T), FF / 2, FF / 2, FF / 2}; MoeOrder<false> S{(const LAS int*)(F.lds + SCR_OFF), nullptr, 4, 1024, F.G, bx};
        EpiDn8 E{WSP(bf16, WS_YB), WSP(float, WS_PAR) + PAR_BD, WSP(float, WS_PAR) + PAR_WSC};
        pg8::gemm_phase<EpiDn8, MoeOrder<false>, true>(ring, g, S, E);
    } SEAM(13);
#else
    if (IN(12)) REPL(12) {
        moe_tables(F, 8, 2048);
        pg8::Gemm g{WSP(bf16, WS_H2), WSP(bf16, WS_WGU_T), D, D, D}; MoeOrder<true> S{(const LAS int*)(F.lds + SCR_OFF), WSP(int, WS_ELIST), 8, 2048, F.G, bx};
        EpiGU E{WSP(bf16, WS_H1), WSP(float, WS_PAR) + PAR_BG, WSP(float, WS_PAR) + PAR_BU};
        pg8::gemm_phase(ring, g, S, E);
    } SEAM(12);
    if (IN(13)) REPL(13) {
        moe_tables(F, 4, 1024);
        pg8::Gemm g{WSP(bf16, WS_H1), WSP(bf16, WS_WDN_T), FF, FF, FF}; MoeOrder<false> S{(const LAS int*)(F.lds + SCR_OFF), nullptr, 4, 1024, F.G, bx};
        EpiDn E{WSP(bf16, WS_YB), WSP(float, WS_PAR) + PAR_BD};
        pg8::gemm_phase(ring, g, S, E);
    } SEAM(13);
#endif
#else
    if (IN(12)) REPL(12) {
        moe_tables(F);
        pg8::Gemm g{(const bf16*)F.ws, WSP(bf16, WS_WGU_T), D, D, D};
        EpiMoe E{WSP(bf16, WS_H1), WSP(bf16, WS_YB), WSP(float, WS_PAR) + PAR_BG, WSP(float, WS_PAR) + PAR_BU, WSP(float, WS_PAR) + PAR_BD};
        for (int base = 0;;) { MoeFused S{(const LAS int*)(F.lds + SCR_OFF), WSP(int, WS_ELIST), F.ctl, F.G, bx, base};
            const int nd = pg8::gemm_phase(ring, g, S, E); if (nd == 0) break; base += nd; }
    } SEAM(12);
#endif
    if (IN(14)) REPL(14) { phase_final(F, (REP_PHASE == 14 || ((REP_MASK >> 14) & 1)) && rep_ == 0); }
#ifdef TPROBE
    if (blockIdx.x == 0 && F.tid == 0) { const unsigned long long t0_ = TP_SLOT[0], tk_ = TP_SLOT[1], te_ = __builtin_amdgcn_s_memrealtime();
        while (__builtin_amdgcn_s_memrealtime() - te_ < (tk_ - t0_) * TPROBE_MULT) __builtin_amdgcn_s_sleep(8); }
#endif
#undef IN
#undef SEAM
}

extern "C" void kernel_launch(void* const* d_in, const int* in_sizes, int n_in, void* d_out, int out_size, void* d_ws, size_t ws_size, hipStream_t stream) {
    static int grid = 0;
    if (grid == 0) {
        if (n_in != 30 || in_sizes[0] != T * D || out_size != T * D || ws_size < WS_END) { fprintf(stderr, "kernel_launch: unexpected shapes (n_in %d, in0 %d, out %d, ws %zu)\n", n_in, n_in > 0 ? in_sizes[0] : -1, out_size, ws_size); grid = -1; return; }
        int dev = 0, cus = 0, per_cu = 0;
        if (hipGetDevice(&dev) != hipSuccess || hipDeviceGetAttribute(&cus, hipDeviceAttributeMultiprocessorCount, dev) != hipSuccess) { grid = -1; return; }
        if (hipFuncSetAttribute((const void*)mega_fwd, hipFuncAttributeMaxDynamicSharedMemorySize, LDS_BYTES) != hipSuccess) { fprintf(stderr, "kernel_launch: hipFuncSetAttribute failed\n"); grid = -1; return; }
        if (hipOccupancyMaxActiveBlocksPerMultiprocessor(&per_cu, (const void*)mega_fwd, NWAVES * 64, LDS_BYTES) != hipSuccess || per_cu < 1) { fprintf(stderr, "kernel_launch: occupancy query says %d\n", per_cu); }
        (void)hipGetLastError();
        grid = cus;
    }
    if (grid < 0) return;
    (void)hipMemsetAsync((char*)d_ws + WS_CTL, 0, CTL_ZERO_USED, stream);
    Args a{};
    for (int i = 0; i < 30; ++i) a.in[i] = (const float*)d_in[i];
    a.out = (float*)d_out; a.ws = (unsigned char*)d_ws;
#ifndef PLAIN_LAUNCH
    if (MK_N_LAUNCHES == 1) { a.ph_lo = 0; a.ph_hi = N_PHASES; void* kargs[] = {(void*)&a};
        const hipError_t e = hipLaunchCooperativeKernel((const void*)mega_fwd, dim3(grid), dim3(NWAVES * 64), kargs, LDS_BYTES, stream);
        if (e != hipSuccess) fprintf(stderr, "kernel_launch: cooperative launch failed: %s\n", hipGetErrorString(e)); }
#else
    if (MK_N_LAUNCHES == 1) { a.ph_lo = 0; a.ph_hi = N_PHASES; hipLaunchKernelGGL(mega_fwd, dim3(grid), dim3(NWAVES * 64), LDS_BYTES, stream, a); }
#endif
    else for (int p = 0; p < N_PHASES; ++p) { a.ph_lo = p; a.ph_hi = p + 1; hipLaunchKernelGGL(mega_fwd, dim3(grid), dim3(NWAVES * 64), LDS_BYTES, stream, a); }
}
```
